# Optimizing an MI355X kernel written in HIP

```python
import jax, jax.numpy as jnp
from jax import lax
import numpy as np

D_MODEL = 1024
BATCH = 8
SEQ = 4096
DEPTH = 1

GMLP_WIDTH = D_MODEL
GMLP_GROUPS = 4
GMLP_CHUNK = 128
N_HEADS = 8
HEAD_DIM = D_MODEL // N_HEADS
ATTN_WIDTH = N_HEADS * HEAD_DIM
MOBA_BLOCK = 256
MOBA_TOPK = 3
MOBA_QCHUNK = 16
N_EXPERTS = 32
TOP_K = 4
D_EXPERT = D_MODEL
SWIGLU_LIMIT = 7.0
SWIGLU_ALPHA = 1.702
MOE_BLOCK = 256
LN_EPS = 1e-5
DEEPNORM_ALPHA = (2 * DEPTH) ** 0.25
DEEPNORM_BETA = (8 * DEPTH) ** -0.25
IN_SPLITS = (GMLP_WIDTH, GMLP_WIDTH, ATTN_WIDTH, ATTN_WIDTH, ATTN_WIDTH, D_MODEL, D_MODEL)
IN_COLS = sum(IN_SPLITS)

kernel_name = "hybrid_gmlp_moba_moe_deepnorm"


def layer_norm(x, g, b):
    xf = x.astype(jnp.float32)
    mu = jnp.mean(xf, axis=-1, keepdims=True)
    var = jnp.mean(jnp.square(xf - mu), axis=-1, keepdims=True)
    y = (xf - mu) * lax.rsqrt(var + LN_EPS)
    return (y * g.astype(jnp.float32) + b.astype(jnp.float32)).astype(x.dtype)


def chunked_spatial_gating(u, v, w_s, b_s, ln_g, ln_b):
    B, S, _ = u.shape
    C = GMLP_CHUNK
    nc = S // C
    gd = GMLP_WIDTH // GMLP_GROUPS
    v = layer_norm(v, ln_g, ln_b).reshape(B, nc, C, GMLP_GROUPS, gd)
    causal = jnp.tril(jnp.ones((C, C), dtype=bool))
    w = jnp.where(causal[None], w_s, jnp.zeros_like(w_s))
    vs = jnp.einsum('gts,bcsgd->bctgd', w, v) + b_s.T[None, None, :, :, None]
    return u * vs.reshape(B, S, GMLP_WIDTH)


def moba_attention(q, k, v):
    B, H, S, dh = q.shape
    L = MOBA_BLOCK
    nb = -(-S // L)
    Sp = nb * L
    padw = ((0, 0), (0, 0), (0, Sp - S), (0, 0))
    q = jnp.pad(q, padw)
    k = jnp.pad(k, padw)
    v = jnp.pad(v, padw)
    kb = k.reshape(B, H, nb, L, dh)
    vb = v.reshape(B, H, nb, L, dh)
    k_mean = jnp.mean(kb.astype(jnp.float32), axis=3)
    gate = jnp.einsum('bhsd,bhnd->bhsn', q.astype(jnp.float32), k_mean)
    q_blk = jnp.arange(Sp) // L
    past = jnp.arange(nb)[None, :] < q_blk[:, None]
    gate = jnp.where(past, gate, -jnp.inf)
    topk = min(MOBA_TOPK, nb)
    _, sel = lax.top_k(gate, topk)
    sel_ok = sel < q_blk[:, None]
    scale = dh ** -0.5
    QC = MOBA_QCHUNK
    bi = jnp.arange(B)[:, None, None, None]
    hi = jnp.arange(H)[None, :, None, None]

    def query_chunk(c):
        s0 = c * QC
        qc = lax.dynamic_slice_in_dim(q, s0, QC, axis=2)
        idx = lax.dynamic_slice_in_dim(sel, s0, QC, axis=2)
        ok = lax.dynamic_slice_in_dim(sel_ok, s0, QC, axis=2)
        k_sel = kb[bi, hi, idx]
        v_sel = vb[bi, hi, idx]
        own = s0 // L
        k_own = lax.dynamic_index_in_dim(kb, own, axis=2, keepdims=False)
        v_own = lax.dynamic_index_in_dim(vb, own, axis=2, keepdims=False)
        s_sel = jnp.einsum('bhqd,bhqnld->bhqnl', qc, k_sel).astype(jnp.float32) * scale
        s_sel = jnp.where(ok[..., None], s_sel, -jnp.inf)
        s_own = jnp.einsum('bhqd,bhld->bhql', qc, k_own).astype(jnp.float32) * scale
        causal = (own * L + jnp.arange(L))[None, :] <= (s0 + jnp.arange(QC))[:, None]
        s_own = jnp.where(causal, s_own, -jnp.inf)
        s_all = jnp.concatenate([s_sel.reshape(B, H, QC, topk * L), s_own], axis=-1)
        p = jax.nn.softmax(s_all, axis=-1).astype(v.dtype)
        p_sel = p[..., :topk * L].reshape(B, H, QC, topk, L)
        p_own = p[..., topk * L:]
        return (jnp.einsum('bhqnl,bhqnld->bhqd', p_sel, v_sel)
                + jnp.einsum('bhql,bhld->bhqd', p_own, v_own))

    outs = lax.map(query_chunk, jnp.arange(Sp // QC))
    out = outs.transpose(1, 2, 0, 3, 4).reshape(B, H, Sp, dh)
    return out[:, :, :S]


def moe_ffn(h, w_router, b_router, w_up, b_up, w_down, b_down):
    B, S, D = h.shape
    x = h.reshape(-1, D)
    T = x.shape[0]
    F = D_EXPERT
    M = MOE_BLOCK
    logits = (x @ w_router).astype(jnp.float32) + b_router.astype(jnp.float32)
    top_val, top_idx = lax.top_k(logits, TOP_K)
    gate = jax.nn.softmax(top_val, axis=-1)
    A = T * TOP_K
    R = (-(-A // M)) * M + N_EXPERTS * M
    flat_e = top_idx.reshape(-1)
    flat_tok = jnp.arange(A, dtype=jnp.int32) // TOP_K
    flat_w = gate.reshape(-1)
    order = jnp.argsort(flat_e)
    e_sorted = flat_e[order]
    counts = jnp.bincount(flat_e, length=N_EXPERTS)
    padded = (counts + M - 1) // M * M
    start = jnp.cumsum(counts) - counts
    pend = jnp.cumsum(padded)
    pstart = pend - padded
    dest = pstart[e_sorted] + jnp.arange(A) - start[e_sorted]
    row_tok = jnp.zeros((R,), jnp.int32).at[dest].set(flat_tok[order])
    row_w = jnp.zeros((R,), jnp.float32).at[dest].set(flat_w[order])
    n_blocks = R // M
    block_e = jnp.minimum(jnp.searchsorted(pend, jnp.arange(n_blocks) * M, side='right'),
                          N_EXPERTS - 1)

    def expert_block(args):
        e, tok = args
        xe = x[tok]
        gu = xe @ w_up[e] + b_up[e]
        g = jnp.minimum(gu[:, :F], SWIGLU_LIMIT)
        u = jnp.clip(gu[:, F:], -SWIGLU_LIMIT, SWIGLU_LIMIT)
        act = (u + 1.0) * (g * jax.nn.sigmoid(SWIGLU_ALPHA * g))
        return act @ w_down[e] + b_down[e]

    y = lax.map(expert_block, (block_e, row_tok.reshape(n_blocks, M)))
    y = y.reshape(R, D) * row_w[:, None].astype(y.dtype)
    out = jnp.zeros_like(x).at[row_tok].add(y)
    return out.reshape(B, S, D)


def setup_inputs(seed: int = 0) -> dict:
    key = jax.random.key(seed)
    ks = jax.random.split(key, 24)
    f32 = jnp.float32

    def nrm(k, shape, scale):
        return jax.random.normal(k, shape, f32) * scale

    D, L, E, F = D_MODEL, DEPTH, N_EXPERTS, D_EXPERT
    C, G = GMLP_CHUNK, GMLP_GROUPS
    return {
        "x": nrm(ks[0], (BATCH, SEQ, D), 1.0),
        "ln_in_g": 1.0 + nrm(ks[1], (D,), 0.02),
        "ln_in_b": nrm(ks[2], (D,), 0.02),
        "w_in": nrm(ks[3], (L, D, IN_COLS), D ** -0.5),
        "gmlp_ln_g": 1.0 + nrm(ks[4], (L, GMLP_WIDTH), 0.02),
        "gmlp_ln_b": nrm(ks[5], (L, GMLP_WIDTH), 0.02),
        "w_spatial": nrm(ks[6], (L, G, C, C), C ** -0.5),
        "b_spatial": 1.0 + nrm(ks[7], (L, G, C), 0.02),
        "w_branch_a": nrm(ks[8], (L, GMLP_WIDTH, D), GMLP_WIDTH ** -0.5),
        "w_branch_b": nrm(ks[9], (L, ATTN_WIDTH, D), ATTN_WIDTH ** -0.5),
        "w_out": nrm(ks[10], (L, D, D), DEEPNORM_BETA * D ** -0.5),
        "ln_mix_g": 1.0 + nrm(ks[11], (L, D), 0.02),
        "ln_mix_b": nrm(ks[12], (L, D), 0.02),
        "w_router": nrm(ks[13], (L, D, E), D ** -0.5),
        "b_router": nrm(ks[14], (L, E), 0.01),
        "w_up": nrm(ks[15], (L, E, D, 2 * F), D ** -0.5),
        "b_up": nrm(ks[16], (L, E, 2 * F), 0.01),
        "w_down": nrm(ks[17], (L, E, F, D), DEEPNORM_BETA * F ** -0.5),
        "b_down": nrm(ks[18], (L, E, D), 0.01),
        "ln_ffn_g": 1.0 + nrm(ks[19], (L, D), 0.02),
        "ln_ffn_b": nrm(ks[20], (L, D), 0.02),
    }


def reference(x, ln_in_g, ln_in_b, w_in, gmlp_ln_g, gmlp_ln_b, w_spatial, b_spatial,
              w_branch_a, w_branch_b, w_out, ln_mix_g, ln_mix_b, w_router, b_router,
              w_up, b_up, w_down, b_down, ln_ffn_g, ln_ffn_b):
    B, S, D = x.shape
    offsets = list(np.cumsum(IN_SPLITS)[:-1])
    h = layer_norm(x, ln_in_g, ln_in_b)
    for l in range(DEPTH):
        p = h @ w_in[l]
        u_a, v_a, q, k, v, g_a, g_b = jnp.split(p, offsets, axis=-1)
        y_a = chunked_spatial_gating(jax.nn.gelu(u_a, approximate=False),
                                     jax.nn.gelu(v_a, approximate=False),
                                     w_spatial[l], b_spatial[l], gmlp_ln_g[l], gmlp_ln_b[l])
        def heads(t):
            return t.reshape(B, S, N_HEADS, HEAD_DIM).transpose(0, 2, 1, 3)
        y_b = moba_attention(heads(q), heads(k), heads(v))
        y_b = y_b.transpose(0, 2, 1, 3).reshape(B, S, ATTN_WIDTH)
        merged = (jax.nn.sigmoid(g_a) * (y_a @ w_branch_a[l])
                  + jax.nn.sigmoid(g_b) * (y_b @ w_branch_b[l]))
        h = layer_norm(DEEPNORM_ALPHA * h + merged @ w_out[l], ln_mix_g[l], ln_mix_b[l])
        f = moe_ffn(h, w_router[l], b_router[l], w_up[l], b_up[l], w_down[l], b_down[l])
        h = layer_norm(DEEPNORM_ALPHA * h + f, ln_ffn_g[l], ln_ffn_b[l])
    return h
```

```cpp
#include <hip/hip_runtime.h>
#include <hip/hip_cooperative_groups.h>
#include <cstdio>
#include <cstdint>
namespace cg = cooperative_groups;

#ifndef MK_COOP
#define MK_COOP 0
#endif

#define LAS __attribute__((address_space(3)))
typedef unsigned short bf16_t;
typedef short bf16x8 __attribute__((ext_vector_type(8)));
typedef float f32x4 __attribute__((ext_vector_type(4)));
typedef float f32x2 __attribute__((ext_vector_type(2)));
typedef unsigned u32x4 __attribute__((ext_vector_type(4)));
typedef unsigned u32x2 __attribute__((ext_vector_type(2)));

constexpr int NB = 8, SEQ = 4096, DM = 1024, T = NB * SEQ;
constexpr int NH = 8, DH = 128, LBLK = 256, NBLK = SEQ / LBLK;
constexpr int NE = 32, TOPK = 4, FF = 1024;
constexpr int INCOLS = 7 * DM;
constexpr int RMAX = T * TOPK + NE * 256;
constexpr float LN_EPS = 1e-5f;
constexpr float ALPHA = 1.189207115002721f;
constexpr float QSCALE = 0.08838834764831845f * 1.4426950408889634f;

constexpr size_t MiB = 1u << 20, U64 = 64 * MiB;
constexpr size_t WS_CTL = 0, CTL_ZERO_BYTES = 1 * MiB;
constexpr int CW_ECNT = 64;
constexpr int CW_LCNT = 1024;
constexpr int CW_BAR = 4096;
constexpr size_t WS_KMEAN = 1 * MiB;
constexpr size_t WS_GVST = 2 * MiB;
constexpr size_t WS_ZST = 6 * MiB;
constexpr size_t WS_SEL = 10 * MiB;
constexpr size_t WS_TKE = 11 * MiB;
constexpr size_t WS_TKW = 11 * MiB + 512 * 1024;
constexpr size_t WS_TKP = 12 * MiB;
constexpr size_t WS_ROWOF = 12 * MiB + 512 * 1024;
constexpr size_t WS_ROWTOK = 13 * MiB;
constexpr size_t WS_ROWW = 14 * MiB;
constexpr size_t WS_TILE = 15 * MiB;
constexpr size_t WS_LISTS = 16 * MiB;
constexpr size_t WS_LSE = 32 * MiB;
constexpr size_t WS_WIN = 40 * MiB;
constexpr size_t WS_WAB = 54 * MiB;
constexpr size_t WS_WOUT = 58 * MiB;
constexpr size_t WS_WDN = 60 * MiB;
constexpr size_t WS_WUP = 124 * MiB;
constexpr size_t WS_H0 = 4 * U64;
constexpr size_t WS_YAB = 5 * U64;
constexpr size_t WS_GV = 7 * U64;
constexpr size_t WS_Q = 8 * U64, WS_K = 9 * U64, WS_V = 10 * U64, WS_SA = 11 * U64, WS_SB = 12 * U64;
constexpr size_t WS_OP = 13 * U64;
constexpr size_t WS_MG = WS_GV;
constexpr size_t WS_Z = 14 * U64;
constexpr size_t WS_H1 = WS_H0;
constexpr size_t WS_XG = 5 * U64;
constexpr size_t WS_ACT = 9 * U64 + 16 * MiB;
constexpr size_t WS_YS = WS_XG;
constexpr size_t WS_END = 16 * U64;
static_assert(WS_XG + (size_t)RMAX * 2048 <= WS_ACT && WS_ACT + (size_t)RMAX * 2048 <= WS_Z, "ws map");

constexpr int LDS_BYTES = 147456;
constexpr int LDS_MISC = 131072;
constexpr int NPHASE = 12;

__device__ __forceinline__ float bf2f(bf16_t v) { return __uint_as_float((unsigned)v << 16); }
__device__ __forceinline__ float bflo(unsigned u) { return __uint_as_float(u << 16); }
__device__ __forceinline__ float bfhi(unsigned u) { return __uint_as_float(u & 0xffff0000u); }
__device__ __forceinline__ unsigned f2bf(float f) { unsigned u = __builtin_bit_cast(unsigned, f); return (u + 0x7fffu + ((u >> 16) & 1u)) >> 16; }
__device__ __forceinline__ unsigned pk2(float lo, float hi) { return f2bf(lo) | (f2bf(hi) << 16); }
typedef __bf16 bf16x2_t __attribute__((ext_vector_type(2)));
__device__ __forceinline__ unsigned cvt_pk_bf16(float lo, float hi) { f32x2 v = {lo, hi}; bf16x2_t b = __builtin_convertvector(v, bf16x2_t); return __builtin_bit_cast(unsigned, b); }
__device__ __forceinline__ int lane_id_asm() { int l; asm volatile("v_mbcnt_lo_u32_b32 %0, -1, 0\n\tv_mbcnt_hi_u32_b32 %0, -1, %0" : "=v"(l)); return l; }
__device__ __forceinline__ float wave_sum(float v) {
#pragma unroll
    for (int o = 1; o < 64; o <<= 1) v += __shfl_xor(v, o);
    return v;
}
__device__ __forceinline__ float wave_max(float v) {
#pragma unroll
    for (int o = 1; o < 64; o <<= 1) v = fmaxf(v, __shfl_xor(v, o));
    return v;
}
__device__ __forceinline__ f32x2 gelu_pk(f32x2 v) {
    const f32x2 av = __builtin_elementwise_abs(v), d = av * 0.2316418882f + 1.0f;
    f32x2 t; t.x = __builtin_amdgcn_rcpf(d.x); t.y = __builtin_amdgcn_rcpf(d.y);
    f32x2 q = t * 0.5307027145f + (-0.7265760135f); q = q * t + 0.7107068705f; q = q * t + (-0.142248368f); q = q * t + 0.127414796f; q = q * t;
    const f32x2 s = (v * v) * (-0.72134752044f);
    f32x2 e; e.x = __builtin_amdgcn_exp2f(s.x); e.y = __builtin_amdgcn_exp2f(s.y);
    const f32x2 m = v * (q * e), r = v - m;
    f32x2 o; o.x = v.x < 0.f ? m.x : r.x; o.y = v.y < 0.f ? m.y : r.y; return o;
}
__device__ __forceinline__ float sigmoidf_(float x) { return __builtin_amdgcn_rcpf(1.0f + __builtin_amdgcn_exp2f(-1.4426950408889634f * x)); }

namespace pg8 {
constexpr int BM = 256, BK = 64, HALF = 128, HTB = HALF * BK * 2, STAGE_BYTES = 8 * HTB, NXCD = 8, WGM = 8;
__host__ __device__ __forceinline__ int lds_byte(int r, int c) { const int st = (r >> 4) * 2 + (c >> 5), rr = r & 15, cc = c & 31, ob = rr * 64 + cc * 2; return st * 1024 + (ob ^ (((ob >> 9) & 1) << 5)); }
__host__ __device__ __forceinline__ void stage_rc(int b, int& R, int& C) { const int st = b / 1024, sb = b % 1024, swz = sb ^ (((sb >> 9) & 1) << 5); R = (st >> 1) * 16 + swz / 64; C = (st & 1) * 32 + (swz % 64) / 2; }
__host__ __device__ __forceinline__ int perm32(int rho) { const int n = rho >> 4, i = rho & 15; return 8 * (i >> 2) + 4 * n + (i & 3); }

struct Unit { int pm, pn, bt; };
struct Gemm { const bf16_t* A; const bf16_t* Bt; int K, lda, ldb; };

struct StaticOrder {
    int nM, nN, nwg, G, c;
    __device__ void init(int M, int N, int G_, int c_) { nM = M / BM; nN = N / BM; nwg = nM * nN; G = G_; c = c_; }
    __device__ bool next(int i, Unit& u) const {
        const long L = (long)i * G + c; if (L >= nwg) return false;
        int wgid = (int)L; { const int q = nwg / NXCD, r = nwg % NXCD, xcd = wgid % NXCD, off = wgid / NXCD; wgid = (xcd < r ? xcd * (q + 1) : r * (q + 1) + (xcd - r) * q) + off; }
        const int nig = WGM * nN, gid = wgid / nig, fm = gid * WGM, gsz = (nM - fm) < WGM ? (nM - fm) : WGM;
        u.pm = fm + ((wgid % nig) % gsz); u.pn = (wgid % nig) / gsz; u.bt = u.pn; return true;
    }
};
struct MoeOrder {
    int nM, nN, nwg, G, c; const int* tile_e;
    __device__ void init(const int* tiletab, int nN_, int G_, int c_) { nM = tiletab[0]; tile_e = tiletab + 16; nN = nN_; nwg = nM * nN; G = G_; c = c_; }
    __device__ bool next(int i, Unit& u) const {
        const long L = (long)i * G + c; if (L >= nwg) return false;
        int wgid = (int)L; { const int q = nwg / NXCD, r = nwg % NXCD, xcd = wgid % NXCD, off = wgid / NXCD; wgid = (xcd < r ? xcd * (q + 1) : r * (q + 1) + (xcd - r) * q) + off; }
        const int nig = WGM * nN, gid = wgid / nig, fm = gid * WGM, gsz = (nM - fm) < WGM ? (nM - fm) : WGM;
        u.pm = fm + ((wgid % nig) % gsz); u.pn = (wgid % nig) / gsz; u.bt = tile_e[u.pm] * nN + u.pn; return true;
    }
};

template <class Epi, class Sched, bool ALIGN_EPI>
__device__ __forceinline__ void gemm_phase(LAS unsigned char* lds, const Gemm g, const Sched& S, const Epi& E, const int wid) {
    const int lane = lane_id_asm(), tid = wid * 64 + lane;
    const int wr = wid >> 2, wc = wid & 3, fr = lane & 15, fq = lane >> 4;
    const int nt = g.K / BK;
    unsigned voffA[2], voffB[2];
#pragma unroll
    for (int i = 0; i < 2; ++i) { int R, C; stage_rc(tid * 16 + i * 8192, R, C); const int Rb = Epi::PERM ? ((R & ~31) + perm32(R & 31)) : R;
        voffA[i] = (unsigned)(R * g.lda + C) * 2u; voffB[i] = (unsigned)(Rb * g.ldb + C) * 2u; }
    const size_t kstep = (size_t)(BK * 2);
    const size_t hstepA = (size_t)HALF * g.lda * 2, hstepB = (size_t)HALF * g.ldb * 2;
    const size_t tstepA = 2 * hstepA, tstepB = 2 * hstepB;
    const unsigned ldsw = (unsigned)wid * 1024u;
    const int aoff = lds_byte(wr * 64 + fr, fq * 8), boff = lds_byte(wc * 32 + fr, fq * 8);
#define PG8_SA(b, h) (((b) * 2 + (h)) * HTB)
#define PG8_SB(b, h) ((4 + (b) * 2 + (h)) * HTB)
#define PG8_STAGE(bufoff, gbase, voff) do { _Pragma("unroll") for (int _i = 0; _i < 2; ++_i) \
        __builtin_amdgcn_global_load_lds((const unsigned*)((const char*)(gbase) + (voff)[_i]), (LAS unsigned*)(lds + (bufoff) + ldsw + _i * 8192), 16, 0, 0); } while (0)
#define PG8_LDA(dst, b, h) do { _Pragma("unroll") for (int m = 0; m < 4; ++m) _Pragma("unroll") for (int k = 0; k < 2; ++k) dst[m][k] = *(const LAS bf16x8*)(lds + PG8_SA(b, h) + aoff + m * 2048 + k * 1024); } while (0)
#define PG8_LDB(dst, b, h) do { _Pragma("unroll") for (int n = 0; n < 2; ++n) _Pragma("unroll") for (int k = 0; k < 2; ++k) dst[n][k] = *(const LAS bf16x8*)(lds + PG8_SB(b, h) + boff + n * 2048 + k * 1024); } while (0)
#define PG8_MMA(ai, bj, At, Bt) do { __builtin_amdgcn_s_setprio(1); _Pragma("unroll") for (int m = 0; m < 4; ++m) _Pragma("unroll") for (int n = 0; n < 2; ++n) _Pragma("unroll") for (int k = 0; k < 2; ++k) \
        acc[ai][bj][m][n] = __builtin_amdgcn_mfma_f32_16x16x32_bf16(Bt[n][k], At[m][k], acc[ai][bj][m][n], 0, 0, 0); __builtin_amdgcn_s_setprio(0); } while (0)
#define PG8_WAIT_V(n) asm volatile("s_waitcnt vmcnt(" #n ")" ::: "memory")
#define PG8_WAIT_L(n) asm volatile("s_waitcnt lgkmcnt(" #n ")" ::: "memory")
#define PG8_BAR __builtin_amdgcn_s_barrier()
#define PG8_SCHED __builtin_amdgcn_sched_barrier(0)
    Unit cur, nxt; int ui = 0;
    if (!S.next(0, cur)) return;
    f32x4 acc[2][2][4][2];
#pragma unroll
    for (int a = 0; a < 2; ++a)
#pragma unroll
        for (int b = 0; b < 2; ++b)
#pragma unroll
            for (int m = 0; m < 4; ++m)
#pragma unroll
                for (int n = 0; n < 2; ++n) acc[a][b][m][n] = (f32x4){0.f, 0.f, 0.f, 0.f};
    bf16x8 At[4][2], B0[2][2], B1[2][2];
    const char* cA = (const char*)g.A + (size_t)cur.pm * tstepA; const char* cB = (const char*)g.Bt + (size_t)cur.bt * tstepB;
    PG8_STAGE(PG8_SB(0, 0), cB, voffB); PG8_STAGE(PG8_SB(0, 1), cB + hstepB, voffB); PG8_STAGE(PG8_SA(0, 0), cA, voffA); PG8_STAGE(PG8_SA(0, 1), cA + hstepA, voffA);
    if (wr == 1) PG8_BAR;
    PG8_WAIT_V(2); PG8_BAR;
    PG8_STAGE(PG8_SB(1, 0), cB + kstep, voffB); PG8_STAGE(PG8_SA(1, 0), cA + kstep, voffA); PG8_STAGE(PG8_SB(1, 1), cB + hstepB + kstep, voffB);
    PG8_WAIT_V(6); PG8_BAR;
    for (;;) {
        const bool has_next = S.next(ui + 1, nxt);
        const char* nA = has_next ? (const char*)g.A + (size_t)nxt.pm * tstepA : cA; const char* nB = has_next ? (const char*)g.Bt + (size_t)nxt.bt * tstepB : cB;
        for (int t = 0; t < nt; t += 2) {
            const bool last = (t == nt - 2);
            const char* a1 = cA + (size_t)(t + 1) * kstep;
            const char* a2 = last ? nA : cA + (size_t)(t + 2) * kstep; const char* b2 = last ? nB : cB + (size_t)(t + 2) * kstep;
            const char* a3 = a2 + kstep; const char* b3 = b2 + kstep;
            if constexpr (Epi::MID_T > 0) { if (t == Epi::MID_T) E.mid(acc, cur, wr, wc, fr, fq); }
            PG8_LDB(B0, 0, 0); PG8_LDB(B1, 0, 1); PG8_SCHED; PG8_LDA(At, 0, 0); PG8_STAGE(PG8_SA(1, 1), a1 + hstepA, voffA);
            PG8_WAIT_V(8); PG8_WAIT_L(0); PG8_BAR; PG8_MMA(0, 0, At, B0); PG8_MMA(0, 1, At, B1); PG8_BAR; PG8_SCHED;
            PG8_LDA(At, 0, 1); PG8_STAGE(PG8_SB(0, 0), b2, voffB); PG8_STAGE(PG8_SB(0, 1), b2 + hstepB, voffB); PG8_STAGE(PG8_SA(0, 0), a2, voffA);
            PG8_WAIT_V(8); PG8_WAIT_L(0); PG8_BAR; PG8_MMA(1, 0, At, B0); PG8_MMA(1, 1, At, B1); PG8_BAR; PG8_SCHED;
            PG8_LDB(B0, 1, 0); PG8_LDB(B1, 1, 1); PG8_SCHED; PG8_LDA(At, 1, 0); PG8_STAGE(PG8_SA(0, 1), a2 + hstepA, voffA);
            PG8_WAIT_V(8); PG8_WAIT_L(0); PG8_BAR; PG8_MMA(0, 0, At, B0); PG8_MMA(0, 1, At, B1); PG8_BAR; PG8_SCHED;
            PG8_LDA(At, 1, 1); PG8_STAGE(PG8_SB(1, 0), b3, voffB); PG8_STAGE(PG8_SB(1, 1), b3 + hstepB, voffB); PG8_STAGE(PG8_SA(1, 0), a3, voffA);
            PG8_WAIT_V(8); PG8_WAIT_L(0); PG8_BAR; PG8_MMA(1, 0, At, B0); PG8_MMA(1, 1, At, B1); PG8_BAR; PG8_SCHED;
        }
        if constexpr (ALIGN_EPI) { if (wr == 0) PG8_BAR; }
        E(acc, cur, wr, wc, fr, fq);
        if (!has_next) break;
#pragma unroll
        for (int a = 0; a < 2; ++a)
#pragma unroll
            for (int b = 0; b < 2; ++b)
#pragma unroll
                for (int m = 0; m < 4; ++m)
#pragma unroll
                    for (int n = 0; n < 2; ++n) acc[a][b][m][n] = (f32x4){0.f, 0.f, 0.f, 0.f};
        cur = nxt; cA = nA; cB = nB; ++ui;
        if constexpr (ALIGN_EPI) { if (wr == 1) PG8_BAR; }
    }
    PG8_WAIT_V(0);
    if constexpr (!ALIGN_EPI) { if (wr == 0) PG8_BAR; }
    PG8_BAR;
#undef PG8_SA
#undef PG8_SB
#undef PG8_STAGE
#undef PG8_LDA
#undef PG8_LDB
#undef PG8_MMA
#undef PG8_WAIT_V
#undef PG8_WAIT_L
#undef PG8_BAR
#undef PG8_SCHED
}

typedef f32x4 Acc[2][2][4][2];

struct Epi1 {
    static constexpr bool PERM = true; static constexpr int MID_T = 0;
    bf16_t *yab, *gv, *q, *k, *v, *sa, *sb; float* gvst;
    template <int MODE  >
    __device__ __forceinline__ void run(const Acc& acc, const Unit& u, int wr, int wc, int fr, int fq, bf16_t* base, int ld) const {
        const int row0 = u.pm * BM + wr * 64 + fr, col0 = (u.pn & 3) * 256 + wc * 32 + 8 * fq;
#pragma unroll
        for (int ai = 0; ai < 2; ++ai)
#pragma unroll
            for (int m = 0; m < 4; ++m) {
                const int row = row0 + ai * HALF + m * 16; bf16_t* rowp = base + (size_t)row * ld + col0;
                float s1 = 0.f, s2 = 0.f;
#pragma unroll
                for (int bj = 0; bj < 2; ++bj) {
                    f32x4 v0 = acc[ai][bj][m][0], v1 = acc[ai][bj][m][1];
                    if (MODE == 0 || MODE == 1) {
                        f32x2 a = gelu_pk((f32x2){v0[0], v0[1]}), b = gelu_pk((f32x2){v0[2], v0[3]}), c = gelu_pk((f32x2){v1[0], v1[1]}), d = gelu_pk((f32x2){v1[2], v1[3]});
                        v0 = (f32x4){a.x, a.y, b.x, b.y}; v1 = (f32x4){c.x, c.y, d.x, d.y};
                    } else if (MODE == 2) { v0 = v0 * QSCALE; v1 = v1 * QSCALE; }
                    else if (MODE == 4) {
#pragma unroll
                        for (int j = 0; j < 4; ++j) { v0[j] = sigmoidf_(v0[j]); v1[j] = sigmoidf_(v1[j]); }
                    }
                    if (MODE == 1) {
                        s1 += (v0[0] + v0[1]) + (v0[2] + v0[3]) + (v1[0] + v1[1]) + (v1[2] + v1[3]);
                        s2 += (v0[0] * v0[0] + v0[1] * v0[1]) + (v0[2] * v0[2] + v0[3] * v0[3]) + (v1[0] * v1[0] + v1[1] * v1[1]) + (v1[2] * v1[2] + v1[3] * v1[3]);
                    }
                    u32x4 w; w.x = cvt_pk_bf16(v0[0], v0[1]); w.y = cvt_pk_bf16(v0[2], v0[3]); w.z = cvt_pk_bf16(v1[0], v1[1]); w.w = cvt_pk_bf16(v1[2], v1[3]);
                    *(u32x4*)(rowp + bj * HALF) = w;
                }
                if (MODE == 1) {
                    s1 += __shfl_xor(s1, 16); s1 += __shfl_xor(s1, 32); s2 += __shfl_xor(s2, 16); s2 += __shfl_xor(s2, 32);
                    if (fq == 0) *(f32x2*)(gvst + ((size_t)row * 16 + (u.pn & 3) * 4 + wc) * 2) = (f32x2){s1, s2};
                }
            }
    }
    __device__ __forceinline__ void operator()(const Acc& acc, const Unit& u, int wr, int wc, int fr, int fq) const {
        const int region = u.pn >> 2;
        if (region == 0) run<0>(acc, u, wr, wc, fr, fq, yab, 2048);
        else if (region == 1) run<1>(acc, u, wr, wc, fr, fq, gv, 1024);
        else if (region == 2) run<2>(acc, u, wr, wc, fr, fq, q, 1024);
        else if (region == 3) run<3>(acc, u, wr, wc, fr, fq, k, 1024);
        else if (region == 4) run<3>(acc, u, wr, wc, fr, fq, v, 1024);
        else if (region == 5) run<4>(acc, u, wr, wc, fr, fq, sa, 1024);
        else run<4>(acc, u, wr, wc, fr, fq, sb, 1024);
    }
    __device__ __forceinline__ void mid(Acc&, const Unit&, int, int, int, int) const {}
};

struct Epi2 {
    static constexpr bool PERM = true; static constexpr int MID_T = 16;
    const bf16_t *sa, *sb; bf16_t* mg;
    __device__ __forceinline__ void mid(Acc& acc, const Unit& u, int wr, int wc, int fr, int fq) const {
        int row0 = u.pm * BM + wr * 64 + fr, col0 = u.pn * BM + wc * 32 + 8 * fq;
        asm volatile("" : "+v"(row0), "+v"(col0));
#pragma unroll
        for (int ai = 0; ai < 2; ++ai)
#pragma unroll
            for (int m = 0; m < 4; ++m) {
                const size_t off = (size_t)(row0 + ai * HALF + m * 16) * DM + col0;
#pragma unroll
                for (int bj = 0; bj < 2; ++bj) {
                    const u32x4 a = *(const u32x4*)(sa + off + bj * HALF), b = *(const u32x4*)(sb + off + bj * HALF);
                    f32x4 r0, r1;
#define RQ(x, y) ((x) * __builtin_amdgcn_rcpf(y))
                    r0[0] = RQ(bflo(a.x), bflo(b.x)); r0[1] = RQ(bfhi(a.x), bfhi(b.x)); r0[2] = RQ(bflo(a.y), bflo(b.y)); r0[3] = RQ(bfhi(a.y), bfhi(b.y));
                    r1[0] = RQ(bflo(a.z), bflo(b.z)); r1[1] = RQ(bfhi(a.z), bfhi(b.z)); r1[2] = RQ(bflo(a.w), bflo(b.w)); r1[3] = RQ(bfhi(a.w), bfhi(b.w));
#undef RQ
                    acc[ai][bj][m][0] = acc[ai][bj][m][0] * r0; acc[ai][bj][m][1] = acc[ai][bj][m][1] * r1;
                }
                asm volatile("" : "+v"(acc[ai][0][m][0]), "+v"(acc[ai][0][m][1]), "+v"(acc[ai][1][m][0]), "+v"(acc[ai][1][m][1]));
                asm volatile("" ::: "memory");
            }
    }
    __device__ __forceinline__ void operator()(const Acc& acc, const Unit& u, int wr, int wc, int fr, int fq) const {
        const int row0 = u.pm * BM + wr * 64 + fr, col0 = u.pn * BM + wc * 32 + 8 * fq;
#pragma unroll
        for (int ai = 0; ai < 2; ++ai)
#pragma unroll
            for (int m = 0; m < 4; ++m) {
                const size_t off = (size_t)(row0 + ai * HALF + m * 16) * DM + col0;
#pragma unroll
                for (int bj = 0; bj < 2; ++bj) {
                    const u32x4 b = *(const u32x4*)(sb + off + bj * HALF);
                    const f32x4 v0 = acc[ai][bj][m][0], v1 = acc[ai][bj][m][1];
                    u32x4 w; w.x = cvt_pk_bf16(v0[0] * bflo(b.x), v0[1] * bfhi(b.x)); w.y = cvt_pk_bf16(v0[2] * bflo(b.y), v0[3] * bfhi(b.y));
                    w.z = cvt_pk_bf16(v1[0] * bflo(b.z), v1[1] * bfhi(b.z)); w.w = cvt_pk_bf16(v1[2] * bflo(b.w), v1[3] * bfhi(b.w));
                    *(u32x4*)(mg + off + bj * HALF) = w;
                }
            }
    }
};

struct Epi3 {
    static constexpr bool PERM = false; static constexpr int MID_T = 0;
    const bf16_t* h0; float* z; float* zst;
    __device__ __forceinline__ void mid(Acc&, const Unit&, int, int, int, int) const {}
    __device__ __forceinline__ void operator()(const Acc& acc, const Unit& u, int wr, int wc, int fr, int fq) const {
        const int row0 = u.pm * BM + wr * 64 + fr, col0 = u.pn * BM + wc * 32 + 4 * fq;
#pragma unroll
        for (int ai = 0; ai < 2; ++ai)
#pragma unroll
            for (int m = 0; m < 4; ++m) {
                const int row = row0 + ai * HALF + m * 16; const size_t off = (size_t)row * DM + col0;
                float s1 = 0.f, s2 = 0.f;
#pragma unroll
                for (int bj = 0; bj < 2; ++bj)
#pragma unroll
                    for (int n = 0; n < 2; ++n) {
                        const u32x2 hb = *(const u32x2*)(h0 + off + bj * HALF + n * 16);
                        f32x4 v = acc[ai][bj][m][n];
                        v[0] += ALPHA * bflo(hb.x); v[1] += ALPHA * bfhi(hb.x); v[2] += ALPHA * bflo(hb.y); v[3] += ALPHA * bfhi(hb.y);
                        s1 += (v[0] + v[1]) + (v[2] + v[3]); s2 += (v[0] * v[0] + v[1] * v[1]) + (v[2] * v[2] + v[3] * v[3]);
                        *(f32x4*)(z + off + bj * HALF + n * 16) = v;
                    }
                s1 += __shfl_xor(s1, 16); s1 += __shfl_xor(s1, 32); s2 += __shfl_xor(s2, 16); s2 += __shfl_xor(s2, 32);
                if (fq == 0) *(f32x2*)(zst + ((size_t)row * 16 + u.pn * 4 + wc) * 2) = (f32x2){s1, s2};
            }
    }
};

struct Epi4 {
    static constexpr bool PERM = true; static constexpr int MID_T = 0;
    const float* b_up; bf16_t* act;
    __device__ __forceinline__ void mid(Acc&, const Unit&, int, int, int, int) const {}
    __device__ __forceinline__ void operator()(const Acc& acc, const Unit& u, int wr, int wc, int fr, int fq) const {
        const int e = u.bt >> 3;
        const int row0 = u.pm * BM + wr * 64 + fr, c0 = u.pn * HALF + wc * 32 + 8 * fq;
        const float* bg = b_up + (size_t)e * 2 * FF + c0; const float* bu = bg + FF;
        const f32x4 bg0 = *(const f32x4*)bg, bg1 = *(const f32x4*)(bg + 4), bu0 = *(const f32x4*)bu, bu1 = *(const f32x4*)(bu + 4);
#pragma unroll
        for (int ai = 0; ai < 2; ++ai)
#pragma unroll
            for (int m = 0; m < 4; ++m) {
                const int row = row0 + ai * HALF + m * 16;
                float o[8];
#pragma unroll
                for (int n = 0; n < 2; ++n)
#pragma unroll
                    for (int j = 0; j < 4; ++j) {
                        float gg = acc[ai][0][m][n][j] + (n ? bg1[j] : bg0[j]), uu = acc[ai][1][m][n][j] + (n ? bu1[j] : bu0[j]);
                        gg = fminf(gg, 7.0f); uu = fminf(fmaxf(uu, -7.0f), 7.0f);
                        o[n * 4 + j] = (uu + 1.0f) * (gg * sigmoidf_(1.702f * gg));
                    }
                u32x4 w; w.x = cvt_pk_bf16(o[0], o[1]); w.y = cvt_pk_bf16(o[2], o[3]); w.z = cvt_pk_bf16(o[4], o[5]); w.w = cvt_pk_bf16(o[6], o[7]);
                *(u32x4*)(act + (size_t)row * FF + c0) = w;
            }
    }
};

struct Epi5 {
    static constexpr bool PERM = true; static constexpr int MID_T = 0;
    const float* b_down; const float* roww; bf16_t* ys;
    __device__ __forceinline__ void mid(Acc&, const Unit&, int, int, int, int) const {}
    __device__ __forceinline__ void operator()(const Acc& acc, const Unit& u, int wr, int wc, int fr, int fq) const {
        const int e = u.bt >> 2;
        const int row0 = u.pm * BM + wr * 64 + fr, col0 = u.pn * BM + wc * 32 + 8 * fq;
        f32x4 bv[2][2];
#pragma unroll
        for (int bj = 0; bj < 2; ++bj)
#pragma unroll
            for (int n = 0; n < 2; ++n) bv[bj][n] = *(const f32x4*)(b_down + (size_t)e * DM + col0 + bj * HALF + 4 * n);
#pragma unroll
        for (int ai = 0; ai < 2; ++ai)
#pragma unroll
            for (int m = 0; m < 4; ++m) {
                const int row = row0 + ai * HALF + m * 16; const float rw = roww[row];
#pragma unroll
                for (int bj = 0; bj < 2; ++bj) {
                    const f32x4 v0 = (acc[ai][bj][m][0] + bv[bj][0]) * rw, v1 = (acc[ai][bj][m][1] + bv[bj][1]) * rw;
                    u32x4 w; w.x = cvt_pk_bf16(v0[0], v0[1]); w.y = cvt_pk_bf16(v0[2], v0[3]); w.z = cvt_pk_bf16(v1[0], v1[1]); w.w = cvt_pk_bf16(v1[2], v1[3]);
                    *(u32x4*)(ys + (size_t)row * DM + col0 + bj * HALF) = w;
                }
            }
    }
};
}

struct Args { const float* in[21]; float* out; unsigned char* ws; int ph_lo, ph_hi; };
enum { I_X = 0, I_LNIN_G, I_LNIN_B, I_WIN, I_GLN_G, I_GLN_B, I_WSP, I_BSP, I_WBA, I_WBB, I_WOUT, I_LNMIX_G, I_LNMIX_B, I_WR, I_BR, I_WUP, I_BUP, I_WDN, I_BDN, I_LNF_G, I_LNF_B };

struct Ctx { const Args* a; unsigned char* ws; LAS unsigned char* lds; unsigned char* ldsg; int tid, lane, wave, G, vcu; };

__device__ __forceinline__ void tr_item(const float* W, int N, int k0, int n0, bf16_t* dst, int drow0, int dld, int dcol0, LAS float* scr, int lane) {
#pragma unroll 8
    for (int i = 0; i < 32; ++i) { const int kk = 2 * i + (lane >> 5); scr[kk * 33 + (lane & 31)] = W[(size_t)(k0 + kk) * N + n0 + (lane & 31)]; }
    asm volatile("s_waitcnt lgkmcnt(0)" ::: "memory");
    const int c = lane & 7;
#pragma unroll
    for (int j = 0; j < 4; ++j) { const int n = (lane >> 3) + 8 * j; const LAS float* s = scr + (8 * c) * 33 + n;
        u32x4 o; o.x = pk2(s[0 * 33], s[1 * 33]); o.y = pk2(s[2 * 33], s[3 * 33]); o.z = pk2(s[4 * 33], s[5 * 33]); o.w = pk2(s[6 * 33], s[7 * 33]);
        *(u32x4*)(dst + (size_t)(drow0 + n) * dld + dcol0 + k0 + 8 * c) = o; }
    asm volatile("s_waitcnt lgkmcnt(0)" ::: "memory");
}
__device__ __forceinline__ void ph_prologue(const Ctx& F) {
    const Args& A = *F.a;
    LAS float* scr = (LAS float*)(F.lds + F.wave * 16384);
    const int gw = F.vcu * 8 + F.wave, NGW = F.G * 8;
    bf16_t* WIN = (bf16_t*)(F.ws + WS_WIN); bf16_t* WAB = (bf16_t*)(F.ws + WS_WAB); bf16_t* WOUT = (bf16_t*)(F.ws + WS_WOUT);
    bf16_t* WDN = (bf16_t*)(F.ws + WS_WDN); bf16_t* WUP = (bf16_t*)(F.ws + WS_WUP);
    constexpr int I_IN = 16 * (INCOLS / 32), I_SQ = 16 * 32, I_UP = NE * 16 * 64, I_DN = NE * 16 * 32;
    constexpr int NITEMS = I_IN + 3 * I_SQ + I_UP + I_DN;
    for (int it = gw; it < NITEMS; it += NGW) {
        int r = it;
        if (r < I_IN) { const int nblk = INCOLS / 32, kb = r / nblk, nb = r % nblk; tr_item(A.in[I_WIN], INCOLS, 64 * kb, 32 * nb, WIN, 32 * nb, DM, 0, scr, F.lane); continue; } r -= I_IN;
        if (r < I_SQ) { const int kb = r / 32, nb = r % 32; tr_item(A.in[I_WBA], DM, 64 * kb, 32 * nb, WAB, 32 * nb, 2048, 0, scr, F.lane); continue; } r -= I_SQ;
        if (r < I_SQ) { const int kb = r / 32, nb = r % 32; tr_item(A.in[I_WBB], DM, 64 * kb, 32 * nb, WAB, 32 * nb, 2048, 1024, scr, F.lane); continue; } r -= I_SQ;
        if (r < I_SQ) { const int kb = r / 32, nb = r % 32; tr_item(A.in[I_WOUT], DM, 64 * kb, 32 * nb, WOUT, 32 * nb, DM, 0, scr, F.lane); continue; } r -= I_SQ;
        if (r < I_UP) { const int e = r / (16 * 64), rr = r % (16 * 64), kb = rr / 64, nb = rr % 64; const int n0 = 32 * nb, half = n0 >= FF, rem = n0 - half * FF, pn = rem >> 7, b = (rem & 127) >> 5;
            tr_item(A.in[I_WUP] + (size_t)e * DM * 2 * FF, 2 * FF, 64 * kb, n0, WUP, e * 2048 + 256 * pn + half * 128 + 32 * b, DM, 0, scr, F.lane); continue; } r -= I_UP;
        { const int e = r / (16 * 32), rr = r % (16 * 32), kb = rr / 32, nb = rr % 32; tr_item(A.in[I_WDN] + (size_t)e * FF * DM, DM, 64 * kb, 32 * nb, WDN, e * 1024 + 32 * nb, FF, 0, scr, F.lane); }
    }
    const float* lg = A.in[I_LNIN_G]; const float* lb = A.in[I_LNIN_B]; bf16_t* H0 = (bf16_t*)(F.ws + WS_H0);
    f32x4 gg[4], bb[4];
#pragma unroll
    for (int j = 0; j < 4; ++j) { gg[j] = *((const f32x4*)lg + F.lane + 64 * j); bb[j] = *((const f32x4*)lb + F.lane + 64 * j); }
    for (int m = gw; m < T; m += NGW) {
        const f32x4* xr = (const f32x4*)(A.in[I_X] + (size_t)m * DM) + F.lane;
        f32x4 v[4]; float s = 0.f;
#pragma unroll
        for (int j = 0; j < 4; ++j) { v[j] = xr[64 * j]; s += (v[j].x + v[j].y) + (v[j].z + v[j].w); }
        const float mean = wave_sum(s) * (1.f / DM); float s2 = 0.f;
#pragma unroll
        for (int j = 0; j < 4; ++j) { v[j] = v[j] - mean; s2 += (v[j].x * v[j].x + v[j].y * v[j].y) + (v[j].z * v[j].z + v[j].w * v[j].w); }
        const float rstd = 1.f / sqrtf(wave_sum(s2) * (1.f / DM) + LN_EPS);
        u32x2* o8 = (u32x2*)(H0 + (size_t)m * DM) + F.lane;
#pragma unroll
        for (int j = 0; j < 4; ++j) { const f32x4 y = v[j] * rstd * gg[j] + bb[j]; o8[64 * j] = (u32x2){pk2(y.x, y.y), pk2(y.z, y.w)}; }
    }
}

__device__ __forceinline__ void ph_kmean(const Ctx& F) {
    const bf16_t* K = (const bf16_t*)(F.ws + WS_K); float* KM = (float*)(F.ws + WS_KMEAN);
    float* red = (float*)F.ldsg;
    const int d = F.tid & 127, part = F.tid >> 7;
    for (int it = F.vcu; it < NB * NH * NBLK; it += F.G) {
        const int b = it / (NH * NBLK), h = (it / NBLK) % NH, j = it % NBLK;
        const bf16_t* kp = K + ((size_t)(b * SEQ + j * LBLK + part * 64)) * DM + h * DH + d;
        float s = 0.f;
        for (int r = 0; r < 64; ++r) s += bf2f(kp[(size_t)r * DM]);
        red[part * 128 + d] = s;
        __syncthreads();
        if (F.tid < 128) KM[(size_t)it * DH + d] = (red[d] + red[128 + d] + red[256 + d] + red[384 + d]) * (1.0f / LBLK);
        __syncthreads();
    }
}
__device__ __forceinline__ void ph_mixer_a(const Ctx& F) {
    const Args& A = *F.a;
    const bf16_t* GV = (const bf16_t*)(F.ws + WS_GV); bf16_t* YAB = (bf16_t*)(F.ws + WS_YAB); const float* GVST = (const float*)(F.ws + WS_GVST);
    const float* lg = A.in[I_GLN_G]; const float* lb = A.in[I_GLN_B]; const float* wsp = A.in[I_WSP]; const float* bsp = A.in[I_BSP];
    float* vt = (float*)F.ldsg;
    float* st = (float*)(F.ldsg + 131072);
    for (int it = F.vcu; it < NB * 32 * 4; it += F.G) {
        const int b = it / 128, c = (it >> 2) & 31, g = it & 3;
        const int tok0 = b * SEQ + c * 128;
        if (F.tid < 128) {
            const float* p = GVST + (size_t)(tok0 + F.tid) * 32; float s1 = 0.f, s2 = 0.f;
            for (int i = 0; i < 16; ++i) { s1 += p[2 * i]; s2 += p[2 * i + 1]; }
            const float mean = s1 * (1.f / DM), var = s2 * (1.f / DM) - mean * mean;
            st[2 * F.tid] = mean; st[2 * F.tid + 1] = 1.f / sqrtf(fmaxf(var, 0.f) + LN_EPS);
        }
        __syncthreads();
        for (int k = 0; k < 8; ++k) {
            const int idx = F.tid + 512 * k, s = idx >> 5, d0 = (idx & 31) * 8;
            const u32x4 raw = *(const u32x4*)(GV + (size_t)(tok0 + s) * DM + g * 256 + d0);
            const float mean = st[2 * s], rstd = st[2 * s + 1];
            const float* gp = lg + g * 256 + d0; const float* bp = lb + g * 256 + d0;
            float x[8] = {bflo(raw.x), bfhi(raw.x), bflo(raw.y), bfhi(raw.y), bflo(raw.z), bfhi(raw.z), bflo(raw.w), bfhi(raw.w)};
#pragma unroll
            for (int j = 0; j < 8; ++j) vt[s * 256 + d0 + j] = (x[j] - mean) * rstd * gp[j] + bp[j];
        }
        __syncthreads();
        const int d = F.tid & 255, th = F.tid >> 8;
        for (int tt = 0; tt < 64; ++tt) {
            const int t = th * 64 + tt;
            const float* wrow = wsp + ((size_t)g * 128 + t) * 128;
            float acc = 0.f;
            for (int s = 0; s <= t; ++s) acc += wrow[s] * vt[s * 256 + d];
            acc += bsp[g * 128 + t];
            bf16_t* yp = YAB + (size_t)(tok0 + t) * 2048 + g * 256 + d;
            *yp = (bf16_t)f2bf(bf2f(*yp) * acc);
        }
        __syncthreads();
    }
}

__device__ __forceinline__ void ph_gate(const Ctx& F) {
    const bf16_t* Q = (const bf16_t*)(F.ws + WS_Q); const float* KM = (const float*)(F.ws + WS_KMEAN);
    unsigned* SEL = (unsigned*)(F.ws + WS_SEL); unsigned* LISTS = (unsigned*)(F.ws + WS_LISTS); unsigned* LCNT = (unsigned*)(F.ws + WS_CTL) + CW_LCNT;
    float* km = (float*)F.ldsg;
    unsigned* lc = (unsigned*)(F.ldsg + 8192);
    for (int it = F.vcu; it < NB * NH * 8; it += F.G) {
        const int b = it / 64, h = (it >> 3) & 7, tc = it & 7;
        for (int i = F.tid; i < NBLK * DH; i += 512) km[i] = KM[(size_t)(b * NH + h) * NBLK * DH + i];
        if (F.tid < 32) lc[F.tid] = 0u;
        __syncthreads();
        const int t = tc * 512 + F.tid, qi = t >> 8;
        float gsc[15];
#pragma unroll
        for (int j = 0; j < 15; ++j) gsc[j] = 0.f;
        const bf16_t* qp = Q + (size_t)(b * SEQ + t) * DM + h * DH;
        for (int c = 0; c < 16; ++c) {
            const u32x4 raw = *(const u32x4*)(qp + c * 8);
            const float x[8] = {bflo(raw.x), bfhi(raw.x), bflo(raw.y), bfhi(raw.y), bflo(raw.z), bfhi(raw.z), bflo(raw.w), bfhi(raw.w)};
#pragma unroll
            for (int j = 0; j < 15; ++j) if (j < qi) {
                const float* kk = km + j * DH + c * 8;
#pragma unroll
                for (int e = 0; e < 8; ++e) gsc[j] += x[e] * kk[e];
            }
        }
        const int nsel = qi < 3 ? qi : 3;
        int sel[3] = {0, 0, 0}; unsigned lpos[3] = {0, 0, 0};
#pragma unroll
        for (int r = 0; r < 3; ++r) {
            float best = -INFINITY; int bi = -1;
#pragma unroll
            for (int j = 0; j < 15; ++j) { const bool c = (j < qi) && (gsc[j] > best); best = c ? gsc[j] : best; bi = c ? j : bi; }
#pragma unroll
            for (int j = 0; j < 15; ++j) if (j == bi) gsc[j] = -INFINITY;
            sel[r] = bi < 0 ? 0 : bi;
            if (r < nsel) lpos[r] = atomicAdd(&lc[sel[r]], 1u);
        }
        SEL[(size_t)(b * SEQ + t) * NH + h] = (unsigned)sel[0] | ((unsigned)sel[1] << 8) | ((unsigned)sel[2] << 16) | ((unsigned)nsel << 24);
        __syncthreads();
        if (F.tid < 16) lc[16 + F.tid] = lc[F.tid] ? atomicAdd(&LCNT[(b * NH + h) * NBLK + F.tid], lc[F.tid]) : 0u;
        __syncthreads();
#pragma unroll
        for (int r = 0; r < 3; ++r) if (r < nsel) LISTS[(size_t)((b * NH + h) * NBLK + sel[r]) * 4096 + lc[16 + sel[r]] + lpos[r]] = (unsigned)t | ((unsigned)r << 12);
        __syncthreads();
    }
}

__device__ __forceinline__ void ph_attn_naive(const Ctx& F) {
    const bf16_t* Q = (const bf16_t*)(F.ws + WS_Q); const bf16_t* K = (const bf16_t*)(F.ws + WS_K); const bf16_t* V = (const bf16_t*)(F.ws + WS_V);
    const unsigned* SEL = (const unsigned*)(F.ws + WS_SEL); bf16_t* YAB = (bf16_t*)(F.ws + WS_YAB);
    float* qs = (float*)(F.ldsg + F.wave * 4608);
    float* sc = qs + 128;
    const int gw = F.vcu * 8 + F.wave, NGW = F.G * 8;
    for (int w = gw; w < NB * NH * SEQ; w += NGW) {
        const int b = w / (NH * SEQ), h = (w / SEQ) % NH, t = w % SEQ, qi = t >> 8, tl = t & 255;
        const size_t tok = (size_t)b * SEQ + t;
        { const unsigned qq = *(const unsigned*)(Q + tok * DM + h * DH + 2 * F.lane); qs[2 * F.lane] = bflo(qq); qs[2 * F.lane + 1] = bfhi(qq); }
        const unsigned selw = SEL[tok * NH + h]; const int nsel = selw >> 24;
        float mx = -INFINITY;
        for (int r = 0; r <= nsel; ++r) {
            const int jb = (r < nsel) ? (int)((selw >> (8 * r)) & 0xff) : qi;
            for (int c = 0; c < 4; ++c) {
                const int key = c * 64 + F.lane;
                const bool valid = (r < nsel) || (key <= tl);
                const bf16_t* kp = K + ((size_t)b * SEQ + jb * LBLK + key) * DM + h * DH;
                float s = 0.f;
#pragma unroll 4
                for (int dd = 0; dd < 16; ++dd) {
                    const u32x4 raw = *(const u32x4*)(kp + dd * 8);
                    const float* q8 = qs + dd * 8;
                    s += bflo(raw.x) * q8[0] + bfhi(raw.x) * q8[1] + bflo(raw.y) * q8[2] + bfhi(raw.y) * q8[3] + bflo(raw.z) * q8[4] + bfhi(raw.z) * q8[5] + bflo(raw.w) * q8[6] + bfhi(raw.w) * q8[7];
                }
                s = valid ? s : -INFINITY;
                sc[r * 256 + key] = s; mx = fmaxf(mx, s);
            }
        }
        mx = wave_max(mx);
        float l = 0.f;
        const int ntot = (nsel + 1) * 256;
        for (int i = F.lane; i < ntot; i += 64) { const float p = __builtin_amdgcn_exp2f(sc[i] - mx); sc[i] = p; l += p; }
        l = wave_sum(l);
        float o0 = 0.f, o1 = 0.f;
        for (int r = 0; r <= nsel; ++r) {
            const int jb = (r < nsel) ? (int)((selw >> (8 * r)) & 0xff) : qi;
            const int nk = (r < nsel) ? 256 : tl + 1;
            const bf16_t* vp = V + ((size_t)b * SEQ + jb * LBLK) * DM + h * DH + 2 * F.lane;
#pragma unroll 4
            for (int key = 0; key < nk; ++key) { const unsigned vv = *(const unsigned*)(vp + (size_t)key * DM); const float p = sc[r * 256 + key]; o0 += p * bflo(vv); o1 += p * bfhi(vv); }
        }
        const float il = 1.f / l;
        *(unsigned*)(YAB + tok * 2048 + 1024 + h * DH + 2 * F.lane) = pk2(o0 * il, o1 * il);
    }
}

__device__ __forceinline__ void ln_stats16(const float* st, int lane, float& mean, float& rstd) {
    float s1 = 0.f, s2 = 0.f;
    if (lane < 16) { const f32x2 p = *(const f32x2*)(st + 2 * lane); s1 = p.x; s2 = p.y; }
    s1 = wave_sum(s1); s2 = wave_sum(s2);
    mean = s1 * (1.f / DM); const float var = s2 * (1.f / DM) - mean * mean; rstd = 1.f / sqrtf(fmaxf(var, 0.f) + LN_EPS);
}
__device__ __forceinline__ void ph_router(const Ctx& F) {
    const Args& A = *F.a;
    const float* Z = (const float*)(F.ws + WS_Z); const float* ZST = (const float*)(F.ws + WS_ZST); bf16_t* H1 = (bf16_t*)(F.ws + WS_H1);
    int* TKE = (int*)(F.ws + WS_TKE); float* TKW = (float*)(F.ws + WS_TKW); int* TKP = (int*)(F.ws + WS_TKP); unsigned* ECNT = (unsigned*)(F.ws + WS_CTL) + CW_ECNT;
    const float* wr = A.in[I_WR]; const float* br = A.in[I_BR];
    const int gw = F.vcu * 8 + F.wave, NGW = F.G * 8;
    const f32x4* gp = (const f32x4*)A.in[I_LNMIX_G] + F.lane; const f32x4* bp = (const f32x4*)A.in[I_LNMIX_B] + F.lane;
    for (int m = gw; m < T; m += NGW) {
        float mean, rstd; ln_stats16(ZST + (size_t)m * 32, F.lane, mean, rstd);
        const f32x4* zr = (const f32x4*)(Z + (size_t)m * DM) + F.lane;
        f32x4 hv[4];
        u32x2* o8 = (u32x2*)(H1 + (size_t)m * DM) + F.lane;
#pragma unroll
        for (int j = 0; j < 4; ++j) { hv[j] = (zr[64 * j] - mean) * rstd * gp[64 * j] + bp[64 * j]; o8[64 * j] = (u32x2){pk2(hv[j].x, hv[j].y), pk2(hv[j].z, hv[j].w)}; }
        asm volatile("" ::: "memory");
        int lo4 = 4 * F.lane; asm volatile("" : "+v"(lo4));
        const int myexp = F.lane & 31;
        float mylg = 0.f;
#pragma unroll 1
        for (int eg = 0; eg < 4; ++eg) {
            float l8[8];
#pragma unroll
            for (int k = 0; k < 8; ++k) l8[k] = 0.f;
#pragma unroll
            for (int j = 0; j < 4; ++j)
#pragma unroll
                for (int c = 0; c < 4; ++c) {
                    const float hx = hv[j][c]; const f32x4* wp = (const f32x4*)(wr + (size_t)(lo4 + 256 * j + c) * NE + eg * 8);
                    const f32x4 w0 = wp[0], w1 = wp[1];
                    l8[0] += hx * w0.x; l8[1] += hx * w0.y; l8[2] += hx * w0.z; l8[3] += hx * w0.w; l8[4] += hx * w1.x; l8[5] += hx * w1.y; l8[6] += hx * w1.z; l8[7] += hx * w1.w;
                }
#pragma unroll
            for (int k = 0; k < 8; ++k) { const float sres = wave_sum(l8[k]); mylg = (myexp == eg * 8 + k) ? sres : mylg; }
        }
        mylg += br[myexp];
        int te[4]; float tv[4];
#pragma unroll
        for (int r = 0; r < 4; ++r) {
            float v = mylg; int idx = myexp;
#pragma unroll
            for (int o = 1; o < 32; o <<= 1) { const float ov = __shfl_xor(v, o); const int oi = __shfl_xor(idx, o); const bool take = (ov > v) || (ov == v && oi < idx); v = take ? ov : v; idx = take ? oi : idx; }
            te[r] = idx; tv[r] = v; mylg = (myexp == idx) ? -INFINITY : mylg;
        }
        const float e1 = __expf(tv[1] - tv[0]), e2 = __expf(tv[2] - tv[0]), e3 = __expf(tv[3] - tv[0]); const float inv = 1.f / (1.f + e1 + e2 + e3);
        const float tw[4] = {inv, e1 * inv, e2 * inv, e3 * inv};
        if (F.lane < 4) {
            const int e = F.lane == 0 ? te[0] : F.lane == 1 ? te[1] : F.lane == 2 ? te[2] : te[3];
            const float w = F.lane == 0 ? tw[0] : F.lane == 1 ? tw[1] : F.lane == 2 ? tw[2] : tw[3];
            const unsigned pos = atomicAdd(&ECNT[e], 1u);
            TKE[(size_t)m * 4 + F.lane] = e; TKW[(size_t)m * 4 + F.lane] = w; TKP[(size_t)m * 4 + F.lane] = (int)pos;
        }
    }
}

__device__ __forceinline__ void ph_scatter(const Ctx& F) {
    const unsigned* ECNT = (const unsigned*)(F.ws + WS_CTL) + CW_ECNT;
    const int* TKE = (const int*)(F.ws + WS_TKE); const float* TKW = (const float*)(F.ws + WS_TKW); const int* TKP = (const int*)(F.ws + WS_TKP);
    int* ROWOF = (int*)(F.ws + WS_ROWOF); int* ROWTOK = (int*)(F.ws + WS_ROWTOK); float* ROWW = (float*)(F.ws + WS_ROWW); int* TILE = (int*)(F.ws + WS_TILE);
    const bf16_t* H1 = (const bf16_t*)(F.ws + WS_H1); bf16_t* XG = (bf16_t*)(F.ws + WS_XG);
    int* pst = (int*)F.ldsg;
    if (F.tid == 0) {
        int acc = 0;
        for (int e = 0; e < NE; ++e) { const int c = (int)__hip_atomic_load(ECNT + e, __ATOMIC_RELAXED, __HIP_MEMORY_SCOPE_AGENT); pst[e] = acc; pst[32 + e] = c; acc += (c + 255) / 256 * 256; }
        pst[64] = acc;
    }
    __syncthreads();
    if (blockIdx.x == 0) {
        const int ntiles = pst[64] / 256;
        if (F.tid == 0) TILE[0] = ntiles;
        for (int i = F.tid; i < ntiles; i += 512) { int e = 0; for (int k = 1; k < NE; ++k) if (i * 256 >= pst[k]) e = k; TILE[16 + i] = e; }
        for (int e = 0; e < NE; ++e) { const int s = pst[e] + pst[32 + e], en = (e + 1 < NE) ? pst[e + 1] : pst[64]; for (int r = s + F.tid; r < en; r += 512) { ROWTOK[r] = 0; ROWW[r] = 0.f; } }
    }
    const int gw = F.vcu * 8 + F.wave, NGW = F.G * 8;
    for (int idx = gw; idx < T * TOPK; idx += NGW) {
        const int t = idx >> 2, e = TKE[idx], row = pst[e] + TKP[idx];
        if (F.lane == 0) { ROWTOK[row] = t; ROWW[row] = TKW[idx]; ROWOF[idx] = row; }
        const u32x4* src = (const u32x4*)(H1 + (size_t)t * DM); u32x4* dst = (u32x4*)(XG + (size_t)row * DM);
        dst[F.lane] = src[F.lane]; dst[64 + F.lane] = src[64 + F.lane];
    }
}

__device__ __forceinline__ void ph_final(const Ctx& F) {
    const Args& A = *F.a;
    const float* Z = (const float*)(F.ws + WS_Z); const float* ZST = (const float*)(F.ws + WS_ZST); const bf16_t* YS = (const bf16_t*)(F.ws + WS_YS); const int* ROWOF = (const int*)(F.ws + WS_ROWOF);
    const int gw = F.vcu * 8 + F.wave, NGW = F.G * 8;
    f32x4 gg[4], bb[4], g2[4], b2[4];
#pragma unroll
    for (int j = 0; j < 4; ++j) { gg[j] = *((const f32x4*)A.in[I_LNMIX_G] + F.lane + 64 * j); bb[j] = *((const f32x4*)A.in[I_LNMIX_B] + F.lane + 64 * j);
        g2[j] = *((const f32x4*)A.in[I_LNF_G] + F.lane + 64 * j); b2[j] = *((const f32x4*)A.in[I_LNF_B] + F.lane + 64 * j); }
    for (int m = gw; m < T; m += NGW) {
        float mean, rstd; ln_stats16(ZST + (size_t)m * 32, F.lane, mean, rstd);
        const f32x4* zr = (const f32x4*)(Z + (size_t)m * DM) + F.lane;
        f32x4 v[4];
#pragma unroll
        for (int j = 0; j < 4; ++j) v[j] = ((zr[64 * j] - mean) * rstd * gg[j] + bb[j]) * ALPHA;
#pragma unroll
        for (int k = 0; k < 4; ++k) {
            const int row = ROWOF[(size_t)m * 4 + k]; const u32x2* yr = (const u32x2*)(YS + (size_t)row * DM) + F.lane;
#pragma unroll
            for (int j = 0; j < 4; ++j) { const u32x2 y = yr[64 * j]; v[j].x += bflo(y.x); v[j].y += bfhi(y.x); v[j].z += bflo(y.y); v[j].w += bfhi(y.y); }
        }
        float s = 0.f;
#pragma unroll
        for (int j = 0; j < 4; ++j) s += (v[j].x + v[j].y) + (v[j].z + v[j].w);
        const float mu = wave_sum(s) * (1.f / DM); float s2 = 0.f;
#pragma unroll
        for (int j = 0; j < 4; ++j) { v[j] = v[j] - mu; s2 += (v[j].x * v[j].x + v[j].y * v[j].y) + (v[j].z * v[j].z + v[j].w * v[j].w); }
        const float rs = 1.f / sqrtf(wave_sum(s2) * (1.f / DM) + LN_EPS);
        f32x4* orow = (f32x4*)(A.out + (size_t)m * DM) + F.lane;
#pragma unroll
        for (int j = 0; j < 4; ++j) orow[64 * j] = v[j] * rs * g2[j] + b2[j];
    }
}

template <bool COOP>
__global__ void __launch_bounds__(512, 2) mega(Args args) {
    extern __shared__ __attribute__((aligned(16))) unsigned char lds_raw[];
    Ctx F;
    const int wave0 = __builtin_amdgcn_readfirstlane(threadIdx.x >> 6);
#define MKCTX() do { F.a = &args; F.ws = args.ws; F.lds = (LAS unsigned char*)lds_raw; F.ldsg = lds_raw; F.lane = lane_id_asm(); F.wave = wave0; F.tid = wave0 * 64 + F.lane; \
    F.G = gridDim.x; { const int bx = blockIdx.x; F.vcu = (F.G % 8 == 0) ? (bx % 8) * (F.G / 8) + bx / 8 : bx; } } while (0)
    MKCTX();
    const int lo = args.ph_lo, hi = args.ph_hi;
    unsigned char* ws = args.ws;
#ifndef PHMASK
#define PHMASK 0xFFFF
#endif
#define IN(k) (((PHMASK >> (k)) & 1) && lo <= (k) && (k) < hi)
#define SEAM(k) do { if (COOP && IN(k) && IN((k) + 1)) { cg::this_grid().sync(); } } while (0)
    if (IN(0)) { MKCTX(); ph_prologue(F); } SEAM(0);
    if (IN(1)) {
        pg8::Gemm g{(const bf16_t*)(ws + WS_H0), (const bf16_t*)(ws + WS_WIN), DM, DM, DM}; pg8::StaticOrder S; S.init(T, INCOLS, F.G, (int)blockIdx.x);
        pg8::Epi1 E{(bf16_t*)(ws + WS_YAB), (bf16_t*)(ws + WS_GV), (bf16_t*)(ws + WS_Q), (bf16_t*)(ws + WS_K), (bf16_t*)(ws + WS_V), (bf16_t*)(ws + WS_SA), (bf16_t*)(ws + WS_SB), (float*)(ws + WS_GVST)};
        pg8::gemm_phase<pg8::Epi1, pg8::StaticOrder, true>(F.lds, g, S, E, wave0);
    } SEAM(1);
    if (IN(2)) { MKCTX(); ph_kmean(F); ph_mixer_a(F); } SEAM(2);
    if (IN(3)) { MKCTX(); ph_gate(F); } SEAM(3);
    if (IN(4)) { MKCTX(); ph_attn_naive(F); } SEAM(4);
    if (IN(5)) {
        pg8::Gemm g{(const bf16_t*)(ws + WS_YAB), (const bf16_t*)(ws + WS_WAB), 2048, 2048, 2048}; pg8::StaticOrder S; S.init(T, DM, F.G, (int)blockIdx.x);
        pg8::Epi2 E{(const bf16_t*)(ws + WS_SA), (const bf16_t*)(ws + WS_SB), (bf16_t*)(ws + WS_MG)};
        pg8::gemm_phase<pg8::Epi2, pg8::StaticOrder, true>(F.lds, g, S, E, wave0);
    } SEAM(5);
    if (IN(6)) {
        pg8::Gemm g{(const bf16_t*)(ws + WS_MG), (const bf16_t*)(ws + WS_WOUT), DM, DM, DM}; pg8::StaticOrder S; S.init(T, DM, F.G, (int)blockIdx.x);
        pg8::Epi3 E{(const bf16_t*)(ws + WS_H0), (float*)(ws + WS_Z), (float*)(ws + WS_ZST)};
        pg8::gemm_phase<pg8::Epi3, pg8::StaticOrder, true>(F.lds, g, S, E, wave0);
    } SEAM(6);
    if (IN(7)) { MKCTX(); ph_router(F); } SEAM(7);
    if (IN(8)) { MKCTX(); ph_scatter(F); } SEAM(8);
    if (IN(9)) {
        pg8::Gemm g{(const bf16_t*)(ws + WS_XG), (const bf16_t*)(ws + WS_WUP), DM, DM, DM}; pg8::MoeOrder S; S.init((const int*)(ws + WS_TILE), 8, F.G, (int)blockIdx.x);
        pg8::Epi4 E{args.in[I_BUP], (bf16_t*)(ws + WS_ACT)};
        pg8::gemm_phase<pg8::Epi4, pg8::MoeOrder, true>(F.lds, g, S, E, wave0);
    } SEAM(9);
    if (IN(10)) {
        pg8::Gemm g{(const bf16_t*)(ws + WS_ACT), (const bf16_t*)(ws + WS_WDN), FF, FF, FF}; pg8::MoeOrder S; S.init((const int*)(ws + WS_TILE), 4, F.G, (int)blockIdx.x);
        pg8::Epi5 E{args.in[I_BDN], (const float*)(ws + WS_ROWW), (bf16_t*)(ws + WS_YS)};
        pg8::gemm_phase<pg8::Epi5, pg8::MoeOrder, true>(F.lds, g, S, E, wave0);
    } SEAM(10);
    if (IN(11)) { MKCTX(); ph_final(F); }
#undef IN
#undef SEAM
}

extern "C" void kernel_launch(void* const* d_in, const int* in_sizes, int n_in, void* d_out, int out_size, void* d_ws, size_t ws_size, hipStream_t stream) {
    static int grid = 0;
    if (grid == 0) {
        if (n_in != 21 || in_sizes[0] != T * DM || out_size != T * DM || ws_size < WS_END) { fprintf(stderr, "kernel_launch: unexpected shapes (n_in %d, in0 %d, out %d, ws %zu)\n", n_in, n_in > 0 ? in_sizes[0] : -1, out_size, ws_size); grid = -1; return; }
        int dev = 0, cus = 0, per_cu = 0;
        hipGetDevice(&dev); hipDeviceGetAttribute(&cus, hipDeviceAttributeMultiprocessorCount, dev);
        const void* fn = MK_COOP ? (const void*)mega<true> : (const void*)mega<false>;
        hipFuncSetAttribute(fn, hipFuncAttributeMaxDynamicSharedMemorySize, LDS_BYTES);
        hipOccupancyMaxActiveBlocksPerMultiprocessor(&per_cu, fn, 512, LDS_BYTES);
        (void)hipGetLastError();
        if (per_cu < 1) { fprintf(stderr, "kernel_launch: occupancy query says %d blocks/CU\n", per_cu); per_cu = 1; }
        grid = cus * 1;
    }
    if (grid < 0) return;
    hipMemsetAsync((char*)d_ws + WS_CTL, 0, CTL_ZERO_BYTES, stream);
    Args a{};
    for (int i = 0; i < 21; ++i) a.in[i] = (const float*)d_in[i];
    a.out = (float*)d_out; a.ws = (unsigned char*)d_ws;
#if MK_COOP
    a.ph_lo = 0; a.ph_hi = NPHASE;
    void* kargs[] = {&a};
    hipError_t e = hipLaunchCooperativeKernel((const void*)mega<true>, dim3(grid), dim3(512), kargs, LDS_BYTES, stream);
    if (e != hipSuccess) fprintf(stderr, "cooperative launch failed: %s (grid %d)\n", hipGetErrorString(e), grid);
#else
    for (int p = 0; p < NPHASE; ++p) { a.ph_lo = p; a.ph_hi = p + 1; hipLaunchKernelGGL(mega<false>, dim3(grid), dim3(512), LDS_BYTES, stream, a); }
#endif
}
```

```cpp
#include <hip/hip_runtime.h>
#include <hip/hip_cooperative_groups.h>
#include <cstdio>
#include <cstdint>
namespace cg = cooperative_groups;

#ifndef MK_COOP
#define MK_COOP 1
#endif

#define LAS __attribute__((address_space(3)))
typedef unsigned short bf16_t;
typedef short bf16x8 __attribute__((ext_vector_type(8)));
typedef float f32x4 __attribute__((ext_vector_type(4)));
typedef float f32x2 __attribute__((ext_vector_type(2)));
typedef unsigned u32x4 __attribute__((ext_vector_type(4)));
typedef unsigned u32x2 __attribute__((ext_vector_type(2)));

constexpr int NB = 8, SEQ = 4096, DM = 1024, T = NB * SEQ;
constexpr int NH = 8, DH = 128, LBLK = 256, NBLK = SEQ / LBLK;
constexpr int NE = 32, TOPK = 4, FF = 1024;
constexpr int INCOLS = 7 * DM;
constexpr int RMAX = T * TOPK + NE * 256;
constexpr float LN_EPS = 1e-5f;
constexpr float ALPHA = 1.189207115002721f;
constexpr float QSCALE = 0.08838834764831845f * 1.4426950408889634f;

constexpr size_t MiB = 1u << 20, U64 = 64 * MiB;
constexpr size_t WS_CTL = 0, CTL_ZERO_BYTES = 1 * MiB;
constexpr int CW_ECNT = 64;
constexpr int CW_LCNT = 1024;
constexpr int CW_BAR = 4096;
constexpr size_t WS_KMEAN = 1 * MiB;
constexpr size_t WS_GVST = 2 * MiB;
constexpr size_t WS_ZST = 6 * MiB;
constexpr size_t WS_SEL = 10 * MiB;
constexpr size_t WS_TKE = 11 * MiB;
constexpr size_t WS_TKW = 11 * MiB + 512 * 1024;
constexpr size_t WS_TKP = 12 * MiB;
constexpr size_t WS_ROWOF = 12 * MiB + 512 * 1024;
constexpr size_t WS_ROWTOK = 13 * MiB;
constexpr size_t WS_ROWW = 14 * MiB;
constexpr size_t WS_TILE = 15 * MiB;
constexpr size_t WS_LISTS = 16 * MiB;
constexpr size_t WS_LSE = 32 * MiB;
constexpr size_t WS_WIN = 40 * MiB;
constexpr size_t WS_WAB = 54 * MiB;
constexpr size_t WS_WOUT = 58 * MiB;
constexpr size_t WS_WDN = 60 * MiB;
constexpr size_t WS_WUP = 124 * MiB;
constexpr size_t WS_H0 = 4 * U64;
constexpr size_t WS_YAB = 5 * U64;
constexpr size_t WS_GV = 7 * U64;
constexpr size_t WS_Q = 8 * U64, WS_K = 9 * U64, WS_V = 10 * U64, WS_SA = 11 * U64, WS_SB = 12 * U64;
constexpr size_t WS_OP = 13 * U64;
constexpr size_t WS_MG = WS_GV;
constexpr size_t WS_Z = 14 * U64;
constexpr size_t WS_H1 = WS_H0;
constexpr size_t WS_XG = 5 * U64;
constexpr size_t WS_ACT = 9 * U64 + 16 * MiB;
constexpr size_t WS_YS = WS_XG;
constexpr size_t WS_END = 16 * U64;
static_assert(WS_XG + (size_t)RMAX * 2048 <= WS_ACT && WS_ACT + (size_t)RMAX * 2048 <= WS_Z, "ws map");

constexpr int LDS_BYTES = 147456;
constexpr int LDS_MISC = 131072;
constexpr int NPHASE = 12;

__device__ __forceinline__ float bf2f(bf16_t v) { return __uint_as_float((unsigned)v << 16); }
__device__ __forceinline__ float bflo(unsigned u) { return __uint_as_float(u << 16); }
__device__ __forceinline__ float bfhi(unsigned u) { return __uint_as_float(u & 0xffff0000u); }
__device__ __forceinline__ unsigned f2bf(float f) { unsigned u = __builtin_bit_cast(unsigned, f); return (u + 0x7fffu + ((u >> 16) & 1u)) >> 16; }
__device__ __forceinline__ unsigned pk2(float lo, float hi) { return f2bf(lo) | (f2bf(hi) << 16); }
typedef __bf16 bf16x2_t __attribute__((ext_vector_type(2)));
__device__ __forceinline__ unsigned cvt_pk_bf16(float lo, float hi) { f32x2 v = {lo, hi}; bf16x2_t b = __builtin_convertvector(v, bf16x2_t); return __builtin_bit_cast(unsigned, b); }
__device__ __forceinline__ int lane_id_asm() { int l; asm volatile("v_mbcnt_lo_u32_b32 %0, -1, 0\n\tv_mbcnt_hi_u32_b32 %0, -1, %0" : "=v"(l)); return l; }
__device__ __forceinline__ float wave_sum(float v) {
#pragma unroll
    for (int o = 1; o < 64; o <<= 1) v += __shfl_xor(v, o);
    return v;
}
__device__ __forceinline__ float wave_max(float v) {
#pragma unroll
    for (int o = 1; o < 64; o <<= 1) v = fmaxf(v, __shfl_xor(v, o));
    return v;
}
__device__ __forceinline__ f32x2 gelu_pk(f32x2 v) {
    const f32x2 av = __builtin_elementwise_abs(v), d = av * 0.2316418882f + 1.0f;
    f32x2 t; t.x = __builtin_amdgcn_rcpf(d.x); t.y = __builtin_amdgcn_rcpf(d.y);
    f32x2 q = t * 0.5307027145f + (-0.7265760135f); q = q * t + 0.7107068705f; q = q * t + (-0.142248368f); q = q * t + 0.127414796f; q = q * t;
    const f32x2 s = (v * v) * (-0.72134752044f);
    f32x2 e; e.x = __builtin_amdgcn_exp2f(s.x); e.y = __builtin_amdgcn_exp2f(s.y);
    const f32x2 m = v * (q * e), r = v - m;
    f32x2 o; o.x = v.x < 0.f ? m.x : r.x; o.y = v.y < 0.f ? m.y : r.y; return o;
}
__device__ __forceinline__ float sigmoidf_(float x) { return __builtin_amdgcn_rcpf(1.0f + __builtin_amdgcn_exp2f(-1.4426950408889634f * x)); }

namespace pg8 {
constexpr int BM = 256, BK = 64, HALF = 128, HTB = HALF * BK * 2, STAGE_BYTES = 8 * HTB, NXCD = 8, WGM = 8;
__host__ __device__ __forceinline__ int lds_byte(int r, int c) { const int st = (r >> 4) * 2 + (c >> 5), rr = r & 15, cc = c & 31, ob = rr * 64 + cc * 2; return st * 1024 + (ob ^ (((ob >> 9) & 1) << 5)); }
__host__ __device__ __forceinline__ void stage_rc(int b, int& R, int& C) { const int st = b / 1024, sb = b % 1024, swz = sb ^ (((sb >> 9) & 1) << 5); R = (st >> 1) * 16 + swz / 64; C = (st & 1) * 32 + (swz % 64) / 2; }
__host__ __device__ __forceinline__ int perm32(int rho) { const int n = rho >> 4, i = rho & 15; return 8 * (i >> 2) + 4 * n + (i & 3); }

struct Unit { int pm, pn, bt; };
struct Gemm { const bf16_t* A; const bf16_t* Bt; int K, lda, ldb; };

struct StaticOrder {
    int nM, nN, nwg, G, c;
    __device__ void init(int M, int N, int G_, int c_) { nM = M / BM; nN = N / BM; nwg = nM * nN; G = G_; c = c_; }
    __device__ bool next(int i, Unit& u) const {
        const long L = (long)i * G + c; if (L >= nwg) return false;
        int wgid = (int)L; { const int q = nwg / NXCD, r = nwg % NXCD, xcd = wgid % NXCD, off = wgid / NXCD; wgid = (xcd < r ? xcd * (q + 1) : r * (q + 1) + (xcd - r) * q) + off; }
        const int nig = WGM * nN, gid = wgid / nig, fm = gid * WGM, gsz = (nM - fm) < WGM ? (nM - fm) : WGM;
        u.pm = fm + ((wgid % nig) % gsz); u.pn = (wgid % nig) / gsz; u.bt = u.pn; return true;
    }
};
struct MoeOrder {
    int nM, nN, nwg, G, c; const int* tile_e;
    __device__ void init(const int* tiletab, int nN_, int G_, int c_) { nM = tiletab[0]; tile_e = tiletab + 16; nN = nN_; nwg = nM * nN; G = G_; c = c_; }
    __device__ bool next(int i, Unit& u) const {
        const long L = (long)i * G + c; if (L >= nwg) return false;
        int wgid = (int)L; { const int q = nwg / NXCD, r = nwg % NXCD, xcd = wgid % NXCD, off = wgid / NXCD; wgid = (xcd < r ? xcd * (q + 1) : r * (q + 1) + (xcd - r) * q) + off; }
        const int nig = WGM * nN, gid = wgid / nig, fm = gid * WGM, gsz = (nM - fm) < WGM ? (nM - fm) : WGM;
        u.pm = fm + ((wgid % nig) % gsz); u.pn = (wgid % nig) / gsz; u.bt = tile_e[u.pm] * nN + u.pn; return true;
    }
};

template <class Epi, class Sched, bool ALIGN_EPI>
__device__ __forceinline__ void gemm_phase(LAS unsigned char* lds, const Gemm g, const Sched& S, const Epi& E, const int wid) {
    const int lane = lane_id_asm(), tid = wid * 64 + lane;
    const int wr = wid >> 2, wc = wid & 3, fr = lane & 15, fq = lane >> 4;
    const int nt = g.K / BK;
    unsigned voffA[2], voffB[2];
#pragma unroll
    for (int i = 0; i < 2; ++i) { int R, C; stage_rc(tid * 16 + i * 8192, R, C); const int Rb = Epi::PERM ? ((R & ~31) + perm32(R & 31)) : R;
        voffA[i] = (unsigned)(R * g.lda + C) * 2u; voffB[i] = (unsigned)(Rb * g.ldb + C) * 2u; }
    const size_t kstep = (size_t)(BK * 2);
    const size_t hstepA = (size_t)HALF * g.lda * 2, hstepB = (size_t)HALF * g.ldb * 2;
    const size_t tstepA = 2 * hstepA, tstepB = 2 * hstepB;
    const unsigned ldsw = (unsigned)wid * 1024u;
    const int aoff = lds_byte(wr * 64 + fr, fq * 8), boff = lds_byte(wc * 32 + fr, fq * 8);
#define PG8_SA(b, h) (((b) * 2 + (h)) * HTB)
#define PG8_SB(b, h) ((4 + (b) * 2 + (h)) * HTB)
#define PG8_STAGE(bufoff, gbase, voff) do { _Pragma("unroll") for (int _i = 0; _i < 2; ++_i) \
        __builtin_amdgcn_global_load_lds((const unsigned*)((const char*)(gbase) + (voff)[_i]), (LAS unsigned*)(lds + (bufoff) + ldsw + _i * 8192), 16, 0, 0); } while (0)
#define PG8_LDA(dst, b, h) do { _Pragma("unroll") for (int m = 0; m < 4; ++m) _Pragma("unroll") for (int k = 0; k < 2; ++k) dst[m][k] = *(const LAS bf16x8*)(lds + PG8_SA(b, h) + aoff + m * 2048 + k * 1024); } while (0)
#define PG8_LDB(dst, b, h) do { _Pragma("unroll") for (int n = 0; n < 2; ++n) _Pragma("unroll") for (int k = 0; k < 2; ++k) dst[n][k] = *(const LAS bf16x8*)(lds + PG8_SB(b, h) + boff + n * 2048 + k * 1024); } while (0)
#define PG8_MMA(ai, bj, At, Bt) do { __builtin_amdgcn_s_setprio(1); _Pragma("unroll") for (int m = 0; m < 4; ++m) _Pragma("unroll") for (int n = 0; n < 2; ++n) _Pragma("unroll") for (int k = 0; k < 2; ++k) \
        acc[ai][bj][m][n] = __builtin_amdgcn_mfma_f32_16x16x32_bf16(Bt[n][k], At[m][k], acc[ai][bj][m][n], 0, 0, 0); __builtin_amdgcn_s_setprio(0); } while (0)
#define PG8_WAIT_V(n) asm volatile("s_waitcnt vmcnt(" #n ")" ::: "memory")
#define PG8_WAIT_L(n) asm volatile("s_waitcnt lgkmcnt(" #n ")" ::: "memory")
#define PG8_BAR __builtin_amdgcn_s_barrier()
#define PG8_SCHED __builtin_amdgcn_sched_barrier(0)
    Unit cur, nxt; int ui = 0;
    if (!S.next(0, cur)) return;
    f32x4 acc[2][2][4][2];
#pragma unroll
    for (int a = 0; a < 2; ++a)
#pragma unroll
        for (int b = 0; b < 2; ++b)
#pragma unroll
            for (int m = 0; m < 4; ++m)
#pragma unroll
                for (int n = 0; n < 2; ++n) acc[a][b][m][n] = (f32x4){0.f, 0.f, 0.f, 0.f};
    bf16x8 At[4][2], B0[2][2], B1[2][2];
    const char* cA = (const char*)g.A + (size_t)cur.pm * tstepA; const char* cB = (const char*)g.Bt + (size_t)cur.bt * tstepB;
    PG8_STAGE(PG8_SB(0, 0), cB, voffB); PG8_STAGE(PG8_SB(0, 1), cB + hstepB, voffB); PG8_STAGE(PG8_SA(0, 0), cA, voffA); PG8_STAGE(PG8_SA(0, 1), cA + hstepA, voffA);
    if (wr == 1) PG8_BAR;
    PG8_WAIT_V(2); PG8_BAR;
    PG8_STAGE(PG8_SB(1, 0), cB + kstep, voffB); PG8_STAGE(PG8_SA(1, 0), cA + kstep, voffA); PG8_STAGE(PG8_SB(1, 1), cB + hstepB + kstep, voffB);
    PG8_WAIT_V(6); PG8_BAR;
    for (;;) {
        const bool has_next = S.next(ui + 1, nxt);
        const char* nA = has_next ? (const char*)g.A + (size_t)nxt.pm * tstepA : cA; const char* nB = has_next ? (const char*)g.Bt + (size_t)nxt.bt * tstepB : cB;
        for (int t = 0; t < nt; t += 2) {
            const bool last = (t == nt - 2);
            const char* a1 = cA + (size_t)(t + 1) * kstep;
            const char* a2 = last ? nA : cA + (size_t)(t + 2) * kstep; const char* b2 = last ? nB : cB + (size_t)(t + 2) * kstep;
            const char* a3 = a2 + kstep; const char* b3 = b2 + kstep;
            if constexpr (Epi::MID_T > 0) { if (t == Epi::MID_T) E.mid(acc, cur, wr, wc, fr, fq); }
            PG8_LDB(B0, 0, 0); PG8_LDB(B1, 0, 1); PG8_SCHED; PG8_LDA(At, 0, 0); PG8_STAGE(PG8_SA(1, 1), a1 + hstepA, voffA);
            PG8_WAIT_V(8); PG8_WAIT_L(0); PG8_BAR; PG8_MMA(0, 0, At, B0); PG8_MMA(0, 1, At, B1); PG8_BAR; PG8_SCHED;
            PG8_LDA(At, 0, 1); PG8_STAGE(PG8_SB(0, 0), b2, voffB); PG8_STAGE(PG8_SB(0, 1), b2 + hstepB, voffB); PG8_STAGE(PG8_SA(0, 0), a2, voffA);
            PG8_WAIT_V(8); PG8_WAIT_L(0); PG8_BAR; PG8_MMA(1, 0, At, B0); PG8_MMA(1, 1, At, B1); PG8_BAR; PG8_SCHED;
            PG8_LDB(B0, 1, 0); PG8_LDB(B1, 1, 1); PG8_SCHED; PG8_LDA(At, 1, 0); PG8_STAGE(PG8_SA(0, 1), a2 + hstepA, voffA);
            PG8_WAIT_V(8); PG8_WAIT_L(0); PG8_BAR; PG8_MMA(0, 0, At, B0); PG8_MMA(0, 1, At, B1); PG8_BAR; PG8_SCHED;
            PG8_LDA(At, 1, 1); PG8_STAGE(PG8_SB(1, 0), b3, voffB); PG8_STAGE(PG8_SB(1, 1), b3 + hstepB, voffB); PG8_STAGE(PG8_SA(1, 0), a3, voffA);
            PG8_WAIT_V(8); PG8_WAIT_L(0); PG8_BAR; PG8_MMA(1, 0, At, B0); PG8_MMA(1, 1, At, B1); PG8_BAR; PG8_SCHED;
        }
        if constexpr (ALIGN_EPI) { if (wr == 0) PG8_BAR; }
        E(acc, cur, wr, wc, fr, fq);
        if (!has_next) break;
#pragma unroll
        for (int a = 0; a < 2; ++a)
#pragma unroll
            for (int b = 0; b < 2; ++b)
#pragma unroll
                for (int m = 0; m < 4; ++m)
#pragma unroll
                    for (int n = 0; n < 2; ++n) acc[a][b][m][n] = (f32x4){0.f, 0.f, 0.f, 0.f};
        cur = nxt; cA = nA; cB = nB; ++ui;
        if constexpr (ALIGN_EPI) { if (wr == 1) PG8_BAR; }
    }
    PG8_WAIT_V(0);
    if constexpr (!ALIGN_EPI) { if (wr == 0) PG8_BAR; }
    PG8_BAR;
#undef PG8_SA
#undef PG8_SB
#undef PG8_STAGE
#undef PG8_LDA
#undef PG8_LDB
#undef PG8_MMA
#undef PG8_WAIT_V
#undef PG8_WAIT_L
#undef PG8_BAR
#undef PG8_SCHED
}

typedef f32x4 Acc[2][2][4][2];

struct Epi1 {
    static constexpr bool PERM = true; static constexpr int MID_T = 0;
    bf16_t *yab, *gv, *q, *k, *v, *sa, *sb; float* gvst;
    template <int MODE  >
    __device__ __forceinline__ void run(const Acc& acc, const Unit& u, int wr, int wc, int fr, int fq, bf16_t* base, int ld) const {
        const int row0 = u.pm * BM + wr * 64 + fr, col0 = (u.pn & 3) * 256 + wc * 32 + 8 * fq;
#pragma unroll
        for (int ai = 0; ai < 2; ++ai)
#pragma unroll
            for (int m = 0; m < 4; ++m) {
                const int row = row0 + ai * HALF + m * 16; bf16_t* rowp = base + (size_t)row * ld + col0;
                float s1 = 0.f, s2 = 0.f;
#pragma unroll
                for (int bj = 0; bj < 2; ++bj) {
                    f32x4 v0 = acc[ai][bj][m][0], v1 = acc[ai][bj][m][1];
                    if (MODE == 0 || MODE == 1) {
                        f32x2 a = gelu_pk((f32x2){v0[0], v0[1]}), b = gelu_pk((f32x2){v0[2], v0[3]}), c = gelu_pk((f32x2){v1[0], v1[1]}), d = gelu_pk((f32x2){v1[2], v1[3]});
                        v0 = (f32x4){a.x, a.y, b.x, b.y}; v1 = (f32x4){c.x, c.y, d.x, d.y};
                    } else if (MODE == 2) { v0 = v0 * QSCALE; v1 = v1 * QSCALE; }
                    else if (MODE == 4) {
#pragma unroll
                        for (int j = 0; j < 4; ++j) { v0[j] = sigmoidf_(v0[j]); v1[j] = sigmoidf_(v1[j]); }
                    }
                    if (MODE == 1) {
                        s1 += (v0[0] + v0[1]) + (v0[2] + v0[3]) + (v1[0] + v1[1]) + (v1[2] + v1[3]);
                        s2 += (v0[0] * v0[0] + v0[1] * v0[1]) + (v0[2] * v0[2] + v0[3] * v0[3]) + (v1[0] * v1[0] + v1[1] * v1[1]) + (v1[2] * v1[2] + v1[3] * v1[3]);
                    }
                    u32x4 w; w.x = cvt_pk_bf16(v0[0], v0[1]); w.y = cvt_pk_bf16(v0[2], v0[3]); w.z = cvt_pk_bf16(v1[0], v1[1]); w.w = cvt_pk_bf16(v1[2], v1[3]);
                    *(u32x4*)(rowp + bj * HALF) = w;
                }
                if (MODE == 1) {
                    s1 += __shfl_xor(s1, 16); s1 += __shfl_xor(s1, 32); s2 += __shfl_xor(s2, 16); s2 += __shfl_xor(s2, 32);
                    if (fq == 0) *(f32x2*)(gvst + ((size_t)row * 16 + (u.pn & 3) * 4 + wc) * 2) = (f32x2){s1, s2};
                }
            }
    }
    __device__ __forceinline__ void operator()(const Acc& acc, const Unit& u, int wr, int wc, int fr, int fq) const {
        const int region = u.pn >> 2;
        if (region == 0) run<0>(acc, u, wr, wc, fr, fq, yab, 2048);
        else if (region == 1) run<1>(acc, u, wr, wc, fr, fq, gv, 1024);
        else if (region == 2) run<2>(acc, u, wr, wc, fr, fq, q, 1024);
        else if (region == 3) run<3>(acc, u, wr, wc, fr, fq, k, 1024);
        else if (region == 4) run<3>(acc, u, wr, wc, fr, fq, v, 1024);
        else if (region == 5) run<4>(acc, u, wr, wc, fr, fq, sa, 1024);
        else run<4>(acc, u, wr, wc, fr, fq, sb, 1024);
    }
    __device__ __forceinline__ void mid(Acc&, const Unit&, int, int, int, int) const {}
};

struct Epi2 {
    static constexpr bool PERM = true; static constexpr int MID_T = 16;
    const bf16_t *sa, *sb; bf16_t* mg;
    __device__ __forceinline__ void mid(Acc& acc, const Unit& u, int wr, int wc, int fr, int fq) const {
        int row0 = u.pm * BM + wr * 64 + fr, col0 = u.pn * BM + wc * 32 + 8 * fq;
        asm volatile("" : "+v"(row0), "+v"(col0));
#pragma unroll
        for (int ai = 0; ai < 2; ++ai)
#pragma unroll
            for (int m = 0; m < 4; ++m) {
                const size_t off = (size_t)(row0 + ai * HALF + m * 16) * DM + col0;
#pragma unroll
                for (int bj = 0; bj < 2; ++bj) {
                    const u32x4 a = *(const u32x4*)(sa + off + bj * HALF), b = *(const u32x4*)(sb + off + bj * HALF);
                    f32x4 r0, r1;
#define RQ(x, y) ((x) * __builtin_amdgcn_rcpf(y))
                    r0[0] = RQ(bflo(a.x), bflo(b.x)); r0[1] = RQ(bfhi(a.x), bfhi(b.x)); r0[2] = RQ(bflo(a.y), bflo(b.y)); r0[3] = RQ(bfhi(a.y), bfhi(b.y));
                    r1[0] = RQ(bflo(a.z), bflo(b.z)); r1[1] = RQ(bfhi(a.z), bfhi(b.z)); r1[2] = RQ(bflo(a.w), bflo(b.w)); r1[3] = RQ(bfhi(a.w), bfhi(b.w));
#undef RQ
                    acc[ai][bj][m][0] = acc[ai][bj][m][0] * r0; acc[ai][bj][m][1] = acc[ai][bj][m][1] * r1;
                }
                asm volatile("" : "+v"(acc[ai][0][m][0]), "+v"(acc[ai][0][m][1]), "+v"(acc[ai][1][m][0]), "+v"(acc[ai][1][m][1]));
                asm volatile("" ::: "memory");
            }
    }
    __device__ __forceinline__ void operator()(const Acc& acc, const Unit& u, int wr, int wc, int fr, int fq) const {
        const int row0 = u.pm * BM + wr * 64 + fr, col0 = u.pn * BM + wc * 32 + 8 * fq;
#pragma unroll
        for (int ai = 0; ai < 2; ++ai)
#pragma unroll
            for (int m = 0; m < 4; ++m) {
                const size_t off = (size_t)(row0 + ai * HALF + m * 16) * DM + col0;
#pragma unroll
                for (int bj = 0; bj < 2; ++bj) {
                    const u32x4 b = *(const u32x4*)(sb + off + bj * HALF);
                    const f32x4 v0 = acc[ai][bj][m][0], v1 = acc[ai][bj][m][1];
                    u32x4 w; w.x = cvt_pk_bf16(v0[0] * bflo(b.x), v0[1] * bfhi(b.x)); w.y = cvt_pk_bf16(v0[2] * bflo(b.y), v0[3] * bfhi(b.y));
                    w.z = cvt_pk_bf16(v1[0] * bflo(b.z), v1[1] * bfhi(b.z)); w.w = cvt_pk_bf16(v1[2] * bflo(b.w), v1[3] * bfhi(b.w));
                    *(u32x4*)(mg + off + bj * HALF) = w;
                }
            }
    }
};

struct Epi3 {
    static constexpr bool PERM = false; static constexpr int MID_T = 0;
    const bf16_t* h0; float* z; float* zst;
    __device__ __forceinline__ void mid(Acc&, const Unit&, int, int, int, int) const {}
    __device__ __forceinline__ void operator()(const Acc& acc, const Unit& u, int wr, int wc, int fr, int fq) const {
        const int row0 = u.pm * BM + wr * 64 + fr, col0 = u.pn * BM + wc * 32 + 4 * fq;
#pragma unroll
        for (int ai = 0; ai < 2; ++ai)
#pragma unroll
            for (int m = 0; m < 4; ++m) {
                const int row = row0 + ai * HALF + m * 16; const size_t off = (size_t)row * DM + col0;
                float s1 = 0.f, s2 = 0.f;
#pragma unroll
                for (int bj = 0; bj < 2; ++bj)
#pragma unroll
                    for (int n = 0; n < 2; ++n) {
                        const u32x2 hb = *(const u32x2*)(h0 + off + bj * HALF + n * 16);
                        f32x4 v = acc[ai][bj][m][n];
                        v[0] += ALPHA * bflo(hb.x); v[1] += ALPHA * bfhi(hb.x); v[2] += ALPHA * bflo(hb.y); v[3] += ALPHA * bfhi(hb.y);
                        s1 += (v[0] + v[1]) + (v[2] + v[3]); s2 += (v[0] * v[0] + v[1] * v[1]) + (v[2] * v[2] + v[3] * v[3]);
                        *(f32x4*)(z + off + bj * HALF + n * 16) = v;
                    }
                s1 += __shfl_xor(s1, 16); s1 += __shfl_xor(s1, 32); s2 += __shfl_xor(s2, 16); s2 += __shfl_xor(s2, 32);
                if (fq == 0) *(f32x2*)(zst + ((size_t)row * 16 + u.pn * 4 + wc) * 2) = (f32x2){s1, s2};
            }
    }
};

struct Epi4 {
    static constexpr bool PERM = true; static constexpr int MID_T = 0;
    const float* b_up; bf16_t* act;
    __device__ __forceinline__ void mid(Acc&, const Unit&, int, int, int, int) const {}
    __device__ __forceinline__ void operator()(const Acc& acc, const Unit& u, int wr, int wc, int fr, int fq) const {
        const int e = u.bt >> 3;
        const int row0 = u.pm * BM + wr * 64 + fr, c0 = u.pn * HALF + wc * 32 + 8 * fq;
        const float* bg = b_up + (size_t)e * 2 * FF + c0; const float* bu = bg + FF;
        const f32x4 bg0 = *(const f32x4*)bg, bg1 = *(const f32x4*)(bg + 4), bu0 = *(const f32x4*)bu, bu1 = *(const f32x4*)(bu + 4);
#pragma unroll
        for (int ai = 0; ai < 2; ++ai)
#pragma unroll
            for (int m = 0; m < 4; ++m) {
                const int row = row0 + ai * HALF + m * 16;
                float o[8];
#pragma unroll
                for (int n = 0; n < 2; ++n)
#pragma unroll
                    for (int j = 0; j < 4; ++j) {
                        float gg = acc[ai][0][m][n][j] + (n ? bg1[j] : bg0[j]), uu = acc[ai][1][m][n][j] + (n ? bu1[j] : bu0[j]);
                        gg = fminf(gg, 7.0f); uu = fminf(fmaxf(uu, -7.0f), 7.0f);
                        o[n * 4 + j] = (uu + 1.0f) * (gg * sigmoidf_(1.702f * gg));
                    }
                u32x4 w; w.x = cvt_pk_bf16(o[0], o[1]); w.y = cvt_pk_bf16(o[2], o[3]); w.z = cvt_pk_bf16(o[4], o[5]); w.w = cvt_pk_bf16(o[6], o[7]);
                *(u32x4*)(act + (size_t)row * FF + c0) = w;
            }
    }
};

struct Epi5 {
    static constexpr bool PERM = true; static constexpr int MID_T = 0;
    const float* b_down; const float* roww; bf16_t* ys;
    __device__ __forceinline__ void mid(Acc&, const Unit&, int, int, int, int) const {}
    __device__ __forceinline__ void operator()(const Acc& acc, const Unit& u, int wr, int wc, int fr, int fq) const {
        const int e = u.bt >> 2;
        const int row0 = u.pm * BM + wr * 64 + fr, col0 = u.pn * BM + wc * 32 + 8 * fq;
        f32x4 bv[2][2];
#pragma unroll
        for (int bj = 0; bj < 2; ++bj)
#pragma unroll
            for (int n = 0; n < 2; ++n) bv[bj][n] = *(const f32x4*)(b_down + (size_t)e * DM + col0 + bj * HALF + 4 * n);
#pragma unroll
        for (int ai = 0; ai < 2; ++ai)
#pragma unroll
            for (int m = 0; m < 4; ++m) {
                const int row = row0 + ai * HALF + m * 16; const float rw = roww[row];
#pragma unroll
                for (int bj = 0; bj < 2; ++bj) {
                    const f32x4 v0 = (acc[ai][bj][m][0] + bv[bj][0]) * rw, v1 = (acc[ai][bj][m][1] + bv[bj][1]) * rw;
                    u32x4 w; w.x = cvt_pk_bf16(v0[0], v0[1]); w.y = cvt_pk_bf16(v0[2], v0[3]); w.z = cvt_pk_bf16(v1[0], v1[1]); w.w = cvt_pk_bf16(v1[2], v1[3]);
                    *(u32x4*)(ys + (size_t)row * DM + col0 + bj * HALF) = w;
                }
            }
    }
};
}

struct Args { const float* in[21]; float* out; unsigned char* ws; int ph_lo, ph_hi; };
enum { I_X = 0, I_LNIN_G, I_LNIN_B, I_WIN, I_GLN_G, I_GLN_B, I_WSP, I_BSP, I_WBA, I_WBB, I_WOUT, I_LNMIX_G, I_LNMIX_B, I_WR, I_BR, I_WUP, I_BUP, I_WDN, I_BDN, I_LNF_G, I_LNF_B };

struct Ctx { const Args* a; unsigned char* ws; LAS unsigned char* lds; unsigned char* ldsg; int tid, lane, wave, G, vcu; };

__device__ __forceinline__ void tr_item(const float* W, int N, int k0, int n0, bf16_t* dst, int drow0, int dld, int dcol0, LAS float* scr, int lane) {
#pragma unroll 8
    for (int i = 0; i < 32; ++i) { const int kk = 2 * i + (lane >> 5); scr[kk * 33 + (lane & 31)] = W[(size_t)(k0 + kk) * N + n0 + (lane & 31)]; }
    asm volatile("s_waitcnt lgkmcnt(0)" ::: "memory");
    const int c = lane & 7;
#pragma unroll
    for (int j = 0; j < 4; ++j) { const int n = (lane >> 3) + 8 * j; const LAS float* s = scr + (8 * c) * 33 + n;
        u32x4 o; o.x = pk2(s[0 * 33], s[1 * 33]); o.y = pk2(s[2 * 33], s[3 * 33]); o.z = pk2(s[4 * 33], s[5 * 33]); o.w = pk2(s[6 * 33], s[7 * 33]);
        *(u32x4*)(dst + (size_t)(drow0 + n) * dld + dcol0 + k0 + 8 * c) = o; }
    asm volatile("s_waitcnt lgkmcnt(0)" ::: "memory");
}
__device__ __forceinline__ void ph_prologue(const Ctx& F) {
    const Args& A = *F.a;
    LAS float* scr = (LAS float*)(F.lds + F.wave * 16384);
    const int gw = F.vcu * 8 + F.wave, NGW = F.G * 8;
    bf16_t* WIN = (bf16_t*)(F.ws + WS_WIN); bf16_t* WAB = (bf16_t*)(F.ws + WS_WAB); bf16_t* WOUT = (bf16_t*)(F.ws + WS_WOUT);
    bf16_t* WDN = (bf16_t*)(F.ws + WS_WDN); bf16_t* WUP = (bf16_t*)(F.ws + WS_WUP);
    constexpr int I_IN = 16 * (INCOLS / 32), I_SQ = 16 * 32, I_UP = NE * 16 * 64, I_DN = NE * 16 * 32;
    constexpr int NITEMS = I_IN + 3 * I_SQ + I_UP + I_DN;
    for (int it = gw; it < NITEMS; it += NGW) {
        int r = it;
        if (r < I_IN) { const int nblk = INCOLS / 32, kb = r / nblk, nb = r % nblk; tr_item(A.in[I_WIN], INCOLS, 64 * kb, 32 * nb, WIN, 32 * nb, DM, 0, scr, F.lane); continue; } r -= I_IN;
        if (r < I_SQ) { const int kb = r / 32, nb = r % 32; tr_item(A.in[I_WBA], DM, 64 * kb, 32 * nb, WAB, 32 * nb, 2048, 0, scr, F.lane); continue; } r -= I_SQ;
        if (r < I_SQ) { const int kb = r / 32, nb = r % 32; tr_item(A.in[I_WBB], DM, 64 * kb, 32 * nb, WAB, 32 * nb, 2048, 1024, scr, F.lane); continue; } r -= I_SQ;
        if (r < I_SQ) { const int kb = r / 32, nb = r % 32; tr_item(A.in[I_WOUT], DM, 64 * kb, 32 * nb, WOUT, 32 * nb, DM, 0, scr, F.lane); continue; } r -= I_SQ;
        if (r < I_UP) { const int e = r / (16 * 64), rr = r % (16 * 64), kb = rr / 64, nb = rr % 64; const int n0 = 32 * nb, half = n0 >= FF, rem = n0 - half * FF, pn = rem >> 7, b = (rem & 127) >> 5;
            tr_item(A.in[I_WUP] + (size_t)e * DM * 2 * FF, 2 * FF, 64 * kb, n0, WUP, e * 2048 + 256 * pn + half * 128 + 32 * b, DM, 0, scr, F.lane); continue; } r -= I_UP;
        { const int e = r / (16 * 32), rr = r % (16 * 32), kb = rr / 32, nb = rr % 32; tr_item(A.in[I_WDN] + (size_t)e * FF * DM, DM, 64 * kb, 32 * nb, WDN, e * 1024 + 32 * nb, FF, 0, scr, F.lane); }
    }
    const float* lg = A.in[I_LNIN_G]; const float* lb = A.in[I_LNIN_B]; bf16_t* H0 = (bf16_t*)(F.ws + WS_H0);
    f32x4 gg[4], bb[4];
#pragma unroll
    for (int j = 0; j < 4; ++j) { gg[j] = *((const f32x4*)lg + F.lane + 64 * j); bb[j] = *((const f32x4*)lb + F.lane + 64 * j); }
    for (int m = gw; m < T; m += NGW) {
        const f32x4* xr = (const f32x4*)(A.in[I_X] + (size_t)m * DM) + F.lane;
        f32x4 v[4]; float s = 0.f;
#pragma unroll
        for (int j = 0; j < 4; ++j) { v[j] = xr[64 * j]; s += (v[j].x + v[j].y) + (v[j].z + v[j].w); }
        const float mean = wave_sum(s) * (1.f / DM); float s2 = 0.f;
#pragma unroll
        for (int j = 0; j < 4; ++j) { v[j] = v[j] - mean; s2 += (v[j].x * v[j].x + v[j].y * v[j].y) + (v[j].z * v[j].z + v[j].w * v[j].w); }
        const float rstd = 1.f / sqrtf(wave_sum(s2) * (1.f / DM) + LN_EPS);
        u32x2* o8 = (u32x2*)(H0 + (size_t)m * DM) + F.lane;
#pragma unroll
        for (int j = 0; j < 4; ++j) { const f32x4 y = v[j] * rstd * gg[j] + bb[j]; o8[64 * j] = (u32x2){pk2(y.x, y.y), pk2(y.z, y.w)}; }
    }
}

__device__ __forceinline__ void ph_kmean(const Ctx& F) {
    const bf16_t* K = (const bf16_t*)(F.ws + WS_K); float* KM = (float*)(F.ws + WS_KMEAN);
    float* red = (float*)F.ldsg;
    const int d = F.tid & 127, part = F.tid >> 7;
    for (int it = F.vcu; it < NB * NH * NBLK; it += F.G) {
        const int b = it / (NH * NBLK), h = (it / NBLK) % NH, j = it % NBLK;
        const bf16_t* kp = K + ((size_t)(b * SEQ + j * LBLK + part * 64)) * DM + h * DH + d;
        float s = 0.f;
        for (int r = 0; r < 64; ++r) s += bf2f(kp[(size_t)r * DM]);
        red[part * 128 + d] = s;
        __syncthreads();
        if (F.tid < 128) KM[(size_t)it * DH + d] = (red[d] + red[128 + d] + red[256 + d] + red[384 + d]) * (1.0f / LBLK);
        __syncthreads();
    }
}
__device__ __forceinline__ void ph_mixer_a(const Ctx& F) {
    const Args& A = *F.a;
    const bf16_t* GV = (const bf16_t*)(F.ws + WS_GV); bf16_t* YAB = (bf16_t*)(F.ws + WS_YAB); const float* GVST = (const float*)(F.ws + WS_GVST);
    const float* lg = A.in[I_GLN_G]; const float* lb = A.in[I_GLN_B]; const float* wsp = A.in[I_WSP]; const float* bsp = A.in[I_BSP];
    float* vt = (float*)F.ldsg;
    float* st = (float*)(F.ldsg + 131072);
    for (int it = F.vcu; it < NB * 32 * 4; it += F.G) {
        const int b = it / 128, c = (it >> 2) & 31, g = it & 3;
        const int tok0 = b * SEQ + c * 128;
        if (F.tid < 128) {
            const float* p = GVST + (size_t)(tok0 + F.tid) * 32; float s1 = 0.f, s2 = 0.f;
            for (int i = 0; i < 16; ++i) { s1 += p[2 * i]; s2 += p[2 * i + 1]; }
            const float mean = s1 * (1.f / DM), var = s2 * (1.f / DM) - mean * mean;
            st[2 * F.tid] = mean; st[2 * F.tid + 1] = 1.f / sqrtf(fmaxf(var, 0.f) + LN_EPS);
        }
        __syncthreads();
        for (int k = 0; k < 8; ++k) {
            const int idx = F.tid + 512 * k, s = idx >> 5, d0 = (idx & 31) * 8;
            const u32x4 raw = *(const u32x4*)(GV + (size_t)(tok0 + s) * DM + g * 256 + d0);
            const float mean = st[2 * s], rstd = st[2 * s + 1];
            const float* gp = lg + g * 256 + d0; const float* bp = lb + g * 256 + d0;
            float x[8] = {bflo(raw.x), bfhi(raw.x), bflo(raw.y), bfhi(raw.y), bflo(raw.z), bfhi(raw.z), bflo(raw.w), bfhi(raw.w)};
#pragma unroll
            for (int j = 0; j < 8; ++j) vt[s * 256 + d0 + j] = (x[j] - mean) * rstd * gp[j] + bp[j];
        }
        __syncthreads();
        const int d = F.tid & 255, th = F.tid >> 8;
        for (int tt = 0; tt < 64; ++tt) {
            const int t = th * 64 + tt;
            const float* wrow = wsp + ((size_t)g * 128 + t) * 128;
            float acc = 0.f;
            for (int s = 0; s <= t; ++s) acc += wrow[s] * vt[s * 256 + d];
            acc += bsp[g * 128 + t];
            bf16_t* yp = YAB + (size_t)(tok0 + t) * 2048 + g * 256 + d;
            *yp = (bf16_t)f2bf(bf2f(*yp) * acc);
        }
        __syncthreads();
    }
}

__device__ __forceinline__ void ph_gate(const Ctx& F) {
    const bf16_t* Q = (const bf16_t*)(F.ws + WS_Q); const float* KM = (const float*)(F.ws + WS_KMEAN);
    unsigned* SEL = (unsigned*)(F.ws + WS_SEL); unsigned* LISTS = (unsigned*)(F.ws + WS_LISTS); unsigned* LCNT = (unsigned*)(F.ws + WS_CTL) + CW_LCNT;
    float* km = (float*)F.ldsg;
    unsigned* lc = (unsigned*)(F.ldsg + 8192);
    for (int it = F.vcu; it < NB * NH * 8; it += F.G) {
        const int b = it / 64, h = (it >> 3) & 7, tc = it & 7;
        for (int i = F.tid; i < NBLK * DH; i += 512) km[i] = KM[(size_t)(b * NH + h) * NBLK * DH + i];
        if (F.tid < 32) lc[F.tid] = 0u;
        __syncthreads();
        const int t = tc * 512 + F.tid, qi = t >> 8;
        float gsc[15];
#pragma unroll
        for (int j = 0; j < 15; ++j) gsc[j] = 0.f;
        const bf16_t* qp = Q + (size_t)(b * SEQ + t) * DM + h * DH;
        for (int c = 0; c < 16; ++c) {
            const u32x4 raw = *(const u32x4*)(qp + c * 8);
            const float x[8] = {bflo(raw.x), bfhi(raw.x), bflo(raw.y), bfhi(raw.y), bflo(raw.z), bfhi(raw.z), bflo(raw.w), bfhi(raw.w)};
#pragma unroll
            for (int j = 0; j < 15; ++j) if (j < qi) {
                const float* kk = km + j * DH + c * 8;
#pragma unroll
                for (int e = 0; e < 8; ++e) gsc[j] += x[e] * kk[e];
            }
        }
        const int nsel = qi < 3 ? qi : 3;
        int sel[3] = {0, 0, 0}; unsigned lpos[3] = {0, 0, 0};
#pragma unroll
        for (int r = 0; r < 3; ++r) {
            float best = -INFINITY; int bi = -1;
#pragma unroll
            for (int j = 0; j < 15; ++j) { const bool c = (j < qi) && (gsc[j] > best); best = c ? gsc[j] : best; bi = c ? j : bi; }
#pragma unroll
            for (int j = 0; j < 15; ++j) if (j == bi) gsc[j] = -INFINITY;
            sel[r] = bi < 0 ? 0 : bi;
            if (r < nsel) lpos[r] = atomicAdd(&lc[sel[r]], 1u);
        }
        SEL[(size_t)(b * SEQ + t) * NH + h] = (unsigned)sel[0] | ((unsigned)sel[1] << 8) | ((unsigned)sel[2] << 16) | ((unsigned)nsel << 24);
        __syncthreads();
        if (F.tid < 16) lc[16 + F.tid] = lc[F.tid] ? atomicAdd(&LCNT[(b * NH + h) * NBLK + F.tid], lc[F.tid]) : 0u;
        __syncthreads();
#pragma unroll
        for (int r = 0; r < 3; ++r) if (r < nsel) LISTS[(size_t)((b * NH + h) * NBLK + sel[r]) * 4096 + lc[16 + sel[r]] + lpos[r]] = (unsigned)t | ((unsigned)r << 12);
        __syncthreads();
    }
}

__device__ __forceinline__ void ph_attn_naive(const Ctx& F) {
    const bf16_t* Q = (const bf16_t*)(F.ws + WS_Q); const bf16_t* K = (const bf16_t*)(F.ws + WS_K); const bf16_t* V = (const bf16_t*)(F.ws + WS_V);
    const unsigned* SEL = (const unsigned*)(F.ws + WS_SEL); bf16_t* YAB = (bf16_t*)(F.ws + WS_YAB);
    float* qs = (float*)(F.ldsg + F.wave * 4608);
    float* sc = qs + 128;
    const int gw = F.vcu * 8 + F.wave, NGW = F.G * 8;
    for (int w = gw; w < NB * NH * SEQ; w += NGW) {
        const int b = w / (NH * SEQ), h = (w / SEQ) % NH, t = w % SEQ, qi = t >> 8, tl = t & 255;
        const size_t tok = (size_t)b * SEQ + t;
        { const unsigned qq = *(const unsigned*)(Q + tok * DM + h * DH + 2 * F.lane); qs[2 * F.lane] = bflo(qq); qs[2 * F.lane + 1] = bfhi(qq); }
        const unsigned selw = SEL[tok * NH + h]; const int nsel = selw >> 24;
        float mx = -INFINITY;
        for (int r = 0; r <= nsel; ++r) {
            const int jb = (r < nsel) ? (int)((selw >> (8 * r)) & 0xff) : qi;
            for (int c = 0; c < 4; ++c) {
                const int key = c * 64 + F.lane;
                const bool valid = (r < nsel) || (key <= tl);
                const bf16_t* kp = K + ((size_t)b * SEQ + jb * LBLK + key) * DM + h * DH;
                float s = 0.f;
#pragma unroll 4
                for (int dd = 0; dd < 16; ++dd) {
                    const u32x4 raw = *(const u32x4*)(kp + dd * 8);
                    const float* q8 = qs + dd * 8;
                    s += bflo(raw.x) * q8[0] + bfhi(raw.x) * q8[1] + bflo(raw.y) * q8[2] + bfhi(raw.y) * q8[3] + bflo(raw.z) * q8[4] + bfhi(raw.z) * q8[5] + bflo(raw.w) * q8[6] + bfhi(raw.w) * q8[7];
                }
                s = valid ? s : -INFINITY;
                sc[r * 256 + key] = s; mx = fmaxf(mx, s);
            }
        }
        mx = wave_max(mx);
        float l = 0.f;
        const int ntot = (nsel + 1) * 256;
        for (int i = F.lane; i < ntot; i += 64) { const float p = __builtin_amdgcn_exp2f(sc[i] - mx); sc[i] = p; l += p; }
        l = wave_sum(l);
        float o0 = 0.f, o1 = 0.f;
        for (int r = 0; r <= nsel; ++r) {
            const int jb = (r < nsel) ? (int)((selw >> (8 * r)) & 0xff) : qi;
            const int nk = (r < nsel) ? 256 : tl + 1;
            const bf16_t* vp = V + ((size_t)b * SEQ + jb * LBLK) * DM + h * DH + 2 * F.lane;
#pragma unroll 4
            for (int key = 0; key < nk; ++key) { const unsigned vv = *(const unsigned*)(vp + (size_t)key * DM); const float p = sc[r * 256 + key]; o0 += p * bflo(vv); o1 += p * bfhi(vv); }
        }
        const float il = 1.f / l;
        *(unsigned*)(YAB + tok * 2048 + 1024 + h * DH + 2 * F.lane) = pk2(o0 * il, o1 * il);
    }
}

__device__ __forceinline__ void ln_stats16(const float* st, int lane, float& mean, float& rstd) {
    float s1 = 0.f, s2 = 0.f;
    if (lane < 16) { const f32x2 p = *(const f32x2*)(st + 2 * lane); s1 = p.x; s2 = p.y; }
    s1 = wave_sum(s1); s2 = wave_sum(s2);
    mean = s1 * (1.f / DM); const float var = s2 * (1.f / DM) - mean * mean; rstd = 1.f / sqrtf(fmaxf(var, 0.f) + LN_EPS);
}
__device__ __forceinline__ void ph_router(const Ctx& F) {
    const Args& A = *F.a;
    const float* Z = (const float*)(F.ws + WS_Z); const float* ZST = (const float*)(F.ws + WS_ZST); bf16_t* H1 = (bf16_t*)(F.ws + WS_H1);
    int* TKE = (int*)(F.ws + WS_TKE); float* TKW = (float*)(F.ws + WS_TKW); int* TKP = (int*)(F.ws + WS_TKP); unsigned* ECNT = (unsigned*)(F.ws + WS_CTL) + CW_ECNT;
    const float* wr = A.in[I_WR]; const float* br = A.in[I_BR];
    const int gw = F.vcu * 8 + F.wave, NGW = F.G * 8;
    const f32x4* gp = (const f32x4*)A.in[I_LNMIX_G] + F.lane; const f32x4* bp = (const f32x4*)A.in[I_LNMIX_B] + F.lane;
    for (int m = gw; m < T; m += NGW) {
        float mean, rstd; ln_stats16(ZST + (size_t)m * 32, F.lane, mean, rstd);
        const f32x4* zr = (const f32x4*)(Z + (size_t)m * DM) + F.lane;
        f32x4 hv[4];
        u32x2* o8 = (u32x2*)(H1 + (size_t)m * DM) + F.lane;
#pragma unroll
        for (int j = 0; j < 4; ++j) { hv[j] = (zr[64 * j] - mean) * rstd * gp[64 * j] + bp[64 * j]; o8[64 * j] = (u32x2){pk2(hv[j].x, hv[j].y), pk2(hv[j].z, hv[j].w)}; }
        asm volatile("" ::: "memory");
        int lo4 = 4 * F.lane; asm volatile("" : "+v"(lo4));
        const int myexp = F.lane & 31;
        float mylg = 0.f;
#pragma unroll 1
        for (int eg = 0; eg < 4; ++eg) {
            float l8[8];
#pragma unroll
            for (int k = 0; k < 8; ++k) l8[k] = 0.f;
#pragma unroll
            for (int j = 0; j < 4; ++j)
#pragma unroll
                for (int c = 0; c < 4; ++c) {
                    const float hx = hv[j][c]; const f32x4* wp = (const f32x4*)(wr + (size_t)(lo4 + 256 * j + c) * NE + eg * 8);
                    const f32x4 w0 = wp[0], w1 = wp[1];
                    l8[0] += hx * w0.x; l8[1] += hx * w0.y; l8[2] += hx * w0.z; l8[3] += hx * w0.w; l8[4] += hx * w1.x; l8[5] += hx * w1.y; l8[6] += hx * w1.z; l8[7] += hx * w1.w;
                }
#pragma unroll
            for (int k = 0; k < 8; ++k) { const float sres = wave_sum(l8[k]); mylg = (myexp == eg * 8 + k) ? sres : mylg; }
        }
        mylg += br[myexp];
        int te[4]; float tv[4];
#pragma unroll
        for (int r = 0; r < 4; ++r) {
            float v = mylg; int idx = myexp;
#pragma unroll
            for (int o = 1; o < 32; o <<= 1) { const float ov = __shfl_xor(v, o); const int oi = __shfl_xor(idx, o); const bool take = (ov > v) || (ov == v && oi < idx); v = take ? ov : v; idx = take ? oi : idx; }
            te[r] = idx; tv[r] = v; mylg = (myexp == idx) ? -INFINITY : mylg;
        }
        const float e1 = __expf(tv[1] - tv[0]), e2 = __expf(tv[2] - tv[0]), e3 = __expf(tv[3] - tv[0]); const float inv = 1.f / (1.f + e1 + e2 + e3);
        const float tw[4] = {inv, e1 * inv, e2 * inv, e3 * inv};
        if (F.lane < 4) {
            const int e = F.lane == 0 ? te[0] : F.lane == 1 ? te[1] : F.lane == 2 ? te[2] : te[3];
            const float w = F.lane == 0 ? tw[0] : F.lane == 1 ? tw[1] : F.lane == 2 ? tw[2] : tw[3];
            const unsigned pos = atomicAdd(&ECNT[e], 1u);
            TKE[(size_t)m * 4 + F.lane] = e; TKW[(size_t)m * 4 + F.lane] = w; TKP[(size_t)m * 4 + F.lane] = (int)pos;
        }
    }
}

__device__ __forceinline__ void ph_scatter(const Ctx& F) {
    const unsigned* ECNT = (const unsigned*)(F.ws + WS_CTL) + CW_ECNT;
    const int* TKE = (const int*)(F.ws + WS_TKE); const float* TKW = (const float*)(F.ws + WS_TKW); const int* TKP = (const int*)(F.ws + WS_TKP);
    int* ROWOF = (int*)(F.ws + WS_ROWOF); int* ROWTOK = (int*)(F.ws + WS_ROWTOK); float* ROWW = (float*)(F.ws + WS_ROWW); int* TILE = (int*)(F.ws + WS_TILE);
    const bf16_t* H1 = (const bf16_t*)(F.ws + WS_H1); bf16_t* XG = (bf16_t*)(F.ws + WS_XG);
    int* pst = (int*)F.ldsg;
    if (F.tid == 0) {
        int acc = 0;
        for (int e = 0; e < NE; ++e) { const int c = (int)__hip_atomic_load(ECNT + e, __ATOMIC_RELAXED, __HIP_MEMORY_SCOPE_AGENT); pst[e] = acc; pst[32 + e] = c; acc += (c + 255) / 256 * 256; }
        pst[64] = acc;
    }
    __syncthreads();
    if (blockIdx.x == 0) {
        const int ntiles = pst[64] / 256;
        if (F.tid == 0) TILE[0] = ntiles;
        for (int i = F.tid; i < ntiles; i += 512) { int e = 0; for (int k = 1; k < NE; ++k) if (i * 256 >= pst[k]) e = k; TILE[16 + i] = e; }
        for (int e = 0; e < NE; ++e) { const int s = pst[e] + pst[32 + e], en = (e + 1 < NE) ? pst[e + 1] : pst[64]; for (int r = s + F.tid; r < en; r += 512) { ROWTOK[r] = 0; ROWW[r] = 0.f; } }
    }
    const int gw = F.vcu * 8 + F.wave, NGW = F.G * 8;
    for (int idx = gw; idx < T * TOPK; idx += NGW) {
        const int t = idx >> 2, e = TKE[idx], row = pst[e] + TKP[idx];
        if (F.lane == 0) { ROWTOK[row] = t; ROWW[row] = TKW[idx]; ROWOF[idx] = row; }
        const u32x4* src = (const u32x4*)(H1 + (size_t)t * DM); u32x4* dst = (u32x4*)(XG + (size_t)row * DM);
        dst[F.lane] = src[F.lane]; dst[64 + F.lane] = src[64 + F.lane];
    }
}

__device__ __forceinline__ void ph_final(const Ctx& F) {
    const Args& A = *F.a;
    const float* Z = (const float*)(F.ws + WS_Z); const float* ZST = (const float*)(F.ws + WS_ZST); const bf16_t* YS = (const bf16_t*)(F.ws + WS_YS); const int* ROWOF = (const int*)(F.ws + WS_ROWOF);
    const int gw = F.vcu * 8 + F.wave, NGW = F.G * 8;
    f32x4 gg[4], bb[4], g2[4], b2[4];
#pragma unroll
    for (int j = 0; j < 4; ++j) { gg[j] = *((const f32x4*)A.in[I_LNMIX_G] + F.lane + 64 * j); bb[j] = *((const f32x4*)A.in[I_LNMIX_B] + F.lane + 64 * j);
        g2[j] = *((const f32x4*)A.in[I_LNF_G] + F.lane + 64 * j); b2[j] = *((const f32x4*)A.in[I_LNF_B] + F.lane + 64 * j); }
    for (int m = gw; m < T; m += NGW) {
        float mean, rstd; ln_stats16(ZST + (size_t)m * 32, F.lane, mean, rstd);
        const f32x4* zr = (const f32x4*)(Z + (size_t)m * DM) + F.lane;
        f32x4 v[4];
#pragma unroll
        for (int j = 0; j < 4; ++j) v[j] = ((zr[64 * j] - mean) * rstd * gg[j] + bb[j]) * ALPHA;
#pragma unroll
        for (int k = 0; k < 4; ++k) {
            const int row = ROWOF[(size_t)m * 4 + k]; const u32x2* yr = (const u32x2*)(YS + (size_t)row * DM) + F.lane;
#pragma unroll
            for (int j = 0; j < 4; ++j) { const u32x2 y = yr[64 * j]; v[j].x += bflo(y.x); v[j].y += bfhi(y.x); v[j].z += bflo(y.y); v[j].w += bfhi(y.y); }
        }
        float s = 0.f;
#pragma unroll
        for (int j = 0; j < 4; ++j) s += (v[j].x + v[j].y) + (v[j].z + v[j].w);
        const float mu = wave_sum(s) * (1.f / DM); float s2 = 0.f;
#pragma unroll
        for (int j = 0; j < 4; ++j) { v[j] = v[j] - mu; s2 += (v[j].x * v[j].x + v[j].y * v[j].y) + (v[j].z * v[j].z + v[j].w * v[j].w); }
        const float rs = 1.f / sqrtf(wave_sum(s2) * (1.f / DM) + LN_EPS);
        f32x4* orow = (f32x4*)(A.out + (size_t)m * DM) + F.lane;
#pragma unroll
        for (int j = 0; j < 4; ++j) orow[64 * j] = v[j] * rs * g2[j] + b2[j];
    }
}

template <bool COOP>
__global__ void __launch_bounds__(512, 2) mega(Args args) {
    extern __shared__ __attribute__((aligned(16))) unsigned char lds_raw[];
    Ctx F;
    const int wave0 = __builtin_amdgcn_readfirstlane(threadIdx.x >> 6);
#define MKCTX() do { F.a = &args; F.ws = args.ws; F.lds = (LAS unsigned char*)lds_raw; F.ldsg = lds_raw; F.lane = lane_id_asm(); F.wave = wave0; F.tid = wave0 * 64 + F.lane; \
    F.G = gridDim.x; { const int bx = blockIdx.x; F.vcu = (F.G % 8 == 0) ? (bx % 8) * (F.G / 8) + bx / 8 : bx; } } while (0)
    MKCTX();
    const int lo = args.ph_lo, hi = args.ph_hi;
    unsigned char* ws = args.ws;
#ifndef PHMASK
#define PHMASK 0xFFFF
#endif
#define IN(k) (((PHMASK >> (k)) & 1) && lo <= (k) && (k) < hi)
#define SEAM(k) do { if (COOP && IN(k) && IN((k) + 1)) { cg::this_grid().sync(); } } while (0)
    if (IN(0)) { MKCTX(); ph_prologue(F); } SEAM(0);
    if (IN(1)) {
        pg8::Gemm g{(const bf16_t*)(ws + WS_H0), (const bf16_t*)(ws + WS_WIN), DM, DM, DM}; pg8::StaticOrder S; S.init(T, INCOLS, F.G, (int)blockIdx.x);
        pg8::Epi1 E{(bf16_t*)(ws + WS_YAB), (bf16_t*)(ws + WS_GV), (bf16_t*)(ws + WS_Q), (bf16_t*)(ws + WS_K), (bf16_t*)(ws + WS_V), (bf16_t*)(ws + WS_SA), (bf16_t*)(ws + WS_SB), (float*)(ws + WS_GVST)};
        pg8::gemm_phase<pg8::Epi1, pg8::StaticOrder, true>(F.lds, g, S, E, wave0);
    } SEAM(1);
    if (IN(2)) { MKCTX(); ph_kmean(F); ph_mixer_a(F); } SEAM(2);
    if (IN(3)) { MKCTX(); ph_gate(F); } SEAM(3);
    if (IN(4)) { MKCTX(); ph_attn_naive(F); } SEAM(4);
    if (IN(5)) {
        pg8::Gemm g{(const bf16_t*)(ws + WS_YAB), (const bf16_t*)(ws + WS_WAB), 2048, 2048, 2048}; pg8::StaticOrder S; S.init(T, DM, F.G, (int)blockIdx.x);
        pg8::Epi2 E{(const bf16_t*)(ws + WS_SA), (const bf16_t*)(ws + WS_SB), (bf16_t*)(ws + WS_MG)};
        pg8::gemm_phase<pg8::Epi2, pg8::StaticOrder, true>(F.lds, g, S, E, wave0);
    } SEAM(5);
    if (IN(6)) {
        pg8::Gemm g{(const bf16_t*)(ws + WS_MG), (const bf16_t*)(ws + WS_WOUT), DM, DM, DM}; pg8::StaticOrder S; S.init(T, DM, F.G, (int)blockIdx.x);
        pg8::Epi3 E{(const bf16_t*)(ws + WS_H0), (float*)(ws + WS_Z), (float*)(ws + WS_ZST)};
        pg8::gemm_phase<pg8::Epi3, pg8::StaticOrder, true>(F.lds, g, S, E, wave0);
    } SEAM(6);
    if (IN(7)) { MKCTX(); ph_router(F); } SEAM(7);
    if (IN(8)) { MKCTX(); ph_scatter(F); } SEAM(8);
    if (IN(9)) {
        pg8::Gemm g{(const bf16_t*)(ws + WS_XG), (const bf16_t*)(ws + WS_WUP), DM, DM, DM}; pg8::MoeOrder S; S.init((const int*)(ws + WS_TILE), 8, F.G, (int)blockIdx.x);
        pg8::Epi4 E{args.in[I_BUP], (bf16_t*)(ws + WS_ACT)};
        pg8::gemm_phase<pg8::Epi4, pg8::MoeOrder, true>(F.lds, g, S, E, wave0);
    } SEAM(9);
    if (IN(10)) {
        pg8::Gemm g{(const bf16_t*)(ws + WS_ACT), (const bf16_t*)(ws + WS_WDN), FF, FF, FF}; pg8::MoeOrder S; S.init((const int*)(ws + WS_TILE), 4, F.G, (int)blockIdx.x);
        pg8::Epi5 E{args.in[I_BDN], (const float*)(ws + WS_ROWW), (bf16_t*)(ws + WS_YS)};
        pg8::gemm_phase<pg8::Epi5, pg8::MoeOrder, true>(F.lds, g, S, E, wave0);
    } SEAM(10);
    if (IN(11)) { MKCTX(); ph_final(F); }
#undef IN
#undef SEAM
}

extern "C" void kernel_launch(void* const* d_in, const int* in_sizes, int n_in, void* d_out, int out_size, void* d_ws, size_t ws_size, hipStream_t stream) {
    static int grid = 0;
    if (grid == 0) {
        if (n_in != 21 || in_sizes[0] != T * DM || out_size != T * DM || ws_size < WS_END) { fprintf(stderr, "kernel_launch: unexpected shapes (n_in %d, in0 %d, out %d, ws %zu)\n", n_in, n_in > 0 ? in_sizes[0] : -1, out_size, ws_size); grid = -1; return; }
        int dev = 0, cus = 0, per_cu = 0;
        hipGetDevice(&dev); hipDeviceGetAttribute(&cus, hipDeviceAttributeMultiprocessorCount, dev);
        const void* fn = MK_COOP ? (const void*)mega<true> : (const void*)mega<false>;
        hipFuncSetAttribute(fn, hipFuncAttributeMaxDynamicSharedMemorySize, LDS_BYTES);
        hipOccupancyMaxActiveBlocksPerMultiprocessor(&per_cu, fn, 512, LDS_BYTES);
        (void)hipGetLastError();
        if (per_cu < 1) { fprintf(stderr, "kernel_launch: occupancy query says %d blocks/CU\n", per_cu); per_cu = 1; }
        grid = cus * 1;
    }
    if (grid < 0) return;
    hipMemsetAsync((char*)d_ws + WS_CTL, 0, CTL_ZERO_BYTES, stream);
    Args a{};
    for (int i = 0; i < 21; ++i) a.in[i] = (const float*)d_in[i];
    a.out = (float*)d_out; a.ws = (unsigned char*)d_ws;
#if MK_COOP
    a.ph_lo = 0; a.ph_hi = NPHASE;
    void* kargs[] = {&a};
    hipError_t e = hipLaunchCooperativeKernel((const void*)mega<true>, dim3(grid), dim3(512), kargs, LDS_BYTES, stream);
    if (e != hipSuccess) fprintf(stderr, "cooperative launch failed: %s (grid %d)\n", hipGetErrorString(e), grid);
#else
    for (int p = 0; p < NPHASE; ++p) { a.ph_lo = p; a.ph_hi = p + 1; hipLaunchKernelGGL(mega<false>, dim3(grid), dim3(512), LDS_BYTES, stream, a); }
#endif
}
```

```cpp
#include <hip/hip_runtime.h>
#include <hip/hip_cooperative_groups.h>
#include <cstdio>
#include <cstdint>
namespace cg = cooperative_groups;

#ifndef MK_COOP
#define MK_COOP 1
#endif

#define LAS __attribute__((address_space(3)))
typedef unsigned short bf16_t;
typedef short bf16x8 __attribute__((ext_vector_type(8)));
typedef float f32x4 __attribute__((ext_vector_type(4)));
typedef float f32x2 __attribute__((ext_vector_type(2)));
typedef unsigned u32x4 __attribute__((ext_vector_type(4)));
typedef unsigned u32x2 __attribute__((ext_vector_type(2)));

constexpr int NB = 8, SEQ = 4096, DM = 1024, T = NB * SEQ;
constexpr int NH = 8, DH = 128, LBLK = 256, NBLK = SEQ / LBLK;
constexpr int NE = 32, TOPK = 4, FF = 1024;
constexpr int INCOLS = 7 * DM;
constexpr int RMAX = T * TOPK + NE * 256;
constexpr float LN_EPS = 1e-5f;
constexpr float ALPHA = 1.189207115002721f;
constexpr float QSCALE = 0.08838834764831845f * 1.4426950408889634f;

constexpr size_t MiB = 1u << 20, U64 = 64 * MiB;
constexpr size_t WS_CTL = 0, CTL_ZERO_BYTES = 1 * MiB;
constexpr int CW_ECNT = 64;
constexpr int CW_LCNT = 1024;
constexpr int CW_BAR = 4096;
constexpr size_t WS_KMEAN = 1 * MiB;
constexpr size_t WS_GVST = 2 * MiB;
constexpr size_t WS_ZST = 6 * MiB;
constexpr size_t WS_SEL = 10 * MiB;
constexpr size_t WS_TKE = 11 * MiB;
constexpr size_t WS_TKW = 11 * MiB + 512 * 1024;
constexpr size_t WS_TKP = 12 * MiB;
constexpr size_t WS_ROWOF = 12 * MiB + 512 * 1024;
constexpr size_t WS_ROWTOK = 13 * MiB;
constexpr size_t WS_ROWW = 14 * MiB;
constexpr size_t WS_TILE = 15 * MiB;
constexpr size_t WS_LISTS = 16 * MiB;
constexpr size_t WS_LSE = 32 * MiB;
constexpr size_t WS_WIN = 40 * MiB;
constexpr size_t WS_WAB = 54 * MiB;
constexpr size_t WS_WOUT = 58 * MiB;
constexpr size_t WS_WDN = 60 * MiB;
constexpr size_t WS_WUP = 124 * MiB;
constexpr size_t WS_H0 = 4 * U64;
constexpr size_t WS_YAB = 5 * U64;
constexpr size_t WS_GV = 7 * U64;
constexpr size_t WS_Q = 8 * U64, WS_K = 9 * U64, WS_V = 10 * U64, WS_SA = 11 * U64, WS_SB = 12 * U64;
constexpr size_t WS_OP = 13 * U64;
constexpr size_t WS_MG = WS_GV;
constexpr size_t WS_Z = 14 * U64;
constexpr size_t WS_H1 = WS_H0;
constexpr size_t WS_XG = 5 * U64;
constexpr size_t WS_ACT = 9 * U64 + 16 * MiB;
constexpr size_t WS_YS = WS_XG;
constexpr size_t WS_END = 16 * U64;
static_assert(WS_XG + (size_t)RMAX * 2048 <= WS_ACT && WS_ACT + (size_t)RMAX * 2048 <= WS_Z, "ws map");

constexpr int LDS_BYTES = 147456;
constexpr int LDS_MISC = 131072;
constexpr int NPHASE = 13;

__device__ __forceinline__ float bf2f(bf16_t v) { return __uint_as_float((unsigned)v << 16); }
__device__ __forceinline__ float bflo(unsigned u) { return __uint_as_float(u << 16); }
__device__ __forceinline__ float bfhi(unsigned u) { return __uint_as_float(u & 0xffff0000u); }
__device__ __forceinline__ unsigned f2bf(float f) { unsigned u = __builtin_bit_cast(unsigned, f); return (u + 0x7fffu + ((u >> 16) & 1u)) >> 16; }
__device__ __forceinline__ unsigned pk2(float lo, float hi) { return f2bf(lo) | (f2bf(hi) << 16); }
typedef __bf16 bf16x2_t __attribute__((ext_vector_type(2)));
__device__ __forceinline__ unsigned cvt_pk_bf16(float lo, float hi) { f32x2 v = {lo, hi}; bf16x2_t b = __builtin_convertvector(v, bf16x2_t); return __builtin_bit_cast(unsigned, b); }
__device__ __forceinline__ int lane_id_asm() { int l; asm volatile("v_mbcnt_lo_u32_b32 %0, -1, 0\n\tv_mbcnt_hi_u32_b32 %0, -1, %0" : "=v"(l)); return l; }
__device__ __forceinline__ float wave_sum(float v) {
#pragma unroll
    for (int o = 1; o < 64; o <<= 1) v += __shfl_xor(v, o);
    return v;
}
__device__ __forceinline__ float wave_max(float v) {
#pragma unroll
    for (int o = 1; o < 64; o <<= 1) v = fmaxf(v, __shfl_xor(v, o));
    return v;
}
__device__ __forceinline__ f32x2 gelu_pk(f32x2 v) {
    const f32x2 av = __builtin_elementwise_abs(v), d = av * 0.2316418882f + 1.0f;
    f32x2 t; t.x = __builtin_amdgcn_rcpf(d.x); t.y = __builtin_amdgcn_rcpf(d.y);
    f32x2 q = t * 0.5307027145f + (-0.7265760135f); q = q * t + 0.7107068705f; q = q * t + (-0.142248368f); q = q * t + 0.127414796f; q = q * t;
    const f32x2 s = (v * v) * (-0.72134752044f);
    f32x2 e; e.x = __builtin_amdgcn_exp2f(s.x); e.y = __builtin_amdgcn_exp2f(s.y);
    const f32x2 m = v * (q * e), r = v - m;
    f32x2 o; o.x = v.x < 0.f ? m.x : r.x; o.y = v.y < 0.f ? m.y : r.y; return o;
}
__device__ __forceinline__ float sigmoidf_(float x) { return __builtin_amdgcn_rcpf(1.0f + __builtin_amdgcn_exp2f(-1.4426950408889634f * x)); }

namespace pg8 {
constexpr int BM = 256, BK = 64, HALF = 128, HTB = HALF * BK * 2, STAGE_BYTES = 8 * HTB, NXCD = 8, WGM = 8;
__host__ __device__ __forceinline__ int lds_byte(int r, int c) { const int st = (r >> 4) * 2 + (c >> 5), rr = r & 15, cc = c & 31, ob = rr * 64 + cc * 2; return st * 1024 + (ob ^ (((ob >> 9) & 1) << 5)); }
__host__ __device__ __forceinline__ void stage_rc(int b, int& R, int& C) { const int st = b / 1024, sb = b % 1024, swz = sb ^ (((sb >> 9) & 1) << 5); R = (st >> 1) * 16 + swz / 64; C = (st & 1) * 32 + (swz % 64) / 2; }
__host__ __device__ __forceinline__ int perm32(int rho) { const int n = rho >> 4, i = rho & 15; return 8 * (i >> 2) + 4 * n + (i & 3); }

struct Unit { int pm, pn, bt; };
struct Gemm { const bf16_t* A; const bf16_t* Bt; int K, lda, ldb; };

struct StaticOrder {
    int nM, nN, nwg, G, c;
    __device__ void init(int M, int N, int G_, int c_) { nM = M / BM; nN = N / BM; nwg = nM * nN; G = G_; c = c_; }
    __device__ bool next(int i, Unit& u) const {
        const long L = (long)i * G + c; if (L >= nwg) return false;
        int wgid = (int)L; { const int q = nwg / NXCD, r = nwg % NXCD, xcd = wgid % NXCD, off = wgid / NXCD; wgid = (xcd < r ? xcd * (q + 1) : r * (q + 1) + (xcd - r) * q) + off; }
        const int nig = WGM * nN, gid = wgid / nig, fm = gid * WGM, gsz = (nM - fm) < WGM ? (nM - fm) : WGM;
        u.pm = fm + ((wgid % nig) % gsz); u.pn = (wgid % nig) / gsz; u.bt = u.pn; return true;
    }
};
struct MoeOrder {
    int nM, nN, nwg, G, c; const int* tile_e;
    __device__ void init(const int* tiletab, int nN_, int G_, int c_) { nM = tiletab[0]; tile_e = tiletab + 16; nN = nN_; nwg = nM * nN; G = G_; c = c_; }
    __device__ bool next(int i, Unit& u) const {
        const long L = (long)i * G + c; if (L >= nwg) return false;
        int wgid = (int)L; { const int q = nwg / NXCD, r = nwg % NXCD, xcd = wgid % NXCD, off = wgid / NXCD; wgid = (xcd < r ? xcd * (q + 1) : r * (q + 1) + (xcd - r) * q) + off; }
        const int nig = WGM * nN, gid = wgid / nig, fm = gid * WGM, gsz = (nM - fm) < WGM ? (nM - fm) : WGM;
        u.pm = fm + ((wgid % nig) % gsz); u.pn = (wgid % nig) / gsz; u.bt = tile_e[u.pm] * nN + u.pn; return true;
    }
};

template <class Epi, class Sched, bool ALIGN_EPI>
__device__ __forceinline__ void gemm_phase(LAS unsigned char* lds, const Gemm g, const Sched& S, const Epi& E, const int wid) {
    const int lane = lane_id_asm(), tid = wid * 64 + lane;
    const int wr = wid >> 2, wc = wid & 3, fr = lane & 15, fq = lane >> 4;
    const int nt = g.K / BK;
    unsigned voffA[2], voffB[2];
#pragma unroll
    for (int i = 0; i < 2; ++i) { int R, C; stage_rc(tid * 16 + i * 8192, R, C); const int Rb = Epi::PERM ? ((R & ~31) + perm32(R & 31)) : R;
        voffA[i] = (unsigned)(R * g.lda + C) * 2u; voffB[i] = (unsigned)(Rb * g.ldb + C) * 2u; }
    const size_t kstep = (size_t)(BK * 2);
    const size_t hstepA = (size_t)HALF * g.lda * 2, hstepB = (size_t)HALF * g.ldb * 2;
    const size_t tstepA = 2 * hstepA, tstepB = 2 * hstepB;
    const unsigned ldsw = (unsigned)wid * 1024u;
    const int aoff = lds_byte(wr * 64 + fr, fq * 8), boff = lds_byte(wc * 32 + fr, fq * 8);
#define PG8_SA(b, h) (((b) * 2 + (h)) * HTB)
#define PG8_SB(b, h) ((4 + (b) * 2 + (h)) * HTB)
#define PG8_STAGE(bufoff, gbase, voff) do { _Pragma("unroll") for (int _i = 0; _i < 2; ++_i) \
        __builtin_amdgcn_global_load_lds((const unsigned*)((const char*)(gbase) + (voff)[_i]), (LAS unsigned*)(lds + (bufoff) + ldsw + _i * 8192), 16, 0, 0); } while (0)
#define PG8_LDA(dst, b, h) do { _Pragma("unroll") for (int m = 0; m < 4; ++m) _Pragma("unroll") for (int k = 0; k < 2; ++k) dst[m][k] = *(const LAS bf16x8*)(lds + PG8_SA(b, h) + aoff + m * 2048 + k * 1024); } while (0)
#define PG8_LDB(dst, b, h) do { _Pragma("unroll") for (int n = 0; n < 2; ++n) _Pragma("unroll") for (int k = 0; k < 2; ++k) dst[n][k] = *(const LAS bf16x8*)(lds + PG8_SB(b, h) + boff + n * 2048 + k * 1024); } while (0)
#define PG8_MMA(ai, bj, At, Bt) do { __builtin_amdgcn_s_setprio(1); _Pragma("unroll") for (int m = 0; m < 4; ++m) _Pragma("unroll") for (int n = 0; n < 2; ++n) _Pragma("unroll") for (int k = 0; k < 2; ++k) \
        acc[ai][bj][m][n] = __builtin_amdgcn_mfma_f32_16x16x32_bf16(Bt[n][k], At[m][k], acc[ai][bj][m][n], 0, 0, 0); __builtin_amdgcn_s_setprio(0); } while (0)
#define PG8_WAIT_V(n) asm volatile("s_waitcnt vmcnt(" #n ")" ::: "memory")
#define PG8_WAIT_L(n) asm volatile("s_waitcnt lgkmcnt(" #n ")" ::: "memory")
#define PG8_BAR __builtin_amdgcn_s_barrier()
#define PG8_SCHED __builtin_amdgcn_sched_barrier(0)
    Unit cur, nxt; int ui = 0;
    if (!S.next(0, cur)) return;
    f32x4 acc[2][2][4][2];
#pragma unroll
    for (int a = 0; a < 2; ++a)
#pragma unroll
        for (int b = 0; b < 2; ++b)
#pragma unroll
            for (int m = 0; m < 4; ++m)
#pragma unroll
                for (int n = 0; n < 2; ++n) acc[a][b][m][n] = (f32x4){0.f, 0.f, 0.f, 0.f};
    bf16x8 At[4][2], B0[2][2], B1[2][2];
    const char* cA = (const char*)g.A + (size_t)cur.pm * tstepA; const char* cB = (const char*)g.Bt + (size_t)cur.bt * tstepB;
    PG8_STAGE(PG8_SB(0, 0), cB, voffB); PG8_STAGE(PG8_SB(0, 1), cB + hstepB, voffB); PG8_STAGE(PG8_SA(0, 0), cA, voffA); PG8_STAGE(PG8_SA(0, 1), cA + hstepA, voffA);
    if (wr == 1) PG8_BAR;
    PG8_WAIT_V(2); PG8_BAR;
    PG8_STAGE(PG8_SB(1, 0), cB + kstep, voffB); PG8_STAGE(PG8_SA(1, 0), cA + kstep, voffA); PG8_STAGE(PG8_SB(1, 1), cB + hstepB + kstep, voffB);
    PG8_WAIT_V(6); PG8_BAR;
    for (;;) {
        const bool has_next = S.next(ui + 1, nxt);
        const char* nA = has_next ? (const char*)g.A + (size_t)nxt.pm * tstepA : cA; const char* nB = has_next ? (const char*)g.Bt + (size_t)nxt.bt * tstepB : cB;
        for (int t = 0; t < nt; t += 2) {
            const bool last = (t == nt - 2);
            const char* a1 = cA + (size_t)(t + 1) * kstep;
            const char* a2 = last ? nA : cA + (size_t)(t + 2) * kstep; const char* b2 = last ? nB : cB + (size_t)(t + 2) * kstep;
            const char* a3 = a2 + kstep; const char* b3 = b2 + kstep;
            if constexpr (Epi::MID_T > 0) { if (t == Epi::MID_T) E.mid(acc, cur, wr, wc, fr, fq); }
            PG8_LDB(B0, 0, 0); PG8_LDB(B1, 0, 1); PG8_SCHED; PG8_LDA(At, 0, 0); PG8_STAGE(PG8_SA(1, 1), a1 + hstepA, voffA);
            PG8_WAIT_V(8); PG8_WAIT_L(0); PG8_BAR; PG8_MMA(0, 0, At, B0); PG8_MMA(0, 1, At, B1); PG8_BAR; PG8_SCHED;
            PG8_LDA(At, 0, 1); PG8_STAGE(PG8_SB(0, 0), b2, voffB); PG8_STAGE(PG8_SB(0, 1), b2 + hstepB, voffB); PG8_STAGE(PG8_SA(0, 0), a2, voffA);
            PG8_WAIT_V(8); PG8_WAIT_L(0); PG8_BAR; PG8_MMA(1, 0, At, B0); PG8_MMA(1, 1, At, B1); PG8_BAR; PG8_SCHED;
            PG8_LDB(B0, 1, 0); PG8_LDB(B1, 1, 1); PG8_SCHED; PG8_LDA(At, 1, 0); PG8_STAGE(PG8_SA(0, 1), a2 + hstepA, voffA);
            PG8_WAIT_V(8); PG8_WAIT_L(0); PG8_BAR; PG8_MMA(0, 0, At, B0); PG8_MMA(0, 1, At, B1); PG8_BAR; PG8_SCHED;
            PG8_LDA(At, 1, 1); PG8_STAGE(PG8_SB(1, 0), b3, voffB); PG8_STAGE(PG8_SB(1, 1), b3 + hstepB, voffB); PG8_STAGE(PG8_SA(1, 0), a3, voffA);
            PG8_WAIT_V(8); PG8_WAIT_L(0); PG8_BAR; PG8_MMA(1, 0, At, B0); PG8_MMA(1, 1, At, B1); PG8_BAR; PG8_SCHED;
        }
        if constexpr (ALIGN_EPI) { if (wr == 0) PG8_BAR; }
        E(acc, cur, wr, wc, fr, fq);
        if (!has_next) break;
#pragma unroll
        for (int a = 0; a < 2; ++a)
#pragma unroll
            for (int b = 0; b < 2; ++b)
#pragma unroll
                for (int m = 0; m < 4; ++m)
#pragma unroll
                    for (int n = 0; n < 2; ++n) acc[a][b][m][n] = (f32x4){0.f, 0.f, 0.f, 0.f};
        cur = nxt; cA = nA; cB = nB; ++ui;
        if constexpr (ALIGN_EPI) { if (wr == 1) PG8_BAR; }
    }
    PG8_WAIT_V(0);
    if constexpr (!ALIGN_EPI) { if (wr == 0) PG8_BAR; }
    PG8_BAR;
#undef PG8_SA
#undef PG8_SB
#undef PG8_STAGE
#undef PG8_LDA
#undef PG8_LDB
#undef PG8_MMA
#undef PG8_WAIT_V
#undef PG8_WAIT_L
#undef PG8_BAR
#undef PG8_SCHED
}

typedef f32x4 Acc[2][2][4][2];

struct Epi1 {
    static constexpr bool PERM = true; static constexpr int MID_T = 0;
    bf16_t *yab, *gv, *q, *k, *v, *sa, *sb; float* gvst;
    template <int MODE  >
    __device__ __forceinline__ void run(const Acc& acc, const Unit& u, int wr, int wc, int fr, int fq, bf16_t* base, int ld) const {
        const int row0 = u.pm * BM + wr * 64 + fr, col0 = (u.pn & 3) * 256 + wc * 32 + 8 * fq;
#pragma unroll
        for (int ai = 0; ai < 2; ++ai)
#pragma unroll
            for (int m = 0; m < 4; ++m) {
                const int row = row0 + ai * HALF + m * 16; bf16_t* rowp = base + (size_t)row * ld + col0;
                float s1 = 0.f, s2 = 0.f;
#pragma unroll
                for (int bj = 0; bj < 2; ++bj) {
                    f32x4 v0 = acc[ai][bj][m][0], v1 = acc[ai][bj][m][1];
                    if (MODE == 0 || MODE == 1) {
                        f32x2 a = gelu_pk((f32x2){v0[0], v0[1]}), b = gelu_pk((f32x2){v0[2], v0[3]}), c = gelu_pk((f32x2){v1[0], v1[1]}), d = gelu_pk((f32x2){v1[2], v1[3]});
                        v0 = (f32x4){a.x, a.y, b.x, b.y}; v1 = (f32x4){c.x, c.y, d.x, d.y};
                    } else if (MODE == 2) { v0 = v0 * QSCALE; v1 = v1 * QSCALE; }
                    else if (MODE == 4) {
#pragma unroll
                        for (int j = 0; j < 4; ++j) { v0[j] = sigmoidf_(v0[j]); v1[j] = sigmoidf_(v1[j]); }
                    }
                    if (MODE == 1) {
                        s1 += (v0[0] + v0[1]) + (v0[2] + v0[3]) + (v1[0] + v1[1]) + (v1[2] + v1[3]);
                        s2 += (v0[0] * v0[0] + v0[1] * v0[1]) + (v0[2] * v0[2] + v0[3] * v0[3]) + (v1[0] * v1[0] + v1[1] * v1[1]) + (v1[2] * v1[2] + v1[3] * v1[3]);
                    }
                    u32x4 w; w.x = cvt_pk_bf16(v0[0], v0[1]); w.y = cvt_pk_bf16(v0[2], v0[3]); w.z = cvt_pk_bf16(v1[0], v1[1]); w.w = cvt_pk_bf16(v1[2], v1[3]);
                    *(u32x4*)(rowp + bj * HALF) = w;
                }
                if (MODE == 1) {
                    s1 += __shfl_xor(s1, 16); s1 += __shfl_xor(s1, 32); s2 += __shfl_xor(s2, 16); s2 += __shfl_xor(s2, 32);
                    if (fq == 0) *(f32x2*)(gvst + ((size_t)row * 16 + (u.pn & 3) * 4 + wc) * 2) = (f32x2){s1, s2};
                }
            }
    }
    __device__ __forceinline__ void operator()(const Acc& acc, const Unit& u, int wr, int wc, int fr, int fq) const {
        const int region = u.pn >> 2;
        if (region == 0) run<0>(acc, u, wr, wc, fr, fq, yab, 2048);
        else if (region == 1) run<1>(acc, u, wr, wc, fr, fq, gv, 1024);
        else if (region == 2) run<2>(acc, u, wr, wc, fr, fq, q, 1024);
        else if (region == 3) run<3>(acc, u, wr, wc, fr, fq, k, 1024);
        else if (region == 4) run<3>(acc, u, wr, wc, fr, fq, v, 1024);
        else if (region == 5) run<4>(acc, u, wr, wc, fr, fq, sa, 1024);
        else run<4>(acc, u, wr, wc, fr, fq, sb, 1024);
    }
    __device__ __forceinline__ void mid(Acc&, const Unit&, int, int, int, int) const {}
};

struct Epi2 {
    static constexpr bool PERM = true; static constexpr int MID_T = 16;
    const bf16_t *sa, *sb; bf16_t* mg;
    __device__ __forceinline__ void mid(Acc& acc, const Unit& u, int wr, int wc, int fr, int fq) const {
        int row0 = u.pm * BM + wr * 64 + fr, col0 = u.pn * BM + wc * 32 + 8 * fq;
        asm volatile("" : "+v"(row0), "+v"(col0));
#pragma unroll
        for (int ai = 0; ai < 2; ++ai)
#pragma unroll
            for (int m = 0; m < 4; ++m) {
                const size_t off = (size_t)(row0 + ai * HALF + m * 16) * DM + col0;
#pragma unroll
                for (int bj = 0; bj < 2; ++bj) {
                    const u32x4 a = *(const u32x4*)(sa + off + bj * HALF), b = *(const u32x4*)(sb + off + bj * HALF);
                    f32x4 r0, r1;
#define RQ(x, y) ((x) * __builtin_amdgcn_rcpf(y))
                    r0[0] = RQ(bflo(a.x), bflo(b.x)); r0[1] = RQ(bfhi(a.x), bfhi(b.x)); r0[2] = RQ(bflo(a.y), bflo(b.y)); r0[3] = RQ(bfhi(a.y), bfhi(b.y));
                    r1[0] = RQ(bflo(a.z), bflo(b.z)); r1[1] = RQ(bfhi(a.z), bfhi(b.z)); r1[2] = RQ(bflo(a.w), bflo(b.w)); r1[3] = RQ(bfhi(a.w), bfhi(b.w));
#undef RQ
                    acc[ai][bj][m][0] = acc[ai][bj][m][0] * r0; acc[ai][bj][m][1] = acc[ai][bj][m][1] * r1;
                }
                asm volatile("" : "+v"(acc[ai][0][m][0]), "+v"(acc[ai][0][m][1]), "+v"(acc[ai][1][m][0]), "+v"(acc[ai][1][m][1]));
                asm volatile("" ::: "memory");
            }
    }
    __device__ __forceinline__ void operator()(const Acc& acc, const Unit& u, int wr, int wc, int fr, int fq) const {
        const int row0 = u.pm * BM + wr * 64 + fr, col0 = u.pn * BM + wc * 32 + 8 * fq;
#pragma unroll
        for (int ai = 0; ai < 2; ++ai)
#pragma unroll
            for (int m = 0; m < 4; ++m) {
                const size_t off = (size_t)(row0 + ai * HALF + m * 16) * DM + col0;
#pragma unroll
                for (int bj = 0; bj < 2; ++bj) {
                    const u32x4 b = *(const u32x4*)(sb + off + bj * HALF);
                    const f32x4 v0 = acc[ai][bj][m][0], v1 = acc[ai][bj][m][1];
                    u32x4 w; w.x = cvt_pk_bf16(v0[0] * bflo(b.x), v0[1] * bfhi(b.x)); w.y = cvt_pk_bf16(v0[2] * bflo(b.y), v0[3] * bfhi(b.y));
                    w.z = cvt_pk_bf16(v1[0] * bflo(b.z), v1[1] * bfhi(b.z)); w.w = cvt_pk_bf16(v1[2] * bflo(b.w), v1[3] * bfhi(b.w));
                    *(u32x4*)(mg + off + bj * HALF) = w;
                }
            }
    }
};

struct Epi3 {
    static constexpr bool PERM = false; static constexpr int MID_T = 0;
    const bf16_t* h0; float* z; float* zst;
    __device__ __forceinline__ void mid(Acc&, const Unit&, int, int, int, int) const {}
    __device__ __forceinline__ void operator()(const Acc& acc, const Unit& u, int wr, int wc, int fr, int fq) const {
        const int row0 = u.pm * BM + wr * 64 + fr, col0 = u.pn * BM + wc * 32 + 4 * fq;
#pragma unroll
        for (int ai = 0; ai < 2; ++ai)
#pragma unroll
            for (int m = 0; m < 4; ++m) {
                const int row = row0 + ai * HALF + m * 16; const size_t off = (size_t)row * DM + col0;
                float s1 = 0.f, s2 = 0.f;
#pragma unroll
                for (int bj = 0; bj < 2; ++bj)
#pragma unroll
                    for (int n = 0; n < 2; ++n) {
                        const u32x2 hb = *(const u32x2*)(h0 + off + bj * HALF + n * 16);
                        f32x4 v = acc[ai][bj][m][n];
                        v[0] += ALPHA * bflo(hb.x); v[1] += ALPHA * bfhi(hb.x); v[2] += ALPHA * bflo(hb.y); v[3] += ALPHA * bfhi(hb.y);
                        s1 += (v[0] + v[1]) + (v[2] + v[3]); s2 += (v[0] * v[0] + v[1] * v[1]) + (v[2] * v[2] + v[3] * v[3]);
                        *(f32x4*)(z + off + bj * HALF + n * 16) = v;
                    }
                s1 += __shfl_xor(s1, 16); s1 += __shfl_xor(s1, 32); s2 += __shfl_xor(s2, 16); s2 += __shfl_xor(s2, 32);
                if (fq == 0) *(f32x2*)(zst + ((size_t)row * 16 + u.pn * 4 + wc) * 2) = (f32x2){s1, s2};
            }
    }
};

struct Epi4 {
    static constexpr bool PERM = true; static constexpr int MID_T = 0;
    const float* b_up; bf16_t* act;
    __device__ __forceinline__ void mid(Acc&, const Unit&, int, int, int, int) const {}
    __device__ __forceinline__ void operator()(const Acc& acc, const Unit& u, int wr, int wc, int fr, int fq) const {
        const int e = u.bt >> 3;
        const int row0 = u.pm * BM + wr * 64 + fr, c0 = u.pn * HALF + wc * 32 + 8 * fq;
        const float* bg = b_up + (size_t)e * 2 * FF + c0; const float* bu = bg + FF;
        const f32x4 bg0 = *(const f32x4*)bg, bg1 = *(const f32x4*)(bg + 4), bu0 = *(const f32x4*)bu, bu1 = *(const f32x4*)(bu + 4);
#pragma unroll
        for (int ai = 0; ai < 2; ++ai)
#pragma unroll
            for (int m = 0; m < 4; ++m) {
                const int row = row0 + ai * HALF + m * 16;
                float o[8];
#pragma unroll
                for (int n = 0; n < 2; ++n)
#pragma unroll
                    for (int j = 0; j < 4; ++j) {
                        float gg = acc[ai][0][m][n][j] + (n ? bg1[j] : bg0[j]), uu = acc[ai][1][m][n][j] + (n ? bu1[j] : bu0[j]);
                        gg = fminf(gg, 7.0f); uu = fminf(fmaxf(uu, -7.0f), 7.0f);
                        o[n * 4 + j] = (uu + 1.0f) * (gg * sigmoidf_(1.702f * gg));
                    }
                u32x4 w; w.x = cvt_pk_bf16(o[0], o[1]); w.y = cvt_pk_bf16(o[2], o[3]); w.z = cvt_pk_bf16(o[4], o[5]); w.w = cvt_pk_bf16(o[6], o[7]);
                *(u32x4*)(act + (size_t)row * FF + c0) = w;
            }
    }
};

struct Epi5 {
    static constexpr bool PERM = true; static constexpr int MID_T = 0;
    const float* b_down; const float* roww; bf16_t* ys;
    __device__ __forceinline__ void mid(Acc&, const Unit&, int, int, int, int) const {}
    __device__ __forceinline__ void operator()(const Acc& acc, const Unit& u, int wr, int wc, int fr, int fq) const {
        const int e = u.bt >> 2;
        const int row0 = u.pm * BM + wr * 64 + fr, col0 = u.pn * BM + wc * 32 + 8 * fq;
        f32x4 bv[2][2];
#pragma unroll
        for (int bj = 0; bj < 2; ++bj)
#pragma unroll
            for (int n = 0; n < 2; ++n) bv[bj][n] = *(const f32x4*)(b_down + (size_t)e * DM + col0 + bj * HALF + 4 * n);
#pragma unroll
        for (int ai = 0; ai < 2; ++ai)
#pragma unroll
            for (int m = 0; m < 4; ++m) {
                const int row = row0 + ai * HALF + m * 16; const float rw = roww[row];
#pragma unroll
                for (int bj = 0; bj < 2; ++bj) {
                    const f32x4 v0 = (acc[ai][bj][m][0] + bv[bj][0]) * rw, v1 = (acc[ai][bj][m][1] + bv[bj][1]) * rw;
                    u32x4 w; w.x = cvt_pk_bf16(v0[0], v0[1]); w.y = cvt_pk_bf16(v0[2], v0[3]); w.z = cvt_pk_bf16(v1[0], v1[1]); w.w = cvt_pk_bf16(v1[2], v1[3]);
                    *(u32x4*)(ys + (size_t)row * DM + col0 + bj * HALF) = w;
                }
            }
    }
};
}

struct Args { const float* in[21]; float* out; unsigned char* ws; int ph_lo, ph_hi; };
enum { I_X = 0, I_LNIN_G, I_LNIN_B, I_WIN, I_GLN_G, I_GLN_B, I_WSP, I_BSP, I_WBA, I_WBB, I_WOUT, I_LNMIX_G, I_LNMIX_B, I_WR, I_BR, I_WUP, I_BUP, I_WDN, I_BDN, I_LNF_G, I_LNF_B };

struct Ctx { const Args* a; unsigned char* ws; LAS unsigned char* lds; unsigned char* ldsg; int tid, lane, wave, G, vcu; };

__device__ __forceinline__ void tr_item(const float* W, int N, int k0, int n0, bf16_t* dst, int drow0, int dld, int dcol0, LAS float* scr, int lane) {
#pragma unroll 8
    for (int i = 0; i < 32; ++i) { const int kk = 2 * i + (lane >> 5); scr[kk * 33 + (lane & 31)] = W[(size_t)(k0 + kk) * N + n0 + (lane & 31)]; }
    asm volatile("s_waitcnt lgkmcnt(0)" ::: "memory");
    const int c = lane & 7;
#pragma unroll
    for (int j = 0; j < 4; ++j) { const int n = (lane >> 3) + 8 * j; const LAS float* s = scr + (8 * c) * 33 + n;
        u32x4 o; o.x = pk2(s[0 * 33], s[1 * 33]); o.y = pk2(s[2 * 33], s[3 * 33]); o.z = pk2(s[4 * 33], s[5 * 33]); o.w = pk2(s[6 * 33], s[7 * 33]);
        *(u32x4*)(dst + (size_t)(drow0 + n) * dld + dcol0 + k0 + 8 * c) = o; }
    asm volatile("s_waitcnt lgkmcnt(0)" ::: "memory");
}
__device__ __forceinline__ void ph_prologue(const Ctx& F) {
    const Args& A = *F.a;
    LAS float* scr = (LAS float*)(F.lds + F.wave * 16384);
    const int gw = F.vcu * 8 + F.wave, NGW = F.G * 8;
    bf16_t* WIN = (bf16_t*)(F.ws + WS_WIN); bf16_t* WAB = (bf16_t*)(F.ws + WS_WAB); bf16_t* WOUT = (bf16_t*)(F.ws + WS_WOUT);
    bf16_t* WDN = (bf16_t*)(F.ws + WS_WDN); bf16_t* WUP = (bf16_t*)(F.ws + WS_WUP);
    constexpr int I_IN = 16 * (INCOLS / 32), I_SQ = 16 * 32, I_UP = NE * 16 * 64, I_DN = NE * 16 * 32;
    constexpr int NITEMS = I_IN + 3 * I_SQ + I_UP + I_DN;
    for (int it = gw; it < NITEMS; it += NGW) {
        int r = it;
        if (r < I_IN) { const int nblk = INCOLS / 32, kb = r / nblk, nb = r % nblk; tr_item(A.in[I_WIN], INCOLS, 64 * kb, 32 * nb, WIN, 32 * nb, DM, 0, scr, F.lane); continue; } r -= I_IN;
        if (r < I_SQ) { const int kb = r / 32, nb = r % 32; tr_item(A.in[I_WBA], DM, 64 * kb, 32 * nb, WAB, 32 * nb, 2048, 0, scr, F.lane); continue; } r -= I_SQ;
        if (r < I_SQ) { const int kb = r / 32, nb = r % 32; tr_item(A.in[I_WBB], DM, 64 * kb, 32 * nb, WAB, 32 * nb, 2048, 1024, scr, F.lane); continue; } r -= I_SQ;
        if (r < I_SQ) { const int kb = r / 32, nb = r % 32; tr_item(A.in[I_WOUT], DM, 64 * kb, 32 * nb, WOUT, 32 * nb, DM, 0, scr, F.lane); continue; } r -= I_SQ;
        if (r < I_UP) { const int e = r / (16 * 64), rr = r % (16 * 64), kb = rr / 64, nb = rr % 64; const int n0 = 32 * nb, half = n0 >= FF, rem = n0 - half * FF, pn = rem >> 7, b = (rem & 127) >> 5;
            tr_item(A.in[I_WUP] + (size_t)e * DM * 2 * FF, 2 * FF, 64 * kb, n0, WUP, e * 2048 + 256 * pn + half * 128 + 32 * b, DM, 0, scr, F.lane); continue; } r -= I_UP;
        { const int e = r / (16 * 32), rr = r % (16 * 32), kb = rr / 32, nb = rr % 32; tr_item(A.in[I_WDN] + (size_t)e * FF * DM, DM, 64 * kb, 32 * nb, WDN, e * 1024 + 32 * nb, FF, 0, scr, F.lane); }
    }
    const float* lg = A.in[I_LNIN_G]; const float* lb = A.in[I_LNIN_B]; bf16_t* H0 = (bf16_t*)(F.ws + WS_H0);
    f32x4 gg[4], bb[4];
#pragma unroll
    for (int j = 0; j < 4; ++j) { gg[j] = *((const f32x4*)lg + F.lane + 64 * j); bb[j] = *((const f32x4*)lb + F.lane + 64 * j); }
    for (int m = gw; m < T; m += NGW) {
        const f32x4* xr = (const f32x4*)(A.in[I_X] + (size_t)m * DM) + F.lane;
        f32x4 v[4]; float s = 0.f;
#pragma unroll
        for (int j = 0; j < 4; ++j) { v[j] = xr[64 * j]; s += (v[j].x + v[j].y) + (v[j].z + v[j].w); }
        const float mean = wave_sum(s) * (1.f / DM); float s2 = 0.f;
#pragma unroll
        for (int j = 0; j < 4; ++j) { v[j] = v[j] - mean; s2 += (v[j].x * v[j].x + v[j].y * v[j].y) + (v[j].z * v[j].z + v[j].w * v[j].w); }
        const float rstd = 1.f / sqrtf(wave_sum(s2) * (1.f / DM) + LN_EPS);
        u32x2* o8 = (u32x2*)(H0 + (size_t)m * DM) + F.lane;
#pragma unroll
        for (int j = 0; j < 4; ++j) { const f32x4 y = v[j] * rstd * gg[j] + bb[j]; o8[64 * j] = (u32x2){pk2(y.x, y.y), pk2(y.z, y.w)}; }
    }
}

__device__ __forceinline__ void ph_kmean(const Ctx& F) {
    const bf16_t* K = (const bf16_t*)(F.ws + WS_K); float* KM = (float*)(F.ws + WS_KMEAN);
    float* red = (float*)F.ldsg;
    const int d = F.tid & 127, part = F.tid >> 7;
    for (int it = F.vcu; it < NB * NH * NBLK; it += F.G) {
        const int b = it / (NH * NBLK), h = (it / NBLK) % NH, j = it % NBLK;
        const bf16_t* kp = K + ((size_t)(b * SEQ + j * LBLK + part * 64)) * DM + h * DH + d;
        float s = 0.f;
        for (int r = 0; r < 64; ++r) s += bf2f(kp[(size_t)r * DM]);
        red[part * 128 + d] = s;
        __syncthreads();
        if (F.tid < 128) KM[(size_t)it * DH + d] = (red[d] + red[128 + d] + red[256 + d] + red[384 + d]) * (1.0f / LBLK);
        __syncthreads();
    }
}
typedef short v4i16_t __attribute__((ext_vector_type(4)));
__device__ __forceinline__ v4i16_t lds_tr16(LAS const unsigned char* p) { return __builtin_amdgcn_ds_read_tr16_b64_v4i16((LAS v4i16_t*)p); }
__device__ __forceinline__ void ph_mixer_a(const Ctx& F) {
    const Args& A = *F.a;
    const bf16_t* GV = (const bf16_t*)(F.ws + WS_GV); bf16_t* YAB = (bf16_t*)(F.ws + WS_YAB); const float* GVST = (const float*)(F.ws + WS_GVST);
    const float* lg = A.in[I_GLN_G]; const float* lb = A.in[I_GLN_B]; const float* wsp = A.in[I_WSP]; const float* bsp = A.in[I_BSP];
    constexpr int RSV = 544, RSW = 272, OFF_W = 128 * RSV, OFF_ST = OFF_W + 128 * RSW;
    LAS unsigned char* VT = F.lds; LAS unsigned char* WT = F.lds + OFF_W; LAS float* ST = (LAS float*)(F.lds + OFF_ST);
    const int lane = F.lane, wv = F.wave;
    int curg = -1;
    for (int it = F.vcu; it < NB * 32 * 4; it += F.G) {
        const int b = it / 128, c = (it >> 2) & 31, g = it & 3;
        const int tok0 = b * SEQ + c * 128;
        if (g != curg) {
            curg = g;
            for (int k = 0; k < 4; ++k) {
                const int idx = F.tid + 512 * k, t = idx >> 4, s8 = (idx & 15) * 8;
                const f32x4 w0 = *(const f32x4*)(wsp + ((size_t)g * 128 + t) * 128 + s8), w1 = *(const f32x4*)(wsp + ((size_t)g * 128 + t) * 128 + s8 + 4);
                float x[8] = {w0.x, w0.y, w0.z, w0.w, w1.x, w1.y, w1.z, w1.w};
#pragma unroll
                for (int j = 0; j < 8; ++j) x[j] = (s8 + j <= t) ? x[j] : 0.f;
                u32x4 o; o.x = pk2(x[0], x[1]); o.y = pk2(x[2], x[3]); o.z = pk2(x[4], x[5]); o.w = pk2(x[6], x[7]);
                *(LAS u32x4*)(WT + t * RSW + s8 * 2) = o;
            }
        }
        if (F.tid < 128) {
            const float* p = GVST + (size_t)(tok0 + F.tid) * 32; float s1 = 0.f, s2 = 0.f;
            for (int i = 0; i < 16; ++i) { s1 += p[2 * i]; s2 += p[2 * i + 1]; }
            const float mean = s1 * (1.f / DM), var = s2 * (1.f / DM) - mean * mean;
            ST[2 * F.tid] = mean; ST[2 * F.tid + 1] = 1.f / sqrtf(fmaxf(var, 0.f) + LN_EPS);
        }
        __syncthreads();
        {
            const int dc = F.tid & 31;
            const f32x4 g0 = *(const f32x4*)(lg + g * 256 + dc * 8), g1 = *(const f32x4*)(lg + g * 256 + dc * 8 + 4), b0 = *(const f32x4*)(lb + g * 256 + dc * 8), b1 = *(const f32x4*)(lb + g * 256 + dc * 8 + 4);
#pragma unroll
            for (int k = 0; k < 8; ++k) {
                const int s = (F.tid >> 5) + 16 * k;
                const u32x4 raw = *(const u32x4*)(GV + (size_t)(tok0 + s) * DM + g * 256 + dc * 8);
                const float mean = ST[2 * s], rstd = ST[2 * s + 1];
                f32x4 x0 = {bflo(raw.x), bfhi(raw.x), bflo(raw.y), bfhi(raw.y)}, x1 = {bflo(raw.z), bfhi(raw.z), bflo(raw.w), bfhi(raw.w)};
                x0 = (x0 - mean) * rstd * g0 + b0; x1 = (x1 - mean) * rstd * g1 + b1;
                u32x4 o; o.x = pk2(x0.x, x0.y); o.y = pk2(x0.z, x0.w); o.z = pk2(x1.x, x1.y); o.w = pk2(x1.z, x1.w);
                *(LAS u32x4*)(VT + s * RSV + dc * 16) = o;
            }
        }
        __syncthreads();
        {
            const int dbase = 32 * wv, kg = lane >> 4, q = (lane & 15) >> 2, p = lane & 3, fr = lane & 15;
            bf16x8 Af[2][4];
#pragma unroll
            for (int m = 0; m < 2; ++m)
#pragma unroll
                for (int kk = 0; kk < 4; ++kk) {
                    LAS const unsigned char* ap = VT + (32 * kk + 8 * kg + q) * RSV + (dbase + 16 * m + 4 * p) * 2;
                    const v4i16_t lo = lds_tr16(ap), hi = lds_tr16(ap + 4 * RSV);
                    Af[m][kk] = (bf16x8){lo[0], lo[1], lo[2], lo[3], hi[0], hi[1], hi[2], hi[3]};
                }
#pragma unroll
            for (int n = 0; n < 8; ++n) {
                f32x4 acc0 = {0.f, 0.f, 0.f, 0.f}, acc1 = {0.f, 0.f, 0.f, 0.f};
#pragma unroll
                for (int kk = 0; kk < 4; ++kk) if (kk <= (n >> 1)) {
                    const bf16x8 Bf = *(LAS const bf16x8*)(WT + (16 * n + fr) * RSW + (32 * kk + 8 * kg) * 2);
                    acc0 = __builtin_amdgcn_mfma_f32_16x16x32_bf16(Af[0][kk], Bf, acc0, 0, 0, 0);
                    acc1 = __builtin_amdgcn_mfma_f32_16x16x32_bf16(Af[1][kk], Bf, acc1, 0, 0, 0);
                }
                const int t = 16 * n + fr; const float bsv = bsp[g * 128 + t];
                bf16_t* yp = YAB + (size_t)(tok0 + t) * 2048 + g * 256 + dbase + 4 * kg;
                const u32x2 u0 = *(const u32x2*)yp, u1 = *(const u32x2*)(yp + 16);
                u32x2 o0, o1;
                o0.x = pk2(bflo(u0.x) * (acc0[0] + bsv), bfhi(u0.x) * (acc0[1] + bsv)); o0.y = pk2(bflo(u0.y) * (acc0[2] + bsv), bfhi(u0.y) * (acc0[3] + bsv));
                o1.x = pk2(bflo(u1.x) * (acc1[0] + bsv), bfhi(u1.x) * (acc1[1] + bsv)); o1.y = pk2(bflo(u1.y) * (acc1[2] + bsv), bfhi(u1.y) * (acc1[3] + bsv));
                *(u32x2*)yp = o0; *(u32x2*)(yp + 16) = o1;
            }
        }
        __syncthreads();
    }
}

__device__ __forceinline__ void ph_gate(const Ctx& F) {
    const bf16_t* Q = (const bf16_t*)(F.ws + WS_Q); const float* KM = (const float*)(F.ws + WS_KMEAN);
    unsigned* SEL = (unsigned*)(F.ws + WS_SEL); unsigned* LISTS = (unsigned*)(F.ws + WS_LISTS); unsigned* LCNT = (unsigned*)(F.ws + WS_CTL) + CW_LCNT;
    float* km = (float*)F.ldsg;
    unsigned* lc = (unsigned*)(F.ldsg + 8192);
    for (int it = F.vcu; it < NB * NH * 8; it += F.G) {
        const int b = it / 64, h = (it >> 3) & 7, tc = it & 7;
        for (int i = F.tid; i < NBLK * DH; i += 512) km[i] = KM[(size_t)(b * NH + h) * NBLK * DH + i];
        if (F.tid < 32) lc[F.tid] = 0u;
        __syncthreads();
        const int t = tc * 512 + F.tid, qi = t >> 8;
        float gsc[15];
#pragma unroll
        for (int j = 0; j < 15; ++j) gsc[j] = 0.f;
        const bf16_t* qp = Q + (size_t)(b * SEQ + t) * DM + h * DH;
        for (int c = 0; c < 16; ++c) {
            const u32x4 raw = *(const u32x4*)(qp + c * 8);
            const float x[8] = {bflo(raw.x), bfhi(raw.x), bflo(raw.y), bfhi(raw.y), bflo(raw.z), bfhi(raw.z), bflo(raw.w), bfhi(raw.w)};
#pragma unroll
            for (int j = 0; j < 15; ++j) if (j < qi) {
                const float* kk = km + j * DH + c * 8;
#pragma unroll
                for (int e = 0; e < 8; ++e) gsc[j] += x[e] * kk[e];
            }
        }
        const int nsel = qi < 3 ? qi : 3;
        int sel[3] = {0, 0, 0}; unsigned lpos[3] = {0, 0, 0};
#pragma unroll
        for (int r = 0; r < 3; ++r) {
            float best = -INFINITY; int bi = -1;
#pragma unroll
            for (int j = 0; j < 15; ++j) { const bool c = (j < qi) && (gsc[j] > best); best = c ? gsc[j] : best; bi = c ? j : bi; }
#pragma unroll
            for (int j = 0; j < 15; ++j) if (j == bi) gsc[j] = -INFINITY;
            sel[r] = bi < 0 ? 0 : bi;
            if (r < nsel) lpos[r] = atomicAdd(&lc[sel[r]], 1u);
        }
        SEL[(size_t)(b * SEQ + t) * NH + h] = (unsigned)sel[0] | ((unsigned)sel[1] << 8) | ((unsigned)sel[2] << 16) | ((unsigned)nsel << 24);
        __syncthreads();
        if (F.tid < 16) lc[16 + F.tid] = lc[F.tid] ? atomicAdd(&LCNT[(b * NH + h) * NBLK + F.tid], lc[F.tid]) : 0u;
        __syncthreads();
#pragma unroll
        for (int r = 0; r < 3; ++r) if (r < nsel) LISTS[(size_t)((b * NH + h) * NBLK + sel[r]) * 4096 + lc[16 + sel[r]] + lpos[r]] = (unsigned)t | ((unsigned)r << 12);
        __syncthreads();
    }
}

__device__ __forceinline__ void ph_attn_naive(const Ctx& F) {
    const bf16_t* Q = (const bf16_t*)(F.ws + WS_Q); const bf16_t* K = (const bf16_t*)(F.ws + WS_K); const bf16_t* V = (const bf16_t*)(F.ws + WS_V);
    const unsigned* SEL = (const unsigned*)(F.ws + WS_SEL); bf16_t* YAB = (bf16_t*)(F.ws + WS_YAB);
    float* qs = (float*)(F.ldsg + F.wave * 4608);
    float* sc = qs + 128;
    const int gw = F.vcu * 8 + F.wave, NGW = F.G * 8;
    for (int w = gw; w < NB * NH * SEQ; w += NGW) {
        const int b = w / (NH * SEQ), h = (w / SEQ) % NH, t = w % SEQ, qi = t >> 8, tl = t & 255;
        const size_t tok = (size_t)b * SEQ + t;
        { const unsigned qq = *(const unsigned*)(Q + tok * DM + h * DH + 2 * F.lane); qs[2 * F.lane] = bflo(qq); qs[2 * F.lane + 1] = bfhi(qq); }
        const unsigned selw = SEL[tok * NH + h]; const int nsel = selw >> 24;
        float mx = -INFINITY;
        for (int r = 0; r <= nsel; ++r) {
            const int jb = (r < nsel) ? (int)((selw >> (8 * r)) & 0xff) : qi;
            for (int c = 0; c < 4; ++c) {
                const int key = c * 64 + F.lane;
                const bool valid = (r < nsel) || (key <= tl);
                const bf16_t* kp = K + ((size_t)b * SEQ + jb * LBLK + key) * DM + h * DH;
                float s = 0.f;
#pragma unroll 4
                for (int dd = 0; dd < 16; ++dd) {
                    const u32x4 raw = *(const u32x4*)(kp + dd * 8);
                    const float* q8 = qs + dd * 8;
                    s += bflo(raw.x) * q8[0] + bfhi(raw.x) * q8[1] + bflo(raw.y) * q8[2] + bfhi(raw.y) * q8[3] + bflo(raw.z) * q8[4] + bfhi(raw.z) * q8[5] + bflo(raw.w) * q8[6] + bfhi(raw.w) * q8[7];
                }
                s = valid ? s : -INFINITY;
                sc[r * 256 + key] = s; mx = fmaxf(mx, s);
            }
        }
        mx = wave_max(mx);
        float l = 0.f;
        const int ntot = (nsel + 1) * 256;
        for (int i = F.lane; i < ntot; i += 64) { const float p = __builtin_amdgcn_exp2f(sc[i] - mx); sc[i] = p; l += p; }
        l = wave_sum(l);
        float o0 = 0.f, o1 = 0.f;
        for (int r = 0; r <= nsel; ++r) {
            const int jb = (r < nsel) ? (int)((selw >> (8 * r)) & 0xff) : qi;
            const int nk = (r < nsel) ? 256 : tl + 1;
            const bf16_t* vp = V + ((size_t)b * SEQ + jb * LBLK) * DM + h * DH + 2 * F.lane;
#pragma unroll 4
            for (int key = 0; key < nk; ++key) { const unsigned vv = *(const unsigned*)(vp + (size_t)key * DM); const float p = sc[r * 256 + key]; o0 += p * bflo(vv); o1 += p * bfhi(vv); }
        }
        const float il = 1.f / l;
        *(unsigned*)(YAB + tok * 2048 + 1024 + h * DH + 2 * F.lane) = pk2(o0 * il, o1 * il);
    }
}

typedef float f32x16 __attribute__((ext_vector_type(16)));
namespace att {
constexpr int KCH = 4112, VDB = 16448, OFF_K = 0, OFF_V = 16 * KCH, OFF_WS = OFF_V + 4 * VDB  , WSW = 512, OFF_TAB = OFF_WS + 8 * WSW  ;
static_assert(OFF_TAB + 1028 * 4 <= LDS_BYTES, "attention LDS map");
__device__ __forceinline__ int crow(int r, int hi) { return (r & 3) + 8 * (r >> 2) + 4 * hi; }

__device__ __forceinline__ void load_kv(const Ctx& F, const bf16_t* K, const bf16_t* V, size_t tokbase, int h) {
    u32x4 kv[8], vv[8];
#pragma unroll
    for (int k = 0; k < 8; ++k) { const int idx = F.tid + 512 * k, key = idx >> 4, c = idx & 15; const size_t off = (tokbase + key) * DM + h * DH + c * 8;
        kv[k] = *(const u32x4*)(K + off); vv[k] = *(const u32x4*)(V + off); }
#pragma unroll
    for (int k = 0; k < 8; ++k) { const int idx = F.tid + 512 * k, key = idx >> 4, c = idx & 15;
        *(LAS u32x4*)(F.lds + OFF_K + c * KCH + key * 16) = kv[k];
        *(LAS u32x4*)(F.lds + OFF_V + (c >> 2) * VDB + (key >> 3) * 512 + (key & 7) * 64 + (c & 3) * 16) = vv[k]; }
}

template <bool CAUSAL>
__device__ __forceinline__ void core(const Ctx& F, const bf16_t* qrow, f32x16 (&o)[4], float& m, float& l) {
    const int r = F.lane & 31, hh = F.lane >> 5;
    LAS float* wsf = (LAS float*)(F.lds + OFF_WS + F.wave * WSW);
    bf16x8 qr[8];
#pragma unroll
    for (int ds = 0; ds < 8; ++ds) qr[ds] = *(const bf16x8*)(qrow + ds * 16 + hh * 8);
#pragma unroll
    for (int db = 0; db < 4; ++db)
#pragma unroll
        for (int i = 0; i < 16; ++i) o[db][i] = 0.f;
    m = -1e30f; l = 0.f;
    const int nt = CAUSAL ? (F.wave >> 1) + 1 : 4;
    LAS const unsigned char* kbase = F.lds + OFF_K + hh * KCH + r * 16;
    LAS const unsigned char* vbase = F.lds + OFF_V + (4 * hh + ((F.lane & 15) >> 2)) * 64 + ((F.lane >> 4) & 1) * 32 + (F.lane & 3) * 8;
    for (int kt = 0; kt < nt; ++kt) {
        const bool diag = CAUSAL && (kt == nt - 1);
        const bool skip1 = diag && !(F.wave & 1);
        f32x16 p0, p1;
#pragma unroll
        for (int i = 0; i < 16; ++i) { p0[i] = 0.f; p1[i] = 0.f; }
        LAS const unsigned char* kp = kbase + (64 * kt) * 16;
#pragma unroll
        for (int ds = 0; ds < 8; ++ds) { const bf16x8 kf = *(LAS const bf16x8*)(kp + 2 * ds * KCH); p0 = __builtin_amdgcn_mfma_f32_32x32x16_bf16(kf, qr[ds], p0, 0, 0, 0); }
        if (!skip1) {
#pragma unroll
            for (int ds = 0; ds < 8; ++ds) { const bf16x8 kf = *(LAS const bf16x8*)(kp + 2 * ds * KCH + 512); p1 = __builtin_amdgcn_mfma_f32_32x32x16_bf16(kf, qr[ds], p1, 0, 0, 0); }
        }
        if (diag) {
            if (F.wave & 1) {
#pragma unroll
                for (int i = 0; i < 16; ++i) p1[i] = (crow(i, hh) > r) ? -INFINITY : p1[i];
            } else {
#pragma unroll
                for (int i = 0; i < 16; ++i) { p0[i] = (crow(i, hh) > r) ? -INFINITY : p0[i]; p1[i] = -INFINITY; }
            }
        }
        float mx = fmaxf(p0[0], p1[0]);
#pragma unroll
        for (int i = 1; i < 16; ++i) mx = fmaxf(mx, fmaxf(p0[i], p1[i]));
        mx = fmaxf(mx, __shfl_xor(mx, 32));
        const float mnew = fmaxf(m, mx);
        if (__any(mnew > m)) {
            const float alpha = __builtin_amdgcn_exp2f(m - mnew);
            l *= alpha; m = mnew;
            if (hh == 0) wsf[r] = alpha;
            asm volatile("s_waitcnt lgkmcnt(0)" ::: "memory");
#pragma unroll
            for (int i = 0; i < 16; ++i) { const float a = wsf[crow(i, hh)];
#pragma unroll
                for (int db = 0; db < 4; ++db) o[db][i] *= a; }
        }
        float ls = 0.f;
#pragma unroll
        for (int i = 0; i < 16; ++i) { p0[i] = __builtin_amdgcn_exp2f(p0[i] - m); p1[i] = __builtin_amdgcn_exp2f(p1[i] - m); ls += p0[i] + p1[i]; }
        l += ls;
        u32x4 pw[4];
#pragma unroll
        for (int s2 = 0; s2 < 2; ++s2) {
            pw[s2] = (u32x4){cvt_pk_bf16(p0[8 * s2], p0[8 * s2 + 1]), cvt_pk_bf16(p0[8 * s2 + 2], p0[8 * s2 + 3]), cvt_pk_bf16(p0[8 * s2 + 4], p0[8 * s2 + 5]), cvt_pk_bf16(p0[8 * s2 + 6], p0[8 * s2 + 7])};
            pw[2 + s2] = (u32x4){cvt_pk_bf16(p1[8 * s2], p1[8 * s2 + 1]), cvt_pk_bf16(p1[8 * s2 + 2], p1[8 * s2 + 3]), cvt_pk_bf16(p1[8 * s2 + 4], p1[8 * s2 + 5]), cvt_pk_bf16(p1[8 * s2 + 6], p1[8 * s2 + 7])};
        }
        LAS const unsigned char* vp = vbase + (8 * kt) * 512;
#pragma unroll
        for (int ks = 0; ks < 4; ++ks) {
            if (ks >= 2 && skip1) break;
            const bf16x8 pa = __builtin_bit_cast(bf16x8, pw[ks]);
#pragma unroll
            for (int db = 0; db < 4; ++db) {
                const v4i16_t lo = lds_tr16(vp + db * VDB + ks * 1024), hi = lds_tr16(vp + db * VDB + ks * 1024 + 512);
                const bf16x8 vf = (bf16x8){lo[0], lo[1], lo[2], lo[3], hi[0], hi[1], hi[2], hi[3]};
                o[db] = __builtin_amdgcn_mfma_f32_32x32x16_bf16(pa, vf, o[db], 0, 0, 0);
            }
        }
    }
}
__device__ __forceinline__ void finish_and_stage(const Ctx& F, const f32x16 (&o)[4], float m, float l) {
    const int r = F.lane & 31, hh = F.lane >> 5;
    LAS float* wsf = (LAS float*)(F.lds + OFF_WS + F.wave * WSW);
    const float lt = l + __shfl_xor(l, 32);
    if (hh == 0) { wsf[r] = 1.0f / lt; wsf[32 + r] = m + __builtin_amdgcn_logf(lt); }
    __syncthreads();
    LAS float* stg = (LAS float*)(F.lds + F.wave * 16384);
#pragma unroll
    for (int i = 0; i < 16; ++i) { const int q = crow(i, hh); const float a = wsf[q];
#pragma unroll
        for (int db = 0; db < 4; ++db) stg[q * 128 + 32 * db + r] = o[db][i] * a; }
    asm volatile("s_waitcnt lgkmcnt(0)" ::: "memory");
}
}

__device__ __forceinline__ void ph_attn_partial(const Ctx& F) {
    using namespace att;
    const bf16_t* Q = (const bf16_t*)(F.ws + WS_Q); const bf16_t* K = (const bf16_t*)(F.ws + WS_K); const bf16_t* V = (const bf16_t*)(F.ws + WS_V);
    const unsigned* LISTS = (const unsigned*)(F.ws + WS_LISTS); const unsigned* LCNT = (const unsigned*)(F.ws + WS_CTL) + CW_LCNT;
    bf16_t* OP = (bf16_t*)(F.ws + WS_OP); float* LSE = (float*)(F.ws + WS_LSE);
    LAS int* P = (LAS int*)(F.lds + OFF_TAB);
    if (F.tid < 64) {
        int c[16]; int s = 0;
#pragma unroll
        for (int i = 0; i < 16; ++i) { c[i] = ((int)__hip_atomic_load(LCNT + F.tid * 16 + i, __ATOMIC_RELAXED, __HIP_MEMORY_SCOPE_AGENT) + 255) >> 8; s += c[i]; }
        int inc = s;
#pragma unroll
        for (int o = 1; o < 64; o <<= 1) { const int t = __shfl_up(inc, o); if (F.lane >= o) inc += t; }
        int run = inc - s;
#pragma unroll
        for (int i = 0; i < 16; ++i) { P[F.tid * 16 + i] = run; run += c[i]; }
        if (F.tid == 63) P[1024] = run;
    }
    __syncthreads();
    const int total = P[1024];
    LAS float* wsf = (LAS float*)(F.lds + OFF_WS + F.wave * WSW);
    LAS int* wsi = (LAS int*)wsf;
    for (int item = F.vcu; item < total; item += F.G) {
        int lo = 0, hi = 1023;
        while (lo < hi) { const int mid = (lo + hi + 1) >> 1; if (P[mid] <= item) lo = mid; else hi = mid - 1; }
        const int bhj = lo, chunk = item - P[lo];
        const int b = bhj >> 7, h = (bhj >> 4) & 7, j = bhj & 15;
        const int cnt = (int)__hip_atomic_load(LCNT + bhj, __ATOMIC_RELAXED, __HIP_MEMORY_SCOPE_AGENT);
        load_kv(F, K, V, (size_t)b * SEQ + j * LBLK, h);
        const int r = F.lane & 31, qi = chunk * 256 + F.wave * 32 + r;
        const unsigned ent = LISTS[(size_t)bhj * 4096 + (qi < cnt ? qi : 0)];
        const int tq = ent & 4095, slot = (qi < cnt) ? (int)(ent >> 12) : -1;
        if (F.lane < 32) { wsi[64 + r] = tq; wsi[96 + r] = slot; }
        __syncthreads();
        f32x16 o[4]; float m, l;
        core<false>(F, Q + ((size_t)b * SEQ + tq) * DM + h * DH, o, m, l);
        finish_and_stage(F, o, m, l);
        LAS const float* stg = (LAS const float*)(F.lds + F.wave * 16384);
#pragma unroll
        for (int ps = 0; ps < 8; ++ps) {
            const int q = ps * 4 + (F.lane >> 4), dc = F.lane & 15;
            const f32x4 a = *(LAS const f32x4*)(stg + q * 128 + dc * 8), c = *(LAS const f32x4*)(stg + q * 128 + dc * 8 + 4);
            const int t = wsi[64 + q], sl = wsi[96 + q];
            if (sl >= 0) {
                const size_t row = (((size_t)sl * NB + b) * SEQ + t) * NH + h;
                u32x4 w; w.x = cvt_pk_bf16(a.x, a.y); w.y = cvt_pk_bf16(a.z, a.w); w.z = cvt_pk_bf16(c.x, c.y); w.w = cvt_pk_bf16(c.z, c.w);
                *(u32x4*)(OP + row * DH + dc * 8) = w;
                if (dc == 0) LSE[row] = wsf[32 + q];
            }
        }
        __syncthreads();
    }
}

__device__ __forceinline__ void ph_attn_own(const Ctx& F) {
    using namespace att;
    const bf16_t* Q = (const bf16_t*)(F.ws + WS_Q); const bf16_t* K = (const bf16_t*)(F.ws + WS_K); const bf16_t* V = (const bf16_t*)(F.ws + WS_V);
    const bf16_t* OP = (const bf16_t*)(F.ws + WS_OP); const float* LSE = (const float*)(F.ws + WS_LSE); bf16_t* YAB = (bf16_t*)(F.ws + WS_YAB);
    LAS float* wsf = (LAS float*)(F.lds + OFF_WS + F.wave * WSW);
    for (int it = F.vcu; it < NB * NH * NBLK; it += F.G) {
        const int b = it >> 7, h = (it >> 4) & 7, j = it & 15;
        load_kv(F, K, V, (size_t)b * SEQ + j * LBLK, h);
        __syncthreads();
        const int r = F.lane & 31, t0 = j * LBLK + F.wave * 32;
        f32x16 o[4]; float m, l;
        core<true>(F, Q + ((size_t)b * SEQ + t0 + r) * DM + h * DH, o, m, l);
        finish_and_stage(F, o, m, l);
        LAS const float* stg = (LAS const float*)(F.lds + F.wave * 16384);
        const int nv = j < 3 ? j : 3;
#pragma unroll 2
        for (int ps = 0; ps < 8; ++ps) {
            const int q = ps * 4 + (F.lane >> 4), dc = F.lane & 15, t = t0 + q;
            const f32x4 a = *(LAS const f32x4*)(stg + q * 128 + dc * 8), c = *(LAS const f32x4*)(stg + q * 128 + dc * 8 + 4);
            const float lse_own = wsf[32 + q];
            float ls[3] = {-1e30f, -1e30f, -1e30f}; u32x4 pv[3] = {};
#pragma unroll
            for (int s2 = 0; s2 < 3; ++s2) if (s2 < nv) { const size_t row = (((size_t)s2 * NB + b) * SEQ + t) * NH + h; ls[s2] = LSE[row]; pv[s2] = *(const u32x4*)(OP + row * DH + dc * 8); }
            const float M = fmaxf(fmaxf(lse_own, ls[0]), fmaxf(ls[1], ls[2]));
            const float w0 = __builtin_amdgcn_exp2f(lse_own - M);
            float den = w0; f32x4 x0 = a * w0, x1 = c * w0;
#pragma unroll
            for (int s2 = 0; s2 < 3; ++s2) {
                const float w = (s2 < nv) ? __builtin_amdgcn_exp2f(ls[s2] - M) : 0.f; den += w;
                x0.x += w * bflo(pv[s2].x); x0.y += w * bfhi(pv[s2].x); x0.z += w * bflo(pv[s2].y); x0.w += w * bfhi(pv[s2].y);
                x1.x += w * bflo(pv[s2].z); x1.y += w * bfhi(pv[s2].z); x1.z += w * bflo(pv[s2].w); x1.w += w * bfhi(pv[s2].w);
            }
            const float id = 1.0f / den; x0 = x0 * id; x1 = x1 * id;
            u32x4 w; w.x = cvt_pk_bf16(x0.x, x0.y); w.y = cvt_pk_bf16(x0.z, x0.w); w.z = cvt_pk_bf16(x1.x, x1.y); w.w = cvt_pk_bf16(x1.z, x1.w);
            *(u32x4*)(YAB + ((size_t)b * SEQ + t) * 2048 + 1024 + h * DH + dc * 8) = w;
        }
        __syncthreads();
    }
}

__device__ __forceinline__ void ln_stats16(const float* st, int lane, float& mean, float& rstd) {
    float s1 = 0.f, s2 = 0.f;
    if (lane < 16) { const f32x2 p = *(const f32x2*)(st + 2 * lane); s1 = p.x; s2 = p.y; }
    s1 = wave_sum(s1); s2 = wave_sum(s2);
    mean = s1 * (1.f / DM); const float var = s2 * (1.f / DM) - mean * mean; rstd = 1.f / sqrtf(fmaxf(var, 0.f) + LN_EPS);
}
__device__ __forceinline__ void ph_router(const Ctx& F) {
    const Args& A = *F.a;
    const float* Z = (const float*)(F.ws + WS_Z); const float* ZST = (const float*)(F.ws + WS_ZST); bf16_t* H1 = (bf16_t*)(F.ws + WS_H1);
    int* TKE = (int*)(F.ws + WS_TKE); float* TKW = (float*)(F.ws + WS_TKW); int* TKP = (int*)(F.ws + WS_TKP); unsigned* ECNT = (unsigned*)(F.ws + WS_CTL) + CW_ECNT;
    const float* wr = A.in[I_WR]; const float* br = A.in[I_BR];
    const int gw = F.vcu * 8 + F.wave, NGW = F.G * 8;
    const f32x4* gp = (const f32x4*)A.in[I_LNMIX_G] + F.lane; const f32x4* bp = (const f32x4*)A.in[I_LNMIX_B] + F.lane;
    for (int m = gw; m < T; m += NGW) {
        float mean, rstd; ln_stats16(ZST + (size_t)m * 32, F.lane, mean, rstd);
        const f32x4* zr = (const f32x4*)(Z + (size_t)m * DM) + F.lane;
        f32x4 hv[4];
        u32x2* o8 = (u32x2*)(H1 + (size_t)m * DM) + F.lane;
#pragma unroll
        for (int j = 0; j < 4; ++j) { hv[j] = (zr[64 * j] - mean) * rstd * gp[64 * j] + bp[64 * j]; o8[64 * j] = (u32x2){pk2(hv[j].x, hv[j].y), pk2(hv[j].z, hv[j].w)}; }
        asm volatile("" ::: "memory");
        int lo4 = 4 * F.lane; asm volatile("" : "+v"(lo4));
        const int myexp = F.lane & 31;
        float mylg = 0.f;
#pragma unroll 1
        for (int eg = 0; eg < 4; ++eg) {
            float l8[8];
#pragma unroll
            for (int k = 0; k < 8; ++k) l8[k] = 0.f;
#pragma unroll
            for (int j = 0; j < 4; ++j)
#pragma unroll
                for (int c = 0; c < 4; ++c) {
                    const float hx = hv[j][c]; const f32x4* wp = (const f32x4*)(wr + (size_t)(lo4 + 256 * j + c) * NE + eg * 8);
                    const f32x4 w0 = wp[0], w1 = wp[1];
                    l8[0] += hx * w0.x; l8[1] += hx * w0.y; l8[2] += hx * w0.z; l8[3] += hx * w0.w; l8[4] += hx * w1.x; l8[5] += hx * w1.y; l8[6] += hx * w1.z; l8[7] += hx * w1.w;
                }
#pragma unroll
            for (int k = 0; k < 8; ++k) { const float sres = wave_sum(l8[k]); mylg = (myexp == eg * 8 + k) ? sres : mylg; }
        }
        mylg += br[myexp];
        int te[4]; float tv[4];
#pragma unroll
        for (int r = 0; r < 4; ++r) {
            float v = mylg; int idx = myexp;
#pragma unroll
            for (int o = 1; o < 32; o <<= 1) { const float ov = __shfl_xor(v, o); const int oi = __shfl_xor(idx, o); const bool take = (ov > v) || (ov == v && oi < idx); v = take ? ov : v; idx = take ? oi : idx; }
            te[r] = idx; tv[r] = v; mylg = (myexp == idx) ? -INFINITY : mylg;
        }
        const float e1 = __expf(tv[1] - tv[0]), e2 = __expf(tv[2] - tv[0]), e3 = __expf(tv[3] - tv[0]); const float inv = 1.f / (1.f + e1 + e2 + e3);
        const float tw[4] = {inv, e1 * inv, e2 * inv, e3 * inv};
        if (F.lane < 4) {
            const int e = F.lane == 0 ? te[0] : F.lane == 1 ? te[1] : F.lane == 2 ? te[2] : te[3];
            const float w = F.lane == 0 ? tw[0] : F.lane == 1 ? tw[1] : F.lane == 2 ? tw[2] : tw[3];
            const unsigned pos = atomicAdd(&ECNT[e], 1u);
            TKE[(size_t)m * 4 + F.lane] = e; TKW[(size_t)m * 4 + F.lane] = w; TKP[(size_t)m * 4 + F.lane] = (int)pos;
        }
    }
}

__device__ __forceinline__ void ph_scatter(const Ctx& F) {
    const unsigned* ECNT = (const unsigned*)(F.ws + WS_CTL) + CW_ECNT;
    const int* TKE = (const int*)(F.ws + WS_TKE); const float* TKW = (const float*)(F.ws + WS_TKW); const int* TKP = (const int*)(F.ws + WS_TKP);
    int* ROWOF = (int*)(F.ws + WS_ROWOF); int* ROWTOK = (int*)(F.ws + WS_ROWTOK); float* ROWW = (float*)(F.ws + WS_ROWW); int* TILE = (int*)(F.ws + WS_TILE);
    const bf16_t* H1 = (const bf16_t*)(F.ws + WS_H1); bf16_t* XG = (bf16_t*)(F.ws + WS_XG);
    int* pst = (int*)F.ldsg;
    if (F.tid == 0) {
        int acc = 0;
        for (int e = 0; e < NE; ++e) { const int c = (int)__hip_atomic_load(ECNT + e, __ATOMIC_RELAXED, __HIP_MEMORY_SCOPE_AGENT); pst[e] = acc; pst[32 + e] = c; acc += (c + 255) / 256 * 256; }
        pst[64] = acc;
    }
    __syncthreads();
    if (blockIdx.x == 0) {
        const int ntiles = pst[64] / 256;
        if (F.tid == 0) TILE[0] = ntiles;
        for (int i = F.tid; i < ntiles; i += 512) { int e = 0; for (int k = 1; k < NE; ++k) if (i * 256 >= pst[k]) e = k; TILE[16 + i] = e; }
        for (int e = 0; e < NE; ++e) { const int s = pst[e] + pst[32 + e], en = (e + 1 < NE) ? pst[e + 1] : pst[64]; for (int r = s + F.tid; r < en; r += 512) { ROWTOK[r] = 0; ROWW[r] = 0.f; } }
    }
    const int gw = F.vcu * 8 + F.wave, NGW = F.G * 8;
    for (int idx = gw; idx < T * TOPK; idx += NGW) {
        const int t = idx >> 2, e = TKE[idx], row = pst[e] + TKP[idx];
        if (F.lane == 0) { ROWTOK[row] = t; ROWW[row] = TKW[idx]; ROWOF[idx] = row; }
        const u32x4* src = (const u32x4*)(H1 + (size_t)t * DM); u32x4* dst = (u32x4*)(XG + (size_t)row * DM);
        dst[F.lane] = src[F.lane]; dst[64 + F.lane] = src[64 + F.lane];
    }
}

__device__ __forceinline__ void ph_final(const Ctx& F) {
    const Args& A = *F.a;
    const float* Z = (const float*)(F.ws + WS_Z); const float* ZST = (const float*)(F.ws + WS_ZST); const bf16_t* YS = (const bf16_t*)(F.ws + WS_YS); const int* ROWOF = (const int*)(F.ws + WS_ROWOF);
    const int gw = F.vcu * 8 + F.wave, NGW = F.G * 8;
    f32x4 gg[4], bb[4], g2[4], b2[4];
#pragma unroll
    for (int j = 0; j < 4; ++j) { gg[j] = *((const f32x4*)A.in[I_LNMIX_G] + F.lane + 64 * j); bb[j] = *((const f32x4*)A.in[I_LNMIX_B] + F.lane + 64 * j);
        g2[j] = *((const f32x4*)A.in[I_LNF_G] + F.lane + 64 * j); b2[j] = *((const f32x4*)A.in[I_LNF_B] + F.lane + 64 * j); }
    for (int m = gw; m < T; m += NGW) {
        float mean, rstd; ln_stats16(ZST + (size_t)m * 32, F.lane, mean, rstd);
        const f32x4* zr = (const f32x4*)(Z + (size_t)m * DM) + F.lane;
        f32x4 v[4];
#pragma unroll
        for (int j = 0; j < 4; ++j) v[j] = ((zr[64 * j] - mean) * rstd * gg[j] + bb[j]) * ALPHA;
#pragma unroll
        for (int k = 0; k < 4; ++k) {
            const int row = ROWOF[(size_t)m * 4 + k]; const u32x2* yr = (const u32x2*)(YS + (size_t)row * DM) + F.lane;
#pragma unroll
            for (int j = 0; j < 4; ++j) { const u32x2 y = yr[64 * j]; v[j].x += bflo(y.x); v[j].y += bfhi(y.x); v[j].z += bflo(y.y); v[j].w += bfhi(y.y); }
        }
        float s = 0.f;
#pragma unroll
        for (int j = 0; j < 4; ++j) s += (v[j].x + v[j].y) + (v[j].z + v[j].w);
        const float mu = wave_sum(s) * (1.f / DM); float s2 = 0.f;
#pragma unroll
        for (int j = 0; j < 4; ++j) { v[j] = v[j] - mu; s2 += (v[j].x * v[j].x + v[j].y * v[j].y) + (v[j].z * v[j].z + v[j].w * v[j].w); }
        const float rs = 1.f / sqrtf(wave_sum(s2) * (1.f / DM) + LN_EPS);
        f32x4* orow = (f32x4*)(A.out + (size_t)m * DM) + F.lane;
#pragma unroll
        for (int j = 0; j < 4; ++j) orow[64 * j] = v[j] * rs * g2[j] + b2[j];
    }
}

template <bool COOP>
__global__ void __launch_bounds__(512, 2) mega(Args args) {
    extern __shared__ __attribute__((aligned(16))) unsigned char lds_raw[];
    Ctx F;
    const int wave0 = __builtin_amdgcn_readfirstlane(threadIdx.x >> 6);
#define MKCTX() do { F.a = &args; F.ws = args.ws; F.lds = (LAS unsigned char*)lds_raw; F.ldsg = lds_raw; F.lane = lane_id_asm(); F.wave = wave0; F.tid = wave0 * 64 + F.lane; \
    F.G = gridDim.x; { const int bx = blockIdx.x; F.vcu = (F.G % 8 == 0) ? (bx % 8) * (F.G / 8) + bx / 8 : bx; } } while (0)
    MKCTX();
    const int lo = args.ph_lo, hi = args.ph_hi;
    unsigned char* ws = args.ws;
#ifndef PHMASK
#define PHMASK 0xFFFF
#endif
#define IN(k) (((PHMASK >> (k)) & 1) && lo <= (k) && (k) < hi)
#define SEAM(k) do { if (COOP && IN(k) && IN((k) + 1)) { cg::this_grid().sync(); } } while (0)
    if (IN(0)) { MKCTX(); ph_prologue(F); } SEAM(0);
    if (IN(1)) {
        pg8::Gemm g{(const bf16_t*)(ws + WS_H0), (const bf16_t*)(ws + WS_WIN), DM, DM, DM}; pg8::StaticOrder S; S.init(T, INCOLS, F.G, (int)blockIdx.x);
        pg8::Epi1 E{(bf16_t*)(ws + WS_YAB), (bf16_t*)(ws + WS_GV), (bf16_t*)(ws + WS_Q), (bf16_t*)(ws + WS_K), (bf16_t*)(ws + WS_V), (bf16_t*)(ws + WS_SA), (bf16_t*)(ws + WS_SB), (float*)(ws + WS_GVST)};
        pg8::gemm_phase<pg8::Epi1, pg8::StaticOrder, true>(F.lds, g, S, E, wave0);
    } SEAM(1);
    if (IN(2)) { MKCTX(); ph_kmean(F); ph_mixer_a(F); } SEAM(2);
    if (IN(3)) { MKCTX(); ph_gate(F); } SEAM(3);
    if (IN(4)) { MKCTX(); ph_attn_partial(F); } SEAM(4);
    if (IN(5)) { MKCTX(); ph_attn_own(F); } SEAM(5);
    if (IN(6)) {
        pg8::Gemm g{(const bf16_t*)(ws + WS_YAB), (const bf16_t*)(ws + WS_WAB), 2048, 2048, 2048}; pg8::StaticOrder S; S.init(T, DM, F.G, (int)blockIdx.x);
        pg8::Epi2 E{(const bf16_t*)(ws + WS_SA), (const bf16_t*)(ws + WS_SB), (bf16_t*)(ws + WS_MG)};
        pg8::gemm_phase<pg8::Epi2, pg8::StaticOrder, true>(F.lds, g, S, E, wave0);
    } SEAM(6);
    if (IN(7)) {
        pg8::Gemm g{(const bf16_t*)(ws + WS_MG), (const bf16_t*)(ws + WS_WOUT), DM, DM, DM}; pg8::StaticOrder S; S.init(T, DM, F.G, (int)blockIdx.x);
        pg8::Epi3 E{(const bf16_t*)(ws + WS_H0), (float*)(ws + WS_Z), (float*)(ws + WS_ZST)};
        pg8::gemm_phase<pg8::Epi3, pg8::StaticOrder, true>(F.lds, g, S, E, wave0);
    } SEAM(7);
    if (IN(8)) { MKCTX(); ph_router(F); } SEAM(8);
    if (IN(9)) { MKCTX(); ph_scatter(F); } SEAM(9);
    if (IN(10)) {
        pg8::Gemm g{(const bf16_t*)(ws + WS_XG), (const bf16_t*)(ws + WS_WUP), DM, DM, DM}; pg8::MoeOrder S; S.init((const int*)(ws + WS_TILE), 8, F.G, (int)blockIdx.x);
        pg8::Epi4 E{args.in[I_BUP], (bf16_t*)(ws + WS_ACT)};
        pg8::gemm_phase<pg8::Epi4, pg8::MoeOrder, true>(F.lds, g, S, E, wave0);
    } SEAM(10);
    if (IN(11)) {
        pg8::Gemm g{(const bf16_t*)(ws + WS_ACT), (const bf16_t*)(ws + WS_WDN), FF, FF, FF}; pg8::MoeOrder S; S.init((const int*)(ws + WS_TILE), 4, F.G, (int)blockIdx.x);
        pg8::Epi5 E{args.in[I_BDN], (const float*)(ws + WS_ROWW), (bf16_t*)(ws + WS_YS)};
        pg8::gemm_phase<pg8::Epi5, pg8::MoeOrder, true>(F.lds, g, S, E, wave0);
    } SEAM(11);
    if (IN(12)) { MKCTX(); ph_final(F); }
#undef IN
#undef SEAM
}

extern "C" void kernel_launch(void* const* d_in, const int* in_sizes, int n_in, void* d_out, int out_size, void* d_ws, size_t ws_size, hipStream_t stream) {
    static int grid = 0;
    if (grid == 0) {
        if (n_in != 21 || in_sizes[0] != T * DM || out_size != T * DM || ws_size < WS_END) { fprintf(stderr, "kernel_launch: unexpected shapes (n_in %d, in0 %d, out %d, ws %zu)\n", n_in, n_in > 0 ? in_sizes[0] : -1, out_size, ws_size); grid = -1; return; }
        int dev = 0, cus = 0, per_cu = 0;
        hipGetDevice(&dev); hipDeviceGetAttribute(&cus, hipDeviceAttributeMultiprocessorCount, dev);
        const void* fn = MK_COOP ? (const void*)mega<true> : (const void*)mega<false>;
        hipFuncSetAttribute(fn, hipFuncAttributeMaxDynamicSharedMemorySize, LDS_BYTES);
        hipOccupancyMaxActiveBlocksPerMultiprocessor(&per_cu, fn, 512, LDS_BYTES);
        (void)hipGetLastError();
        if (per_cu < 1) { fprintf(stderr, "kernel_launch: occupancy query says %d blocks/CU\n", per_cu); per_cu = 1; }
        grid = cus * 1;
    }
    if (grid < 0) return;
    hipMemsetAsync((char*)d_ws + WS_CTL, 0, CTL_ZERO_BYTES, stream);
    Args a{};
    for (int i = 0; i < 21; ++i) a.in[i] = (const float*)d_in[i];
    a.out = (float*)d_out; a.ws = (unsigned char*)d_ws;
#if MK_COOP
    a.ph_lo = 0; a.ph_hi = NPHASE;
    void* kargs[] = {&a};
    hipError_t e = hipLaunchCooperativeKernel((const void*)mega<true>, dim3(grid), dim3(512), kargs, LDS_BYTES, stream);
    if (e != hipSuccess) fprintf(stderr, "cooperative launch failed: %s (grid %d)\n", hipGetErrorString(e), grid);
#else
    for (int p = 0; p < NPHASE; ++p) { a.ph_lo = p; a.ph_hi = p + 1; hipLaunchKernelGGL(mega<false>, dim3(grid), dim3(512), LDS_BYTES, stream, a); }
#endif
}
```

```cpp
#include <hip/hip_runtime.h>
#include <hip/hip_cooperative_groups.h>
#include <cstdio>
#include <cstdint>
namespace cg = cooperative_groups;

#ifndef MK_COOP
#define MK_COOP 1
#endif

#define LAS __attribute__((address_space(3)))
typedef unsigned short bf16_t;
typedef short bf16x8 __attribute__((ext_vector_type(8)));
typedef float f32x4 __attribute__((ext_vector_type(4)));
typedef float f32x2 __attribute__((ext_vector_type(2)));
typedef unsigned u32x4 __attribute__((ext_vector_type(4)));
typedef unsigned u32x2 __attribute__((ext_vector_type(2)));

constexpr int NB = 8, SEQ = 4096, DM = 1024, T = NB * SEQ;
constexpr int NH = 8, DH = 128, LBLK = 256, NBLK = SEQ / LBLK;
constexpr int NE = 32, TOPK = 4, FF = 1024;
constexpr int INCOLS = 7 * DM;
constexpr int RMAX = T * TOPK + NE * 256;
constexpr float LN_EPS = 1e-5f;
constexpr float ALPHA = 1.189207115002721f;
constexpr float QSCALE = 0.08838834764831845f * 1.4426950408889634f;

constexpr size_t MiB = 1u << 20, U64 = 64 * MiB;
constexpr size_t WS_CTL = 0, CTL_ZERO_BYTES = 1 * MiB;
constexpr int CW_ECNT = 64;
constexpr int CW_LCNT = 1024;
constexpr int CW_BAR = 4096;
constexpr size_t WS_KMEAN = 1 * MiB;
constexpr size_t WS_GVST = 2 * MiB;
constexpr size_t WS_ZST = 6 * MiB;
constexpr size_t WS_SEL = 10 * MiB;
constexpr size_t WS_TKE = 11 * MiB;
constexpr size_t WS_TKW = 11 * MiB + 512 * 1024;
constexpr size_t WS_TKP = 12 * MiB;
constexpr size_t WS_ROWOF = 12 * MiB + 512 * 1024;
constexpr size_t WS_ROWTOK = 13 * MiB;
constexpr size_t WS_ROWW = 14 * MiB;
constexpr size_t WS_TILE = 15 * MiB;
constexpr size_t WS_LISTS = 16 * MiB;
constexpr size_t WS_LSE = 32 * MiB;
constexpr size_t WS_WIN = 40 * MiB;
constexpr size_t WS_WAB = 54 * MiB;
constexpr size_t WS_WOUT = 58 * MiB;
constexpr size_t WS_WDN = 60 * MiB;
constexpr size_t WS_WUP = 124 * MiB;
constexpr size_t WS_H0 = 4 * U64;
constexpr size_t WS_YAB = 5 * U64;
constexpr size_t WS_GV = 7 * U64;
constexpr size_t WS_Q = 8 * U64, WS_K = 9 * U64, WS_V = 10 * U64, WS_SA = 11 * U64, WS_SB = 12 * U64;
constexpr size_t WS_OP = 13 * U64;
constexpr size_t WS_MG = WS_GV;
constexpr size_t WS_Z = 14 * U64;
constexpr size_t WS_H1 = WS_H0;
constexpr size_t WS_XG = 5 * U64;
constexpr size_t WS_ACT = 9 * U64 + 16 * MiB;
constexpr size_t WS_YS = WS_XG;
constexpr size_t WS_END = 16 * U64;
static_assert(WS_XG + (size_t)RMAX * 2048 <= WS_ACT && WS_ACT + (size_t)RMAX * 2048 <= WS_Z, "ws map");

constexpr int LDS_BYTES = 163840;
constexpr int LDS_MISC = 131072;
constexpr int NPHASE = 13;

__device__ __forceinline__ float bf2f(bf16_t v) { return __uint_as_float((unsigned)v << 16); }
__device__ __forceinline__ float bflo(unsigned u) { return __uint_as_float(u << 16); }
__device__ __forceinline__ float bfhi(unsigned u) { return __uint_as_float(u & 0xffff0000u); }
__device__ __forceinline__ unsigned f2bf(float f) { unsigned u = __builtin_bit_cast(unsigned, f); return (u + 0x7fffu + ((u >> 16) & 1u)) >> 16; }
__device__ __forceinline__ unsigned pk2(float lo, float hi) { return f2bf(lo) | (f2bf(hi) << 16); }
typedef __bf16 bf16x2_t __attribute__((ext_vector_type(2)));
__device__ __forceinline__ unsigned cvt_pk_bf16(float lo, float hi) { f32x2 v = {lo, hi}; bf16x2_t b = __builtin_convertvector(v, bf16x2_t); return __builtin_bit_cast(unsigned, b); }
__device__ __forceinline__ int lane_id_asm() { int l; asm volatile("v_mbcnt_lo_u32_b32 %0, -1, 0\n\tv_mbcnt_hi_u32_b32 %0, -1, %0" : "=v"(l)); return l; }
__device__ __forceinline__ float wave_sum(float v) {
#pragma unroll
    for (int o = 1; o < 64; o <<= 1) v += __shfl_xor(v, o);
    return v;
}
__device__ __forceinline__ float wave_max(float v) {
#pragma unroll
    for (int o = 1; o < 64; o <<= 1) v = fmaxf(v, __shfl_xor(v, o));
    return v;
}
__device__ __forceinline__ f32x2 gelu_pk(f32x2 v) {
    const f32x2 av = __builtin_elementwise_abs(v), d = av * 0.2316418882f + 1.0f;
    f32x2 t; t.x = __builtin_amdgcn_rcpf(d.x); t.y = __builtin_amdgcn_rcpf(d.y);
    f32x2 q = t * 0.5307027145f + (-0.7265760135f); q = q * t + 0.7107068705f; q = q * t + (-0.142248368f); q = q * t + 0.127414796f; q = q * t;
    const f32x2 s = (v * v) * (-0.72134752044f);
    f32x2 e; e.x = __builtin_amdgcn_exp2f(s.x); e.y = __builtin_amdgcn_exp2f(s.y);
    const f32x2 m = v * (q * e), r = v - m;
    f32x2 o; o.x = v.x < 0.f ? m.x : r.x; o.y = v.y < 0.f ? m.y : r.y; return o;
}
__device__ __forceinline__ float sigmoidf_(float x) { return __builtin_amdgcn_rcpf(1.0f + __builtin_amdgcn_exp2f(-1.4426950408889634f * x)); }

namespace pg8 {
constexpr int BM = 256, BK = 64, HALF = 128, HTB = HALF * BK * 2, STAGE_BYTES = 8 * HTB, NXCD = 8, WGM = 8;
__host__ __device__ __forceinline__ int lds_byte(int r, int c) { const int st = (r >> 4) * 2 + (c >> 5), rr = r & 15, cc = c & 31, ob = rr * 64 + cc * 2; return st * 1024 + (ob ^ (((ob >> 9) & 1) << 5)); }
__host__ __device__ __forceinline__ void stage_rc(int b, int& R, int& C) { const int st = b / 1024, sb = b % 1024, swz = sb ^ (((sb >> 9) & 1) << 5); R = (st >> 1) * 16 + swz / 64; C = (st & 1) * 32 + (swz % 64) / 2; }
__host__ __device__ __forceinline__ int perm32(int rho) { const int n = rho >> 4, i = rho & 15; return 8 * (i >> 2) + 4 * n + (i & 3); }

struct Unit { int pm, pn, bt; };
struct Gemm { const bf16_t* A; const bf16_t* Bt; int K, lda, ldb; };

struct StaticOrder {
    int nM, nN, nwg, G, c;
    __device__ void init(int M, int N, int G_, int c_) { nM = M / BM; nN = N / BM; nwg = nM * nN; G = G_; c = c_; }
    __device__ bool next(int i, Unit& u) const {
        const long L = (long)i * G + c; if (L >= nwg) return false;
        int wgid = (int)L; { const int q = nwg / NXCD, r = nwg % NXCD, xcd = wgid % NXCD, off = wgid / NXCD; wgid = (xcd < r ? xcd * (q + 1) : r * (q + 1) + (xcd - r) * q) + off; }
        const int nig = WGM * nN, gid = wgid / nig, fm = gid * WGM, gsz = (nM - fm) < WGM ? (nM - fm) : WGM;
        u.pm = fm + ((wgid % nig) % gsz); u.pn = (wgid % nig) / gsz; u.bt = u.pn; return true;
    }
};
struct MoeOrder {
    int nM, nN, nwg, G, c; const int* tile_e;
    __device__ void init(const int* tiletab, int nN_, int G_, int c_) { nM = tiletab[0]; tile_e = tiletab + 16; nN = nN_; nwg = nM * nN; G = G_; c = c_; }
    __device__ bool next(int i, Unit& u) const {
        const long L = (long)i * G + c; if (L >= nwg) return false;
        int wgid = (int)L; { const int q = nwg / NXCD, r = nwg % NXCD, xcd = wgid % NXCD, off = wgid / NXCD; wgid = (xcd < r ? xcd * (q + 1) : r * (q + 1) + (xcd - r) * q) + off; }
        const int nig = WGM * nN, gid = wgid / nig, fm = gid * WGM, gsz = (nM - fm) < WGM ? (nM - fm) : WGM;
        u.pm = fm + ((wgid % nig) % gsz); u.pn = (wgid % nig) / gsz; u.bt = tile_e[u.pm] * nN + u.pn; return true;
    }
};

template <class Epi, class Sched, bool ALIGN_EPI>
__device__ __forceinline__ void gemm_phase(LAS unsigned char* lds, const Gemm g, const Sched& S, const Epi& E, const int wid) {
    const int lane = lane_id_asm(), tid = wid * 64 + lane;
    const int wr = wid >> 2, wc = wid & 3, fr = lane & 15, fq = lane >> 4;
    const int nt = g.K / BK;
    unsigned voffA[2], voffB[2];
#pragma unroll
    for (int i = 0; i < 2; ++i) { int R, C; stage_rc(tid * 16 + i * 8192, R, C); const int Rb = Epi::PERM ? ((R & ~31) + perm32(R & 31)) : R;
        voffA[i] = (unsigned)(R * g.lda + C) * 2u; voffB[i] = (unsigned)(Rb * g.ldb + C) * 2u; }
    const size_t kstep = (size_t)(BK * 2);
    const size_t hstepA = (size_t)HALF * g.lda * 2, hstepB = (size_t)HALF * g.ldb * 2;
    const size_t tstepA = 2 * hstepA, tstepB = 2 * hstepB;
    const unsigned ldsw = (unsigned)wid * 1024u;
    const int aoff = lds_byte(wr * 64 + fr, fq * 8), boff = lds_byte(wc * 32 + fr, fq * 8);
#define PG8_SA(b, h) (((b) * 2 + (h)) * HTB)
#define PG8_SB(b, h) ((4 + (b) * 2 + (h)) * HTB)
#define PG8_STAGE(bufoff, gbase, voff) do { _Pragma("unroll") for (int _i = 0; _i < 2; ++_i) \
        __builtin_amdgcn_global_load_lds((const unsigned*)((const char*)(gbase) + (voff)[_i]), (LAS unsigned*)(lds + (bufoff) + ldsw + _i * 8192), 16, 0, 0); } while (0)
#define PG8_LDA(dst, b, h) do { _Pragma("unroll") for (int m = 0; m < 4; ++m) _Pragma("unroll") for (int k = 0; k < 2; ++k) dst[m][k] = *(const LAS bf16x8*)(lds + PG8_SA(b, h) + aoff + m * 2048 + k * 1024); } while (0)
#define PG8_LDB(dst, b, h) do { _Pragma("unroll") for (int n = 0; n < 2; ++n) _Pragma("unroll") for (int k = 0; k < 2; ++k) dst[n][k] = *(const LAS bf16x8*)(lds + PG8_SB(b, h) + boff + n * 2048 + k * 1024); } while (0)
#define PG8_MMA(ai, bj, At, Bt) do { __builtin_amdgcn_s_setprio(1); _Pragma("unroll") for (int m = 0; m < 4; ++m) _Pragma("unroll") for (int n = 0; n < 2; ++n) _Pragma("unroll") for (int k = 0; k < 2; ++k) \
        acc[ai][bj][m][n] = __builtin_amdgcn_mfma_f32_16x16x32_bf16(Bt[n][k], At[m][k], acc[ai][bj][m][n], 0, 0, 0); __builtin_amdgcn_s_setprio(0); } while (0)
#define PG8_WAIT_V(n) asm volatile("s_waitcnt vmcnt(" #n ")" ::: "memory")
#define PG8_WAIT_L(n) asm volatile("s_waitcnt lgkmcnt(" #n ")" ::: "memory")
#define PG8_BAR __builtin_amdgcn_s_barrier()
#define PG8_SCHED __builtin_amdgcn_sched_barrier(0)
    Unit cur, nxt; int ui = 0;
    if (!S.next(0, cur)) return;
    f32x4 acc[2][2][4][2];
#pragma unroll
    for (int a = 0; a < 2; ++a)
#pragma unroll
        for (int b = 0; b < 2; ++b)
#pragma unroll
            for (int m = 0; m < 4; ++m)
#pragma unroll
                for (int n = 0; n < 2; ++n) acc[a][b][m][n] = (f32x4){0.f, 0.f, 0.f, 0.f};
    bf16x8 At[4][2], B0[2][2], B1[2][2];
    const char* cA = (const char*)g.A + (size_t)cur.pm * tstepA; const char* cB = (const char*)g.Bt + (size_t)cur.bt * tstepB;
    PG8_STAGE(PG8_SB(0, 0), cB, voffB); PG8_STAGE(PG8_SB(0, 1), cB + hstepB, voffB); PG8_STAGE(PG8_SA(0, 0), cA, voffA); PG8_STAGE(PG8_SA(0, 1), cA + hstepA, voffA);
    if (wr == 1) PG8_BAR;
    PG8_WAIT_V(2); PG8_BAR;
    PG8_STAGE(PG8_SB(1, 0), cB + kstep, voffB); PG8_STAGE(PG8_SA(1, 0), cA + kstep, voffA); PG8_STAGE(PG8_SB(1, 1), cB + hstepB + kstep, voffB);
    PG8_WAIT_V(6); PG8_BAR;
    for (;;) {
        const bool has_next = S.next(ui + 1, nxt);
        const char* nA = has_next ? (const char*)g.A + (size_t)nxt.pm * tstepA : cA; const char* nB = has_next ? (const char*)g.Bt + (size_t)nxt.bt * tstepB : cB;
        for (int t = 0; t < nt; t += 2) {
            const bool last = (t == nt - 2);
            const char* a1 = cA + (size_t)(t + 1) * kstep;
            const char* a2 = last ? nA : cA + (size_t)(t + 2) * kstep; const char* b2 = last ? nB : cB + (size_t)(t + 2) * kstep;
            const char* a3 = a2 + kstep; const char* b3 = b2 + kstep;
            if constexpr (Epi::MID_T > 0) { if (t == Epi::MID_T) E.mid(acc, cur, wr, wc, fr, fq); }
            PG8_LDB(B0, 0, 0); PG8_LDB(B1, 0, 1); PG8_SCHED; PG8_LDA(At, 0, 0); PG8_STAGE(PG8_SA(1, 1), a1 + hstepA, voffA);
            PG8_WAIT_V(8); PG8_WAIT_L(0); PG8_BAR; PG8_MMA(0, 0, At, B0); PG8_MMA(0, 1, At, B1); PG8_BAR; PG8_SCHED;
            PG8_LDA(At, 0, 1); PG8_STAGE(PG8_SB(0, 0), b2, voffB); PG8_STAGE(PG8_SB(0, 1), b2 + hstepB, voffB); PG8_STAGE(PG8_SA(0, 0), a2, voffA);
            PG8_WAIT_V(8); PG8_WAIT_L(0); PG8_BAR; PG8_MMA(1, 0, At, B0); PG8_MMA(1, 1, At, B1); PG8_BAR; PG8_SCHED;
            PG8_LDB(B0, 1, 0); PG8_LDB(B1, 1, 1); PG8_SCHED; PG8_LDA(At, 1, 0); PG8_STAGE(PG8_SA(0, 1), a2 + hstepA, voffA);
            PG8_WAIT_V(8); PG8_WAIT_L(0); PG8_BAR; PG8_MMA(0, 0, At, B0); PG8_MMA(0, 1, At, B1); PG8_BAR; PG8_SCHED;
            PG8_LDA(At, 1, 1); PG8_STAGE(PG8_SB(1, 0), b3, voffB); PG8_STAGE(PG8_SB(1, 1), b3 + hstepB, voffB); PG8_STAGE(PG8_SA(1, 0), a3, voffA);
            PG8_WAIT_V(8); PG8_WAIT_L(0); PG8_BAR; PG8_MMA(1, 0, At, B0); PG8_MMA(1, 1, At, B1); PG8_BAR; PG8_SCHED;
        }
        if constexpr (ALIGN_EPI) { if (wr == 0) PG8_BAR; }
        E(acc, cur, wr, wc, fr, fq);
        if (!has_next) break;
#pragma unroll
        for (int a = 0; a < 2; ++a)
#pragma unroll
            for (int b = 0; b < 2; ++b)
#pragma unroll
                for (int m = 0; m < 4; ++m)
#pragma unroll
                    for (int n = 0; n < 2; ++n) acc[a][b][m][n] = (f32x4){0.f, 0.f, 0.f, 0.f};
        cur = nxt; cA = nA; cB = nB; ++ui;
        if constexpr (ALIGN_EPI) { if (wr == 1) PG8_BAR; }
    }
    PG8_WAIT_V(0);
    if constexpr (!ALIGN_EPI) { if (wr == 0) PG8_BAR; }
    PG8_BAR;
#undef PG8_SA
#undef PG8_SB
#undef PG8_STAGE
#undef PG8_LDA
#undef PG8_LDB
#undef PG8_MMA
#undef PG8_WAIT_V
#undef PG8_WAIT_L
#undef PG8_BAR
#undef PG8_SCHED
}

typedef f32x4 Acc[2][2][4][2];

struct Epi1 {
    static constexpr bool PERM = true; static constexpr int MID_T = 0;
    bf16_t *yab, *gv, *q, *k, *v, *sa, *sb; float* gvst;
    template <int MODE  >
    __device__ __forceinline__ void run(const Acc& acc, const Unit& u, int wr, int wc, int fr, int fq, bf16_t* base, int ld) const {
        const int row0 = u.pm * BM + wr * 64 + fr, col0 = (u.pn & 3) * 256 + wc * 32 + 8 * fq;
#pragma unroll
        for (int ai = 0; ai < 2; ++ai)
#pragma unroll
            for (int m = 0; m < 4; ++m) {
                const int row = row0 + ai * HALF + m * 16; bf16_t* rowp = base + (size_t)row * ld + col0;
                float s1 = 0.f, s2 = 0.f;
#pragma unroll
                for (int bj = 0; bj < 2; ++bj) {
                    f32x4 v0 = acc[ai][bj][m][0], v1 = acc[ai][bj][m][1];
                    if (MODE == 0 || MODE == 1) {
                        f32x2 a = gelu_pk((f32x2){v0[0], v0[1]}), b = gelu_pk((f32x2){v0[2], v0[3]}), c = gelu_pk((f32x2){v1[0], v1[1]}), d = gelu_pk((f32x2){v1[2], v1[3]});
                        v0 = (f32x4){a.x, a.y, b.x, b.y}; v1 = (f32x4){c.x, c.y, d.x, d.y};
                    } else if (MODE == 2) { v0 = v0 * QSCALE; v1 = v1 * QSCALE; }
                    else if (MODE == 4) {
#pragma unroll
                        for (int j = 0; j < 4; ++j) { v0[j] = sigmoidf_(v0[j]); v1[j] = sigmoidf_(v1[j]); }
                    }
                    if (MODE == 1) {
                        s1 += (v0[0] + v0[1]) + (v0[2] + v0[3]) + (v1[0] + v1[1]) + (v1[2] + v1[3]);
                        s2 += (v0[0] * v0[0] + v0[1] * v0[1]) + (v0[2] * v0[2] + v0[3] * v0[3]) + (v1[0] * v1[0] + v1[1] * v1[1]) + (v1[2] * v1[2] + v1[3] * v1[3]);
                    }
                    u32x4 w; w.x = cvt_pk_bf16(v0[0], v0[1]); w.y = cvt_pk_bf16(v0[2], v0[3]); w.z = cvt_pk_bf16(v1[0], v1[1]); w.w = cvt_pk_bf16(v1[2], v1[3]);
                    *(u32x4*)(rowp + bj * HALF) = w;
                }
                if (MODE == 1) {
                    s1 += __shfl_xor(s1, 16); s1 += __shfl_xor(s1, 32); s2 += __shfl_xor(s2, 16); s2 += __shfl_xor(s2, 32);
                    if (fq == 0) *(f32x2*)(gvst + ((size_t)row * 16 + (u.pn & 3) * 4 + wc) * 2) = (f32x2){s1, s2};
                }
            }
    }
    __device__ __forceinline__ void operator()(const Acc& acc, const Unit& u, int wr, int wc, int fr, int fq) const {
        const int region = u.pn >> 2;
        if (region == 0) run<0>(acc, u, wr, wc, fr, fq, yab, 2048);
        else if (region == 1) run<1>(acc, u, wr, wc, fr, fq, gv, 1024);
        else if (region == 2) run<2>(acc, u, wr, wc, fr, fq, q, 1024);
        else if (region == 3) run<3>(acc, u, wr, wc, fr, fq, k, 1024);
        else if (region == 4) run<3>(acc, u, wr, wc, fr, fq, v, 1024);
        else if (region == 5) run<4>(acc, u, wr, wc, fr, fq, sa, 1024);
        else run<4>(acc, u, wr, wc, fr, fq, sb, 1024);
    }
    __device__ __forceinline__ void mid(Acc&, const Unit&, int, int, int, int) const {}
};

struct Epi2 {
    static constexpr bool PERM = true; static constexpr int MID_T = 16;
    const bf16_t *sa, *sb; bf16_t* mg;
    __device__ __forceinline__ void mid(Acc& acc, const Unit& u, int wr, int wc, int fr, int fq) const {
        int row0 = u.pm * BM + wr * 64 + fr, col0 = u.pn * BM + wc * 32 + 8 * fq;
        asm volatile("" : "+v"(row0), "+v"(col0));
#pragma unroll
        for (int ai = 0; ai < 2; ++ai)
#pragma unroll
            for (int m = 0; m < 4; ++m) {
                const size_t off = (size_t)(row0 + ai * HALF + m * 16) * DM + col0;
#pragma unroll
                for (int bj = 0; bj < 2; ++bj) {
                    const u32x4 a = *(const u32x4*)(sa + off + bj * HALF), b = *(const u32x4*)(sb + off + bj * HALF);
                    f32x4 r0, r1;
#define RQ(x, y) ((x) * __builtin_amdgcn_rcpf(y))
                    r0[0] = RQ(bflo(a.x), bflo(b.x)); r0[1] = RQ(bfhi(a.x), bfhi(b.x)); r0[2] = RQ(bflo(a.y), bflo(b.y)); r0[3] = RQ(bfhi(a.y), bfhi(b.y));
                    r1[0] = RQ(bflo(a.z), bflo(b.z)); r1[1] = RQ(bfhi(a.z), bfhi(b.z)); r1[2] = RQ(bflo(a.w), bflo(b.w)); r1[3] = RQ(bfhi(a.w), bfhi(b.w));
#undef RQ
                    acc[ai][bj][m][0] = acc[ai][bj][m][0] * r0; acc[ai][bj][m][1] = acc[ai][bj][m][1] * r1;
                }
                asm volatile("" : "+v"(acc[ai][0][m][0]), "+v"(acc[ai][0][m][1]), "+v"(acc[ai][1][m][0]), "+v"(acc[ai][1][m][1]));
                asm volatile("" ::: "memory");
            }
    }
    __device__ __forceinline__ void operator()(const Acc& acc, const Unit& u, int wr, int wc, int fr, int fq) const {
        const int row0 = u.pm * BM + wr * 64 + fr, col0 = u.pn * BM + wc * 32 + 8 * fq;
#pragma unroll
        for (int ai = 0; ai < 2; ++ai)
#pragma unroll
            for (int m = 0; m < 4; ++m) {
                const size_t off = (size_t)(row0 + ai * HALF + m * 16) * DM + col0;
#pragma unroll
                for (int bj = 0; bj < 2; ++bj) {
                    const u32x4 b = *(const u32x4*)(sb + off + bj * HALF);
                    const f32x4 v0 = acc[ai][bj][m][0], v1 = acc[ai][bj][m][1];
                    u32x4 w; w.x = cvt_pk_bf16(v0[0] * bflo(b.x), v0[1] * bfhi(b.x)); w.y = cvt_pk_bf16(v0[2] * bflo(b.y), v0[3] * bfhi(b.y));
                    w.z = cvt_pk_bf16(v1[0] * bflo(b.z), v1[1] * bfhi(b.z)); w.w = cvt_pk_bf16(v1[2] * bflo(b.w), v1[3] * bfhi(b.w));
                    *(u32x4*)(mg + off + bj * HALF) = w;
                }
            }
    }
};

struct Epi3 {
    static constexpr bool PERM = false; static constexpr int MID_T = 0;
    const bf16_t* h0; float* z; float* zst;
    __device__ __forceinline__ void mid(Acc&, const Unit&, int, int, int, int) const {}
    __device__ __forceinline__ void operator()(const Acc& acc, const Unit& u, int wr, int wc, int fr, int fq) const {
        const int row0 = u.pm * BM + wr * 64 + fr, col0 = u.pn * BM + wc * 32 + 4 * fq;
#pragma unroll
        for (int ai = 0; ai < 2; ++ai)
#pragma unroll
            for (int m = 0; m < 4; ++m) {
                const int row = row0 + ai * HALF + m * 16; const size_t off = (size_t)row * DM + col0;
                float s1 = 0.f, s2 = 0.f;
#pragma unroll
                for (int bj = 0; bj < 2; ++bj)
#pragma unroll
                    for (int n = 0; n < 2; ++n) {
                        const u32x2 hb = *(const u32x2*)(h0 + off + bj * HALF + n * 16);
                        f32x4 v = acc[ai][bj][m][n];
                        v[0] += ALPHA * bflo(hb.x); v[1] += ALPHA * bfhi(hb.x); v[2] += ALPHA * bflo(hb.y); v[3] += ALPHA * bfhi(hb.y);
                        s1 += (v[0] + v[1]) + (v[2] + v[3]); s2 += (v[0] * v[0] + v[1] * v[1]) + (v[2] * v[2] + v[3] * v[3]);
                        *(f32x4*)(z + off + bj * HALF + n * 16) = v;
                    }
                s1 += __shfl_xor(s1, 16); s1 += __shfl_xor(s1, 32); s2 += __shfl_xor(s2, 16); s2 += __shfl_xor(s2, 32);
                if (fq == 0) *(f32x2*)(zst + ((size_t)row * 16 + u.pn * 4 + wc) * 2) = (f32x2){s1, s2};
            }
    }
};

struct Epi4 {
    static constexpr bool PERM = true; static constexpr int MID_T = 0;
    const float* b_up; bf16_t* act;
    __device__ __forceinline__ void mid(Acc&, const Unit&, int, int, int, int) const {}
    __device__ __forceinline__ void operator()(const Acc& acc, const Unit& u, int wr, int wc, int fr, int fq) const {
        const int e = u.bt >> 3;
        const int row0 = u.pm * BM + wr * 64 + fr, c0 = u.pn * HALF + wc * 32 + 8 * fq;
        const float* bg = b_up + (size_t)e * 2 * FF + c0; const float* bu = bg + FF;
        const f32x4 bg0 = *(const f32x4*)bg, bg1 = *(const f32x4*)(bg + 4), bu0 = *(const f32x4*)bu, bu1 = *(const f32x4*)(bu + 4);
#pragma unroll
        for (int ai = 0; ai < 2; ++ai)
#pragma unroll
            for (int m = 0; m < 4; ++m) {
                const int row = row0 + ai * HALF + m * 16;
                float o[8];
#pragma unroll
                for (int n = 0; n < 2; ++n)
#pragma unroll
                    for (int j = 0; j < 4; ++j) {
                        float gg = acc[ai][0][m][n][j] + (n ? bg1[j] : bg0[j]), uu = acc[ai][1][m][n][j] + (n ? bu1[j] : bu0[j]);
                        gg = fminf(gg, 7.0f); uu = fminf(fmaxf(uu, -7.0f), 7.0f);
                        o[n * 4 + j] = (uu + 1.0f) * (gg * sigmoidf_(1.702f * gg));
                    }
                u32x4 w; w.x = cvt_pk_bf16(o[0], o[1]); w.y = cvt_pk_bf16(o[2], o[3]); w.z = cvt_pk_bf16(o[4], o[5]); w.w = cvt_pk_bf16(o[6], o[7]);
                *(u32x4*)(act + (size_t)row * FF + c0) = w;
            }
    }
};

struct Epi5 {
    static constexpr bool PERM = true; static constexpr int MID_T = 0;
    const float* b_down; const float* roww; bf16_t* ys;
    __device__ __forceinline__ void mid(Acc&, const Unit&, int, int, int, int) const {}
    __device__ __forceinline__ void operator()(const Acc& acc, const Unit& u, int wr, int wc, int fr, int fq) const {
        const int e = u.bt >> 2;
        const int row0 = u.pm * BM + wr * 64 + fr, col0 = u.pn * BM + wc * 32 + 8 * fq;
        f32x4 bv[2][2];
#pragma unroll
        for (int bj = 0; bj < 2; ++bj)
#pragma unroll
            for (int n = 0; n < 2; ++n) bv[bj][n] = *(const f32x4*)(b_down + (size_t)e * DM + col0 + bj * HALF + 4 * n);
#pragma unroll
        for (int ai = 0; ai < 2; ++ai)
#pragma unroll
            for (int m = 0; m < 4; ++m) {
                const int row = row0 + ai * HALF + m * 16; const float rw = roww[row];
#pragma unroll
                for (int bj = 0; bj < 2; ++bj) {
                    const f32x4 v0 = (acc[ai][bj][m][0] + bv[bj][0]) * rw, v1 = (acc[ai][bj][m][1] + bv[bj][1]) * rw;
                    u32x4 w; w.x = cvt_pk_bf16(v0[0], v0[1]); w.y = cvt_pk_bf16(v0[2], v0[3]); w.z = cvt_pk_bf16(v1[0], v1[1]); w.w = cvt_pk_bf16(v1[2], v1[3]);
                    *(u32x4*)(ys + (size_t)row * DM + col0 + bj * HALF) = w;
                }
            }
    }
};
}

struct Args { const float* in[21]; float* out; unsigned char* ws; int ph_lo, ph_hi; };
enum { I_X = 0, I_LNIN_G, I_LNIN_B, I_WIN, I_GLN_G, I_GLN_B, I_WSP, I_BSP, I_WBA, I_WBB, I_WOUT, I_LNMIX_G, I_LNMIX_B, I_WR, I_BR, I_WUP, I_BUP, I_WDN, I_BDN, I_LNF_G, I_LNF_B };

struct Ctx { const Args* a; unsigned char* ws; LAS unsigned char* lds; unsigned char* ldsg; int tid, lane, wave, G, vcu; };

__device__ __forceinline__ void tr_item(const float* W, int N, int k0, int n0, bf16_t* dst, int drow0, int dld, int dcol0, LAS float* scr, int lane) {
#pragma unroll 8
    for (int i = 0; i < 32; ++i) { const int kk = 2 * i + (lane >> 5); scr[kk * 33 + (lane & 31)] = W[(size_t)(k0 + kk) * N + n0 + (lane & 31)]; }
    asm volatile("s_waitcnt lgkmcnt(0)" ::: "memory");
    const int c = lane & 7;
#pragma unroll
    for (int j = 0; j < 4; ++j) { const int n = (lane >> 3) + 8 * j; const LAS float* s = scr + (8 * c) * 33 + n;
        u32x4 o; o.x = pk2(s[0 * 33], s[1 * 33]); o.y = pk2(s[2 * 33], s[3 * 33]); o.z = pk2(s[4 * 33], s[5 * 33]); o.w = pk2(s[6 * 33], s[7 * 33]);
        *(u32x4*)(dst + (size_t)(drow0 + n) * dld + dcol0 + k0 + 8 * c) = o; }
    asm volatile("s_waitcnt lgkmcnt(0)" ::: "memory");
}
__device__ __forceinline__ void ph_prologue(const Ctx& F) {
    const Args& A = *F.a;
    LAS float* scr = (LAS float*)(F.lds + F.wave * 16384);
    const int gw = F.vcu * 8 + F.wave, NGW = F.G * 8;
    bf16_t* WIN = (bf16_t*)(F.ws + WS_WIN); bf16_t* WAB = (bf16_t*)(F.ws + WS_WAB); bf16_t* WOUT = (bf16_t*)(F.ws + WS_WOUT);
    bf16_t* WDN = (bf16_t*)(F.ws + WS_WDN); bf16_t* WUP = (bf16_t*)(F.ws + WS_WUP);
    constexpr int I_IN = 16 * (INCOLS / 32), I_SQ = 16 * 32, I_UP = NE * 16 * 64, I_DN = NE * 16 * 32;
    constexpr int NITEMS = I_IN + 3 * I_SQ + I_UP + I_DN;
    for (int it = gw; it < NITEMS; it += NGW) {
        int r = it;
        if (r < I_IN) { const int nblk = INCOLS / 32, kb = r / nblk, nb = r % nblk; tr_item(A.in[I_WIN], INCOLS, 64 * kb, 32 * nb, WIN, 32 * nb, DM, 0, scr, F.lane); continue; } r -= I_IN;
        if (r < I_SQ) { const int kb = r / 32, nb = r % 32; tr_item(A.in[I_WBA], DM, 64 * kb, 32 * nb, WAB, 32 * nb, 2048, 0, scr, F.lane); continue; } r -= I_SQ;
        if (r < I_SQ) { const int kb = r / 32, nb = r % 32; tr_item(A.in[I_WBB], DM, 64 * kb, 32 * nb, WAB, 32 * nb, 2048, 1024, scr, F.lane); continue; } r -= I_SQ;
        if (r < I_SQ) { const int kb = r / 32, nb = r % 32; tr_item(A.in[I_WOUT], DM, 64 * kb, 32 * nb, WOUT, 32 * nb, DM, 0, scr, F.lane); continue; } r -= I_SQ;
        if (r < I_UP) { const int e = r / (16 * 64), rr = r % (16 * 64), kb = rr / 64, nb = rr % 64; const int n0 = 32 * nb, half = n0 >= FF, rem = n0 - half * FF, pn = rem >> 7, b = (rem & 127) >> 5;
            tr_item(A.in[I_WUP] + (size_t)e * DM * 2 * FF, 2 * FF, 64 * kb, n0, WUP, e * 2048 + 256 * pn + half * 128 + 32 * b, DM, 0, scr, F.lane); continue; } r -= I_UP;
        { const int e = r / (16 * 32), rr = r % (16 * 32), kb = rr / 32, nb = rr % 32; tr_item(A.in[I_WDN] + (size_t)e * FF * DM, DM, 64 * kb, 32 * nb, WDN, e * 1024 + 32 * nb, FF, 0, scr, F.lane); }
    }
    const float* lg = A.in[I_LNIN_G]; const float* lb = A.in[I_LNIN_B]; bf16_t* H0 = (bf16_t*)(F.ws + WS_H0);
    f32x4 gg[4], bb[4];
#pragma unroll
    for (int j = 0; j < 4; ++j) { gg[j] = *((const f32x4*)lg + F.lane + 64 * j); bb[j] = *((const f32x4*)lb + F.lane + 64 * j); }
    for (int m = gw; m < T; m += NGW) {
        const f32x4* xr = (const f32x4*)(A.in[I_X] + (size_t)m * DM) + F.lane;
        f32x4 v[4]; float s = 0.f;
#pragma unroll
        for (int j = 0; j < 4; ++j) { v[j] = xr[64 * j]; s += (v[j].x + v[j].y) + (v[j].z + v[j].w); }
        const float mean = wave_sum(s) * (1.f / DM); float s2 = 0.f;
#pragma unroll
        for (int j = 0; j < 4; ++j) { v[j] = v[j] - mean; s2 += (v[j].x * v[j].x + v[j].y * v[j].y) + (v[j].z * v[j].z + v[j].w * v[j].w); }
        const float rstd = 1.f / sqrtf(wave_sum(s2) * (1.f / DM) + LN_EPS);
        u32x2* o8 = (u32x2*)(H0 + (size_t)m * DM) + F.lane;
#pragma unroll
        for (int j = 0; j < 4; ++j) { const f32x4 y = v[j] * rstd * gg[j] + bb[j]; o8[64 * j] = (u32x2){pk2(y.x, y.y), pk2(y.z, y.w)}; }
    }
}

__device__ __forceinline__ void ph_kmean(const Ctx& F) {
    const bf16_t* K = (const bf16_t*)(F.ws + WS_K); float* KM = (float*)(F.ws + WS_KMEAN);
    float* red = (float*)F.ldsg;
    const int d = F.tid & 127, part = F.tid >> 7;
    for (int it = F.vcu; it < NB * NH * NBLK; it += F.G) {
        const int b = it / (NH * NBLK), h = (it / NBLK) % NH, j = it % NBLK;
        const bf16_t* kp = K + ((size_t)(b * SEQ + j * LBLK + part * 64)) * DM + h * DH + d;
        float s = 0.f;
        for (int r = 0; r < 64; ++r) s += bf2f(kp[(size_t)r * DM]);
        red[part * 128 + d] = s;
        __syncthreads();
        if (F.tid < 128) KM[(size_t)it * DH + d] = (red[d] + red[128 + d] + red[256 + d] + red[384 + d]) * (1.0f / LBLK);
        __syncthreads();
    }
}
typedef short v4i16_t __attribute__((ext_vector_type(4)));
__device__ __forceinline__ v4i16_t lds_tr16(LAS const unsigned char* p) { return __builtin_amdgcn_ds_read_tr16_b64_v4i16((LAS v4i16_t*)p); }
__device__ __forceinline__ void ph_mixer_a(const Ctx& F) {
    const Args& A = *F.a;
    const bf16_t* GV = (const bf16_t*)(F.ws + WS_GV); bf16_t* YAB = (bf16_t*)(F.ws + WS_YAB); const float* GVST = (const float*)(F.ws + WS_GVST);
    const float* lg = A.in[I_GLN_G]; const float* lb = A.in[I_GLN_B]; const float* wsp = A.in[I_WSP]; const float* bsp = A.in[I_BSP];
    constexpr int RSV = 544, RSW = 272, OFF_W = 128 * RSV, OFF_ST = OFF_W + 128 * RSW;
    LAS unsigned char* VT = F.lds; LAS unsigned char* WT = F.lds + OFF_W; LAS float* ST = (LAS float*)(F.lds + OFF_ST);
    const int lane = F.lane, wv = F.wave;
    int curg = -1;
    for (int it = F.vcu; it < NB * 32 * 4; it += F.G) {
        const int b = it / 128, c = (it >> 2) & 31, g = it & 3;
        const int tok0 = b * SEQ + c * 128;
        if (g != curg) {
            curg = g;
            for (int k = 0; k < 4; ++k) {
                const int idx = F.tid + 512 * k, t = idx >> 4, s8 = (idx & 15) * 8;
                const f32x4 w0 = *(const f32x4*)(wsp + ((size_t)g * 128 + t) * 128 + s8), w1 = *(const f32x4*)(wsp + ((size_t)g * 128 + t) * 128 + s8 + 4);
                float x[8] = {w0.x, w0.y, w0.z, w0.w, w1.x, w1.y, w1.z, w1.w};
#pragma unroll
                for (int j = 0; j < 8; ++j) x[j] = (s8 + j <= t) ? x[j] : 0.f;
                u32x4 o; o.x = pk2(x[0], x[1]); o.y = pk2(x[2], x[3]); o.z = pk2(x[4], x[5]); o.w = pk2(x[6], x[7]);
                *(LAS u32x4*)(WT + t * RSW + s8 * 2) = o;
            }
        }
        if (F.tid < 128) {
            const float* p = GVST + (size_t)(tok0 + F.tid) * 32; float s1 = 0.f, s2 = 0.f;
            for (int i = 0; i < 16; ++i) { s1 += p[2 * i]; s2 += p[2 * i + 1]; }
            const float mean = s1 * (1.f / DM), var = s2 * (1.f / DM) - mean * mean;
            ST[2 * F.tid] = mean; ST[2 * F.tid + 1] = 1.f / sqrtf(fmaxf(var, 0.f) + LN_EPS);
        }
        __syncthreads();
        {
            const int dc = F.tid & 31;
            const f32x4 g0 = *(const f32x4*)(lg + g * 256 + dc * 8), g1 = *(const f32x4*)(lg + g * 256 + dc * 8 + 4), b0 = *(const f32x4*)(lb + g * 256 + dc * 8), b1 = *(const f32x4*)(lb + g * 256 + dc * 8 + 4);
#pragma unroll
            for (int k = 0; k < 8; ++k) {
                const int s = (F.tid >> 5) + 16 * k;
                const u32x4 raw = *(const u32x4*)(GV + (size_t)(tok0 + s) * DM + g * 256 + dc * 8);
                const float mean = ST[2 * s], rstd = ST[2 * s + 1];
                f32x4 x0 = {bflo(raw.x), bfhi(raw.x), bflo(raw.y), bfhi(raw.y)}, x1 = {bflo(raw.z), bfhi(raw.z), bflo(raw.w), bfhi(raw.w)};
                x0 = (x0 - mean) * rstd * g0 + b0; x1 = (x1 - mean) * rstd * g1 + b1;
                u32x4 o; o.x = pk2(x0.x, x0.y); o.y = pk2(x0.z, x0.w); o.z = pk2(x1.x, x1.y); o.w = pk2(x1.z, x1.w);
                *(LAS u32x4*)(VT + s * RSV + dc * 16) = o;
            }
        }
        __syncthreads();
        {
            const int dbase = 32 * wv, kg = lane >> 4, q = (lane & 15) >> 2, p = lane & 3, fr = lane & 15;
            bf16x8 Af[2][4];
#pragma unroll
            for (int m = 0; m < 2; ++m)
#pragma unroll
                for (int kk = 0; kk < 4; ++kk) {
                    LAS const unsigned char* ap = VT + (32 * kk + 8 * kg + q) * RSV + (dbase + 16 * m + 4 * p) * 2;
                    const v4i16_t lo = lds_tr16(ap), hi = lds_tr16(ap + 4 * RSV);
                    Af[m][kk] = (bf16x8){lo[0], lo[1], lo[2], lo[3], hi[0], hi[1], hi[2], hi[3]};
                }
#pragma unroll
            for (int n = 0; n < 8; ++n) {
                f32x4 acc0 = {0.f, 0.f, 0.f, 0.f}, acc1 = {0.f, 0.f, 0.f, 0.f};
#pragma unroll
                for (int kk = 0; kk < 4; ++kk) if (kk <= (n >> 1)) {
                    const bf16x8 Bf = *(LAS const bf16x8*)(WT + (16 * n + fr) * RSW + (32 * kk + 8 * kg) * 2);
                    acc0 = __builtin_amdgcn_mfma_f32_16x16x32_bf16(Af[0][kk], Bf, acc0, 0, 0, 0);
                    acc1 = __builtin_amdgcn_mfma_f32_16x16x32_bf16(Af[1][kk], Bf, acc1, 0, 0, 0);
                }
                const int t = 16 * n + fr; const float bsv = bsp[g * 128 + t];
                bf16_t* yp = YAB + (size_t)(tok0 + t) * 2048 + g * 256 + dbase + 4 * kg;
                const u32x2 u0 = *(const u32x2*)yp, u1 = *(const u32x2*)(yp + 16);
                u32x2 o0, o1;
                o0.x = pk2(bflo(u0.x) * (acc0[0] + bsv), bfhi(u0.x) * (acc0[1] + bsv)); o0.y = pk2(bflo(u0.y) * (acc0[2] + bsv), bfhi(u0.y) * (acc0[3] + bsv));
                o1.x = pk2(bflo(u1.x) * (acc1[0] + bsv), bfhi(u1.x) * (acc1[1] + bsv)); o1.y = pk2(bflo(u1.y) * (acc1[2] + bsv), bfhi(u1.y) * (acc1[3] + bsv));
                *(u32x2*)yp = o0; *(u32x2*)(yp + 16) = o1;
            }
        }
        __syncthreads();
    }
}

__device__ __forceinline__ void ph_gate(const Ctx& F) {
    const bf16_t* Q = (const bf16_t*)(F.ws + WS_Q); const float* KM = (const float*)(F.ws + WS_KMEAN);
    unsigned* SEL = (unsigned*)(F.ws + WS_SEL); unsigned* LISTS = (unsigned*)(F.ws + WS_LISTS); unsigned* LCNT = (unsigned*)(F.ws + WS_CTL) + CW_LCNT;
    float* km = (float*)F.ldsg;
    unsigned* lc = (unsigned*)(F.ldsg + 8192);
    for (int it = F.vcu; it < NB * NH * 8; it += F.G) {
        const int b = it / 64, h = (it >> 3) & 7, tc = it & 7;
        for (int i = F.tid; i < NBLK * DH; i += 512) km[i] = KM[(size_t)(b * NH + h) * NBLK * DH + i];
        if (F.tid < 32) lc[F.tid] = 0u;
        __syncthreads();
        const int t = tc * 512 + F.tid, qi = t >> 8;
        float gsc[15];
#pragma unroll
        for (int j = 0; j < 15; ++j) gsc[j] = 0.f;
        const bf16_t* qp = Q + (size_t)(b * SEQ + t) * DM + h * DH;
        for (int c = 0; c < 16; ++c) {
            const u32x4 raw = *(const u32x4*)(qp + c * 8);
            const float x[8] = {bflo(raw.x), bfhi(raw.x), bflo(raw.y), bfhi(raw.y), bflo(raw.z), bfhi(raw.z), bflo(raw.w), bfhi(raw.w)};
#pragma unroll
            for (int j = 0; j < 15; ++j) if (j < qi) {
                const float* kk = km + j * DH + c * 8;
#pragma unroll
                for (int e = 0; e < 8; ++e) gsc[j] += x[e] * kk[e];
            }
        }
        const int nsel = qi < 3 ? qi : 3;
        int sel[3] = {0, 0, 0}; unsigned lpos[3] = {0, 0, 0};
#pragma unroll
        for (int r = 0; r < 3; ++r) {
            float best = -INFINITY; int bi = -1;
#pragma unroll
            for (int j = 0; j < 15; ++j) { const bool c = (j < qi) && (gsc[j] > best); best = c ? gsc[j] : best; bi = c ? j : bi; }
#pragma unroll
            for (int j = 0; j < 15; ++j) if (j == bi) gsc[j] = -INFINITY;
            sel[r] = bi < 0 ? 0 : bi;
            if (r < nsel) lpos[r] = atomicAdd(&lc[sel[r]], 1u);
        }
        SEL[(size_t)(b * SEQ + t) * NH + h] = (unsigned)sel[0] | ((unsigned)sel[1] << 8) | ((unsigned)sel[2] << 16) | ((unsigned)nsel << 24);
        __syncthreads();
        if (F.tid < 16) lc[16 + F.tid] = lc[F.tid] ? atomicAdd(&LCNT[(b * NH + h) * NBLK + F.tid], lc[F.tid]) : 0u;
        __syncthreads();
#pragma unroll
        for (int r = 0; r < 3; ++r) if (r < nsel) LISTS[(size_t)((b * NH + h) * NBLK + sel[r]) * 4096 + lc[16 + sel[r]] + lpos[r]] = (unsigned)t | ((unsigned)r << 12);
        __syncthreads();
    }
}

__device__ __forceinline__ void ph_attn_naive(const Ctx& F) {
    const bf16_t* Q = (const bf16_t*)(F.ws + WS_Q); const bf16_t* K = (const bf16_t*)(F.ws + WS_K); const bf16_t* V = (const bf16_t*)(F.ws + WS_V);
    const unsigned* SEL = (const unsigned*)(F.ws + WS_SEL); bf16_t* YAB = (bf16_t*)(F.ws + WS_YAB);
    float* qs = (float*)(F.ldsg + F.wave * 4608);
    float* sc = qs + 128;
    const int gw = F.vcu * 8 + F.wave, NGW = F.G * 8;
    for (int w = gw; w < NB * NH * SEQ; w += NGW) {
        const int b = w / (NH * SEQ), h = (w / SEQ) % NH, t = w % SEQ, qi = t >> 8, tl = t & 255;
        const size_t tok = (size_t)b * SEQ + t;
        { const unsigned qq = *(const unsigned*)(Q + tok * DM + h * DH + 2 * F.lane); qs[2 * F.lane] = bflo(qq); qs[2 * F.lane + 1] = bfhi(qq); }
        const unsigned selw = SEL[tok * NH + h]; const int nsel = selw >> 24;
        float mx = -INFINITY;
        for (int r = 0; r <= nsel; ++r) {
            const int jb = (r < nsel) ? (int)((selw >> (8 * r)) & 0xff) : qi;
            for (int c = 0; c < 4; ++c) {
                const int key = c * 64 + F.lane;
                const bool valid = (r < nsel) || (key <= tl);
                const bf16_t* kp = K + ((size_t)b * SEQ + jb * LBLK + key) * DM + h * DH;
                float s = 0.f;
#pragma unroll 4
                for (int dd = 0; dd < 16; ++dd) {
                    const u32x4 raw = *(const u32x4*)(kp + dd * 8);
                    const float* q8 = qs + dd * 8;
                    s += bflo(raw.x) * q8[0] + bfhi(raw.x) * q8[1] + bflo(raw.y) * q8[2] + bfhi(raw.y) * q8[3] + bflo(raw.z) * q8[4] + bfhi(raw.z) * q8[5] + bflo(raw.w) * q8[6] + bfhi(raw.w) * q8[7];
                }
                s = valid ? s : -INFINITY;
                sc[r * 256 + key] = s; mx = fmaxf(mx, s);
            }
        }
        mx = wave_max(mx);
        float l = 0.f;
        const int ntot = (nsel + 1) * 256;
        for (int i = F.lane; i < ntot; i += 64) { const float p = __builtin_amdgcn_exp2f(sc[i] - mx); sc[i] = p; l += p; }
        l = wave_sum(l);
        float o0 = 0.f, o1 = 0.f;
        for (int r = 0; r <= nsel; ++r) {
            const int jb = (r < nsel) ? (int)((selw >> (8 * r)) & 0xff) : qi;
            const int nk = (r < nsel) ? 256 : tl + 1;
            const bf16_t* vp = V + ((size_t)b * SEQ + jb * LBLK) * DM + h * DH + 2 * F.lane;
#pragma unroll 4
            for (int key = 0; key < nk; ++key) { const unsigned vv = *(const unsigned*)(vp + (size_t)key * DM); const float p = sc[r * 256 + key]; o0 += p * bflo(vv); o1 += p * bfhi(vv); }
        }
        const float il = 1.f / l;
        *(unsigned*)(YAB + tok * 2048 + 1024 + h * DH + 2 * F.lane) = pk2(o0 * il, o1 * il);
    }
}

typedef float f32x16 __attribute__((ext_vector_type(16)));
namespace att {
constexpr int KCH = 4112, VDB = 16448, OFF_K = 0, OFF_V = 16 * KCH, OFF_WS = OFF_V + 4 * VDB  , WSW = 512, OFF_TAB = OFF_WS + 8 * WSW  ;
static_assert(OFF_TAB + 1028 * 4 <= LDS_BYTES, "attention LDS map");
__device__ __forceinline__ int crow(int r, int hi) { return (r & 3) + 8 * (r >> 2) + 4 * hi; }

__device__ __forceinline__ void load_kv(const Ctx& F, const bf16_t* K, const bf16_t* V, size_t tokbase, int h) {
    u32x4 kv[8], vv[8];
#pragma unroll
    for (int k = 0; k < 8; ++k) { const int idx = F.tid + 512 * k, key = idx >> 4, c = idx & 15; const size_t off = (tokbase + key) * DM + h * DH + c * 8;
        kv[k] = *(const u32x4*)(K + off); vv[k] = *(const u32x4*)(V + off); }
#pragma unroll
    for (int k = 0; k < 8; ++k) { const int idx = F.tid + 512 * k, key = idx >> 4, c = idx & 15;
        *(LAS u32x4*)(F.lds + OFF_K + c * KCH + key * 16) = kv[k];
        *(LAS u32x4*)(F.lds + OFF_V + (c >> 2) * VDB + (key >> 3) * 512 + (key & 7) * 64 + (c & 3) * 16) = vv[k]; }
}

template <bool CAUSAL>
__device__ __forceinline__ void core(const Ctx& F, const bf16_t* qrow, f32x16 (&o)[4], float& m, float& l) {
    const int r = F.lane & 31, hh = F.lane >> 5;
    LAS float* wsf = (LAS float*)(F.lds + OFF_WS + F.wave * WSW);
    bf16x8 qr[8];
#pragma unroll
    for (int ds = 0; ds < 8; ++ds) qr[ds] = *(const bf16x8*)(qrow + ds * 16 + hh * 8);
#pragma unroll
    for (int db = 0; db < 4; ++db)
#pragma unroll
        for (int i = 0; i < 16; ++i) o[db][i] = 0.f;
    m = -1e30f; l = 0.f;
    const int nt = CAUSAL ? (F.wave >> 1) + 1 : 4;
    LAS const unsigned char* kbase = F.lds + OFF_K + hh * KCH + r * 16;
    LAS const unsigned char* vbase = F.lds + OFF_V + (4 * hh + ((F.lane & 15) >> 2)) * 64 + ((F.lane >> 4) & 1) * 32 + (F.lane & 3) * 8;
    for (int kt = 0; kt < nt; ++kt) {
        const bool diag = CAUSAL && (kt == nt - 1);
        const bool skip1 = diag && !(F.wave & 1);
        f32x16 p0, p1;
#pragma unroll
        for (int i = 0; i < 16; ++i) { p0[i] = 0.f; p1[i] = 0.f; }
        LAS const unsigned char* kp = kbase + (64 * kt) * 16;
#pragma unroll
        for (int ds = 0; ds < 8; ++ds) { const bf16x8 kf = *(LAS const bf16x8*)(kp + 2 * ds * KCH); p0 = __builtin_amdgcn_mfma_f32_32x32x16_bf16(kf, qr[ds], p0, 0, 0, 0); }
        if (!skip1) {
#pragma unroll
            for (int ds = 0; ds < 8; ++ds) { const bf16x8 kf = *(LAS const bf16x8*)(kp + 2 * ds * KCH + 512); p1 = __builtin_amdgcn_mfma_f32_32x32x16_bf16(kf, qr[ds], p1, 0, 0, 0); }
        }
        if (diag) {
            if (F.wave & 1) {
#pragma unroll
                for (int i = 0; i < 16; ++i) p1[i] = (crow(i, hh) > r) ? -INFINITY : p1[i];
            } else {
#pragma unroll
                for (int i = 0; i < 16; ++i) { p0[i] = (crow(i, hh) > r) ? -INFINITY : p0[i]; p1[i] = -INFINITY; }
            }
        }
        float mx = fmaxf(p0[0], p1[0]);
#pragma unroll
        for (int i = 1; i < 16; ++i) mx = fmaxf(mx, fmaxf(p0[i], p1[i]));
        mx = fmaxf(mx, __shfl_xor(mx, 32));
        const float mnew = fmaxf(m, mx);
        if (__any(mnew > m)) {
            const float alpha = __builtin_amdgcn_exp2f(m - mnew);
            l *= alpha; m = mnew;
            if (hh == 0) wsf[r] = alpha;
            asm volatile("s_waitcnt lgkmcnt(0)" ::: "memory");
#pragma unroll
            for (int i = 0; i < 16; ++i) { const float a = wsf[crow(i, hh)];
#pragma unroll
                for (int db = 0; db < 4; ++db) o[db][i] *= a; }
        }
        float ls = 0.f;
#pragma unroll
        for (int i = 0; i < 16; ++i) { p0[i] = __builtin_amdgcn_exp2f(p0[i] - m); p1[i] = __builtin_amdgcn_exp2f(p1[i] - m); ls += p0[i] + p1[i]; }
        l += ls;
        u32x4 pw[4];
#pragma unroll
        for (int s2 = 0; s2 < 2; ++s2) {
            pw[s2] = (u32x4){cvt_pk_bf16(p0[8 * s2], p0[8 * s2 + 1]), cvt_pk_bf16(p0[8 * s2 + 2], p0[8 * s2 + 3]), cvt_pk_bf16(p0[8 * s2 + 4], p0[8 * s2 + 5]), cvt_pk_bf16(p0[8 * s2 + 6], p0[8 * s2 + 7])};
            pw[2 + s2] = (u32x4){cvt_pk_bf16(p1[8 * s2], p1[8 * s2 + 1]), cvt_pk_bf16(p1[8 * s2 + 2], p1[8 * s2 + 3]), cvt_pk_bf16(p1[8 * s2 + 4], p1[8 * s2 + 5]), cvt_pk_bf16(p1[8 * s2 + 6], p1[8 * s2 + 7])};
        }
        LAS const unsigned char* vp = vbase + (8 * kt) * 512;
#pragma unroll
        for (int ks = 0; ks < 4; ++ks) {
            if (ks >= 2 && skip1) break;
            const bf16x8 pa = __builtin_bit_cast(bf16x8, pw[ks]);
#pragma unroll
            for (int db = 0; db < 4; ++db) {
                const v4i16_t lo = lds_tr16(vp + db * VDB + ks * 1024), hi = lds_tr16(vp + db * VDB + ks * 1024 + 512);
                const bf16x8 vf = (bf16x8){lo[0], lo[1], lo[2], lo[3], hi[0], hi[1], hi[2], hi[3]};
                o[db] = __builtin_amdgcn_mfma_f32_32x32x16_bf16(pa, vf, o[db], 0, 0, 0);
            }
        }
    }
}
__device__ __forceinline__ void finish_and_stage(const Ctx& F, const f32x16 (&o)[4], float m, float l) {
    const int r = F.lane & 31, hh = F.lane >> 5;
    LAS float* wsf = (LAS float*)(F.lds + OFF_WS + F.wave * WSW);
    const float lt = l + __shfl_xor(l, 32);
    if (hh == 0) { wsf[r] = 1.0f / lt; wsf[32 + r] = m + __builtin_amdgcn_logf(lt); }
    __syncthreads();
    LAS float* stg = (LAS float*)(F.lds + F.wave * 16384);
#pragma unroll
    for (int i = 0; i < 16; ++i) { const int q = crow(i, hh); const float a = wsf[q];
#pragma unroll
        for (int db = 0; db < 4; ++db) stg[q * 128 + 32 * db + r] = o[db][i] * a; }
    asm volatile("s_waitcnt lgkmcnt(0)" ::: "memory");
}
}

__device__ __forceinline__ void ph_attn_partial(const Ctx& F) {
    using namespace att;
    const bf16_t* Q = (const bf16_t*)(F.ws + WS_Q); const bf16_t* K = (const bf16_t*)(F.ws + WS_K); const bf16_t* V = (const bf16_t*)(F.ws + WS_V);
    const unsigned* LISTS = (const unsigned*)(F.ws + WS_LISTS); const unsigned* LCNT = (const unsigned*)(F.ws + WS_CTL) + CW_LCNT;
    bf16_t* OP = (bf16_t*)(F.ws + WS_OP); float* LSE = (float*)(F.ws + WS_LSE);
    LAS int* P = (LAS int*)(F.lds + OFF_TAB);
    if (F.tid < 64) {
        int c[16]; int s = 0;
#pragma unroll
        for (int i = 0; i < 16; ++i) { c[i] = ((int)__hip_atomic_load(LCNT + F.tid * 16 + i, __ATOMIC_RELAXED, __HIP_MEMORY_SCOPE_AGENT) + 255) >> 8; s += c[i]; }
        int inc = s;
#pragma unroll
        for (int o = 1; o < 64; o <<= 1) { const int t = __shfl_up(inc, o); if (F.lane >= o) inc += t; }
        int run = inc - s;
#pragma unroll
        for (int i = 0; i < 16; ++i) { P[F.tid * 16 + i] = run; run += c[i]; }
        if (F.tid == 63) P[1024] = run;
    }
    __syncthreads();
    const int total = P[1024];
    LAS float* wsf = (LAS float*)(F.lds + OFF_WS + F.wave * WSW);
    LAS int* wsi = (LAS int*)wsf;
    for (int item = F.vcu; item < total; item += F.G) {
        int lo = 0, hi = 1023;
        while (lo < hi) { const int mid = (lo + hi + 1) >> 1; if (P[mid] <= item) lo = mid; else hi = mid - 1; }
        const int bhj = lo, chunk = item - P[lo];
        const int b = bhj >> 7, h = (bhj >> 4) & 7, j = bhj & 15;
        const int cnt = (int)__hip_atomic_load(LCNT + bhj, __ATOMIC_RELAXED, __HIP_MEMORY_SCOPE_AGENT);
        load_kv(F, K, V, (size_t)b * SEQ + j * LBLK, h);
        const int r = F.lane & 31, qi = chunk * 256 + F.wave * 32 + r;
        const unsigned ent = LISTS[(size_t)bhj * 4096 + (qi < cnt ? qi : 0)];
        const int tq = ent & 4095, slot = (qi < cnt) ? (int)(ent >> 12) : -1;
        if (F.lane < 32) { wsi[64 + r] = tq; wsi[96 + r] = slot; }
        __syncthreads();
        f32x16 o[4]; float m, l;
        core<false>(F, Q + ((size_t)b * SEQ + tq) * DM + h * DH, o, m, l);
        finish_and_stage(F, o, m, l);
        LAS const float* stg = (LAS const float*)(F.lds + F.wave * 16384);
#pragma unroll
        for (int ps = 0; ps < 8; ++ps) {
            const int q = ps * 4 + (F.lane >> 4), dc = F.lane & 15;
            const f32x4 a = *(LAS const f32x4*)(stg + q * 128 + dc * 8), c = *(LAS const f32x4*)(stg + q * 128 + dc * 8 + 4);
            const int t = wsi[64 + q], sl = wsi[96 + q];
            if (sl >= 0) {
                const size_t row = (((size_t)sl * NB + b) * SEQ + t) * NH + h;
                u32x4 w; w.x = cvt_pk_bf16(a.x, a.y); w.y = cvt_pk_bf16(a.z, a.w); w.z = cvt_pk_bf16(c.x, c.y); w.w = cvt_pk_bf16(c.z, c.w);
                *(u32x4*)(OP + row * DH + dc * 8) = w;
                if (dc == 0) LSE[row] = wsf[32 + q];
            }
        }
        __syncthreads();
    }
}

__device__ __forceinline__ void ph_attn_own(const Ctx& F) {
    using namespace att;
    const bf16_t* Q = (const bf16_t*)(F.ws + WS_Q); const bf16_t* K = (const bf16_t*)(F.ws + WS_K); const bf16_t* V = (const bf16_t*)(F.ws + WS_V);
    const bf16_t* OP = (const bf16_t*)(F.ws + WS_OP); const float* LSE = (const float*)(F.ws + WS_LSE); bf16_t* YAB = (bf16_t*)(F.ws + WS_YAB);
    LAS float* wsf = (LAS float*)(F.lds + OFF_WS + F.wave * WSW);
    for (int it = F.vcu; it < NB * NH * NBLK; it += F.G) {
        const int b = it >> 7, h = (it >> 4) & 7, j = it & 15;
        load_kv(F, K, V, (size_t)b * SEQ + j * LBLK, h);
        __syncthreads();
        const int r = F.lane & 31, t0 = j * LBLK + F.wave * 32;
        f32x16 o[4]; float m, l;
        core<true>(F, Q + ((size_t)b * SEQ + t0 + r) * DM + h * DH, o, m, l);
        finish_and_stage(F, o, m, l);
        LAS const float* stg = (LAS const float*)(F.lds + F.wave * 16384);
        const int nv = j < 3 ? j : 3;
#pragma unroll 2
        for (int ps = 0; ps < 8; ++ps) {
            const int q = ps * 4 + (F.lane >> 4), dc = F.lane & 15, t = t0 + q;
            const f32x4 a = *(LAS const f32x4*)(stg + q * 128 + dc * 8), c = *(LAS const f32x4*)(stg + q * 128 + dc * 8 + 4);
            const float lse_own = wsf[32 + q];
            float ls[3] = {-1e30f, -1e30f, -1e30f}; u32x4 pv[3] = {};
#pragma unroll
            for (int s2 = 0; s2 < 3; ++s2) if (s2 < nv) { const size_t row = (((size_t)s2 * NB + b) * SEQ + t) * NH + h; ls[s2] = LSE[row]; pv[s2] = *(const u32x4*)(OP + row * DH + dc * 8); }
            const float M = fmaxf(fmaxf(lse_own, ls[0]), fmaxf(ls[1], ls[2]));
            const float w0 = __builtin_amdgcn_exp2f(lse_own - M);
            float den = w0; f32x4 x0 = a * w0, x1 = c * w0;
#pragma unroll
            for (int s2 = 0; s2 < 3; ++s2) {
                const float w = (s2 < nv) ? __builtin_amdgcn_exp2f(ls[s2] - M) : 0.f; den += w;
                x0.x += w * bflo(pv[s2].x); x0.y += w * bfhi(pv[s2].x); x0.z += w * bflo(pv[s2].y); x0.w += w * bfhi(pv[s2].y);
                x1.x += w * bflo(pv[s2].z); x1.y += w * bfhi(pv[s2].z); x1.z += w * bflo(pv[s2].w); x1.w += w * bfhi(pv[s2].w);
            }
            const float id = 1.0f / den; x0 = x0 * id; x1 = x1 * id;
            u32x4 w; w.x = cvt_pk_bf16(x0.x, x0.y); w.y = cvt_pk_bf16(x0.z, x0.w); w.z = cvt_pk_bf16(x1.x, x1.y); w.w = cvt_pk_bf16(x1.z, x1.w);
            *(u32x4*)(YAB + ((size_t)b * SEQ + t) * 2048 + 1024 + h * DH + dc * 8) = w;
        }
        __syncthreads();
    }
}

__device__ __forceinline__ void ln_stats16(const float* st, int lane, float& mean, float& rstd) {
    float s1 = 0.f, s2 = 0.f;
    if (lane < 16) { const f32x2 p = *(const f32x2*)(st + 2 * lane); s1 = p.x; s2 = p.y; }
    s1 = wave_sum(s1); s2 = wave_sum(s2);
    mean = s1 * (1.f / DM); const float var = s2 * (1.f / DM) - mean * mean; rstd = 1.f / sqrtf(fmaxf(var, 0.f) + LN_EPS);
}
__device__ __forceinline__ void ph_router(const Ctx& F) {
    const Args& A = *F.a;
    const float* Z = (const float*)(F.ws + WS_Z); const float* ZST = (const float*)(F.ws + WS_ZST); bf16_t* H1 = (bf16_t*)(F.ws + WS_H1);
    int* TKE = (int*)(F.ws + WS_TKE); float* TKW = (float*)(F.ws + WS_TKW); int* TKP = (int*)(F.ws + WS_TKP); unsigned* ECNT = (unsigned*)(F.ws + WS_CTL) + CW_ECNT;
    const float* wr = A.in[I_WR]; const float* br = A.in[I_BR];
    constexpr int RS = 2064, OFF_LO = 32 * RS, OFF_G = 2 * 32 * RS  , OFF_B = OFF_G + 4096, OFF_LG = OFF_B + 4096  , OFF_CNT = OFF_LG + 8 * 2112  ;
    static_assert(OFF_CNT + 256 <= LDS_BYTES, "router LDS map");
    LAS unsigned char* WH = F.lds; LAS unsigned char* WL = F.lds + OFF_LO;
    LAS float* LG = (LAS float*)(F.lds + OFF_G); LAS float* LB = (LAS float*)(F.lds + OFF_B);
    LAS float* lgt = (LAS float*)(F.lds + OFF_LG + F.wave * 2112);
    LAS unsigned* lcnt = (LAS unsigned*)(F.lds + OFF_CNT);
    for (int i = F.tid; i < 512 * 32; i += 512) {
        const int n = i & 31, k2 = i >> 5;
        const float w0 = wr[(size_t)(2 * k2) * NE + n], w1 = wr[(size_t)(2 * k2 + 1) * NE + n];
        const unsigned h0 = f2bf(w0), h1 = f2bf(w1);
        const float r0 = w0 - __uint_as_float(h0 << 16), r1 = w1 - __uint_as_float(h1 << 16);
        *(LAS unsigned*)(WH + n * RS + k2 * 4) = h0 | (h1 << 16);
        *(LAS unsigned*)(WL + n * RS + k2 * 4) = pk2(r0, r1);
    }
    for (int i = F.tid; i < DM; i += 512) { LG[i] = A.in[I_LNMIX_G][i]; LB[i] = A.in[I_LNMIX_B][i]; }
    if (F.tid < 64) lcnt[F.tid] = 0u;
    __syncthreads();
    const int fr = F.lane & 15, kg = F.lane >> 4;
    const int ntask = T / 16, NGW = F.G * 8;
    const int rounds = (ntask + NGW - 1) / NGW;
    for (int rd = 0; rd < rounds; ++rd) {
        const int task = rd * NGW + F.vcu * 8 + F.wave;
        const bool live = task < ntask;
        int te[4] = {0, 0, 0, 0}; float tw[4] = {0.f, 0.f, 0.f, 0.f}; unsigned lp[4] = {0, 0, 0, 0};
        if (live) {
            const int tok = task * 16 + fr;
            float mean, rstd;
            { const f32x4* sp = (const f32x4*)(ZST + (size_t)tok * 32); float s1 = 0.f, s2 = 0.f;
#pragma unroll
              for (int i = 0; i < 8; ++i) { const f32x4 v = sp[i]; s1 += v.x + v.z; s2 += v.y + v.w; }
              mean = s1 * (1.f / DM); const float var = s2 * (1.f / DM) - mean * mean; rstd = 1.f / sqrtf(fmaxf(var, 0.f) + LN_EPS); }
            f32x4 acc0 = {0.f, 0.f, 0.f, 0.f}, acc1 = {0.f, 0.f, 0.f, 0.f};
            const float* zp = Z + (size_t)tok * DM + 8 * kg; bf16_t* hp = H1 + (size_t)tok * DM + 8 * kg;
#pragma unroll 4
            for (int kk = 0; kk < 32; ++kk) {
                const f32x4 z0 = *(const f32x4*)(zp + 32 * kk), z1 = *(const f32x4*)(zp + 32 * kk + 4);
                const f32x4 g0 = *(LAS const f32x4*)(LG + 32 * kk + 8 * kg), g1 = *(LAS const f32x4*)(LG + 32 * kk + 8 * kg + 4);
                const f32x4 b0 = *(LAS const f32x4*)(LB + 32 * kk + 8 * kg), b1 = *(LAS const f32x4*)(LB + 32 * kk + 8 * kg + 4);
                const f32x4 x0 = (z0 - mean) * rstd * g0 + b0, x1 = (z1 - mean) * rstd * g1 + b1;
                u32x4 hi; hi.x = cvt_pk_bf16(x0.x, x0.y); hi.y = cvt_pk_bf16(x0.z, x0.w); hi.z = cvt_pk_bf16(x1.x, x1.y); hi.w = cvt_pk_bf16(x1.z, x1.w);
                *(u32x4*)(hp + 32 * kk) = hi;
                u32x4 lo; lo.x = cvt_pk_bf16(x0.x - bflo(hi.x), x0.y - bfhi(hi.x)); lo.y = cvt_pk_bf16(x0.z - bflo(hi.y), x0.w - bfhi(hi.y));
                lo.z = cvt_pk_bf16(x1.x - bflo(hi.z), x1.y - bfhi(hi.z)); lo.w = cvt_pk_bf16(x1.z - bflo(hi.w), x1.w - bfhi(hi.w));
                const bf16x8 ah = __builtin_bit_cast(bf16x8, hi), al = __builtin_bit_cast(bf16x8, lo);
                const int bo = fr * RS + (32 * kk + 8 * kg) * 2;
                const bf16x8 wh0 = *(LAS const bf16x8*)(WH + bo), wh1 = *(LAS const bf16x8*)(WH + bo + 16 * RS), wl0 = *(LAS const bf16x8*)(WL + bo), wl1 = *(LAS const bf16x8*)(WL + bo + 16 * RS);
                acc0 = __builtin_amdgcn_mfma_f32_16x16x32_bf16(ah, wh0, acc0, 0, 0, 0); acc1 = __builtin_amdgcn_mfma_f32_16x16x32_bf16(ah, wh1, acc1, 0, 0, 0);
                acc0 = __builtin_amdgcn_mfma_f32_16x16x32_bf16(ah, wl0, acc0, 0, 0, 0); acc1 = __builtin_amdgcn_mfma_f32_16x16x32_bf16(ah, wl1, acc1, 0, 0, 0);
                acc0 = __builtin_amdgcn_mfma_f32_16x16x32_bf16(al, wh0, acc0, 0, 0, 0); acc1 = __builtin_amdgcn_mfma_f32_16x16x32_bf16(al, wh1, acc1, 0, 0, 0);
            }
            const float br0 = br[fr], br1 = br[16 + fr];
#pragma unroll
            for (int i = 0; i < 4; ++i) { lgt[(4 * kg + i) * 33 + fr] = acc0[i] + br0; lgt[(4 * kg + i) * 33 + 16 + fr] = acc1[i] + br1; }
            asm volatile("s_waitcnt lgkmcnt(0)" ::: "memory");
            if (F.lane < 16) {
                float lg[NE];
#pragma unroll
                for (int e = 0; e < NE; ++e) lg[e] = lgt[F.lane * 33 + e];
                float tv[4];
#pragma unroll
                for (int r = 0; r < 4; ++r) {
                    float best = -INFINITY; int bi = 0;
#pragma unroll
                    for (int e = 0; e < NE; ++e) { const bool c = lg[e] > best; best = c ? lg[e] : best; bi = c ? e : bi; }
#pragma unroll
                    for (int e = 0; e < NE; ++e) lg[e] = (e == bi) ? -INFINITY : lg[e];
                    te[r] = bi; tv[r] = best;
                }
                const float e1 = __expf(tv[1] - tv[0]), e2 = __expf(tv[2] - tv[0]), e3 = __expf(tv[3] - tv[0]); const float inv = 1.f / (1.f + e1 + e2 + e3);
                tw[0] = inv; tw[1] = e1 * inv; tw[2] = e2 * inv; tw[3] = e3 * inv;
#pragma unroll
                for (int r = 0; r < 4; ++r) lp[r] = atomicAdd((unsigned*)(lcnt + te[r]), 1u);
            }
        }
        __syncthreads();
        if (F.tid < 32) { const unsigned c = lcnt[F.tid]; lcnt[32 + F.tid] = c ? atomicAdd(&ECNT[F.tid], c) : 0u; }
        __syncthreads();
        if (live && F.lane < 16) {
            const size_t tok = (size_t)task * 16 + F.lane;
            int4 pe = {te[0], te[1], te[2], te[3]}; float4 pw = {tw[0], tw[1], tw[2], tw[3]};
            int4 pp = {(int)(lcnt[32 + te[0]] + lp[0]), (int)(lcnt[32 + te[1]] + lp[1]), (int)(lcnt[32 + te[2]] + lp[2]), (int)(lcnt[32 + te[3]] + lp[3])};
            *(int4*)(TKE + tok * 4) = pe; *(float4*)(TKW + tok * 4) = pw; *(int4*)(TKP + tok * 4) = pp;
        }
        __syncthreads();
        if (F.tid < 32) lcnt[F.tid] = 0u;
        __syncthreads();
    }
}

__device__ __forceinline__ void ph_scatter(const Ctx& F) {
    const unsigned* ECNT = (const unsigned*)(F.ws + WS_CTL) + CW_ECNT;
    const int* TKE = (const int*)(F.ws + WS_TKE); const float* TKW = (const float*)(F.ws + WS_TKW); const int* TKP = (const int*)(F.ws + WS_TKP);
    int* ROWOF = (int*)(F.ws + WS_ROWOF); int* ROWTOK = (int*)(F.ws + WS_ROWTOK); float* ROWW = (float*)(F.ws + WS_ROWW); int* TILE = (int*)(F.ws + WS_TILE);
    const bf16_t* H1 = (const bf16_t*)(F.ws + WS_H1); bf16_t* XG = (bf16_t*)(F.ws + WS_XG);
    int* pst = (int*)F.ldsg;
    if (F.tid == 0) {
        int acc = 0;
        for (int e = 0; e < NE; ++e) { const int c = (int)__hip_atomic_load(ECNT + e, __ATOMIC_RELAXED, __HIP_MEMORY_SCOPE_AGENT); pst[e] = acc; pst[32 + e] = c; acc += (c + 255) / 256 * 256; }
        pst[64] = acc;
    }
    __syncthreads();
    if (blockIdx.x == 0) {
        const int ntiles = pst[64] / 256;
        if (F.tid == 0) TILE[0] = ntiles;
        for (int i = F.tid; i < ntiles; i += 512) { int e = 0; for (int k = 1; k < NE; ++k) if (i * 256 >= pst[k]) e = k; TILE[16 + i] = e; }
        for (int e = 0; e < NE; ++e) { const int s = pst[e] + pst[32 + e], en = (e + 1 < NE) ? pst[e + 1] : pst[64]; for (int r = s + F.tid; r < en; r += 512) { ROWTOK[r] = 0; ROWW[r] = 0.f; } }
    }
    const int gw = F.vcu * 8 + F.wave, NGW = F.G * 8;
    for (int idx = gw; idx < T * TOPK; idx += NGW) {
        const int t = idx >> 2, e = TKE[idx], row = pst[e] + TKP[idx];
        if (F.lane == 0) { ROWTOK[row] = t; ROWW[row] = TKW[idx]; ROWOF[idx] = row; }
        const u32x4* src = (const u32x4*)(H1 + (size_t)t * DM); u32x4* dst = (u32x4*)(XG + (size_t)row * DM);
        dst[F.lane] = src[F.lane]; dst[64 + F.lane] = src[64 + F.lane];
    }
}

__device__ __forceinline__ void ph_final(const Ctx& F) {
    const Args& A = *F.a;
    const float* Z = (const float*)(F.ws + WS_Z); const float* ZST = (const float*)(F.ws + WS_ZST); const bf16_t* YS = (const bf16_t*)(F.ws + WS_YS); const int* ROWOF = (const int*)(F.ws + WS_ROWOF);
    const int gw = F.vcu * 8 + F.wave, NGW = F.G * 8;
    f32x4 gg[4], bb[4], g2[4], b2[4];
#pragma unroll
    for (int j = 0; j < 4; ++j) { gg[j] = *((const f32x4*)A.in[I_LNMIX_G] + F.lane + 64 * j); bb[j] = *((const f32x4*)A.in[I_LNMIX_B] + F.lane + 64 * j);
        g2[j] = *((const f32x4*)A.in[I_LNF_G] + F.lane + 64 * j); b2[j] = *((const f32x4*)A.in[I_LNF_B] + F.lane + 64 * j); }
    for (int m = gw; m < T; m += NGW) {
        float mean, rstd; ln_stats16(ZST + (size_t)m * 32, F.lane, mean, rstd);
        const f32x4* zr = (const f32x4*)(Z + (size_t)m * DM) + F.lane;
        f32x4 v[4];
#pragma unroll
        for (int j = 0; j < 4; ++j) v[j] = ((zr[64 * j] - mean) * rstd * gg[j] + bb[j]) * ALPHA;
#pragma unroll
        for (int k = 0; k < 4; ++k) {
            const int row = ROWOF[(size_t)m * 4 + k]; const u32x2* yr = (const u32x2*)(YS + (size_t)row * DM) + F.lane;
#pragma unroll
            for (int j = 0; j < 4; ++j) { const u32x2 y = yr[64 * j]; v[j].x += bflo(y.x); v[j].y += bfhi(y.x); v[j].z += bflo(y.y); v[j].w += bfhi(y.y); }
        }
        float s = 0.f;
#pragma unroll
        for (int j = 0; j < 4; ++j) s += (v[j].x + v[j].y) + (v[j].z + v[j].w);
        const float mu = wave_sum(s) * (1.f / DM); float s2 = 0.f;
#pragma unroll
        for (int j = 0; j < 4; ++j) { v[j] = v[j] - mu; s2 += (v[j].x * v[j].x + v[j].y * v[j].y) + (v[j].z * v[j].z + v[j].w * v[j].w); }
        const float rs = 1.f / sqrtf(wave_sum(s2) * (1.f / DM) + LN_EPS);
        f32x4* orow = (f32x4*)(A.out + (size_t)m * DM) + F.lane;
#pragma unroll
        for (int j = 0; j < 4; ++j) orow[64 * j] = v[j] * rs * g2[j] + b2[j];
    }
}

#define XB_TMO      128
#define XB_XCNT(j)  (256  + 64 * (j))
#define XB_XSUB(j)  (1280 + 64 * (j))
#define XB_XGEN(j)  (2304 + 64 * (j))
#define XB_TOP      3328
#define XB_TOPGEN   3392
#define XCD_BAR_WORDS 3456
#define XB_SPIN_CAP (1u << 18)
__device__ __forceinline__ unsigned xb_ld(unsigned* p)              { return __hip_atomic_load(p, __ATOMIC_RELAXED, __HIP_MEMORY_SCOPE_AGENT); }
__device__ __forceinline__ unsigned xb_add(unsigned* p, unsigned v) { return __hip_atomic_fetch_add(p, v, __ATOMIC_RELAXED, __HIP_MEMORY_SCOPE_AGENT); }
__device__ __forceinline__ unsigned xb_xcc_id() { return (unsigned)__builtin_amdgcn_s_getreg((3 << 11) | 20) & 0xFu; }
#define XB_SPIN(cond, bar) do { unsigned _sp = 0; while (cond) { __builtin_amdgcn_s_sleep(1); \
    if ((++_sp & 255u) == 0u) { if (xb_ld(&(bar)[XB_TMO])) break; if (_sp > XB_SPIN_CAP) { atomicAdd(&(bar)[XB_TMO], 1u); break; } } } } while (0)
__device__ __forceinline__ void xcd_barrier_complete(unsigned* bar, unsigned x, unsigned& nloc, unsigned& nx) {
    const unsigned G = gridDim.x * gridDim.y * gridDim.z;
    unsigned sum, cnt, mine, sp = 0u;
    for (;;) {
        sum = 0u; cnt = 0u; mine = 0u;
#pragma unroll
        for (unsigned j = 0; j < 16; ++j) { const unsigned c = xb_ld(&bar[XB_XCNT(j)]); sum += c; cnt += (c > 0u) ? 1u : 0u; mine = (j == x) ? c : mine; }
        if (sum == G) break;
        __builtin_amdgcn_s_sleep(1);
        if ((++sp & 255u) == 0u) { if (xb_ld(&bar[XB_TMO])) break; if (sp > XB_SPIN_CAP) { atomicAdd(&bar[XB_TMO], 1u); break; } }
    }
    nloc = mine > 0u ? mine : 1u; nx = cnt > 0u ? cnt : 1u;
}
__device__ __forceinline__ void xcd_barrier(unsigned* bar, volatile LAS unsigned* st, unsigned x, bool leader_thread) {
    asm volatile("s_waitcnt vmcnt(0)" ::: "memory");
    __syncthreads();
    if (leader_thread) {
        __builtin_amdgcn_s_waitcnt(0);
        unsigned nloc = st[0], nx = st[1];
        if (nloc == 0u) { xcd_barrier_complete(bar, x, nloc, nx); st[0] = nloc; st[1] = nx; }
        const unsigned old = xb_add(&bar[XB_XSUB(x)], 1u);
        const unsigned gen = old / nloc;
        if (old + 1u == (gen + 1u) * nloc) {
            __builtin_amdgcn_fence(__ATOMIC_RELEASE, "agent");
            asm volatile("s_waitcnt vmcnt(0)" ::: "memory");
            const unsigned og = xb_add(&bar[XB_TOP], 1u);
            const unsigned tg = og / nx;
            if (og + 1u == (tg + 1u) * nx) xb_add(&bar[XB_TOPGEN], 1u);
            else XB_SPIN(xb_ld(&bar[XB_TOPGEN]) == tg, bar);
            __builtin_amdgcn_fence(__ATOMIC_ACQUIRE, "agent");
            xb_add(&bar[XB_XGEN(x)], 1u);
            asm volatile("s_waitcnt vmcnt(0)" ::: "memory");
        } else {
            XB_SPIN(xb_ld(&bar[XB_XGEN(x)]) == gen, bar);
            __builtin_amdgcn_fence(__ATOMIC_ACQUIRE, "agent");
            asm volatile("s_waitcnt vmcnt(0)" ::: "memory");
        }
    }
    __syncthreads();
}

template <bool COOP>
__global__ void __launch_bounds__(512, 2) mega(Args args) {
    extern __shared__ __attribute__((aligned(16))) unsigned char lds_raw[];
    Ctx F;
    const int wave0 = __builtin_amdgcn_readfirstlane(threadIdx.x >> 6);
#define MKCTX() do { F.a = &args; F.ws = args.ws; F.lds = (LAS unsigned char*)lds_raw; F.ldsg = lds_raw; F.lane = lane_id_asm(); F.wave = wave0; F.tid = wave0 * 64 + F.lane; \
    F.G = gridDim.x; { const int bx = blockIdx.x; F.vcu = (F.G % 8 == 0) ? (bx % 8) * (F.G / 8) + bx / 8 : bx; } } while (0)
    MKCTX();
    const int lo = args.ph_lo, hi = args.ph_hi;
    unsigned char* ws = args.ws;
#ifndef PHMASK
#define PHMASK 0xFFFF
#endif
#define IN(k) (((PHMASK >> (k)) & 1) && lo <= (k) && (k) < hi)
    unsigned* barw = (unsigned*)(ws + WS_CTL) + CW_BAR; volatile LAS unsigned* bst = (volatile LAS unsigned*)((LAS unsigned char*)lds_raw + LDS_BYTES - 64);
    const unsigned my_xcc = xb_xcc_id();
    if (COOP) { if (threadIdx.x == 0) { bst[0] = 0u; bst[1] = 0u; (void)xb_add(&barw[XB_XCNT(my_xcc)], 1u); } __syncthreads(); }
#define SEAM(k) do { if (COOP && IN(k) && IN((k) + 1)) { if ((k) == 0) cg::this_grid().sync(); else xcd_barrier(barw, bst, my_xcc, wave0 == 0 && lane_id_asm() == 0); } } while (0)
    if (IN(0)) { MKCTX(); ph_prologue(F); } SEAM(0);
    if (IN(1)) {
        pg8::Gemm g{(const bf16_t*)(ws + WS_H0), (const bf16_t*)(ws + WS_WIN), DM, DM, DM}; pg8::StaticOrder S; S.init(T, INCOLS, F.G, (int)blockIdx.x);
        pg8::Epi1 E{(bf16_t*)(ws + WS_YAB), (bf16_t*)(ws + WS_GV), (bf16_t*)(ws + WS_Q), (bf16_t*)(ws + WS_K), (bf16_t*)(ws + WS_V), (bf16_t*)(ws + WS_SA), (bf16_t*)(ws + WS_SB), (float*)(ws + WS_GVST)};
        pg8::gemm_phase<pg8::Epi1, pg8::StaticOrder, true>(F.lds, g, S, E, wave0);
    } SEAM(1);
    if (IN(2)) { MKCTX(); ph_kmean(F); ph_mixer_a(F); } SEAM(2);
    if (IN(3)) { MKCTX(); ph_gate(F); } SEAM(3);
    if (IN(4)) { MKCTX(); ph_attn_partial(F); } SEAM(4);
    if (IN(5)) { MKCTX(); ph_attn_own(F); } SEAM(5);
    if (IN(6)) {
        pg8::Gemm g{(const bf16_t*)(ws + WS_YAB), (const bf16_t*)(ws + WS_WAB), 2048, 2048, 2048}; pg8::StaticOrder S; S.init(T, DM, F.G, (int)blockIdx.x);
        pg8::Epi2 E{(const bf16_t*)(ws + WS_SA), (const bf16_t*)(ws + WS_SB), (bf16_t*)(ws + WS_MG)};
        pg8::gemm_phase<pg8::Epi2, pg8::StaticOrder, true>(F.lds, g, S, E, wave0);
    } SEAM(6);
    if (IN(7)) {
        pg8::Gemm g{(const bf16_t*)(ws + WS_MG), (const bf16_t*)(ws + WS_WOUT), DM, DM, DM}; pg8::StaticOrder S; S.init(T, DM, F.G, (int)blockIdx.x);
        pg8::Epi3 E{(const bf16_t*)(ws + WS_H0), (float*)(ws + WS_Z), (float*)(ws + WS_ZST)};
        pg8::gemm_phase<pg8::Epi3, pg8::StaticOrder, true>(F.lds, g, S, E, wave0);
    } SEAM(7);
    if (IN(8)) { MKCTX(); ph_router(F); } SEAM(8);
    if (IN(9)) { MKCTX(); ph_scatter(F); } SEAM(9);
    if (IN(10)) {
        pg8::Gemm g{(const bf16_t*)(ws + WS_XG), (const bf16_t*)(ws + WS_WUP), DM, DM, DM}; pg8::MoeOrder S; S.init((const int*)(ws + WS_TILE), 8, F.G, (int)blockIdx.x);
        pg8::Epi4 E{args.in[I_BUP], (bf16_t*)(ws + WS_ACT)};
        pg8::gemm_phase<pg8::Epi4, pg8::MoeOrder, true>(F.lds, g, S, E, wave0);
    } SEAM(10);
    if (IN(11)) {
        pg8::Gemm g{(const bf16_t*)(ws + WS_ACT), (const bf16_t*)(ws + WS_WDN), FF, FF, FF}; pg8::MoeOrder S; S.init((const int*)(ws + WS_TILE), 4, F.G, (int)blockIdx.x);
        pg8::Epi5 E{args.in[I_BDN], (const float*)(ws + WS_ROWW), (bf16_t*)(ws + WS_YS)};
        pg8::gemm_phase<pg8::Epi5, pg8::MoeOrder, true>(F.lds, g, S, E, wave0);
    } SEAM(11);
    if (IN(12)) { MKCTX(); ph_final(F); }
#undef IN
#undef SEAM
}

extern "C" void kernel_launch(void* const* d_in, const int* in_sizes, int n_in, void* d_out, int out_size, void* d_ws, size_t ws_size, hipStream_t stream) {
    static int grid = 0;
    if (grid == 0) {
        if (n_in != 21 || in_sizes[0] != T * DM || out_size != T * DM || ws_size < WS_END) { fprintf(stderr, "kernel_launch: unexpected shapes (n_in %d, in0 %d, out %d, ws %zu)\n", n_in, n_in > 0 ? in_sizes[0] : -1, out_size, ws_size); grid = -1; return; }
        int dev = 0, cus = 0, per_cu = 0;
        hipGetDevice(&dev); hipDeviceGetAttribute(&cus, hipDeviceAttributeMultiprocessorCount, dev);
        const void* fn = MK_COOP ? (const void*)mega<true> : (const void*)mega<false>;
        hipFuncSetAttribute(fn, hipFuncAttributeMaxDynamicSharedMemorySize, LDS_BYTES);
        hipOccupancyMaxActiveBlocksPerMultiprocessor(&per_cu, fn, 512, LDS_BYTES);
        (void)hipGetLastError();
        if (per_cu < 1) { fprintf(stderr, "kernel_launch: occupancy query says %d blocks/CU\n", per_cu); per_cu = 1; }
        grid = cus * 1;
    }
    if (grid < 0) return;
    hipMemsetAsync((char*)d_ws + WS_CTL, 0, CTL_ZERO_BYTES, stream);
    Args a{};
    for (int i = 0; i < 21; ++i) a.in[i] = (const float*)d_in[i];
    a.out = (float*)d_out; a.ws = (unsigned char*)d_ws;
#if MK_COOP
    a.ph_lo = 0; a.ph_hi = NPHASE;
    void* kargs[] = {&a};
    hipError_t e = hipLaunchCooperativeKernel((const void*)mega<true>, dim3(grid), dim3(512), kargs, LDS_BYTES, stream);
    if (e != hipSuccess) fprintf(stderr, "cooperative launch failed: %s (grid %d)\n", hipGetErrorString(e), grid);
#else
    for (int p = 0; p < NPHASE; ++p) { a.ph_lo = p; a.ph_hi = p + 1; hipLaunchKernelGGL(mega<false>, dim3(grid), dim3(512), LDS_BYTES, stream, a); }
#endif
}
```

```cpp
#include <hip/hip_runtime.h>
#include <hip/hip_cooperative_groups.h>
#include <cstdio>
#include <cstdint>
namespace cg = cooperative_groups;

#ifndef MK_COOP
#define MK_COOP 1
#endif

#define LAS __attribute__((address_space(3)))
typedef unsigned short bf16_t;
typedef short bf16x8 __attribute__((ext_vector_type(8)));
typedef float f32x4 __attribute__((ext_vector_type(4)));
typedef float f32x2 __attribute__((ext_vector_type(2)));
typedef unsigned u32x4 __attribute__((ext_vector_type(4)));
typedef unsigned u32x2 __attribute__((ext_vector_type(2)));

constexpr int NB = 8, SEQ = 4096, DM = 1024, T = NB * SEQ;
constexpr int NH = 8, DH = 128, LBLK = 256, NBLK = SEQ / LBLK;
constexpr int NE = 32, TOPK = 4, FF = 1024;
constexpr int INCOLS = 7 * DM;
constexpr int RMAX = T * TOPK + NE * 256;
constexpr float LN_EPS = 1e-5f;
constexpr float ALPHA = 1.189207115002721f;
constexpr float QSCALE = 0.08838834764831845f * 1.4426950408889634f;

constexpr size_t MiB = 1u << 20, U64 = 64 * MiB;
constexpr size_t WS_CTL = 0, CTL_ZERO_BYTES = 1 * MiB;
constexpr int CW_ECNT = 64;
constexpr int CW_LCNT = 1024;
constexpr int CW_BAR = 4096;
constexpr size_t WS_KMEAN = 1 * MiB;
constexpr size_t WS_GVST = 2 * MiB;
constexpr size_t WS_ZST = 6 * MiB;
constexpr size_t WS_SEL = 10 * MiB;
constexpr size_t WS_TKE = 11 * MiB;
constexpr size_t WS_TKW = 11 * MiB + 512 * 1024;
constexpr size_t WS_TKP = 12 * MiB;
constexpr size_t WS_ROWOF = 12 * MiB + 512 * 1024;
constexpr size_t WS_ROWTOK = 13 * MiB;
constexpr size_t WS_ROWW = 14 * MiB;
constexpr size_t WS_TILE = 15 * MiB;
constexpr size_t WS_LISTS = 16 * MiB;
constexpr size_t WS_LSE = 32 * MiB;
constexpr size_t WS_WIN = 40 * MiB;
constexpr size_t WS_WAB = 54 * MiB;
constexpr size_t WS_WOUT = 58 * MiB;
constexpr size_t WS_WDN = 60 * MiB;
constexpr size_t WS_WUP = 124 * MiB;
constexpr size_t WS_H0 = 4 * U64;
constexpr size_t WS_YAB = 5 * U64;
constexpr size_t WS_GV = 7 * U64;
constexpr size_t WS_Q = 8 * U64, WS_K = 9 * U64, WS_V = 10 * U64, WS_SA = 11 * U64, WS_SB = 12 * U64;
constexpr size_t WS_OP = 13 * U64;
constexpr size_t WS_MG = WS_GV;
constexpr size_t WS_Z = 14 * U64;
constexpr size_t WS_H1 = WS_H0;
constexpr size_t WS_XG = 5 * U64;
constexpr size_t WS_ACT = 9 * U64 + 16 * MiB;
constexpr size_t WS_YS = WS_XG;
constexpr size_t WS_END = 16 * U64;
static_assert(WS_XG + (size_t)RMAX * 2048 <= WS_ACT && WS_ACT + (size_t)RMAX * 2048 <= WS_Z, "ws map");

constexpr int LDS_BYTES = 163840;
constexpr int LDS_MISC = 131072;
constexpr int NPHASE = 13;

__device__ __forceinline__ float bf2f(bf16_t v) { return __uint_as_float((unsigned)v << 16); }
__device__ __forceinline__ float bflo(unsigned u) { return __uint_as_float(u << 16); }
__device__ __forceinline__ float bfhi(unsigned u) { return __uint_as_float(u & 0xffff0000u); }
__device__ __forceinline__ unsigned f2bf(float f) { unsigned u = __builtin_bit_cast(unsigned, f); return (u + 0x7fffu + ((u >> 16) & 1u)) >> 16; }
__device__ __forceinline__ unsigned pk2(float lo, float hi) { return f2bf(lo) | (f2bf(hi) << 16); }
typedef __bf16 bf16x2_t __attribute__((ext_vector_type(2)));
__device__ __forceinline__ unsigned cvt_pk_bf16(float lo, float hi) { f32x2 v = {lo, hi}; bf16x2_t b = __builtin_convertvector(v, bf16x2_t); return __builtin_bit_cast(unsigned, b); }
__device__ __forceinline__ int lane_id_asm() { int l; asm volatile("v_mbcnt_lo_u32_b32 %0, -1, 0\n\tv_mbcnt_hi_u32_b32 %0, -1, %0" : "=v"(l)); return l; }
__device__ __forceinline__ float wave_sum(float v) {
#pragma unroll
    for (int o = 1; o < 64; o <<= 1) v += __shfl_xor(v, o);
    return v;
}
__device__ __forceinline__ float wave_max(float v) {
#pragma unroll
    for (int o = 1; o < 64; o <<= 1) v = fmaxf(v, __shfl_xor(v, o));
    return v;
}
__device__ __forceinline__ f32x2 gelu_pk(f32x2 v) {
    const f32x2 av = __builtin_elementwise_abs(v), d = av * 0.2316418882f + 1.0f;
    f32x2 t; t.x = __builtin_amdgcn_rcpf(d.x); t.y = __builtin_amdgcn_rcpf(d.y);
    f32x2 q = t * 0.5307027145f + (-0.7265760135f); q = q * t + 0.7107068705f; q = q * t + (-0.142248368f); q = q * t + 0.127414796f; q = q * t;
    const f32x2 s = (v * v) * (-0.72134752044f);
    f32x2 e; e.x = __builtin_amdgcn_exp2f(s.x); e.y = __builtin_amdgcn_exp2f(s.y);
    const f32x2 m = v * (q * e), r = v - m;
    f32x2 o; o.x = v.x < 0.f ? m.x : r.x; o.y = v.y < 0.f ? m.y : r.y; return o;
}
__device__ __forceinline__ float sigmoidf_(float x) { return __builtin_amdgcn_rcpf(1.0f + __builtin_amdgcn_exp2f(-1.4426950408889634f * x)); }

namespace pg8 {
constexpr int BM = 256, BK = 64, HALF = 128, HTB = HALF * BK * 2, STAGE_BYTES = 8 * HTB, NXCD = 8, WGM = 8;
__host__ __device__ __forceinline__ int lds_byte(int r, int c) { const int st = (r >> 4) * 2 + (c >> 5), rr = r & 15, cc = c & 31, ob = rr * 64 + cc * 2; return st * 1024 + (ob ^ (((ob >> 9) & 1) << 5)); }
__host__ __device__ __forceinline__ void stage_rc(int b, int& R, int& C) { const int st = b / 1024, sb = b % 1024, swz = sb ^ (((sb >> 9) & 1) << 5); R = (st >> 1) * 16 + swz / 64; C = (st & 1) * 32 + (swz % 64) / 2; }
__host__ __device__ __forceinline__ int perm32(int rho) { const int n = rho >> 4, i = rho & 15; return 8 * (i >> 2) + 4 * n + (i & 3); }

struct Unit { int pm, pn, bt; };
struct Gemm { const bf16_t* A; const bf16_t* Bt; int K, lda, ldb; };

struct StaticOrder {
    int nM, nN, nwg, G, c;
    __device__ void init(int M, int N, int G_, int c_) { nM = M / BM; nN = N / BM; nwg = nM * nN; G = G_; c = c_; }
    __device__ bool next(int i, Unit& u) const {
        const long L = (long)i * G + c; if (L >= nwg) return false;
        int wgid = (int)L; { const int q = nwg / NXCD, r = nwg % NXCD, xcd = wgid % NXCD, off = wgid / NXCD; wgid = (xcd < r ? xcd * (q + 1) : r * (q + 1) + (xcd - r) * q) + off; }
        const int nig = WGM * nN, gid = wgid / nig, fm = gid * WGM, gsz = (nM - fm) < WGM ? (nM - fm) : WGM;
        u.pm = fm + ((wgid % nig) % gsz); u.pn = (wgid % nig) / gsz; u.bt = u.pn; return true;
    }
};
struct MoeOrder {
    int nM, nN, nwg, G, c; const int* tile_e;
    __device__ void init(const int* tiletab, int nN_, int G_, int c_) { nM = tiletab[0]; tile_e = tiletab + 16; nN = nN_; nwg = nM * nN; G = G_; c = c_; }
    __device__ bool next(int i, Unit& u) const {
        const long L = (long)i * G + c; if (L >= nwg) return false;
        int wgid = (int)L; { const int q = nwg / NXCD, r = nwg % NXCD, xcd = wgid % NXCD, off = wgid / NXCD; wgid = (xcd < r ? xcd * (q + 1) : r * (q + 1) + (xcd - r) * q) + off; }
        const int nig = WGM * nN, gid = wgid / nig, fm = gid * WGM, gsz = (nM - fm) < WGM ? (nM - fm) : WGM;
        u.pm = fm + ((wgid % nig) % gsz); u.pn = (wgid % nig) / gsz; u.bt = tile_e[u.pm] * nN + u.pn; return true;
    }
};

typedef int v4i_t __attribute__((ext_vector_type(4)));
typedef int v8i_t __attribute__((ext_vector_type(8)));
template <class Epi, class Sched, bool ALIGN_EPI, bool FP8 = false>
__device__ __forceinline__ void gemm_phase(LAS unsigned char* lds, const Gemm g, const Sched& S, const Epi& E, const int wid) {
    const int lane = lane_id_asm(), tid = wid * 64 + lane;
    const int wr = wid >> 2, wc = wid & 3, fr = lane & 15, fq = lane >> 4;
    const int nt = g.K / BK;
    unsigned voffA[2], voffB[2];
#pragma unroll
    for (int i = 0; i < 2; ++i) { int R, C; stage_rc(tid * 16 + i * 8192, R, C); const int Rb = Epi::PERM ? ((R & ~31) + perm32(R & 31)) : R;
        voffA[i] = (unsigned)(R * g.lda + C) * 2u; voffB[i] = (unsigned)(Rb * g.ldb + C) * 2u; }
    const size_t kstep = (size_t)(BK * 2);
    const size_t hstepA = (size_t)HALF * g.lda * 2, hstepB = (size_t)HALF * g.ldb * 2;
    const size_t tstepA = 2 * hstepA, tstepB = 2 * hstepB;
    const unsigned ldsw = (unsigned)wid * 1024u;
    const int aoff = lds_byte(wr * 64 + fr, fq * 8), boff = lds_byte(wc * 32 + fr, fq * 8);
#define PG8_SA(b, h) (((b) * 2 + (h)) * HTB)
#define PG8_SB(b, h) ((4 + (b) * 2 + (h)) * HTB)
#define PG8_STAGE(bufoff, gbase, voff) do { _Pragma("unroll") for (int _i = 0; _i < 2; ++_i) \
        __builtin_amdgcn_global_load_lds((const unsigned*)((const char*)(gbase) + (voff)[_i]), (LAS unsigned*)(lds + (bufoff) + ldsw + _i * 8192), 16, 0, 0); } while (0)
#define PG8_LD8(p) __builtin_shufflevector(*(const LAS v4i_t*)(p), *(const LAS v4i_t*)((p) + 1024), 0, 1, 2, 3, 4, 5, 6, 7)
#define PG8_LDA(dst, b, h) do { _Pragma("unroll") for (int m = 0; m < 4; ++m) { if constexpr (FP8) dst##8[m] = PG8_LD8(lds + PG8_SA(b, h) + aoff + m * 2048); \
        else { _Pragma("unroll") for (int k = 0; k < 2; ++k) dst[m][k] = *(const LAS bf16x8*)(lds + PG8_SA(b, h) + aoff + m * 2048 + k * 1024); } } } while (0)
#define PG8_LDB(dst, b, h) do { _Pragma("unroll") for (int n = 0; n < 2; ++n) { if constexpr (FP8) dst##8[n] = PG8_LD8(lds + PG8_SB(b, h) + boff + n * 2048); \
        else { _Pragma("unroll") for (int k = 0; k < 2; ++k) dst[n][k] = *(const LAS bf16x8*)(lds + PG8_SB(b, h) + boff + n * 2048 + k * 1024); } } } while (0)
#define PG8_MMA(ai, bj, At, Bt) do { __builtin_amdgcn_s_setprio(1); _Pragma("unroll") for (int m = 0; m < 4; ++m) _Pragma("unroll") for (int n = 0; n < 2; ++n) { \
        if constexpr (FP8) { asm volatile("s_nop 1\n\tv_mfma_scale_f32_16x16x128_f8f6f4 %0, %1, %2, %0, %3, %3 op_sel_hi:[0,0,0]" : "+v"(acc[ai][bj][m][n]) : "v"(Bt##8[n]), "v"(At##8[m]), "v"(scl8)); } \
        else { _Pragma("unroll") for (int k = 0; k < 2; ++k) acc[ai][bj][m][n] = __builtin_amdgcn_mfma_f32_16x16x32_bf16(Bt[n][k], At[m][k], acc[ai][bj][m][n], 0, 0, 0); } } \
        __builtin_amdgcn_s_setprio(0); } while (0)
#define PG8_WAIT_V(n) asm volatile("s_waitcnt vmcnt(" #n ")" ::: "memory")
#define PG8_WAIT_L(n) asm volatile("s_waitcnt lgkmcnt(" #n ")" ::: "memory")
#define PG8_BAR __builtin_amdgcn_s_barrier()
#define PG8_SCHED __builtin_amdgcn_sched_barrier(0)
    Unit cur, nxt; int ui = 0;
    if (!S.next(0, cur)) return;
    f32x4 acc[2][2][4][2];
#pragma unroll
    for (int a = 0; a < 2; ++a)
#pragma unroll
        for (int b = 0; b < 2; ++b)
#pragma unroll
            for (int m = 0; m < 4; ++m)
#pragma unroll
                for (int n = 0; n < 2; ++n) acc[a][b][m][n] = (f32x4){0.f, 0.f, 0.f, 0.f};
    bf16x8 At[4][2], B0[2][2], B1[2][2]; v8i_t At8[4], B08[2], B18[2];
    int scl8 = 0x7f7f7f7f; asm volatile("" : "+v"(scl8));
    const char* cA = (const char*)g.A + (size_t)cur.pm * tstepA; const char* cB = (const char*)g.Bt + (size_t)cur.bt * tstepB;
    PG8_STAGE(PG8_SB(0, 0), cB, voffB); PG8_STAGE(PG8_SB(0, 1), cB + hstepB, voffB); PG8_STAGE(PG8_SA(0, 0), cA, voffA); PG8_STAGE(PG8_SA(0, 1), cA + hstepA, voffA);
    if (wr == 1) PG8_BAR;
    PG8_WAIT_V(2); PG8_BAR;
    PG8_STAGE(PG8_SB(1, 0), cB + kstep, voffB); PG8_STAGE(PG8_SA(1, 0), cA + kstep, voffA); PG8_STAGE(PG8_SB(1, 1), cB + hstepB + kstep, voffB);
    PG8_WAIT_V(6); PG8_BAR;
    for (;;) {
        const bool has_next = S.next(ui + 1, nxt);
        const char* nA = has_next ? (const char*)g.A + (size_t)nxt.pm * tstepA : cA; const char* nB = has_next ? (const char*)g.Bt + (size_t)nxt.bt * tstepB : cB;
#pragma unroll 1
        for (int t = 0; t < nt; t += 2) {
            const bool last = (t == nt - 2);
            const char* a1 = cA + (size_t)(t + 1) * kstep;
            const char* a2 = last ? nA : cA + (size_t)(t + 2) * kstep; const char* b2 = last ? nB : cB + (size_t)(t + 2) * kstep;
            const char* a3 = a2 + kstep; const char* b3 = b2 + kstep;
            if constexpr (Epi::MID_T > 0) { if (t == Epi::MID_T) E.mid(acc, cur, wr, wc, fr, fq); }
            PG8_LDB(B0, 0, 0); PG8_LDB(B1, 0, 1); PG8_SCHED; PG8_LDA(At, 0, 0); PG8_STAGE(PG8_SA(1, 1), a1 + hstepA, voffA);
            PG8_WAIT_V(8); PG8_WAIT_L(0); PG8_BAR; PG8_MMA(0, 0, At, B0); PG8_MMA(0, 1, At, B1); PG8_BAR; PG8_SCHED;
            PG8_LDA(At, 0, 1); PG8_STAGE(PG8_SB(0, 0), b2, voffB); PG8_STAGE(PG8_SB(0, 1), b2 + hstepB, voffB); PG8_STAGE(PG8_SA(0, 0), a2, voffA);
            PG8_WAIT_V(8); PG8_WAIT_L(0); PG8_BAR; PG8_MMA(1, 0, At, B0); PG8_MMA(1, 1, At, B1); PG8_BAR; PG8_SCHED;
            PG8_LDB(B0, 1, 0); PG8_LDB(B1, 1, 1); PG8_SCHED; PG8_LDA(At, 1, 0); PG8_STAGE(PG8_SA(0, 1), a2 + hstepA, voffA);
            PG8_WAIT_V(8); PG8_WAIT_L(0); PG8_BAR; PG8_MMA(0, 0, At, B0); PG8_MMA(0, 1, At, B1); PG8_BAR; PG8_SCHED;
            PG8_LDA(At, 1, 1); PG8_STAGE(PG8_SB(1, 0), b3, voffB); PG8_STAGE(PG8_SB(1, 1), b3 + hstepB, voffB); PG8_STAGE(PG8_SA(1, 0), a3, voffA);
            PG8_WAIT_V(8); PG8_WAIT_L(0); PG8_BAR; PG8_MMA(1, 0, At, B0); PG8_MMA(1, 1, At, B1); PG8_BAR; PG8_SCHED;
        }
        if constexpr (ALIGN_EPI) { if (wr == 0) PG8_BAR; }
        if constexpr (FP8) {
#pragma unroll
            for (int a = 0; a < 2; ++a)
#pragma unroll
                for (int b = 0; b < 2; ++b)
                    asm volatile("s_nop 15\n\ts_nop 7" : "+v"(acc[a][b][0][0]), "+v"(acc[a][b][0][1]), "+v"(acc[a][b][1][0]), "+v"(acc[a][b][1][1]), "+v"(acc[a][b][2][0]), "+v"(acc[a][b][2][1]), "+v"(acc[a][b][3][0]), "+v"(acc[a][b][3][1]));
        }
        E(acc, cur, wr, wc, fr, fq);
        if (!has_next) break;
#pragma unroll
        for (int a = 0; a < 2; ++a)
#pragma unroll
            for (int b = 0; b < 2; ++b)
#pragma unroll
                for (int m = 0; m < 4; ++m)
#pragma unroll
                    for (int n = 0; n < 2; ++n) acc[a][b][m][n] = (f32x4){0.f, 0.f, 0.f, 0.f};
        cur = nxt; cA = nA; cB = nB; ++ui;
        if constexpr (ALIGN_EPI) { if (wr == 1) PG8_BAR; }
    }
    PG8_WAIT_V(0);
    if constexpr (!ALIGN_EPI) { if (wr == 0) PG8_BAR; }
    PG8_BAR;
#undef PG8_SA
#undef PG8_SB
#undef PG8_STAGE
#undef PG8_LDA
#undef PG8_LDB
#undef PG8_MMA
#undef PG8_LD8
#undef PG8_WAIT_V
#undef PG8_WAIT_L
#undef PG8_BAR
#undef PG8_SCHED
}

typedef f32x4 Acc[2][2][4][2];

struct Epi1 {
    static constexpr bool PERM = true; static constexpr int MID_T = 0;
    bf16_t *yab, *gv, *q, *k, *v, *sa, *sb; float* gvst;
    template <int MODE  >
    __device__ __forceinline__ void run(const Acc& acc, const Unit& u, int wr, int wc, int fr, int fq, bf16_t* base, int ld) const {
        const int row0 = u.pm * BM + wr * 64 + fr, col0 = (u.pn & 3) * 256 + wc * 32 + 8 * fq;
#pragma unroll
        for (int ai = 0; ai < 2; ++ai)
#pragma unroll
            for (int m = 0; m < 4; ++m) {
                const int row = row0 + ai * HALF + m * 16; bf16_t* rowp = base + (size_t)row * ld + col0;
                float s1 = 0.f, s2 = 0.f;
#pragma unroll
                for (int bj = 0; bj < 2; ++bj) {
                    f32x4 v0 = acc[ai][bj][m][0], v1 = acc[ai][bj][m][1];
                    if (MODE == 0 || MODE == 1) {
                        f32x2 a = gelu_pk((f32x2){v0[0], v0[1]}), b = gelu_pk((f32x2){v0[2], v0[3]}), c = gelu_pk((f32x2){v1[0], v1[1]}), d = gelu_pk((f32x2){v1[2], v1[3]});
                        v0 = (f32x4){a.x, a.y, b.x, b.y}; v1 = (f32x4){c.x, c.y, d.x, d.y};
                    } else if (MODE == 2) { v0 = v0 * QSCALE; v1 = v1 * QSCALE; }
                    else if (MODE == 4) {
#pragma unroll
                        for (int j = 0; j < 4; ++j) { v0[j] = sigmoidf_(v0[j]); v1[j] = sigmoidf_(v1[j]); }
                    }
                    if (MODE == 1) {
                        s1 += (v0[0] + v0[1]) + (v0[2] + v0[3]) + (v1[0] + v1[1]) + (v1[2] + v1[3]);
                        s2 += (v0[0] * v0[0] + v0[1] * v0[1]) + (v0[2] * v0[2] + v0[3] * v0[3]) + (v1[0] * v1[0] + v1[1] * v1[1]) + (v1[2] * v1[2] + v1[3] * v1[3]);
                    }
                    u32x4 w; w.x = cvt_pk_bf16(v0[0], v0[1]); w.y = cvt_pk_bf16(v0[2], v0[3]); w.z = cvt_pk_bf16(v1[0], v1[1]); w.w = cvt_pk_bf16(v1[2], v1[3]);
                    *(u32x4*)(rowp + bj * HALF) = w;
                }
                if (MODE == 1) {
                    s1 += __shfl_xor(s1, 16); s1 += __shfl_xor(s1, 32); s2 += __shfl_xor(s2, 16); s2 += __shfl_xor(s2, 32);
                    if (fq == 0) *(f32x2*)(gvst + ((size_t)row * 16 + (u.pn & 3) * 4 + wc) * 2) = (f32x2){s1, s2};
                }
            }
    }
    __device__ __forceinline__ void operator()(const Acc& acc, const Unit& u, int wr, int wc, int fr, int fq) const {
        const int region = u.pn >> 2;
        if (region == 0) run<0>(acc, u, wr, wc, fr, fq, yab, 2048);
        else if (region == 1) run<1>(acc, u, wr, wc, fr, fq, gv, 1024);
        else if (region == 2) run<2>(acc, u, wr, wc, fr, fq, q, 1024);
        else if (region == 3) run<3>(acc, u, wr, wc, fr, fq, k, 1024);
        else if (region == 4) run<3>(acc, u, wr, wc, fr, fq, v, 1024);
        else if (region == 5) run<4>(acc, u, wr, wc, fr, fq, sa, 1024);
        else run<4>(acc, u, wr, wc, fr, fq, sb, 1024);
    }
    __device__ __forceinline__ void mid(Acc&, const Unit&, int, int, int, int) const {}
};

struct Epi2 {
    static constexpr bool PERM = true; static constexpr int MID_T = 16;
    const bf16_t *sa, *sb; bf16_t* mg;
    __device__ __forceinline__ void mid(Acc& acc, const Unit& u, int wr, int wc, int fr, int fq) const {
        int row0 = u.pm * BM + wr * 64 + fr, col0 = u.pn * BM + wc * 32 + 8 * fq;
        asm volatile("" : "+v"(row0), "+v"(col0));
#pragma unroll
        for (int ai = 0; ai < 2; ++ai)
#pragma unroll
            for (int m = 0; m < 4; ++m) {
                const size_t off = (size_t)(row0 + ai * HALF + m * 16) * DM + col0;
#pragma unroll
                for (int bj = 0; bj < 2; ++bj) {
                    const u32x4 a = *(const u32x4*)(sa + off + bj * HALF), b = *(const u32x4*)(sb + off + bj * HALF);
                    f32x4 r0, r1;
#define RQ(x, y) ((x) * __builtin_amdgcn_rcpf(y))
                    r0[0] = RQ(bflo(a.x), bflo(b.x)); r0[1] = RQ(bfhi(a.x), bfhi(b.x)); r0[2] = RQ(bflo(a.y), bflo(b.y)); r0[3] = RQ(bfhi(a.y), bfhi(b.y));
                    r1[0] = RQ(bflo(a.z), bflo(b.z)); r1[1] = RQ(bfhi(a.z), bfhi(b.z)); r1[2] = RQ(bflo(a.w), bflo(b.w)); r1[3] = RQ(bfhi(a.w), bfhi(b.w));
#undef RQ
                    acc[ai][bj][m][0] = acc[ai][bj][m][0] * r0; acc[ai][bj][m][1] = acc[ai][bj][m][1] * r1;
                }
                asm volatile("" : "+v"(acc[ai][0][m][0]), "+v"(acc[ai][0][m][1]), "+v"(acc[ai][1][m][0]), "+v"(acc[ai][1][m][1]));
                asm volatile("" ::: "memory");
            }
    }
    __device__ __forceinline__ void operator()(const Acc& acc, const Unit& u, int wr, int wc, int fr, int fq) const {
        const int row0 = u.pm * BM + wr * 64 + fr, col0 = u.pn * BM + wc * 32 + 8 * fq;
#pragma unroll
        for (int ai = 0; ai < 2; ++ai)
#pragma unroll
            for (int m = 0; m < 4; ++m) {
                const size_t off = (size_t)(row0 + ai * HALF + m * 16) * DM + col0;
#pragma unroll
                for (int bj = 0; bj < 2; ++bj) {
                    const u32x4 b = *(const u32x4*)(sb + off + bj * HALF);
                    const f32x4 v0 = acc[ai][bj][m][0], v1 = acc[ai][bj][m][1];
                    u32x4 w; w.x = cvt_pk_bf16(v0[0] * bflo(b.x), v0[1] * bfhi(b.x)); w.y = cvt_pk_bf16(v0[2] * bflo(b.y), v0[3] * bfhi(b.y));
                    w.z = cvt_pk_bf16(v1[0] * bflo(b.z), v1[1] * bfhi(b.z)); w.w = cvt_pk_bf16(v1[2] * bflo(b.w), v1[3] * bfhi(b.w));
                    *(u32x4*)(mg + off + bj * HALF) = w;
                }
            }
    }
};

struct Epi3 {
    static constexpr bool PERM = false; static constexpr int MID_T = 0;
    const bf16_t* h0; float* z; float* zst;
    __device__ __forceinline__ void mid(Acc&, const Unit&, int, int, int, int) const {}
    __device__ __forceinline__ void operator()(const Acc& acc, const Unit& u, int wr, int wc, int fr, int fq) const {
        const int row0 = u.pm * BM + wr * 64 + fr, col0 = u.pn * BM + wc * 32 + 4 * fq;
#pragma unroll
        for (int ai = 0; ai < 2; ++ai)
#pragma unroll
            for (int m = 0; m < 4; ++m) {
                const int row = row0 + ai * HALF + m * 16; const size_t off = (size_t)row * DM + col0;
                float s1 = 0.f, s2 = 0.f;
#pragma unroll
                for (int bj = 0; bj < 2; ++bj)
#pragma unroll
                    for (int n = 0; n < 2; ++n) {
                        const u32x2 hb = *(const u32x2*)(h0 + off + bj * HALF + n * 16);
                        f32x4 v = acc[ai][bj][m][n];
                        v[0] += ALPHA * bflo(hb.x); v[1] += ALPHA * bfhi(hb.x); v[2] += ALPHA * bflo(hb.y); v[3] += ALPHA * bfhi(hb.y);
                        s1 += (v[0] + v[1]) + (v[2] + v[3]); s2 += (v[0] * v[0] + v[1] * v[1]) + (v[2] * v[2] + v[3] * v[3]);
                        *(f32x4*)(z + off + bj * HALF + n * 16) = v;
                    }
                s1 += __shfl_xor(s1, 16); s1 += __shfl_xor(s1, 32); s2 += __shfl_xor(s2, 16); s2 += __shfl_xor(s2, 32);
                if (fq == 0) *(f32x2*)(zst + ((size_t)row * 16 + u.pn * 4 + wc) * 2) = (f32x2){s1, s2};
            }
    }
};

struct Epi4 {
    static constexpr bool PERM = true; static constexpr int MID_T = 0;
    const float* b_up; unsigned char* act;
    __device__ __forceinline__ void mid(Acc&, const Unit&, int, int, int, int) const {}
    __device__ __forceinline__ void operator()(const Acc& acc, const Unit& u, int wr, int wc, int fr, int fq) const {
        const int e = u.bt >> 3;
        const int row0 = u.pm * BM + wr * 64 + fr, c0 = u.pn * HALF + wc * 32 + 8 * fq;
        const float* bg = b_up + (size_t)e * 2 * FF + c0; const float* bu = bg + FF;
        const f32x4 bg0 = *(const f32x4*)bg, bg1 = *(const f32x4*)(bg + 4), bu0 = *(const f32x4*)bu, bu1 = *(const f32x4*)(bu + 4);
#pragma unroll
        for (int ai = 0; ai < 2; ++ai)
#pragma unroll
            for (int m = 0; m < 4; ++m) {
                const int row = row0 + ai * HALF + m * 16;
                float o[8];
#pragma unroll
                for (int n = 0; n < 2; ++n)
#pragma unroll
                    for (int j = 0; j < 4; ++j) {
                        float gg = acc[ai][0][m][n][j] * 0.03125f + (n ? bg1[j] : bg0[j]), uu = acc[ai][1][m][n][j] * 0.03125f + (n ? bu1[j] : bu0[j]);
                        gg = fminf(gg, 7.0f); uu = fminf(fmaxf(uu, -7.0f), 7.0f);
                        o[n * 4 + j] = (uu + 1.0f) * (gg * sigmoidf_(1.702f * gg));
                    }
                unsigned w0 = 0u, w1 = 0u;
                w0 = __builtin_amdgcn_cvt_pk_fp8_f32(o[0], o[1], w0, false); w0 = __builtin_amdgcn_cvt_pk_fp8_f32(o[2], o[3], w0, true);
                w1 = __builtin_amdgcn_cvt_pk_fp8_f32(o[4], o[5], w1, false); w1 = __builtin_amdgcn_cvt_pk_fp8_f32(o[6], o[7], w1, true);
                *(u32x2*)(act + (size_t)row * FF + c0) = (u32x2){w0, w1};
            }
    }
};

struct Epi5 {
    static constexpr bool PERM = true; static constexpr int MID_T = 0;
    const float* b_down; const float* roww; bf16_t* ys;
    __device__ __forceinline__ void mid(Acc&, const Unit&, int, int, int, int) const {}
    __device__ __forceinline__ void operator()(const Acc& acc, const Unit& u, int wr, int wc, int fr, int fq) const {
        const int e = u.bt >> 2;
        const int row0 = u.pm * BM + wr * 64 + fr, col0 = u.pn * BM + wc * 32 + 8 * fq;
        f32x4 bv[2][2];
#pragma unroll
        for (int bj = 0; bj < 2; ++bj)
#pragma unroll
            for (int n = 0; n < 2; ++n) bv[bj][n] = *(const f32x4*)(b_down + (size_t)e * DM + col0 + bj * HALF + 4 * n);
#pragma unroll
        for (int ai = 0; ai < 2; ++ai)
#pragma unroll
            for (int m = 0; m < 4; ++m) {
                const int row = row0 + ai * HALF + m * 16; const float rw = roww[row];
#pragma unroll
                for (int bj = 0; bj < 2; ++bj) {
                    const f32x4 v0 = (acc[ai][bj][m][0] * 0.015625f + bv[bj][0]) * rw, v1 = (acc[ai][bj][m][1] * 0.015625f + bv[bj][1]) * rw;
                    u32x4 w; w.x = cvt_pk_bf16(v0[0], v0[1]); w.y = cvt_pk_bf16(v0[2], v0[3]); w.z = cvt_pk_bf16(v1[0], v1[1]); w.w = cvt_pk_bf16(v1[2], v1[3]);
                    *(u32x4*)(ys + (size_t)row * DM + col0 + bj * HALF) = w;
                }
            }
    }
};
}

struct Args { const float* in[21]; float* out; unsigned char* ws; int ph_lo, ph_hi; };
enum { I_X = 0, I_LNIN_G, I_LNIN_B, I_WIN, I_GLN_G, I_GLN_B, I_WSP, I_BSP, I_WBA, I_WBB, I_WOUT, I_LNMIX_G, I_LNMIX_B, I_WR, I_BR, I_WUP, I_BUP, I_WDN, I_BDN, I_LNF_G, I_LNF_B };

struct Ctx { const Args* a; unsigned char* ws; LAS unsigned char* lds; unsigned char* ldsg; int tid, lane, wave, G, vcu; };

__device__ __forceinline__ void tr_item(const float* W, int N, int k0, int n0, bf16_t* dst, int drow0, int dld, int dcol0, LAS float* scr, int lane) {
#pragma unroll 8
    for (int i = 0; i < 32; ++i) { const int kk = 2 * i + (lane >> 5); scr[kk * 33 + (lane & 31)] = W[(size_t)(k0 + kk) * N + n0 + (lane & 31)]; }
    asm volatile("s_waitcnt lgkmcnt(0)" ::: "memory");
    const int c = lane & 7;
#pragma unroll
    for (int j = 0; j < 4; ++j) { const int n = (lane >> 3) + 8 * j; const LAS float* s = scr + (8 * c) * 33 + n;
        u32x4 o; o.x = pk2(s[0 * 33], s[1 * 33]); o.y = pk2(s[2 * 33], s[3 * 33]); o.z = pk2(s[4 * 33], s[5 * 33]); o.w = pk2(s[6 * 33], s[7 * 33]);
        *(u32x4*)(dst + (size_t)(drow0 + n) * dld + dcol0 + k0 + 8 * c) = o; }
    asm volatile("s_waitcnt lgkmcnt(0)" ::: "memory");
}
__device__ __forceinline__ void tr_item8(const float* W, int N, int k0, int n0, unsigned char* dst, int drow0, int dld, float sc, LAS float* scr, int lane) {
#pragma unroll 8
    for (int i = 0; i < 32; ++i) { const int kk = 2 * i + (lane >> 5); scr[kk * 33 + (lane & 31)] = W[(size_t)(k0 + kk) * N + n0 + (lane & 31)]; }
    asm volatile("s_waitcnt lgkmcnt(0)" ::: "memory");
    const int c = lane & 7;
#pragma unroll
    for (int j = 0; j < 4; ++j) { const int n = (lane >> 3) + 8 * j; const LAS float* s = scr + (8 * c) * 33 + n;
        unsigned w0 = 0u, w1 = 0u;
        w0 = __builtin_amdgcn_cvt_pk_fp8_f32(s[0 * 33] * sc, s[1 * 33] * sc, w0, false); w0 = __builtin_amdgcn_cvt_pk_fp8_f32(s[2 * 33] * sc, s[3 * 33] * sc, w0, true);
        w1 = __builtin_amdgcn_cvt_pk_fp8_f32(s[4 * 33] * sc, s[5 * 33] * sc, w1, false); w1 = __builtin_amdgcn_cvt_pk_fp8_f32(s[6 * 33] * sc, s[7 * 33] * sc, w1, true);
        *(u32x2*)(dst + (size_t)(drow0 + n) * dld + k0 + 8 * c) = (u32x2){w0, w1}; }
    asm volatile("s_waitcnt lgkmcnt(0)" ::: "memory");
}
__device__ __forceinline__ void ph_prologue(const Ctx& F) {
    const Args& A = *F.a;
    LAS float* scr = (LAS float*)(F.lds + F.wave * 16384);
    const int gw = F.vcu * 8 + F.wave, NGW = F.G * 8;
    bf16_t* WIN = (bf16_t*)(F.ws + WS_WIN); bf16_t* WAB = (bf16_t*)(F.ws + WS_WAB); bf16_t* WOUT = (bf16_t*)(F.ws + WS_WOUT);
    unsigned char* WDN = F.ws + WS_WDN; unsigned char* WUP = F.ws + WS_WUP;
    constexpr int I_IN = 16 * (INCOLS / 32), I_SQ = 16 * 32, I_UP = NE * 16 * 64, I_DN = NE * 16 * 32;
    constexpr int NITEMS = I_IN + 3 * I_SQ + I_UP + I_DN;
    for (int it = gw; it < NITEMS; it += NGW) {
        int r = it;
        if (r < I_IN) { const int nblk = INCOLS / 32, kb = r / nblk, nb = r % nblk; tr_item(A.in[I_WIN], INCOLS, 64 * kb, 32 * nb, WIN, 32 * nb, DM, 0, scr, F.lane); continue; } r -= I_IN;
        if (r < I_SQ) { const int kb = r / 32, nb = r % 32; tr_item(A.in[I_WBA], DM, 64 * kb, 32 * nb, WAB, 32 * nb, 2048, 0, scr, F.lane); continue; } r -= I_SQ;
        if (r < I_SQ) { const int kb = r / 32, nb = r % 32; tr_item(A.in[I_WBB], DM, 64 * kb, 32 * nb, WAB, 32 * nb, 2048, 1024, scr, F.lane); continue; } r -= I_SQ;
        if (r < I_SQ) { const int kb = r / 32, nb = r % 32; tr_item(A.in[I_WOUT], DM, 64 * kb, 32 * nb, WOUT, 32 * nb, DM, 0, scr, F.lane); continue; } r -= I_SQ;
        if (r < I_UP) { const int e = r / (16 * 64), rr = r % (16 * 64), kb = rr / 64, nb = rr % 64; const int n0 = 32 * nb, half = n0 >= FF, rem = n0 - half * FF, pn = rem >> 7, b = (rem & 127) >> 5;
            tr_item8(A.in[I_WUP] + (size_t)e * DM * 2 * FF, 2 * FF, 64 * kb, n0, WUP, e * 2048 + 256 * pn + half * 128 + 32 * b, DM, 32.0f, scr, F.lane); continue; } r -= I_UP;
        { const int e = r / (16 * 32), rr = r % (16 * 32), kb = rr / 32, nb = rr % 32; tr_item8(A.in[I_WDN] + (size_t)e * FF * DM, DM, 64 * kb, 32 * nb, WDN, e * 1024 + 32 * nb, FF, 64.0f, scr, F.lane); }
    }
    const float* lg = A.in[I_LNIN_G]; const float* lb = A.in[I_LNIN_B]; bf16_t* H0 = (bf16_t*)(F.ws + WS_H0);
    f32x4 gg[4], bb[4];
#pragma unroll
    for (int j = 0; j < 4; ++j) { gg[j] = *((const f32x4*)lg + F.lane + 64 * j); bb[j] = *((const f32x4*)lb + F.lane + 64 * j); }
    for (int m = gw; m < T; m += NGW) {
        const f32x4* xr = (const f32x4*)(A.in[I_X] + (size_t)m * DM) + F.lane;
        f32x4 v[4]; float s = 0.f;
#pragma unroll
        for (int j = 0; j < 4; ++j) { v[j] = xr[64 * j]; s += (v[j].x + v[j].y) + (v[j].z + v[j].w); }
        const float mean = wave_sum(s) * (1.f / DM); float s2 = 0.f;
#pragma unroll
        for (int j = 0; j < 4; ++j) { v[j] = v[j] - mean; s2 += (v[j].x * v[j].x + v[j].y * v[j].y) + (v[j].z * v[j].z + v[j].w * v[j].w); }
        const float rstd = 1.f / sqrtf(wave_sum(s2) * (1.f / DM) + LN_EPS);
        u32x2* o8 = (u32x2*)(H0 + (size_t)m * DM) + F.lane;
#pragma unroll
        for (int j = 0; j < 4; ++j) { const f32x4 y = v[j] * rstd * gg[j] + bb[j]; o8[64 * j] = (u32x2){pk2(y.x, y.y), pk2(y.z, y.w)}; }
    }
}

__device__ __forceinline__ void ph_kmean(const Ctx& F) {
    const bf16_t* K = (const bf16_t*)(F.ws + WS_K); float* KM = (float*)(F.ws + WS_KMEAN);
    float* red = (float*)F.ldsg;
    const int d = F.tid & 127, part = F.tid >> 7;
    for (int it = F.vcu; it < NB * NH * NBLK; it += F.G) {
        const int b = it / (NH * NBLK), h = (it / NBLK) % NH, j = it % NBLK;
        const bf16_t* kp = K + ((size_t)(b * SEQ + j * LBLK + part * 64)) * DM + h * DH + d;
        float s = 0.f;
        for (int r = 0; r < 64; ++r) s += bf2f(kp[(size_t)r * DM]);
        red[part * 128 + d] = s;
        __syncthreads();
        if (F.tid < 128) KM[(size_t)it * DH + d] = (red[d] + red[128 + d] + red[256 + d] + red[384 + d]) * (1.0f / LBLK);
        __syncthreads();
    }
}
typedef short v4i16_t __attribute__((ext_vector_type(4)));
__device__ __forceinline__ v4i16_t lds_tr16(LAS const unsigned char* p) { return __builtin_amdgcn_ds_read_tr16_b64_v4i16((LAS v4i16_t*)p); }
__device__ __forceinline__ void ph_mixer_a(const Ctx& F) {
    const Args& A = *F.a;
    const bf16_t* GV = (const bf16_t*)(F.ws + WS_GV); bf16_t* YAB = (bf16_t*)(F.ws + WS_YAB); const float* GVST = (const float*)(F.ws + WS_GVST);
    const float* lg = A.in[I_GLN_G]; const float* lb = A.in[I_GLN_B]; const float* wsp = A.in[I_WSP]; const float* bsp = A.in[I_BSP];
    constexpr int RSV = 544, RSW = 272, OFF_W = 128 * RSV, OFF_ST = OFF_W + 128 * RSW;
    LAS unsigned char* VT = F.lds; LAS unsigned char* WT = F.lds + OFF_W; LAS float* ST = (LAS float*)(F.lds + OFF_ST);
    const int lane = F.lane, wv = F.wave;
    int curg = -1;
    for (int it = F.vcu; it < NB * 32 * 4; it += F.G) {
        const int b = it / 128, c = (it >> 2) & 31, g = it & 3;
        const int tok0 = b * SEQ + c * 128;
        if (g != curg) {
            curg = g;
            for (int k = 0; k < 4; ++k) {
                const int idx = F.tid + 512 * k, t = idx >> 4, s8 = (idx & 15) * 8;
                const f32x4 w0 = *(const f32x4*)(wsp + ((size_t)g * 128 + t) * 128 + s8), w1 = *(const f32x4*)(wsp + ((size_t)g * 128 + t) * 128 + s8 + 4);
                float x[8] = {w0.x, w0.y, w0.z, w0.w, w1.x, w1.y, w1.z, w1.w};
#pragma unroll
                for (int j = 0; j < 8; ++j) x[j] = (s8 + j <= t) ? x[j] : 0.f;
                u32x4 o; o.x = pk2(x[0], x[1]); o.y = pk2(x[2], x[3]); o.z = pk2(x[4], x[5]); o.w = pk2(x[6], x[7]);
                *(LAS u32x4*)(WT + t * RSW + s8 * 2) = o;
            }
        }
        if (F.tid < 128) {
            const float* p = GVST + (size_t)(tok0 + F.tid) * 32; float s1 = 0.f, s2 = 0.f;
            for (int i = 0; i < 16; ++i) { s1 += p[2 * i]; s2 += p[2 * i + 1]; }
            const float mean = s1 * (1.f / DM), var = s2 * (1.f / DM) - mean * mean;
            ST[2 * F.tid] = mean; ST[2 * F.tid + 1] = 1.f / sqrtf(fmaxf(var, 0.f) + LN_EPS);
        }
        __syncthreads();
        {
            const int dc = F.tid & 31;
            const f32x4 g0 = *(const f32x4*)(lg + g * 256 + dc * 8), g1 = *(const f32x4*)(lg + g * 256 + dc * 8 + 4), b0 = *(const f32x4*)(lb + g * 256 + dc * 8), b1 = *(const f32x4*)(lb + g * 256 + dc * 8 + 4);
#pragma unroll
            for (int k = 0; k < 8; ++k) {
                const int s = (F.tid >> 5) + 16 * k;
                const u32x4 raw = *(const u32x4*)(GV + (size_t)(tok0 + s) * DM + g * 256 + dc * 8);
                const float mean = ST[2 * s], rstd = ST[2 * s + 1];
                f32x4 x0 = {bflo(raw.x), bfhi(raw.x), bflo(raw.y), bfhi(raw.y)}, x1 = {bflo(raw.z), bfhi(raw.z), bflo(raw.w), bfhi(raw.w)};
                x0 = (x0 - mean) * rstd * g0 + b0; x1 = (x1 - mean) * rstd * g1 + b1;
                u32x4 o; o.x = pk2(x0.x, x0.y); o.y = pk2(x0.z, x0.w); o.z = pk2(x1.x, x1.y); o.w = pk2(x1.z, x1.w);
                *(LAS u32x4*)(VT + s * RSV + dc * 16) = o;
            }
        }
        __syncthreads();
        {
            const int dbase = 32 * wv, kg = lane >> 4, q = (lane & 15) >> 2, p = lane & 3, fr = lane & 15;
            bf16x8 Af[2][4];
#pragma unroll
            for (int m = 0; m < 2; ++m)
#pragma unroll
                for (int kk = 0; kk < 4; ++kk) {
                    LAS const unsigned char* ap = VT + (32 * kk + 8 * kg + q) * RSV + (dbase + 16 * m + 4 * p) * 2;
                    const v4i16_t lo = lds_tr16(ap), hi = lds_tr16(ap + 4 * RSV);
                    Af[m][kk] = (bf16x8){lo[0], lo[1], lo[2], lo[3], hi[0], hi[1], hi[2], hi[3]};
                }
#pragma unroll
            for (int n = 0; n < 8; ++n) {
                f32x4 acc0 = {0.f, 0.f, 0.f, 0.f}, acc1 = {0.f, 0.f, 0.f, 0.f};
#pragma unroll
                for (int kk = 0; kk < 4; ++kk) if (kk <= (n >> 1)) {
                    const bf16x8 Bf = *(LAS const bf16x8*)(WT + (16 * n + fr) * RSW + (32 * kk + 8 * kg) * 2);
                    acc0 = __builtin_amdgcn_mfma_f32_16x16x32_bf16(Af[0][kk], Bf, acc0, 0, 0, 0);
                    acc1 = __builtin_amdgcn_mfma_f32_16x16x32_bf16(Af[1][kk], Bf, acc1, 0, 0, 0);
                }
                const int t = 16 * n + fr; const float bsv = bsp[g * 128 + t];
                bf16_t* yp = YAB + (size_t)(tok0 + t) * 2048 + g * 256 + dbase + 4 * kg;
                const u32x2 u0 = *(const u32x2*)yp, u1 = *(const u32x2*)(yp + 16);
                u32x2 o0, o1;
                o0.x = pk2(bflo(u0.x) * (acc0[0] + bsv), bfhi(u0.x) * (acc0[1] + bsv)); o0.y = pk2(bflo(u0.y) * (acc0[2] + bsv), bfhi(u0.y) * (acc0[3] + bsv));
                o1.x = pk2(bflo(u1.x) * (acc1[0] + bsv), bfhi(u1.x) * (acc1[1] + bsv)); o1.y = pk2(bflo(u1.y) * (acc1[2] + bsv), bfhi(u1.y) * (acc1[3] + bsv));
                *(u32x2*)yp = o0; *(u32x2*)(yp + 16) = o1;
            }
        }
        __syncthreads();
    }
}

__device__ __forceinline__ void ph_gate(const Ctx& F) {
    const bf16_t* Q = (const bf16_t*)(F.ws + WS_Q); const float* KM = (const float*)(F.ws + WS_KMEAN);
    unsigned* SEL = (unsigned*)(F.ws + WS_SEL); unsigned* LISTS = (unsigned*)(F.ws + WS_LISTS); unsigned* LCNT = (unsigned*)(F.ws + WS_CTL) + CW_LCNT;
    float* km = (float*)F.ldsg;
    unsigned* lc = (unsigned*)(F.ldsg + 8192);
    for (int it = F.vcu; it < NB * NH * 8; it += F.G) {
        const int b = it / 64, h = (it >> 3) & 7, tc = it & 7;
        for (int i = F.tid; i < NBLK * DH; i += 512) km[i] = KM[(size_t)(b * NH + h) * NBLK * DH + i];
        if (F.tid < 32) lc[F.tid] = 0u;
        __syncthreads();
        const int t = tc * 512 + F.tid, qi = t >> 8;
        float gsc[15];
#pragma unroll
        for (int j = 0; j < 15; ++j) gsc[j] = 0.f;
        const bf16_t* qp = Q + (size_t)(b * SEQ + t) * DM + h * DH;
        for (int c = 0; c < 16; ++c) {
            const u32x4 raw = *(const u32x4*)(qp + c * 8);
            const float x[8] = {bflo(raw.x), bfhi(raw.x), bflo(raw.y), bfhi(raw.y), bflo(raw.z), bfhi(raw.z), bflo(raw.w), bfhi(raw.w)};
#pragma unroll
            for (int j = 0; j < 15; ++j) if (j < qi) {
                const float* kk = km + j * DH + c * 8;
#pragma unroll
                for (int e = 0; e < 8; ++e) gsc[j] += x[e] * kk[e];
            }
        }
        const int nsel = qi < 3 ? qi : 3;
        int sel[3] = {0, 0, 0}; unsigned lpos[3] = {0, 0, 0};
#pragma unroll
        for (int r = 0; r < 3; ++r) {
            float best = -INFINITY; int bi = -1;
#pragma unroll
            for (int j = 0; j < 15; ++j) { const bool c = (j < qi) && (gsc[j] > best); best = c ? gsc[j] : best; bi = c ? j : bi; }
#pragma unroll
            for (int j = 0; j < 15; ++j) if (j == bi) gsc[j] = -INFINITY;
            sel[r] = bi < 0 ? 0 : bi;
            if (r < nsel) lpos[r] = atomicAdd(&lc[sel[r]], 1u);
        }
        SEL[(size_t)(b * SEQ + t) * NH + h] = (unsigned)sel[0] | ((unsigned)sel[1] << 8) | ((unsigned)sel[2] << 16) | ((unsigned)nsel << 24);
        __syncthreads();
        if (F.tid < 16) lc[16 + F.tid] = lc[F.tid] ? atomicAdd(&LCNT[(b * NH + h) * NBLK + F.tid], lc[F.tid]) : 0u;
        __syncthreads();
#pragma unroll
        for (int r = 0; r < 3; ++r) if (r < nsel) LISTS[(size_t)((b * NH + h) * NBLK + sel[r]) * 4096 + lc[16 + sel[r]] + lpos[r]] = (unsigned)t | ((unsigned)r << 12);
        __syncthreads();
    }
}

__device__ __forceinline__ void ph_attn_naive(const Ctx& F) {
    const bf16_t* Q = (const bf16_t*)(F.ws + WS_Q); const bf16_t* K = (const bf16_t*)(F.ws + WS_K); const bf16_t* V = (const bf16_t*)(F.ws + WS_V);
    const unsigned* SEL = (const unsigned*)(F.ws + WS_SEL); bf16_t* YAB = (bf16_t*)(F.ws + WS_YAB);
    float* qs = (float*)(F.ldsg + F.wave * 4608);
    float* sc = qs + 128;
    const int gw = F.vcu * 8 + F.wave, NGW = F.G * 8;
    for (int w = gw; w < NB * NH * SEQ; w += NGW) {
        const int b = w / (NH * SEQ), h = (w / SEQ) % NH, t = w % SEQ, qi = t >> 8, tl = t & 255;
        const size_t tok = (size_t)b * SEQ + t;
        { const unsigned qq = *(const unsigned*)(Q + tok * DM + h * DH + 2 * F.lane); qs[2 * F.lane] = bflo(qq); qs[2 * F.lane + 1] = bfhi(qq); }
        const unsigned selw = SEL[tok * NH + h]; const int nsel = selw >> 24;
        float mx = -INFINITY;
        for (int r = 0; r <= nsel; ++r) {
            const int jb = (r < nsel) ? (int)((selw >> (8 * r)) & 0xff) : qi;
            for (int c = 0; c < 4; ++c) {
                const int key = c * 64 + F.lane;
                const bool valid = (r < nsel) || (key <= tl);
                const bf16_t* kp = K + ((size_t)b * SEQ + jb * LBLK + key) * DM + h * DH;
                float s = 0.f;
#pragma unroll 4
                for (int dd = 0; dd < 16; ++dd) {
                    const u32x4 raw = *(const u32x4*)(kp + dd * 8);
                    const float* q8 = qs + dd * 8;
                    s += bflo(raw.x) * q8[0] + bfhi(raw.x) * q8[1] + bflo(raw.y) * q8[2] + bfhi(raw.y) * q8[3] + bflo(raw.z) * q8[4] + bfhi(raw.z) * q8[5] + bflo(raw.w) * q8[6] + bfhi(raw.w) * q8[7];
                }
                s = valid ? s : -INFINITY;
                sc[r * 256 + key] = s; mx = fmaxf(mx, s);
            }
        }
        mx = wave_max(mx);
        float l = 0.f;
        const int ntot = (nsel + 1) * 256;
        for (int i = F.lane; i < ntot; i += 64) { const float p = __builtin_amdgcn_exp2f(sc[i] - mx); sc[i] = p; l += p; }
        l = wave_sum(l);
        float o0 = 0.f, o1 = 0.f;
        for (int r = 0; r <= nsel; ++r) {
            const int jb = (r < nsel) ? (int)((selw >> (8 * r)) & 0xff) : qi;
            const int nk = (r < nsel) ? 256 : tl + 1;
            const bf16_t* vp = V + ((size_t)b * SEQ + jb * LBLK) * DM + h * DH + 2 * F.lane;
#pragma unroll 4
            for (int key = 0; key < nk; ++key) { const unsigned vv = *(const unsigned*)(vp + (size_t)key * DM); const float p = sc[r * 256 + key]; o0 += p * bflo(vv); o1 += p * bfhi(vv); }
        }
        const float il = 1.f / l;
        *(unsigned*)(YAB + tok * 2048 + 1024 + h * DH + 2 * F.lane) = pk2(o0 * il, o1 * il);
    }
}

typedef float f32x16 __attribute__((ext_vector_type(16)));
namespace att {
constexpr int KCH = 4112, VDB = 16448, OFF_K = 0, OFF_V = 16 * KCH, OFF_WS = OFF_V + 4 * VDB  , WSW = 512, OFF_TAB = OFF_WS + 8 * WSW  ;
static_assert(OFF_TAB + 1028 * 4 <= LDS_BYTES, "attention LDS map");
__device__ __forceinline__ int crow(int r, int hi) { return (r & 3) + 8 * (r >> 2) + 4 * hi; }
#define TRR(dst, vaddr, off) asm volatile("ds_read_b64_tr_b16 %0, %1 offset:%c2" : "=v"(dst) : "v"(vaddr), "i"(off) : "memory")
#define TRWAIT() do { asm volatile("s_waitcnt lgkmcnt(0)" ::: "memory"); __builtin_amdgcn_sched_barrier(0); } while (0)

__device__ __forceinline__ void load_kv(const Ctx& F, const bf16_t* K, const bf16_t* V, size_t tokbase, int h) {
    u32x4 kv[8], vv[8];
#pragma unroll
    for (int k = 0; k < 8; ++k) { const int idx = F.tid + 512 * k, key = idx >> 4, c = idx & 15; const size_t off = (tokbase + key) * DM + h * DH + c * 8;
        kv[k] = *(const u32x4*)(K + off); vv[k] = *(const u32x4*)(V + off); }
#pragma unroll
    for (int k = 0; k < 8; ++k) { const int idx = F.tid + 512 * k, key = idx >> 4, c = idx & 15;
        *(LAS u32x4*)(F.lds + OFF_K + c * KCH + key * 16) = kv[k];
        *(LAS u32x4*)(F.lds + OFF_V + (c >> 2) * VDB + (key >> 3) * 512 + (key & 7) * 64 + (c & 3) * 16) = vv[k]; }
}

template <bool CAUSAL>
__device__ __forceinline__ void core(const Ctx& F, const bf16_t* qrow, f32x16 (&o)[4], float& m, float& l) {
    const int r = F.lane & 31, hh = F.lane >> 5;
    LAS float* wsf = (LAS float*)(F.lds + OFF_WS + F.wave * WSW);
    bf16x8 qr[8];
#pragma unroll
    for (int ds = 0; ds < 8; ++ds) qr[ds] = *(const bf16x8*)(qrow + ds * 16 + hh * 8);
#pragma unroll
    for (int db = 0; db < 4; ++db)
#pragma unroll
        for (int i = 0; i < 16; ++i) o[db][i] = 0.f;
    m = -1e30f; l = 0.f;
    const int nt = CAUSAL ? (F.wave >> 1) + 1 : 4;
    LAS const unsigned char* kbase = F.lds + OFF_K + hh * KCH + r * 16;
    LAS const unsigned char* vbase = F.lds + OFF_V + (4 * hh + ((F.lane & 15) >> 2)) * 64 + ((F.lane >> 4) & 1) * 32 + (F.lane & 3) * 8;
    for (int kt = 0; kt < nt; ++kt) {
        const bool diag = CAUSAL && (kt == nt - 1);
        constexpr bool skip1 = false;
        f32x16 p0, p1;
#pragma unroll
        for (int i = 0; i < 16; ++i) { p0[i] = 0.f; p1[i] = 0.f; }
        LAS const unsigned char* kp = kbase + (64 * kt) * 16;
        LAS const unsigned char* vp = vbase + (8 * kt) * 512;
        {
            bf16x8 ka[8], kb[8];
#pragma unroll
            for (int ds = 0; ds < 8; ++ds) ka[ds] = *(LAS const bf16x8*)(kp + 2 * ds * KCH);
            if (!skip1) {
#pragma unroll
                for (int ds = 0; ds < 8; ++ds) kb[ds] = *(LAS const bf16x8*)(kp + 2 * ds * KCH + 512);
            }
            __builtin_amdgcn_sched_barrier(0);
#pragma unroll
            for (int ds = 0; ds < 8; ++ds) p0 = __builtin_amdgcn_mfma_f32_32x32x16_bf16(ka[ds], qr[ds], p0, 0, 0, 0);
            if (!skip1) {
#pragma unroll
                for (int ds = 0; ds < 8; ++ds) p1 = __builtin_amdgcn_mfma_f32_32x32x16_bf16(kb[ds], qr[ds], p1, 0, 0, 0);
            }
            __builtin_amdgcn_sched_barrier(0);
        }
        v4i16_t vl[2][4], vh[2][4];
        const unsigned vaddr = (unsigned)(uintptr_t)vp;
#pragma unroll
        for (int ks = 0; ks < 2; ++ks)
#pragma unroll
            for (int db = 0; db < 4; ++db) { TRR(vl[ks][db], vaddr, db * VDB + ks * 1024); TRR(vh[ks][db], vaddr, db * VDB + ks * 1024 + 512); }
        __builtin_amdgcn_sched_barrier(0);
        if (diag) {
            if (F.wave & 1) {
#pragma unroll
                for (int i = 0; i < 16; ++i) p1[i] = (crow(i, hh) > r) ? -INFINITY : p1[i];
            } else {
#pragma unroll
                for (int i = 0; i < 16; ++i) { p0[i] = (crow(i, hh) > r) ? -INFINITY : p0[i]; p1[i] = -INFINITY; }
            }
        }
        float mx = fmaxf(p0[0], p1[0]);
#pragma unroll
        for (int i = 1; i < 16; ++i) mx = fmaxf(mx, fmaxf(p0[i], p1[i]));
        mx = fmaxf(mx, __shfl_xor(mx, 32));
        const float mnew = fmaxf(m, mx);
        if (__any(mnew > m)) {
            const float alpha = __builtin_amdgcn_exp2f(m - mnew);
            l *= alpha; m = mnew;
            if (hh == 0) wsf[r] = alpha;
            asm volatile("s_waitcnt lgkmcnt(0)" ::: "memory");
#pragma unroll
            for (int i = 0; i < 16; ++i) { const float a = wsf[crow(i, hh)];
#pragma unroll
                for (int db = 0; db < 4; ++db) o[db][i] *= a; }
        }
        float ls = 0.f;
#pragma unroll
        for (int i = 0; i < 16; ++i) { p0[i] = __builtin_amdgcn_exp2f(p0[i] - m); p1[i] = __builtin_amdgcn_exp2f(p1[i] - m); ls += p0[i] + p1[i]; }
        l += ls;
        u32x4 pw[4];
#pragma unroll
        for (int s2 = 0; s2 < 2; ++s2) {
            pw[s2] = (u32x4){cvt_pk_bf16(p0[8 * s2], p0[8 * s2 + 1]), cvt_pk_bf16(p0[8 * s2 + 2], p0[8 * s2 + 3]), cvt_pk_bf16(p0[8 * s2 + 4], p0[8 * s2 + 5]), cvt_pk_bf16(p0[8 * s2 + 6], p0[8 * s2 + 7])};
            pw[2 + s2] = (u32x4){cvt_pk_bf16(p1[8 * s2], p1[8 * s2 + 1]), cvt_pk_bf16(p1[8 * s2 + 2], p1[8 * s2 + 3]), cvt_pk_bf16(p1[8 * s2 + 4], p1[8 * s2 + 5]), cvt_pk_bf16(p1[8 * s2 + 6], p1[8 * s2 + 7])};
        }
        TRWAIT();
        v4i16_t wl[2][4], wh[2][4];
        if (!skip1) {
#pragma unroll
            for (int ks = 0; ks < 2; ++ks)
#pragma unroll
                for (int db = 0; db < 4; ++db) { TRR(wl[ks][db], vaddr, db * VDB + (2 + ks) * 1024); TRR(wh[ks][db], vaddr, db * VDB + (2 + ks) * 1024 + 512); }
        }
        __builtin_amdgcn_sched_barrier(0);
#pragma unroll
        for (int ks = 0; ks < 2; ++ks) {
            const bf16x8 pa = __builtin_bit_cast(bf16x8, pw[ks]);
#pragma unroll
            for (int db = 0; db < 4; ++db) {
                const bf16x8 vf = (bf16x8){vl[ks][db][0], vl[ks][db][1], vl[ks][db][2], vl[ks][db][3], vh[ks][db][0], vh[ks][db][1], vh[ks][db][2], vh[ks][db][3]};
                o[db] = __builtin_amdgcn_mfma_f32_32x32x16_bf16(pa, vf, o[db], 0, 0, 0);
            }
        }
        TRWAIT();
        if (!skip1) {
#pragma unroll
            for (int ks = 0; ks < 2; ++ks) {
                const bf16x8 pa = __builtin_bit_cast(bf16x8, pw[2 + ks]);
#pragma unroll
                for (int db = 0; db < 4; ++db) {
                    const bf16x8 vf = (bf16x8){wl[ks][db][0], wl[ks][db][1], wl[ks][db][2], wl[ks][db][3], wh[ks][db][0], wh[ks][db][1], wh[ks][db][2], wh[ks][db][3]};
                    o[db] = __builtin_amdgcn_mfma_f32_32x32x16_bf16(pa, vf, o[db], 0, 0, 0);
                }
            }
        }
        __builtin_amdgcn_sched_barrier(0);
    }
}
__device__ __forceinline__ void finish_and_stage(const Ctx& F, const f32x16 (&o)[4], float m, float l) {
    const int r = F.lane & 31, hh = F.lane >> 5;
    LAS float* wsf = (LAS float*)(F.lds + OFF_WS + F.wave * WSW);
    const float lt = l + __shfl_xor(l, 32);
    if (hh == 0) { wsf[r] = 1.0f / lt; wsf[32 + r] = m + __builtin_amdgcn_logf(lt); }
    __syncthreads();
    LAS float* stg = (LAS float*)(F.lds + F.wave * 16384);
#pragma unroll
    for (int i = 0; i < 16; ++i) { const int q = crow(i, hh); const float a = wsf[q];
#pragma unroll
        for (int db = 0; db < 4; ++db) stg[q * 128 + 32 * db + r] = o[db][i] * a; }
    asm volatile("s_waitcnt lgkmcnt(0)" ::: "memory");
}
}

__device__ __forceinline__ void ph_attn_partial(const Ctx& F) {
    using namespace att;
    const bf16_t* Q = (const bf16_t*)(F.ws + WS_Q); const bf16_t* K = (const bf16_t*)(F.ws + WS_K); const bf16_t* V = (const bf16_t*)(F.ws + WS_V);
    const unsigned* LISTS = (const unsigned*)(F.ws + WS_LISTS); const unsigned* LCNT = (const unsigned*)(F.ws + WS_CTL) + CW_LCNT;
    bf16_t* OP = (bf16_t*)(F.ws + WS_OP); float* LSE = (float*)(F.ws + WS_LSE);
    LAS int* P = (LAS int*)(F.lds + OFF_TAB);
    if (F.tid < 64) {
        int c[16]; int s = 0;
#pragma unroll
        for (int i = 0; i < 16; ++i) { c[i] = ((int)__hip_atomic_load(LCNT + F.tid * 16 + i, __ATOMIC_RELAXED, __HIP_MEMORY_SCOPE_AGENT) + 255) >> 8; s += c[i]; }
        int inc = s;
#pragma unroll
        for (int o = 1; o < 64; o <<= 1) { const int t = __shfl_up(inc, o); if (F.lane >= o) inc += t; }
        int run = inc - s;
#pragma unroll
        for (int i = 0; i < 16; ++i) { P[F.tid * 16 + i] = run; run += c[i]; }
        if (F.tid == 63) P[1024] = run;
    }
    __syncthreads();
    const int total = P[1024];
    LAS float* wsf = (LAS float*)(F.lds + OFF_WS + F.wave * WSW);
    LAS int* wsi = (LAS int*)wsf;
    for (int item = F.vcu; item < total; item += F.G) {
        int lo = 0, hi = 1023;
        while (lo < hi) { const int mid = (lo + hi + 1) >> 1; if (P[mid] <= item) lo = mid; else hi = mid - 1; }
        const int bhj = lo, chunk = item - P[lo];
        const int b = bhj >> 7, h = (bhj >> 4) & 7, j = bhj & 15;
        const int cnt = (int)__hip_atomic_load(LCNT + bhj, __ATOMIC_RELAXED, __HIP_MEMORY_SCOPE_AGENT);
        load_kv(F, K, V, (size_t)b * SEQ + j * LBLK, h);
        const int r = F.lane & 31, qi = chunk * 256 + F.wave * 32 + r;
        const unsigned ent = LISTS[(size_t)bhj * 4096 + (qi < cnt ? qi : 0)];
        const int tq = ent & 4095, slot = (qi < cnt) ? (int)(ent >> 12) : -1;
        if (F.lane < 32) { wsi[64 + r] = tq; wsi[96 + r] = slot; }
        __syncthreads();
        f32x16 o[4]; float m, l;
        core<false>(F, Q + ((size_t)b * SEQ + tq) * DM + h * DH, o, m, l);
        finish_and_stage(F, o, m, l);
        LAS const float* stg = (LAS const float*)(F.lds + F.wave * 16384);
#pragma unroll
        for (int ps = 0; ps < 8; ++ps) {
            const int q = ps * 4 + (F.lane >> 4), dc = F.lane & 15;
            const f32x4 a = *(LAS const f32x4*)(stg + q * 128 + dc * 8), c = *(LAS const f32x4*)(stg + q * 128 + dc * 8 + 4);
            const int t = wsi[64 + q], sl = wsi[96 + q];
            if (sl >= 0) {
                const size_t row = (((size_t)sl * NB + b) * SEQ + t) * NH + h;
                u32x4 w; w.x = cvt_pk_bf16(a.x, a.y); w.y = cvt_pk_bf16(a.z, a.w); w.z = cvt_pk_bf16(c.x, c.y); w.w = cvt_pk_bf16(c.z, c.w);
                *(u32x4*)(OP + row * DH + dc * 8) = w;
                if (dc == 0) LSE[row] = wsf[32 + q];
            }
        }
        __syncthreads();
    }
}

__device__ __forceinline__ void ph_attn_own(const Ctx& F) {
    using namespace att;
    const bf16_t* Q = (const bf16_t*)(F.ws + WS_Q); const bf16_t* K = (const bf16_t*)(F.ws + WS_K); const bf16_t* V = (const bf16_t*)(F.ws + WS_V);
    const bf16_t* OP = (const bf16_t*)(F.ws + WS_OP); const float* LSE = (const float*)(F.ws + WS_LSE); bf16_t* YAB = (bf16_t*)(F.ws + WS_YAB);
    LAS float* wsf = (LAS float*)(F.lds + OFF_WS + F.wave * WSW);
    for (int it = F.vcu; it < NB * NH * NBLK; it += F.G) {
        const int b = it >> 7, h = (it >> 4) & 7, j = it & 15;
        load_kv(F, K, V, (size_t)b * SEQ + j * LBLK, h);
        __syncthreads();
        const int r = F.lane & 31, t0 = j * LBLK + F.wave * 32;
        f32x16 o[4]; float m, l;
        core<true>(F, Q + ((size_t)b * SEQ + t0 + r) * DM + h * DH, o, m, l);
        finish_and_stage(F, o, m, l);
        LAS const float* stg = (LAS const float*)(F.lds + F.wave * 16384);
        const int nv = j < 3 ? j : 3;
#pragma unroll 2
        for (int ps = 0; ps < 8; ++ps) {
            const int q = ps * 4 + (F.lane >> 4), dc = F.lane & 15, t = t0 + q;
            const f32x4 a = *(LAS const f32x4*)(stg + q * 128 + dc * 8), c = *(LAS const f32x4*)(stg + q * 128 + dc * 8 + 4);
            const float lse_own = wsf[32 + q];
            float ls[3] = {-1e30f, -1e30f, -1e30f}; u32x4 pv[3] = {};
#pragma unroll
            for (int s2 = 0; s2 < 3; ++s2) if (s2 < nv) { const size_t row = (((size_t)s2 * NB + b) * SEQ + t) * NH + h; ls[s2] = LSE[row]; pv[s2] = *(const u32x4*)(OP + row * DH + dc * 8); }
            const float M = fmaxf(fmaxf(lse_own, ls[0]), fmaxf(ls[1], ls[2]));
            const float w0 = __builtin_amdgcn_exp2f(lse_own - M);
            float den = w0; f32x4 x0 = a * w0, x1 = c * w0;
#pragma unroll
            for (int s2 = 0; s2 < 3; ++s2) {
                const float w = (s2 < nv) ? __builtin_amdgcn_exp2f(ls[s2] - M) : 0.f; den += w;
                x0.x += w * bflo(pv[s2].x); x0.y += w * bfhi(pv[s2].x); x0.z += w * bflo(pv[s2].y); x0.w += w * bfhi(pv[s2].y);
                x1.x += w * bflo(pv[s2].z); x1.y += w * bfhi(pv[s2].z); x1.z += w * bflo(pv[s2].w); x1.w += w * bfhi(pv[s2].w);
            }
            const float id = 1.0f / den; x0 = x0 * id; x1 = x1 * id;
            u32x4 w; w.x = cvt_pk_bf16(x0.x, x0.y); w.y = cvt_pk_bf16(x0.z, x0.w); w.z = cvt_pk_bf16(x1.x, x1.y); w.w = cvt_pk_bf16(x1.z, x1.w);
            *(u32x4*)(YAB + ((size_t)b * SEQ + t) * 2048 + 1024 + h * DH + dc * 8) = w;
        }
        __syncthreads();
    }
}

__device__ __forceinline__ void ln_stats16(const float* st, int lane, float& mean, float& rstd) {
    float s1 = 0.f, s2 = 0.f;
    if (lane < 16) { const f32x2 p = *(const f32x2*)(st + 2 * lane); s1 = p.x; s2 = p.y; }
    s1 = wave_sum(s1); s2 = wave_sum(s2);
    mean = s1 * (1.f / DM); const float var = s2 * (1.f / DM) - mean * mean; rstd = 1.f / sqrtf(fmaxf(var, 0.f) + LN_EPS);
}
__device__ __forceinline__ void ph_router(const Ctx& F) {
    const Args& A = *F.a;
    const float* Z = (const float*)(F.ws + WS_Z); const float* ZST = (const float*)(F.ws + WS_ZST); bf16_t* H1 = (bf16_t*)(F.ws + WS_H1);
    int* TKE = (int*)(F.ws + WS_TKE); float* TKW = (float*)(F.ws + WS_TKW); int* TKP = (int*)(F.ws + WS_TKP); unsigned* ECNT = (unsigned*)(F.ws + WS_CTL) + CW_ECNT;
    const float* wr = A.in[I_WR]; const float* br = A.in[I_BR];
    constexpr int RS = 2064, OFF_LO = 32 * RS, OFF_G = 2 * 32 * RS  , OFF_B = OFF_G + 4096, OFF_LG = OFF_B + 4096  , OFF_CNT = OFF_LG + 8 * 2112  ;
    static_assert(OFF_CNT + 256 <= LDS_BYTES, "router LDS map");
    LAS unsigned char* WH = F.lds; LAS unsigned char* WL = F.lds + OFF_LO;
    LAS float* LG = (LAS float*)(F.lds + OFF_G); LAS float* LB = (LAS float*)(F.lds + OFF_B);
    LAS float* lgt = (LAS float*)(F.lds + OFF_LG + F.wave * 2112);
    LAS unsigned* lcnt = (LAS unsigned*)(F.lds + OFF_CNT);
    for (int i = F.tid; i < 512 * 32; i += 512) {
        const int n = i & 31, k2 = i >> 5;
        const float w0 = wr[(size_t)(2 * k2) * NE + n], w1 = wr[(size_t)(2 * k2 + 1) * NE + n];
        const unsigned h0 = f2bf(w0), h1 = f2bf(w1);
        const float r0 = w0 - __uint_as_float(h0 << 16), r1 = w1 - __uint_as_float(h1 << 16);
        *(LAS unsigned*)(WH + n * RS + k2 * 4) = h0 | (h1 << 16);
        *(LAS unsigned*)(WL + n * RS + k2 * 4) = pk2(r0, r1);
    }
    for (int i = F.tid; i < DM; i += 512) { LG[i] = A.in[I_LNMIX_G][i]; LB[i] = A.in[I_LNMIX_B][i]; }
    if (F.tid < 64) lcnt[F.tid] = 0u;
    __syncthreads();
    const int fr = F.lane & 15, kg = F.lane >> 4;
    const int ntask = T / 16, NGW = F.G * 8;
    const int rounds = (ntask + NGW - 1) / NGW;
    for (int rd = 0; rd < rounds; ++rd) {
        const int task = rd * NGW + F.vcu * 8 + F.wave;
        const bool live = task < ntask;
        int te[4] = {0, 0, 0, 0}; float tw[4] = {0.f, 0.f, 0.f, 0.f}; unsigned lp[4] = {0, 0, 0, 0};
        if (live) {
            const int tok = task * 16 + fr;
            float mean, rstd;
            { const f32x4* sp = (const f32x4*)(ZST + (size_t)tok * 32); float s1 = 0.f, s2 = 0.f;
#pragma unroll
              for (int i = 0; i < 8; ++i) { const f32x4 v = sp[i]; s1 += v.x + v.z; s2 += v.y + v.w; }
              mean = s1 * (1.f / DM); const float var = s2 * (1.f / DM) - mean * mean; rstd = 1.f / sqrtf(fmaxf(var, 0.f) + LN_EPS); }
            f32x4 acc0 = {0.f, 0.f, 0.f, 0.f}, acc1 = {0.f, 0.f, 0.f, 0.f};
            const float* zp = Z + (size_t)tok * DM + 8 * kg; bf16_t* hp = H1 + (size_t)tok * DM + 8 * kg;
#pragma unroll 4
            for (int kk = 0; kk < 32; ++kk) {
                const f32x4 z0 = *(const f32x4*)(zp + 32 * kk), z1 = *(const f32x4*)(zp + 32 * kk + 4);
                const f32x4 g0 = *(LAS const f32x4*)(LG + 32 * kk + 8 * kg), g1 = *(LAS const f32x4*)(LG + 32 * kk + 8 * kg + 4);
                const f32x4 b0 = *(LAS const f32x4*)(LB + 32 * kk + 8 * kg), b1 = *(LAS const f32x4*)(LB + 32 * kk + 8 * kg + 4);
                const f32x4 x0 = (z0 - mean) * rstd * g0 + b0, x1 = (z1 - mean) * rstd * g1 + b1;
                u32x4 hi; hi.x = cvt_pk_bf16(x0.x, x0.y); hi.y = cvt_pk_bf16(x0.z, x0.w); hi.z = cvt_pk_bf16(x1.x, x1.y); hi.w = cvt_pk_bf16(x1.z, x1.w);
                *(u32x4*)(hp + 32 * kk) = hi;
                u32x4 lo; lo.x = cvt_pk_bf16(x0.x - bflo(hi.x), x0.y - bfhi(hi.x)); lo.y = cvt_pk_bf16(x0.z - bflo(hi.y), x0.w - bfhi(hi.y));
                lo.z = cvt_pk_bf16(x1.x - bflo(hi.z), x1.y - bfhi(hi.z)); lo.w = cvt_pk_bf16(x1.z - bflo(hi.w), x1.w - bfhi(hi.w));
                const bf16x8 ah = __builtin_bit_cast(bf16x8, hi), al = __builtin_bit_cast(bf16x8, lo);
                const int bo = fr * RS + (32 * kk + 8 * kg) * 2;
                const bf16x8 wh0 = *(LAS const bf16x8*)(WH + bo), wh1 = *(LAS const bf16x8*)(WH + bo + 16 * RS), wl0 = *(LAS const bf16x8*)(WL + bo), wl1 = *(LAS const bf16x8*)(WL + bo + 16 * RS);
                acc0 = __builtin_amdgcn_mfma_f32_16x16x32_bf16(ah, wh0, acc0, 0, 0, 0); acc1 = __builtin_amdgcn_mfma_f32_16x16x32_bf16(ah, wh1, acc1, 0, 0, 0);
                acc0 = __builtin_amdgcn_mfma_f32_16x16x32_bf16(ah, wl0, acc0, 0, 0, 0); acc1 = __builtin_amdgcn_mfma_f32_16x16x32_bf16(ah, wl1, acc1, 0, 0, 0);
                acc0 = __builtin_amdgcn_mfma_f32_16x16x32_bf16(al, wh0, acc0, 0, 0, 0); acc1 = __builtin_amdgcn_mfma_f32_16x16x32_bf16(al, wh1, acc1, 0, 0, 0);
            }
            const float br0 = br[fr], br1 = br[16 + fr];
#pragma unroll
            for (int i = 0; i < 4; ++i) { lgt[(4 * kg + i) * 33 + fr] = acc0[i] + br0; lgt[(4 * kg + i) * 33 + 16 + fr] = acc1[i] + br1; }
            asm volatile("s_waitcnt lgkmcnt(0)" ::: "memory");
            if (F.lane < 16) {
                float lg[NE];
#pragma unroll
                for (int e = 0; e < NE; ++e) lg[e] = lgt[F.lane * 33 + e];
                float tv[4];
#pragma unroll
                for (int r = 0; r < 4; ++r) {
                    float best = -INFINITY; int bi = 0;
#pragma unroll
                    for (int e = 0; e < NE; ++e) { const bool c = lg[e] > best; best = c ? lg[e] : best; bi = c ? e : bi; }
#pragma unroll
                    for (int e = 0; e < NE; ++e) lg[e] = (e == bi) ? -INFINITY : lg[e];
                    te[r] = bi; tv[r] = best;
                }
                const float e1 = __expf(tv[1] - tv[0]), e2 = __expf(tv[2] - tv[0]), e3 = __expf(tv[3] - tv[0]); const float inv = 1.f / (1.f + e1 + e2 + e3);
                tw[0] = inv; tw[1] = e1 * inv; tw[2] = e2 * inv; tw[3] = e3 * inv;
#pragma unroll
                for (int r = 0; r < 4; ++r) lp[r] = atomicAdd((unsigned*)(lcnt + te[r]), 1u);
            }
        }
        __syncthreads();
        if (F.tid < 32) { const unsigned c = lcnt[F.tid]; lcnt[32 + F.tid] = c ? atomicAdd(&ECNT[F.tid], c) : 0u; }
        __syncthreads();
        if (live && F.lane < 16) {
            const size_t tok = (size_t)task * 16 + F.lane;
            int4 pe = {te[0], te[1], te[2], te[3]}; float4 pw = {tw[0], tw[1], tw[2], tw[3]};
            int4 pp = {(int)(lcnt[32 + te[0]] + lp[0]), (int)(lcnt[32 + te[1]] + lp[1]), (int)(lcnt[32 + te[2]] + lp[2]), (int)(lcnt[32 + te[3]] + lp[3])};
            *(int4*)(TKE + tok * 4) = pe; *(float4*)(TKW + tok * 4) = pw; *(int4*)(TKP + tok * 4) = pp;
        }
        __syncthreads();
        if (F.tid < 32) lcnt[F.tid] = 0u;
        __syncthreads();
    }
}

__device__ __forceinline__ void ph_scatter(const Ctx& F) {
    const unsigned* ECNT = (const unsigned*)(F.ws + WS_CTL) + CW_ECNT;
    const int* TKE = (const int*)(F.ws + WS_TKE); const float* TKW = (const float*)(F.ws + WS_TKW); const int* TKP = (const int*)(F.ws + WS_TKP);
    int* ROWOF = (int*)(F.ws + WS_ROWOF); int* ROWTOK = (int*)(F.ws + WS_ROWTOK); float* ROWW = (float*)(F.ws + WS_ROWW); int* TILE = (int*)(F.ws + WS_TILE);
    const bf16_t* H1 = (const bf16_t*)(F.ws + WS_H1); unsigned char* XG = F.ws + WS_XG;
    int* pst = (int*)F.ldsg;
    if (F.tid == 0) {
        int acc = 0;
        for (int e = 0; e < NE; ++e) { const int c = (int)__hip_atomic_load(ECNT + e, __ATOMIC_RELAXED, __HIP_MEMORY_SCOPE_AGENT); pst[e] = acc; pst[32 + e] = c; acc += (c + 255) / 256 * 256; }
        pst[64] = acc;
    }
    __syncthreads();
    if (blockIdx.x == 0) {
        const int ntiles = pst[64] / 256;
        if (F.tid == 0) TILE[0] = ntiles;
        for (int i = F.tid; i < ntiles; i += 512) { int e = 0; for (int k = 1; k < NE; ++k) if (i * 256 >= pst[k]) e = k; TILE[16 + i] = e; }
        for (int e = 0; e < NE; ++e) { const int s = pst[e] + pst[32 + e], en = (e + 1 < NE) ? pst[e + 1] : pst[64]; for (int r = s + F.tid; r < en; r += 512) { ROWTOK[r] = 0; ROWW[r] = 0.f; } }
    }
    const int gw = F.vcu * 8 + F.wave, NGW = F.G * 8;
    for (int idx = gw; idx < T * TOPK; idx += NGW) {
        const int t = idx >> 2, e = TKE[idx], row = pst[e] + TKP[idx];
        if (F.lane == 0) { ROWTOK[row] = t; ROWW[row] = TKW[idx]; ROWOF[idx] = row; }
        const u32x4* src = (const u32x4*)(H1 + (size_t)t * DM) + 2 * F.lane; const u32x4 a = src[0], b = src[1];
        u32x4 o = {0u, 0u, 0u, 0u};
        o.x = __builtin_amdgcn_cvt_pk_fp8_f32(bflo(a.x), bfhi(a.x), o.x, false); o.x = __builtin_amdgcn_cvt_pk_fp8_f32(bflo(a.y), bfhi(a.y), o.x, true);
        o.y = __builtin_amdgcn_cvt_pk_fp8_f32(bflo(a.z), bfhi(a.z), o.y, false); o.y = __builtin_amdgcn_cvt_pk_fp8_f32(bflo(a.w), bfhi(a.w), o.y, true);
        o.z = __builtin_amdgcn_cvt_pk_fp8_f32(bflo(b.x), bfhi(b.x), o.z, false); o.z = __builtin_amdgcn_cvt_pk_fp8_f32(bflo(b.y), bfhi(b.y), o.z, true);
        o.w = __builtin_amdgcn_cvt_pk_fp8_f32(bflo(b.z), bfhi(b.z), o.w, false); o.w = __builtin_amdgcn_cvt_pk_fp8_f32(bflo(b.w), bfhi(b.w), o.w, true);
        *((u32x4*)(XG + (size_t)row * DM) + F.lane) = o;
    }
}

__device__ __forceinline__ void ph_final(const Ctx& F) {
    const Args& A = *F.a;
    const float* Z = (const float*)(F.ws + WS_Z); const float* ZST = (const float*)(F.ws + WS_ZST); const bf16_t* YS = (const bf16_t*)(F.ws + WS_YS); const int* ROWOF = (const int*)(F.ws + WS_ROWOF);
    const int gw = F.vcu * 8 + F.wave, NGW = F.G * 8;
    f32x4 gg[4], bb[4], g2[4], b2[4];
#pragma unroll
    for (int j = 0; j < 4; ++j) { gg[j] = *((const f32x4*)A.in[I_LNMIX_G] + F.lane + 64 * j); bb[j] = *((const f32x4*)A.in[I_LNMIX_B] + F.lane + 64 * j);
        g2[j] = *((const f32x4*)A.in[I_LNF_G] + F.lane + 64 * j); b2[j] = *((const f32x4*)A.in[I_LNF_B] + F.lane + 64 * j); }
    for (int m = gw; m < T; m += NGW) {
        float mean, rstd; ln_stats16(ZST + (size_t)m * 32, F.lane, mean, rstd);
        const f32x4* zr = (const f32x4*)(Z + (size_t)m * DM) + F.lane;
        f32x4 v[4];
#pragma unroll
        for (int j = 0; j < 4; ++j) v[j] = ((zr[64 * j] - mean) * rstd * gg[j] + bb[j]) * ALPHA;
#pragma unroll
        for (int k = 0; k < 4; ++k) {
            const int row = ROWOF[(size_t)m * 4 + k]; const u32x2* yr = (const u32x2*)(YS + (size_t)row * DM) + F.lane;
#pragma unroll
            for (int j = 0; j < 4; ++j) { const u32x2 y = yr[64 * j]; v[j].x += bflo(y.x); v[j].y += bfhi(y.x); v[j].z += bflo(y.y); v[j].w += bfhi(y.y); }
        }
        float s = 0.f;
#pragma unroll
        for (int j = 0; j < 4; ++j) s += (v[j].x + v[j].y) + (v[j].z + v[j].w);
        const float mu = wave_sum(s) * (1.f / DM); float s2 = 0.f;
#pragma unroll
        for (int j = 0; j < 4; ++j) { v[j] = v[j] - mu; s2 += (v[j].x * v[j].x + v[j].y * v[j].y) + (v[j].z * v[j].z + v[j].w * v[j].w); }
        const float rs = 1.f / sqrtf(wave_sum(s2) * (1.f / DM) + LN_EPS);
        f32x4* orow = (f32x4*)(A.out + (size_t)m * DM) + F.lane;
#pragma unroll
        for (int j = 0; j < 4; ++j) orow[64 * j] = v[j] * rs * g2[j] + b2[j];
    }
}

#define XB_TMO      128
#define XB_XCNT(j)  (256  + 64 * (j))
#define XB_XSUB(j)  (1280 + 64 * (j))
#define XB_XGEN(j)  (2304 + 64 * (j))
#define XB_TOP      3328
#define XB_TOPGEN   3392
#define XCD_BAR_WORDS 3456
#define XB_SPIN_CAP (1u << 18)
__device__ __forceinline__ unsigned xb_ld(unsigned* p)              { return __hip_atomic_load(p, __ATOMIC_RELAXED, __HIP_MEMORY_SCOPE_AGENT); }
__device__ __forceinline__ unsigned xb_add(unsigned* p, unsigned v) { return __hip_atomic_fetch_add(p, v, __ATOMIC_RELAXED, __HIP_MEMORY_SCOPE_AGENT); }
__device__ __forceinline__ unsigned xb_xcc_id() { return (unsigned)__builtin_amdgcn_s_getreg((3 << 11) | 20) & 0xFu; }
#define XB_SPIN(cond, bar) do { unsigned _sp = 0; while (cond) { __builtin_amdgcn_s_sleep(1); \
    if ((++_sp & 255u) == 0u) { if (xb_ld(&(bar)[XB_TMO])) break; if (_sp > XB_SPIN_CAP) { atomicAdd(&(bar)[XB_TMO], 1u); break; } } } } while (0)
__device__ __forceinline__ void xcd_barrier_complete(unsigned* bar, unsigned x, unsigned& nloc, unsigned& nx) {
    const unsigned G = gridDim.x * gridDim.y * gridDim.z;
    unsigned sum, cnt, mine, sp = 0u;
    for (;;) {
        sum = 0u; cnt = 0u; mine = 0u;
#pragma unroll
        for (unsigned j = 0; j < 16; ++j) { const unsigned c = xb_ld(&bar[XB_XCNT(j)]); sum += c; cnt += (c > 0u) ? 1u : 0u; mine = (j == x) ? c : mine; }
        if (sum == G) break;
        __builtin_amdgcn_s_sleep(1);
        if ((++sp & 255u) == 0u) { if (xb_ld(&bar[XB_TMO])) break; if (sp > XB_SPIN_CAP) { atomicAdd(&bar[XB_TMO], 1u); break; } }
    }
    nloc = mine > 0u ? mine : 1u; nx = cnt > 0u ? cnt : 1u;
}
__device__ __forceinline__ void xcd_barrier(unsigned* bar, volatile LAS unsigned* st, unsigned x, bool leader_thread) {
    asm volatile("s_waitcnt vmcnt(0)" ::: "memory");
    __syncthreads();
    if (leader_thread) {
        __builtin_amdgcn_s_waitcnt(0);
        unsigned nloc = st[0], nx = st[1];
        if (nloc == 0u) { xcd_barrier_complete(bar, x, nloc, nx); st[0] = nloc; st[1] = nx; }
        const unsigned old = xb_add(&bar[XB_XSUB(x)], 1u);
        const unsigned gen = old / nloc;
        if (old + 1u == (gen + 1u) * nloc) {
            __builtin_amdgcn_fence(__ATOMIC_RELEASE, "agent");
            asm volatile("s_waitcnt vmcnt(0)" ::: "memory");
            const unsigned og = xb_add(&bar[XB_TOP], 1u);
            const unsigned tg = og / nx;
            if (og + 1u == (tg + 1u) * nx) xb_add(&bar[XB_TOPGEN], 1u);
            else XB_SPIN(xb_ld(&bar[XB_TOPGEN]) == tg, bar);
            __builtin_amdgcn_fence(__ATOMIC_ACQUIRE, "agent");
            xb_add(&bar[XB_XGEN(x)], 1u);
            asm volatile("s_waitcnt vmcnt(0)" ::: "memory");
        } else {
            XB_SPIN(xb_ld(&bar[XB_XGEN(x)]) == gen, bar);
            __builtin_amdgcn_fence(__ATOMIC_ACQUIRE, "agent");
            asm volatile("s_waitcnt vmcnt(0)" ::: "memory");
        }
    }
    __syncthreads();
}

template <bool COOP>
__global__ void __launch_bounds__(512, 2) mega(Args args) {
    extern __shared__ __attribute__((aligned(16))) unsigned char lds_raw[];
    Ctx F;
    const int wave0 = __builtin_amdgcn_readfirstlane(threadIdx.x >> 6);
#define MKCTX() do { F.a = &args; F.ws = args.ws; F.lds = (LAS unsigned char*)lds_raw; F.ldsg = lds_raw; F.lane = lane_id_asm(); F.wave = wave0; F.tid = wave0 * 64 + F.lane; \
    F.G = gridDim.x; { const int bx = blockIdx.x; F.vcu = (F.G % 8 == 0) ? (bx % 8) * (F.G / 8) + bx / 8 : bx; } } while (0)
    MKCTX();
    const int lo = args.ph_lo, hi = args.ph_hi;
    unsigned char* ws = args.ws;
#ifndef PHMASK
#define PHMASK 0xFFFF
#endif
#define IN(k) (((PHMASK >> (k)) & 1) && lo <= (k) && (k) < hi)
    unsigned* barw = (unsigned*)(ws + WS_CTL) + CW_BAR; volatile LAS unsigned* bst = (volatile LAS unsigned*)((LAS unsigned char*)lds_raw + LDS_BYTES - 64);
    const unsigned my_xcc = xb_xcc_id();
    if (COOP) { if (threadIdx.x == 0) { bst[0] = 0u; bst[1] = 0u; (void)xb_add(&barw[XB_XCNT(my_xcc)], 1u); } __syncthreads(); }
#define SEAM(k) do { if (COOP && IN(k) && IN((k) + 1)) { if ((k) == 0) cg::this_grid().sync(); else xcd_barrier(barw, bst, my_xcc, wave0 == 0 && lane_id_asm() == 0); } } while (0)
    if (IN(0)) { MKCTX(); ph_prologue(F); } SEAM(0);
    if (IN(1)) {
        pg8::Gemm g{(const bf16_t*)(ws + WS_H0), (const bf16_t*)(ws + WS_WIN), DM, DM, DM}; pg8::StaticOrder S; S.init(T, INCOLS, F.G, (int)blockIdx.x);
        pg8::Epi1 E{(bf16_t*)(ws + WS_YAB), (bf16_t*)(ws + WS_GV), (bf16_t*)(ws + WS_Q), (bf16_t*)(ws + WS_K), (bf16_t*)(ws + WS_V), (bf16_t*)(ws + WS_SA), (bf16_t*)(ws + WS_SB), (float*)(ws + WS_GVST)};
        pg8::gemm_phase<pg8::Epi1, pg8::StaticOrder, true>(F.lds, g, S, E, wave0);
    } SEAM(1);
    if (IN(2)) { MKCTX(); ph_kmean(F); ph_mixer_a(F); } SEAM(2);
    if (IN(3)) { MKCTX(); ph_gate(F); } SEAM(3);
    if (IN(4)) { MKCTX(); ph_attn_partial(F); } SEAM(4);
    if (IN(5)) { MKCTX(); ph_attn_own(F); } SEAM(5);
    if (IN(6)) {
        pg8::Gemm g{(const bf16_t*)(ws + WS_YAB), (const bf16_t*)(ws + WS_WAB), 2048, 2048, 2048}; pg8::StaticOrder S; S.init(T, DM, F.G, (int)blockIdx.x);
        pg8::Epi2 E{(const bf16_t*)(ws + WS_SA), (const bf16_t*)(ws + WS_SB), (bf16_t*)(ws + WS_MG)};
        pg8::gemm_phase<pg8::Epi2, pg8::StaticOrder, true>(F.lds, g, S, E, wave0);
    } SEAM(6);
    if (IN(7)) {
        pg8::Gemm g{(const bf16_t*)(ws + WS_MG), (const bf16_t*)(ws + WS_WOUT), DM, DM, DM}; pg8::StaticOrder S; S.init(T, DM, F.G, (int)blockIdx.x);
        pg8::Epi3 E{(const bf16_t*)(ws + WS_H0), (float*)(ws + WS_Z), (float*)(ws + WS_ZST)};
        pg8::gemm_phase<pg8::Epi3, pg8::StaticOrder, true>(F.lds, g, S, E, wave0);
    } SEAM(7);
    if (IN(8)) { MKCTX(); ph_router(F); } SEAM(8);
    if (IN(9)) { MKCTX(); ph_scatter(F); } SEAM(9);
    if (IN(10)) {
        pg8::Gemm g{(const bf16_t*)(ws + WS_XG), (const bf16_t*)(ws + WS_WUP), DM / 2, DM / 2, DM / 2}; pg8::MoeOrder S;   S.init((const int*)(ws + WS_TILE), 8, F.G, (int)blockIdx.x);
        pg8::Epi4 E{args.in[I_BUP], ws + WS_ACT};
        pg8::gemm_phase<pg8::Epi4, pg8::MoeOrder, true, true>(F.lds, g, S, E, wave0);
    } SEAM(10);
    if (IN(11)) {
        pg8::Gemm g{(const bf16_t*)(ws + WS_ACT), (const bf16_t*)(ws + WS_WDN), FF / 2, FF / 2, FF / 2}; pg8::MoeOrder S; S.init((const int*)(ws + WS_TILE), 4, F.G, (int)blockIdx.x);
        pg8::Epi5 E{args.in[I_BDN], (const float*)(ws + WS_ROWW), (bf16_t*)(ws + WS_YS)};
        pg8::gemm_phase<pg8::Epi5, pg8::MoeOrder, true, true>(F.lds, g, S, E, wave0);
    } SEAM(11);
    if (IN(12)) { MKCTX(); ph_final(F); }
#undef IN
#undef SEAM
}

extern "C" void kernel_launch(void* const* d_in, const int* in_sizes, int n_in, void* d_out, int out_size, void* d_ws, size_t ws_size, hipStream_t stream) {
    static int grid = 0;
    if (grid == 0) {
        if (n_in != 21 || in_sizes[0] != T * DM || out_size != T * DM || ws_size < WS_END) { fprintf(stderr, "kernel_launch: unexpected shapes (n_in %d, in0 %d, out %d, ws %zu)\n", n_in, n_in > 0 ? in_sizes[0] : -1, out_size, ws_size); grid = -1; return; }
        int dev = 0, cus = 0, per_cu = 0;
        hipGetDevice(&dev); hipDeviceGetAttribute(&cus, hipDeviceAttributeMultiprocessorCount, dev);
        const void* fn = MK_COOP ? (const void*)mega<true> : (const void*)mega<false>;
        hipFuncSetAttribute(fn, hipFuncAttributeMaxDynamicSharedMemorySize, LDS_BYTES);
        hipOccupancyMaxActiveBlocksPerMultiprocessor(&per_cu, fn, 512, LDS_BYTES);
        (void)hipGetLastError();
        if (per_cu < 1) { fprintf(stderr, "kernel_launch: occupancy query says %d blocks/CU\n", per_cu); per_cu = 1; }
        grid = cus * 1;
    }
    if (grid < 0) return;
    hipMemsetAsync((char*)d_ws + WS_CTL, 0, CTL_ZERO_BYTES, stream);
    Args a{};
    for (int i = 0; i < 21; ++i) a.in[i] = (const float*)d_in[i];
    a.out = (float*)d_out; a.ws = (unsigned char*)d_ws;
#if MK_COOP
    a.ph_lo = 0; a.ph_hi = NPHASE;
    void* kargs[] = {&a};
    hipError_t e = hipLaunchCooperativeKernel((const void*)mega<true>, dim3(grid), dim3(512), kargs, LDS_BYTES, stream);
    if (e != hipSuccess) fprintf(stderr, "cooperative launch failed: %s (grid %d)\n", hipGetErrorString(e), grid);
#else
    for (int p = 0; p < NPHASE; ++p) { a.ph_lo = p; a.ph_hi = p + 1; hipLaunchKernelGGL(mega<false>, dim3(grid), dim3(512), LDS_BYTES, stream, a); }
#endif
}
```

```cpp
#include <hip/hip_runtime.h>
#include <hip/hip_cooperative_groups.h>
#include <cstdio>
#include <cstdint>
namespace cg = cooperative_groups;

#ifndef MK_COOP
#define MK_COOP 1
#endif

#define LAS __attribute__((address_space(3)))
typedef unsigned short bf16_t;
typedef short bf16x8 __attribute__((ext_vector_type(8)));
typedef float f32x4 __attribute__((ext_vector_type(4)));
typedef float f32x2 __attribute__((ext_vector_type(2)));
typedef unsigned u32x4 __attribute__((ext_vector_type(4)));
typedef unsigned u32x2 __attribute__((ext_vector_type(2)));

constexpr int NB = 8, SEQ = 4096, DM = 1024, T = NB * SEQ;
constexpr int NH = 8, DH = 128, LBLK = 256, NBLK = SEQ / LBLK;
constexpr int NE = 32, TOPK = 4, FF = 1024;
constexpr int INCOLS = 7 * DM;
constexpr int RMAX = T * TOPK + NE * 256;
constexpr float LN_EPS = 1e-5f;
constexpr float ALPHA = 1.189207115002721f;
constexpr float QSCALE = 0.08838834764831845f * 1.4426950408889634f;

constexpr size_t MiB = 1u << 20, U64 = 64 * MiB;
constexpr size_t WS_CTL = 0, CTL_ZERO_BYTES = 1 * MiB;
constexpr int CW_ECNT = 64;
constexpr int CW_LCNT = 1024;
constexpr int CW_BAR = 4096;
constexpr size_t WS_KMEAN = 1 * MiB;
constexpr size_t WS_GVST = 2 * MiB;
constexpr size_t WS_ZST = 6 * MiB;
constexpr size_t WS_SEL = 10 * MiB;
constexpr size_t WS_TKE = 11 * MiB;
constexpr size_t WS_TKW = 11 * MiB + 512 * 1024;
constexpr size_t WS_TKP = 12 * MiB;
constexpr size_t WS_ROWOF = 12 * MiB + 512 * 1024;
constexpr size_t WS_ROWTOK = 13 * MiB;
constexpr size_t WS_ROWW = 14 * MiB;
constexpr size_t WS_TILE = 15 * MiB;
constexpr size_t WS_LISTS = 16 * MiB;
constexpr size_t WS_LSE = 32 * MiB;
constexpr size_t WS_WIN = 40 * MiB;
constexpr size_t WS_WAB = 54 * MiB;
constexpr size_t WS_WOUT = 58 * MiB;
constexpr size_t WS_WDN = 60 * MiB;
constexpr size_t WS_WUP = 124 * MiB;
constexpr size_t WS_H0 = 4 * U64;
constexpr size_t WS_YAB = 5 * U64;
constexpr size_t WS_GV = 7 * U64;
constexpr size_t WS_Q = 8 * U64, WS_K = 9 * U64, WS_V = 10 * U64, WS_SA = 11 * U64, WS_SB = 12 * U64;
constexpr size_t WS_OP = 13 * U64;
constexpr size_t WS_MG = WS_GV;
constexpr size_t WS_Z = 14 * U64;
constexpr size_t WS_H1 = WS_H0;
constexpr size_t WS_XG = 5 * U64;
constexpr size_t WS_H1F8 = 12 * U64;
constexpr size_t WS_ACT = 9 * U64 + 16 * MiB;
constexpr size_t WS_YS = WS_XG;
constexpr size_t WS_H0F8 = 13 * U64;
constexpr size_t WS_WIN8 = 192 * MiB;
constexpr int PN8_LO = 8, PN8_HI = 20;
constexpr size_t WS_END = 16 * U64;
static_assert(WS_XG + (size_t)RMAX * 2048 <= WS_ACT && WS_ACT + (size_t)RMAX * 2048 <= WS_Z, "ws map");

constexpr int LDS_BYTES = 163840;
constexpr int LDS_MISC = 131072;
constexpr int NPHASE = 13;

__device__ __forceinline__ float bf2f(bf16_t v) { return __uint_as_float((unsigned)v << 16); }
__device__ __forceinline__ float bflo(unsigned u) { return __uint_as_float(u << 16); }
__device__ __forceinline__ float bfhi(unsigned u) { return __uint_as_float(u & 0xffff0000u); }
__device__ __forceinline__ unsigned f2bf(float f) { unsigned u = __builtin_bit_cast(unsigned, f); return (u + 0x7fffu + ((u >> 16) & 1u)) >> 16; }
__device__ __forceinline__ unsigned pk2(float lo, float hi) { return f2bf(lo) | (f2bf(hi) << 16); }
typedef __bf16 bf16x2_t __attribute__((ext_vector_type(2)));
__device__ __forceinline__ unsigned cvt_pk_bf16(float lo, float hi) { f32x2 v = {lo, hi}; bf16x2_t b = __builtin_convertvector(v, bf16x2_t); return __builtin_bit_cast(unsigned, b); }
__device__ __forceinline__ int lane_id_asm() { int l; asm volatile("v_mbcnt_lo_u32_b32 %0, -1, 0\n\tv_mbcnt_hi_u32_b32 %0, -1, %0" : "=v"(l)); return l; }
__device__ __forceinline__ float wave_sum(float v) {
#pragma unroll
    for (int o = 1; o < 64; o <<= 1) v += __shfl_xor(v, o);
    return v;
}
__device__ __forceinline__ float wave_max(float v) {
#pragma unroll
    for (int o = 1; o < 64; o <<= 1) v = fmaxf(v, __shfl_xor(v, o));
    return v;
}
__device__ __forceinline__ f32x2 gelu_pk(f32x2 v) {
    const f32x2 av = __builtin_elementwise_abs(v), d = av * 0.2316418882f + 1.0f;
    f32x2 t; t.x = __builtin_amdgcn_rcpf(d.x); t.y = __builtin_amdgcn_rcpf(d.y);
    f32x2 q = t * 0.5307027145f + (-0.7265760135f); q = q * t + 0.7107068705f; q = q * t + (-0.142248368f); q = q * t + 0.127414796f; q = q * t;
    const f32x2 s = (v * v) * (-0.72134752044f);
    f32x2 e; e.x = __builtin_amdgcn_exp2f(s.x); e.y = __builtin_amdgcn_exp2f(s.y);
    const f32x2 m = v * (q * e), r = v - m;
    f32x2 o; o.x = v.x < 0.f ? m.x : r.x; o.y = v.y < 0.f ? m.y : r.y; return o;
}
typedef float f32x2v __attribute__((ext_vector_type(2)));
template <bool HI> __device__ __forceinline__ unsigned f8x2_to_bf16x2(unsigned w) { const f32x2v f = __builtin_amdgcn_cvt_pk_f32_fp8((int)w, HI); return cvt_pk_bf16(f.x, f.y); }
__device__ __forceinline__ u32x4 f8x8_to_bf16x8(unsigned lo, unsigned hi) { return (u32x4){f8x2_to_bf16x2<false>(lo), f8x2_to_bf16x2<true>(lo), f8x2_to_bf16x2<false>(hi), f8x2_to_bf16x2<true>(hi)}; }
__device__ __forceinline__ unsigned pack_fp8x4(float a, float b, float c, float d) { unsigned w = 0u; w = __builtin_amdgcn_cvt_pk_fp8_f32(a, b, w, false); w = __builtin_amdgcn_cvt_pk_fp8_f32(c, d, w, true); return w; }
__device__ __forceinline__ float sigmoidf_(float x) { return __builtin_amdgcn_rcpf(1.0f + __builtin_amdgcn_exp2f(-1.4426950408889634f * x)); }

namespace pg8 {
constexpr int BM = 256, BK = 64, HALF = 128, HTB = HALF * BK * 2, STAGE_BYTES = 8 * HTB, NXCD = 8, WGM = 8;
__host__ __device__ __forceinline__ int lds_byte(int r, int c) { const int st = (r >> 4) * 2 + (c >> 5), rr = r & 15, cc = c & 31, ob = rr * 64 + cc * 2; return st * 1024 + (ob ^ (((ob >> 9) & 1) << 5)); }
__host__ __device__ __forceinline__ void stage_rc(int b, int& R, int& C) { const int st = b / 1024, sb = b % 1024, swz = sb ^ (((sb >> 9) & 1) << 5); R = (st >> 1) * 16 + swz / 64; C = (st & 1) * 32 + (swz % 64) / 2; }
__host__ __device__ __forceinline__ int perm32(int rho) { const int n = rho >> 4, i = rho & 15; return 8 * (i >> 2) + 4 * n + (i & 3); }

struct Unit { int pm, pn, bt; };
struct Gemm { const bf16_t* A; const bf16_t* Bt; int K, lda, ldb; const int* rowidx; };

struct StaticOrder {
    int nM, nN, nwg, G, c, pbase, psplit, pjump;
    __device__ void init(int M, int N, int G_, int c_, int pbase_ = 0, int psplit_ = 1 << 20, int pjump_ = 0) { nM = M / BM; nN = N / BM; nwg = nM * nN; G = G_; c = c_; pbase = pbase_; psplit = psplit_; pjump = pjump_; }
    __device__ bool next(int i, Unit& u) const {
        const long L = (long)i * G + c; if (L >= nwg) return false;
        int wgid = (int)L; { const int q = nwg / NXCD, r = nwg % NXCD, xcd = wgid % NXCD, off = wgid / NXCD; wgid = (xcd < r ? xcd * (q + 1) : r * (q + 1) + (xcd - r) * q) + off; }
        const int nig = WGM * nN, gid = wgid / nig, fm = gid * WGM, gsz = (nM - fm) < WGM ? (nM - fm) : WGM;
        u.pm = fm + ((wgid % nig) % gsz); const int p = (wgid % nig) / gsz; u.pn = pbase + (p < psplit ? p : p + pjump); u.bt = u.pn; return true;
    }
};
struct MoeOrder {
    int nM, nN, nwg, G, c; const int* tile_e;
    __device__ void init(const int* tiletab, int nN_, int G_, int c_) { nM = tiletab[0]; tile_e = tiletab + 16; nN = nN_; nwg = nM * nN; G = G_; c = c_; }
    __device__ bool next(int i, Unit& u) const {
        const long L = (long)i * G + c; if (L >= nwg) return false;
        int wgid = (int)L; { const int q = nwg / NXCD, r = nwg % NXCD, xcd = wgid % NXCD, off = wgid / NXCD; wgid = (xcd < r ? xcd * (q + 1) : r * (q + 1) + (xcd - r) * q) + off; }
        const int nig = WGM * nN, gid = wgid / nig, fm = gid * WGM, gsz = (nM - fm) < WGM ? (nM - fm) : WGM;
        u.pm = fm + ((wgid % nig) % gsz); u.pn = (wgid % nig) / gsz; u.bt = tile_e[u.pm] * nN + u.pn; return true;
    }
};

typedef int v4i_t __attribute__((ext_vector_type(4)));
typedef int v8i_t __attribute__((ext_vector_type(8)));
template <class Epi, class Sched, bool ALIGN_EPI, bool FP8 = false, bool GATHER = false>
__device__ __forceinline__ void gemm_phase(LAS unsigned char* lds, const Gemm g, const Sched& S, const Epi& E, const int wid) {
    const int lane = lane_id_asm(), tid = wid * 64 + lane;
    const int wr = wid >> 2, wc = wid & 3, fr = lane & 15, fq = lane >> 4;
    const int nt = g.K / BK;
    unsigned voffA[2], voffB[2]; int gR[2];
#pragma unroll
    for (int i = 0; i < 2; ++i) { int R, C; stage_rc(tid * 16 + i * 8192, R, C); const int Rb = Epi::PERM ? ((R & ~31) + perm32(R & 31)) : R;
        voffA[i] = GATHER ? (unsigned)C * 2u : (unsigned)(R * g.lda + C) * 2u; voffB[i] = (unsigned)(Rb * g.ldb + C) * 2u; gR[i] = R; }
    const size_t kstep = (size_t)(BK * 2);
    const size_t hstepA = GATHER ? 0 : (size_t)HALF * g.lda * 2, hstepB = (size_t)HALF * g.ldb * 2;
    const size_t tstepA = 2 * hstepA, tstepB = 2 * hstepB;
    const unsigned ldsw = (unsigned)wid * 1024u;
    const int aoff = lds_byte(wr * 64 + fr, fq * 8), boff = lds_byte(wc * 32 + fr, fq * 8);
#define PG8_SA(b, h) (((b) * 2 + (h)) * HTB)
#define PG8_SB(b, h) ((4 + (b) * 2 + (h)) * HTB)
#define PG8_STAGE(bufoff, gbase, voff) do { _Pragma("unroll") for (int _i = 0; _i < 2; ++_i) \
        __builtin_amdgcn_global_load_lds((const unsigned*)((const char*)(gbase) + (voff)[_i]), (LAS unsigned*)(lds + (bufoff) + ldsw + _i * 8192), 16, 0, 0); } while (0)
#define PG8_LD8(p) __builtin_shufflevector(*(const LAS v4i_t*)(p), *(const LAS v4i_t*)((p) + 1024), 0, 1, 2, 3, 4, 5, 6, 7)
#define PG8_LDA(dst, b, h) do { _Pragma("unroll") for (int m = 0; m < 4; ++m) { if constexpr (FP8) dst##8[m] = PG8_LD8(lds + PG8_SA(b, h) + aoff + m * 2048); \
        else { _Pragma("unroll") for (int k = 0; k < 2; ++k) dst[m][k] = *(const LAS bf16x8*)(lds + PG8_SA(b, h) + aoff + m * 2048 + k * 1024); } } } while (0)
#define PG8_LDB(dst, b, h) do { _Pragma("unroll") for (int n = 0; n < 2; ++n) { if constexpr (FP8) dst##8[n] = PG8_LD8(lds + PG8_SB(b, h) + boff + n * 2048); \
        else { _Pragma("unroll") for (int k = 0; k < 2; ++k) dst[n][k] = *(const LAS bf16x8*)(lds + PG8_SB(b, h) + boff + n * 2048 + k * 1024); } } } while (0)
#define PG8_MMA(ai, bj, At, Bt) do { __builtin_amdgcn_s_setprio(1); _Pragma("unroll") for (int m = 0; m < 4; ++m) _Pragma("unroll") for (int n = 0; n < 2; ++n) { \
        if constexpr (FP8) { asm volatile("s_nop 1\n\tv_mfma_scale_f32_16x16x128_f8f6f4 %0, %1, %2, %0, %3, %3 op_sel_hi:[0,0,0]" : "+v"(acc[ai][bj][m][n]) : "v"(Bt##8[n]), "v"(At##8[m]), "v"(scl8)); } \
        else { _Pragma("unroll") for (int k = 0; k < 2; ++k) acc[ai][bj][m][n] = __builtin_amdgcn_mfma_f32_16x16x32_bf16(Bt[n][k], At[m][k], acc[ai][bj][m][n], 0, 0, 0); } } \
        __builtin_amdgcn_s_setprio(0); } while (0)
#define PG8_WAIT_V(n) asm volatile("s_waitcnt vmcnt(" #n ")" ::: "memory")
#define PG8_WAIT_L(n) asm volatile("s_waitcnt lgkmcnt(" #n ")" ::: "memory")
#define PG8_BAR __builtin_amdgcn_s_barrier()
#define PG8_SCHED __builtin_amdgcn_sched_barrier(0)
    Unit cur, nxt; int ui = 0;
    if (!S.next(0, cur)) return;
    unsigned va0[2], va1[2], vn0[2], vn1[2];
#define PG8_GIDX(dst0, dst1, u) do { if constexpr (GATHER) { _Pragma("unroll") for (int _i = 0; _i < 2; ++_i) { \
        dst0[_i] = (unsigned)g.rowidx[(u).pm * BM + gR[_i]] * (unsigned)(g.lda * 2) + voffA[_i]; dst1[_i] = (unsigned)g.rowidx[(u).pm * BM + HALF + gR[_i]] * (unsigned)(g.lda * 2) + voffA[_i]; } } \
        else { _Pragma("unroll") for (int _i = 0; _i < 2; ++_i) { dst0[_i] = voffA[_i]; dst1[_i] = voffA[_i]; } } } while (0)
    PG8_GIDX(va0, va1, cur);
    f32x4 acc[2][2][4][2];
#pragma unroll
    for (int a = 0; a < 2; ++a)
#pragma unroll
        for (int b = 0; b < 2; ++b)
#pragma unroll
            for (int m = 0; m < 4; ++m)
#pragma unroll
                for (int n = 0; n < 2; ++n) acc[a][b][m][n] = (f32x4){0.f, 0.f, 0.f, 0.f};
    bf16x8 At[4][2], B0[2][2], B1[2][2]; v8i_t At8[4], B08[2], B18[2];
    int scl8 = 0x7f7f7f7f; asm volatile("" : "+v"(scl8));
    const char* cA = (const char*)g.A + (GATHER ? 0 : (size_t)cur.pm * tstepA); const char* cB = (const char*)g.Bt + (size_t)cur.bt * tstepB;
    PG8_STAGE(PG8_SB(0, 0), cB, voffB); PG8_STAGE(PG8_SB(0, 1), cB + hstepB, voffB); PG8_STAGE(PG8_SA(0, 0), cA, va0); PG8_STAGE(PG8_SA(0, 1), cA + hstepA, va1);
    if (wr == 1) PG8_BAR;
    PG8_WAIT_V(2); PG8_BAR;
    PG8_STAGE(PG8_SB(1, 0), cB + kstep, voffB); PG8_STAGE(PG8_SA(1, 0), cA + kstep, va0); PG8_STAGE(PG8_SB(1, 1), cB + hstepB + kstep, voffB);
    PG8_WAIT_V(6); PG8_BAR;
    for (;;) {
        const bool has_next = S.next(ui + 1, nxt);
        const char* nA = (has_next && !GATHER) ? (const char*)g.A + (size_t)nxt.pm * tstepA : cA; const char* nB = has_next ? (const char*)g.Bt + (size_t)nxt.bt * tstepB : cB;
        if (has_next) PG8_GIDX(vn0, vn1, nxt); else { _Pragma("unroll") for (int _i = 0; _i < 2; ++_i) { vn0[_i] = va0[_i]; vn1[_i] = va1[_i]; } }
#pragma unroll 1
        for (int t = 0; t < nt; t += 2) {
            const bool last = (t == nt - 2);
            const char* a1 = cA + (size_t)(t + 1) * kstep;
            const char* a2 = last ? nA : cA + (size_t)(t + 2) * kstep; const char* b2 = last ? nB : cB + (size_t)(t + 2) * kstep;
            const char* a3 = a2 + kstep; const char* b3 = b2 + kstep;
            if constexpr (Epi::MID_T > 0) { if (t == Epi::MID_T) E.mid(acc, cur, wr, wc, fr, fq); }
            unsigned vs0[2], vs1[2];
#pragma unroll
            for (int _i = 0; _i < 2; ++_i) { vs0[_i] = last ? vn0[_i] : va0[_i]; vs1[_i] = last ? vn1[_i] : va1[_i]; }
            PG8_LDB(B0, 0, 0); PG8_LDB(B1, 0, 1); PG8_SCHED; PG8_LDA(At, 0, 0); PG8_STAGE(PG8_SA(1, 1), a1 + hstepA, va1);
            PG8_WAIT_V(8); PG8_WAIT_L(0); PG8_BAR; PG8_MMA(0, 0, At, B0); PG8_MMA(0, 1, At, B1); PG8_BAR; PG8_SCHED;
            PG8_LDA(At, 0, 1); PG8_STAGE(PG8_SB(0, 0), b2, voffB); PG8_STAGE(PG8_SB(0, 1), b2 + hstepB, voffB); PG8_STAGE(PG8_SA(0, 0), a2, vs0);
            PG8_WAIT_V(8); PG8_WAIT_L(0); PG8_BAR; PG8_MMA(1, 0, At, B0); PG8_MMA(1, 1, At, B1); PG8_BAR; PG8_SCHED;
            PG8_LDB(B0, 1, 0); PG8_LDB(B1, 1, 1); PG8_SCHED; PG8_LDA(At, 1, 0); PG8_STAGE(PG8_SA(0, 1), a2 + hstepA, vs1);
            PG8_WAIT_V(8); PG8_WAIT_L(0); PG8_BAR; PG8_MMA(0, 0, At, B0); PG8_MMA(0, 1, At, B1); PG8_BAR; PG8_SCHED;
            PG8_LDA(At, 1, 1); PG8_STAGE(PG8_SB(1, 0), b3, voffB); PG8_STAGE(PG8_SB(1, 1), b3 + hstepB, voffB); PG8_STAGE(PG8_SA(1, 0), a3, vs0);
            PG8_WAIT_V(8); PG8_WAIT_L(0); PG8_BAR; PG8_MMA(1, 0, At, B0); PG8_MMA(1, 1, At, B1); PG8_BAR; PG8_SCHED;
        }
        if constexpr (ALIGN_EPI) { if (wr == 0) PG8_BAR; }
        if constexpr (FP8) {
#pragma unroll
            for (int a = 0; a < 2; ++a)
#pragma unroll
                for (int b = 0; b < 2; ++b)
                    asm volatile("s_nop 15\n\ts_nop 7" : "+v"(acc[a][b][0][0]), "+v"(acc[a][b][0][1]), "+v"(acc[a][b][1][0]), "+v"(acc[a][b][1][1]), "+v"(acc[a][b][2][0]), "+v"(acc[a][b][2][1]), "+v"(acc[a][b][3][0]), "+v"(acc[a][b][3][1]));
        }
        E(acc, cur, wr, wc, fr, fq);
        if (!has_next) break;
#pragma unroll
        for (int a = 0; a < 2; ++a)
#pragma unroll
            for (int b = 0; b < 2; ++b)
#pragma unroll
                for (int m = 0; m < 4; ++m)
#pragma unroll
                    for (int n = 0; n < 2; ++n) acc[a][b][m][n] = (f32x4){0.f, 0.f, 0.f, 0.f};
        cur = nxt; cA = nA; cB = nB; ++ui;
#pragma unroll
        for (int _i = 0; _i < 2; ++_i) { va0[_i] = vn0[_i]; va1[_i] = vn1[_i]; }
        if constexpr (ALIGN_EPI) { if (wr == 1) PG8_BAR; }
    }
    PG8_WAIT_V(0);
    if constexpr (!ALIGN_EPI) { if (wr == 0) PG8_BAR; }
    PG8_BAR;
#undef PG8_SA
#undef PG8_SB
#undef PG8_STAGE
#undef PG8_GIDX
#undef PG8_LDA
#undef PG8_LDB
#undef PG8_MMA
#undef PG8_LD8
#undef PG8_WAIT_V
#undef PG8_WAIT_L
#undef PG8_BAR
#undef PG8_SCHED
}

typedef f32x4 Acc[2][2][4][2];

struct Epi1 {
    static constexpr bool PERM = true; static constexpr int MID_T = 0;
    bf16_t *yab, *gv; unsigned char *q, *k, *v; bf16_t *sa, *sb; float* gvst; float sc;
    template <int MODE  >
    __device__ __forceinline__ void run(const Acc& acc, const Unit& u, int wr, int wc, int fr, int fq, bf16_t* base, int ld) const {
        const int row0 = u.pm * BM + wr * 64 + fr, col0 = (u.pn & 3) * 256 + wc * 32 + 8 * fq;
#pragma unroll
        for (int ai = 0; ai < 2; ++ai)
#pragma unroll
            for (int m = 0; m < 4; ++m) {
                const int row = row0 + ai * HALF + m * 16; bf16_t* rowp = base + (size_t)row * ld + col0;
                float s1 = 0.f, s2 = 0.f;
#pragma unroll
                for (int bj = 0; bj < 2; ++bj) {
                    f32x4 v0 = acc[ai][bj][m][0], v1 = acc[ai][bj][m][1];
                    if (MODE == 2 || MODE == 3) {
                        const float f = (MODE == 2) ? sc * QSCALE : sc; v0 = v0 * f; v1 = v1 * f;
                        *(u32x2*)((unsigned char*)base + (size_t)row * 1024 + col0 + bj * HALF) = (u32x2){pack_fp8x4(v0[0], v0[1], v0[2], v0[3]), pack_fp8x4(v1[0], v1[1], v1[2], v1[3])};
                        continue;
                    }
                    if (MODE == 0 || MODE == 1) {
                        f32x2 a = gelu_pk((f32x2){v0[0], v0[1]}), b = gelu_pk((f32x2){v0[2], v0[3]}), c = gelu_pk((f32x2){v1[0], v1[1]}), d = gelu_pk((f32x2){v1[2], v1[3]});
                        v0 = (f32x4){a.x, a.y, b.x, b.y}; v1 = (f32x4){c.x, c.y, d.x, d.y};
                    } else if (MODE == 4) {
#pragma unroll
                        for (int j = 0; j < 4; ++j) { v0[j] = sigmoidf_(v0[j]); v1[j] = sigmoidf_(v1[j]); }
                    }
                    if (MODE == 1) {
                        s1 += (v0[0] + v0[1]) + (v0[2] + v0[3]) + (v1[0] + v1[1]) + (v1[2] + v1[3]);
                        s2 += (v0[0] * v0[0] + v0[1] * v0[1]) + (v0[2] * v0[2] + v0[3] * v0[3]) + (v1[0] * v1[0] + v1[1] * v1[1]) + (v1[2] * v1[2] + v1[3] * v1[3]);
                    }
                    u32x4 w; w.x = cvt_pk_bf16(v0[0], v0[1]); w.y = cvt_pk_bf16(v0[2], v0[3]); w.z = cvt_pk_bf16(v1[0], v1[1]); w.w = cvt_pk_bf16(v1[2], v1[3]);
                    *(u32x4*)(rowp + bj * HALF) = w;
                }
                if (MODE == 1) {
                    s1 += __shfl_xor(s1, 16); s1 += __shfl_xor(s1, 32); s2 += __shfl_xor(s2, 16); s2 += __shfl_xor(s2, 32);
                    if (fq == 0) *(f32x2*)(gvst + ((size_t)row * 16 + (u.pn & 3) * 4 + wc) * 2) = (f32x2){s1, s2};
                }
            }
    }
    __device__ __forceinline__ void operator()(const Acc& acc, const Unit& u, int wr, int wc, int fr, int fq) const {
        const int region = u.pn >> 2;
        if (region == 0) run<0>(acc, u, wr, wc, fr, fq, yab, 2048);
        else if (region == 1) run<1>(acc, u, wr, wc, fr, fq, gv, 1024);
        else if (region == 2) run<2>(acc, u, wr, wc, fr, fq, (bf16_t*)q, 1024);
        else if (region == 3) run<3>(acc, u, wr, wc, fr, fq, (bf16_t*)k, 1024);
        else if (region == 4) run<3>(acc, u, wr, wc, fr, fq, (bf16_t*)v, 1024);
        else if (region == 5) run<4>(acc, u, wr, wc, fr, fq, sa, 1024);
        else run<4>(acc, u, wr, wc, fr, fq, sb, 1024);
    }
    __device__ __forceinline__ void mid(Acc&, const Unit&, int, int, int, int) const {}
};

struct Epi2 {
    static constexpr bool PERM = true; static constexpr int MID_T = 16;
    const bf16_t *sa, *sb; bf16_t* mg;
    __device__ __forceinline__ void mid(Acc& acc, const Unit& u, int wr, int wc, int fr, int fq) const {
        int row0 = u.pm * BM + wr * 64 + fr, col0 = u.pn * BM + wc * 32 + 8 * fq;
        asm volatile("" : "+v"(row0), "+v"(col0));
#pragma unroll
        for (int ai = 0; ai < 2; ++ai)
#pragma unroll
            for (int m = 0; m < 4; ++m) {
                const size_t off = (size_t)(row0 + ai * HALF + m * 16) * DM + col0;
#pragma unroll
                for (int bj = 0; bj < 2; ++bj) {
                    const u32x4 a = *(const u32x4*)(sa + off + bj * HALF), b = *(const u32x4*)(sb + off + bj * HALF);
                    f32x4 r0, r1;
#define RQ(x, y) ((x) * __builtin_amdgcn_rcpf(y))
                    r0[0] = RQ(bflo(a.x), bflo(b.x)); r0[1] = RQ(bfhi(a.x), bfhi(b.x)); r0[2] = RQ(bflo(a.y), bflo(b.y)); r0[3] = RQ(bfhi(a.y), bfhi(b.y));
                    r1[0] = RQ(bflo(a.z), bflo(b.z)); r1[1] = RQ(bfhi(a.z), bfhi(b.z)); r1[2] = RQ(bflo(a.w), bflo(b.w)); r1[3] = RQ(bfhi(a.w), bfhi(b.w));
#undef RQ
                    acc[ai][bj][m][0] = acc[ai][bj][m][0] * r0; acc[ai][bj][m][1] = acc[ai][bj][m][1] * r1;
                }
                asm volatile("" : "+v"(acc[ai][0][m][0]), "+v"(acc[ai][0][m][1]), "+v"(acc[ai][1][m][0]), "+v"(acc[ai][1][m][1]));
                asm volatile("" ::: "memory");
            }
    }
    __device__ __forceinline__ void operator()(const Acc& acc, const Unit& u, int wr, int wc, int fr, int fq) const {
        const int row0 = u.pm * BM + wr * 64 + fr, col0 = u.pn * BM + wc * 32 + 8 * fq;
#pragma unroll
        for (int ai = 0; ai < 2; ++ai)
#pragma unroll
            for (int m = 0; m < 4; ++m) {
                const size_t off = (size_t)(row0 + ai * HALF + m * 16) * DM + col0;
#pragma unroll
                for (int bj = 0; bj < 2; ++bj) {
                    const u32x4 b = *(const u32x4*)(sb + off + bj * HALF);
                    const f32x4 v0 = acc[ai][bj][m][0], v1 = acc[ai][bj][m][1];
                    u32x4 w; w.x = cvt_pk_bf16(v0[0] * bflo(b.x), v0[1] * bfhi(b.x)); w.y = cvt_pk_bf16(v0[2] * bflo(b.y), v0[3] * bfhi(b.y));
                    w.z = cvt_pk_bf16(v1[0] * bflo(b.z), v1[1] * bfhi(b.z)); w.w = cvt_pk_bf16(v1[2] * bflo(b.w), v1[3] * bfhi(b.w));
                    *(u32x4*)(mg + off + bj * HALF) = w;
                }
            }
    }
};

struct Epi3 {
    static constexpr bool PERM = false; static constexpr int MID_T = 0;
    const bf16_t* h0; float* z; float* zst;
    __device__ __forceinline__ void mid(Acc&, const Unit&, int, int, int, int) const {}
    __device__ __forceinline__ void operator()(const Acc& acc, const Unit& u, int wr, int wc, int fr, int fq) const {
        const int row0 = u.pm * BM + wr * 64 + fr, col0 = u.pn * BM + wc * 32 + 4 * fq;
#pragma unroll
        for (int ai = 0; ai < 2; ++ai)
#pragma unroll
            for (int m = 0; m < 4; ++m) {
                const int row = row0 + ai * HALF + m * 16; const size_t off = (size_t)row * DM + col0;
                float s1 = 0.f, s2 = 0.f;
#pragma unroll
                for (int bj = 0; bj < 2; ++bj)
#pragma unroll
                    for (int n = 0; n < 2; ++n) {
                        const u32x2 hb = *(const u32x2*)(h0 + off + bj * HALF + n * 16);
                        f32x4 v = acc[ai][bj][m][n];
                        v[0] += ALPHA * bflo(hb.x); v[1] += ALPHA * bfhi(hb.x); v[2] += ALPHA * bflo(hb.y); v[3] += ALPHA * bfhi(hb.y);
                        s1 += (v[0] + v[1]) + (v[2] + v[3]); s2 += (v[0] * v[0] + v[1] * v[1]) + (v[2] * v[2] + v[3] * v[3]);
                        *(f32x4*)(z + off + bj * HALF + n * 16) = v;
                    }
                s1 += __shfl_xor(s1, 16); s1 += __shfl_xor(s1, 32); s2 += __shfl_xor(s2, 16); s2 += __shfl_xor(s2, 32);
                if (fq == 0) *(f32x2*)(zst + ((size_t)row * 16 + u.pn * 4 + wc) * 2) = (f32x2){s1, s2};
            }
    }
};

struct Epi4 {
    static constexpr bool PERM = true; static constexpr int MID_T = 0;
    const float* b_up; unsigned char* act;
    __device__ __forceinline__ void mid(Acc&, const Unit&, int, int, int, int) const {}
    __device__ __forceinline__ void operator()(const Acc& acc, const Unit& u, int wr, int wc, int fr, int fq) const {
        const int e = u.bt >> 3;
        const int row0 = u.pm * BM + wr * 64 + fr, c0 = u.pn * HALF + wc * 32 + 8 * fq;
        const float* bg = b_up + (size_t)e * 2 * FF + c0; const float* bu = bg + FF;
        const f32x4 bg0 = *(const f32x4*)bg, bg1 = *(const f32x4*)(bg + 4), bu0 = *(const f32x4*)bu, bu1 = *(const f32x4*)(bu + 4);
#pragma unroll
        for (int ai = 0; ai < 2; ++ai)
#pragma unroll
            for (int m = 0; m < 4; ++m) {
                const int row = row0 + ai * HALF + m * 16;
                float o[8];
#pragma unroll
                for (int n = 0; n < 2; ++n)
#pragma unroll
                    for (int j = 0; j < 4; ++j) {
                        float gg = acc[ai][0][m][n][j] * 0.03125f + (n ? bg1[j] : bg0[j]), uu = acc[ai][1][m][n][j] * 0.03125f + (n ? bu1[j] : bu0[j]);
                        gg = fminf(gg, 7.0f); uu = fminf(fmaxf(uu, -7.0f), 7.0f);
                        o[n * 4 + j] = (uu + 1.0f) * (gg * sigmoidf_(1.702f * gg));
                    }
                unsigned w0 = 0u, w1 = 0u;
                w0 = __builtin_amdgcn_cvt_pk_fp8_f32(o[0], o[1], w0, false); w0 = __builtin_amdgcn_cvt_pk_fp8_f32(o[2], o[3], w0, true);
                w1 = __builtin_amdgcn_cvt_pk_fp8_f32(o[4], o[5], w1, false); w1 = __builtin_amdgcn_cvt_pk_fp8_f32(o[6], o[7], w1, true);
                *(u32x2*)(act + (size_t)row * FF + c0) = (u32x2){w0, w1};
            }
    }
};

struct Epi5 {
    static constexpr bool PERM = true; static constexpr int MID_T = 0;
    const float* b_down; const float* roww; bf16_t* ys;
    __device__ __forceinline__ void mid(Acc&, const Unit&, int, int, int, int) const {}
    __device__ __forceinline__ void operator()(const Acc& acc, const Unit& u, int wr, int wc, int fr, int fq) const {
        const int e = u.bt >> 2;
        const int row0 = u.pm * BM + wr * 64 + fr, col0 = u.pn * BM + wc * 32 + 8 * fq;
        f32x4 bv[2][2];
#pragma unroll
        for (int bj = 0; bj < 2; ++bj)
#pragma unroll
            for (int n = 0; n < 2; ++n) bv[bj][n] = *(const f32x4*)(b_down + (size_t)e * DM + col0 + bj * HALF + 4 * n);
#pragma unroll
        for (int ai = 0; ai < 2; ++ai)
#pragma unroll
            for (int m = 0; m < 4; ++m) {
                const int row = row0 + ai * HALF + m * 16; const float rw = roww[row];
#pragma unroll
                for (int bj = 0; bj < 2; ++bj) {
                    const f32x4 v0 = (acc[ai][bj][m][0] * 0.015625f + bv[bj][0]) * rw, v1 = (acc[ai][bj][m][1] * 0.015625f + bv[bj][1]) * rw;
                    u32x4 w; w.x = cvt_pk_bf16(v0[0], v0[1]); w.y = cvt_pk_bf16(v0[2], v0[3]); w.z = cvt_pk_bf16(v1[0], v1[1]); w.w = cvt_pk_bf16(v1[2], v1[3]);
                    *(u32x4*)(ys + (size_t)row * DM + col0 + bj * HALF) = w;
                }
            }
    }
};
}

struct Args { const float* in[21]; float* out; unsigned char* ws; int ph_lo, ph_hi; };
enum { I_X = 0, I_LNIN_G, I_LNIN_B, I_WIN, I_GLN_G, I_GLN_B, I_WSP, I_BSP, I_WBA, I_WBB, I_WOUT, I_LNMIX_G, I_LNMIX_B, I_WR, I_BR, I_WUP, I_BUP, I_WDN, I_BDN, I_LNF_G, I_LNF_B };

struct Ctx { const Args* a; unsigned char* ws; LAS unsigned char* lds; unsigned char* ldsg; int tid, lane, wave, G, vcu; };

__device__ __forceinline__ void tr_item(const float* W, int N, int k0, int n0, bf16_t* dst, int drow0, int dld, int dcol0, LAS float* scr, int lane) {
#pragma unroll 8
    for (int i = 0; i < 32; ++i) { const int kk = 2 * i + (lane >> 5); scr[kk * 33 + (lane & 31)] = W[(size_t)(k0 + kk) * N + n0 + (lane & 31)]; }
    asm volatile("s_waitcnt lgkmcnt(0)" ::: "memory");
    const int c = lane & 7;
#pragma unroll
    for (int j = 0; j < 4; ++j) { const int n = (lane >> 3) + 8 * j; const LAS float* s = scr + (8 * c) * 33 + n;
        u32x4 o; o.x = pk2(s[0 * 33], s[1 * 33]); o.y = pk2(s[2 * 33], s[3 * 33]); o.z = pk2(s[4 * 33], s[5 * 33]); o.w = pk2(s[6 * 33], s[7 * 33]);
        *(u32x4*)(dst + (size_t)(drow0 + n) * dld + dcol0 + k0 + 8 * c) = o; }
    asm volatile("s_waitcnt lgkmcnt(0)" ::: "memory");
}
__device__ __forceinline__ void tr_item8(const float* W, int N, int k0, int n0, unsigned char* dst, int drow0, int dld, float sc, LAS float* scr, int lane) {
#pragma unroll 8
    for (int i = 0; i < 32; ++i) { const int kk = 2 * i + (lane >> 5); scr[kk * 33 + (lane & 31)] = W[(size_t)(k0 + kk) * N + n0 + (lane & 31)]; }
    asm volatile("s_waitcnt lgkmcnt(0)" ::: "memory");
    const int c = lane & 7;
#pragma unroll
    for (int j = 0; j < 4; ++j) { const int n = (lane >> 3) + 8 * j; const LAS float* s = scr + (8 * c) * 33 + n;
        unsigned w0 = 0u, w1 = 0u;
        w0 = __builtin_amdgcn_cvt_pk_fp8_f32(s[0 * 33] * sc, s[1 * 33] * sc, w0, false); w0 = __builtin_amdgcn_cvt_pk_fp8_f32(s[2 * 33] * sc, s[3 * 33] * sc, w0, true);
        w1 = __builtin_amdgcn_cvt_pk_fp8_f32(s[4 * 33] * sc, s[5 * 33] * sc, w1, false); w1 = __builtin_amdgcn_cvt_pk_fp8_f32(s[6 * 33] * sc, s[7 * 33] * sc, w1, true);
        *(u32x2*)(dst + (size_t)(drow0 + n) * dld + k0 + 8 * c) = (u32x2){w0, w1}; }
    asm volatile("s_waitcnt lgkmcnt(0)" ::: "memory");
}
__device__ __forceinline__ void ph_prologue(const Ctx& F) {
    const Args& A = *F.a;
    LAS float* scr = (LAS float*)(F.lds + F.wave * 16384);
    const int gw = F.vcu * 8 + F.wave, NGW = F.G * 8;
    bf16_t* WIN = (bf16_t*)(F.ws + WS_WIN); bf16_t* WAB = (bf16_t*)(F.ws + WS_WAB); bf16_t* WOUT = (bf16_t*)(F.ws + WS_WOUT);
    unsigned char* WDN = F.ws + WS_WDN; unsigned char* WUP = F.ws + WS_WUP;
    constexpr int I_IN = 16 * (INCOLS / 32), I_SQ = 16 * 32, I_UP = NE * 16 * 64, I_DN = NE * 16 * 32;
    constexpr int NITEMS = I_IN + 3 * I_SQ + I_UP + I_DN;
    for (int it = gw; it < NITEMS; it += NGW) {
        int r = it;
        if (r < I_IN) { const int nblk = INCOLS / 32, kb = r / nblk, nb = r % nblk;
            if (32 * nb >= PN8_LO * 256 && 32 * nb < PN8_HI * 256) tr_item8(A.in[I_WIN], INCOLS, 64 * kb, 32 * nb, F.ws + WS_WIN8, 32 * nb, DM, 32.0f, scr, F.lane);
            else tr_item(A.in[I_WIN], INCOLS, 64 * kb, 32 * nb, WIN, 32 * nb, DM, 0, scr, F.lane);
            continue; } r -= I_IN;
        if (r < I_SQ) { const int kb = r / 32, nb = r % 32; tr_item(A.in[I_WBA], DM, 64 * kb, 32 * nb, WAB, 32 * nb, 2048, 0, scr, F.lane); continue; } r -= I_SQ;
        if (r < I_SQ) { const int kb = r / 32, nb = r % 32; tr_item(A.in[I_WBB], DM, 64 * kb, 32 * nb, WAB, 32 * nb, 2048, 1024, scr, F.lane); continue; } r -= I_SQ;
        if (r < I_SQ) { const int kb = r / 32, nb = r % 32; tr_item(A.in[I_WOUT], DM, 64 * kb, 32 * nb, WOUT, 32 * nb, DM, 0, scr, F.lane); continue; } r -= I_SQ;
        if (r < I_UP) { const int e = r / (16 * 64), rr = r % (16 * 64), kb = rr / 64, nb = rr % 64; const int n0 = 32 * nb, half = n0 >= FF, rem = n0 - half * FF, pn = rem >> 7, b = (rem & 127) >> 5;
            tr_item8(A.in[I_WUP] + (size_t)e * DM * 2 * FF, 2 * FF, 64 * kb, n0, WUP, e * 2048 + 256 * pn + half * 128 + 32 * b, DM, 32.0f, scr, F.lane); continue; } r -= I_UP;
        { const int e = r / (16 * 32), rr = r % (16 * 32), kb = rr / 32, nb = rr % 32; tr_item8(A.in[I_WDN] + (size_t)e * FF * DM, DM, 64 * kb, 32 * nb, WDN, e * 1024 + 32 * nb, FF, 64.0f, scr, F.lane); }
    }
    const float* lg = A.in[I_LNIN_G]; const float* lb = A.in[I_LNIN_B]; bf16_t* H0 = (bf16_t*)(F.ws + WS_H0);
    f32x4 gg[4], bb[4];
#pragma unroll
    for (int j = 0; j < 4; ++j) { gg[j] = *((const f32x4*)lg + F.lane + 64 * j); bb[j] = *((const f32x4*)lb + F.lane + 64 * j); }
    for (int m = gw; m < T; m += NGW) {
        const f32x4* xr = (const f32x4*)(A.in[I_X] + (size_t)m * DM) + F.lane;
        f32x4 v[4]; float s = 0.f;
#pragma unroll
        for (int j = 0; j < 4; ++j) { v[j] = xr[64 * j]; s += (v[j].x + v[j].y) + (v[j].z + v[j].w); }
        const float mean = wave_sum(s) * (1.f / DM); float s2 = 0.f;
#pragma unroll
        for (int j = 0; j < 4; ++j) { v[j] = v[j] - mean; s2 += (v[j].x * v[j].x + v[j].y * v[j].y) + (v[j].z * v[j].z + v[j].w * v[j].w); }
        const float rstd = 1.f / sqrtf(wave_sum(s2) * (1.f / DM) + LN_EPS);
        u32x2* o8 = (u32x2*)(H0 + (size_t)m * DM) + F.lane; unsigned* o4 = (unsigned*)(F.ws + WS_H0F8 + (size_t)m * DM) + F.lane;
#pragma unroll
        for (int j = 0; j < 4; ++j) { const f32x4 y = v[j] * rstd * gg[j] + bb[j]; o8[64 * j] = (u32x2){pk2(y.x, y.y), pk2(y.z, y.w)}; o4[64 * j] = pack_fp8x4(y.x, y.y, y.z, y.w); }
    }
}

__device__ __forceinline__ void ph_kmean(const Ctx& F) {
    const unsigned char* K = F.ws + WS_K; float* KM = (float*)(F.ws + WS_KMEAN);
    float* red = (float*)F.ldsg;
    const int d = F.tid & 127, part = F.tid >> 7;
    for (int it = F.vcu; it < NB * NH * NBLK; it += F.G) {
        const int b = it / (NH * NBLK), h = (it / NBLK) % NH, j = it % NBLK;
        const unsigned char* kp = K + ((size_t)(b * SEQ + j * LBLK + part * 64)) * DM + h * DH + d;
        float s = 0.f;
        for (int r = 0; r < 64; ++r) s += __builtin_amdgcn_cvt_f32_fp8((int)kp[(size_t)r * DM], 0);
        red[part * 128 + d] = s;
        __syncthreads();
        if (F.tid < 128) KM[(size_t)it * DH + d] = (red[d] + red[128 + d] + red[256 + d] + red[384 + d]) * (1.0f / LBLK);
        __syncthreads();
    }
}
typedef short v4i16_t __attribute__((ext_vector_type(4)));
__device__ __forceinline__ v4i16_t lds_tr16(LAS const unsigned char* p) { return __builtin_amdgcn_ds_read_tr16_b64_v4i16((LAS v4i16_t*)p); }
__device__ __forceinline__ void ph_mixer_a(const Ctx& F) {
    const Args& A = *F.a;
    const bf16_t* GV = (const bf16_t*)(F.ws + WS_GV); bf16_t* YAB = (bf16_t*)(F.ws + WS_YAB); const float* GVST = (const float*)(F.ws + WS_GVST);
    const float* lg = A.in[I_GLN_G]; const float* lb = A.in[I_GLN_B]; const float* wsp = A.in[I_WSP]; const float* bsp = A.in[I_BSP];
    constexpr int RSV = 544, RSW = 272, OFF_W = 128 * RSV, OFF_ST = OFF_W + 128 * RSW;
    LAS unsigned char* VT = F.lds; LAS unsigned char* WT = F.lds + OFF_W; LAS float* ST = (LAS float*)(F.lds + OFF_ST);
    const int lane = F.lane, wv = F.wave;
    int curg = -1;
    for (int it = F.vcu; it < NB * 32 * 4; it += F.G) {
        const int b = it / 128, c = (it >> 2) & 31, g = it & 3;
        const int tok0 = b * SEQ + c * 128;
        if (g != curg) {
            curg = g;
            for (int k = 0; k < 4; ++k) {
                const int idx = F.tid + 512 * k, t = idx >> 4, s8 = (idx & 15) * 8;
                const f32x4 w0 = *(const f32x4*)(wsp + ((size_t)g * 128 + t) * 128 + s8), w1 = *(const f32x4*)(wsp + ((size_t)g * 128 + t) * 128 + s8 + 4);
                float x[8] = {w0.x, w0.y, w0.z, w0.w, w1.x, w1.y, w1.z, w1.w};
#pragma unroll
                for (int j = 0; j < 8; ++j) x[j] = (s8 + j <= t) ? x[j] : 0.f;
                u32x4 o; o.x = pk2(x[0], x[1]); o.y = pk2(x[2], x[3]); o.z = pk2(x[4], x[5]); o.w = pk2(x[6], x[7]);
                *(LAS u32x4*)(WT + t * RSW + s8 * 2) = o;
            }
        }
        if (F.tid < 128) {
            const float* p = GVST + (size_t)(tok0 + F.tid) * 32; float s1 = 0.f, s2 = 0.f;
            for (int i = 0; i < 16; ++i) { s1 += p[2 * i]; s2 += p[2 * i + 1]; }
            const float mean = s1 * (1.f / DM), var = s2 * (1.f / DM) - mean * mean;
            ST[2 * F.tid] = mean; ST[2 * F.tid + 1] = 1.f / sqrtf(fmaxf(var, 0.f) + LN_EPS);
        }
        __syncthreads();
        {
            const int dc = F.tid & 31;
            const f32x4 g0 = *(const f32x4*)(lg + g * 256 + dc * 8), g1 = *(const f32x4*)(lg + g * 256 + dc * 8 + 4), b0 = *(const f32x4*)(lb + g * 256 + dc * 8), b1 = *(const f32x4*)(lb + g * 256 + dc * 8 + 4);
#pragma unroll
            for (int k = 0; k < 8; ++k) {
                const int s = (F.tid >> 5) + 16 * k;
                const u32x4 raw = *(const u32x4*)(GV + (size_t)(tok0 + s) * DM + g * 256 + dc * 8);
                const float mean = ST[2 * s], rstd = ST[2 * s + 1];
                f32x4 x0 = {bflo(raw.x), bfhi(raw.x), bflo(raw.y), bfhi(raw.y)}, x1 = {bflo(raw.z), bfhi(raw.z), bflo(raw.w), bfhi(raw.w)};
                x0 = (x0 - mean) * rstd * g0 + b0; x1 = (x1 - mean) * rstd * g1 + b1;
                u32x4 o; o.x = pk2(x0.x, x0.y); o.y = pk2(x0.z, x0.w); o.z = pk2(x1.x, x1.y); o.w = pk2(x1.z, x1.w);
                *(LAS u32x4*)(VT + s * RSV + dc * 16) = o;
            }
        }
        __syncthreads();
        {
            const int dbase = 32 * wv, kg = lane >> 4, q = (lane & 15) >> 2, p = lane & 3, fr = lane & 15;
            bf16x8 Af[2][4];
#pragma unroll
            for (int m = 0; m < 2; ++m)
#pragma unroll
                for (int kk = 0; kk < 4; ++kk) {
                    LAS const unsigned char* ap = VT + (32 * kk + 8 * kg + q) * RSV + (dbase + 16 * m + 4 * p) * 2;
                    const v4i16_t lo = lds_tr16(ap), hi = lds_tr16(ap + 4 * RSV);
                    Af[m][kk] = (bf16x8){lo[0], lo[1], lo[2], lo[3], hi[0], hi[1], hi[2], hi[3]};
                }
#pragma unroll
            for (int n = 0; n < 8; ++n) {
                f32x4 acc0 = {0.f, 0.f, 0.f, 0.f}, acc1 = {0.f, 0.f, 0.f, 0.f};
#pragma unroll
                for (int kk = 0; kk < 4; ++kk) if (kk <= (n >> 1)) {
                    const bf16x8 Bf = *(LAS const bf16x8*)(WT + (16 * n + fr) * RSW + (32 * kk + 8 * kg) * 2);
                    acc0 = __builtin_amdgcn_mfma_f32_16x16x32_bf16(Af[0][kk], Bf, acc0, 0, 0, 0);
                    acc1 = __builtin_amdgcn_mfma_f32_16x16x32_bf16(Af[1][kk], Bf, acc1, 0, 0, 0);
                }
                const int t = 16 * n + fr; const float bsv = bsp[g * 128 + t];
                bf16_t* yp = YAB + (size_t)(tok0 + t) * 2048 + g * 256 + dbase + 4 * kg;
                const u32x2 u0 = *(const u32x2*)yp, u1 = *(const u32x2*)(yp + 16);
                u32x2 o0, o1;
                o0.x = pk2(bflo(u0.x) * (acc0[0] + bsv), bfhi(u0.x) * (acc0[1] + bsv)); o0.y = pk2(bflo(u0.y) * (acc0[2] + bsv), bfhi(u0.y) * (acc0[3] + bsv));
                o1.x = pk2(bflo(u1.x) * (acc1[0] + bsv), bfhi(u1.x) * (acc1[1] + bsv)); o1.y = pk2(bflo(u1.y) * (acc1[2] + bsv), bfhi(u1.y) * (acc1[3] + bsv));
                *(u32x2*)yp = o0; *(u32x2*)(yp + 16) = o1;
            }
        }
        __syncthreads();
    }
}

__device__ __forceinline__ void ph_gate(const Ctx& F) {
    const unsigned char* Q = F.ws + WS_Q; const float* KM = (const float*)(F.ws + WS_KMEAN);
    unsigned* SEL = (unsigned*)(F.ws + WS_SEL); unsigned* LISTS = (unsigned*)(F.ws + WS_LISTS); unsigned* LCNT = (unsigned*)(F.ws + WS_CTL) + CW_LCNT;
    float* km = (float*)F.ldsg;
    unsigned* lc = (unsigned*)(F.ldsg + 8192);
    for (int it = F.vcu; it < NB * NH * 8; it += F.G) {
        const int b = it / 64, h = (it >> 3) & 7, tc = it & 7;
        for (int i = F.tid; i < NBLK * DH; i += 512) km[i] = KM[(size_t)(b * NH + h) * NBLK * DH + i];
        if (F.tid < 32) lc[F.tid] = 0u;
        __syncthreads();
        const int t = tc * 512 + F.tid, qi = t >> 8;
        float gsc[15];
#pragma unroll
        for (int j = 0; j < 15; ++j) gsc[j] = 0.f;
        const unsigned char* qp = Q + (size_t)(b * SEQ + t) * DM + h * DH;
        for (int c = 0; c < 16; ++c) {
            const u32x2 raw = *(const u32x2*)(qp + c * 8);
            const f32x2v f0 = __builtin_amdgcn_cvt_pk_f32_fp8((int)raw.x, false), f1 = __builtin_amdgcn_cvt_pk_f32_fp8((int)raw.x, true), f2 = __builtin_amdgcn_cvt_pk_f32_fp8((int)raw.y, false), f3 = __builtin_amdgcn_cvt_pk_f32_fp8((int)raw.y, true);
            const float x[8] = {f0.x, f0.y, f1.x, f1.y, f2.x, f2.y, f3.x, f3.y};
#pragma unroll
            for (int j = 0; j < 15; ++j) if (j < qi) {
                const float* kk = km + j * DH + c * 8;
#pragma unroll
                for (int e = 0; e < 8; ++e) gsc[j] += x[e] * kk[e];
            }
        }
        const int nsel = qi < 3 ? qi : 3;
        int sel[3] = {0, 0, 0}; unsigned lpos[3] = {0, 0, 0};
#pragma unroll
        for (int r = 0; r < 3; ++r) {
            float best = -INFINITY; int bi = -1;
#pragma unroll
            for (int j = 0; j < 15; ++j) { const bool c = (j < qi) && (gsc[j] > best); best = c ? gsc[j] : best; bi = c ? j : bi; }
#pragma unroll
            for (int j = 0; j < 15; ++j) if (j == bi) gsc[j] = -INFINITY;
            sel[r] = bi < 0 ? 0 : bi;
            if (r < nsel) lpos[r] = atomicAdd(&lc[sel[r]], 1u);
        }
        SEL[(size_t)(b * SEQ + t) * NH + h] = (unsigned)sel[0] | ((unsigned)sel[1] << 8) | ((unsigned)sel[2] << 16) | ((unsigned)nsel << 24);
        __syncthreads();
        if (F.tid < 16) lc[16 + F.tid] = lc[F.tid] ? atomicAdd(&LCNT[(b * NH + h) * NBLK + F.tid], lc[F.tid]) : 0u;
        __syncthreads();
#pragma unroll
        for (int r = 0; r < 3; ++r) if (r < nsel) LISTS[(size_t)((b * NH + h) * NBLK + sel[r]) * 4096 + lc[16 + sel[r]] + lpos[r]] = (unsigned)t | ((unsigned)r << 12);
        __syncthreads();
    }
}

__device__ __forceinline__ void ph_attn_naive(const Ctx& F) {
    const bf16_t* Q = (const bf16_t*)(F.ws + WS_Q); const bf16_t* K = (const bf16_t*)(F.ws + WS_K); const bf16_t* V = (const bf16_t*)(F.ws + WS_V);
    const unsigned* SEL = (const unsigned*)(F.ws + WS_SEL); bf16_t* YAB = (bf16_t*)(F.ws + WS_YAB);
    float* qs = (float*)(F.ldsg + F.wave * 4608);
    float* sc = qs + 128;
    const int gw = F.vcu * 8 + F.wave, NGW = F.G * 8;
    for (int w = gw; w < NB * NH * SEQ; w += NGW) {
        const int b = w / (NH * SEQ), h = (w / SEQ) % NH, t = w % SEQ, qi = t >> 8, tl = t & 255;
        const size_t tok = (size_t)b * SEQ + t;
        { const unsigned qq = *(const unsigned*)(Q + tok * DM + h * DH + 2 * F.lane); qs[2 * F.lane] = bflo(qq); qs[2 * F.lane + 1] = bfhi(qq); }
        const unsigned selw = SEL[tok * NH + h]; const int nsel = selw >> 24;
        float mx = -INFINITY;
        for (int r = 0; r <= nsel; ++r) {
            const int jb = (r < nsel) ? (int)((selw >> (8 * r)) & 0xff) : qi;
            for (int c = 0; c < 4; ++c) {
                const int key = c * 64 + F.lane;
                const bool valid = (r < nsel) || (key <= tl);
                const bf16_t* kp = K + ((size_t)b * SEQ + jb * LBLK + key) * DM + h * DH;
                float s = 0.f;
#pragma unroll 4
                for (int dd = 0; dd < 16; ++dd) {
                    const u32x4 raw = *(const u32x4*)(kp + dd * 8);
                    const float* q8 = qs + dd * 8;
                    s += bflo(raw.x) * q8[0] + bfhi(raw.x) * q8[1] + bflo(raw.y) * q8[2] + bfhi(raw.y) * q8[3] + bflo(raw.z) * q8[4] + bfhi(raw.z) * q8[5] + bflo(raw.w) * q8[6] + bfhi(raw.w) * q8[7];
                }
                s = valid ? s : -INFINITY;
                sc[r * 256 + key] = s; mx = fmaxf(mx, s);
            }
        }
        mx = wave_max(mx);
        float l = 0.f;
        const int ntot = (nsel + 1) * 256;
        for (int i = F.lane; i < ntot; i += 64) { const float p = __builtin_amdgcn_exp2f(sc[i] - mx); sc[i] = p; l += p; }
        l = wave_sum(l);
        float o0 = 0.f, o1 = 0.f;
        for (int r = 0; r <= nsel; ++r) {
            const int jb = (r < nsel) ? (int)((selw >> (8 * r)) & 0xff) : qi;
            const int nk = (r < nsel) ? 256 : tl + 1;
            const bf16_t* vp = V + ((size_t)b * SEQ + jb * LBLK) * DM + h * DH + 2 * F.lane;
#pragma unroll 4
            for (int key = 0; key < nk; ++key) { const unsigned vv = *(const unsigned*)(vp + (size_t)key * DM); const float p = sc[r * 256 + key]; o0 += p * bflo(vv); o1 += p * bfhi(vv); }
        }
        const float il = 1.f / l;
        *(unsigned*)(YAB + tok * 2048 + 1024 + h * DH + 2 * F.lane) = pk2(o0 * il, o1 * il);
    }
}

typedef float f32x16 __attribute__((ext_vector_type(16)));
namespace att {
constexpr int KCH = 4112, VDB = 16448, OFF_K = 0, OFF_V = 16 * KCH, OFF_WS = OFF_V + 4 * VDB  , WSW = 512, OFF_TAB = OFF_WS + 8 * WSW  ;
static_assert(OFF_TAB + 1028 * 4 <= LDS_BYTES, "attention LDS map");
__device__ __forceinline__ int crow(int r, int hi) { return (r & 3) + 8 * (r >> 2) + 4 * hi; }
#define TRR(dst, vaddr, off) asm volatile("ds_read_b64_tr_b16 %0, %1 offset:%c2" : "=v"(dst) : "v"(vaddr), "i"(off) : "memory")
#define TRWAIT() do { asm volatile("s_waitcnt lgkmcnt(0)" ::: "memory"); __builtin_amdgcn_sched_barrier(0); } while (0)

__device__ __forceinline__ void load_kv(const Ctx& F, const unsigned char* K, const unsigned char* V, size_t tokbase, int h) {
    u32x4 kv[4], vv[4];
#pragma unroll
    for (int k = 0; k < 4; ++k) { const int idx = F.tid + 512 * k, key = idx >> 3, c2 = idx & 7; const size_t off = (tokbase + key) * DM + h * DH + c2 * 16;
        kv[k] = *(const u32x4*)(K + off); vv[k] = *(const u32x4*)(V + off); }
#pragma unroll
    for (int k = 0; k < 4; ++k) { const int idx = F.tid + 512 * k, key = idx >> 3, c2 = idx & 7, c = 2 * c2;
        *(LAS u32x4*)(F.lds + OFF_K + c * KCH + key * 16) = f8x8_to_bf16x8(kv[k].x, kv[k].y);
        *(LAS u32x4*)(F.lds + OFF_K + (c + 1) * KCH + key * 16) = f8x8_to_bf16x8(kv[k].z, kv[k].w);
        LAS unsigned char* vd = F.lds + OFF_V + (c >> 2) * VDB + (key >> 3) * 512 + (key & 7) * 64 + (c & 3) * 16;
        *(LAS u32x4*)vd = f8x8_to_bf16x8(vv[k].x, vv[k].y); *(LAS u32x4*)(vd + 16) = f8x8_to_bf16x8(vv[k].z, vv[k].w); }
}

template <bool CAUSAL>
__device__ __forceinline__ void core(const Ctx& F, const unsigned char* qrow, f32x16 (&o)[4], float& m, float& l) {
    const int r = F.lane & 31, hh = F.lane >> 5;
    LAS float* wsf = (LAS float*)(F.lds + OFF_WS + F.wave * WSW);
    bf16x8 qr[8];
#pragma unroll
    for (int ds = 0; ds < 8; ++ds) { const u32x2 raw = *(const u32x2*)(qrow + ds * 16 + hh * 8); qr[ds] = __builtin_bit_cast(bf16x8, f8x8_to_bf16x8(raw.x, raw.y)); }
#pragma unroll
    for (int db = 0; db < 4; ++db)
#pragma unroll
        for (int i = 0; i < 16; ++i) o[db][i] = 0.f;
    m = -1e30f; l = 0.f;
    const int nt = CAUSAL ? (F.wave >> 1) + 1 : 4;
    LAS const unsigned char* kbase = F.lds + OFF_K + hh * KCH + r * 16;
    LAS const unsigned char* vbase = F.lds + OFF_V + (4 * hh + ((F.lane & 15) >> 2)) * 64 + ((F.lane >> 4) & 1) * 32 + (F.lane & 3) * 8;
    for (int kt = 0; kt < nt; ++kt) {
        const bool diag = CAUSAL && (kt == nt - 1);
        constexpr bool skip1 = false;
        f32x16 p0, p1;
#pragma unroll
        for (int i = 0; i < 16; ++i) { p0[i] = 0.f; p1[i] = 0.f; }
        LAS const unsigned char* kp = kbase + (64 * kt) * 16;
        LAS const unsigned char* vp = vbase + (8 * kt) * 512;
        {
            bf16x8 ka[8], kb[8];
#pragma unroll
            for (int ds = 0; ds < 8; ++ds) ka[ds] = *(LAS const bf16x8*)(kp + 2 * ds * KCH);
            if (!skip1) {
#pragma unroll
                for (int ds = 0; ds < 8; ++ds) kb[ds] = *(LAS const bf16x8*)(kp + 2 * ds * KCH + 512);
            }
            __builtin_amdgcn_sched_barrier(0);
#pragma unroll
            for (int ds = 0; ds < 8; ++ds) p0 = __builtin_amdgcn_mfma_f32_32x32x16_bf16(ka[ds], qr[ds], p0, 0, 0, 0);
            if (!skip1) {
#pragma unroll
                for (int ds = 0; ds < 8; ++ds) p1 = __builtin_amdgcn_mfma_f32_32x32x16_bf16(kb[ds], qr[ds], p1, 0, 0, 0);
            }
            __builtin_amdgcn_sched_barrier(0);
        }
        v4i16_t vl[2][4], vh[2][4];
        const unsigned vaddr = (unsigned)(uintptr_t)vp;
#pragma unroll
        for (int ks = 0; ks < 2; ++ks)
#pragma unroll
            for (int db = 0; db < 4; ++db) { TRR(vl[ks][db], vaddr, db * VDB + ks * 1024); TRR(vh[ks][db], vaddr, db * VDB + ks * 1024 + 512); }
        __builtin_amdgcn_sched_barrier(0);
        if (diag) {
            if (F.wave & 1) {
#pragma unroll
                for (int i = 0; i < 16; ++i) p1[i] = (crow(i, hh) > r) ? -INFINITY : p1[i];
            } else {
#pragma unroll
                for (int i = 0; i < 16; ++i) { p0[i] = (crow(i, hh) > r) ? -INFINITY : p0[i]; p1[i] = -INFINITY; }
            }
        }
        float mx = fmaxf(p0[0], p1[0]);
#pragma unroll
        for (int i = 1; i < 16; ++i) mx = fmaxf(mx, fmaxf(p0[i], p1[i]));
        mx = fmaxf(mx, __shfl_xor(mx, 32));
        const float mnew = fmaxf(m, mx);
        if (__any(mnew > m)) {
            const float alpha = __builtin_amdgcn_exp2f(m - mnew);
            l *= alpha; m = mnew;
            if (hh == 0) wsf[r] = alpha;
            asm volatile("s_waitcnt lgkmcnt(0)" ::: "memory");
#pragma unroll
            for (int i = 0; i < 16; ++i) { const float a = wsf[crow(i, hh)];
#pragma unroll
                for (int db = 0; db < 4; ++db) o[db][i] *= a; }
        }
        float ls = 0.f;
#pragma unroll
        for (int i = 0; i < 16; ++i) { p0[i] = __builtin_amdgcn_exp2f(p0[i] - m); p1[i] = __builtin_amdgcn_exp2f(p1[i] - m); ls += p0[i] + p1[i]; }
        l += ls;
        u32x4 pw[4];
#pragma unroll
        for (int s2 = 0; s2 < 2; ++s2) {
            pw[s2] = (u32x4){cvt_pk_bf16(p0[8 * s2], p0[8 * s2 + 1]), cvt_pk_bf16(p0[8 * s2 + 2], p0[8 * s2 + 3]), cvt_pk_bf16(p0[8 * s2 + 4], p0[8 * s2 + 5]), cvt_pk_bf16(p0[8 * s2 + 6], p0[8 * s2 + 7])};
            pw[2 + s2] = (u32x4){cvt_pk_bf16(p1[8 * s2], p1[8 * s2 + 1]), cvt_pk_bf16(p1[8 * s2 + 2], p1[8 * s2 + 3]), cvt_pk_bf16(p1[8 * s2 + 4], p1[8 * s2 + 5]), cvt_pk_bf16(p1[8 * s2 + 6], p1[8 * s2 + 7])};
        }
        TRWAIT();
        v4i16_t wl[2][4], wh[2][4];
        if (!skip1) {
#pragma unroll
            for (int ks = 0; ks < 2; ++ks)
#pragma unroll
                for (int db = 0; db < 4; ++db) { TRR(wl[ks][db], vaddr, db * VDB + (2 + ks) * 1024); TRR(wh[ks][db], vaddr, db * VDB + (2 + ks) * 1024 + 512); }
        }
        __builtin_amdgcn_sched_barrier(0);
#pragma unroll
        for (int ks = 0; ks < 2; ++ks) {
            const bf16x8 pa = __builtin_bit_cast(bf16x8, pw[ks]);
#pragma unroll
            for (int db = 0; db < 4; ++db) {
                const bf16x8 vf = (bf16x8){vl[ks][db][0], vl[ks][db][1], vl[ks][db][2], vl[ks][db][3], vh[ks][db][0], vh[ks][db][1], vh[ks][db][2], vh[ks][db][3]};
                o[db] = __builtin_amdgcn_mfma_f32_32x32x16_bf16(pa, vf, o[db], 0, 0, 0);
            }
        }
        TRWAIT();
        if (!skip1) {
#pragma unroll
            for (int ks = 0; ks < 2; ++ks) {
                const bf16x8 pa = __builtin_bit_cast(bf16x8, pw[2 + ks]);
#pragma unroll
                for (int db = 0; db < 4; ++db) {
                    const bf16x8 vf = (bf16x8){wl[ks][db][0], wl[ks][db][1], wl[ks][db][2], wl[ks][db][3], wh[ks][db][0], wh[ks][db][1], wh[ks][db][2], wh[ks][db][3]};
                    o[db] = __builtin_amdgcn_mfma_f32_32x32x16_bf16(pa, vf, o[db], 0, 0, 0);
                }
            }
        }
        __builtin_amdgcn_sched_barrier(0);
    }
}
__device__ __forceinline__ void finish_and_stage(const Ctx& F, const f32x16 (&o)[4], float m, float l) {
    const int r = F.lane & 31, hh = F.lane >> 5;
    LAS float* wsf = (LAS float*)(F.lds + OFF_WS + F.wave * WSW);
    const float lt = l + __shfl_xor(l, 32);
    if (hh == 0) { wsf[r] = 1.0f / lt; wsf[32 + r] = m + __builtin_amdgcn_logf(lt); }
    __syncthreads();
    LAS float* stg = (LAS float*)(F.lds + F.wave * 16384);
#pragma unroll
    for (int i = 0; i < 16; ++i) { const int q = crow(i, hh); const float a = wsf[q];
#pragma unroll
        for (int db = 0; db < 4; ++db) stg[q * 128 + 32 * db + r] = o[db][i] * a; }
    asm volatile("s_waitcnt lgkmcnt(0)" ::: "memory");
}
}

__device__ __forceinline__ void ph_attn_partial(const Ctx& F) {
    using namespace att;
    const unsigned char* Q = F.ws + WS_Q; const unsigned char* K = F.ws + WS_K; const unsigned char* V = F.ws + WS_V;
    const unsigned* LISTS = (const unsigned*)(F.ws + WS_LISTS); const unsigned* LCNT = (const unsigned*)(F.ws + WS_CTL) + CW_LCNT;
    bf16_t* OP = (bf16_t*)(F.ws + WS_OP); float* LSE = (float*)(F.ws + WS_LSE);
    LAS int* P = (LAS int*)(F.lds + OFF_TAB);
    if (F.tid < 64) {
        int c[16]; int s = 0;
#pragma unroll
        for (int i = 0; i < 16; ++i) { c[i] = ((int)__hip_atomic_load(LCNT + F.tid * 16 + i, __ATOMIC_RELAXED, __HIP_MEMORY_SCOPE_AGENT) + 255) >> 8; s += c[i]; }
        int inc = s;
#pragma unroll
        for (int o = 1; o < 64; o <<= 1) { const int t = __shfl_up(inc, o); if (F.lane >= o) inc += t; }
        int run = inc - s;
#pragma unroll
        for (int i = 0; i < 16; ++i) { P[F.tid * 16 + i] = run; run += c[i]; }
        if (F.tid == 63) P[1024] = run;
    }
    __syncthreads();
    const int total = P[1024];
    LAS float* wsf = (LAS float*)(F.lds + OFF_WS + F.wave * WSW);
    LAS int* wsi = (LAS int*)wsf;
    for (int item = F.vcu; item < total; item += F.G) {
        int lo = 0, hi = 1023;
        while (lo < hi) { const int mid = (lo + hi + 1) >> 1; if (P[mid] <= item) lo = mid; else hi = mid - 1; }
        const int bhj = lo, chunk = item - P[lo];
        const int b = bhj >> 7, h = (bhj >> 4) & 7, j = bhj & 15;
        const int cnt = (int)__hip_atomic_load(LCNT + bhj, __ATOMIC_RELAXED, __HIP_MEMORY_SCOPE_AGENT);
        load_kv(F, K, V, (size_t)b * SEQ + j * LBLK, h);
        const int r = F.lane & 31, qi = chunk * 256 + F.wave * 32 + r;
        const unsigned ent = LISTS[(size_t)bhj * 4096 + (qi < cnt ? qi : 0)];
        const int tq = ent & 4095, slot = (qi < cnt) ? (int)(ent >> 12) : -1;
        if (F.lane < 32) { wsi[64 + r] = tq; wsi[96 + r] = slot; }
        __syncthreads();
        f32x16 o[4]; float m, l;
        core<false>(F, Q + ((size_t)b * SEQ + tq) * DM + h * DH, o, m, l);
        finish_and_stage(F, o, m, l);
        LAS const float* stg = (LAS const float*)(F.lds + F.wave * 16384);
#pragma unroll
        for (int ps = 0; ps < 8; ++ps) {
            const int q = ps * 4 + (F.lane >> 4), dc = F.lane & 15;
            const f32x4 a = *(LAS const f32x4*)(stg + q * 128 + dc * 8), c = *(LAS const f32x4*)(stg + q * 128 + dc * 8 + 4);
            const int t = wsi[64 + q], sl = wsi[96 + q];
            if (sl >= 0) {
                const size_t row = (((size_t)sl * NB + b) * SEQ + t) * NH + h;
                u32x4 w; w.x = cvt_pk_bf16(a.x, a.y); w.y = cvt_pk_bf16(a.z, a.w); w.z = cvt_pk_bf16(c.x, c.y); w.w = cvt_pk_bf16(c.z, c.w);
                *(u32x4*)(OP + row * DH + dc * 8) = w;
                if (dc == 0) LSE[row] = wsf[32 + q];
            }
        }
        __syncthreads();
    }
}

__device__ __forceinline__ void ph_attn_own(const Ctx& F) {
    using namespace att;
    const unsigned char* Q = F.ws + WS_Q; const unsigned char* K = F.ws + WS_K; const unsigned char* V = F.ws + WS_V;
    const bf16_t* OP = (const bf16_t*)(F.ws + WS_OP); const float* LSE = (const float*)(F.ws + WS_LSE); bf16_t* YAB = (bf16_t*)(F.ws + WS_YAB);
    LAS float* wsf = (LAS float*)(F.lds + OFF_WS + F.wave * WSW);
    for (int it = F.vcu; it < NB * NH * NBLK; it += F.G) {
        const int b = it >> 7, h = (it >> 4) & 7, j = it & 15;
        load_kv(F, K, V, (size_t)b * SEQ + j * LBLK, h);
        __syncthreads();
        const int r = F.lane & 31, t0 = j * LBLK + F.wave * 32;
        f32x16 o[4]; float m, l;
        core<true>(F, Q + ((size_t)b * SEQ + t0 + r) * DM + h * DH, o, m, l);
        finish_and_stage(F, o, m, l);
        LAS const float* stg = (LAS const float*)(F.lds + F.wave * 16384);
        const int nv = j < 3 ? j : 3;
#pragma unroll 2
        for (int ps = 0; ps < 8; ++ps) {
            const int q = ps * 4 + (F.lane >> 4), dc = F.lane & 15, t = t0 + q;
            const f32x4 a = *(LAS const f32x4*)(stg + q * 128 + dc * 8), c = *(LAS const f32x4*)(stg + q * 128 + dc * 8 + 4);
            const float lse_own = wsf[32 + q];
            float ls[3] = {-1e30f, -1e30f, -1e30f}; u32x4 pv[3] = {};
#pragma unroll
            for (int s2 = 0; s2 < 3; ++s2) if (s2 < nv) { const size_t row = (((size_t)s2 * NB + b) * SEQ + t) * NH + h; ls[s2] = LSE[row]; pv[s2] = *(const u32x4*)(OP + row * DH + dc * 8); }
            const float M = fmaxf(fmaxf(lse_own, ls[0]), fmaxf(ls[1], ls[2]));
            const float w0 = __builtin_amdgcn_exp2f(lse_own - M);
            float den = w0; f32x4 x0 = a * w0, x1 = c * w0;
#pragma unroll
            for (int s2 = 0; s2 < 3; ++s2) {
                const float w = (s2 < nv) ? __builtin_amdgcn_exp2f(ls[s2] - M) : 0.f; den += w;
                x0.x += w * bflo(pv[s2].x); x0.y += w * bfhi(pv[s2].x); x0.z += w * bflo(pv[s2].y); x0.w += w * bfhi(pv[s2].y);
                x1.x += w * bflo(pv[s2].z); x1.y += w * bfhi(pv[s2].z); x1.z += w * bflo(pv[s2].w); x1.w += w * bfhi(pv[s2].w);
            }
            const float id = 1.0f / den; x0 = x0 * id; x1 = x1 * id;
            u32x4 w; w.x = cvt_pk_bf16(x0.x, x0.y); w.y = cvt_pk_bf16(x0.z, x0.w); w.z = cvt_pk_bf16(x1.x, x1.y); w.w = cvt_pk_bf16(x1.z, x1.w);
            *(u32x4*)(YAB + ((size_t)b * SEQ + t) * 2048 + 1024 + h * DH + dc * 8) = w;
        }
        __syncthreads();
    }
}

__device__ __forceinline__ void ln_stats16(const float* st, int lane, float& mean, float& rstd) {
    float s1 = 0.f, s2 = 0.f;
    if (lane < 16) { const f32x2 p = *(const f32x2*)(st + 2 * lane); s1 = p.x; s2 = p.y; }
    s1 = wave_sum(s1); s2 = wave_sum(s2);
    mean = s1 * (1.f / DM); const float var = s2 * (1.f / DM) - mean * mean; rstd = 1.f / sqrtf(fmaxf(var, 0.f) + LN_EPS);
}
__device__ __forceinline__ void ph_router(const Ctx& F) {
    const Args& A = *F.a;
    const float* Z = (const float*)(F.ws + WS_Z); const float* ZST = (const float*)(F.ws + WS_ZST); bf16_t* H1 = (bf16_t*)(F.ws + WS_H1); unsigned char* H1F8 = F.ws + WS_H1F8;
    int* TKE = (int*)(F.ws + WS_TKE); float* TKW = (float*)(F.ws + WS_TKW); int* TKP = (int*)(F.ws + WS_TKP); unsigned* ECNT = (unsigned*)(F.ws + WS_CTL) + CW_ECNT;
    const float* wr = A.in[I_WR]; const float* br = A.in[I_BR];
    constexpr int RS = 2064, OFF_LO = 32 * RS, OFF_G = 2 * 32 * RS  , OFF_B = OFF_G + 4096, OFF_LG = OFF_B + 4096  , OFF_CNT = OFF_LG + 8 * 2112  ;
    static_assert(OFF_CNT + 256 <= LDS_BYTES, "router LDS map");
    LAS unsigned char* WH = F.lds; LAS unsigned char* WL = F.lds + OFF_LO;
    LAS float* LG = (LAS float*)(F.lds + OFF_G); LAS float* LB = (LAS float*)(F.lds + OFF_B);
    LAS float* lgt = (LAS float*)(F.lds + OFF_LG + F.wave * 2112);
    LAS unsigned* lcnt = (LAS unsigned*)(F.lds + OFF_CNT);
    for (int i = F.tid; i < 512 * 32; i += 512) {
        const int n = i & 31, k2 = i >> 5;
        const float w0 = wr[(size_t)(2 * k2) * NE + n], w1 = wr[(size_t)(2 * k2 + 1) * NE + n];
        const unsigned h0 = f2bf(w0), h1 = f2bf(w1);
        const float r0 = w0 - __uint_as_float(h0 << 16), r1 = w1 - __uint_as_float(h1 << 16);
        *(LAS unsigned*)(WH + n * RS + k2 * 4) = h0 | (h1 << 16);
        *(LAS unsigned*)(WL + n * RS + k2 * 4) = pk2(r0, r1);
    }
    for (int i = F.tid; i < DM; i += 512) { LG[i] = A.in[I_LNMIX_G][i]; LB[i] = A.in[I_LNMIX_B][i]; }
    if (F.tid < 64) lcnt[F.tid] = 0u;
    __syncthreads();
    const int fr = F.lane & 15, kg = F.lane >> 4;
    const int ntask = T / 16, NGW = F.G * 8;
    const int rounds = (ntask + NGW - 1) / NGW;
    for (int rd = 0; rd < rounds; ++rd) {
        const int task = rd * NGW + F.vcu * 8 + F.wave;
        const bool live = task < ntask;
        int te[4] = {0, 0, 0, 0}; float tw[4] = {0.f, 0.f, 0.f, 0.f}; unsigned lp[4] = {0, 0, 0, 0};
        if (live) {
            const int tok = task * 16 + fr;
            float mean, rstd;
            { const f32x4* sp = (const f32x4*)(ZST + (size_t)tok * 32); float s1 = 0.f, s2 = 0.f;
#pragma unroll
              for (int i = 0; i < 8; ++i) { const f32x4 v = sp[i]; s1 += v.x + v.z; s2 += v.y + v.w; }
              mean = s1 * (1.f / DM); const float var = s2 * (1.f / DM) - mean * mean; rstd = 1.f / sqrtf(fmaxf(var, 0.f) + LN_EPS); }
            f32x4 acc0 = {0.f, 0.f, 0.f, 0.f}, acc1 = {0.f, 0.f, 0.f, 0.f};
            const float* zp = Z + (size_t)tok * DM + 8 * kg; bf16_t* hp = H1 + (size_t)tok * DM + 8 * kg; unsigned char* h8 = H1F8 + (size_t)tok * DM + 8 * kg;
#pragma unroll 4
            for (int kk = 0; kk < 32; ++kk) {
                const f32x4 z0 = *(const f32x4*)(zp + 32 * kk), z1 = *(const f32x4*)(zp + 32 * kk + 4);
                const f32x4 g0 = *(LAS const f32x4*)(LG + 32 * kk + 8 * kg), g1 = *(LAS const f32x4*)(LG + 32 * kk + 8 * kg + 4);
                const f32x4 b0 = *(LAS const f32x4*)(LB + 32 * kk + 8 * kg), b1 = *(LAS const f32x4*)(LB + 32 * kk + 8 * kg + 4);
                const f32x4 x0 = (z0 - mean) * rstd * g0 + b0, x1 = (z1 - mean) * rstd * g1 + b1;
                u32x4 hi; hi.x = cvt_pk_bf16(x0.x, x0.y); hi.y = cvt_pk_bf16(x0.z, x0.w); hi.z = cvt_pk_bf16(x1.x, x1.y); hi.w = cvt_pk_bf16(x1.z, x1.w);
                *(u32x4*)(hp + 32 * kk) = hi;
                { unsigned w0 = 0u, w1 = 0u;
                  w0 = __builtin_amdgcn_cvt_pk_fp8_f32(x0.x, x0.y, w0, false); w0 = __builtin_amdgcn_cvt_pk_fp8_f32(x0.z, x0.w, w0, true);
                  w1 = __builtin_amdgcn_cvt_pk_fp8_f32(x1.x, x1.y, w1, false); w1 = __builtin_amdgcn_cvt_pk_fp8_f32(x1.z, x1.w, w1, true);
                  *(u32x2*)(h8 + 32 * kk) = (u32x2){w0, w1}; }
                u32x4 lo; lo.x = cvt_pk_bf16(x0.x - bflo(hi.x), x0.y - bfhi(hi.x)); lo.y = cvt_pk_bf16(x0.z - bflo(hi.y), x0.w - bfhi(hi.y));
                lo.z = cvt_pk_bf16(x1.x - bflo(hi.z), x1.y - bfhi(hi.z)); lo.w = cvt_pk_bf16(x1.z - bflo(hi.w), x1.w - bfhi(hi.w));
                const bf16x8 ah = __builtin_bit_cast(bf16x8, hi), al = __builtin_bit_cast(bf16x8, lo);
                const int bo = fr * RS + (32 * kk + 8 * kg) * 2;
                const bf16x8 wh0 = *(LAS const bf16x8*)(WH + bo), wh1 = *(LAS const bf16x8*)(WH + bo + 16 * RS), wl0 = *(LAS const bf16x8*)(WL + bo), wl1 = *(LAS const bf16x8*)(WL + bo + 16 * RS);
                acc0 = __builtin_amdgcn_mfma_f32_16x16x32_bf16(ah, wh0, acc0, 0, 0, 0); acc1 = __builtin_amdgcn_mfma_f32_16x16x32_bf16(ah, wh1, acc1, 0, 0, 0);
                acc0 = __builtin_amdgcn_mfma_f32_16x16x32_bf16(ah, wl0, acc0, 0, 0, 0); acc1 = __builtin_amdgcn_mfma_f32_16x16x32_bf16(ah, wl1, acc1, 0, 0, 0);
                acc0 = __builtin_amdgcn_mfma_f32_16x16x32_bf16(al, wh0, acc0, 0, 0, 0); acc1 = __builtin_amdgcn_mfma_f32_16x16x32_bf16(al, wh1, acc1, 0, 0, 0);
            }
            const float br0 = br[fr], br1 = br[16 + fr];
#pragma unroll
            for (int i = 0; i < 4; ++i) { lgt[(4 * kg + i) * 33 + fr] = acc0[i] + br0; lgt[(4 * kg + i) * 33 + 16 + fr] = acc1[i] + br1; }
            asm volatile("s_waitcnt lgkmcnt(0)" ::: "memory");
            if (F.lane < 16) {
                float lg[NE];
#pragma unroll
                for (int e = 0; e < NE; ++e) lg[e] = lgt[F.lane * 33 + e];
                float tv[4];
#pragma unroll
                for (int r = 0; r < 4; ++r) {
                    float best = -INFINITY; int bi = 0;
#pragma unroll
                    for (int e = 0; e < NE; ++e) { const bool c = lg[e] > best; best = c ? lg[e] : best; bi = c ? e : bi; }
#pragma unroll
                    for (int e = 0; e < NE; ++e) lg[e] = (e == bi) ? -INFINITY : lg[e];
                    te[r] = bi; tv[r] = best;
                }
                const float e1 = __expf(tv[1] - tv[0]), e2 = __expf(tv[2] - tv[0]), e3 = __expf(tv[3] - tv[0]); const float inv = 1.f / (1.f + e1 + e2 + e3);
                tw[0] = inv; tw[1] = e1 * inv; tw[2] = e2 * inv; tw[3] = e3 * inv;
#pragma unroll
                for (int r = 0; r < 4; ++r) lp[r] = atomicAdd((unsigned*)(lcnt + te[r]), 1u);
            }
        }
        __syncthreads();
        if (F.tid < 32) { const unsigned c = lcnt[F.tid]; lcnt[32 + F.tid] = c ? atomicAdd(&ECNT[F.tid], c) : 0u; }
        __syncthreads();
        if (live && F.lane < 16) {
            const size_t tok = (size_t)task * 16 + F.lane;
            int4 pe = {te[0], te[1], te[2], te[3]}; float4 pw = {tw[0], tw[1], tw[2], tw[3]};
            int4 pp = {(int)(lcnt[32 + te[0]] + lp[0]), (int)(lcnt[32 + te[1]] + lp[1]), (int)(lcnt[32 + te[2]] + lp[2]), (int)(lcnt[32 + te[3]] + lp[3])};
            *(int4*)(TKE + tok * 4) = pe; *(float4*)(TKW + tok * 4) = pw; *(int4*)(TKP + tok * 4) = pp;
        }
        __syncthreads();
        if (F.tid < 32) lcnt[F.tid] = 0u;
        __syncthreads();
    }
}

__device__ __forceinline__ void ph_scatter(const Ctx& F) {
    const unsigned* ECNT = (const unsigned*)(F.ws + WS_CTL) + CW_ECNT;
    const int* TKE = (const int*)(F.ws + WS_TKE); const float* TKW = (const float*)(F.ws + WS_TKW); const int* TKP = (const int*)(F.ws + WS_TKP);
    int* ROWOF = (int*)(F.ws + WS_ROWOF); int* ROWTOK = (int*)(F.ws + WS_ROWTOK); float* ROWW = (float*)(F.ws + WS_ROWW); int* TILE = (int*)(F.ws + WS_TILE);
    int* pst = (int*)F.ldsg;
    if (F.tid == 0) {
        int acc = 0;
        for (int e = 0; e < NE; ++e) { const int c = (int)__hip_atomic_load(ECNT + e, __ATOMIC_RELAXED, __HIP_MEMORY_SCOPE_AGENT); pst[e] = acc; pst[32 + e] = c; acc += (c + 255) / 256 * 256; }
        pst[64] = acc;
    }
    __syncthreads();
    if (blockIdx.x == 0) {
        const int ntiles = pst[64] / 256;
        if (F.tid == 0) TILE[0] = ntiles;
        for (int i = F.tid; i < ntiles; i += 512) { int e = 0; for (int k = 1; k < NE; ++k) if (i * 256 >= pst[k]) e = k; TILE[16 + i] = e; }
        for (int e = 0; e < NE; ++e) { const int s = pst[e] + pst[32 + e], en = (e + 1 < NE) ? pst[e + 1] : pst[64]; for (int r = s + F.tid; r < en; r += 512) { ROWTOK[r] = 0; ROWW[r] = 0.f; } }
    }
    for (int idx = F.vcu * 512 + F.tid; idx < T * TOPK; idx += F.G * 512) {
        const int t = idx >> 2, e = TKE[idx], row = pst[e] + TKP[idx];
        ROWTOK[row] = t; ROWW[row] = TKW[idx]; ROWOF[idx] = row;
    }
}

__device__ __forceinline__ void ph_final(const Ctx& F) {
    const Args& A = *F.a;
    const bf16_t* H1 = (const bf16_t*)(F.ws + WS_H1); const bf16_t* YS = (const bf16_t*)(F.ws + WS_YS); const int* ROWOF = (const int*)(F.ws + WS_ROWOF);
    const int gw = F.vcu * 8 + F.wave, NGW = F.G * 8;
    f32x4 g2[4], b2[4];
#pragma unroll
    for (int j = 0; j < 4; ++j) { g2[j] = *((const f32x4*)A.in[I_LNF_G] + F.lane + 64 * j); b2[j] = *((const f32x4*)A.in[I_LNF_B] + F.lane + 64 * j); }
    for (int m = gw; m < T; m += NGW) {
        const u32x2* hr = (const u32x2*)(H1 + (size_t)m * DM) + F.lane;
        f32x4 v[4];
#pragma unroll
        for (int j = 0; j < 4; ++j) { const u32x2 hb = hr[64 * j]; v[j] = (f32x4){bflo(hb.x), bfhi(hb.x), bflo(hb.y), bfhi(hb.y)} * ALPHA; }
#pragma unroll
        for (int k = 0; k < 4; ++k) {
            const int row = ROWOF[(size_t)m * 4 + k]; const u32x2* yr = (const u32x2*)(YS + (size_t)row * DM) + F.lane;
#pragma unroll
            for (int j = 0; j < 4; ++j) { const u32x2 y = yr[64 * j]; v[j].x += bflo(y.x); v[j].y += bfhi(y.x); v[j].z += bflo(y.y); v[j].w += bfhi(y.y); }
        }
        float s = 0.f;
#pragma unroll
        for (int j = 0; j < 4; ++j) s += (v[j].x + v[j].y) + (v[j].z + v[j].w);
        const float mu = wave_sum(s) * (1.f / DM); float s2 = 0.f;
#pragma unroll
        for (int j = 0; j < 4; ++j) { v[j] = v[j] - mu; s2 += (v[j].x * v[j].x + v[j].y * v[j].y) + (v[j].z * v[j].z + v[j].w * v[j].w); }
        const float rs = 1.f / sqrtf(wave_sum(s2) * (1.f / DM) + LN_EPS);
        f32x4* orow = (f32x4*)(A.out + (size_t)m * DM) + F.lane;
#pragma unroll
        for (int j = 0; j < 4; ++j) orow[64 * j] = v[j] * rs * g2[j] + b2[j];
    }
}

#define XB_TMO      128
#define XB_XCNT(j)  (256  + 64 * (j))
#define XB_XSUB(j)  (1280 + 64 * (j))
#define XB_XGEN(j)  (2304 + 64 * (j))
#define XB_TOP      3328
#define XB_TOPGEN   3392
#define XCD_BAR_WORDS 3456
#define XB_SPIN_CAP (1u << 18)
__device__ __forceinline__ unsigned xb_ld(unsigned* p)              { return __hip_atomic_load(p, __ATOMIC_RELAXED, __HIP_MEMORY_SCOPE_AGENT); }
__device__ __forceinline__ unsigned xb_add(unsigned* p, unsigned v) { return __hip_atomic_fetch_add(p, v, __ATOMIC_RELAXED, __HIP_MEMORY_SCOPE_AGENT); }
__device__ __forceinline__ unsigned xb_xcc_id() { return (unsigned)__builtin_amdgcn_s_getreg((3 << 11) | 20) & 0xFu; }
#define XB_SPIN(cond, bar) do { unsigned _sp = 0; while (cond) { __builtin_amdgcn_s_sleep(1); \
    if ((++_sp & 255u) == 0u) { if (xb_ld(&(bar)[XB_TMO])) break; if (_sp > XB_SPIN_CAP) { atomicAdd(&(bar)[XB_TMO], 1u); break; } } } } while (0)
__device__ __forceinline__ void xcd_barrier_complete(unsigned* bar, unsigned x, unsigned& nloc, unsigned& nx) {
    const unsigned G = gridDim.x * gridDim.y * gridDim.z;
    unsigned sum, cnt, mine, sp = 0u;
    for (;;) {
        sum = 0u; cnt = 0u; mine = 0u;
#pragma unroll
        for (unsigned j = 0; j < 16; ++j) { const unsigned c = xb_ld(&bar[XB_XCNT(j)]); sum += c; cnt += (c > 0u) ? 1u : 0u; mine = (j == x) ? c : mine; }
        if (sum == G) break;
        __builtin_amdgcn_s_sleep(1);
        if ((++sp & 255u) == 0u) { if (xb_ld(&bar[XB_TMO])) break; if (sp > XB_SPIN_CAP) { atomicAdd(&bar[XB_TMO], 1u); break; } }
    }
    nloc = mine > 0u ? mine : 1u; nx = cnt > 0u ? cnt : 1u;
}
__device__ __forceinline__ void xcd_barrier(unsigned* bar, volatile LAS unsigned* st, unsigned x, bool leader_thread) {
    asm volatile("s_waitcnt vmcnt(0)" ::: "memory");
    __syncthreads();
    if (leader_thread) {
        __builtin_amdgcn_s_waitcnt(0);
        unsigned nloc = st[0], nx = st[1];
        if (nloc == 0u) { xcd_barrier_complete(bar, x, nloc, nx); st[0] = nloc; st[1] = nx; }
        const unsigned old = xb_add(&bar[XB_XSUB(x)], 1u);
        const unsigned gen = old / nloc;
        if (old + 1u == (gen + 1u) * nloc) {
            __builtin_amdgcn_fence(__ATOMIC_RELEASE, "agent");
            asm volatile("s_waitcnt vmcnt(0)" ::: "memory");
            const unsigned og = xb_add(&bar[XB_TOP], 1u);
            const unsigned tg = og / nx;
            if (og + 1u == (tg + 1u) * nx) xb_add(&bar[XB_TOPGEN], 1u);
            else XB_SPIN(xb_ld(&bar[XB_TOPGEN]) == tg, bar);
            __builtin_amdgcn_fence(__ATOMIC_ACQUIRE, "agent");
            xb_add(&bar[XB_XGEN(x)], 1u);
            asm volatile("s_waitcnt vmcnt(0)" ::: "memory");
        } else {
            XB_SPIN(xb_ld(&bar[XB_XGEN(x)]) == gen, bar);
            __builtin_amdgcn_fence(__ATOMIC_ACQUIRE, "agent");
            asm volatile("s_waitcnt vmcnt(0)" ::: "memory");
        }
    }
    __syncthreads();
}

template <bool COOP>
__global__ void __launch_bounds__(512, 2) mega(Args args) {
    extern __shared__ __attribute__((aligned(16))) unsigned char lds_raw[];
    Ctx F;
    const int wave0 = __builtin_amdgcn_readfirstlane(threadIdx.x >> 6);
#define MKCTX() do { F.a = &args; F.ws = args.ws; F.lds = (LAS unsigned char*)lds_raw; F.ldsg = lds_raw; F.lane = lane_id_asm(); F.wave = wave0; F.tid = wave0 * 64 + F.lane; \
    F.G = gridDim.x; { const int bx = blockIdx.x; F.vcu = (F.G % 8 == 0) ? (bx % 8) * (F.G / 8) + bx / 8 : bx; } } while (0)
    MKCTX();
    const int lo = args.ph_lo, hi = args.ph_hi;
    unsigned char* ws = args.ws;
#ifndef PHMASK
#define PHMASK 0xFFFF
#endif
#define IN(k) (((PHMASK >> (k)) & 1) && lo <= (k) && (k) < hi)
    unsigned* barw = (unsigned*)(ws + WS_CTL) + CW_BAR; volatile LAS unsigned* bst = (volatile LAS unsigned*)((LAS unsigned char*)lds_raw + LDS_BYTES - 64);
    const unsigned my_xcc = xb_xcc_id();
    if (COOP) { if (threadIdx.x == 0) { bst[0] = 0u; bst[1] = 0u; (void)xb_add(&barw[XB_XCNT(my_xcc)], 1u); } __syncthreads(); }
#define SEAM(k) do { if (COOP && IN(k) && IN((k) + 1)) { if ((k) == 0) cg::this_grid().sync(); else xcd_barrier(barw, bst, my_xcc, wave0 == 0 && lane_id_asm() == 0); } } while (0)
    if (IN(0)) { MKCTX(); ph_prologue(F); } SEAM(0);
    if (IN(1)) {
        pg8::Epi1 E{(bf16_t*)(ws + WS_YAB), (bf16_t*)(ws + WS_GV), ws + WS_Q, ws + WS_K, ws + WS_V, (bf16_t*)(ws + WS_SA), (bf16_t*)(ws + WS_SB), (float*)(ws + WS_GVST), 1.0f};
        {
            pg8::Gemm g{(const bf16_t*)(ws + WS_H0), (const bf16_t*)(ws + WS_WIN), DM, DM, DM, nullptr}; pg8::StaticOrder S; S.init(T, (PN8_LO + 28 - PN8_HI) * 256, F.G, (int)blockIdx.x, 0, PN8_LO, PN8_HI - PN8_LO);
            pg8::gemm_phase<pg8::Epi1, pg8::StaticOrder, true>(F.lds, g, S, E, wave0);
        }
        {
            E.sc = 0.03125f;
            pg8::Gemm g{(const bf16_t*)(ws + WS_H0F8), (const bf16_t*)(ws + WS_WIN8), DM / 2, DM / 2, DM / 2, nullptr}; pg8::StaticOrder S; S.init(T, (PN8_HI - PN8_LO) * 256, F.G, (int)blockIdx.x, PN8_LO);
            pg8::gemm_phase<pg8::Epi1, pg8::StaticOrder, true, true>(F.lds, g, S, E, wave0);
        }
    } SEAM(1);
    if (IN(2)) { MKCTX(); ph_kmean(F); ph_mixer_a(F); } SEAM(2);
    if (IN(3)) { MKCTX(); ph_gate(F); } SEAM(3);
    if (IN(4)) { MKCTX(); ph_attn_partial(F); } SEAM(4);
    if (IN(5)) { MKCTX(); ph_attn_own(F); } SEAM(5);
    if (IN(6)) {
        pg8::Gemm g{(const bf16_t*)(ws + WS_YAB), (const bf16_t*)(ws + WS_WAB), 2048, 2048, 2048, nullptr}; pg8::StaticOrder S; S.init(T, DM, F.G, (int)blockIdx.x);
        pg8::Epi2 E{(const bf16_t*)(ws + WS_SA), (const bf16_t*)(ws + WS_SB), (bf16_t*)(ws + WS_MG)};
        pg8::gemm_phase<pg8::Epi2, pg8::StaticOrder, true>(F.lds, g, S, E, wave0);
    } SEAM(6);
    if (IN(7)) {
        pg8::Gemm g{(const bf16_t*)(ws + WS_MG), (const bf16_t*)(ws + WS_WOUT), DM, DM, DM, nullptr}; pg8::StaticOrder S; S.init(T, DM, F.G, (int)blockIdx.x);
        pg8::Epi3 E{(const bf16_t*)(ws + WS_H0), (float*)(ws + WS_Z), (float*)(ws + WS_ZST)};
        pg8::gemm_phase<pg8::Epi3, pg8::StaticOrder, true>(F.lds, g, S, E, wave0);
    } SEAM(7);
    if (IN(8)) { MKCTX(); ph_router(F); } SEAM(8);
    if (IN(9)) { MKCTX(); ph_scatter(F); } SEAM(9);
    if (IN(10)) {
        pg8::Gemm g{(const bf16_t*)(ws + WS_H1F8), (const bf16_t*)(ws + WS_WUP), DM / 2, DM / 2, DM / 2, (const int*)(ws + WS_ROWTOK)}; pg8::MoeOrder S;   S.init((const int*)(ws + WS_TILE), 8, F.G, (int)blockIdx.x);
        pg8::Epi4 E{args.in[I_BUP], ws + WS_ACT};
        pg8::gemm_phase<pg8::Epi4, pg8::MoeOrder, true, true, true>(F.lds, g, S, E, wave0);
    } SEAM(10);
    if (IN(11)) {
        pg8::Gemm g{(const bf16_t*)(ws + WS_ACT), (const bf16_t*)(ws + WS_WDN), FF / 2, FF / 2, FF / 2, nullptr}; pg8::MoeOrder S; S.init((const int*)(ws + WS_TILE), 4, F.G, (int)blockIdx.x);
        pg8::Epi5 E{args.in[I_BDN], (const float*)(ws + WS_ROWW), (bf16_t*)(ws + WS_YS)};
        pg8::gemm_phase<pg8::Epi5, pg8::MoeOrder, true, true>(F.lds, g, S, E, wave0);
    } SEAM(11);
    if (IN(12)) { MKCTX(); ph_final(F); }
#undef IN
#undef SEAM
}

extern "C" void kernel_launch(void* const* d_in, const int* in_sizes, int n_in, void* d_out, int out_size, void* d_ws, size_t ws_size, hipStream_t stream) {
    static int grid = 0;
    if (grid == 0) {
        if (n_in != 21 || in_sizes[0] != T * DM || out_size != T * DM || ws_size < WS_END) { fprintf(stderr, "kernel_launch: unexpected shapes (n_in %d, in0 %d, out %d, ws %zu)\n", n_in, n_in > 0 ? in_sizes[0] : -1, out_size, ws_size); grid = -1; return; }
        int dev = 0, cus = 0, per_cu = 0;
        hipGetDevice(&dev); hipDeviceGetAttribute(&cus, hipDeviceAttributeMultiprocessorCount, dev);
        const void* fn = MK_COOP ? (const void*)mega<true> : (const void*)mega<false>;
        hipFuncSetAttribute(fn, hipFuncAttributeMaxDynamicSharedMemorySize, LDS_BYTES);
        hipOccupancyMaxActiveBlocksPerMultiprocessor(&per_cu, fn, 512, LDS_BYTES);
        (void)hipGetLastError();
        if (per_cu < 1) { fprintf(stderr, "kernel_launch: occupancy query says %d blocks/CU\n", per_cu); per_cu = 1; }
        grid = cus * 1;
    }
    if (grid < 0) return;
    hipMemsetAsync((char*)d_ws + WS_CTL, 0, CTL_ZERO_BYTES, stream);
    Args a{};
    for (int i = 0; i < 21; ++i) a.in[i] = (const float*)d_in[i];
    a.out = (float*)d_out; a.ws = (unsigned char*)d_ws;
#if MK_COOP
    a.ph_lo = 0; a.ph_hi = NPHASE;
    void* kargs[] = {&a};
    hipError_t e = hipLaunchCooperativeKernel((const void*)mega<true>, dim3(grid), dim3(512), kargs, LDS_BYTES, stream);
    if (e != hipSuccess) fprintf(stderr, "cooperative launch failed: %s (grid %d)\n", hipGetErrorString(e), grid);
#else
    for (int p = 0; p < NPHASE; ++p) { a.ph_lo = p; a.ph_hi = p + 1; hipLaunchKernelGGL(mega<false>, dim3(grid), dim3(512), LDS_BYTES, stream, a); }
#endif
}
```

```cpp
#include <hip/hip_runtime.h>
#include <hip/hip_cooperative_groups.h>
#include <cstdio>
#include <cstdint>
namespace cg = cooperative_groups;

#ifndef MK_COOP
#define MK_COOP 1
#endif

#define LAS __attribute__((address_space(3)))
typedef unsigned short bf16_t;
typedef short bf16x8 __attribute__((ext_vector_type(8)));
typedef float f32x4 __attribute__((ext_vector_type(4)));
typedef float f32x2 __attribute__((ext_vector_type(2)));
typedef unsigned u32x4 __attribute__((ext_vector_type(4)));
typedef unsigned u32x2 __attribute__((ext_vector_type(2)));

constexpr int NB = 8, SEQ = 4096, DM = 1024, T = NB * SEQ;
constexpr int NH = 8, DH = 128, LBLK = 256, NBLK = SEQ / LBLK;
constexpr int NE = 32, TOPK = 4, FF = 1024;
constexpr int INCOLS = 7 * DM;
constexpr int RMAX = T * TOPK + NE * 256;
constexpr float LN_EPS = 1e-5f;
constexpr float ALPHA = 1.189207115002721f;
constexpr float QSCALE = 0.08838834764831845f * 1.4426950408889634f;

constexpr size_t MiB = 1u << 20, U64 = 64 * MiB;
constexpr size_t WS_CTL = 0, CTL_ZERO_BYTES = 1 * MiB;
constexpr int CW_ECNT = 64;
constexpr int CW_LCNT = 1024;
constexpr int CW_BAR = 4096;
constexpr size_t WS_KMEAN = 1 * MiB;
constexpr size_t WS_GVST = 2 * MiB;
constexpr size_t WS_ZST = 6 * MiB;
constexpr size_t WS_SEL = 10 * MiB;
constexpr size_t WS_TKE = 11 * MiB;
constexpr size_t WS_TKW = 11 * MiB + 512 * 1024;
constexpr size_t WS_TKP = 12 * MiB;
constexpr size_t WS_ROWOF = 12 * MiB + 512 * 1024;
constexpr size_t WS_ROWTOK = 13 * MiB;
constexpr size_t WS_ROWW = 14 * MiB;
constexpr size_t WS_TILE = 15 * MiB;
constexpr size_t WS_LISTS = 16 * MiB;
constexpr size_t WS_LSE = 32 * MiB;
constexpr size_t WS_WIN = 40 * MiB;
constexpr size_t WS_WAB = 54 * MiB;
constexpr size_t WS_WOUT = 58 * MiB;
constexpr size_t WS_WDN = 60 * MiB;
constexpr size_t WS_WUP = 124 * MiB;
constexpr size_t WS_H0 = 4 * U64;
constexpr size_t WS_YAB = 5 * U64;
constexpr size_t WS_GV = 7 * U64;
constexpr size_t WS_Q = 8 * U64, WS_K = 9 * U64, WS_V = 10 * U64, WS_SA = 11 * U64, WS_SB = 12 * U64;
constexpr size_t WS_OP = 13 * U64;
constexpr size_t WS_MG = WS_GV;
constexpr size_t WS_Z = 14 * U64;
constexpr size_t WS_H1 = WS_H0;
constexpr size_t WS_XG = 5 * U64;
constexpr size_t WS_H1F8 = 12 * U64;
constexpr size_t WS_ACT = 9 * U64 + 16 * MiB;
constexpr size_t WS_YS = WS_XG;
constexpr size_t WS_H0F8 = 13 * U64;
constexpr size_t WS_WIN8 = 192 * MiB;
constexpr int PN8_LO = 8, PN8_HI = 28;
constexpr size_t WS_END = 16 * U64;
static_assert(WS_XG + (size_t)RMAX * 2048 <= WS_ACT && WS_ACT + (size_t)RMAX * 2048 <= WS_Z, "ws map");

constexpr int LDS_BYTES = 163840;
constexpr int LDS_MISC = 131072;
constexpr int NPHASE = 13;

__device__ __forceinline__ float bf2f(bf16_t v) { return __uint_as_float((unsigned)v << 16); }
__device__ __forceinline__ float bflo(unsigned u) { return __uint_as_float(u << 16); }
__device__ __forceinline__ float bfhi(unsigned u) { return __uint_as_float(u & 0xffff0000u); }
__device__ __forceinline__ unsigned f2bf(float f) { unsigned u = __builtin_bit_cast(unsigned, f); return (u + 0x7fffu + ((u >> 16) & 1u)) >> 16; }
__device__ __forceinline__ unsigned pk2(float lo, float hi) { return f2bf(lo) | (f2bf(hi) << 16); }
typedef __bf16 bf16x2_t __attribute__((ext_vector_type(2)));
__device__ __forceinline__ unsigned cvt_pk_bf16(float lo, float hi) { f32x2 v = {lo, hi}; bf16x2_t b = __builtin_convertvector(v, bf16x2_t); return __builtin_bit_cast(unsigned, b); }
__device__ __forceinline__ int lane_id_asm() { int l; asm volatile("v_mbcnt_lo_u32_b32 %0, -1, 0\n\tv_mbcnt_hi_u32_b32 %0, -1, %0" : "=v"(l)); return l; }
__device__ __forceinline__ float wave_sum(float v) {
#pragma unroll
    for (int o = 1; o < 64; o <<= 1) v += __shfl_xor(v, o);
    return v;
}
__device__ __forceinline__ float wave_max(float v) {
#pragma unroll
    for (int o = 1; o < 64; o <<= 1) v = fmaxf(v, __shfl_xor(v, o));
    return v;
}
__device__ __forceinline__ f32x2 gelu_pk(f32x2 v) {
    const f32x2 av = __builtin_elementwise_abs(v), d = av * 0.2316418882f + 1.0f;
    f32x2 t; t.x = __builtin_amdgcn_rcpf(d.x); t.y = __builtin_amdgcn_rcpf(d.y);
    f32x2 q = t * 0.5307027145f + (-0.7265760135f); q = q * t + 0.7107068705f; q = q * t + (-0.142248368f); q = q * t + 0.127414796f; q = q * t;
    const f32x2 s = (v * v) * (-0.72134752044f);
    f32x2 e; e.x = __builtin_amdgcn_exp2f(s.x); e.y = __builtin_amdgcn_exp2f(s.y);
    const f32x2 m = v * (q * e), r = v - m;
    f32x2 o; o.x = v.x < 0.f ? m.x : r.x; o.y = v.y < 0.f ? m.y : r.y; return o;
}
typedef float f32x2v __attribute__((ext_vector_type(2)));
template <bool HI> __device__ __forceinline__ unsigned f8x2_to_bf16x2(unsigned w) { const f32x2v f = __builtin_amdgcn_cvt_pk_f32_fp8((int)w, HI); return cvt_pk_bf16(f.x, f.y); }
__device__ __forceinline__ u32x4 f8x8_to_bf16x8(unsigned lo, unsigned hi) { return (u32x4){f8x2_to_bf16x2<false>(lo), f8x2_to_bf16x2<true>(lo), f8x2_to_bf16x2<false>(hi), f8x2_to_bf16x2<true>(hi)}; }
__device__ __forceinline__ unsigned pack_fp8x4(float a, float b, float c, float d) { unsigned w = 0u; w = __builtin_amdgcn_cvt_pk_fp8_f32(a, b, w, false); w = __builtin_amdgcn_cvt_pk_fp8_f32(c, d, w, true); return w; }
__device__ __forceinline__ float sigmoidf_(float x) { return __builtin_amdgcn_rcpf(1.0f + __builtin_amdgcn_exp2f(-1.4426950408889634f * x)); }

namespace pg8 {
constexpr int BM = 256, BK = 64, HALF = 128, HTB = HALF * BK * 2, STAGE_BYTES = 8 * HTB, NXCD = 8, WGM = 8;
__host__ __device__ __forceinline__ int lds_byte(int r, int c) { const int st = (r >> 4) * 2 + (c >> 5), rr = r & 15, cc = c & 31, ob = rr * 64 + cc * 2; return st * 1024 + (ob ^ (((ob >> 9) & 1) << 5)); }
__host__ __device__ __forceinline__ void stage_rc(int b, int& R, int& C) { const int st = b / 1024, sb = b % 1024, swz = sb ^ (((sb >> 9) & 1) << 5); R = (st >> 1) * 16 + swz / 64; C = (st & 1) * 32 + (swz % 64) / 2; }
__host__ __device__ __forceinline__ int perm32(int rho) { const int n = rho >> 4, i = rho & 15; return 8 * (i >> 2) + 4 * n + (i & 3); }

struct Unit { int pm, pn, bt; };
struct Gemm { const bf16_t* A; const bf16_t* Bt; int K, lda, ldb; const int* rowidx; };

struct StaticOrder {
    int nM, nN, nwg, G, c, pbase, psplit, pjump;
    __device__ void init(int M, int N, int G_, int c_, int pbase_ = 0, int psplit_ = 1 << 20, int pjump_ = 0) { nM = M / BM; nN = N / BM; nwg = nM * nN; G = G_; c = c_; pbase = pbase_; psplit = psplit_; pjump = pjump_; }
    __device__ bool next(int i, Unit& u) const {
        const long L = (long)i * G + c; if (L >= nwg) return false;
        int wgid = (int)L; { const int q = nwg / NXCD, r = nwg % NXCD, xcd = wgid % NXCD, off = wgid / NXCD; wgid = (xcd < r ? xcd * (q + 1) : r * (q + 1) + (xcd - r) * q) + off; }
        const int nig = WGM * nN, gid = wgid / nig, fm = gid * WGM, gsz = (nM - fm) < WGM ? (nM - fm) : WGM;
        u.pm = fm + ((wgid % nig) % gsz); const int p = (wgid % nig) / gsz; u.pn = pbase + (p < psplit ? p : p + pjump); u.bt = u.pn; return true;
    }
};
struct MoeOrder {
    int nM, nN, nwg, G, c; const int* tile_e;
    __device__ void init(const int* tiletab, int nN_, int G_, int c_) { nM = tiletab[0]; tile_e = tiletab + 16; nN = nN_; nwg = nM * nN; G = G_; c = c_; }
    __device__ bool next(int i, Unit& u) const {
        const long L = (long)i * G + c; if (L >= nwg) return false;
        int wgid = (int)L; { const int q = nwg / NXCD, r = nwg % NXCD, xcd = wgid % NXCD, off = wgid / NXCD; wgid = (xcd < r ? xcd * (q + 1) : r * (q + 1) + (xcd - r) * q) + off; }
        const int nig = WGM * nN, gid = wgid / nig, fm = gid * WGM, gsz = (nM - fm) < WGM ? (nM - fm) : WGM;
        u.pm = fm + ((wgid % nig) % gsz); u.pn = (wgid % nig) / gsz; u.bt = tile_e[u.pm] * nN + u.pn; return true;
    }
};

typedef int v4i_t __attribute__((ext_vector_type(4)));
typedef int v8i_t __attribute__((ext_vector_type(8)));
template <class Epi, class Sched, bool ALIGN_EPI, bool FP8 = false, bool GATHER = false>
__device__ __forceinline__ void gemm_phase(LAS unsigned char* lds, const Gemm g, const Sched& S, const Epi& E, const int wid) {
    const int lane = lane_id_asm(), tid = wid * 64 + lane;
    const int wr = wid >> 2, wc = wid & 3, fr = lane & 15, fq = lane >> 4;
    const int nt = g.K / BK;
    unsigned voffA[2], voffB[2]; int gR[2];
#pragma unroll
    for (int i = 0; i < 2; ++i) { int R, C; stage_rc(tid * 16 + i * 8192, R, C); const int Rb = Epi::PERM ? ((R & ~31) + perm32(R & 31)) : R;
        voffA[i] = GATHER ? (unsigned)C * 2u : (unsigned)(R * g.lda + C) * 2u; voffB[i] = (unsigned)(Rb * g.ldb + C) * 2u; gR[i] = R; }
    const size_t kstep = (size_t)(BK * 2);
    const size_t hstepA = GATHER ? 0 : (size_t)HALF * g.lda * 2, hstepB = (size_t)HALF * g.ldb * 2;
    const size_t tstepA = 2 * hstepA, tstepB = 2 * hstepB;
    const unsigned ldsw = (unsigned)wid * 1024u;
    const int aoff = lds_byte(wr * 64 + fr, fq * 8), boff = lds_byte(wc * 32 + fr, fq * 8);
#define PG8_SA(b, h) (((b) * 2 + (h)) * HTB)
#define PG8_SB(b, h) ((4 + (b) * 2 + (h)) * HTB)
#define PG8_STAGE(bufoff, gbase, voff) do { _Pragma("unroll") for (int _i = 0; _i < 2; ++_i) \
        __builtin_amdgcn_global_load_lds((const unsigned*)((const char*)(gbase) + (voff)[_i]), (LAS unsigned*)(lds + (bufoff) + ldsw + _i * 8192), 16, 0, 0); } while (0)
#define PG8_LD8(p) __builtin_shufflevector(*(const LAS v4i_t*)(p), *(const LAS v4i_t*)((p) + 1024), 0, 1, 2, 3, 4, 5, 6, 7)
#define PG8_LDA(dst, b, h) do { _Pragma("unroll") for (int m = 0; m < 4; ++m) { if constexpr (FP8) dst##8[m] = PG8_LD8(lds + PG8_SA(b, h) + aoff + m * 2048); \
        else { _Pragma("unroll") for (int k = 0; k < 2; ++k) dst[m][k] = *(const LAS bf16x8*)(lds + PG8_SA(b, h) + aoff + m * 2048 + k * 1024); } } } while (0)
#define PG8_LDB(dst, b, h) do { _Pragma("unroll") for (int n = 0; n < 2; ++n) { if constexpr (FP8) dst##8[n] = PG8_LD8(lds + PG8_SB(b, h) + boff + n * 2048); \
        else { _Pragma("unroll") for (int k = 0; k < 2; ++k) dst[n][k] = *(const LAS bf16x8*)(lds + PG8_SB(b, h) + boff + n * 2048 + k * 1024); } } } while (0)
#define PG8_MMA(ai, bj, At, Bt) do { __builtin_amdgcn_s_setprio(1); _Pragma("unroll") for (int m = 0; m < 4; ++m) _Pragma("unroll") for (int n = 0; n < 2; ++n) { \
        if constexpr (FP8) { asm volatile("s_nop 1\n\tv_mfma_scale_f32_16x16x128_f8f6f4 %0, %1, %2, %0, %3, %3 op_sel_hi:[0,0,0]" : "+v"(acc[ai][bj][m][n]) : "v"(Bt##8[n]), "v"(At##8[m]), "v"(scl8)); } \
        else { _Pragma("unroll") for (int k = 0; k < 2; ++k) acc[ai][bj][m][n] = __builtin_amdgcn_mfma_f32_16x16x32_bf16(Bt[n][k], At[m][k], acc[ai][bj][m][n], 0, 0, 0); } } \
        __builtin_amdgcn_s_setprio(0); } while (0)
#define PG8_WAIT_V(n) asm volatile("s_waitcnt vmcnt(" #n ")" ::: "memory")
#define PG8_WAIT_L(n) asm volatile("s_waitcnt lgkmcnt(" #n ")" ::: "memory")
#define PG8_BAR __builtin_amdgcn_s_barrier()
#define PG8_SCHED __builtin_amdgcn_sched_barrier(0)
    Unit cur, nxt; int ui = 0;
    if (!S.next(0, cur)) return;
    unsigned va0[2], va1[2], vn0[2], vn1[2];
#define PG8_GIDX(dst0, dst1, u) do { if constexpr (GATHER) { _Pragma("unroll") for (int _i = 0; _i < 2; ++_i) { \
        dst0[_i] = (unsigned)g.rowidx[(u).pm * BM + gR[_i]] * (unsigned)(g.lda * 2) + voffA[_i]; dst1[_i] = (unsigned)g.rowidx[(u).pm * BM + HALF + gR[_i]] * (unsigned)(g.lda * 2) + voffA[_i]; } } \
        else { _Pragma("unroll") for (int _i = 0; _i < 2; ++_i) { dst0[_i] = voffA[_i]; dst1[_i] = voffA[_i]; } } } while (0)
    PG8_GIDX(va0, va1, cur);
    f32x4 acc[2][2][4][2];
#pragma unroll
    for (int a = 0; a < 2; ++a)
#pragma unroll
        for (int b = 0; b < 2; ++b)
#pragma unroll
            for (int m = 0; m < 4; ++m)
#pragma unroll
                for (int n = 0; n < 2; ++n) acc[a][b][m][n] = (f32x4){0.f, 0.f, 0.f, 0.f};
    bf16x8 At[4][2], B0[2][2], B1[2][2]; v8i_t At8[4], B08[2], B18[2];
    int scl8 = 0x7f7f7f7f; asm volatile("" : "+v"(scl8));
    const char* cA = (const char*)g.A + (GATHER ? 0 : (size_t)cur.pm * tstepA); const char* cB = (const char*)g.Bt + (size_t)cur.bt * tstepB;
    PG8_STAGE(PG8_SB(0, 0), cB, voffB); PG8_STAGE(PG8_SB(0, 1), cB + hstepB, voffB); PG8_STAGE(PG8_SA(0, 0), cA, va0); PG8_STAGE(PG8_SA(0, 1), cA + hstepA, va1);
    if (wr == 1) PG8_BAR;
    PG8_WAIT_V(2); PG8_BAR;
    PG8_STAGE(PG8_SB(1, 0), cB + kstep, voffB); PG8_STAGE(PG8_SA(1, 0), cA + kstep, va0); PG8_STAGE(PG8_SB(1, 1), cB + hstepB + kstep, voffB);
    PG8_WAIT_V(6); PG8_BAR;
    for (;;) {
        const bool has_next = S.next(ui + 1, nxt);
        const char* nA = (has_next && !GATHER) ? (const char*)g.A + (size_t)nxt.pm * tstepA : cA; const char* nB = has_next ? (const char*)g.Bt + (size_t)nxt.bt * tstepB : cB;
        if (has_next) PG8_GIDX(vn0, vn1, nxt); else { _Pragma("unroll") for (int _i = 0; _i < 2; ++_i) { vn0[_i] = va0[_i]; vn1[_i] = va1[_i]; } }
#pragma unroll 1
        for (int t = 0; t < nt; t += 2) {
            const bool last = (t == nt - 2);
            const char* a1 = cA + (size_t)(t + 1) * kstep;
            const char* a2 = last ? nA : cA + (size_t)(t + 2) * kstep; const char* b2 = last ? nB : cB + (size_t)(t + 2) * kstep;
            const char* a3 = a2 + kstep; const char* b3 = b2 + kstep;
            if constexpr (Epi::MID_T > 0) { if (t == Epi::MID_T) E.mid(acc, cur, wr, wc, fr, fq); }
            unsigned vs0[2], vs1[2];
#pragma unroll
            for (int _i = 0; _i < 2; ++_i) { vs0[_i] = last ? vn0[_i] : va0[_i]; vs1[_i] = last ? vn1[_i] : va1[_i]; }
            PG8_LDB(B0, 0, 0); PG8_LDB(B1, 0, 1); PG8_SCHED; PG8_LDA(At, 0, 0); PG8_STAGE(PG8_SA(1, 1), a1 + hstepA, va1);
            PG8_WAIT_V(8); PG8_WAIT_L(0); PG8_BAR; PG8_MMA(0, 0, At, B0); PG8_MMA(0, 1, At, B1); PG8_BAR; PG8_SCHED;
            PG8_LDA(At, 0, 1); PG8_STAGE(PG8_SB(0, 0), b2, voffB); PG8_STAGE(PG8_SB(0, 1), b2 + hstepB, voffB); PG8_STAGE(PG8_SA(0, 0), a2, vs0);
            PG8_WAIT_V(8); PG8_WAIT_L(0); PG8_BAR; PG8_MMA(1, 0, At, B0); PG8_MMA(1, 1, At, B1); PG8_BAR; PG8_SCHED;
            PG8_LDB(B0, 1, 0); PG8_LDB(B1, 1, 1); PG8_SCHED; PG8_LDA(At, 1, 0); PG8_STAGE(PG8_SA(0, 1), a2 + hstepA, vs1);
            PG8_WAIT_V(8); PG8_WAIT_L(0); PG8_BAR; PG8_MMA(0, 0, At, B0); PG8_MMA(0, 1, At, B1); PG8_BAR; PG8_SCHED;
            PG8_LDA(At, 1, 1); PG8_STAGE(PG8_SB(1, 0), b3, voffB); PG8_STAGE(PG8_SB(1, 1), b3 + hstepB, voffB); PG8_STAGE(PG8_SA(1, 0), a3, vs0);
            PG8_WAIT_V(8); PG8_WAIT_L(0); PG8_BAR; PG8_MMA(1, 0, At, B0); PG8_MMA(1, 1, At, B1); PG8_BAR; PG8_SCHED;
        }
        if constexpr (ALIGN_EPI) { if (wr == 0) PG8_BAR; }
        if constexpr (FP8) {
#pragma unroll
            for (int a = 0; a < 2; ++a)
#pragma unroll
                for (int b = 0; b < 2; ++b)
                    asm volatile("s_nop 15\n\ts_nop 7" : "+v"(acc[a][b][0][0]), "+v"(acc[a][b][0][1]), "+v"(acc[a][b][1][0]), "+v"(acc[a][b][1][1]), "+v"(acc[a][b][2][0]), "+v"(acc[a][b][2][1]), "+v"(acc[a][b][3][0]), "+v"(acc[a][b][3][1]));
        }
        E(acc, cur, wr, wc, fr, fq);
        if (!has_next) break;
#pragma unroll
        for (int a = 0; a < 2; ++a)
#pragma unroll
            for (int b = 0; b < 2; ++b)
#pragma unroll
                for (int m = 0; m < 4; ++m)
#pragma unroll
                    for (int n = 0; n < 2; ++n) acc[a][b][m][n] = (f32x4){0.f, 0.f, 0.f, 0.f};
        cur = nxt; cA = nA; cB = nB; ++ui;
#pragma unroll
        for (int _i = 0; _i < 2; ++_i) { va0[_i] = vn0[_i]; va1[_i] = vn1[_i]; }
        if constexpr (ALIGN_EPI) { if (wr == 1) PG8_BAR; }
    }
    PG8_WAIT_V(0);
    if constexpr (!ALIGN_EPI) { if (wr == 0) PG8_BAR; }
    PG8_BAR;
#undef PG8_SA
#undef PG8_SB
#undef PG8_STAGE
#undef PG8_GIDX
#undef PG8_LDA
#undef PG8_LDB
#undef PG8_MMA
#undef PG8_LD8
#undef PG8_WAIT_V
#undef PG8_WAIT_L
#undef PG8_BAR
#undef PG8_SCHED
}

typedef f32x4 Acc[2][2][4][2];

struct Epi1 {
    static constexpr bool PERM = true; static constexpr int MID_T = 0;
    bf16_t *yab, *gv; unsigned char *q, *k, *v; bf16_t *sa, *sb; float* gvst; float sc;
    template <int MODE  >
    __device__ __forceinline__ void run(const Acc& acc, const Unit& u, int wr, int wc, int fr, int fq, bf16_t* base, int ld) const {
        const int row0 = u.pm * BM + wr * 64 + fr, col0 = (u.pn & 3) * 256 + wc * 32 + 8 * fq;
#pragma unroll
        for (int ai = 0; ai < 2; ++ai)
#pragma unroll
            for (int m = 0; m < 4; ++m) {
                const int row = row0 + ai * HALF + m * 16; bf16_t* rowp = base + (size_t)row * ld + col0;
                float s1 = 0.f, s2 = 0.f;
#pragma unroll
                for (int bj = 0; bj < 2; ++bj) {
                    f32x4 v0 = acc[ai][bj][m][0], v1 = acc[ai][bj][m][1];
                    if (MODE == 2 || MODE == 3) {
                        const float f = (MODE == 2) ? sc * QSCALE : sc; v0 = v0 * f; v1 = v1 * f;
                        *(u32x2*)((unsigned char*)base + (size_t)row * 1024 + col0 + bj * HALF) = (u32x2){pack_fp8x4(v0[0], v0[1], v0[2], v0[3]), pack_fp8x4(v1[0], v1[1], v1[2], v1[3])};
                        continue;
                    }
                    if (MODE == 0 || MODE == 1) {
                        f32x2 a = gelu_pk((f32x2){v0[0], v0[1]}), b = gelu_pk((f32x2){v0[2], v0[3]}), c = gelu_pk((f32x2){v1[0], v1[1]}), d = gelu_pk((f32x2){v1[2], v1[3]});
                        v0 = (f32x4){a.x, a.y, b.x, b.y}; v1 = (f32x4){c.x, c.y, d.x, d.y};
                    } else if (MODE == 4) {
#pragma unroll
                        for (int j = 0; j < 4; ++j) { v0[j] = sigmoidf_(v0[j] * sc); v1[j] = sigmoidf_(v1[j] * sc); }
                    }
                    if (MODE == 1) {
                        s1 += (v0[0] + v0[1]) + (v0[2] + v0[3]) + (v1[0] + v1[1]) + (v1[2] + v1[3]);
                        s2 += (v0[0] * v0[0] + v0[1] * v0[1]) + (v0[2] * v0[2] + v0[3] * v0[3]) + (v1[0] * v1[0] + v1[1] * v1[1]) + (v1[2] * v1[2] + v1[3] * v1[3]);
                    }
                    u32x4 w; w.x = cvt_pk_bf16(v0[0], v0[1]); w.y = cvt_pk_bf16(v0[2], v0[3]); w.z = cvt_pk_bf16(v1[0], v1[1]); w.w = cvt_pk_bf16(v1[2], v1[3]);
                    *(u32x4*)(rowp + bj * HALF) = w;
                }
                if (MODE == 1) {
                    s1 += __shfl_xor(s1, 16); s1 += __shfl_xor(s1, 32); s2 += __shfl_xor(s2, 16); s2 += __shfl_xor(s2, 32);
                    if (fq == 0) *(f32x2*)(gvst + ((size_t)row * 16 + (u.pn & 3) * 4 + wc) * 2) = (f32x2){s1, s2};
                }
            }
    }
    __device__ __forceinline__ void operator()(const Acc& acc, const Unit& u, int wr, int wc, int fr, int fq) const {
        const int region = u.pn >> 2;
        if (region == 0) run<0>(acc, u, wr, wc, fr, fq, yab, 2048);
        else if (region == 1) run<1>(acc, u, wr, wc, fr, fq, gv, 1024);
        else if (region == 2) run<2>(acc, u, wr, wc, fr, fq, (bf16_t*)q, 1024);
        else if (region == 3) run<3>(acc, u, wr, wc, fr, fq, (bf16_t*)k, 1024);
        else if (region == 4) run<3>(acc, u, wr, wc, fr, fq, (bf16_t*)v, 1024);
        else if (region == 5) run<4>(acc, u, wr, wc, fr, fq, sa, 1024);
        else run<4>(acc, u, wr, wc, fr, fq, sb, 1024);
    }
    __device__ __forceinline__ void mid(Acc&, const Unit&, int, int, int, int) const {}
};

struct Epi2 {
    static constexpr bool PERM = true; static constexpr int MID_T = 16;
    const bf16_t *sa, *sb; bf16_t* mg;
    __device__ __forceinline__ void mid(Acc& acc, const Unit& u, int wr, int wc, int fr, int fq) const {
        int row0 = u.pm * BM + wr * 64 + fr, col0 = u.pn * BM + wc * 32 + 8 * fq;
        asm volatile("" : "+v"(row0), "+v"(col0));
#pragma unroll
        for (int ai = 0; ai < 2; ++ai)
#pragma unroll
            for (int m = 0; m < 4; ++m) {
                const size_t off = (size_t)(row0 + ai * HALF + m * 16) * DM + col0;
#pragma unroll
                for (int bj = 0; bj < 2; ++bj) {
                    const u32x4 a = *(const u32x4*)(sa + off + bj * HALF), b = *(const u32x4*)(sb + off + bj * HALF);
                    f32x4 r0, r1;
#define RQ(x, y) ((x) * __builtin_amdgcn_rcpf(y))
                    r0[0] = RQ(bflo(a.x), bflo(b.x)); r0[1] = RQ(bfhi(a.x), bfhi(b.x)); r0[2] = RQ(bflo(a.y), bflo(b.y)); r0[3] = RQ(bfhi(a.y), bfhi(b.y));
                    r1[0] = RQ(bflo(a.z), bflo(b.z)); r1[1] = RQ(bfhi(a.z), bfhi(b.z)); r1[2] = RQ(bflo(a.w), bflo(b.w)); r1[3] = RQ(bfhi(a.w), bfhi(b.w));
#undef RQ
                    acc[ai][bj][m][0] = acc[ai][bj][m][0] * r0; acc[ai][bj][m][1] = acc[ai][bj][m][1] * r1;
                }
                asm volatile("" : "+v"(acc[ai][0][m][0]), "+v"(acc[ai][0][m][1]), "+v"(acc[ai][1][m][0]), "+v"(acc[ai][1][m][1]));
                asm volatile("" ::: "memory");
            }
    }
    __device__ __forceinline__ void operator()(const Acc& acc, const Unit& u, int wr, int wc, int fr, int fq) const {
        const int row0 = u.pm * BM + wr * 64 + fr, col0 = u.pn * BM + wc * 32 + 8 * fq;
#pragma unroll
        for (int ai = 0; ai < 2; ++ai)
#pragma unroll
            for (int m = 0; m < 4; ++m) {
                const size_t off = (size_t)(row0 + ai * HALF + m * 16) * DM + col0;
#pragma unroll
                for (int bj = 0; bj < 2; ++bj) {
                    const u32x4 b = *(const u32x4*)(sb + off + bj * HALF);
                    const f32x4 v0 = acc[ai][bj][m][0], v1 = acc[ai][bj][m][1];
                    u32x4 w; w.x = cvt_pk_bf16(v0[0] * bflo(b.x), v0[1] * bfhi(b.x)); w.y = cvt_pk_bf16(v0[2] * bflo(b.y), v0[3] * bfhi(b.y));
                    w.z = cvt_pk_bf16(v1[0] * bflo(b.z), v1[1] * bfhi(b.z)); w.w = cvt_pk_bf16(v1[2] * bflo(b.w), v1[3] * bfhi(b.w));
                    *(u32x4*)(mg + off + bj * HALF) = w;
                }
            }
    }
};

struct Epi3 {
    static constexpr bool PERM = false; static constexpr int MID_T = 0;
    const bf16_t* h0; float* z; float* zst;
    __device__ __forceinline__ void mid(Acc&, const Unit&, int, int, int, int) const {}
    __device__ __forceinline__ void operator()(const Acc& acc, const Unit& u, int wr, int wc, int fr, int fq) const {
        const int row0 = u.pm * BM + wr * 64 + fr, col0 = u.pn * BM + wc * 32 + 4 * fq;
#pragma unroll
        for (int ai = 0; ai < 2; ++ai)
#pragma unroll
            for (int m = 0; m < 4; ++m) {
                const int row = row0 + ai * HALF + m * 16; const size_t off = (size_t)row * DM + col0;
                float s1 = 0.f, s2 = 0.f;
#pragma unroll
                for (int bj = 0; bj < 2; ++bj)
#pragma unroll
                    for (int n = 0; n < 2; ++n) {
                        const u32x2 hb = *(const u32x2*)(h0 + off + bj * HALF + n * 16);
                        f32x4 v = acc[ai][bj][m][n];
                        v[0] += ALPHA * bflo(hb.x); v[1] += ALPHA * bfhi(hb.x); v[2] += ALPHA * bflo(hb.y); v[3] += ALPHA * bfhi(hb.y);
                        s1 += (v[0] + v[1]) + (v[2] + v[3]); s2 += (v[0] * v[0] + v[1] * v[1]) + (v[2] * v[2] + v[3] * v[3]);
                        *(f32x4*)(z + off + bj * HALF + n * 16) = v;
                    }
                s1 += __shfl_xor(s1, 16); s1 += __shfl_xor(s1, 32); s2 += __shfl_xor(s2, 16); s2 += __shfl_xor(s2, 32);
                if (fq == 0) *(f32x2*)(zst + ((size_t)row * 16 + u.pn * 4 + wc) * 2) = (f32x2){s1, s2};
            }
    }
};

struct Epi4 {
    static constexpr bool PERM = true; static constexpr int MID_T = 0;
    const float* b_up; unsigned char* act;
    __device__ __forceinline__ void mid(Acc&, const Unit&, int, int, int, int) const {}
    __device__ __forceinline__ void operator()(const Acc& acc, const Unit& u, int wr, int wc, int fr, int fq) const {
        const int e = u.bt >> 3;
        const int row0 = u.pm * BM + wr * 64 + fr, c0 = u.pn * HALF + wc * 32 + 8 * fq;
        const float* bg = b_up + (size_t)e * 2 * FF + c0; const float* bu = bg + FF;
        const f32x4 bg0 = *(const f32x4*)bg, bg1 = *(const f32x4*)(bg + 4), bu0 = *(const f32x4*)bu, bu1 = *(const f32x4*)(bu + 4);
#pragma unroll
        for (int ai = 0; ai < 2; ++ai)
#pragma unroll
            for (int m = 0; m < 4; ++m) {
                const int row = row0 + ai * HALF + m * 16;
                float o[8];
#pragma unroll
                for (int n = 0; n < 2; ++n)
#pragma unroll
                    for (int j = 0; j < 4; ++j) {
                        float gg = acc[ai][0][m][n][j] * 0.03125f + (n ? bg1[j] : bg0[j]), uu = acc[ai][1][m][n][j] * 0.03125f + (n ? bu1[j] : bu0[j]);
                        gg = fminf(gg, 7.0f); uu = fminf(fmaxf(uu, -7.0f), 7.0f);
                        o[n * 4 + j] = (uu + 1.0f) * (gg * sigmoidf_(1.702f * gg));
                    }
                unsigned w0 = 0u, w1 = 0u;
                w0 = __builtin_amdgcn_cvt_pk_fp8_f32(o[0], o[1], w0, false); w0 = __builtin_amdgcn_cvt_pk_fp8_f32(o[2], o[3], w0, true);
                w1 = __builtin_amdgcn_cvt_pk_fp8_f32(o[4], o[5], w1, false); w1 = __builtin_amdgcn_cvt_pk_fp8_f32(o[6], o[7], w1, true);
                *(u32x2*)(act + (size_t)row * FF + c0) = (u32x2){w0, w1};
            }
    }
};

struct Epi5 {
    static constexpr bool PERM = true; static constexpr int MID_T = 0;
    const float* b_down; const float* roww; bf16_t* ys;
    __device__ __forceinline__ void mid(Acc&, const Unit&, int, int, int, int) const {}
    __device__ __forceinline__ void operator()(const Acc& acc, const Unit& u, int wr, int wc, int fr, int fq) const {
        const int e = u.bt >> 2;
        const int row0 = u.pm * BM + wr * 64 + fr, col0 = u.pn * BM + wc * 32 + 8 * fq;
        f32x4 bv[2][2];
#pragma unroll
        for (int bj = 0; bj < 2; ++bj)
#pragma unroll
            for (int n = 0; n < 2; ++n) bv[bj][n] = *(const f32x4*)(b_down + (size_t)e * DM + col0 + bj * HALF + 4 * n);
#pragma unroll
        for (int ai = 0; ai < 2; ++ai)
#pragma unroll
            for (int m = 0; m < 4; ++m) {
                const int row = row0 + ai * HALF + m * 16; const float rw = roww[row];
#pragma unroll
                for (int bj = 0; bj < 2; ++bj) {
                    const f32x4 v0 = (acc[ai][bj][m][0] * 0.015625f + bv[bj][0]) * rw, v1 = (acc[ai][bj][m][1] * 0.015625f + bv[bj][1]) * rw;
                    u32x4 w; w.x = cvt_pk_bf16(v0[0], v0[1]); w.y = cvt_pk_bf16(v0[2], v0[3]); w.z = cvt_pk_bf16(v1[0], v1[1]); w.w = cvt_pk_bf16(v1[2], v1[3]);
                    *(u32x4*)(ys + (size_t)row * DM + col0 + bj * HALF) = w;
                }
            }
    }
};
}

struct Args { const float* in[21]; float* out; unsigned char* ws; int ph_lo, ph_hi; };
enum { I_X = 0, I_LNIN_G, I_LNIN_B, I_WIN, I_GLN_G, I_GLN_B, I_WSP, I_BSP, I_WBA, I_WBB, I_WOUT, I_LNMIX_G, I_LNMIX_B, I_WR, I_BR, I_WUP, I_BUP, I_WDN, I_BDN, I_LNF_G, I_LNF_B };

struct Ctx { const Args* a; unsigned char* ws; LAS unsigned char* lds; unsigned char* ldsg; int tid, lane, wave, G, vcu; };

__device__ __forceinline__ void tr_item(const float* W, int N, int k0, int n0, bf16_t* dst, int drow0, int dld, int dcol0, LAS float* scr, int lane) {
#pragma unroll 8
    for (int i = 0; i < 32; ++i) { const int kk = 2 * i + (lane >> 5); scr[kk * 33 + (lane & 31)] = W[(size_t)(k0 + kk) * N + n0 + (lane & 31)]; }
    asm volatile("s_waitcnt lgkmcnt(0)" ::: "memory");
    const int c = lane & 7;
#pragma unroll
    for (int j = 0; j < 4; ++j) { const int n = (lane >> 3) + 8 * j; const LAS float* s = scr + (8 * c) * 33 + n;
        u32x4 o; o.x = pk2(s[0 * 33], s[1 * 33]); o.y = pk2(s[2 * 33], s[3 * 33]); o.z = pk2(s[4 * 33], s[5 * 33]); o.w = pk2(s[6 * 33], s[7 * 33]);
        *(u32x4*)(dst + (size_t)(drow0 + n) * dld + dcol0 + k0 + 8 * c) = o; }
    asm volatile("s_waitcnt lgkmcnt(0)" ::: "memory");
}
__device__ __forceinline__ void tr_item8(const float* W, int N, int k0, int n0, unsigned char* dst, int drow0, int dld, float sc, LAS float* scr, int lane) {
#pragma unroll 8
    for (int i = 0; i < 32; ++i) { const int kk = 2 * i + (lane >> 5); scr[kk * 33 + (lane & 31)] = W[(size_t)(k0 + kk) * N + n0 + (lane & 31)]; }
    asm volatile("s_waitcnt lgkmcnt(0)" ::: "memory");
    const int c = lane & 7;
#pragma unroll
    for (int j = 0; j < 4; ++j) { const int n = (lane >> 3) + 8 * j; const LAS float* s = scr + (8 * c) * 33 + n;
        unsigned w0 = 0u, w1 = 0u;
        w0 = __builtin_amdgcn_cvt_pk_fp8_f32(s[0 * 33] * sc, s[1 * 33] * sc, w0, false); w0 = __builtin_amdgcn_cvt_pk_fp8_f32(s[2 * 33] * sc, s[3 * 33] * sc, w0, true);
        w1 = __builtin_amdgcn_cvt_pk_fp8_f32(s[4 * 33] * sc, s[5 * 33] * sc, w1, false); w1 = __builtin_amdgcn_cvt_pk_fp8_f32(s[6 * 33] * sc, s[7 * 33] * sc, w1, true);
        *(u32x2*)(dst + (size_t)(drow0 + n) * dld + k0 + 8 * c) = (u32x2){w0, w1}; }
    asm volatile("s_waitcnt lgkmcnt(0)" ::: "memory");
}
__device__ __forceinline__ void ph_prologue(const Ctx& F) {
    const Args& A = *F.a;
    LAS float* scr = (LAS float*)(F.lds + F.wave * 16384);
    const int gw = F.vcu * 8 + F.wave, NGW = F.G * 8;
    bf16_t* WIN = (bf16_t*)(F.ws + WS_WIN); bf16_t* WAB = (bf16_t*)(F.ws + WS_WAB); bf16_t* WOUT = (bf16_t*)(F.ws + WS_WOUT);
    unsigned char* WDN = F.ws + WS_WDN; unsigned char* WUP = F.ws + WS_WUP;
    constexpr int I_IN = 16 * (INCOLS / 32), I_SQ = 16 * 32, I_UP = NE * 16 * 64, I_DN = NE * 16 * 32;
    constexpr int NITEMS = I_IN + 3 * I_SQ + I_UP + I_DN;
    for (int it = gw; it < NITEMS; it += NGW) {
        int r = it;
        if (r < I_IN) { const int nblk = INCOLS / 32, kb = r / nblk, nb = r % nblk;
            if (32 * nb >= PN8_LO * 256 && 32 * nb < PN8_HI * 256) tr_item8(A.in[I_WIN], INCOLS, 64 * kb, 32 * nb, F.ws + WS_WIN8, 32 * nb, DM, 32.0f, scr, F.lane);
            else tr_item(A.in[I_WIN], INCOLS, 64 * kb, 32 * nb, WIN, 32 * nb, DM, 0, scr, F.lane);
            continue; } r -= I_IN;
        if (r < I_SQ) { const int kb = r / 32, nb = r % 32; tr_item(A.in[I_WBA], DM, 64 * kb, 32 * nb, WAB, 32 * nb, 2048, 0, scr, F.lane); continue; } r -= I_SQ;
        if (r < I_SQ) { const int kb = r / 32, nb = r % 32; tr_item(A.in[I_WBB], DM, 64 * kb, 32 * nb, WAB, 32 * nb, 2048, 1024, scr, F.lane); continue; } r -= I_SQ;
        if (r < I_SQ) { const int kb = r / 32, nb = r % 32; tr_item(A.in[I_WOUT], DM, 64 * kb, 32 * nb, WOUT, 32 * nb, DM, 0, scr, F.lane); continue; } r -= I_SQ;
        if (r < I_UP) { const int e = r / (16 * 64), rr = r % (16 * 64), kb = rr / 64, nb = rr % 64; const int n0 = 32 * nb, half = n0 >= FF, rem = n0 - half * FF, pn = rem >> 7, b = (rem & 127) >> 5;
            tr_item8(A.in[I_WUP] + (size_t)e * DM * 2 * FF, 2 * FF, 64 * kb, n0, WUP, e * 2048 + 256 * pn + half * 128 + 32 * b, DM, 32.0f, scr, F.lane); continue; } r -= I_UP;
        { const int e = r / (16 * 32), rr = r % (16 * 32), kb = rr / 32, nb = rr % 32; tr_item8(A.in[I_WDN] + (size_t)e * FF * DM, DM, 64 * kb, 32 * nb, WDN, e * 1024 + 32 * nb, FF, 64.0f, scr, F.lane); }
    }
    const float* lg = A.in[I_LNIN_G]; const float* lb = A.in[I_LNIN_B]; bf16_t* H0 = (bf16_t*)(F.ws + WS_H0);
    f32x4 gg[4], bb[4];
#pragma unroll
    for (int j = 0; j < 4; ++j) { gg[j] = *((const f32x4*)lg + F.lane + 64 * j); bb[j] = *((const f32x4*)lb + F.lane + 64 * j); }
    for (int m = gw; m < T; m += NGW) {
        const f32x4* xr = (const f32x4*)(A.in[I_X] + (size_t)m * DM) + F.lane;
        f32x4 v[4]; float s = 0.f;
#pragma unroll
        for (int j = 0; j < 4; ++j) { v[j] = xr[64 * j]; s += (v[j].x + v[j].y) + (v[j].z + v[j].w); }
        const float mean = wave_sum(s) * (1.f / DM); float s2 = 0.f;
#pragma unroll
        for (int j = 0; j < 4; ++j) { v[j] = v[j] - mean; s2 += (v[j].x * v[j].x + v[j].y * v[j].y) + (v[j].z * v[j].z + v[j].w * v[j].w); }
        const float rstd = 1.f / sqrtf(wave_sum(s2) * (1.f / DM) + LN_EPS);
        u32x2* o8 = (u32x2*)(H0 + (size_t)m * DM) + F.lane; unsigned* o4 = (unsigned*)(F.ws + WS_H0F8 + (size_t)m * DM) + F.lane;
#pragma unroll
        for (int j = 0; j < 4; ++j) { const f32x4 y = v[j] * rstd * gg[j] + bb[j]; o8[64 * j] = (u32x2){pk2(y.x, y.y), pk2(y.z, y.w)}; o4[64 * j] = pack_fp8x4(y.x, y.y, y.z, y.w); }
    }
}

__device__ __forceinline__ void ph_kmean(const Ctx& F) {
    const unsigned char* K = F.ws + WS_K; float* KM = (float*)(F.ws + WS_KMEAN);
    float* red = (float*)F.ldsg;
    const int d = F.tid & 127, part = F.tid >> 7;
    for (int it = F.vcu; it < NB * NH * NBLK; it += F.G) {
        const int b = it / (NH * NBLK), h = (it / NBLK) % NH, j = it % NBLK;
        const unsigned char* kp = K + ((size_t)(b * SEQ + j * LBLK + part * 64)) * DM + h * DH + d;
        float s = 0.f;
        for (int r = 0; r < 64; ++r) s += __builtin_amdgcn_cvt_f32_fp8((int)kp[(size_t)r * DM], 0);
        red[part * 128 + d] = s;
        __syncthreads();
        if (F.tid < 128) KM[(size_t)it * DH + d] = (red[d] + red[128 + d] + red[256 + d] + red[384 + d]) * (1.0f / LBLK);
        __syncthreads();
    }
}
typedef short v4i16_t __attribute__((ext_vector_type(4)));
__device__ __forceinline__ v4i16_t lds_tr16(LAS const unsigned char* p) { return __builtin_amdgcn_ds_read_tr16_b64_v4i16((LAS v4i16_t*)p); }
__device__ __forceinline__ void ph_mixer_a(const Ctx& F) {
    const Args& A = *F.a;
    const bf16_t* GV = (const bf16_t*)(F.ws + WS_GV); bf16_t* YAB = (bf16_t*)(F.ws + WS_YAB); const float* GVST = (const float*)(F.ws + WS_GVST);
    const float* lg = A.in[I_GLN_G]; const float* lb = A.in[I_GLN_B]; const float* wsp = A.in[I_WSP]; const float* bsp = A.in[I_BSP];
    constexpr int RSV = 544, RSW = 272, OFF_W = 128 * RSV, OFF_ST = OFF_W + 128 * RSW;
    LAS unsigned char* VT = F.lds; LAS unsigned char* WT = F.lds + OFF_W; LAS float* ST = (LAS float*)(F.lds + OFF_ST);
    const int lane = F.lane, wv = F.wave;
    int curg = -1;
    for (int it = F.vcu; it < NB * 32 * 4; it += F.G) {
        const int b = it / 128, c = (it >> 2) & 31, g = it & 3;
        const int tok0 = b * SEQ + c * 128;
        if (g != curg) {
            curg = g;
            for (int k = 0; k < 4; ++k) {
                const int idx = F.tid + 512 * k, t = idx >> 4, s8 = (idx & 15) * 8;
                const f32x4 w0 = *(const f32x4*)(wsp + ((size_t)g * 128 + t) * 128 + s8), w1 = *(const f32x4*)(wsp + ((size_t)g * 128 + t) * 128 + s8 + 4);
                float x[8] = {w0.x, w0.y, w0.z, w0.w, w1.x, w1.y, w1.z, w1.w};
#pragma unroll
                for (int j = 0; j < 8; ++j) x[j] = (s8 + j <= t) ? x[j] : 0.f;
                u32x4 o; o.x = pk2(x[0], x[1]); o.y = pk2(x[2], x[3]); o.z = pk2(x[4], x[5]); o.w = pk2(x[6], x[7]);
                *(LAS u32x4*)(WT + t * RSW + s8 * 2) = o;
            }
        }
        if (F.tid < 128) {
            const float* p = GVST + (size_t)(tok0 + F.tid) * 32; float s1 = 0.f, s2 = 0.f;
            for (int i = 0; i < 16; ++i) { s1 += p[2 * i]; s2 += p[2 * i + 1]; }
            const float mean = s1 * (1.f / DM), var = s2 * (1.f / DM) - mean * mean;
            ST[2 * F.tid] = mean; ST[2 * F.tid + 1] = 1.f / sqrtf(fmaxf(var, 0.f) + LN_EPS);
        }
        __syncthreads();
        {
            const int dc = F.tid & 31;
            const f32x4 g0 = *(const f32x4*)(lg + g * 256 + dc * 8), g1 = *(const f32x4*)(lg + g * 256 + dc * 8 + 4), b0 = *(const f32x4*)(lb + g * 256 + dc * 8), b1 = *(const f32x4*)(lb + g * 256 + dc * 8 + 4);
#pragma unroll
            for (int k = 0; k < 8; ++k) {
                const int s = (F.tid >> 5) + 16 * k;
                const u32x4 raw = *(const u32x4*)(GV + (size_t)(tok0 + s) * DM + g * 256 + dc * 8);
                const float mean = ST[2 * s], rstd = ST[2 * s + 1];
                f32x4 x0 = {bflo(raw.x), bfhi(raw.x), bflo(raw.y), bfhi(raw.y)}, x1 = {bflo(raw.z), bfhi(raw.z), bflo(raw.w), bfhi(raw.w)};
                x0 = (x0 - mean) * rstd * g0 + b0; x1 = (x1 - mean) * rstd * g1 + b1;
                u32x4 o; o.x = pk2(x0.x, x0.y); o.y = pk2(x0.z, x0.w); o.z = pk2(x1.x, x1.y); o.w = pk2(x1.z, x1.w);
                *(LAS u32x4*)(VT + s * RSV + dc * 16) = o;
            }
        }
        __syncthreads();
        {
            const int dbase = 32 * wv, kg = lane >> 4, q = (lane & 15) >> 2, p = lane & 3, fr = lane & 15;
            bf16x8 Af[2][4];
#pragma unroll
            for (int m = 0; m < 2; ++m)
#pragma unroll
                for (int kk = 0; kk < 4; ++kk) {
                    LAS const unsigned char* ap = VT + (32 * kk + 8 * kg + q) * RSV + (dbase + 16 * m + 4 * p) * 2;
                    const v4i16_t lo = lds_tr16(ap), hi = lds_tr16(ap + 4 * RSV);
                    Af[m][kk] = (bf16x8){lo[0], lo[1], lo[2], lo[3], hi[0], hi[1], hi[2], hi[3]};
                }
#pragma unroll
            for (int n = 0; n < 8; ++n) {
                f32x4 acc0 = {0.f, 0.f, 0.f, 0.f}, acc1 = {0.f, 0.f, 0.f, 0.f};
#pragma unroll
                for (int kk = 0; kk < 4; ++kk) if (kk <= (n >> 1)) {
                    const bf16x8 Bf = *(LAS const bf16x8*)(WT + (16 * n + fr) * RSW + (32 * kk + 8 * kg) * 2);
                    acc0 = __builtin_amdgcn_mfma_f32_16x16x32_bf16(Af[0][kk], Bf, acc0, 0, 0, 0);
                    acc1 = __builtin_amdgcn_mfma_f32_16x16x32_bf16(Af[1][kk], Bf, acc1, 0, 0, 0);
                }
                const int t = 16 * n + fr; const float bsv = bsp[g * 128 + t];
                bf16_t* yp = YAB + (size_t)(tok0 + t) * 2048 + g * 256 + dbase + 4 * kg;
                const u32x2 u0 = *(const u32x2*)yp, u1 = *(const u32x2*)(yp + 16);
                u32x2 o0, o1;
                o0.x = pk2(bflo(u0.x) * (acc0[0] + bsv), bfhi(u0.x) * (acc0[1] + bsv)); o0.y = pk2(bflo(u0.y) * (acc0[2] + bsv), bfhi(u0.y) * (acc0[3] + bsv));
                o1.x = pk2(bflo(u1.x) * (acc1[0] + bsv), bfhi(u1.x) * (acc1[1] + bsv)); o1.y = pk2(bflo(u1.y) * (acc1[2] + bsv), bfhi(u1.y) * (acc1[3] + bsv));
                *(u32x2*)yp = o0; *(u32x2*)(yp + 16) = o1;
            }
        }
        __syncthreads();
    }
}

__device__ __forceinline__ void ph_gate(const Ctx& F) {
    const unsigned char* Q = F.ws + WS_Q; const float* KM = (const float*)(F.ws + WS_KMEAN);
    unsigned* SEL = (unsigned*)(F.ws + WS_SEL); unsigned* LISTS = (unsigned*)(F.ws + WS_LISTS); unsigned* LCNT = (unsigned*)(F.ws + WS_CTL) + CW_LCNT;
    float* km = (float*)F.ldsg;
    unsigned* lc = (unsigned*)(F.ldsg + 8192);
    for (int it = F.vcu; it < NB * NH * 8; it += F.G) {
        const int b = it / 64, h = (it >> 3) & 7, tc = it & 7;
        for (int i = F.tid; i < NBLK * DH; i += 512) km[i] = KM[(size_t)(b * NH + h) * NBLK * DH + i];
        if (F.tid < 32) lc[F.tid] = 0u;
        __syncthreads();
        const int t = tc * 512 + F.tid, qi = t >> 8;
        float gsc[15];
#pragma unroll
        for (int j = 0; j < 15; ++j) gsc[j] = 0.f;
        const unsigned char* qp = Q + (size_t)(b * SEQ + t) * DM + h * DH;
        for (int c = 0; c < 16; ++c) {
            const u32x2 raw = *(const u32x2*)(qp + c * 8);
            const f32x2v f0 = __builtin_amdgcn_cvt_pk_f32_fp8((int)raw.x, false), f1 = __builtin_amdgcn_cvt_pk_f32_fp8((int)raw.x, true), f2 = __builtin_amdgcn_cvt_pk_f32_fp8((int)raw.y, false), f3 = __builtin_amdgcn_cvt_pk_f32_fp8((int)raw.y, true);
            const float x[8] = {f0.x, f0.y, f1.x, f1.y, f2.x, f2.y, f3.x, f3.y};
#pragma unroll
            for (int j = 0; j < 15; ++j) if (j < qi) {
                const float* kk = km + j * DH + c * 8;
#pragma unroll
                for (int e = 0; e < 8; ++e) gsc[j] += x[e] * kk[e];
            }
        }
        const int nsel = qi < 3 ? qi : 3;
        int sel[3] = {0, 0, 0}; unsigned lpos[3] = {0, 0, 0};
#pragma unroll
        for (int r = 0; r < 3; ++r) {
            float best = -INFINITY; int bi = -1;
#pragma unroll
            for (int j = 0; j < 15; ++j) { const bool c = (j < qi) && (gsc[j] > best); best = c ? gsc[j] : best; bi = c ? j : bi; }
#pragma unroll
            for (int j = 0; j < 15; ++j) if (j == bi) gsc[j] = -INFINITY;
            sel[r] = bi < 0 ? 0 : bi;
            if (r < nsel) lpos[r] = atomicAdd(&lc[sel[r]], 1u);
        }
        SEL[(size_t)(b * SEQ + t) * NH + h] = (unsigned)sel[0] | ((unsigned)sel[1] << 8) | ((unsigned)sel[2] << 16) | ((unsigned)nsel << 24);
        __syncthreads();
        if (F.tid < 16) lc[16 + F.tid] = lc[F.tid] ? atomicAdd(&LCNT[(b * NH + h) * NBLK + F.tid], lc[F.tid]) : 0u;
        __syncthreads();
#pragma unroll
        for (int r = 0; r < 3; ++r) if (r < nsel) LISTS[(size_t)((b * NH + h) * NBLK + sel[r]) * 4096 + lc[16 + sel[r]] + lpos[r]] = (unsigned)t | ((unsigned)r << 12);
        __syncthreads();
    }
}

__device__ __forceinline__ void ph_attn_naive(const Ctx& F) {
    const bf16_t* Q = (const bf16_t*)(F.ws + WS_Q); const bf16_t* K = (const bf16_t*)(F.ws + WS_K); const bf16_t* V = (const bf16_t*)(F.ws + WS_V);
    const unsigned* SEL = (const unsigned*)(F.ws + WS_SEL); bf16_t* YAB = (bf16_t*)(F.ws + WS_YAB);
    float* qs = (float*)(F.ldsg + F.wave * 4608);
    float* sc = qs + 128;
    const int gw = F.vcu * 8 + F.wave, NGW = F.G * 8;
    for (int w = gw; w < NB * NH * SEQ; w += NGW) {
        const int b = w / (NH * SEQ), h = (w / SEQ) % NH, t = w % SEQ, qi = t >> 8, tl = t & 255;
        const size_t tok = (size_t)b * SEQ + t;
        { const unsigned qq = *(const unsigned*)(Q + tok * DM + h * DH + 2 * F.lane); qs[2 * F.lane] = bflo(qq); qs[2 * F.lane + 1] = bfhi(qq); }
        const unsigned selw = SEL[tok * NH + h]; const int nsel = selw >> 24;
        float mx = -INFINITY;
        for (int r = 0; r <= nsel; ++r) {
            const int jb = (r < nsel) ? (int)((selw >> (8 * r)) & 0xff) : qi;
            for (int c = 0; c < 4; ++c) {
                const int key = c * 64 + F.lane;
                const bool valid = (r < nsel) || (key <= tl);
                const bf16_t* kp = K + ((size_t)b * SEQ + jb * LBLK + key) * DM + h * DH;
                float s = 0.f;
#pragma unroll 4
                for (int dd = 0; dd < 16; ++dd) {
                    const u32x4 raw = *(const u32x4*)(kp + dd * 8);
                    const float* q8 = qs + dd * 8;
                    s += bflo(raw.x) * q8[0] + bfhi(raw.x) * q8[1] + bflo(raw.y) * q8[2] + bfhi(raw.y) * q8[3] + bflo(raw.z) * q8[4] + bfhi(raw.z) * q8[5] + bflo(raw.w) * q8[6] + bfhi(raw.w) * q8[7];
                }
                s = valid ? s : -INFINITY;
                sc[r * 256 + key] = s; mx = fmaxf(mx, s);
            }
        }
        mx = wave_max(mx);
        float l = 0.f;
        const int ntot = (nsel + 1) * 256;
        for (int i = F.lane; i < ntot; i += 64) { const float p = __builtin_amdgcn_exp2f(sc[i] - mx); sc[i] = p; l += p; }
        l = wave_sum(l);
        float o0 = 0.f, o1 = 0.f;
        for (int r = 0; r <= nsel; ++r) {
            const int jb = (r < nsel) ? (int)((selw >> (8 * r)) & 0xff) : qi;
            const int nk = (r < nsel) ? 256 : tl + 1;
            const bf16_t* vp = V + ((size_t)b * SEQ + jb * LBLK) * DM + h * DH + 2 * F.lane;
#pragma unroll 4
            for (int key = 0; key < nk; ++key) { const unsigned vv = *(const unsigned*)(vp + (size_t)key * DM); const float p = sc[r * 256 + key]; o0 += p * bflo(vv); o1 += p * bfhi(vv); }
        }
        const float il = 1.f / l;
        *(unsigned*)(YAB + tok * 2048 + 1024 + h * DH + 2 * F.lane) = pk2(o0 * il, o1 * il);
    }
}

typedef float f32x16 __attribute__((ext_vector_type(16)));
namespace att {
constexpr int KCH = 4112, VDB = 16448, OFF_K = 0, OFF_V = 16 * KCH, OFF_WS = OFF_V + 4 * VDB  , WSW = 512, OFF_TAB = OFF_WS + 8 * WSW  ;
static_assert(OFF_TAB + 1028 * 4 <= LDS_BYTES, "attention LDS map");
__device__ __forceinline__ int crow(int r, int hi) { return (r & 3) + 8 * (r >> 2) + 4 * hi; }
#define TRR(dst, vaddr, off) asm volatile("ds_read_b64_tr_b16 %0, %1 offset:%c2" : "=v"(dst) : "v"(vaddr), "i"(off) : "memory")
#define TRWAIT() do { asm volatile("s_waitcnt lgkmcnt(0)" ::: "memory"); __builtin_amdgcn_sched_barrier(0); } while (0)

__device__ __forceinline__ void load_kv(const Ctx& F, const unsigned char* K, const unsigned char* V, size_t tokbase, int h) {
    u32x4 kv[4], vv[4];
#pragma unroll
    for (int k = 0; k < 4; ++k) { const int idx = F.tid + 512 * k, key = idx >> 3, c2 = idx & 7; const size_t off = (tokbase + key) * DM + h * DH + c2 * 16;
        kv[k] = *(const u32x4*)(K + off); vv[k] = *(const u32x4*)(V + off); }
#pragma unroll
    for (int k = 0; k < 4; ++k) { const int idx = F.tid + 512 * k, key = idx >> 3, c2 = idx & 7, c = 2 * c2;
        *(LAS u32x4*)(F.lds + OFF_K + c * KCH + key * 16) = f8x8_to_bf16x8(kv[k].x, kv[k].y);
        *(LAS u32x4*)(F.lds + OFF_K + (c + 1) * KCH + key * 16) = f8x8_to_bf16x8(kv[k].z, kv[k].w);
        LAS unsigned char* vd = F.lds + OFF_V + (c >> 2) * VDB + (key >> 3) * 512 + (key & 7) * 64 + (c & 3) * 16;
        *(LAS u32x4*)vd = f8x8_to_bf16x8(vv[k].x, vv[k].y); *(LAS u32x4*)(vd + 16) = f8x8_to_bf16x8(vv[k].z, vv[k].w); }
}

template <bool CAUSAL>
__device__ __forceinline__ void core(const Ctx& F, const unsigned char* qrow, f32x16 (&o)[4], float& m, float& l) {
    const int r = F.lane & 31, hh = F.lane >> 5;
    LAS float* wsf = (LAS float*)(F.lds + OFF_WS + F.wave * WSW);
    bf16x8 qr[8];
#pragma unroll
    for (int ds = 0; ds < 8; ++ds) { const u32x2 raw = *(const u32x2*)(qrow + ds * 16 + hh * 8); qr[ds] = __builtin_bit_cast(bf16x8, f8x8_to_bf16x8(raw.x, raw.y)); }
#pragma unroll
    for (int db = 0; db < 4; ++db)
#pragma unroll
        for (int i = 0; i < 16; ++i) o[db][i] = 0.f;
    m = -1e30f; l = 0.f;
    const int nt = CAUSAL ? (F.wave >> 1) + 1 : 4;
    LAS const unsigned char* kbase = F.lds + OFF_K + hh * KCH + r * 16;
    LAS const unsigned char* vbase = F.lds + OFF_V + (4 * hh + ((F.lane & 15) >> 2)) * 64 + ((F.lane >> 4) & 1) * 32 + (F.lane & 3) * 8;
    for (int kt = 0; kt < nt; ++kt) {
        const bool diag = CAUSAL && (kt == nt - 1);
        constexpr bool skip1 = false;
        f32x16 p0, p1;
#pragma unroll
        for (int i = 0; i < 16; ++i) { p0[i] = 0.f; p1[i] = 0.f; }
        LAS const unsigned char* kp = kbase + (64 * kt) * 16;
        LAS const unsigned char* vp = vbase + (8 * kt) * 512;
        {
            bf16x8 ka[8], kb[8];
#pragma unroll
            for (int ds = 0; ds < 8; ++ds) ka[ds] = *(LAS const bf16x8*)(kp + 2 * ds * KCH);
            if (!skip1) {
#pragma unroll
                for (int ds = 0; ds < 8; ++ds) kb[ds] = *(LAS const bf16x8*)(kp + 2 * ds * KCH + 512);
            }
            __builtin_amdgcn_sched_barrier(0);
#pragma unroll
            for (int ds = 0; ds < 8; ++ds) p0 = __builtin_amdgcn_mfma_f32_32x32x16_bf16(ka[ds], qr[ds], p0, 0, 0, 0);
            if (!skip1) {
#pragma unroll
                for (int ds = 0; ds < 8; ++ds) p1 = __builtin_amdgcn_mfma_f32_32x32x16_bf16(kb[ds], qr[ds], p1, 0, 0, 0);
            }
            __builtin_amdgcn_sched_barrier(0);
        }
        v4i16_t vl[2][4], vh[2][4];
        const unsigned vaddr = (unsigned)(uintptr_t)vp;
#pragma unroll
        for (int ks = 0; ks < 2; ++ks)
#pragma unroll
            for (int db = 0; db < 4; ++db) { TRR(vl[ks][db], vaddr, db * VDB + ks * 1024); TRR(vh[ks][db], vaddr, db * VDB + ks * 1024 + 512); }
        __builtin_amdgcn_sched_barrier(0);
        if (diag) {
            if (F.wave & 1) {
#pragma unroll
                for (int i = 0; i < 16; ++i) p1[i] = (crow(i, hh) > r) ? -INFINITY : p1[i];
            } else {
#pragma unroll
                for (int i = 0; i < 16; ++i) { p0[i] = (crow(i, hh) > r) ? -INFINITY : p0[i]; p1[i] = -INFINITY; }
            }
        }
        float mx = fmaxf(p0[0], p1[0]);
#pragma unroll
        for (int i = 1; i < 16; ++i) mx = fmaxf(mx, fmaxf(p0[i], p1[i]));
        mx = fmaxf(mx, __shfl_xor(mx, 32));
        const float mnew = fmaxf(m, mx);
        if (__any(mnew > m)) {
            const float alpha = __builtin_amdgcn_exp2f(m - mnew);
            l *= alpha; m = mnew;
            if (hh == 0) wsf[r] = alpha;
            asm volatile("s_waitcnt lgkmcnt(0)" ::: "memory");
#pragma unroll
            for (int i = 0; i < 16; ++i) { const float a = wsf[crow(i, hh)];
#pragma unroll
                for (int db = 0; db < 4; ++db) o[db][i] *= a; }
        }
        float ls = 0.f;
#pragma unroll
        for (int i = 0; i < 16; ++i) { p0[i] = __builtin_amdgcn_exp2f(p0[i] - m); p1[i] = __builtin_amdgcn_exp2f(p1[i] - m); ls += p0[i] + p1[i]; }
        l += ls;
        u32x4 pw[4];
#pragma unroll
        for (int s2 = 0; s2 < 2; ++s2) {
            pw[s2] = (u32x4){cvt_pk_bf16(p0[8 * s2], p0[8 * s2 + 1]), cvt_pk_bf16(p0[8 * s2 + 2], p0[8 * s2 + 3]), cvt_pk_bf16(p0[8 * s2 + 4], p0[8 * s2 + 5]), cvt_pk_bf16(p0[8 * s2 + 6], p0[8 * s2 + 7])};
            pw[2 + s2] = (u32x4){cvt_pk_bf16(p1[8 * s2], p1[8 * s2 + 1]), cvt_pk_bf16(p1[8 * s2 + 2], p1[8 * s2 + 3]), cvt_pk_bf16(p1[8 * s2 + 4], p1[8 * s2 + 5]), cvt_pk_bf16(p1[8 * s2 + 6], p1[8 * s2 + 7])};
        }
        TRWAIT();
        v4i16_t wl[2][4], wh[2][4];
        if (!skip1) {
#pragma unroll
            for (int ks = 0; ks < 2; ++ks)
#pragma unroll
                for (int db = 0; db < 4; ++db) { TRR(wl[ks][db], vaddr, db * VDB + (2 + ks) * 1024); TRR(wh[ks][db], vaddr, db * VDB + (2 + ks) * 1024 + 512); }
        }
        __builtin_amdgcn_sched_barrier(0);
#pragma unroll
        for (int ks = 0; ks < 2; ++ks) {
            const bf16x8 pa = __builtin_bit_cast(bf16x8, pw[ks]);
#pragma unroll
            for (int db = 0; db < 4; ++db) {
                const bf16x8 vf = (bf16x8){vl[ks][db][0], vl[ks][db][1], vl[ks][db][2], vl[ks][db][3], vh[ks][db][0], vh[ks][db][1], vh[ks][db][2], vh[ks][db][3]};
                o[db] = __builtin_amdgcn_mfma_f32_32x32x16_bf16(pa, vf, o[db], 0, 0, 0);
            }
        }
        TRWAIT();
        if (!skip1) {
#pragma unroll
            for (int ks = 0; ks < 2; ++ks) {
                const bf16x8 pa = __builtin_bit_cast(bf16x8, pw[2 + ks]);
#pragma unroll
                for (int db = 0; db < 4; ++db) {
                    const bf16x8 vf = (bf16x8){wl[ks][db][0], wl[ks][db][1], wl[ks][db][2], wl[ks][db][3], wh[ks][db][0], wh[ks][db][1], wh[ks][db][2], wh[ks][db][3]};
                    o[db] = __builtin_amdgcn_mfma_f32_32x32x16_bf16(pa, vf, o[db], 0, 0, 0);
                }
            }
        }
        __builtin_amdgcn_sched_barrier(0);
    }
}
__device__ __forceinline__ void finish_and_stage(const Ctx& F, const f32x16 (&o)[4], float m, float l) {
    const int r = F.lane & 31, hh = F.lane >> 5;
    LAS float* wsf = (LAS float*)(F.lds + OFF_WS + F.wave * WSW);
    const float lt = l + __shfl_xor(l, 32);
    if (hh == 0) { wsf[r] = 1.0f / lt; wsf[32 + r] = m + __builtin_amdgcn_logf(lt); }
    __syncthreads();
    LAS float* stg = (LAS float*)(F.lds + F.wave * 16384);
#pragma unroll
    for (int i = 0; i < 16; ++i) { const int q = crow(i, hh); const float a = wsf[q];
#pragma unroll
        for (int db = 0; db < 4; ++db) stg[q * 128 + 32 * db + r] = o[db][i] * a; }
    asm volatile("s_waitcnt lgkmcnt(0)" ::: "memory");
}
}

__device__ __forceinline__ void ph_attn_partial(const Ctx& F) {
    using namespace att;
    const unsigned char* Q = F.ws + WS_Q; const unsigned char* K = F.ws + WS_K; const unsigned char* V = F.ws + WS_V;
    const unsigned* LISTS = (const unsigned*)(F.ws + WS_LISTS); const unsigned* LCNT = (const unsigned*)(F.ws + WS_CTL) + CW_LCNT;
    bf16_t* OP = (bf16_t*)(F.ws + WS_OP); float* LSE = (float*)(F.ws + WS_LSE);
    LAS int* P = (LAS int*)(F.lds + OFF_TAB);
    if (F.tid < 64) {
        int c[16]; int s = 0;
#pragma unroll
        for (int i = 0; i < 16; ++i) { c[i] = ((int)__hip_atomic_load(LCNT + F.tid * 16 + i, __ATOMIC_RELAXED, __HIP_MEMORY_SCOPE_AGENT) + 255) >> 8; s += c[i]; }
        int inc = s;
#pragma unroll
        for (int o = 1; o < 64; o <<= 1) { const int t = __shfl_up(inc, o); if (F.lane >= o) inc += t; }
        int run = inc - s;
#pragma unroll
        for (int i = 0; i < 16; ++i) { P[F.tid * 16 + i] = run; run += c[i]; }
        if (F.tid == 63) P[1024] = run;
    }
    __syncthreads();
    const int total = P[1024];
    LAS float* wsf = (LAS float*)(F.lds + OFF_WS + F.wave * WSW);
    LAS int* wsi = (LAS int*)wsf;
    for (int item = F.vcu; item < total; item += F.G) {
        int lo = 0, hi = 1023;
        while (lo < hi) { const int mid = (lo + hi + 1) >> 1; if (P[mid] <= item) lo = mid; else hi = mid - 1; }
        const int bhj = lo, chunk = item - P[lo];
        const int b = bhj >> 7, h = (bhj >> 4) & 7, j = bhj & 15;
        const int cnt = (int)__hip_atomic_load(LCNT + bhj, __ATOMIC_RELAXED, __HIP_MEMORY_SCOPE_AGENT);
        load_kv(F, K, V, (size_t)b * SEQ + j * LBLK, h);
        const int r = F.lane & 31, qi = chunk * 256 + F.wave * 32 + r;
        const unsigned ent = LISTS[(size_t)bhj * 4096 + (qi < cnt ? qi : 0)];
        const int tq = ent & 4095, slot = (qi < cnt) ? (int)(ent >> 12) : -1;
        if (F.lane < 32) { wsi[64 + r] = tq; wsi[96 + r] = slot; }
        __syncthreads();
        f32x16 o[4]; float m, l;
        core<false>(F, Q + ((size_t)b * SEQ + tq) * DM + h * DH, o, m, l);
        finish_and_stage(F, o, m, l);
        LAS const float* stg = (LAS const float*)(F.lds + F.wave * 16384);
#pragma unroll
        for (int ps = 0; ps < 8; ++ps) {
            const int q = ps * 4 + (F.lane >> 4), dc = F.lane & 15;
            const f32x4 a = *(LAS const f32x4*)(stg + q * 128 + dc * 8), c = *(LAS const f32x4*)(stg + q * 128 + dc * 8 + 4);
            const int t = wsi[64 + q], sl = wsi[96 + q];
            if (sl >= 0) {
                const size_t row = (((size_t)sl * NB + b) * SEQ + t) * NH + h;
                u32x4 w; w.x = cvt_pk_bf16(a.x, a.y); w.y = cvt_pk_bf16(a.z, a.w); w.z = cvt_pk_bf16(c.x, c.y); w.w = cvt_pk_bf16(c.z, c.w);
                *(u32x4*)(OP + row * DH + dc * 8) = w;
                if (dc == 0) LSE[row] = wsf[32 + q];
            }
        }
        __syncthreads();
    }
}

__device__ __forceinline__ void ph_attn_own(const Ctx& F) {
    using namespace att;
    const unsigned char* Q = F.ws + WS_Q; const unsigned char* K = F.ws + WS_K; const unsigned char* V = F.ws + WS_V;
    const bf16_t* OP = (const bf16_t*)(F.ws + WS_OP); const float* LSE = (const float*)(F.ws + WS_LSE); bf16_t* YAB = (bf16_t*)(F.ws + WS_YAB);
    LAS float* wsf = (LAS float*)(F.lds + OFF_WS + F.wave * WSW);
    for (int it = F.vcu; it < NB * NH * NBLK; it += F.G) {
        const int b = it >> 7, h = (it >> 4) & 7, j = it & 15;
        load_kv(F, K, V, (size_t)b * SEQ + j * LBLK, h);
        __syncthreads();
        const int r = F.lane & 31, t0 = j * LBLK + F.wave * 32;
        f32x16 o[4]; float m, l;
        core<true>(F, Q + ((size_t)b * SEQ + t0 + r) * DM + h * DH, o, m, l);
        finish_and_stage(F, o, m, l);
        LAS const float* stg = (LAS const float*)(F.lds + F.wave * 16384);
        const int nv = j < 3 ? j : 3;
#pragma unroll 2
        for (int ps = 0; ps < 8; ++ps) {
            const int q = ps * 4 + (F.lane >> 4), dc = F.lane & 15, t = t0 + q;
            const f32x4 a = *(LAS const f32x4*)(stg + q * 128 + dc * 8), c = *(LAS const f32x4*)(stg + q * 128 + dc * 8 + 4);
            const float lse_own = wsf[32 + q];
            float ls[3] = {-1e30f, -1e30f, -1e30f}; u32x4 pv[3] = {};
#pragma unroll
            for (int s2 = 0; s2 < 3; ++s2) if (s2 < nv) { const size_t row = (((size_t)s2 * NB + b) * SEQ + t) * NH + h; ls[s2] = LSE[row]; pv[s2] = *(const u32x4*)(OP + row * DH + dc * 8); }
            const float M = fmaxf(fmaxf(lse_own, ls[0]), fmaxf(ls[1], ls[2]));
            const float w0 = __builtin_amdgcn_exp2f(lse_own - M);
            float den = w0; f32x4 x0 = a * w0, x1 = c * w0;
#pragma unroll
            for (int s2 = 0; s2 < 3; ++s2) {
                const float w = (s2 < nv) ? __builtin_amdgcn_exp2f(ls[s2] - M) : 0.f; den += w;
                x0.x += w * bflo(pv[s2].x); x0.y += w * bfhi(pv[s2].x); x0.z += w * bflo(pv[s2].y); x0.w += w * bfhi(pv[s2].y);
                x1.x += w * bflo(pv[s2].z); x1.y += w * bfhi(pv[s2].z); x1.z += w * bflo(pv[s2].w); x1.w += w * bfhi(pv[s2].w);
            }
            const float id = 1.0f / den; x0 = x0 * id; x1 = x1 * id;
            u32x4 w; w.x = cvt_pk_bf16(x0.x, x0.y); w.y = cvt_pk_bf16(x0.z, x0.w); w.z = cvt_pk_bf16(x1.x, x1.y); w.w = cvt_pk_bf16(x1.z, x1.w);
            *(u32x4*)(YAB + ((size_t)b * SEQ + t) * 2048 + 1024 + h * DH + dc * 8) = w;
        }
        __syncthreads();
    }
}

__device__ __forceinline__ void ln_stats16(const float* st, int lane, float& mean, float& rstd) {
    float s1 = 0.f, s2 = 0.f;
    if (lane < 16) { const f32x2 p = *(const f32x2*)(st + 2 * lane); s1 = p.x; s2 = p.y; }
    s1 = wave_sum(s1); s2 = wave_sum(s2);
    mean = s1 * (1.f / DM); const float var = s2 * (1.f / DM) - mean * mean; rstd = 1.f / sqrtf(fmaxf(var, 0.f) + LN_EPS);
}
__device__ __forceinline__ void ph_router(const Ctx& F) {
    const Args& A = *F.a;
    const float* Z = (const float*)(F.ws + WS_Z); const float* ZST = (const float*)(F.ws + WS_ZST); bf16_t* H1 = (bf16_t*)(F.ws + WS_H1); unsigned char* H1F8 = F.ws + WS_H1F8;
    int* TKE = (int*)(F.ws + WS_TKE); float* TKW = (float*)(F.ws + WS_TKW); int* TKP = (int*)(F.ws + WS_TKP); unsigned* ECNT = (unsigned*)(F.ws + WS_CTL) + CW_ECNT;
    const float* wr = A.in[I_WR]; const float* br = A.in[I_BR];
    constexpr int RS = 2064, OFF_LO = 32 * RS, OFF_G = 2 * 32 * RS  , OFF_B = OFF_G + 4096, OFF_LG = OFF_B + 4096  , OFF_CNT = OFF_LG + 8 * 2112  ;
    static_assert(OFF_CNT + 256 <= LDS_BYTES, "router LDS map");
    LAS unsigned char* WH = F.lds; LAS unsigned char* WL = F.lds + OFF_LO;
    LAS float* LG = (LAS float*)(F.lds + OFF_G); LAS float* LB = (LAS float*)(F.lds + OFF_B);
    LAS float* lgt = (LAS float*)(F.lds + OFF_LG + F.wave * 2112);
    LAS unsigned* lcnt = (LAS unsigned*)(F.lds + OFF_CNT);
    for (int i = F.tid; i < 512 * 32; i += 512) {
        const int n = i & 31, k2 = i >> 5;
        const float w0 = wr[(size_t)(2 * k2) * NE + n], w1 = wr[(size_t)(2 * k2 + 1) * NE + n];
        const unsigned h0 = f2bf(w0), h1 = f2bf(w1);
        const float r0 = w0 - __uint_as_float(h0 << 16), r1 = w1 - __uint_as_float(h1 << 16);
        *(LAS unsigned*)(WH + n * RS + k2 * 4) = h0 | (h1 << 16);
        *(LAS unsigned*)(WL + n * RS + k2 * 4) = pk2(r0, r1);
    }
    for (int i = F.tid; i < DM; i += 512) { LG[i] = A.in[I_LNMIX_G][i]; LB[i] = A.in[I_LNMIX_B][i]; }
    if (F.tid < 64) lcnt[F.tid] = 0u;
    __syncthreads();
    const int fr = F.lane & 15, kg = F.lane >> 4;
    const int ntask = T / 16, NGW = F.G * 8;
    const int rounds = (ntask + NGW - 1) / NGW;
    for (int rd = 0; rd < rounds; ++rd) {
        const int task = rd * NGW + F.vcu * 8 + F.wave;
        const bool live = task < ntask;
        int te[4] = {0, 0, 0, 0}; float tw[4] = {0.f, 0.f, 0.f, 0.f}; unsigned lp[4] = {0, 0, 0, 0};
        if (live) {
            const int tok = task * 16 + fr;
            float mean, rstd;
            { const f32x4* sp = (const f32x4*)(ZST + (size_t)tok * 32); float s1 = 0.f, s2 = 0.f;
#pragma unroll
              for (int i = 0; i < 8; ++i) { const f32x4 v = sp[i]; s1 += v.x + v.z; s2 += v.y + v.w; }
              mean = s1 * (1.f / DM); const float var = s2 * (1.f / DM) - mean * mean; rstd = 1.f / sqrtf(fmaxf(var, 0.f) + LN_EPS); }
            f32x4 acc0 = {0.f, 0.f, 0.f, 0.f}, acc1 = {0.f, 0.f, 0.f, 0.f};
            const float* zp = Z + (size_t)tok * DM + 8 * kg; bf16_t* hp = H1 + (size_t)tok * DM + 8 * kg; unsigned char* h8 = H1F8 + (size_t)tok * DM + 8 * kg;
#pragma unroll 4
            for (int kk = 0; kk < 32; ++kk) {
                const f32x4 z0 = *(const f32x4*)(zp + 32 * kk), z1 = *(const f32x4*)(zp + 32 * kk + 4);
                const f32x4 g0 = *(LAS const f32x4*)(LG + 32 * kk + 8 * kg), g1 = *(LAS const f32x4*)(LG + 32 * kk + 8 * kg + 4);
                const f32x4 b0 = *(LAS const f32x4*)(LB + 32 * kk + 8 * kg), b1 = *(LAS const f32x4*)(LB + 32 * kk + 8 * kg + 4);
                const f32x4 x0 = (z0 - mean) * rstd * g0 + b0, x1 = (z1 - mean) * rstd * g1 + b1;
                u32x4 hi; hi.x = cvt_pk_bf16(x0.x, x0.y); hi.y = cvt_pk_bf16(x0.z, x0.w); hi.z = cvt_pk_bf16(x1.x, x1.y); hi.w = cvt_pk_bf16(x1.z, x1.w);
                *(u32x4*)(hp + 32 * kk) = hi;
                { unsigned w0 = 0u, w1 = 0u;
                  w0 = __builtin_amdgcn_cvt_pk_fp8_f32(x0.x, x0.y, w0, false); w0 = __builtin_amdgcn_cvt_pk_fp8_f32(x0.z, x0.w, w0, true);
                  w1 = __builtin_amdgcn_cvt_pk_fp8_f32(x1.x, x1.y, w1, false); w1 = __builtin_amdgcn_cvt_pk_fp8_f32(x1.z, x1.w, w1, true);
                  *(u32x2*)(h8 + 32 * kk) = (u32x2){w0, w1}; }
                u32x4 lo; lo.x = cvt_pk_bf16(x0.x - bflo(hi.x), x0.y - bfhi(hi.x)); lo.y = cvt_pk_bf16(x0.z - bflo(hi.y), x0.w - bfhi(hi.y));
                lo.z = cvt_pk_bf16(x1.x - bflo(hi.z), x1.y - bfhi(hi.z)); lo.w = cvt_pk_bf16(x1.z - bflo(hi.w), x1.w - bfhi(hi.w));
                const bf16x8 ah = __builtin_bit_cast(bf16x8, hi), al = __builtin_bit_cast(bf16x8, lo);
                const int bo = fr * RS + (32 * kk + 8 * kg) * 2;
                const bf16x8 wh0 = *(LAS const bf16x8*)(WH + bo), wh1 = *(LAS const bf16x8*)(WH + bo + 16 * RS), wl0 = *(LAS const bf16x8*)(WL + bo), wl1 = *(LAS const bf16x8*)(WL + bo + 16 * RS);
                acc0 = __builtin_amdgcn_mfma_f32_16x16x32_bf16(ah, wh0, acc0, 0, 0, 0); acc1 = __builtin_amdgcn_mfma_f32_16x16x32_bf16(ah, wh1, acc1, 0, 0, 0);
                acc0 = __builtin_amdgcn_mfma_f32_16x16x32_bf16(ah, wl0, acc0, 0, 0, 0); acc1 = __builtin_amdgcn_mfma_f32_16x16x32_bf16(ah, wl1, acc1, 0, 0, 0);
                acc0 = __builtin_amdgcn_mfma_f32_16x16x32_bf16(al, wh0, acc0, 0, 0, 0); acc1 = __builtin_amdgcn_mfma_f32_16x16x32_bf16(al, wh1, acc1, 0, 0, 0);
            }
            const float br0 = br[fr], br1 = br[16 + fr];
#pragma unroll
            for (int i = 0; i < 4; ++i) { lgt[(4 * kg + i) * 33 + fr] = acc0[i] + br0; lgt[(4 * kg + i) * 33 + 16 + fr] = acc1[i] + br1; }
            asm volatile("s_waitcnt lgkmcnt(0)" ::: "memory");
            if (F.lane < 16) {
                float lg[NE];
#pragma unroll
                for (int e = 0; e < NE; ++e) lg[e] = lgt[F.lane * 33 + e];
                float tv[4];
#pragma unroll
                for (int r = 0; r < 4; ++r) {
                    float best = -INFINITY; int bi = 0;
#pragma unroll
                    for (int e = 0; e < NE; ++e) { const bool c = lg[e] > best; best = c ? lg[e] : best; bi = c ? e : bi; }
#pragma unroll
                    for (int e = 0; e < NE; ++e) lg[e] = (e == bi) ? -INFINITY : lg[e];
                    te[r] = bi; tv[r] = best;
                }
                const float e1 = __expf(tv[1] - tv[0]), e2 = __expf(tv[2] - tv[0]), e3 = __expf(tv[3] - tv[0]); const float inv = 1.f / (1.f + e1 + e2 + e3);
                tw[0] = inv; tw[1] = e1 * inv; tw[2] = e2 * inv; tw[3] = e3 * inv;
#pragma unroll
                for (int r = 0; r < 4; ++r) lp[r] = atomicAdd((unsigned*)(lcnt + te[r]), 1u);
            }
        }
        __syncthreads();
        if (F.tid < 32) { const unsigned c = lcnt[F.tid]; lcnt[32 + F.tid] = c ? atomicAdd(&ECNT[F.tid], c) : 0u; }
        __syncthreads();
        if (live && F.lane < 16) {
            const size_t tok = (size_t)task * 16 + F.lane;
            int4 pe = {te[0], te[1], te[2], te[3]}; float4 pw = {tw[0], tw[1], tw[2], tw[3]};
            int4 pp = {(int)(lcnt[32 + te[0]] + lp[0]), (int)(lcnt[32 + te[1]] + lp[1]), (int)(lcnt[32 + te[2]] + lp[2]), (int)(lcnt[32 + te[3]] + lp[3])};
            *(int4*)(TKE + tok * 4) = pe; *(float4*)(TKW + tok * 4) = pw; *(int4*)(TKP + tok * 4) = pp;
        }
        __syncthreads();
        if (F.tid < 32) lcnt[F.tid] = 0u;
        __syncthreads();
    }
}

__device__ __forceinline__ void ph_scatter(const Ctx& F) {
    const unsigned* ECNT = (const unsigned*)(F.ws + WS_CTL) + CW_ECNT;
    const int* TKE = (const int*)(F.ws + WS_TKE); const float* TKW = (const float*)(F.ws + WS_TKW); const int* TKP = (const int*)(F.ws + WS_TKP);
    int* ROWOF = (int*)(F.ws + WS_ROWOF); int* ROWTOK = (int*)(F.ws + WS_ROWTOK); float* ROWW = (float*)(F.ws + WS_ROWW); int* TILE = (int*)(F.ws + WS_TILE);
    int* pst = (int*)F.ldsg;
    if (F.tid == 0) {
        int acc = 0;
        for (int e = 0; e < NE; ++e) { const int c = (int)__hip_atomic_load(ECNT + e, __ATOMIC_RELAXED, __HIP_MEMORY_SCOPE_AGENT); pst[e] = acc; pst[32 + e] = c; acc += (c + 255) / 256 * 256; }
        pst[64] = acc;
    }
    __syncthreads();
    if (blockIdx.x == 0) {
        const int ntiles = pst[64] / 256;
        if (F.tid == 0) TILE[0] = ntiles;
        for (int i = F.tid; i < ntiles; i += 512) { int e = 0; for (int k = 1; k < NE; ++k) if (i * 256 >= pst[k]) e = k; TILE[16 + i] = e; }
        for (int e = 0; e < NE; ++e) { const int s = pst[e] + pst[32 + e], en = (e + 1 < NE) ? pst[e + 1] : pst[64]; for (int r = s + F.tid; r < en; r += 512) { ROWTOK[r] = 0; ROWW[r] = 0.f; } }
    }
    for (int idx = F.vcu * 512 + F.tid; idx < T * TOPK; idx += F.G * 512) {
        const int t = idx >> 2, e = TKE[idx], row = pst[e] + TKP[idx];
        ROWTOK[row] = t; ROWW[row] = TKW[idx]; ROWOF[idx] = row;
    }
}

__device__ __forceinline__ void ph_final(const Ctx& F) {
    const Args& A = *F.a;
    const bf16_t* H1 = (const bf16_t*)(F.ws + WS_H1); const bf16_t* YS = (const bf16_t*)(F.ws + WS_YS); const int* ROWOF = (const int*)(F.ws + WS_ROWOF);
    const int gw = F.vcu * 8 + F.wave, NGW = F.G * 8;
    f32x4 g2[4], b2[4];
#pragma unroll
    for (int j = 0; j < 4; ++j) { g2[j] = *((const f32x4*)A.in[I_LNF_G] + F.lane + 64 * j); b2[j] = *((const f32x4*)A.in[I_LNF_B] + F.lane + 64 * j); }
    for (int m = gw; m < T; m += NGW) {
        const u32x2* hr = (const u32x2*)(H1 + (size_t)m * DM) + F.lane;
        f32x4 v[4];
#pragma unroll
        for (int j = 0; j < 4; ++j) { const u32x2 hb = hr[64 * j]; v[j] = (f32x4){bflo(hb.x), bfhi(hb.x), bflo(hb.y), bfhi(hb.y)} * ALPHA; }
#pragma unroll
        for (int k = 0; k < 4; ++k) {
            const int row = ROWOF[(size_t)m * 4 + k]; const u32x2* yr = (const u32x2*)(YS + (size_t)row * DM) + F.lane;
#pragma unroll
            for (int j = 0; j < 4; ++j) { const u32x2 y = yr[64 * j]; v[j].x += bflo(y.x); v[j].y += bfhi(y.x); v[j].z += bflo(y.y); v[j].w += bfhi(y.y); }
        }
        float s = 0.f;
#pragma unroll
        for (int j = 0; j < 4; ++j) s += (v[j].x + v[j].y) + (v[j].z + v[j].w);
        const float mu = wave_sum(s) * (1.f / DM); float s2 = 0.f;
#pragma unroll
        for (int j = 0; j < 4; ++j) { v[j] = v[j] - mu; s2 += (v[j].x * v[j].x + v[j].y * v[j].y) + (v[j].z * v[j].z + v[j].w * v[j].w); }
        const float rs = 1.f / sqrtf(wave_sum(s2) * (1.f / DM) + LN_EPS);
        f32x4* orow = (f32x4*)(A.out + (size_t)m * DM) + F.lane;
#pragma unroll
        for (int j = 0; j < 4; ++j) orow[64 * j] = v[j] * rs * g2[j] + b2[j];
    }
}

#define XB_TMO      128
#define XB_XCNT(j)  (256  + 64 * (j))
#define XB_XSUB(j)  (1280 + 64 * (j))
#define XB_XGEN(j)  (2304 + 64 * (j))
#define XB_TOP      3328
#define XB_TOPGEN   3392
#define XCD_BAR_WORDS 3456
#define XB_SPIN_CAP (1u << 18)
__device__ __forceinline__ unsigned xb_ld(unsigned* p)              { return __hip_atomic_load(p, __ATOMIC_RELAXED, __HIP_MEMORY_SCOPE_AGENT); }
__device__ __forceinline__ unsigned xb_add(unsigned* p, unsigned v) { return __hip_atomic_fetch_add(p, v, __ATOMIC_RELAXED, __HIP_MEMORY_SCOPE_AGENT); }
__device__ __forceinline__ unsigned xb_xcc_id() { return (unsigned)__builtin_amdgcn_s_getreg((3 << 11) | 20) & 0xFu; }
#define XB_SPIN(cond, bar) do { unsigned _sp = 0; while (cond) { __builtin_amdgcn_s_sleep(1); \
    if ((++_sp & 255u) == 0u) { if (xb_ld(&(bar)[XB_TMO])) break; if (_sp > XB_SPIN_CAP) { atomicAdd(&(bar)[XB_TMO], 1u); break; } } } } while (0)
__device__ __forceinline__ void xcd_barrier_complete(unsigned* bar, unsigned x, unsigned& nloc, unsigned& nx) {
    const unsigned G = gridDim.x * gridDim.y * gridDim.z;
    unsigned sum, cnt, mine, sp = 0u;
    for (;;) {
        sum = 0u; cnt = 0u; mine = 0u;
#pragma unroll
        for (unsigned j = 0; j < 16; ++j) { const unsigned c = xb_ld(&bar[XB_XCNT(j)]); sum += c; cnt += (c > 0u) ? 1u : 0u; mine = (j == x) ? c : mine; }
        if (sum == G) break;
        __builtin_amdgcn_s_sleep(1);
        if ((++sp & 255u) == 0u) { if (xb_ld(&bar[XB_TMO])) break; if (sp > XB_SPIN_CAP) { atomicAdd(&bar[XB_TMO], 1u); break; } }
    }
    nloc = mine > 0u ? mine : 1u; nx = cnt > 0u ? cnt : 1u;
}
__device__ __forceinline__ void xcd_barrier(unsigned* bar, volatile LAS unsigned* st, unsigned x, bool leader_thread) {
    asm volatile("s_waitcnt vmcnt(0)" ::: "memory");
    __syncthreads();
    if (leader_thread) {
        __builtin_amdgcn_s_waitcnt(0);
        unsigned nloc = st[0], nx = st[1];
        if (nloc == 0u) { xcd_barrier_complete(bar, x, nloc, nx); st[0] = nloc; st[1] = nx; }
        const unsigned old = xb_add(&bar[XB_XSUB(x)], 1u);
        const unsigned gen = old / nloc;
        if (old + 1u == (gen + 1u) * nloc) {
            __builtin_amdgcn_fence(__ATOMIC_RELEASE, "agent");
            asm volatile("s_waitcnt vmcnt(0)" ::: "memory");
            const unsigned og = xb_add(&bar[XB_TOP], 1u);
            const unsigned tg = og / nx;
            if (og + 1u == (tg + 1u) * nx) xb_add(&bar[XB_TOPGEN], 1u);
            else XB_SPIN(xb_ld(&bar[XB_TOPGEN]) == tg, bar);
            __builtin_amdgcn_fence(__ATOMIC_ACQUIRE, "agent");
            xb_add(&bar[XB_XGEN(x)], 1u);
            asm volatile("s_waitcnt vmcnt(0)" ::: "memory");
        } else {
            XB_SPIN(xb_ld(&bar[XB_XGEN(x)]) == gen, bar);
            __builtin_amdgcn_fence(__ATOMIC_ACQUIRE, "agent");
            asm volatile("s_waitcnt vmcnt(0)" ::: "memory");
        }
    }
    __syncthreads();
}

template <bool COOP>
__global__ void __launch_bounds__(512, 2) mega(Args args) {
    extern __shared__ __attribute__((aligned(16))) unsigned char lds_raw[];
    Ctx F;
    const int wave0 = __builtin_amdgcn_readfirstlane(threadIdx.x >> 6);
#define MKCTX() do { F.a = &args; F.ws = args.ws; F.lds = (LAS unsigned char*)lds_raw; F.ldsg = lds_raw; F.lane = lane_id_asm(); F.wave = wave0; F.tid = wave0 * 64 + F.lane; \
    F.G = gridDim.x; { const int bx = blockIdx.x; F.vcu = (F.G % 8 == 0) ? (bx % 8) * (F.G / 8) + bx / 8 : bx; } } while (0)
    MKCTX();
    const int lo = args.ph_lo, hi = args.ph_hi;
    unsigned char* ws = args.ws;
#ifndef PHMASK
#define PHMASK 0xFFFF
#endif
#define IN(k) (((PHMASK >> (k)) & 1) && lo <= (k) && (k) < hi)
    unsigned* barw = (unsigned*)(ws + WS_CTL) + CW_BAR; volatile LAS unsigned* bst = (volatile LAS unsigned*)((LAS unsigned char*)lds_raw + LDS_BYTES - 64);
    const unsigned my_xcc = xb_xcc_id();
    if (COOP) { if (threadIdx.x == 0) { bst[0] = 0u; bst[1] = 0u; (void)xb_add(&barw[XB_XCNT(my_xcc)], 1u); } __syncthreads(); }
#define SEAM(k) do { if (COOP && IN(k) && IN((k) + 1)) { if ((k) == 0) cg::this_grid().sync(); else xcd_barrier(barw, bst, my_xcc, wave0 == 0 && lane_id_asm() == 0); } } while (0)
    if (IN(0)) { MKCTX(); ph_prologue(F); } SEAM(0);
    if (IN(1)) {
        pg8::Epi1 E{(bf16_t*)(ws + WS_YAB), (bf16_t*)(ws + WS_GV), ws + WS_Q, ws + WS_K, ws + WS_V, (bf16_t*)(ws + WS_SA), (bf16_t*)(ws + WS_SB), (float*)(ws + WS_GVST), 1.0f};
        {
            pg8::Gemm g{(const bf16_t*)(ws + WS_H0), (const bf16_t*)(ws + WS_WIN), DM, DM, DM, nullptr}; pg8::StaticOrder S; S.init(T, (PN8_LO + 28 - PN8_HI) * 256, F.G, (int)blockIdx.x, 0, PN8_LO, PN8_HI - PN8_LO);
            pg8::gemm_phase<pg8::Epi1, pg8::StaticOrder, true>(F.lds, g, S, E, wave0);
        }
        {
            E.sc = 0.03125f;
            pg8::Gemm g{(const bf16_t*)(ws + WS_H0F8), (const bf16_t*)(ws + WS_WIN8), DM / 2, DM / 2, DM / 2, nullptr}; pg8::StaticOrder S; S.init(T, (PN8_HI - PN8_LO) * 256, F.G, (int)blockIdx.x, PN8_LO);
            pg8::gemm_phase<pg8::Epi1, pg8::StaticOrder, true, true>(F.lds, g, S, E, wave0);
        }
    } SEAM(1);
    if (IN(2)) { MKCTX(); ph_kmean(F); ph_mixer_a(F); } SEAM(2);
    if (IN(3)) { MKCTX(); ph_gate(F); } SEAM(3);
    if (IN(4)) { MKCTX(); ph_attn_partial(F); } SEAM(4);
    if (IN(5)) { MKCTX(); ph_attn_own(F); } SEAM(5);
    if (IN(6)) {
        pg8::Gemm g{(const bf16_t*)(ws + WS_YAB), (const bf16_t*)(ws + WS_WAB), 2048, 2048, 2048, nullptr}; pg8::StaticOrder S; S.init(T, DM, F.G, (int)blockIdx.x);
        pg8::Epi2 E{(const bf16_t*)(ws + WS_SA), (const bf16_t*)(ws + WS_SB), (bf16_t*)(ws + WS_MG)};
        pg8::gemm_phase<pg8::Epi2, pg8::StaticOrder, true>(F.lds, g, S, E, wave0);
    } SEAM(6);
    if (IN(7)) {
        pg8::Gemm g{(const bf16_t*)(ws + WS_MG), (const bf16_t*)(ws + WS_WOUT), DM, DM, DM, nullptr}; pg8::StaticOrder S; S.init(T, DM, F.G, (int)blockIdx.x);
        pg8::Epi3 E{(const bf16_t*)(ws + WS_H0), (float*)(ws + WS_Z), (float*)(ws + WS_ZST)};
        pg8::gemm_phase<pg8::Epi3, pg8::StaticOrder, true>(F.lds, g, S, E, wave0);
    } SEAM(7);
    if (IN(8)) { MKCTX(); ph_router(F); } SEAM(8);
    if (IN(9)) { MKCTX(); ph_scatter(F); } SEAM(9);
    if (IN(10)) {
        pg8::Gemm g{(const bf16_t*)(ws + WS_H1F8), (const bf16_t*)(ws + WS_WUP), DM / 2, DM / 2, DM / 2, (const int*)(ws + WS_ROWTOK)}; pg8::MoeOrder S;   S.init((const int*)(ws + WS_TILE), 8, F.G, (int)blockIdx.x);
        pg8::Epi4 E{args.in[I_BUP], ws + WS_ACT};
        pg8::gemm_phase<pg8::Epi4, pg8::MoeOrder, true, true, true>(F.lds, g, S, E, wave0);
    } SEAM(10);
    if (IN(11)) {
        pg8::Gemm g{(const bf16_t*)(ws + WS_ACT), (const bf16_t*)(ws + WS_WDN), FF / 2, FF / 2, FF / 2, nullptr}; pg8::MoeOrder S; S.init((const int*)(ws + WS_TILE), 4, F.G, (int)blockIdx.x);
        pg8::Epi5 E{args.in[I_BDN], (const float*)(ws + WS_ROWW), (bf16_t*)(ws + WS_YS)};
        pg8::gemm_phase<pg8::Epi5, pg8::MoeOrder, true, true>(F.lds, g, S, E, wave0);
    } SEAM(11);
    if (IN(12)) { MKCTX(); ph_final(F); }
#undef IN
#undef SEAM
}

extern "C" void kernel_launch(void* const* d_in, const int* in_sizes, int n_in, void* d_out, int out_size, void* d_ws, size_t ws_size, hipStream_t stream) {
    static int grid = 0;
    if (grid == 0) {
        if (n_in != 21 || in_sizes[0] != T * DM || out_size != T * DM || ws_size < WS_END) { fprintf(stderr, "kernel_launch: unexpected shapes (n_in %d, in0 %d, out %d, ws %zu)\n", n_in, n_in > 0 ? in_sizes[0] : -1, out_size, ws_size); grid = -1; return; }
        int dev = 0, cus = 0, per_cu = 0;
        hipGetDevice(&dev); hipDeviceGetAttribute(&cus, hipDeviceAttributeMultiprocessorCount, dev);
        const void* fn = MK_COOP ? (const void*)mega<true> : (const void*)mega<false>;
        hipFuncSetAttribute(fn, hipFuncAttributeMaxDynamicSharedMemorySize, LDS_BYTES);
        hipOccupancyMaxActiveBlocksPerMultiprocessor(&per_cu, fn, 512, LDS_BYTES);
        (void)hipGetLastError();
        if (per_cu < 1) { fprintf(stderr, "kernel_launch: occupancy query says %d blocks/CU\n", per_cu); per_cu = 1; }
        grid = cus * 1;
    }
    if (grid < 0) return;
    hipMemsetAsync((char*)d_ws + WS_CTL, 0, CTL_ZERO_BYTES, stream);
    Args a{};
    for (int i = 0; i < 21; ++i) a.in[i] = (const float*)d_in[i];
    a.out = (float*)d_out; a.ws = (unsigned char*)d_ws;
#if MK_COOP
    a.ph_lo = 0; a.ph_hi = NPHASE;
    void* kargs[] = {&a};
    hipError_t e = hipLaunchCooperativeKernel((const void*)mega<true>, dim3(grid), dim3(512), kargs, LDS_BYTES, stream);
    if (e != hipSuccess) fprintf(stderr, "cooperative launch failed: %s (grid %d)\n", hipGetErrorString(e), grid);
#else
    for (int p = 0; p < NPHASE; ++p) { a.ph_lo = p; a.ph_hi = p + 1; hipLaunchKernelGGL(mega<false>, dim3(grid), dim3(512), LDS_BYTES, stream, a); }
#endif
}
```

```cpp
#include <hip/hip_runtime.h>
#include <hip/hip_cooperative_groups.h>
#include <cstdio>
#include <cstdint>
namespace cg = cooperative_groups;

#ifndef MK_COOP
#define MK_COOP 1
#endif

#define LAS __attribute__((address_space(3)))
typedef unsigned short bf16_t;
typedef short bf16x8 __attribute__((ext_vector_type(8)));
typedef float f32x4 __attribute__((ext_vector_type(4)));
typedef float f32x2 __attribute__((ext_vector_type(2)));
typedef unsigned u32x4 __attribute__((ext_vector_type(4)));
typedef unsigned u32x2 __attribute__((ext_vector_type(2)));

constexpr int NB = 8, SEQ = 4096, DM = 1024, T = NB * SEQ;
constexpr int NH = 8, DH = 128, LBLK = 256, NBLK = SEQ / LBLK;
constexpr int NE = 32, TOPK = 4, FF = 1024;
constexpr int INCOLS = 7 * DM;
constexpr int RMAX = T * TOPK + NE * 256;
constexpr float LN_EPS = 1e-5f;
constexpr float ALPHA = 1.189207115002721f;
constexpr float QSCALE = 0.08838834764831845f * 1.4426950408889634f;

constexpr size_t MiB = 1u << 20, U64 = 64 * MiB;
constexpr size_t WS_CTL = 0, CTL_ZERO_BYTES = 1 * MiB;
constexpr int CW_ECNT = 64;
constexpr int CW_LCNT = 1024;
constexpr int CW_BAR = 4096;
constexpr size_t WS_KMEAN = 1 * MiB;
constexpr size_t WS_GVST = 2 * MiB;
constexpr size_t WS_ZST = 6 * MiB;
constexpr size_t WS_SEL = 10 * MiB;
constexpr size_t WS_TKE = 11 * MiB;
constexpr size_t WS_TKW = 11 * MiB + 512 * 1024;
constexpr size_t WS_TKP = 12 * MiB;
constexpr size_t WS_ROWOF = 12 * MiB + 512 * 1024;
constexpr size_t WS_ROWTOK = 13 * MiB;
constexpr size_t WS_ROWW = 14 * MiB;
constexpr size_t WS_TILE = 15 * MiB;
constexpr size_t WS_LISTS = 16 * MiB;
constexpr size_t WS_LSE = 32 * MiB;
constexpr size_t WS_RT = 16 * MiB;
constexpr size_t WS_RW = 20 * MiB;
constexpr int LDS_MOE = 131072 + 1024;
constexpr size_t WS_WIN = 40 * MiB;
constexpr size_t WS_WAB = 54 * MiB;
constexpr size_t WS_WOUT = 58 * MiB;
constexpr size_t WS_WDN = 60 * MiB;
constexpr size_t WS_WUP = 124 * MiB;
constexpr size_t WS_H0 = 4 * U64;
constexpr size_t WS_YAB = 5 * U64;
constexpr size_t WS_GV = 7 * U64;
constexpr size_t WS_Q = 8 * U64, WS_K = 9 * U64, WS_V = 10 * U64, WS_SA = 11 * U64, WS_SB = 12 * U64;
constexpr size_t WS_OP = 13 * U64;
constexpr size_t WS_MG = WS_GV;
constexpr size_t WS_Z = 14 * U64;
constexpr size_t WS_H1 = WS_H0;
constexpr size_t WS_XG = 5 * U64;
constexpr size_t WS_H1F8 = 12 * U64;
constexpr size_t WS_ACT = 9 * U64 + 16 * MiB;
constexpr size_t WS_YS = WS_XG;
constexpr size_t WS_H0F8 = 13 * U64;
constexpr size_t WS_WIN8 = 192 * MiB;
constexpr int PN8_LO = 8, PN8_HI = 28;
constexpr size_t WS_END = 16 * U64;
static_assert(WS_XG + (size_t)RMAX * 2048 <= WS_ACT && WS_ACT + (size_t)RMAX * 2048 <= WS_Z, "ws map");

constexpr int LDS_BYTES = 163840;
constexpr int LDS_MISC = 131072;
constexpr int NPHASE = 13;

__device__ __forceinline__ float bf2f(bf16_t v) { return __uint_as_float((unsigned)v << 16); }
__device__ __forceinline__ float bflo(unsigned u) { return __uint_as_float(u << 16); }
__device__ __forceinline__ float bfhi(unsigned u) { return __uint_as_float(u & 0xffff0000u); }
__device__ __forceinline__ unsigned f2bf(float f) { unsigned u = __builtin_bit_cast(unsigned, f); return (u + 0x7fffu + ((u >> 16) & 1u)) >> 16; }
__device__ __forceinline__ unsigned pk2(float lo, float hi) { return f2bf(lo) | (f2bf(hi) << 16); }
typedef __bf16 bf16x2_t __attribute__((ext_vector_type(2)));
__device__ __forceinline__ unsigned cvt_pk_bf16(float lo, float hi) { f32x2 v = {lo, hi}; bf16x2_t b = __builtin_convertvector(v, bf16x2_t); return __builtin_bit_cast(unsigned, b); }
__device__ __forceinline__ int lane_id_asm() { int l; asm volatile("v_mbcnt_lo_u32_b32 %0, -1, 0\n\tv_mbcnt_hi_u32_b32 %0, -1, %0" : "=v"(l)); return l; }
__device__ __forceinline__ float wave_sum(float v) {
#pragma unroll
    for (int o = 1; o < 64; o <<= 1) v += __shfl_xor(v, o);
    return v;
}
__device__ __forceinline__ float wave_max(float v) {
#pragma unroll
    for (int o = 1; o < 64; o <<= 1) v = fmaxf(v, __shfl_xor(v, o));
    return v;
}
__device__ __forceinline__ f32x2 gelu_pk(f32x2 v) {
    const f32x2 av = __builtin_elementwise_abs(v), d = av * 0.2316418882f + 1.0f;
    f32x2 t; t.x = __builtin_amdgcn_rcpf(d.x); t.y = __builtin_amdgcn_rcpf(d.y);
    f32x2 q = t * 0.5307027145f + (-0.7265760135f); q = q * t + 0.7107068705f; q = q * t + (-0.142248368f); q = q * t + 0.127414796f; q = q * t;
    const f32x2 s = (v * v) * (-0.72134752044f);
    f32x2 e; e.x = __builtin_amdgcn_exp2f(s.x); e.y = __builtin_amdgcn_exp2f(s.y);
    const f32x2 m = v * (q * e), r = v - m;
    f32x2 o; o.x = v.x < 0.f ? m.x : r.x; o.y = v.y < 0.f ? m.y : r.y; return o;
}
typedef float f32x2v __attribute__((ext_vector_type(2)));
template <bool HI> __device__ __forceinline__ unsigned f8x2_to_bf16x2(unsigned w) { const f32x2v f = __builtin_amdgcn_cvt_pk_f32_fp8((int)w, HI); return cvt_pk_bf16(f.x, f.y); }
__device__ __forceinline__ u32x4 f8x8_to_bf16x8(unsigned lo, unsigned hi) { return (u32x4){f8x2_to_bf16x2<false>(lo), f8x2_to_bf16x2<true>(lo), f8x2_to_bf16x2<false>(hi), f8x2_to_bf16x2<true>(hi)}; }
__device__ __forceinline__ unsigned pack_fp8x4(float a, float b, float c, float d) { unsigned w = 0u; w = __builtin_amdgcn_cvt_pk_fp8_f32(a, b, w, false); w = __builtin_amdgcn_cvt_pk_fp8_f32(c, d, w, true); return w; }
__device__ __forceinline__ float sigmoidf_(float x) { return __builtin_amdgcn_rcpf(1.0f + __builtin_amdgcn_exp2f(-1.4426950408889634f * x)); }

namespace pg8 {
constexpr int BM = 256, BK = 64, HALF = 128, HTB = HALF * BK * 2, STAGE_BYTES = 8 * HTB, NXCD = 8, WGM = 8;
__host__ __device__ __forceinline__ int lds_byte(int r, int c) { const int st = (r >> 4) * 2 + (c >> 5), rr = r & 15, cc = c & 31, ob = rr * 64 + cc * 2; return st * 1024 + (ob ^ (((ob >> 9) & 1) << 5)); }
__host__ __device__ __forceinline__ void stage_rc(int b, int& R, int& C) { const int st = b / 1024, sb = b % 1024, swz = sb ^ (((sb >> 9) & 1) << 5); R = (st >> 1) * 16 + swz / 64; C = (st & 1) * 32 + (swz % 64) / 2; }
__host__ __device__ __forceinline__ int perm32(int rho) { const int n = rho >> 4, i = rho & 15; return 8 * (i >> 2) + 4 * n + (i & 3); }

struct Unit { int pm, pn, bt, rbase; };
struct Gemm { const bf16_t* A; const bf16_t* Bt; int K, lda, ldb; const int* rowidx; };

struct StaticOrder {
    int nM, nN, nwg, G, c, pbase, psplit, pjump;
    __device__ void init(int M, int N, int G_, int c_, int pbase_ = 0, int psplit_ = 1 << 20, int pjump_ = 0) { nM = M / BM; nN = N / BM; nwg = nM * nN; G = G_; c = c_; pbase = pbase_; psplit = psplit_; pjump = pjump_; }
    __device__ bool next(int i, Unit& u) const {
        const long L = (long)i * G + c; if (L >= nwg) return false;
        int wgid = (int)L; { const int q = nwg / NXCD, r = nwg % NXCD, xcd = wgid % NXCD, off = wgid / NXCD; wgid = (xcd < r ? xcd * (q + 1) : r * (q + 1) + (xcd - r) * q) + off; }
        const int nig = WGM * nN, gid = wgid / nig, fm = gid * WGM, gsz = (nM - fm) < WGM ? (nM - fm) : WGM;
        u.pm = fm + ((wgid % nig) % gsz); const int p = (wgid % nig) / gsz; u.pn = pbase + (p < psplit ? p : p + pjump); u.bt = u.pn; u.rbase = u.pm * BM; return true;
    }
};
struct MoeOrder {
    int nM, nN, nwg, G, c; const LAS int* tab;
    __device__ void init(const LAS int* tiletab, int nN_, int G_, int c_) { nM = tiletab[0]; tab = tiletab; nN = nN_; nwg = nM * nN; G = G_; c = c_; }
    __device__ bool next(int i, Unit& u) const {
        const long L = (long)i * G + c; if (L >= nwg) return false;
        int wgid = (int)L; { const int q = nwg / NXCD, r = nwg % NXCD, xcd = wgid % NXCD, off = wgid / NXCD; wgid = (xcd < r ? xcd * (q + 1) : r * (q + 1) + (xcd - r) * q) + off; }
        const int nig = WGM * nN, gid = wgid / nig, fm = gid * WGM, gsz = (nM - fm) < WGM ? (nM - fm) : WGM;
        u.pm = fm + ((wgid % nig) % gsz); u.pn = (wgid % nig) / gsz; { const int e = tab[128 + 2 * u.pm], tl = tab[129 + 2 * u.pm]; u.bt = e * nN + u.pn; u.rbase = e * T + tl * BM; } return true;
    }
};

typedef int v4i_t __attribute__((ext_vector_type(4)));
typedef int v8i_t __attribute__((ext_vector_type(8)));
template <class Epi, class Sched, bool ALIGN_EPI, bool FP8 = false, bool GATHER = false>
__device__ __forceinline__ void gemm_phase(LAS unsigned char* lds, const Gemm g, const Sched& S, const Epi& E, const int wid) {
    const int lane = lane_id_asm(), tid = wid * 64 + lane;
    const int wr = wid >> 2, wc = wid & 3, fr = lane & 15, fq = lane >> 4;
    const int nt = g.K / BK;
    unsigned voffA[2], voffB[2]; int gR[2];
#pragma unroll
    for (int i = 0; i < 2; ++i) { int R, C; stage_rc(tid * 16 + i * 8192, R, C); const int Rb = Epi::PERM ? ((R & ~31) + perm32(R & 31)) : R;
        voffA[i] = GATHER ? (unsigned)C * 2u : (unsigned)(R * g.lda + C) * 2u; voffB[i] = (unsigned)(Rb * g.ldb + C) * 2u; gR[i] = R; }
    const size_t kstep = (size_t)(BK * 2);
    const size_t hstepA = GATHER ? 0 : (size_t)HALF * g.lda * 2, hstepB = (size_t)HALF * g.ldb * 2;
    const size_t tstepA = 2 * hstepA, tstepB = 2 * hstepB;
    const unsigned ldsw = (unsigned)wid * 1024u;
    const int aoff = lds_byte(wr * 64 + fr, fq * 8), boff = lds_byte(wc * 32 + fr, fq * 8);
#define PG8_SA(b, h) (((b) * 2 + (h)) * HTB)
#define PG8_SB(b, h) ((4 + (b) * 2 + (h)) * HTB)
#define PG8_STAGE(bufoff, gbase, voff) do { _Pragma("unroll") for (int _i = 0; _i < 2; ++_i) \
        __builtin_amdgcn_global_load_lds((const unsigned*)((const char*)(gbase) + (voff)[_i]), (LAS unsigned*)(lds + (bufoff) + ldsw + _i * 8192), 16, 0, 0); } while (0)
#define PG8_LD8(p) __builtin_shufflevector(*(const LAS v4i_t*)(p), *(const LAS v4i_t*)((p) + 1024), 0, 1, 2, 3, 4, 5, 6, 7)
#define PG8_LDA(dst, b, h) do { _Pragma("unroll") for (int m = 0; m < 4; ++m) { if constexpr (FP8) dst##8[m] = PG8_LD8(lds + PG8_SA(b, h) + aoff + m * 2048); \
        else { _Pragma("unroll") for (int k = 0; k < 2; ++k) dst[m][k] = *(const LAS bf16x8*)(lds + PG8_SA(b, h) + aoff + m * 2048 + k * 1024); } } } while (0)
#define PG8_LDB(dst, b, h) do { _Pragma("unroll") for (int n = 0; n < 2; ++n) { if constexpr (FP8) dst##8[n] = PG8_LD8(lds + PG8_SB(b, h) + boff + n * 2048); \
        else { _Pragma("unroll") for (int k = 0; k < 2; ++k) dst[n][k] = *(const LAS bf16x8*)(lds + PG8_SB(b, h) + boff + n * 2048 + k * 1024); } } } while (0)
#define PG8_MMA(ai, bj, At, Bt) do { __builtin_amdgcn_s_setprio(1); _Pragma("unroll") for (int m = 0; m < 4; ++m) _Pragma("unroll") for (int n = 0; n < 2; ++n) { \
        if constexpr (FP8) { asm volatile("s_nop 1\n\tv_mfma_scale_f32_16x16x128_f8f6f4 %0, %1, %2, %0, %3, %3 op_sel_hi:[0,0,0]" : "+v"(acc[ai][bj][m][n]) : "v"(Bt##8[n]), "v"(At##8[m]), "v"(scl8)); } \
        else { _Pragma("unroll") for (int k = 0; k < 2; ++k) acc[ai][bj][m][n] = __builtin_amdgcn_mfma_f32_16x16x32_bf16(Bt[n][k], At[m][k], acc[ai][bj][m][n], 0, 0, 0); } } \
        __builtin_amdgcn_s_setprio(0); } while (0)
#define PG8_WAIT_V(n) asm volatile("s_waitcnt vmcnt(" #n ")" ::: "memory")
#define PG8_WAIT_L(n) asm volatile("s_waitcnt lgkmcnt(" #n ")" ::: "memory")
#define PG8_BAR __builtin_amdgcn_s_barrier()
#define PG8_SCHED __builtin_amdgcn_sched_barrier(0)
    Unit cur, nxt; int ui = 0;
    if (!S.next(0, cur)) return;
    unsigned va0[2], va1[2], vn0[2], vn1[2];
#define PG8_GIDX(dst0, dst1, u) do { if constexpr (GATHER) { _Pragma("unroll") for (int _i = 0; _i < 2; ++_i) { \
        dst0[_i] = min((unsigned)g.rowidx[(u).rbase + gR[_i]], (unsigned)(T - 1)) * (unsigned)(g.lda * 2) + voffA[_i]; dst1[_i] = min((unsigned)g.rowidx[(u).rbase + HALF + gR[_i]], (unsigned)(T - 1)) * (unsigned)(g.lda * 2) + voffA[_i]; } } \
        else { _Pragma("unroll") for (int _i = 0; _i < 2; ++_i) { dst0[_i] = voffA[_i]; dst1[_i] = voffA[_i]; } } } while (0)
    PG8_GIDX(va0, va1, cur);
    f32x4 acc[2][2][4][2];
#pragma unroll
    for (int a = 0; a < 2; ++a)
#pragma unroll
        for (int b = 0; b < 2; ++b)
#pragma unroll
            for (int m = 0; m < 4; ++m)
#pragma unroll
                for (int n = 0; n < 2; ++n) acc[a][b][m][n] = (f32x4){0.f, 0.f, 0.f, 0.f};
    bf16x8 At[4][2], B0[2][2], B1[2][2]; v8i_t At8[4], B08[2], B18[2];
    int scl8 = 0x7f7f7f7f; asm volatile("" : "+v"(scl8));
    const char* cA = (const char*)g.A + (GATHER ? 0 : (size_t)cur.pm * tstepA); const char* cB = (const char*)g.Bt + (size_t)cur.bt * tstepB;
    PG8_STAGE(PG8_SB(0, 0), cB, voffB); PG8_STAGE(PG8_SB(0, 1), cB + hstepB, voffB); PG8_STAGE(PG8_SA(0, 0), cA, va0); PG8_STAGE(PG8_SA(0, 1), cA + hstepA, va1);
    if (wr == 1) PG8_BAR;
    PG8_WAIT_V(2); PG8_BAR;
    PG8_STAGE(PG8_SB(1, 0), cB + kstep, voffB); PG8_STAGE(PG8_SA(1, 0), cA + kstep, va0); PG8_STAGE(PG8_SB(1, 1), cB + hstepB + kstep, voffB);
    PG8_WAIT_V(6); PG8_BAR;
    for (;;) {
        const bool has_next = S.next(ui + 1, nxt);
        const char* nA = (has_next && !GATHER) ? (const char*)g.A + (size_t)nxt.pm * tstepA : cA; const char* nB = has_next ? (const char*)g.Bt + (size_t)nxt.bt * tstepB : cB;
        if (has_next) PG8_GIDX(vn0, vn1, nxt); else { _Pragma("unroll") for (int _i = 0; _i < 2; ++_i) { vn0[_i] = va0[_i]; vn1[_i] = va1[_i]; } }
#pragma unroll 1
        for (int t = 0; t < nt; t += 2) {
            const bool last = (t == nt - 2);
            const char* a1 = cA + (size_t)(t + 1) * kstep;
            const char* a2 = last ? nA : cA + (size_t)(t + 2) * kstep; const char* b2 = last ? nB : cB + (size_t)(t + 2) * kstep;
            const char* a3 = a2 + kstep; const char* b3 = b2 + kstep;
            if constexpr (Epi::MID_T > 0) { if (t == Epi::MID_T) E.mid(acc, cur, wr, wc, fr, fq); }
            unsigned vs0[2], vs1[2];
#pragma unroll
            for (int _i = 0; _i < 2; ++_i) { vs0[_i] = last ? vn0[_i] : va0[_i]; vs1[_i] = last ? vn1[_i] : va1[_i]; }
            PG8_LDB(B0, 0, 0); PG8_LDB(B1, 0, 1); PG8_SCHED; PG8_LDA(At, 0, 0); PG8_STAGE(PG8_SA(1, 1), a1 + hstepA, va1);
            PG8_WAIT_V(8); PG8_WAIT_L(0); PG8_BAR; PG8_MMA(0, 0, At, B0); PG8_MMA(0, 1, At, B1); PG8_BAR; PG8_SCHED;
            PG8_LDA(At, 0, 1); PG8_STAGE(PG8_SB(0, 0), b2, voffB); PG8_STAGE(PG8_SB(0, 1), b2 + hstepB, voffB); PG8_STAGE(PG8_SA(0, 0), a2, vs0);
            PG8_WAIT_V(8); PG8_WAIT_L(0); PG8_BAR; PG8_MMA(1, 0, At, B0); PG8_MMA(1, 1, At, B1); PG8_BAR; PG8_SCHED;
            PG8_LDB(B0, 1, 0); PG8_LDB(B1, 1, 1); PG8_SCHED; PG8_LDA(At, 1, 0); PG8_STAGE(PG8_SA(0, 1), a2 + hstepA, vs1);
            PG8_WAIT_V(8); PG8_WAIT_L(0); PG8_BAR; PG8_MMA(0, 0, At, B0); PG8_MMA(0, 1, At, B1); PG8_BAR; PG8_SCHED;
            PG8_LDA(At, 1, 1); PG8_STAGE(PG8_SB(1, 0), b3, voffB); PG8_STAGE(PG8_SB(1, 1), b3 + hstepB, voffB); PG8_STAGE(PG8_SA(1, 0), a3, vs0);
            PG8_WAIT_V(8); PG8_WAIT_L(0); PG8_BAR; PG8_MMA(1, 0, At, B0); PG8_MMA(1, 1, At, B1); PG8_BAR; PG8_SCHED;
        }
        if constexpr (ALIGN_EPI) { if (wr == 0) PG8_BAR; }
        if constexpr (FP8) {
#pragma unroll
            for (int a = 0; a < 2; ++a)
#pragma unroll
                for (int b = 0; b < 2; ++b)
                    asm volatile("s_nop 15\n\ts_nop 7" : "+v"(acc[a][b][0][0]), "+v"(acc[a][b][0][1]), "+v"(acc[a][b][1][0]), "+v"(acc[a][b][1][1]), "+v"(acc[a][b][2][0]), "+v"(acc[a][b][2][1]), "+v"(acc[a][b][3][0]), "+v"(acc[a][b][3][1]));
        }
        E(acc, cur, wr, wc, fr, fq);
        if (!has_next) break;
#pragma unroll
        for (int a = 0; a < 2; ++a)
#pragma unroll
            for (int b = 0; b < 2; ++b)
#pragma unroll
                for (int m = 0; m < 4; ++m)
#pragma unroll
                    for (int n = 0; n < 2; ++n) acc[a][b][m][n] = (f32x4){0.f, 0.f, 0.f, 0.f};
        cur = nxt; cA = nA; cB = nB; ++ui;
#pragma unroll
        for (int _i = 0; _i < 2; ++_i) { va0[_i] = vn0[_i]; va1[_i] = vn1[_i]; }
        if constexpr (ALIGN_EPI) { if (wr == 1) PG8_BAR; }
    }
    PG8_WAIT_V(0);
    if constexpr (!ALIGN_EPI) { if (wr == 0) PG8_BAR; }
    PG8_BAR;
#undef PG8_SA
#undef PG8_SB
#undef PG8_STAGE
#undef PG8_GIDX
#undef PG8_LDA
#undef PG8_LDB
#undef PG8_MMA
#undef PG8_LD8
#undef PG8_WAIT_V
#undef PG8_WAIT_L
#undef PG8_BAR
#undef PG8_SCHED
}

typedef f32x4 Acc[2][2][4][2];

struct Epi1 {
    static constexpr bool PERM = true; static constexpr int MID_T = 0;
    bf16_t *yab, *gv; unsigned char *q, *k, *v; bf16_t *sa, *sb; float* gvst; float* kmp; float sc, pad_;
    template <int MODE  >
    __device__ __forceinline__ void run(const Acc& acc, const Unit& u, int wr, int wc, int fr, int fq, bf16_t* base, int ld) const {
        const int row0 = u.pm * BM + wr * 64 + fr, col0 = (u.pn & 3) * 256 + wc * 32 + 8 * fq;
        f32x4 csA0 = {0.f, 0.f, 0.f, 0.f}, csB0 = csA0, csA1 = csA0, csB1 = csA0;
#pragma unroll
        for (int ai = 0; ai < 2; ++ai)
#pragma unroll
            for (int m = 0; m < 4; ++m) {
                const int row = row0 + ai * HALF + m * 16; bf16_t* rowp = base + (size_t)row * ld + col0;
                float s1 = 0.f, s2 = 0.f;
#pragma unroll
                for (int bj = 0; bj < 2; ++bj) {
                    f32x4 v0 = acc[ai][bj][m][0], v1 = acc[ai][bj][m][1];
                    if (MODE == 2 || MODE == 3 || MODE == 5) {
                        const float f = (MODE == 2) ? sc * QSCALE : sc; v0 = v0 * f; v1 = v1 * f;
                        if (MODE == 5) { if (bj == 0) { csA0 = csA0 + v0; csB0 = csB0 + v1; } else { csA1 = csA1 + v0; csB1 = csB1 + v1; } }
                        *(u32x2*)((unsigned char*)base + (size_t)row * 1024 + col0 + bj * HALF) = (u32x2){pack_fp8x4(v0[0], v0[1], v0[2], v0[3]), pack_fp8x4(v1[0], v1[1], v1[2], v1[3])};
                        continue;
                    }
                    if (MODE == 0 || MODE == 1) {
                        f32x2 a = gelu_pk((f32x2){v0[0], v0[1]}), b = gelu_pk((f32x2){v0[2], v0[3]}), c = gelu_pk((f32x2){v1[0], v1[1]}), d = gelu_pk((f32x2){v1[2], v1[3]});
                        v0 = (f32x4){a.x, a.y, b.x, b.y}; v1 = (f32x4){c.x, c.y, d.x, d.y};
                    } else if (MODE == 4) {
#pragma unroll
                        for (int j = 0; j < 4; ++j) { v0[j] = v0[j]; }
                        { const float cs_ = -1.4426950408889634f * sc; const f32x4 t0 = v0 * cs_, t1 = v1 * cs_; f32x4 e0, e1;
#pragma unroll
                          for (int j = 0; j < 4; ++j) { e0[j] = __builtin_amdgcn_exp2f(t0[j]); e1[j] = __builtin_amdgcn_exp2f(t1[j]); }
                          e0 = e0 + 1.0f; e1 = e1 + 1.0f;
#pragma unroll
                          for (int j = 0; j < 4; ++j) { v0[j] = __builtin_amdgcn_rcpf(e0[j]); v1[j] = __builtin_amdgcn_rcpf(e1[j]); } }
                        *(u32x2*)((unsigned char*)base + (size_t)row * 1024 + col0 + bj * HALF) = (u32x2){pack_fp8x4(v0[0], v0[1], v0[2], v0[3]), pack_fp8x4(v1[0], v1[1], v1[2], v1[3])};
                        continue;
                    }
                    if (MODE == 1) {
                        s1 += (v0[0] + v0[1]) + (v0[2] + v0[3]) + (v1[0] + v1[1]) + (v1[2] + v1[3]);
                        s2 += (v0[0] * v0[0] + v0[1] * v0[1]) + (v0[2] * v0[2] + v0[3] * v0[3]) + (v1[0] * v1[0] + v1[1] * v1[1]) + (v1[2] * v1[2] + v1[3] * v1[3]);
                        *(u32x2*)((unsigned char*)base + (size_t)row * 1024 + col0 + bj * HALF) = (u32x2){pack_fp8x4(v0[0], v0[1], v0[2], v0[3]), pack_fp8x4(v1[0], v1[1], v1[2], v1[3])};
                        continue;
                    }
                    u32x4 w; w.x = cvt_pk_bf16(v0[0], v0[1]); w.y = cvt_pk_bf16(v0[2], v0[3]); w.z = cvt_pk_bf16(v1[0], v1[1]); w.w = cvt_pk_bf16(v1[2], v1[3]);
                    *(u32x4*)(rowp + bj * HALF) = w;
                }
                if (MODE == 1) {
                    s1 += __shfl_xor(s1, 16); s1 += __shfl_xor(s1, 32); s2 += __shfl_xor(s2, 16); s2 += __shfl_xor(s2, 32);
                    if (fq == 0) *(f32x2*)(gvst + ((size_t)row * 16 + (u.pn & 3) * 4 + wc) * 2) = (f32x2){s1, s2};
                }
            }
        if (MODE == 5) {
#define KM_RED(v) do { _Pragma("unroll") for (int j_ = 0; j_ < 4; ++j_) { float x = v[j_]; x += __shfl_xor(x, 1); x += __shfl_xor(x, 2); x += __shfl_xor(x, 4); x += __shfl_xor(x, 8); v[j_] = x; } } while (0)
            KM_RED(csA0); KM_RED(csB0); KM_RED(csA1); KM_RED(csB1);
#undef KM_RED
            if (fr == 0) {
                float* kp = kmp + ((size_t)(u.pm * 2 + wr) * DM) + col0;
                *(f32x4*)kp = csA0; *(f32x4*)(kp + 4) = csB0; *(f32x4*)(kp + HALF) = csA1; *(f32x4*)(kp + HALF + 4) = csB1;
            }
        }
    }
    __device__ __forceinline__ void operator()(const Acc& acc, const Unit& u, int wr, int wc, int fr, int fq) const {
        const int region = u.pn >> 2;
        if (region == 0) run<0>(acc, u, wr, wc, fr, fq, yab, 2048);
        else if (region == 1) run<1>(acc, u, wr, wc, fr, fq, gv, 1024);
        else if (region == 2) run<2>(acc, u, wr, wc, fr, fq, (bf16_t*)q, 1024);
        else if (region == 3) run<5>(acc, u, wr, wc, fr, fq, (bf16_t*)k, 1024);
        else if (region == 4) run<3>(acc, u, wr, wc, fr, fq, (bf16_t*)v, 1024);
        else if (region == 5) run<4>(acc, u, wr, wc, fr, fq, sa, 1024);
        else run<4>(acc, u, wr, wc, fr, fq, sb, 1024);
    }
    __device__ __forceinline__ void mid(Acc&, const Unit&, int, int, int, int) const {}
};

struct Epi2 {
    static constexpr bool PERM = true; static constexpr int MID_T = 16;
    const unsigned char *sa, *sb; bf16_t* mg;
    __device__ __forceinline__ void mid(Acc& acc, const Unit& u, int wr, int wc, int fr, int fq) const {
        int row0 = u.pm * BM + wr * 64 + fr, col0 = u.pn * BM + wc * 32 + 8 * fq;
        asm volatile("" : "+v"(row0), "+v"(col0));
#pragma unroll
        for (int ai = 0; ai < 2; ++ai)
#pragma unroll
            for (int m = 0; m < 4; ++m) {
                const size_t off = (size_t)(row0 + ai * HALF + m * 16) * DM + col0;
#pragma unroll
                for (int bj = 0; bj < 2; ++bj) {
                    const u32x2 a = *(const u32x2*)(sa + off + bj * HALF), b = *(const u32x2*)(sb + off + bj * HALF);
                    const f32x2v a0 = __builtin_amdgcn_cvt_pk_f32_fp8((int)a.x, false), a1 = __builtin_amdgcn_cvt_pk_f32_fp8((int)a.x, true), a2 = __builtin_amdgcn_cvt_pk_f32_fp8((int)a.y, false), a3 = __builtin_amdgcn_cvt_pk_f32_fp8((int)a.y, true);
                    const f32x2v b0 = __builtin_amdgcn_cvt_pk_f32_fp8((int)b.x, false), b1 = __builtin_amdgcn_cvt_pk_f32_fp8((int)b.x, true), b2 = __builtin_amdgcn_cvt_pk_f32_fp8((int)b.y, false), b3 = __builtin_amdgcn_cvt_pk_f32_fp8((int)b.y, true);
                    f32x4 r0, r1;
#define RQ(x, y) ((x) * __builtin_amdgcn_rcpf(y))
                    r0[0] = RQ(a0.x, b0.x); r0[1] = RQ(a0.y, b0.y); r0[2] = RQ(a1.x, b1.x); r0[3] = RQ(a1.y, b1.y);
                    r1[0] = RQ(a2.x, b2.x); r1[1] = RQ(a2.y, b2.y); r1[2] = RQ(a3.x, b3.x); r1[3] = RQ(a3.y, b3.y);
#undef RQ
                    acc[ai][bj][m][0] = acc[ai][bj][m][0] * r0; acc[ai][bj][m][1] = acc[ai][bj][m][1] * r1;
                }
                asm volatile("" : "+v"(acc[ai][0][m][0]), "+v"(acc[ai][0][m][1]), "+v"(acc[ai][1][m][0]), "+v"(acc[ai][1][m][1]));
                asm volatile("" ::: "memory");
            }
    }
    __device__ __forceinline__ void operator()(const Acc& acc, const Unit& u, int wr, int wc, int fr, int fq) const {
        const int row0 = u.pm * BM + wr * 64 + fr, col0 = u.pn * BM + wc * 32 + 8 * fq;
#pragma unroll
        for (int ai = 0; ai < 2; ++ai)
#pragma unroll
            for (int m = 0; m < 4; ++m) {
                const size_t off = (size_t)(row0 + ai * HALF + m * 16) * DM + col0;
#pragma unroll
                for (int bj = 0; bj < 2; ++bj) {
                    const u32x2 b = *(const u32x2*)(sb + off + bj * HALF);
                    const f32x2v b0 = __builtin_amdgcn_cvt_pk_f32_fp8((int)b.x, false), b1 = __builtin_amdgcn_cvt_pk_f32_fp8((int)b.x, true), b2 = __builtin_amdgcn_cvt_pk_f32_fp8((int)b.y, false), b3 = __builtin_amdgcn_cvt_pk_f32_fp8((int)b.y, true);
                    const f32x4 v0 = acc[ai][bj][m][0], v1 = acc[ai][bj][m][1];
                    u32x4 w; w.x = cvt_pk_bf16(v0[0] * b0.x, v0[1] * b0.y); w.y = cvt_pk_bf16(v0[2] * b1.x, v0[3] * b1.y);
                    w.z = cvt_pk_bf16(v1[0] * b2.x, v1[1] * b2.y); w.w = cvt_pk_bf16(v1[2] * b3.x, v1[3] * b3.y);
                    *(u32x4*)(mg + off + bj * HALF) = w;
                }
            }
    }
};

struct Epi3 {
    static constexpr bool PERM = true; static constexpr int MID_T = 0;
    const bf16_t* h0; bf16_t* z; float* zst;
    __device__ __forceinline__ void mid(Acc&, const Unit&, int, int, int, int) const {}
    __device__ __forceinline__ void operator()(const Acc& acc, const Unit& u, int wr, int wc, int fr, int fq) const {
        const int row0 = u.pm * BM + wr * 64 + fr, col0 = u.pn * BM + wc * 32 + 8 * fq;
#pragma unroll
        for (int ai = 0; ai < 2; ++ai)
#pragma unroll
            for (int m = 0; m < 4; ++m) {
                const int row = row0 + ai * HALF + m * 16; const size_t off = (size_t)row * DM + col0;
                float s1 = 0.f, s2 = 0.f;
#pragma unroll
                for (int bj = 0; bj < 2; ++bj) {
                    const u32x4 hb = *(const u32x4*)(h0 + off + bj * HALF);
                    f32x4 v0 = acc[ai][bj][m][0], v1 = acc[ai][bj][m][1];
                    v0[0] += ALPHA * bflo(hb.x); v0[1] += ALPHA * bfhi(hb.x); v0[2] += ALPHA * bflo(hb.y); v0[3] += ALPHA * bfhi(hb.y);
                    v1[0] += ALPHA * bflo(hb.z); v1[1] += ALPHA * bfhi(hb.z); v1[2] += ALPHA * bflo(hb.w); v1[3] += ALPHA * bfhi(hb.w);
                    s1 += ((v0[0] + v0[1]) + (v0[2] + v0[3])) + ((v1[0] + v1[1]) + (v1[2] + v1[3]));
                    s2 += ((v0[0] * v0[0] + v0[1] * v0[1]) + (v0[2] * v0[2] + v0[3] * v0[3])) + ((v1[0] * v1[0] + v1[1] * v1[1]) + (v1[2] * v1[2] + v1[3] * v1[3]));
                    *(u32x4*)(z + off + bj * HALF) = (u32x4){cvt_pk_bf16(v0[0], v0[1]), cvt_pk_bf16(v0[2], v0[3]), cvt_pk_bf16(v1[0], v1[1]), cvt_pk_bf16(v1[2], v1[3])};
                }
                s1 += __shfl_xor(s1, 16); s1 += __shfl_xor(s1, 32); s2 += __shfl_xor(s2, 16); s2 += __shfl_xor(s2, 32);
                if (fq == 0) *(f32x2*)(zst + ((size_t)row * 16 + u.pn * 4 + wc) * 2) = (f32x2){s1, s2};
            }
    }
};

struct Epi4 {
    static constexpr bool PERM = true; static constexpr int MID_T = 0;
    const float* b_up; unsigned char* act;
    __device__ __forceinline__ void mid(Acc&, const Unit&, int, int, int, int) const {}
    __device__ __forceinline__ void operator()(const Acc& acc, const Unit& u, int wr, int wc, int fr, int fq) const {
        const int e = u.bt >> 3;
        const int row0 = u.pm * BM + wr * 64 + fr, c0 = u.pn * HALF + wc * 32 + 8 * fq;
        const float* bg = b_up + (size_t)e * 2 * FF + c0; const float* bu = bg + FF;
        const f32x4 bg0 = *(const f32x4*)bg, bg1 = *(const f32x4*)(bg + 4), bu0 = *(const f32x4*)bu, bu1 = *(const f32x4*)(bu + 4);
#pragma unroll
        for (int ai = 0; ai < 2; ++ai)
#pragma unroll
            for (int m = 0; m < 4; ++m) {
                const int row = row0 + ai * HALF + m * 16;
                float o[8];
#pragma unroll
                for (int n = 0; n < 2; ++n)
#pragma unroll
                    for (int jp = 0; jp < 2; ++jp) {
                        const int j = 2 * jp;
                        const f32x2 ag = {acc[ai][0][m][n][j], acc[ai][0][m][n][j + 1]}, au = {acc[ai][1][m][n][j], acc[ai][1][m][n][j + 1]};
                        const f32x2 vbg = n ? (f32x2){bg1[j], bg1[j + 1]} : (f32x2){bg0[j], bg0[j + 1]}, vbu = n ? (f32x2){bu1[j], bu1[j + 1]} : (f32x2){bu0[j], bu0[j + 1]};
                        f32x2 gg = ag * 0.03125f + vbg, uu = au * 0.03125f + vbu;
                        gg.x = fminf(gg.x, 7.0f); gg.y = fminf(gg.y, 7.0f);
                        uu.x = __builtin_amdgcn_fmed3f(uu.x, -7.0f, 7.0f); uu.y = __builtin_amdgcn_fmed3f(uu.y, -7.0f, 7.0f);
                        const f32x2 t = gg * (-1.702f * 1.4426950408889634f);
                        f32x2 ex; ex.x = __builtin_amdgcn_exp2f(t.x); ex.y = __builtin_amdgcn_exp2f(t.y);
                        const f32x2 d = ex + 1.0f;
                        f32x2 rc; rc.x = __builtin_amdgcn_rcpf(d.x); rc.y = __builtin_amdgcn_rcpf(d.y);
                        const f32x2 res = (uu + 1.0f) * (gg * rc);
                        o[n * 4 + j] = res.x; o[n * 4 + j + 1] = res.y;
                    }
                unsigned w0 = 0u, w1 = 0u;
                w0 = __builtin_amdgcn_cvt_pk_fp8_f32(o[0], o[1], w0, false); w0 = __builtin_amdgcn_cvt_pk_fp8_f32(o[2], o[3], w0, true);
                w1 = __builtin_amdgcn_cvt_pk_fp8_f32(o[4], o[5], w1, false); w1 = __builtin_amdgcn_cvt_pk_fp8_f32(o[6], o[7], w1, true);
                *(u32x2*)(act + (size_t)row * FF + c0) = (u32x2){w0, w1};
            }
    }
};

__device__ __forceinline__ u32x4 pair16(u32x2 x, u32x2 y) {
    const auto r0 = __builtin_amdgcn_permlane16_swap(x.x, y.x, false, false);
    const auto r1 = __builtin_amdgcn_permlane16_swap(x.y, y.y, false, false);
    return (u32x4){r0[0], r1[0], r0[1], r1[1]};
}
struct Epi5 {
    static constexpr bool PERM = true; static constexpr int MID_T = 0;
    const float* b_down; const float* roww; unsigned char* ys;
    __device__ __forceinline__ void mid(Acc&, const Unit&, int, int, int, int) const {}
    __device__ __forceinline__ void operator()(const Acc& acc, const Unit& u, int wr, int wc, int fr, int fq) const {
        const int e = u.bt >> 2;
        const int row0 = u.pm * BM + wr * 64 + fr, col0 = u.pn * BM + wc * 32 + 8 * fq;
        f32x4 bv[2][2];
#pragma unroll
        for (int bj = 0; bj < 2; ++bj)
#pragma unroll
            for (int n = 0; n < 2; ++n) bv[bj][n] = *(const f32x4*)(b_down + (size_t)e * DM + col0 + bj * HALF + 4 * n);
        float rwv[2][4];
#pragma unroll
        for (int ai = 0; ai < 2; ++ai)
#pragma unroll
            for (int m = 0; m < 4; ++m) rwv[ai][m] = roww[u.rbase + wr * 64 + fr + ai * HALF + m * 16];
        asm volatile("" ::: "memory");
        const int colp = u.pn * BM + wc * 32 + 8 * (fq & ~1);
#pragma unroll
        for (int ai = 0; ai < 2; ++ai)
#pragma unroll
            for (int mp = 0; mp < 2; ++mp) {
                const int rowst = row0 + ai * HALF + (2 * mp + (fq & 1)) * 16;
#pragma unroll
                for (int bj = 0; bj < 2; ++bj) {
                    u32x2 pc[2];
#pragma unroll
                    for (int k = 0; k < 2; ++k) { const int m = 2 * mp + k; const float rw16 = rwv[ai][m] * 16.0f;
                        const f32x4 v0 = (acc[ai][bj][m][0] * 0.015625f + bv[bj][0]) * rw16, v1 = (acc[ai][bj][m][1] * 0.015625f + bv[bj][1]) * rw16;
                        pc[k] = (u32x2){pack_fp8x4(v0[0], v0[1], v0[2], v0[3]), pack_fp8x4(v1[0], v1[1], v1[2], v1[3])}; }
                    *(u32x4*)(ys + (size_t)rowst * DM + colp + bj * HALF) = pair16(pc[0], pc[1]);
                }
            }
    }
};
}

struct Args { const float* in[21]; float* out; unsigned char* ws; int ph_lo, ph_hi; };
enum { I_X = 0, I_LNIN_G, I_LNIN_B, I_WIN, I_GLN_G, I_GLN_B, I_WSP, I_BSP, I_WBA, I_WBB, I_WOUT, I_LNMIX_G, I_LNMIX_B, I_WR, I_BR, I_WUP, I_BUP, I_WDN, I_BDN, I_LNF_G, I_LNF_B };

struct Ctx { const Args* a; unsigned char* ws; LAS unsigned char* lds; unsigned char* ldsg; int tid, lane, wave, G, vcu; };

__device__ __forceinline__ void tr_item(const float* W, int N, int k0, int n0, bf16_t* dst, int drow0, int dld, int dcol0, LAS float* scr, int lane) {
#pragma unroll 8
    for (int i = 0; i < 32; ++i) { const int kk = 2 * i + (lane >> 5); scr[kk * 33 + (lane & 31)] = __builtin_nontemporal_load(W + (size_t)(k0 + kk) * N + n0 + (lane & 31)); }
    asm volatile("s_waitcnt lgkmcnt(0)" ::: "memory");
    const int c = lane & 7;
#pragma unroll
    for (int j = 0; j < 4; ++j) { const int n = (lane >> 3) + 8 * j; const LAS float* s = scr + (8 * c) * 33 + n;
        u32x4 o; o.x = pk2(s[0 * 33], s[1 * 33]); o.y = pk2(s[2 * 33], s[3 * 33]); o.z = pk2(s[4 * 33], s[5 * 33]); o.w = pk2(s[6 * 33], s[7 * 33]);
        *(u32x4*)(dst + (size_t)(drow0 + n) * dld + dcol0 + k0 + 8 * c) = o; }
    asm volatile("s_waitcnt lgkmcnt(0)" ::: "memory");
}
__device__ __forceinline__ void tr_item8(const float* W, int N, int k0, int n0, unsigned char* dst, int drow0, int dld, float sc, LAS float* scr, int lane) {
#pragma unroll 8
    for (int i = 0; i < 32; ++i) { const int kk = 2 * i + (lane >> 5); scr[kk * 33 + (lane & 31)] = __builtin_nontemporal_load(W + (size_t)(k0 + kk) * N + n0 + (lane & 31)); }
    asm volatile("s_waitcnt lgkmcnt(0)" ::: "memory");
    const int c = lane & 7;
#pragma unroll
    for (int j = 0; j < 4; ++j) { const int n = (lane >> 3) + 8 * j; const LAS float* s = scr + (8 * c) * 33 + n;
        unsigned w0 = 0u, w1 = 0u;
        w0 = __builtin_amdgcn_cvt_pk_fp8_f32(s[0 * 33] * sc, s[1 * 33] * sc, w0, false); w0 = __builtin_amdgcn_cvt_pk_fp8_f32(s[2 * 33] * sc, s[3 * 33] * sc, w0, true);
        w1 = __builtin_amdgcn_cvt_pk_fp8_f32(s[4 * 33] * sc, s[5 * 33] * sc, w1, false); w1 = __builtin_amdgcn_cvt_pk_fp8_f32(s[6 * 33] * sc, s[7 * 33] * sc, w1, true);
        *(u32x2*)(dst + (size_t)(drow0 + n) * dld + k0 + 8 * c) = (u32x2){w0, w1}; }
    asm volatile("s_waitcnt lgkmcnt(0)" ::: "memory");
}
__device__ __forceinline__ void ph_prologue(const Ctx& F) {
    const Args& A = *F.a;
    LAS float* scr = (LAS float*)(F.lds + F.wave * 16384);
    const int gw = F.vcu * 8 + F.wave, NGW = F.G * 8;
    bf16_t* WIN = (bf16_t*)(F.ws + WS_WIN); bf16_t* WAB = (bf16_t*)(F.ws + WS_WAB); bf16_t* WOUT = (bf16_t*)(F.ws + WS_WOUT);
    unsigned char* WDN = F.ws + WS_WDN; unsigned char* WUP = F.ws + WS_WUP;
    constexpr int I_IN = 16 * (INCOLS / 32), I_SQ = 16 * 32, I_UP = NE * 16 * 64, I_DN = NE * 16 * 32;
    constexpr int NITEMS = I_IN + 3 * I_SQ + I_UP + I_DN;
    for (int it = gw; it < NITEMS; it += NGW) {
        int r = it;
        if (r < I_IN) { const int nblk = INCOLS / 32, kb = r / nblk, nb = r % nblk;
            if (32 * nb >= PN8_LO * 256 && 32 * nb < PN8_HI * 256) tr_item8(A.in[I_WIN], INCOLS, 64 * kb, 32 * nb, F.ws + WS_WIN8, 32 * nb, DM, 32.0f, scr, F.lane);
            else tr_item(A.in[I_WIN], INCOLS, 64 * kb, 32 * nb, WIN, 32 * nb, DM, 0, scr, F.lane);
            continue; } r -= I_IN;
        if (r < I_SQ) { const int kb = r / 32, nb = r % 32; tr_item(A.in[I_WBA], DM, 64 * kb, 32 * nb, WAB, 32 * nb, 2048, 0, scr, F.lane); continue; } r -= I_SQ;
        if (r < I_SQ) { const int kb = r / 32, nb = r % 32; tr_item(A.in[I_WBB], DM, 64 * kb, 32 * nb, WAB, 32 * nb, 2048, 1024, scr, F.lane); continue; } r -= I_SQ;
        if (r < I_SQ) { const int kb = r / 32, nb = r % 32; tr_item(A.in[I_WOUT], DM, 64 * kb, 32 * nb, WOUT, 32 * nb, DM, 0, scr, F.lane); continue; } r -= I_SQ;
        if (r < I_UP) { const int e = r / (16 * 64), rr = r % (16 * 64), kb = rr / 64, nb = rr % 64; const int n0 = 32 * nb, half = n0 >= FF, rem = n0 - half * FF, pn = rem >> 7, b = (rem & 127) >> 5;
            tr_item8(A.in[I_WUP] + (size_t)e * DM * 2 * FF, 2 * FF, 64 * kb, n0, WUP, e * 2048 + 256 * pn + half * 128 + 32 * b, DM, 32.0f, scr, F.lane); continue; } r -= I_UP;
        { const int e = r / (16 * 32), rr = r % (16 * 32), kb = rr / 32, nb = rr % 32; tr_item8(A.in[I_WDN] + (size_t)e * FF * DM, DM, 64 * kb, 32 * nb, WDN, e * 1024 + 32 * nb, FF, 64.0f, scr, F.lane); }
    }
    const float* lg = A.in[I_LNIN_G]; const float* lb = A.in[I_LNIN_B]; bf16_t* H0 = (bf16_t*)(F.ws + WS_H0);
    f32x4 gg[4], bb[4];
#pragma unroll
    for (int j = 0; j < 4; ++j) { gg[j] = *((const f32x4*)lg + F.lane + 64 * j); bb[j] = *((const f32x4*)lb + F.lane + 64 * j); }
    for (int m = gw; m < T; m += NGW) {
        const f32x4* xr = (const f32x4*)(A.in[I_X] + (size_t)m * DM) + F.lane;
        f32x4 v[4]; float s = 0.f;
#pragma unroll
        for (int j = 0; j < 4; ++j) { v[j] = __builtin_nontemporal_load(xr + 64 * j); s += (v[j].x + v[j].y) + (v[j].z + v[j].w); }
        const float mean = wave_sum(s) * (1.f / DM); float s2 = 0.f;
#pragma unroll
        for (int j = 0; j < 4; ++j) { v[j] = v[j] - mean; s2 += (v[j].x * v[j].x + v[j].y * v[j].y) + (v[j].z * v[j].z + v[j].w * v[j].w); }
        const float rstd = 1.f / sqrtf(wave_sum(s2) * (1.f / DM) + LN_EPS);
        u32x2* o8 = (u32x2*)(H0 + (size_t)m * DM) + F.lane; unsigned* o4 = (unsigned*)(F.ws + WS_H0F8 + (size_t)m * DM) + F.lane;
#pragma unroll
        for (int j = 0; j < 4; ++j) { const f32x4 y = v[j] * rstd * gg[j] + bb[j]; o8[64 * j] = (u32x2){pk2(y.x, y.y), pk2(y.z, y.w)}; o4[64 * j] = pack_fp8x4(y.x, y.y, y.z, y.w); }
    }
}

__device__ __forceinline__ void ph_kmean(const Ctx& F) {
    const unsigned char* K = F.ws + WS_K; float* KM = (float*)(F.ws + WS_KMEAN);
    float* red = (float*)F.ldsg;
    const int d = F.tid & 127, part = F.tid >> 7;
    for (int it = F.vcu; it < NB * NH * NBLK; it += F.G) {
        const int b = it / (NH * NBLK), h = (it / NBLK) % NH, j = it % NBLK;
        const unsigned char* kp = K + ((size_t)(b * SEQ + j * LBLK + part * 64)) * DM + h * DH + d;
        float s = 0.f;
        for (int r = 0; r < 64; ++r) s += __builtin_amdgcn_cvt_f32_fp8((int)kp[(size_t)r * DM], 0);
        red[part * 128 + d] = s;
        __syncthreads();
        if (F.tid < 128) KM[(size_t)it * DH + d] = (red[d] + red[128 + d] + red[256 + d] + red[384 + d]) * (1.0f / LBLK);
        __syncthreads();
    }
}
typedef short v4i16_t __attribute__((ext_vector_type(4)));
__device__ __forceinline__ v4i16_t lds_tr16(LAS const unsigned char* p) { return __builtin_amdgcn_ds_read_tr16_b64_v4i16((LAS v4i16_t*)p); }
__device__ __forceinline__ void ph_mixer_a(const Ctx& F) {
    const Args& A = *F.a;
    const unsigned char* GV = F.ws + WS_GV; bf16_t* YAB = (bf16_t*)(F.ws + WS_YAB); const float* GVST = (const float*)(F.ws + WS_GVST);
    const float* lg = A.in[I_GLN_G]; const float* lb = A.in[I_GLN_B]; const float* wsp = A.in[I_WSP]; const float* bsp = A.in[I_BSP];
    constexpr int RSV = 544, RSW = 272, OFF_W = 128 * RSV, OFF_ST = OFF_W + 128 * RSW;
    LAS unsigned char* VT = F.lds; LAS unsigned char* WT = F.lds + OFF_W; LAS float* ST = (LAS float*)(F.lds + OFF_ST);
    const int lane = F.lane, wv = F.wave;
    int curg = -1;
    for (int it = F.vcu; it < NB * 32 * 4; it += F.G) {
        const int b = it / 128, c = (it >> 2) & 31, g = it & 3;
        const int tok0 = b * SEQ + c * 128;
        if (g != curg) {
            curg = g;
            for (int k = 0; k < 4; ++k) {
                const int idx = F.tid + 512 * k, t = idx >> 4, s8 = (idx & 15) * 8;
                const f32x4 w0 = *(const f32x4*)(wsp + ((size_t)g * 128 + t) * 128 + s8), w1 = *(const f32x4*)(wsp + ((size_t)g * 128 + t) * 128 + s8 + 4);
                float x[8] = {w0.x, w0.y, w0.z, w0.w, w1.x, w1.y, w1.z, w1.w};
#pragma unroll
                for (int j = 0; j < 8; ++j) x[j] = (s8 + j <= t) ? x[j] : 0.f;
                u32x4 o; o.x = pk2(x[0], x[1]); o.y = pk2(x[2], x[3]); o.z = pk2(x[4], x[5]); o.w = pk2(x[6], x[7]);
                *(LAS u32x4*)(WT + t * RSW + s8 * 2) = o;
            }
        }
        if (F.tid < 128) {
            const float* p = GVST + (size_t)(tok0 + F.tid) * 32; float s1 = 0.f, s2 = 0.f;
            for (int i = 0; i < 16; ++i) { s1 += p[2 * i]; s2 += p[2 * i + 1]; }
            const float mean = s1 * (1.f / DM), var = s2 * (1.f / DM) - mean * mean;
            ST[2 * F.tid] = mean; ST[2 * F.tid + 1] = 1.f / sqrtf(fmaxf(var, 0.f) + LN_EPS);
        }
        __syncthreads();
        {
            const int dc = F.tid & 31;
            const f32x4 g0 = *(const f32x4*)(lg + g * 256 + dc * 8), g1 = *(const f32x4*)(lg + g * 256 + dc * 8 + 4), b0 = *(const f32x4*)(lb + g * 256 + dc * 8), b1 = *(const f32x4*)(lb + g * 256 + dc * 8 + 4);
#pragma unroll
            for (int k = 0; k < 8; ++k) {
                const int s = (F.tid >> 5) + 16 * k;
                const u32x2 raw = *(const u32x2*)(GV + (size_t)(tok0 + s) * DM + g * 256 + dc * 8);
                const float mean = ST[2 * s], rstd = ST[2 * s + 1];
                const f32x2v f0 = __builtin_amdgcn_cvt_pk_f32_fp8((int)raw.x, false), f1 = __builtin_amdgcn_cvt_pk_f32_fp8((int)raw.x, true), f2 = __builtin_amdgcn_cvt_pk_f32_fp8((int)raw.y, false), f3 = __builtin_amdgcn_cvt_pk_f32_fp8((int)raw.y, true);
                f32x4 x0 = {f0.x, f0.y, f1.x, f1.y}, x1 = {f2.x, f2.y, f3.x, f3.y};
                x0 = (x0 - mean) * rstd * g0 + b0; x1 = (x1 - mean) * rstd * g1 + b1;
                u32x4 o; o.x = pk2(x0.x, x0.y); o.y = pk2(x0.z, x0.w); o.z = pk2(x1.x, x1.y); o.w = pk2(x1.z, x1.w);
                *(LAS u32x4*)(VT + s * RSV + dc * 16) = o;
            }
        }
        __syncthreads();
        {
            const int dbase = 32 * wv, kg = lane >> 4, q = (lane & 15) >> 2, p = lane & 3, fr = lane & 15;
            bf16x8 Af[2][4];
#pragma unroll
            for (int m = 0; m < 2; ++m)
#pragma unroll
                for (int kk = 0; kk < 4; ++kk) {
                    LAS const unsigned char* ap = VT + (32 * kk + 8 * kg + q) * RSV + (dbase + 16 * m + 4 * p) * 2;
                    const v4i16_t lo = lds_tr16(ap), hi = lds_tr16(ap + 4 * RSV);
                    Af[m][kk] = (bf16x8){lo[0], lo[1], lo[2], lo[3], hi[0], hi[1], hi[2], hi[3]};
                }
#pragma unroll
            for (int n = 0; n < 8; ++n) {
                f32x4 acc0 = {0.f, 0.f, 0.f, 0.f}, acc1 = {0.f, 0.f, 0.f, 0.f};
#pragma unroll
                for (int kk = 0; kk < 4; ++kk) if (kk <= (n >> 1)) {
                    const bf16x8 Bf = *(LAS const bf16x8*)(WT + (16 * n + fr) * RSW + (32 * kk + 8 * kg) * 2);
                    acc0 = __builtin_amdgcn_mfma_f32_16x16x32_bf16(Af[0][kk], Bf, acc0, 0, 0, 0);
                    acc1 = __builtin_amdgcn_mfma_f32_16x16x32_bf16(Af[1][kk], Bf, acc1, 0, 0, 0);
                }
                const int t = 16 * n + fr; const float bsv = bsp[g * 128 + t];
                bf16_t* yp = YAB + (size_t)(tok0 + t) * 2048 + g * 256 + dbase + 4 * kg;
                const u32x2 u0 = *(const u32x2*)yp, u1 = *(const u32x2*)(yp + 16);
                u32x2 o0, o1;
                o0.x = pk2(bflo(u0.x) * (acc0[0] + bsv), bfhi(u0.x) * (acc0[1] + bsv)); o0.y = pk2(bflo(u0.y) * (acc0[2] + bsv), bfhi(u0.y) * (acc0[3] + bsv));
                o1.x = pk2(bflo(u1.x) * (acc1[0] + bsv), bfhi(u1.x) * (acc1[1] + bsv)); o1.y = pk2(bflo(u1.y) * (acc1[2] + bsv), bfhi(u1.y) * (acc1[3] + bsv));
                *(u32x2*)yp = o0; *(u32x2*)(yp + 16) = o1;
            }
        }
        __syncthreads();
    }
}

__device__ __forceinline__ void ph_gate(const Ctx& F) {
    const unsigned char* Q = F.ws + WS_Q; const float* KM = (const float*)(F.ws + WS_KMEAN);
    unsigned* SEL = (unsigned*)(F.ws + WS_SEL); unsigned* LISTS = (unsigned*)(F.ws + WS_LISTS); unsigned* LCNT = (unsigned*)(F.ws + WS_CTL) + CW_LCNT;
    float* km = (float*)F.ldsg;
    unsigned* lc = (unsigned*)(F.ldsg + 8192);
    for (int it = F.vcu; it < NB * NH * 8; it += F.G) {
        const int b = it / 64, h = (it >> 3) & 7, tc = it & 7;
        for (int i = F.tid; i < NBLK * DH; i += 512) { const int j = i >> 7, d = i & 127; const float* kp = KM + (size_t)((b * NBLK + j) * 2) * DM + h * DH + d; km[i] = (kp[0] + kp[DM]) * (1.0f / LBLK); }
        if (F.tid < 32) lc[F.tid] = 0u;
        __syncthreads();
        const int t = tc * 512 + F.tid, qi = t >> 8;
        float gsc[15];
#pragma unroll
        for (int j = 0; j < 15; ++j) gsc[j] = 0.f;
        const unsigned char* qp = Q + (size_t)(b * SEQ + t) * DM + h * DH;
        u32x4 qraw[8];
#pragma unroll
        for (int c = 0; c < 8; ++c) qraw[c] = *(const u32x4*)(qp + c * 16);
#pragma unroll
        for (int c = 0; c < 16; ++c) {
            const u32x2 raw = (c & 1) ? (u32x2){qraw[c >> 1].z, qraw[c >> 1].w} : (u32x2){qraw[c >> 1].x, qraw[c >> 1].y};
            const f32x2v f0 = __builtin_amdgcn_cvt_pk_f32_fp8((int)raw.x, false), f1 = __builtin_amdgcn_cvt_pk_f32_fp8((int)raw.x, true), f2 = __builtin_amdgcn_cvt_pk_f32_fp8((int)raw.y, false), f3 = __builtin_amdgcn_cvt_pk_f32_fp8((int)raw.y, true);
            const float x[8] = {f0.x, f0.y, f1.x, f1.y, f2.x, f2.y, f3.x, f3.y};
#pragma unroll
            for (int j = 0; j < 15; ++j) if (j < qi) {
                const float* kk = km + j * DH + c * 8;
#pragma unroll
                for (int e = 0; e < 8; ++e) gsc[j] += x[e] * kk[e];
            }
        }
        const int nsel = qi < 3 ? qi : 3;
        int sel[3] = {0, 0, 0}; unsigned lpos[3] = {0, 0, 0};
#pragma unroll
        for (int r = 0; r < 3; ++r) {
            float best = -INFINITY; int bi = -1;
#pragma unroll
            for (int j = 0; j < 15; ++j) { const bool c = (j < qi) && (gsc[j] > best); best = c ? gsc[j] : best; bi = c ? j : bi; }
#pragma unroll
            for (int j = 0; j < 15; ++j) if (j == bi) gsc[j] = -INFINITY;
            sel[r] = bi < 0 ? 0 : bi;
            if (r < nsel) lpos[r] = atomicAdd(&lc[sel[r]], 1u);
        }
        SEL[(size_t)(b * SEQ + t) * NH + h] = (unsigned)sel[0] | ((unsigned)sel[1] << 8) | ((unsigned)sel[2] << 16) | ((unsigned)nsel << 24);
        __syncthreads();
        if (F.tid < 16) lc[16 + F.tid] = lc[F.tid] ? atomicAdd(&LCNT[(b * NH + h) * NBLK + F.tid], lc[F.tid]) : 0u;
        __syncthreads();
#pragma unroll
        for (int r = 0; r < 3; ++r) if (r < nsel) LISTS[(size_t)((b * NH + h) * NBLK + sel[r]) * 4096 + lc[16 + sel[r]] + lpos[r]] = (unsigned)t | ((unsigned)r << 12);
        __syncthreads();
    }
}

__device__ __forceinline__ void ph_attn_naive(const Ctx& F) {
    const bf16_t* Q = (const bf16_t*)(F.ws + WS_Q); const bf16_t* K = (const bf16_t*)(F.ws + WS_K); const bf16_t* V = (const bf16_t*)(F.ws + WS_V);
    const unsigned* SEL = (const unsigned*)(F.ws + WS_SEL); bf16_t* YAB = (bf16_t*)(F.ws + WS_YAB);
    float* qs = (float*)(F.ldsg + F.wave * 4608);
    float* sc = qs + 128;
    const int gw = F.vcu * 8 + F.wave, NGW = F.G * 8;
    for (int w = gw; w < NB * NH * SEQ; w += NGW) {
        const int b = w / (NH * SEQ), h = (w / SEQ) % NH, t = w % SEQ, qi = t >> 8, tl = t & 255;
        const size_t tok = (size_t)b * SEQ + t;
        { const unsigned qq = *(const unsigned*)(Q + tok * DM + h * DH + 2 * F.lane); qs[2 * F.lane] = bflo(qq); qs[2 * F.lane + 1] = bfhi(qq); }
        const unsigned selw = SEL[tok * NH + h]; const int nsel = selw >> 24;
        float mx = -INFINITY;
        for (int r = 0; r <= nsel; ++r) {
            const int jb = (r < nsel) ? (int)((selw >> (8 * r)) & 0xff) : qi;
            for (int c = 0; c < 4; ++c) {
                const int key = c * 64 + F.lane;
                const bool valid = (r < nsel) || (key <= tl);
                const bf16_t* kp = K + ((size_t)b * SEQ + jb * LBLK + key) * DM + h * DH;
                float s = 0.f;
#pragma unroll 4
                for (int dd = 0; dd < 16; ++dd) {
                    const u32x4 raw = *(const u32x4*)(kp + dd * 8);
                    const float* q8 = qs + dd * 8;
                    s += bflo(raw.x) * q8[0] + bfhi(raw.x) * q8[1] + bflo(raw.y) * q8[2] + bfhi(raw.y) * q8[3] + bflo(raw.z) * q8[4] + bfhi(raw.z) * q8[5] + bflo(raw.w) * q8[6] + bfhi(raw.w) * q8[7];
                }
                s = valid ? s : -INFINITY;
                sc[r * 256 + key] = s; mx = fmaxf(mx, s);
            }
        }
        mx = wave_max(mx);
        float l = 0.f;
        const int ntot = (nsel + 1) * 256;
        for (int i = F.lane; i < ntot; i += 64) { const float p = __builtin_amdgcn_exp2f(sc[i] - mx); sc[i] = p; l += p; }
        l = wave_sum(l);
        float o0 = 0.f, o1 = 0.f;
        for (int r = 0; r <= nsel; ++r) {
            const int jb = (r < nsel) ? (int)((selw >> (8 * r)) & 0xff) : qi;
            const int nk = (r < nsel) ? 256 : tl + 1;
            const bf16_t* vp = V + ((size_t)b * SEQ + jb * LBLK) * DM + h * DH + 2 * F.lane;
#pragma unroll 4
            for (int key = 0; key < nk; ++key) { const unsigned vv = *(const unsigned*)(vp + (size_t)key * DM); const float p = sc[r * 256 + key]; o0 += p * bflo(vv); o1 += p * bfhi(vv); }
        }
        const float il = 1.f / l;
        *(unsigned*)(YAB + tok * 2048 + 1024 + h * DH + 2 * F.lane) = pk2(o0 * il, o1 * il);
    }
}

typedef float f32x16 __attribute__((ext_vector_type(16)));
namespace att {
constexpr int KCH = 4112, VDB = 16448, OFF_K = 0, OFF_V = 16 * KCH, OFF_WS = OFF_V + 4 * VDB  , WSW = 512, OFF_TAB = OFF_WS + 8 * WSW  ;
static_assert(OFF_TAB + 1028 * 4 <= LDS_BYTES, "attention LDS map");
__device__ __forceinline__ int crow(int r, int hi) { return (r & 3) + 8 * (r >> 2) + 4 * hi; }
#define TRR(dst, vaddr, off) asm volatile("ds_read_b64_tr_b16 %0, %1 offset:%c2" : "=v"(dst) : "v"(vaddr), "i"(off) : "memory")
#define TRWAIT() do { asm volatile("s_waitcnt lgkmcnt(0)" ::: "memory"); __builtin_amdgcn_sched_barrier(0); } while (0)

__device__ __forceinline__ void load_kv(const Ctx& F, const unsigned char* K, const unsigned char* V, size_t tokbase, int h) {
    u32x4 kv[4], vv[4];
#pragma unroll
    for (int k = 0; k < 4; ++k) { const int idx = F.tid + 512 * k, key = idx >> 3, c2 = idx & 7; const size_t off = (tokbase + key) * DM + h * DH + c2 * 16;
        kv[k] = *(const u32x4*)(K + off); vv[k] = *(const u32x4*)(V + off); }
#pragma unroll
    for (int k = 0; k < 4; ++k) { const int idx = F.tid + 512 * k, key = idx >> 3, c2 = idx & 7, c = 2 * c2;
        *(LAS u32x4*)(F.lds + OFF_K + c * KCH + key * 16) = f8x8_to_bf16x8(kv[k].x, kv[k].y);
        *(LAS u32x4*)(F.lds + OFF_K + (c + 1) * KCH + key * 16) = f8x8_to_bf16x8(kv[k].z, kv[k].w);
        LAS unsigned char* vd = F.lds + OFF_V + (c >> 2) * VDB + (key >> 3) * 512 + (key & 7) * 64 + (c & 3) * 16;
        *(LAS u32x4*)vd = f8x8_to_bf16x8(vv[k].x, vv[k].y); *(LAS u32x4*)(vd + 16) = f8x8_to_bf16x8(vv[k].z, vv[k].w); }
}

template <bool CAUSAL>
__device__ __forceinline__ void core(const Ctx& F, const unsigned char* qrow, f32x16 (&o)[4], float& m, float& l) {
    const int r = F.lane & 31, hh = F.lane >> 5;
    LAS float* wsf = (LAS float*)(F.lds + OFF_WS + F.wave * WSW);
    bf16x8 qr[8];
#pragma unroll
    for (int ds = 0; ds < 8; ++ds) { const u32x2 raw = *(const u32x2*)(qrow + ds * 16 + hh * 8); qr[ds] = __builtin_bit_cast(bf16x8, f8x8_to_bf16x8(raw.x, raw.y)); }
#pragma unroll
    for (int db = 0; db < 4; ++db)
#pragma unroll
        for (int i = 0; i < 16; ++i) o[db][i] = 0.f;
    m = -1e30f; l = 0.f;
    const int nt = CAUSAL ? (F.wave >> 1) + 1 : 4;
    LAS const unsigned char* kbase = F.lds + OFF_K + hh * KCH + r * 16;
    LAS const unsigned char* vbase = F.lds + OFF_V + (4 * hh + ((F.lane & 15) >> 2)) * 64 + ((F.lane >> 4) & 1) * 32 + (F.lane & 3) * 8;
    for (int kt = 0; kt < nt; ++kt) {
        const bool diag = CAUSAL && (kt == nt - 1);
        constexpr bool skip1 = false;
        f32x16 p0, p1;
#pragma unroll
        for (int i = 0; i < 16; ++i) { p0[i] = 0.f; p1[i] = 0.f; }
        LAS const unsigned char* kp = kbase + (64 * kt) * 16;
        LAS const unsigned char* vp = vbase + (8 * kt) * 512;
        {
            bf16x8 ka[8], kb[8];
#pragma unroll
            for (int ds = 0; ds < 8; ++ds) ka[ds] = *(LAS const bf16x8*)(kp + 2 * ds * KCH);
            if (!skip1) {
#pragma unroll
                for (int ds = 0; ds < 8; ++ds) kb[ds] = *(LAS const bf16x8*)(kp + 2 * ds * KCH + 512);
            }
            __builtin_amdgcn_sched_barrier(0);
#pragma unroll
            for (int ds = 0; ds < 8; ++ds) p0 = __builtin_amdgcn_mfma_f32_32x32x16_bf16(ka[ds], qr[ds], p0, 0, 0, 0);
            if (!skip1) {
#pragma unroll
                for (int ds = 0; ds < 8; ++ds) p1 = __builtin_amdgcn_mfma_f32_32x32x16_bf16(kb[ds], qr[ds], p1, 0, 0, 0);
            }
            __builtin_amdgcn_sched_barrier(0);
        }
        v4i16_t vl[2][4], vh[2][4];
        const unsigned vaddr = (unsigned)(uintptr_t)vp;
#pragma unroll
        for (int ks = 0; ks < 2; ++ks)
#pragma unroll
            for (int db = 0; db < 4; ++db) { TRR(vl[ks][db], vaddr, db * VDB + ks * 1024); TRR(vh[ks][db], vaddr, db * VDB + ks * 1024 + 512); }
        __builtin_amdgcn_sched_barrier(0);
        if (diag) {
            if (F.wave & 1) {
#pragma unroll
                for (int i = 0; i < 16; ++i) p1[i] = (crow(i, hh) > r) ? -INFINITY : p1[i];
            } else {
#pragma unroll
                for (int i = 0; i < 16; ++i) { p0[i] = (crow(i, hh) > r) ? -INFINITY : p0[i]; p1[i] = -INFINITY; }
            }
        }
        float mx = fmaxf(p0[0], p1[0]);
#pragma unroll
        for (int i = 1; i < 16; ++i) mx = fmaxf(mx, fmaxf(p0[i], p1[i]));
        mx = fmaxf(mx, __shfl_xor(mx, 32));
        const float mnew = fmaxf(m, mx);
        if (__any(mx > m + 8.0f)) {
            const float alpha = __builtin_amdgcn_exp2f(m - mnew);
            l *= alpha; m = mnew;
            if (hh == 0) wsf[r] = alpha;
            asm volatile("s_waitcnt lgkmcnt(0)" ::: "memory");
#pragma unroll
            for (int i = 0; i < 16; ++i) { const float a = wsf[crow(i, hh)];
#pragma unroll
                for (int db = 0; db < 4; ++db) o[db][i] *= a; }
        }
        float ls = 0.f;
#pragma unroll
        for (int i = 0; i < 16; ++i) { p0[i] = __builtin_amdgcn_exp2f(p0[i] - m); p1[i] = __builtin_amdgcn_exp2f(p1[i] - m); ls += p0[i] + p1[i]; }
        l += ls;
        u32x4 pw[4];
#pragma unroll
        for (int s2 = 0; s2 < 2; ++s2) {
            pw[s2] = (u32x4){cvt_pk_bf16(p0[8 * s2], p0[8 * s2 + 1]), cvt_pk_bf16(p0[8 * s2 + 2], p0[8 * s2 + 3]), cvt_pk_bf16(p0[8 * s2 + 4], p0[8 * s2 + 5]), cvt_pk_bf16(p0[8 * s2 + 6], p0[8 * s2 + 7])};
            pw[2 + s2] = (u32x4){cvt_pk_bf16(p1[8 * s2], p1[8 * s2 + 1]), cvt_pk_bf16(p1[8 * s2 + 2], p1[8 * s2 + 3]), cvt_pk_bf16(p1[8 * s2 + 4], p1[8 * s2 + 5]), cvt_pk_bf16(p1[8 * s2 + 6], p1[8 * s2 + 7])};
        }
        TRWAIT();
        v4i16_t wl[2][4], wh[2][4];
        if (!skip1) {
#pragma unroll
            for (int ks = 0; ks < 2; ++ks)
#pragma unroll
                for (int db = 0; db < 4; ++db) { TRR(wl[ks][db], vaddr, db * VDB + (2 + ks) * 1024); TRR(wh[ks][db], vaddr, db * VDB + (2 + ks) * 1024 + 512); }
        }
        __builtin_amdgcn_sched_barrier(0);
#pragma unroll
        for (int ks = 0; ks < 2; ++ks) {
            const bf16x8 pa = __builtin_bit_cast(bf16x8, pw[ks]);
#pragma unroll
            for (int db = 0; db < 4; ++db) {
                const bf16x8 vf = (bf16x8){vl[ks][db][0], vl[ks][db][1], vl[ks][db][2], vl[ks][db][3], vh[ks][db][0], vh[ks][db][1], vh[ks][db][2], vh[ks][db][3]};
                o[db] = __builtin_amdgcn_mfma_f32_32x32x16_bf16(pa, vf, o[db], 0, 0, 0);
            }
        }
        TRWAIT();
        if (!skip1) {
#pragma unroll
            for (int ks = 0; ks < 2; ++ks) {
                const bf16x8 pa = __builtin_bit_cast(bf16x8, pw[2 + ks]);
#pragma unroll
                for (int db = 0; db < 4; ++db) {
                    const bf16x8 vf = (bf16x8){wl[ks][db][0], wl[ks][db][1], wl[ks][db][2], wl[ks][db][3], wh[ks][db][0], wh[ks][db][1], wh[ks][db][2], wh[ks][db][3]};
                    o[db] = __builtin_amdgcn_mfma_f32_32x32x16_bf16(pa, vf, o[db], 0, 0, 0);
                }
            }
        }
        __builtin_amdgcn_sched_barrier(0);
    }
}
__device__ __forceinline__ void finish_and_stage(const Ctx& F, const f32x16 (&o)[4], float m, float l) {
    const int r = F.lane & 31, hh = F.lane >> 5;
    LAS float* wsf = (LAS float*)(F.lds + OFF_WS + F.wave * WSW);
    const float lt = l + __shfl_xor(l, 32);
    if (hh == 0) { wsf[r] = 1.0f / lt; wsf[32 + r] = m + __builtin_amdgcn_logf(lt); }
    __syncthreads();
    LAS float* stg = (LAS float*)(F.lds + F.wave * 16384);
#pragma unroll
    for (int i = 0; i < 16; ++i) { const int q = crow(i, hh); const float a = wsf[q];
#pragma unroll
        for (int db = 0; db < 4; ++db) stg[q * 128 + 32 * db + r] = o[db][i] * a; }
    asm volatile("s_waitcnt lgkmcnt(0)" ::: "memory");
}
}

namespace att2 {
constexpr int KCH2 = 1040, VDB2 = 4160, KSL = 16 * KCH2, VSL = 4 * VDB2;
constexpr int OFF_K = 0, OFF_V = 2 * KSL, OFF_STG = OFF_V + 2 * VSL  , OFF_WS = OFF_STG + 8 * 8192  , WSW = 1024, OFF_TAB = OFF_WS + 8 * WSW  ;
static_assert(OFF_TAB + 1028 * 4 <= LDS_BYTES - 64, "attention (partial) LDS map");
using att::crow;

__device__ __forceinline__ void tile_load(const Ctx& F, const unsigned char* K, const unsigned char* V, size_t tokbase, int h, int kt, u32x4& rk, u32x4& rv) {
    const size_t off = (tokbase + 64 * kt + (F.tid >> 3)) * DM + h * DH + (F.tid & 7) * 16;
    rk = *(const u32x4*)(K + off); rv = *(const u32x4*)(V + off);
}
__device__ __forceinline__ void tile_write(const Ctx& F, int slot, const u32x4& rk, const u32x4& rv) {
    const int key = F.tid >> 3, c = 2 * (F.tid & 7);
    LAS unsigned char* kd = F.lds + OFF_K + slot * KSL + c * KCH2 + key * 16;
    *(LAS u32x4*)kd = f8x8_to_bf16x8(rk.x, rk.y); *(LAS u32x4*)(kd + KCH2) = f8x8_to_bf16x8(rk.z, rk.w);
    LAS unsigned char* vd = F.lds + OFF_V + slot * VSL + (c >> 2) * VDB2 + (key >> 3) * 512 + (key & 7) * 64 + (c & 3) * 16;
    *(LAS u32x4*)vd = f8x8_to_bf16x8(rv.x, rv.y); *(LAS u32x4*)(vd + 16) = f8x8_to_bf16x8(rv.z, rv.w);
}
template <bool CAUSAL = false>
__device__ __forceinline__ void tile_compute(const Ctx& F, int slot, const bf16x8 (&qr)[8], f32x16 (&o)[4], float& m, float& l, bool diag = false) {
    const int r = F.lane & 31, hh = F.lane >> 5;
    LAS float* wsf = (LAS float*)(F.lds + OFF_WS + F.wave * WSW);
    LAS const unsigned char* kp = F.lds + OFF_K + slot * KSL + hh * KCH2 + r * 16;
    LAS const unsigned char* vp = F.lds + OFF_V + slot * VSL + (4 * hh + ((F.lane & 15) >> 2)) * 64 + ((F.lane >> 4) & 1) * 32 + (F.lane & 3) * 8;
    f32x16 p0, p1;
#pragma unroll
    for (int i = 0; i < 16; ++i) { p0[i] = 0.f; p1[i] = 0.f; }
    {
        bf16x8 ka[8];
#pragma unroll
        for (int ds = 0; ds < 8; ++ds) ka[ds] = *(LAS const bf16x8*)(kp + 2 * ds * KCH2);
        __builtin_amdgcn_sched_barrier(0);
#pragma unroll
        for (int ds = 0; ds < 8; ++ds) p0 = __builtin_amdgcn_mfma_f32_32x32x16_bf16(ka[ds], qr[ds], p0, 0, 0, 0);
        __builtin_amdgcn_sched_barrier(0);
#pragma unroll
        for (int ds = 0; ds < 8; ++ds) ka[ds] = *(LAS const bf16x8*)(kp + 2 * ds * KCH2 + 512);
        __builtin_amdgcn_sched_barrier(0);
#pragma unroll
        for (int ds = 0; ds < 8; ++ds) p1 = __builtin_amdgcn_mfma_f32_32x32x16_bf16(ka[ds], qr[ds], p1, 0, 0, 0);
        __builtin_amdgcn_sched_barrier(0);
    }
    v4i16_t vl[2][4], vh[2][4];
    const unsigned vaddr = (unsigned)(uintptr_t)vp;
#pragma unroll
    for (int ks = 0; ks < 2; ++ks)
#pragma unroll
        for (int db = 0; db < 4; ++db) { TRR(vl[ks][db], vaddr, db * VDB2 + ks * 1024); TRR(vh[ks][db], vaddr, db * VDB2 + ks * 1024 + 512); }
    __builtin_amdgcn_sched_barrier(0);
    if (CAUSAL && diag) {
        if (F.wave & 1) {
#pragma unroll
            for (int i = 0; i < 16; ++i) p1[i] = (crow(i, hh) > r) ? -INFINITY : p1[i];
        } else {
#pragma unroll
            for (int i = 0; i < 16; ++i) { p0[i] = (crow(i, hh) > r) ? -INFINITY : p0[i]; p1[i] = -INFINITY; }
        }
    }
    float mx = fmaxf(p0[0], p1[0]);
#pragma unroll
    for (int i = 1; i < 16; ++i) mx = fmaxf(mx, fmaxf(p0[i], p1[i]));
    mx = fmaxf(mx, __shfl_xor(mx, 32));
    const float mnew = fmaxf(m, mx);
    if (__any(mx > m + 8.0f)) {
        const float alpha = __builtin_amdgcn_exp2f(m - mnew);
        l *= alpha; m = mnew;
        if (hh == 0) wsf[r] = alpha;
        asm volatile("s_waitcnt lgkmcnt(0)" ::: "memory");
#pragma unroll
        for (int i = 0; i < 16; ++i) { const float a = wsf[crow(i, hh)];
#pragma unroll
            for (int db = 0; db < 4; ++db) o[db][i] *= a; }
    }
    float ls = 0.f;
#pragma unroll
    for (int i = 0; i < 16; ++i) { p0[i] = __builtin_amdgcn_exp2f(p0[i] - m); p1[i] = __builtin_amdgcn_exp2f(p1[i] - m); ls += p0[i] + p1[i]; }
    l += ls;
    u32x4 pw[4];
#pragma unroll
    for (int s2 = 0; s2 < 2; ++s2) {
        pw[s2] = (u32x4){cvt_pk_bf16(p0[8 * s2], p0[8 * s2 + 1]), cvt_pk_bf16(p0[8 * s2 + 2], p0[8 * s2 + 3]), cvt_pk_bf16(p0[8 * s2 + 4], p0[8 * s2 + 5]), cvt_pk_bf16(p0[8 * s2 + 6], p0[8 * s2 + 7])};
        pw[2 + s2] = (u32x4){cvt_pk_bf16(p1[8 * s2], p1[8 * s2 + 1]), cvt_pk_bf16(p1[8 * s2 + 2], p1[8 * s2 + 3]), cvt_pk_bf16(p1[8 * s2 + 4], p1[8 * s2 + 5]), cvt_pk_bf16(p1[8 * s2 + 6], p1[8 * s2 + 7])};
    }
    TRWAIT();
#pragma unroll
    for (int ks = 0; ks < 2; ++ks) {
        const bf16x8 pa = __builtin_bit_cast(bf16x8, pw[ks]);
#pragma unroll
        for (int db = 0; db < 4; ++db) {
            const bf16x8 vf = (bf16x8){vl[ks][db][0], vl[ks][db][1], vl[ks][db][2], vl[ks][db][3], vh[ks][db][0], vh[ks][db][1], vh[ks][db][2], vh[ks][db][3]};
            o[db] = __builtin_amdgcn_mfma_f32_32x32x16_bf16(pa, vf, o[db], 0, 0, 0);
        }
    }
    __builtin_amdgcn_sched_barrier(0);
#pragma unroll
    for (int ks = 0; ks < 2; ++ks)
#pragma unroll
        for (int db = 0; db < 4; ++db) { TRR(vl[ks][db], vaddr, db * VDB2 + (2 + ks) * 1024); TRR(vh[ks][db], vaddr, db * VDB2 + (2 + ks) * 1024 + 512); }
    TRWAIT();
#pragma unroll
    for (int ks = 0; ks < 2; ++ks) {
        const bf16x8 pa = __builtin_bit_cast(bf16x8, pw[2 + ks]);
#pragma unroll
        for (int db = 0; db < 4; ++db) {
            const bf16x8 vf = (bf16x8){vl[ks][db][0], vl[ks][db][1], vl[ks][db][2], vl[ks][db][3], vh[ks][db][0], vh[ks][db][1], vh[ks][db][2], vh[ks][db][3]};
            o[db] = __builtin_amdgcn_mfma_f32_32x32x16_bf16(pa, vf, o[db], 0, 0, 0);
        }
    }
    __builtin_amdgcn_sched_barrier(0);
}
}

#define ATT2_DECODE(item, bhj_, chunk_) do { int lo_ = 0, hi_ = 1023; while (lo_ < hi_) { const int mid_ = (lo_ + hi_ + 1) >> 1; if (P[mid_] <= (item)) lo_ = mid_; else hi_ = mid_ - 1; } bhj_ = lo_; chunk_ = (item) - P[lo_]; } while (0)
__device__ __forceinline__ void ph_attn_partial(const Ctx& F) {
    using namespace att2;
    const unsigned char* Q = F.ws + WS_Q; const unsigned char* K = F.ws + WS_K; const unsigned char* V = F.ws + WS_V;
    const unsigned* LISTS = (const unsigned*)(F.ws + WS_LISTS); const unsigned* LCNT = (const unsigned*)(F.ws + WS_CTL) + CW_LCNT;
    unsigned char* OP = F.ws + WS_OP; float* LSE = (float*)(F.ws + WS_LSE);
    LAS int* P = (LAS int*)(F.lds + OFF_TAB);
    if (F.tid < 64) {
        int c[16]; int s = 0;
#pragma unroll
        for (int i = 0; i < 16; ++i) { c[i] = ((int)__hip_atomic_load(LCNT + F.tid * 16 + i, __ATOMIC_RELAXED, __HIP_MEMORY_SCOPE_AGENT) + 255) >> 8; s += c[i]; }
        int inc = s;
#pragma unroll
        for (int o = 1; o < 64; o <<= 1) { const int t = __shfl_up(inc, o); if (F.lane >= o) inc += t; }
        int run = inc - s;
#pragma unroll
        for (int i = 0; i < 16; ++i) { P[F.tid * 16 + i] = run; run += c[i]; }
        if (F.tid == 63) P[1024] = run;
    }
    __syncthreads();
    const int total = P[1024];
    LAS float* wsf = (LAS float*)(F.lds + OFF_WS + F.wave * WSW);
    LAS int* wsi = (LAS int*)wsf;
    const int r = F.lane & 31, hh = F.lane >> 5;
    int it = F.vcu;
    if (it < total) {
        int bhj, chunk; ATT2_DECODE(it, bhj, chunk);
        int itn = it + F.G, bhjn = 0, chunkn = 0; bool hasn = itn < total; if (hasn) ATT2_DECODE(itn, bhjn, chunkn);
        u32x4 rkA, rvA, rkB, rvB;
        { const int b = bhj >> 7, h = (bhj >> 4) & 7, j = bhj & 15; const size_t tb = (size_t)b * SEQ + j * LBLK;
          tile_load(F, K, V, tb, h, 0, rkA, rvA); tile_load(F, K, V, tb, h, 1, rkB, rvB); tile_write(F, 0, rkA, rvA); tile_write(F, 1, rkB, rvB);
          tile_load(F, K, V, tb, h, 2, rkA, rvA); }
        int cnt = (int)__hip_atomic_load(LCNT + bhj, __ATOMIC_RELAXED, __HIP_MEMORY_SCOPE_AGENT);
        int qi = chunk * 256 + F.wave * 32 + r;
        unsigned ent = LISTS[(size_t)bhj * 4096 + (qi < cnt ? qi : 0)];
        int tq = ent & 4095, slot = (qi < cnt) ? (int)(ent >> 12) : -1;
        u32x2 qraw[8];
        { const unsigned char* qrow = Q + ((size_t)(bhj >> 7) * SEQ + tq) * DM + ((bhj >> 4) & 7) * DH + hh * 8;
#pragma unroll
          for (int ds = 0; ds < 8; ++ds) qraw[ds] = *(const u32x2*)(qrow + ds * 16); }
        unsigned entn = 0u; int cntn = 0;
        __syncthreads();
        int s = 0;
        for (;;) {
            const int b = bhj >> 7, h = (bhj >> 4) & 7, j = bhj & 15;
            bf16x8 qr[8];
#pragma unroll
            for (int ds = 0; ds < 8; ++ds) qr[ds] = __builtin_bit_cast(bf16x8, f8x8_to_bf16x8(qraw[ds].x, qraw[ds].y));
            if (F.lane < 32) { wsi[64 + r] = tq; wsi[96 + r] = slot; }
            f32x16 o[4]; float m = -1e30f, l = 0.f;
#pragma unroll
            for (int db = 0; db < 4; ++db)
#pragma unroll
                for (int i = 0; i < 16; ++i) o[db][i] = 0.f;
#define ATT2_TB(bb) ((size_t)((bb) >> 7) * SEQ + ((bb) & 15) * LBLK)
#define ATT2_H(bb) (((bb) >> 4) & 7)
#pragma unroll 1
            for (int kp2 = 0; kp2 < 2; ++kp2) {
                const int kt = 2 * kp2;
                { const bool cur3 = kt + 3 < 4, have3 = cur3 || hasn, have2 = (kt + 2 < 4) || hasn;
                  if (have3) { const int bb = cur3 ? bhj : bhjn; tile_load(F, K, V, ATT2_TB(bb), ATT2_H(bb), (kt + 3) & 3, rkB, rvB); }
                  if (kt == 0 && hasn) { cntn = (int)__hip_atomic_load(LCNT + bhjn, __ATOMIC_RELAXED, __HIP_MEMORY_SCOPE_AGENT); }
                  if (kt == 2 && hasn) { const unsigned char* qrow = Q + ((size_t)(bhjn >> 7) * SEQ + (entn & 4095)) * DM + ((bhjn >> 4) & 7) * DH + hh * 8;
#pragma unroll
                      for (int ds = 0; ds < 8; ++ds) qraw[ds] = *(const u32x2*)(qrow + ds * 16); }
                  tile_compute(F, 0, qr, o, m, l);
                  asm volatile("s_waitcnt lgkmcnt(0)" ::: "memory"); __builtin_amdgcn_s_barrier(); asm volatile("" ::: "memory");
                  if (have2) tile_write(F, 0, rkA, rvA); }
                { const bool have4 = hasn, have3 = (kt + 3 < 4) || hasn;
                  if (have4) { tile_load(F, K, V, ATT2_TB(bhjn), ATT2_H(bhjn), kt, rkA, rvA); }
                  if (kt == 0 && hasn) { const int qn = chunkn * 256 + F.wave * 32 + r; entn = LISTS[(size_t)bhjn * 4096 + (qn < cntn ? qn : 0)]; }
                  tile_compute(F, 1, qr, o, m, l);
                  asm volatile("s_waitcnt lgkmcnt(0)" ::: "memory"); __builtin_amdgcn_s_barrier(); asm volatile("" ::: "memory");
                  if (have3) tile_write(F, 1, rkB, rvB); }
            }
            const float lt = l + __shfl_xor(l, 32);
            if (hh == 0) { wsf[r] = 1.0f / lt; wsf[32 + r] = m + __builtin_amdgcn_logf(lt); }
            asm volatile("s_waitcnt lgkmcnt(0)" ::: "memory");
            int re = r, he = hh; asm volatile("" : "+v"(re), "+v"(he));
#pragma unroll
            for (int i = 0; i < 16; ++i) {
                const int q = crow(i, he); const float a = wsf[q]; const int t = wsi[64 + q], sl = wsi[96 + q];
                const unsigned w = pack_fp8x4(o[0][i] * a, o[1][i] * a, o[2][i] * a, o[3][i] * a);
                if (sl >= 0) { const size_t row = (((size_t)sl * NB + b) * SEQ + t) * NH + h; *(unsigned*)(OP + row * DH + 4 * re) = w; }
            }
            if (he == 0 && slot >= 0) LSE[(((size_t)slot * NB + b) * SEQ + tq) * NH + h] = wsf[32 + re];
            asm volatile("s_waitcnt lgkmcnt(0)" ::: "memory");
            if (!hasn) break;
            it = itn; bhj = bhjn; chunk = chunkn; cnt = cntn;
            { const int qn = chunk * 256 + F.wave * 32 + r; tq = entn & 4095; slot = (qn < cnt) ? (int)(entn >> 12) : -1; }
            itn = it + F.G; hasn = itn < total; if (hasn) ATT2_DECODE(itn, bhjn, chunkn);
        }
    }
    __syncthreads();
}

__device__ __forceinline__ void ph_attn_own(const Ctx& F) {
    using namespace att2;
    const unsigned char* Q = F.ws + WS_Q; const unsigned char* K = F.ws + WS_K; const unsigned char* V = F.ws + WS_V;
    const unsigned char* OP = F.ws + WS_OP; const float* LSE = (const float*)(F.ws + WS_LSE); bf16_t* YAB = (bf16_t*)(F.ws + WS_YAB);
    LAS float* wsf = (LAS float*)(F.lds + OFF_WS + F.wave * WSW);
    const int r = F.lane & 31, hh = F.lane >> 5;
    constexpr int NIT = NB * NH * NBLK;
    int it = F.vcu;
    if (it < NIT) {
        int itn = it + F.G; bool hasn = itn < NIT;
        u32x4 rkA, rvA, rkB, rvB;
#define OWN_TB(i_) ((size_t)((i_) >> 7) * SEQ + ((i_) & 15) * LBLK)
#define OWN_H(i_) (((i_) >> 4) & 7)
        tile_load(F, K, V, OWN_TB(it), OWN_H(it), 0, rkA, rvA); tile_load(F, K, V, OWN_TB(it), OWN_H(it), 1, rkB, rvB); tile_write(F, 0, rkA, rvA); tile_write(F, 1, rkB, rvB);
        tile_load(F, K, V, OWN_TB(it), OWN_H(it), 2, rkA, rvA);
        u32x2 qraw[8];
        { const unsigned char* qrow = Q + (OWN_TB(it) + F.wave * 32 + r) * DM + OWN_H(it) * DH + hh * 8;
#pragma unroll
          for (int ds = 0; ds < 8; ++ds) qraw[ds] = *(const u32x2*)(qrow + ds * 16); }
        __syncthreads();
        const int wdiag = F.wave >> 1;
        for (;;) {
            const int b = it >> 7, h = (it >> 4) & 7, j = it & 15, t0 = j * LBLK + F.wave * 32;
            bf16x8 qr[8];
#pragma unroll
            for (int ds = 0; ds < 8; ++ds) qr[ds] = __builtin_bit_cast(bf16x8, f8x8_to_bf16x8(qraw[ds].x, qraw[ds].y));
            f32x16 o[4]; float m = -1e30f, l = 0.f;
#pragma unroll
            for (int db = 0; db < 4; ++db)
#pragma unroll
                for (int i = 0; i < 16; ++i) o[db][i] = 0.f;
#pragma unroll 1
            for (int kp2 = 0; kp2 < 2; ++kp2) {
                const int kt = 2 * kp2;
                { const bool cur3 = kt + 3 < 4, have3 = cur3 || hasn, have2 = (kt + 2 < 4) || hasn;
                  if (have3) { const int ii = cur3 ? it : itn; tile_load(F, K, V, OWN_TB(ii), OWN_H(ii), (kt + 3) & 3, rkB, rvB); }
                  if (kt == 2 && hasn) { const unsigned char* qrow = Q + (OWN_TB(itn) + F.wave * 32 + r) * DM + OWN_H(itn) * DH + hh * 8;
#pragma unroll
                      for (int ds = 0; ds < 8; ++ds) qraw[ds] = *(const u32x2*)(qrow + ds * 16); }
                  if (kt <= wdiag) tile_compute<true>(F, 0, qr, o, m, l, kt == wdiag);
                  asm volatile("s_waitcnt lgkmcnt(0)" ::: "memory"); __builtin_amdgcn_s_barrier(); asm volatile("" ::: "memory");
                  if (have2) tile_write(F, 0, rkA, rvA); }
                { const bool have4 = hasn, have3 = (kt + 3 < 4) || hasn;
                  if (have4) { tile_load(F, K, V, OWN_TB(itn), OWN_H(itn), kt, rkA, rvA); }
                  if (kt + 1 <= wdiag) tile_compute<true>(F, 1, qr, o, m, l, kt + 1 == wdiag);
                  asm volatile("s_waitcnt lgkmcnt(0)" ::: "memory"); __builtin_amdgcn_s_barrier(); asm volatile("" ::: "memory");
                  if (have3) tile_write(F, 1, rkB, rvB); }
            }
            const int nv = j < 3 ? j : 3;
            {
                const float lt = l + __shfl_xor(l, 32); const float lse_own = m + __builtin_amdgcn_logf(lt);
                float ls[3];
#pragma unroll
                for (int s2 = 0; s2 < 3; ++s2) ls[s2] = (s2 < nv) ? LSE[(((size_t)s2 * NB + b) * SEQ + t0 + r) * NH + h] : -1e30f;
                const float M = fmaxf(fmaxf(lse_own, ls[0]), fmaxf(ls[1], ls[2]));
                const float w0 = __builtin_amdgcn_exp2f(lse_own - M);
                float w[3], den = w0;
#pragma unroll
                for (int s2 = 0; s2 < 3; ++s2) { w[s2] = (s2 < nv) ? __builtin_amdgcn_exp2f(ls[s2] - M) : 0.f; den += w[s2]; }
                const float inv = 1.0f / den;
                if (hh == 0) { wsf[r] = w0 * inv / lt; wsf[32 + r] = w[0] * inv; wsf[64 + r] = w[1] * inv; wsf[96 + r] = w[2] * inv; }
                asm volatile("s_waitcnt lgkmcnt(0)" ::: "memory");
            }
            int re = r, he = hh; asm volatile("" : "+v"(re), "+v"(he));
            LAS float* stg = (LAS float*)(F.lds + OFF_STG + F.wave * 8192);
            {
                unsigned pv[16][3];
#pragma unroll
                for (int i = 0; i < 16; ++i) { const int q = crow(i, he);
#pragma unroll
                    for (int s2 = 0; s2 < 3; ++s2) { pv[i][s2] = 0u; if (s2 < nv) pv[i][s2] = *(const unsigned*)(OP + ((((size_t)s2 * NB + b) * SEQ + t0 + q) * NH + h) * DH + 4 * re); } }
#pragma unroll
                for (int i = 0; i < 16; ++i) { const int q = crow(i, he); const float a = wsf[q];
                    float x0 = o[0][i] * a, x1 = o[1][i] * a, x2 = o[2][i] * a, x3 = o[3][i] * a;
#pragma unroll
                    for (int s2 = 0; s2 < 3; ++s2) { const float ww = wsf[32 * (s2 + 1) + q]; const f32x2v f0 = __builtin_amdgcn_cvt_pk_f32_fp8((int)pv[i][s2], false), f1 = __builtin_amdgcn_cvt_pk_f32_fp8((int)pv[i][s2], true);
                        x0 += ww * f0.x; x1 += ww * f0.y; x2 += ww * f1.x; x3 += ww * f1.y; }
                    o[0][i] = x0; o[1][i] = x1; o[2][i] = x2; o[3][i] = x3; }
            }
#pragma unroll
            for (int half = 0; half < 2; ++half) {
#pragma unroll
                for (int i = 0; i < 16; ++i) { const int q = crow(i, he); stg[q * 64 + re] = o[2 * half][i]; stg[q * 64 + 32 + re] = o[2 * half + 1][i]; }
                asm volatile("s_waitcnt lgkmcnt(0)" ::: "memory");
#pragma unroll
                for (int ps = 0; ps < 4; ++ps) {
                    const int q = ps * 8 + ((re + 32 * he) >> 3), dc = re & 7;
                    const f32x4 x = *(LAS const f32x4*)(stg + q * 64 + dc * 8), y = *(LAS const f32x4*)(stg + q * 64 + dc * 8 + 4);
                    *(u32x4*)(YAB + ((size_t)b * SEQ + t0 + q) * 2048 + 1024 + h * DH + half * 64 + dc * 8) = (u32x4){cvt_pk_bf16(x.x, x.y), cvt_pk_bf16(x.z, x.w), cvt_pk_bf16(y.x, y.y), cvt_pk_bf16(y.z, y.w)};
                }
                asm volatile("s_waitcnt lgkmcnt(0)" ::: "memory");
            }
            if (!hasn) break;
            it = itn; itn = it + F.G; hasn = itn < NIT;
        }
#undef OWN_TB
#undef OWN_H
    }
    __syncthreads();
}

__device__ __forceinline__ void ph_router(const Ctx& F) {
    const Args& A = *F.a;
    const bf16_t* Z = (const bf16_t*)(F.ws + WS_Z); const float* ZST = (const float*)(F.ws + WS_ZST); bf16_t* H1 = (bf16_t*)(F.ws + WS_H1); unsigned char* H1F8 = F.ws + WS_H1F8;
    int* TKE = (int*)(F.ws + WS_TKE); int* TKP = (int*)(F.ws + WS_TKP); unsigned* ECNT = (unsigned*)(F.ws + WS_CTL) + CW_ECNT; int* RT = (int*)(F.ws + WS_RT); float* RW = (float*)(F.ws + WS_RW);
    const float* wr = A.in[I_WR]; const float* br = A.in[I_BR];
    constexpr int RS = 2064, OFF_LO = 32 * RS, OFF_G = 2 * 32 * RS  , OFF_B = OFF_G + 4096, OFF_LG = OFF_B + 4096  , OFF_CNT = OFF_LG + 8 * 2112  ;
    static_assert(OFF_CNT + 256 <= LDS_BYTES, "router LDS map");
    LAS unsigned char* WH = F.lds; LAS unsigned char* WL = F.lds + OFF_LO;
    LAS float* LG = (LAS float*)(F.lds + OFF_G); LAS float* LB = (LAS float*)(F.lds + OFF_B);
    LAS float* lgt = (LAS float*)(F.lds + OFF_LG + F.wave * 2112);
    LAS unsigned* lcnt = (LAS unsigned*)(F.lds + OFF_CNT);
    {
        f32x4 wa[8], wb[8];
#pragma unroll
        for (int u_ = 0; u_ < 8; ++u_) { const int i = F.tid + 512 * u_, nq = i & 7, k2 = i >> 3;
            wa[u_] = *(const f32x4*)(wr + (size_t)(2 * k2) * NE + 4 * nq); wb[u_] = *(const f32x4*)(wr + (size_t)(2 * k2 + 1) * NE + 4 * nq); }
#pragma unroll
        for (int u_ = 0; u_ < 8; ++u_) { const int i = F.tid + 512 * u_, nq = i & 7, k2 = i >> 3;
#pragma unroll
            for (int c = 0; c < 4; ++c) {
                const float w0 = wa[u_][c], w1 = wb[u_][c];
                const unsigned h0 = f2bf(w0), h1 = f2bf(w1);
                const float r0 = w0 - __uint_as_float(h0 << 16), r1 = w1 - __uint_as_float(h1 << 16);
                *(LAS unsigned*)(WH + (4 * nq + c) * RS + k2 * 4) = h0 | (h1 << 16);
                *(LAS unsigned*)(WL + (4 * nq + c) * RS + k2 * 4) = pk2(r0, r1);
            } }
    }
    for (int i = F.tid; i < DM; i += 512) { LG[i] = A.in[I_LNMIX_G][i]; LB[i] = A.in[I_LNMIX_B][i]; }
    if (F.tid < 64) lcnt[F.tid] = 0u;
    __syncthreads();
    const int fr = F.lane & 15, kg = F.lane >> 4;
    const int ntask = T / 16, NGW = F.G * 8;
    const int rounds = (ntask + NGW - 1) / NGW;
    for (int rd = 0; rd < rounds; ++rd) {
        const int task = rd * NGW + F.vcu * 8 + F.wave;
        const bool live = task < ntask;
        int te[4] = {0, 0, 0, 0}; float tw[4] = {0.f, 0.f, 0.f, 0.f}; unsigned lp[4] = {0, 0, 0, 0};
        if (live) {
            const int tok = task * 16 + fr;
            float mean, rstd;
            { const f32x4* sp = (const f32x4*)(ZST + (size_t)tok * 32); float s1 = 0.f, s2 = 0.f;
#pragma unroll
              for (int i = 0; i < 8; ++i) { const f32x4 v = sp[i]; s1 += v.x + v.z; s2 += v.y + v.w; }
              mean = s1 * (1.f / DM); const float var = s2 * (1.f / DM) - mean * mean; rstd = 1.f / sqrtf(fmaxf(var, 0.f) + LN_EPS); }
            f32x4 acc0 = {0.f, 0.f, 0.f, 0.f}, acc1 = {0.f, 0.f, 0.f, 0.f};
            const bf16_t* zp = Z + (size_t)tok * DM + 8 * kg; unsigned char* h8 = H1F8 + (size_t)tok * DM + 8 * kg;
#pragma unroll 8
            for (int kk = 0; kk < 32; ++kk) {
                const u32x4 zr = *(const u32x4*)(zp + 32 * kk); const f32x4 z0 = {bflo(zr.x), bfhi(zr.x), bflo(zr.y), bfhi(zr.y)}, z1 = {bflo(zr.z), bfhi(zr.z), bflo(zr.w), bfhi(zr.w)};
                const f32x4 g0 = *(LAS const f32x4*)(LG + 32 * kk + 8 * kg), g1 = *(LAS const f32x4*)(LG + 32 * kk + 8 * kg + 4);
                const f32x4 b0 = *(LAS const f32x4*)(LB + 32 * kk + 8 * kg), b1 = *(LAS const f32x4*)(LB + 32 * kk + 8 * kg + 4);
                const f32x4 x0 = (z0 - mean) * rstd * g0 + b0, x1 = (z1 - mean) * rstd * g1 + b1;
                u32x4 hi; hi.x = cvt_pk_bf16(x0.x, x0.y); hi.y = cvt_pk_bf16(x0.z, x0.w); hi.z = cvt_pk_bf16(x1.x, x1.y); hi.w = cvt_pk_bf16(x1.z, x1.w);
                { unsigned w0 = 0u, w1 = 0u;
                  w0 = __builtin_amdgcn_cvt_pk_fp8_f32(x0.x, x0.y, w0, false); w0 = __builtin_amdgcn_cvt_pk_fp8_f32(x0.z, x0.w, w0, true);
                  w1 = __builtin_amdgcn_cvt_pk_fp8_f32(x1.x, x1.y, w1, false); w1 = __builtin_amdgcn_cvt_pk_fp8_f32(x1.z, x1.w, w1, true);
                  *(u32x2*)(h8 + 32 * kk) = (u32x2){w0, w1}; }
                u32x4 lo; lo.x = cvt_pk_bf16(x0.x - bflo(hi.x), x0.y - bfhi(hi.x)); lo.y = cvt_pk_bf16(x0.z - bflo(hi.y), x0.w - bfhi(hi.y));
                lo.z = cvt_pk_bf16(x1.x - bflo(hi.z), x1.y - bfhi(hi.z)); lo.w = cvt_pk_bf16(x1.z - bflo(hi.w), x1.w - bfhi(hi.w));
                const bf16x8 ah = __builtin_bit_cast(bf16x8, hi), al = __builtin_bit_cast(bf16x8, lo);
                const int bo = fr * RS + (32 * kk + 8 * kg) * 2;
                const bf16x8 wh0 = *(LAS const bf16x8*)(WH + bo), wh1 = *(LAS const bf16x8*)(WH + bo + 16 * RS), wl0 = *(LAS const bf16x8*)(WL + bo), wl1 = *(LAS const bf16x8*)(WL + bo + 16 * RS);
                acc0 = __builtin_amdgcn_mfma_f32_16x16x32_bf16(ah, wh0, acc0, 0, 0, 0); acc1 = __builtin_amdgcn_mfma_f32_16x16x32_bf16(ah, wh1, acc1, 0, 0, 0);
                acc0 = __builtin_amdgcn_mfma_f32_16x16x32_bf16(ah, wl0, acc0, 0, 0, 0); acc1 = __builtin_amdgcn_mfma_f32_16x16x32_bf16(ah, wl1, acc1, 0, 0, 0);
                acc0 = __builtin_amdgcn_mfma_f32_16x16x32_bf16(al, wh0, acc0, 0, 0, 0); acc1 = __builtin_amdgcn_mfma_f32_16x16x32_bf16(al, wh1, acc1, 0, 0, 0);
            }
            const float br0 = br[fr], br1 = br[16 + fr];
#pragma unroll
            for (int i = 0; i < 4; ++i) { lgt[(4 * kg + i) * 33 + fr] = acc0[i] + br0; lgt[(4 * kg + i) * 33 + 16 + fr] = acc1[i] + br1; }
            asm volatile("s_waitcnt lgkmcnt(0)" ::: "memory");
            if (F.lane < 16) {
                float lg[NE];
#pragma unroll
                for (int e = 0; e < NE; ++e) lg[e] = lgt[F.lane * 33 + e];
                float tv[4];
#pragma unroll
                for (int r = 0; r < 4; ++r) {
                    float best = -INFINITY; int bi = 0;
#pragma unroll
                    for (int e = 0; e < NE; ++e) { const bool c = lg[e] > best; best = c ? lg[e] : best; bi = c ? e : bi; }
#pragma unroll
                    for (int e = 0; e < NE; ++e) lg[e] = (e == bi) ? -INFINITY : lg[e];
                    te[r] = bi; tv[r] = best;
                }
                const float e1 = __expf(tv[1] - tv[0]), e2 = __expf(tv[2] - tv[0]), e3 = __expf(tv[3] - tv[0]); const float inv = 1.f / (1.f + e1 + e2 + e3);
                tw[0] = inv; tw[1] = e1 * inv; tw[2] = e2 * inv; tw[3] = e3 * inv;
#pragma unroll
                for (int r = 0; r < 4; ++r) lp[r] = atomicAdd((unsigned*)(lcnt + te[r]), 1u);
            }
        }
        __syncthreads();
        if (F.tid < 32) { const unsigned c = lcnt[F.tid]; lcnt[32 + F.tid] = c ? atomicAdd(&ECNT[F.tid], c) : 0u; }
        __syncthreads();
        if (live && F.lane < 16) {
            const size_t tok = (size_t)task * 16 + F.lane;
            int4 pe = {te[0], te[1], te[2], te[3]};
            int4 pp = {(int)(lcnt[32 + te[0]] + lp[0]), (int)(lcnt[32 + te[1]] + lp[1]), (int)(lcnt[32 + te[2]] + lp[2]), (int)(lcnt[32 + te[3]] + lp[3])};
            *(int4*)(TKE + tok * 4) = pe; *(int4*)(TKP + tok * 4) = pp;
#pragma unroll
            for (int r = 0; r < 4; ++r) { const size_t o_ = (size_t)te[r] * T + (r == 0 ? pp.x : r == 1 ? pp.y : r == 2 ? pp.z : pp.w); RT[o_] = (int)tok; RW[o_] = tw[r]; }
        }
        __syncthreads();
        if (F.tid < 32) lcnt[F.tid] = 0u;
        __syncthreads();
    }
}

__device__ __forceinline__ void moe_table(const Ctx& F) {
    const unsigned* ECNT = (const unsigned*)(F.ws + WS_CTL) + CW_ECNT;
    LAS int* tab = (LAS int*)(F.lds + LDS_MOE);
    __syncthreads();
    if (F.tid == 0) {
        int acc = 0;
        for (int e = 0; e < NE; ++e) { const int c = (int)__hip_atomic_load(ECNT + e, __ATOMIC_RELAXED, __HIP_MEMORY_SCOPE_AGENT); tab[32 + e] = acc; acc += (c + 255) / 256 * 256; }
        tab[64] = acc; tab[0] = acc / 256;
    }
    __syncthreads();
    const int ntiles = tab[0];
    for (int i = F.tid; i < ntiles; i += 512) { int e = 0; for (int k = 1; k < NE; ++k) if (i * 256 >= tab[32 + k]) e = k; tab[128 + 2 * i] = e; tab[129 + 2 * i] = i - tab[32 + e] / 256; }
    __syncthreads();
}

__device__ __forceinline__ void ln_stats16(const float* st, int lane, float& mean, float& rstd) {
    float s1 = 0.f, s2 = 0.f;
    if (lane < 16) { const f32x2 p = *(const f32x2*)(st + 2 * lane); s1 = p.x; s2 = p.y; }
    s1 = wave_sum(s1); s2 = wave_sum(s2);
    mean = s1 * (1.f / DM); const float var = s2 * (1.f / DM) - mean * mean; rstd = 1.f / sqrtf(fmaxf(var, 0.f) + LN_EPS);
}
__device__ __forceinline__ void ph_final(const Ctx& F) {
    const Args& A = *F.a;
    const bf16_t* Z = (const bf16_t*)(F.ws + WS_Z); const float* ZST = (const float*)(F.ws + WS_ZST); const unsigned char* YS = F.ws + WS_YS; const int* TKE = (const int*)(F.ws + WS_TKE); const int* TKP = (const int*)(F.ws + WS_TKP);
    const LAS int* tab = (const LAS int*)(F.lds + LDS_MOE);
    const int gw = F.vcu * 8 + F.wave, NGW = F.G * 8;
    f32x4 g2[4], b2[4], g1[4], b1[4];
#pragma unroll
    for (int j = 0; j < 4; ++j) { g2[j] = *((const f32x4*)A.in[I_LNF_G] + F.lane + 64 * j); b2[j] = *((const f32x4*)A.in[I_LNF_B] + F.lane + 64 * j);
        g1[j] = *((const f32x4*)A.in[I_LNMIX_G] + F.lane + 64 * j) * ALPHA; b1[j] = *((const f32x4*)A.in[I_LNMIX_B] + F.lane + 64 * j) * ALPHA; }
    for (int m = gw; m < T; m += NGW) {
        float mean, rstd; ln_stats16(ZST + (size_t)m * 32, F.lane, mean, rstd);
        const u32x2* hr = (const u32x2*)(Z + (size_t)m * DM) + F.lane;
        f32x4 v[4];
#pragma unroll
        for (int j = 0; j < 4; ++j) { const u32x2 hb = hr[64 * j]; v[j] = ((f32x4){bflo(hb.x), bfhi(hb.x), bflo(hb.y), bfhi(hb.y)} - mean) * rstd * g1[j] + b1[j]; }
#pragma unroll
        for (int k = 0; k < 4; ++k) {
            const int row = tab[32 + TKE[(size_t)m * 4 + k]] + TKP[(size_t)m * 4 + k]; const unsigned* yr = (const unsigned*)(YS + (size_t)row * DM) + F.lane;
#pragma unroll
            for (int j = 0; j < 4; ++j) { const unsigned y = yr[64 * j]; const f32x2v f0 = __builtin_amdgcn_cvt_pk_f32_fp8((int)y, false), f1 = __builtin_amdgcn_cvt_pk_f32_fp8((int)y, true);
                v[j].x += 0.0625f * f0.x; v[j].y += 0.0625f * f0.y; v[j].z += 0.0625f * f1.x; v[j].w += 0.0625f * f1.y; }
        }
        float s = 0.f;
#pragma unroll
        for (int j = 0; j < 4; ++j) s += (v[j].x + v[j].y) + (v[j].z + v[j].w);
        const float mu = wave_sum(s) * (1.f / DM); float s2 = 0.f;
#pragma unroll
        for (int j = 0; j < 4; ++j) { v[j] = v[j] - mu; s2 += (v[j].x * v[j].x + v[j].y * v[j].y) + (v[j].z * v[j].z + v[j].w * v[j].w); }
        const float rs = 1.f / sqrtf(wave_sum(s2) * (1.f / DM) + LN_EPS);
        f32x4* orow = (f32x4*)(A.out + (size_t)m * DM) + F.lane;
#pragma unroll
        for (int j = 0; j < 4; ++j) orow[64 * j] = v[j] * rs * g2[j] + b2[j];
    }
}

#define XB_TMO      128
#define XB_XCNT(j)  (256  + 64 * (j))
#define XB_XSUB(j)  (1280 + 64 * (j))
#define XB_XGEN(j)  (2304 + 64 * (j))
#define XB_TOP      3328
#define XB_TOPGEN   3392
#define XCD_BAR_WORDS 3456
#define XB_SPIN_CAP (1u << 18)
__device__ __forceinline__ unsigned xb_ld(unsigned* p)              { return __hip_atomic_load(p, __ATOMIC_RELAXED, __HIP_MEMORY_SCOPE_AGENT); }
__device__ __forceinline__ unsigned xb_add(unsigned* p, unsigned v) { return __hip_atomic_fetch_add(p, v, __ATOMIC_RELAXED, __HIP_MEMORY_SCOPE_AGENT); }
__device__ __forceinline__ unsigned xb_xcc_id() { return (unsigned)__builtin_amdgcn_s_getreg((3 << 11) | 20) & 0xFu; }
#define XB_SPIN(cond, bar) do { unsigned _sp = 0; while (cond) { __builtin_amdgcn_s_sleep(1); \
    if ((++_sp & 255u) == 0u) { if (xb_ld(&(bar)[XB_TMO])) break; if (_sp > XB_SPIN_CAP) { atomicAdd(&(bar)[XB_TMO], 1u); break; } } } } while (0)
__device__ __forceinline__ void xcd_barrier_complete(unsigned* bar, unsigned x, unsigned& nloc, unsigned& nx) {
    const unsigned G = gridDim.x * gridDim.y * gridDim.z;
    unsigned sum, cnt, mine, sp = 0u;
    for (;;) {
        sum = 0u; cnt = 0u; mine = 0u;
#pragma unroll
        for (unsigned j = 0; j < 16; ++j) { const unsigned c = xb_ld(&bar[XB_XCNT(j)]); sum += c; cnt += (c > 0u) ? 1u : 0u; mine = (j == x) ? c : mine; }
        if (sum == G) break;
        __builtin_amdgcn_s_sleep(1);
        if ((++sp & 255u) == 0u) { if (xb_ld(&bar[XB_TMO])) break; if (sp > XB_SPIN_CAP) { atomicAdd(&bar[XB_TMO], 1u); break; } }
    }
    nloc = mine > 0u ? mine : 1u; nx = cnt > 0u ? cnt : 1u;
}
__device__ __forceinline__ void xcd_barrier(unsigned* bar, volatile LAS unsigned* st, unsigned x, bool leader_thread) {
    asm volatile("s_waitcnt vmcnt(0)" ::: "memory");
    __syncthreads();
    if (leader_thread) {
        __builtin_amdgcn_s_waitcnt(0);
        unsigned nloc = st[0], nx = st[1];
        if (nloc == 0u) { xcd_barrier_complete(bar, x, nloc, nx); st[0] = nloc; st[1] = nx; }
        const unsigned old = xb_add(&bar[XB_XSUB(x)], 1u);
        const unsigned gen = old / nloc;
        if (old + 1u == (gen + 1u) * nloc) {
            __builtin_amdgcn_fence(__ATOMIC_RELEASE, "agent");
            asm volatile("s_waitcnt vmcnt(0)" ::: "memory");
            const unsigned og = xb_add(&bar[XB_TOP], 1u);
            const unsigned tg = og / nx;
            if (og + 1u == (tg + 1u) * nx) xb_add(&bar[XB_TOPGEN], 1u);
            else XB_SPIN(xb_ld(&bar[XB_TOPGEN]) == tg, bar);
            __builtin_amdgcn_fence(__ATOMIC_ACQUIRE, "agent");
            xb_add(&bar[XB_XGEN(x)], 1u);
            asm volatile("s_waitcnt vmcnt(0)" ::: "memory");
        } else {
            XB_SPIN(xb_ld(&bar[XB_XGEN(x)]) == gen, bar);
            __builtin_amdgcn_fence(__ATOMIC_ACQUIRE, "agent");
            asm volatile("s_waitcnt vmcnt(0)" ::: "memory");
        }
    }
    __syncthreads();
}

template <bool COOP>
__global__ void __launch_bounds__(512, 2) mega(Args args) {
    extern __shared__ __attribute__((aligned(16))) unsigned char lds_raw[];
    Ctx F;
    const int wave0 = __builtin_amdgcn_readfirstlane(threadIdx.x >> 6);
#define MKCTX() do { F.a = &args; F.ws = args.ws; F.lds = (LAS unsigned char*)lds_raw; F.ldsg = lds_raw; F.lane = lane_id_asm(); F.wave = wave0; F.tid = wave0 * 64 + F.lane; \
    F.G = gridDim.x; { const int bx = blockIdx.x; F.vcu = (F.G % 8 == 0) ? (bx % 8) * (F.G / 8) + bx / 8 : bx; } } while (0)
    MKCTX();
    const int lo = args.ph_lo, hi = args.ph_hi;
    unsigned char* ws = args.ws;
#ifndef PHMASK
#define PHMASK 0xFFFF
#endif
#define IN(k) (((PHMASK >> (k)) & 1) && lo <= (k) && (k) < hi)
    unsigned* barw = (unsigned*)(ws + WS_CTL) + CW_BAR; volatile LAS unsigned* bst = (volatile LAS unsigned*)((LAS unsigned char*)lds_raw + LDS_BYTES - 64);
    const unsigned my_xcc = xb_xcc_id();
    if (COOP) { if (threadIdx.x == 0) { bst[0] = 0u; bst[1] = 0u; (void)xb_add(&barw[XB_XCNT(my_xcc)], 1u); } __syncthreads(); }
#define SEAM(k) do { if (COOP && IN(k) && IN((k) + 1)) { if (args.ph_hi > 1000) cg::this_grid().sync();   xcd_barrier(barw, bst, my_xcc, wave0 == 0 && lane_id_asm() == 0); } } while (0)
    if (IN(0)) { MKCTX(); ph_prologue(F); } SEAM(0);
    if (IN(1)) {
        {
            pg8::Gemm g{(const bf16_t*)(ws + WS_H0), (const bf16_t*)(ws + WS_WIN), DM, DM, DM, nullptr}; pg8::StaticOrder S; S.init(T, (PN8_LO + 28 - PN8_HI) * 256, F.G, (int)blockIdx.x, 0, PN8_LO, PN8_HI - PN8_LO);
            const pg8::Epi1 E{(bf16_t*)(ws + WS_YAB), (bf16_t*)(ws + WS_GV), ws + WS_Q, ws + WS_K, ws + WS_V, (bf16_t*)(ws + WS_SA), (bf16_t*)(ws + WS_SB), (float*)(ws + WS_GVST), (float*)(ws + WS_KMEAN), 1.0f, 0.f};
            pg8::gemm_phase<pg8::Epi1, pg8::StaticOrder, true>(F.lds, g, S, E, wave0);
        }
        {
            const pg8::Epi1 E{(bf16_t*)(ws + WS_YAB), (bf16_t*)(ws + WS_GV), ws + WS_Q, ws + WS_K, ws + WS_V, (bf16_t*)(ws + WS_SA), (bf16_t*)(ws + WS_SB), (float*)(ws + WS_GVST), (float*)(ws + WS_KMEAN), 0.03125f, 0.f};
            pg8::Gemm g{(const bf16_t*)(ws + WS_H0F8), (const bf16_t*)(ws + WS_WIN8), DM / 2, DM / 2, DM / 2, nullptr}; pg8::StaticOrder S; S.init(T, (PN8_HI - PN8_LO) * 256, F.G, (int)blockIdx.x, PN8_LO);
            pg8::gemm_phase<pg8::Epi1, pg8::StaticOrder, true, true>(F.lds, g, S, E, wave0);
        }
    } SEAM(1);
    if (IN(2)) { MKCTX(); ph_mixer_a(F); __syncthreads(); ph_gate(F); } SEAM(2);
    if (IN(3)) { } if (COOP && IN(3) && IN(4)) { }
    if (IN(4)) { MKCTX(); ph_attn_partial(F); } SEAM(4);
    if (IN(5)) { MKCTX(); ph_attn_own(F); } SEAM(5);
    if (IN(6)) {
        pg8::Gemm g{(const bf16_t*)(ws + WS_YAB), (const bf16_t*)(ws + WS_WAB), 2048, 2048, 2048, nullptr}; pg8::StaticOrder S; S.init(T, DM, F.G, (int)blockIdx.x);
        pg8::Epi2 E{ws + WS_SA, ws + WS_SB, (bf16_t*)(ws + WS_MG)};
        pg8::gemm_phase<pg8::Epi2, pg8::StaticOrder, true>(F.lds, g, S, E, wave0);
    } SEAM(6);
    if (IN(7)) {
        pg8::Gemm g{(const bf16_t*)(ws + WS_MG), (const bf16_t*)(ws + WS_WOUT), DM, DM, DM, nullptr}; pg8::StaticOrder S; S.init(T, DM, F.G, (int)blockIdx.x);
        pg8::Epi3 E{(const bf16_t*)(ws + WS_H0), (bf16_t*)(ws + WS_Z), (float*)(ws + WS_ZST)};
        pg8::gemm_phase<pg8::Epi3, pg8::StaticOrder, true>(F.lds, g, S, E, wave0);
    } SEAM(7);
    if (IN(8)) { MKCTX(); ph_router(F); } SEAM(8);
    if (IN(9)) { } if (COOP && IN(9) && IN(10)) { }
    if (IN(10)) {
        MKCTX(); moe_table(F);
        pg8::Gemm g{(const bf16_t*)(ws + WS_H1F8), (const bf16_t*)(ws + WS_WUP), DM / 2, DM / 2, DM / 2, (const int*)(ws + WS_RT)}; pg8::MoeOrder S;   S.init((const LAS int*)(F.lds + LDS_MOE), 8, F.G, (int)blockIdx.x);
        pg8::Epi4 E{args.in[I_BUP], ws + WS_ACT};
        pg8::gemm_phase<pg8::Epi4, pg8::MoeOrder, true, true, true>(F.lds, g, S, E, wave0);
    } SEAM(10);
    if (IN(11)) {
        MKCTX(); moe_table(F);
        pg8::Gemm g{(const bf16_t*)(ws + WS_ACT), (const bf16_t*)(ws + WS_WDN), FF / 2, FF / 2, FF / 2, nullptr}; pg8::MoeOrder S; S.init((const LAS int*)(F.lds + LDS_MOE), 4, F.G, (int)blockIdx.x);
        pg8::Epi5 E{args.in[I_BDN], (const float*)(ws + WS_RW), ws + WS_YS};
        pg8::gemm_phase<pg8::Epi5, pg8::MoeOrder, true, true>(F.lds, g, S, E, wave0);
    } SEAM(11);
    if (IN(12)) { MKCTX(); moe_table(F); ph_final(F); }
#undef IN
#undef SEAM
}

extern "C" void kernel_launch(void* const* d_in, const int* in_sizes, int n_in, void* d_out, int out_size, void* d_ws, size_t ws_size, hipStream_t stream) {
    static int grid = 0;
    if (grid == 0) {
        if (n_in != 21 || in_sizes[0] != T * DM || out_size != T * DM || ws_size < WS_END) { fprintf(stderr, "kernel_launch: unexpected shapes (n_in %d, in0 %d, out %d, ws %zu)\n", n_in, n_in > 0 ? in_sizes[0] : -1, out_size, ws_size); grid = -1; return; }
        int dev = 0, cus = 0, per_cu = 0;
        hipGetDevice(&dev); hipDeviceGetAttribute(&cus, hipDeviceAttributeMultiprocessorCount, dev);
        const void* fn = MK_COOP ? (const void*)mega<true> : (const void*)mega<false>;
        hipFuncSetAttribute(fn, hipFuncAttributeMaxDynamicSharedMemorySize, LDS_BYTES);
        hipOccupancyMaxActiveBlocksPerMultiprocessor(&per_cu, fn, 512, LDS_BYTES);
        (void)hipGetLastError();
        if (per_cu < 1) { fprintf(stderr, "kernel_launch: occupancy query says %d blocks/CU\n", per_cu); per_cu = 1; }
        grid = cus * 1;
    }
    if (grid < 0) return;
    hipMemsetAsync((char*)d_ws + WS_CTL, 0, CTL_ZERO_BYTES, stream);
    Args a{};
    for (int i = 0; i < 21; ++i) a.in[i] = (const float*)d_in[i];
    a.out = (float*)d_out; a.ws = (unsigned char*)d_ws;
#if MK_COOP
    a.ph_lo = 0; a.ph_hi = NPHASE;
    void* kargs[] = {&a};
    hipError_t e = hipLaunchCooperativeKernel((const void*)mega<true>, dim3(grid), dim3(512), kargs, LDS_BYTES, stream);
    if (e != hipSuccess) fprintf(stderr, "cooperative launch failed: %s (grid %d)\n", hipGetErrorString(e), grid);
#else
    for (int p = 0; p < NPHASE; ++p) { a.ph_lo = p; a.ph_hi = p + 1; hipLaunchKernelGGL(mega<false>, dim3(grid), dim3(512), LDS_BYTES, stream, a); }
#endif
}
```

```cpp
#include <hip/hip_runtime.h>
#include <hip/hip_cooperative_groups.h>
#include <cstdio>
#include <cstdint>
namespace cg = cooperative_groups;

#ifndef MK_COOP
#define MK_COOP 1
#endif

#define LAS __attribute__((address_space(3)))
typedef unsigned short bf16_t;
typedef short bf16x8 __attribute__((ext_vector_type(8)));
typedef float f32x4 __attribute__((ext_vector_type(4)));
typedef float f32x2 __attribute__((ext_vector_type(2)));
typedef unsigned u32x4 __attribute__((ext_vector_type(4)));
typedef unsigned u32x2 __attribute__((ext_vector_type(2)));

constexpr int NB = 8, SEQ = 4096, DM = 1024, T = NB * SEQ;
constexpr int NH = 8, DH = 128, LBLK = 256, NBLK = SEQ / LBLK;
constexpr int NE = 32, TOPK = 4, FF = 1024;
constexpr int INCOLS = 7 * DM;
constexpr int RMAX = T * TOPK + NE * 256;
constexpr float LN_EPS = 1e-5f;
constexpr float ALPHA = 1.189207115002721f;
constexpr float QSCALE = 0.08838834764831845f * 1.4426950408889634f;

constexpr size_t MiB = 1u << 20, U64 = 64 * MiB;
constexpr size_t WS_CTL = 0, CTL_ZERO_BYTES = 1 * MiB;
constexpr int CW_ECNT = 64;
constexpr int CW_LCNT = 1024;
constexpr int CW_BAR = 4096;
constexpr size_t WS_KMEAN = 1 * MiB;
constexpr size_t WS_GVST = 2 * MiB;
constexpr size_t WS_ZST = 6 * MiB;
constexpr size_t WS_SEL = 10 * MiB;
constexpr size_t WS_TKE = 11 * MiB;
constexpr size_t WS_TKW = 11 * MiB + 512 * 1024;
constexpr size_t WS_TKP = 12 * MiB;
constexpr size_t WS_ROWOF = 12 * MiB + 512 * 1024;
constexpr size_t WS_ROWTOK = 13 * MiB;
constexpr size_t WS_ROWW = 14 * MiB;
constexpr size_t WS_TILE = 15 * MiB;
constexpr size_t WS_LISTS = 16 * MiB;
constexpr size_t WS_LSE = 32 * MiB;
constexpr size_t WS_RT = 16 * MiB;
constexpr size_t WS_RW = 20 * MiB;
constexpr int LDS_MOE = 131072 + 1024;
constexpr size_t WS_WIN = 40 * MiB;
constexpr size_t WS_WAB = 54 * MiB;
constexpr size_t WS_WOUT = 58 * MiB;
constexpr size_t WS_WDN = 60 * MiB;
constexpr size_t WS_WUP = 124 * MiB;
constexpr size_t WS_H0 = 4 * U64;
constexpr size_t WS_YAB = 5 * U64;
constexpr size_t WS_GV = 7 * U64;
constexpr size_t WS_Q = 8 * U64, WS_K = 9 * U64, WS_V = 10 * U64, WS_SA = 11 * U64, WS_SB = 12 * U64;
constexpr size_t WS_OP = 13 * U64;
constexpr size_t WS_MG = WS_GV;
constexpr size_t WS_Z = 14 * U64;
constexpr size_t WS_H1 = WS_H0;
constexpr size_t WS_XG = 5 * U64;
constexpr size_t WS_H1F8 = 12 * U64;
constexpr size_t WS_ACT = 9 * U64 + 16 * MiB;
constexpr size_t WS_YS = WS_XG;
constexpr size_t WS_H0F8 = 13 * U64;
constexpr size_t WS_WIN8 = 192 * MiB;
constexpr int PN8_LO = 8, PN8_HI = 28;
constexpr size_t WS_END = 16 * U64;
static_assert(WS_XG + (size_t)RMAX * 2048 <= WS_ACT && WS_ACT + (size_t)RMAX * 2048 <= WS_Z, "ws map");

constexpr int LDS_BYTES = 163840;
constexpr int LDS_MISC = 131072;
constexpr int NPHASE = 13;

__device__ __forceinline__ float bf2f(bf16_t v) { return __uint_as_float((unsigned)v << 16); }
__device__ __forceinline__ float bflo(unsigned u) { return __uint_as_float(u << 16); }
__device__ __forceinline__ float bfhi(unsigned u) { return __uint_as_float(u & 0xffff0000u); }
__device__ __forceinline__ unsigned f2bf(float f) { unsigned u = __builtin_bit_cast(unsigned, f); return (u + 0x7fffu + ((u >> 16) & 1u)) >> 16; }
__device__ __forceinline__ unsigned pk2(float lo, float hi) { return f2bf(lo) | (f2bf(hi) << 16); }
typedef __bf16 bf16x2_t __attribute__((ext_vector_type(2)));
__device__ __forceinline__ unsigned cvt_pk_bf16(float lo, float hi) { f32x2 v = {lo, hi}; bf16x2_t b = __builtin_convertvector(v, bf16x2_t); return __builtin_bit_cast(unsigned, b); }
__device__ __forceinline__ int lane_id_asm() { int l; asm volatile("v_mbcnt_lo_u32_b32 %0, -1, 0\n\tv_mbcnt_hi_u32_b32 %0, -1, %0" : "=v"(l)); return l; }
__device__ __forceinline__ float wave_sum(float v) {
#pragma unroll
    for (int o = 1; o < 64; o <<= 1) v += __shfl_xor(v, o);
    return v;
}
__device__ __forceinline__ float wave_max(float v) {
#pragma unroll
    for (int o = 1; o < 64; o <<= 1) v = fmaxf(v, __shfl_xor(v, o));
    return v;
}
__device__ __forceinline__ f32x2 gelu_pk(f32x2 v) {
    const f32x2 av = __builtin_elementwise_abs(v), d = av * 0.2316418882f + 1.0f;
    f32x2 t; t.x = __builtin_amdgcn_rcpf(d.x); t.y = __builtin_amdgcn_rcpf(d.y);
    f32x2 q = t * 0.5307027145f + (-0.7265760135f); q = q * t + 0.7107068705f; q = q * t + (-0.142248368f); q = q * t + 0.127414796f; q = q * t;
    const f32x2 s = (v * v) * (-0.72134752044f);
    f32x2 e; e.x = __builtin_amdgcn_exp2f(s.x); e.y = __builtin_amdgcn_exp2f(s.y);
    const f32x2 m = v * (q * e), r = v - m;
    f32x2 o; o.x = v.x < 0.f ? m.x : r.x; o.y = v.y < 0.f ? m.y : r.y; return o;
}
typedef float f32x2v __attribute__((ext_vector_type(2)));
template <bool HI> __device__ __forceinline__ unsigned f8x2_to_bf16x2(unsigned w) { const f32x2v f = __builtin_amdgcn_cvt_pk_f32_fp8((int)w, HI); return cvt_pk_bf16(f.x, f.y); }
__device__ __forceinline__ u32x4 f8x8_to_bf16x8(unsigned lo, unsigned hi) { return (u32x4){f8x2_to_bf16x2<false>(lo), f8x2_to_bf16x2<true>(lo), f8x2_to_bf16x2<false>(hi), f8x2_to_bf16x2<true>(hi)}; }
__device__ __forceinline__ unsigned pack_fp8x4(float a, float b, float c, float d) { unsigned w = 0u; w = __builtin_amdgcn_cvt_pk_fp8_f32(a, b, w, false); w = __builtin_amdgcn_cvt_pk_fp8_f32(c, d, w, true); return w; }
__device__ __forceinline__ float sigmoidf_(float x) { return __builtin_amdgcn_rcpf(1.0f + __builtin_amdgcn_exp2f(-1.4426950408889634f * x)); }

namespace pg8 {
constexpr int BM = 256, BK = 64, HALF = 128, HTB = HALF * BK * 2, STAGE_BYTES = 8 * HTB, NXCD = 8, WGM = 8;
__host__ __device__ __forceinline__ int lds_byte(int r, int c) { const int st = (r >> 4) * 2 + (c >> 5), rr = r & 15, cc = c & 31, ob = rr * 64 + cc * 2; return st * 1024 + (ob ^ (((ob >> 9) & 1) << 5)); }
__host__ __device__ __forceinline__ void stage_rc(int b, int& R, int& C) { const int st = b / 1024, sb = b % 1024, swz = sb ^ (((sb >> 9) & 1) << 5); R = (st >> 1) * 16 + swz / 64; C = (st & 1) * 32 + (swz % 64) / 2; }
__host__ __device__ __forceinline__ int perm32(int rho) { const int n = rho >> 4, i = rho & 15; return 8 * (i >> 2) + 4 * n + (i & 3); }

struct Unit { int pm, pn, bt, rbase; };
struct Gemm { const bf16_t* A; const bf16_t* Bt; int K, lda, ldb; const int* rowidx; };

struct StaticOrder {
    int nM, nN, nwg, G, c, pbase, psplit, pjump;
    __device__ void init(int M, int N, int G_, int c_, int pbase_ = 0, int psplit_ = 1 << 20, int pjump_ = 0) { nM = M / BM; nN = N / BM; nwg = nM * nN; G = G_; c = c_; pbase = pbase_; psplit = psplit_; pjump = pjump_; }
    __device__ bool next(int i, Unit& u) const {
        const long L = (long)i * G + c; if (L >= nwg) return false;
        int wgid = (int)L; { const int q = nwg / NXCD, r = nwg % NXCD, xcd = wgid % NXCD, off = wgid / NXCD; wgid = (xcd < r ? xcd * (q + 1) : r * (q + 1) + (xcd - r) * q) + off; }
        const int nig = WGM * nN, gid = wgid / nig, fm = gid * WGM, gsz = (nM - fm) < WGM ? (nM - fm) : WGM;
        u.pm = fm + ((wgid % nig) % gsz); const int p = (wgid % nig) / gsz; u.pn = pbase + (p < psplit ? p : p + pjump); u.bt = u.pn; u.rbase = u.pm * BM; return true;
    }
};
struct MoeOrder {
    int nM, nN, nwg, G, c; const LAS int* tab;
    __device__ void init(const LAS int* tiletab, int nN_, int G_, int c_) { nM = tiletab[0]; tab = tiletab; nN = nN_; nwg = nM * nN; G = G_; c = c_; }
    __device__ bool next(int i, Unit& u) const {
        const long L = (long)i * G + c; if (L >= nwg) return false;
        int wgid = (int)L; { const int q = nwg / NXCD, r = nwg % NXCD, xcd = wgid % NXCD, off = wgid / NXCD; wgid = (xcd < r ? xcd * (q + 1) : r * (q + 1) + (xcd - r) * q) + off; }
        const int nig = WGM * nN, gid = wgid / nig, fm = gid * WGM, gsz = (nM - fm) < WGM ? (nM - fm) : WGM;
        u.pm = fm + ((wgid % nig) % gsz); u.pn = (wgid % nig) / gsz; { const int e = tab[128 + 2 * u.pm], tl = tab[129 + 2 * u.pm]; u.bt = e * nN + u.pn; u.rbase = e * T + tl * BM; } return true;
    }
};

typedef int v4i_t __attribute__((ext_vector_type(4)));
typedef int v8i_t __attribute__((ext_vector_type(8)));
template <class Epi, class Sched, bool ALIGN_EPI, bool FP8 = false, bool GATHER = false>
__device__ __forceinline__ void gemm_phase(LAS unsigned char* lds, const Gemm g, const Sched& S, const Epi& E, const int wid) {
    const int lane = lane_id_asm(), tid = wid * 64 + lane;
    const int wr = wid >> 2, wc = wid & 3, fr = lane & 15, fq = lane >> 4;
    const int nt = g.K / BK;
    unsigned voffA[2], voffB[2]; int gR[2];
#pragma unroll
    for (int i = 0; i < 2; ++i) { int R, C; stage_rc(tid * 16 + i * 8192, R, C); const int Rb = Epi::PERM ? ((R & ~31) + perm32(R & 31)) : R;
        voffA[i] = GATHER ? (unsigned)C * 2u : (unsigned)(R * g.lda + C) * 2u; voffB[i] = (unsigned)(Rb * g.ldb + C) * 2u; gR[i] = R; }
    const size_t kstep = (size_t)(BK * 2);
    const size_t hstepA = GATHER ? 0 : (size_t)HALF * g.lda * 2, hstepB = (size_t)HALF * g.ldb * 2;
    const size_t tstepA = 2 * hstepA, tstepB = 2 * hstepB;
    const unsigned ldsw = (unsigned)wid * 1024u;
    const int aoff = lds_byte(wr * 64 + fr, fq * 8), boff = lds_byte(wc * 32 + fr, fq * 8);
#define PG8_SA(b, h) (((b) * 2 + (h)) * HTB)
#define PG8_SB(b, h) ((4 + (b) * 2 + (h)) * HTB)
#define PG8_STAGE(bufoff, gbase, voff) do { _Pragma("unroll") for (int _i = 0; _i < 2; ++_i) \
        __builtin_amdgcn_global_load_lds((const unsigned*)((const char*)(gbase) + (voff)[_i]), (LAS unsigned*)(lds + (bufoff) + ldsw + _i * 8192), 16, 0, 0); } while (0)
#define PG8_LD8(p) __builtin_shufflevector(*(const LAS v4i_t*)(p), *(const LAS v4i_t*)((p) + 1024), 0, 1, 2, 3, 4, 5, 6, 7)
#define PG8_LDA(dst, b, h) do { _Pragma("unroll") for (int m = 0; m < 4; ++m) { if constexpr (FP8) dst##8[m] = PG8_LD8(lds + PG8_SA(b, h) + aoff + m * 2048); \
        else { _Pragma("unroll") for (int k = 0; k < 2; ++k) dst[m][k] = *(const LAS bf16x8*)(lds + PG8_SA(b, h) + aoff + m * 2048 + k * 1024); } } } while (0)
#define PG8_LDB(dst, b, h) do { _Pragma("unroll") for (int n = 0; n < 2; ++n) { if constexpr (FP8) dst##8[n] = PG8_LD8(lds + PG8_SB(b, h) + boff + n * 2048); \
        else { _Pragma("unroll") for (int k = 0; k < 2; ++k) dst[n][k] = *(const LAS bf16x8*)(lds + PG8_SB(b, h) + boff + n * 2048 + k * 1024); } } } while (0)
#define PG8_MMA(ai, bj, At, Bt) do { __builtin_amdgcn_s_setprio(1); _Pragma("unroll") for (int m = 0; m < 4; ++m) _Pragma("unroll") for (int n = 0; n < 2; ++n) { \
        if constexpr (FP8) { asm volatile("s_nop 1\n\tv_mfma_scale_f32_16x16x128_f8f6f4 %0, %1, %2, %0, %3, %3 op_sel_hi:[0,0,0]" : "+v"(acc[ai][bj][m][n]) : "v"(Bt##8[n]), "v"(At##8[m]), "v"(scl8)); } \
        else { _Pragma("unroll") for (int k = 0; k < 2; ++k) acc[ai][bj][m][n] = __builtin_amdgcn_mfma_f32_16x16x32_bf16(Bt[n][k], At[m][k], acc[ai][bj][m][n], 0, 0, 0); } } \
        __builtin_amdgcn_s_setprio(0); } while (0)
#define PG8_WAIT_V(n) asm volatile("s_waitcnt vmcnt(" #n ")" ::: "memory")
#define PG8_WAIT_L(n) asm volatile("s_waitcnt lgkmcnt(" #n ")" ::: "memory")
#define PG8_BAR __builtin_amdgcn_s_barrier()
#define PG8_SCHED __builtin_amdgcn_sched_barrier(0)
    Unit cur, nxt; int ui = 0;
    if (!S.next(0, cur)) return;
    unsigned va0[2], va1[2], vn0[2], vn1[2];
#define PG8_GIDX(dst0, dst1, u) do { if constexpr (GATHER) { _Pragma("unroll") for (int _i = 0; _i < 2; ++_i) { \
        dst0[_i] = min((unsigned)g.rowidx[(u).rbase + gR[_i]], (unsigned)(T - 1)) * (unsigned)(g.lda * 2) + voffA[_i]; dst1[_i] = min((unsigned)g.rowidx[(u).rbase + HALF + gR[_i]], (unsigned)(T - 1)) * (unsigned)(g.lda * 2) + voffA[_i]; } } \
        else { _Pragma("unroll") for (int _i = 0; _i < 2; ++_i) { dst0[_i] = voffA[_i]; dst1[_i] = voffA[_i]; } } } while (0)
    PG8_GIDX(va0, va1, cur);
    f32x4 acc[2][2][4][2];
#pragma unroll
    for (int a = 0; a < 2; ++a)
#pragma unroll
        for (int b = 0; b < 2; ++b)
#pragma unroll
            for (int m = 0; m < 4; ++m)
#pragma unroll
                for (int n = 0; n < 2; ++n) acc[a][b][m][n] = (f32x4){0.f, 0.f, 0.f, 0.f};
    bf16x8 At[4][2], B0[2][2], B1[2][2]; v8i_t At8[4], B08[2], B18[2];
    int scl8 = 0x7f7f7f7f; asm volatile("" : "+v"(scl8));
    const char* cA = (const char*)g.A + (GATHER ? 0 : (size_t)cur.pm * tstepA); const char* cB = (const char*)g.Bt + (size_t)cur.bt * tstepB;
    PG8_STAGE(PG8_SB(0, 0), cB, voffB); PG8_STAGE(PG8_SB(0, 1), cB + hstepB, voffB); PG8_STAGE(PG8_SA(0, 0), cA, va0); PG8_STAGE(PG8_SA(0, 1), cA + hstepA, va1);
    if (wr == 1) PG8_BAR;
    PG8_WAIT_V(2); PG8_BAR;
    PG8_STAGE(PG8_SB(1, 0), cB + kstep, voffB); PG8_STAGE(PG8_SA(1, 0), cA + kstep, va0); PG8_STAGE(PG8_SB(1, 1), cB + hstepB + kstep, voffB);
    PG8_WAIT_V(6); PG8_BAR;
    for (;;) {
        const bool has_next = S.next(ui + 1, nxt);
        const char* nA = (has_next && !GATHER) ? (const char*)g.A + (size_t)nxt.pm * tstepA : cA; const char* nB = has_next ? (const char*)g.Bt + (size_t)nxt.bt * tstepB : cB;
        if (has_next) PG8_GIDX(vn0, vn1, nxt); else { _Pragma("unroll") for (int _i = 0; _i < 2; ++_i) { vn0[_i] = va0[_i]; vn1[_i] = va1[_i]; } }
#pragma unroll 1
        for (int t = 0; t < nt; t += 2) {
            const bool last = (t == nt - 2);
            const char* a1 = cA + (size_t)(t + 1) * kstep;
            const char* a2 = last ? nA : cA + (size_t)(t + 2) * kstep; const char* b2 = last ? nB : cB + (size_t)(t + 2) * kstep;
            const char* a3 = a2 + kstep; const char* b3 = b2 + kstep;
            if constexpr (Epi::MID_T > 0) { if (t == Epi::MID_T) E.mid(acc, cur, wr, wc, fr, fq); }
            unsigned vs0[2], vs1[2];
#pragma unroll
            for (int _i = 0; _i < 2; ++_i) { vs0[_i] = last ? vn0[_i] : va0[_i]; vs1[_i] = last ? vn1[_i] : va1[_i]; }
            PG8_LDB(B0, 0, 0); PG8_LDB(B1, 0, 1); PG8_SCHED; PG8_LDA(At, 0, 0); PG8_STAGE(PG8_SA(1, 1), a1 + hstepA, va1);
            PG8_WAIT_V(8); PG8_WAIT_L(0); PG8_BAR; PG8_MMA(0, 0, At, B0); PG8_MMA(0, 1, At, B1); PG8_BAR; PG8_SCHED;
            PG8_LDA(At, 0, 1); PG8_STAGE(PG8_SB(0, 0), b2, voffB); PG8_STAGE(PG8_SB(0, 1), b2 + hstepB, voffB); PG8_STAGE(PG8_SA(0, 0), a2, vs0);
            PG8_WAIT_V(8); PG8_WAIT_L(0); PG8_BAR; PG8_MMA(1, 0, At, B0); PG8_MMA(1, 1, At, B1); PG8_BAR; PG8_SCHED;
            PG8_LDB(B0, 1, 0); PG8_LDB(B1, 1, 1); PG8_SCHED; PG8_LDA(At, 1, 0); PG8_STAGE(PG8_SA(0, 1), a2 + hstepA, vs1);
            PG8_WAIT_V(8); PG8_WAIT_L(0); PG8_BAR; PG8_MMA(0, 0, At, B0); PG8_MMA(0, 1, At, B1); PG8_BAR; PG8_SCHED;
            PG8_LDA(At, 1, 1); PG8_STAGE(PG8_SB(1, 0), b3, voffB); PG8_STAGE(PG8_SB(1, 1), b3 + hstepB, voffB); PG8_STAGE(PG8_SA(1, 0), a3, vs0);
            PG8_WAIT_V(8); PG8_WAIT_L(0); PG8_BAR; PG8_MMA(1, 0, At, B0); PG8_MMA(1, 1, At, B1); PG8_BAR; PG8_SCHED;
        }
        if constexpr (ALIGN_EPI) { if (wr == 0) PG8_BAR; }
        if constexpr (FP8) {
#pragma unroll
            for (int a = 0; a < 2; ++a)
#pragma unroll
                for (int b = 0; b < 2; ++b)
                    asm volatile("s_nop 15\n\ts_nop 7" : "+v"(acc[a][b][0][0]), "+v"(acc[a][b][0][1]), "+v"(acc[a][b][1][0]), "+v"(acc[a][b][1][1]), "+v"(acc[a][b][2][0]), "+v"(acc[a][b][2][1]), "+v"(acc[a][b][3][0]), "+v"(acc[a][b][3][1]));
        }
        E(acc, cur, wr, wc, fr, fq);
        if (!has_next) break;
#pragma unroll
        for (int a = 0; a < 2; ++a)
#pragma unroll
            for (int b = 0; b < 2; ++b)
#pragma unroll
                for (int m = 0; m < 4; ++m)
#pragma unroll
                    for (int n = 0; n < 2; ++n) acc[a][b][m][n] = (f32x4){0.f, 0.f, 0.f, 0.f};
        cur = nxt; cA = nA; cB = nB; ++ui;
#pragma unroll
        for (int _i = 0; _i < 2; ++_i) { va0[_i] = vn0[_i]; va1[_i] = vn1[_i]; }
        if constexpr (ALIGN_EPI) { if (wr == 1) PG8_BAR; }
    }
    PG8_WAIT_V(0);
    if constexpr (!ALIGN_EPI) { if (wr == 0) PG8_BAR; }
    PG8_BAR;
#undef PG8_SA
#undef PG8_SB
#undef PG8_STAGE
#undef PG8_GIDX
#undef PG8_LDA
#undef PG8_LDB
#undef PG8_MMA
#undef PG8_LD8
#undef PG8_WAIT_V
#undef PG8_WAIT_L
#undef PG8_BAR
#undef PG8_SCHED
}

typedef f32x4 Acc[2][2][4][2];

__device__ __forceinline__ u32x4 pair16(u32x2 x, u32x2 y) {
    const auto r0 = __builtin_amdgcn_permlane16_swap(x.x, y.x, false, false);
    const auto r1 = __builtin_amdgcn_permlane16_swap(x.y, y.y, false, false);
    return (u32x4){r0[0], r1[0], r0[1], r1[1]};
}
struct Epi1 {
    static constexpr bool PERM = true; static constexpr int MID_T = 0;
    bf16_t *yab, *gv; unsigned char *q, *k, *v; bf16_t *sa, *sb; float* gvst; float* kmp; float sc, pad_;
    template <int MODE  >
    __device__ __forceinline__ void run(const Acc& acc, const Unit& u, int wr, int wc, int fr, int fq, bf16_t* base, int ld) const {
        const int row0 = u.pm * BM + wr * 64 + fr, col0 = (u.pn & 3) * 256 + wc * 32 + 8 * fq;
        const int colp = (u.pn & 3) * 256 + wc * 32 + 8 * (fq & ~1);
        f32x4 csA0 = {0.f, 0.f, 0.f, 0.f}, csB0 = csA0, csA1 = csA0, csB1 = csA0;
#pragma unroll
        for (int ai = 0; ai < 2; ++ai)
#pragma unroll
            for (int mp = 0; mp < 2; ++mp) {
                u32x2 pc[2][2];
#pragma unroll
                for (int k = 0; k < 2; ++k) {
                    const int m = 2 * mp + k;
                    const int row = row0 + ai * HALF + m * 16; bf16_t* rowp = base + (size_t)row * ld + col0;
                    float s1 = 0.f, s2 = 0.f;
#pragma unroll
                    for (int bj = 0; bj < 2; ++bj) {
                        f32x4 v0 = acc[ai][bj][m][0], v1 = acc[ai][bj][m][1];
                        if (MODE == 2 || MODE == 3 || MODE == 5) {
                            const float f = (MODE == 2) ? sc * QSCALE : sc; v0 = v0 * f; v1 = v1 * f;
                            if (MODE == 5) { if (bj == 0) { csA0 = csA0 + v0; csB0 = csB0 + v1; } else { csA1 = csA1 + v0; csB1 = csB1 + v1; } }
                            pc[bj][k] = (u32x2){pack_fp8x4(v0[0], v0[1], v0[2], v0[3]), pack_fp8x4(v1[0], v1[1], v1[2], v1[3])};
                            continue;
                        }
                        if (MODE == 0 || MODE == 1) {
                            f32x2 a = gelu_pk((f32x2){v0[0], v0[1]}), b = gelu_pk((f32x2){v0[2], v0[3]}), c = gelu_pk((f32x2){v1[0], v1[1]}), d = gelu_pk((f32x2){v1[2], v1[3]});
                            v0 = (f32x4){a.x, a.y, b.x, b.y}; v1 = (f32x4){c.x, c.y, d.x, d.y};
                        } else if (MODE == 4) {
                            { const float cs_ = -1.4426950408889634f * sc; const f32x4 t0 = v0 * cs_, t1 = v1 * cs_; f32x4 e0, e1;
#pragma unroll
                              for (int j = 0; j < 4; ++j) { e0[j] = __builtin_amdgcn_exp2f(t0[j]); e1[j] = __builtin_amdgcn_exp2f(t1[j]); }
                              e0 = e0 + 1.0f; e1 = e1 + 1.0f;
#pragma unroll
                              for (int j = 0; j < 4; ++j) { v0[j] = __builtin_amdgcn_rcpf(e0[j]); v1[j] = __builtin_amdgcn_rcpf(e1[j]); } }
                            pc[bj][k] = (u32x2){pack_fp8x4(v0[0], v0[1], v0[2], v0[3]), pack_fp8x4(v1[0], v1[1], v1[2], v1[3])};
                            continue;
                        }
                        if (MODE == 1) {
                            s1 += (v0[0] + v0[1]) + (v0[2] + v0[3]) + (v1[0] + v1[1]) + (v1[2] + v1[3]);
                            s2 += (v0[0] * v0[0] + v0[1] * v0[1]) + (v0[2] * v0[2] + v0[3] * v0[3]) + (v1[0] * v1[0] + v1[1] * v1[1]) + (v1[2] * v1[2] + v1[3] * v1[3]);
                            pc[bj][k] = (u32x2){pack_fp8x4(v0[0], v0[1], v0[2], v0[3]), pack_fp8x4(v1[0], v1[1], v1[2], v1[3])};
                            continue;
                        }
                        u32x4 w; w.x = cvt_pk_bf16(v0[0], v0[1]); w.y = cvt_pk_bf16(v0[2], v0[3]); w.z = cvt_pk_bf16(v1[0], v1[1]); w.w = cvt_pk_bf16(v1[2], v1[3]);
                        *(u32x4*)(rowp + bj * HALF) = w;
                    }
                    if (MODE == 1) {
                        s1 += __shfl_xor(s1, 16); s1 += __shfl_xor(s1, 32); s2 += __shfl_xor(s2, 16); s2 += __shfl_xor(s2, 32);
                        if (fq == 0) *(f32x2*)(gvst + ((size_t)row * 16 + (u.pn & 3) * 4 + wc) * 2) = (f32x2){s1, s2};
                    }
                }
                if (MODE != 0) {
                    const int rowst = row0 + ai * HALF + (2 * mp + (fq & 1)) * 16;
#pragma unroll
                    for (int bj = 0; bj < 2; ++bj) *(u32x4*)((unsigned char*)base + (size_t)rowst * 1024 + colp + bj * HALF) = pair16(pc[bj][0], pc[bj][1]);
                }
            }
        if (MODE == 5) {
#define KM_RED(v) do { _Pragma("unroll") for (int j_ = 0; j_ < 4; ++j_) { float x = v[j_]; x += __shfl_xor(x, 1); x += __shfl_xor(x, 2); x += __shfl_xor(x, 4); x += __shfl_xor(x, 8); v[j_] = x; } } while (0)
            KM_RED(csA0); KM_RED(csB0); KM_RED(csA1); KM_RED(csB1);
#undef KM_RED
            if (fr == 0) {
                float* kp = kmp + ((size_t)(u.pm * 2 + wr) * DM) + col0;
                *(f32x4*)kp = csA0; *(f32x4*)(kp + 4) = csB0; *(f32x4*)(kp + HALF) = csA1; *(f32x4*)(kp + HALF + 4) = csB1;
            }
        }
    }
    __device__ __forceinline__ void operator()(const Acc& acc, const Unit& u, int wr, int wc, int fr, int fq) const {
        const int region = u.pn >> 2;
        if (region == 0) run<0>(acc, u, wr, wc, fr, fq, yab, 2048);
        else if (region == 1) run<1>(acc, u, wr, wc, fr, fq, gv, 1024);
        else if (region == 2) run<2>(acc, u, wr, wc, fr, fq, (bf16_t*)q, 1024);
        else if (region == 3) run<5>(acc, u, wr, wc, fr, fq, (bf16_t*)k, 1024);
        else if (region == 4) run<3>(acc, u, wr, wc, fr, fq, (bf16_t*)v, 1024);
        else if (region == 5) run<4>(acc, u, wr, wc, fr, fq, sa, 1024);
        else run<4>(acc, u, wr, wc, fr, fq, sb, 1024);
    }
    __device__ __forceinline__ void mid(Acc&, const Unit&, int, int, int, int) const {}
};

struct Epi2 {
    static constexpr bool PERM = true; static constexpr int MID_T = 16;
    const unsigned char *sa, *sb; bf16_t* mg;
    __device__ __forceinline__ void mid(Acc& acc, const Unit& u, int wr, int wc, int fr, int fq) const {
        int row0 = u.pm * BM + wr * 64 + fr, col0 = u.pn * BM + wc * 32 + 8 * fq;
        asm volatile("" : "+v"(row0), "+v"(col0));
#pragma unroll
        for (int ai = 0; ai < 2; ++ai)
#pragma unroll
            for (int m = 0; m < 4; ++m) {
                const size_t off = (size_t)(row0 + ai * HALF + m * 16) * DM + col0;
#pragma unroll
                for (int bj = 0; bj < 2; ++bj) {
                    const u32x2 a = *(const u32x2*)(sa + off + bj * HALF), b = *(const u32x2*)(sb + off + bj * HALF);
                    const f32x2v a0 = __builtin_amdgcn_cvt_pk_f32_fp8((int)a.x, false), a1 = __builtin_amdgcn_cvt_pk_f32_fp8((int)a.x, true), a2 = __builtin_amdgcn_cvt_pk_f32_fp8((int)a.y, false), a3 = __builtin_amdgcn_cvt_pk_f32_fp8((int)a.y, true);
                    const f32x2v b0 = __builtin_amdgcn_cvt_pk_f32_fp8((int)b.x, false), b1 = __builtin_amdgcn_cvt_pk_f32_fp8((int)b.x, true), b2 = __builtin_amdgcn_cvt_pk_f32_fp8((int)b.y, false), b3 = __builtin_amdgcn_cvt_pk_f32_fp8((int)b.y, true);
                    f32x4 r0, r1;
#define RQ(x, y) ((x) * __builtin_amdgcn_rcpf(y))
                    r0[0] = RQ(a0.x, b0.x); r0[1] = RQ(a0.y, b0.y); r0[2] = RQ(a1.x, b1.x); r0[3] = RQ(a1.y, b1.y);
                    r1[0] = RQ(a2.x, b2.x); r1[1] = RQ(a2.y, b2.y); r1[2] = RQ(a3.x, b3.x); r1[3] = RQ(a3.y, b3.y);
#undef RQ
                    acc[ai][bj][m][0] = acc[ai][bj][m][0] * r0; acc[ai][bj][m][1] = acc[ai][bj][m][1] * r1;
                }
                asm volatile("" : "+v"(acc[ai][0][m][0]), "+v"(acc[ai][0][m][1]), "+v"(acc[ai][1][m][0]), "+v"(acc[ai][1][m][1]));
                asm volatile("" ::: "memory");
            }
    }
    __device__ __forceinline__ void operator()(const Acc& acc, const Unit& u, int wr, int wc, int fr, int fq) const {
        const int row0 = u.pm * BM + wr * 64 + fr, col0 = u.pn * BM + wc * 32 + 8 * fq;
#pragma unroll
        for (int ai = 0; ai < 2; ++ai)
#pragma unroll
            for (int m = 0; m < 4; ++m) {
                const size_t off = (size_t)(row0 + ai * HALF + m * 16) * DM + col0;
#pragma unroll
                for (int bj = 0; bj < 2; ++bj) {
                    const u32x2 b = *(const u32x2*)(sb + off + bj * HALF);
                    const f32x2v b0 = __builtin_amdgcn_cvt_pk_f32_fp8((int)b.x, false), b1 = __builtin_amdgcn_cvt_pk_f32_fp8((int)b.x, true), b2 = __builtin_amdgcn_cvt_pk_f32_fp8((int)b.y, false), b3 = __builtin_amdgcn_cvt_pk_f32_fp8((int)b.y, true);
                    const f32x4 v0 = acc[ai][bj][m][0], v1 = acc[ai][bj][m][1];
                    u32x4 w; w.x = cvt_pk_bf16(v0[0] * b0.x, v0[1] * b0.y); w.y = cvt_pk_bf16(v0[2] * b1.x, v0[3] * b1.y);
                    w.z = cvt_pk_bf16(v1[0] * b2.x, v1[1] * b2.y); w.w = cvt_pk_bf16(v1[2] * b3.x, v1[3] * b3.y);
                    *(u32x4*)(mg + off + bj * HALF) = w;
                }
            }
    }
};

struct Epi3 {
    static constexpr bool PERM = true; static constexpr int MID_T = 0;
    const bf16_t* h0; bf16_t* z; float* zst;
    __device__ __forceinline__ void mid(Acc&, const Unit&, int, int, int, int) const {}
    __device__ __forceinline__ void operator()(const Acc& acc, const Unit& u, int wr, int wc, int fr, int fq) const {
        const int row0 = u.pm * BM + wr * 64 + fr, col0 = u.pn * BM + wc * 32 + 8 * fq;
#pragma unroll
        for (int ai = 0; ai < 2; ++ai)
#pragma unroll
            for (int m = 0; m < 4; ++m) {
                const int row = row0 + ai * HALF + m * 16; const size_t off = (size_t)row * DM + col0;
                float s1 = 0.f, s2 = 0.f;
#pragma unroll
                for (int bj = 0; bj < 2; ++bj) {
                    const u32x4 hb = *(const u32x4*)(h0 + off + bj * HALF);
                    f32x4 v0 = acc[ai][bj][m][0], v1 = acc[ai][bj][m][1];
                    v0[0] += ALPHA * bflo(hb.x); v0[1] += ALPHA * bfhi(hb.x); v0[2] += ALPHA * bflo(hb.y); v0[3] += ALPHA * bfhi(hb.y);
                    v1[0] += ALPHA * bflo(hb.z); v1[1] += ALPHA * bfhi(hb.z); v1[2] += ALPHA * bflo(hb.w); v1[3] += ALPHA * bfhi(hb.w);
                    s1 += ((v0[0] + v0[1]) + (v0[2] + v0[3])) + ((v1[0] + v1[1]) + (v1[2] + v1[3]));
                    s2 += ((v0[0] * v0[0] + v0[1] * v0[1]) + (v0[2] * v0[2] + v0[3] * v0[3])) + ((v1[0] * v1[0] + v1[1] * v1[1]) + (v1[2] * v1[2] + v1[3] * v1[3]));
                    *(u32x4*)(z + off + bj * HALF) = (u32x4){cvt_pk_bf16(v0[0], v0[1]), cvt_pk_bf16(v0[2], v0[3]), cvt_pk_bf16(v1[0], v1[1]), cvt_pk_bf16(v1[2], v1[3])};
                }
                s1 += __shfl_xor(s1, 16); s1 += __shfl_xor(s1, 32); s2 += __shfl_xor(s2, 16); s2 += __shfl_xor(s2, 32);
                if (fq == 0) *(f32x2*)(zst + ((size_t)row * 16 + u.pn * 4 + wc) * 2) = (f32x2){s1, s2};
            }
    }
};

struct Epi4 {
    static constexpr bool PERM = true; static constexpr int MID_T = 0;
    const float* b_up; unsigned char* act;
    __device__ __forceinline__ void mid(Acc&, const Unit&, int, int, int, int) const {}
    __device__ __forceinline__ void operator()(const Acc& acc, const Unit& u, int wr, int wc, int fr, int fq) const {
        const int e = u.bt >> 3;
        const int row0 = u.pm * BM + wr * 64 + fr, c0 = u.pn * HALF + wc * 32 + 8 * fq;
        const float* bg = b_up + (size_t)e * 2 * FF + c0; const float* bu = bg + FF;
        const f32x4 bg0 = *(const f32x4*)bg, bg1 = *(const f32x4*)(bg + 4), bu0 = *(const f32x4*)bu, bu1 = *(const f32x4*)(bu + 4);
        const int cp = u.pn * HALF + wc * 32 + 8 * (fq & ~1);
#pragma unroll
        for (int ai = 0; ai < 2; ++ai)
#pragma unroll
            for (int mp = 0; mp < 2; ++mp) {
                u32x2 pc[2];
#pragma unroll
                for (int k = 0; k < 2; ++k) {
                    const int m = 2 * mp + k;
                    float o[8];
#pragma unroll
                    for (int n = 0; n < 2; ++n)
#pragma unroll
                        for (int jp = 0; jp < 2; ++jp) {
                            const int j = 2 * jp;
                            const f32x2 ag = {acc[ai][0][m][n][j], acc[ai][0][m][n][j + 1]}, au = {acc[ai][1][m][n][j], acc[ai][1][m][n][j + 1]};
                            const f32x2 vbg = n ? (f32x2){bg1[j], bg1[j + 1]} : (f32x2){bg0[j], bg0[j + 1]}, vbu = n ? (f32x2){bu1[j], bu1[j + 1]} : (f32x2){bu0[j], bu0[j + 1]};
                            f32x2 gg = ag * 0.03125f + vbg, uu = au * 0.03125f + vbu;
                            gg.x = fminf(gg.x, 7.0f); gg.y = fminf(gg.y, 7.0f);
                            uu.x = __builtin_amdgcn_fmed3f(uu.x, -7.0f, 7.0f); uu.y = __builtin_amdgcn_fmed3f(uu.y, -7.0f, 7.0f);
                            const f32x2 t = gg * (-1.702f * 1.4426950408889634f);
                            f32x2 ex; ex.x = __builtin_amdgcn_exp2f(t.x); ex.y = __builtin_amdgcn_exp2f(t.y);
                            const f32x2 d = ex + 1.0f;
                            f32x2 rc; rc.x = __builtin_amdgcn_rcpf(d.x); rc.y = __builtin_amdgcn_rcpf(d.y);
                            const f32x2 res = (uu + 1.0f) * (gg * rc);
                            o[n * 4 + j] = res.x; o[n * 4 + j + 1] = res.y;
                        }
                    unsigned w0 = 0u, w1 = 0u;
                    w0 = __builtin_amdgcn_cvt_pk_fp8_f32(o[0], o[1], w0, false); w0 = __builtin_amdgcn_cvt_pk_fp8_f32(o[2], o[3], w0, true);
                    w1 = __builtin_amdgcn_cvt_pk_fp8_f32(o[4], o[5], w1, false); w1 = __builtin_amdgcn_cvt_pk_fp8_f32(o[6], o[7], w1, true);
                    pc[k] = (u32x2){w0, w1};
                }
                const int rowst = row0 + ai * HALF + (2 * mp + (fq & 1)) * 16;
                *(u32x4*)(act + (size_t)rowst * FF + cp) = pair16(pc[0], pc[1]);
            }
    }
};

struct Epi5 {
    static constexpr bool PERM = true; static constexpr int MID_T = 0;
    const float* b_down; const float* roww; unsigned char* ys;
    __device__ __forceinline__ void mid(Acc&, const Unit&, int, int, int, int) const {}
    __device__ __forceinline__ void operator()(const Acc& acc, const Unit& u, int wr, int wc, int fr, int fq) const {
        const int e = u.bt >> 2;
        const int row0 = u.pm * BM + wr * 64 + fr, col0 = u.pn * BM + wc * 32 + 8 * fq;
        f32x4 bv[2][2];
#pragma unroll
        for (int bj = 0; bj < 2; ++bj)
#pragma unroll
            for (int n = 0; n < 2; ++n) bv[bj][n] = *(const f32x4*)(b_down + (size_t)e * DM + col0 + bj * HALF + 4 * n);
        float rwv[2][4];
#pragma unroll
        for (int ai = 0; ai < 2; ++ai)
#pragma unroll
            for (int m = 0; m < 4; ++m) rwv[ai][m] = roww[u.rbase + wr * 64 + fr + ai * HALF + m * 16];
        asm volatile("" ::: "memory");
        const int colp = u.pn * BM + wc * 32 + 8 * (fq & ~1);
#pragma unroll
        for (int ai = 0; ai < 2; ++ai)
#pragma unroll
            for (int mp = 0; mp < 2; ++mp) {
                const int rowst = row0 + ai * HALF + (2 * mp + (fq & 1)) * 16;
#pragma unroll
                for (int bj = 0; bj < 2; ++bj) {
                    u32x2 pc[2];
#pragma unroll
                    for (int k = 0; k < 2; ++k) { const int m = 2 * mp + k; const float rw16 = rwv[ai][m] * 16.0f;
                        const f32x4 v0 = (acc[ai][bj][m][0] * 0.015625f + bv[bj][0]) * rw16, v1 = (acc[ai][bj][m][1] * 0.015625f + bv[bj][1]) * rw16;
                        pc[k] = (u32x2){pack_fp8x4(v0[0], v0[1], v0[2], v0[3]), pack_fp8x4(v1[0], v1[1], v1[2], v1[3])}; }
                    *(u32x4*)(ys + (size_t)rowst * DM + colp + bj * HALF) = pair16(pc[0], pc[1]);
                }
            }
    }
};
}

struct Args { const float* in[21]; float* out; unsigned char* ws; int ph_lo, ph_hi; };
enum { I_X = 0, I_LNIN_G, I_LNIN_B, I_WIN, I_GLN_G, I_GLN_B, I_WSP, I_BSP, I_WBA, I_WBB, I_WOUT, I_LNMIX_G, I_LNMIX_B, I_WR, I_BR, I_WUP, I_BUP, I_WDN, I_BDN, I_LNF_G, I_LNF_B };

struct Ctx { const Args* a; unsigned char* ws; LAS unsigned char* lds; unsigned char* ldsg; int tid, lane, wave, G, vcu; };

__device__ __forceinline__ void tr_item(const float* W, int N, int k0, int n0, bf16_t* dst, int drow0, int dld, int dcol0, LAS float* scr, int lane) {
#pragma unroll 8
    for (int i = 0; i < 32; ++i) { const int kk = 2 * i + (lane >> 5); scr[kk * 33 + (lane & 31)] = __builtin_nontemporal_load(W + (size_t)(k0 + kk) * N + n0 + (lane & 31)); }
    asm volatile("s_waitcnt lgkmcnt(0)" ::: "memory");
    const int c = lane & 7;
#pragma unroll
    for (int j = 0; j < 4; ++j) { const int n = (lane >> 3) + 8 * j; const LAS float* s = scr + (8 * c) * 33 + n;
        u32x4 o; o.x = pk2(s[0 * 33], s[1 * 33]); o.y = pk2(s[2 * 33], s[3 * 33]); o.z = pk2(s[4 * 33], s[5 * 33]); o.w = pk2(s[6 * 33], s[7 * 33]);
        *(u32x4*)(dst + (size_t)(drow0 + n) * dld + dcol0 + k0 + 8 * c) = o; }
    asm volatile("s_waitcnt lgkmcnt(0)" ::: "memory");
}
__device__ __forceinline__ void tr_item8(const float* W, int N, int k0, int n0, unsigned char* dst, int drow0, int dld, float sc, LAS float* scr, int lane) {
#pragma unroll 8
    for (int i = 0; i < 32; ++i) { const int kk = 2 * i + (lane >> 5); scr[kk * 33 + (lane & 31)] = __builtin_nontemporal_load(W + (size_t)(k0 + kk) * N + n0 + (lane & 31)); }
    asm volatile("s_waitcnt lgkmcnt(0)" ::: "memory");
    const int c = lane & 7;
#pragma unroll
    for (int j = 0; j < 4; ++j) { const int n = (lane >> 3) + 8 * j; const LAS float* s = scr + (8 * c) * 33 + n;
        unsigned w0 = 0u, w1 = 0u;
        w0 = __builtin_amdgcn_cvt_pk_fp8_f32(s[0 * 33] * sc, s[1 * 33] * sc, w0, false); w0 = __builtin_amdgcn_cvt_pk_fp8_f32(s[2 * 33] * sc, s[3 * 33] * sc, w0, true);
        w1 = __builtin_amdgcn_cvt_pk_fp8_f32(s[4 * 33] * sc, s[5 * 33] * sc, w1, false); w1 = __builtin_amdgcn_cvt_pk_fp8_f32(s[6 * 33] * sc, s[7 * 33] * sc, w1, true);
        *(u32x2*)(dst + (size_t)(drow0 + n) * dld + k0 + 8 * c) = (u32x2){w0, w1}; }
    asm volatile("s_waitcnt lgkmcnt(0)" ::: "memory");
}
__device__ __forceinline__ void ph_prologue(const Ctx& F) {
    const Args& A = *F.a;
    LAS float* scr = (LAS float*)(F.lds + F.wave * 16384);
    const int gw = F.vcu * 8 + F.wave, NGW = F.G * 8;
    bf16_t* WIN = (bf16_t*)(F.ws + WS_WIN); bf16_t* WAB = (bf16_t*)(F.ws + WS_WAB); bf16_t* WOUT = (bf16_t*)(F.ws + WS_WOUT);
    unsigned char* WDN = F.ws + WS_WDN; unsigned char* WUP = F.ws + WS_WUP;
    constexpr int I_IN = 16 * (INCOLS / 32), I_SQ = 16 * 32, I_UP = NE * 16 * 64, I_DN = NE * 16 * 32;
    constexpr int NITEMS = I_IN + 3 * I_SQ + I_UP + I_DN;
    for (int it = gw; it < NITEMS; it += NGW) {
        int r = it;
        if (r < I_IN) { const int nblk = INCOLS / 32, kb = r / nblk, nb = r % nblk;
            if (32 * nb >= PN8_LO * 256 && 32 * nb < PN8_HI * 256) tr_item8(A.in[I_WIN], INCOLS, 64 * kb, 32 * nb, F.ws + WS_WIN8, 32 * nb, DM, 32.0f, scr, F.lane);
            else tr_item(A.in[I_WIN], INCOLS, 64 * kb, 32 * nb, WIN, 32 * nb, DM, 0, scr, F.lane);
            continue; } r -= I_IN;
        if (r < I_SQ) { const int kb = r / 32, nb = r % 32; tr_item(A.in[I_WBA], DM, 64 * kb, 32 * nb, WAB, 32 * nb, 2048, 0, scr, F.lane); continue; } r -= I_SQ;
        if (r < I_SQ) { const int kb = r / 32, nb = r % 32; tr_item(A.in[I_WBB], DM, 64 * kb, 32 * nb, WAB, 32 * nb, 2048, 1024, scr, F.lane); continue; } r -= I_SQ;
        if (r < I_SQ) { const int kb = r / 32, nb = r % 32; tr_item(A.in[I_WOUT], DM, 64 * kb, 32 * nb, WOUT, 32 * nb, DM, 0, scr, F.lane); continue; } r -= I_SQ;
        if (r < I_UP) { const int e = r / (16 * 64), rr = r % (16 * 64), kb = rr / 64, nb = rr % 64; const int n0 = 32 * nb, half = n0 >= FF, rem = n0 - half * FF, pn = rem >> 7, b = (rem & 127) >> 5;
            tr_item8(A.in[I_WUP] + (size_t)e * DM * 2 * FF, 2 * FF, 64 * kb, n0, WUP, e * 2048 + 256 * pn + half * 128 + 32 * b, DM, 32.0f, scr, F.lane); continue; } r -= I_UP;
        { const int e = r / (16 * 32), rr = r % (16 * 32), kb = rr / 32, nb = rr % 32; tr_item8(A.in[I_WDN] + (size_t)e * FF * DM, DM, 64 * kb, 32 * nb, WDN, e * 1024 + 32 * nb, FF, 64.0f, scr, F.lane); }
    }
    const float* lg = A.in[I_LNIN_G]; const float* lb = A.in[I_LNIN_B]; bf16_t* H0 = (bf16_t*)(F.ws + WS_H0);
    f32x4 gg[4], bb[4];
#pragma unroll
    for (int j = 0; j < 4; ++j) { gg[j] = *((const f32x4*)lg + F.lane + 64 * j); bb[j] = *((const f32x4*)lb + F.lane + 64 * j); }
    for (int m = gw; m < T; m += NGW) {
        const f32x4* xr = (const f32x4*)(A.in[I_X] + (size_t)m * DM) + F.lane;
        f32x4 v[4]; float s = 0.f;
#pragma unroll
        for (int j = 0; j < 4; ++j) { v[j] = __builtin_nontemporal_load(xr + 64 * j); s += (v[j].x + v[j].y) + (v[j].z + v[j].w); }
        const float mean = wave_sum(s) * (1.f / DM); float s2 = 0.f;
#pragma unroll
        for (int j = 0; j < 4; ++j) { v[j] = v[j] - mean; s2 += (v[j].x * v[j].x + v[j].y * v[j].y) + (v[j].z * v[j].z + v[j].w * v[j].w); }
        const float rstd = 1.f / sqrtf(wave_sum(s2) * (1.f / DM) + LN_EPS);
        u32x2* o8 = (u32x2*)(H0 + (size_t)m * DM) + F.lane; unsigned* o4 = (unsigned*)(F.ws + WS_H0F8 + (size_t)m * DM) + F.lane;
#pragma unroll
        for (int j = 0; j < 4; ++j) { const f32x4 y = v[j] * rstd * gg[j] + bb[j]; o8[64 * j] = (u32x2){pk2(y.x, y.y), pk2(y.z, y.w)}; o4[64 * j] = pack_fp8x4(y.x, y.y, y.z, y.w); }
    }
}

__device__ __forceinline__ void ph_kmean(const Ctx& F) {
    const unsigned char* K = F.ws + WS_K; float* KM = (float*)(F.ws + WS_KMEAN);
    float* red = (float*)F.ldsg;
    const int d = F.tid & 127, part = F.tid >> 7;
    for (int it = F.vcu; it < NB * NH * NBLK; it += F.G) {
        const int b = it / (NH * NBLK), h = (it / NBLK) % NH, j = it % NBLK;
        const unsigned char* kp = K + ((size_t)(b * SEQ + j * LBLK + part * 64)) * DM + h * DH + d;
        float s = 0.f;
        for (int r = 0; r < 64; ++r) s += __builtin_amdgcn_cvt_f32_fp8((int)kp[(size_t)r * DM], 0);
        red[part * 128 + d] = s;
        __syncthreads();
        if (F.tid < 128) KM[(size_t)it * DH + d] = (red[d] + red[128 + d] + red[256 + d] + red[384 + d]) * (1.0f / LBLK);
        __syncthreads();
    }
}
typedef short v4i16_t __attribute__((ext_vector_type(4)));
__device__ __forceinline__ v4i16_t lds_tr16(LAS const unsigned char* p) { return __builtin_amdgcn_ds_read_tr16_b64_v4i16((LAS v4i16_t*)p); }
__device__ __forceinline__ void ph_mixer_a(const Ctx& F) {
    const Args& A = *F.a;
    const unsigned char* GV = F.ws + WS_GV; bf16_t* YAB = (bf16_t*)(F.ws + WS_YAB); const float* GVST = (const float*)(F.ws + WS_GVST);
    const float* lg = A.in[I_GLN_G]; const float* lb = A.in[I_GLN_B]; const float* wsp = A.in[I_WSP]; const float* bsp = A.in[I_BSP];
    constexpr int RSV = 544, RSW = 272, OFF_W = 128 * RSV, OFF_ST = OFF_W + 128 * RSW;
    LAS unsigned char* VT = F.lds; LAS unsigned char* WT = F.lds + OFF_W; LAS float* ST = (LAS float*)(F.lds + OFF_ST);
    const int lane = F.lane, wv = F.wave;
    int curg = -1;
    for (int it = F.vcu; it < NB * 32 * 4; it += F.G) {
        const int b = it / 128, c = (it >> 2) & 31, g = it & 3;
        const int tok0 = b * SEQ + c * 128;
        if (g != curg) {
            curg = g;
            for (int k = 0; k < 4; ++k) {
                const int idx = F.tid + 512 * k, t = idx >> 4, s8 = (idx & 15) * 8;
                const f32x4 w0 = *(const f32x4*)(wsp + ((size_t)g * 128 + t) * 128 + s8), w1 = *(const f32x4*)(wsp + ((size_t)g * 128 + t) * 128 + s8 + 4);
                float x[8] = {w0.x, w0.y, w0.z, w0.w, w1.x, w1.y, w1.z, w1.w};
#pragma unroll
                for (int j = 0; j < 8; ++j) x[j] = (s8 + j <= t) ? x[j] : 0.f;
                u32x4 o; o.x = pk2(x[0], x[1]); o.y = pk2(x[2], x[3]); o.z = pk2(x[4], x[5]); o.w = pk2(x[6], x[7]);
                *(LAS u32x4*)(WT + t * RSW + s8 * 2) = o;
            }
        }
        if (F.tid < 128) {
            const float* p = GVST + (size_t)(tok0 + F.tid) * 32; float s1 = 0.f, s2 = 0.f;
            for (int i = 0; i < 16; ++i) { s1 += p[2 * i]; s2 += p[2 * i + 1]; }
            const float mean = s1 * (1.f / DM), var = s2 * (1.f / DM) - mean * mean;
            ST[2 * F.tid] = mean; ST[2 * F.tid + 1] = 1.f / sqrtf(fmaxf(var, 0.f) + LN_EPS);
        }
        __syncthreads();
        {
            const int dc = F.tid & 31;
            const f32x4 g0 = *(const f32x4*)(lg + g * 256 + dc * 8), g1 = *(const f32x4*)(lg + g * 256 + dc * 8 + 4), b0 = *(const f32x4*)(lb + g * 256 + dc * 8), b1 = *(const f32x4*)(lb + g * 256 + dc * 8 + 4);
#pragma unroll
            for (int k = 0; k < 8; ++k) {
                const int s = (F.tid >> 5) + 16 * k;
                const u32x2 raw = *(const u32x2*)(GV + (size_t)(tok0 + s) * DM + g * 256 + dc * 8);
                const float mean = ST[2 * s], rstd = ST[2 * s + 1];
                const f32x2v f0 = __builtin_amdgcn_cvt_pk_f32_fp8((int)raw.x, false), f1 = __builtin_amdgcn_cvt_pk_f32_fp8((int)raw.x, true), f2 = __builtin_amdgcn_cvt_pk_f32_fp8((int)raw.y, false), f3 = __builtin_amdgcn_cvt_pk_f32_fp8((int)raw.y, true);
                f32x4 x0 = {f0.x, f0.y, f1.x, f1.y}, x1 = {f2.x, f2.y, f3.x, f3.y};
                x0 = (x0 - mean) * rstd * g0 + b0; x1 = (x1 - mean) * rstd * g1 + b1;
                u32x4 o; o.x = pk2(x0.x, x0.y); o.y = pk2(x0.z, x0.w); o.z = pk2(x1.x, x1.y); o.w = pk2(x1.z, x1.w);
                *(LAS u32x4*)(VT + s * RSV + dc * 16) = o;
            }
        }
        __syncthreads();
        {
            const int dbase = 32 * wv, kg = lane >> 4, q = (lane & 15) >> 2, p = lane & 3, fr = lane & 15;
            bf16x8 Af[2][4];
#pragma unroll
            for (int m = 0; m < 2; ++m)
#pragma unroll
                for (int kk = 0; kk < 4; ++kk) {
                    LAS const unsigned char* ap = VT + (32 * kk + 8 * kg + q) * RSV + (dbase + 16 * m + 4 * p) * 2;
                    const v4i16_t lo = lds_tr16(ap), hi = lds_tr16(ap + 4 * RSV);
                    Af[m][kk] = (bf16x8){lo[0], lo[1], lo[2], lo[3], hi[0], hi[1], hi[2], hi[3]};
                }
#pragma unroll
            for (int n = 0; n < 8; ++n) {
                f32x4 acc0 = {0.f, 0.f, 0.f, 0.f}, acc1 = {0.f, 0.f, 0.f, 0.f};
#pragma unroll
                for (int kk = 0; kk < 4; ++kk) if (kk <= (n >> 1)) {
                    const bf16x8 Bf = *(LAS const bf16x8*)(WT + (16 * n + fr) * RSW + (32 * kk + 8 * kg) * 2);
                    acc0 = __builtin_amdgcn_mfma_f32_16x16x32_bf16(Af[0][kk], Bf, acc0, 0, 0, 0);
                    acc1 = __builtin_amdgcn_mfma_f32_16x16x32_bf16(Af[1][kk], Bf, acc1, 0, 0, 0);
                }
                const int t = 16 * n + fr; const float bsv = bsp[g * 128 + t];
                bf16_t* yp = YAB + (size_t)(tok0 + t) * 2048 + g * 256 + dbase + 4 * kg;
                const u32x2 u0 = *(const u32x2*)yp, u1 = *(const u32x2*)(yp + 16);
                u32x2 o0, o1;
                o0.x = pk2(bflo(u0.x) * (acc0[0] + bsv), bfhi(u0.x) * (acc0[1] + bsv)); o0.y = pk2(bflo(u0.y) * (acc0[2] + bsv), bfhi(u0.y) * (acc0[3] + bsv));
                o1.x = pk2(bflo(u1.x) * (acc1[0] + bsv), bfhi(u1.x) * (acc1[1] + bsv)); o1.y = pk2(bflo(u1.y) * (acc1[2] + bsv), bfhi(u1.y) * (acc1[3] + bsv));
                *(u32x2*)yp = o0; *(u32x2*)(yp + 16) = o1;
            }
        }
        __syncthreads();
    }
}

__device__ __forceinline__ void ph_gate(const Ctx& F) {
    const unsigned char* Q = F.ws + WS_Q; const float* KM = (const float*)(F.ws + WS_KMEAN);
    unsigned* SEL = (unsigned*)(F.ws + WS_SEL); unsigned* LISTS = (unsigned*)(F.ws + WS_LISTS); unsigned* LCNT = (unsigned*)(F.ws + WS_CTL) + CW_LCNT;
    float* km = (float*)F.ldsg;
    unsigned* lc = (unsigned*)(F.ldsg + 8192);
    for (int it = F.vcu; it < NB * NH * 8; it += F.G) {
        const int b = it / 64, h = (it >> 3) & 7, tc = it & 7;
        for (int i = F.tid; i < NBLK * DH; i += 512) { const int j = i >> 7, d = i & 127; const float* kp = KM + (size_t)((b * NBLK + j) * 2) * DM + h * DH + d; km[i] = (kp[0] + kp[DM]) * (1.0f / LBLK); }
        if (F.tid < 32) lc[F.tid] = 0u;
        __syncthreads();
        const int t = tc * 512 + F.tid, qi = t >> 8;
        float gsc[15];
#pragma unroll
        for (int j = 0; j < 15; ++j) gsc[j] = 0.f;
        const unsigned char* qp = Q + (size_t)(b * SEQ + t) * DM + h * DH;
        u32x4 qraw[8];
#pragma unroll
        for (int c = 0; c < 8; ++c) qraw[c] = *(const u32x4*)(qp + c * 16);
#pragma unroll
        for (int c = 0; c < 16; ++c) {
            const u32x2 raw = (c & 1) ? (u32x2){qraw[c >> 1].z, qraw[c >> 1].w} : (u32x2){qraw[c >> 1].x, qraw[c >> 1].y};
            const f32x2v f0 = __builtin_amdgcn_cvt_pk_f32_fp8((int)raw.x, false), f1 = __builtin_amdgcn_cvt_pk_f32_fp8((int)raw.x, true), f2 = __builtin_amdgcn_cvt_pk_f32_fp8((int)raw.y, false), f3 = __builtin_amdgcn_cvt_pk_f32_fp8((int)raw.y, true);
            const float x[8] = {f0.x, f0.y, f1.x, f1.y, f2.x, f2.y, f3.x, f3.y};
#pragma unroll
            for (int j = 0; j < 15; ++j) if (j < qi) {
                const float* kk = km + j * DH + c * 8;
#pragma unroll
                for (int e = 0; e < 8; ++e) gsc[j] += x[e] * kk[e];
            }
        }
        const int nsel = qi < 3 ? qi : 3;
        int sel[3] = {0, 0, 0}; unsigned lpos[3] = {0, 0, 0};
#pragma unroll
        for (int r = 0; r < 3; ++r) {
            float best = -INFINITY; int bi = -1;
#pragma unroll
            for (int j = 0; j < 15; ++j) { const bool c = (j < qi) && (gsc[j] > best); best = c ? gsc[j] : best; bi = c ? j : bi; }
#pragma unroll
            for (int j = 0; j < 15; ++j) if (j == bi) gsc[j] = -INFINITY;
            sel[r] = bi < 0 ? 0 : bi;
            if (r < nsel) lpos[r] = atomicAdd(&lc[sel[r]], 1u);
        }
        SEL[(size_t)(b * SEQ + t) * NH + h] = (unsigned)sel[0] | ((unsigned)sel[1] << 8) | ((unsigned)sel[2] << 16) | ((unsigned)nsel << 24);
        __syncthreads();
        if (F.tid < 16) lc[16 + F.tid] = lc[F.tid] ? atomicAdd(&LCNT[(b * NH + h) * NBLK + F.tid], lc[F.tid]) : 0u;
        __syncthreads();
#pragma unroll
        for (int r = 0; r < 3; ++r) if (r < nsel) LISTS[(size_t)((b * NH + h) * NBLK + sel[r]) * 4096 + lc[16 + sel[r]] + lpos[r]] = (unsigned)t | ((unsigned)r << 12);
        __syncthreads();
    }
}

__device__ __forceinline__ void ph_attn_naive(const Ctx& F) {
    const bf16_t* Q = (const bf16_t*)(F.ws + WS_Q); const bf16_t* K = (const bf16_t*)(F.ws + WS_K); const bf16_t* V = (const bf16_t*)(F.ws + WS_V);
    const unsigned* SEL = (const unsigned*)(F.ws + WS_SEL); bf16_t* YAB = (bf16_t*)(F.ws + WS_YAB);
    float* qs = (float*)(F.ldsg + F.wave * 4608);
    float* sc = qs + 128;
    const int gw = F.vcu * 8 + F.wave, NGW = F.G * 8;
    for (int w = gw; w < NB * NH * SEQ; w += NGW) {
        const int b = w / (NH * SEQ), h = (w / SEQ) % NH, t = w % SEQ, qi = t >> 8, tl = t & 255;
        const size_t tok = (size_t)b * SEQ + t;
        { const unsigned qq = *(const unsigned*)(Q + tok * DM + h * DH + 2 * F.lane); qs[2 * F.lane] = bflo(qq); qs[2 * F.lane + 1] = bfhi(qq); }
        const unsigned selw = SEL[tok * NH + h]; const int nsel = selw >> 24;
        float mx = -INFINITY;
        for (int r = 0; r <= nsel; ++r) {
            const int jb = (r < nsel) ? (int)((selw >> (8 * r)) & 0xff) : qi;
            for (int c = 0; c < 4; ++c) {
                const int key = c * 64 + F.lane;
                const bool valid = (r < nsel) || (key <= tl);
                const bf16_t* kp = K + ((size_t)b * SEQ + jb * LBLK + key) * DM + h * DH;
                float s = 0.f;
#pragma unroll 4
                for (int dd = 0; dd < 16; ++dd) {
                    const u32x4 raw = *(const u32x4*)(kp + dd * 8);
                    const float* q8 = qs + dd * 8;
                    s += bflo(raw.x) * q8[0] + bfhi(raw.x) * q8[1] + bflo(raw.y) * q8[2] + bfhi(raw.y) * q8[3] + bflo(raw.z) * q8[4] + bfhi(raw.z) * q8[5] + bflo(raw.w) * q8[6] + bfhi(raw.w) * q8[7];
                }
                s = valid ? s : -INFINITY;
                sc[r * 256 + key] = s; mx = fmaxf(mx, s);
            }
        }
        mx = wave_max(mx);
        float l = 0.f;
        const int ntot = (nsel + 1) * 256;
        for (int i = F.lane; i < ntot; i += 64) { const float p = __builtin_amdgcn_exp2f(sc[i] - mx); sc[i] = p; l += p; }
        l = wave_sum(l);
        float o0 = 0.f, o1 = 0.f;
        for (int r = 0; r <= nsel; ++r) {
            const int jb = (r < nsel) ? (int)((selw >> (8 * r)) & 0xff) : qi;
            const int nk = (r < nsel) ? 256 : tl + 1;
            const bf16_t* vp = V + ((size_t)b * SEQ + jb * LBLK) * DM + h * DH + 2 * F.lane;
#pragma unroll 4
            for (int key = 0; key < nk; ++key) { const unsigned vv = *(const unsigned*)(vp + (size_t)key * DM); const float p = sc[r * 256 + key]; o0 += p * bflo(vv); o1 += p * bfhi(vv); }
        }
        const float il = 1.f / l;
        *(unsigned*)(YAB + tok * 2048 + 1024 + h * DH + 2 * F.lane) = pk2(o0 * il, o1 * il);
    }
}

typedef float f32x16 __attribute__((ext_vector_type(16)));
namespace att {
constexpr int KCH = 4112, VDB = 16448, OFF_K = 0, OFF_V = 16 * KCH, OFF_WS = OFF_V + 4 * VDB  , WSW = 512, OFF_TAB = OFF_WS + 8 * WSW  ;
static_assert(OFF_TAB + 1028 * 4 <= LDS_BYTES, "attention LDS map");
__device__ __forceinline__ int crow(int r, int hi) { return (r & 3) + 8 * (r >> 2) + 4 * hi; }
#define TRR(dst, vaddr, off) asm volatile("ds_read_b64_tr_b16 %0, %1 offset:%c2" : "=v"(dst) : "v"(vaddr), "i"(off) : "memory")
#define TRWAIT() do { asm volatile("s_waitcnt lgkmcnt(0)" ::: "memory"); __builtin_amdgcn_sched_barrier(0); } while (0)

__device__ __forceinline__ void load_kv(const Ctx& F, const unsigned char* K, const unsigned char* V, size_t tokbase, int h) {
    u32x4 kv[4], vv[4];
#pragma unroll
    for (int k = 0; k < 4; ++k) { const int idx = F.tid + 512 * k, key = idx >> 3, c2 = idx & 7; const size_t off = (tokbase + key) * DM + h * DH + c2 * 16;
        kv[k] = *(const u32x4*)(K + off); vv[k] = *(const u32x4*)(V + off); }
#pragma unroll
    for (int k = 0; k < 4; ++k) { const int idx = F.tid + 512 * k, key = idx >> 3, c2 = idx & 7, c = 2 * c2;
        *(LAS u32x4*)(F.lds + OFF_K + c * KCH + key * 16) = f8x8_to_bf16x8(kv[k].x, kv[k].y);
        *(LAS u32x4*)(F.lds + OFF_K + (c + 1) * KCH + key * 16) = f8x8_to_bf16x8(kv[k].z, kv[k].w);
        LAS unsigned char* vd = F.lds + OFF_V + (c >> 2) * VDB + (key >> 3) * 512 + (key & 7) * 64 + (c & 3) * 16;
        *(LAS u32x4*)vd = f8x8_to_bf16x8(vv[k].x, vv[k].y); *(LAS u32x4*)(vd + 16) = f8x8_to_bf16x8(vv[k].z, vv[k].w); }
}

template <bool CAUSAL>
__device__ __forceinline__ void core(const Ctx& F, const unsigned char* qrow, f32x16 (&o)[4], float& m, float& l) {
    const int r = F.lane & 31, hh = F.lane >> 5;
    LAS float* wsf = (LAS float*)(F.lds + OFF_WS + F.wave * WSW);
    bf16x8 qr[8];
#pragma unroll
    for (int ds = 0; ds < 8; ++ds) { const u32x2 raw = *(const u32x2*)(qrow + ds * 16 + hh * 8); qr[ds] = __builtin_bit_cast(bf16x8, f8x8_to_bf16x8(raw.x, raw.y)); }
#pragma unroll
    for (int db = 0; db < 4; ++db)
#pragma unroll
        for (int i = 0; i < 16; ++i) o[db][i] = 0.f;
    m = -1e30f; l = 0.f;
    const int nt = CAUSAL ? (F.wave >> 1) + 1 : 4;
    LAS const unsigned char* kbase = F.lds + OFF_K + hh * KCH + r * 16;
    LAS const unsigned char* vbase = F.lds + OFF_V + (4 * hh + ((F.lane & 15) >> 2)) * 64 + ((F.lane >> 4) & 1) * 32 + (F.lane & 3) * 8;
    for (int kt = 0; kt < nt; ++kt) {
        const bool diag = CAUSAL && (kt == nt - 1);
        constexpr bool skip1 = false;
        f32x16 p0, p1;
#pragma unroll
        for (int i = 0; i < 16; ++i) { p0[i] = 0.f; p1[i] = 0.f; }
        LAS const unsigned char* kp = kbase + (64 * kt) * 16;
        LAS const unsigned char* vp = vbase + (8 * kt) * 512;
        {
            bf16x8 ka[8], kb[8];
#pragma unroll
            for (int ds = 0; ds < 8; ++ds) ka[ds] = *(LAS const bf16x8*)(kp + 2 * ds * KCH);
            if (!skip1) {
#pragma unroll
                for (int ds = 0; ds < 8; ++ds) kb[ds] = *(LAS const bf16x8*)(kp + 2 * ds * KCH + 512);
            }
            __builtin_amdgcn_sched_barrier(0);
#pragma unroll
            for (int ds = 0; ds < 8; ++ds) p0 = __builtin_amdgcn_mfma_f32_32x32x16_bf16(ka[ds], qr[ds], p0, 0, 0, 0);
            if (!skip1) {
#pragma unroll
                for (int ds = 0; ds < 8; ++ds) p1 = __builtin_amdgcn_mfma_f32_32x32x16_bf16(kb[ds], qr[ds], p1, 0, 0, 0);
            }
            __builtin_amdgcn_sched_barrier(0);
        }
        v4i16_t vl[2][4], vh[2][4];
        const unsigned vaddr = (unsigned)(uintptr_t)vp;
#pragma unroll
        for (int ks = 0; ks < 2; ++ks)
#pragma unroll
            for (int db = 0; db < 4; ++db) { TRR(vl[ks][db], vaddr, db * VDB + ks * 1024); TRR(vh[ks][db], vaddr, db * VDB + ks * 1024 + 512); }
        __builtin_amdgcn_sched_barrier(0);
        if (diag) {
            if (F.wave & 1) {
#pragma unroll
                for (int i = 0; i < 16; ++i) p1[i] = (crow(i, hh) > r) ? -INFINITY : p1[i];
            } else {
#pragma unroll
                for (int i = 0; i < 16; ++i) { p0[i] = (crow(i, hh) > r) ? -INFINITY : p0[i]; p1[i] = -INFINITY; }
            }
        }
        float mx = fmaxf(p0[0], p1[0]);
#pragma unroll
        for (int i = 1; i < 16; ++i) mx = fmaxf(mx, fmaxf(p0[i], p1[i]));
        mx = fmaxf(mx, __shfl_xor(mx, 32));
        const float mnew = fmaxf(m, mx);
        if (__any(mx > m + 8.0f)) {
            const float alpha = __builtin_amdgcn_exp2f(m - mnew);
            l *= alpha; m = mnew;
            if (hh == 0) wsf[r] = alpha;
            asm volatile("s_waitcnt lgkmcnt(0)" ::: "memory");
#pragma unroll
            for (int i = 0; i < 16; ++i) { const float a = wsf[crow(i, hh)];
#pragma unroll
                for (int db = 0; db < 4; ++db) o[db][i] *= a; }
        }
        float ls = 0.f;
#pragma unroll
        for (int i = 0; i < 16; ++i) { p0[i] = __builtin_amdgcn_exp2f(p0[i] - m); p1[i] = __builtin_amdgcn_exp2f(p1[i] - m); ls += p0[i] + p1[i]; }
        l += ls;
        u32x4 pw[4];
#pragma unroll
        for (int s2 = 0; s2 < 2; ++s2) {
            pw[s2] = (u32x4){cvt_pk_bf16(p0[8 * s2], p0[8 * s2 + 1]), cvt_pk_bf16(p0[8 * s2 + 2], p0[8 * s2 + 3]), cvt_pk_bf16(p0[8 * s2 + 4], p0[8 * s2 + 5]), cvt_pk_bf16(p0[8 * s2 + 6], p0[8 * s2 + 7])};
            pw[2 + s2] = (u32x4){cvt_pk_bf16(p1[8 * s2], p1[8 * s2 + 1]), cvt_pk_bf16(p1[8 * s2 + 2], p1[8 * s2 + 3]), cvt_pk_bf16(p1[8 * s2 + 4], p1[8 * s2 + 5]), cvt_pk_bf16(p1[8 * s2 + 6], p1[8 * s2 + 7])};
        }
        TRWAIT();
        v4i16_t wl[2][4], wh[2][4];
        if (!skip1) {
#pragma unroll
            for (int ks = 0; ks < 2; ++ks)
#pragma unroll
                for (int db = 0; db < 4; ++db) { TRR(wl[ks][db], vaddr, db * VDB + (2 + ks) * 1024); TRR(wh[ks][db], vaddr, db * VDB + (2 + ks) * 1024 + 512); }
        }
        __builtin_amdgcn_sched_barrier(0);
#pragma unroll
        for (int ks = 0; ks < 2; ++ks) {
            const bf16x8 pa = __builtin_bit_cast(bf16x8, pw[ks]);
#pragma unroll
            for (int db = 0; db < 4; ++db) {
                const bf16x8 vf = (bf16x8){vl[ks][db][0], vl[ks][db][1], vl[ks][db][2], vl[ks][db][3], vh[ks][db][0], vh[ks][db][1], vh[ks][db][2], vh[ks][db][3]};
                o[db] = __builtin_amdgcn_mfma_f32_32x32x16_bf16(pa, vf, o[db], 0, 0, 0);
            }
        }
        TRWAIT();
        if (!skip1) {
#pragma unroll
            for (int ks = 0; ks < 2; ++ks) {
                const bf16x8 pa = __builtin_bit_cast(bf16x8, pw[2 + ks]);
#pragma unroll
                for (int db = 0; db < 4; ++db) {
                    const bf16x8 vf = (bf16x8){wl[ks][db][0], wl[ks][db][1], wl[ks][db][2], wl[ks][db][3], wh[ks][db][0], wh[ks][db][1], wh[ks][db][2], wh[ks][db][3]};
                    o[db] = __builtin_amdgcn_mfma_f32_32x32x16_bf16(pa, vf, o[db], 0, 0, 0);
                }
            }
        }
        __builtin_amdgcn_sched_barrier(0);
    }
}
__device__ __forceinline__ void finish_and_stage(const Ctx& F, const f32x16 (&o)[4], float m, float l) {
    const int r = F.lane & 31, hh = F.lane >> 5;
    LAS float* wsf = (LAS float*)(F.lds + OFF_WS + F.wave * WSW);
    const float lt = l + __shfl_xor(l, 32);
    if (hh == 0) { wsf[r] = 1.0f / lt; wsf[32 + r] = m + __builtin_amdgcn_logf(lt); }
    __syncthreads();
    LAS float* stg = (LAS float*)(F.lds + F.wave * 16384);
#pragma unroll
    for (int i = 0; i < 16; ++i) { const int q = crow(i, hh); const float a = wsf[q];
#pragma unroll
        for (int db = 0; db < 4; ++db) stg[q * 128 + 32 * db + r] = o[db][i] * a; }
    asm volatile("s_waitcnt lgkmcnt(0)" ::: "memory");
}
}

namespace att2 {
constexpr int KCH2 = 1040, VDB2 = 4160, KSL = 16 * KCH2, VSL = 4 * VDB2;
constexpr int OFF_K = 0, OFF_V = 2 * KSL, OFF_STG = OFF_V + 2 * VSL  , OFF_WS = OFF_STG + 8 * 8192  , WSW = 1024, OFF_TAB = OFF_WS + 8 * WSW  ;
static_assert(OFF_TAB + 1028 * 4 <= LDS_BYTES - 64, "attention (partial) LDS map");
using att::crow;

__device__ __forceinline__ void tile_load(const Ctx& F, const unsigned char* K, const unsigned char* V, size_t tokbase, int h, int kt, u32x4& rk, u32x4& rv) {
    const size_t off = (tokbase + 64 * kt + (F.tid >> 3)) * DM + h * DH + (F.tid & 7) * 16;
    rk = *(const u32x4*)(K + off); rv = *(const u32x4*)(V + off);
}
__device__ __forceinline__ void tile_write(const Ctx& F, int slot, const u32x4& rk, const u32x4& rv) {
    const int key = F.tid >> 3, c = 2 * (F.tid & 7);
    LAS unsigned char* kd = F.lds + OFF_K + slot * KSL + c * KCH2 + key * 16;
    *(LAS u32x4*)kd = f8x8_to_bf16x8(rk.x, rk.y); *(LAS u32x4*)(kd + KCH2) = f8x8_to_bf16x8(rk.z, rk.w);
    LAS unsigned char* vd = F.lds + OFF_V + slot * VSL + (c >> 2) * VDB2 + (key >> 3) * 512 + (key & 7) * 64 + (c & 3) * 16;
    *(LAS u32x4*)vd = f8x8_to_bf16x8(rv.x, rv.y); *(LAS u32x4*)(vd + 16) = f8x8_to_bf16x8(rv.z, rv.w);
}
template <bool CAUSAL = false>
__device__ __forceinline__ void tile_compute(const Ctx& F, int slot, const bf16x8 (&qr)[8], f32x16 (&o)[4], float& m, float& l, bool diag = false) {
    const int r = F.lane & 31, hh = F.lane >> 5;
    LAS float* wsf = (LAS float*)(F.lds + OFF_WS + F.wave * WSW);
    LAS const unsigned char* kp = F.lds + OFF_K + slot * KSL + hh * KCH2 + r * 16;
    LAS const unsigned char* vp = F.lds + OFF_V + slot * VSL + (4 * hh + ((F.lane & 15) >> 2)) * 64 + ((F.lane >> 4) & 1) * 32 + (F.lane & 3) * 8;
    f32x16 p0, p1;
#pragma unroll
    for (int i = 0; i < 16; ++i) { p0[i] = 0.f; p1[i] = 0.f; }
    {
        bf16x8 ka[8];
#pragma unroll
        for (int ds = 0; ds < 8; ++ds) ka[ds] = *(LAS const bf16x8*)(kp + 2 * ds * KCH2);
        __builtin_amdgcn_sched_barrier(0);
#pragma unroll
        for (int ds = 0; ds < 8; ++ds) p0 = __builtin_amdgcn_mfma_f32_32x32x16_bf16(ka[ds], qr[ds], p0, 0, 0, 0);
        __builtin_amdgcn_sched_barrier(0);
#pragma unroll
        for (int ds = 0; ds < 8; ++ds) ka[ds] = *(LAS const bf16x8*)(kp + 2 * ds * KCH2 + 512);
        __builtin_amdgcn_sched_barrier(0);
#pragma unroll
        for (int ds = 0; ds < 8; ++ds) p1 = __builtin_amdgcn_mfma_f32_32x32x16_bf16(ka[ds], qr[ds], p1, 0, 0, 0);
        __builtin_amdgcn_sched_barrier(0);
    }
    v4i16_t vl[2][4], vh[2][4];
    const unsigned vaddr = (unsigned)(uintptr_t)vp;
#pragma unroll
    for (int ks = 0; ks < 2; ++ks)
#pragma unroll
        for (int db = 0; db < 4; ++db) { TRR(vl[ks][db], vaddr, db * VDB2 + ks * 1024); TRR(vh[ks][db], vaddr, db * VDB2 + ks * 1024 + 512); }
    __builtin_amdgcn_sched_barrier(0);
    if (CAUSAL && diag) {
        if (F.wave & 1) {
#pragma unroll
            for (int i = 0; i < 16; ++i) p1[i] = (crow(i, hh) > r) ? -INFINITY : p1[i];
        } else {
#pragma unroll
            for (int i = 0; i < 16; ++i) { p0[i] = (crow(i, hh) > r) ? -INFINITY : p0[i]; p1[i] = -INFINITY; }
        }
    }
    float mx = fmaxf(p0[0], p1[0]);
#pragma unroll
    for (int i = 1; i < 16; ++i) mx = fmaxf(mx, fmaxf(p0[i], p1[i]));
    mx = fmaxf(mx, __shfl_xor(mx, 32));
    const float mnew = fmaxf(m, mx);
    if (__any(mx > m + 8.0f)) {
        const float alpha = __builtin_amdgcn_exp2f(m - mnew);
        l *= alpha; m = mnew;
        if (hh == 0) wsf[r] = alpha;
        asm volatile("s_waitcnt lgkmcnt(0)" ::: "memory");
#pragma unroll
        for (int i = 0; i < 16; ++i) { const float a = wsf[crow(i, hh)];
#pragma unroll
            for (int db = 0; db < 4; ++db) o[db][i] *= a; }
    }
    float ls = 0.f;
#pragma unroll
    for (int i = 0; i < 16; ++i) { p0[i] = __builtin_amdgcn_exp2f(p0[i] - m); p1[i] = __builtin_amdgcn_exp2f(p1[i] - m); ls += p0[i] + p1[i]; }
    l += ls;
    u32x4 pw[4];
#pragma unroll
    for (int s2 = 0; s2 < 2; ++s2) {
        pw[s2] = (u32x4){cvt_pk_bf16(p0[8 * s2], p0[8 * s2 + 1]), cvt_pk_bf16(p0[8 * s2 + 2], p0[8 * s2 + 3]), cvt_pk_bf16(p0[8 * s2 + 4], p0[8 * s2 + 5]), cvt_pk_bf16(p0[8 * s2 + 6], p0[8 * s2 + 7])};
        pw[2 + s2] = (u32x4){cvt_pk_bf16(p1[8 * s2], p1[8 * s2 + 1]), cvt_pk_bf16(p1[8 * s2 + 2], p1[8 * s2 + 3]), cvt_pk_bf16(p1[8 * s2 + 4], p1[8 * s2 + 5]), cvt_pk_bf16(p1[8 * s2 + 6], p1[8 * s2 + 7])};
    }
    TRWAIT();
#pragma unroll
    for (int ks = 0; ks < 2; ++ks) {
        const bf16x8 pa = __builtin_bit_cast(bf16x8, pw[ks]);
#pragma unroll
        for (int db = 0; db < 4; ++db) {
            const bf16x8 vf = (bf16x8){vl[ks][db][0], vl[ks][db][1], vl[ks][db][2], vl[ks][db][3], vh[ks][db][0], vh[ks][db][1], vh[ks][db][2], vh[ks][db][3]};
            o[db] = __builtin_amdgcn_mfma_f32_32x32x16_bf16(pa, vf, o[db], 0, 0, 0);
        }
    }
    __builtin_amdgcn_sched_barrier(0);
#pragma unroll
    for (int ks = 0; ks < 2; ++ks)
#pragma unroll
        for (int db = 0; db < 4; ++db) { TRR(vl[ks][db], vaddr, db * VDB2 + (2 + ks) * 1024); TRR(vh[ks][db], vaddr, db * VDB2 + (2 + ks) * 1024 + 512); }
    TRWAIT();
#pragma unroll
    for (int ks = 0; ks < 2; ++ks) {
        const bf16x8 pa = __builtin_bit_cast(bf16x8, pw[2 + ks]);
#pragma unroll
        for (int db = 0; db < 4; ++db) {
            const bf16x8 vf = (bf16x8){vl[ks][db][0], vl[ks][db][1], vl[ks][db][2], vl[ks][db][3], vh[ks][db][0], vh[ks][db][1], vh[ks][db][2], vh[ks][db][3]};
            o[db] = __builtin_amdgcn_mfma_f32_32x32x16_bf16(pa, vf, o[db], 0, 0, 0);
        }
    }
    __builtin_amdgcn_sched_barrier(0);
}
}

#define ATT2_DECODE(item, bhj_, chunk_) do { int lo_ = 0, hi_ = 1023; while (lo_ < hi_) { const int mid_ = (lo_ + hi_ + 1) >> 1; if (P[mid_] <= (item)) lo_ = mid_; else hi_ = mid_ - 1; } bhj_ = lo_; chunk_ = (item) - P[lo_]; } while (0)
__device__ __forceinline__ void ph_attn_partial(const Ctx& F) {
    using namespace att2;
    const unsigned char* Q = F.ws + WS_Q; const unsigned char* K = F.ws + WS_K; const unsigned char* V = F.ws + WS_V;
    const unsigned* LISTS = (const unsigned*)(F.ws + WS_LISTS); const unsigned* LCNT = (const unsigned*)(F.ws + WS_CTL) + CW_LCNT;
    unsigned char* OP = F.ws + WS_OP; float* LSE = (float*)(F.ws + WS_LSE);
    LAS int* P = (LAS int*)(F.lds + OFF_TAB);
    if (F.tid < 64) {
        int c[16]; int s = 0;
#pragma unroll
        for (int i = 0; i < 16; ++i) { c[i] = ((int)__hip_atomic_load(LCNT + F.tid * 16 + i, __ATOMIC_RELAXED, __HIP_MEMORY_SCOPE_AGENT) + 255) >> 8; s += c[i]; }
        int inc = s;
#pragma unroll
        for (int o = 1; o < 64; o <<= 1) { const int t = __shfl_up(inc, o); if (F.lane >= o) inc += t; }
        int run = inc - s;
#pragma unroll
        for (int i = 0; i < 16; ++i) { P[F.tid * 16 + i] = run; run += c[i]; }
        if (F.tid == 63) P[1024] = run;
    }
    __syncthreads();
    const int total = P[1024];
    LAS float* wsf = (LAS float*)(F.lds + OFF_WS + F.wave * WSW);
    LAS int* wsi = (LAS int*)wsf;
    const int r = F.lane & 31, hh = F.lane >> 5;
    int it = F.vcu;
    if (it < total) {
        int bhj, chunk; ATT2_DECODE(it, bhj, chunk);
        int itn = it + F.G, bhjn = 0, chunkn = 0; bool hasn = itn < total; if (hasn) ATT2_DECODE(itn, bhjn, chunkn);
        u32x4 rkA, rvA, rkB, rvB;
        { const int b = bhj >> 7, h = (bhj >> 4) & 7, j = bhj & 15; const size_t tb = (size_t)b * SEQ + j * LBLK;
          tile_load(F, K, V, tb, h, 0, rkA, rvA); tile_load(F, K, V, tb, h, 1, rkB, rvB); tile_write(F, 0, rkA, rvA); tile_write(F, 1, rkB, rvB);
          tile_load(F, K, V, tb, h, 2, rkA, rvA); }
        int cnt = (int)__hip_atomic_load(LCNT + bhj, __ATOMIC_RELAXED, __HIP_MEMORY_SCOPE_AGENT);
        int qi = chunk * 256 + F.wave * 32 + r;
        unsigned ent = LISTS[(size_t)bhj * 4096 + (qi < cnt ? qi : 0)];
        int tq = ent & 4095, slot = (qi < cnt) ? (int)(ent >> 12) : -1;
        u32x2 qraw[8];
        { const unsigned char* qrow = Q + ((size_t)(bhj >> 7) * SEQ + tq) * DM + ((bhj >> 4) & 7) * DH + hh * 8;
#pragma unroll
          for (int ds = 0; ds < 8; ++ds) qraw[ds] = *(const u32x2*)(qrow + ds * 16); }
        unsigned entn = 0u; int cntn = 0;
        __syncthreads();
        int s = 0;
        for (;;) {
            const int b = bhj >> 7, h = (bhj >> 4) & 7, j = bhj & 15;
            bf16x8 qr[8];
#pragma unroll
            for (int ds = 0; ds < 8; ++ds) qr[ds] = __builtin_bit_cast(bf16x8, f8x8_to_bf16x8(qraw[ds].x, qraw[ds].y));
            if (F.lane < 32) { wsi[64 + r] = tq; wsi[96 + r] = slot; }
            f32x16 o[4]; float m = -1e30f, l = 0.f;
#pragma unroll
            for (int db = 0; db < 4; ++db)
#pragma unroll
                for (int i = 0; i < 16; ++i) o[db][i] = 0.f;
#define ATT2_TB(bb) ((size_t)((bb) >> 7) * SEQ + ((bb) & 15) * LBLK)
#define ATT2_H(bb) (((bb) >> 4) & 7)
#pragma unroll 1
            for (int kp2 = 0; kp2 < 2; ++kp2) {
                const int kt = 2 * kp2;
                { const bool cur3 = kt + 3 < 4, have3 = cur3 || hasn, have2 = (kt + 2 < 4) || hasn;
                  if (have3) { const int bb = cur3 ? bhj : bhjn; tile_load(F, K, V, ATT2_TB(bb), ATT2_H(bb), (kt + 3) & 3, rkB, rvB); }
                  if (kt == 0 && hasn) { cntn = (int)__hip_atomic_load(LCNT + bhjn, __ATOMIC_RELAXED, __HIP_MEMORY_SCOPE_AGENT); }
                  if (kt == 2 && hasn) { const unsigned char* qrow = Q + ((size_t)(bhjn >> 7) * SEQ + (entn & 4095)) * DM + ((bhjn >> 4) & 7) * DH + hh * 8;
#pragma unroll
                      for (int ds = 0; ds < 8; ++ds) qraw[ds] = *(const u32x2*)(qrow + ds * 16); }
                  tile_compute(F, 0, qr, o, m, l);
                  asm volatile("s_waitcnt lgkmcnt(0)" ::: "memory"); __builtin_amdgcn_s_barrier(); asm volatile("" ::: "memory");
                  if (have2) tile_write(F, 0, rkA, rvA); }
                { const bool have4 = hasn, have3 = (kt + 3 < 4) || hasn;
                  if (have4) { tile_load(F, K, V, ATT2_TB(bhjn), ATT2_H(bhjn), kt, rkA, rvA); }
                  if (kt == 0 && hasn) { const int qn = chunkn * 256 + F.wave * 32 + r; entn = LISTS[(size_t)bhjn * 4096 + (qn < cntn ? qn : 0)]; }
                  tile_compute(F, 1, qr, o, m, l);
                  asm volatile("s_waitcnt lgkmcnt(0)" ::: "memory"); __builtin_amdgcn_s_barrier(); asm volatile("" ::: "memory");
                  if (have3) tile_write(F, 1, rkB, rvB); }
            }
            const float lt = l + __shfl_xor(l, 32);
            if (hh == 0) { wsf[r] = 1.0f / lt; wsf[32 + r] = m + __builtin_amdgcn_logf(lt); }
            asm volatile("s_waitcnt lgkmcnt(0)" ::: "memory");
            int re = r, he = hh; asm volatile("" : "+v"(re), "+v"(he));
#pragma unroll
            for (int i = 0; i < 16; ++i) {
                const int q = crow(i, he); const float a = wsf[q]; const int t = wsi[64 + q], sl = wsi[96 + q];
                const unsigned w = pack_fp8x4(o[0][i] * a, o[1][i] * a, o[2][i] * a, o[3][i] * a);
                if (sl >= 0) { const size_t row = (((size_t)sl * NB + b) * SEQ + t) * NH + h; *(unsigned*)(OP + row * DH + 4 * re) = w; }
            }
            if (he == 0 && slot >= 0) LSE[(((size_t)slot * NB + b) * SEQ + tq) * NH + h] = wsf[32 + re];
            asm volatile("s_waitcnt lgkmcnt(0)" ::: "memory");
            if (!hasn) break;
            it = itn; bhj = bhjn; chunk = chunkn; cnt = cntn;
            { const int qn = chunk * 256 + F.wave * 32 + r; tq = entn & 4095; slot = (qn < cnt) ? (int)(entn >> 12) : -1; }
            itn = it + F.G; hasn = itn < total; if (hasn) ATT2_DECODE(itn, bhjn, chunkn);
        }
    }
    __syncthreads();
}

__device__ __forceinline__ void ph_attn_own(const Ctx& F) {
    using namespace att2;
    const unsigned char* Q = F.ws + WS_Q; const unsigned char* K = F.ws + WS_K; const unsigned char* V = F.ws + WS_V;
    const unsigned char* OP = F.ws + WS_OP; const float* LSE = (const float*)(F.ws + WS_LSE); bf16_t* YAB = (bf16_t*)(F.ws + WS_YAB);
    LAS float* wsf = (LAS float*)(F.lds + OFF_WS + F.wave * WSW);
    const int r = F.lane & 31, hh = F.lane >> 5;
    constexpr int NIT = NB * NH * NBLK;
    int it = F.vcu;
    if (it < NIT) {
        int itn = it + F.G; bool hasn = itn < NIT;
        u32x4 rkA, rvA, rkB, rvB;
#define OWN_TB(i_) ((size_t)((i_) >> 7) * SEQ + ((i_) & 15) * LBLK)
#define OWN_H(i_) (((i_) >> 4) & 7)
        tile_load(F, K, V, OWN_TB(it), OWN_H(it), 0, rkA, rvA); tile_load(F, K, V, OWN_TB(it), OWN_H(it), 1, rkB, rvB); tile_write(F, 0, rkA, rvA); tile_write(F, 1, rkB, rvB);
        tile_load(F, K, V, OWN_TB(it), OWN_H(it), 2, rkA, rvA);
        u32x2 qraw[8];
        { const unsigned char* qrow = Q + (OWN_TB(it) + F.wave * 32 + r) * DM + OWN_H(it) * DH + hh * 8;
#pragma unroll
          for (int ds = 0; ds < 8; ++ds) qraw[ds] = *(const u32x2*)(qrow + ds * 16); }
        __syncthreads();
        const int wdiag = F.wave >> 1;
        for (;;) {
            const int b = it >> 7, h = (it >> 4) & 7, j = it & 15, t0 = j * LBLK + F.wave * 32;
            bf16x8 qr[8];
#pragma unroll
            for (int ds = 0; ds < 8; ++ds) qr[ds] = __builtin_bit_cast(bf16x8, f8x8_to_bf16x8(qraw[ds].x, qraw[ds].y));
            f32x16 o[4]; float m = -1e30f, l = 0.f;
#pragma unroll
            for (int db = 0; db < 4; ++db)
#pragma unroll
                for (int i = 0; i < 16; ++i) o[db][i] = 0.f;
#pragma unroll 1
            for (int kp2 = 0; kp2 < 2; ++kp2) {
                const int kt = 2 * kp2;
                { const bool cur3 = kt + 3 < 4, have3 = cur3 || hasn, have2 = (kt + 2 < 4) || hasn;
                  if (have3) { const int ii = cur3 ? it : itn; tile_load(F, K, V, OWN_TB(ii), OWN_H(ii), (kt + 3) & 3, rkB, rvB); }
                  if (kt == 2 && hasn) { const unsigned char* qrow = Q + (OWN_TB(itn) + F.wave * 32 + r) * DM + OWN_H(itn) * DH + hh * 8;
#pragma unroll
                      for (int ds = 0; ds < 8; ++ds) qraw[ds] = *(const u32x2*)(qrow + ds * 16); }
                  if (kt <= wdiag) tile_compute<true>(F, 0, qr, o, m, l, kt == wdiag);
                  asm volatile("s_waitcnt lgkmcnt(0)" ::: "memory"); __builtin_amdgcn_s_barrier(); asm volatile("" ::: "memory");
                  if (have2) tile_write(F, 0, rkA, rvA); }
                { const bool have4 = hasn, have3 = (kt + 3 < 4) || hasn;
                  if (have4) { tile_load(F, K, V, OWN_TB(itn), OWN_H(itn), kt, rkA, rvA); }
                  if (kt + 1 <= wdiag) tile_compute<true>(F, 1, qr, o, m, l, kt + 1 == wdiag);
                  asm volatile("s_waitcnt lgkmcnt(0)" ::: "memory"); __builtin_amdgcn_s_barrier(); asm volatile("" ::: "memory");
                  if (have3) tile_write(F, 1, rkB, rvB); }
            }
            const int nv = j < 3 ? j : 3;
            {
                const float lt = l + __shfl_xor(l, 32); const float lse_own = m + __builtin_amdgcn_logf(lt);
                float ls[3];
#pragma unroll
                for (int s2 = 0; s2 < 3; ++s2) ls[s2] = (s2 < nv) ? LSE[(((size_t)s2 * NB + b) * SEQ + t0 + r) * NH + h] : -1e30f;
                const float M = fmaxf(fmaxf(lse_own, ls[0]), fmaxf(ls[1], ls[2]));
                const float w0 = __builtin_amdgcn_exp2f(lse_own - M);
                float w[3], den = w0;
#pragma unroll
                for (int s2 = 0; s2 < 3; ++s2) { w[s2] = (s2 < nv) ? __builtin_amdgcn_exp2f(ls[s2] - M) : 0.f; den += w[s2]; }
                const float inv = 1.0f / den;
                if (hh == 0) { wsf[r] = w0 * inv / lt; wsf[32 + r] = w[0] * inv; wsf[64 + r] = w[1] * inv; wsf[96 + r] = w[2] * inv; }
                asm volatile("s_waitcnt lgkmcnt(0)" ::: "memory");
            }
            int re = r, he = hh; asm volatile("" : "+v"(re), "+v"(he));
            LAS float* stg = (LAS float*)(F.lds + OFF_STG + F.wave * 8192);
            {
                unsigned pv[16][3];
#pragma unroll
                for (int i = 0; i < 16; ++i) { const int q = crow(i, he);
#pragma unroll
                    for (int s2 = 0; s2 < 3; ++s2) { pv[i][s2] = 0u; if (s2 < nv) pv[i][s2] = *(const unsigned*)(OP + ((((size_t)s2 * NB + b) * SEQ + t0 + q) * NH + h) * DH + 4 * re); } }
#pragma unroll
                for (int i = 0; i < 16; ++i) { const int q = crow(i, he); const float a = wsf[q];
                    float x0 = o[0][i] * a, x1 = o[1][i] * a, x2 = o[2][i] * a, x3 = o[3][i] * a;
#pragma unroll
                    for (int s2 = 0; s2 < 3; ++s2) { const float ww = wsf[32 * (s2 + 1) + q]; const f32x2v f0 = __builtin_amdgcn_cvt_pk_f32_fp8((int)pv[i][s2], false), f1 = __builtin_amdgcn_cvt_pk_f32_fp8((int)pv[i][s2], true);
                        x0 += ww * f0.x; x1 += ww * f0.y; x2 += ww * f1.x; x3 += ww * f1.y; }
                    o[0][i] = x0; o[1][i] = x1; o[2][i] = x2; o[3][i] = x3; }
            }
#pragma unroll
            for (int half = 0; half < 2; ++half) {
#pragma unroll
                for (int i = 0; i < 16; ++i) { const int q = crow(i, he); stg[q * 64 + re] = o[2 * half][i]; stg[q * 64 + 32 + re] = o[2 * half + 1][i]; }
                asm volatile("s_waitcnt lgkmcnt(0)" ::: "memory");
#pragma unroll
                for (int ps = 0; ps < 4; ++ps) {
                    const int q = ps * 8 + ((re + 32 * he) >> 3), dc = re & 7;
                    const f32x4 x = *(LAS const f32x4*)(stg + q * 64 + dc * 8), y = *(LAS const f32x4*)(stg + q * 64 + dc * 8 + 4);
                    *(u32x4*)(YAB + ((size_t)b * SEQ + t0 + q) * 2048 + 1024 + h * DH + half * 64 + dc * 8) = (u32x4){cvt_pk_bf16(x.x, x.y), cvt_pk_bf16(x.z, x.w), cvt_pk_bf16(y.x, y.y), cvt_pk_bf16(y.z, y.w)};
                }
                asm volatile("s_waitcnt lgkmcnt(0)" ::: "memory");
            }
            if (!hasn) break;
            it = itn; itn = it + F.G; hasn = itn < NIT;
        }
#undef OWN_TB
#undef OWN_H
    }
    __syncthreads();
}

__device__ __forceinline__ void ph_router(const Ctx& F) {
    const Args& A = *F.a;
    const bf16_t* Z = (const bf16_t*)(F.ws + WS_Z); const float* ZST = (const float*)(F.ws + WS_ZST); bf16_t* H1 = (bf16_t*)(F.ws + WS_H1); unsigned char* H1F8 = F.ws + WS_H1F8;
    int* TKE = (int*)(F.ws + WS_TKE); int* TKP = (int*)(F.ws + WS_TKP); unsigned* ECNT = (unsigned*)(F.ws + WS_CTL) + CW_ECNT; int* RT = (int*)(F.ws + WS_RT); float* RW = (float*)(F.ws + WS_RW);
    const float* wr = A.in[I_WR]; const float* br = A.in[I_BR];
    constexpr int RS = 2064, OFF_LO = 32 * RS, OFF_G = 2 * 32 * RS  , OFF_B = OFF_G + 4096, OFF_LG = OFF_B + 4096  , OFF_CNT = OFF_LG + 8 * 2112  ;
    static_assert(OFF_CNT + 256 <= LDS_BYTES, "router LDS map");
    LAS unsigned char* WH = F.lds; LAS unsigned char* WL = F.lds + OFF_LO;
    LAS float* LG = (LAS float*)(F.lds + OFF_G); LAS float* LB = (LAS float*)(F.lds + OFF_B);
    LAS float* lgt = (LAS float*)(F.lds + OFF_LG + F.wave * 2112);
    LAS unsigned* lcnt = (LAS unsigned*)(F.lds + OFF_CNT);
    {
        f32x4 wa[8], wb[8];
#pragma unroll
        for (int u_ = 0; u_ < 8; ++u_) { const int i = F.tid + 512 * u_, nq = i & 7, k2 = i >> 3;
            wa[u_] = *(const f32x4*)(wr + (size_t)(2 * k2) * NE + 4 * nq); wb[u_] = *(const f32x4*)(wr + (size_t)(2 * k2 + 1) * NE + 4 * nq); }
#pragma unroll
        for (int u_ = 0; u_ < 8; ++u_) { const int i = F.tid + 512 * u_, nq = i & 7, k2 = i >> 3;
#pragma unroll
            for (int c = 0; c < 4; ++c) {
                const float w0 = wa[u_][c], w1 = wb[u_][c];
                const unsigned h0 = f2bf(w0), h1 = f2bf(w1);
                const float r0 = w0 - __uint_as_float(h0 << 16), r1 = w1 - __uint_as_float(h1 << 16);
                *(LAS unsigned*)(WH + (4 * nq + c) * RS + k2 * 4) = h0 | (h1 << 16);
                *(LAS unsigned*)(WL + (4 * nq + c) * RS + k2 * 4) = pk2(r0, r1);
            } }
    }
    for (int i = F.tid; i < DM; i += 512) { LG[i] = A.in[I_LNMIX_G][i]; LB[i] = A.in[I_LNMIX_B][i]; }
    if (F.tid < 64) lcnt[F.tid] = 0u;
    __syncthreads();
    const int fr = F.lane & 15, kg = F.lane >> 4;
    const int ntask = T / 16, NGW = F.G * 8;
    const int rounds = (ntask + NGW - 1) / NGW;
    for (int rd = 0; rd < rounds; ++rd) {
        const int task = rd * NGW + F.vcu * 8 + F.wave;
        const bool live = task < ntask;
        int te[4] = {0, 0, 0, 0}; float tw[4] = {0.f, 0.f, 0.f, 0.f}; unsigned lp[4] = {0, 0, 0, 0};
        if (live) {
            const int tok = task * 16 + fr;
            float mean, rstd;
            { const f32x4* sp = (const f32x4*)(ZST + (size_t)tok * 32); float s1 = 0.f, s2 = 0.f;
#pragma unroll
              for (int i = 0; i < 8; ++i) { const f32x4 v = sp[i]; s1 += v.x + v.z; s2 += v.y + v.w; }
              mean = s1 * (1.f / DM); const float var = s2 * (1.f / DM) - mean * mean; rstd = 1.f / sqrtf(fmaxf(var, 0.f) + LN_EPS); }
            f32x4 acc0 = {0.f, 0.f, 0.f, 0.f}, acc1 = {0.f, 0.f, 0.f, 0.f};
            const bf16_t* zp = Z + (size_t)tok * DM + 8 * kg; unsigned char* h8 = H1F8 + (size_t)tok * DM + 8 * kg;
#pragma unroll 8
            for (int kk = 0; kk < 32; ++kk) {
                const u32x4 zr = *(const u32x4*)(zp + 32 * kk); const f32x4 z0 = {bflo(zr.x), bfhi(zr.x), bflo(zr.y), bfhi(zr.y)}, z1 = {bflo(zr.z), bfhi(zr.z), bflo(zr.w), bfhi(zr.w)};
                const f32x4 g0 = *(LAS const f32x4*)(LG + 32 * kk + 8 * kg), g1 = *(LAS const f32x4*)(LG + 32 * kk + 8 * kg + 4);
                const f32x4 b0 = *(LAS const f32x4*)(LB + 32 * kk + 8 * kg), b1 = *(LAS const f32x4*)(LB + 32 * kk + 8 * kg + 4);
                const f32x4 x0 = (z0 - mean) * rstd * g0 + b0, x1 = (z1 - mean) * rstd * g1 + b1;
                u32x4 hi; hi.x = cvt_pk_bf16(x0.x, x0.y); hi.y = cvt_pk_bf16(x0.z, x0.w); hi.z = cvt_pk_bf16(x1.x, x1.y); hi.w = cvt_pk_bf16(x1.z, x1.w);
                { unsigned w0 = 0u, w1 = 0u;
                  w0 = __builtin_amdgcn_cvt_pk_fp8_f32(x0.x, x0.y, w0, false); w0 = __builtin_amdgcn_cvt_pk_fp8_f32(x0.z, x0.w, w0, true);
                  w1 = __builtin_amdgcn_cvt_pk_fp8_f32(x1.x, x1.y, w1, false); w1 = __builtin_amdgcn_cvt_pk_fp8_f32(x1.z, x1.w, w1, true);
                  *(u32x2*)(h8 + 32 * kk) = (u32x2){w0, w1}; }
                u32x4 lo; lo.x = cvt_pk_bf16(x0.x - bflo(hi.x), x0.y - bfhi(hi.x)); lo.y = cvt_pk_bf16(x0.z - bflo(hi.y), x0.w - bfhi(hi.y));
                lo.z = cvt_pk_bf16(x1.x - bflo(hi.z), x1.y - bfhi(hi.z)); lo.w = cvt_pk_bf16(x1.z - bflo(hi.w), x1.w - bfhi(hi.w));
                const bf16x8 ah = __builtin_bit_cast(bf16x8, hi), al = __builtin_bit_cast(bf16x8, lo);
                const int bo = fr * RS + (32 * kk + 8 * kg) * 2;
                const bf16x8 wh0 = *(LAS const bf16x8*)(WH + bo), wh1 = *(LAS const bf16x8*)(WH + bo + 16 * RS), wl0 = *(LAS const bf16x8*)(WL + bo), wl1 = *(LAS const bf16x8*)(WL + bo + 16 * RS);
                acc0 = __builtin_amdgcn_mfma_f32_16x16x32_bf16(ah, wh0, acc0, 0, 0, 0); acc1 = __builtin_amdgcn_mfma_f32_16x16x32_bf16(ah, wh1, acc1, 0, 0, 0);
                acc0 = __builtin_amdgcn_mfma_f32_16x16x32_bf16(ah, wl0, acc0, 0, 0, 0); acc1 = __builtin_amdgcn_mfma_f32_16x16x32_bf16(ah, wl1, acc1, 0, 0, 0);
                acc0 = __builtin_amdgcn_mfma_f32_16x16x32_bf16(al, wh0, acc0, 0, 0, 0); acc1 = __builtin_amdgcn_mfma_f32_16x16x32_bf16(al, wh1, acc1, 0, 0, 0);
            }
            const float br0 = br[fr], br1 = br[16 + fr];
#pragma unroll
            for (int i = 0; i < 4; ++i) { lgt[(4 * kg + i) * 33 + fr] = acc0[i] + br0; lgt[(4 * kg + i) * 33 + 16 + fr] = acc1[i] + br1; }
            asm volatile("s_waitcnt lgkmcnt(0)" ::: "memory");
            if (F.lane < 16) {
                float lg[NE];
#pragma unroll
                for (int e = 0; e < NE; ++e) lg[e] = lgt[F.lane * 33 + e];
                float tv[4];
#pragma unroll
                for (int r = 0; r < 4; ++r) {
                    float best = -INFINITY; int bi = 0;
#pragma unroll
                    for (int e = 0; e < NE; ++e) { const bool c = lg[e] > best; best = c ? lg[e] : best; bi = c ? e : bi; }
#pragma unroll
                    for (int e = 0; e < NE; ++e) lg[e] = (e == bi) ? -INFINITY : lg[e];
                    te[r] = bi; tv[r] = best;
                }
                const float e1 = __expf(tv[1] - tv[0]), e2 = __expf(tv[2] - tv[0]), e3 = __expf(tv[3] - tv[0]); const float inv = 1.f / (1.f + e1 + e2 + e3);
                tw[0] = inv; tw[1] = e1 * inv; tw[2] = e2 * inv; tw[3] = e3 * inv;
#pragma unroll
                for (int r = 0; r < 4; ++r) lp[r] = atomicAdd((unsigned*)(lcnt + te[r]), 1u);
            }
        }
        __syncthreads();
        if (F.tid < 32) { const unsigned c = lcnt[F.tid]; lcnt[32 + F.tid] = c ? atomicAdd(&ECNT[F.tid], c) : 0u; }
        __syncthreads();
        if (live && F.lane < 16) {
            const size_t tok = (size_t)task * 16 + F.lane;
            int4 pe = {te[0], te[1], te[2], te[3]};
            int4 pp = {(int)(lcnt[32 + te[0]] + lp[0]), (int)(lcnt[32 + te[1]] + lp[1]), (int)(lcnt[32 + te[2]] + lp[2]), (int)(lcnt[32 + te[3]] + lp[3])};
            *(int4*)(TKE + tok * 4) = pe; *(int4*)(TKP + tok * 4) = pp;
#pragma unroll
            for (int r = 0; r < 4; ++r) { const size_t o_ = (size_t)te[r] * T + (r == 0 ? pp.x : r == 1 ? pp.y : r == 2 ? pp.z : pp.w); RT[o_] = (int)tok; RW[o_] = tw[r]; }
        }
        __syncthreads();
        if (F.tid < 32) lcnt[F.tid] = 0u;
        __syncthreads();
    }
}

__device__ __forceinline__ void moe_table(const Ctx& F) {
    const unsigned* ECNT = (const unsigned*)(F.ws + WS_CTL) + CW_ECNT;
    LAS int* tab = (LAS int*)(F.lds + LDS_MOE);
    __syncthreads();
    if (F.tid == 0) {
        int acc = 0;
        for (int e = 0; e < NE; ++e) { const int c = (int)__hip_atomic_load(ECNT + e, __ATOMIC_RELAXED, __HIP_MEMORY_SCOPE_AGENT); tab[32 + e] = acc; acc += (c + 255) / 256 * 256; }
        tab[64] = acc; tab[0] = acc / 256;
    }
    __syncthreads();
    const int ntiles = tab[0];
    for (int i = F.tid; i < ntiles; i += 512) { int e = 0; for (int k = 1; k < NE; ++k) if (i * 256 >= tab[32 + k]) e = k; tab[128 + 2 * i] = e; tab[129 + 2 * i] = i - tab[32 + e] / 256; }
    __syncthreads();
}

__device__ __forceinline__ void ln_stats16(const float* st, int lane, float& mean, float& rstd) {
    float s1 = 0.f, s2 = 0.f;
    if (lane < 16) { const f32x2 p = *(const f32x2*)(st + 2 * lane); s1 = p.x; s2 = p.y; }
    s1 = wave_sum(s1); s2 = wave_sum(s2);
    mean = s1 * (1.f / DM); const float var = s2 * (1.f / DM) - mean * mean; rstd = 1.f / sqrtf(fmaxf(var, 0.f) + LN_EPS);
}
__device__ __forceinline__ void ph_final(const Ctx& F) {
    const Args& A = *F.a;
    const bf16_t* Z = (const bf16_t*)(F.ws + WS_Z); const float* ZST = (const float*)(F.ws + WS_ZST); const unsigned char* YS = F.ws + WS_YS; const int* TKE = (const int*)(F.ws + WS_TKE); const int* TKP = (const int*)(F.ws + WS_TKP);
    const LAS int* tab = (const LAS int*)(F.lds + LDS_MOE);
    const int gw = F.vcu * 8 + F.wave, NGW = F.G * 8;
    f32x4 g2[4], b2[4], g1[4], b1[4];
#pragma unroll
    for (int j = 0; j < 4; ++j) { g2[j] = *((const f32x4*)A.in[I_LNF_G] + F.lane + 64 * j); b2[j] = *((const f32x4*)A.in[I_LNF_B] + F.lane + 64 * j);
        g1[j] = *((const f32x4*)A.in[I_LNMIX_G] + F.lane + 64 * j) * ALPHA; b1[j] = *((const f32x4*)A.in[I_LNMIX_B] + F.lane + 64 * j) * ALPHA; }
    for (int m = gw; m < T; m += NGW) {
        float mean, rstd; ln_stats16(ZST + (size_t)m * 32, F.lane, mean, rstd);
        const u32x2* hr = (const u32x2*)(Z + (size_t)m * DM) + F.lane;
        f32x4 v[4];
#pragma unroll
        for (int j = 0; j < 4; ++j) { const u32x2 hb = hr[64 * j]; v[j] = ((f32x4){bflo(hb.x), bfhi(hb.x), bflo(hb.y), bfhi(hb.y)} - mean) * rstd * g1[j] + b1[j]; }
#pragma unroll
        for (int k = 0; k < 4; ++k) {
            const int row = tab[32 + TKE[(size_t)m * 4 + k]] + TKP[(size_t)m * 4 + k]; const unsigned* yr = (const unsigned*)(YS + (size_t)row * DM) + F.lane;
#pragma unroll
            for (int j = 0; j < 4; ++j) { const unsigned y = yr[64 * j]; const f32x2v f0 = __builtin_amdgcn_cvt_pk_f32_fp8((int)y, false), f1 = __builtin_amdgcn_cvt_pk_f32_fp8((int)y, true);
                v[j].x += 0.0625f * f0.x; v[j].y += 0.0625f * f0.y; v[j].z += 0.0625f * f1.x; v[j].w += 0.0625f * f1.y; }
        }
        float s = 0.f;
#pragma unroll
        for (int j = 0; j < 4; ++j) s += (v[j].x + v[j].y) + (v[j].z + v[j].w);
        const float mu = wave_sum(s) * (1.f / DM); float s2 = 0.f;
#pragma unroll
        for (int j = 0; j < 4; ++j) { v[j] = v[j] - mu; s2 += (v[j].x * v[j].x + v[j].y * v[j].y) + (v[j].z * v[j].z + v[j].w * v[j].w); }
        const float rs = 1.f / sqrtf(wave_sum(s2) * (1.f / DM) + LN_EPS);
        f32x4* orow = (f32x4*)(A.out + (size_t)m * DM) + F.lane;
#pragma unroll
        for (int j = 0; j < 4; ++j) orow[64 * j] = v[j] * rs * g2[j] + b2[j];
    }
}

#define XB_TMO      128
#define XB_XCNT(j)  (256  + 64 * (j))
#define XB_XSUB(j)  (1280 + 64 * (j))
#define XB_XGEN(j)  (2304 + 64 * (j))
#define XB_TOP      3328
#define XB_TOPGEN   3392
#define XCD_BAR_WORDS 3456
#define XB_SPIN_CAP (1u << 18)
__device__ __forceinline__ unsigned xb_ld(unsigned* p)              { return __hip_atomic_load(p, __ATOMIC_RELAXED, __HIP_MEMORY_SCOPE_AGENT); }
__device__ __forceinline__ unsigned xb_add(unsigned* p, unsigned v) { return __hip_atomic_fetch_add(p, v, __ATOMIC_RELAXED, __HIP_MEMORY_SCOPE_AGENT); }
__device__ __forceinline__ unsigned xb_xcc_id() { return (unsigned)__builtin_amdgcn_s_getreg((3 << 11) | 20) & 0xFu; }
#define XB_SPIN(cond, bar) do { unsigned _sp = 0; while (cond) { __builtin_amdgcn_s_sleep(1); \
    if ((++_sp & 255u) == 0u) { if (xb_ld(&(bar)[XB_TMO])) break; if (_sp > XB_SPIN_CAP) { atomicAdd(&(bar)[XB_TMO], 1u); break; } } } } while (0)
__device__ __forceinline__ void xcd_barrier_complete(unsigned* bar, unsigned x, unsigned& nloc, unsigned& nx) {
    const unsigned G = gridDim.x * gridDim.y * gridDim.z;
    unsigned sum, cnt, mine, sp = 0u;
    for (;;) {
        sum = 0u; cnt = 0u; mine = 0u;
#pragma unroll
        for (unsigned j = 0; j < 16; ++j) { const unsigned c = xb_ld(&bar[XB_XCNT(j)]); sum += c; cnt += (c > 0u) ? 1u : 0u; mine = (j == x) ? c : mine; }
        if (sum == G) break;
        __builtin_amdgcn_s_sleep(1);
        if ((++sp & 255u) == 0u) { if (xb_ld(&bar[XB_TMO])) break; if (sp > XB_SPIN_CAP) { atomicAdd(&bar[XB_TMO], 1u); break; } }
    }
    nloc = mine > 0u ? mine : 1u; nx = cnt > 0u ? cnt : 1u;
}
__device__ __forceinline__ void xcd_barrier(unsigned* bar, volatile LAS unsigned* st, unsigned x, bool leader_thread) {
    asm volatile("s_waitcnt vmcnt(0)" ::: "memory");
    __syncthreads();
    if (leader_thread) {
        __builtin_amdgcn_s_waitcnt(0);
        unsigned nloc = st[0], nx = st[1];
        if (nloc == 0u) { xcd_barrier_complete(bar, x, nloc, nx); st[0] = nloc; st[1] = nx; }
        const unsigned old = xb_add(&bar[XB_XSUB(x)], 1u);
        const unsigned gen = old / nloc;
        if (old + 1u == (gen + 1u) * nloc) {
            __builtin_amdgcn_fence(__ATOMIC_RELEASE, "agent");
            asm volatile("s_waitcnt vmcnt(0)" ::: "memory");
            const unsigned og = xb_add(&bar[XB_TOP], 1u);
            const unsigned tg = og / nx;
            if (og + 1u == (tg + 1u) * nx) xb_add(&bar[XB_TOPGEN], 1u);
            else XB_SPIN(xb_ld(&bar[XB_TOPGEN]) == tg, bar);
            __builtin_amdgcn_fence(__ATOMIC_ACQUIRE, "agent");
            xb_add(&bar[XB_XGEN(x)], 1u);
            asm volatile("s_waitcnt vmcnt(0)" ::: "memory");
        } else {
            XB_SPIN(xb_ld(&bar[XB_XGEN(x)]) == gen, bar);
            __builtin_amdgcn_fence(__ATOMIC_ACQUIRE, "agent");
            asm volatile("s_waitcnt vmcnt(0)" ::: "memory");
        }
    }
    __syncthreads();
}

template <bool COOP>
__global__ void __launch_bounds__(512, 2) mega(Args args) {
    extern __shared__ __attribute__((aligned(16))) unsigned char lds_raw[];
    Ctx F;
    const int wave0 = __builtin_amdgcn_readfirstlane(threadIdx.x >> 6);
#define MKCTX() do { F.a = &args; F.ws = args.ws; F.lds = (LAS unsigned char*)lds_raw; F.ldsg = lds_raw; F.lane = lane_id_asm(); F.wave = wave0; F.tid = wave0 * 64 + F.lane; \
    F.G = gridDim.x; { const int bx = blockIdx.x; F.vcu = (F.G % 8 == 0) ? (bx % 8) * (F.G / 8) + bx / 8 : bx; } } while (0)
    MKCTX();
    const int lo = args.ph_lo, hi = args.ph_hi;
    unsigned char* ws = args.ws;
#ifndef PHMASK
#define PHMASK 0xFFFF
#endif
#define IN(k) (((PHMASK >> (k)) & 1) && lo <= (k) && (k) < hi)
    unsigned* barw = (unsigned*)(ws + WS_CTL) + CW_BAR; volatile LAS unsigned* bst = (volatile LAS unsigned*)((LAS unsigned char*)lds_raw + LDS_BYTES - 64);
    const unsigned my_xcc = xb_xcc_id();
    if (COOP) { if (threadIdx.x == 0) { bst[0] = 0u; bst[1] = 0u; (void)xb_add(&barw[XB_XCNT(my_xcc)], 1u); } __syncthreads(); }
#define SEAM(k) do { if (COOP && IN(k) && IN((k) + 1)) { if (args.ph_hi > 1000) cg::this_grid().sync();   xcd_barrier(barw, bst, my_xcc, wave0 == 0 && lane_id_asm() == 0); } } while (0)
    if (IN(0)) { MKCTX(); ph_prologue(F); } SEAM(0);
    if (IN(1)) {
        {
            pg8::Gemm g{(const bf16_t*)(ws + WS_H0), (const bf16_t*)(ws + WS_WIN), DM, DM, DM, nullptr}; pg8::StaticOrder S; S.init(T, (PN8_LO + 28 - PN8_HI) * 256, F.G, (int)blockIdx.x, 0, PN8_LO, PN8_HI - PN8_LO);
            const pg8::Epi1 E{(bf16_t*)(ws + WS_YAB), (bf16_t*)(ws + WS_GV), ws + WS_Q, ws + WS_K, ws + WS_V, (bf16_t*)(ws + WS_SA), (bf16_t*)(ws + WS_SB), (float*)(ws + WS_GVST), (float*)(ws + WS_KMEAN), 1.0f, 0.f};
            pg8::gemm_phase<pg8::Epi1, pg8::StaticOrder, true>(F.lds, g, S, E, wave0);
        }
        {
            const pg8::Epi1 E{(bf16_t*)(ws + WS_YAB), (bf16_t*)(ws + WS_GV), ws + WS_Q, ws + WS_K, ws + WS_V, (bf16_t*)(ws + WS_SA), (bf16_t*)(ws + WS_SB), (float*)(ws + WS_GVST), (float*)(ws + WS_KMEAN), 0.03125f, 0.f};
            pg8::Gemm g{(const bf16_t*)(ws + WS_H0F8), (const bf16_t*)(ws + WS_WIN8), DM / 2, DM / 2, DM / 2, nullptr}; pg8::StaticOrder S; S.init(T, (PN8_HI - PN8_LO) * 256, F.G, (int)blockIdx.x, PN8_LO);
            pg8::gemm_phase<pg8::Epi1, pg8::StaticOrder, true, true>(F.lds, g, S, E, wave0);
        }
    } SEAM(1);
    if (IN(2)) { MKCTX(); ph_mixer_a(F); __syncthreads(); ph_gate(F); } SEAM(2);
    if (IN(3)) { } if (COOP && IN(3) && IN(4)) { }
    if (IN(4)) { MKCTX(); ph_attn_partial(F); } SEAM(4);
    if (IN(5)) { MKCTX(); ph_attn_own(F); } SEAM(5);
    if (IN(6)) {
        pg8::Gemm g{(const bf16_t*)(ws + WS_YAB), (const bf16_t*)(ws + WS_WAB), 2048, 2048, 2048, nullptr}; pg8::StaticOrder S; S.init(T, DM, F.G, (int)blockIdx.x);
        pg8::Epi2 E{ws + WS_SA, ws + WS_SB, (bf16_t*)(ws + WS_MG)};
        pg8::gemm_phase<pg8::Epi2, pg8::StaticOrder, true>(F.lds, g, S, E, wave0);
    } SEAM(6);
    if (IN(7)) {
        pg8::Gemm g{(const bf16_t*)(ws + WS_MG), (const bf16_t*)(ws + WS_WOUT), DM, DM, DM, nullptr}; pg8::StaticOrder S; S.init(T, DM, F.G, (int)blockIdx.x);
        pg8::Epi3 E{(const bf16_t*)(ws + WS_H0), (bf16_t*)(ws + WS_Z), (float*)(ws + WS_ZST)};
        pg8::gemm_phase<pg8::Epi3, pg8::StaticOrder, true>(F.lds, g, S, E, wave0);
    } SEAM(7);
    if (IN(8)) { MKCTX(); ph_router(F); } SEAM(8);
    if (IN(9)) { } if (COOP && IN(9) && IN(10)) { }
    if (IN(10)) {
        MKCTX(); moe_table(F);
        pg8::Gemm g{(const bf16_t*)(ws + WS_H1F8), (const bf16_t*)(ws + WS_WUP), DM / 2, DM / 2, DM / 2, (const int*)(ws + WS_RT)}; pg8::MoeOrder S;   S.init((const LAS int*)(F.lds + LDS_MOE), 8, F.G, (int)blockIdx.x);
        pg8::Epi4 E{args.in[I_BUP], ws + WS_ACT};
        pg8::gemm_phase<pg8::Epi4, pg8::MoeOrder, true, true, true>(F.lds, g, S, E, wave0);
    } SEAM(10);
    if (IN(11)) {
        MKCTX(); moe_table(F);
        pg8::Gemm g{(const bf16_t*)(ws + WS_ACT), (const bf16_t*)(ws + WS_WDN), FF / 2, FF / 2, FF / 2, nullptr}; pg8::MoeOrder S; S.init((const LAS int*)(F.lds + LDS_MOE), 4, F.G, (int)blockIdx.x);
        pg8::Epi5 E{args.in[I_BDN], (const float*)(ws + WS_RW), ws + WS_YS};
        pg8::gemm_phase<pg8::Epi5, pg8::MoeOrder, true, true>(F.lds, g, S, E, wave0);
    } SEAM(11);
    if (IN(12)) { MKCTX(); moe_table(F); ph_final(F); }
#undef IN
#undef SEAM
}

extern "C" void kernel_launch(void* const* d_in, const int* in_sizes, int n_in, void* d_out, int out_size, void* d_ws, size_t ws_size, hipStream_t stream) {
    static int grid = 0;
    if (grid == 0) {
        if (n_in != 21 || in_sizes[0] != T * DM || out_size != T * DM || ws_size < WS_END) { fprintf(stderr, "kernel_launch: unexpected shapes (n_in %d, in0 %d, out %d, ws %zu)\n", n_in, n_in > 0 ? in_sizes[0] : -1, out_size, ws_size); grid = -1; return; }
        int dev = 0, cus = 0, per_cu = 0;
        hipGetDevice(&dev); hipDeviceGetAttribute(&cus, hipDeviceAttributeMultiprocessorCount, dev);
        const void* fn = MK_COOP ? (const void*)mega<true> : (const void*)mega<false>;
        hipFuncSetAttribute(fn, hipFuncAttributeMaxDynamicSharedMemorySize, LDS_BYTES);
        hipOccupancyMaxActiveBlocksPerMultiprocessor(&per_cu, fn, 512, LDS_BYTES);
        (void)hipGetLastError();
        if (per_cu < 1) { fprintf(stderr, "kernel_launch: occupancy query says %d blocks/CU\n", per_cu); per_cu = 1; }
        grid = cus * 1;
    }
    if (grid < 0) return;
    hipMemsetAsync((char*)d_ws + WS_CTL, 0, CTL_ZERO_BYTES, stream);
    Args a{};
    for (int i = 0; i < 21; ++i) a.in[i] = (const float*)d_in[i];
    a.out = (float*)d_out; a.ws = (unsigned char*)d_ws;
#if MK_COOP
    a.ph_lo = 0; a.ph_hi = NPHASE;
    void* kargs[] = {&a};
    hipError_t e = hipLaunchCooperativeKernel((const void*)mega<true>, dim3(grid), dim3(512), kargs, LDS_BYTES, stream);
    if (e != hipSuccess) fprintf(stderr, "cooperative launch failed: %s (grid %d)\n", hipGetErrorString(e), grid);
#else
    for (int p = 0; p < NPHASE; ++p) { a.ph_lo = p; a.ph_hi = p + 1; hipLaunchKernelGGL(mega<false>, dim3(grid), dim3(512), LDS_BYTES, stream, a); }
#endif
}
```

```cpp
#include <hip/hip_runtime.h>
#include <hip/hip_cooperative_groups.h>
#include <cstdio>
#include <cstdint>
namespace cg = cooperative_groups;

#ifndef MK_COOP
#define MK_COOP 1
#endif

#define LAS __attribute__((address_space(3)))
typedef unsigned short bf16_t;
typedef short bf16x8 __attribute__((ext_vector_type(8)));
typedef float f32x4 __attribute__((ext_vector_type(4)));
typedef float f32x2 __attribute__((ext_vector_type(2)));
typedef unsigned u32x4 __attribute__((ext_vector_type(4)));
typedef unsigned u32x2 __attribute__((ext_vector_type(2)));

constexpr int NB = 8, SEQ = 4096, DM = 1024, T = NB * SEQ;
constexpr int NH = 8, DH = 128, LBLK = 256, NBLK = SEQ / LBLK;
constexpr int NE = 32, TOPK = 4, FF = 1024;
constexpr int INCOLS = 7 * DM;
constexpr int RMAX = T * TOPK + NE * 256;
constexpr float LN_EPS = 1e-5f;
constexpr float ALPHA = 1.189207115002721f;
constexpr float QSCALE = 0.08838834764831845f * 1.4426950408889634f;

constexpr size_t MiB = 1u << 20, U64 = 64 * MiB;
constexpr size_t WS_CTL = 0, CTL_ZERO_BYTES = 1 * MiB;
constexpr int CW_ECNT = 64;
constexpr int CW_LCNT = 1024;
constexpr int CW_BAR = 4096;
constexpr size_t WS_KMEAN = 1 * MiB;
constexpr size_t WS_GVST = 2 * MiB;
constexpr size_t WS_ZST = 6 * MiB;
constexpr size_t WS_SEL = 10 * MiB;
constexpr size_t WS_TKE = 11 * MiB;
constexpr size_t WS_TKW = 11 * MiB + 512 * 1024;
constexpr size_t WS_TKP = 12 * MiB;
constexpr size_t WS_ROWOF = 12 * MiB + 512 * 1024;
constexpr size_t WS_ROWTOK = 13 * MiB;
constexpr size_t WS_ROWW = 14 * MiB;
constexpr size_t WS_TILE = 15 * MiB;
constexpr size_t WS_LISTS = 16 * MiB;
constexpr size_t WS_LSE = 32 * MiB;
constexpr size_t WS_RT = 16 * MiB;
constexpr size_t WS_RW = 20 * MiB;
constexpr int LDS_MOE = 131072 + 1024;
constexpr size_t WS_WIN = 40 * MiB;
constexpr size_t WS_WAB = 54 * MiB;
constexpr size_t WS_WOUT = 58 * MiB;
constexpr size_t WS_WDN = 60 * MiB;
constexpr size_t WS_WUP = 124 * MiB;
constexpr size_t WS_H0 = 4 * U64;
constexpr size_t WS_YAB = 5 * U64;
constexpr size_t WS_GV = 7 * U64;
constexpr size_t WS_Q = 8 * U64, WS_K = 9 * U64, WS_V = 10 * U64, WS_SA = 11 * U64, WS_SB = 12 * U64;
constexpr size_t WS_OP = 13 * U64;
constexpr size_t WS_MG = WS_GV;
constexpr size_t WS_Z = 14 * U64;
constexpr size_t WS_H1 = WS_H0;
constexpr size_t WS_XG = 5 * U64;
constexpr size_t WS_H1F8 = 12 * U64;
constexpr size_t WS_ACT = 9 * U64 + 16 * MiB;
constexpr size_t WS_YS = WS_XG;
constexpr size_t WS_H0F8 = 13 * U64;
constexpr size_t WS_WIN8 = 192 * MiB;
constexpr int PN8_LO = 8, PN8_HI = 28;
constexpr size_t WS_END = 16 * U64;
static_assert(WS_XG + (size_t)RMAX * 2048 <= WS_ACT && WS_ACT + (size_t)RMAX * 2048 <= WS_Z, "ws map");

constexpr int LDS_BYTES = 163840;
constexpr int LDS_MISC = 131072;
constexpr int NPHASE = 13;

__device__ __forceinline__ float bf2f(bf16_t v) { return __uint_as_float((unsigned)v << 16); }
__device__ __forceinline__ float bflo(unsigned u) { return __uint_as_float(u << 16); }
__device__ __forceinline__ float bfhi(unsigned u) { return __uint_as_float(u & 0xffff0000u); }
__device__ __forceinline__ unsigned f2bf(float f) { unsigned u = __builtin_bit_cast(unsigned, f); return (u + 0x7fffu + ((u >> 16) & 1u)) >> 16; }
__device__ __forceinline__ unsigned pk2(float lo, float hi) { return f2bf(lo) | (f2bf(hi) << 16); }
typedef __bf16 bf16x2_t __attribute__((ext_vector_type(2)));
__device__ __forceinline__ unsigned cvt_pk_bf16(float lo, float hi) { f32x2 v = {lo, hi}; bf16x2_t b = __builtin_convertvector(v, bf16x2_t); return __builtin_bit_cast(unsigned, b); }
__device__ __forceinline__ int lane_id_asm() { int l; asm volatile("v_mbcnt_lo_u32_b32 %0, -1, 0\n\tv_mbcnt_hi_u32_b32 %0, -1, %0" : "=v"(l)); return l; }
__device__ __forceinline__ float wave_sum(float v) {
#pragma unroll
    for (int o = 1; o < 64; o <<= 1) v += __shfl_xor(v, o);
    return v;
}
__device__ __forceinline__ float wave_max(float v) {
#pragma unroll
    for (int o = 1; o < 64; o <<= 1) v = fmaxf(v, __shfl_xor(v, o));
    return v;
}
__device__ __forceinline__ f32x2 gelu_pk(f32x2 v) {
    const f32x2 av = __builtin_elementwise_abs(v), d = av * 0.2316418882f + 1.0f;
    f32x2 t; t.x = __builtin_amdgcn_rcpf(d.x); t.y = __builtin_amdgcn_rcpf(d.y);
    f32x2 q = t * 0.5307027145f + (-0.7265760135f); q = q * t + 0.7107068705f; q = q * t + (-0.142248368f); q = q * t + 0.127414796f; q = q * t;
    const f32x2 s = (v * v) * (-0.72134752044f);
    f32x2 e; e.x = __builtin_amdgcn_exp2f(s.x); e.y = __builtin_amdgcn_exp2f(s.y);
    const f32x2 m = v * (q * e), r = v - m;
    f32x2 o; o.x = v.x < 0.f ? m.x : r.x; o.y = v.y < 0.f ? m.y : r.y; return o;
}
typedef float f32x2v __attribute__((ext_vector_type(2)));
template <bool HI> __device__ __forceinline__ unsigned f8x2_to_bf16x2(unsigned w) { const f32x2v f = __builtin_amdgcn_cvt_pk_f32_fp8((int)w, HI); return cvt_pk_bf16(f.x, f.y); }
__device__ __forceinline__ u32x4 f8x8_to_bf16x8(unsigned lo, unsigned hi) { return (u32x4){f8x2_to_bf16x2<false>(lo), f8x2_to_bf16x2<true>(lo), f8x2_to_bf16x2<false>(hi), f8x2_to_bf16x2<true>(hi)}; }
__device__ __forceinline__ unsigned pack_fp8x4(float a, float b, float c, float d) { unsigned w = 0u; w = __builtin_amdgcn_cvt_pk_fp8_f32(a, b, w, false); w = __builtin_amdgcn_cvt_pk_fp8_f32(c, d, w, true); return w; }
__device__ __forceinline__ float sigmoidf_(float x) { return __builtin_amdgcn_rcpf(1.0f + __builtin_amdgcn_exp2f(-1.4426950408889634f * x)); }

namespace pg8 {
constexpr int BM = 256, BK = 64, HALF = 128, HTB = HALF * BK * 2, STAGE_BYTES = 8 * HTB, NXCD = 8, WGM = 8;
__host__ __device__ __forceinline__ int lds_byte(int r, int c) { const int st = (r >> 4) * 2 + (c >> 5), rr = r & 15, cc = c & 31, ob = rr * 64 + cc * 2; return st * 1024 + (ob ^ (((ob >> 9) & 1) << 5)); }
__host__ __device__ __forceinline__ void stage_rc(int b, int& R, int& C) { const int st = b / 1024, sb = b % 1024, swz = sb ^ (((sb >> 9) & 1) << 5); R = (st >> 1) * 16 + swz / 64; C = (st & 1) * 32 + (swz % 64) / 2; }
__host__ __device__ __forceinline__ int perm32(int rho) { const int n = rho >> 4, i = rho & 15; return 8 * (i >> 2) + 4 * n + (i & 3); }

struct Unit { int pm, pn, bt, rbase; };
struct Gemm { const bf16_t* A; const bf16_t* Bt; int K, lda, ldb; const int* rowidx; };

struct StaticOrder {
    int nM, nN, nwg, G, c, pbase, psplit, pjump;
    __device__ void init(int M, int N, int G_, int c_, int pbase_ = 0, int psplit_ = 1 << 20, int pjump_ = 0) { nM = M / BM; nN = N / BM; nwg = nM * nN; G = G_; c = c_; pbase = pbase_; psplit = psplit_; pjump = pjump_; }
    __device__ bool next(int i, Unit& u) const {
        const long L = (long)i * G + c; if (L >= nwg) return false;
        int wgid = (int)L; { const int q = nwg / NXCD, r = nwg % NXCD, xcd = wgid % NXCD, off = wgid / NXCD; wgid = (xcd < r ? xcd * (q + 1) : r * (q + 1) + (xcd - r) * q) + off; }
        const int nig = WGM * nN, gid = wgid / nig, fm = gid * WGM, gsz = (nM - fm) < WGM ? (nM - fm) : WGM;
        u.pm = fm + ((wgid % nig) % gsz); const int p = (wgid % nig) / gsz; u.pn = pbase + (p < psplit ? p : p + pjump); u.bt = u.pn; u.rbase = u.pm * BM; return true;
    }
};
struct MoeOrder {
    int nM, nN, nwg, G, c; const LAS int* tab;
    __device__ void init(const LAS int* tiletab, int nN_, int G_, int c_) { nM = tiletab[0]; tab = tiletab; nN = nN_; nwg = nM * nN; G = G_; c = c_; }
    __device__ bool next(int i, Unit& u) const {
        const long L = (long)i * G + c; if (L >= nwg) return false;
        int wgid = (int)L; { const int q = nwg / NXCD, r = nwg % NXCD, xcd = wgid % NXCD, off = wgid / NXCD; wgid = (xcd < r ? xcd * (q + 1) : r * (q + 1) + (xcd - r) * q) + off; }
        const int nig = WGM * nN, gid = wgid / nig, fm = gid * WGM, gsz = (nM - fm) < WGM ? (nM - fm) : WGM;
        u.pm = fm + ((wgid % nig) % gsz); u.pn = (wgid % nig) / gsz; { const int e = tab[128 + 2 * u.pm], tl = tab[129 + 2 * u.pm]; u.bt = e * nN + u.pn; u.rbase = e * T + tl * BM; } return true;
    }
};

typedef int v4i_t __attribute__((ext_vector_type(4)));
typedef int v8i_t __attribute__((ext_vector_type(8)));
template <class Epi, class Sched, bool ALIGN_EPI, bool FP8 = false, bool GATHER = false>
__device__ __forceinline__ void gemm_phase(LAS unsigned char* lds, const Gemm g, const Sched& S, const Epi& E, const int wid) {
    const int lane = lane_id_asm(), tid = wid * 64 + lane;
    const int wr = wid >> 2, wc = wid & 3, fr = lane & 15, fq = lane >> 4;
    const int nt = g.K / BK;
    unsigned voffA[2], voffB[2]; int gR[2];
#pragma unroll
    for (int i = 0; i < 2; ++i) { int R, C; stage_rc(tid * 16 + i * 8192, R, C); const int Rb = Epi::PERM ? ((R & ~31) + perm32(R & 31)) : R;
        voffA[i] = GATHER ? (unsigned)C * 2u : (unsigned)(R * g.lda + C) * 2u; voffB[i] = (unsigned)(Rb * g.ldb + C) * 2u; gR[i] = R; }
    const size_t kstep = (size_t)(BK * 2);
    const size_t hstepA = GATHER ? 0 : (size_t)HALF * g.lda * 2, hstepB = (size_t)HALF * g.ldb * 2;
    const size_t tstepA = 2 * hstepA, tstepB = 2 * hstepB;
    const unsigned ldsw = (unsigned)wid * 1024u;
    const int aoff = lds_byte(wr * 64 + fr, fq * 8), boff = lds_byte(wc * 32 + fr, fq * 8);
#define PG8_SA(b, h) (((b) * 2 + (h)) * HTB)
#define PG8_SB(b, h) ((4 + (b) * 2 + (h)) * HTB)
#define PG8_STAGE(bufoff, gbase, voff) do { _Pragma("unroll") for (int _i = 0; _i < 2; ++_i) \
        __builtin_amdgcn_global_load_lds((const unsigned*)((const char*)(gbase) + (voff)[_i]), (LAS unsigned*)(lds + (bufoff) + ldsw + _i * 8192), 16, 0, 0); } while (0)
#define PG8_LD8(p) __builtin_shufflevector(*(const LAS v4i_t*)(p), *(const LAS v4i_t*)((p) + 1024), 0, 1, 2, 3, 4, 5, 6, 7)
#define PG8_LDA(dst, b, h) do { _Pragma("unroll") for (int m = 0; m < 4; ++m) { if constexpr (FP8) dst##8[m] = PG8_LD8(lds + PG8_SA(b, h) + aoff + m * 2048); \
        else { _Pragma("unroll") for (int k = 0; k < 2; ++k) dst[m][k] = *(const LAS bf16x8*)(lds + PG8_SA(b, h) + aoff + m * 2048 + k * 1024); } } } while (0)
#define PG8_LDB(dst, b, h) do { _Pragma("unroll") for (int n = 0; n < 2; ++n) { if constexpr (FP8) dst##8[n] = PG8_LD8(lds + PG8_SB(b, h) + boff + n * 2048); \
        else { _Pragma("unroll") for (int k = 0; k < 2; ++k) dst[n][k] = *(const LAS bf16x8*)(lds + PG8_SB(b, h) + boff + n * 2048 + k * 1024); } } } while (0)
#define PG8_MMA(ai, bj, At, Bt) do { __builtin_amdgcn_s_setprio(1); _Pragma("unroll") for (int m = 0; m < 4; ++m) _Pragma("unroll") for (int n = 0; n < 2; ++n) { \
        if constexpr (FP8) { asm volatile("s_nop 1\n\tv_mfma_scale_f32_16x16x128_f8f6f4 %0, %1, %2, %0, %3, %3 op_sel_hi:[0,0,0]" : "+v"(acc[ai][bj][m][n]) : "v"(Bt##8[n]), "v"(At##8[m]), "v"(scl8)); } \
        else { _Pragma("unroll") for (int k = 0; k < 2; ++k) acc[ai][bj][m][n] = __builtin_amdgcn_mfma_f32_16x16x32_bf16(Bt[n][k], At[m][k], acc[ai][bj][m][n], 0, 0, 0); } } \
        __builtin_amdgcn_s_setprio(0); } while (0)
#define PG8_WAIT_V(n) asm volatile("s_waitcnt vmcnt(" #n ")" ::: "memory")
#define PG8_WAIT_L(n) asm volatile("s_waitcnt lgkmcnt(" #n ")" ::: "memory")
#define PG8_BAR __builtin_amdgcn_s_barrier()
#define PG8_SCHED __builtin_amdgcn_sched_barrier(0)
    Unit cur, nxt; int ui = 0;
    if (!S.next(0, cur)) return;
    unsigned va0[2], va1[2], vn0[2], vn1[2];
#define PG8_GIDX(dst0, dst1, u) do { if constexpr (GATHER) { _Pragma("unroll") for (int _i = 0; _i < 2; ++_i) { \
        dst0[_i] = min((unsigned)g.rowidx[(u).rbase + gR[_i]], (unsigned)(T - 1)) * (unsigned)(g.lda * 2) + voffA[_i]; dst1[_i] = min((unsigned)g.rowidx[(u).rbase + HALF + gR[_i]], (unsigned)(T - 1)) * (unsigned)(g.lda * 2) + voffA[_i]; } } \
        else { _Pragma("unroll") for (int _i = 0; _i < 2; ++_i) { dst0[_i] = voffA[_i]; dst1[_i] = voffA[_i]; } } } while (0)
    PG8_GIDX(va0, va1, cur);
    f32x4 acc[2][2][4][2];
#pragma unroll
    for (int a = 0; a < 2; ++a)
#pragma unroll
        for (int b = 0; b < 2; ++b)
#pragma unroll
            for (int m = 0; m < 4; ++m)
#pragma unroll
                for (int n = 0; n < 2; ++n) acc[a][b][m][n] = (f32x4){0.f, 0.f, 0.f, 0.f};
    bf16x8 At[4][2], B0[2][2], B1[2][2]; v8i_t At8[4], B08[2], B18[2];
    int scl8 = 0x7f7f7f7f; asm volatile("" : "+v"(scl8));
    const char* cA = (const char*)g.A + (GATHER ? 0 : (size_t)cur.pm * tstepA); const char* cB = (const char*)g.Bt + (size_t)cur.bt * tstepB;
    PG8_STAGE(PG8_SB(0, 0), cB, voffB); PG8_STAGE(PG8_SB(0, 1), cB + hstepB, voffB); PG8_STAGE(PG8_SA(0, 0), cA, va0); PG8_STAGE(PG8_SA(0, 1), cA + hstepA, va1);
    if (wr == 1) PG8_BAR;
    PG8_WAIT_V(2); PG8_BAR;
    PG8_STAGE(PG8_SB(1, 0), cB + kstep, voffB); PG8_STAGE(PG8_SA(1, 0), cA + kstep, va0); PG8_STAGE(PG8_SB(1, 1), cB + hstepB + kstep, voffB);
    PG8_WAIT_V(6); PG8_BAR;
    for (;;) {
        const bool has_next = S.next(ui + 1, nxt);
        const char* nA = (has_next && !GATHER) ? (const char*)g.A + (size_t)nxt.pm * tstepA : cA; const char* nB = has_next ? (const char*)g.Bt + (size_t)nxt.bt * tstepB : cB;
        if (has_next) PG8_GIDX(vn0, vn1, nxt); else { _Pragma("unroll") for (int _i = 0; _i < 2; ++_i) { vn0[_i] = va0[_i]; vn1[_i] = va1[_i]; } }
#pragma unroll 1
        for (int t = 0; t < nt; t += 2) {
            const bool last = (t == nt - 2);
            const char* a1 = cA + (size_t)(t + 1) * kstep;
            const char* a2 = last ? nA : cA + (size_t)(t + 2) * kstep; const char* b2 = last ? nB : cB + (size_t)(t + 2) * kstep;
            const char* a3 = a2 + kstep; const char* b3 = b2 + kstep;
            if constexpr (Epi::MID_T > 0) { if (t == Epi::MID_T) E.mid(acc, cur, wr, wc, fr, fq); }
            unsigned vs0[2], vs1[2];
#pragma unroll
            for (int _i = 0; _i < 2; ++_i) { vs0[_i] = last ? vn0[_i] : va0[_i]; vs1[_i] = last ? vn1[_i] : va1[_i]; }
            PG8_LDB(B0, 0, 0); PG8_LDB(B1, 0, 1); PG8_SCHED; PG8_LDA(At, 0, 0); PG8_STAGE(PG8_SA(1, 1), a1 + hstepA, va1);
            PG8_WAIT_V(8); PG8_WAIT_L(0); PG8_BAR; PG8_MMA(0, 0, At, B0); PG8_MMA(0, 1, At, B1); PG8_BAR; PG8_SCHED;
            PG8_LDA(At, 0, 1); PG8_STAGE(PG8_SB(0, 0), b2, voffB); PG8_STAGE(PG8_SB(0, 1), b2 + hstepB, voffB); PG8_STAGE(PG8_SA(0, 0), a2, vs0);
            PG8_WAIT_V(8); PG8_WAIT_L(0); PG8_BAR; PG8_MMA(1, 0, At, B0); PG8_MMA(1, 1, At, B1); PG8_BAR; PG8_SCHED;
            PG8_LDB(B0, 1, 0); PG8_LDB(B1, 1, 1); PG8_SCHED; PG8_LDA(At, 1, 0); PG8_STAGE(PG8_SA(0, 1), a2 + hstepA, vs1);
            PG8_WAIT_V(8); PG8_WAIT_L(0); PG8_BAR; PG8_MMA(0, 0, At, B0); PG8_MMA(0, 1, At, B1); PG8_BAR; PG8_SCHED;
            PG8_LDA(At, 1, 1); PG8_STAGE(PG8_SB(1, 0), b3, voffB); PG8_STAGE(PG8_SB(1, 1), b3 + hstepB, voffB); PG8_STAGE(PG8_SA(1, 0), a3, vs0);
            PG8_WAIT_V(8); PG8_WAIT_L(0); PG8_BAR; PG8_MMA(1, 0, At, B0); PG8_MMA(1, 1, At, B1); PG8_BAR; PG8_SCHED;
        }
        if constexpr (ALIGN_EPI) { if (wr == 0) PG8_BAR; }
        if constexpr (FP8) {
#pragma unroll
            for (int a = 0; a < 2; ++a)
#pragma unroll
                for (int b = 0; b < 2; ++b)
                    asm volatile("s_nop 15\n\ts_nop 7" : "+v"(acc[a][b][0][0]), "+v"(acc[a][b][0][1]), "+v"(acc[a][b][1][0]), "+v"(acc[a][b][1][1]), "+v"(acc[a][b][2][0]), "+v"(acc[a][b][2][1]), "+v"(acc[a][b][3][0]), "+v"(acc[a][b][3][1]));
        }
        E(acc, cur, wr, wc, fr, fq);
        if (!has_next) break;
#pragma unroll
        for (int a = 0; a < 2; ++a)
#pragma unroll
            for (int b = 0; b < 2; ++b)
#pragma unroll
                for (int m = 0; m < 4; ++m)
#pragma unroll
                    for (int n = 0; n < 2; ++n) acc[a][b][m][n] = (f32x4){0.f, 0.f, 0.f, 0.f};
        cur = nxt; cA = nA; cB = nB; ++ui;
#pragma unroll
        for (int _i = 0; _i < 2; ++_i) { va0[_i] = vn0[_i]; va1[_i] = vn1[_i]; }
        if constexpr (ALIGN_EPI) { if (wr == 1) PG8_BAR; }
    }
    PG8_WAIT_V(0);
    if constexpr (!ALIGN_EPI) { if (wr == 0) PG8_BAR; }
    PG8_BAR;
#undef PG8_SA
#undef PG8_SB
#undef PG8_STAGE
#undef PG8_GIDX
#undef PG8_LDA
#undef PG8_LDB
#undef PG8_MMA
#undef PG8_LD8
#undef PG8_WAIT_V
#undef PG8_WAIT_L
#undef PG8_BAR
#undef PG8_SCHED
}

typedef f32x4 Acc[2][2][4][2];

__device__ __forceinline__ u32x4 pair16(u32x2 x, u32x2 y) {
    const auto r0 = __builtin_amdgcn_permlane16_swap(x.x, y.x, false, false);
    const auto r1 = __builtin_amdgcn_permlane16_swap(x.y, y.y, false, false);
    return (u32x4){r0[0], r1[0], r0[1], r1[1]};
}
struct Epi1 {
    static constexpr bool PERM = true; static constexpr int MID_T = 0;
    bf16_t *yab, *gv; unsigned char *q, *k, *v; bf16_t *sa, *sb; float* gvst; float* kmp; float sc, pad_;
    template <int MODE  >
    __device__ __forceinline__ void run(const Acc& acc, const Unit& u, int wr, int wc, int fr, int fq, bf16_t* base, int ld) const {
        const int row0 = u.pm * BM + wr * 64 + fr, col0 = (u.pn & 3) * 256 + wc * 32 + 8 * fq;
        const int colp = (u.pn & 3) * 256 + wc * 32 + 8 * (fq & ~1);
        f32x4 csA0 = {0.f, 0.f, 0.f, 0.f}, csB0 = csA0, csA1 = csA0, csB1 = csA0;
#pragma unroll
        for (int ai = 0; ai < 2; ++ai)
#pragma unroll
            for (int mp = 0; mp < 2; ++mp) {
                u32x2 pc[2][2];
#pragma unroll
                for (int k = 0; k < 2; ++k) {
                    const int m = 2 * mp + k;
                    const int row = row0 + ai * HALF + m * 16; bf16_t* rowp = base + (size_t)row * ld + col0;
                    float s1 = 0.f, s2 = 0.f;
#pragma unroll
                    for (int bj = 0; bj < 2; ++bj) {
                        f32x4 v0 = acc[ai][bj][m][0], v1 = acc[ai][bj][m][1];
                        if (MODE == 2 || MODE == 3 || MODE == 5) {
                            const float f = (MODE == 2) ? sc * QSCALE : sc; v0 = v0 * f; v1 = v1 * f;
                            if (MODE == 5) { if (bj == 0) { csA0 = csA0 + v0; csB0 = csB0 + v1; } else { csA1 = csA1 + v0; csB1 = csB1 + v1; } }
                            pc[bj][k] = (u32x2){pack_fp8x4(v0[0], v0[1], v0[2], v0[3]), pack_fp8x4(v1[0], v1[1], v1[2], v1[3])};
                            continue;
                        }
                        if (MODE == 0 || MODE == 1) {
                            f32x2 a = gelu_pk((f32x2){v0[0], v0[1]}), b = gelu_pk((f32x2){v0[2], v0[3]}), c = gelu_pk((f32x2){v1[0], v1[1]}), d = gelu_pk((f32x2){v1[2], v1[3]});
                            v0 = (f32x4){a.x, a.y, b.x, b.y}; v1 = (f32x4){c.x, c.y, d.x, d.y};
                        } else if (MODE == 4) {
                            { const float cs_ = -1.4426950408889634f * sc; const f32x4 t0 = v0 * cs_, t1 = v1 * cs_; f32x4 e0, e1;
#pragma unroll
                              for (int j = 0; j < 4; ++j) { e0[j] = __builtin_amdgcn_exp2f(t0[j]); e1[j] = __builtin_amdgcn_exp2f(t1[j]); }
                              e0 = e0 + 1.0f; e1 = e1 + 1.0f;
#pragma unroll
                              for (int j = 0; j < 4; ++j) { v0[j] = __builtin_amdgcn_rcpf(e0[j]); v1[j] = __builtin_amdgcn_rcpf(e1[j]); } }
                            pc[bj][k] = (u32x2){pack_fp8x4(v0[0], v0[1], v0[2], v0[3]), pack_fp8x4(v1[0], v1[1], v1[2], v1[3])};
                            continue;
                        }
                        if (MODE == 1) {
                            s1 += (v0[0] + v0[1]) + (v0[2] + v0[3]) + (v1[0] + v1[1]) + (v1[2] + v1[3]);
                            s2 += (v0[0] * v0[0] + v0[1] * v0[1]) + (v0[2] * v0[2] + v0[3] * v0[3]) + (v1[0] * v1[0] + v1[1] * v1[1]) + (v1[2] * v1[2] + v1[3] * v1[3]);
                            pc[bj][k] = (u32x2){pack_fp8x4(v0[0], v0[1], v0[2], v0[3]), pack_fp8x4(v1[0], v1[1], v1[2], v1[3])};
                            continue;
                        }
                        u32x4 w; w.x = cvt_pk_bf16(v0[0], v0[1]); w.y = cvt_pk_bf16(v0[2], v0[3]); w.z = cvt_pk_bf16(v1[0], v1[1]); w.w = cvt_pk_bf16(v1[2], v1[3]);
                        *(u32x4*)(rowp + bj * HALF) = w;
                    }
                    if (MODE == 1) {
                        s1 += __shfl_xor(s1, 16); s1 += __shfl_xor(s1, 32); s2 += __shfl_xor(s2, 16); s2 += __shfl_xor(s2, 32);
                        if (fq == 0) *(f32x2*)(gvst + ((size_t)row * 16 + (u.pn & 3) * 4 + wc) * 2) = (f32x2){s1, s2};
                    }
                }
                if (MODE != 0) {
                    const int rowst = row0 + ai * HALF + (2 * mp + (fq & 1)) * 16;
#pragma unroll
                    for (int bj = 0; bj < 2; ++bj) *(u32x4*)((unsigned char*)base + (size_t)rowst * 1024 + colp + bj * HALF) = pair16(pc[bj][0], pc[bj][1]);
                }
            }
        if (MODE == 5) {
#define KM_RED(v) do { _Pragma("unroll") for (int j_ = 0; j_ < 4; ++j_) { float x = v[j_]; x += __shfl_xor(x, 1); x += __shfl_xor(x, 2); x += __shfl_xor(x, 4); x += __shfl_xor(x, 8); v[j_] = x; } } while (0)
            KM_RED(csA0); KM_RED(csB0); KM_RED(csA1); KM_RED(csB1);
#undef KM_RED
            if (fr == 0) {
                float* kp = kmp + ((size_t)(u.pm * 2 + wr) * DM) + col0;
                *(f32x4*)kp = csA0; *(f32x4*)(kp + 4) = csB0; *(f32x4*)(kp + HALF) = csA1; *(f32x4*)(kp + HALF + 4) = csB1;
            }
        }
    }
    __device__ __forceinline__ void operator()(const Acc& acc, const Unit& u, int wr, int wc, int fr, int fq) const {
        const int region = u.pn >> 2;
        if (region == 0) run<0>(acc, u, wr, wc, fr, fq, yab, 2048);
        else if (region == 1) run<1>(acc, u, wr, wc, fr, fq, gv, 1024);
        else if (region == 2) run<2>(acc, u, wr, wc, fr, fq, (bf16_t*)q, 1024);
        else if (region == 3) run<5>(acc, u, wr, wc, fr, fq, (bf16_t*)k, 1024);
        else if (region == 4) run<3>(acc, u, wr, wc, fr, fq, (bf16_t*)v, 1024);
        else if (region == 5) run<4>(acc, u, wr, wc, fr, fq, sa, 1024);
        else run<4>(acc, u, wr, wc, fr, fq, sb, 1024);
    }
    __device__ __forceinline__ void mid(Acc&, const Unit&, int, int, int, int) const {}
};

struct Epi2 {
    static constexpr bool PERM = true; static constexpr int MID_T = 16;
    const unsigned char *sa, *sb; bf16_t* mg;
    __device__ __forceinline__ void mid(Acc& acc, const Unit& u, int wr, int wc, int fr, int fq) const {
        int row0 = u.pm * BM + wr * 64 + fr, col0 = u.pn * BM + wc * 32 + 8 * fq;
        asm volatile("" : "+v"(row0), "+v"(col0));
#pragma unroll
        for (int ai = 0; ai < 2; ++ai)
#pragma unroll
            for (int m = 0; m < 4; ++m) {
                const size_t off = (size_t)(row0 + ai * HALF + m * 16) * DM + col0;
#pragma unroll
                for (int bj = 0; bj < 2; ++bj) {
                    const u32x2 a = *(const u32x2*)(sa + off + bj * HALF), b = *(const u32x2*)(sb + off + bj * HALF);
                    const f32x2v a0 = __builtin_amdgcn_cvt_pk_f32_fp8((int)a.x, false), a1 = __builtin_amdgcn_cvt_pk_f32_fp8((int)a.x, true), a2 = __builtin_amdgcn_cvt_pk_f32_fp8((int)a.y, false), a3 = __builtin_amdgcn_cvt_pk_f32_fp8((int)a.y, true);
                    const f32x2v b0 = __builtin_amdgcn_cvt_pk_f32_fp8((int)b.x, false), b1 = __builtin_amdgcn_cvt_pk_f32_fp8((int)b.x, true), b2 = __builtin_amdgcn_cvt_pk_f32_fp8((int)b.y, false), b3 = __builtin_amdgcn_cvt_pk_f32_fp8((int)b.y, true);
                    f32x4 r0, r1;
#define RQ(x, y) ((x) * __builtin_amdgcn_rcpf(y))
                    r0[0] = RQ(a0.x, b0.x); r0[1] = RQ(a0.y, b0.y); r0[2] = RQ(a1.x, b1.x); r0[3] = RQ(a1.y, b1.y);
                    r1[0] = RQ(a2.x, b2.x); r1[1] = RQ(a2.y, b2.y); r1[2] = RQ(a3.x, b3.x); r1[3] = RQ(a3.y, b3.y);
#undef RQ
                    acc[ai][bj][m][0] = acc[ai][bj][m][0] * r0; acc[ai][bj][m][1] = acc[ai][bj][m][1] * r1;
                }
                asm volatile("" : "+v"(acc[ai][0][m][0]), "+v"(acc[ai][0][m][1]), "+v"(acc[ai][1][m][0]), "+v"(acc[ai][1][m][1]));
                asm volatile("" ::: "memory");
            }
    }
    __device__ __forceinline__ void operator()(const Acc& acc, const Unit& u, int wr, int wc, int fr, int fq) const {
        const int row0 = u.pm * BM + wr * 64 + fr, col0 = u.pn * BM + wc * 32 + 8 * fq;
#pragma unroll
        for (int ai = 0; ai < 2; ++ai)
#pragma unroll
            for (int m = 0; m < 4; ++m) {
                const size_t off = (size_t)(row0 + ai * HALF + m * 16) * DM + col0;
#pragma unroll
                for (int bj = 0; bj < 2; ++bj) {
                    const u32x2 b = *(const u32x2*)(sb + off + bj * HALF);
                    const f32x2v b0 = __builtin_amdgcn_cvt_pk_f32_fp8((int)b.x, false), b1 = __builtin_amdgcn_cvt_pk_f32_fp8((int)b.x, true), b2 = __builtin_amdgcn_cvt_pk_f32_fp8((int)b.y, false), b3 = __builtin_amdgcn_cvt_pk_f32_fp8((int)b.y, true);
                    const f32x4 v0 = acc[ai][bj][m][0], v1 = acc[ai][bj][m][1];
                    u32x4 w; w.x = cvt_pk_bf16(v0[0] * b0.x, v0[1] * b0.y); w.y = cvt_pk_bf16(v0[2] * b1.x, v0[3] * b1.y);
                    w.z = cvt_pk_bf16(v1[0] * b2.x, v1[1] * b2.y); w.w = cvt_pk_bf16(v1[2] * b3.x, v1[3] * b3.y);
                    *(u32x4*)(mg + off + bj * HALF) = w;
                }
            }
    }
};

struct Epi3 {
    static constexpr bool PERM = true; static constexpr int MID_T = 0;
    const bf16_t* h0; bf16_t* z; float* zst;
    __device__ __forceinline__ void mid(Acc&, const Unit&, int, int, int, int) const {}
    __device__ __forceinline__ void operator()(const Acc& acc, const Unit& u, int wr, int wc, int fr, int fq) const {
        const int row0 = u.pm * BM + wr * 64 + fr, col0 = u.pn * BM + wc * 32 + 8 * fq;
#pragma unroll
        for (int ai = 0; ai < 2; ++ai)
#pragma unroll
            for (int m = 0; m < 4; ++m) {
                const int row = row0 + ai * HALF + m * 16; const size_t off = (size_t)row * DM + col0;
                float s1 = 0.f, s2 = 0.f;
#pragma unroll
                for (int bj = 0; bj < 2; ++bj) {
                    const u32x4 hb = *(const u32x4*)(h0 + off + bj * HALF);
                    f32x4 v0 = acc[ai][bj][m][0], v1 = acc[ai][bj][m][1];
                    v0[0] += ALPHA * bflo(hb.x); v0[1] += ALPHA * bfhi(hb.x); v0[2] += ALPHA * bflo(hb.y); v0[3] += ALPHA * bfhi(hb.y);
                    v1[0] += ALPHA * bflo(hb.z); v1[1] += ALPHA * bfhi(hb.z); v1[2] += ALPHA * bflo(hb.w); v1[3] += ALPHA * bfhi(hb.w);
                    s1 += ((v0[0] + v0[1]) + (v0[2] + v0[3])) + ((v1[0] + v1[1]) + (v1[2] + v1[3]));
                    s2 += ((v0[0] * v0[0] + v0[1] * v0[1]) + (v0[2] * v0[2] + v0[3] * v0[3])) + ((v1[0] * v1[0] + v1[1] * v1[1]) + (v1[2] * v1[2] + v1[3] * v1[3]));
                    *(u32x4*)(z + off + bj * HALF) = (u32x4){cvt_pk_bf16(v0[0], v0[1]), cvt_pk_bf16(v0[2], v0[3]), cvt_pk_bf16(v1[0], v1[1]), cvt_pk_bf16(v1[2], v1[3])};
                }
                s1 += __shfl_xor(s1, 16); s1 += __shfl_xor(s1, 32); s2 += __shfl_xor(s2, 16); s2 += __shfl_xor(s2, 32);
                if (fq == 0) *(f32x2*)(zst + ((size_t)row * 16 + u.pn * 4 + wc) * 2) = (f32x2){s1, s2};
            }
    }
};

struct Epi4 {
    static constexpr bool PERM = true; static constexpr int MID_T = 0;
    const float* b_up; unsigned char* act;
    __device__ __forceinline__ void mid(Acc&, const Unit&, int, int, int, int) const {}
    __device__ __forceinline__ void operator()(const Acc& acc, const Unit& u, int wr, int wc, int fr, int fq) const {
        const int e = u.bt >> 3;
        const int row0 = u.pm * BM + wr * 64 + fr, c0 = u.pn * HALF + wc * 32 + 8 * fq;
        const float* bg = b_up + (size_t)e * 2 * FF + c0; const float* bu = bg + FF;
        const f32x4 bg0 = *(const f32x4*)bg, bg1 = *(const f32x4*)(bg + 4), bu0 = *(const f32x4*)bu, bu1 = *(const f32x4*)(bu + 4);
        const int cp = u.pn * HALF + wc * 32 + 8 * (fq & ~1);
#pragma unroll
        for (int ai = 0; ai < 2; ++ai)
#pragma unroll
            for (int mp = 0; mp < 2; ++mp) {
                u32x2 pc[2];
#pragma unroll
                for (int k = 0; k < 2; ++k) {
                    const int m = 2 * mp + k;
                    float o[8];
#pragma unroll
                    for (int n = 0; n < 2; ++n)
#pragma unroll
                        for (int jp = 0; jp < 2; ++jp) {
                            const int j = 2 * jp;
                            const f32x2 ag = {acc[ai][0][m][n][j], acc[ai][0][m][n][j + 1]}, au = {acc[ai][1][m][n][j], acc[ai][1][m][n][j + 1]};
                            const f32x2 vbg = n ? (f32x2){bg1[j], bg1[j + 1]} : (f32x2){bg0[j], bg0[j + 1]}, vbu = n ? (f32x2){bu1[j], bu1[j + 1]} : (f32x2){bu0[j], bu0[j + 1]};
                            f32x2 gg = ag * 0.03125f + vbg, uu = au * 0.03125f + vbu;
                            gg.x = fminf(gg.x, 7.0f); gg.y = fminf(gg.y, 7.0f);
                            uu.x = __builtin_amdgcn_fmed3f(uu.x, -7.0f, 7.0f); uu.y = __builtin_amdgcn_fmed3f(uu.y, -7.0f, 7.0f);
                            const f32x2 t = gg * (-1.702f * 1.4426950408889634f);
                            f32x2 ex; ex.x = __builtin_amdgcn_exp2f(t.x); ex.y = __builtin_amdgcn_exp2f(t.y);
                            const f32x2 d = ex + 1.0f;
                            f32x2 rc; rc.x = __builtin_amdgcn_rcpf(d.x); rc.y = __builtin_amdgcn_rcpf(d.y);
                            const f32x2 res = (uu + 1.0f) * (gg * rc);
                            o[n * 4 + j] = res.x; o[n * 4 + j + 1] = res.y;
                        }
                    unsigned w0 = 0u, w1 = 0u;
                    w0 = __builtin_amdgcn_cvt_pk_fp8_f32(o[0], o[1], w0, false); w0 = __builtin_amdgcn_cvt_pk_fp8_f32(o[2], o[3], w0, true);
                    w1 = __builtin_amdgcn_cvt_pk_fp8_f32(o[4], o[5], w1, false); w1 = __builtin_amdgcn_cvt_pk_fp8_f32(o[6], o[7], w1, true);
                    pc[k] = (u32x2){w0, w1};
                }
                const int rowst = row0 + ai * HALF + (2 * mp + (fq & 1)) * 16;
                *(u32x4*)(act + (size_t)rowst * FF + cp) = pair16(pc[0], pc[1]);
            }
    }
};

struct Epi5 {
    static constexpr bool PERM = true; static constexpr int MID_T = 0;
    const float* b_down; const float* roww; unsigned char* ys;
    __device__ __forceinline__ void mid(Acc&, const Unit&, int, int, int, int) const {}
    __device__ __forceinline__ void operator()(const Acc& acc, const Unit& u, int wr, int wc, int fr, int fq) const {
        const int e = u.bt >> 2;
        const int row0 = u.pm * BM + wr * 64 + fr, col0 = u.pn * BM + wc * 32 + 8 * fq;
        f32x4 bv[2][2];
#pragma unroll
        for (int bj = 0; bj < 2; ++bj)
#pragma unroll
            for (int n = 0; n < 2; ++n) bv[bj][n] = *(const f32x4*)(b_down + (size_t)e * DM + col0 + bj * HALF + 4 * n);
        float rwv[2][4];
#pragma unroll
        for (int ai = 0; ai < 2; ++ai)
#pragma unroll
            for (int m = 0; m < 4; ++m) rwv[ai][m] = roww[u.rbase + wr * 64 + fr + ai * HALF + m * 16];
        asm volatile("" ::: "memory");
        const int colp = u.pn * BM + wc * 32 + 8 * (fq & ~1);
#pragma unroll
        for (int ai = 0; ai < 2; ++ai)
#pragma unroll
            for (int mp = 0; mp < 2; ++mp) {
                const int rowst = row0 + ai * HALF + (2 * mp + (fq & 1)) * 16;
#pragma unroll
                for (int bj = 0; bj < 2; ++bj) {
                    u32x2 pc[2];
#pragma unroll
                    for (int k = 0; k < 2; ++k) { const int m = 2 * mp + k; const float rw16 = rwv[ai][m] * 16.0f;
                        const f32x4 v0 = (acc[ai][bj][m][0] * 0.015625f + bv[bj][0]) * rw16, v1 = (acc[ai][bj][m][1] * 0.015625f + bv[bj][1]) * rw16;
                        pc[k] = (u32x2){pack_fp8x4(v0[0], v0[1], v0[2], v0[3]), pack_fp8x4(v1[0], v1[1], v1[2], v1[3])}; }
                    *(u32x4*)(ys + (size_t)rowst * DM + colp + bj * HALF) = pair16(pc[0], pc[1]);
                }
            }
    }
};
}

struct Args { const float* in[21]; float* out; unsigned char* ws; int ph_lo, ph_hi; };
enum { I_X = 0, I_LNIN_G, I_LNIN_B, I_WIN, I_GLN_G, I_GLN_B, I_WSP, I_BSP, I_WBA, I_WBB, I_WOUT, I_LNMIX_G, I_LNMIX_B, I_WR, I_BR, I_WUP, I_BUP, I_WDN, I_BDN, I_LNF_G, I_LNF_B };

struct Ctx { const Args* a; unsigned char* ws; LAS unsigned char* lds; unsigned char* ldsg; int tid, lane, wave, G, vcu; };

__device__ __forceinline__ void tr_item(const float* W, int N, int k0, int n0, bf16_t* dst, int drow0, int dld, int dcol0, LAS float* scr, int lane) {
#pragma unroll 8
    for (int i = 0; i < 32; ++i) { const int kk = 2 * i + (lane >> 5); scr[kk * 33 + (lane & 31)] = __builtin_nontemporal_load(W + (size_t)(k0 + kk) * N + n0 + (lane & 31)); }
    asm volatile("s_waitcnt lgkmcnt(0)" ::: "memory");
    const int c = lane & 7;
#pragma unroll
    for (int j = 0; j < 4; ++j) { const int n = (lane >> 3) + 8 * j; const LAS float* s = scr + (8 * c) * 33 + n;
        u32x4 o; o.x = pk2(s[0 * 33], s[1 * 33]); o.y = pk2(s[2 * 33], s[3 * 33]); o.z = pk2(s[4 * 33], s[5 * 33]); o.w = pk2(s[6 * 33], s[7 * 33]);
        *(u32x4*)(dst + (size_t)(drow0 + n) * dld + dcol0 + k0 + 8 * c) = o; }
    asm volatile("s_waitcnt lgkmcnt(0)" ::: "memory");
}
__device__ __forceinline__ void tr_item8(const float* W, int N, int k0, int n0, unsigned char* dst, int drow0, int dld, float sc, LAS float* scr, int lane) {
#pragma unroll 8
    for (int i = 0; i < 32; ++i) { const int kk = 2 * i + (lane >> 5); scr[kk * 33 + (lane & 31)] = __builtin_nontemporal_load(W + (size_t)(k0 + kk) * N + n0 + (lane & 31)); }
    asm volatile("s_waitcnt lgkmcnt(0)" ::: "memory");
    const int c = lane & 7;
#pragma unroll
    for (int j = 0; j < 4; ++j) { const int n = (lane >> 3) + 8 * j; const LAS float* s = scr + (8 * c) * 33 + n;
        unsigned w0 = 0u, w1 = 0u;
        w0 = __builtin_amdgcn_cvt_pk_fp8_f32(s[0 * 33] * sc, s[1 * 33] * sc, w0, false); w0 = __builtin_amdgcn_cvt_pk_fp8_f32(s[2 * 33] * sc, s[3 * 33] * sc, w0, true);
        w1 = __builtin_amdgcn_cvt_pk_fp8_f32(s[4 * 33] * sc, s[5 * 33] * sc, w1, false); w1 = __builtin_amdgcn_cvt_pk_fp8_f32(s[6 * 33] * sc, s[7 * 33] * sc, w1, true);
        *(u32x2*)(dst + (size_t)(drow0 + n) * dld + k0 + 8 * c) = (u32x2){w0, w1}; }
    asm volatile("s_waitcnt lgkmcnt(0)" ::: "memory");
}
__device__ __forceinline__ void ph_prologue(const Ctx& F) {
    const Args& A = *F.a;
    LAS float* scr = (LAS float*)(F.lds + F.wave * 16384);
    const int gw = F.vcu * 8 + F.wave, NGW = F.G * 8;
    bf16_t* WIN = (bf16_t*)(F.ws + WS_WIN); bf16_t* WAB = (bf16_t*)(F.ws + WS_WAB); bf16_t* WOUT = (bf16_t*)(F.ws + WS_WOUT);
    unsigned char* WDN = F.ws + WS_WDN; unsigned char* WUP = F.ws + WS_WUP;
    constexpr int I_IN = 16 * (INCOLS / 32), I_SQ = 16 * 32, I_UP = NE * 16 * 64, I_DN = NE * 16 * 32;
    constexpr int NITEMS = I_IN + 3 * I_SQ + I_UP + I_DN;
    for (int it = gw; it < NITEMS; it += NGW) {
        int r = it;
        if (r < I_IN) { const int nblk = INCOLS / 32, kb = r / nblk, nb = r % nblk;
            if (32 * nb >= PN8_LO * 256 && 32 * nb < PN8_HI * 256) tr_item8(A.in[I_WIN], INCOLS, 64 * kb, 32 * nb, F.ws + WS_WIN8, 32 * nb, DM, 32.0f, scr, F.lane);
            else tr_item(A.in[I_WIN], INCOLS, 64 * kb, 32 * nb, WIN, 32 * nb, DM, 0, scr, F.lane);
            continue; } r -= I_IN;
        if (r < I_SQ) { const int kb = r / 32, nb = r % 32; tr_item(A.in[I_WBA], DM, 64 * kb, 32 * nb, WAB, 32 * nb, 2048, 0, scr, F.lane); continue; } r -= I_SQ;
        if (r < I_SQ) { const int kb = r / 32, nb = r % 32; tr_item(A.in[I_WBB], DM, 64 * kb, 32 * nb, WAB, 32 * nb, 2048, 1024, scr, F.lane); continue; } r -= I_SQ;
        if (r < I_SQ) { const int kb = r / 32, nb = r % 32; tr_item(A.in[I_WOUT], DM, 64 * kb, 32 * nb, WOUT, 32 * nb, DM, 0, scr, F.lane); continue; } r -= I_SQ;
        if (r < I_UP) { const int e = r / (16 * 64), rr = r % (16 * 64), kb = rr / 64, nb = rr % 64; const int n0 = 32 * nb, half = n0 >= FF, rem = n0 - half * FF, pn = rem >> 7, b = (rem & 127) >> 5;
            tr_item8(A.in[I_WUP] + (size_t)e * DM * 2 * FF, 2 * FF, 64 * kb, n0, WUP, e * 2048 + 256 * pn + half * 128 + 32 * b, DM, 32.0f, scr, F.lane); continue; } r -= I_UP;
        { const int e = r / (16 * 32), rr = r % (16 * 32), kb = rr / 32, nb = rr % 32; tr_item8(A.in[I_WDN] + (size_t)e * FF * DM, DM, 64 * kb, 32 * nb, WDN, e * 1024 + 32 * nb, FF, 64.0f, scr, F.lane); }
    }
    const float* lg = A.in[I_LNIN_G]; const float* lb = A.in[I_LNIN_B]; bf16_t* H0 = (bf16_t*)(F.ws + WS_H0);
    f32x4 gg[4], bb[4];
#pragma unroll
    for (int j = 0; j < 4; ++j) { gg[j] = *((const f32x4*)lg + F.lane + 64 * j); bb[j] = *((const f32x4*)lb + F.lane + 64 * j); }
    for (int m = gw; m < T; m += NGW) {
        const f32x4* xr = (const f32x4*)(A.in[I_X] + (size_t)m * DM) + F.lane;
        f32x4 v[4]; float s = 0.f;
#pragma unroll
        for (int j = 0; j < 4; ++j) { v[j] = __builtin_nontemporal_load(xr + 64 * j); s += (v[j].x + v[j].y) + (v[j].z + v[j].w); }
        const float mean = wave_sum(s) * (1.f / DM); float s2 = 0.f;
#pragma unroll
        for (int j = 0; j < 4; ++j) { v[j] = v[j] - mean; s2 += (v[j].x * v[j].x + v[j].y * v[j].y) + (v[j].z * v[j].z + v[j].w * v[j].w); }
        const float rstd = 1.f / sqrtf(wave_sum(s2) * (1.f / DM) + LN_EPS);
        u32x2* o8 = (u32x2*)(H0 + (size_t)m * DM) + F.lane; unsigned* o4 = (unsigned*)(F.ws + WS_H0F8 + (size_t)m * DM) + F.lane;
#pragma unroll
        for (int j = 0; j < 4; ++j) { const f32x4 y = v[j] * rstd * gg[j] + bb[j]; o8[64 * j] = (u32x2){pk2(y.x, y.y), pk2(y.z, y.w)}; o4[64 * j] = pack_fp8x4(y.x, y.y, y.z, y.w); }
    }
}

__device__ __forceinline__ void ph_kmean(const Ctx& F) {
    const unsigned char* K = F.ws + WS_K; float* KM = (float*)(F.ws + WS_KMEAN);
    float* red = (float*)F.ldsg;
    const int d = F.tid & 127, part = F.tid >> 7;
    for (int it = F.vcu; it < NB * NH * NBLK; it += F.G) {
        const int b = it / (NH * NBLK), h = (it / NBLK) % NH, j = it % NBLK;
        const unsigned char* kp = K + ((size_t)(b * SEQ + j * LBLK + part * 64)) * DM + h * DH + d;
        float s = 0.f;
        for (int r = 0; r < 64; ++r) s += __builtin_amdgcn_cvt_f32_fp8((int)kp[(size_t)r * DM], 0);
        red[part * 128 + d] = s;
        __syncthreads();
        if (F.tid < 128) KM[(size_t)it * DH + d] = (red[d] + red[128 + d] + red[256 + d] + red[384 + d]) * (1.0f / LBLK);
        __syncthreads();
    }
}
typedef short v4i16_t __attribute__((ext_vector_type(4)));
__device__ __forceinline__ v4i16_t lds_tr16(LAS const unsigned char* p) { return __builtin_amdgcn_ds_read_tr16_b64_v4i16((LAS v4i16_t*)p); }
__device__ __forceinline__ void ph_mixer_a(const Ctx& F) {
    const Args& A = *F.a;
    const unsigned char* GV = F.ws + WS_GV; bf16_t* YAB = (bf16_t*)(F.ws + WS_YAB); const float* GVST = (const float*)(F.ws + WS_GVST);
    const float* lg = A.in[I_GLN_G]; const float* lb = A.in[I_GLN_B]; const float* wsp = A.in[I_WSP]; const float* bsp = A.in[I_BSP];
    constexpr int RSV = 544, RSW = 272, OFF_W = 128 * RSV, OFF_ST = OFF_W + 128 * RSW;
    LAS unsigned char* VT = F.lds; LAS unsigned char* WT = F.lds + OFF_W; LAS float* ST = (LAS float*)(F.lds + OFF_ST);
    const int lane = F.lane, wv = F.wave;
    int curg = -1;
    for (int it = F.vcu; it < NB * 32 * 4; it += F.G) {
        const int b = it / 128, c = (it >> 2) & 31, g = it & 3;
        const int tok0 = b * SEQ + c * 128;
        if (g != curg) {
            curg = g;
            for (int k = 0; k < 4; ++k) {
                const int idx = F.tid + 512 * k, t = idx >> 4, s8 = (idx & 15) * 8;
                const f32x4 w0 = *(const f32x4*)(wsp + ((size_t)g * 128 + t) * 128 + s8), w1 = *(const f32x4*)(wsp + ((size_t)g * 128 + t) * 128 + s8 + 4);
                float x[8] = {w0.x, w0.y, w0.z, w0.w, w1.x, w1.y, w1.z, w1.w};
#pragma unroll
                for (int j = 0; j < 8; ++j) x[j] = (s8 + j <= t) ? x[j] : 0.f;
                u32x4 o; o.x = pk2(x[0], x[1]); o.y = pk2(x[2], x[3]); o.z = pk2(x[4], x[5]); o.w = pk2(x[6], x[7]);
                *(LAS u32x4*)(WT + t * RSW + s8 * 2) = o;
            }
        }
        if (F.tid < 128) {
            const float* p = GVST + (size_t)(tok0 + F.tid) * 32; float s1 = 0.f, s2 = 0.f;
            for (int i = 0; i < 16; ++i) { s1 += p[2 * i]; s2 += p[2 * i + 1]; }
            const float mean = s1 * (1.f / DM), var = s2 * (1.f / DM) - mean * mean;
            ST[2 * F.tid] = mean; ST[2 * F.tid + 1] = 1.f / sqrtf(fmaxf(var, 0.f) + LN_EPS);
        }
        __syncthreads();
        {
            const int dc = F.tid & 31;
            const f32x4 g0 = *(const f32x4*)(lg + g * 256 + dc * 8), g1 = *(const f32x4*)(lg + g * 256 + dc * 8 + 4), b0 = *(const f32x4*)(lb + g * 256 + dc * 8), b1 = *(const f32x4*)(lb + g * 256 + dc * 8 + 4);
#pragma unroll
            for (int k = 0; k < 8; ++k) {
                const int s = (F.tid >> 5) + 16 * k;
                const u32x2 raw = *(const u32x2*)(GV + (size_t)(tok0 + s) * DM + g * 256 + dc * 8);
                const float mean = ST[2 * s], rstd = ST[2 * s + 1];
                const f32x2v f0 = __builtin_amdgcn_cvt_pk_f32_fp8((int)raw.x, false), f1 = __builtin_amdgcn_cvt_pk_f32_fp8((int)raw.x, true), f2 = __builtin_amdgcn_cvt_pk_f32_fp8((int)raw.y, false), f3 = __builtin_amdgcn_cvt_pk_f32_fp8((int)raw.y, true);
                f32x4 x0 = {f0.x, f0.y, f1.x, f1.y}, x1 = {f2.x, f2.y, f3.x, f3.y};
                x0 = (x0 - mean) * rstd * g0 + b0; x1 = (x1 - mean) * rstd * g1 + b1;
                u32x4 o; o.x = pk2(x0.x, x0.y); o.y = pk2(x0.z, x0.w); o.z = pk2(x1.x, x1.y); o.w = pk2(x1.z, x1.w);
                *(LAS u32x4*)(VT + s * RSV + dc * 16) = o;
            }
        }
        __syncthreads();
        {
            const int dbase = 32 * wv, kg = lane >> 4, q = (lane & 15) >> 2, p = lane & 3, fr = lane & 15;
            bf16x8 Af[2][4];
#pragma unroll
            for (int m = 0; m < 2; ++m)
#pragma unroll
                for (int kk = 0; kk < 4; ++kk) {
                    LAS const unsigned char* ap = VT + (32 * kk + 8 * kg + q) * RSV + (dbase + 16 * m + 4 * p) * 2;
                    const v4i16_t lo = lds_tr16(ap), hi = lds_tr16(ap + 4 * RSV);
                    Af[m][kk] = (bf16x8){lo[0], lo[1], lo[2], lo[3], hi[0], hi[1], hi[2], hi[3]};
                }
#pragma unroll
            for (int n = 0; n < 8; ++n) {
                f32x4 acc0 = {0.f, 0.f, 0.f, 0.f}, acc1 = {0.f, 0.f, 0.f, 0.f};
#pragma unroll
                for (int kk = 0; kk < 4; ++kk) if (kk <= (n >> 1)) {
                    const bf16x8 Bf = *(LAS const bf16x8*)(WT + (16 * n + fr) * RSW + (32 * kk + 8 * kg) * 2);
                    acc0 = __builtin_amdgcn_mfma_f32_16x16x32_bf16(Af[0][kk], Bf, acc0, 0, 0, 0);
                    acc1 = __builtin_amdgcn_mfma_f32_16x16x32_bf16(Af[1][kk], Bf, acc1, 0, 0, 0);
                }
                const int t = 16 * n + fr; const float bsv = bsp[g * 128 + t];
                bf16_t* yp = YAB + (size_t)(tok0 + t) * 2048 + g * 256 + dbase + 4 * kg;
                const u32x2 u0 = *(const u32x2*)yp, u1 = *(const u32x2*)(yp + 16);
                u32x2 o0, o1;
                o0.x = pk2(bflo(u0.x) * (acc0[0] + bsv), bfhi(u0.x) * (acc0[1] + bsv)); o0.y = pk2(bflo(u0.y) * (acc0[2] + bsv), bfhi(u0.y) * (acc0[3] + bsv));
                o1.x = pk2(bflo(u1.x) * (acc1[0] + bsv), bfhi(u1.x) * (acc1[1] + bsv)); o1.y = pk2(bflo(u1.y) * (acc1[2] + bsv), bfhi(u1.y) * (acc1[3] + bsv));
                *(u32x2*)yp = o0; *(u32x2*)(yp + 16) = o1;
            }
        }
        __syncthreads();
    }
}

__device__ __forceinline__ void ph_gate(const Ctx& F) {
    const unsigned char* Q = F.ws + WS_Q; const float* KM = (const float*)(F.ws + WS_KMEAN);
    unsigned* SEL = (unsigned*)(F.ws + WS_SEL); unsigned* LISTS = (unsigned*)(F.ws + WS_LISTS); unsigned* LCNT = (unsigned*)(F.ws + WS_CTL) + CW_LCNT;
    float* km = (float*)F.ldsg;
    unsigned* lc = (unsigned*)(F.ldsg + 8192);
    for (int it = F.vcu; it < NB * NH * 8; it += F.G) {
        const int b = it / 64, h = (it >> 3) & 7, tc = it & 7;
        for (int i = F.tid; i < NBLK * DH; i += 512) { const int j = i >> 7, d = i & 127; const float* kp = KM + (size_t)((b * NBLK + j) * 2) * DM + h * DH + d; km[i] = (kp[0] + kp[DM]) * (1.0f / LBLK); }
        if (F.tid < 32) lc[F.tid] = 0u;
        __syncthreads();
        const int t = tc * 512 + F.tid, qi = t >> 8;
        float gsc[15];
#pragma unroll
        for (int j = 0; j < 15; ++j) gsc[j] = 0.f;
        const unsigned char* qp = Q + (size_t)(b * SEQ + t) * DM + h * DH;
        u32x4 qraw[8];
#pragma unroll
        for (int c = 0; c < 8; ++c) qraw[c] = *(const u32x4*)(qp + c * 16);
#pragma unroll
        for (int c = 0; c < 16; ++c) {
            const u32x2 raw = (c & 1) ? (u32x2){qraw[c >> 1].z, qraw[c >> 1].w} : (u32x2){qraw[c >> 1].x, qraw[c >> 1].y};
            const f32x2v f0 = __builtin_amdgcn_cvt_pk_f32_fp8((int)raw.x, false), f1 = __builtin_amdgcn_cvt_pk_f32_fp8((int)raw.x, true), f2 = __builtin_amdgcn_cvt_pk_f32_fp8((int)raw.y, false), f3 = __builtin_amdgcn_cvt_pk_f32_fp8((int)raw.y, true);
            const float x[8] = {f0.x, f0.y, f1.x, f1.y, f2.x, f2.y, f3.x, f3.y};
#pragma unroll
            for (int j = 0; j < 15; ++j) if (j < qi) {
                const float* kk = km + j * DH + c * 8;
#pragma unroll
                for (int e = 0; e < 8; ++e) gsc[j] += x[e] * kk[e];
            }
        }
        const int nsel = qi < 3 ? qi : 3;
        int sel[3] = {0, 0, 0}; unsigned lpos[3] = {0, 0, 0};
#pragma unroll
        for (int r = 0; r < 3; ++r) {
            float best = -INFINITY; int bi = -1;
#pragma unroll
            for (int j = 0; j < 15; ++j) { const bool c = (j < qi) && (gsc[j] > best); best = c ? gsc[j] : best; bi = c ? j : bi; }
#pragma unroll
            for (int j = 0; j < 15; ++j) if (j == bi) gsc[j] = -INFINITY;
            sel[r] = bi < 0 ? 0 : bi;
            if (r < nsel) lpos[r] = atomicAdd(&lc[sel[r]], 1u);
        }
        SEL[(size_t)(b * SEQ + t) * NH + h] = (unsigned)sel[0] | ((unsigned)sel[1] << 8) | ((unsigned)sel[2] << 16) | ((unsigned)nsel << 24);
        __syncthreads();
        if (F.tid < 16) lc[16 + F.tid] = lc[F.tid] ? atomicAdd(&LCNT[(b * NH + h) * NBLK + F.tid], lc[F.tid]) : 0u;
        __syncthreads();
#pragma unroll
        for (int r = 0; r < 3; ++r) if (r < nsel) LISTS[(size_t)((b * NH + h) * NBLK + sel[r]) * 4096 + lc[16 + sel[r]] + lpos[r]] = (unsigned)t | ((unsigned)r << 12);
        __syncthreads();
    }
}

__device__ __forceinline__ void ph_attn_naive(const Ctx& F) {
    const bf16_t* Q = (const bf16_t*)(F.ws + WS_Q); const bf16_t* K = (const bf16_t*)(F.ws + WS_K); const bf16_t* V = (const bf16_t*)(F.ws + WS_V);
    const unsigned* SEL = (const unsigned*)(F.ws + WS_SEL); bf16_t* YAB = (bf16_t*)(F.ws + WS_YAB);
    float* qs = (float*)(F.ldsg + F.wave * 4608);
    float* sc = qs + 128;
    const int gw = F.vcu * 8 + F.wave, NGW = F.G * 8;
    for (int w = gw; w < NB * NH * SEQ; w += NGW) {
        const int b = w / (NH * SEQ), h = (w / SEQ) % NH, t = w % SEQ, qi = t >> 8, tl = t & 255;
        const size_t tok = (size_t)b * SEQ + t;
        { const unsigned qq = *(const unsigned*)(Q + tok * DM + h * DH + 2 * F.lane); qs[2 * F.lane] = bflo(qq); qs[2 * F.lane + 1] = bfhi(qq); }
        const unsigned selw = SEL[tok * NH + h]; const int nsel = selw >> 24;
        float mx = -INFINITY;
        for (int r = 0; r <= nsel; ++r) {
            const int jb = (r < nsel) ? (int)((selw >> (8 * r)) & 0xff) : qi;
            for (int c = 0; c < 4; ++c) {
                const int key = c * 64 + F.lane;
                const bool valid = (r < nsel) || (key <= tl);
                const bf16_t* kp = K + ((size_t)b * SEQ + jb * LBLK + key) * DM + h * DH;
                float s = 0.f;
#pragma unroll 4
                for (int dd = 0; dd < 16; ++dd) {
                    const u32x4 raw = *(const u32x4*)(kp + dd * 8);
                    const float* q8 = qs + dd * 8;
                    s += bflo(raw.x) * q8[0] + bfhi(raw.x) * q8[1] + bflo(raw.y) * q8[2] + bfhi(raw.y) * q8[3] + bflo(raw.z) * q8[4] + bfhi(raw.z) * q8[5] + bflo(raw.w) * q8[6] + bfhi(raw.w) * q8[7];
                }
                s = valid ? s : -INFINITY;
                sc[r * 256 + key] = s; mx = fmaxf(mx, s);
            }
        }
        mx = wave_max(mx);
        float l = 0.f;
        const int ntot = (nsel + 1) * 256;
        for (int i = F.lane; i < ntot; i += 64) { const float p = __builtin_amdgcn_exp2f(sc[i] - mx); sc[i] = p; l += p; }
        l = wave_sum(l);
        float o0 = 0.f, o1 = 0.f;
        for (int r = 0; r <= nsel; ++r) {
            const int jb = (r < nsel) ? (int)((selw >> (8 * r)) & 0xff) : qi;
            const int nk = (r < nsel) ? 256 : tl + 1;
            const bf16_t* vp = V + ((size_t)b * SEQ + jb * LBLK) * DM + h * DH + 2 * F.lane;
#pragma unroll 4
            for (int key = 0; key < nk; ++key) { const unsigned vv = *(const unsigned*)(vp + (size_t)key * DM); const float p = sc[r * 256 + key]; o0 += p * bflo(vv); o1 += p * bfhi(vv); }
        }
        const float il = 1.f / l;
        *(unsigned*)(YAB + tok * 2048 + 1024 + h * DH + 2 * F.lane) = pk2(o0 * il, o1 * il);
    }
}

typedef float f32x16 __attribute__((ext_vector_type(16)));
namespace att {
constexpr int KCH = 4112, VDB = 16448, OFF_K = 0, OFF_V = 16 * KCH, OFF_WS = OFF_V + 4 * VDB  , WSW = 512, OFF_TAB = OFF_WS + 8 * WSW  ;
static_assert(OFF_TAB + 1028 * 4 <= LDS_BYTES, "attention LDS map");
__device__ __forceinline__ int crow(int r, int hi) { return (r & 3) + 8 * (r >> 2) + 4 * hi; }
#define TRR(dst, vaddr, off) asm volatile("ds_read_b64_tr_b16 %0, %1 offset:%c2" : "=v"(dst) : "v"(vaddr), "i"(off) : "memory")
#define TRWAIT() do { asm volatile("s_waitcnt lgkmcnt(0)" ::: "memory"); __builtin_amdgcn_sched_barrier(0); } while (0)

__device__ __forceinline__ void load_kv(const Ctx& F, const unsigned char* K, const unsigned char* V, size_t tokbase, int h) {
    u32x4 kv[4], vv[4];
#pragma unroll
    for (int k = 0; k < 4; ++k) { const int idx = F.tid + 512 * k, key = idx >> 3, c2 = idx & 7; const size_t off = (tokbase + key) * DM + h * DH + c2 * 16;
        kv[k] = *(const u32x4*)(K + off); vv[k] = *(const u32x4*)(V + off); }
#pragma unroll
    for (int k = 0; k < 4; ++k) { const int idx = F.tid + 512 * k, key = idx >> 3, c2 = idx & 7, c = 2 * c2;
        *(LAS u32x4*)(F.lds + OFF_K + c * KCH + key * 16) = f8x8_to_bf16x8(kv[k].x, kv[k].y);
        *(LAS u32x4*)(F.lds + OFF_K + (c + 1) * KCH + key * 16) = f8x8_to_bf16x8(kv[k].z, kv[k].w);
        LAS unsigned char* vd = F.lds + OFF_V + (c >> 2) * VDB + (key >> 3) * 512 + (key & 7) * 64 + (c & 3) * 16;
        *(LAS u32x4*)vd = f8x8_to_bf16x8(vv[k].x, vv[k].y); *(LAS u32x4*)(vd + 16) = f8x8_to_bf16x8(vv[k].z, vv[k].w); }
}

template <bool CAUSAL>
__device__ __forceinline__ void core(const Ctx& F, const unsigned char* qrow, f32x16 (&o)[4], float& m, float& l) {
    const int r = F.lane & 31, hh = F.lane >> 5;
    LAS float* wsf = (LAS float*)(F.lds + OFF_WS + F.wave * WSW);
    bf16x8 qr[8];
#pragma unroll
    for (int ds = 0; ds < 8; ++ds) { const u32x2 raw = *(const u32x2*)(qrow + ds * 16 + hh * 8); qr[ds] = __builtin_bit_cast(bf16x8, f8x8_to_bf16x8(raw.x, raw.y)); }
#pragma unroll
    for (int db = 0; db < 4; ++db)
#pragma unroll
        for (int i = 0; i < 16; ++i) o[db][i] = 0.f;
    m = -1e30f; l = 0.f;
    const int nt = CAUSAL ? (F.wave >> 1) + 1 : 4;
    LAS const unsigned char* kbase = F.lds + OFF_K + hh * KCH + r * 16;
    LAS const unsigned char* vbase = F.lds + OFF_V + (4 * hh + ((F.lane & 15) >> 2)) * 64 + ((F.lane >> 4) & 1) * 32 + (F.lane & 3) * 8;
    for (int kt = 0; kt < nt; ++kt) {
        const bool diag = CAUSAL && (kt == nt - 1);
        constexpr bool skip1 = false;
        f32x16 p0, p1;
#pragma unroll
        for (int i = 0; i < 16; ++i) { p0[i] = 0.f; p1[i] = 0.f; }
        LAS const unsigned char* kp = kbase + (64 * kt) * 16;
        LAS const unsigned char* vp = vbase + (8 * kt) * 512;
        {
            bf16x8 ka[8], kb[8];
#pragma unroll
            for (int ds = 0; ds < 8; ++ds) ka[ds] = *(LAS const bf16x8*)(kp + 2 * ds * KCH);
            if (!skip1) {
#pragma unroll
                for (int ds = 0; ds < 8; ++ds) kb[ds] = *(LAS const bf16x8*)(kp + 2 * ds * KCH + 512);
            }
            __builtin_amdgcn_sched_barrier(0);
#pragma unroll
            for (int ds = 0; ds < 8; ++ds) p0 = __builtin_amdgcn_mfma_f32_32x32x16_bf16(ka[ds], qr[ds], p0, 0, 0, 0);
            if (!skip1) {
#pragma unroll
                for (int ds = 0; ds < 8; ++ds) p1 = __builtin_amdgcn_mfma_f32_32x32x16_bf16(kb[ds], qr[ds], p1, 0, 0, 0);
            }
            __builtin_amdgcn_sched_barrier(0);
        }
        v4i16_t vl[2][4], vh[2][4];
        const unsigned vaddr = (unsigned)(uintptr_t)vp;
#pragma unroll
        for (int ks = 0; ks < 2; ++ks)
#pragma unroll
            for (int db = 0; db < 4; ++db) { TRR(vl[ks][db], vaddr, db * VDB + ks * 1024); TRR(vh[ks][db], vaddr, db * VDB + ks * 1024 + 512); }
        __builtin_amdgcn_sched_barrier(0);
        if (diag) {
            if (F.wave & 1) {
#pragma unroll
                for (int i = 0; i < 16; ++i) p1[i] = (crow(i, hh) > r) ? -INFINITY : p1[i];
            } else {
#pragma unroll
                for (int i = 0; i < 16; ++i) { p0[i] = (crow(i, hh) > r) ? -INFINITY : p0[i]; p1[i] = -INFINITY; }
            }
        }
        float mx = fmaxf(p0[0], p1[0]);
#pragma unroll
        for (int i = 1; i < 16; ++i) mx = fmaxf(mx, fmaxf(p0[i], p1[i]));
        mx = fmaxf(mx, __shfl_xor(mx, 32));
        const float mnew = fmaxf(m, mx);
        if (__any(mx > m + 8.0f)) {
            const float alpha = __builtin_amdgcn_exp2f(m - mnew);
            l *= alpha; m = mnew;
            if (hh == 0) wsf[r] = alpha;
            asm volatile("s_waitcnt lgkmcnt(0)" ::: "memory");
#pragma unroll
            for (int i = 0; i < 16; ++i) { const float a = wsf[crow(i, hh)];
#pragma unroll
                for (int db = 0; db < 4; ++db) o[db][i] *= a; }
        }
        float ls = 0.f;
#pragma unroll
        for (int i = 0; i < 16; ++i) { p0[i] = __builtin_amdgcn_exp2f(p0[i] - m); p1[i] = __builtin_amdgcn_exp2f(p1[i] - m); ls += p0[i] + p1[i]; }
        l += ls;
        u32x4 pw[4];
#pragma unroll
        for (int s2 = 0; s2 < 2; ++s2) {
            pw[s2] = (u32x4){cvt_pk_bf16(p0[8 * s2], p0[8 * s2 + 1]), cvt_pk_bf16(p0[8 * s2 + 2], p0[8 * s2 + 3]), cvt_pk_bf16(p0[8 * s2 + 4], p0[8 * s2 + 5]), cvt_pk_bf16(p0[8 * s2 + 6], p0[8 * s2 + 7])};
            pw[2 + s2] = (u32x4){cvt_pk_bf16(p1[8 * s2], p1[8 * s2 + 1]), cvt_pk_bf16(p1[8 * s2 + 2], p1[8 * s2 + 3]), cvt_pk_bf16(p1[8 * s2 + 4], p1[8 * s2 + 5]), cvt_pk_bf16(p1[8 * s2 + 6], p1[8 * s2 + 7])};
        }
        TRWAIT();
        v4i16_t wl[2][4], wh[2][4];
        if (!skip1) {
#pragma unroll
            for (int ks = 0; ks < 2; ++ks)
#pragma unroll
                for (int db = 0; db < 4; ++db) { TRR(wl[ks][db], vaddr, db * VDB + (2 + ks) * 1024); TRR(wh[ks][db], vaddr, db * VDB + (2 + ks) * 1024 + 512); }
        }
        __builtin_amdgcn_sched_barrier(0);
#pragma unroll
        for (int ks = 0; ks < 2; ++ks) {
            const bf16x8 pa = __builtin_bit_cast(bf16x8, pw[ks]);
#pragma unroll
            for (int db = 0; db < 4; ++db) {
                const bf16x8 vf = (bf16x8){vl[ks][db][0], vl[ks][db][1], vl[ks][db][2], vl[ks][db][3], vh[ks][db][0], vh[ks][db][1], vh[ks][db][2], vh[ks][db][3]};
                o[db] = __builtin_amdgcn_mfma_f32_32x32x16_bf16(pa, vf, o[db], 0, 0, 0);
            }
        }
        TRWAIT();
        if (!skip1) {
#pragma unroll
            for (int ks = 0; ks < 2; ++ks) {
                const bf16x8 pa = __builtin_bit_cast(bf16x8, pw[2 + ks]);
#pragma unroll
                for (int db = 0; db < 4; ++db) {
                    const bf16x8 vf = (bf16x8){wl[ks][db][0], wl[ks][db][1], wl[ks][db][2], wl[ks][db][3], wh[ks][db][0], wh[ks][db][1], wh[ks][db][2], wh[ks][db][3]};
                    o[db] = __builtin_amdgcn_mfma_f32_32x32x16_bf16(pa, vf, o[db], 0, 0, 0);
                }
            }
        }
        __builtin_amdgcn_sched_barrier(0);
    }
}
__device__ __forceinline__ void finish_and_stage(const Ctx& F, const f32x16 (&o)[4], float m, float l) {
    const int r = F.lane & 31, hh = F.lane >> 5;
    LAS float* wsf = (LAS float*)(F.lds + OFF_WS + F.wave * WSW);
    const float lt = l + __shfl_xor(l, 32);
    if (hh == 0) { wsf[r] = 1.0f / lt; wsf[32 + r] = m + __builtin_amdgcn_logf(lt); }
    __syncthreads();
    LAS float* stg = (LAS float*)(F.lds + F.wave * 16384);
#pragma unroll
    for (int i = 0; i < 16; ++i) { const int q = crow(i, hh); const float a = wsf[q];
#pragma unroll
        for (int db = 0; db < 4; ++db) stg[q * 128 + 32 * db + r] = o[db][i] * a; }
    asm volatile("s_waitcnt lgkmcnt(0)" ::: "memory");
}
}

namespace att2 {
constexpr int KCH2 = 1040, VDB2 = 4160, KSL = 16 * KCH2, VSL = 4 * VDB2;
constexpr int OFF_K = 0, OFF_V = 2 * KSL, OFF_STG = OFF_V + 2 * VSL  , OFF_WS = OFF_STG + 8 * 8192  , WSW = 1024, OFF_TAB = OFF_WS + 8 * WSW  ;
static_assert(OFF_TAB + 1028 * 4 <= LDS_BYTES - 64, "attention (partial) LDS map");
using att::crow;

__device__ __forceinline__ void tile_load(const Ctx& F, const unsigned char* K, const unsigned char* V, size_t tokbase, int h, int kt, u32x4& rk, u32x4& rv) {
    const size_t off = (tokbase + 64 * kt + (F.tid >> 3)) * DM + h * DH + (F.tid & 7) * 16;
    rk = *(const u32x4*)(K + off); rv = *(const u32x4*)(V + off);
}
__device__ __forceinline__ void tile_write(const Ctx& F, int slot, const u32x4& rk, const u32x4& rv) {
    const int key = F.tid >> 3, c = 2 * (F.tid & 7);
    LAS unsigned char* kd = F.lds + OFF_K + slot * KSL + c * KCH2 + key * 16;
    *(LAS u32x4*)kd = f8x8_to_bf16x8(rk.x, rk.y); *(LAS u32x4*)(kd + KCH2) = f8x8_to_bf16x8(rk.z, rk.w);
    LAS unsigned char* vd = F.lds + OFF_V + slot * VSL + (c >> 2) * VDB2 + (key >> 3) * 512 + (key & 7) * 64 + (c & 3) * 16;
    *(LAS u32x4*)vd = f8x8_to_bf16x8(rv.x, rv.y); *(LAS u32x4*)(vd + 16) = f8x8_to_bf16x8(rv.z, rv.w);
}
template <bool CAUSAL = false>
__device__ __forceinline__ void tile_compute(const Ctx& F, int slot, const bf16x8 (&qr)[8], f32x16 (&o)[4], float& m, float& l, bool first, bool diag = false) {
    const int r = F.lane & 31, hh = F.lane >> 5;
    LAS float* wsf = (LAS float*)(F.lds + OFF_WS + F.wave * WSW);
    LAS const unsigned char* kp = F.lds + OFF_K + slot * KSL + hh * KCH2 + r * 16;
    LAS const unsigned char* vp = F.lds + OFF_V + slot * VSL + (4 * hh + ((F.lane & 15) >> 2)) * 64 + ((F.lane >> 4) & 1) * 32 + (F.lane & 3) * 8;
    f32x16 p0, p1;
#pragma unroll
    for (int i = 0; i < 16; ++i) { p0[i] = 0.f; p1[i] = 0.f; }
    {
        bf16x8 ka[8];
#pragma unroll
        for (int ds = 0; ds < 8; ++ds) ka[ds] = *(LAS const bf16x8*)(kp + 2 * ds * KCH2);
        __builtin_amdgcn_sched_barrier(0);
#pragma unroll
        for (int ds = 0; ds < 8; ++ds) p0 = __builtin_amdgcn_mfma_f32_32x32x16_bf16(ka[ds], qr[ds], p0, 0, 0, 0);
        __builtin_amdgcn_sched_barrier(0);
#pragma unroll
        for (int ds = 0; ds < 8; ++ds) ka[ds] = *(LAS const bf16x8*)(kp + 2 * ds * KCH2 + 512);
        __builtin_amdgcn_sched_barrier(0);
#pragma unroll
        for (int ds = 0; ds < 8; ++ds) p1 = __builtin_amdgcn_mfma_f32_32x32x16_bf16(ka[ds], qr[ds], p1, 0, 0, 0);
        __builtin_amdgcn_sched_barrier(0);
    }
    v4i16_t vl[2][4], vh[2][4];
    const unsigned vaddr = (unsigned)(uintptr_t)vp;
#pragma unroll
    for (int ks = 0; ks < 2; ++ks)
#pragma unroll
        for (int db = 0; db < 4; ++db) { TRR(vl[ks][db], vaddr, db * VDB2 + ks * 1024); TRR(vh[ks][db], vaddr, db * VDB2 + ks * 1024 + 512); }
    __builtin_amdgcn_sched_barrier(0);
    if (CAUSAL && diag) {
        if (F.wave & 1) {
#pragma unroll
            for (int i = 0; i < 16; ++i) p1[i] = (crow(i, hh) > r) ? -INFINITY : p1[i];
        } else {
#pragma unroll
            for (int i = 0; i < 16; ++i) { p0[i] = (crow(i, hh) > r) ? -INFINITY : p0[i]; p1[i] = -INFINITY; }
        }
    }
    const float dm = first ? 0.f : m;
    { const f32x2 dm2 = {dm, dm};
#pragma unroll
      for (int j = 0; j < 8; ++j) { f32x2 a = {p0[2 * j], p0[2 * j + 1]}, b = {p1[2 * j], p1[2 * j + 1]}; a = a - dm2; b = b - dm2; p0[2 * j] = a.x; p0[2 * j + 1] = a.y; p1[2 * j] = b.x; p1[2 * j + 1] = b.y; } }
    float mx = fmaxf(p0[0], p1[0]);
#pragma unroll
    for (int i = 1; i < 16; ++i) mx = fmaxf(mx, fmaxf(p0[i], p1[i]));
    mx = fmaxf(mx, __shfl_xor(mx, 32));
    if (first || __any(mx > 8.0f)) {
        const float delta = first ? mx : fmaxf(mx, 0.f);
        const float alpha = first ? 0.f : __builtin_amdgcn_exp2f(-delta);
        l *= alpha; m = dm + delta;
        { const f32x2 d2 = {delta, delta};
#pragma unroll
          for (int j = 0; j < 8; ++j) { f32x2 a = {p0[2 * j], p0[2 * j + 1]}, b = {p1[2 * j], p1[2 * j + 1]}; a = a - d2; b = b - d2; p0[2 * j] = a.x; p0[2 * j + 1] = a.y; p1[2 * j] = b.x; p1[2 * j + 1] = b.y; } }
        if (!first) {
            if (hh == 0) wsf[r] = alpha;
            asm volatile("s_waitcnt lgkmcnt(0)" ::: "memory");
#pragma unroll
            for (int i = 0; i < 16; ++i) { const float a = wsf[crow(i, hh)];
#pragma unroll
                for (int db = 0; db < 4; ++db) o[db][i] *= a; }
        }
    }
    { f32x2 sa = {0.f, 0.f}, sb = {0.f, 0.f};
#pragma unroll
      for (int j = 0; j < 8; ++j) {
          p0[2 * j] = __builtin_amdgcn_exp2f(p0[2 * j]); p0[2 * j + 1] = __builtin_amdgcn_exp2f(p0[2 * j + 1]); p1[2 * j] = __builtin_amdgcn_exp2f(p1[2 * j]); p1[2 * j + 1] = __builtin_amdgcn_exp2f(p1[2 * j + 1]);
          sa = sa + (f32x2){p0[2 * j], p0[2 * j + 1]}; sb = sb + (f32x2){p1[2 * j], p1[2 * j + 1]}; }
      sa = sa + sb; l += sa.x + sa.y; }
    u32x4 pw[4];
#pragma unroll
    for (int s2 = 0; s2 < 2; ++s2) {
        pw[s2] = (u32x4){cvt_pk_bf16(p0[8 * s2], p0[8 * s2 + 1]), cvt_pk_bf16(p0[8 * s2 + 2], p0[8 * s2 + 3]), cvt_pk_bf16(p0[8 * s2 + 4], p0[8 * s2 + 5]), cvt_pk_bf16(p0[8 * s2 + 6], p0[8 * s2 + 7])};
        pw[2 + s2] = (u32x4){cvt_pk_bf16(p1[8 * s2], p1[8 * s2 + 1]), cvt_pk_bf16(p1[8 * s2 + 2], p1[8 * s2 + 3]), cvt_pk_bf16(p1[8 * s2 + 4], p1[8 * s2 + 5]), cvt_pk_bf16(p1[8 * s2 + 6], p1[8 * s2 + 7])};
    }
    TRWAIT();
#pragma unroll
    for (int ks = 0; ks < 2; ++ks) {
        const bf16x8 pa = __builtin_bit_cast(bf16x8, pw[ks]);
#pragma unroll
        for (int db = 0; db < 4; ++db) {
            const bf16x8 vf = (bf16x8){vl[ks][db][0], vl[ks][db][1], vl[ks][db][2], vl[ks][db][3], vh[ks][db][0], vh[ks][db][1], vh[ks][db][2], vh[ks][db][3]};
            o[db] = __builtin_amdgcn_mfma_f32_32x32x16_bf16(pa, vf, o[db], 0, 0, 0);
        }
    }
    __builtin_amdgcn_sched_barrier(0);
#pragma unroll
    for (int ks = 0; ks < 2; ++ks)
#pragma unroll
        for (int db = 0; db < 4; ++db) { TRR(vl[ks][db], vaddr, db * VDB2 + (2 + ks) * 1024); TRR(vh[ks][db], vaddr, db * VDB2 + (2 + ks) * 1024 + 512); }
    TRWAIT();
#pragma unroll
    for (int ks = 0; ks < 2; ++ks) {
        const bf16x8 pa = __builtin_bit_cast(bf16x8, pw[2 + ks]);
#pragma unroll
        for (int db = 0; db < 4; ++db) {
            const bf16x8 vf = (bf16x8){vl[ks][db][0], vl[ks][db][1], vl[ks][db][2], vl[ks][db][3], vh[ks][db][0], vh[ks][db][1], vh[ks][db][2], vh[ks][db][3]};
            o[db] = __builtin_amdgcn_mfma_f32_32x32x16_bf16(pa, vf, o[db], 0, 0, 0);
        }
    }
    __builtin_amdgcn_sched_barrier(0);
}
}

#define ATT2_DECODE(item, bhj_, chunk_) do { int lo_ = 0, hi_ = 1023; while (lo_ < hi_) { const int mid_ = (lo_ + hi_ + 1) >> 1; if (P[mid_] <= (item)) lo_ = mid_; else hi_ = mid_ - 1; } bhj_ = lo_; chunk_ = (item) - P[lo_]; } while (0)
__device__ __forceinline__ void ph_attn_partial(const Ctx& F) {
    using namespace att2;
    const unsigned char* Q = F.ws + WS_Q; const unsigned char* K = F.ws + WS_K; const unsigned char* V = F.ws + WS_V;
    const unsigned* LISTS = (const unsigned*)(F.ws + WS_LISTS); const unsigned* LCNT = (const unsigned*)(F.ws + WS_CTL) + CW_LCNT;
    unsigned char* OP = F.ws + WS_OP; float* LSE = (float*)(F.ws + WS_LSE);
    LAS int* P = (LAS int*)(F.lds + OFF_TAB);
    if (F.tid < 64) {
        int c[16]; int s = 0;
#pragma unroll
        for (int i = 0; i < 16; ++i) { c[i] = ((int)__hip_atomic_load(LCNT + F.tid * 16 + i, __ATOMIC_RELAXED, __HIP_MEMORY_SCOPE_AGENT) + 255) >> 8; s += c[i]; }
        int inc = s;
#pragma unroll
        for (int o = 1; o < 64; o <<= 1) { const int t = __shfl_up(inc, o); if (F.lane >= o) inc += t; }
        int run = inc - s;
#pragma unroll
        for (int i = 0; i < 16; ++i) { P[F.tid * 16 + i] = run; run += c[i]; }
        if (F.tid == 63) P[1024] = run;
    }
    __syncthreads();
    const int total = P[1024];
    LAS float* wsf = (LAS float*)(F.lds + OFF_WS + F.wave * WSW);
    LAS int* wsi = (LAS int*)wsf;
    const int r = F.lane & 31, hh = F.lane >> 5;
    int it = F.vcu;
    if (it < total) {
        int bhj, chunk; ATT2_DECODE(it, bhj, chunk);
        int itn = it + F.G, bhjn = 0, chunkn = 0; bool hasn = itn < total; if (hasn) ATT2_DECODE(itn, bhjn, chunkn);
        u32x4 rkA, rvA, rkB, rvB;
        { const int b = bhj >> 7, h = (bhj >> 4) & 7, j = bhj & 15; const size_t tb = (size_t)b * SEQ + j * LBLK;
          tile_load(F, K, V, tb, h, 0, rkA, rvA); tile_load(F, K, V, tb, h, 1, rkB, rvB); tile_write(F, 0, rkA, rvA); tile_write(F, 1, rkB, rvB);
          tile_load(F, K, V, tb, h, 2, rkA, rvA); }
        int cnt = (int)__hip_atomic_load(LCNT + bhj, __ATOMIC_RELAXED, __HIP_MEMORY_SCOPE_AGENT);
        int qi = chunk * 256 + F.wave * 32 + r;
        unsigned ent = LISTS[(size_t)bhj * 4096 + (qi < cnt ? qi : 0)];
        int tq = ent & 4095, slot = (qi < cnt) ? (int)(ent >> 12) : -1;
        u32x2 qraw[8];
        { const unsigned char* qrow = Q + ((size_t)(bhj >> 7) * SEQ + tq) * DM + ((bhj >> 4) & 7) * DH + hh * 8;
#pragma unroll
          for (int ds = 0; ds < 8; ++ds) qraw[ds] = *(const u32x2*)(qrow + ds * 16); }
        unsigned entn = 0u; int cntn = 0;
        __syncthreads();
        int s = 0;
        for (;;) {
            const int b = bhj >> 7, h = (bhj >> 4) & 7, j = bhj & 15;
            bf16x8 qr[8];
#pragma unroll
            for (int ds = 0; ds < 8; ++ds) qr[ds] = __builtin_bit_cast(bf16x8, f8x8_to_bf16x8(qraw[ds].x, qraw[ds].y));
            if (F.lane < 32) { wsi[64 + r] = tq; wsi[96 + r] = slot; }
            f32x16 o[4]; float m = -1e30f, l = 0.f;
#pragma unroll
            for (int db = 0; db < 4; ++db)
#pragma unroll
                for (int i = 0; i < 16; ++i) o[db][i] = 0.f;
#define ATT2_TB(bb) ((size_t)((bb) >> 7) * SEQ + ((bb) & 15) * LBLK)
#define ATT2_H(bb) (((bb) >> 4) & 7)
#pragma unroll 1
            for (int kp2 = 0; kp2 < 2; ++kp2) {
                const int kt = 2 * kp2;
                { const bool cur3 = kt + 3 < 4, have3 = cur3 || hasn, have2 = (kt + 2 < 4) || hasn;
                  if (have3) { const int bb = cur3 ? bhj : bhjn; tile_load(F, K, V, ATT2_TB(bb), ATT2_H(bb), (kt + 3) & 3, rkB, rvB); }
                  if (kt == 0 && hasn) { cntn = (int)__hip_atomic_load(LCNT + bhjn, __ATOMIC_RELAXED, __HIP_MEMORY_SCOPE_AGENT); }
                  if (kt == 2 && hasn) { const unsigned char* qrow = Q + ((size_t)(bhjn >> 7) * SEQ + (entn & 4095)) * DM + ((bhjn >> 4) & 7) * DH + hh * 8;
#pragma unroll
                      for (int ds = 0; ds < 8; ++ds) qraw[ds] = *(const u32x2*)(qrow + ds * 16); }
                  tile_compute(F, 0, qr, o, m, l, kp2 == 0);
                  asm volatile("s_waitcnt lgkmcnt(0)" ::: "memory"); __builtin_amdgcn_s_barrier(); asm volatile("" ::: "memory");
                  if (have2) tile_write(F, 0, rkA, rvA); }
                { const bool have4 = hasn, have3 = (kt + 3 < 4) || hasn;
                  if (have4) { tile_load(F, K, V, ATT2_TB(bhjn), ATT2_H(bhjn), kt, rkA, rvA); }
                  if (kt == 0 && hasn) { const int qn = chunkn * 256 + F.wave * 32 + r; entn = LISTS[(size_t)bhjn * 4096 + (qn < cntn ? qn : 0)]; }
                  tile_compute(F, 1, qr, o, m, l, false);
                  asm volatile("s_waitcnt lgkmcnt(0)" ::: "memory"); __builtin_amdgcn_s_barrier(); asm volatile("" ::: "memory");
                  if (have3) tile_write(F, 1, rkB, rvB); }
            }
            const float lt = l + __shfl_xor(l, 32);
            if (hh == 0) { wsf[r] = 1.0f / lt; wsf[32 + r] = m + __builtin_amdgcn_logf(lt); }
            asm volatile("s_waitcnt lgkmcnt(0)" ::: "memory");
            int re = r, he = hh; asm volatile("" : "+v"(re), "+v"(he));
#pragma unroll
            for (int i = 0; i < 16; ++i) {
                const int q = crow(i, he); const float a = wsf[q]; const int t = wsi[64 + q], sl = wsi[96 + q];
                const unsigned w = pack_fp8x4(o[0][i] * a, o[1][i] * a, o[2][i] * a, o[3][i] * a);
                if (sl >= 0) { const size_t row = (((size_t)sl * NB + b) * SEQ + t) * NH + h; *(unsigned*)(OP + row * DH + 4 * re) = w; }
            }
            if (he == 0 && slot >= 0) LSE[(((size_t)slot * NB + b) * SEQ + tq) * NH + h] = wsf[32 + re];
            asm volatile("s_waitcnt lgkmcnt(0)" ::: "memory");
            if (!hasn) break;
            it = itn; bhj = bhjn; chunk = chunkn; cnt = cntn;
            { const int qn = chunk * 256 + F.wave * 32 + r; tq = entn & 4095; slot = (qn < cnt) ? (int)(entn >> 12) : -1; }
            itn = it + F.G; hasn = itn < total; if (hasn) ATT2_DECODE(itn, bhjn, chunkn);
        }
    }
    __syncthreads();
}

__device__ __forceinline__ void ph_attn_own(const Ctx& F) {
    using namespace att2;
    const unsigned char* Q = F.ws + WS_Q; const unsigned char* K = F.ws + WS_K; const unsigned char* V = F.ws + WS_V;
    const unsigned char* OP = F.ws + WS_OP; const float* LSE = (const float*)(F.ws + WS_LSE); bf16_t* YAB = (bf16_t*)(F.ws + WS_YAB);
    LAS float* wsf = (LAS float*)(F.lds + OFF_WS + F.wave * WSW);
    const int r = F.lane & 31, hh = F.lane >> 5;
    constexpr int NIT = NB * NH * NBLK;
    int it = F.vcu;
    if (it < NIT) {
        int itn = it + F.G; bool hasn = itn < NIT;
        u32x4 rkA, rvA, rkB, rvB;
#define OWN_TB(i_) ((size_t)((i_) >> 7) * SEQ + ((i_) & 15) * LBLK)
#define OWN_H(i_) (((i_) >> 4) & 7)
        tile_load(F, K, V, OWN_TB(it), OWN_H(it), 0, rkA, rvA); tile_load(F, K, V, OWN_TB(it), OWN_H(it), 1, rkB, rvB); tile_write(F, 0, rkA, rvA); tile_write(F, 1, rkB, rvB);
        tile_load(F, K, V, OWN_TB(it), OWN_H(it), 2, rkA, rvA);
        u32x2 qraw[8];
        { const unsigned char* qrow = Q + (OWN_TB(it) + F.wave * 32 + r) * DM + OWN_H(it) * DH + hh * 8;
#pragma unroll
          for (int ds = 0; ds < 8; ++ds) qraw[ds] = *(const u32x2*)(qrow + ds * 16); }
        __syncthreads();
        const int wdiag = F.wave >> 1;
        for (;;) {
            const int b = it >> 7, h = (it >> 4) & 7, j = it & 15, t0 = j * LBLK + F.wave * 32;
            bf16x8 qr[8];
#pragma unroll
            for (int ds = 0; ds < 8; ++ds) qr[ds] = __builtin_bit_cast(bf16x8, f8x8_to_bf16x8(qraw[ds].x, qraw[ds].y));
            f32x16 o[4]; float m = -1e30f, l = 0.f;
#pragma unroll
            for (int db = 0; db < 4; ++db)
#pragma unroll
                for (int i = 0; i < 16; ++i) o[db][i] = 0.f;
#pragma unroll 1
            for (int kp2 = 0; kp2 < 2; ++kp2) {
                const int kt = 2 * kp2;
                { const bool cur3 = kt + 3 < 4, have3 = cur3 || hasn, have2 = (kt + 2 < 4) || hasn;
                  if (have3) { const int ii = cur3 ? it : itn; tile_load(F, K, V, OWN_TB(ii), OWN_H(ii), (kt + 3) & 3, rkB, rvB); }
                  if (kt == 2 && hasn) { const unsigned char* qrow = Q + (OWN_TB(itn) + F.wave * 32 + r) * DM + OWN_H(itn) * DH + hh * 8;
#pragma unroll
                      for (int ds = 0; ds < 8; ++ds) qraw[ds] = *(const u32x2*)(qrow + ds * 16); }
                  if (kt <= wdiag) tile_compute<true>(F, 0, qr, o, m, l, kp2 == 0, kt == wdiag);
                  asm volatile("s_waitcnt lgkmcnt(0)" ::: "memory"); __builtin_amdgcn_s_barrier(); asm volatile("" ::: "memory");
                  if (have2) tile_write(F, 0, rkA, rvA); }
                { const bool have4 = hasn, have3 = (kt + 3 < 4) || hasn;
                  if (have4) { tile_load(F, K, V, OWN_TB(itn), OWN_H(itn), kt, rkA, rvA); }
                  if (kt + 1 <= wdiag) tile_compute<true>(F, 1, qr, o, m, l, false, kt + 1 == wdiag);
                  asm volatile("s_waitcnt lgkmcnt(0)" ::: "memory"); __builtin_amdgcn_s_barrier(); asm volatile("" ::: "memory");
                  if (have3) tile_write(F, 1, rkB, rvB); }
            }
            const int nv = j < 3 ? j : 3;
            {
                const float lt = l + __shfl_xor(l, 32); const float lse_own = m + __builtin_amdgcn_logf(lt);
                float ls[3];
#pragma unroll
                for (int s2 = 0; s2 < 3; ++s2) ls[s2] = (s2 < nv) ? LSE[(((size_t)s2 * NB + b) * SEQ + t0 + r) * NH + h] : -1e30f;
                const float M = fmaxf(fmaxf(lse_own, ls[0]), fmaxf(ls[1], ls[2]));
                const float w0 = __builtin_amdgcn_exp2f(lse_own - M);
                float w[3], den = w0;
#pragma unroll
                for (int s2 = 0; s2 < 3; ++s2) { w[s2] = (s2 < nv) ? __builtin_amdgcn_exp2f(ls[s2] - M) : 0.f; den += w[s2]; }
                const float inv = 1.0f / den;
                if (hh == 0) { wsf[r] = w0 * inv / lt; wsf[32 + r] = w[0] * inv; wsf[64 + r] = w[1] * inv; wsf[96 + r] = w[2] * inv; }
                asm volatile("s_waitcnt lgkmcnt(0)" ::: "memory");
            }
            int re = r, he = hh; asm volatile("" : "+v"(re), "+v"(he));
            LAS float* stg = (LAS float*)(F.lds + OFF_STG + F.wave * 8192);
            {
                unsigned pv[16][3];
#pragma unroll
                for (int i = 0; i < 16; ++i) { const int q = crow(i, he);
#pragma unroll
                    for (int s2 = 0; s2 < 3; ++s2) { pv[i][s2] = 0u; if (s2 < nv) pv[i][s2] = *(const unsigned*)(OP + ((((size_t)s2 * NB + b) * SEQ + t0 + q) * NH + h) * DH + 4 * re); } }
#pragma unroll
                for (int i = 0; i < 16; ++i) { const int q = crow(i, he); const float a = wsf[q];
                    float x0 = o[0][i] * a, x1 = o[1][i] * a, x2 = o[2][i] * a, x3 = o[3][i] * a;
#pragma unroll
                    for (int s2 = 0; s2 < 3; ++s2) { const float ww = wsf[32 * (s2 + 1) + q]; const f32x2v f0 = __builtin_amdgcn_cvt_pk_f32_fp8((int)pv[i][s2], false), f1 = __builtin_amdgcn_cvt_pk_f32_fp8((int)pv[i][s2], true);
                        x0 += ww * f0.x; x1 += ww * f0.y; x2 += ww * f1.x; x3 += ww * f1.y; }
                    o[0][i] = x0; o[1][i] = x1; o[2][i] = x2; o[3][i] = x3; }
            }
#pragma unroll
            for (int half = 0; half < 2; ++half) {
#pragma unroll
                for (int i = 0; i < 16; ++i) { const int q = crow(i, he); stg[q * 64 + re] = o[2 * half][i]; stg[q * 64 + 32 + re] = o[2 * half + 1][i]; }
                asm volatile("s_waitcnt lgkmcnt(0)" ::: "memory");
#pragma unroll
                for (int ps = 0; ps < 4; ++ps) {
                    const int q = ps * 8 + ((re + 32 * he) >> 3), dc = re & 7;
                    const f32x4 x = *(LAS const f32x4*)(stg + q * 64 + dc * 8), y = *(LAS const f32x4*)(stg + q * 64 + dc * 8 + 4);
                    *(u32x4*)(YAB + ((size_t)b * SEQ + t0 + q) * 2048 + 1024 + h * DH + half * 64 + dc * 8) = (u32x4){cvt_pk_bf16(x.x, x.y), cvt_pk_bf16(x.z, x.w), cvt_pk_bf16(y.x, y.y), cvt_pk_bf16(y.z, y.w)};
                }
                asm volatile("s_waitcnt lgkmcnt(0)" ::: "memory");
            }
            if (!hasn) break;
            it = itn; itn = it + F.G; hasn = itn < NIT;
        }
#undef OWN_TB
#undef OWN_H
    }
    __syncthreads();
}

__device__ __forceinline__ void ph_router(const Ctx& F) {
    const Args& A = *F.a;
    const bf16_t* Z = (const bf16_t*)(F.ws + WS_Z); const float* ZST = (const float*)(F.ws + WS_ZST); bf16_t* H1 = (bf16_t*)(F.ws + WS_H1); unsigned char* H1F8 = F.ws + WS_H1F8;
    int* TKE = (int*)(F.ws + WS_TKE); int* TKP = (int*)(F.ws + WS_TKP); unsigned* ECNT = (unsigned*)(F.ws + WS_CTL) + CW_ECNT; int* RT = (int*)(F.ws + WS_RT); float* RW = (float*)(F.ws + WS_RW);
    const float* wr = A.in[I_WR]; const float* br = A.in[I_BR];
    constexpr int RS = 2064, OFF_LO = 32 * RS, OFF_G = 2 * 32 * RS  , OFF_B = OFF_G + 4096, OFF_LG = OFF_B + 4096  , OFF_CNT = OFF_LG + 8 * 2112  ;
    static_assert(OFF_CNT + 256 <= LDS_BYTES, "router LDS map");
    LAS unsigned char* WH = F.lds; LAS unsigned char* WL = F.lds + OFF_LO;
    LAS float* LG = (LAS float*)(F.lds + OFF_G); LAS float* LB = (LAS float*)(F.lds + OFF_B);
    LAS float* lgt = (LAS float*)(F.lds + OFF_LG + F.wave * 2112);
    LAS unsigned* lcnt = (LAS unsigned*)(F.lds + OFF_CNT);
    {
        f32x4 wa[8], wb[8];
#pragma unroll
        for (int u_ = 0; u_ < 8; ++u_) { const int i = F.tid + 512 * u_, nq = i & 7, k2 = i >> 3;
            wa[u_] = *(const f32x4*)(wr + (size_t)(2 * k2) * NE + 4 * nq); wb[u_] = *(const f32x4*)(wr + (size_t)(2 * k2 + 1) * NE + 4 * nq); }
#pragma unroll
        for (int u_ = 0; u_ < 8; ++u_) { const int i = F.tid + 512 * u_, nq = i & 7, k2 = i >> 3;
#pragma unroll
            for (int c = 0; c < 4; ++c) {
                const float w0 = wa[u_][c], w1 = wb[u_][c];
                const unsigned h0 = f2bf(w0), h1 = f2bf(w1);
                const float r0 = w0 - __uint_as_float(h0 << 16), r1 = w1 - __uint_as_float(h1 << 16);
                *(LAS unsigned*)(WH + (4 * nq + c) * RS + k2 * 4) = h0 | (h1 << 16);
                *(LAS unsigned*)(WL + (4 * nq + c) * RS + k2 * 4) = pk2(r0, r1);
            } }
    }
    for (int i = F.tid; i < DM; i += 512) { LG[i] = A.in[I_LNMIX_G][i]; LB[i] = A.in[I_LNMIX_B][i]; }
    if (F.tid < 64) lcnt[F.tid] = 0u;
    __syncthreads();
    const int fr = F.lane & 15, kg = F.lane >> 4;
    const int ntask = T / 16, NGW = F.G * 8;
    const int rounds = (ntask + NGW - 1) / NGW;
    for (int rd = 0; rd < rounds; ++rd) {
        const int task = rd * NGW + F.vcu * 8 + F.wave;
        const bool live = task < ntask;
        int te[4] = {0, 0, 0, 0}; float tw[4] = {0.f, 0.f, 0.f, 0.f}; unsigned lp[4] = {0, 0, 0, 0};
        if (live) {
            const int tok = task * 16 + fr;
            float mean, rstd;
            { const f32x4* sp = (const f32x4*)(ZST + (size_t)tok * 32); float s1 = 0.f, s2 = 0.f;
#pragma unroll
              for (int i = 0; i < 8; ++i) { const f32x4 v = sp[i]; s1 += v.x + v.z; s2 += v.y + v.w; }
              mean = s1 * (1.f / DM); const float var = s2 * (1.f / DM) - mean * mean; rstd = 1.f / sqrtf(fmaxf(var, 0.f) + LN_EPS); }
            f32x4 acc0 = {0.f, 0.f, 0.f, 0.f}, acc1 = {0.f, 0.f, 0.f, 0.f};
            const bf16_t* zp = Z + (size_t)tok * DM + 8 * kg; unsigned char* h8 = H1F8 + (size_t)tok * DM + 8 * kg;
#pragma unroll 8
            for (int kk = 0; kk < 32; ++kk) {
                const u32x4 zr = *(const u32x4*)(zp + 32 * kk); const f32x4 z0 = {bflo(zr.x), bfhi(zr.x), bflo(zr.y), bfhi(zr.y)}, z1 = {bflo(zr.z), bfhi(zr.z), bflo(zr.w), bfhi(zr.w)};
                const f32x4 g0 = *(LAS const f32x4*)(LG + 32 * kk + 8 * kg), g1 = *(LAS const f32x4*)(LG + 32 * kk + 8 * kg + 4);
                const f32x4 b0 = *(LAS const f32x4*)(LB + 32 * kk + 8 * kg), b1 = *(LAS const f32x4*)(LB + 32 * kk + 8 * kg + 4);
                const f32x4 x0 = (z0 - mean) * rstd * g0 + b0, x1 = (z1 - mean) * rstd * g1 + b1;
                u32x4 hi; hi.x = cvt_pk_bf16(x0.x, x0.y); hi.y = cvt_pk_bf16(x0.z, x0.w); hi.z = cvt_pk_bf16(x1.x, x1.y); hi.w = cvt_pk_bf16(x1.z, x1.w);
                { unsigned w0 = 0u, w1 = 0u;
                  w0 = __builtin_amdgcn_cvt_pk_fp8_f32(x0.x, x0.y, w0, false); w0 = __builtin_amdgcn_cvt_pk_fp8_f32(x0.z, x0.w, w0, true);
                  w1 = __builtin_amdgcn_cvt_pk_fp8_f32(x1.x, x1.y, w1, false); w1 = __builtin_amdgcn_cvt_pk_fp8_f32(x1.z, x1.w, w1, true);
                  *(u32x2*)(h8 + 32 * kk) = (u32x2){w0, w1}; }
                u32x4 lo; lo.x = cvt_pk_bf16(x0.x - bflo(hi.x), x0.y - bfhi(hi.x)); lo.y = cvt_pk_bf16(x0.z - bflo(hi.y), x0.w - bfhi(hi.y));
                lo.z = cvt_pk_bf16(x1.x - bflo(hi.z), x1.y - bfhi(hi.z)); lo.w = cvt_pk_bf16(x1.z - bflo(hi.w), x1.w - bfhi(hi.w));
                const bf16x8 ah = __builtin_bit_cast(bf16x8, hi), al = __builtin_bit_cast(bf16x8, lo);
                const int bo = fr * RS + (32 * kk + 8 * kg) * 2;
                const bf16x8 wh0 = *(LAS const bf16x8*)(WH + bo), wh1 = *(LAS const bf16x8*)(WH + bo + 16 * RS), wl0 = *(LAS const bf16x8*)(WL + bo), wl1 = *(LAS const bf16x8*)(WL + bo + 16 * RS);
                acc0 = __builtin_amdgcn_mfma_f32_16x16x32_bf16(ah, wh0, acc0, 0, 0, 0); acc1 = __builtin_amdgcn_mfma_f32_16x16x32_bf16(ah, wh1, acc1, 0, 0, 0);
                acc0 = __builtin_amdgcn_mfma_f32_16x16x32_bf16(ah, wl0, acc0, 0, 0, 0); acc1 = __builtin_amdgcn_mfma_f32_16x16x32_bf16(ah, wl1, acc1, 0, 0, 0);
                acc0 = __builtin_amdgcn_mfma_f32_16x16x32_bf16(al, wh0, acc0, 0, 0, 0); acc1 = __builtin_amdgcn_mfma_f32_16x16x32_bf16(al, wh1, acc1, 0, 0, 0);
            }
            const float br0 = br[fr], br1 = br[16 + fr];
#pragma unroll
            for (int i = 0; i < 4; ++i) { lgt[(4 * kg + i) * 33 + fr] = acc0[i] + br0; lgt[(4 * kg + i) * 33 + 16 + fr] = acc1[i] + br1; }
            asm volatile("s_waitcnt lgkmcnt(0)" ::: "memory");
            if (F.lane < 16) {
                float lg[NE];
#pragma unroll
                for (int e = 0; e < NE; ++e) lg[e] = lgt[F.lane * 33 + e];
                float tv[4];
#pragma unroll
                for (int r = 0; r < 4; ++r) {
                    float best = -INFINITY; int bi = 0;
#pragma unroll
                    for (int e = 0; e < NE; ++e) { const bool c = lg[e] > best; best = c ? lg[e] : best; bi = c ? e : bi; }
#pragma unroll
                    for (int e = 0; e < NE; ++e) lg[e] = (e == bi) ? -INFINITY : lg[e];
                    te[r] = bi; tv[r] = best;
                }
                const float e1 = __expf(tv[1] - tv[0]), e2 = __expf(tv[2] - tv[0]), e3 = __expf(tv[3] - tv[0]); const float inv = 1.f / (1.f + e1 + e2 + e3);
                tw[0] = inv; tw[1] = e1 * inv; tw[2] = e2 * inv; tw[3] = e3 * inv;
#pragma unroll
                for (int r = 0; r < 4; ++r) lp[r] = atomicAdd((unsigned*)(lcnt + te[r]), 1u);
            }
        }
        __syncthreads();
        if (F.tid < 32) { const unsigned c = lcnt[F.tid]; lcnt[32 + F.tid] = c ? atomicAdd(&ECNT[F.tid], c) : 0u; }
        __syncthreads();
        if (live && F.lane < 16) {
            const size_t tok = (size_t)task * 16 + F.lane;
            int4 pe = {te[0], te[1], te[2], te[3]};
            int4 pp = {(int)(lcnt[32 + te[0]] + lp[0]), (int)(lcnt[32 + te[1]] + lp[1]), (int)(lcnt[32 + te[2]] + lp[2]), (int)(lcnt[32 + te[3]] + lp[3])};
            *(int4*)(TKE + tok * 4) = pe; *(int4*)(TKP + tok * 4) = pp;
#pragma unroll
            for (int r = 0; r < 4; ++r) { const size_t o_ = (size_t)te[r] * T + (r == 0 ? pp.x : r == 1 ? pp.y : r == 2 ? pp.z : pp.w); RT[o_] = (int)tok; RW[o_] = tw[r]; }
        }
        __syncthreads();
        if (F.tid < 32) lcnt[F.tid] = 0u;
        __syncthreads();
    }
}

__device__ __forceinline__ void moe_table(const Ctx& F) {
    const unsigned* ECNT = (const unsigned*)(F.ws + WS_CTL) + CW_ECNT;
    LAS int* tab = (LAS int*)(F.lds + LDS_MOE);
    __syncthreads();
    if (F.tid == 0) {
        int acc = 0;
        for (int e = 0; e < NE; ++e) { const int c = (int)__hip_atomic_load(ECNT + e, __ATOMIC_RELAXED, __HIP_MEMORY_SCOPE_AGENT); tab[32 + e] = acc; acc += (c + 255) / 256 * 256; }
        tab[64] = acc; tab[0] = acc / 256;
    }
    __syncthreads();
    const int ntiles = tab[0];
    for (int i = F.tid; i < ntiles; i += 512) { int e = 0; for (int k = 1; k < NE; ++k) if (i * 256 >= tab[32 + k]) e = k; tab[128 + 2 * i] = e; tab[129 + 2 * i] = i - tab[32 + e] / 256; }
    __syncthreads();
}

__device__ __forceinline__ void ln_stats16(const float* st, int lane, float& mean, float& rstd) {
    float s1 = 0.f, s2 = 0.f;
    if (lane < 16) { const f32x2 p = *(const f32x2*)(st + 2 * lane); s1 = p.x; s2 = p.y; }
    s1 = wave_sum(s1); s2 = wave_sum(s2);
    mean = s1 * (1.f / DM); const float var = s2 * (1.f / DM) - mean * mean; rstd = 1.f / sqrtf(fmaxf(var, 0.f) + LN_EPS);
}
__device__ __forceinline__ void ph_final(const Ctx& F) {
    const Args& A = *F.a;
    const bf16_t* Z = (const bf16_t*)(F.ws + WS_Z); const float* ZST = (const float*)(F.ws + WS_ZST); const unsigned char* YS = F.ws + WS_YS; const int* TKE = (const int*)(F.ws + WS_TKE); const int* TKP = (const int*)(F.ws + WS_TKP);
    const LAS int* tab = (const LAS int*)(F.lds + LDS_MOE);
    const int gw = F.vcu * 8 + F.wave, NGW = F.G * 8;
    f32x4 g2[4], b2[4], g1[4], b1[4];
#pragma unroll
    for (int j = 0; j < 4; ++j) { g2[j] = *((const f32x4*)A.in[I_LNF_G] + F.lane + 64 * j); b2[j] = *((const f32x4*)A.in[I_LNF_B] + F.lane + 64 * j);
        g1[j] = *((const f32x4*)A.in[I_LNMIX_G] + F.lane + 64 * j) * ALPHA; b1[j] = *((const f32x4*)A.in[I_LNMIX_B] + F.lane + 64 * j) * ALPHA; }
    for (int m = gw; m < T; m += NGW) {
        float mean, rstd; ln_stats16(ZST + (size_t)m * 32, F.lane, mean, rstd);
        const u32x2* hr = (const u32x2*)(Z + (size_t)m * DM) + F.lane;
        f32x4 v[4];
#pragma unroll
        for (int j = 0; j < 4; ++j) { const u32x2 hb = hr[64 * j]; v[j] = ((f32x4){bflo(hb.x), bfhi(hb.x), bflo(hb.y), bfhi(hb.y)} - mean) * rstd * g1[j] + b1[j]; }
#pragma unroll
        for (int k = 0; k < 4; ++k) {
            const int row = tab[32 + TKE[(size_t)m * 4 + k]] + TKP[(size_t)m * 4 + k]; const unsigned* yr = (const unsigned*)(YS + (size_t)row * DM) + F.lane;
#pragma unroll
            for (int j = 0; j < 4; ++j) { const unsigned y = yr[64 * j]; const f32x2v f0 = __builtin_amdgcn_cvt_pk_f32_fp8((int)y, false), f1 = __builtin_amdgcn_cvt_pk_f32_fp8((int)y, true);
                v[j].x += 0.0625f * f0.x; v[j].y += 0.0625f * f0.y; v[j].z += 0.0625f * f1.x; v[j].w += 0.0625f * f1.y; }
        }
        float s = 0.f;
#pragma unroll
        for (int j = 0; j < 4; ++j) s += (v[j].x + v[j].y) + (v[j].z + v[j].w);
        const float mu = wave_sum(s) * (1.f / DM); float s2 = 0.f;
#pragma unroll
        for (int j = 0; j < 4; ++j) { v[j] = v[j] - mu; s2 += (v[j].x * v[j].x + v[j].y * v[j].y) + (v[j].z * v[j].z + v[j].w * v[j].w); }
        const float rs = 1.f / sqrtf(wave_sum(s2) * (1.f / DM) + LN_EPS);
        f32x4* orow = (f32x4*)(A.out + (size_t)m * DM) + F.lane;
#pragma unroll
        for (int j = 0; j < 4; ++j) orow[64 * j] = v[j] * rs * g2[j] + b2[j];
    }
}

#define XB_TMO      128
#define XB_XCNT(j)  (256  + 64 * (j))
#define XB_XSUB(j)  (1280 + 64 * (j))
#define XB_XGEN(j)  (2304 + 64 * (j))
#define XB_TOP      3328
#define XB_TOPGEN   3392
#define XCD_BAR_WORDS 3456
#define XB_SPIN_CAP (1u << 18)
__device__ __forceinline__ unsigned xb_ld(unsigned* p)              { return __hip_atomic_load(p, __ATOMIC_RELAXED, __HIP_MEMORY_SCOPE_AGENT); }
__device__ __forceinline__ unsigned xb_add(unsigned* p, unsigned v) { return __hip_atomic_fetch_add(p, v, __ATOMIC_RELAXED, __HIP_MEMORY_SCOPE_AGENT); }
__device__ __forceinline__ unsigned xb_xcc_id() { return (unsigned)__builtin_amdgcn_s_getreg((3 << 11) | 20) & 0xFu; }
#define XB_SPIN(cond, bar) do { unsigned _sp = 0; while (cond) { __builtin_amdgcn_s_sleep(1); \
    if ((++_sp & 255u) == 0u) { if (xb_ld(&(bar)[XB_TMO])) break; if (_sp > XB_SPIN_CAP) { atomicAdd(&(bar)[XB_TMO], 1u); break; } } } } while (0)
__device__ __forceinline__ void xcd_barrier_complete(unsigned* bar, unsigned x, unsigned& nloc, unsigned& nx) {
    const unsigned G = gridDim.x * gridDim.y * gridDim.z;
    unsigned sum, cnt, mine, sp = 0u;
    for (;;) {
        sum = 0u; cnt = 0u; mine = 0u;
#pragma unroll
        for (unsigned j = 0; j < 16; ++j) { const unsigned c = xb_ld(&bar[XB_XCNT(j)]); sum += c; cnt += (c > 0u) ? 1u : 0u; mine = (j == x) ? c : mine; }
        if (sum == G) break;
        __builtin_amdgcn_s_sleep(1);
        if ((++sp & 255u) == 0u) { if (xb_ld(&bar[XB_TMO])) break; if (sp > XB_SPIN_CAP) { atomicAdd(&bar[XB_TMO], 1u); break; } }
    }
    nloc = mine > 0u ? mine : 1u; nx = cnt > 0u ? cnt : 1u;
}
__device__ __forceinline__ void xcd_barrier(unsigned* bar, volatile LAS unsigned* st, unsigned x, bool leader_thread) {
    asm volatile("s_waitcnt vmcnt(0)" ::: "memory");
    __syncthreads();
    if (leader_thread) {
        __builtin_amdgcn_s_waitcnt(0);
        unsigned nloc = st[0], nx = st[1];
        if (nloc == 0u) { xcd_barrier_complete(bar, x, nloc, nx); st[0] = nloc; st[1] = nx; }
        const unsigned old = xb_add(&bar[XB_XSUB(x)], 1u);
        const unsigned gen = old / nloc;
        if (old + 1u == (gen + 1u) * nloc) {
            __builtin_amdgcn_fence(__ATOMIC_RELEASE, "agent");
            asm volatile("s_waitcnt vmcnt(0)" ::: "memory");
            const unsigned og = xb_add(&bar[XB_TOP], 1u);
            const unsigned tg = og / nx;
            if (og + 1u == (tg + 1u) * nx) xb_add(&bar[XB_TOPGEN], 1u);
            else XB_SPIN(xb_ld(&bar[XB_TOPGEN]) == tg, bar);
            __builtin_amdgcn_fence(__ATOMIC_ACQUIRE, "agent");
            xb_add(&bar[XB_XGEN(x)], 1u);
            asm volatile("s_waitcnt vmcnt(0)" ::: "memory");
        } else {
            XB_SPIN(xb_ld(&bar[XB_XGEN(x)]) == gen, bar);
            __builtin_amdgcn_fence(__ATOMIC_ACQUIRE, "agent");
            asm volatile("s_waitcnt vmcnt(0)" ::: "memory");
        }
    }
    __syncthreads();
}

template <bool COOP>
__global__ void __launch_bounds__(512, 2) mega(Args args) {
    extern __shared__ __attribute__((aligned(16))) unsigned char lds_raw[];
    Ctx F;
    const int wave0 = __builtin_amdgcn_readfirstlane(threadIdx.x >> 6);
#define MKCTX() do { F.a = &args; F.ws = args.ws; F.lds = (LAS unsigned char*)lds_raw; F.ldsg = lds_raw; F.lane = lane_id_asm(); F.wave = wave0; F.tid = wave0 * 64 + F.lane; \
    F.G = gridDim.x; { const int bx = blockIdx.x; F.vcu = (F.G % 8 == 0) ? (bx % 8) * (F.G / 8) + bx / 8 : bx; } } while (0)
    MKCTX();
    const int lo = args.ph_lo, hi = args.ph_hi;
    unsigned char* ws = args.ws;
#ifndef PHMASK
#define PHMASK 0xFFFF
#endif
#define IN(k) (((PHMASK >> (k)) & 1) && lo <= (k) && (k) < hi)
    unsigned* barw = (unsigned*)(ws + WS_CTL) + CW_BAR; volatile LAS unsigned* bst = (volatile LAS unsigned*)((LAS unsigned char*)lds_raw + LDS_BYTES - 64);
    const unsigned my_xcc = xb_xcc_id();
    if (COOP) { if (threadIdx.x == 0) { bst[0] = 0u; bst[1] = 0u; (void)xb_add(&barw[XB_XCNT(my_xcc)], 1u); } __syncthreads(); }
#define SEAM(k) do { if (COOP && IN(k) && IN((k) + 1)) { if (args.ph_hi > 1000) cg::this_grid().sync();   xcd_barrier(barw, bst, my_xcc, wave0 == 0 && lane_id_asm() == 0); } } while (0)
    if (IN(0)) { MKCTX(); ph_prologue(F); } SEAM(0);
    if (IN(1)) {
        {
            pg8::Gemm g{(const bf16_t*)(ws + WS_H0), (const bf16_t*)(ws + WS_WIN), DM, DM, DM, nullptr}; pg8::StaticOrder S; S.init(T, (PN8_LO + 28 - PN8_HI) * 256, F.G, (int)blockIdx.x, 0, PN8_LO, PN8_HI - PN8_LO);
            const pg8::Epi1 E{(bf16_t*)(ws + WS_YAB), (bf16_t*)(ws + WS_GV), ws + WS_Q, ws + WS_K, ws + WS_V, (bf16_t*)(ws + WS_SA), (bf16_t*)(ws + WS_SB), (float*)(ws + WS_GVST), (float*)(ws + WS_KMEAN), 1.0f, 0.f};
            pg8::gemm_phase<pg8::Epi1, pg8::StaticOrder, true>(F.lds, g, S, E, wave0);
        }
        {
            const pg8::Epi1 E{(bf16_t*)(ws + WS_YAB), (bf16_t*)(ws + WS_GV), ws + WS_Q, ws + WS_K, ws + WS_V, (bf16_t*)(ws + WS_SA), (bf16_t*)(ws + WS_SB), (float*)(ws + WS_GVST), (float*)(ws + WS_KMEAN), 0.03125f, 0.f};
            pg8::Gemm g{(const bf16_t*)(ws + WS_H0F8), (const bf16_t*)(ws + WS_WIN8), DM / 2, DM / 2, DM / 2, nullptr}; pg8::StaticOrder S; S.init(T, (PN8_HI - PN8_LO) * 256, F.G, (int)blockIdx.x, PN8_LO);
            pg8::gemm_phase<pg8::Epi1, pg8::StaticOrder, true, true>(F.lds, g, S, E, wave0);
        }
    } SEAM(1);
    if (IN(2)) { MKCTX(); ph_mixer_a(F); __syncthreads(); ph_gate(F); } SEAM(2);
    if (IN(3)) { } if (COOP && IN(3) && IN(4)) { }
    if (IN(4)) { MKCTX(); ph_attn_partial(F); } SEAM(4);
    if (IN(5)) { MKCTX(); ph_attn_own(F); } SEAM(5);
    if (IN(6)) {
        pg8::Gemm g{(const bf16_t*)(ws + WS_YAB), (const bf16_t*)(ws + WS_WAB), 2048, 2048, 2048, nullptr}; pg8::StaticOrder S; S.init(T, DM, F.G, (int)blockIdx.x);
        pg8::Epi2 E{ws + WS_SA, ws + WS_SB, (bf16_t*)(ws + WS_MG)};
        pg8::gemm_phase<pg8::Epi2, pg8::StaticOrder, true>(F.lds, g, S, E, wave0);
    } SEAM(6);
    if (IN(7)) {
        pg8::Gemm g{(const bf16_t*)(ws + WS_MG), (const bf16_t*)(ws + WS_WOUT), DM, DM, DM, nullptr}; pg8::StaticOrder S; S.init(T, DM, F.G, (int)blockIdx.x);
        pg8::Epi3 E{(const bf16_t*)(ws + WS_H0), (bf16_t*)(ws + WS_Z), (float*)(ws + WS_ZST)};
        pg8::gemm_phase<pg8::Epi3, pg8::StaticOrder, true>(F.lds, g, S, E, wave0);
    } SEAM(7);
    if (IN(8)) { MKCTX(); ph_router(F); } SEAM(8);
    if (IN(9)) { } if (COOP && IN(9) && IN(10)) { }
    if (IN(10)) {
        MKCTX(); moe_table(F);
        pg8::Gemm g{(const bf16_t*)(ws + WS_H1F8), (const bf16_t*)(ws + WS_WUP), DM / 2, DM / 2, DM / 2, (const int*)(ws + WS_RT)}; pg8::MoeOrder S;   S.init((const LAS int*)(F.lds + LDS_MOE), 8, F.G, (int)blockIdx.x);
        pg8::Epi4 E{args.in[I_BUP], ws + WS_ACT};
        pg8::gemm_phase<pg8::Epi4, pg8::MoeOrder, true, true, true>(F.lds, g, S, E, wave0);
    } SEAM(10);
    if (IN(11)) {
        MKCTX(); moe_table(F);
        pg8::Gemm g{(const bf16_t*)(ws + WS_ACT), (const bf16_t*)(ws + WS_WDN), FF / 2, FF / 2, FF / 2, nullptr}; pg8::MoeOrder S; S.init((const LAS int*)(F.lds + LDS_MOE), 4, F.G, (int)blockIdx.x);
        pg8::Epi5 E{args.in[I_BDN], (const float*)(ws + WS_RW), ws + WS_YS};
        pg8::gemm_phase<pg8::Epi5, pg8::MoeOrder, true, true>(F.lds, g, S, E, wave0);
    } SEAM(11);
    if (IN(12)) { MKCTX(); moe_table(F); ph_final(F); }
#undef IN
#undef SEAM
}

extern "C" void kernel_launch(void* const* d_in, const int* in_sizes, int n_in, void* d_out, int out_size, void* d_ws, size_t ws_size, hipStream_t stream) {
    static int grid = 0;
    if (grid == 0) {
        if (n_in != 21 || in_sizes[0] != T * DM || out_size != T * DM || ws_size < WS_END) { fprintf(stderr, "kernel_launch: unexpected shapes (n_in %d, in0 %d, out %d, ws %zu)\n", n_in, n_in > 0 ? in_sizes[0] : -1, out_size, ws_size); grid = -1; return; }
        int dev = 0, cus = 0, per_cu = 0;
        hipGetDevice(&dev); hipDeviceGetAttribute(&cus, hipDeviceAttributeMultiprocessorCount, dev);
        const void* fn = MK_COOP ? (const void*)mega<true> : (const void*)mega<false>;
        hipFuncSetAttribute(fn, hipFuncAttributeMaxDynamicSharedMemorySize, LDS_BYTES);
        hipOccupancyMaxActiveBlocksPerMultiprocessor(&per_cu, fn, 512, LDS_BYTES);
        (void)hipGetLastError();
        if (per_cu < 1) { fprintf(stderr, "kernel_launch: occupancy query says %d blocks/CU\n", per_cu); per_cu = 1; }
        grid = cus * 1;
    }
    if (grid < 0) return;
    hipMemsetAsync((char*)d_ws + WS_CTL, 0, CTL_ZERO_BYTES, stream);
    Args a{};
    for (int i = 0; i < 21; ++i) a.in[i] = (const float*)d_in[i];
    a.out = (float*)d_out; a.ws = (unsigned char*)d_ws;
#if MK_COOP
    a.ph_lo = 0; a.ph_hi = NPHASE;
    void* kargs[] = {&a};
    hipError_t e = hipLaunchCooperativeKernel((const void*)mega<true>, dim3(grid), dim3(512), kargs, LDS_BYTES, stream);
    if (e != hipSuccess) fprintf(stderr, "cooperative launch failed: %s (grid %d)\n", hipGetErrorString(e), grid);
#else
    for (int p = 0; p < NPHASE; ++p) { a.ph_lo = p; a.ph_hi = p + 1; hipLaunchKernelGGL(mega<false>, dim3(grid), dim3(512), LDS_BYTES, stream, a); }
#endif
}
```

```cpp
#include <hip/hip_runtime.h>
#include <hip/hip_cooperative_groups.h>
#include <cstdio>
#include <cstdint>
namespace cg = cooperative_groups;

#ifndef MK_COOP
#define MK_COOP 1
#endif

#define LAS __attribute__((address_space(3)))
typedef unsigned short bf16_t;
typedef short bf16x8 __attribute__((ext_vector_type(8)));
typedef float f32x4 __attribute__((ext_vector_type(4)));
typedef float f32x2 __attribute__((ext_vector_type(2)));
typedef unsigned u32x4 __attribute__((ext_vector_type(4)));
typedef unsigned u32x2 __attribute__((ext_vector_type(2)));

constexpr int NB = 8, SEQ = 4096, DM = 1024, T = NB * SEQ;
constexpr int NH = 8, DH = 128, LBLK = 256, NBLK = SEQ / LBLK;
constexpr int NE = 32, TOPK = 4, FF = 1024;
constexpr int INCOLS = 7 * DM;
constexpr int RMAX = T * TOPK + NE * 256;
constexpr float LN_EPS = 1e-5f;
constexpr float ALPHA = 1.189207115002721f;
constexpr float QSCALE = 0.08838834764831845f * 1.4426950408889634f;

constexpr size_t MiB = 1u << 20, U64 = 64 * MiB;
constexpr size_t WS_CTL = 0, CTL_ZERO_BYTES = 1 * MiB;
constexpr int CW_ECNT = 64;
constexpr int CW_LCNT = 1024;
constexpr int CW_BAR = 4096;
constexpr size_t WS_KMEAN = 1 * MiB;
constexpr size_t WS_GVST = 2 * MiB;
constexpr size_t WS_ZST = 6 * MiB;
constexpr size_t WS_SEL = 10 * MiB;
constexpr size_t WS_TKE = 11 * MiB;
constexpr size_t WS_TKW = 11 * MiB + 512 * 1024;
constexpr size_t WS_TKP = 12 * MiB;
constexpr size_t WS_ROWOF = 12 * MiB + 512 * 1024;
constexpr size_t WS_ROWTOK = 13 * MiB;
constexpr size_t WS_ROWW = 14 * MiB;
constexpr size_t WS_TILE = 15 * MiB;
constexpr size_t WS_LISTS = 16 * MiB;
constexpr size_t WS_LSE = 32 * MiB;
constexpr size_t WS_RT = 16 * MiB;
constexpr size_t WS_RW = 20 * MiB;
constexpr int LDS_MOE = 131072 + 1024;
constexpr size_t WS_WIN = 40 * MiB;
constexpr size_t WS_WAB = 54 * MiB;
constexpr size_t WS_WOUT = 58 * MiB;
constexpr size_t WS_WDN = 60 * MiB;
constexpr size_t WS_WUP = 124 * MiB;
constexpr size_t WS_H0 = 4 * U64;
constexpr size_t WS_YAB = 5 * U64;
constexpr size_t WS_GV = 7 * U64;
constexpr size_t WS_Q = 8 * U64, WS_K = 9 * U64, WS_V = 10 * U64, WS_SA = 11 * U64, WS_SB = 12 * U64;
constexpr size_t WS_OP = 13 * U64;
constexpr size_t WS_MG = WS_GV;
constexpr size_t WS_Z = 14 * U64;
constexpr size_t WS_H1 = WS_H0;
constexpr size_t WS_XG = 5 * U64;
constexpr size_t WS_H1F8 = 12 * U64;
constexpr size_t WS_ACT = 9 * U64 + 16 * MiB;
constexpr size_t WS_YS = WS_XG;
constexpr size_t WS_H0F8 = 13 * U64;
constexpr size_t WS_WIN8 = 192 * MiB;
constexpr int PN8_LO = 8, PN8_HI = 28;
constexpr size_t WS_END = 16 * U64;
static_assert(WS_XG + (size_t)RMAX * 2048 <= WS_ACT && WS_ACT + (size_t)RMAX * 2048 <= WS_Z, "ws map");

constexpr int LDS_BYTES = 163840;
constexpr int LDS_MISC = 131072;
constexpr int NPHASE = 13;

__device__ __forceinline__ float bf2f(bf16_t v) { return __uint_as_float((unsigned)v << 16); }
__device__ __forceinline__ float bflo(unsigned u) { return __uint_as_float(u << 16); }
__device__ __forceinline__ float bfhi(unsigned u) { return __uint_as_float(u & 0xffff0000u); }
__device__ __forceinline__ unsigned f2bf(float f) { unsigned u = __builtin_bit_cast(unsigned, f); return (u + 0x7fffu + ((u >> 16) & 1u)) >> 16; }
__device__ __forceinline__ unsigned pk2(float lo, float hi) { return f2bf(lo) | (f2bf(hi) << 16); }
typedef __bf16 bf16x2_t __attribute__((ext_vector_type(2)));
__device__ __forceinline__ unsigned cvt_pk_bf16(float lo, float hi) { f32x2 v = {lo, hi}; bf16x2_t b = __builtin_convertvector(v, bf16x2_t); return __builtin_bit_cast(unsigned, b); }
__device__ __forceinline__ int lane_id_asm() { int l; asm volatile("v_mbcnt_lo_u32_b32 %0, -1, 0\n\tv_mbcnt_hi_u32_b32 %0, -1, %0" : "=v"(l)); return l; }
__device__ __forceinline__ float wave_sum(float v) {
#pragma unroll
    for (int o = 1; o < 64; o <<= 1) v += __shfl_xor(v, o);
    return v;
}
__device__ __forceinline__ float wave_max(float v) {
#pragma unroll
    for (int o = 1; o < 64; o <<= 1) v = fmaxf(v, __shfl_xor(v, o));
    return v;
}
__device__ __forceinline__ f32x2 gelu_pk(f32x2 v) {
    const f32x2 av = __builtin_elementwise_abs(v), d = av * 0.2316418882f + 1.0f;
    f32x2 t; t.x = __builtin_amdgcn_rcpf(d.x); t.y = __builtin_amdgcn_rcpf(d.y);
    f32x2 q = t * 0.5307027145f + (-0.7265760135f); q = q * t + 0.7107068705f; q = q * t + (-0.142248368f); q = q * t + 0.127414796f; q = q * t;
    const f32x2 s = (v * v) * (-0.72134752044f);
    f32x2 e; e.x = __builtin_amdgcn_exp2f(s.x); e.y = __builtin_amdgcn_exp2f(s.y);
    const f32x2 m = v * (q * e), r = v - m;
    f32x2 o; o.x = v.x < 0.f ? m.x : r.x; o.y = v.y < 0.f ? m.y : r.y; return o;
}
typedef float f32x2v __attribute__((ext_vector_type(2)));
template <bool HI> __device__ __forceinline__ unsigned f8x2_to_bf16x2(unsigned w) { const f32x2v f = __builtin_amdgcn_cvt_pk_f32_fp8((int)w, HI); return cvt_pk_bf16(f.x, f.y); }
__device__ __forceinline__ u32x4 f8x8_to_bf16x8(unsigned lo, unsigned hi) { return (u32x4){f8x2_to_bf16x2<false>(lo), f8x2_to_bf16x2<true>(lo), f8x2_to_bf16x2<false>(hi), f8x2_to_bf16x2<true>(hi)}; }
__device__ __forceinline__ unsigned pack_fp8x4(float a, float b, float c, float d) { unsigned w = 0u; w = __builtin_amdgcn_cvt_pk_fp8_f32(a, b, w, false); w = __builtin_amdgcn_cvt_pk_fp8_f32(c, d, w, true); return w; }
__device__ __forceinline__ float sigmoidf_(float x) { return __builtin_amdgcn_rcpf(1.0f + __builtin_amdgcn_exp2f(-1.4426950408889634f * x)); }

namespace pg8 {
constexpr int BM = 256, BK = 64, HALF = 128, HTB = HALF * BK * 2, STAGE_BYTES = 8 * HTB, NXCD = 8, WGM = 8;
__host__ __device__ __forceinline__ int lds_byte(int r, int c) { const int st = (r >> 4) * 2 + (c >> 5), rr = r & 15, cc = c & 31, ob = rr * 64 + cc * 2; return st * 1024 + (ob ^ (((ob >> 9) & 1) << 5)); }
__host__ __device__ __forceinline__ void stage_rc(int b, int& R, int& C) { const int st = b / 1024, sb = b % 1024, swz = sb ^ (((sb >> 9) & 1) << 5); R = (st >> 1) * 16 + swz / 64; C = (st & 1) * 32 + (swz % 64) / 2; }
__host__ __device__ __forceinline__ int perm32(int rho) { const int n = rho >> 4, i = rho & 15; return 8 * (i >> 2) + 4 * n + (i & 3); }

struct Unit { int pm, pn, bt, rbase; };
struct Gemm { const bf16_t* A; const bf16_t* Bt; int K, lda, ldb; const int* rowidx; };

struct StaticOrder {
    int nM, nN, nwg, G, c, pbase, psplit, pjump;
    __device__ void init(int M, int N, int G_, int c_, int pbase_ = 0, int psplit_ = 1 << 20, int pjump_ = 0) { nM = M / BM; nN = N / BM; nwg = nM * nN; G = G_; c = c_; pbase = pbase_; psplit = psplit_; pjump = pjump_; }
    __device__ bool next(int i, Unit& u) const {
        const long L = (long)i * G + c; if (L >= nwg) return false;
        int wgid = (int)L; { const int q = nwg / NXCD, r = nwg % NXCD, xcd = wgid % NXCD, off = wgid / NXCD; wgid = (xcd < r ? xcd * (q + 1) : r * (q + 1) + (xcd - r) * q) + off; }
        const int nig = WGM * nN, gid = wgid / nig, fm = gid * WGM, gsz = (nM - fm) < WGM ? (nM - fm) : WGM;
        u.pm = fm + ((wgid % nig) % gsz); const int p = (wgid % nig) / gsz; u.pn = pbase + (p < psplit ? p : p + pjump); u.bt = u.pn; u.rbase = u.pm * BM; return true;
    }
};
struct MoeOrder {
    int nM, nN, nwg, G, c; const LAS int* tab;
    __device__ void init(const LAS int* tiletab, int nN_, int G_, int c_) { nM = tiletab[0]; tab = tiletab; nN = nN_; nwg = nM * nN; G = G_; c = c_; }
    __device__ bool next(int i, Unit& u) const {
        const long L = (long)i * G + c; if (L >= nwg) return false;
        int wgid = (int)L; { const int q = nwg / NXCD, r = nwg % NXCD, xcd = wgid % NXCD, off = wgid / NXCD; wgid = (xcd < r ? xcd * (q + 1) : r * (q + 1) + (xcd - r) * q) + off; }
        const int nig = WGM * nN, gid = wgid / nig, fm = gid * WGM, gsz = (nM - fm) < WGM ? (nM - fm) : WGM;
        u.pm = fm + ((wgid % nig) % gsz); u.pn = (wgid % nig) / gsz; { const int e = tab[128 + 2 * u.pm], tl = tab[129 + 2 * u.pm]; u.bt = e * nN + u.pn; u.rbase = e * T + tl * BM; } return true;
    }
};

typedef int v4i_t __attribute__((ext_vector_type(4)));
typedef int v8i_t __attribute__((ext_vector_type(8)));
template <class Epi, class Sched, bool ALIGN_EPI, bool FP8 = false, bool GATHER = false>
__device__ __forceinline__ void gemm_phase(LAS unsigned char* lds, const Gemm g, const Sched& S, const Epi& E, const int wid) {
    const int lane = lane_id_asm(), tid = wid * 64 + lane;
    const int wr = wid >> 2, wc = wid & 3, fr = lane & 15, fq = lane >> 4;
    const int nt = g.K / BK;
    unsigned voffA[2], voffB[2]; int gR[2];
#pragma unroll
    for (int i = 0; i < 2; ++i) { int R, C; stage_rc(tid * 16 + i * 8192, R, C); const int Rb = Epi::PERM ? ((R & ~31) + perm32(R & 31)) : R;
        voffA[i] = GATHER ? (unsigned)C * 2u : (unsigned)(R * g.lda + C) * 2u; voffB[i] = (unsigned)(Rb * g.ldb + C) * 2u; gR[i] = R; }
    const size_t kstep = (size_t)(BK * 2);
    const size_t hstepA = GATHER ? 0 : (size_t)HALF * g.lda * 2, hstepB = (size_t)HALF * g.ldb * 2;
    const size_t tstepA = 2 * hstepA, tstepB = 2 * hstepB;
    const unsigned ldsw = (unsigned)wid * 1024u;
    const int aoff = lds_byte(wr * 64 + fr, fq * 8), boff = lds_byte(wc * 32 + fr, fq * 8);
#define PG8_SA(b, h) (((b) * 2 + (h)) * HTB)
#define PG8_SB(b, h) ((4 + (b) * 2 + (h)) * HTB)
#define PG8_STAGE(bufoff, gbase, voff) do { _Pragma("unroll") for (int _i = 0; _i < 2; ++_i) \
        __builtin_amdgcn_global_load_lds((const unsigned*)((const char*)(gbase) + (voff)[_i]), (LAS unsigned*)(lds + (bufoff) + ldsw + _i * 8192), 16, 0, 0); } while (0)
#define PG8_LD8(p) __builtin_shufflevector(*(const LAS v4i_t*)(p), *(const LAS v4i_t*)((p) + 1024), 0, 1, 2, 3, 4, 5, 6, 7)
#define PG8_LDA(dst, b, h) do { _Pragma("unroll") for (int m = 0; m < 4; ++m) { if constexpr (FP8) dst##8[m] = PG8_LD8(lds + PG8_SA(b, h) + aoff + m * 2048); \
        else { _Pragma("unroll") for (int k = 0; k < 2; ++k) dst[m][k] = *(const LAS bf16x8*)(lds + PG8_SA(b, h) + aoff + m * 2048 + k * 1024); } } } while (0)
#define PG8_LDB(dst, b, h) do { _Pragma("unroll") for (int n = 0; n < 2; ++n) { if constexpr (FP8) dst##8[n] = PG8_LD8(lds + PG8_SB(b, h) + boff + n * 2048); \
        else { _Pragma("unroll") for (int k = 0; k < 2; ++k) dst[n][k] = *(const LAS bf16x8*)(lds + PG8_SB(b, h) + boff + n * 2048 + k * 1024); } } } while (0)
#define PG8_MMA(ai, bj, At, Bt) do { __builtin_amdgcn_s_setprio(1); _Pragma("unroll") for (int m = 0; m < 4; ++m) _Pragma("unroll") for (int n = 0; n < 2; ++n) { \
        if constexpr (FP8) { asm volatile("s_nop 1\n\tv_mfma_scale_f32_16x16x128_f8f6f4 %0, %1, %2, %0, %3, %3 op_sel_hi:[0,0,0]" : "+v"(acc[ai][bj][m][n]) : "v"(Bt##8[n]), "v"(At##8[m]), "v"(scl8)); } \
        else { _Pragma("unroll") for (int k = 0; k < 2; ++k) acc[ai][bj][m][n] = __builtin_amdgcn_mfma_f32_16x16x32_bf16(Bt[n][k], At[m][k], acc[ai][bj][m][n], 0, 0, 0); } } \
        __builtin_amdgcn_s_setprio(0); } while (0)
#define PG8_WAIT_V(n) asm volatile("s_waitcnt vmcnt(" #n ")" ::: "memory")
#define PG8_WAIT_L(n) asm volatile("s_waitcnt lgkmcnt(" #n ")" ::: "memory")
#define PG8_BAR __builtin_amdgcn_s_barrier()
#define PG8_SCHED __builtin_amdgcn_sched_barrier(0)
    Unit cur, nxt; int ui = 0;
    if (!S.next(0, cur)) return;
    unsigned va0[2], va1[2], vn0[2], vn1[2];
#define PG8_GIDX(dst0, dst1, u) do { if constexpr (GATHER) { _Pragma("unroll") for (int _i = 0; _i < 2; ++_i) { \
        dst0[_i] = min((unsigned)g.rowidx[(u).rbase + gR[_i]], (unsigned)(T - 1)) * (unsigned)(g.lda * 2) + voffA[_i]; dst1[_i] = min((unsigned)g.rowidx[(u).rbase + HALF + gR[_i]], (unsigned)(T - 1)) * (unsigned)(g.lda * 2) + voffA[_i]; } } \
        else { _Pragma("unroll") for (int _i = 0; _i < 2; ++_i) { dst0[_i] = voffA[_i]; dst1[_i] = voffA[_i]; } } } while (0)
    PG8_GIDX(va0, va1, cur);
    f32x4 acc[2][2][4][2];
#pragma unroll
    for (int a = 0; a < 2; ++a)
#pragma unroll
        for (int b = 0; b < 2; ++b)
#pragma unroll
            for (int m = 0; m < 4; ++m)
#pragma unroll
                for (int n = 0; n < 2; ++n) acc[a][b][m][n] = (f32x4){0.f, 0.f, 0.f, 0.f};
    bf16x8 At[4][2], B0[2][2], B1[2][2]; v8i_t At8[4], B08[2], B18[2];
    int scl8 = 0x7f7f7f7f; asm volatile("" : "+v"(scl8));
    const char* cA = (const char*)g.A + (GATHER ? 0 : (size_t)cur.pm * tstepA); const char* cB = (const char*)g.Bt + (size_t)cur.bt * tstepB;
    PG8_STAGE(PG8_SB(0, 0), cB, voffB); PG8_STAGE(PG8_SB(0, 1), cB + hstepB, voffB); PG8_STAGE(PG8_SA(0, 0), cA, va0); PG8_STAGE(PG8_SA(0, 1), cA + hstepA, va1);
    if (wr == 1) PG8_BAR;
    PG8_WAIT_V(2); PG8_BAR;
    PG8_STAGE(PG8_SB(1, 0), cB + kstep, voffB); PG8_STAGE(PG8_SA(1, 0), cA + kstep, va0); PG8_STAGE(PG8_SB(1, 1), cB + hstepB + kstep, voffB);
    PG8_WAIT_V(6); PG8_BAR;
    for (;;) {
        const bool has_next = S.next(ui + 1, nxt);
        const char* nA = (has_next && !GATHER) ? (const char*)g.A + (size_t)nxt.pm * tstepA : cA; const char* nB = has_next ? (const char*)g.Bt + (size_t)nxt.bt * tstepB : cB;
        if (has_next) PG8_GIDX(vn0, vn1, nxt); else { _Pragma("unroll") for (int _i = 0; _i < 2; ++_i) { vn0[_i] = va0[_i]; vn1[_i] = va1[_i]; } }
#pragma unroll 1
        for (int t = 0; t < nt; t += 2) {
            const bool last = (t == nt - 2);
            const char* a1 = cA + (size_t)(t + 1) * kstep;
            const char* a2 = last ? nA : cA + (size_t)(t + 2) * kstep; const char* b2 = last ? nB : cB + (size_t)(t + 2) * kstep;
            const char* a3 = a2 + kstep; const char* b3 = b2 + kstep;
            if constexpr (Epi::MID_T > 0) { if (t == Epi::MID_T) E.mid(acc, cur, wr, wc, fr, fq); }
            unsigned vs0[2], vs1[2];
#pragma unroll
            for (int _i = 0; _i < 2; ++_i) { vs0[_i] = last ? vn0[_i] : va0[_i]; vs1[_i] = last ? vn1[_i] : va1[_i]; }
            PG8_LDB(B0, 0, 0); PG8_LDB(B1, 0, 1); PG8_SCHED; PG8_LDA(At, 0, 0); PG8_STAGE(PG8_SA(1, 1), a1 + hstepA, va1);
            PG8_WAIT_V(8); PG8_WAIT_L(0); PG8_BAR; PG8_MMA(0, 0, At, B0); PG8_MMA(0, 1, At, B1); PG8_BAR; PG8_SCHED;
            PG8_LDA(At, 0, 1); PG8_STAGE(PG8_SB(0, 0), b2, voffB); PG8_STAGE(PG8_SB(0, 1), b2 + hstepB, voffB); PG8_STAGE(PG8_SA(0, 0), a2, vs0);
            PG8_WAIT_V(8); PG8_WAIT_L(0); PG8_BAR; PG8_MMA(1, 0, At, B0); PG8_MMA(1, 1, At, B1); PG8_BAR; PG8_SCHED;
            PG8_LDB(B0, 1, 0); PG8_LDB(B1, 1, 1); PG8_SCHED; PG8_LDA(At, 1, 0); PG8_STAGE(PG8_SA(0, 1), a2 + hstepA, vs1);
            PG8_WAIT_V(8); PG8_WAIT_L(0); PG8_BAR; PG8_MMA(0, 0, At, B0); PG8_MMA(0, 1, At, B1); PG8_BAR; PG8_SCHED;
            PG8_LDA(At, 1, 1); PG8_STAGE(PG8_SB(1, 0), b3, voffB); PG8_STAGE(PG8_SB(1, 1), b3 + hstepB, voffB); PG8_STAGE(PG8_SA(1, 0), a3, vs0);
            PG8_WAIT_V(8); PG8_WAIT_L(0); PG8_BAR; PG8_MMA(1, 0, At, B0); PG8_MMA(1, 1, At, B1); PG8_BAR; PG8_SCHED;
        }
        if constexpr (ALIGN_EPI) { if (wr == 0) PG8_BAR; }
        if constexpr (FP8) {
#pragma unroll
            for (int a = 0; a < 2; ++a)
#pragma unroll
                for (int b = 0; b < 2; ++b)
                    asm volatile("s_nop 15\n\ts_nop 7" : "+v"(acc[a][b][0][0]), "+v"(acc[a][b][0][1]), "+v"(acc[a][b][1][0]), "+v"(acc[a][b][1][1]), "+v"(acc[a][b][2][0]), "+v"(acc[a][b][2][1]), "+v"(acc[a][b][3][0]), "+v"(acc[a][b][3][1]));
        }
        E(acc, cur, wr, wc, fr, fq);
        if (!has_next) break;
#pragma unroll
        for (int a = 0; a < 2; ++a)
#pragma unroll
            for (int b = 0; b < 2; ++b)
#pragma unroll
                for (int m = 0; m < 4; ++m)
#pragma unroll
                    for (int n = 0; n < 2; ++n) acc[a][b][m][n] = (f32x4){0.f, 0.f, 0.f, 0.f};
        cur = nxt; cA = nA; cB = nB; ++ui;
#pragma unroll
        for (int _i = 0; _i < 2; ++_i) { va0[_i] = vn0[_i]; va1[_i] = vn1[_i]; }
        if constexpr (ALIGN_EPI) { if (wr == 1) PG8_BAR; }
    }
    PG8_WAIT_V(0);
    if constexpr (!ALIGN_EPI) { if (wr == 0) PG8_BAR; }
    PG8_BAR;
#undef PG8_SA
#undef PG8_SB
#undef PG8_STAGE
#undef PG8_GIDX
#undef PG8_LDA
#undef PG8_LDB
#undef PG8_MMA
#undef PG8_LD8
#undef PG8_WAIT_V
#undef PG8_WAIT_L
#undef PG8_BAR
#undef PG8_SCHED
}

typedef f32x4 Acc[2][2][4][2];

__device__ __forceinline__ u32x4 pair16(u32x2 x, u32x2 y) {
    const auto r0 = __builtin_amdgcn_permlane16_swap(x.x, y.x, false, false);
    const auto r1 = __builtin_amdgcn_permlane16_swap(x.y, y.y, false, false);
    return (u32x4){r0[0], r1[0], r0[1], r1[1]};
}
struct Epi1 {
    static constexpr bool PERM = true; static constexpr int MID_T = 0;
    bf16_t *yab, *gv; unsigned char *q, *k, *v; bf16_t *sa, *sb; float* gvst; float* kmp; float sc, pad_;
    template <int MODE  >
    __device__ __forceinline__ void run(const Acc& acc, const Unit& u, int wr, int wc, int fr, int fq, bf16_t* base, int ld) const {
        const int row0 = u.pm * BM + wr * 64 + fr, col0 = (u.pn & 3) * 256 + wc * 32 + 8 * fq;
        const int colp = (u.pn & 3) * 256 + wc * 32 + 8 * (fq & ~1);
        f32x4 csA0 = {0.f, 0.f, 0.f, 0.f}, csB0 = csA0, csA1 = csA0, csB1 = csA0;
#pragma unroll
        for (int ai = 0; ai < 2; ++ai)
#pragma unroll
            for (int mp = 0; mp < 2; ++mp) {
                u32x2 pc[2][2];
#pragma unroll
                for (int k = 0; k < 2; ++k) {
                    const int m = 2 * mp + k;
                    const int row = row0 + ai * HALF + m * 16; bf16_t* rowp = base + (size_t)row * ld + col0;
                    float s1 = 0.f, s2 = 0.f;
#pragma unroll
                    for (int bj = 0; bj < 2; ++bj) {
                        f32x4 v0 = acc[ai][bj][m][0], v1 = acc[ai][bj][m][1];
                        if (MODE == 2 || MODE == 3 || MODE == 5) {
                            const float f = (MODE == 2) ? sc * QSCALE : sc; v0 = v0 * f; v1 = v1 * f;
                            if (MODE == 5) { if (bj == 0) { csA0 = csA0 + v0; csB0 = csB0 + v1; } else { csA1 = csA1 + v0; csB1 = csB1 + v1; } }
                            pc[bj][k] = (u32x2){pack_fp8x4(v0[0], v0[1], v0[2], v0[3]), pack_fp8x4(v1[0], v1[1], v1[2], v1[3])};
                            continue;
                        }
                        if (MODE == 0 || MODE == 1) {
                            f32x2 a = gelu_pk((f32x2){v0[0], v0[1]}), b = gelu_pk((f32x2){v0[2], v0[3]}), c = gelu_pk((f32x2){v1[0], v1[1]}), d = gelu_pk((f32x2){v1[2], v1[3]});
                            v0 = (f32x4){a.x, a.y, b.x, b.y}; v1 = (f32x4){c.x, c.y, d.x, d.y};
                        } else if (MODE == 4) {
                            { const float cs_ = -1.4426950408889634f * sc; const f32x4 t0 = v0 * cs_, t1 = v1 * cs_; f32x4 e0, e1;
#pragma unroll
                              for (int j = 0; j < 4; ++j) { e0[j] = __builtin_amdgcn_exp2f(t0[j]); e1[j] = __builtin_amdgcn_exp2f(t1[j]); }
                              e0 = e0 + 1.0f; e1 = e1 + 1.0f;
#pragma unroll
                              for (int j = 0; j < 4; ++j) { v0[j] = __builtin_amdgcn_rcpf(e0[j]); v1[j] = __builtin_amdgcn_rcpf(e1[j]); } }
                            pc[bj][k] = (u32x2){pack_fp8x4(v0[0], v0[1], v0[2], v0[3]), pack_fp8x4(v1[0], v1[1], v1[2], v1[3])};
                            continue;
                        }
                        if (MODE == 1) {
                            s1 += (v0[0] + v0[1]) + (v0[2] + v0[3]) + (v1[0] + v1[1]) + (v1[2] + v1[3]);
                            s2 += (v0[0] * v0[0] + v0[1] * v0[1]) + (v0[2] * v0[2] + v0[3] * v0[3]) + (v1[0] * v1[0] + v1[1] * v1[1]) + (v1[2] * v1[2] + v1[3] * v1[3]);
                            pc[bj][k] = (u32x2){pack_fp8x4(v0[0], v0[1], v0[2], v0[3]), pack_fp8x4(v1[0], v1[1], v1[2], v1[3])};
                            continue;
                        }
                        u32x4 w; w.x = cvt_pk_bf16(v0[0], v0[1]); w.y = cvt_pk_bf16(v0[2], v0[3]); w.z = cvt_pk_bf16(v1[0], v1[1]); w.w = cvt_pk_bf16(v1[2], v1[3]);
                        *(u32x4*)(rowp + bj * HALF) = w;
                    }
                    if (MODE == 1) {
                        s1 += __shfl_xor(s1, 16); s1 += __shfl_xor(s1, 32); s2 += __shfl_xor(s2, 16); s2 += __shfl_xor(s2, 32);
                        if (fq == 0) *(f32x2*)(gvst + ((size_t)row * 16 + (u.pn & 3) * 4 + wc) * 2) = (f32x2){s1, s2};
                    }
                }
                if (MODE != 0) {
                    const int rowst = row0 + ai * HALF + (2 * mp + (fq & 1)) * 16;
#pragma unroll
                    for (int bj = 0; bj < 2; ++bj) *(u32x4*)((unsigned char*)base + (size_t)rowst * 1024 + colp + bj * HALF) = pair16(pc[bj][0], pc[bj][1]);
                }
            }
        if (MODE == 5) {
#define KM_RED(v) do { _Pragma("unroll") for (int j_ = 0; j_ < 4; ++j_) { float x = v[j_]; x += __shfl_xor(x, 1); x += __shfl_xor(x, 2); x += __shfl_xor(x, 4); x += __shfl_xor(x, 8); v[j_] = x; } } while (0)
            KM_RED(csA0); KM_RED(csB0); KM_RED(csA1); KM_RED(csB1);
#undef KM_RED
            if (fr == 0) {
                float* kp = kmp + ((size_t)(u.pm * 2 + wr) * DM) + col0;
                *(f32x4*)kp = csA0; *(f32x4*)(kp + 4) = csB0; *(f32x4*)(kp + HALF) = csA1; *(f32x4*)(kp + HALF + 4) = csB1;
            }
        }
    }
    __device__ __forceinline__ void operator()(const Acc& acc, const Unit& u, int wr, int wc, int fr, int fq) const {
        const int region = u.pn >> 2;
        if (region == 0) run<0>(acc, u, wr, wc, fr, fq, yab, 2048);
        else if (region == 1) run<1>(acc, u, wr, wc, fr, fq, gv, 1024);
        else if (region == 2) run<2>(acc, u, wr, wc, fr, fq, (bf16_t*)q, 1024);
        else if (region == 3) run<5>(acc, u, wr, wc, fr, fq, (bf16_t*)k, 1024);
        else if (region == 4) run<3>(acc, u, wr, wc, fr, fq, (bf16_t*)v, 1024);
        else if (region == 5) run<4>(acc, u, wr, wc, fr, fq, sa, 1024);
        else run<4>(acc, u, wr, wc, fr, fq, sb, 1024);
    }
    __device__ __forceinline__ void mid(Acc&, const Unit&, int, int, int, int) const {}
};

struct Epi2 {
    static constexpr bool PERM = true; static constexpr int MID_T = 16;
    const unsigned char *sa, *sb; bf16_t* mg;
    __device__ __forceinline__ void mid(Acc& acc, const Unit& u, int wr, int wc, int fr, int fq) const {
        int row0 = u.pm * BM + wr * 64 + fr, col0 = u.pn * BM + wc * 32 + 8 * fq;
        asm volatile("" : "+v"(row0), "+v"(col0));
#pragma unroll
        for (int ai = 0; ai < 2; ++ai)
#pragma unroll
            for (int m = 0; m < 4; ++m) {
                const size_t off = (size_t)(row0 + ai * HALF + m * 16) * DM + col0;
#pragma unroll
                for (int bj = 0; bj < 2; ++bj) {
                    const u32x2 a = *(const u32x2*)(sa + off + bj * HALF), b = *(const u32x2*)(sb + off + bj * HALF);
                    const f32x2v a0 = __builtin_amdgcn_cvt_pk_f32_fp8((int)a.x, false), a1 = __builtin_amdgcn_cvt_pk_f32_fp8((int)a.x, true), a2 = __builtin_amdgcn_cvt_pk_f32_fp8((int)a.y, false), a3 = __builtin_amdgcn_cvt_pk_f32_fp8((int)a.y, true);
                    const f32x2v b0 = __builtin_amdgcn_cvt_pk_f32_fp8((int)b.x, false), b1 = __builtin_amdgcn_cvt_pk_f32_fp8((int)b.x, true), b2 = __builtin_amdgcn_cvt_pk_f32_fp8((int)b.y, false), b3 = __builtin_amdgcn_cvt_pk_f32_fp8((int)b.y, true);
                    f32x4 r0, r1;
#define RQ(x, y) ((x) * __builtin_amdgcn_rcpf(y))
                    r0[0] = RQ(a0.x, b0.x); r0[1] = RQ(a0.y, b0.y); r0[2] = RQ(a1.x, b1.x); r0[3] = RQ(a1.y, b1.y);
                    r1[0] = RQ(a2.x, b2.x); r1[1] = RQ(a2.y, b2.y); r1[2] = RQ(a3.x, b3.x); r1[3] = RQ(a3.y, b3.y);
#undef RQ
                    acc[ai][bj][m][0] = acc[ai][bj][m][0] * r0; acc[ai][bj][m][1] = acc[ai][bj][m][1] * r1;
                }
                asm volatile("" : "+v"(acc[ai][0][m][0]), "+v"(acc[ai][0][m][1]), "+v"(acc[ai][1][m][0]), "+v"(acc[ai][1][m][1]));
                asm volatile("" ::: "memory");
            }
    }
    __device__ __forceinline__ void operator()(const Acc& acc, const Unit& u, int wr, int wc, int fr, int fq) const {
        const int row0 = u.pm * BM + wr * 64 + fr, col0 = u.pn * BM + wc * 32 + 8 * fq;
#pragma unroll
        for (int ai = 0; ai < 2; ++ai)
#pragma unroll
            for (int m = 0; m < 4; ++m) {
                const size_t off = (size_t)(row0 + ai * HALF + m * 16) * DM + col0;
#pragma unroll
                for (int bj = 0; bj < 2; ++bj) {
                    const u32x2 b = *(const u32x2*)(sb + off + bj * HALF);
                    const f32x2v b0 = __builtin_amdgcn_cvt_pk_f32_fp8((int)b.x, false), b1 = __builtin_amdgcn_cvt_pk_f32_fp8((int)b.x, true), b2 = __builtin_amdgcn_cvt_pk_f32_fp8((int)b.y, false), b3 = __builtin_amdgcn_cvt_pk_f32_fp8((int)b.y, true);
                    const f32x4 v0 = acc[ai][bj][m][0], v1 = acc[ai][bj][m][1];
                    u32x4 w; w.x = cvt_pk_bf16(v0[0] * b0.x, v0[1] * b0.y); w.y = cvt_pk_bf16(v0[2] * b1.x, v0[3] * b1.y);
                    w.z = cvt_pk_bf16(v1[0] * b2.x, v1[1] * b2.y); w.w = cvt_pk_bf16(v1[2] * b3.x, v1[3] * b3.y);
                    *(u32x4*)(mg + off + bj * HALF) = w;
                }
            }
    }
};

struct Epi3 {
    static constexpr bool PERM = true; static constexpr int MID_T = 0;
    const bf16_t* h0; bf16_t* z; float* zst;
    __device__ __forceinline__ void mid(Acc&, const Unit&, int, int, int, int) const {}
    __device__ __forceinline__ void operator()(const Acc& acc, const Unit& u, int wr, int wc, int fr, int fq) const {
        const int row0 = u.pm * BM + wr * 64 + fr, col0 = u.pn * BM + wc * 32 + 8 * fq;
#pragma unroll
        for (int ai = 0; ai < 2; ++ai)
#pragma unroll
            for (int m = 0; m < 4; ++m) {
                const int row = row0 + ai * HALF + m * 16; const size_t off = (size_t)row * DM + col0;
                float s1 = 0.f, s2 = 0.f;
#pragma unroll
                for (int bj = 0; bj < 2; ++bj) {
                    const u32x4 hb = *(const u32x4*)(h0 + off + bj * HALF);
                    f32x4 v0 = acc[ai][bj][m][0], v1 = acc[ai][bj][m][1];
                    v0[0] += ALPHA * bflo(hb.x); v0[1] += ALPHA * bfhi(hb.x); v0[2] += ALPHA * bflo(hb.y); v0[3] += ALPHA * bfhi(hb.y);
                    v1[0] += ALPHA * bflo(hb.z); v1[1] += ALPHA * bfhi(hb.z); v1[2] += ALPHA * bflo(hb.w); v1[3] += ALPHA * bfhi(hb.w);
                    s1 += ((v0[0] + v0[1]) + (v0[2] + v0[3])) + ((v1[0] + v1[1]) + (v1[2] + v1[3]));
                    s2 += ((v0[0] * v0[0] + v0[1] * v0[1]) + (v0[2] * v0[2] + v0[3] * v0[3])) + ((v1[0] * v1[0] + v1[1] * v1[1]) + (v1[2] * v1[2] + v1[3] * v1[3]));
                    *(u32x4*)(z + off + bj * HALF) = (u32x4){cvt_pk_bf16(v0[0], v0[1]), cvt_pk_bf16(v0[2], v0[3]), cvt_pk_bf16(v1[0], v1[1]), cvt_pk_bf16(v1[2], v1[3])};
                }
                s1 += __shfl_xor(s1, 16); s1 += __shfl_xor(s1, 32); s2 += __shfl_xor(s2, 16); s2 += __shfl_xor(s2, 32);
                if (fq == 0) *(f32x2*)(zst + ((size_t)row * 16 + u.pn * 4 + wc) * 2) = (f32x2){s1, s2};
            }
    }
};

struct Epi4 {
    static constexpr bool PERM = true; static constexpr int MID_T = 0;
    const float* b_up; unsigned char* act;
    __device__ __forceinline__ void mid(Acc&, const Unit&, int, int, int, int) const {}
    __device__ __forceinline__ void operator()(const Acc& acc, const Unit& u, int wr, int wc, int fr, int fq) const {
        const int e = u.bt >> 3;
        const int row0 = u.pm * BM + wr * 64 + fr, c0 = u.pn * HALF + wc * 32 + 8 * fq;
        const float* bg = b_up + (size_t)e * 2 * FF + c0; const float* bu = bg + FF;
        const f32x4 bg0 = *(const f32x4*)bg, bg1 = *(const f32x4*)(bg + 4), bu0 = *(const f32x4*)bu, bu1 = *(const f32x4*)(bu + 4);
        const int cp = u.pn * HALF + wc * 32 + 8 * (fq & ~1);
#pragma unroll
        for (int ai = 0; ai < 2; ++ai)
#pragma unroll
            for (int mp = 0; mp < 2; ++mp) {
                u32x2 pc[2];
#pragma unroll
                for (int k = 0; k < 2; ++k) {
                    const int m = 2 * mp + k;
                    float o[8];
#pragma unroll
                    for (int n = 0; n < 2; ++n)
#pragma unroll
                        for (int jp = 0; jp < 2; ++jp) {
                            const int j = 2 * jp;
                            const f32x2 ag = {acc[ai][0][m][n][j], acc[ai][0][m][n][j + 1]}, au = {acc[ai][1][m][n][j], acc[ai][1][m][n][j + 1]};
                            const f32x2 vbg = n ? (f32x2){bg1[j], bg1[j + 1]} : (f32x2){bg0[j], bg0[j + 1]}, vbu = n ? (f32x2){bu1[j], bu1[j + 1]} : (f32x2){bu0[j], bu0[j + 1]};
                            f32x2 gg = ag * 0.03125f + vbg, uu = au * 0.03125f + vbu;
                            gg.x = fminf(gg.x, 7.0f); gg.y = fminf(gg.y, 7.0f);
                            uu.x = __builtin_amdgcn_fmed3f(uu.x, -7.0f, 7.0f); uu.y = __builtin_amdgcn_fmed3f(uu.y, -7.0f, 7.0f);
                            const f32x2 t = gg * (-1.702f * 1.4426950408889634f);
                            f32x2 ex; ex.x = __builtin_amdgcn_exp2f(t.x); ex.y = __builtin_amdgcn_exp2f(t.y);
                            const f32x2 d = ex + 1.0f;
                            f32x2 rc; rc.x = __builtin_amdgcn_rcpf(d.x); rc.y = __builtin_amdgcn_rcpf(d.y);
                            const f32x2 res = (uu + 1.0f) * (gg * rc);
                            o[n * 4 + j] = res.x; o[n * 4 + j + 1] = res.y;
                        }
                    unsigned w0 = 0u, w1 = 0u;
                    w0 = __builtin_amdgcn_cvt_pk_fp8_f32(o[0], o[1], w0, false); w0 = __builtin_amdgcn_cvt_pk_fp8_f32(o[2], o[3], w0, true);
                    w1 = __builtin_amdgcn_cvt_pk_fp8_f32(o[4], o[5], w1, false); w1 = __builtin_amdgcn_cvt_pk_fp8_f32(o[6], o[7], w1, true);
                    pc[k] = (u32x2){w0, w1};
                }
                const int rowst = row0 + ai * HALF + (2 * mp + (fq & 1)) * 16;
                *(u32x4*)(act + (size_t)rowst * FF + cp) = pair16(pc[0], pc[1]);
            }
    }
};

struct Epi5 {
    static constexpr bool PERM = true; static constexpr int MID_T = 0;
    const float* b_down; const float* roww; unsigned char* ys;
    __device__ __forceinline__ void mid(Acc&, const Unit&, int, int, int, int) const {}
    __device__ __forceinline__ void operator()(const Acc& acc, const Unit& u, int wr, int wc, int fr, int fq) const {
        const int e = u.bt >> 2;
        const int row0 = u.pm * BM + wr * 64 + fr, col0 = u.pn * BM + wc * 32 + 8 * fq;
        f32x4 bv[2][2];
#pragma unroll
        for (int bj = 0; bj < 2; ++bj)
#pragma unroll
            for (int n = 0; n < 2; ++n) bv[bj][n] = *(const f32x4*)(b_down + (size_t)e * DM + col0 + bj * HALF + 4 * n);
        float rwv[2][4];
#pragma unroll
        for (int ai = 0; ai < 2; ++ai)
#pragma unroll
            for (int m = 0; m < 4; ++m) rwv[ai][m] = roww[u.rbase + wr * 64 + fr + ai * HALF + m * 16];
        asm volatile("" ::: "memory");
        const int colp = u.pn * BM + wc * 32 + 8 * (fq & ~1);
#pragma unroll
        for (int ai = 0; ai < 2; ++ai)
#pragma unroll
            for (int mp = 0; mp < 2; ++mp) {
                const int rowst = row0 + ai * HALF + (2 * mp + (fq & 1)) * 16;
#pragma unroll
                for (int bj = 0; bj < 2; ++bj) {
                    u32x2 pc[2];
#pragma unroll
                    for (int k = 0; k < 2; ++k) { const int m = 2 * mp + k; const float rw16 = rwv[ai][m] * 16.0f;
                        const f32x4 v0 = (acc[ai][bj][m][0] * 0.015625f + bv[bj][0]) * rw16, v1 = (acc[ai][bj][m][1] * 0.015625f + bv[bj][1]) * rw16;
                        pc[k] = (u32x2){pack_fp8x4(v0[0], v0[1], v0[2], v0[3]), pack_fp8x4(v1[0], v1[1], v1[2], v1[3])}; }
                    *(u32x4*)(ys + (size_t)rowst * DM + colp + bj * HALF) = pair16(pc[0], pc[1]);
                }
            }
    }
};
}

struct Args { const float* in[21]; float* out; unsigned char* ws; int ph_lo, ph_hi; };
enum { I_X = 0, I_LNIN_G, I_LNIN_B, I_WIN, I_GLN_G, I_GLN_B, I_WSP, I_BSP, I_WBA, I_WBB, I_WOUT, I_LNMIX_G, I_LNMIX_B, I_WR, I_BR, I_WUP, I_BUP, I_WDN, I_BDN, I_LNF_G, I_LNF_B };

struct Ctx { const Args* a; unsigned char* ws; LAS unsigned char* lds; unsigned char* ldsg; int tid, lane, wave, G, vcu; };

__device__ __forceinline__ void tr_item(const float* W, int N, int k0, int n0, bf16_t* dst, int drow0, int dld, int dcol0, LAS float* scr, int lane) {
#pragma unroll 8
    for (int i = 0; i < 32; ++i) { const int kk = 2 * i + (lane >> 5); scr[kk * 33 + (lane & 31)] = __builtin_nontemporal_load(W + (size_t)(k0 + kk) * N + n0 + (lane & 31)); }
    asm volatile("s_waitcnt lgkmcnt(0)" ::: "memory");
    const int c = lane & 7;
#pragma unroll
    for (int j = 0; j < 4; ++j) { const int n = (lane >> 3) + 8 * j; const LAS float* s = scr + (8 * c) * 33 + n;
        u32x4 o; o.x = pk2(s[0 * 33], s[1 * 33]); o.y = pk2(s[2 * 33], s[3 * 33]); o.z = pk2(s[4 * 33], s[5 * 33]); o.w = pk2(s[6 * 33], s[7 * 33]);
        *(u32x4*)(dst + (size_t)(drow0 + n) * dld + dcol0 + k0 + 8 * c) = o; }
    asm volatile("s_waitcnt lgkmcnt(0)" ::: "memory");
}
__device__ __forceinline__ void tr_item8(const float* W, int N, int k0, int n0, unsigned char* dst, int drow0, int dld, float sc, LAS float* scr, int lane) {
#pragma unroll 8
    for (int i = 0; i < 32; ++i) { const int kk = 2 * i + (lane >> 5); scr[kk * 33 + (lane & 31)] = __builtin_nontemporal_load(W + (size_t)(k0 + kk) * N + n0 + (lane & 31)); }
    asm volatile("s_waitcnt lgkmcnt(0)" ::: "memory");
    const int c = lane & 7;
#pragma unroll
    for (int j = 0; j < 4; ++j) { const int n = (lane >> 3) + 8 * j; const LAS float* s = scr + (8 * c) * 33 + n;
        unsigned w0 = 0u, w1 = 0u;
        w0 = __builtin_amdgcn_cvt_pk_fp8_f32(s[0 * 33] * sc, s[1 * 33] * sc, w0, false); w0 = __builtin_amdgcn_cvt_pk_fp8_f32(s[2 * 33] * sc, s[3 * 33] * sc, w0, true);
        w1 = __builtin_amdgcn_cvt_pk_fp8_f32(s[4 * 33] * sc, s[5 * 33] * sc, w1, false); w1 = __builtin_amdgcn_cvt_pk_fp8_f32(s[6 * 33] * sc, s[7 * 33] * sc, w1, true);
        *(u32x2*)(dst + (size_t)(drow0 + n) * dld + k0 + 8 * c) = (u32x2){w0, w1}; }
    asm volatile("s_waitcnt lgkmcnt(0)" ::: "memory");
}
__device__ __forceinline__ void ph_prologue(const Ctx& F) {
    const Args& A = *F.a;
    LAS float* scr = (LAS float*)(F.lds + F.wave * 16384);
    const int gw = F.vcu * 8 + F.wave, NGW = F.G * 8;
    bf16_t* WIN = (bf16_t*)(F.ws + WS_WIN); bf16_t* WAB = (bf16_t*)(F.ws + WS_WAB); bf16_t* WOUT = (bf16_t*)(F.ws + WS_WOUT);
    unsigned char* WDN = F.ws + WS_WDN; unsigned char* WUP = F.ws + WS_WUP;
    constexpr int I_IN = 16 * (INCOLS / 32), I_SQ = 16 * 32, I_UP = NE * 16 * 64, I_DN = NE * 16 * 32;
    constexpr int NITEMS = I_IN + 3 * I_SQ + I_UP + I_DN;
    for (int it = gw; it < NITEMS; it += NGW) {
        int r = it;
        if (r < I_IN) { const int nblk = INCOLS / 32, kb = r / nblk, nb = r % nblk;
            if (32 * nb >= PN8_LO * 256 && 32 * nb < PN8_HI * 256) tr_item8(A.in[I_WIN], INCOLS, 64 * kb, 32 * nb, F.ws + WS_WIN8, 32 * nb, DM, 32.0f, scr, F.lane);
            else tr_item(A.in[I_WIN], INCOLS, 64 * kb, 32 * nb, WIN, 32 * nb, DM, 0, scr, F.lane);
            continue; } r -= I_IN;
        if (r < I_SQ) { const int kb = r / 32, nb = r % 32; tr_item(A.in[I_WBA], DM, 64 * kb, 32 * nb, WAB, 32 * nb, 2048, 0, scr, F.lane); continue; } r -= I_SQ;
        if (r < I_SQ) { const int kb = r / 32, nb = r % 32; tr_item(A.in[I_WBB], DM, 64 * kb, 32 * nb, WAB, 32 * nb, 2048, 1024, scr, F.lane); continue; } r -= I_SQ;
        if (r < I_SQ) { const int kb = r / 32, nb = r % 32; tr_item(A.in[I_WOUT], DM, 64 * kb, 32 * nb, WOUT, 32 * nb, DM, 0, scr, F.lane); continue; } r -= I_SQ;
        if (r < I_UP) { const int e = r / (16 * 64), rr = r % (16 * 64), kb = rr / 64, nb = rr % 64; const int n0 = 32 * nb, half = n0 >= FF, rem = n0 - half * FF, pn = rem >> 7, b = (rem & 127) >> 5;
            tr_item8(A.in[I_WUP] + (size_t)e * DM * 2 * FF, 2 * FF, 64 * kb, n0, WUP, e * 2048 + 256 * pn + half * 128 + 32 * b, DM, 32.0f, scr, F.lane); continue; } r -= I_UP;
        { const int e = r / (16 * 32), rr = r % (16 * 32), kb = rr / 32, nb = rr % 32; tr_item8(A.in[I_WDN] + (size_t)e * FF * DM, DM, 64 * kb, 32 * nb, WDN, e * 1024 + 32 * nb, FF, 64.0f, scr, F.lane); }
    }
    const float* lg = A.in[I_LNIN_G]; const float* lb = A.in[I_LNIN_B]; bf16_t* H0 = (bf16_t*)(F.ws + WS_H0);
    f32x4 gg[4], bb[4];
#pragma unroll
    for (int j = 0; j < 4; ++j) { gg[j] = *((const f32x4*)lg + F.lane + 64 * j); bb[j] = *((const f32x4*)lb + F.lane + 64 * j); }
    for (int m = gw; m < T; m += NGW) {
        const f32x4* xr = (const f32x4*)(A.in[I_X] + (size_t)m * DM) + F.lane;
        f32x4 v[4]; float s = 0.f;
#pragma unroll
        for (int j = 0; j < 4; ++j) { v[j] = __builtin_nontemporal_load(xr + 64 * j); s += (v[j].x + v[j].y) + (v[j].z + v[j].w); }
        const float mean = wave_sum(s) * (1.f / DM); float s2 = 0.f;
#pragma unroll
        for (int j = 0; j < 4; ++j) { v[j] = v[j] - mean; s2 += (v[j].x * v[j].x + v[j].y * v[j].y) + (v[j].z * v[j].z + v[j].w * v[j].w); }
        const float rstd = 1.f / sqrtf(wave_sum(s2) * (1.f / DM) + LN_EPS);
        u32x2* o8 = (u32x2*)(H0 + (size_t)m * DM) + F.lane; unsigned* o4 = (unsigned*)(F.ws + WS_H0F8 + (size_t)m * DM) + F.lane;
#pragma unroll
        for (int j = 0; j < 4; ++j) { const f32x4 y = v[j] * rstd * gg[j] + bb[j]; o8[64 * j] = (u32x2){pk2(y.x, y.y), pk2(y.z, y.w)}; o4[64 * j] = pack_fp8x4(y.x, y.y, y.z, y.w); }
    }
}

typedef short v4i16_t __attribute__((ext_vector_type(4)));
__device__ __forceinline__ v4i16_t lds_tr16(LAS const unsigned char* p) { return __builtin_amdgcn_ds_read_tr16_b64_v4i16((LAS v4i16_t*)p); }
__device__ __forceinline__ void ph_mixer_a(const Ctx& F) {
    const Args& A = *F.a;
    const unsigned char* GV = F.ws + WS_GV; bf16_t* YAB = (bf16_t*)(F.ws + WS_YAB); const float* GVST = (const float*)(F.ws + WS_GVST);
    const float* lg = A.in[I_GLN_G]; const float* lb = A.in[I_GLN_B]; const float* wsp = A.in[I_WSP]; const float* bsp = A.in[I_BSP];
    constexpr int RSV = 544, RSW = 272, OFF_W = 128 * RSV, OFF_ST = OFF_W + 128 * RSW;
    LAS unsigned char* VT = F.lds; LAS unsigned char* WT = F.lds + OFF_W; LAS float* ST = (LAS float*)(F.lds + OFF_ST);
    const int lane = F.lane, wv = F.wave;
    int curg = -1;
    for (int it = F.vcu; it < NB * 32 * 4; it += F.G) {
        const int b = it / 128, c = (it >> 2) & 31, g = it & 3;
        const int tok0 = b * SEQ + c * 128;
        if (g != curg) {
            curg = g;
            for (int k = 0; k < 4; ++k) {
                const int idx = F.tid + 512 * k, t = idx >> 4, s8 = (idx & 15) * 8;
                const f32x4 w0 = *(const f32x4*)(wsp + ((size_t)g * 128 + t) * 128 + s8), w1 = *(const f32x4*)(wsp + ((size_t)g * 128 + t) * 128 + s8 + 4);
                float x[8] = {w0.x, w0.y, w0.z, w0.w, w1.x, w1.y, w1.z, w1.w};
#pragma unroll
                for (int j = 0; j < 8; ++j) x[j] = (s8 + j <= t) ? x[j] : 0.f;
                u32x4 o; o.x = pk2(x[0], x[1]); o.y = pk2(x[2], x[3]); o.z = pk2(x[4], x[5]); o.w = pk2(x[6], x[7]);
                *(LAS u32x4*)(WT + t * RSW + s8 * 2) = o;
            }
        }
        if (F.tid < 128) {
            const float* p = GVST + (size_t)(tok0 + F.tid) * 32; float s1 = 0.f, s2 = 0.f;
            for (int i = 0; i < 16; ++i) { s1 += p[2 * i]; s2 += p[2 * i + 1]; }
            const float mean = s1 * (1.f / DM), var = s2 * (1.f / DM) - mean * mean;
            ST[2 * F.tid] = mean; ST[2 * F.tid + 1] = 1.f / sqrtf(fmaxf(var, 0.f) + LN_EPS);
        }
        __syncthreads();
        {
            const int dc = F.tid & 31;
            const f32x4 g0 = *(const f32x4*)(lg + g * 256 + dc * 8), g1 = *(const f32x4*)(lg + g * 256 + dc * 8 + 4), b0 = *(const f32x4*)(lb + g * 256 + dc * 8), b1 = *(const f32x4*)(lb + g * 256 + dc * 8 + 4);
#pragma unroll
            for (int k = 0; k < 8; ++k) {
                const int s = (F.tid >> 5) + 16 * k;
                const u32x2 raw = *(const u32x2*)(GV + (size_t)(tok0 + s) * DM + g * 256 + dc * 8);
                const float mean = ST[2 * s], rstd = ST[2 * s + 1];
                const f32x2v f0 = __builtin_amdgcn_cvt_pk_f32_fp8((int)raw.x, false), f1 = __builtin_amdgcn_cvt_pk_f32_fp8((int)raw.x, true), f2 = __builtin_amdgcn_cvt_pk_f32_fp8((int)raw.y, false), f3 = __builtin_amdgcn_cvt_pk_f32_fp8((int)raw.y, true);
                f32x4 x0 = {f0.x, f0.y, f1.x, f1.y}, x1 = {f2.x, f2.y, f3.x, f3.y};
                x0 = (x0 - mean) * rstd * g0 + b0; x1 = (x1 - mean) * rstd * g1 + b1;
                u32x4 o; o.x = pk2(x0.x, x0.y); o.y = pk2(x0.z, x0.w); o.z = pk2(x1.x, x1.y); o.w = pk2(x1.z, x1.w);
                *(LAS u32x4*)(VT + s * RSV + dc * 16) = o;
            }
        }
        __syncthreads();
        {
            const int dbase = 32 * wv, kg = lane >> 4, q = (lane & 15) >> 2, p = lane & 3, fr = lane & 15;
            bf16x8 Af[2][4];
#pragma unroll
            for (int m = 0; m < 2; ++m)
#pragma unroll
                for (int kk = 0; kk < 4; ++kk) {
                    LAS const unsigned char* ap = VT + (32 * kk + 8 * kg + q) * RSV + (dbase + 16 * m + 4 * p) * 2;
                    const v4i16_t lo = lds_tr16(ap), hi = lds_tr16(ap + 4 * RSV);
                    Af[m][kk] = (bf16x8){lo[0], lo[1], lo[2], lo[3], hi[0], hi[1], hi[2], hi[3]};
                }
#pragma unroll
            for (int n = 0; n < 8; ++n) {
                f32x4 acc0 = {0.f, 0.f, 0.f, 0.f}, acc1 = {0.f, 0.f, 0.f, 0.f};
#pragma unroll
                for (int kk = 0; kk < 4; ++kk) if (kk <= (n >> 1)) {
                    const bf16x8 Bf = *(LAS const bf16x8*)(WT + (16 * n + fr) * RSW + (32 * kk + 8 * kg) * 2);
                    acc0 = __builtin_amdgcn_mfma_f32_16x16x32_bf16(Af[0][kk], Bf, acc0, 0, 0, 0);
                    acc1 = __builtin_amdgcn_mfma_f32_16x16x32_bf16(Af[1][kk], Bf, acc1, 0, 0, 0);
                }
                const int t = 16 * n + fr; const float bsv = bsp[g * 128 + t];
                bf16_t* yp = YAB + (size_t)(tok0 + t) * 2048 + g * 256 + dbase + 4 * kg;
                const u32x2 u0 = *(const u32x2*)yp, u1 = *(const u32x2*)(yp + 16);
                u32x2 o0, o1;
                o0.x = pk2(bflo(u0.x) * (acc0[0] + bsv), bfhi(u0.x) * (acc0[1] + bsv)); o0.y = pk2(bflo(u0.y) * (acc0[2] + bsv), bfhi(u0.y) * (acc0[3] + bsv));
                o1.x = pk2(bflo(u1.x) * (acc1[0] + bsv), bfhi(u1.x) * (acc1[1] + bsv)); o1.y = pk2(bflo(u1.y) * (acc1[2] + bsv), bfhi(u1.y) * (acc1[3] + bsv));
                *(u32x2*)yp = o0; *(u32x2*)(yp + 16) = o1;
            }
        }
        __syncthreads();
    }
}

__device__ __forceinline__ void ph_gate(const Ctx& F) {
    const unsigned char* Q = F.ws + WS_Q; const float* KM = (const float*)(F.ws + WS_KMEAN);
    unsigned* SEL = (unsigned*)(F.ws + WS_SEL); unsigned* LISTS = (unsigned*)(F.ws + WS_LISTS); unsigned* LCNT = (unsigned*)(F.ws + WS_CTL) + CW_LCNT;
    float* km = (float*)F.ldsg;
    unsigned* lc = (unsigned*)(F.ldsg + 8192);
    for (int it = F.vcu; it < NB * NH * 8; it += F.G) {
        const int b = it / 64, h = (it >> 3) & 7, tc = it & 7;
        for (int i = F.tid; i < NBLK * DH; i += 512) { const int j = i >> 7, d = i & 127; const float* kp = KM + (size_t)((b * NBLK + j) * 2) * DM + h * DH + d; km[i] = (kp[0] + kp[DM]) * (1.0f / LBLK); }
        if (F.tid < 32) lc[F.tid] = 0u;
        __syncthreads();
        const int t = tc * 512 + F.tid, qi = t >> 8;
        float gsc[15];
#pragma unroll
        for (int j = 0; j < 15; ++j) gsc[j] = 0.f;
        const unsigned char* qp = Q + (size_t)(b * SEQ + t) * DM + h * DH;
        u32x4 qraw[8];
#pragma unroll
        for (int c = 0; c < 8; ++c) qraw[c] = *(const u32x4*)(qp + c * 16);
#pragma unroll
        for (int c = 0; c < 16; ++c) {
            const u32x2 raw = (c & 1) ? (u32x2){qraw[c >> 1].z, qraw[c >> 1].w} : (u32x2){qraw[c >> 1].x, qraw[c >> 1].y};
            const f32x2v f0 = __builtin_amdgcn_cvt_pk_f32_fp8((int)raw.x, false), f1 = __builtin_amdgcn_cvt_pk_f32_fp8((int)raw.x, true), f2 = __builtin_amdgcn_cvt_pk_f32_fp8((int)raw.y, false), f3 = __builtin_amdgcn_cvt_pk_f32_fp8((int)raw.y, true);
            const float x[8] = {f0.x, f0.y, f1.x, f1.y, f2.x, f2.y, f3.x, f3.y};
#pragma unroll
            for (int j = 0; j < 15; ++j) if (j < qi) {
                const float* kk = km + j * DH + c * 8;
#pragma unroll
                for (int e = 0; e < 8; ++e) gsc[j] += x[e] * kk[e];
            }
        }
        const int nsel = qi < 3 ? qi : 3;
        int sel[3] = {0, 0, 0}; unsigned lpos[3] = {0, 0, 0};
#pragma unroll
        for (int r = 0; r < 3; ++r) {
            float best = -INFINITY; int bi = -1;
#pragma unroll
            for (int j = 0; j < 15; ++j) { const bool c = (j < qi) && (gsc[j] > best); best = c ? gsc[j] : best; bi = c ? j : bi; }
#pragma unroll
            for (int j = 0; j < 15; ++j) if (j == bi) gsc[j] = -INFINITY;
            sel[r] = bi < 0 ? 0 : bi;
            if (r < nsel) lpos[r] = atomicAdd(&lc[sel[r]], 1u);
        }
        SEL[(size_t)(b * SEQ + t) * NH + h] = (unsigned)sel[0] | ((unsigned)sel[1] << 8) | ((unsigned)sel[2] << 16) | ((unsigned)nsel << 24);
        __syncthreads();
        if (F.tid < 16) lc[16 + F.tid] = lc[F.tid] ? atomicAdd(&LCNT[(b * NH + h) * NBLK + F.tid], lc[F.tid]) : 0u;
        __syncthreads();
#pragma unroll
        for (int r = 0; r < 3; ++r) if (r < nsel) LISTS[(size_t)((b * NH + h) * NBLK + sel[r]) * 4096 + lc[16 + sel[r]] + lpos[r]] = (unsigned)t | ((unsigned)r << 12);
        __syncthreads();
    }
}


typedef float f32x16 __attribute__((ext_vector_type(16)));
namespace att {
__device__ __forceinline__ int crow(int r, int hi) { return (r & 3) + 8 * (r >> 2) + 4 * hi; }
#define TRR(dst, vaddr, off) asm volatile("ds_read_b64_tr_b16 %0, %1 offset:%c2" : "=v"(dst) : "v"(vaddr), "i"(off) : "memory")
#define TRWAIT() do { asm volatile("s_waitcnt lgkmcnt(0)" ::: "memory"); __builtin_amdgcn_sched_barrier(0); } while (0)

}

namespace att2 {
constexpr int KCH2 = 1040, VDB2 = 4160, KSL = 8 * KCH2, VSL = 4 * VDB2;
constexpr int OFF_K = 0, OFF_V = 2 * KSL, OFF_STG = OFF_V + 2 * VSL  , OFF_WS = OFF_STG + 8 * 8192  , WSW = 1024, OFF_TAB = OFF_WS + 8 * WSW  ;
static_assert(OFF_TAB + 1028 * 4 <= LDS_BYTES - 64, "attention (partial) LDS map");
using att::crow;

__device__ __forceinline__ void tile_load(const Ctx& F, const unsigned char* K, const unsigned char* V, size_t tokbase, int h, int kt, u32x4& rk, u32x4& rv) {
    const size_t off = (tokbase + 64 * kt + (F.tid >> 3)) * DM + h * DH + (F.tid & 7) * 16;
    rk = *(const u32x4*)(K + off); rv = *(const u32x4*)(V + off);
}
__device__ __forceinline__ void tile_write(const Ctx& F, int slot, const u32x4& rk, const u32x4& rv) {
    const int key = F.tid >> 3, c = 2 * (F.tid & 7);
    *(LAS u32x4*)(F.lds + OFF_K + slot * KSL + (F.tid & 7) * KCH2 + key * 16) = rk;
    LAS unsigned char* vd = F.lds + OFF_V + slot * VSL + (c >> 2) * VDB2 + (key >> 3) * 512 + (key & 7) * 64 + (c & 3) * 16;
    *(LAS u32x4*)vd = f8x8_to_bf16x8(rv.x, rv.y); *(LAS u32x4*)(vd + 16) = f8x8_to_bf16x8(rv.z, rv.w);
}
template <bool CAUSAL = false>
__device__ __forceinline__ void tile_compute(const Ctx& F, int slot, const pg8::v8i_t (&qf)[2], f32x16 (&o)[4], float& m, float& l, bool first, bool diag = false) {
    const int r = F.lane & 31, hh = F.lane >> 5;
    LAS float* wsf = (LAS float*)(F.lds + OFF_WS + F.wave * WSW);
    LAS const unsigned char* kp = F.lds + OFF_K + slot * KSL + 2 * hh * KCH2 + r * 16;
    LAS const unsigned char* vp = F.lds + OFF_V + slot * VSL + (4 * hh + ((F.lane & 15) >> 2)) * 64 + ((F.lane >> 4) & 1) * 32 + (F.lane & 3) * 8;
    f32x16 p0, p1;
#pragma unroll
    for (int i = 0; i < 16; ++i) { p0[i] = 0.f; p1[i] = 0.f; }
    {
        pg8::v8i_t ka[2][2];
#pragma unroll
        for (int kb = 0; kb < 2; ++kb)
#pragma unroll
            for (int j2 = 0; j2 < 2; ++j2) ka[kb][j2] = __builtin_shufflevector(*(LAS const pg8::v4i_t*)(kp + 4 * j2 * KCH2 + kb * 512), *(LAS const pg8::v4i_t*)(kp + (4 * j2 + 1) * KCH2 + kb * 512), 0, 1, 2, 3, 4, 5, 6, 7);
        __builtin_amdgcn_sched_barrier(0);
#pragma unroll
        for (int j2 = 0; j2 < 2; ++j2) p0 = __builtin_amdgcn_mfma_scale_f32_32x32x64_f8f6f4(ka[0][j2], qf[j2], p0, 0, 0, 0, 0x7f7f7f7f, 0, 0x7f7f7f7f);
#pragma unroll
        for (int j2 = 0; j2 < 2; ++j2) p1 = __builtin_amdgcn_mfma_scale_f32_32x32x64_f8f6f4(ka[1][j2], qf[j2], p1, 0, 0, 0, 0x7f7f7f7f, 0, 0x7f7f7f7f);
        __builtin_amdgcn_sched_barrier(0);
    }
    v4i16_t vl[2][4], vh[2][4];
    const unsigned vaddr = (unsigned)(uintptr_t)vp;
#pragma unroll
    for (int ks = 0; ks < 2; ++ks)
#pragma unroll
        for (int db = 0; db < 4; ++db) { TRR(vl[ks][db], vaddr, db * VDB2 + ks * 1024); TRR(vh[ks][db], vaddr, db * VDB2 + ks * 1024 + 512); }
    __builtin_amdgcn_sched_barrier(0);
    if (CAUSAL && diag) {
        if (F.wave & 1) {
#pragma unroll
            for (int i = 0; i < 16; ++i) p1[i] = (crow(i, hh) > r) ? -INFINITY : p1[i];
        } else {
#pragma unroll
            for (int i = 0; i < 16; ++i) { p0[i] = (crow(i, hh) > r) ? -INFINITY : p0[i]; p1[i] = -INFINITY; }
        }
    }
    const float dm = first ? 0.f : m;
    { const f32x2 dm2 = {dm, dm};
#pragma unroll
      for (int j = 0; j < 8; ++j) { f32x2 a = {p0[2 * j], p0[2 * j + 1]}, b = {p1[2 * j], p1[2 * j + 1]}; a = a - dm2; b = b - dm2; p0[2 * j] = a.x; p0[2 * j + 1] = a.y; p1[2 * j] = b.x; p1[2 * j + 1] = b.y; } }
    float mx = fmaxf(p0[0], p1[0]);
#pragma unroll
    for (int i = 1; i < 16; ++i) mx = fmaxf(mx, fmaxf(p0[i], p1[i]));
    mx = fmaxf(mx, __shfl_xor(mx, 32));
    if (first || __any(mx > 8.0f)) {
        const float delta = first ? mx : fmaxf(mx, 0.f);
        const float alpha = first ? 0.f : __builtin_amdgcn_exp2f(-delta);
        l *= alpha; m = dm + delta;
        { const f32x2 d2 = {delta, delta};
#pragma unroll
          for (int j = 0; j < 8; ++j) { f32x2 a = {p0[2 * j], p0[2 * j + 1]}, b = {p1[2 * j], p1[2 * j + 1]}; a = a - d2; b = b - d2; p0[2 * j] = a.x; p0[2 * j + 1] = a.y; p1[2 * j] = b.x; p1[2 * j + 1] = b.y; } }
        if (!first) {
            if (hh == 0) wsf[r] = alpha;
            asm volatile("s_waitcnt lgkmcnt(0)" ::: "memory");
#pragma unroll
            for (int i = 0; i < 16; ++i) { const float a = wsf[crow(i, hh)];
#pragma unroll
                for (int db = 0; db < 4; ++db) o[db][i] *= a; }
        }
    }
    { f32x2 sa = {0.f, 0.f}, sb = {0.f, 0.f};
#pragma unroll
      for (int j = 0; j < 8; ++j) {
          p0[2 * j] = __builtin_amdgcn_exp2f(p0[2 * j]); p0[2 * j + 1] = __builtin_amdgcn_exp2f(p0[2 * j + 1]); p1[2 * j] = __builtin_amdgcn_exp2f(p1[2 * j]); p1[2 * j + 1] = __builtin_amdgcn_exp2f(p1[2 * j + 1]);
          sa = sa + (f32x2){p0[2 * j], p0[2 * j + 1]}; sb = sb + (f32x2){p1[2 * j], p1[2 * j + 1]}; }
      sa = sa + sb; l += sa.x + sa.y; }
    u32x4 pw[4];
#pragma unroll
    for (int s2 = 0; s2 < 2; ++s2) {
        pw[s2] = (u32x4){cvt_pk_bf16(p0[8 * s2], p0[8 * s2 + 1]), cvt_pk_bf16(p0[8 * s2 + 2], p0[8 * s2 + 3]), cvt_pk_bf16(p0[8 * s2 + 4], p0[8 * s2 + 5]), cvt_pk_bf16(p0[8 * s2 + 6], p0[8 * s2 + 7])};
        pw[2 + s2] = (u32x4){cvt_pk_bf16(p1[8 * s2], p1[8 * s2 + 1]), cvt_pk_bf16(p1[8 * s2 + 2], p1[8 * s2 + 3]), cvt_pk_bf16(p1[8 * s2 + 4], p1[8 * s2 + 5]), cvt_pk_bf16(p1[8 * s2 + 6], p1[8 * s2 + 7])};
    }
    TRWAIT();
#pragma unroll
    for (int ks = 0; ks < 2; ++ks) {
        const bf16x8 pa = __builtin_bit_cast(bf16x8, pw[ks]);
#pragma unroll
        for (int db = 0; db < 4; ++db) {
            const bf16x8 vf = (bf16x8){vl[ks][db][0], vl[ks][db][1], vl[ks][db][2], vl[ks][db][3], vh[ks][db][0], vh[ks][db][1], vh[ks][db][2], vh[ks][db][3]};
            o[db] = __builtin_amdgcn_mfma_f32_32x32x16_bf16(pa, vf, o[db], 0, 0, 0);
        }
    }
    __builtin_amdgcn_sched_barrier(0);
#pragma unroll
    for (int ks = 0; ks < 2; ++ks)
#pragma unroll
        for (int db = 0; db < 4; ++db) { TRR(vl[ks][db], vaddr, db * VDB2 + (2 + ks) * 1024); TRR(vh[ks][db], vaddr, db * VDB2 + (2 + ks) * 1024 + 512); }
    TRWAIT();
#pragma unroll
    for (int ks = 0; ks < 2; ++ks) {
        const bf16x8 pa = __builtin_bit_cast(bf16x8, pw[2 + ks]);
#pragma unroll
        for (int db = 0; db < 4; ++db) {
            const bf16x8 vf = (bf16x8){vl[ks][db][0], vl[ks][db][1], vl[ks][db][2], vl[ks][db][3], vh[ks][db][0], vh[ks][db][1], vh[ks][db][2], vh[ks][db][3]};
            o[db] = __builtin_amdgcn_mfma_f32_32x32x16_bf16(pa, vf, o[db], 0, 0, 0);
        }
    }
    __builtin_amdgcn_sched_barrier(0);
}
}

#define ATT2_DECODE(item, bhj_, chunk_) do { int lo_ = 0, hi_ = 1023; while (lo_ < hi_) { const int mid_ = (lo_ + hi_ + 1) >> 1; if (P[mid_] <= (item)) lo_ = mid_; else hi_ = mid_ - 1; } bhj_ = lo_; chunk_ = (item) - P[lo_]; } while (0)
__device__ __forceinline__ void ph_attn_partial(const Ctx& F) {
    using namespace att2;
    const unsigned char* Q = F.ws + WS_Q; const unsigned char* K = F.ws + WS_K; const unsigned char* V = F.ws + WS_V;
    const unsigned* LISTS = (const unsigned*)(F.ws + WS_LISTS); const unsigned* LCNT = (const unsigned*)(F.ws + WS_CTL) + CW_LCNT;
    unsigned char* OP = F.ws + WS_OP; float* LSE = (float*)(F.ws + WS_LSE);
    LAS int* P = (LAS int*)(F.lds + OFF_TAB);
    if (F.tid < 64) {
        int c[16]; int s = 0;
#pragma unroll
        for (int i = 0; i < 16; ++i) { c[i] = ((int)__hip_atomic_load(LCNT + F.tid * 16 + i, __ATOMIC_RELAXED, __HIP_MEMORY_SCOPE_AGENT) + 255) >> 8; s += c[i]; }
        int inc = s;
#pragma unroll
        for (int o = 1; o < 64; o <<= 1) { const int t = __shfl_up(inc, o); if (F.lane >= o) inc += t; }
        int run = inc - s;
#pragma unroll
        for (int i = 0; i < 16; ++i) { P[F.tid * 16 + i] = run; run += c[i]; }
        if (F.tid == 63) P[1024] = run;
    }
    __syncthreads();
    const int total = P[1024];
    LAS float* wsf = (LAS float*)(F.lds + OFF_WS + F.wave * WSW);
    LAS int* wsi = (LAS int*)wsf;
    const int r = F.lane & 31, hh = F.lane >> 5;
    int it = F.vcu;
    if (it < total) {
        int bhj, chunk; ATT2_DECODE(it, bhj, chunk);
        int itn = it + F.G, bhjn = 0, chunkn = 0; bool hasn = itn < total; if (hasn) ATT2_DECODE(itn, bhjn, chunkn);
        u32x4 rkA, rvA, rkB, rvB;
        { const int b = bhj >> 7, h = (bhj >> 4) & 7, j = bhj & 15; const size_t tb = (size_t)b * SEQ + j * LBLK;
          tile_load(F, K, V, tb, h, 0, rkA, rvA); tile_load(F, K, V, tb, h, 1, rkB, rvB); tile_write(F, 0, rkA, rvA); tile_write(F, 1, rkB, rvB);
          tile_load(F, K, V, tb, h, 2, rkA, rvA); }
        int cnt = (int)__hip_atomic_load(LCNT + bhj, __ATOMIC_RELAXED, __HIP_MEMORY_SCOPE_AGENT);
        int qi = chunk * 256 + F.wave * 32 + r;
        unsigned ent = LISTS[(size_t)bhj * 4096 + (qi < cnt ? qi : 0)];
        int tq = ent & 4095, slot = (qi < cnt) ? (int)(ent >> 12) : -1;
        u32x4 qraw[4];
        { const unsigned char* qrow = Q + ((size_t)(bhj >> 7) * SEQ + tq) * DM + ((bhj >> 4) & 7) * DH + hh * 32;
#pragma unroll
          for (int c = 0; c < 4; ++c) qraw[c] = *(const u32x4*)(qrow + (c >> 1) * 64 + (c & 1) * 16); }
        unsigned entn = 0u; int cntn = 0;
        __syncthreads();
        int s = 0;
        for (;;) {
            const int b = bhj >> 7, h = (bhj >> 4) & 7, j = bhj & 15;
            pg8::v8i_t qr[2];
#pragma unroll
            for (int j2 = 0; j2 < 2; ++j2) qr[j2] = __builtin_shufflevector(__builtin_bit_cast(pg8::v4i_t, qraw[2 * j2]), __builtin_bit_cast(pg8::v4i_t, qraw[2 * j2 + 1]), 0, 1, 2, 3, 4, 5, 6, 7);
            if (F.lane < 32) { wsi[64 + r] = tq; wsi[96 + r] = slot; }
            f32x16 o[4]; float m = -1e30f, l = 0.f;
#pragma unroll
            for (int db = 0; db < 4; ++db)
#pragma unroll
                for (int i = 0; i < 16; ++i) o[db][i] = 0.f;
#define ATT2_TB(bb) ((size_t)((bb) >> 7) * SEQ + ((bb) & 15) * LBLK)
#define ATT2_H(bb) (((bb) >> 4) & 7)
#pragma unroll 1
            for (int kp2 = 0; kp2 < 2; ++kp2) {
                const int kt = 2 * kp2;
                { const bool cur3 = kt + 3 < 4, have3 = cur3 || hasn, have2 = (kt + 2 < 4) || hasn;
                  if (have3) { const int bb = cur3 ? bhj : bhjn; tile_load(F, K, V, ATT2_TB(bb), ATT2_H(bb), (kt + 3) & 3, rkB, rvB); }
                  if (kt == 0 && hasn) { cntn = (int)__hip_atomic_load(LCNT + bhjn, __ATOMIC_RELAXED, __HIP_MEMORY_SCOPE_AGENT); }
                  if (kt == 2 && hasn) { const unsigned char* qrow = Q + ((size_t)(bhjn >> 7) * SEQ + (entn & 4095)) * DM + ((bhjn >> 4) & 7) * DH + hh * 32;
#pragma unroll
                      for (int c = 0; c < 4; ++c) qraw[c] = *(const u32x4*)(qrow + (c >> 1) * 64 + (c & 1) * 16); }
                  tile_compute(F, 0, qr, o, m, l, kp2 == 0);
                  asm volatile("s_waitcnt lgkmcnt(0)" ::: "memory"); __builtin_amdgcn_s_barrier(); asm volatile("" ::: "memory");
                  if (have2) tile_write(F, 0, rkA, rvA); }
                { const bool have4 = hasn, have3 = (kt + 3 < 4) || hasn;
                  if (have4) { tile_load(F, K, V, ATT2_TB(bhjn), ATT2_H(bhjn), kt, rkA, rvA); }
                  if (kt == 0 && hasn) { const int qn = chunkn * 256 + F.wave * 32 + r; entn = LISTS[(size_t)bhjn * 4096 + (qn < cntn ? qn : 0)]; }
                  tile_compute(F, 1, qr, o, m, l, false);
                  asm volatile("s_waitcnt lgkmcnt(0)" ::: "memory"); __builtin_amdgcn_s_barrier(); asm volatile("" ::: "memory");
                  if (have3) tile_write(F, 1, rkB, rvB); }
            }
            const float lt = l + __shfl_xor(l, 32);
            if (hh == 0) { wsf[r] = 1.0f / lt; wsf[32 + r] = m + __builtin_amdgcn_logf(lt); }
            asm volatile("s_waitcnt lgkmcnt(0)" ::: "memory");
            int re = r, he = hh; asm volatile("" : "+v"(re), "+v"(he));
#pragma unroll
            for (int i = 0; i < 16; ++i) {
                const int q = crow(i, he); const float a = wsf[q]; const int t = wsi[64 + q], sl = wsi[96 + q];
                const unsigned w = pack_fp8x4(o[0][i] * a, o[1][i] * a, o[2][i] * a, o[3][i] * a);
                if (sl >= 0) { const size_t row = (((size_t)sl * NB + b) * SEQ + t) * NH + h; *(unsigned*)(OP + row * DH + 4 * re) = w; }
            }
            if (he == 0 && slot >= 0) LSE[(((size_t)slot * NB + b) * SEQ + tq) * NH + h] = wsf[32 + re];
            asm volatile("s_waitcnt lgkmcnt(0)" ::: "memory");
            if (!hasn) break;
            it = itn; bhj = bhjn; chunk = chunkn; cnt = cntn;
            { const int qn = chunk * 256 + F.wave * 32 + r; tq = entn & 4095; slot = (qn < cnt) ? (int)(entn >> 12) : -1; }
            itn = it + F.G; hasn = itn < total; if (hasn) ATT2_DECODE(itn, bhjn, chunkn);
        }
    }
    __syncthreads();
}

__device__ __forceinline__ void ph_attn_own(const Ctx& F) {
    using namespace att2;
    const unsigned char* Q = F.ws + WS_Q; const unsigned char* K = F.ws + WS_K; const unsigned char* V = F.ws + WS_V;
    const unsigned char* OP = F.ws + WS_OP; const float* LSE = (const float*)(F.ws + WS_LSE); bf16_t* YAB = (bf16_t*)(F.ws + WS_YAB);
    LAS float* wsf = (LAS float*)(F.lds + OFF_WS + F.wave * WSW);
    const int r = F.lane & 31, hh = F.lane >> 5;
    constexpr int NIT = NB * NH * NBLK;
    int it = F.vcu;
    if (it < NIT) {
        int itn = it + F.G; bool hasn = itn < NIT;
        u32x4 rkA, rvA, rkB, rvB;
#define OWN_TB(i_) ((size_t)((i_) >> 7) * SEQ + ((i_) & 15) * LBLK)
#define OWN_H(i_) (((i_) >> 4) & 7)
        tile_load(F, K, V, OWN_TB(it), OWN_H(it), 0, rkA, rvA); tile_load(F, K, V, OWN_TB(it), OWN_H(it), 1, rkB, rvB); tile_write(F, 0, rkA, rvA); tile_write(F, 1, rkB, rvB);
        tile_load(F, K, V, OWN_TB(it), OWN_H(it), 2, rkA, rvA);
        u32x4 qraw[4];
        { const unsigned char* qrow = Q + (OWN_TB(it) + F.wave * 32 + r) * DM + OWN_H(it) * DH + hh * 32;
#pragma unroll
          for (int c = 0; c < 4; ++c) qraw[c] = *(const u32x4*)(qrow + (c >> 1) * 64 + (c & 1) * 16); }
        __syncthreads();
        const int wdiag = F.wave >> 1;
        for (;;) {
            const int b = it >> 7, h = (it >> 4) & 7, j = it & 15, t0 = j * LBLK + F.wave * 32;
            pg8::v8i_t qr[2];
#pragma unroll
            for (int j2 = 0; j2 < 2; ++j2) qr[j2] = __builtin_shufflevector(__builtin_bit_cast(pg8::v4i_t, qraw[2 * j2]), __builtin_bit_cast(pg8::v4i_t, qraw[2 * j2 + 1]), 0, 1, 2, 3, 4, 5, 6, 7);
            f32x16 o[4]; float m = -1e30f, l = 0.f;
#pragma unroll
            for (int db = 0; db < 4; ++db)
#pragma unroll
                for (int i = 0; i < 16; ++i) o[db][i] = 0.f;
#pragma unroll 1
            for (int kp2 = 0; kp2 < 2; ++kp2) {
                const int kt = 2 * kp2;
                { const bool cur3 = kt + 3 < 4, have3 = cur3 || hasn, have2 = (kt + 2 < 4) || hasn;
                  if (have3) { const int ii = cur3 ? it : itn; tile_load(F, K, V, OWN_TB(ii), OWN_H(ii), (kt + 3) & 3, rkB, rvB); }
                  if (kt == 2 && hasn) { const unsigned char* qrow = Q + (OWN_TB(itn) + F.wave * 32 + r) * DM + OWN_H(itn) * DH + hh * 32;
#pragma unroll
                      for (int c = 0; c < 4; ++c) qraw[c] = *(const u32x4*)(qrow + (c >> 1) * 64 + (c & 1) * 16); }
                  if (kt <= wdiag) tile_compute<true>(F, 0, qr, o, m, l, kp2 == 0, kt == wdiag);
                  asm volatile("s_waitcnt lgkmcnt(0)" ::: "memory"); __builtin_amdgcn_s_barrier(); asm volatile("" ::: "memory");
                  if (have2) tile_write(F, 0, rkA, rvA); }
                { const bool have4 = hasn, have3 = (kt + 3 < 4) || hasn;
                  if (have4) { tile_load(F, K, V, OWN_TB(itn), OWN_H(itn), kt, rkA, rvA); }
                  if (kt + 1 <= wdiag) tile_compute<true>(F, 1, qr, o, m, l, false, kt + 1 == wdiag);
                  asm volatile("s_waitcnt lgkmcnt(0)" ::: "memory"); __builtin_amdgcn_s_barrier(); asm volatile("" ::: "memory");
                  if (have3) tile_write(F, 1, rkB, rvB); }
            }
            const int nv = j < 3 ? j : 3;
            {
                const float lt = l + __shfl_xor(l, 32); const float lse_own = m + __builtin_amdgcn_logf(lt);
                float ls[3];
#pragma unroll
                for (int s2 = 0; s2 < 3; ++s2) ls[s2] = (s2 < nv) ? LSE[(((size_t)s2 * NB + b) * SEQ + t0 + r) * NH + h] : -1e30f;
                const float M = fmaxf(fmaxf(lse_own, ls[0]), fmaxf(ls[1], ls[2]));
                const float w0 = __builtin_amdgcn_exp2f(lse_own - M);
                float w[3], den = w0;
#pragma unroll
                for (int s2 = 0; s2 < 3; ++s2) { w[s2] = (s2 < nv) ? __builtin_amdgcn_exp2f(ls[s2] - M) : 0.f; den += w[s2]; }
                const float inv = 1.0f / den;
                if (hh == 0) { wsf[r] = w0 * inv / lt; wsf[32 + r] = w[0] * inv; wsf[64 + r] = w[1] * inv; wsf[96 + r] = w[2] * inv; }
                asm volatile("s_waitcnt lgkmcnt(0)" ::: "memory");
            }
            int re = r, he = hh; asm volatile("" : "+v"(re), "+v"(he));
            LAS float* stg = (LAS float*)(F.lds + OFF_STG + F.wave * 8192);
            {
                unsigned pv[16][3];
#pragma unroll
                for (int i = 0; i < 16; ++i) { const int q = crow(i, he);
#pragma unroll
                    for (int s2 = 0; s2 < 3; ++s2) { pv[i][s2] = 0u; if (s2 < nv) pv[i][s2] = *(const unsigned*)(OP + ((((size_t)s2 * NB + b) * SEQ + t0 + q) * NH + h) * DH + 4 * re); } }
#pragma unroll
                for (int i = 0; i < 16; ++i) { const int q = crow(i, he); const float a = wsf[q];
                    float x0 = o[0][i] * a, x1 = o[1][i] * a, x2 = o[2][i] * a, x3 = o[3][i] * a;
#pragma unroll
                    for (int s2 = 0; s2 < 3; ++s2) { const float ww = wsf[32 * (s2 + 1) + q]; const f32x2v f0 = __builtin_amdgcn_cvt_pk_f32_fp8((int)pv[i][s2], false), f1 = __builtin_amdgcn_cvt_pk_f32_fp8((int)pv[i][s2], true);
                        x0 += ww * f0.x; x1 += ww * f0.y; x2 += ww * f1.x; x3 += ww * f1.y; }
                    o[0][i] = x0; o[1][i] = x1; o[2][i] = x2; o[3][i] = x3; }
            }
#pragma unroll
            for (int half = 0; half < 2; ++half) {
#pragma unroll
                for (int i = 0; i < 16; ++i) { const int q = crow(i, he); stg[q * 64 + re] = o[2 * half][i]; stg[q * 64 + 32 + re] = o[2 * half + 1][i]; }
                asm volatile("s_waitcnt lgkmcnt(0)" ::: "memory");
#pragma unroll
                for (int ps = 0; ps < 4; ++ps) {
                    const int q = ps * 8 + ((re + 32 * he) >> 3), dc = re & 7;
                    const f32x4 x = *(LAS const f32x4*)(stg + q * 64 + dc * 8), y = *(LAS const f32x4*)(stg + q * 64 + dc * 8 + 4);
                    *(u32x4*)(YAB + ((size_t)b * SEQ + t0 + q) * 2048 + 1024 + h * DH + half * 64 + dc * 8) = (u32x4){cvt_pk_bf16(x.x, x.y), cvt_pk_bf16(x.z, x.w), cvt_pk_bf16(y.x, y.y), cvt_pk_bf16(y.z, y.w)};
                }
                asm volatile("s_waitcnt lgkmcnt(0)" ::: "memory");
            }
            if (!hasn) break;
            it = itn; itn = it + F.G; hasn = itn < NIT;
        }
#undef OWN_TB
#undef OWN_H
    }
    __syncthreads();
}

__device__ __forceinline__ void ph_router(const Ctx& F) {
    const Args& A = *F.a;
    const bf16_t* Z = (const bf16_t*)(F.ws + WS_Z); const float* ZST = (const float*)(F.ws + WS_ZST); bf16_t* H1 = (bf16_t*)(F.ws + WS_H1); unsigned char* H1F8 = F.ws + WS_H1F8;
    int* TKE = (int*)(F.ws + WS_TKE); int* TKP = (int*)(F.ws + WS_TKP); unsigned* ECNT = (unsigned*)(F.ws + WS_CTL) + CW_ECNT; int* RT = (int*)(F.ws + WS_RT); float* RW = (float*)(F.ws + WS_RW);
    const float* wr = A.in[I_WR]; const float* br = A.in[I_BR];
    constexpr int RS = 2064, OFF_LO = 32 * RS, OFF_G = 2 * 32 * RS  , OFF_B = OFF_G + 4096, OFF_LG = OFF_B + 4096  , OFF_CNT = OFF_LG + 8 * 2112  ;
    static_assert(OFF_CNT + 256 <= LDS_BYTES, "router LDS map");
    LAS unsigned char* WH = F.lds; LAS unsigned char* WL = F.lds + OFF_LO;
    LAS float* LG = (LAS float*)(F.lds + OFF_G); LAS float* LB = (LAS float*)(F.lds + OFF_B);
    LAS float* lgt = (LAS float*)(F.lds + OFF_LG + F.wave * 2112);
    LAS unsigned* lcnt = (LAS unsigned*)(F.lds + OFF_CNT);
    {
        f32x4 wa[8], wb[8];
#pragma unroll
        for (int u_ = 0; u_ < 8; ++u_) { const int i = F.tid + 512 * u_, nq = i & 7, k2 = i >> 3;
            wa[u_] = *(const f32x4*)(wr + (size_t)(2 * k2) * NE + 4 * nq); wb[u_] = *(const f32x4*)(wr + (size_t)(2 * k2 + 1) * NE + 4 * nq); }
#pragma unroll
        for (int u_ = 0; u_ < 8; ++u_) { const int i = F.tid + 512 * u_, nq = i & 7, k2 = i >> 3;
#pragma unroll
            for (int c = 0; c < 4; ++c) {
                const float w0 = wa[u_][c], w1 = wb[u_][c];
                const unsigned h0 = f2bf(w0), h1 = f2bf(w1);
                const float r0 = w0 - __uint_as_float(h0 << 16), r1 = w1 - __uint_as_float(h1 << 16);
                *(LAS unsigned*)(WH + (4 * nq + c) * RS + k2 * 4) = h0 | (h1 << 16);
                *(LAS unsigned*)(WL + (4 * nq + c) * RS + k2 * 4) = pk2(r0, r1);
            } }
    }
    for (int i = F.tid; i < DM; i += 512) { LG[i] = A.in[I_LNMIX_G][i]; LB[i] = A.in[I_LNMIX_B][i]; }
    if (F.tid < 64) lcnt[F.tid] = 0u;
    __syncthreads();
    const int fr = F.lane & 15, kg = F.lane >> 4;
    const int ntask = T / 16, NGW = F.G * 8;
    const int rounds = (ntask + NGW - 1) / NGW;
    for (int rd = 0; rd < rounds; ++rd) {
        const int task = rd * NGW + F.vcu * 8 + F.wave;
        const bool live = task < ntask;
        int te[4] = {0, 0, 0, 0}; float tw[4] = {0.f, 0.f, 0.f, 0.f}; unsigned lp[4] = {0, 0, 0, 0};
        if (live) {
            const int tok = task * 16 + fr;
            float mean, rstd;
            { const f32x4* sp = (const f32x4*)(ZST + (size_t)tok * 32); float s1 = 0.f, s2 = 0.f;
#pragma unroll
              for (int i = 0; i < 8; ++i) { const f32x4 v = sp[i]; s1 += v.x + v.z; s2 += v.y + v.w; }
              mean = s1 * (1.f / DM); const float var = s2 * (1.f / DM) - mean * mean; rstd = 1.f / sqrtf(fmaxf(var, 0.f) + LN_EPS); }
            f32x4 acc0 = {0.f, 0.f, 0.f, 0.f}, acc1 = {0.f, 0.f, 0.f, 0.f};
            const bf16_t* zp = Z + (size_t)tok * DM + 8 * kg; unsigned char* h8 = H1F8 + (size_t)tok * DM + 8 * kg;
#pragma unroll 8
            for (int kk = 0; kk < 32; ++kk) {
                const u32x4 zr = *(const u32x4*)(zp + 32 * kk); const f32x4 z0 = {bflo(zr.x), bfhi(zr.x), bflo(zr.y), bfhi(zr.y)}, z1 = {bflo(zr.z), bfhi(zr.z), bflo(zr.w), bfhi(zr.w)};
                const f32x4 g0 = *(LAS const f32x4*)(LG + 32 * kk + 8 * kg), g1 = *(LAS const f32x4*)(LG + 32 * kk + 8 * kg + 4);
                const f32x4 b0 = *(LAS const f32x4*)(LB + 32 * kk + 8 * kg), b1 = *(LAS const f32x4*)(LB + 32 * kk + 8 * kg + 4);
                const f32x4 x0 = (z0 - mean) * rstd * g0 + b0, x1 = (z1 - mean) * rstd * g1 + b1;
                u32x4 hi; hi.x = cvt_pk_bf16(x0.x, x0.y); hi.y = cvt_pk_bf16(x0.z, x0.w); hi.z = cvt_pk_bf16(x1.x, x1.y); hi.w = cvt_pk_bf16(x1.z, x1.w);
                { unsigned w0 = 0u, w1 = 0u;
                  w0 = __builtin_amdgcn_cvt_pk_fp8_f32(x0.x, x0.y, w0, false); w0 = __builtin_amdgcn_cvt_pk_fp8_f32(x0.z, x0.w, w0, true);
                  w1 = __builtin_amdgcn_cvt_pk_fp8_f32(x1.x, x1.y, w1, false); w1 = __builtin_amdgcn_cvt_pk_fp8_f32(x1.z, x1.w, w1, true);
                  *(u32x2*)(h8 + 32 * kk) = (u32x2){w0, w1}; }
                u32x4 lo; lo.x = cvt_pk_bf16(x0.x - bflo(hi.x), x0.y - bfhi(hi.x)); lo.y = cvt_pk_bf16(x0.z - bflo(hi.y), x0.w - bfhi(hi.y));
                lo.z = cvt_pk_bf16(x1.x - bflo(hi.z), x1.y - bfhi(hi.z)); lo.w = cvt_pk_bf16(x1.z - bflo(hi.w), x1.w - bfhi(hi.w));
                const bf16x8 ah = __builtin_bit_cast(bf16x8, hi), al = __builtin_bit_cast(bf16x8, lo);
                const int bo = fr * RS + (32 * kk + 8 * kg) * 2;
                const bf16x8 wh0 = *(LAS const bf16x8*)(WH + bo), wh1 = *(LAS const bf16x8*)(WH + bo + 16 * RS), wl0 = *(LAS const bf16x8*)(WL + bo), wl1 = *(LAS const bf16x8*)(WL + bo + 16 * RS);
                acc0 = __builtin_amdgcn_mfma_f32_16x16x32_bf16(ah, wh0, acc0, 0, 0, 0); acc1 = __builtin_amdgcn_mfma_f32_16x16x32_bf16(ah, wh1, acc1, 0, 0, 0);
                acc0 = __builtin_amdgcn_mfma_f32_16x16x32_bf16(ah, wl0, acc0, 0, 0, 0); acc1 = __builtin_amdgcn_mfma_f32_16x16x32_bf16(ah, wl1, acc1, 0, 0, 0);
                acc0 = __builtin_amdgcn_mfma_f32_16x16x32_bf16(al, wh0, acc0, 0, 0, 0); acc1 = __builtin_amdgcn_mfma_f32_16x16x32_bf16(al, wh1, acc1, 0, 0, 0);
            }
            const float br0 = br[fr], br1 = br[16 + fr];
#pragma unroll
            for (int i = 0; i < 4; ++i) { lgt[(4 * kg + i) * 33 + fr] = acc0[i] + br0; lgt[(4 * kg + i) * 33 + 16 + fr] = acc1[i] + br1; }
            asm volatile("s_waitcnt lgkmcnt(0)" ::: "memory");
            if (F.lane < 16) {
                float lg[NE];
#pragma unroll
                for (int e = 0; e < NE; ++e) lg[e] = lgt[F.lane * 33 + e];
                float tv[4];
#pragma unroll
                for (int r = 0; r < 4; ++r) {
                    float best = -INFINITY; int bi = 0;
#pragma unroll
                    for (int e = 0; e < NE; ++e) { const bool c = lg[e] > best; best = c ? lg[e] : best; bi = c ? e : bi; }
#pragma unroll
                    for (int e = 0; e < NE; ++e) lg[e] = (e == bi) ? -INFINITY : lg[e];
                    te[r] = bi; tv[r] = best;
                }
                const float e1 = __expf(tv[1] - tv[0]), e2 = __expf(tv[2] - tv[0]), e3 = __expf(tv[3] - tv[0]); const float inv = 1.f / (1.f + e1 + e2 + e3);
                tw[0] = inv; tw[1] = e1 * inv; tw[2] = e2 * inv; tw[3] = e3 * inv;
#pragma unroll
                for (int r = 0; r < 4; ++r) lp[r] = atomicAdd((unsigned*)(lcnt + te[r]), 1u);
            }
        }
        __syncthreads();
        if (F.tid < 32) { const unsigned c = lcnt[F.tid]; lcnt[32 + F.tid] = c ? atomicAdd(&ECNT[F.tid], c) : 0u; }
        __syncthreads();
        if (live && F.lane < 16) {
            const size_t tok = (size_t)task * 16 + F.lane;
            int4 pe = {te[0], te[1], te[2], te[3]};
            int4 pp = {(int)(lcnt[32 + te[0]] + lp[0]), (int)(lcnt[32 + te[1]] + lp[1]), (int)(lcnt[32 + te[2]] + lp[2]), (int)(lcnt[32 + te[3]] + lp[3])};
            *(int4*)(TKE + tok * 4) = pe; *(int4*)(TKP + tok * 4) = pp;
#pragma unroll
            for (int r = 0; r < 4; ++r) { const size_t o_ = (size_t)te[r] * T + (r == 0 ? pp.x : r == 1 ? pp.y : r == 2 ? pp.z : pp.w); RT[o_] = (int)tok; RW[o_] = tw[r]; }
        }
        __syncthreads();
        if (F.tid < 32) lcnt[F.tid] = 0u;
        __syncthreads();
    }
}

__device__ __forceinline__ void moe_table(const Ctx& F) {
    const unsigned* ECNT = (const unsigned*)(F.ws + WS_CTL) + CW_ECNT;
    LAS int* tab = (LAS int*)(F.lds + LDS_MOE);
    __syncthreads();
    if (F.tid == 0) {
        int acc = 0;
        for (int e = 0; e < NE; ++e) { const int c = (int)__hip_atomic_load(ECNT + e, __ATOMIC_RELAXED, __HIP_MEMORY_SCOPE_AGENT); tab[32 + e] = acc; acc += (c + 255) / 256 * 256; }
        tab[64] = acc; tab[0] = acc / 256;
    }
    __syncthreads();
    const int ntiles = tab[0];
    for (int i = F.tid; i < ntiles; i += 512) { int e = 0; for (int k = 1; k < NE; ++k) if (i * 256 >= tab[32 + k]) e = k; tab[128 + 2 * i] = e; tab[129 + 2 * i] = i - tab[32 + e] / 256; }
    __syncthreads();
}

__device__ __forceinline__ void ln_stats16(const float* st, int lane, float& mean, float& rstd) {
    float s1 = 0.f, s2 = 0.f;
    if (lane < 16) { const f32x2 p = *(const f32x2*)(st + 2 * lane); s1 = p.x; s2 = p.y; }
    s1 = wave_sum(s1); s2 = wave_sum(s2);
    mean = s1 * (1.f / DM); const float var = s2 * (1.f / DM) - mean * mean; rstd = 1.f / sqrtf(fmaxf(var, 0.f) + LN_EPS);
}
__device__ __forceinline__ void ph_final(const Ctx& F) {
    const Args& A = *F.a;
    const bf16_t* Z = (const bf16_t*)(F.ws + WS_Z); const float* ZST = (const float*)(F.ws + WS_ZST); const unsigned char* YS = F.ws + WS_YS; const int* TKE = (const int*)(F.ws + WS_TKE); const int* TKP = (const int*)(F.ws + WS_TKP);
    const LAS int* tab = (const LAS int*)(F.lds + LDS_MOE);
    const int gw = F.vcu * 8 + F.wave, NGW = F.G * 8;
    f32x4 g2[4], b2[4], g1[4], b1[4];
#pragma unroll
    for (int j = 0; j < 4; ++j) { g2[j] = *((const f32x4*)A.in[I_LNF_G] + F.lane + 64 * j); b2[j] = *((const f32x4*)A.in[I_LNF_B] + F.lane + 64 * j);
        g1[j] = *((const f32x4*)A.in[I_LNMIX_G] + F.lane + 64 * j) * ALPHA; b1[j] = *((const f32x4*)A.in[I_LNMIX_B] + F.lane + 64 * j) * ALPHA; }
    for (int m = gw; m < T; m += NGW) {
        float mean, rstd; ln_stats16(ZST + (size_t)m * 32, F.lane, mean, rstd);
        const u32x2* hr = (const u32x2*)(Z + (size_t)m * DM) + F.lane;
        f32x4 v[4];
#pragma unroll
        for (int j = 0; j < 4; ++j) { const u32x2 hb = hr[64 * j]; v[j] = ((f32x4){bflo(hb.x), bfhi(hb.x), bflo(hb.y), bfhi(hb.y)} - mean) * rstd * g1[j] + b1[j]; }
#pragma unroll
        for (int k = 0; k < 4; ++k) {
            const int row = tab[32 + TKE[(size_t)m * 4 + k]] + TKP[(size_t)m * 4 + k]; const unsigned* yr = (const unsigned*)(YS + (size_t)row * DM) + F.lane;
#pragma unroll
            for (int j = 0; j < 4; ++j) { const unsigned y = yr[64 * j]; const f32x2v f0 = __builtin_amdgcn_cvt_pk_f32_fp8((int)y, false), f1 = __builtin_amdgcn_cvt_pk_f32_fp8((int)y, true);
                v[j].x += 0.0625f * f0.x; v[j].y += 0.0625f * f0.y; v[j].z += 0.0625f * f1.x; v[j].w += 0.0625f * f1.y; }
        }
        float s = 0.f;
#pragma unroll
        for (int j = 0; j < 4; ++j) s += (v[j].x + v[j].y) + (v[j].z + v[j].w);
        const float mu = wave_sum(s) * (1.f / DM); float s2 = 0.f;
#pragma unroll
        for (int j = 0; j < 4; ++j) { v[j] = v[j] - mu; s2 += (v[j].x * v[j].x + v[j].y * v[j].y) + (v[j].z * v[j].z + v[j].w * v[j].w); }
        const float rs = 1.f / sqrtf(wave_sum(s2) * (1.f / DM) + LN_EPS);
        f32x4* orow = (f32x4*)(A.out + (size_t)m * DM) + F.lane;
#pragma unroll
        for (int j = 0; j < 4; ++j) orow[64 * j] = v[j] * rs * g2[j] + b2[j];
    }
}

#define XB_TMO      128
#define XB_XCNT(j)  (256  + 64 * (j))
#define XB_XSUB(j)  (1280 + 64 * (j))
#define XB_XGEN(j)  (2304 + 64 * (j))
#define XB_TOP      3328
#define XB_TOPGEN   3392
#define XCD_BAR_WORDS 3456
#define XB_SPIN_CAP (1u << 18)
__device__ __forceinline__ unsigned xb_ld(unsigned* p)              { return __hip_atomic_load(p, __ATOMIC_RELAXED, __HIP_MEMORY_SCOPE_AGENT); }
__device__ __forceinline__ unsigned xb_add(unsigned* p, unsigned v) { return __hip_atomic_fetch_add(p, v, __ATOMIC_RELAXED, __HIP_MEMORY_SCOPE_AGENT); }
__device__ __forceinline__ unsigned xb_xcc_id() { return (unsigned)__builtin_amdgcn_s_getreg((3 << 11) | 20) & 0xFu; }
#define XB_SPIN(cond, bar) do { unsigned _sp = 0; while (cond) { __builtin_amdgcn_s_sleep(1); \
    if ((++_sp & 255u) == 0u) { if (xb_ld(&(bar)[XB_TMO])) break; if (_sp > XB_SPIN_CAP) { atomicAdd(&(bar)[XB_TMO], 1u); break; } } } } while (0)
__device__ __forceinline__ void xcd_barrier_complete(unsigned* bar, unsigned x, unsigned& nloc, unsigned& nx) {
    const unsigned G = gridDim.x * gridDim.y * gridDim.z;
    unsigned sum, cnt, mine, sp = 0u;
    for (;;) {
        sum = 0u; cnt = 0u; mine = 0u;
#pragma unroll
        for (unsigned j = 0; j < 16; ++j) { const unsigned c = xb_ld(&bar[XB_XCNT(j)]); sum += c; cnt += (c > 0u) ? 1u : 0u; mine = (j == x) ? c : mine; }
        if (sum == G) break;
        __builtin_amdgcn_s_sleep(1);
        if ((++sp & 255u) == 0u) { if (xb_ld(&bar[XB_TMO])) break; if (sp > XB_SPIN_CAP) { atomicAdd(&bar[XB_TMO], 1u); break; } }
    }
    nloc = mine > 0u ? mine : 1u; nx = cnt > 0u ? cnt : 1u;
}
__device__ __forceinline__ void xcd_barrier(unsigned* bar, volatile LAS unsigned* st, unsigned x, bool leader_thread) {
    asm volatile("s_waitcnt vmcnt(0)" ::: "memory");
    __syncthreads();
    if (leader_thread) {
        __builtin_amdgcn_s_waitcnt(0);
        unsigned nloc = st[0], nx = st[1];
        if (nloc == 0u) { xcd_barrier_complete(bar, x, nloc, nx); st[0] = nloc; st[1] = nx; }
        const unsigned old = xb_add(&bar[XB_XSUB(x)], 1u);
        const unsigned gen = old / nloc;
        if (old + 1u == (gen + 1u) * nloc) {
            __builtin_amdgcn_fence(__ATOMIC_RELEASE, "agent");
            asm volatile("s_waitcnt vmcnt(0)" ::: "memory");
            const unsigned og = xb_add(&bar[XB_TOP], 1u);
            const unsigned tg = og / nx;
            if (og + 1u == (tg + 1u) * nx) xb_add(&bar[XB_TOPGEN], 1u);
            else XB_SPIN(xb_ld(&bar[XB_TOPGEN]) == tg, bar);
            __builtin_amdgcn_fence(__ATOMIC_ACQUIRE, "agent");
            xb_add(&bar[XB_XGEN(x)], 1u);
            asm volatile("s_waitcnt vmcnt(0)" ::: "memory");
        } else {
            XB_SPIN(xb_ld(&bar[XB_XGEN(x)]) == gen, bar);
            __builtin_amdgcn_fence(__ATOMIC_ACQUIRE, "agent");
            asm volatile("s_waitcnt vmcnt(0)" ::: "memory");
        }
    }
    __syncthreads();
}

template <bool COOP>
__global__ void __launch_bounds__(512, 2) mega(Args args) {
    extern __shared__ __attribute__((aligned(16))) unsigned char lds_raw[];
    Ctx F;
    const int wave0 = __builtin_amdgcn_readfirstlane(threadIdx.x >> 6);
#define MKCTX() do { F.a = &args; F.ws = args.ws; F.lds = (LAS unsigned char*)lds_raw; F.ldsg = lds_raw; F.lane = lane_id_asm(); F.wave = wave0; F.tid = wave0 * 64 + F.lane; \
    F.G = gridDim.x; { const int bx = blockIdx.x; F.vcu = (F.G % 8 == 0) ? (bx % 8) * (F.G / 8) + bx / 8 : bx; } } while (0)
    MKCTX();
    const int lo = args.ph_lo, hi = args.ph_hi;
    unsigned char* ws = args.ws;
#ifndef PHMASK
#define PHMASK 0xFFFF
#endif
#define IN(k) (((PHMASK >> (k)) & 1) && lo <= (k) && (k) < hi)
    unsigned* barw = (unsigned*)(ws + WS_CTL) + CW_BAR; volatile LAS unsigned* bst = (volatile LAS unsigned*)((LAS unsigned char*)lds_raw + LDS_BYTES - 64);
    const unsigned my_xcc = xb_xcc_id();
    if (COOP) { if (threadIdx.x == 0) { bst[0] = 0u; bst[1] = 0u; (void)xb_add(&barw[XB_XCNT(my_xcc)], 1u); } __syncthreads(); }
#define SEAM(k) do { if (COOP && IN(k) && IN((k) + 1)) { if (args.ph_hi > 1000) cg::this_grid().sync();   xcd_barrier(barw, bst, my_xcc, wave0 == 0 && lane_id_asm() == 0); } } while (0)
    if (IN(0)) { MKCTX(); ph_prologue(F); } SEAM(0);
    if (IN(1)) {
        {
            pg8::Gemm g{(const bf16_t*)(ws + WS_H0), (const bf16_t*)(ws + WS_WIN), DM, DM, DM, nullptr}; pg8::StaticOrder S; S.init(T, (PN8_LO + 28 - PN8_HI) * 256, F.G, (int)blockIdx.x, 0, PN8_LO, PN8_HI - PN8_LO);
            const pg8::Epi1 E{(bf16_t*)(ws + WS_YAB), (bf16_t*)(ws + WS_GV), ws + WS_Q, ws + WS_K, ws + WS_V, (bf16_t*)(ws + WS_SA), (bf16_t*)(ws + WS_SB), (float*)(ws + WS_GVST), (float*)(ws + WS_KMEAN), 1.0f, 0.f};
            pg8::gemm_phase<pg8::Epi1, pg8::StaticOrder, true>(F.lds, g, S, E, wave0);
        }
        {
            const pg8::Epi1 E{(bf16_t*)(ws + WS_YAB), (bf16_t*)(ws + WS_GV), ws + WS_Q, ws + WS_K, ws + WS_V, (bf16_t*)(ws + WS_SA), (bf16_t*)(ws + WS_SB), (float*)(ws + WS_GVST), (float*)(ws + WS_KMEAN), 0.03125f, 0.f};
            pg8::Gemm g{(const bf16_t*)(ws + WS_H0F8), (const bf16_t*)(ws + WS_WIN8), DM / 2, DM / 2, DM / 2, nullptr}; pg8::StaticOrder S; S.init(T, (PN8_HI - PN8_LO) * 256, F.G, (int)blockIdx.x, PN8_LO);
            pg8::gemm_phase<pg8::Epi1, pg8::StaticOrder, true, true>(F.lds, g, S, E, wave0);
        }
    } SEAM(1);
    if (IN(2)) { MKCTX(); ph_mixer_a(F); __syncthreads(); ph_gate(F); } SEAM(2);
    if (IN(3)) { } if (COOP && IN(3) && IN(4)) { }
    if (IN(4)) { MKCTX(); ph_attn_partial(F); } SEAM(4);
    if (IN(5)) { MKCTX(); ph_attn_own(F); } SEAM(5);
    if (IN(6)) {
        pg8::Gemm g{(const bf16_t*)(ws + WS_YAB), (const bf16_t*)(ws + WS_WAB), 2048, 2048, 2048, nullptr}; pg8::StaticOrder S; S.init(T, DM, F.G, (int)blockIdx.x);
        pg8::Epi2 E{ws + WS_SA, ws + WS_SB, (bf16_t*)(ws + WS_MG)};
        pg8::gemm_phase<pg8::Epi2, pg8::StaticOrder, true>(F.lds, g, S, E, wave0);
    } SEAM(6);
    if (IN(7)) {
        pg8::Gemm g{(const bf16_t*)(ws + WS_MG), (const bf16_t*)(ws + WS_WOUT), DM, DM, DM, nullptr}; pg8::StaticOrder S; S.init(T, DM, F.G, (int)blockIdx.x);
        pg8::Epi3 E{(const bf16_t*)(ws + WS_H0), (bf16_t*)(ws + WS_Z), (float*)(ws + WS_ZST)};
        pg8::gemm_phase<pg8::Epi3, pg8::StaticOrder, true>(F.lds, g, S, E, wave0);
    } SEAM(7);
    if (IN(8)) { MKCTX(); ph_router(F); } SEAM(8);
    if (IN(9)) { } if (COOP && IN(9) && IN(10)) { }
    if (IN(10)) {
        MKCTX(); moe_table(F);
        pg8::Gemm g{(const bf16_t*)(ws + WS_H1F8), (const bf16_t*)(ws + WS_WUP), DM / 2, DM / 2, DM / 2, (const int*)(ws + WS_RT)}; pg8::MoeOrder S;   S.init((const LAS int*)(F.lds + LDS_MOE), 8, F.G, (int)blockIdx.x);
        pg8::Epi4 E{args.in[I_BUP], ws + WS_ACT};
        pg8::gemm_phase<pg8::Epi4, pg8::MoeOrder, true, true, true>(F.lds, g, S, E, wave0);
    } SEAM(10);
    if (IN(11)) {
        MKCTX(); moe_table(F);
        pg8::Gemm g{(const bf16_t*)(ws + WS_ACT), (const bf16_t*)(ws + WS_WDN), FF / 2, FF / 2, FF / 2, nullptr}; pg8::MoeOrder S; S.init((const LAS int*)(F.lds + LDS_MOE), 4, F.G, (int)blockIdx.x);
        pg8::Epi5 E{args.in[I_BDN], (const float*)(ws + WS_RW), ws + WS_YS};
        pg8::gemm_phase<pg8::Epi5, pg8::MoeOrder, true, true>(F.lds, g, S, E, wave0);
    } SEAM(11);
    if (IN(12)) { MKCTX(); moe_table(F); ph_final(F); }
#undef IN
#undef SEAM
}

extern "C" void kernel_launch(void* const* d_in, const int* in_sizes, int n_in, void* d_out, int out_size, void* d_ws, size_t ws_size, hipStream_t stream) {
    static int grid = 0;
    if (grid == 0) {
        if (n_in != 21 || in_sizes[0] != T * DM || out_size != T * DM || ws_size < WS_END) { fprintf(stderr, "kernel_launch: unexpected shapes (n_in %d, in0 %d, out %d, ws %zu)\n", n_in, n_in > 0 ? in_sizes[0] : -1, out_size, ws_size); grid = -1; return; }
        int dev = 0, cus = 0, per_cu = 0;
        hipGetDevice(&dev); hipDeviceGetAttribute(&cus, hipDeviceAttributeMultiprocessorCount, dev);
        const void* fn = MK_COOP ? (const void*)mega<true> : (const void*)mega<false>;
        hipFuncSetAttribute(fn, hipFuncAttributeMaxDynamicSharedMemorySize, LDS_BYTES);
        hipOccupancyMaxActiveBlocksPerMultiprocessor(&per_cu, fn, 512, LDS_BYTES);
        (void)hipGetLastError();
        if (per_cu < 1) { fprintf(stderr, "kernel_launch: occupancy query says %d blocks/CU\n", per_cu); per_cu = 1; }
        grid = cus * 1;
    }
    if (grid < 0) return;
    hipMemsetAsync((char*)d_ws + WS_CTL, 0, CTL_ZERO_BYTES, stream);
    Args a{};
    for (int i = 0; i < 21; ++i) a.in[i] = (const float*)d_in[i];
    a.out = (float*)d_out; a.ws = (unsigned char*)d_ws;
#if MK_COOP
    a.ph_lo = 0; a.ph_hi = NPHASE;
    void* kargs[] = {&a};
    hipError_t e = hipLaunchCooperativeKernel((const void*)mega<true>, dim3(grid), dim3(512), kargs, LDS_BYTES, stream);
    if (e != hipSuccess) fprintf(stderr, "cooperative launch failed: %s (grid %d)\n", hipGetErrorString(e), grid);
#else
    for (int p = 0; p < NPHASE; ++p) { a.ph_lo = p; a.ph_hi = p + 1; hipLaunchKernelGGL(mega<false>, dim3(grid), dim3(512), LDS_BYTES, stream, a); }
#endif
}
```

```cpp
#include <hip/hip_runtime.h>
#include <hip/hip_cooperative_groups.h>
#include <cstdio>
#include <cstdint>
namespace cg = cooperative_groups;

#ifndef MK_COOP
#define MK_COOP 1
#endif

#define LAS __attribute__((address_space(3)))
typedef unsigned short bf16_t;
typedef short bf16x8 __attribute__((ext_vector_type(8)));
typedef float f32x4 __attribute__((ext_vector_type(4)));
typedef float f32x2 __attribute__((ext_vector_type(2)));
typedef unsigned u32x4 __attribute__((ext_vector_type(4)));
typedef unsigned u32x2 __attribute__((ext_vector_type(2)));

constexpr int NB = 8, SEQ = 4096, DM = 1024, T = NB * SEQ;
constexpr int NH = 8, DH = 128, LBLK = 256, NBLK = SEQ / LBLK;
constexpr int NE = 32, TOPK = 4, FF = 1024;
constexpr int INCOLS = 7 * DM;
constexpr int RMAX = T * TOPK + NE * 256;
constexpr float LN_EPS = 1e-5f;
constexpr float ALPHA = 1.189207115002721f;
constexpr float QSCALE = 0.08838834764831845f * 1.4426950408889634f;

constexpr size_t MiB = 1u << 20, U64 = 64 * MiB;
constexpr size_t WS_CTL = 0, CTL_ZERO_BYTES = 1 * MiB;
constexpr int CW_ECNT = 64;
constexpr int CW_LCNT = 1024;
constexpr int CW_BAR = 4096;
constexpr size_t WS_KMEAN = 1 * MiB;
constexpr size_t WS_GVST = 2 * MiB;
constexpr size_t WS_ZST = 6 * MiB;
constexpr size_t WS_SEL = 10 * MiB;
constexpr size_t WS_TKE = 11 * MiB;
constexpr size_t WS_TKW = 11 * MiB + 512 * 1024;
constexpr size_t WS_TKP = 12 * MiB;
constexpr size_t WS_ROWOF = 12 * MiB + 512 * 1024;
constexpr size_t WS_ROWTOK = 13 * MiB;
constexpr size_t WS_ROWW = 14 * MiB;
constexpr size_t WS_TILE = 15 * MiB;
constexpr size_t WS_LISTS = 16 * MiB;
constexpr size_t WS_LSE = 32 * MiB;
constexpr size_t WS_RT = 16 * MiB;
constexpr size_t WS_RW = 20 * MiB;
constexpr int LDS_MOE = 131072 + 1024;
constexpr size_t WS_WIN = 40 * MiB;
constexpr size_t WS_WAB = 54 * MiB;
constexpr size_t WS_WOUT = 58 * MiB;
constexpr size_t WS_WDN = 60 * MiB;
constexpr size_t WS_WUP = 124 * MiB;
constexpr size_t WS_H0 = 4 * U64;
constexpr size_t WS_YAB = 5 * U64;
constexpr size_t WS_GV = 7 * U64;
constexpr size_t WS_Q = 8 * U64, WS_K = 9 * U64, WS_V = 10 * U64, WS_SA = 11 * U64, WS_SB = 12 * U64;
constexpr size_t WS_OP = 13 * U64;
constexpr size_t WS_MG = WS_GV;
constexpr size_t WS_Z = 14 * U64;
constexpr size_t WS_H1 = WS_H0;
constexpr size_t WS_XG = 5 * U64;
constexpr size_t WS_H1F8 = 12 * U64;
constexpr size_t WS_ACT = 9 * U64 + 16 * MiB;
constexpr size_t WS_YS = WS_XG;
constexpr size_t WS_H0F8 = 13 * U64;
constexpr size_t WS_WIN8 = 192 * MiB;
constexpr int PN8_LO = 8, PN8_HI = 28;
constexpr size_t WS_END = 16 * U64;
static_assert(WS_XG + (size_t)RMAX * 2048 <= WS_ACT && WS_ACT + (size_t)RMAX * 2048 <= WS_Z, "ws map");

constexpr int LDS_BYTES = 163840;
constexpr int LDS_MISC = 131072;
constexpr int NPHASE = 13;

__device__ __forceinline__ float bf2f(bf16_t v) { return __uint_as_float((unsigned)v << 16); }
__device__ __forceinline__ float bflo(unsigned u) { return __uint_as_float(u << 16); }
__device__ __forceinline__ float bfhi(unsigned u) { return __uint_as_float(u & 0xffff0000u); }
__device__ __forceinline__ unsigned f2bf(float f) { unsigned u = __builtin_bit_cast(unsigned, f); return (u + 0x7fffu + ((u >> 16) & 1u)) >> 16; }
__device__ __forceinline__ unsigned pk2(float lo, float hi) { return f2bf(lo) | (f2bf(hi) << 16); }
typedef __bf16 bf16x2_t __attribute__((ext_vector_type(2)));
__device__ __forceinline__ unsigned cvt_pk_bf16(float lo, float hi) { f32x2 v = {lo, hi}; bf16x2_t b = __builtin_convertvector(v, bf16x2_t); return __builtin_bit_cast(unsigned, b); }
__device__ __forceinline__ int lane_id_asm() { int l; asm volatile("v_mbcnt_lo_u32_b32 %0, -1, 0\n\tv_mbcnt_hi_u32_b32 %0, -1, %0" : "=v"(l)); return l; }
__device__ __forceinline__ float wave_sum(float v) {
#pragma unroll
    for (int o = 1; o < 64; o <<= 1) v += __shfl_xor(v, o);
    return v;
}
__device__ __forceinline__ float wave_max(float v) {
#pragma unroll
    for (int o = 1; o < 64; o <<= 1) v = fmaxf(v, __shfl_xor(v, o));
    return v;
}
__device__ __forceinline__ f32x2 gelu_pk(f32x2 v) {
    const f32x2 av = __builtin_elementwise_abs(v), d = av * 0.2316418882f + 1.0f;
    f32x2 t; t.x = __builtin_amdgcn_rcpf(d.x); t.y = __builtin_amdgcn_rcpf(d.y);
    f32x2 q = t * 0.5307027145f + (-0.7265760135f); q = q * t + 0.7107068705f; q = q * t + (-0.142248368f); q = q * t + 0.127414796f; q = q * t;
    const f32x2 s = (v * v) * (-0.72134752044f);
    f32x2 e; e.x = __builtin_amdgcn_exp2f(s.x); e.y = __builtin_amdgcn_exp2f(s.y);
    const f32x2 m = v * (q * e), r = v - m;
    f32x2 o; o.x = v.x < 0.f ? m.x : r.x; o.y = v.y < 0.f ? m.y : r.y; return o;
}
typedef float f32x2v __attribute__((ext_vector_type(2)));
template <bool HI> __device__ __forceinline__ unsigned f8x2_to_bf16x2(unsigned w) { const f32x2v f = __builtin_amdgcn_cvt_pk_f32_fp8((int)w, HI); return cvt_pk_bf16(f.x, f.y); }
__device__ __forceinline__ u32x4 f8x8_to_bf16x8(unsigned lo, unsigned hi) { return (u32x4){f8x2_to_bf16x2<false>(lo), f8x2_to_bf16x2<true>(lo), f8x2_to_bf16x2<false>(hi), f8x2_to_bf16x2<true>(hi)}; }
__device__ __forceinline__ unsigned pack_fp8x4(float a, float b, float c, float d) { unsigned w = 0u; w = __builtin_amdgcn_cvt_pk_fp8_f32(a, b, w, false); w = __builtin_amdgcn_cvt_pk_fp8_f32(c, d, w, true); return w; }
__device__ __forceinline__ float sigmoidf_(float x) { return __builtin_amdgcn_rcpf(1.0f + __builtin_amdgcn_exp2f(-1.4426950408889634f * x)); }

namespace pg8 {
constexpr int BM = 256, BK = 64, HALF = 128, HTB = HALF * BK * 2, STAGE_BYTES = 8 * HTB, NXCD = 8, WGM = 8;
__host__ __device__ __forceinline__ int lds_byte(int r, int c) { const int st = (r >> 4) * 2 + (c >> 5), rr = r & 15, cc = c & 31, ob = rr * 64 + cc * 2; return st * 1024 + (ob ^ (((ob >> 9) & 1) << 5)); }
__host__ __device__ __forceinline__ void stage_rc(int b, int& R, int& C) { const int st = b / 1024, sb = b % 1024, swz = sb ^ (((sb >> 9) & 1) << 5); R = (st >> 1) * 16 + swz / 64; C = (st & 1) * 32 + (swz % 64) / 2; }
__host__ __device__ __forceinline__ int perm32(int rho) { const int n = rho >> 4, i = rho & 15; return 8 * (i >> 2) + 4 * n + (i & 3); }

struct Unit { int pm, pn, bt, rbase; };
struct Gemm { const bf16_t* A; const bf16_t* Bt; int K, lda, ldb; const int* rowidx; };

struct StaticOrder {
    int nM, nN, nwg, G, c, pbase, psplit, pjump;
    __device__ void init(int M, int N, int G_, int c_, int pbase_ = 0, int psplit_ = 1 << 20, int pjump_ = 0) { nM = M / BM; nN = N / BM; nwg = nM * nN; G = G_; c = c_; pbase = pbase_; psplit = psplit_; pjump = pjump_; }
    __device__ bool next(int i, Unit& u) const {
        const long L = (long)i * G + c; if (L >= nwg) return false;
        int wgid = (int)L; { const int q = nwg / NXCD, r = nwg % NXCD, xcd = wgid % NXCD, off = wgid / NXCD; wgid = (xcd < r ? xcd * (q + 1) : r * (q + 1) + (xcd - r) * q) + off; }
        const int nig = WGM * nN, gid = wgid / nig, fm = gid * WGM, gsz = (nM - fm) < WGM ? (nM - fm) : WGM;
        u.pm = fm + ((wgid % nig) % gsz); const int p = (wgid % nig) / gsz; u.pn = pbase + (p < psplit ? p : p + pjump); u.bt = u.pn; u.rbase = u.pm * BM; return true;
    }
};
struct MoeOrder {
    int nM, nN, nwg, G, c; const LAS int* tab;
    __device__ void init(const LAS int* tiletab, int nN_, int G_, int c_) { nM = tiletab[0]; tab = tiletab; nN = nN_; nwg = nM * nN; G = G_; c = c_; }
    __device__ bool next(int i, Unit& u) const {
        const long L = (long)i * G + c; if (L >= nwg) return false;
        int wgid = (int)L; { const int q = nwg / NXCD, r = nwg % NXCD, xcd = wgid % NXCD, off = wgid / NXCD; wgid = (xcd < r ? xcd * (q + 1) : r * (q + 1) + (xcd - r) * q) + off; }
        const int nig = WGM * nN, gid = wgid / nig, fm = gid * WGM, gsz = (nM - fm) < WGM ? (nM - fm) : WGM;
        u.pm = fm + ((wgid % nig) % gsz); u.pn = (wgid % nig) / gsz; { const int e = tab[128 + 2 * u.pm], tl = tab[129 + 2 * u.pm]; u.bt = e * nN + u.pn; u.rbase = e * T + tl * BM; } return true;
    }
};

typedef int v4i_t __attribute__((ext_vector_type(4)));
typedef int v8i_t __attribute__((ext_vector_type(8)));
template <class Epi, class Sched, bool ALIGN_EPI, bool FP8 = false, bool GATHER = false>
__device__ __forceinline__ void gemm_phase(LAS unsigned char* lds, const Gemm g, const Sched& S, const Epi& E, const int wid) {
    const int lane = lane_id_asm(), tid = wid * 64 + lane;
    const int wr = wid >> 2, wc = wid & 3, fr = lane & 15, fq = lane >> 4;
    const int nt = g.K / BK;
    unsigned voffA[2], voffB[2]; int gR[2];
#pragma unroll
    for (int i = 0; i < 2; ++i) { int R, C; stage_rc(tid * 16 + i * 8192, R, C); const int Rb = Epi::PERM ? ((R & ~31) + perm32(R & 31)) : R;
        voffA[i] = GATHER ? (unsigned)C * 2u : (unsigned)(R * g.lda + C) * 2u; voffB[i] = (unsigned)(Rb * g.ldb + C) * 2u; gR[i] = R; }
    const size_t kstep = (size_t)(BK * 2);
    const size_t hstepA = GATHER ? 0 : (size_t)HALF * g.lda * 2, hstepB = (size_t)HALF * g.ldb * 2;
    const size_t tstepA = 2 * hstepA, tstepB = 2 * hstepB;
    const unsigned ldsw = (unsigned)wid * 1024u;
    const int aoff = lds_byte(wr * 64 + fr, fq * 8), boff = lds_byte(wc * 32 + fr, fq * 8);
#define PG8_SA(b, h) (((b) * 2 + (h)) * HTB)
#define PG8_SB(b, h) ((4 + (b) * 2 + (h)) * HTB)
#define PG8_STAGE(bufoff, gbase, voff) do { _Pragma("unroll") for (int _i = 0; _i < 2; ++_i) \
        __builtin_amdgcn_global_load_lds((const unsigned*)((const char*)(gbase) + (voff)[_i]), (LAS unsigned*)(lds + (bufoff) + ldsw + _i * 8192), 16, 0, 0); } while (0)
#define PG8_LD8(p) __builtin_shufflevector(*(const LAS v4i_t*)(p), *(const LAS v4i_t*)((p) + 1024), 0, 1, 2, 3, 4, 5, 6, 7)
#define PG8_LDA(dst, b, h) do { _Pragma("unroll") for (int m = 0; m < 4; ++m) { if constexpr (FP8) dst##8[m] = PG8_LD8(lds + PG8_SA(b, h) + aoff + m * 2048); \
        else { _Pragma("unroll") for (int k = 0; k < 2; ++k) dst[m][k] = *(const LAS bf16x8*)(lds + PG8_SA(b, h) + aoff + m * 2048 + k * 1024); } } } while (0)
#define PG8_LDB(dst, b, h) do { _Pragma("unroll") for (int n = 0; n < 2; ++n) { if constexpr (FP8) dst##8[n] = PG8_LD8(lds + PG8_SB(b, h) + boff + n * 2048); \
        else { _Pragma("unroll") for (int k = 0; k < 2; ++k) dst[n][k] = *(const LAS bf16x8*)(lds + PG8_SB(b, h) + boff + n * 2048 + k * 1024); } } } while (0)
#define PG8_MMA(ai, bj, At, Bt) do { __builtin_amdgcn_s_setprio(1); _Pragma("unroll") for (int m = 0; m < 4; ++m) _Pragma("unroll") for (int n = 0; n < 2; ++n) { \
        if constexpr (FP8) { asm volatile("s_nop 1\n\tv_mfma_scale_f32_16x16x128_f8f6f4 %0, %1, %2, %0, %3, %3 op_sel_hi:[0,0,0]" : "+v"(acc[ai][bj][m][n]) : "v"(Bt##8[n]), "v"(At##8[m]), "v"(scl8)); } \
        else { _Pragma("unroll") for (int k = 0; k < 2; ++k) acc[ai][bj][m][n] = __builtin_amdgcn_mfma_f32_16x16x32_bf16(Bt[n][k], At[m][k], acc[ai][bj][m][n], 0, 0, 0); } } \
        __builtin_amdgcn_s_setprio(0); } while (0)
#define PG8_WAIT_V(n) asm volatile("s_waitcnt vmcnt(" #n ")" ::: "memory")
#define PG8_WAIT_L(n) asm volatile("s_waitcnt lgkmcnt(" #n ")" ::: "memory")
#define PG8_BAR __builtin_amdgcn_s_barrier()
#define PG8_SCHED __builtin_amdgcn_sched_barrier(0)
    Unit cur, nxt; int ui = 0;
    if (!S.next(0, cur)) return;
    unsigned va0[2], va1[2], vn0[2], vn1[2];
#define PG8_GIDX(dst0, dst1, u) do { if constexpr (GATHER) { _Pragma("unroll") for (int _i = 0; _i < 2; ++_i) { \
        dst0[_i] = min((unsigned)g.rowidx[(u).rbase + gR[_i]], (unsigned)(T - 1)) * (unsigned)(g.lda * 2) + voffA[_i]; dst1[_i] = min((unsigned)g.rowidx[(u).rbase + HALF + gR[_i]], (unsigned)(T - 1)) * (unsigned)(g.lda * 2) + voffA[_i]; } } \
        else { _Pragma("unroll") for (int _i = 0; _i < 2; ++_i) { dst0[_i] = voffA[_i]; dst1[_i] = voffA[_i]; } } } while (0)
    PG8_GIDX(va0, va1, cur);
    f32x4 acc[2][2][4][2];
#pragma unroll
    for (int a = 0; a < 2; ++a)
#pragma unroll
        for (int b = 0; b < 2; ++b)
#pragma unroll
            for (int m = 0; m < 4; ++m)
#pragma unroll
                for (int n = 0; n < 2; ++n) acc[a][b][m][n] = (f32x4){0.f, 0.f, 0.f, 0.f};
    bf16x8 At[4][2], B0[2][2], B1[2][2]; v8i_t At8[4], B08[2], B18[2];
    int scl8 = 0x7f7f7f7f; asm volatile("" : "+v"(scl8));
    const char* cA = (const char*)g.A + (GATHER ? 0 : (size_t)cur.pm * tstepA); const char* cB = (const char*)g.Bt + (size_t)cur.bt * tstepB;
    PG8_STAGE(PG8_SB(0, 0), cB, voffB); PG8_STAGE(PG8_SB(0, 1), cB + hstepB, voffB); PG8_STAGE(PG8_SA(0, 0), cA, va0); PG8_STAGE(PG8_SA(0, 1), cA + hstepA, va1);
    if (wr == 1) PG8_BAR;
    PG8_WAIT_V(2); PG8_BAR;
    PG8_STAGE(PG8_SB(1, 0), cB + kstep, voffB); PG8_STAGE(PG8_SA(1, 0), cA + kstep, va0); PG8_STAGE(PG8_SB(1, 1), cB + hstepB + kstep, voffB);
    PG8_WAIT_V(6); PG8_BAR;
    for (;;) {
        const bool has_next = S.next(ui + 1, nxt);
        const char* nA = (has_next && !GATHER) ? (const char*)g.A + (size_t)nxt.pm * tstepA : cA; const char* nB = has_next ? (const char*)g.Bt + (size_t)nxt.bt * tstepB : cB;
        if (has_next) PG8_GIDX(vn0, vn1, nxt); else { _Pragma("unroll") for (int _i = 0; _i < 2; ++_i) { vn0[_i] = va0[_i]; vn1[_i] = va1[_i]; } }
#pragma unroll 1
        for (int t = 0; t < nt; t += 2) {
            const bool last = (t == nt - 2);
            const char* a1 = cA + (size_t)(t + 1) * kstep;
            const char* a2 = last ? nA : cA + (size_t)(t + 2) * kstep; const char* b2 = last ? nB : cB + (size_t)(t + 2) * kstep;
            const char* a3 = a2 + kstep; const char* b3 = b2 + kstep;
            if constexpr (Epi::MID_T > 0) { if (t == Epi::MID_T) E.mid(acc, cur, wr, wc, fr, fq); }
            unsigned vs0[2], vs1[2];
#pragma unroll
            for (int _i = 0; _i < 2; ++_i) { vs0[_i] = last ? vn0[_i] : va0[_i]; vs1[_i] = last ? vn1[_i] : va1[_i]; }
            PG8_LDB(B0, 0, 0); PG8_LDB(B1, 0, 1); PG8_SCHED; PG8_LDA(At, 0, 0); PG8_STAGE(PG8_SA(1, 1), a1 + hstepA, va1);
            PG8_WAIT_V(8); PG8_WAIT_L(0); PG8_BAR; PG8_MMA(0, 0, At, B0); PG8_MMA(0, 1, At, B1); PG8_BAR; PG8_SCHED;
            PG8_LDA(At, 0, 1); PG8_STAGE(PG8_SB(0, 0), b2, voffB); PG8_STAGE(PG8_SB(0, 1), b2 + hstepB, voffB); PG8_STAGE(PG8_SA(0, 0), a2, vs0);
            PG8_WAIT_V(8); PG8_WAIT_L(0); PG8_BAR; PG8_MMA(1, 0, At, B0); PG8_MMA(1, 1, At, B1); PG8_BAR; PG8_SCHED;
            PG8_LDB(B0, 1, 0); PG8_LDB(B1, 1, 1); PG8_SCHED; PG8_LDA(At, 1, 0); PG8_STAGE(PG8_SA(0, 1), a2 + hstepA, vs1);
            PG8_WAIT_V(8); PG8_WAIT_L(0); PG8_BAR; PG8_MMA(0, 0, At, B0); PG8_MMA(0, 1, At, B1); PG8_BAR; PG8_SCHED;
            PG8_LDA(At, 1, 1); PG8_STAGE(PG8_SB(1, 0), b3, voffB); PG8_STAGE(PG8_SB(1, 1), b3 + hstepB, voffB); PG8_STAGE(PG8_SA(1, 0), a3, vs0);
            PG8_WAIT_V(8); PG8_WAIT_L(0); PG8_BAR; PG8_MMA(1, 0, At, B0); PG8_MMA(1, 1, At, B1); PG8_BAR; PG8_SCHED;
        }
        if constexpr (ALIGN_EPI) { if (wr == 0) PG8_BAR; }
        if constexpr (FP8) {
#pragma unroll
            for (int a = 0; a < 2; ++a)
#pragma unroll
                for (int b = 0; b < 2; ++b)
                    asm volatile("s_nop 15\n\ts_nop 7" : "+v"(acc[a][b][0][0]), "+v"(acc[a][b][0][1]), "+v"(acc[a][b][1][0]), "+v"(acc[a][b][1][1]), "+v"(acc[a][b][2][0]), "+v"(acc[a][b][2][1]), "+v"(acc[a][b][3][0]), "+v"(acc[a][b][3][1]));
        }
        E(acc, cur, wr, wc, fr, fq);
        if (!has_next) break;
#pragma unroll
        for (int a = 0; a < 2; ++a)
#pragma unroll
            for (int b = 0; b < 2; ++b)
#pragma unroll
                for (int m = 0; m < 4; ++m)
#pragma unroll
                    for (int n = 0; n < 2; ++n) acc[a][b][m][n] = (f32x4){0.f, 0.f, 0.f, 0.f};
        cur = nxt; cA = nA; cB = nB; ++ui;
#pragma unroll
        for (int _i = 0; _i < 2; ++_i) { va0[_i] = vn0[_i]; va1[_i] = vn1[_i]; }
        if constexpr (ALIGN_EPI) { if (wr == 1) PG8_BAR; }
    }
    PG8_WAIT_V(0);
    if constexpr (!ALIGN_EPI) { if (wr == 0) PG8_BAR; }
    PG8_BAR;
#undef PG8_SA
#undef PG8_SB
#undef PG8_STAGE
#undef PG8_GIDX
#undef PG8_LDA
#undef PG8_LDB
#undef PG8_MMA
#undef PG8_LD8
#undef PG8_WAIT_V
#undef PG8_WAIT_L
#undef PG8_BAR
#undef PG8_SCHED
}

typedef f32x4 Acc[2][2][4][2];

__device__ __forceinline__ u32x4 pair16(u32x2 x, u32x2 y) {
    const auto r0 = __builtin_amdgcn_permlane16_swap(x.x, y.x, false, false);
    const auto r1 = __builtin_amdgcn_permlane16_swap(x.y, y.y, false, false);
    return (u32x4){r0[0], r1[0], r0[1], r1[1]};
}
struct Epi1 {
    static constexpr bool PERM = true; static constexpr int MID_T = 0;
    bf16_t *yab, *gv; unsigned char *q, *k, *v; bf16_t *sa, *sb; float* gvst; float* kmp; float sc, pad_;
    template <int MODE  >
    __device__ __forceinline__ void run(const Acc& acc, const Unit& u, int wr, int wc, int fr, int fq, bf16_t* base, int ld) const {
        const int row0 = u.pm * BM + wr * 64 + fr, col0 = (u.pn & 3) * 256 + wc * 32 + 8 * fq;
        const int colp = (u.pn & 3) * 256 + wc * 32 + 8 * (fq & ~1);
        f32x4 csA0 = {0.f, 0.f, 0.f, 0.f}, csB0 = csA0, csA1 = csA0, csB1 = csA0;
#pragma unroll
        for (int ai = 0; ai < 2; ++ai)
#pragma unroll
            for (int mp = 0; mp < 2; ++mp) {
                u32x2 pc[2][2];
#pragma unroll
                for (int k = 0; k < 2; ++k) {
                    const int m = 2 * mp + k;
                    const int row = row0 + ai * HALF + m * 16; bf16_t* rowp = base + (size_t)row * ld + col0;
                    float s1 = 0.f, s2 = 0.f;
#pragma unroll
                    for (int bj = 0; bj < 2; ++bj) {
                        f32x4 v0 = acc[ai][bj][m][0], v1 = acc[ai][bj][m][1];
                        if (MODE == 2 || MODE == 3 || MODE == 5) {
                            const float f = (MODE == 2) ? sc * QSCALE : sc; v0 = v0 * f; v1 = v1 * f;
                            if (MODE == 5) { if (bj == 0) { csA0 = csA0 + v0; csB0 = csB0 + v1; } else { csA1 = csA1 + v0; csB1 = csB1 + v1; } }
                            pc[bj][k] = (u32x2){pack_fp8x4(v0[0], v0[1], v0[2], v0[3]), pack_fp8x4(v1[0], v1[1], v1[2], v1[3])};
                            continue;
                        }
                        if (MODE == 0 || MODE == 1) {
                            f32x2 a = gelu_pk((f32x2){v0[0], v0[1]}), b = gelu_pk((f32x2){v0[2], v0[3]}), c = gelu_pk((f32x2){v1[0], v1[1]}), d = gelu_pk((f32x2){v1[2], v1[3]});
                            v0 = (f32x4){a.x, a.y, b.x, b.y}; v1 = (f32x4){c.x, c.y, d.x, d.y};
                        } else if (MODE == 4) {
                            { const float cs_ = -1.4426950408889634f * sc; const f32x4 t0 = v0 * cs_, t1 = v1 * cs_; f32x4 e0, e1;
#pragma unroll
                              for (int j = 0; j < 4; ++j) { e0[j] = __builtin_amdgcn_exp2f(t0[j]); e1[j] = __builtin_amdgcn_exp2f(t1[j]); }
                              e0 = e0 + 1.0f; e1 = e1 + 1.0f;
#pragma unroll
                              for (int j = 0; j < 4; ++j) { v0[j] = __builtin_amdgcn_rcpf(e0[j]); v1[j] = __builtin_amdgcn_rcpf(e1[j]); } }
                            pc[bj][k] = (u32x2){pack_fp8x4(v0[0], v0[1], v0[2], v0[3]), pack_fp8x4(v1[0], v1[1], v1[2], v1[3])};
                            continue;
                        }
                        if (MODE == 1) {
                            s1 += (v0[0] + v0[1]) + (v0[2] + v0[3]) + (v1[0] + v1[1]) + (v1[2] + v1[3]);
                            s2 += (v0[0] * v0[0] + v0[1] * v0[1]) + (v0[2] * v0[2] + v0[3] * v0[3]) + (v1[0] * v1[0] + v1[1] * v1[1]) + (v1[2] * v1[2] + v1[3] * v1[3]);
                            pc[bj][k] = (u32x2){pack_fp8x4(v0[0], v0[1], v0[2], v0[3]), pack_fp8x4(v1[0], v1[1], v1[2], v1[3])};
                            continue;
                        }
                        u32x4 w; w.x = cvt_pk_bf16(v0[0], v0[1]); w.y = cvt_pk_bf16(v0[2], v0[3]); w.z = cvt_pk_bf16(v1[0], v1[1]); w.w = cvt_pk_bf16(v1[2], v1[3]);
                        *(u32x4*)(rowp + bj * HALF) = w;
                    }
                    if (MODE == 1) {
                        s1 += __shfl_xor(s1, 16); s1 += __shfl_xor(s1, 32); s2 += __shfl_xor(s2, 16); s2 += __shfl_xor(s2, 32);
                        if (fq == 0) *(f32x2*)(gvst + ((size_t)row * 16 + (u.pn & 3) * 4 + wc) * 2) = (f32x2){s1, s2};
                    }
                }
                if (MODE != 0) {
                    const int rowst = row0 + ai * HALF + (2 * mp + (fq & 1)) * 16;
#pragma unroll
                    for (int bj = 0; bj < 2; ++bj) *(u32x4*)((unsigned char*)base + (size_t)rowst * 1024 + colp + bj * HALF) = pair16(pc[bj][0], pc[bj][1]);
                }
            }
        if (MODE == 5) {
#define KM_RED(v) do { _Pragma("unroll") for (int j_ = 0; j_ < 4; ++j_) { float x = v[j_]; x += __shfl_xor(x, 1); x += __shfl_xor(x, 2); x += __shfl_xor(x, 4); x += __shfl_xor(x, 8); v[j_] = x; } } while (0)
            KM_RED(csA0); KM_RED(csB0); KM_RED(csA1); KM_RED(csB1);
#undef KM_RED
            if (fr == 0) {
                float* kp = kmp + ((size_t)(u.pm * 2 + wr) * DM) + col0;
                *(f32x4*)kp = csA0; *(f32x4*)(kp + 4) = csB0; *(f32x4*)(kp + HALF) = csA1; *(f32x4*)(kp + HALF + 4) = csB1;
            }
        }
    }
    __device__ __forceinline__ void operator()(const Acc& acc, const Unit& u, int wr, int wc, int fr, int fq) const {
        const int region = u.pn >> 2;
        if (region == 0) run<0>(acc, u, wr, wc, fr, fq, yab, 2048);
        else if (region == 1) run<1>(acc, u, wr, wc, fr, fq, gv, 1024);
        else if (region == 2) run<2>(acc, u, wr, wc, fr, fq, (bf16_t*)q, 1024);
        else if (region == 3) run<5>(acc, u, wr, wc, fr, fq, (bf16_t*)k, 1024);
        else if (region == 4) run<3>(acc, u, wr, wc, fr, fq, (bf16_t*)v, 1024);
        else if (region == 5) run<4>(acc, u, wr, wc, fr, fq, sa, 1024);
        else run<4>(acc, u, wr, wc, fr, fq, sb, 1024);
    }
    __device__ __forceinline__ void mid(Acc&, const Unit&, int, int, int, int) const {}
};

struct Epi2 {
    static constexpr bool PERM = true; static constexpr int MID_T = 16;
    const unsigned char *sa, *sb; bf16_t* mg;
    __device__ __forceinline__ void mid(Acc& acc, const Unit& u, int wr, int wc, int fr, int fq) const {
        int row0 = u.pm * BM + wr * 64 + fr, col0 = u.pn * BM + wc * 32 + 8 * fq;
        asm volatile("" : "+v"(row0), "+v"(col0));
#pragma unroll
        for (int ai = 0; ai < 2; ++ai)
#pragma unroll
            for (int m = 0; m < 4; ++m) {
                const size_t off = (size_t)(row0 + ai * HALF + m * 16) * DM + col0;
#pragma unroll
                for (int bj = 0; bj < 2; ++bj) {
                    const u32x2 a = *(const u32x2*)(sa + off + bj * HALF), b = *(const u32x2*)(sb + off + bj * HALF);
                    const f32x2v a0 = __builtin_amdgcn_cvt_pk_f32_fp8((int)a.x, false), a1 = __builtin_amdgcn_cvt_pk_f32_fp8((int)a.x, true), a2 = __builtin_amdgcn_cvt_pk_f32_fp8((int)a.y, false), a3 = __builtin_amdgcn_cvt_pk_f32_fp8((int)a.y, true);
                    const f32x2v b0 = __builtin_amdgcn_cvt_pk_f32_fp8((int)b.x, false), b1 = __builtin_amdgcn_cvt_pk_f32_fp8((int)b.x, true), b2 = __builtin_amdgcn_cvt_pk_f32_fp8((int)b.y, false), b3 = __builtin_amdgcn_cvt_pk_f32_fp8((int)b.y, true);
                    f32x4 r0, r1;
#define RQ(x, y) ((x) * __builtin_amdgcn_rcpf(y))
                    r0[0] = RQ(a0.x, b0.x); r0[1] = RQ(a0.y, b0.y); r0[2] = RQ(a1.x, b1.x); r0[3] = RQ(a1.y, b1.y);
                    r1[0] = RQ(a2.x, b2.x); r1[1] = RQ(a2.y, b2.y); r1[2] = RQ(a3.x, b3.x); r1[3] = RQ(a3.y, b3.y);
#undef RQ
                    acc[ai][bj][m][0] = acc[ai][bj][m][0] * r0; acc[ai][bj][m][1] = acc[ai][bj][m][1] * r1;
                }
                asm volatile("" : "+v"(acc[ai][0][m][0]), "+v"(acc[ai][0][m][1]), "+v"(acc[ai][1][m][0]), "+v"(acc[ai][1][m][1]));
                asm volatile("" ::: "memory");
            }
    }
    __device__ __forceinline__ void operator()(const Acc& acc, const Unit& u, int wr, int wc, int fr, int fq) const {
        const int row0 = u.pm * BM + wr * 64 + fr, col0 = u.pn * BM + wc * 32 + 8 * fq;
#pragma unroll
        for (int ai = 0; ai < 2; ++ai)
#pragma unroll
            for (int m = 0; m < 4; ++m) {
                const size_t off = (size_t)(row0 + ai * HALF + m * 16) * DM + col0;
#pragma unroll
                for (int bj = 0; bj < 2; ++bj) {
                    const u32x2 b = *(const u32x2*)(sb + off + bj * HALF);
                    const f32x2v b0 = __builtin_amdgcn_cvt_pk_f32_fp8((int)b.x, false), b1 = __builtin_amdgcn_cvt_pk_f32_fp8((int)b.x, true), b2 = __builtin_amdgcn_cvt_pk_f32_fp8((int)b.y, false), b3 = __builtin_amdgcn_cvt_pk_f32_fp8((int)b.y, true);
                    const f32x4 v0 = acc[ai][bj][m][0], v1 = acc[ai][bj][m][1];
                    u32x4 w; w.x = cvt_pk_bf16(v0[0] * b0.x, v0[1] * b0.y); w.y = cvt_pk_bf16(v0[2] * b1.x, v0[3] * b1.y);
                    w.z = cvt_pk_bf16(v1[0] * b2.x, v1[1] * b2.y); w.w = cvt_pk_bf16(v1[2] * b3.x, v1[3] * b3.y);
                    *(u32x4*)(mg + off + bj * HALF) = w;
                }
            }
    }
};

struct Epi3 {
    static constexpr bool PERM = true; static constexpr int MID_T = 0;
    const bf16_t* h0; bf16_t* z; float* zst;
    __device__ __forceinline__ void mid(Acc&, const Unit&, int, int, int, int) const {}
    __device__ __forceinline__ void operator()(const Acc& acc, const Unit& u, int wr, int wc, int fr, int fq) const {
        const int row0 = u.pm * BM + wr * 64 + fr, col0 = u.pn * BM + wc * 32 + 8 * fq;
#pragma unroll
        for (int ai = 0; ai < 2; ++ai)
#pragma unroll
            for (int m = 0; m < 4; ++m) {
                const int row = row0 + ai * HALF + m * 16; const size_t off = (size_t)row * DM + col0;
                float s1 = 0.f, s2 = 0.f;
#pragma unroll
                for (int bj = 0; bj < 2; ++bj) {
                    const u32x4 hb = *(const u32x4*)(h0 + off + bj * HALF);
                    f32x4 v0 = acc[ai][bj][m][0], v1 = acc[ai][bj][m][1];
                    v0[0] += ALPHA * bflo(hb.x); v0[1] += ALPHA * bfhi(hb.x); v0[2] += ALPHA * bflo(hb.y); v0[3] += ALPHA * bfhi(hb.y);
                    v1[0] += ALPHA * bflo(hb.z); v1[1] += ALPHA * bfhi(hb.z); v1[2] += ALPHA * bflo(hb.w); v1[3] += ALPHA * bfhi(hb.w);
                    s1 += ((v0[0] + v0[1]) + (v0[2] + v0[3])) + ((v1[0] + v1[1]) + (v1[2] + v1[3]));
                    s2 += ((v0[0] * v0[0] + v0[1] * v0[1]) + (v0[2] * v0[2] + v0[3] * v0[3])) + ((v1[0] * v1[0] + v1[1] * v1[1]) + (v1[2] * v1[2] + v1[3] * v1[3]));
                    *(u32x4*)(z + off + bj * HALF) = (u32x4){cvt_pk_bf16(v0[0], v0[1]), cvt_pk_bf16(v0[2], v0[3]), cvt_pk_bf16(v1[0], v1[1]), cvt_pk_bf16(v1[2], v1[3])};
                }
                s1 += __shfl_xor(s1, 16); s1 += __shfl_xor(s1, 32); s2 += __shfl_xor(s2, 16); s2 += __shfl_xor(s2, 32);
                if (fq == 0) *(f32x2*)(zst + ((size_t)row * 16 + u.pn * 4 + wc) * 2) = (f32x2){s1, s2};
            }
    }
};

struct Epi4 {
    static constexpr bool PERM = true; static constexpr int MID_T = 0;
    const float* b_up; unsigned char* act;
    __device__ __forceinline__ void mid(Acc&, const Unit&, int, int, int, int) const {}
    __device__ __forceinline__ void operator()(const Acc& acc, const Unit& u, int wr, int wc, int fr, int fq) const {
        const int e = u.bt >> 3;
        const int row0 = u.pm * BM + wr * 64 + fr, c0 = u.pn * HALF + wc * 32 + 8 * fq;
        const float* bg = b_up + (size_t)e * 2 * FF + c0; const float* bu = bg + FF;
        const f32x4 bg0 = *(const f32x4*)bg, bg1 = *(const f32x4*)(bg + 4), bu0 = *(const f32x4*)bu, bu1 = *(const f32x4*)(bu + 4);
        const int cp = u.pn * HALF + wc * 32 + 8 * (fq & ~1);
#pragma unroll
        for (int ai = 0; ai < 2; ++ai)
#pragma unroll
            for (int mp = 0; mp < 2; ++mp) {
                u32x2 pc[2];
#pragma unroll
                for (int k = 0; k < 2; ++k) {
                    const int m = 2 * mp + k;
                    float o[8];
#pragma unroll
                    for (int n = 0; n < 2; ++n)
#pragma unroll
                        for (int jp = 0; jp < 2; ++jp) {
                            const int j = 2 * jp;
                            const f32x2 ag = {acc[ai][0][m][n][j], acc[ai][0][m][n][j + 1]}, au = {acc[ai][1][m][n][j], acc[ai][1][m][n][j + 1]};
                            const f32x2 vbg = n ? (f32x2){bg1[j], bg1[j + 1]} : (f32x2){bg0[j], bg0[j + 1]}, vbu = n ? (f32x2){bu1[j], bu1[j + 1]} : (f32x2){bu0[j], bu0[j + 1]};
                            f32x2 gg = ag * 0.03125f + vbg, uu = au * 0.03125f + vbu;
                            gg.x = fminf(gg.x, 7.0f); gg.y = fminf(gg.y, 7.0f);
                            uu.x = __builtin_amdgcn_fmed3f(uu.x, -7.0f, 7.0f); uu.y = __builtin_amdgcn_fmed3f(uu.y, -7.0f, 7.0f);
                            const f32x2 t = gg * (-1.702f * 1.4426950408889634f);
                            f32x2 ex; ex.x = __builtin_amdgcn_exp2f(t.x); ex.y = __builtin_amdgcn_exp2f(t.y);
                            const f32x2 d = ex + 1.0f;
                            f32x2 rc; rc.x = __builtin_amdgcn_rcpf(d.x); rc.y = __builtin_amdgcn_rcpf(d.y);
                            const f32x2 res = (uu + 1.0f) * (gg * rc);
                            o[n * 4 + j] = res.x; o[n * 4 + j + 1] = res.y;
                        }
                    unsigned w0 = 0u, w1 = 0u;
                    w0 = __builtin_amdgcn_cvt_pk_fp8_f32(o[0], o[1], w0, false); w0 = __builtin_amdgcn_cvt_pk_fp8_f32(o[2], o[3], w0, true);
                    w1 = __builtin_amdgcn_cvt_pk_fp8_f32(o[4], o[5], w1, false); w1 = __builtin_amdgcn_cvt_pk_fp8_f32(o[6], o[7], w1, true);
                    pc[k] = (u32x2){w0, w1};
                }
                const int rowst = row0 + ai * HALF + (2 * mp + (fq & 1)) * 16;
                *(u32x4*)(act + (size_t)rowst * FF + cp) = pair16(pc[0], pc[1]);
            }
    }
};

struct Epi5 {
    static constexpr bool PERM = true; static constexpr int MID_T = 0;
    const float* b_down; const float* roww; unsigned char* ys;
    __device__ __forceinline__ void mid(Acc&, const Unit&, int, int, int, int) const {}
    __device__ __forceinline__ void operator()(const Acc& acc, const Unit& u, int wr, int wc, int fr, int fq) const {
        const int e = u.bt >> 2;
        const int row0 = u.pm * BM + wr * 64 + fr, col0 = u.pn * BM + wc * 32 + 8 * fq;
        f32x4 bv[2][2];
#pragma unroll
        for (int bj = 0; bj < 2; ++bj)
#pragma unroll
            for (int n = 0; n < 2; ++n) bv[bj][n] = *(const f32x4*)(b_down + (size_t)e * DM + col0 + bj * HALF + 4 * n);
        float rwv[2][4];
#pragma unroll
        for (int ai = 0; ai < 2; ++ai)
#pragma unroll
            for (int m = 0; m < 4; ++m) rwv[ai][m] = roww[u.rbase + wr * 64 + fr + ai * HALF + m * 16];
        asm volatile("" ::: "memory");
        const int colp = u.pn * BM + wc * 32 + 8 * (fq & ~1);
#pragma unroll
        for (int ai = 0; ai < 2; ++ai)
#pragma unroll
            for (int mp = 0; mp < 2; ++mp) {
                const int rowst = row0 + ai * HALF + (2 * mp + (fq & 1)) * 16;
#pragma unroll
                for (int bj = 0; bj < 2; ++bj) {
                    u32x2 pc[2];
#pragma unroll
                    for (int k = 0; k < 2; ++k) { const int m = 2 * mp + k; const float rw16 = rwv[ai][m] * 16.0f;
                        const f32x4 v0 = (acc[ai][bj][m][0] * 0.015625f + bv[bj][0]) * rw16, v1 = (acc[ai][bj][m][1] * 0.015625f + bv[bj][1]) * rw16;
                        pc[k] = (u32x2){pack_fp8x4(v0[0], v0[1], v0[2], v0[3]), pack_fp8x4(v1[0], v1[1], v1[2], v1[3])}; }
                    *(u32x4*)(ys + (size_t)rowst * DM + colp + bj * HALF) = pair16(pc[0], pc[1]);
                }
            }
    }
};
}

struct Args { const float* in[21]; float* out; unsigned char* ws; int ph_lo, ph_hi; };
enum { I_X = 0, I_LNIN_G, I_LNIN_B, I_WIN, I_GLN_G, I_GLN_B, I_WSP, I_BSP, I_WBA, I_WBB, I_WOUT, I_LNMIX_G, I_LNMIX_B, I_WR, I_BR, I_WUP, I_BUP, I_WDN, I_BDN, I_LNF_G, I_LNF_B };

struct Ctx { const Args* a; unsigned char* ws; LAS unsigned char* lds; unsigned char* ldsg; int tid, lane, wave, G, vcu; };

__device__ __forceinline__ void tr_item(const float* W, int N, int k0, int n0, bf16_t* dst, int drow0, int dld, int dcol0, LAS float* scr, int lane) {
#pragma unroll 8
    for (int i = 0; i < 32; ++i) { const int kk = 2 * i + (lane >> 5); scr[kk * 33 + (lane & 31)] = __builtin_nontemporal_load(W + (size_t)(k0 + kk) * N + n0 + (lane & 31)); }
    asm volatile("s_waitcnt lgkmcnt(0)" ::: "memory");
    const int c = lane & 7;
#pragma unroll
    for (int j = 0; j < 4; ++j) { const int n = (lane >> 3) + 8 * j; const LAS float* s = scr + (8 * c) * 33 + n;
        u32x4 o; o.x = pk2(s[0 * 33], s[1 * 33]); o.y = pk2(s[2 * 33], s[3 * 33]); o.z = pk2(s[4 * 33], s[5 * 33]); o.w = pk2(s[6 * 33], s[7 * 33]);
        *(u32x4*)(dst + (size_t)(drow0 + n) * dld + dcol0 + k0 + 8 * c) = o; }
    asm volatile("s_waitcnt lgkmcnt(0)" ::: "memory");
}
__device__ __forceinline__ void tr_item8(const float* W, int N, int k0, int n0, unsigned char* dst, int drow0, int dld, float sc, LAS float* scr, int lane) {
#pragma unroll 8
    for (int i = 0; i < 32; ++i) { const int kk = 2 * i + (lane >> 5); scr[kk * 33 + (lane & 31)] = __builtin_nontemporal_load(W + (size_t)(k0 + kk) * N + n0 + (lane & 31)); }
    asm volatile("s_waitcnt lgkmcnt(0)" ::: "memory");
    const int c = lane & 7;
#pragma unroll
    for (int j = 0; j < 4; ++j) { const int n = (lane >> 3) + 8 * j; const LAS float* s = scr + (8 * c) * 33 + n;
        unsigned w0 = 0u, w1 = 0u;
        w0 = __builtin_amdgcn_cvt_pk_fp8_f32(s[0 * 33] * sc, s[1 * 33] * sc, w0, false); w0 = __builtin_amdgcn_cvt_pk_fp8_f32(s[2 * 33] * sc, s[3 * 33] * sc, w0, true);
        w1 = __builtin_amdgcn_cvt_pk_fp8_f32(s[4 * 33] * sc, s[5 * 33] * sc, w1, false); w1 = __builtin_amdgcn_cvt_pk_fp8_f32(s[6 * 33] * sc, s[7 * 33] * sc, w1, true);
        *(u32x2*)(dst + (size_t)(drow0 + n) * dld + k0 + 8 * c) = (u32x2){w0, w1}; }
    asm volatile("s_waitcnt lgkmcnt(0)" ::: "memory");
}
__device__ __forceinline__ void ph_prologue(const Ctx& F) {
    const Args& A = *F.a;
    LAS float* scr = (LAS float*)(F.lds + F.wave * 16384);
    const int gw = F.vcu * 8 + F.wave, NGW = F.G * 8;
    bf16_t* WIN = (bf16_t*)(F.ws + WS_WIN); bf16_t* WAB = (bf16_t*)(F.ws + WS_WAB); bf16_t* WOUT = (bf16_t*)(F.ws + WS_WOUT);
    unsigned char* WDN = F.ws + WS_WDN; unsigned char* WUP = F.ws + WS_WUP;
    constexpr int I_IN = 16 * (INCOLS / 32), I_SQ = 16 * 32, I_UP = NE * 16 * 64, I_DN = NE * 16 * 32;
    constexpr int NITEMS = I_IN + 3 * I_SQ + I_UP + I_DN;
    for (int it = gw; it < NITEMS; it += NGW) {
        int r = it;
        if (r < I_IN) { const int nblk = INCOLS / 32, kb = r / nblk, nb = r % nblk;
            if (32 * nb >= PN8_LO * 256 && 32 * nb < PN8_HI * 256) tr_item8(A.in[I_WIN], INCOLS, 64 * kb, 32 * nb, F.ws + WS_WIN8, 32 * nb, DM, 32.0f, scr, F.lane);
            else tr_item(A.in[I_WIN], INCOLS, 64 * kb, 32 * nb, WIN, 32 * nb, DM, 0, scr, F.lane);
            continue; } r -= I_IN;
        if (r < I_SQ) { const int kb = r / 32, nb = r % 32; tr_item(A.in[I_WBA], DM, 64 * kb, 32 * nb, WAB, 32 * nb, 2048, 0, scr, F.lane); continue; } r -= I_SQ;
        if (r < I_SQ) { const int kb = r / 32, nb = r % 32; tr_item(A.in[I_WBB], DM, 64 * kb, 32 * nb, WAB, 32 * nb, 2048, 1024, scr, F.lane); continue; } r -= I_SQ;
        if (r < I_SQ) { const int kb = r / 32, nb = r % 32; tr_item(A.in[I_WOUT], DM, 64 * kb, 32 * nb, WOUT, 32 * nb, DM, 0, scr, F.lane); continue; } r -= I_SQ;
        if (r < I_UP) { const int e = r / (16 * 64), rr = r % (16 * 64), kb = rr / 64, nb = rr % 64; const int n0 = 32 * nb, half = n0 >= FF, rem = n0 - half * FF, pn = rem >> 7, b = (rem & 127) >> 5;
            tr_item8(A.in[I_WUP] + (size_t)e * DM * 2 * FF, 2 * FF, 64 * kb, n0, WUP, e * 2048 + 256 * pn + half * 128 + 32 * b, DM, 32.0f, scr, F.lane); continue; } r -= I_UP;
        { const int e = r / (16 * 32), rr = r % (16 * 32), kb = rr / 32, nb = rr % 32; tr_item8(A.in[I_WDN] + (size_t)e * FF * DM, DM, 64 * kb, 32 * nb, WDN, e * 1024 + 32 * nb, FF, 64.0f, scr, F.lane); }
    }
    const float* lg = A.in[I_LNIN_G]; const float* lb = A.in[I_LNIN_B]; bf16_t* H0 = (bf16_t*)(F.ws + WS_H0);
    f32x4 gg[4], bb[4];
#pragma unroll
    for (int j = 0; j < 4; ++j) { gg[j] = *((const f32x4*)lg + F.lane + 64 * j); bb[j] = *((const f32x4*)lb + F.lane + 64 * j); }
    for (int m = gw; m < T; m += NGW) {
        const f32x4* xr = (const f32x4*)(A.in[I_X] + (size_t)m * DM) + F.lane;
        f32x4 v[4]; float s = 0.f;
#pragma unroll
        for (int j = 0; j < 4; ++j) { v[j] = __builtin_nontemporal_load(xr + 64 * j); s += (v[j].x + v[j].y) + (v[j].z + v[j].w); }
        const float mean = wave_sum(s) * (1.f / DM); float s2 = 0.f;
#pragma unroll
        for (int j = 0; j < 4; ++j) { v[j] = v[j] - mean; s2 += (v[j].x * v[j].x + v[j].y * v[j].y) + (v[j].z * v[j].z + v[j].w * v[j].w); }
        const float rstd = 1.f / sqrtf(wave_sum(s2) * (1.f / DM) + LN_EPS);
        u32x2* o8 = (u32x2*)(H0 + (size_t)m * DM) + F.lane; unsigned* o4 = (unsigned*)(F.ws + WS_H0F8 + (size_t)m * DM) + F.lane;
#pragma unroll
        for (int j = 0; j < 4; ++j) { const f32x4 y = v[j] * rstd * gg[j] + bb[j]; o8[64 * j] = (u32x2){pk2(y.x, y.y), pk2(y.z, y.w)}; o4[64 * j] = pack_fp8x4(y.x, y.y, y.z, y.w); }
    }
}

typedef short v4i16_t __attribute__((ext_vector_type(4)));
__device__ __forceinline__ v4i16_t lds_tr16(LAS const unsigned char* p) { return __builtin_amdgcn_ds_read_tr16_b64_v4i16((LAS v4i16_t*)p); }
__device__ __forceinline__ void ph_mixer_a(const Ctx& F) {
    const Args& A = *F.a;
    const unsigned char* GV = F.ws + WS_GV; bf16_t* YAB = (bf16_t*)(F.ws + WS_YAB); const float* GVST = (const float*)(F.ws + WS_GVST);
    const float* lg = A.in[I_GLN_G]; const float* lb = A.in[I_GLN_B]; const float* wsp = A.in[I_WSP]; const float* bsp = A.in[I_BSP];
    constexpr int RSV = 544, RSW = 272, OFF_W = 128 * RSV, OFF_ST = OFF_W + 128 * RSW;
    LAS unsigned char* VT = F.lds; LAS unsigned char* WT = F.lds + OFF_W; LAS float* ST = (LAS float*)(F.lds + OFF_ST);
    const int lane = F.lane, wv = F.wave;
    int curg = -1;
    for (int it = F.vcu; it < NB * 32 * 4; it += F.G) {
        const int b = it / 128, c = (it >> 2) & 31, g = it & 3;
        const int tok0 = b * SEQ + c * 128;
        if (g != curg) {
            curg = g;
            for (int k = 0; k < 4; ++k) {
                const int idx = F.tid + 512 * k, t = idx >> 4, s8 = (idx & 15) * 8;
                const f32x4 w0 = *(const f32x4*)(wsp + ((size_t)g * 128 + t) * 128 + s8), w1 = *(const f32x4*)(wsp + ((size_t)g * 128 + t) * 128 + s8 + 4);
                float x[8] = {w0.x, w0.y, w0.z, w0.w, w1.x, w1.y, w1.z, w1.w};
#pragma unroll
                for (int j = 0; j < 8; ++j) x[j] = (s8 + j <= t) ? x[j] : 0.f;
                u32x4 o; o.x = pk2(x[0], x[1]); o.y = pk2(x[2], x[3]); o.z = pk2(x[4], x[5]); o.w = pk2(x[6], x[7]);
                *(LAS u32x4*)(WT + t * RSW + s8 * 2) = o;
            }
        }
        if (F.tid < 128) {
            const float* p = GVST + (size_t)(tok0 + F.tid) * 32; float s1 = 0.f, s2 = 0.f;
            for (int i = 0; i < 16; ++i) { s1 += p[2 * i]; s2 += p[2 * i + 1]; }
            const float mean = s1 * (1.f / DM), var = s2 * (1.f / DM) - mean * mean;
            ST[2 * F.tid] = mean; ST[2 * F.tid + 1] = 1.f / sqrtf(fmaxf(var, 0.f) + LN_EPS);
        }
        __syncthreads();
        {
            const int dc = F.tid & 31;
            const f32x4 g0 = *(const f32x4*)(lg + g * 256 + dc * 8), g1 = *(const f32x4*)(lg + g * 256 + dc * 8 + 4), b0 = *(const f32x4*)(lb + g * 256 + dc * 8), b1 = *(const f32x4*)(lb + g * 256 + dc * 8 + 4);
#pragma unroll
            for (int k = 0; k < 8; ++k) {
                const int s = (F.tid >> 5) + 16 * k;
                const u32x2 raw = *(const u32x2*)(GV + (size_t)(tok0 + s) * DM + g * 256 + dc * 8);
                const float mean = ST[2 * s], rstd = ST[2 * s + 1];
                const f32x2v f0 = __builtin_amdgcn_cvt_pk_f32_fp8((int)raw.x, false), f1 = __builtin_amdgcn_cvt_pk_f32_fp8((int)raw.x, true), f2 = __builtin_amdgcn_cvt_pk_f32_fp8((int)raw.y, false), f3 = __builtin_amdgcn_cvt_pk_f32_fp8((int)raw.y, true);
                f32x4 x0 = {f0.x, f0.y, f1.x, f1.y}, x1 = {f2.x, f2.y, f3.x, f3.y};
                x0 = (x0 - mean) * rstd * g0 + b0; x1 = (x1 - mean) * rstd * g1 + b1;
                u32x4 o; o.x = pk2(x0.x, x0.y); o.y = pk2(x0.z, x0.w); o.z = pk2(x1.x, x1.y); o.w = pk2(x1.z, x1.w);
                *(LAS u32x4*)(VT + s * RSV + dc * 16) = o;
            }
        }
        __syncthreads();
        {
            const int dbase = 32 * wv, kg = lane >> 4, q = (lane & 15) >> 2, p = lane & 3, fr = lane & 15;
            bf16x8 Af[2][4];
#pragma unroll
            for (int m = 0; m < 2; ++m)
#pragma unroll
                for (int kk = 0; kk < 4; ++kk) {
                    LAS const unsigned char* ap = VT + (32 * kk + 8 * kg + q) * RSV + (dbase + 16 * m + 4 * p) * 2;
                    const v4i16_t lo = lds_tr16(ap), hi = lds_tr16(ap + 4 * RSV);
                    Af[m][kk] = (bf16x8){lo[0], lo[1], lo[2], lo[3], hi[0], hi[1], hi[2], hi[3]};
                }
#pragma unroll
            for (int n = 0; n < 8; ++n) {
                f32x4 acc0 = {0.f, 0.f, 0.f, 0.f}, acc1 = {0.f, 0.f, 0.f, 0.f};
#pragma unroll
                for (int kk = 0; kk < 4; ++kk) if (kk <= (n >> 1)) {
                    const bf16x8 Bf = *(LAS const bf16x8*)(WT + (16 * n + fr) * RSW + (32 * kk + 8 * kg) * 2);
                    acc0 = __builtin_amdgcn_mfma_f32_16x16x32_bf16(Af[0][kk], Bf, acc0, 0, 0, 0);
                    acc1 = __builtin_amdgcn_mfma_f32_16x16x32_bf16(Af[1][kk], Bf, acc1, 0, 0, 0);
                }
                const int t = 16 * n + fr; const float bsv = bsp[g * 128 + t];
                bf16_t* yp = YAB + (size_t)(tok0 + t) * 2048 + g * 256 + dbase + 4 * kg;
                const u32x2 u0 = *(const u32x2*)yp, u1 = *(const u32x2*)(yp + 16);
                u32x2 o0, o1;
                o0.x = pk2(bflo(u0.x) * (acc0[0] + bsv), bfhi(u0.x) * (acc0[1] + bsv)); o0.y = pk2(bflo(u0.y) * (acc0[2] + bsv), bfhi(u0.y) * (acc0[3] + bsv));
                o1.x = pk2(bflo(u1.x) * (acc1[0] + bsv), bfhi(u1.x) * (acc1[1] + bsv)); o1.y = pk2(bflo(u1.y) * (acc1[2] + bsv), bfhi(u1.y) * (acc1[3] + bsv));
                *(u32x2*)yp = o0; *(u32x2*)(yp + 16) = o1;
            }
        }
        __syncthreads();
    }
}

__device__ __forceinline__ void ph_gate(const Ctx& F) {
    const unsigned char* Q = F.ws + WS_Q; const float* KM = (const float*)(F.ws + WS_KMEAN);
    unsigned* SEL = (unsigned*)(F.ws + WS_SEL); unsigned* LISTS = (unsigned*)(F.ws + WS_LISTS); unsigned* LCNT = (unsigned*)(F.ws + WS_CTL) + CW_LCNT;
    constexpr int KMR = 272;
    LAS unsigned char* kmh = F.lds; LAS unsigned char* kml = F.lds + 16 * KMR;
    unsigned* lc = (unsigned*)(F.ldsg + 2 * 16 * KMR);
    LAS float* scw = (LAS float*)(F.lds + 16384) + F.wave * 1024;
    const int fr = F.lane & 15, fq = F.lane >> 4;
    for (int it = F.vcu; it < NB * NH * 8; it += F.G) {
        const int b = it / 64, h = (it >> 3) & 7, tc = it & 7;
        {
            const int j = F.tid >> 5, d4 = (F.tid & 31) * 4;
            const float* kp = KM + (size_t)((b * NBLK + j) * 2) * DM + h * DH + d4;
            const f32x4 s0 = *(const f32x4*)kp, s1 = *(const f32x4*)(kp + DM);
            const f32x4 mv = (s0 + s1) * (1.0f / LBLK);
            unsigned hb[4]; float lo[4];
#pragma unroll
            for (int e = 0; e < 4; ++e) { hb[e] = f2bf(mv[e]); lo[e] = mv[e] - __uint_as_float(hb[e] << 16); }
            *(LAS u32x2*)(kmh + j * KMR + d4 * 2) = (u32x2){hb[0] | (hb[1] << 16), hb[2] | (hb[3] << 16)};
            *(LAS u32x2*)(kml + j * KMR + d4 * 2) = (u32x2){pk2(lo[0], lo[1]), pk2(lo[2], lo[3])};
        }
        if (F.tid < 32) lc[F.tid] = 0u;
        const int tw = tc * 512 + F.wave * 64;
        u32x4 qraw[4][2];
#pragma unroll
        for (int tg = 0; tg < 4; ++tg) { const unsigned char* qp = Q + (size_t)(b * SEQ + tw + 16 * tg + fr) * DM + h * DH + 32 * fq; qraw[tg][0] = *(const u32x4*)qp; qraw[tg][1] = *(const u32x4*)(qp + 16); }
        __syncthreads();
        bf16x8 Ah[4], Al[4];
#pragma unroll
        for (int ks = 0; ks < 4; ++ks) { Ah[ks] = *(LAS const bf16x8*)(kmh + fr * KMR + (32 * fq + 8 * ks) * 2); Al[ks] = *(LAS const bf16x8*)(kml + fr * KMR + (32 * fq + 8 * ks) * 2); }
#pragma unroll
        for (int tg = 0; tg < 4; ++tg) {
            f32x4 acc = {0.f, 0.f, 0.f, 0.f};
#pragma unroll
            for (int ks = 0; ks < 4; ++ks) {
                const u32x4 w = qraw[tg][ks >> 1]; const unsigned w0 = (ks & 1) ? w.z : w.x, w1 = (ks & 1) ? w.w : w.y;
                const bf16x8 Bq = __builtin_bit_cast(bf16x8, f8x8_to_bf16x8(w0, w1));
                acc = __builtin_amdgcn_mfma_f32_16x16x32_bf16(Ah[ks], Bq, acc, 0, 0, 0);
                acc = __builtin_amdgcn_mfma_f32_16x16x32_bf16(Al[ks], Bq, acc, 0, 0, 0);
            }
            *(LAS f32x4*)(scw + (16 * tg + fr) * 16 + 4 * fq) = acc;
        }
        asm volatile("s_waitcnt lgkmcnt(0)" ::: "memory");
        const int t = tc * 512 + F.tid, qi = t >> 8;
        float gsc[15];
        { const f32x4 c0 = *(LAS const f32x4*)(scw + F.lane * 16), c1 = *(LAS const f32x4*)(scw + F.lane * 16 + 4), c2 = *(LAS const f32x4*)(scw + F.lane * 16 + 8), c3 = *(LAS const f32x4*)(scw + F.lane * 16 + 12);
          gsc[0] = c0.x; gsc[1] = c0.y; gsc[2] = c0.z; gsc[3] = c0.w; gsc[4] = c1.x; gsc[5] = c1.y; gsc[6] = c1.z; gsc[7] = c1.w;
          gsc[8] = c2.x; gsc[9] = c2.y; gsc[10] = c2.z; gsc[11] = c2.w; gsc[12] = c3.x; gsc[13] = c3.y; gsc[14] = c3.z; }
        const int nsel = qi < 3 ? qi : 3;
        int sel[3] = {0, 0, 0}; unsigned lpos[3] = {0, 0, 0};
#pragma unroll
        for (int r = 0; r < 3; ++r) {
            float best = -INFINITY; int bi = -1;
#pragma unroll
            for (int j = 0; j < 15; ++j) { const bool c = (j < qi) && (gsc[j] > best); best = c ? gsc[j] : best; bi = c ? j : bi; }
#pragma unroll
            for (int j = 0; j < 15; ++j) if (j == bi) gsc[j] = -INFINITY;
            sel[r] = bi < 0 ? 0 : bi;
            if (r < nsel) lpos[r] = atomicAdd(&lc[sel[r]], 1u);
        }
        SEL[(size_t)(b * SEQ + t) * NH + h] = (unsigned)sel[0] | ((unsigned)sel[1] << 8) | ((unsigned)sel[2] << 16) | ((unsigned)nsel << 24);
        __syncthreads();
        if (F.tid < 16) lc[16 + F.tid] = lc[F.tid] ? atomicAdd(&LCNT[(b * NH + h) * NBLK + F.tid], lc[F.tid]) : 0u;
        __syncthreads();
#pragma unroll
        for (int r = 0; r < 3; ++r) if (r < nsel) LISTS[(size_t)((b * NH + h) * NBLK + sel[r]) * 4096 + lc[16 + sel[r]] + lpos[r]] = (unsigned)t | ((unsigned)r << 12);
        __syncthreads();
    }
}


typedef float f32x16 __attribute__((ext_vector_type(16)));
namespace att {
__device__ __forceinline__ int crow(int r, int hi) { return (r & 3) + 8 * (r >> 2) + 4 * hi; }
#define TRR(dst, vaddr, off) asm volatile("ds_read_b64_tr_b16 %0, %1 offset:%c2" : "=v"(dst) : "v"(vaddr), "i"(off) : "memory")
#define TRWAIT() do { asm volatile("s_waitcnt lgkmcnt(0)" ::: "memory"); __builtin_amdgcn_sched_barrier(0); } while (0)

}

namespace att2 {
constexpr int KCH2 = 1040, VDB2 = 4160, KSL = 8 * KCH2, VSL = 4 * VDB2;
constexpr int OFF_K = 0, OFF_V = 2 * KSL, OFF_STG = OFF_V + 2 * VSL  , OFF_WS = OFF_STG + 8 * 8192  , WSW = 1024, OFF_TAB = OFF_WS + 8 * WSW  ;
static_assert(OFF_TAB + 1028 * 4 <= LDS_BYTES - 64, "attention (partial) LDS map");
using att::crow;

__device__ __forceinline__ void tile_load(const Ctx& F, const unsigned char* K, const unsigned char* V, size_t tokbase, int h, int kt, u32x4& rk, u32x4& rv) {
    const size_t off = (tokbase + 64 * kt + (F.tid >> 3)) * DM + h * DH + (F.tid & 7) * 16;
    rk = *(const u32x4*)(K + off); rv = *(const u32x4*)(V + off);
}
__device__ __forceinline__ void tile_write(const Ctx& F, int slot, const u32x4& rk, const u32x4& rv) {
    const int key = F.tid >> 3, c = 2 * (F.tid & 7);
    *(LAS u32x4*)(F.lds + OFF_K + slot * KSL + (F.tid & 7) * KCH2 + key * 16) = rk;
    LAS unsigned char* vd = F.lds + OFF_V + slot * VSL + (c >> 2) * VDB2 + (key >> 3) * 512 + (key & 7) * 64 + (c & 3) * 16;
    *(LAS u32x4*)vd = f8x8_to_bf16x8(rv.x, rv.y); *(LAS u32x4*)(vd + 16) = f8x8_to_bf16x8(rv.z, rv.w);
}
template <bool CAUSAL = false>
__device__ __forceinline__ void tile_compute(const Ctx& F, int slot, const pg8::v8i_t (&qf)[2], f32x16 (&o)[4], float& m, float& l, bool first, bool diag = false) {
    const int r = F.lane & 31, hh = F.lane >> 5;
    LAS float* wsf = (LAS float*)(F.lds + OFF_WS + F.wave * WSW);
    LAS const unsigned char* kp = F.lds + OFF_K + slot * KSL + 2 * hh * KCH2 + r * 16;
    LAS const unsigned char* vp = F.lds + OFF_V + slot * VSL + (4 * hh + ((F.lane & 15) >> 2)) * 64 + ((F.lane >> 4) & 1) * 32 + (F.lane & 3) * 8;
    f32x16 p0, p1;
#pragma unroll
    for (int i = 0; i < 16; ++i) { p0[i] = 0.f; p1[i] = 0.f; }
    {
        pg8::v8i_t ka[2][2];
#pragma unroll
        for (int kb = 0; kb < 2; ++kb)
#pragma unroll
            for (int j2 = 0; j2 < 2; ++j2) ka[kb][j2] = __builtin_shufflevector(*(LAS const pg8::v4i_t*)(kp + 4 * j2 * KCH2 + kb * 512), *(LAS const pg8::v4i_t*)(kp + (4 * j2 + 1) * KCH2 + kb * 512), 0, 1, 2, 3, 4, 5, 6, 7);
        __builtin_amdgcn_sched_barrier(0);
#pragma unroll
        for (int j2 = 0; j2 < 2; ++j2) p0 = __builtin_amdgcn_mfma_scale_f32_32x32x64_f8f6f4(ka[0][j2], qf[j2], p0, 0, 0, 0, 0x7f7f7f7f, 0, 0x7f7f7f7f);
#pragma unroll
        for (int j2 = 0; j2 < 2; ++j2) p1 = __builtin_amdgcn_mfma_scale_f32_32x32x64_f8f6f4(ka[1][j2], qf[j2], p1, 0, 0, 0, 0x7f7f7f7f, 0, 0x7f7f7f7f);
        __builtin_amdgcn_sched_barrier(0);
    }
    v4i16_t vl[2][4], vh[2][4];
    const unsigned vaddr = (unsigned)(uintptr_t)vp;
#pragma unroll
    for (int ks = 0; ks < 2; ++ks)
#pragma unroll
        for (int db = 0; db < 4; ++db) { TRR(vl[ks][db], vaddr, db * VDB2 + ks * 1024); TRR(vh[ks][db], vaddr, db * VDB2 + ks * 1024 + 512); }
    __builtin_amdgcn_sched_barrier(0);
    if (CAUSAL && diag) {
        if (F.wave & 1) {
#pragma unroll
            for (int i = 0; i < 16; ++i) p1[i] = (crow(i, hh) > r) ? -INFINITY : p1[i];
        } else {
#pragma unroll
            for (int i = 0; i < 16; ++i) { p0[i] = (crow(i, hh) > r) ? -INFINITY : p0[i]; p1[i] = -INFINITY; }
        }
    }
    const float dm = first ? 0.f : m;
    { const f32x2 dm2 = {dm, dm};
#pragma unroll
      for (int j = 0; j < 8; ++j) { f32x2 a = {p0[2 * j], p0[2 * j + 1]}, b = {p1[2 * j], p1[2 * j + 1]}; a = a - dm2; b = b - dm2; p0[2 * j] = a.x; p0[2 * j + 1] = a.y; p1[2 * j] = b.x; p1[2 * j + 1] = b.y; } }
    float mx = fmaxf(p0[0], p1[0]);
#pragma unroll
    for (int i = 1; i < 16; ++i) mx = fmaxf(mx, fmaxf(p0[i], p1[i]));
    mx = fmaxf(mx, __shfl_xor(mx, 32));
    if (first || __any(mx > 8.0f)) {
        const float delta = first ? mx : fmaxf(mx, 0.f);
        const float alpha = first ? 0.f : __builtin_amdgcn_exp2f(-delta);
        l *= alpha; m = dm + delta;
        { const f32x2 d2 = {delta, delta};
#pragma unroll
          for (int j = 0; j < 8; ++j) { f32x2 a = {p0[2 * j], p0[2 * j + 1]}, b = {p1[2 * j], p1[2 * j + 1]}; a = a - d2; b = b - d2; p0[2 * j] = a.x; p0[2 * j + 1] = a.y; p1[2 * j] = b.x; p1[2 * j + 1] = b.y; } }
        if (!first) {
            if (hh == 0) wsf[r] = alpha;
            asm volatile("s_waitcnt lgkmcnt(0)" ::: "memory");
#pragma unroll
            for (int i = 0; i < 16; ++i) { const float a = wsf[crow(i, hh)];
#pragma unroll
                for (int db = 0; db < 4; ++db) o[db][i] *= a; }
        }
    }
    { f32x2 sa = {0.f, 0.f}, sb = {0.f, 0.f};
#pragma unroll
      for (int j = 0; j < 8; ++j) {
          p0[2 * j] = __builtin_amdgcn_exp2f(p0[2 * j]); p0[2 * j + 1] = __builtin_amdgcn_exp2f(p0[2 * j + 1]); p1[2 * j] = __builtin_amdgcn_exp2f(p1[2 * j]); p1[2 * j + 1] = __builtin_amdgcn_exp2f(p1[2 * j + 1]);
          sa = sa + (f32x2){p0[2 * j], p0[2 * j + 1]}; sb = sb + (f32x2){p1[2 * j], p1[2 * j + 1]}; }
      sa = sa + sb; l += sa.x + sa.y; }
    u32x4 pw[4];
#pragma unroll
    for (int s2 = 0; s2 < 2; ++s2) {
        pw[s2] = (u32x4){cvt_pk_bf16(p0[8 * s2], p0[8 * s2 + 1]), cvt_pk_bf16(p0[8 * s2 + 2], p0[8 * s2 + 3]), cvt_pk_bf16(p0[8 * s2 + 4], p0[8 * s2 + 5]), cvt_pk_bf16(p0[8 * s2 + 6], p0[8 * s2 + 7])};
        pw[2 + s2] = (u32x4){cvt_pk_bf16(p1[8 * s2], p1[8 * s2 + 1]), cvt_pk_bf16(p1[8 * s2 + 2], p1[8 * s2 + 3]), cvt_pk_bf16(p1[8 * s2 + 4], p1[8 * s2 + 5]), cvt_pk_bf16(p1[8 * s2 + 6], p1[8 * s2 + 7])};
    }
    TRWAIT();
#pragma unroll
    for (int ks = 0; ks < 2; ++ks) {
        const bf16x8 pa = __builtin_bit_cast(bf16x8, pw[ks]);
#pragma unroll
        for (int db = 0; db < 4; ++db) {
            const bf16x8 vf = (bf16x8){vl[ks][db][0], vl[ks][db][1], vl[ks][db][2], vl[ks][db][3], vh[ks][db][0], vh[ks][db][1], vh[ks][db][2], vh[ks][db][3]};
            o[db] = __builtin_amdgcn_mfma_f32_32x32x16_bf16(pa, vf, o[db], 0, 0, 0);
        }
    }
    __builtin_amdgcn_sched_barrier(0);
#pragma unroll
    for (int ks = 0; ks < 2; ++ks)
#pragma unroll
        for (int db = 0; db < 4; ++db) { TRR(vl[ks][db], vaddr, db * VDB2 + (2 + ks) * 1024); TRR(vh[ks][db], vaddr, db * VDB2 + (2 + ks) * 1024 + 512); }
    TRWAIT();
#pragma unroll
    for (int ks = 0; ks < 2; ++ks) {
        const bf16x8 pa = __builtin_bit_cast(bf16x8, pw[2 + ks]);
#pragma unroll
        for (int db = 0; db < 4; ++db) {
            const bf16x8 vf = (bf16x8){vl[ks][db][0], vl[ks][db][1], vl[ks][db][2], vl[ks][db][3], vh[ks][db][0], vh[ks][db][1], vh[ks][db][2], vh[ks][db][3]};
            o[db] = __builtin_amdgcn_mfma_f32_32x32x16_bf16(pa, vf, o[db], 0, 0, 0);
        }
    }
    __builtin_amdgcn_sched_barrier(0);
}
}

#define ATT2_DECODE(item, bhj_, chunk_) do { int lo_ = 0, hi_ = 1023; while (lo_ < hi_) { const int mid_ = (lo_ + hi_ + 1) >> 1; if (P[mid_] <= (item)) lo_ = mid_; else hi_ = mid_ - 1; } bhj_ = lo_; chunk_ = (item) - P[lo_]; } while (0)
__device__ __forceinline__ void ph_attn_partial(const Ctx& F) {
    using namespace att2;
    const unsigned char* Q = F.ws + WS_Q; const unsigned char* K = F.ws + WS_K; const unsigned char* V = F.ws + WS_V;
    const unsigned* LISTS = (const unsigned*)(F.ws + WS_LISTS); const unsigned* LCNT = (const unsigned*)(F.ws + WS_CTL) + CW_LCNT;
    unsigned char* OP = F.ws + WS_OP; float* LSE = (float*)(F.ws + WS_LSE);
    LAS int* P = (LAS int*)(F.lds + OFF_TAB);
    if (F.tid < 64) {
        int c[16]; int s = 0;
#pragma unroll
        for (int i = 0; i < 16; ++i) { c[i] = ((int)__hip_atomic_load(LCNT + F.tid * 16 + i, __ATOMIC_RELAXED, __HIP_MEMORY_SCOPE_AGENT) + 255) >> 8; s += c[i]; }
        int inc = s;
#pragma unroll
        for (int o = 1; o < 64; o <<= 1) { const int t = __shfl_up(inc, o); if (F.lane >= o) inc += t; }
        int run = inc - s;
#pragma unroll
        for (int i = 0; i < 16; ++i) { P[F.tid * 16 + i] = run; run += c[i]; }
        if (F.tid == 63) P[1024] = run;
    }
    __syncthreads();
    const int total = P[1024];
    LAS float* wsf = (LAS float*)(F.lds + OFF_WS + F.wave * WSW);
    LAS int* wsi = (LAS int*)wsf;
    const int r = F.lane & 31, hh = F.lane >> 5;
    int it = F.vcu;
    if (it < total) {
        int bhj, chunk; ATT2_DECODE(it, bhj, chunk);
        int itn = it + F.G, bhjn = 0, chunkn = 0; bool hasn = itn < total; if (hasn) ATT2_DECODE(itn, bhjn, chunkn);
        u32x4 rkA, rvA, rkB, rvB;
        { const int b = bhj >> 7, h = (bhj >> 4) & 7, j = bhj & 15; const size_t tb = (size_t)b * SEQ + j * LBLK;
          tile_load(F, K, V, tb, h, 0, rkA, rvA); tile_load(F, K, V, tb, h, 1, rkB, rvB); tile_write(F, 0, rkA, rvA); tile_write(F, 1, rkB, rvB);
          tile_load(F, K, V, tb, h, 2, rkA, rvA); }
        int cnt = (int)__hip_atomic_load(LCNT + bhj, __ATOMIC_RELAXED, __HIP_MEMORY_SCOPE_AGENT);
        int qi = chunk * 256 + F.wave * 32 + r;
        unsigned ent = LISTS[(size_t)bhj * 4096 + (qi < cnt ? qi : 0)];
        int tq = ent & 4095, slot = (qi < cnt) ? (int)(ent >> 12) : -1;
        u32x4 qraw[4];
        { const unsigned char* qrow = Q + ((size_t)(bhj >> 7) * SEQ + tq) * DM + ((bhj >> 4) & 7) * DH + hh * 32;
#pragma unroll
          for (int c = 0; c < 4; ++c) qraw[c] = *(const u32x4*)(qrow + (c >> 1) * 64 + (c & 1) * 16); }
        unsigned entn = 0u; int cntn = 0;
        __syncthreads();
        int s = 0;
        for (;;) {
            const int b = bhj >> 7, h = (bhj >> 4) & 7, j = bhj & 15;
            pg8::v8i_t qr[2];
#pragma unroll
            for (int j2 = 0; j2 < 2; ++j2) qr[j2] = __builtin_shufflevector(__builtin_bit_cast(pg8::v4i_t, qraw[2 * j2]), __builtin_bit_cast(pg8::v4i_t, qraw[2 * j2 + 1]), 0, 1, 2, 3, 4, 5, 6, 7);
            if (F.lane < 32) { wsi[64 + r] = tq; wsi[96 + r] = slot; }
            f32x16 o[4]; float m = -1e30f, l = 0.f;
#pragma unroll
            for (int db = 0; db < 4; ++db)
#pragma unroll
                for (int i = 0; i < 16; ++i) o[db][i] = 0.f;
#define ATT2_TB(bb) ((size_t)((bb) >> 7) * SEQ + ((bb) & 15) * LBLK)
#define ATT2_H(bb) (((bb) >> 4) & 7)
#pragma unroll 1
            for (int kp2 = 0; kp2 < 2; ++kp2) {
                const int kt = 2 * kp2;
                { const bool cur3 = kt + 3 < 4, have3 = cur3 || hasn, have2 = (kt + 2 < 4) || hasn;
                  if (have3) { const int bb = cur3 ? bhj : bhjn; tile_load(F, K, V, ATT2_TB(bb), ATT2_H(bb), (kt + 3) & 3, rkB, rvB); }
                  if (kt == 0 && hasn) { cntn = (int)__hip_atomic_load(LCNT + bhjn, __ATOMIC_RELAXED, __HIP_MEMORY_SCOPE_AGENT); }
                  if (kt == 2 && hasn) { const unsigned char* qrow = Q + ((size_t)(bhjn >> 7) * SEQ + (entn & 4095)) * DM + ((bhjn >> 4) & 7) * DH + hh * 32;
#pragma unroll
                      for (int c = 0; c < 4; ++c) qraw[c] = *(const u32x4*)(qrow + (c >> 1) * 64 + (c & 1) * 16); }
                  tile_compute(F, 0, qr, o, m, l, kp2 == 0);
                  asm volatile("s_waitcnt lgkmcnt(0)" ::: "memory"); __builtin_amdgcn_s_barrier(); asm volatile("" ::: "memory");
                  if (have2) tile_write(F, 0, rkA, rvA); }
                { const bool have4 = hasn, have3 = (kt + 3 < 4) || hasn;
                  if (have4) { tile_load(F, K, V, ATT2_TB(bhjn), ATT2_H(bhjn), kt, rkA, rvA); }
                  if (kt == 0 && hasn) { const int qn = chunkn * 256 + F.wave * 32 + r; entn = LISTS[(size_t)bhjn * 4096 + (qn < cntn ? qn : 0)]; }
                  tile_compute(F, 1, qr, o, m, l, false);
                  asm volatile("s_waitcnt lgkmcnt(0)" ::: "memory"); __builtin_amdgcn_s_barrier(); asm volatile("" ::: "memory");
                  if (have3) tile_write(F, 1, rkB, rvB); }
            }
            const float lt = l + __shfl_xor(l, 32);
            if (hh == 0) { wsf[r] = 1.0f / lt; wsf[32 + r] = m + __builtin_amdgcn_logf(lt); }
            asm volatile("s_waitcnt lgkmcnt(0)" ::: "memory");
            int re = r, he = hh; asm volatile("" : "+v"(re), "+v"(he));
#pragma unroll
            for (int i = 0; i < 16; ++i) {
                const int q = crow(i, he); const float a = wsf[q]; const int t = wsi[64 + q], sl = wsi[96 + q];
                const unsigned w = pack_fp8x4(o[0][i] * a, o[1][i] * a, o[2][i] * a, o[3][i] * a);
                if (sl >= 0) { const size_t row = (((size_t)sl * NB + b) * SEQ + t) * NH + h; *(unsigned*)(OP + row * DH + 4 * re) = w; }
            }
            if (he == 0 && slot >= 0) LSE[(((size_t)slot * NB + b) * SEQ + tq) * NH + h] = wsf[32 + re];
            asm volatile("s_waitcnt lgkmcnt(0)" ::: "memory");
            if (!hasn) break;
            it = itn; bhj = bhjn; chunk = chunkn; cnt = cntn;
            { const int qn = chunk * 256 + F.wave * 32 + r; tq = entn & 4095; slot = (qn < cnt) ? (int)(entn >> 12) : -1; }
            itn = it + F.G; hasn = itn < total; if (hasn) ATT2_DECODE(itn, bhjn, chunkn);
        }
    }
    __syncthreads();
}

__device__ __forceinline__ void ph_attn_own(const Ctx& F) {
    using namespace att2;
    const unsigned char* Q = F.ws + WS_Q; const unsigned char* K = F.ws + WS_K; const unsigned char* V = F.ws + WS_V;
    const unsigned char* OP = F.ws + WS_OP; const float* LSE = (const float*)(F.ws + WS_LSE); bf16_t* YAB = (bf16_t*)(F.ws + WS_YAB);
    LAS float* wsf = (LAS float*)(F.lds + OFF_WS + F.wave * WSW);
    const int r = F.lane & 31, hh = F.lane >> 5;
    constexpr int NIT = NB * NH * NBLK;
    int it = F.vcu;
    if (it < NIT) {
        int itn = it + F.G; bool hasn = itn < NIT;
        u32x4 rkA, rvA, rkB, rvB;
#define OWN_TB(i_) ((size_t)((i_) >> 7) * SEQ + ((i_) & 15) * LBLK)
#define OWN_H(i_) (((i_) >> 4) & 7)
        tile_load(F, K, V, OWN_TB(it), OWN_H(it), 0, rkA, rvA); tile_load(F, K, V, OWN_TB(it), OWN_H(it), 1, rkB, rvB); tile_write(F, 0, rkA, rvA); tile_write(F, 1, rkB, rvB);
        tile_load(F, K, V, OWN_TB(it), OWN_H(it), 2, rkA, rvA);
        u32x4 qraw[4];
        { const unsigned char* qrow = Q + (OWN_TB(it) + F.wave * 32 + r) * DM + OWN_H(it) * DH + hh * 32;
#pragma unroll
          for (int c = 0; c < 4; ++c) qraw[c] = *(const u32x4*)(qrow + (c >> 1) * 64 + (c & 1) * 16); }
        __syncthreads();
        const int wdiag = F.wave >> 1;
        for (;;) {
            const int b = it >> 7, h = (it >> 4) & 7, j = it & 15, t0 = j * LBLK + F.wave * 32;
            pg8::v8i_t qr[2];
#pragma unroll
            for (int j2 = 0; j2 < 2; ++j2) qr[j2] = __builtin_shufflevector(__builtin_bit_cast(pg8::v4i_t, qraw[2 * j2]), __builtin_bit_cast(pg8::v4i_t, qraw[2 * j2 + 1]), 0, 1, 2, 3, 4, 5, 6, 7);
            f32x16 o[4]; float m = -1e30f, l = 0.f;
#pragma unroll
            for (int db = 0; db < 4; ++db)
#pragma unroll
                for (int i = 0; i < 16; ++i) o[db][i] = 0.f;
#pragma unroll 1
            for (int kp2 = 0; kp2 < 2; ++kp2) {
                const int kt = 2 * kp2;
                { const bool cur3 = kt + 3 < 4, have3 = cur3 || hasn, have2 = (kt + 2 < 4) || hasn;
                  if (have3) { const int ii = cur3 ? it : itn; tile_load(F, K, V, OWN_TB(ii), OWN_H(ii), (kt + 3) & 3, rkB, rvB); }
                  if (kt == 2 && hasn) { const unsigned char* qrow = Q + (OWN_TB(itn) + F.wave * 32 + r) * DM + OWN_H(itn) * DH + hh * 32;
#pragma unroll
                      for (int c = 0; c < 4; ++c) qraw[c] = *(const u32x4*)(qrow + (c >> 1) * 64 + (c & 1) * 16); }
                  if (kt <= wdiag) tile_compute<true>(F, 0, qr, o, m, l, kp2 == 0, kt == wdiag);
                  asm volatile("s_waitcnt lgkmcnt(0)" ::: "memory"); __builtin_amdgcn_s_barrier(); asm volatile("" ::: "memory");
                  if (have2) tile_write(F, 0, rkA, rvA); }
                { const bool have4 = hasn, have3 = (kt + 3 < 4) || hasn;
                  if (have4) { tile_load(F, K, V, OWN_TB(itn), OWN_H(itn), kt, rkA, rvA); }
                  if (kt + 1 <= wdiag) tile_compute<true>(F, 1, qr, o, m, l, false, kt + 1 == wdiag);
                  asm volatile("s_waitcnt lgkmcnt(0)" ::: "memory"); __builtin_amdgcn_s_barrier(); asm volatile("" ::: "memory");
                  if (have3) tile_write(F, 1, rkB, rvB); }
            }
            const int nv = j < 3 ? j : 3;
            {
                const float lt = l + __shfl_xor(l, 32); const float lse_own = m + __builtin_amdgcn_logf(lt);
                float ls[3];
#pragma unroll
                for (int s2 = 0; s2 < 3; ++s2) ls[s2] = (s2 < nv) ? LSE[(((size_t)s2 * NB + b) * SEQ + t0 + r) * NH + h] : -1e30f;
                const float M = fmaxf(fmaxf(lse_own, ls[0]), fmaxf(ls[1], ls[2]));
                const float w0 = __builtin_amdgcn_exp2f(lse_own - M);
                float w[3], den = w0;
#pragma unroll
                for (int s2 = 0; s2 < 3; ++s2) { w[s2] = (s2 < nv) ? __builtin_amdgcn_exp2f(ls[s2] - M) : 0.f; den += w[s2]; }
                const float inv = 1.0f / den;
                if (hh == 0) { wsf[r] = w0 * inv / lt; wsf[32 + r] = w[0] * inv; wsf[64 + r] = w[1] * inv; wsf[96 + r] = w[2] * inv; }
                asm volatile("s_waitcnt lgkmcnt(0)" ::: "memory");
            }
            int re = r, he = hh; asm volatile("" : "+v"(re), "+v"(he));
            LAS float* stg = (LAS float*)(F.lds + OFF_STG + F.wave * 8192);
            {
                unsigned pv[16][3];
#pragma unroll
                for (int i = 0; i < 16; ++i) { const int q = crow(i, he);
#pragma unroll
                    for (int s2 = 0; s2 < 3; ++s2) { pv[i][s2] = 0u; if (s2 < nv) pv[i][s2] = *(const unsigned*)(OP + ((((size_t)s2 * NB + b) * SEQ + t0 + q) * NH + h) * DH + 4 * re); } }
#pragma unroll
                for (int i = 0; i < 16; ++i) { const int q = crow(i, he); const float a = wsf[q];
                    float x0 = o[0][i] * a, x1 = o[1][i] * a, x2 = o[2][i] * a, x3 = o[3][i] * a;
#pragma unroll
                    for (int s2 = 0; s2 < 3; ++s2) { const float ww = wsf[32 * (s2 + 1) + q]; const f32x2v f0 = __builtin_amdgcn_cvt_pk_f32_fp8((int)pv[i][s2], false), f1 = __builtin_amdgcn_cvt_pk_f32_fp8((int)pv[i][s2], true);
                        x0 += ww * f0.x; x1 += ww * f0.y; x2 += ww * f1.x; x3 += ww * f1.y; }
                    o[0][i] = x0; o[1][i] = x1; o[2][i] = x2; o[3][i] = x3; }
            }
#pragma unroll
            for (int half = 0; half < 2; ++half) {
#pragma unroll
                for (int i = 0; i < 16; ++i) { const int q = crow(i, he); stg[q * 64 + re] = o[2 * half][i]; stg[q * 64 + 32 + re] = o[2 * half + 1][i]; }
                asm volatile("s_waitcnt lgkmcnt(0)" ::: "memory");
#pragma unroll
                for (int ps = 0; ps < 4; ++ps) {
                    const int q = ps * 8 + ((re + 32 * he) >> 3), dc = re & 7;
                    const f32x4 x = *(LAS const f32x4*)(stg + q * 64 + dc * 8), y = *(LAS const f32x4*)(stg + q * 64 + dc * 8 + 4);
                    *(u32x4*)(YAB + ((size_t)b * SEQ + t0 + q) * 2048 + 1024 + h * DH + half * 64 + dc * 8) = (u32x4){cvt_pk_bf16(x.x, x.y), cvt_pk_bf16(x.z, x.w), cvt_pk_bf16(y.x, y.y), cvt_pk_bf16(y.z, y.w)};
                }
                asm volatile("s_waitcnt lgkmcnt(0)" ::: "memory");
            }
            if (!hasn) break;
            it = itn; itn = it + F.G; hasn = itn < NIT;
        }
#undef OWN_TB
#undef OWN_H
    }
    __syncthreads();
}

__device__ __forceinline__ void ph_router(const Ctx& F) {
    const Args& A = *F.a;
    const bf16_t* Z = (const bf16_t*)(F.ws + WS_Z); const float* ZST = (const float*)(F.ws + WS_ZST); bf16_t* H1 = (bf16_t*)(F.ws + WS_H1); unsigned char* H1F8 = F.ws + WS_H1F8;
    int* TKE = (int*)(F.ws + WS_TKE); int* TKP = (int*)(F.ws + WS_TKP); unsigned* ECNT = (unsigned*)(F.ws + WS_CTL) + CW_ECNT; int* RT = (int*)(F.ws + WS_RT); float* RW = (float*)(F.ws + WS_RW);
    const float* wr = A.in[I_WR]; const float* br = A.in[I_BR];
    constexpr int RS = 2064, OFF_LO = 32 * RS, OFF_G = 2 * 32 * RS  , OFF_B = OFF_G + 4096, OFF_LG = OFF_B + 4096  , OFF_CNT = OFF_LG + 8 * 2112  ;
    static_assert(OFF_CNT + 256 <= LDS_BYTES, "router LDS map");
    LAS unsigned char* WH = F.lds; LAS unsigned char* WL = F.lds + OFF_LO;
    LAS float* LG = (LAS float*)(F.lds + OFF_G); LAS float* LB = (LAS float*)(F.lds + OFF_B);
    LAS float* lgt = (LAS float*)(F.lds + OFF_LG + F.wave * 2112);
    LAS unsigned* lcnt = (LAS unsigned*)(F.lds + OFF_CNT);
    {
        f32x4 wa[8], wb[8];
#pragma unroll
        for (int u_ = 0; u_ < 8; ++u_) { const int i = F.tid + 512 * u_, nq = i & 7, k2 = i >> 3;
            wa[u_] = *(const f32x4*)(wr + (size_t)(2 * k2) * NE + 4 * nq); wb[u_] = *(const f32x4*)(wr + (size_t)(2 * k2 + 1) * NE + 4 * nq); }
#pragma unroll
        for (int u_ = 0; u_ < 8; ++u_) { const int i = F.tid + 512 * u_, nq = i & 7, k2 = i >> 3;
#pragma unroll
            for (int c = 0; c < 4; ++c) {
                const float w0 = wa[u_][c], w1 = wb[u_][c];
                const unsigned h0 = f2bf(w0), h1 = f2bf(w1);
                const float r0 = w0 - __uint_as_float(h0 << 16), r1 = w1 - __uint_as_float(h1 << 16);
                *(LAS unsigned*)(WH + (4 * nq + c) * RS + k2 * 4) = h0 | (h1 << 16);
                *(LAS unsigned*)(WL + (4 * nq + c) * RS + k2 * 4) = pk2(r0, r1);
            } }
    }
    for (int i = F.tid; i < DM; i += 512) { LG[i] = A.in[I_LNMIX_G][i]; LB[i] = A.in[I_LNMIX_B][i]; }
    if (F.tid < 64) lcnt[F.tid] = 0u;
    __syncthreads();
    const int fr = F.lane & 15, kg = F.lane >> 4;
    const int ntask = T / 16, NGW = F.G * 8;
    const int rounds = (ntask + NGW - 1) / NGW;
    for (int rd = 0; rd < rounds; ++rd) {
        const int task = rd * NGW + F.vcu * 8 + F.wave;
        const bool live = task < ntask;
        int te[4] = {0, 0, 0, 0}; float tw[4] = {0.f, 0.f, 0.f, 0.f}; unsigned lp[4] = {0, 0, 0, 0};
        if (live) {
            const int tok = task * 16 + fr;
            float mean, rstd;
            { const f32x4* sp = (const f32x4*)(ZST + (size_t)tok * 32); float s1 = 0.f, s2 = 0.f;
#pragma unroll
              for (int i = 0; i < 8; ++i) { const f32x4 v = sp[i]; s1 += v.x + v.z; s2 += v.y + v.w; }
              mean = s1 * (1.f / DM); const float var = s2 * (1.f / DM) - mean * mean; rstd = 1.f / sqrtf(fmaxf(var, 0.f) + LN_EPS); }
            f32x4 acc0 = {0.f, 0.f, 0.f, 0.f}, acc1 = {0.f, 0.f, 0.f, 0.f};
            const bf16_t* zp = Z + (size_t)tok * DM + 8 * kg; unsigned char* h8 = H1F8 + (size_t)tok * DM + 8 * kg;
#pragma unroll 8
            for (int kk = 0; kk < 32; ++kk) {
                const u32x4 zr = *(const u32x4*)(zp + 32 * kk); const f32x4 z0 = {bflo(zr.x), bfhi(zr.x), bflo(zr.y), bfhi(zr.y)}, z1 = {bflo(zr.z), bfhi(zr.z), bflo(zr.w), bfhi(zr.w)};
                const f32x4 g0 = *(LAS const f32x4*)(LG + 32 * kk + 8 * kg), g1 = *(LAS const f32x4*)(LG + 32 * kk + 8 * kg + 4);
                const f32x4 b0 = *(LAS const f32x4*)(LB + 32 * kk + 8 * kg), b1 = *(LAS const f32x4*)(LB + 32 * kk + 8 * kg + 4);
                const f32x4 x0 = (z0 - mean) * rstd * g0 + b0, x1 = (z1 - mean) * rstd * g1 + b1;
                u32x4 hi; hi.x = cvt_pk_bf16(x0.x, x0.y); hi.y = cvt_pk_bf16(x0.z, x0.w); hi.z = cvt_pk_bf16(x1.x, x1.y); hi.w = cvt_pk_bf16(x1.z, x1.w);
                { unsigned w0 = 0u, w1 = 0u;
                  w0 = __builtin_amdgcn_cvt_pk_fp8_f32(x0.x, x0.y, w0, false); w0 = __builtin_amdgcn_cvt_pk_fp8_f32(x0.z, x0.w, w0, true);
                  w1 = __builtin_amdgcn_cvt_pk_fp8_f32(x1.x, x1.y, w1, false); w1 = __builtin_amdgcn_cvt_pk_fp8_f32(x1.z, x1.w, w1, true);
                  *(u32x2*)(h8 + 32 * kk) = (u32x2){w0, w1}; }
                u32x4 lo; lo.x = cvt_pk_bf16(x0.x - bflo(hi.x), x0.y - bfhi(hi.x)); lo.y = cvt_pk_bf16(x0.z - bflo(hi.y), x0.w - bfhi(hi.y));
                lo.z = cvt_pk_bf16(x1.x - bflo(hi.z), x1.y - bfhi(hi.z)); lo.w = cvt_pk_bf16(x1.z - bflo(hi.w), x1.w - bfhi(hi.w));
                const bf16x8 ah = __builtin_bit_cast(bf16x8, hi), al = __builtin_bit_cast(bf16x8, lo);
                const int bo = fr * RS + (32 * kk + 8 * kg) * 2;
                const bf16x8 wh0 = *(LAS const bf16x8*)(WH + bo), wh1 = *(LAS const bf16x8*)(WH + bo + 16 * RS), wl0 = *(LAS const bf16x8*)(WL + bo), wl1 = *(LAS const bf16x8*)(WL + bo + 16 * RS);
                acc0 = __builtin_amdgcn_mfma_f32_16x16x32_bf16(ah, wh0, acc0, 0, 0, 0); acc1 = __builtin_amdgcn_mfma_f32_16x16x32_bf16(ah, wh1, acc1, 0, 0, 0);
                acc0 = __builtin_amdgcn_mfma_f32_16x16x32_bf16(ah, wl0, acc0, 0, 0, 0); acc1 = __builtin_amdgcn_mfma_f32_16x16x32_bf16(ah, wl1, acc1, 0, 0, 0);
                acc0 = __builtin_amdgcn_mfma_f32_16x16x32_bf16(al, wh0, acc0, 0, 0, 0); acc1 = __builtin_amdgcn_mfma_f32_16x16x32_bf16(al, wh1, acc1, 0, 0, 0);
            }
            const float br0 = br[fr], br1 = br[16 + fr];
#pragma unroll
            for (int i = 0; i < 4; ++i) { lgt[(4 * kg + i) * 33 + fr] = acc0[i] + br0; lgt[(4 * kg + i) * 33 + 16 + fr] = acc1[i] + br1; }
            asm volatile("s_waitcnt lgkmcnt(0)" ::: "memory");
            if (F.lane < 16) {
                float lg[NE];
#pragma unroll
                for (int e = 0; e < NE; ++e) lg[e] = lgt[F.lane * 33 + e];
                float tv[4];
#pragma unroll
                for (int r = 0; r < 4; ++r) {
                    float best = -INFINITY; int bi = 0;
#pragma unroll
                    for (int e = 0; e < NE; ++e) { const bool c = lg[e] > best; best = c ? lg[e] : best; bi = c ? e : bi; }
#pragma unroll
                    for (int e = 0; e < NE; ++e) lg[e] = (e == bi) ? -INFINITY : lg[e];
                    te[r] = bi; tv[r] = best;
                }
                const float e1 = __expf(tv[1] - tv[0]), e2 = __expf(tv[2] - tv[0]), e3 = __expf(tv[3] - tv[0]); const float inv = 1.f / (1.f + e1 + e2 + e3);
                tw[0] = inv; tw[1] = e1 * inv; tw[2] = e2 * inv; tw[3] = e3 * inv;
#pragma unroll
                for (int r = 0; r < 4; ++r) lp[r] = atomicAdd((unsigned*)(lcnt + te[r]), 1u);
            }
        }
        __syncthreads();
        if (F.tid < 32) { const unsigned c = lcnt[F.tid]; lcnt[32 + F.tid] = c ? atomicAdd(&ECNT[F.tid], c) : 0u; }
        __syncthreads();
        if (live && F.lane < 16) {
            const size_t tok = (size_t)task * 16 + F.lane;
            int4 pe = {te[0], te[1], te[2], te[3]};
            int4 pp = {(int)(lcnt[32 + te[0]] + lp[0]), (int)(lcnt[32 + te[1]] + lp[1]), (int)(lcnt[32 + te[2]] + lp[2]), (int)(lcnt[32 + te[3]] + lp[3])};
            *(int4*)(TKE + tok * 4) = pe; *(int4*)(TKP + tok * 4) = pp;
#pragma unroll
            for (int r = 0; r < 4; ++r) { const size_t o_ = (size_t)te[r] * T + (r == 0 ? pp.x : r == 1 ? pp.y : r == 2 ? pp.z : pp.w); RT[o_] = (int)tok; RW[o_] = tw[r]; }
        }
        __syncthreads();
        if (F.tid < 32) lcnt[F.tid] = 0u;
        __syncthreads();
    }
}

__device__ __forceinline__ void moe_table(const Ctx& F) {
    const unsigned* ECNT = (const unsigned*)(F.ws + WS_CTL) + CW_ECNT;
    LAS int* tab = (LAS int*)(F.lds + LDS_MOE);
    __syncthreads();
    if (F.tid == 0) {
        int acc = 0;
        for (int e = 0; e < NE; ++e) { const int c = (int)__hip_atomic_load(ECNT + e, __ATOMIC_RELAXED, __HIP_MEMORY_SCOPE_AGENT); tab[32 + e] = acc; acc += (c + 255) / 256 * 256; }
        tab[64] = acc; tab[0] = acc / 256;
    }
    __syncthreads();
    const int ntiles = tab[0];
    for (int i = F.tid; i < ntiles; i += 512) { int e = 0; for (int k = 1; k < NE; ++k) if (i * 256 >= tab[32 + k]) e = k; tab[128 + 2 * i] = e; tab[129 + 2 * i] = i - tab[32 + e] / 256; }
    __syncthreads();
}

__device__ __forceinline__ void ln_stats16(const float* st, int lane, float& mean, float& rstd) {
    float s1 = 0.f, s2 = 0.f;
    if (lane < 16) { const f32x2 p = *(const f32x2*)(st + 2 * lane); s1 = p.x; s2 = p.y; }
    s1 = wave_sum(s1); s2 = wave_sum(s2);
    mean = s1 * (1.f / DM); const float var = s2 * (1.f / DM) - mean * mean; rstd = 1.f / sqrtf(fmaxf(var, 0.f) + LN_EPS);
}
__device__ __forceinline__ void ph_final(const Ctx& F) {
    const Args& A = *F.a;
    const bf16_t* Z = (const bf16_t*)(F.ws + WS_Z); const float* ZST = (const float*)(F.ws + WS_ZST); const unsigned char* YS = F.ws + WS_YS; const int* TKE = (const int*)(F.ws + WS_TKE); const int* TKP = (const int*)(F.ws + WS_TKP);
    const LAS int* tab = (const LAS int*)(F.lds + LDS_MOE);
    const int gw = F.vcu * 8 + F.wave, NGW = F.G * 8;
    f32x4 g2[4], b2[4], g1[4], b1[4];
#pragma unroll
    for (int j = 0; j < 4; ++j) { g2[j] = *((const f32x4*)A.in[I_LNF_G] + F.lane + 64 * j); b2[j] = *((const f32x4*)A.in[I_LNF_B] + F.lane + 64 * j);
        g1[j] = *((const f32x4*)A.in[I_LNMIX_G] + F.lane + 64 * j) * ALPHA; b1[j] = *((const f32x4*)A.in[I_LNMIX_B] + F.lane + 64 * j) * ALPHA; }
    for (int m = gw; m < T; m += NGW) {
        float mean, rstd; ln_stats16(ZST + (size_t)m * 32, F.lane, mean, rstd);
        const u32x2* hr = (const u32x2*)(Z + (size_t)m * DM) + F.lane;
        f32x4 v[4];
#pragma unroll
        for (int j = 0; j < 4; ++j) { const u32x2 hb = hr[64 * j]; v[j] = ((f32x4){bflo(hb.x), bfhi(hb.x), bflo(hb.y), bfhi(hb.y)} - mean) * rstd * g1[j] + b1[j]; }
#pragma unroll
        for (int k = 0; k < 4; ++k) {
            const int row = tab[32 + TKE[(size_t)m * 4 + k]] + TKP[(size_t)m * 4 + k]; const unsigned* yr = (const unsigned*)(YS + (size_t)row * DM) + F.lane;
#pragma unroll
            for (int j = 0; j < 4; ++j) { const unsigned y = yr[64 * j]; const f32x2v f0 = __builtin_amdgcn_cvt_pk_f32_fp8((int)y, false), f1 = __builtin_amdgcn_cvt_pk_f32_fp8((int)y, true);
                v[j].x += 0.0625f * f0.x; v[j].y += 0.0625f * f0.y; v[j].z += 0.0625f * f1.x; v[j].w += 0.0625f * f1.y; }
        }
        float s = 0.f;
#pragma unroll
        for (int j = 0; j < 4; ++j) s += (v[j].x + v[j].y) + (v[j].z + v[j].w);
        const float mu = wave_sum(s) * (1.f / DM); float s2 = 0.f;
#pragma unroll
        for (int j = 0; j < 4; ++j) { v[j] = v[j] - mu; s2 += (v[j].x * v[j].x + v[j].y * v[j].y) + (v[j].z * v[j].z + v[j].w * v[j].w); }
        const float rs = 1.f / sqrtf(wave_sum(s2) * (1.f / DM) + LN_EPS);
        f32x4* orow = (f32x4*)(A.out + (size_t)m * DM) + F.lane;
#pragma unroll
        for (int j = 0; j < 4; ++j) orow[64 * j] = v[j] * rs * g2[j] + b2[j];
    }
}

#define XB_TMO      128
#define XB_XCNT(j)  (256  + 64 * (j))
#define XB_XSUB(j)  (1280 + 64 * (j))
#define XB_XGEN(j)  (2304 + 64 * (j))
#define XB_TOP      3328
#define XB_TOPGEN   3392
#define XCD_BAR_WORDS 3456
#define XB_SPIN_CAP (1u << 18)
__device__ __forceinline__ unsigned xb_ld(unsigned* p)              { return __hip_atomic_load(p, __ATOMIC_RELAXED, __HIP_MEMORY_SCOPE_AGENT); }
__device__ __forceinline__ unsigned xb_add(unsigned* p, unsigned v) { return __hip_atomic_fetch_add(p, v, __ATOMIC_RELAXED, __HIP_MEMORY_SCOPE_AGENT); }
__device__ __forceinline__ unsigned xb_xcc_id() { return (unsigned)__builtin_amdgcn_s_getreg((3 << 11) | 20) & 0xFu; }
#define XB_SPIN(cond, bar) do { unsigned _sp = 0; while (cond) { __builtin_amdgcn_s_sleep(1); \
    if ((++_sp & 255u) == 0u) { if (xb_ld(&(bar)[XB_TMO])) break; if (_sp > XB_SPIN_CAP) { atomicAdd(&(bar)[XB_TMO], 1u); break; } } } } while (0)
__device__ __forceinline__ void xcd_barrier_complete(unsigned* bar, unsigned x, unsigned& nloc, unsigned& nx) {
    const unsigned G = gridDim.x * gridDim.y * gridDim.z;
    unsigned sum, cnt, mine, sp = 0u;
    for (;;) {
        sum = 0u; cnt = 0u; mine = 0u;
#pragma unroll
        for (unsigned j = 0; j < 16; ++j) { const unsigned c = xb_ld(&bar[XB_XCNT(j)]); sum += c; cnt += (c > 0u) ? 1u : 0u; mine = (j == x) ? c : mine; }
        if (sum == G) break;
        __builtin_amdgcn_s_sleep(1);
        if ((++sp & 255u) == 0u) { if (xb_ld(&bar[XB_TMO])) break; if (sp > XB_SPIN_CAP) { atomicAdd(&bar[XB_TMO], 1u); break; } }
    }
    nloc = mine > 0u ? mine : 1u; nx = cnt > 0u ? cnt : 1u;
}
__device__ __forceinline__ void xcd_barrier(unsigned* bar, volatile LAS unsigned* st, unsigned x, bool leader_thread) {
    asm volatile("s_waitcnt vmcnt(0)" ::: "memory");
    __syncthreads();
    if (leader_thread) {
        __builtin_amdgcn_s_waitcnt(0);
        unsigned nloc = st[0], nx = st[1];
        if (nloc == 0u) { xcd_barrier_complete(bar, x, nloc, nx); st[0] = nloc; st[1] = nx; }
        const unsigned old = xb_add(&bar[XB_XSUB(x)], 1u);
        const unsigned gen = old / nloc;
        if (old + 1u == (gen + 1u) * nloc) {
            __builtin_amdgcn_fence(__ATOMIC_RELEASE, "agent");
            asm volatile("s_waitcnt vmcnt(0)" ::: "memory");
            const unsigned og = xb_add(&bar[XB_TOP], 1u);
            const unsigned tg = og / nx;
            if (og + 1u == (tg + 1u) * nx) xb_add(&bar[XB_TOPGEN], 1u);
            else XB_SPIN(xb_ld(&bar[XB_TOPGEN]) == tg, bar);
            __builtin_amdgcn_fence(__ATOMIC_ACQUIRE, "agent");
            xb_add(&bar[XB_XGEN(x)], 1u);
            asm volatile("s_waitcnt vmcnt(0)" ::: "memory");
        } else {
            XB_SPIN(xb_ld(&bar[XB_XGEN(x)]) == gen, bar);
            __builtin_amdgcn_fence(__ATOMIC_ACQUIRE, "agent");
            asm volatile("s_waitcnt vmcnt(0)" ::: "memory");
        }
    }
    __syncthreads();
}

template <bool COOP>
__global__ void __launch_bounds__(512, 2) mega(Args args) {
    extern __shared__ __attribute__((aligned(16))) unsigned char lds_raw[];
    Ctx F;
    const int wave0 = __builtin_amdgcn_readfirstlane(threadIdx.x >> 6);
#define MKCTX() do { F.a = &args; F.ws = args.ws; F.lds = (LAS unsigned char*)lds_raw; F.ldsg = lds_raw; F.lane = lane_id_asm(); F.wave = wave0; F.tid = wave0 * 64 + F.lane; \
    F.G = gridDim.x; { const int bx = blockIdx.x; F.vcu = (F.G % 8 == 0) ? (bx % 8) * (F.G / 8) + bx / 8 : bx; } } while (0)
    MKCTX();
    const int lo = args.ph_lo, hi = args.ph_hi;
    unsigned char* ws = args.ws;
#ifndef PHMASK
#define PHMASK 0xFFFF
#endif
#define IN(k) (((PHMASK >> (k)) & 1) && lo <= (k) && (k) < hi)
    unsigned* barw = (unsigned*)(ws + WS_CTL) + CW_BAR; volatile LAS unsigned* bst = (volatile LAS unsigned*)((LAS unsigned char*)lds_raw + LDS_BYTES - 64);
    const unsigned my_xcc = xb_xcc_id();
    if (COOP) { if (threadIdx.x == 0) { bst[0] = 0u; bst[1] = 0u; (void)xb_add(&barw[XB_XCNT(my_xcc)], 1u); } __syncthreads(); }
#define SEAM(k) do { if (COOP && IN(k) && IN((k) + 1)) { if (args.ph_hi > 1000) cg::this_grid().sync();   xcd_barrier(barw, bst, my_xcc, wave0 == 0 && lane_id_asm() == 0); } } while (0)
    if (IN(0)) { MKCTX(); ph_prologue(F); } SEAM(0);
    if (IN(1)) {
        {
            pg8::Gemm g{(const bf16_t*)(ws + WS_H0), (const bf16_t*)(ws + WS_WIN), DM, DM, DM, nullptr}; pg8::StaticOrder S; S.init(T, (PN8_LO + 28 - PN8_HI) * 256, F.G, (int)blockIdx.x, 0, PN8_LO, PN8_HI - PN8_LO);
            const pg8::Epi1 E{(bf16_t*)(ws + WS_YAB), (bf16_t*)(ws + WS_GV), ws + WS_Q, ws + WS_K, ws + WS_V, (bf16_t*)(ws + WS_SA), (bf16_t*)(ws + WS_SB), (float*)(ws + WS_GVST), (float*)(ws + WS_KMEAN), 1.0f, 0.f};
            pg8::gemm_phase<pg8::Epi1, pg8::StaticOrder, true>(F.lds, g, S, E, wave0);
        }
        {
            const pg8::Epi1 E{(bf16_t*)(ws + WS_YAB), (bf16_t*)(ws + WS_GV), ws + WS_Q, ws + WS_K, ws + WS_V, (bf16_t*)(ws + WS_SA), (bf16_t*)(ws + WS_SB), (float*)(ws + WS_GVST), (float*)(ws + WS_KMEAN), 0.03125f, 0.f};
            pg8::Gemm g{(const bf16_t*)(ws + WS_H0F8), (const bf16_t*)(ws + WS_WIN8), DM / 2, DM / 2, DM / 2, nullptr}; pg8::StaticOrder S; S.init(T, (PN8_HI - PN8_LO) * 256, F.G, (int)blockIdx.x, PN8_LO);
            pg8::gemm_phase<pg8::Epi1, pg8::StaticOrder, true, true>(F.lds, g, S, E, wave0);
        }
    } SEAM(1);
    if (IN(2)) { MKCTX(); ph_mixer_a(F); __syncthreads(); ph_gate(F); } SEAM(2);
    if (IN(3)) { } if (COOP && IN(3) && IN(4)) { }
    if (IN(4)) { MKCTX(); ph_attn_partial(F); } SEAM(4);
    if (IN(5)) { MKCTX(); ph_attn_own(F); } SEAM(5);
    if (IN(6)) {
        pg8::Gemm g{(const bf16_t*)(ws + WS_YAB), (const bf16_t*)(ws + WS_WAB), 2048, 2048, 2048, nullptr}; pg8::StaticOrder S; S.init(T, DM, F.G, (int)blockIdx.x);
        pg8::Epi2 E{ws + WS_SA, ws + WS_SB, (bf16_t*)(ws + WS_MG)};
        pg8::gemm_phase<pg8::Epi2, pg8::StaticOrder, true>(F.lds, g, S, E, wave0);
    } SEAM(6);
    if (IN(7)) {
        pg8::Gemm g{(const bf16_t*)(ws + WS_MG), (const bf16_t*)(ws + WS_WOUT), DM, DM, DM, nullptr}; pg8::StaticOrder S; S.init(T, DM, F.G, (int)blockIdx.x);
        pg8::Epi3 E{(const bf16_t*)(ws + WS_H0), (bf16_t*)(ws + WS_Z), (float*)(ws + WS_ZST)};
        pg8::gemm_phase<pg8::Epi3, pg8::StaticOrder, true>(F.lds, g, S, E, wave0);
    } SEAM(7);
    if (IN(8)) { MKCTX(); ph_router(F); } SEAM(8);
    if (IN(9)) { } if (COOP && IN(9) && IN(10)) { }
    if (IN(10)) {
        MKCTX(); moe_table(F);
        pg8::Gemm g{(const bf16_t*)(ws + WS_H1F8), (const bf16_t*)(ws + WS_WUP), DM / 2, DM / 2, DM / 2, (const int*)(ws + WS_RT)}; pg8::MoeOrder S;   S.init((const LAS int*)(F.lds + LDS_MOE), 8, F.G, (int)blockIdx.x);
        pg8::Epi4 E{args.in[I_BUP], ws + WS_ACT};
        pg8::gemm_phase<pg8::Epi4, pg8::MoeOrder, true, true, true>(F.lds, g, S, E, wave0);
    } SEAM(10);
    if (IN(11)) {
        MKCTX(); moe_table(F);
        pg8::Gemm g{(const bf16_t*)(ws + WS_ACT), (const bf16_t*)(ws + WS_WDN), FF / 2, FF / 2, FF / 2, nullptr}; pg8::MoeOrder S; S.init((const LAS int*)(F.lds + LDS_MOE), 4, F.G, (int)blockIdx.x);
        pg8::Epi5 E{args.in[I_BDN], (const float*)(ws + WS_RW), ws + WS_YS};
        pg8::gemm_phase<pg8::Epi5, pg8::MoeOrder, true, true>(F.lds, g, S, E, wave0);
    } SEAM(11);
    if (IN(12)) { MKCTX(); moe_table(F); ph_final(F); }
#undef IN
#undef SEAM
}

extern "C" void kernel_launch(void* const* d_in, const int* in_sizes, int n_in, void* d_out, int out_size, void* d_ws, size_t ws_size, hipStream_t stream) {
    static int grid = 0;
    if (grid == 0) {
        if (n_in != 21 || in_sizes[0] != T * DM || out_size != T * DM || ws_size < WS_END) { fprintf(stderr, "kernel_launch: unexpected shapes (n_in %d, in0 %d, out %d, ws %zu)\n", n_in, n_in > 0 ? in_sizes[0] : -1, out_size, ws_size); grid = -1; return; }
        int dev = 0, cus = 0, per_cu = 0;
        hipGetDevice(&dev); hipDeviceGetAttribute(&cus, hipDeviceAttributeMultiprocessorCount, dev);
        const void* fn = MK_COOP ? (const void*)mega<true> : (const void*)mega<false>;
        hipFuncSetAttribute(fn, hipFuncAttributeMaxDynamicSharedMemorySize, LDS_BYTES);
        hipOccupancyMaxActiveBlocksPerMultiprocessor(&per_cu, fn, 512, LDS_BYTES);
        (void)hipGetLastError();
        if (per_cu < 1) { fprintf(stderr, "kernel_launch: occupancy query says %d blocks/CU\n", per_cu); per_cu = 1; }
        grid = cus * 1;
    }
    if (grid < 0) return;
    hipMemsetAsync((char*)d_ws + WS_CTL, 0, CTL_ZERO_BYTES, stream);
    Args a{};
    for (int i = 0; i < 21; ++i) a.in[i] = (const float*)d_in[i];
    a.out = (float*)d_out; a.ws = (unsigned char*)d_ws;
#if MK_COOP
    a.ph_lo = 0; a.ph_hi = NPHASE;
    void* kargs[] = {&a};
    hipError_t e = hipLaunchCooperativeKernel((const void*)mega<true>, dim3(grid), dim3(512), kargs, LDS_BYTES, stream);
    if (e != hipSuccess) fprintf(stderr, "cooperative launch failed: %s (grid %d)\n", hipGetErrorString(e), grid);
#else
    for (int p = 0; p < NPHASE; ++p) { a.ph_lo = p; a.ph_hi = p + 1; hipLaunchKernelGGL(mega<false>, dim3(grid), dim3(512), LDS_BYTES, stream, a); }
#endif
}
```

```cpp
#include <hip/hip_runtime.h>
#include <hip/hip_cooperative_groups.h>
#include <cstdio>
#include <cstdint>
namespace cg = cooperative_groups;

#ifndef MK_COOP
#define MK_COOP 1
#endif

#define LAS __attribute__((address_space(3)))
typedef unsigned short bf16_t;
typedef short bf16x8 __attribute__((ext_vector_type(8)));
typedef float f32x4 __attribute__((ext_vector_type(4)));
typedef float f32x2 __attribute__((ext_vector_type(2)));
typedef unsigned u32x4 __attribute__((ext_vector_type(4)));
typedef unsigned u32x2 __attribute__((ext_vector_type(2)));

constexpr int NB = 8, SEQ = 4096, DM = 1024, T = NB * SEQ;
constexpr int NH = 8, DH = 128, LBLK = 256, NBLK = SEQ / LBLK;
constexpr int NE = 32, TOPK = 4, FF = 1024;
constexpr int INCOLS = 7 * DM;
constexpr int RMAX = T * TOPK + NE * 256;
constexpr float LN_EPS = 1e-5f;
constexpr float ALPHA = 1.189207115002721f;
constexpr float QSCALE = 0.08838834764831845f * 1.4426950408889634f;

constexpr size_t MiB = 1u << 20, U64 = 64 * MiB;
constexpr size_t WS_CTL = 0, CTL_ZERO_BYTES = 1 * MiB;
constexpr int CW_ECNT = 64;
constexpr int CW_LCNT = 1024;
constexpr int CW_BAR = 4096;
constexpr size_t WS_KMEAN = 1 * MiB;
constexpr size_t WS_GVST = 2 * MiB;
constexpr size_t WS_ZST = 6 * MiB;
constexpr size_t WS_SEL = 10 * MiB;
constexpr size_t WS_TKE = 11 * MiB;
constexpr size_t WS_TKW = 11 * MiB + 512 * 1024;
constexpr size_t WS_TKP = 12 * MiB;
constexpr size_t WS_ROWOF = 12 * MiB + 512 * 1024;
constexpr size_t WS_ROWTOK = 13 * MiB;
constexpr size_t WS_ROWW = 14 * MiB;
constexpr size_t WS_TILE = 15 * MiB;
constexpr size_t WS_LISTS = 16 * MiB;
constexpr size_t WS_LSE = 32 * MiB;
constexpr size_t WS_RT = 16 * MiB;
constexpr size_t WS_RW = 20 * MiB;
constexpr int LDS_MOE = 131072 + 1024;
constexpr size_t WS_WIN = 40 * MiB;
constexpr size_t WS_WAB = 54 * MiB;
constexpr size_t WS_WOUT = 58 * MiB;
constexpr size_t WS_WDN = 60 * MiB;
constexpr size_t WS_WUP = 124 * MiB;
constexpr size_t WS_H0 = 4 * U64;
constexpr size_t WS_YAB = 5 * U64;
constexpr size_t WS_GV = 7 * U64;
constexpr size_t WS_Q = 8 * U64, WS_K = 9 * U64, WS_V = 10 * U64, WS_SA = 11 * U64, WS_SB = 12 * U64;
constexpr size_t WS_OP = 13 * U64;
constexpr size_t WS_MG = WS_GV;
constexpr size_t WS_Z = 14 * U64;
constexpr size_t WS_H1 = WS_H0;
constexpr size_t WS_XG = 5 * U64;
constexpr size_t WS_H1F8 = 12 * U64;
constexpr size_t WS_ACT = 9 * U64 + 16 * MiB;
constexpr size_t WS_YS = WS_XG;
constexpr size_t WS_H0F8 = 13 * U64;
constexpr size_t WS_WIN8 = 192 * MiB;
constexpr int PN8_LO = 8, PN8_HI = 28;
constexpr size_t WS_END = 16 * U64;
static_assert(WS_XG + (size_t)RMAX * 2048 <= WS_ACT && WS_ACT + (size_t)RMAX * 2048 <= WS_Z, "ws map");

constexpr int LDS_BYTES = 163840;
constexpr int LDS_MISC = 131072;
constexpr int NPHASE = 13;

__device__ __forceinline__ float bf2f(bf16_t v) { return __uint_as_float((unsigned)v << 16); }
__device__ __forceinline__ float bflo(unsigned u) { return __uint_as_float(u << 16); }
__device__ __forceinline__ float bfhi(unsigned u) { return __uint_as_float(u & 0xffff0000u); }
__device__ __forceinline__ unsigned f2bf(float f) { unsigned u = __builtin_bit_cast(unsigned, f); return (u + 0x7fffu + ((u >> 16) & 1u)) >> 16; }
__device__ __forceinline__ unsigned pk2(float lo, float hi) { return f2bf(lo) | (f2bf(hi) << 16); }
typedef __bf16 bf16x2_t __attribute__((ext_vector_type(2)));
__device__ __forceinline__ unsigned cvt_pk_bf16(float lo, float hi) { f32x2 v = {lo, hi}; bf16x2_t b = __builtin_convertvector(v, bf16x2_t); return __builtin_bit_cast(unsigned, b); }
__device__ __forceinline__ int lane_id_asm() { int l; asm volatile("v_mbcnt_lo_u32_b32 %0, -1, 0\n\tv_mbcnt_hi_u32_b32 %0, -1, %0" : "=v"(l)); return l; }
__device__ __forceinline__ float wave_sum(float v) {
#pragma unroll
    for (int o = 1; o < 64; o <<= 1) v += __shfl_xor(v, o);
    return v;
}
__device__ __forceinline__ float wave_max(float v) {
#pragma unroll
    for (int o = 1; o < 64; o <<= 1) v = fmaxf(v, __shfl_xor(v, o));
    return v;
}
__device__ __forceinline__ f32x2 gelu_pk(f32x2 v) {
    const f32x2 av = __builtin_elementwise_abs(v), d = av * 0.2316418882f + 1.0f;
    f32x2 t; t.x = __builtin_amdgcn_rcpf(d.x); t.y = __builtin_amdgcn_rcpf(d.y);
    f32x2 q = t * 0.5307027145f + (-0.7265760135f); q = q * t + 0.7107068705f; q = q * t + (-0.142248368f); q = q * t + 0.127414796f; q = q * t;
    const f32x2 s = (v * v) * (-0.72134752044f);
    f32x2 e; e.x = __builtin_amdgcn_exp2f(s.x); e.y = __builtin_amdgcn_exp2f(s.y);
    const f32x2 m = v * (q * e), r = v - m;
    f32x2 o; o.x = v.x < 0.f ? m.x : r.x; o.y = v.y < 0.f ? m.y : r.y; return o;
}
typedef float f32x2v __attribute__((ext_vector_type(2)));
template <bool HI> __device__ __forceinline__ unsigned f8x2_to_bf16x2(unsigned w) { const f32x2v f = __builtin_amdgcn_cvt_pk_f32_fp8((int)w, HI); return cvt_pk_bf16(f.x, f.y); }
__device__ __forceinline__ u32x4 f8x8_to_bf16x8(unsigned lo, unsigned hi) { return (u32x4){f8x2_to_bf16x2<false>(lo), f8x2_to_bf16x2<true>(lo), f8x2_to_bf16x2<false>(hi), f8x2_to_bf16x2<true>(hi)}; }
__device__ __forceinline__ unsigned pack_fp8x4(float a, float b, float c, float d) { unsigned w = 0u; w = __builtin_amdgcn_cvt_pk_fp8_f32(a, b, w, false); w = __builtin_amdgcn_cvt_pk_fp8_f32(c, d, w, true); return w; }
__device__ __forceinline__ float sigmoidf_(float x) { return __builtin_amdgcn_rcpf(1.0f + __builtin_amdgcn_exp2f(-1.4426950408889634f * x)); }

namespace pg8 {
constexpr int BM = 256, BK = 64, HALF = 128, HTB = HALF * BK * 2, STAGE_BYTES = 8 * HTB, NXCD = 8, WGM = 8;
__host__ __device__ __forceinline__ int lds_byte(int r, int c) { const int st = (r >> 4) * 2 + (c >> 5), rr = r & 15, cc = c & 31, ob = rr * 64 + cc * 2; return st * 1024 + (ob ^ (((ob >> 9) & 1) << 5)); }
__host__ __device__ __forceinline__ void stage_rc(int b, int& R, int& C) { const int st = b / 1024, sb = b % 1024, swz = sb ^ (((sb >> 9) & 1) << 5); R = (st >> 1) * 16 + swz / 64; C = (st & 1) * 32 + (swz % 64) / 2; }
__host__ __device__ __forceinline__ int perm32(int rho) { const int n = rho >> 4, i = rho & 15; return 8 * (i >> 2) + 4 * n + (i & 3); }

struct Unit { int pm, pn, bt, rbase; };
struct Gemm { const bf16_t* A; const bf16_t* Bt; int K, lda, ldb; const int* rowidx; };

struct StaticOrder {
    int nM, nN, nwg, G, c, pbase, psplit, pjump;
    __device__ void init(int M, int N, int G_, int c_, int pbase_ = 0, int psplit_ = 1 << 20, int pjump_ = 0) { nM = M / BM; nN = N / BM; nwg = nM * nN; G = G_; c = c_; pbase = pbase_; psplit = psplit_; pjump = pjump_; }
    __device__ bool next(int i, Unit& u) const {
        const long L = (long)i * G + c; if (L >= nwg) return false;
        int wgid = (int)L; { const int q = nwg / NXCD, r = nwg % NXCD, xcd = wgid % NXCD, off = wgid / NXCD; wgid = (xcd < r ? xcd * (q + 1) : r * (q + 1) + (xcd - r) * q) + off; }
        const int nig = WGM * nN, gid = wgid / nig, fm = gid * WGM, gsz = (nM - fm) < WGM ? (nM - fm) : WGM;
        u.pm = fm + ((wgid % nig) % gsz); const int p = (wgid % nig) / gsz; u.pn = pbase + (p < psplit ? p : p + pjump); u.bt = u.pn; u.rbase = u.pm * BM; return true;
    }
};
struct MoeOrder {
    int nM, nN, nwg, G, c; const LAS int* tab;
    __device__ void init(const LAS int* tiletab, int nN_, int G_, int c_) { nM = tiletab[0]; tab = tiletab; nN = nN_; nwg = nM * nN; G = G_; c = c_; }
    __device__ bool next(int i, Unit& u) const {
        const long L = (long)i * G + c; if (L >= nwg) return false;
        int wgid = (int)L; { const int q = nwg / NXCD, r = nwg % NXCD, xcd = wgid % NXCD, off = wgid / NXCD; wgid = (xcd < r ? xcd * (q + 1) : r * (q + 1) + (xcd - r) * q) + off; }
        const int nig = WGM * nN, gid = wgid / nig, fm = gid * WGM, gsz = (nM - fm) < WGM ? (nM - fm) : WGM;
        u.pm = fm + ((wgid % nig) % gsz); u.pn = (wgid % nig) / gsz; { const int e = tab[128 + 2 * u.pm], tl = tab[129 + 2 * u.pm]; u.bt = e * nN + u.pn; u.rbase = e * T + tl * BM; } return true;
    }
};

typedef int v4i_t __attribute__((ext_vector_type(4)));
typedef int v8i_t __attribute__((ext_vector_type(8)));
template <class Epi, class Sched, bool ALIGN_EPI, bool FP8 = false, bool GATHER = false>
__device__ __forceinline__ void gemm_phase(LAS unsigned char* lds, const Gemm g, const Sched& S, const Epi& E, const int wid) {
    const int lane = lane_id_asm(), tid = wid * 64 + lane;
    const int wr = wid >> 2, wc = wid & 3, fr = lane & 15, fq = lane >> 4;
    const int nt = g.K / BK;
    unsigned voffA[2], voffB[2]; int gR[2];
#pragma unroll
    for (int i = 0; i < 2; ++i) { int R, C; stage_rc(tid * 16 + i * 8192, R, C); const int Rb = Epi::PERM ? ((R & ~31) + perm32(R & 31)) : R;
        voffA[i] = GATHER ? (unsigned)C * 2u : (unsigned)(R * g.lda + C) * 2u; voffB[i] = (unsigned)(Rb * g.ldb + C) * 2u; gR[i] = R; }
    const size_t kstep = (size_t)(BK * 2);
    const size_t hstepA = GATHER ? 0 : (size_t)HALF * g.lda * 2, hstepB = (size_t)HALF * g.ldb * 2;
    const size_t tstepA = 2 * hstepA, tstepB = 2 * hstepB;
    const unsigned ldsw = (unsigned)wid * 1024u;
    const int aoff = lds_byte(wr * 64 + fr, fq * 8), boff = lds_byte(wc * 32 + fr, fq * 8);
#define PG8_SA(b, h) (((b) * 2 + (h)) * HTB)
#define PG8_SB(b, h) ((4 + (b) * 2 + (h)) * HTB)
#define PG8_STAGE(bufoff, gbase, voff) do { _Pragma("unroll") for (int _i = 0; _i < 2; ++_i) \
        __builtin_amdgcn_global_load_lds((const unsigned*)((const char*)(gbase) + (voff)[_i]), (LAS unsigned*)(lds + (bufoff) + ldsw + _i * 8192), 16, 0, 0); } while (0)
#define PG8_LD8(p) __builtin_shufflevector(*(const LAS v4i_t*)(p), *(const LAS v4i_t*)((p) + 1024), 0, 1, 2, 3, 4, 5, 6, 7)
#define PG8_LDA(dst, b, h) do { _Pragma("unroll") for (int m = 0; m < 4; ++m) { if constexpr (FP8) dst##8[m] = PG8_LD8(lds + PG8_SA(b, h) + aoff + m * 2048); \
        else { _Pragma("unroll") for (int k = 0; k < 2; ++k) dst[m][k] = *(const LAS bf16x8*)(lds + PG8_SA(b, h) + aoff + m * 2048 + k * 1024); } } } while (0)
#define PG8_LDB(dst, b, h) do { _Pragma("unroll") for (int n = 0; n < 2; ++n) { if constexpr (FP8) dst##8[n] = PG8_LD8(lds + PG8_SB(b, h) + boff + n * 2048); \
        else { _Pragma("unroll") for (int k = 0; k < 2; ++k) dst[n][k] = *(const LAS bf16x8*)(lds + PG8_SB(b, h) + boff + n * 2048 + k * 1024); } } } while (0)
#define PG8_MMA(ai, bj, At, Bt) do { __builtin_amdgcn_s_setprio(1); _Pragma("unroll") for (int m = 0; m < 4; ++m) _Pragma("unroll") for (int n = 0; n < 2; ++n) { \
        if constexpr (FP8) { asm volatile("s_nop 1\n\tv_mfma_scale_f32_16x16x128_f8f6f4 %0, %1, %2, %0, %3, %3 op_sel_hi:[0,0,0]" : "+v"(acc[ai][bj][m][n]) : "v"(Bt##8[n]), "v"(At##8[m]), "v"(scl8)); } \
        else { _Pragma("unroll") for (int k = 0; k < 2; ++k) acc[ai][bj][m][n] = __builtin_amdgcn_mfma_f32_16x16x32_bf16(Bt[n][k], At[m][k], acc[ai][bj][m][n], 0, 0, 0); } } \
        __builtin_amdgcn_s_setprio(0); } while (0)
#define PG8_WAIT_V(n) asm volatile("s_waitcnt vmcnt(" #n ")" ::: "memory")
#define PG8_WAIT_L(n) asm volatile("s_waitcnt lgkmcnt(" #n ")" ::: "memory")
#define PG8_BAR __builtin_amdgcn_s_barrier()
#define PG8_SCHED __builtin_amdgcn_sched_barrier(0)
    Unit cur, nxt; int ui = 0;
    if (!S.next(0, cur)) return;
    unsigned va0[2], va1[2], vn0[2], vn1[2];
#define PG8_GIDX(dst0, dst1, u) do { if constexpr (GATHER) { _Pragma("unroll") for (int _i = 0; _i < 2; ++_i) { \
        dst0[_i] = min((unsigned)g.rowidx[(u).rbase + gR[_i]], (unsigned)(T - 1)) * (unsigned)(g.lda * 2) + voffA[_i]; dst1[_i] = min((unsigned)g.rowidx[(u).rbase + HALF + gR[_i]], (unsigned)(T - 1)) * (unsigned)(g.lda * 2) + voffA[_i]; } } \
        else { _Pragma("unroll") for (int _i = 0; _i < 2; ++_i) { dst0[_i] = voffA[_i]; dst1[_i] = voffA[_i]; } } } while (0)
    PG8_GIDX(va0, va1, cur);
    f32x4 acc[2][2][4][2];
#pragma unroll
    for (int a = 0; a < 2; ++a)
#pragma unroll
        for (int b = 0; b < 2; ++b)
#pragma unroll
            for (int m = 0; m < 4; ++m)
#pragma unroll
                for (int n = 0; n < 2; ++n) acc[a][b][m][n] = (f32x4){0.f, 0.f, 0.f, 0.f};
    bf16x8 At[4][2], B0[2][2], B1[2][2]; v8i_t At8[4], B08[2], B18[2];
    int scl8 = 0x7f7f7f7f; asm volatile("" : "+v"(scl8));
    const char* cA = (const char*)g.A + (GATHER ? 0 : (size_t)cur.pm * tstepA); const char* cB = (const char*)g.Bt + (size_t)cur.bt * tstepB;
    PG8_STAGE(PG8_SB(0, 0), cB, voffB); PG8_STAGE(PG8_SB(0, 1), cB + hstepB, voffB); PG8_STAGE(PG8_SA(0, 0), cA, va0); PG8_STAGE(PG8_SA(0, 1), cA + hstepA, va1);
    if (wr == 1) PG8_BAR;
    PG8_WAIT_V(2); PG8_BAR;
    PG8_STAGE(PG8_SB(1, 0), cB + kstep, voffB); PG8_STAGE(PG8_SA(1, 0), cA + kstep, va0); PG8_STAGE(PG8_SB(1, 1), cB + hstepB + kstep, voffB);
    PG8_WAIT_V(6); PG8_BAR;
    for (;;) {
        const bool has_next = S.next(ui + 1, nxt);
        const char* nA = (has_next && !GATHER) ? (const char*)g.A + (size_t)nxt.pm * tstepA : cA; const char* nB = has_next ? (const char*)g.Bt + (size_t)nxt.bt * tstepB : cB;
        if (has_next) PG8_GIDX(vn0, vn1, nxt); else { _Pragma("unroll") for (int _i = 0; _i < 2; ++_i) { vn0[_i] = va0[_i]; vn1[_i] = va1[_i]; } }
#pragma unroll 1
        for (int t = 0; t < nt; t += 2) {
            const bool last = (t == nt - 2);
            const char* a1 = cA + (size_t)(t + 1) * kstep;
            const char* a2 = last ? nA : cA + (size_t)(t + 2) * kstep; const char* b2 = last ? nB : cB + (size_t)(t + 2) * kstep;
            const char* a3 = a2 + kstep; const char* b3 = b2 + kstep;
            if constexpr (Epi::MID_T > 0) { if (t == Epi::MID_T) E.mid(acc, cur, wr, wc, fr, fq); }
            unsigned vs0[2], vs1[2];
#pragma unroll
            for (int _i = 0; _i < 2; ++_i) { vs0[_i] = last ? vn0[_i] : va0[_i]; vs1[_i] = last ? vn1[_i] : va1[_i]; }
            PG8_LDB(B0, 0, 0); PG8_LDB(B1, 0, 1); PG8_SCHED; PG8_LDA(At, 0, 0); PG8_STAGE(PG8_SA(1, 1), a1 + hstepA, va1);
            PG8_WAIT_V(8); PG8_WAIT_L(0); PG8_BAR; PG8_MMA(0, 0, At, B0); PG8_MMA(0, 1, At, B1); PG8_BAR; PG8_SCHED;
            PG8_LDA(At, 0, 1); PG8_STAGE(PG8_SB(0, 0), b2, voffB); PG8_STAGE(PG8_SB(0, 1), b2 + hstepB, voffB); PG8_STAGE(PG8_SA(0, 0), a2, vs0);
            PG8_WAIT_V(8); PG8_WAIT_L(0); PG8_BAR; PG8_MMA(1, 0, At, B0); PG8_MMA(1, 1, At, B1); PG8_BAR; PG8_SCHED;
            PG8_LDB(B0, 1, 0); PG8_LDB(B1, 1, 1); PG8_SCHED; PG8_LDA(At, 1, 0); PG8_STAGE(PG8_SA(0, 1), a2 + hstepA, vs1);
            PG8_WAIT_V(8); PG8_WAIT_L(0); PG8_BAR; PG8_MMA(0, 0, At, B0); PG8_MMA(0, 1, At, B1); PG8_BAR; PG8_SCHED;
            PG8_LDA(At, 1, 1); PG8_STAGE(PG8_SB(1, 0), b3, voffB); PG8_STAGE(PG8_SB(1, 1), b3 + hstepB, voffB); PG8_STAGE(PG8_SA(1, 0), a3, vs0);
            PG8_WAIT_V(8); PG8_WAIT_L(0); PG8_BAR; PG8_MMA(1, 0, At, B0); PG8_MMA(1, 1, At, B1); PG8_BAR; PG8_SCHED;
        }
        if constexpr (ALIGN_EPI) { if (wr == 0) PG8_BAR; }
        if constexpr (FP8) {
#pragma unroll
            for (int a = 0; a < 2; ++a)
#pragma unroll
                for (int b = 0; b < 2; ++b)
                    asm volatile("s_nop 15\n\ts_nop 7" : "+v"(acc[a][b][0][0]), "+v"(acc[a][b][0][1]), "+v"(acc[a][b][1][0]), "+v"(acc[a][b][1][1]), "+v"(acc[a][b][2][0]), "+v"(acc[a][b][2][1]), "+v"(acc[a][b][3][0]), "+v"(acc[a][b][3][1]));
        }
        E(acc, cur, wr, wc, fr, fq);
        if (!has_next) break;
#pragma unroll
        for (int a = 0; a < 2; ++a)
#pragma unroll
            for (int b = 0; b < 2; ++b)
#pragma unroll
                for (int m = 0; m < 4; ++m)
#pragma unroll
                    for (int n = 0; n < 2; ++n) acc[a][b][m][n] = (f32x4){0.f, 0.f, 0.f, 0.f};
        cur = nxt; cA = nA; cB = nB; ++ui;
#pragma unroll
        for (int _i = 0; _i < 2; ++_i) { va0[_i] = vn0[_i]; va1[_i] = vn1[_i]; }
        if constexpr (ALIGN_EPI) { if (wr == 1) PG8_BAR; }
    }
    PG8_WAIT_V(0);
    if constexpr (!ALIGN_EPI) { if (wr == 0) PG8_BAR; }
    PG8_BAR;
#undef PG8_SA
#undef PG8_SB
#undef PG8_STAGE
#undef PG8_GIDX
#undef PG8_LDA
#undef PG8_LDB
#undef PG8_MMA
#undef PG8_LD8
#undef PG8_WAIT_V
#undef PG8_WAIT_L
#undef PG8_BAR
#undef PG8_SCHED
}

typedef f32x4 Acc[2][2][4][2];

__device__ __forceinline__ u32x4 pair16(u32x2 x, u32x2 y) {
    const auto r0 = __builtin_amdgcn_permlane16_swap(x.x, y.x, false, false);
    const auto r1 = __builtin_amdgcn_permlane16_swap(x.y, y.y, false, false);
    return (u32x4){r0[0], r1[0], r0[1], r1[1]};
}
struct Epi1 {
    static constexpr bool PERM = true; static constexpr int MID_T = 0;
    bf16_t *yab, *gv; unsigned char *q, *k, *v; bf16_t *sa, *sb; float* gvst; float* kmp; float sc, pad_;
    template <int MODE  >
    __device__ __forceinline__ void run(const Acc& acc, const Unit& u, int wr, int wc, int fr, int fq, bf16_t* base, int ld) const {
        const int row0 = u.pm * BM + wr * 64 + fr, col0 = (u.pn & 3) * 256 + wc * 32 + 8 * fq;
        const int colp = (u.pn & 3) * 256 + wc * 32 + 8 * (fq & ~1);
        f32x4 csA0 = {0.f, 0.f, 0.f, 0.f}, csB0 = csA0, csA1 = csA0, csB1 = csA0;
#pragma unroll
        for (int ai = 0; ai < 2; ++ai)
#pragma unroll
            for (int mp = 0; mp < 2; ++mp) {
                u32x2 pc[2][2];
#pragma unroll
                for (int k = 0; k < 2; ++k) {
                    const int m = 2 * mp + k;
                    const int row = row0 + ai * HALF + m * 16; bf16_t* rowp = base + (size_t)row * ld + col0;
                    float s1 = 0.f, s2 = 0.f;
#pragma unroll
                    for (int bj = 0; bj < 2; ++bj) {
                        f32x4 v0 = acc[ai][bj][m][0], v1 = acc[ai][bj][m][1];
                        if (MODE == 2 || MODE == 3 || MODE == 5) {
                            const float f = (MODE == 2) ? sc * QSCALE : sc; v0 = v0 * f; v1 = v1 * f;
                            if (MODE == 5) { if (bj == 0) { csA0 = csA0 + v0; csB0 = csB0 + v1; } else { csA1 = csA1 + v0; csB1 = csB1 + v1; } }
                            pc[bj][k] = (u32x2){pack_fp8x4(v0[0], v0[1], v0[2], v0[3]), pack_fp8x4(v1[0], v1[1], v1[2], v1[3])};
                            continue;
                        }
                        if (MODE == 0 || MODE == 1) {
                            f32x2 a = gelu_pk((f32x2){v0[0], v0[1]}), b = gelu_pk((f32x2){v0[2], v0[3]}), c = gelu_pk((f32x2){v1[0], v1[1]}), d = gelu_pk((f32x2){v1[2], v1[3]});
                            v0 = (f32x4){a.x, a.y, b.x, b.y}; v1 = (f32x4){c.x, c.y, d.x, d.y};
                        } else if (MODE == 4) {
                            { const float cs_ = -1.4426950408889634f * sc; const f32x4 t0 = v0 * cs_, t1 = v1 * cs_; f32x4 e0, e1;
#pragma unroll
                              for (int j = 0; j < 4; ++j) { e0[j] = __builtin_amdgcn_exp2f(t0[j]); e1[j] = __builtin_amdgcn_exp2f(t1[j]); }
                              e0 = e0 + 1.0f; e1 = e1 + 1.0f;
#pragma unroll
                              for (int j = 0; j < 4; ++j) { v0[j] = __builtin_amdgcn_rcpf(e0[j]); v1[j] = __builtin_amdgcn_rcpf(e1[j]); } }
                            pc[bj][k] = (u32x2){pack_fp8x4(v0[0], v0[1], v0[2], v0[3]), pack_fp8x4(v1[0], v1[1], v1[2], v1[3])};
                            continue;
                        }
                        if (MODE == 1) {
                            s1 += (v0[0] + v0[1]) + (v0[2] + v0[3]) + (v1[0] + v1[1]) + (v1[2] + v1[3]);
                            s2 += (v0[0] * v0[0] + v0[1] * v0[1]) + (v0[2] * v0[2] + v0[3] * v0[3]) + (v1[0] * v1[0] + v1[1] * v1[1]) + (v1[2] * v1[2] + v1[3] * v1[3]);
                            pc[bj][k] = (u32x2){pack_fp8x4(v0[0], v0[1], v0[2], v0[3]), pack_fp8x4(v1[0], v1[1], v1[2], v1[3])};
                            continue;
                        }
                        u32x4 w; w.x = cvt_pk_bf16(v0[0], v0[1]); w.y = cvt_pk_bf16(v0[2], v0[3]); w.z = cvt_pk_bf16(v1[0], v1[1]); w.w = cvt_pk_bf16(v1[2], v1[3]);
                        *(u32x4*)(rowp + bj * HALF) = w;
                    }
                    if (MODE == 1) {
                        s1 += __shfl_xor(s1, 16); s1 += __shfl_xor(s1, 32); s2 += __shfl_xor(s2, 16); s2 += __shfl_xor(s2, 32);
                        if (fq == 0) *(f32x2*)(gvst + ((size_t)row * 16 + (u.pn & 3) * 4 + wc) * 2) = (f32x2){s1, s2};
                    }
                }
                if (MODE != 0) {
                    const int rowst = row0 + ai * HALF + (2 * mp + (fq & 1)) * 16;
#pragma unroll
                    for (int bj = 0; bj < 2; ++bj) *(u32x4*)((unsigned char*)base + (size_t)rowst * 1024 + colp + bj * HALF) = pair16(pc[bj][0], pc[bj][1]);
                }
            }
        if (MODE == 5) {
#define KM_RED(v) do { _Pragma("unroll") for (int j_ = 0; j_ < 4; ++j_) { float x = v[j_]; x += __shfl_xor(x, 1); x += __shfl_xor(x, 2); x += __shfl_xor(x, 4); x += __shfl_xor(x, 8); v[j_] = x; } } while (0)
            KM_RED(csA0); KM_RED(csB0); KM_RED(csA1); KM_RED(csB1);
#undef KM_RED
            if (fr == 0) {
                float* kp = kmp + ((size_t)(u.pm * 2 + wr) * DM) + col0;
                *(f32x4*)kp = csA0; *(f32x4*)(kp + 4) = csB0; *(f32x4*)(kp + HALF) = csA1; *(f32x4*)(kp + HALF + 4) = csB1;
            }
        }
    }
    __device__ __forceinline__ void operator()(const Acc& acc, const Unit& u, int wr, int wc, int fr, int fq) const {
        const int region = u.pn >> 2;
        if (region == 0) run<0>(acc, u, wr, wc, fr, fq, yab, 2048);
        else if (region == 1) run<1>(acc, u, wr, wc, fr, fq, gv, 1024);
        else if (region == 2) run<2>(acc, u, wr, wc, fr, fq, (bf16_t*)q, 1024);
        else if (region == 3) run<5>(acc, u, wr, wc, fr, fq, (bf16_t*)k, 1024);
        else if (region == 4) run<3>(acc, u, wr, wc, fr, fq, (bf16_t*)v, 1024);
        else if (region == 5) run<4>(acc, u, wr, wc, fr, fq, sa, 1024);
        else run<4>(acc, u, wr, wc, fr, fq, sb, 1024);
    }
    __device__ __forceinline__ void mid(Acc&, const Unit&, int, int, int, int) const {}
};

struct Epi2 {
    static constexpr bool PERM = true; static constexpr int MID_T = 16;
    const unsigned char *sa, *sb; bf16_t* mg;
    __device__ __forceinline__ void mid(Acc& acc, const Unit& u, int wr, int wc, int fr, int fq) const {
        int row0 = u.pm * BM + wr * 64 + fr, col0 = u.pn * BM + wc * 32 + 8 * fq;
        asm volatile("" : "+v"(row0), "+v"(col0));
#pragma unroll
        for (int ai = 0; ai < 2; ++ai)
#pragma unroll
            for (int m = 0; m < 4; ++m) {
                const size_t off = (size_t)(row0 + ai * HALF + m * 16) * DM + col0;
#pragma unroll
                for (int bj = 0; bj < 2; ++bj) {
                    const u32x2 a = *(const u32x2*)(sa + off + bj * HALF), b = *(const u32x2*)(sb + off + bj * HALF);
                    const f32x2v a0 = __builtin_amdgcn_cvt_pk_f32_fp8((int)a.x, false), a1 = __builtin_amdgcn_cvt_pk_f32_fp8((int)a.x, true), a2 = __builtin_amdgcn_cvt_pk_f32_fp8((int)a.y, false), a3 = __builtin_amdgcn_cvt_pk_f32_fp8((int)a.y, true);
                    const f32x2v b0 = __builtin_amdgcn_cvt_pk_f32_fp8((int)b.x, false), b1 = __builtin_amdgcn_cvt_pk_f32_fp8((int)b.x, true), b2 = __builtin_amdgcn_cvt_pk_f32_fp8((int)b.y, false), b3 = __builtin_amdgcn_cvt_pk_f32_fp8((int)b.y, true);
                    f32x4 r0, r1;
#define RQ(x, y) ((x) * __builtin_amdgcn_rcpf(y))
                    r0[0] = RQ(a0.x, b0.x); r0[1] = RQ(a0.y, b0.y); r0[2] = RQ(a1.x, b1.x); r0[3] = RQ(a1.y, b1.y);
                    r1[0] = RQ(a2.x, b2.x); r1[1] = RQ(a2.y, b2.y); r1[2] = RQ(a3.x, b3.x); r1[3] = RQ(a3.y, b3.y);
#undef RQ
                    acc[ai][bj][m][0] = acc[ai][bj][m][0] * r0; acc[ai][bj][m][1] = acc[ai][bj][m][1] * r1;
                }
                asm volatile("" : "+v"(acc[ai][0][m][0]), "+v"(acc[ai][0][m][1]), "+v"(acc[ai][1][m][0]), "+v"(acc[ai][1][m][1]));
                asm volatile("" ::: "memory");
            }
    }
    __device__ __forceinline__ void operator()(const Acc& acc, const Unit& u, int wr, int wc, int fr, int fq) const {
        const int row0 = u.pm * BM + wr * 64 + fr, col0 = u.pn * BM + wc * 32 + 8 * fq;
#pragma unroll
        for (int ai = 0; ai < 2; ++ai)
#pragma unroll
            for (int m = 0; m < 4; ++m) {
                const size_t off = (size_t)(row0 + ai * HALF + m * 16) * DM + col0;
#pragma unroll
                for (int bj = 0; bj < 2; ++bj) {
                    const u32x2 b = *(const u32x2*)(sb + off + bj * HALF);
                    const f32x2v b0 = __builtin_amdgcn_cvt_pk_f32_fp8((int)b.x, false), b1 = __builtin_amdgcn_cvt_pk_f32_fp8((int)b.x, true), b2 = __builtin_amdgcn_cvt_pk_f32_fp8((int)b.y, false), b3 = __builtin_amdgcn_cvt_pk_f32_fp8((int)b.y, true);
                    const f32x4 v0 = acc[ai][bj][m][0], v1 = acc[ai][bj][m][1];
                    u32x4 w; w.x = cvt_pk_bf16(v0[0] * b0.x, v0[1] * b0.y); w.y = cvt_pk_bf16(v0[2] * b1.x, v0[3] * b1.y);
                    w.z = cvt_pk_bf16(v1[0] * b2.x, v1[1] * b2.y); w.w = cvt_pk_bf16(v1[2] * b3.x, v1[3] * b3.y);
                    *(u32x4*)(mg + off + bj * HALF) = w;
                }
            }
    }
};

struct Epi3 {
    static constexpr bool PERM = true; static constexpr int MID_T = 0;
    const bf16_t* h0; bf16_t* z; float* zst;
    __device__ __forceinline__ void mid(Acc&, const Unit&, int, int, int, int) const {}
    __device__ __forceinline__ void operator()(const Acc& acc, const Unit& u, int wr, int wc, int fr, int fq) const {
        const int row0 = u.pm * BM + wr * 64 + fr, col0 = u.pn * BM + wc * 32 + 8 * fq;
#pragma unroll
        for (int ai = 0; ai < 2; ++ai)
#pragma unroll
            for (int m = 0; m < 4; ++m) {
                const int row = row0 + ai * HALF + m * 16; const size_t off = (size_t)row * DM + col0;
                float s1 = 0.f, s2 = 0.f;
#pragma unroll
                for (int bj = 0; bj < 2; ++bj) {
                    const u32x4 hb = *(const u32x4*)(h0 + off + bj * HALF);
                    f32x4 v0 = acc[ai][bj][m][0], v1 = acc[ai][bj][m][1];
                    v0[0] += ALPHA * bflo(hb.x); v0[1] += ALPHA * bfhi(hb.x); v0[2] += ALPHA * bflo(hb.y); v0[3] += ALPHA * bfhi(hb.y);
                    v1[0] += ALPHA * bflo(hb.z); v1[1] += ALPHA * bfhi(hb.z); v1[2] += ALPHA * bflo(hb.w); v1[3] += ALPHA * bfhi(hb.w);
                    s1 += ((v0[0] + v0[1]) + (v0[2] + v0[3])) + ((v1[0] + v1[1]) + (v1[2] + v1[3]));
                    s2 += ((v0[0] * v0[0] + v0[1] * v0[1]) + (v0[2] * v0[2] + v0[3] * v0[3])) + ((v1[0] * v1[0] + v1[1] * v1[1]) + (v1[2] * v1[2] + v1[3] * v1[3]));
                    *(u32x4*)(z + off + bj * HALF) = (u32x4){cvt_pk_bf16(v0[0], v0[1]), cvt_pk_bf16(v0[2], v0[3]), cvt_pk_bf16(v1[0], v1[1]), cvt_pk_bf16(v1[2], v1[3])};
                }
                s1 += __shfl_xor(s1, 16); s1 += __shfl_xor(s1, 32); s2 += __shfl_xor(s2, 16); s2 += __shfl_xor(s2, 32);
                if (fq == 0) *(f32x2*)(zst + ((size_t)row * 16 + u.pn * 4 + wc) * 2) = (f32x2){s1, s2};
            }
    }
};

struct Epi4 {
    static constexpr bool PERM = true; static constexpr int MID_T = 0;
    const float* b_up; unsigned char* act;
    __device__ __forceinline__ void mid(Acc&, const Unit&, int, int, int, int) const {}
    __device__ __forceinline__ void operator()(const Acc& acc, const Unit& u, int wr, int wc, int fr, int fq) const {
        const int e = u.bt >> 3;
        const int row0 = u.pm * BM + wr * 64 + fr, c0 = u.pn * HALF + wc * 32 + 8 * fq;
        const float* bg = b_up + (size_t)e * 2 * FF + c0; const float* bu = bg + FF;
        const f32x4 bg0 = *(const f32x4*)bg, bg1 = *(const f32x4*)(bg + 4), bu0 = *(const f32x4*)bu, bu1 = *(const f32x4*)(bu + 4);
        const int cp = u.pn * HALF + wc * 32 + 8 * (fq & ~1);
#pragma unroll
        for (int ai = 0; ai < 2; ++ai)
#pragma unroll
            for (int mp = 0; mp < 2; ++mp) {
                u32x2 pc[2];
#pragma unroll
                for (int k = 0; k < 2; ++k) {
                    const int m = 2 * mp + k;
                    float o[8];
#pragma unroll
                    for (int n = 0; n < 2; ++n)
#pragma unroll
                        for (int jp = 0; jp < 2; ++jp) {
                            const int j = 2 * jp;
                            const f32x2 ag = {acc[ai][0][m][n][j], acc[ai][0][m][n][j + 1]}, au = {acc[ai][1][m][n][j], acc[ai][1][m][n][j + 1]};
                            const f32x2 vbg = n ? (f32x2){bg1[j], bg1[j + 1]} : (f32x2){bg0[j], bg0[j + 1]}, vbu = n ? (f32x2){bu1[j], bu1[j + 1]} : (f32x2){bu0[j], bu0[j + 1]};
                            f32x2 gg = ag * 0.03125f + vbg, uu = au * 0.03125f + vbu;
                            gg.x = fminf(gg.x, 7.0f); gg.y = fminf(gg.y, 7.0f);
                            uu.x = __builtin_amdgcn_fmed3f(uu.x, -7.0f, 7.0f); uu.y = __builtin_amdgcn_fmed3f(uu.y, -7.0f, 7.0f);
                            const f32x2 t = gg * (-1.702f * 1.4426950408889634f);
                            f32x2 ex; ex.x = __builtin_amdgcn_exp2f(t.x); ex.y = __builtin_amdgcn_exp2f(t.y);
                            const f32x2 d = ex + 1.0f;
                            f32x2 rc; rc.x = __builtin_amdgcn_rcpf(d.x); rc.y = __builtin_amdgcn_rcpf(d.y);
                            const f32x2 res = (uu + 1.0f) * (gg * rc);
                            o[n * 4 + j] = res.x; o[n * 4 + j + 1] = res.y;
                        }
                    unsigned w0 = 0u, w1 = 0u;
                    w0 = __builtin_amdgcn_cvt_pk_fp8_f32(o[0], o[1], w0, false); w0 = __builtin_amdgcn_cvt_pk_fp8_f32(o[2], o[3], w0, true);
                    w1 = __builtin_amdgcn_cvt_pk_fp8_f32(o[4], o[5], w1, false); w1 = __builtin_amdgcn_cvt_pk_fp8_f32(o[6], o[7], w1, true);
                    pc[k] = (u32x2){w0, w1};
                }
                const int rowst = row0 + ai * HALF + (2 * mp + (fq & 1)) * 16;
                *(u32x4*)(act + (size_t)rowst * FF + cp) = pair16(pc[0], pc[1]);
            }
    }
};

struct Epi5 {
    static constexpr bool PERM = true; static constexpr int MID_T = 0;
    const float* b_down; const float* roww; unsigned char* ys;
    __device__ __forceinline__ void mid(Acc&, const Unit&, int, int, int, int) const {}
    __device__ __forceinline__ void operator()(const Acc& acc, const Unit& u, int wr, int wc, int fr, int fq) const {
        const int e = u.bt >> 2;
        const int row0 = u.pm * BM + wr * 64 + fr, col0 = u.pn * BM + wc * 32 + 8 * fq;
        f32x4 bv[2][2];
#pragma unroll
        for (int bj = 0; bj < 2; ++bj)
#pragma unroll
            for (int n = 0; n < 2; ++n) bv[bj][n] = *(const f32x4*)(b_down + (size_t)e * DM + col0 + bj * HALF + 4 * n);
        float rwv[2][4];
#pragma unroll
        for (int ai = 0; ai < 2; ++ai)
#pragma unroll
            for (int m = 0; m < 4; ++m) rwv[ai][m] = roww[u.rbase + wr * 64 + fr + ai * HALF + m * 16];
        asm volatile("" ::: "memory");
        const int colp = u.pn * BM + wc * 32 + 8 * (fq & ~1);
#pragma unroll
        for (int ai = 0; ai < 2; ++ai)
#pragma unroll
            for (int mp = 0; mp < 2; ++mp) {
                const int rowst = row0 + ai * HALF + (2 * mp + (fq & 1)) * 16;
#pragma unroll
                for (int bj = 0; bj < 2; ++bj) {
                    u32x2 pc[2];
#pragma unroll
                    for (int k = 0; k < 2; ++k) { const int m = 2 * mp + k; const float rw16 = rwv[ai][m] * 16.0f;
                        const f32x4 v0 = (acc[ai][bj][m][0] * 0.015625f + bv[bj][0]) * rw16, v1 = (acc[ai][bj][m][1] * 0.015625f + bv[bj][1]) * rw16;
                        pc[k] = (u32x2){pack_fp8x4(v0[0], v0[1], v0[2], v0[3]), pack_fp8x4(v1[0], v1[1], v1[2], v1[3])}; }
                    *(u32x4*)(ys + (size_t)rowst * DM + colp + bj * HALF) = pair16(pc[0], pc[1]);
                }
            }
    }
};
}

struct Args { const float* in[21]; float* out; unsigned char* ws; int ph_lo, ph_hi; };
enum { I_X = 0, I_LNIN_G, I_LNIN_B, I_WIN, I_GLN_G, I_GLN_B, I_WSP, I_BSP, I_WBA, I_WBB, I_WOUT, I_LNMIX_G, I_LNMIX_B, I_WR, I_BR, I_WUP, I_BUP, I_WDN, I_BDN, I_LNF_G, I_LNF_B };

struct Ctx { const Args* a; unsigned char* ws; LAS unsigned char* lds; unsigned char* ldsg; int tid, lane, wave, G, vcu; };

__device__ __forceinline__ void tr_item(const float* W, int N, int k0, int n0, bf16_t* dst, int drow0, int dld, int dcol0, LAS float* scr, int lane) {
#pragma unroll 8
    for (int i = 0; i < 32; ++i) { const int kk = 2 * i + (lane >> 5); scr[kk * 33 + (lane & 31)] = __builtin_nontemporal_load(W + (size_t)(k0 + kk) * N + n0 + (lane & 31)); }
    asm volatile("s_waitcnt lgkmcnt(0)" ::: "memory");
    const int c = lane & 7;
#pragma unroll
    for (int j = 0; j < 4; ++j) { const int n = (lane >> 3) + 8 * j; const LAS float* s = scr + (8 * c) * 33 + n;
        u32x4 o; o.x = pk2(s[0 * 33], s[1 * 33]); o.y = pk2(s[2 * 33], s[3 * 33]); o.z = pk2(s[4 * 33], s[5 * 33]); o.w = pk2(s[6 * 33], s[7 * 33]);
        *(u32x4*)(dst + (size_t)(drow0 + n) * dld + dcol0 + k0 + 8 * c) = o; }
    asm volatile("s_waitcnt lgkmcnt(0)" ::: "memory");
}
template <bool DEEP = false>
__device__ __forceinline__ void tr_item8(const float* W, int N, int k0, int n0, unsigned char* dst, int drow0, int dld, float sc, LAS float* scr, int lane) {
    if constexpr (DEEP) {
        float v[32];
#pragma unroll
        for (int i = 0; i < 32; ++i) v[i] = __builtin_nontemporal_load(W + (size_t)(k0 + 2 * i + (lane >> 5)) * N + n0 + (lane & 31));
#pragma unroll
        for (int i = 0; i < 32; ++i) scr[(2 * i + (lane >> 5)) * 33 + (lane & 31)] = v[i];
    } else {
#pragma unroll 8
        for (int i = 0; i < 32; ++i) { const int kk = 2 * i + (lane >> 5); scr[kk * 33 + (lane & 31)] = __builtin_nontemporal_load(W + (size_t)(k0 + kk) * N + n0 + (lane & 31)); }
    }
    asm volatile("s_waitcnt lgkmcnt(0)" ::: "memory");
    const int c = lane & 7;
#pragma unroll
    for (int j = 0; j < 4; ++j) { const int n = (lane >> 3) + 8 * j; const LAS float* s = scr + (8 * c) * 33 + n;
        unsigned w0 = 0u, w1 = 0u;
        w0 = __builtin_amdgcn_cvt_pk_fp8_f32(s[0 * 33] * sc, s[1 * 33] * sc, w0, false); w0 = __builtin_amdgcn_cvt_pk_fp8_f32(s[2 * 33] * sc, s[3 * 33] * sc, w0, true);
        w1 = __builtin_amdgcn_cvt_pk_fp8_f32(s[4 * 33] * sc, s[5 * 33] * sc, w1, false); w1 = __builtin_amdgcn_cvt_pk_fp8_f32(s[6 * 33] * sc, s[7 * 33] * sc, w1, true);
        *(u32x2*)(dst + (size_t)(drow0 + n) * dld + k0 + 8 * c) = (u32x2){w0, w1}; }
    asm volatile("s_waitcnt lgkmcnt(0)" ::: "memory");
}
__device__ __forceinline__ void ph_prologue(const Ctx& F) {
    const Args& A = *F.a;
    LAS float* scr = (LAS float*)(F.lds + F.wave * 16384);
    const int gw = F.vcu * 8 + F.wave, NGW = F.G * 8;
    bf16_t* WIN = (bf16_t*)(F.ws + WS_WIN); bf16_t* WAB = (bf16_t*)(F.ws + WS_WAB); bf16_t* WOUT = (bf16_t*)(F.ws + WS_WOUT);
    constexpr int I_IN = 16 * (INCOLS / 32), I_SQ = 16 * 32;
    constexpr int NITEMS = I_IN + 3 * I_SQ;
    for (int it = gw; it < NITEMS; it += NGW) {
        int r = it;
        if (r < I_IN) { const int nblk = INCOLS / 32, kb = r / nblk, nb = r % nblk;
            if (32 * nb >= PN8_LO * 256 && 32 * nb < PN8_HI * 256) tr_item8(A.in[I_WIN], INCOLS, 64 * kb, 32 * nb, F.ws + WS_WIN8, 32 * nb, DM, 32.0f, scr, F.lane);
            else tr_item(A.in[I_WIN], INCOLS, 64 * kb, 32 * nb, WIN, 32 * nb, DM, 0, scr, F.lane);
            continue; } r -= I_IN;
        if (r < I_SQ) { const int kb = r / 32, nb = r % 32; tr_item(A.in[I_WBA], DM, 64 * kb, 32 * nb, WAB, 32 * nb, 2048, 0, scr, F.lane); continue; } r -= I_SQ;
        if (r < I_SQ) { const int kb = r / 32, nb = r % 32; tr_item(A.in[I_WBB], DM, 64 * kb, 32 * nb, WAB, 32 * nb, 2048, 1024, scr, F.lane); continue; } r -= I_SQ;
        { const int kb = r / 32, nb = r % 32; tr_item(A.in[I_WOUT], DM, 64 * kb, 32 * nb, WOUT, 32 * nb, DM, 0, scr, F.lane); }
    }
    const float* lg = A.in[I_LNIN_G]; const float* lb = A.in[I_LNIN_B]; bf16_t* H0 = (bf16_t*)(F.ws + WS_H0);
    f32x4 gg[4], bb[4];
#pragma unroll
    for (int j = 0; j < 4; ++j) { gg[j] = *((const f32x4*)lg + F.lane + 64 * j); bb[j] = *((const f32x4*)lb + F.lane + 64 * j); }
    for (int m = gw; m < T; m += NGW) {
        const f32x4* xr = (const f32x4*)(A.in[I_X] + (size_t)m * DM) + F.lane;
        f32x4 v[4]; float s = 0.f;
#pragma unroll
        for (int j = 0; j < 4; ++j) { v[j] = __builtin_nontemporal_load(xr + 64 * j); s += (v[j].x + v[j].y) + (v[j].z + v[j].w); }
        const float mean = wave_sum(s) * (1.f / DM); float s2 = 0.f;
#pragma unroll
        for (int j = 0; j < 4; ++j) { v[j] = v[j] - mean; s2 += (v[j].x * v[j].x + v[j].y * v[j].y) + (v[j].z * v[j].z + v[j].w * v[j].w); }
        const float rstd = 1.f / sqrtf(wave_sum(s2) * (1.f / DM) + LN_EPS);
        u32x2* o8 = (u32x2*)(H0 + (size_t)m * DM) + F.lane; unsigned* o4 = (unsigned*)(F.ws + WS_H0F8 + (size_t)m * DM) + F.lane;
#pragma unroll
        for (int j = 0; j < 4; ++j) { const f32x4 y = v[j] * rstd * gg[j] + bb[j]; o8[64 * j] = (u32x2){pk2(y.x, y.y), pk2(y.z, y.w)}; o4[64 * j] = pack_fp8x4(y.x, y.y, y.z, y.w); }
    }
}

__device__ __forceinline__ void ph_wconv(const Ctx& F) {
    const Args& A = *F.a;
    LAS float* scr = (LAS float*)(F.lds + F.wave * 16384);
    unsigned char* WDN = F.ws + WS_WDN; unsigned char* WUP = F.ws + WS_WUP;
    constexpr int I_UP = NE * 16 * 64, I_DN = NE * 16 * 32, NIT = I_UP + I_DN;
    const int chunk = (NIT + F.G - 1) / F.G, lo = (int)blockIdx.x * chunk, hi = (lo + chunk < NIT) ? lo + chunk : NIT;
    __syncthreads();
    for (int it = lo + F.wave; it < hi; it += 8) {
        int r = it;
        if (r < I_UP) { const int e = r / (16 * 64), rr = r % (16 * 64), kb = rr / 64, nb = rr % 64; const int n0 = 32 * nb, half = n0 >= FF, rem = n0 - half * FF, pn = rem >> 7, b = (rem & 127) >> 5;
            tr_item8<true>(A.in[I_WUP] + (size_t)e * DM * 2 * FF, 2 * FF, 64 * kb, n0, WUP, e * 2048 + 256 * pn + half * 128 + 32 * b, DM, 32.0f, scr, F.lane); continue; } r -= I_UP;
        { const int e = r / (16 * 32), rr = r % (16 * 32), kb = rr / 32, nb = rr % 32; tr_item8<true>(A.in[I_WDN] + (size_t)e * FF * DM, DM, 64 * kb, 32 * nb, WDN, e * 1024 + 32 * nb, FF, 64.0f, scr, F.lane); }
    }
    asm volatile("s_waitcnt vmcnt(0)" ::: "memory");
    __syncthreads();
}

typedef short v4i16_t __attribute__((ext_vector_type(4)));
__device__ __forceinline__ v4i16_t lds_tr16(LAS const unsigned char* p) { return __builtin_amdgcn_ds_read_tr16_b64_v4i16((LAS v4i16_t*)p); }
__device__ __forceinline__ void ph_mixer_a(const Ctx& F) {
    const Args& A = *F.a;
    const unsigned char* GV = F.ws + WS_GV; bf16_t* YAB = (bf16_t*)(F.ws + WS_YAB); const float* GVST = (const float*)(F.ws + WS_GVST);
    const float* lg = A.in[I_GLN_G]; const float* lb = A.in[I_GLN_B]; const float* wsp = A.in[I_WSP]; const float* bsp = A.in[I_BSP];
    constexpr int RSV = 544, RSW = 272, OFF_W = 128 * RSV, OFF_ST = OFF_W + 128 * RSW;
    LAS unsigned char* VT = F.lds; LAS unsigned char* WT = F.lds + OFF_W; LAS float* ST = (LAS float*)(F.lds + OFF_ST);
    const int lane = F.lane, wv = F.wave;
    int curg = -1;
    for (int it = F.vcu; it < NB * 32 * 4; it += F.G) {
        const int b = it / 128, c = (it >> 2) & 31, g = it & 3;
        const int tok0 = b * SEQ + c * 128;
        if (g != curg) {
            curg = g;
            for (int k = 0; k < 4; ++k) {
                const int idx = F.tid + 512 * k, t = idx >> 4, s8 = (idx & 15) * 8;
                const f32x4 w0 = *(const f32x4*)(wsp + ((size_t)g * 128 + t) * 128 + s8), w1 = *(const f32x4*)(wsp + ((size_t)g * 128 + t) * 128 + s8 + 4);
                float x[8] = {w0.x, w0.y, w0.z, w0.w, w1.x, w1.y, w1.z, w1.w};
#pragma unroll
                for (int j = 0; j < 8; ++j) x[j] = (s8 + j <= t) ? x[j] : 0.f;
                u32x4 o; o.x = pk2(x[0], x[1]); o.y = pk2(x[2], x[3]); o.z = pk2(x[4], x[5]); o.w = pk2(x[6], x[7]);
                *(LAS u32x4*)(WT + t * RSW + s8 * 2) = o;
            }
        }
        if (F.tid < 128) {
            const float* p = GVST + (size_t)(tok0 + F.tid) * 32; float s1 = 0.f, s2 = 0.f;
            for (int i = 0; i < 16; ++i) { s1 += p[2 * i]; s2 += p[2 * i + 1]; }
            const float mean = s1 * (1.f / DM), var = s2 * (1.f / DM) - mean * mean;
            ST[2 * F.tid] = mean; ST[2 * F.tid + 1] = 1.f / sqrtf(fmaxf(var, 0.f) + LN_EPS);
        }
        __syncthreads();
        {
            const int dc = F.tid & 31;
            const f32x4 g0 = *(const f32x4*)(lg + g * 256 + dc * 8), g1 = *(const f32x4*)(lg + g * 256 + dc * 8 + 4), b0 = *(const f32x4*)(lb + g * 256 + dc * 8), b1 = *(const f32x4*)(lb + g * 256 + dc * 8 + 4);
#pragma unroll
            for (int k = 0; k < 8; ++k) {
                const int s = (F.tid >> 5) + 16 * k;
                const u32x2 raw = *(const u32x2*)(GV + (size_t)(tok0 + s) * DM + g * 256 + dc * 8);
                const float mean = ST[2 * s], rstd = ST[2 * s + 1];
                const f32x2v f0 = __builtin_amdgcn_cvt_pk_f32_fp8((int)raw.x, false), f1 = __builtin_amdgcn_cvt_pk_f32_fp8((int)raw.x, true), f2 = __builtin_amdgcn_cvt_pk_f32_fp8((int)raw.y, false), f3 = __builtin_amdgcn_cvt_pk_f32_fp8((int)raw.y, true);
                f32x4 x0 = {f0.x, f0.y, f1.x, f1.y}, x1 = {f2.x, f2.y, f3.x, f3.y};
                x0 = (x0 - mean) * rstd * g0 + b0; x1 = (x1 - mean) * rstd * g1 + b1;
                u32x4 o; o.x = pk2(x0.x, x0.y); o.y = pk2(x0.z, x0.w); o.z = pk2(x1.x, x1.y); o.w = pk2(x1.z, x1.w);
                *(LAS u32x4*)(VT + s * RSV + dc * 16) = o;
            }
        }
        __syncthreads();
        {
            const int dbase = 32 * wv, kg = lane >> 4, q = (lane & 15) >> 2, p = lane & 3, fr = lane & 15;
            bf16x8 Af[2][4];
#pragma unroll
            for (int m = 0; m < 2; ++m)
#pragma unroll
                for (int kk = 0; kk < 4; ++kk) {
                    LAS const unsigned char* ap = VT + (32 * kk + 8 * kg + q) * RSV + (dbase + 16 * m + 4 * p) * 2;
                    const v4i16_t lo = lds_tr16(ap), hi = lds_tr16(ap + 4 * RSV);
                    Af[m][kk] = (bf16x8){lo[0], lo[1], lo[2], lo[3], hi[0], hi[1], hi[2], hi[3]};
                }
#pragma unroll
            for (int n = 0; n < 8; ++n) {
                f32x4 acc0 = {0.f, 0.f, 0.f, 0.f}, acc1 = {0.f, 0.f, 0.f, 0.f};
#pragma unroll
                for (int kk = 0; kk < 4; ++kk) if (kk <= (n >> 1)) {
                    const bf16x8 Bf = *(LAS const bf16x8*)(WT + (16 * n + fr) * RSW + (32 * kk + 8 * kg) * 2);
                    acc0 = __builtin_amdgcn_mfma_f32_16x16x32_bf16(Af[0][kk], Bf, acc0, 0, 0, 0);
                    acc1 = __builtin_amdgcn_mfma_f32_16x16x32_bf16(Af[1][kk], Bf, acc1, 0, 0, 0);
                }
                const int t = 16 * n + fr; const float bsv = bsp[g * 128 + t];
                bf16_t* yp = YAB + (size_t)(tok0 + t) * 2048 + g * 256 + dbase + 4 * kg;
                const u32x2 u0 = *(const u32x2*)yp, u1 = *(const u32x2*)(yp + 16);
                u32x2 o0, o1;
                o0.x = pk2(bflo(u0.x) * (acc0[0] + bsv), bfhi(u0.x) * (acc0[1] + bsv)); o0.y = pk2(bflo(u0.y) * (acc0[2] + bsv), bfhi(u0.y) * (acc0[3] + bsv));
                o1.x = pk2(bflo(u1.x) * (acc1[0] + bsv), bfhi(u1.x) * (acc1[1] + bsv)); o1.y = pk2(bflo(u1.y) * (acc1[2] + bsv), bfhi(u1.y) * (acc1[3] + bsv));
                *(u32x2*)yp = o0; *(u32x2*)(yp + 16) = o1;
            }
        }
        __syncthreads();
    }
}

__device__ __forceinline__ void ph_gate(const Ctx& F) {
    const unsigned char* Q = F.ws + WS_Q; const float* KM = (const float*)(F.ws + WS_KMEAN);
    unsigned* SEL = (unsigned*)(F.ws + WS_SEL); unsigned* LISTS = (unsigned*)(F.ws + WS_LISTS); unsigned* LCNT = (unsigned*)(F.ws + WS_CTL) + CW_LCNT;
    constexpr int KMR = 272;
    LAS unsigned char* kmh = F.lds; LAS unsigned char* kml = F.lds + 16 * KMR;
    unsigned* lc = (unsigned*)(F.ldsg + 2 * 16 * KMR);
    LAS float* scw = (LAS float*)(F.lds + 16384) + F.wave * 1024;
    const int fr = F.lane & 15, fq = F.lane >> 4;
    for (int it = F.vcu; it < NB * NH * 8; it += F.G) {
        const int b = it / 64, h = (it >> 3) & 7, tc = it & 7;
        {
            const int j = F.tid >> 5, d4 = (F.tid & 31) * 4;
            const float* kp = KM + (size_t)((b * NBLK + j) * 2) * DM + h * DH + d4;
            const f32x4 s0 = *(const f32x4*)kp, s1 = *(const f32x4*)(kp + DM);
            const f32x4 mv = (s0 + s1) * (1.0f / LBLK);
            unsigned hb[4]; float lo[4];
#pragma unroll
            for (int e = 0; e < 4; ++e) { hb[e] = f2bf(mv[e]); lo[e] = mv[e] - __uint_as_float(hb[e] << 16); }
            *(LAS u32x2*)(kmh + j * KMR + d4 * 2) = (u32x2){hb[0] | (hb[1] << 16), hb[2] | (hb[3] << 16)};
            *(LAS u32x2*)(kml + j * KMR + d4 * 2) = (u32x2){pk2(lo[0], lo[1]), pk2(lo[2], lo[3])};
        }
        if (F.tid < 32) lc[F.tid] = 0u;
        const int tw = tc * 512 + F.wave * 64;
        u32x4 qraw[4][2];
#pragma unroll
        for (int tg = 0; tg < 4; ++tg) { const unsigned char* qp = Q + (size_t)(b * SEQ + tw + 16 * tg + fr) * DM + h * DH + 32 * fq; qraw[tg][0] = *(const u32x4*)qp; qraw[tg][1] = *(const u32x4*)(qp + 16); }
        __syncthreads();
        bf16x8 Ah[4], Al[4];
#pragma unroll
        for (int ks = 0; ks < 4; ++ks) { Ah[ks] = *(LAS const bf16x8*)(kmh + fr * KMR + (32 * fq + 8 * ks) * 2); Al[ks] = *(LAS const bf16x8*)(kml + fr * KMR + (32 * fq + 8 * ks) * 2); }
#pragma unroll
        for (int tg = 0; tg < 4; ++tg) {
            f32x4 acc = {0.f, 0.f, 0.f, 0.f};
#pragma unroll
            for (int ks = 0; ks < 4; ++ks) {
                const u32x4 w = qraw[tg][ks >> 1]; const unsigned w0 = (ks & 1) ? w.z : w.x, w1 = (ks & 1) ? w.w : w.y;
                const bf16x8 Bq = __builtin_bit_cast(bf16x8, f8x8_to_bf16x8(w0, w1));
                acc = __builtin_amdgcn_mfma_f32_16x16x32_bf16(Ah[ks], Bq, acc, 0, 0, 0);
                acc = __builtin_amdgcn_mfma_f32_16x16x32_bf16(Al[ks], Bq, acc, 0, 0, 0);
            }
            *(LAS f32x4*)(scw + (16 * tg + fr) * 16 + 4 * fq) = acc;
        }
        asm volatile("s_waitcnt lgkmcnt(0)" ::: "memory");
        const int t = tc * 512 + F.tid, qi = t >> 8;
        float gsc[15];
        { const f32x4 c0 = *(LAS const f32x4*)(scw + F.lane * 16), c1 = *(LAS const f32x4*)(scw + F.lane * 16 + 4), c2 = *(LAS const f32x4*)(scw + F.lane * 16 + 8), c3 = *(LAS const f32x4*)(scw + F.lane * 16 + 12);
          gsc[0] = c0.x; gsc[1] = c0.y; gsc[2] = c0.z; gsc[3] = c0.w; gsc[4] = c1.x; gsc[5] = c1.y; gsc[6] = c1.z; gsc[7] = c1.w;
          gsc[8] = c2.x; gsc[9] = c2.y; gsc[10] = c2.z; gsc[11] = c2.w; gsc[12] = c3.x; gsc[13] = c3.y; gsc[14] = c3.z; }
        const int nsel = qi < 3 ? qi : 3;
        int sel[3] = {0, 0, 0}; unsigned lpos[3] = {0, 0, 0};
#pragma unroll
        for (int r = 0; r < 3; ++r) {
            float best = -INFINITY; int bi = -1;
#pragma unroll
            for (int j = 0; j < 15; ++j) { const bool c = (j < qi) && (gsc[j] > best); best = c ? gsc[j] : best; bi = c ? j : bi; }
#pragma unroll
            for (int j = 0; j < 15; ++j) if (j == bi) gsc[j] = -INFINITY;
            sel[r] = bi < 0 ? 0 : bi;
            if (r < nsel) lpos[r] = atomicAdd(&lc[sel[r]], 1u);
        }
        SEL[(size_t)(b * SEQ + t) * NH + h] = (unsigned)sel[0] | ((unsigned)sel[1] << 8) | ((unsigned)sel[2] << 16) | ((unsigned)nsel << 24);
        __syncthreads();
        if (F.tid < 16) lc[16 + F.tid] = lc[F.tid] ? atomicAdd(&LCNT[(b * NH + h) * NBLK + F.tid], lc[F.tid]) : 0u;
        __syncthreads();
#pragma unroll
        for (int r = 0; r < 3; ++r) if (r < nsel) LISTS[(size_t)((b * NH + h) * NBLK + sel[r]) * 4096 + lc[16 + sel[r]] + lpos[r]] = (unsigned)t | ((unsigned)r << 12);
        __syncthreads();
    }
}


typedef float f32x16 __attribute__((ext_vector_type(16)));
namespace att {
__device__ __forceinline__ int crow(int r, int hi) { return (r & 3) + 8 * (r >> 2) + 4 * hi; }
#define TRR(dst, vaddr, off) asm volatile("ds_read_b64_tr_b16 %0, %1 offset:%c2" : "=v"(dst) : "v"(vaddr), "i"(off) : "memory")
#define TRWAIT() do { asm volatile("s_waitcnt lgkmcnt(0)" ::: "memory"); __builtin_amdgcn_sched_barrier(0); } while (0)

}

namespace att2 {
constexpr int KCH2 = 1040, VDB2 = 4160, KSL = 8 * KCH2, VSL = 4 * VDB2;
constexpr int OFF_K = 0, OFF_V = 2 * KSL, OFF_STG = OFF_V + 2 * VSL  , OFF_WS = OFF_STG + 8 * 8192  , WSW = 1024, OFF_TAB = OFF_WS + 8 * WSW  ;
static_assert(OFF_TAB + 1028 * 4 <= LDS_BYTES - 64, "attention (partial) LDS map");
using att::crow;

__device__ __forceinline__ void tile_load(const Ctx& F, const unsigned char* K, const unsigned char* V, size_t tokbase, int h, int kt, u32x4& rk, u32x4& rv) {
    const size_t off = (tokbase + 64 * kt + (F.tid >> 3)) * DM + h * DH + (F.tid & 7) * 16;
    rk = *(const u32x4*)(K + off); rv = *(const u32x4*)(V + off);
}
__device__ __forceinline__ void tile_write(const Ctx& F, int slot, const u32x4& rk, const u32x4& rv) {
    const int key = F.tid >> 3, c = 2 * (F.tid & 7);
    *(LAS u32x4*)(F.lds + OFF_K + slot * KSL + (F.tid & 7) * KCH2 + key * 16) = rk;
    LAS unsigned char* vd = F.lds + OFF_V + slot * VSL + (c >> 2) * VDB2 + (key >> 3) * 512 + (key & 7) * 64 + (c & 3) * 16;
    *(LAS u32x4*)vd = f8x8_to_bf16x8(rv.x, rv.y); *(LAS u32x4*)(vd + 16) = f8x8_to_bf16x8(rv.z, rv.w);
}
template <bool CAUSAL = false>
__device__ __forceinline__ void tile_compute(const Ctx& F, int slot, const pg8::v8i_t (&qf)[2], f32x16 (&o)[4], float& m, float& l, bool first, bool diag = false) {
    const int r = F.lane & 31, hh = F.lane >> 5;
    LAS float* wsf = (LAS float*)(F.lds + OFF_WS + F.wave * WSW);
    LAS const unsigned char* kp = F.lds + OFF_K + slot * KSL + 2 * hh * KCH2 + r * 16;
    LAS const unsigned char* vp = F.lds + OFF_V + slot * VSL + (4 * hh + ((F.lane & 15) >> 2)) * 64 + ((F.lane >> 4) & 1) * 32 + (F.lane & 3) * 8;
    f32x16 p0, p1;
#pragma unroll
    for (int i = 0; i < 16; ++i) { p0[i] = 0.f; p1[i] = 0.f; }
    {
        pg8::v8i_t ka[2][2];
#pragma unroll
        for (int kb = 0; kb < 2; ++kb)
#pragma unroll
            for (int j2 = 0; j2 < 2; ++j2) ka[kb][j2] = __builtin_shufflevector(*(LAS const pg8::v4i_t*)(kp + 4 * j2 * KCH2 + kb * 512), *(LAS const pg8::v4i_t*)(kp + (4 * j2 + 1) * KCH2 + kb * 512), 0, 1, 2, 3, 4, 5, 6, 7);
        __builtin_amdgcn_sched_barrier(0);
#pragma unroll
        for (int j2 = 0; j2 < 2; ++j2) p0 = __builtin_amdgcn_mfma_scale_f32_32x32x64_f8f6f4(ka[0][j2], qf[j2], p0, 0, 0, 0, 0x7f7f7f7f, 0, 0x7f7f7f7f);
#pragma unroll
        for (int j2 = 0; j2 < 2; ++j2) p1 = __builtin_amdgcn_mfma_scale_f32_32x32x64_f8f6f4(ka[1][j2], qf[j2], p1, 0, 0, 0, 0x7f7f7f7f, 0, 0x7f7f7f7f);
        __builtin_amdgcn_sched_barrier(0);
    }
    v4i16_t vl[2][4], vh[2][4];
    const unsigned vaddr = (unsigned)(uintptr_t)vp;
#pragma unroll
    for (int ks = 0; ks < 2; ++ks)
#pragma unroll
        for (int db = 0; db < 4; ++db) { TRR(vl[ks][db], vaddr, db * VDB2 + ks * 1024); TRR(vh[ks][db], vaddr, db * VDB2 + ks * 1024 + 512); }
    __builtin_amdgcn_sched_barrier(0);
    if (CAUSAL && diag) {
        if (F.wave & 1) {
#pragma unroll
            for (int i = 0; i < 16; ++i) p1[i] = (crow(i, hh) > r) ? -INFINITY : p1[i];
        } else {
#pragma unroll
            for (int i = 0; i < 16; ++i) { p0[i] = (crow(i, hh) > r) ? -INFINITY : p0[i]; p1[i] = -INFINITY; }
        }
    }
    const float dm = first ? 0.f : m;
    { const f32x2 dm2 = {dm, dm};
#pragma unroll
      for (int j = 0; j < 8; ++j) { f32x2 a = {p0[2 * j], p0[2 * j + 1]}, b = {p1[2 * j], p1[2 * j + 1]}; a = a - dm2; b = b - dm2; p0[2 * j] = a.x; p0[2 * j + 1] = a.y; p1[2 * j] = b.x; p1[2 * j + 1] = b.y; } }
    float mx = fmaxf(p0[0], p1[0]);
#pragma unroll
    for (int i = 1; i < 16; ++i) mx = fmaxf(mx, fmaxf(p0[i], p1[i]));
    mx = fmaxf(mx, __shfl_xor(mx, 32));
    if (first || __any(mx > 8.0f)) {
        const float delta = first ? mx : fmaxf(mx, 0.f);
        const float alpha = first ? 0.f : __builtin_amdgcn_exp2f(-delta);
        l *= alpha; m = dm + delta;
        { const f32x2 d2 = {delta, delta};
#pragma unroll
          for (int j = 0; j < 8; ++j) { f32x2 a = {p0[2 * j], p0[2 * j + 1]}, b = {p1[2 * j], p1[2 * j + 1]}; a = a - d2; b = b - d2; p0[2 * j] = a.x; p0[2 * j + 1] = a.y; p1[2 * j] = b.x; p1[2 * j + 1] = b.y; } }
        if (!first) {
            if (hh == 0) wsf[r] = alpha;
            asm volatile("s_waitcnt lgkmcnt(0)" ::: "memory");
#pragma unroll
            for (int i = 0; i < 16; ++i) { const float a = wsf[crow(i, hh)];
#pragma unroll
                for (int db = 0; db < 4; ++db) o[db][i] *= a; }
        }
    }
    { f32x2 sa = {0.f, 0.f}, sb = {0.f, 0.f};
#pragma unroll
      for (int j = 0; j < 8; ++j) {
          p0[2 * j] = __builtin_amdgcn_exp2f(p0[2 * j]); p0[2 * j + 1] = __builtin_amdgcn_exp2f(p0[2 * j + 1]); p1[2 * j] = __builtin_amdgcn_exp2f(p1[2 * j]); p1[2 * j + 1] = __builtin_amdgcn_exp2f(p1[2 * j + 1]);
          sa = sa + (f32x2){p0[2 * j], p0[2 * j + 1]}; sb = sb + (f32x2){p1[2 * j], p1[2 * j + 1]}; }
      sa = sa + sb; l += sa.x + sa.y; }
    u32x4 pw[4];
#pragma unroll
    for (int s2 = 0; s2 < 2; ++s2) {
        pw[s2] = (u32x4){cvt_pk_bf16(p0[8 * s2], p0[8 * s2 + 1]), cvt_pk_bf16(p0[8 * s2 + 2], p0[8 * s2 + 3]), cvt_pk_bf16(p0[8 * s2 + 4], p0[8 * s2 + 5]), cvt_pk_bf16(p0[8 * s2 + 6], p0[8 * s2 + 7])};
        pw[2 + s2] = (u32x4){cvt_pk_bf16(p1[8 * s2], p1[8 * s2 + 1]), cvt_pk_bf16(p1[8 * s2 + 2], p1[8 * s2 + 3]), cvt_pk_bf16(p1[8 * s2 + 4], p1[8 * s2 + 5]), cvt_pk_bf16(p1[8 * s2 + 6], p1[8 * s2 + 7])};
    }
    TRWAIT();
#pragma unroll
    for (int ks = 0; ks < 2; ++ks) {
        const bf16x8 pa = __builtin_bit_cast(bf16x8, pw[ks]);
#pragma unroll
        for (int db = 0; db < 4; ++db) {
            const bf16x8 vf = (bf16x8){vl[ks][db][0], vl[ks][db][1], vl[ks][db][2], vl[ks][db][3], vh[ks][db][0], vh[ks][db][1], vh[ks][db][2], vh[ks][db][3]};
            o[db] = __builtin_amdgcn_mfma_f32_32x32x16_bf16(pa, vf, o[db], 0, 0, 0);
        }
    }
    __builtin_amdgcn_sched_barrier(0);
#pragma unroll
    for (int ks = 0; ks < 2; ++ks)
#pragma unroll
        for (int db = 0; db < 4; ++db) { TRR(vl[ks][db], vaddr, db * VDB2 + (2 + ks) * 1024); TRR(vh[ks][db], vaddr, db * VDB2 + (2 + ks) * 1024 + 512); }
    TRWAIT();
#pragma unroll
    for (int ks = 0; ks < 2; ++ks) {
        const bf16x8 pa = __builtin_bit_cast(bf16x8, pw[2 + ks]);
#pragma unroll
        for (int db = 0; db < 4; ++db) {
            const bf16x8 vf = (bf16x8){vl[ks][db][0], vl[ks][db][1], vl[ks][db][2], vl[ks][db][3], vh[ks][db][0], vh[ks][db][1], vh[ks][db][2], vh[ks][db][3]};
            o[db] = __builtin_amdgcn_mfma_f32_32x32x16_bf16(pa, vf, o[db], 0, 0, 0);
        }
    }
    __builtin_amdgcn_sched_barrier(0);
}
}

#define ATT2_DECODE(item, bhj_, chunk_) do { int lo_ = 0, hi_ = 1023; while (lo_ < hi_) { const int mid_ = (lo_ + hi_ + 1) >> 1; if (P[mid_] <= (item)) lo_ = mid_; else hi_ = mid_ - 1; } bhj_ = lo_; chunk_ = (item) - P[lo_]; } while (0)
__device__ __forceinline__ void ph_attn_partial(const Ctx& F) {
    using namespace att2;
    const unsigned char* Q = F.ws + WS_Q; const unsigned char* K = F.ws + WS_K; const unsigned char* V = F.ws + WS_V;
    const unsigned* LISTS = (const unsigned*)(F.ws + WS_LISTS); const unsigned* LCNT = (const unsigned*)(F.ws + WS_CTL) + CW_LCNT;
    unsigned char* OP = F.ws + WS_OP; float* LSE = (float*)(F.ws + WS_LSE);
    LAS int* P = (LAS int*)(F.lds + OFF_TAB);
    if (F.tid < 64) {
        int c[16]; int s = 0;
#pragma unroll
        for (int i = 0; i < 16; ++i) { c[i] = ((int)__hip_atomic_load(LCNT + F.tid * 16 + i, __ATOMIC_RELAXED, __HIP_MEMORY_SCOPE_AGENT) + 255) >> 8; s += c[i]; }
        int inc = s;
#pragma unroll
        for (int o = 1; o < 64; o <<= 1) { const int t = __shfl_up(inc, o); if (F.lane >= o) inc += t; }
        int run = inc - s;
#pragma unroll
        for (int i = 0; i < 16; ++i) { P[F.tid * 16 + i] = run; run += c[i]; }
        if (F.tid == 63) P[1024] = run;
    }
    __syncthreads();
    const int total = P[1024];
    LAS float* wsf = (LAS float*)(F.lds + OFF_WS + F.wave * WSW);
    LAS int* wsi = (LAS int*)wsf;
    const int r = F.lane & 31, hh = F.lane >> 5;
    int it = F.vcu;
    if (it < total) {
        int bhj, chunk; ATT2_DECODE(it, bhj, chunk);
        int itn = it + F.G, bhjn = 0, chunkn = 0; bool hasn = itn < total; if (hasn) ATT2_DECODE(itn, bhjn, chunkn);
        u32x4 rkA, rvA, rkB, rvB;
        { const int b = bhj >> 7, h = (bhj >> 4) & 7, j = bhj & 15; const size_t tb = (size_t)b * SEQ + j * LBLK;
          tile_load(F, K, V, tb, h, 0, rkA, rvA); tile_load(F, K, V, tb, h, 1, rkB, rvB); tile_write(F, 0, rkA, rvA); tile_write(F, 1, rkB, rvB);
          tile_load(F, K, V, tb, h, 2, rkA, rvA); }
        int cnt = (int)__hip_atomic_load(LCNT + bhj, __ATOMIC_RELAXED, __HIP_MEMORY_SCOPE_AGENT);
        int qi = chunk * 256 + F.wave * 32 + r;
        unsigned ent = LISTS[(size_t)bhj * 4096 + (qi < cnt ? qi : 0)];
        int tq = ent & 4095, slot = (qi < cnt) ? (int)(ent >> 12) : -1;
        u32x4 qraw[4];
        { const unsigned char* qrow = Q + ((size_t)(bhj >> 7) * SEQ + tq) * DM + ((bhj >> 4) & 7) * DH + hh * 32;
#pragma unroll
          for (int c = 0; c < 4; ++c) qraw[c] = *(const u32x4*)(qrow + (c >> 1) * 64 + (c & 1) * 16); }
        unsigned entn = 0u; int cntn = 0;
        __syncthreads();
        int s = 0;
        for (;;) {
            const int b = bhj >> 7, h = (bhj >> 4) & 7, j = bhj & 15;
            pg8::v8i_t qr[2];
#pragma unroll
            for (int j2 = 0; j2 < 2; ++j2) qr[j2] = __builtin_shufflevector(__builtin_bit_cast(pg8::v4i_t, qraw[2 * j2]), __builtin_bit_cast(pg8::v4i_t, qraw[2 * j2 + 1]), 0, 1, 2, 3, 4, 5, 6, 7);
            if (F.lane < 32) { wsi[64 + r] = tq; wsi[96 + r] = slot; }
            f32x16 o[4]; float m = -1e30f, l = 0.f;
#pragma unroll
            for (int db = 0; db < 4; ++db)
#pragma unroll
                for (int i = 0; i < 16; ++i) o[db][i] = 0.f;
#define ATT2_TB(bb) ((size_t)((bb) >> 7) * SEQ + ((bb) & 15) * LBLK)
#define ATT2_H(bb) (((bb) >> 4) & 7)
#pragma unroll 1
            for (int kp2 = 0; kp2 < 2; ++kp2) {
                const int kt = 2 * kp2;
                { const bool cur3 = kt + 3 < 4, have3 = cur3 || hasn, have2 = (kt + 2 < 4) || hasn;
                  if (have3) { const int bb = cur3 ? bhj : bhjn; tile_load(F, K, V, ATT2_TB(bb), ATT2_H(bb), (kt + 3) & 3, rkB, rvB); }
                  if (kt == 0 && hasn) { cntn = (int)__hip_atomic_load(LCNT + bhjn, __ATOMIC_RELAXED, __HIP_MEMORY_SCOPE_AGENT); }
                  if (kt == 2 && hasn) { const unsigned char* qrow = Q + ((size_t)(bhjn >> 7) * SEQ + (entn & 4095)) * DM + ((bhjn >> 4) & 7) * DH + hh * 32;
#pragma unroll
                      for (int c = 0; c < 4; ++c) qraw[c] = *(const u32x4*)(qrow + (c >> 1) * 64 + (c & 1) * 16); }
                  tile_compute(F, 0, qr, o, m, l, kp2 == 0);
                  asm volatile("s_waitcnt lgkmcnt(0)" ::: "memory"); __builtin_amdgcn_s_barrier(); asm volatile("" ::: "memory");
                  if (have2) tile_write(F, 0, rkA, rvA); }
                { const bool have4 = hasn, have3 = (kt + 3 < 4) || hasn;
                  if (have4) { tile_load(F, K, V, ATT2_TB(bhjn), ATT2_H(bhjn), kt, rkA, rvA); }
                  if (kt == 0 && hasn) { const int qn = chunkn * 256 + F.wave * 32 + r; entn = LISTS[(size_t)bhjn * 4096 + (qn < cntn ? qn : 0)]; }
                  tile_compute(F, 1, qr, o, m, l, false);
                  asm volatile("s_waitcnt lgkmcnt(0)" ::: "memory"); __builtin_amdgcn_s_barrier(); asm volatile("" ::: "memory");
                  if (have3) tile_write(F, 1, rkB, rvB); }
            }
            const float lt = l + __shfl_xor(l, 32);
            if (hh == 0) { wsf[r] = 1.0f / lt; wsf[32 + r] = m + __builtin_amdgcn_logf(lt); }
            asm volatile("s_waitcnt lgkmcnt(0)" ::: "memory");
            int re = r, he = hh; asm volatile("" : "+v"(re), "+v"(he));
#pragma unroll
            for (int i = 0; i < 16; ++i) {
                const int q = crow(i, he); const float a = wsf[q]; const int t = wsi[64 + q], sl = wsi[96 + q];
                const unsigned w = pack_fp8x4(o[0][i] * a, o[1][i] * a, o[2][i] * a, o[3][i] * a);
                if (sl >= 0) { const size_t row = (((size_t)sl * NB + b) * SEQ + t) * NH + h; *(unsigned*)(OP + row * DH + 4 * re) = w; }
            }
            if (he == 0 && slot >= 0) LSE[(((size_t)slot * NB + b) * SEQ + tq) * NH + h] = wsf[32 + re];
            asm volatile("s_waitcnt lgkmcnt(0)" ::: "memory");
            if (!hasn) break;
            it = itn; bhj = bhjn; chunk = chunkn; cnt = cntn;
            { const int qn = chunk * 256 + F.wave * 32 + r; tq = entn & 4095; slot = (qn < cnt) ? (int)(entn >> 12) : -1; }
            itn = it + F.G; hasn = itn < total; if (hasn) ATT2_DECODE(itn, bhjn, chunkn);
        }
    }
    __syncthreads();
}

__device__ __forceinline__ void ph_attn_own(const Ctx& F) {
    using namespace att2;
    const unsigned char* Q = F.ws + WS_Q; const unsigned char* K = F.ws + WS_K; const unsigned char* V = F.ws + WS_V;
    const unsigned char* OP = F.ws + WS_OP; const float* LSE = (const float*)(F.ws + WS_LSE); bf16_t* YAB = (bf16_t*)(F.ws + WS_YAB);
    LAS float* wsf = (LAS float*)(F.lds + OFF_WS + F.wave * WSW);
    const int r = F.lane & 31, hh = F.lane >> 5;
    constexpr int NIT = NB * NH * NBLK;
    int it = F.vcu;
    if (it < NIT) {
        int itn = it + F.G; bool hasn = itn < NIT;
        u32x4 rkA, rvA, rkB, rvB;
#define OWN_TB(i_) ((size_t)((i_) >> 7) * SEQ + ((i_) & 15) * LBLK)
#define OWN_H(i_) (((i_) >> 4) & 7)
        tile_load(F, K, V, OWN_TB(it), OWN_H(it), 0, rkA, rvA); tile_load(F, K, V, OWN_TB(it), OWN_H(it), 1, rkB, rvB); tile_write(F, 0, rkA, rvA); tile_write(F, 1, rkB, rvB);
        tile_load(F, K, V, OWN_TB(it), OWN_H(it), 2, rkA, rvA);
        u32x4 qraw[4];
        { const unsigned char* qrow = Q + (OWN_TB(it) + F.wave * 32 + r) * DM + OWN_H(it) * DH + hh * 32;
#pragma unroll
          for (int c = 0; c < 4; ++c) qraw[c] = *(const u32x4*)(qrow + (c >> 1) * 64 + (c & 1) * 16); }
        __syncthreads();
        const int wdiag = F.wave >> 1;
        for (;;) {
            const int b = it >> 7, h = (it >> 4) & 7, j = it & 15, t0 = j * LBLK + F.wave * 32;
            pg8::v8i_t qr[2];
#pragma unroll
            for (int j2 = 0; j2 < 2; ++j2) qr[j2] = __builtin_shufflevector(__builtin_bit_cast(pg8::v4i_t, qraw[2 * j2]), __builtin_bit_cast(pg8::v4i_t, qraw[2 * j2 + 1]), 0, 1, 2, 3, 4, 5, 6, 7);
            f32x16 o[4]; float m = -1e30f, l = 0.f;
#pragma unroll
            for (int db = 0; db < 4; ++db)
#pragma unroll
                for (int i = 0; i < 16; ++i) o[db][i] = 0.f;
#pragma unroll 1
            for (int kp2 = 0; kp2 < 2; ++kp2) {
                const int kt = 2 * kp2;
                { const bool cur3 = kt + 3 < 4, have3 = cur3 || hasn, have2 = (kt + 2 < 4) || hasn;
                  if (have3) { const int ii = cur3 ? it : itn; tile_load(F, K, V, OWN_TB(ii), OWN_H(ii), (kt + 3) & 3, rkB, rvB); }
                  if (kt == 2 && hasn) { const unsigned char* qrow = Q + (OWN_TB(itn) + F.wave * 32 + r) * DM + OWN_H(itn) * DH + hh * 32;
#pragma unroll
                      for (int c = 0; c < 4; ++c) qraw[c] = *(const u32x4*)(qrow + (c >> 1) * 64 + (c & 1) * 16); }
                  if (kt <= wdiag) tile_compute<true>(F, 0, qr, o, m, l, kp2 == 0, kt == wdiag);
                  asm volatile("s_waitcnt lgkmcnt(0)" ::: "memory"); __builtin_amdgcn_s_barrier(); asm volatile("" ::: "memory");
                  if (have2) tile_write(F, 0, rkA, rvA); }
                { const bool have4 = hasn, have3 = (kt + 3 < 4) || hasn;
                  if (have4) { tile_load(F, K, V, OWN_TB(itn), OWN_H(itn), kt, rkA, rvA); }
                  if (kt + 1 <= wdiag) tile_compute<true>(F, 1, qr, o, m, l, false, kt + 1 == wdiag);
                  asm volatile("s_waitcnt lgkmcnt(0)" ::: "memory"); __builtin_amdgcn_s_barrier(); asm volatile("" ::: "memory");
                  if (have3) tile_write(F, 1, rkB, rvB); }
            }
            const int nv = j < 3 ? j : 3;
            {
                const float lt = l + __shfl_xor(l, 32); const float lse_own = m + __builtin_amdgcn_logf(lt);
                float ls[3];
#pragma unroll
                for (int s2 = 0; s2 < 3; ++s2) ls[s2] = (s2 < nv) ? LSE[(((size_t)s2 * NB + b) * SEQ + t0 + r) * NH + h] : -1e30f;
                const float M = fmaxf(fmaxf(lse_own, ls[0]), fmaxf(ls[1], ls[2]));
                const float w0 = __builtin_amdgcn_exp2f(lse_own - M);
                float w[3], den = w0;
#pragma unroll
                for (int s2 = 0; s2 < 3; ++s2) { w[s2] = (s2 < nv) ? __builtin_amdgcn_exp2f(ls[s2] - M) : 0.f; den += w[s2]; }
                const float inv = 1.0f / den;
                if (hh == 0) { wsf[r] = w0 * inv / lt; wsf[32 + r] = w[0] * inv; wsf[64 + r] = w[1] * inv; wsf[96 + r] = w[2] * inv; }
                asm volatile("s_waitcnt lgkmcnt(0)" ::: "memory");
            }
            int re = r, he = hh; asm volatile("" : "+v"(re), "+v"(he));
            LAS float* stg = (LAS float*)(F.lds + OFF_STG + F.wave * 8192);
            {
                unsigned pv[16][3];
#pragma unroll
                for (int i = 0; i < 16; ++i) { const int q = crow(i, he);
#pragma unroll
                    for (int s2 = 0; s2 < 3; ++s2) { pv[i][s2] = 0u; if (s2 < nv) pv[i][s2] = *(const unsigned*)(OP + ((((size_t)s2 * NB + b) * SEQ + t0 + q) * NH + h) * DH + 4 * re); } }
#pragma unroll
                for (int i = 0; i < 16; ++i) { const int q = crow(i, he); const float a = wsf[q];
                    float x0 = o[0][i] * a, x1 = o[1][i] * a, x2 = o[2][i] * a, x3 = o[3][i] * a;
#pragma unroll
                    for (int s2 = 0; s2 < 3; ++s2) { const float ww = wsf[32 * (s2 + 1) + q]; const f32x2v f0 = __builtin_amdgcn_cvt_pk_f32_fp8((int)pv[i][s2], false), f1 = __builtin_amdgcn_cvt_pk_f32_fp8((int)pv[i][s2], true);
                        x0 += ww * f0.x; x1 += ww * f0.y; x2 += ww * f1.x; x3 += ww * f1.y; }
                    o[0][i] = x0; o[1][i] = x1; o[2][i] = x2; o[3][i] = x3; }
            }
#pragma unroll
            for (int half = 0; half < 2; ++half) {
#pragma unroll
                for (int i = 0; i < 16; ++i) { const int q = crow(i, he); stg[q * 64 + re] = o[2 * half][i]; stg[q * 64 + 32 + re] = o[2 * half + 1][i]; }
                asm volatile("s_waitcnt lgkmcnt(0)" ::: "memory");
#pragma unroll
                for (int ps = 0; ps < 4; ++ps) {
                    const int q = ps * 8 + ((re + 32 * he) >> 3), dc = re & 7;
                    const f32x4 x = *(LAS const f32x4*)(stg + q * 64 + dc * 8), y = *(LAS const f32x4*)(stg + q * 64 + dc * 8 + 4);
                    *(u32x4*)(YAB + ((size_t)b * SEQ + t0 + q) * 2048 + 1024 + h * DH + half * 64 + dc * 8) = (u32x4){cvt_pk_bf16(x.x, x.y), cvt_pk_bf16(x.z, x.w), cvt_pk_bf16(y.x, y.y), cvt_pk_bf16(y.z, y.w)};
                }
                asm volatile("s_waitcnt lgkmcnt(0)" ::: "memory");
            }
            if (!hasn) break;
            it = itn; itn = it + F.G; hasn = itn < NIT;
        }
#undef OWN_TB
#undef OWN_H
    }
    __syncthreads();
}

__device__ __forceinline__ void ph_router(const Ctx& F) {
    const Args& A = *F.a;
    const bf16_t* Z = (const bf16_t*)(F.ws + WS_Z); const float* ZST = (const float*)(F.ws + WS_ZST); bf16_t* H1 = (bf16_t*)(F.ws + WS_H1); unsigned char* H1F8 = F.ws + WS_H1F8;
    int* TKE = (int*)(F.ws + WS_TKE); int* TKP = (int*)(F.ws + WS_TKP); unsigned* ECNT = (unsigned*)(F.ws + WS_CTL) + CW_ECNT; int* RT = (int*)(F.ws + WS_RT); float* RW = (float*)(F.ws + WS_RW);
    const float* wr = A.in[I_WR]; const float* br = A.in[I_BR];
    constexpr int RS = 2064, OFF_LO = 32 * RS, OFF_G = 2 * 32 * RS  , OFF_B = OFF_G + 4096, OFF_LG = OFF_B + 4096  , OFF_CNT = OFF_LG + 8 * 2112  ;
    static_assert(OFF_CNT + 256 <= LDS_BYTES, "router LDS map");
    LAS unsigned char* WH = F.lds; LAS unsigned char* WL = F.lds + OFF_LO;
    LAS float* LG = (LAS float*)(F.lds + OFF_G); LAS float* LB = (LAS float*)(F.lds + OFF_B);
    LAS float* lgt = (LAS float*)(F.lds + OFF_LG + F.wave * 2112);
    LAS unsigned* lcnt = (LAS unsigned*)(F.lds + OFF_CNT);
    {
        f32x4 wa[8], wb[8];
#pragma unroll
        for (int u_ = 0; u_ < 8; ++u_) { const int i = F.tid + 512 * u_, nq = i & 7, k2 = i >> 3;
            wa[u_] = *(const f32x4*)(wr + (size_t)(2 * k2) * NE + 4 * nq); wb[u_] = *(const f32x4*)(wr + (size_t)(2 * k2 + 1) * NE + 4 * nq); }
#pragma unroll
        for (int u_ = 0; u_ < 8; ++u_) { const int i = F.tid + 512 * u_, nq = i & 7, k2 = i >> 3;
#pragma unroll
            for (int c = 0; c < 4; ++c) {
                const float w0 = wa[u_][c], w1 = wb[u_][c];
                const unsigned h0 = f2bf(w0), h1 = f2bf(w1);
                const float r0 = w0 - __uint_as_float(h0 << 16), r1 = w1 - __uint_as_float(h1 << 16);
                *(LAS unsigned*)(WH + (4 * nq + c) * RS + k2 * 4) = h0 | (h1 << 16);
                *(LAS unsigned*)(WL + (4 * nq + c) * RS + k2 * 4) = pk2(r0, r1);
            } }
    }
    for (int i = F.tid; i < DM; i += 512) { LG[i] = A.in[I_LNMIX_G][i]; LB[i] = A.in[I_LNMIX_B][i]; }
    if (F.tid < 64) lcnt[F.tid] = 0u;
    __syncthreads();
    const int fr = F.lane & 15, kg = F.lane >> 4;
    const int ntask = T / 16, NGW = F.G * 8;
    const int rounds = (ntask + NGW - 1) / NGW;
    for (int rd = 0; rd < rounds; ++rd) {
        const int task = rd * NGW + F.vcu * 8 + F.wave;
        const bool live = task < ntask;
        int te[4] = {0, 0, 0, 0}; float tw[4] = {0.f, 0.f, 0.f, 0.f}; unsigned lp[4] = {0, 0, 0, 0};
        if (live) {
            const int tok = task * 16 + fr;
            float mean, rstd;
            { const f32x4* sp = (const f32x4*)(ZST + (size_t)tok * 32); float s1 = 0.f, s2 = 0.f;
#pragma unroll
              for (int i = 0; i < 8; ++i) { const f32x4 v = sp[i]; s1 += v.x + v.z; s2 += v.y + v.w; }
              mean = s1 * (1.f / DM); const float var = s2 * (1.f / DM) - mean * mean; rstd = 1.f / sqrtf(fmaxf(var, 0.f) + LN_EPS); }
            f32x4 acc0 = {0.f, 0.f, 0.f, 0.f}, acc1 = {0.f, 0.f, 0.f, 0.f};
            const bf16_t* zp = Z + (size_t)tok * DM + 8 * kg; unsigned char* h8 = H1F8 + (size_t)tok * DM + 8 * kg;
#pragma unroll 8
            for (int kk = 0; kk < 32; ++kk) {
                const u32x4 zr = *(const u32x4*)(zp + 32 * kk); const f32x4 z0 = {bflo(zr.x), bfhi(zr.x), bflo(zr.y), bfhi(zr.y)}, z1 = {bflo(zr.z), bfhi(zr.z), bflo(zr.w), bfhi(zr.w)};
                const f32x4 g0 = *(LAS const f32x4*)(LG + 32 * kk + 8 * kg), g1 = *(LAS const f32x4*)(LG + 32 * kk + 8 * kg + 4);
                const f32x4 b0 = *(LAS const f32x4*)(LB + 32 * kk + 8 * kg), b1 = *(LAS const f32x4*)(LB + 32 * kk + 8 * kg + 4);
                const f32x4 x0 = (z0 - mean) * rstd * g0 + b0, x1 = (z1 - mean) * rstd * g1 + b1;
                u32x4 hi; hi.x = cvt_pk_bf16(x0.x, x0.y); hi.y = cvt_pk_bf16(x0.z, x0.w); hi.z = cvt_pk_bf16(x1.x, x1.y); hi.w = cvt_pk_bf16(x1.z, x1.w);
                { unsigned w0 = 0u, w1 = 0u;
                  w0 = __builtin_amdgcn_cvt_pk_fp8_f32(x0.x, x0.y, w0, false); w0 = __builtin_amdgcn_cvt_pk_fp8_f32(x0.z, x0.w, w0, true);
                  w1 = __builtin_amdgcn_cvt_pk_fp8_f32(x1.x, x1.y, w1, false); w1 = __builtin_amdgcn_cvt_pk_fp8_f32(x1.z, x1.w, w1, true);
                  *(u32x2*)(h8 + 32 * kk) = (u32x2){w0, w1}; }
                u32x4 lo; lo.x = cvt_pk_bf16(x0.x - bflo(hi.x), x0.y - bfhi(hi.x)); lo.y = cvt_pk_bf16(x0.z - bflo(hi.y), x0.w - bfhi(hi.y));
                lo.z = cvt_pk_bf16(x1.x - bflo(hi.z), x1.y - bfhi(hi.z)); lo.w = cvt_pk_bf16(x1.z - bflo(hi.w), x1.w - bfhi(hi.w));
                const bf16x8 ah = __builtin_bit_cast(bf16x8, hi), al = __builtin_bit_cast(bf16x8, lo);
                const int bo = fr * RS + (32 * kk + 8 * kg) * 2;
                const bf16x8 wh0 = *(LAS const bf16x8*)(WH + bo), wh1 = *(LAS const bf16x8*)(WH + bo + 16 * RS), wl0 = *(LAS const bf16x8*)(WL + bo), wl1 = *(LAS const bf16x8*)(WL + bo + 16 * RS);
                acc0 = __builtin_amdgcn_mfma_f32_16x16x32_bf16(ah, wh0, acc0, 0, 0, 0); acc1 = __builtin_amdgcn_mfma_f32_16x16x32_bf16(ah, wh1, acc1, 0, 0, 0);
                acc0 = __builtin_amdgcn_mfma_f32_16x16x32_bf16(ah, wl0, acc0, 0, 0, 0); acc1 = __builtin_amdgcn_mfma_f32_16x16x32_bf16(ah, wl1, acc1, 0, 0, 0);
                acc0 = __builtin_amdgcn_mfma_f32_16x16x32_bf16(al, wh0, acc0, 0, 0, 0); acc1 = __builtin_amdgcn_mfma_f32_16x16x32_bf16(al, wh1, acc1, 0, 0, 0);
            }
            const float br0 = br[fr], br1 = br[16 + fr];
#pragma unroll
            for (int i = 0; i < 4; ++i) { lgt[(4 * kg + i) * 33 + fr] = acc0[i] + br0; lgt[(4 * kg + i) * 33 + 16 + fr] = acc1[i] + br1; }
            asm volatile("s_waitcnt lgkmcnt(0)" ::: "memory");
            if (F.lane < 16) {
                float lg[NE];
#pragma unroll
                for (int e = 0; e < NE; ++e) lg[e] = lgt[F.lane * 33 + e];
                float tv[4];
#pragma unroll
                for (int r = 0; r < 4; ++r) {
                    float best = -INFINITY; int bi = 0;
#pragma unroll
                    for (int e = 0; e < NE; ++e) { const bool c = lg[e] > best; best = c ? lg[e] : best; bi = c ? e : bi; }
#pragma unroll
                    for (int e = 0; e < NE; ++e) lg[e] = (e == bi) ? -INFINITY : lg[e];
                    te[r] = bi; tv[r] = best;
                }
                const float e1 = __expf(tv[1] - tv[0]), e2 = __expf(tv[2] - tv[0]), e3 = __expf(tv[3] - tv[0]); const float inv = 1.f / (1.f + e1 + e2 + e3);
                tw[0] = inv; tw[1] = e1 * inv; tw[2] = e2 * inv; tw[3] = e3 * inv;
#pragma unroll
                for (int r = 0; r < 4; ++r) lp[r] = atomicAdd((unsigned*)(lcnt + te[r]), 1u);
            }
        }
        __syncthreads();
        if (F.tid < 32) { const unsigned c = lcnt[F.tid]; lcnt[32 + F.tid] = c ? atomicAdd(&ECNT[F.tid], c) : 0u; }
        __syncthreads();
        if (live && F.lane < 16) {
            const size_t tok = (size_t)task * 16 + F.lane;
            int4 pe = {te[0], te[1], te[2], te[3]};
            int4 pp = {(int)(lcnt[32 + te[0]] + lp[0]), (int)(lcnt[32 + te[1]] + lp[1]), (int)(lcnt[32 + te[2]] + lp[2]), (int)(lcnt[32 + te[3]] + lp[3])};
            *(int4*)(TKE + tok * 4) = pe; *(int4*)(TKP + tok * 4) = pp;
#pragma unroll
            for (int r = 0; r < 4; ++r) { const size_t o_ = (size_t)te[r] * T + (r == 0 ? pp.x : r == 1 ? pp.y : r == 2 ? pp.z : pp.w); RT[o_] = (int)tok; RW[o_] = tw[r]; }
        }
        __syncthreads();
        if (F.tid < 32) lcnt[F.tid] = 0u;
        __syncthreads();
    }
}

__device__ __forceinline__ void moe_table(const Ctx& F) {
    const unsigned* ECNT = (const unsigned*)(F.ws + WS_CTL) + CW_ECNT;
    LAS int* tab = (LAS int*)(F.lds + LDS_MOE);
    __syncthreads();
    if (F.tid == 0) {
        int acc = 0;
        for (int e = 0; e < NE; ++e) { const int c = (int)__hip_atomic_load(ECNT + e, __ATOMIC_RELAXED, __HIP_MEMORY_SCOPE_AGENT); tab[32 + e] = acc; acc += (c + 255) / 256 * 256; }
        tab[64] = acc; tab[0] = acc / 256;
    }
    __syncthreads();
    const int ntiles = tab[0];
    for (int i = F.tid; i < ntiles; i += 512) { int e = 0; for (int k = 1; k < NE; ++k) if (i * 256 >= tab[32 + k]) e = k; tab[128 + 2 * i] = e; tab[129 + 2 * i] = i - tab[32 + e] / 256; }
    __syncthreads();
}

__device__ __forceinline__ void ln_stats16(const float* st, int lane, float& mean, float& rstd) {
    float s1 = 0.f, s2 = 0.f;
    if (lane < 16) { const f32x2 p = *(const f32x2*)(st + 2 * lane); s1 = p.x; s2 = p.y; }
    s1 = wave_sum(s1); s2 = wave_sum(s2);
    mean = s1 * (1.f / DM); const float var = s2 * (1.f / DM) - mean * mean; rstd = 1.f / sqrtf(fmaxf(var, 0.f) + LN_EPS);
}
__device__ __forceinline__ void ph_final(const Ctx& F) {
    const Args& A = *F.a;
    const bf16_t* Z = (const bf16_t*)(F.ws + WS_Z); const float* ZST = (const float*)(F.ws + WS_ZST); const unsigned char* YS = F.ws + WS_YS; const int* TKE = (const int*)(F.ws + WS_TKE); const int* TKP = (const int*)(F.ws + WS_TKP);
    const LAS int* tab = (const LAS int*)(F.lds + LDS_MOE);
    const int gw = F.vcu * 8 + F.wave, NGW = F.G * 8;
    f32x4 g2[4], b2[4], g1[4], b1[4];
#pragma unroll
    for (int j = 0; j < 4; ++j) { g2[j] = *((const f32x4*)A.in[I_LNF_G] + F.lane + 64 * j); b2[j] = *((const f32x4*)A.in[I_LNF_B] + F.lane + 64 * j);
        g1[j] = *((const f32x4*)A.in[I_LNMIX_G] + F.lane + 64 * j) * ALPHA; b1[j] = *((const f32x4*)A.in[I_LNMIX_B] + F.lane + 64 * j) * ALPHA; }
    for (int m = gw; m < T; m += NGW) {
        float mean, rstd; ln_stats16(ZST + (size_t)m * 32, F.lane, mean, rstd);
        const u32x2* hr = (const u32x2*)(Z + (size_t)m * DM) + F.lane;
        f32x4 v[4];
#pragma unroll
        for (int j = 0; j < 4; ++j) { const u32x2 hb = hr[64 * j]; v[j] = ((f32x4){bflo(hb.x), bfhi(hb.x), bflo(hb.y), bfhi(hb.y)} - mean) * rstd * g1[j] + b1[j]; }
#pragma unroll
        for (int k = 0; k < 4; ++k) {
            const int row = tab[32 + TKE[(size_t)m * 4 + k]] + TKP[(size_t)m * 4 + k]; const unsigned* yr = (const unsigned*)(YS + (size_t)row * DM) + F.lane;
#pragma unroll
            for (int j = 0; j < 4; ++j) { const unsigned y = yr[64 * j]; const f32x2v f0 = __builtin_amdgcn_cvt_pk_f32_fp8((int)y, false), f1 = __builtin_amdgcn_cvt_pk_f32_fp8((int)y, true);
                v[j].x += 0.0625f * f0.x; v[j].y += 0.0625f * f0.y; v[j].z += 0.0625f * f1.x; v[j].w += 0.0625f * f1.y; }
        }
        float s = 0.f;
#pragma unroll
        for (int j = 0; j < 4; ++j) s += (v[j].x + v[j].y) + (v[j].z + v[j].w);
        const float mu = wave_sum(s) * (1.f / DM); float s2 = 0.f;
#pragma unroll
        for (int j = 0; j < 4; ++j) { v[j] = v[j] - mu; s2 += (v[j].x * v[j].x + v[j].y * v[j].y) + (v[j].z * v[j].z + v[j].w * v[j].w); }
        const float rs = 1.f / sqrtf(wave_sum(s2) * (1.f / DM) + LN_EPS);
        f32x4* orow = (f32x4*)(A.out + (size_t)m * DM) + F.lane;
#pragma unroll
        for (int j = 0; j < 4; ++j) orow[64 * j] = v[j] * rs * g2[j] + b2[j];
    }
}

#define XB_TMO      128
#define XB_XCNT(j)  (256  + 64 * (j))
#define XB_XSUB(j)  (1280 + 64 * (j))
#define XB_XGEN(j)  (2304 + 64 * (j))
#define XB_TOP      3328
#define XB_TOPGEN   3392
#define XCD_BAR_WORDS 3456
#define XB_SPIN_CAP (1u << 18)
__device__ __forceinline__ unsigned xb_ld(unsigned* p)              { return __hip_atomic_load(p, __ATOMIC_RELAXED, __HIP_MEMORY_SCOPE_AGENT); }
__device__ __forceinline__ unsigned xb_add(unsigned* p, unsigned v) { return __hip_atomic_fetch_add(p, v, __ATOMIC_RELAXED, __HIP_MEMORY_SCOPE_AGENT); }
__device__ __forceinline__ unsigned xb_xcc_id() { return (unsigned)__builtin_amdgcn_s_getreg((3 << 11) | 20) & 0xFu; }
#define XB_SPIN(cond, bar) do { unsigned _sp = 0; while (cond) { __builtin_amdgcn_s_sleep(1); \
    if ((++_sp & 255u) == 0u) { if (xb_ld(&(bar)[XB_TMO])) break; if (_sp > XB_SPIN_CAP) { atomicAdd(&(bar)[XB_TMO], 1u); break; } } } } while (0)
__device__ __forceinline__ void xcd_barrier_complete(unsigned* bar, unsigned x, unsigned& nloc, unsigned& nx) {
    const unsigned G = gridDim.x * gridDim.y * gridDim.z;
    unsigned sum, cnt, mine, sp = 0u;
    for (;;) {
        sum = 0u; cnt = 0u; mine = 0u;
#pragma unroll
        for (unsigned j = 0; j < 16; ++j) { const unsigned c = xb_ld(&bar[XB_XCNT(j)]); sum += c; cnt += (c > 0u) ? 1u : 0u; mine = (j == x) ? c : mine; }
        if (sum == G) break;
        __builtin_amdgcn_s_sleep(1);
        if ((++sp & 255u) == 0u) { if (xb_ld(&bar[XB_TMO])) break; if (sp > XB_SPIN_CAP) { atomicAdd(&bar[XB_TMO], 1u); break; } }
    }
    nloc = mine > 0u ? mine : 1u; nx = cnt > 0u ? cnt : 1u;
}
__device__ __forceinline__ void xcd_barrier(unsigned* bar, volatile LAS unsigned* st, unsigned x, bool leader_thread) {
    asm volatile("s_waitcnt vmcnt(0)" ::: "memory");
    __syncthreads();
    if (leader_thread) {
        __builtin_amdgcn_s_waitcnt(0);
        unsigned nloc = st[0], nx = st[1];
        if (nloc == 0u) { xcd_barrier_complete(bar, x, nloc, nx); st[0] = nloc; st[1] = nx; }
        const unsigned old = xb_add(&bar[XB_XSUB(x)], 1u);
        const unsigned gen = old / nloc;
        if (old + 1u == (gen + 1u) * nloc) {
            __builtin_amdgcn_fence(__ATOMIC_RELEASE, "agent");
            asm volatile("s_waitcnt vmcnt(0)" ::: "memory");
            const unsigned og = xb_add(&bar[XB_TOP], 1u);
            const unsigned tg = og / nx;
            if (og + 1u == (tg + 1u) * nx) xb_add(&bar[XB_TOPGEN], 1u);
            else XB_SPIN(xb_ld(&bar[XB_TOPGEN]) == tg, bar);
            __builtin_amdgcn_fence(__ATOMIC_ACQUIRE, "agent");
            xb_add(&bar[XB_XGEN(x)], 1u);
            asm volatile("s_waitcnt vmcnt(0)" ::: "memory");
        } else {
            XB_SPIN(xb_ld(&bar[XB_XGEN(x)]) == gen, bar);
            __builtin_amdgcn_fence(__ATOMIC_ACQUIRE, "agent");
            asm volatile("s_waitcnt vmcnt(0)" ::: "memory");
        }
    }
    __syncthreads();
}

template <bool COOP>
__global__ void __launch_bounds__(512, 2) mega(Args args) {
    extern __shared__ __attribute__((aligned(16))) unsigned char lds_raw[];
    Ctx F;
    const int wave0 = __builtin_amdgcn_readfirstlane(threadIdx.x >> 6);
#define MKCTX() do { F.a = &args; F.ws = args.ws; F.lds = (LAS unsigned char*)lds_raw; F.ldsg = lds_raw; F.lane = lane_id_asm(); F.wave = wave0; F.tid = wave0 * 64 + F.lane; \
    F.G = gridDim.x; { const int bx = blockIdx.x; F.vcu = (F.G % 8 == 0) ? (bx % 8) * (F.G / 8) + bx / 8 : bx; } } while (0)
    MKCTX();
    const int lo = args.ph_lo, hi = args.ph_hi;
    unsigned char* ws = args.ws;
#ifndef PHMASK
#define PHMASK 0xFFFF
#endif
#define IN(k) (((PHMASK >> (k)) & 1) && lo <= (k) && (k) < hi)
    unsigned* barw = (unsigned*)(ws + WS_CTL) + CW_BAR; volatile LAS unsigned* bst = (volatile LAS unsigned*)((LAS unsigned char*)lds_raw + LDS_BYTES - 64);
    const unsigned my_xcc = xb_xcc_id();
    if (COOP) { if (threadIdx.x == 0) { bst[0] = 0u; bst[1] = 0u; (void)xb_add(&barw[XB_XCNT(my_xcc)], 1u); } __syncthreads(); }
#define SEAM(k) do { if (COOP && IN(k) && IN((k) + 1)) { if (args.ph_hi > 1000) cg::this_grid().sync();   xcd_barrier(barw, bst, my_xcc, wave0 == 0 && lane_id_asm() == 0); } } while (0)
    if (IN(0)) { MKCTX(); ph_prologue(F); } SEAM(0);
    if (IN(1)) {
        const int wslot = (F.G % 8 == 0) ? ((int)blockIdx.x / 8) % 3 : (int)blockIdx.x % 3;
        if (wslot == 0) { MKCTX(); ph_wconv(F); }
        {
            pg8::Gemm g{(const bf16_t*)(ws + WS_H0), (const bf16_t*)(ws + WS_WIN), DM, DM, DM, nullptr}; pg8::StaticOrder S; S.init(T, (PN8_LO + 28 - PN8_HI) * 256, F.G, (int)blockIdx.x, 0, PN8_LO, PN8_HI - PN8_LO);
            const pg8::Epi1 E{(bf16_t*)(ws + WS_YAB), (bf16_t*)(ws + WS_GV), ws + WS_Q, ws + WS_K, ws + WS_V, (bf16_t*)(ws + WS_SA), (bf16_t*)(ws + WS_SB), (float*)(ws + WS_GVST), (float*)(ws + WS_KMEAN), 1.0f, 0.f};
            pg8::gemm_phase<pg8::Epi1, pg8::StaticOrder, true>(F.lds, g, S, E, wave0);
        }
        if (wslot == 1) { MKCTX(); ph_wconv(F); }
        {
            const pg8::Epi1 E{(bf16_t*)(ws + WS_YAB), (bf16_t*)(ws + WS_GV), ws + WS_Q, ws + WS_K, ws + WS_V, (bf16_t*)(ws + WS_SA), (bf16_t*)(ws + WS_SB), (float*)(ws + WS_GVST), (float*)(ws + WS_KMEAN), 0.03125f, 0.f};
            pg8::Gemm g{(const bf16_t*)(ws + WS_H0F8), (const bf16_t*)(ws + WS_WIN8), DM / 2, DM / 2, DM / 2, nullptr}; pg8::StaticOrder S; S.init(T, (PN8_HI - PN8_LO) * 256, F.G, (int)blockIdx.x, PN8_LO);
            pg8::gemm_phase<pg8::Epi1, pg8::StaticOrder, true, true>(F.lds, g, S, E, wave0);
        }
        if (wslot == 2) { MKCTX(); ph_wconv(F); }
    } SEAM(1);
    if (IN(2)) { MKCTX(); ph_mixer_a(F); __syncthreads(); ph_gate(F); } SEAM(2);
    if (IN(3)) { } if (COOP && IN(3) && IN(4)) { }
    if (IN(4)) { MKCTX(); ph_attn_partial(F); } SEAM(4);
    if (IN(5)) { MKCTX(); ph_attn_own(F); } SEAM(5);
    if (IN(6)) {
        pg8::Gemm g{(const bf16_t*)(ws + WS_YAB), (const bf16_t*)(ws + WS_WAB), 2048, 2048, 2048, nullptr}; pg8::StaticOrder S; S.init(T, DM, F.G, (int)blockIdx.x);
        pg8::Epi2 E{ws + WS_SA, ws + WS_SB, (bf16_t*)(ws + WS_MG)};
        pg8::gemm_phase<pg8::Epi2, pg8::StaticOrder, true>(F.lds, g, S, E, wave0);
    } SEAM(6);
    if (IN(7)) {
        pg8::Gemm g{(const bf16_t*)(ws + WS_MG), (const bf16_t*)(ws + WS_WOUT), DM, DM, DM, nullptr}; pg8::StaticOrder S; S.init(T, DM, F.G, (int)blockIdx.x);
        pg8::Epi3 E{(const bf16_t*)(ws + WS_H0), (bf16_t*)(ws + WS_Z), (float*)(ws + WS_ZST)};
        pg8::gemm_phase<pg8::Epi3, pg8::StaticOrder, true>(F.lds, g, S, E, wave0);
    } SEAM(7);
    if (IN(8)) { MKCTX(); ph_router(F); } SEAM(8);
    if (IN(9)) { } if (COOP && IN(9) && IN(10)) { }
    if (IN(10)) {
        MKCTX(); moe_table(F);
        pg8::Gemm g{(const bf16_t*)(ws + WS_H1F8), (const bf16_t*)(ws + WS_WUP), DM / 2, DM / 2, DM / 2, (const int*)(ws + WS_RT)}; pg8::MoeOrder S;   S.init((const LAS int*)(F.lds + LDS_MOE), 8, F.G, (int)blockIdx.x);
        pg8::Epi4 E{args.in[I_BUP], ws + WS_ACT};
        pg8::gemm_phase<pg8::Epi4, pg8::MoeOrder, true, true, true>(F.lds, g, S, E, wave0);
    } SEAM(10);
    if (IN(11)) {
        MKCTX(); moe_table(F);
        pg8::Gemm g{(const bf16_t*)(ws + WS_ACT), (const bf16_t*)(ws + WS_WDN), FF / 2, FF / 2, FF / 2, nullptr}; pg8::MoeOrder S; S.init((const LAS int*)(F.lds + LDS_MOE), 4, F.G, (int)blockIdx.x);
        pg8::Epi5 E{args.in[I_BDN], (const float*)(ws + WS_RW), ws + WS_YS};
        pg8::gemm_phase<pg8::Epi5, pg8::MoeOrder, true, true>(F.lds, g, S, E, wave0);
    } SEAM(11);
    if (IN(12)) { MKCTX(); moe_table(F); ph_final(F); }
#undef IN
#undef SEAM
}

extern "C" void kernel_launch(void* const* d_in, const int* in_sizes, int n_in, void* d_out, int out_size, void* d_ws, size_t ws_size, hipStream_t stream) {
    static int grid = 0;
    if (grid == 0) {
        if (n_in != 21 || in_sizes[0] != T * DM || out_size != T * DM || ws_size < WS_END) { fprintf(stderr, "kernel_launch: unexpected shapes (n_in %d, in0 %d, out %d, ws %zu)\n", n_in, n_in > 0 ? in_sizes[0] : -1, out_size, ws_size); grid = -1; return; }
        int dev = 0, cus = 0, per_cu = 0;
        hipGetDevice(&dev); hipDeviceGetAttribute(&cus, hipDeviceAttributeMultiprocessorCount, dev);
        const void* fn = MK_COOP ? (const void*)mega<true> : (const void*)mega<false>;
        hipFuncSetAttribute(fn, hipFuncAttributeMaxDynamicSharedMemorySize, LDS_BYTES);
        hipOccupancyMaxActiveBlocksPerMultiprocessor(&per_cu, fn, 512, LDS_BYTES);
        (void)hipGetLastError();
        if (per_cu < 1) { fprintf(stderr, "kernel_launch: occupancy query says %d blocks/CU\n", per_cu); per_cu = 1; }
        grid = cus * 1;
    }
    if (grid < 0) return;
    hipMemsetAsync((char*)d_ws + WS_CTL, 0, CTL_ZERO_BYTES, stream);
    Args a{};
    for (int i = 0; i < 21; ++i) a.in[i] = (const float*)d_in[i];
    a.out = (float*)d_out; a.ws = (unsigned char*)d_ws;
#if MK_COOP
    a.ph_lo = 0; a.ph_hi = NPHASE;
    void* kargs[] = {&a};
    hipError_t e = hipLaunchCooperativeKernel((const void*)mega<true>, dim3(grid), dim3(512), kargs, LDS_BYTES, stream);
    if (e != hipSuccess) fprintf(stderr, "cooperative launch failed: %s (grid %d)\n", hipGetErrorString(e), grid);
#else
    for (int p = 0; p < NPHASE; ++p) { a.ph_lo = p; a.ph_hi = p + 1; hipLaunchKernelGGL(mega<false>, dim3(grid), dim3(512), LDS_BYTES, stream, a); }
#endif
}
```

```cpp
#include <hip/hip_runtime.h>
#include <hip/hip_cooperative_groups.h>
#include <cstdio>
#include <cstdint>
namespace cg = cooperative_groups;

#ifndef MK_COOP
#define MK_COOP 1
#endif

#define LAS __attribute__((address_space(3)))
typedef unsigned short bf16_t;
typedef short bf16x8 __attribute__((ext_vector_type(8)));
typedef float f32x4 __attribute__((ext_vector_type(4)));
typedef float f32x2 __attribute__((ext_vector_type(2)));
typedef unsigned u32x4 __attribute__((ext_vector_type(4)));
typedef unsigned u32x2 __attribute__((ext_vector_type(2)));

constexpr int NB = 8, SEQ = 4096, DM = 1024, T = NB * SEQ;
constexpr int NH = 8, DH = 128, LBLK = 256, NBLK = SEQ / LBLK;
constexpr int NE = 32, TOPK = 4, FF = 1024;
constexpr int INCOLS = 7 * DM;
constexpr int RMAX = T * TOPK + NE * 256;
constexpr float LN_EPS = 1e-5f;
constexpr float ALPHA = 1.189207115002721f;
constexpr float QSCALE = 0.08838834764831845f * 1.4426950408889634f;

constexpr size_t MiB = 1u << 20, U64 = 64 * MiB;
constexpr size_t WS_CTL = 0, CTL_ZERO_BYTES = 1 * MiB;
constexpr int CW_ECNT = 64;
constexpr int CW_LCNT = 1024;
constexpr int CW_BAR = 4096;
constexpr size_t WS_KMEAN = 1 * MiB;
constexpr size_t WS_GVST = 2 * MiB;
constexpr size_t WS_ZST = 6 * MiB;
constexpr size_t WS_SEL = 10 * MiB;
constexpr size_t WS_TKE = 11 * MiB;
constexpr size_t WS_TKW = 11 * MiB + 512 * 1024;
constexpr size_t WS_TKP = 12 * MiB;
constexpr size_t WS_ROWOF = 12 * MiB + 512 * 1024;
constexpr size_t WS_ROWTOK = 13 * MiB;
constexpr size_t WS_ROWW = 14 * MiB;
constexpr size_t WS_TILE = 15 * MiB;
constexpr size_t WS_LISTS = 16 * MiB;
constexpr size_t WS_LSE = 32 * MiB;
constexpr size_t WS_RT = 16 * MiB;
constexpr size_t WS_RW = 20 * MiB;
constexpr int LDS_MOE = 131072 + 1024;
constexpr size_t WS_WIN = 40 * MiB;
constexpr size_t WS_WAB = 54 * MiB;
constexpr size_t WS_WOUT = 58 * MiB;
constexpr size_t WS_WDN = 60 * MiB;
constexpr size_t WS_WUP = 124 * MiB;
constexpr size_t WS_H0 = 4 * U64;
constexpr size_t WS_YAB = 5 * U64;
constexpr size_t WS_GV = 7 * U64;
constexpr size_t WS_Q = 8 * U64, WS_K = 9 * U64, WS_V = 10 * U64, WS_SA = 11 * U64, WS_SB = 12 * U64;
constexpr size_t WS_OP = 13 * U64;
constexpr size_t WS_MG = WS_GV;
constexpr size_t WS_Z = 14 * U64;
constexpr size_t WS_H1 = WS_H0;
constexpr size_t WS_XG = 5 * U64;
constexpr size_t WS_H1F8 = 12 * U64;
constexpr size_t WS_ACT = 9 * U64 + 16 * MiB;
constexpr size_t WS_YS = WS_XG;
constexpr size_t WS_H0F8 = 13 * U64;
constexpr size_t WS_WIN8 = 192 * MiB;
constexpr int PN8_LO = 8, PN8_HI = 28;
constexpr size_t WS_END = 16 * U64;
static_assert(WS_XG + (size_t)RMAX * 2048 <= WS_ACT && WS_ACT + (size_t)RMAX * 2048 <= WS_Z, "ws map");

constexpr int LDS_BYTES = 163840;
constexpr int LDS_MISC = 131072;
constexpr int NPHASE = 13;

__device__ __forceinline__ float bf2f(bf16_t v) { return __uint_as_float((unsigned)v << 16); }
__device__ __forceinline__ float bflo(unsigned u) { return __uint_as_float(u << 16); }
__device__ __forceinline__ float bfhi(unsigned u) { return __uint_as_float(u & 0xffff0000u); }
__device__ __forceinline__ unsigned f2bf(float f) { unsigned u = __builtin_bit_cast(unsigned, f); return (u + 0x7fffu + ((u >> 16) & 1u)) >> 16; }
__device__ __forceinline__ unsigned pk2(float lo, float hi) { return f2bf(lo) | (f2bf(hi) << 16); }
typedef __bf16 bf16x2_t __attribute__((ext_vector_type(2)));
__device__ __forceinline__ unsigned cvt_pk_bf16(float lo, float hi) { f32x2 v = {lo, hi}; bf16x2_t b = __builtin_convertvector(v, bf16x2_t); return __builtin_bit_cast(unsigned, b); }
__device__ __forceinline__ int lane_id_asm() { int l; asm volatile("v_mbcnt_lo_u32_b32 %0, -1, 0\n\tv_mbcnt_hi_u32_b32 %0, -1, %0" : "=v"(l)); return l; }
__device__ __forceinline__ float wave_sum(float v) {
#pragma unroll
    for (int o = 1; o < 64; o <<= 1) v += __shfl_xor(v, o);
    return v;
}
__device__ __forceinline__ float wave_max(float v) {
#pragma unroll
    for (int o = 1; o < 64; o <<= 1) v = fmaxf(v, __shfl_xor(v, o));
    return v;
}
__device__ __forceinline__ f32x2 gelu_pk(f32x2 v) {
    const f32x2 av = __builtin_elementwise_abs(v), d = av * 0.2316418882f + 1.0f;
    f32x2 t; t.x = __builtin_amdgcn_rcpf(d.x); t.y = __builtin_amdgcn_rcpf(d.y);
    f32x2 q = t * 0.5307027145f + (-0.7265760135f); q = q * t + 0.7107068705f; q = q * t + (-0.142248368f); q = q * t + 0.127414796f; q = q * t;
    const f32x2 s = (v * v) * (-0.72134752044f);
    f32x2 e; e.x = __builtin_amdgcn_exp2f(s.x); e.y = __builtin_amdgcn_exp2f(s.y);
    const f32x2 m = v * (q * e), r = v - m;
    f32x2 o; o.x = v.x < 0.f ? m.x : r.x; o.y = v.y < 0.f ? m.y : r.y; return o;
}
typedef float f32x2v __attribute__((ext_vector_type(2)));
template <bool HI> __device__ __forceinline__ unsigned f8x2_to_bf16x2(unsigned w) { const f32x2v f = __builtin_amdgcn_cvt_pk_f32_fp8((int)w, HI); return cvt_pk_bf16(f.x, f.y); }
__device__ __forceinline__ u32x4 f8x8_to_bf16x8(unsigned lo, unsigned hi) { return (u32x4){f8x2_to_bf16x2<false>(lo), f8x2_to_bf16x2<true>(lo), f8x2_to_bf16x2<false>(hi), f8x2_to_bf16x2<true>(hi)}; }
__device__ __forceinline__ unsigned pack_fp8x4(float a, float b, float c, float d) { unsigned w = 0u; w = __builtin_amdgcn_cvt_pk_fp8_f32(a, b, w, false); w = __builtin_amdgcn_cvt_pk_fp8_f32(c, d, w, true); return w; }
__device__ __forceinline__ float sigmoidf_(float x) { return __builtin_amdgcn_rcpf(1.0f + __builtin_amdgcn_exp2f(-1.4426950408889634f * x)); }

namespace pg8 {
constexpr int BM = 256, BK = 64, HALF = 128, HTB = HALF * BK * 2, STAGE_BYTES = 8 * HTB, NXCD = 8, WGM = 8;
__host__ __device__ __forceinline__ int lds_byte(int r, int c) { const int st = (r >> 4) * 2 + (c >> 5), rr = r & 15, cc = c & 31, ob = rr * 64 + cc * 2; return st * 1024 + (ob ^ (((ob >> 9) & 1) << 5)); }
__host__ __device__ __forceinline__ void stage_rc(int b, int& R, int& C) { const int st = b / 1024, sb = b % 1024, swz = sb ^ (((sb >> 9) & 1) << 5); R = (st >> 1) * 16 + swz / 64; C = (st & 1) * 32 + (swz % 64) / 2; }
__host__ __device__ __forceinline__ int perm32(int rho) { const int n = rho >> 4, i = rho & 15; return 8 * (i >> 2) + 4 * n + (i & 3); }

struct Unit { int pm, pn, bt, rbase; };
struct Gemm { const bf16_t* A; const bf16_t* Bt; int K, lda, ldb; const int* rowidx; };

struct StaticOrder {
    int nM, nN, nwg, G, c, pbase, psplit, pjump;
    __device__ void init(int M, int N, int G_, int c_, int pbase_ = 0, int psplit_ = 1 << 20, int pjump_ = 0) { nM = M / BM; nN = N / BM; nwg = nM * nN; G = G_; c = c_; pbase = pbase_; psplit = psplit_; pjump = pjump_; }
    __device__ bool next(int i, Unit& u) const {
        const long L = (long)i * G + c; if (L >= nwg) return false;
        int wgid = (int)L; { const int q = nwg / NXCD, r = nwg % NXCD, xcd = wgid % NXCD, off = wgid / NXCD; wgid = (xcd < r ? xcd * (q + 1) : r * (q + 1) + (xcd - r) * q) + off; }
        const int nig = WGM * nN, gid = wgid / nig, fm = gid * WGM, gsz = (nM - fm) < WGM ? (nM - fm) : WGM;
        u.pm = fm + ((wgid % nig) % gsz); const int p = (wgid % nig) / gsz; u.pn = pbase + (p < psplit ? p : p + pjump); u.bt = u.pn; u.rbase = u.pm * BM; return true;
    }
};
struct MoeOrder {
    int nM, nN, nwg, G, c; const LAS int* tab;
    __device__ void init(const LAS int* tiletab, int nN_, int G_, int c_) { nM = tiletab[0]; tab = tiletab; nN = nN_; nwg = nM * nN; G = G_; c = c_; }
    __device__ bool next(int i, Unit& u) const {
        const long L = (long)i * G + c; if (L >= nwg) return false;
        int wgid = (int)L; { const int q = nwg / NXCD, r = nwg % NXCD, xcd = wgid % NXCD, off = wgid / NXCD; wgid = (xcd < r ? xcd * (q + 1) : r * (q + 1) + (xcd - r) * q) + off; }
        const int nig = WGM * nN, gid = wgid / nig, fm = gid * WGM, gsz = (nM - fm) < WGM ? (nM - fm) : WGM;
        u.pm = fm + ((wgid % nig) % gsz); u.pn = (wgid % nig) / gsz; { const int e = tab[128 + 2 * u.pm], tl = tab[129 + 2 * u.pm]; u.bt = e * nN + u.pn; u.rbase = e * T + tl * BM; } return true;
    }
};

typedef int v4i_t __attribute__((ext_vector_type(4)));
typedef int v8i_t __attribute__((ext_vector_type(8)));
template <class Epi, class Sched, bool ALIGN_EPI, bool FP8 = false, bool GATHER = false>
__device__ __forceinline__ void gemm_phase(LAS unsigned char* lds, const Gemm g, const Sched& S, const Epi& E, const int wid) {
    const int lane = lane_id_asm(), tid = wid * 64 + lane;
    const int wr = wid >> 2, wc = wid & 3, fr = lane & 15, fq = lane >> 4;
    const int nt = g.K / BK;
    unsigned voffA[2], voffB[2]; int gR[2];
#pragma unroll
    for (int i = 0; i < 2; ++i) { int R, C; stage_rc(tid * 16 + i * 8192, R, C); const int Rb = Epi::PERM ? ((R & ~31) + perm32(R & 31)) : R;
        voffA[i] = GATHER ? (unsigned)C * 2u : (unsigned)(R * g.lda + C) * 2u; voffB[i] = (unsigned)(Rb * g.ldb + C) * 2u; gR[i] = R; }
    const size_t kstep = (size_t)(BK * 2);
    const size_t hstepA = GATHER ? 0 : (size_t)HALF * g.lda * 2, hstepB = (size_t)HALF * g.ldb * 2;
    const size_t tstepA = 2 * hstepA, tstepB = 2 * hstepB;
    const unsigned ldsw = (unsigned)wid * 1024u;
    const int aoff = lds_byte(wr * 64 + fr, fq * 8), boff = lds_byte(wc * 32 + fr, fq * 8);
#define PG8_SA(b, h) (((b) * 2 + (h)) * HTB)
#define PG8_SB(b, h) ((4 + (b) * 2 + (h)) * HTB)
#define PG8_STAGE(bufoff, gbase, voff) do { _Pragma("unroll") for (int _i = 0; _i < 2; ++_i) \
        __builtin_amdgcn_global_load_lds((const unsigned*)((const char*)(gbase) + (voff)[_i]), (LAS unsigned*)(lds + (bufoff) + ldsw + _i * 8192), 16, 0, 0); } while (0)
#define PG8_LD8(p) __builtin_shufflevector(*(const LAS v4i_t*)(p), *(const LAS v4i_t*)((p) + 1024), 0, 1, 2, 3, 4, 5, 6, 7)
#define PG8_LDA(dst, b, h) do { _Pragma("unroll") for (int m = 0; m < 4; ++m) { if constexpr (FP8) dst##8[m] = PG8_LD8(lds + PG8_SA(b, h) + aoff + m * 2048); \
        else { _Pragma("unroll") for (int k = 0; k < 2; ++k) dst[m][k] = *(const LAS bf16x8*)(lds + PG8_SA(b, h) + aoff + m * 2048 + k * 1024); } } } while (0)
#define PG8_LDB(dst, b, h) do { _Pragma("unroll") for (int n = 0; n < 2; ++n) { if constexpr (FP8) dst##8[n] = PG8_LD8(lds + PG8_SB(b, h) + boff + n * 2048); \
        else { _Pragma("unroll") for (int k = 0; k < 2; ++k) dst[n][k] = *(const LAS bf16x8*)(lds + PG8_SB(b, h) + boff + n * 2048 + k * 1024); } } } while (0)
#define PG8_MMA(ai, bj, At, Bt) do { __builtin_amdgcn_s_setprio(1); _Pragma("unroll") for (int m = 0; m < 4; ++m) _Pragma("unroll") for (int n = 0; n < 2; ++n) { \
        if constexpr (FP8) { asm volatile("s_nop 1\n\tv_mfma_scale_f32_16x16x128_f8f6f4 %0, %1, %2, %0, %3, %3 op_sel_hi:[0,0,0]" : "+v"(acc[ai][bj][m][n]) : "v"(Bt##8[n]), "v"(At##8[m]), "v"(scl8)); } \
        else { _Pragma("unroll") for (int k = 0; k < 2; ++k) acc[ai][bj][m][n] = __builtin_amdgcn_mfma_f32_16x16x32_bf16(Bt[n][k], At[m][k], acc[ai][bj][m][n], 0, 0, 0); } } \
        __builtin_amdgcn_s_setprio(0); } while (0)
#define PG8_WAIT_V(n) asm volatile("s_waitcnt vmcnt(" #n ")" ::: "memory")
#define PG8_WAIT_L(n) asm volatile("s_waitcnt lgkmcnt(" #n ")" ::: "memory")
#define PG8_BAR __builtin_amdgcn_s_barrier()
#define PG8_SCHED __builtin_amdgcn_sched_barrier(0)
    Unit cur, nxt; int ui = 0;
    if (!S.next(0, cur)) return;
    unsigned va0[2], va1[2], vn0[2], vn1[2];
#define PG8_GIDX(dst0, dst1, u) do { if constexpr (GATHER) { _Pragma("unroll") for (int _i = 0; _i < 2; ++_i) { \
        dst0[_i] = min((unsigned)g.rowidx[(u).rbase + gR[_i]], (unsigned)(T - 1)) * (unsigned)(g.lda * 2) + voffA[_i]; dst1[_i] = min((unsigned)g.rowidx[(u).rbase + HALF + gR[_i]], (unsigned)(T - 1)) * (unsigned)(g.lda * 2) + voffA[_i]; } } \
        else { _Pragma("unroll") for (int _i = 0; _i < 2; ++_i) { dst0[_i] = voffA[_i]; dst1[_i] = voffA[_i]; } } } while (0)
    PG8_GIDX(va0, va1, cur);
    f32x4 acc[2][2][4][2];
#pragma unroll
    for (int a = 0; a < 2; ++a)
#pragma unroll
        for (int b = 0; b < 2; ++b)
#pragma unroll
            for (int m = 0; m < 4; ++m)
#pragma unroll
                for (int n = 0; n < 2; ++n) acc[a][b][m][n] = (f32x4){0.f, 0.f, 0.f, 0.f};
    bf16x8 At[4][2], B0[2][2], B1[2][2]; v8i_t At8[4], B08[2], B18[2];
    int scl8 = 0x7f7f7f7f; asm volatile("" : "+v"(scl8));
    const char* cA = (const char*)g.A + (GATHER ? 0 : (size_t)cur.pm * tstepA); const char* cB = (const char*)g.Bt + (size_t)cur.bt * tstepB;
    PG8_STAGE(PG8_SB(0, 0), cB, voffB); PG8_STAGE(PG8_SB(0, 1), cB + hstepB, voffB); PG8_STAGE(PG8_SA(0, 0), cA, va0); PG8_STAGE(PG8_SA(0, 1), cA + hstepA, va1);
    if (wr == 1) PG8_BAR;
    PG8_WAIT_V(2); PG8_BAR;
    PG8_STAGE(PG8_SB(1, 0), cB + kstep, voffB); PG8_STAGE(PG8_SA(1, 0), cA + kstep, va0); PG8_STAGE(PG8_SB(1, 1), cB + hstepB + kstep, voffB);
    PG8_WAIT_V(6); PG8_BAR;
    for (;;) {
        const bool has_next = S.next(ui + 1, nxt);
        const char* nA = (has_next && !GATHER) ? (const char*)g.A + (size_t)nxt.pm * tstepA : cA; const char* nB = has_next ? (const char*)g.Bt + (size_t)nxt.bt * tstepB : cB;
        if (has_next) PG8_GIDX(vn0, vn1, nxt); else { _Pragma("unroll") for (int _i = 0; _i < 2; ++_i) { vn0[_i] = va0[_i]; vn1[_i] = va1[_i]; } }
#pragma unroll 1
        for (int t = 0; t < nt; t += 2) {
            const bool last = (t == nt - 2);
            const char* a1 = cA + (size_t)(t + 1) * kstep;
            const char* a2 = last ? nA : cA + (size_t)(t + 2) * kstep; const char* b2 = last ? nB : cB + (size_t)(t + 2) * kstep;
            const char* a3 = a2 + kstep; const char* b3 = b2 + kstep;
            if constexpr (Epi::MID_T > 0) { if (t == Epi::MID_T) E.mid(acc, cur, wr, wc, fr, fq); }
            unsigned vs0[2], vs1[2];
#pragma unroll
            for (int _i = 0; _i < 2; ++_i) { vs0[_i] = last ? vn0[_i] : va0[_i]; vs1[_i] = last ? vn1[_i] : va1[_i]; }
            PG8_LDB(B0, 0, 0); PG8_LDB(B1, 0, 1); PG8_SCHED; PG8_LDA(At, 0, 0); PG8_STAGE(PG8_SA(1, 1), a1 + hstepA, va1);
            PG8_WAIT_V(8); PG8_WAIT_L(0); PG8_BAR; PG8_MMA(0, 0, At, B0); PG8_MMA(0, 1, At, B1); PG8_BAR; PG8_SCHED;
            PG8_LDA(At, 0, 1); PG8_STAGE(PG8_SB(0, 0), b2, voffB); PG8_STAGE(PG8_SB(0, 1), b2 + hstepB, voffB); PG8_STAGE(PG8_SA(0, 0), a2, vs0);
            PG8_WAIT_V(8); PG8_WAIT_L(0); PG8_BAR; PG8_MMA(1, 0, At, B0); PG8_MMA(1, 1, At, B1); PG8_BAR; PG8_SCHED;
            PG8_LDB(B0, 1, 0); PG8_LDB(B1, 1, 1); PG8_SCHED; PG8_LDA(At, 1, 0); PG8_STAGE(PG8_SA(0, 1), a2 + hstepA, vs1);
            PG8_WAIT_V(8); PG8_WAIT_L(0); PG8_BAR; PG8_MMA(0, 0, At, B0); PG8_MMA(0, 1, At, B1); PG8_BAR; PG8_SCHED;
            PG8_LDA(At, 1, 1); PG8_STAGE(PG8_SB(1, 0), b3, voffB); PG8_STAGE(PG8_SB(1, 1), b3 + hstepB, voffB); PG8_STAGE(PG8_SA(1, 0), a3, vs0);
            PG8_WAIT_V(8); PG8_WAIT_L(0); PG8_BAR; PG8_MMA(1, 0, At, B0); PG8_MMA(1, 1, At, B1); PG8_BAR; PG8_SCHED;
        }
        if constexpr (ALIGN_EPI) { if (wr == 0) PG8_BAR; }
        if constexpr (FP8) {
#pragma unroll
            for (int a = 0; a < 2; ++a)
#pragma unroll
                for (int b = 0; b < 2; ++b)
                    asm volatile("s_nop 15\n\ts_nop 7" : "+v"(acc[a][b][0][0]), "+v"(acc[a][b][0][1]), "+v"(acc[a][b][1][0]), "+v"(acc[a][b][1][1]), "+v"(acc[a][b][2][0]), "+v"(acc[a][b][2][1]), "+v"(acc[a][b][3][0]), "+v"(acc[a][b][3][1]));
        }
        E(acc, cur, wr, wc, fr, fq);
        if (!has_next) break;
#pragma unroll
        for (int a = 0; a < 2; ++a)
#pragma unroll
            for (int b = 0; b < 2; ++b)
#pragma unroll
                for (int m = 0; m < 4; ++m)
#pragma unroll
                    for (int n = 0; n < 2; ++n) acc[a][b][m][n] = (f32x4){0.f, 0.f, 0.f, 0.f};
        cur = nxt; cA = nA; cB = nB; ++ui;
#pragma unroll
        for (int _i = 0; _i < 2; ++_i) { va0[_i] = vn0[_i]; va1[_i] = vn1[_i]; }
        if constexpr (ALIGN_EPI) { if (wr == 1) PG8_BAR; }
    }
    PG8_WAIT_V(0);
    if constexpr (!ALIGN_EPI) { if (wr == 0) PG8_BAR; }
    PG8_BAR;
#undef PG8_SA
#undef PG8_SB
#undef PG8_STAGE
#undef PG8_GIDX
#undef PG8_LDA
#undef PG8_LDB
#undef PG8_MMA
#undef PG8_LD8
#undef PG8_WAIT_V
#undef PG8_WAIT_L
#undef PG8_BAR
#undef PG8_SCHED
}

typedef f32x4 Acc[2][2][4][2];

__device__ __forceinline__ u32x4 pair16(u32x2 x, u32x2 y) {
    const auto r0 = __builtin_amdgcn_permlane16_swap(x.x, y.x, false, false);
    const auto r1 = __builtin_amdgcn_permlane16_swap(x.y, y.y, false, false);
    return (u32x4){r0[0], r1[0], r0[1], r1[1]};
}
struct Epi1 {
    static constexpr bool PERM = true; static constexpr int MID_T = 0;
    bf16_t *yab, *gv; unsigned char *q, *k, *v; bf16_t *sa, *sb; float* gvst; float* kmp; float sc, pad_;
    template <int MODE  >
    __device__ __forceinline__ void run(const Acc& acc, const Unit& u, int wr, int wc, int fr, int fq, bf16_t* base, int ld) const {
        const int row0 = u.pm * BM + wr * 64 + fr, col0 = (u.pn & 3) * 256 + wc * 32 + 8 * fq;
        const int colp = (u.pn & 3) * 256 + wc * 32 + 8 * (fq & ~1);
        f32x4 csA0 = {0.f, 0.f, 0.f, 0.f}, csB0 = csA0, csA1 = csA0, csB1 = csA0;
#pragma unroll
        for (int ai = 0; ai < 2; ++ai)
#pragma unroll
            for (int mp = 0; mp < 2; ++mp) {
                u32x2 pc[2][2];
#pragma unroll
                for (int k = 0; k < 2; ++k) {
                    const int m = 2 * mp + k;
                    const int row = row0 + ai * HALF + m * 16; bf16_t* rowp = base + (size_t)row * ld + col0;
                    float s1 = 0.f, s2 = 0.f;
#pragma unroll
                    for (int bj = 0; bj < 2; ++bj) {
                        f32x4 v0 = acc[ai][bj][m][0], v1 = acc[ai][bj][m][1];
                        if (MODE == 2 || MODE == 3 || MODE == 5) {
                            const float f = (MODE == 2) ? sc * QSCALE : sc; v0 = v0 * f; v1 = v1 * f;
                            if (MODE == 5) { if (bj == 0) { csA0 = csA0 + v0; csB0 = csB0 + v1; } else { csA1 = csA1 + v0; csB1 = csB1 + v1; } }
                            pc[bj][k] = (u32x2){pack_fp8x4(v0[0], v0[1], v0[2], v0[3]), pack_fp8x4(v1[0], v1[1], v1[2], v1[3])};
                            continue;
                        }
                        if (MODE == 0 || MODE == 1) {
                            f32x2 a = gelu_pk((f32x2){v0[0], v0[1]}), b = gelu_pk((f32x2){v0[2], v0[3]}), c = gelu_pk((f32x2){v1[0], v1[1]}), d = gelu_pk((f32x2){v1[2], v1[3]});
                            v0 = (f32x4){a.x, a.y, b.x, b.y}; v1 = (f32x4){c.x, c.y, d.x, d.y};
                        } else if (MODE == 4) {
                            { const float cs_ = -1.4426950408889634f * sc; const f32x4 t0 = v0 * cs_, t1 = v1 * cs_; f32x4 e0, e1;
#pragma unroll
                              for (int j = 0; j < 4; ++j) { e0[j] = __builtin_amdgcn_exp2f(t0[j]); e1[j] = __builtin_amdgcn_exp2f(t1[j]); }
                              e0 = e0 + 1.0f; e1 = e1 + 1.0f;
#pragma unroll
                              for (int j = 0; j < 4; ++j) { v0[j] = __builtin_amdgcn_rcpf(e0[j]); v1[j] = __builtin_amdgcn_rcpf(e1[j]); } }
                            pc[bj][k] = (u32x2){pack_fp8x4(v0[0], v0[1], v0[2], v0[3]), pack_fp8x4(v1[0], v1[1], v1[2], v1[3])};
                            continue;
                        }
                        if (MODE == 1) {
                            s1 += (v0[0] + v0[1]) + (v0[2] + v0[3]) + (v1[0] + v1[1]) + (v1[2] + v1[3]);
                            s2 += (v0[0] * v0[0] + v0[1] * v0[1]) + (v0[2] * v0[2] + v0[3] * v0[3]) + (v1[0] * v1[0] + v1[1] * v1[1]) + (v1[2] * v1[2] + v1[3] * v1[3]);
                            pc[bj][k] = (u32x2){pack_fp8x4(v0[0], v0[1], v0[2], v0[3]), pack_fp8x4(v1[0], v1[1], v1[2], v1[3])};
                            continue;
                        }
                        u32x4 w; w.x = cvt_pk_bf16(v0[0], v0[1]); w.y = cvt_pk_bf16(v0[2], v0[3]); w.z = cvt_pk_bf16(v1[0], v1[1]); w.w = cvt_pk_bf16(v1[2], v1[3]);
                        *(u32x4*)(rowp + bj * HALF) = w;
                    }
                    if (MODE == 1) {
                        s1 += __shfl_xor(s1, 16); s1 += __shfl_xor(s1, 32); s2 += __shfl_xor(s2, 16); s2 += __shfl_xor(s2, 32);
                        if (fq == 0) *(f32x2*)(gvst + ((size_t)row * 16 + (u.pn & 3) * 4 + wc) * 2) = (f32x2){s1, s2};
                    }
                }
                if (MODE != 0) {
                    const int rowst = row0 + ai * HALF + (2 * mp + (fq & 1)) * 16;
#pragma unroll
                    for (int bj = 0; bj < 2; ++bj) *(u32x4*)((unsigned char*)base + (size_t)rowst * 1024 + colp + bj * HALF) = pair16(pc[bj][0], pc[bj][1]);
                }
            }
        if (MODE == 5) {
#define KM_RED(v) do { _Pragma("unroll") for (int j_ = 0; j_ < 4; ++j_) { float x = v[j_]; x += __shfl_xor(x, 1); x += __shfl_xor(x, 2); x += __shfl_xor(x, 4); x += __shfl_xor(x, 8); v[j_] = x; } } while (0)
            KM_RED(csA0); KM_RED(csB0); KM_RED(csA1); KM_RED(csB1);
#undef KM_RED
            if (fr == 0) {
                float* kp = kmp + ((size_t)(u.pm * 2 + wr) * DM) + col0;
                *(f32x4*)kp = csA0; *(f32x4*)(kp + 4) = csB0; *(f32x4*)(kp + HALF) = csA1; *(f32x4*)(kp + HALF + 4) = csB1;
            }
        }
    }
    __device__ __forceinline__ void operator()(const Acc& acc, const Unit& u, int wr, int wc, int fr, int fq) const {
        const int region = u.pn >> 2;
        if (region == 0) run<0>(acc, u, wr, wc, fr, fq, yab, 2048);
        else if (region == 1) run<1>(acc, u, wr, wc, fr, fq, gv, 1024);
        else if (region == 2) run<2>(acc, u, wr, wc, fr, fq, (bf16_t*)q, 1024);
        else if (region == 3) run<5>(acc, u, wr, wc, fr, fq, (bf16_t*)k, 1024);
        else if (region == 4) run<3>(acc, u, wr, wc, fr, fq, (bf16_t*)v, 1024);
        else if (region == 5) run<4>(acc, u, wr, wc, fr, fq, sa, 1024);
        else run<4>(acc, u, wr, wc, fr, fq, sb, 1024);
    }
    __device__ __forceinline__ void mid(Acc&, const Unit&, int, int, int, int) const {}
};

struct Epi2 {
    static constexpr bool PERM = true; static constexpr int MID_T = 16;
    const unsigned char *sa, *sb; bf16_t* mg;
    __device__ __forceinline__ void mid(Acc& acc, const Unit& u, int wr, int wc, int fr, int fq) const {
        int row0 = u.pm * BM + wr * 64 + fr, col0 = u.pn * BM + wc * 32 + 8 * fq;
        asm volatile("" : "+v"(row0), "+v"(col0));
#pragma unroll
        for (int ai = 0; ai < 2; ++ai)
#pragma unroll
            for (int m = 0; m < 4; ++m) {
                const size_t off = (size_t)(row0 + ai * HALF + m * 16) * DM + col0;
#pragma unroll
                for (int bj = 0; bj < 2; ++bj) {
                    const u32x2 a = *(const u32x2*)(sa + off + bj * HALF), b = *(const u32x2*)(sb + off + bj * HALF);
                    const f32x2v a0 = __builtin_amdgcn_cvt_pk_f32_fp8((int)a.x, false), a1 = __builtin_amdgcn_cvt_pk_f32_fp8((int)a.x, true), a2 = __builtin_amdgcn_cvt_pk_f32_fp8((int)a.y, false), a3 = __builtin_amdgcn_cvt_pk_f32_fp8((int)a.y, true);
                    const f32x2v b0 = __builtin_amdgcn_cvt_pk_f32_fp8((int)b.x, false), b1 = __builtin_amdgcn_cvt_pk_f32_fp8((int)b.x, true), b2 = __builtin_amdgcn_cvt_pk_f32_fp8((int)b.y, false), b3 = __builtin_amdgcn_cvt_pk_f32_fp8((int)b.y, true);
                    f32x4 r0, r1;
#define RQ(x, y) ((x) * __builtin_amdgcn_rcpf(y))
                    r0[0] = RQ(a0.x, b0.x); r0[1] = RQ(a0.y, b0.y); r0[2] = RQ(a1.x, b1.x); r0[3] = RQ(a1.y, b1.y);
                    r1[0] = RQ(a2.x, b2.x); r1[1] = RQ(a2.y, b2.y); r1[2] = RQ(a3.x, b3.x); r1[3] = RQ(a3.y, b3.y);
#undef RQ
                    acc[ai][bj][m][0] = acc[ai][bj][m][0] * r0; acc[ai][bj][m][1] = acc[ai][bj][m][1] * r1;
                }
                asm volatile("" : "+v"(acc[ai][0][m][0]), "+v"(acc[ai][0][m][1]), "+v"(acc[ai][1][m][0]), "+v"(acc[ai][1][m][1]));
                asm volatile("" ::: "memory");
            }
    }
    __device__ __forceinline__ void operator()(const Acc& acc, const Unit& u, int wr, int wc, int fr, int fq) const {
        const int row0 = u.pm * BM + wr * 64 + fr, col0 = u.pn * BM + wc * 32 + 8 * fq;
#pragma unroll
        for (int ai = 0; ai < 2; ++ai)
#pragma unroll
            for (int m = 0; m < 4; ++m) {
                const size_t off = (size_t)(row0 + ai * HALF + m * 16) * DM + col0;
#pragma unroll
                for (int bj = 0; bj < 2; ++bj) {
                    const u32x2 b = *(const u32x2*)(sb + off + bj * HALF);
                    const f32x2v b0 = __builtin_amdgcn_cvt_pk_f32_fp8((int)b.x, false), b1 = __builtin_amdgcn_cvt_pk_f32_fp8((int)b.x, true), b2 = __builtin_amdgcn_cvt_pk_f32_fp8((int)b.y, false), b3 = __builtin_amdgcn_cvt_pk_f32_fp8((int)b.y, true);
                    const f32x4 v0 = acc[ai][bj][m][0], v1 = acc[ai][bj][m][1];
                    u32x4 w; w.x = cvt_pk_bf16(v0[0] * b0.x, v0[1] * b0.y); w.y = cvt_pk_bf16(v0[2] * b1.x, v0[3] * b1.y);
                    w.z = cvt_pk_bf16(v1[0] * b2.x, v1[1] * b2.y); w.w = cvt_pk_bf16(v1[2] * b3.x, v1[3] * b3.y);
                    *(u32x4*)(mg + off + bj * HALF) = w;
                }
            }
    }
};

struct Epi3 {
    static constexpr bool PERM = true; static constexpr int MID_T = 0;
    const bf16_t* h0; bf16_t* z; float* zst;
    __device__ __forceinline__ void mid(Acc&, const Unit&, int, int, int, int) const {}
    __device__ __forceinline__ void operator()(const Acc& acc, const Unit& u, int wr, int wc, int fr, int fq) const {
        const int row0 = u.pm * BM + wr * 64 + fr, col0 = u.pn * BM + wc * 32 + 8 * fq;
#pragma unroll
        for (int ai = 0; ai < 2; ++ai)
#pragma unroll
            for (int m = 0; m < 4; ++m) {
                const int row = row0 + ai * HALF + m * 16; const size_t off = (size_t)row * DM + col0;
                float s1 = 0.f, s2 = 0.f;
#pragma unroll
                for (int bj = 0; bj < 2; ++bj) {
                    const u32x4 hb = *(const u32x4*)(h0 + off + bj * HALF);
                    f32x4 v0 = acc[ai][bj][m][0], v1 = acc[ai][bj][m][1];
                    v0[0] += ALPHA * bflo(hb.x); v0[1] += ALPHA * bfhi(hb.x); v0[2] += ALPHA * bflo(hb.y); v0[3] += ALPHA * bfhi(hb.y);
                    v1[0] += ALPHA * bflo(hb.z); v1[1] += ALPHA * bfhi(hb.z); v1[2] += ALPHA * bflo(hb.w); v1[3] += ALPHA * bfhi(hb.w);
                    s1 += ((v0[0] + v0[1]) + (v0[2] + v0[3])) + ((v1[0] + v1[1]) + (v1[2] + v1[3]));
                    s2 += ((v0[0] * v0[0] + v0[1] * v0[1]) + (v0[2] * v0[2] + v0[3] * v0[3])) + ((v1[0] * v1[0] + v1[1] * v1[1]) + (v1[2] * v1[2] + v1[3] * v1[3]));
                    *(u32x4*)(z + off + bj * HALF) = (u32x4){cvt_pk_bf16(v0[0], v0[1]), cvt_pk_bf16(v0[2], v0[3]), cvt_pk_bf16(v1[0], v1[1]), cvt_pk_bf16(v1[2], v1[3])};
                }
                s1 += __shfl_xor(s1, 16); s1 += __shfl_xor(s1, 32); s2 += __shfl_xor(s2, 16); s2 += __shfl_xor(s2, 32);
                if (fq == 0) *(f32x2*)(zst + ((size_t)row * 16 + u.pn * 4 + wc) * 2) = (f32x2){s1, s2};
            }
    }
};

struct Epi4 {
    static constexpr bool PERM = true; static constexpr int MID_T = 0;
    const float* b_up; unsigned char* act;
    __device__ __forceinline__ void mid(Acc&, const Unit&, int, int, int, int) const {}
    __device__ __forceinline__ void operator()(const Acc& acc, const Unit& u, int wr, int wc, int fr, int fq) const {
        const int e = u.bt >> 3;
        const int row0 = u.pm * BM + wr * 64 + fr, c0 = u.pn * HALF + wc * 32 + 8 * fq;
        const float* bg = b_up + (size_t)e * 2 * FF + c0; const float* bu = bg + FF;
        const f32x4 bg0 = *(const f32x4*)bg, bg1 = *(const f32x4*)(bg + 4), bu0 = *(const f32x4*)bu, bu1 = *(const f32x4*)(bu + 4);
        const int cp = u.pn * HALF + wc * 32 + 8 * (fq & ~1);
#pragma unroll
        for (int ai = 0; ai < 2; ++ai)
#pragma unroll
            for (int mp = 0; mp < 2; ++mp) {
                u32x2 pc[2];
#pragma unroll
                for (int k = 0; k < 2; ++k) {
                    const int m = 2 * mp + k;
                    float o[8];
#pragma unroll
                    for (int n = 0; n < 2; ++n)
#pragma unroll
                        for (int jp = 0; jp < 2; ++jp) {
                            const int j = 2 * jp;
                            const f32x2 ag = {acc[ai][0][m][n][j], acc[ai][0][m][n][j + 1]}, au = {acc[ai][1][m][n][j], acc[ai][1][m][n][j + 1]};
                            const f32x2 vbg = n ? (f32x2){bg1[j], bg1[j + 1]} : (f32x2){bg0[j], bg0[j + 1]}, vbu = n ? (f32x2){bu1[j], bu1[j + 1]} : (f32x2){bu0[j], bu0[j + 1]};
                            f32x2 gg = ag * 0.03125f + vbg, uu = au * 0.03125f + vbu;
                            gg.x = fminf(gg.x, 7.0f); gg.y = fminf(gg.y, 7.0f);
                            uu.x = __builtin_amdgcn_fmed3f(uu.x, -7.0f, 7.0f); uu.y = __builtin_amdgcn_fmed3f(uu.y, -7.0f, 7.0f);
                            const f32x2 t = gg * (-1.702f * 1.4426950408889634f);
                            f32x2 ex; ex.x = __builtin_amdgcn_exp2f(t.x); ex.y = __builtin_amdgcn_exp2f(t.y);
                            const f32x2 d = ex + 1.0f;
                            f32x2 rc; rc.x = __builtin_amdgcn_rcpf(d.x); rc.y = __builtin_amdgcn_rcpf(d.y);
                            const f32x2 res = (uu + 1.0f) * (gg * rc);
                            o[n * 4 + j] = res.x; o[n * 4 + j + 1] = res.y;
                        }
                    unsigned w0 = 0u, w1 = 0u;
                    w0 = __builtin_amdgcn_cvt_pk_fp8_f32(o[0], o[1], w0, false); w0 = __builtin_amdgcn_cvt_pk_fp8_f32(o[2], o[3], w0, true);
                    w1 = __builtin_amdgcn_cvt_pk_fp8_f32(o[4], o[5], w1, false); w1 = __builtin_amdgcn_cvt_pk_fp8_f32(o[6], o[7], w1, true);
                    pc[k] = (u32x2){w0, w1};
                }
                const int rowst = row0 + ai * HALF + (2 * mp + (fq & 1)) * 16;
                *(u32x4*)(act + (size_t)rowst * FF + cp) = pair16(pc[0], pc[1]);
            }
    }
};

struct Epi5 {
    static constexpr bool PERM = true; static constexpr int MID_T = 0;
    const float* b_down; const float* roww; unsigned char* ys;
    __device__ __forceinline__ void mid(Acc&, const Unit&, int, int, int, int) const {}
    __device__ __forceinline__ void operator()(const Acc& acc, const Unit& u, int wr, int wc, int fr, int fq) const {
        const int e = u.bt >> 2;
        const int row0 = u.pm * BM + wr * 64 + fr, col0 = u.pn * BM + wc * 32 + 8 * fq;
        f32x4 bv[2][2];
#pragma unroll
        for (int bj = 0; bj < 2; ++bj)
#pragma unroll
            for (int n = 0; n < 2; ++n) bv[bj][n] = *(const f32x4*)(b_down + (size_t)e * DM + col0 + bj * HALF + 4 * n);
        float rwv[2][4];
#pragma unroll
        for (int ai = 0; ai < 2; ++ai)
#pragma unroll
            for (int m = 0; m < 4; ++m) rwv[ai][m] = roww[u.rbase + wr * 64 + fr + ai * HALF + m * 16];
        asm volatile("" ::: "memory");
        const int colp = u.pn * BM + wc * 32 + 8 * (fq & ~1);
#pragma unroll
        for (int ai = 0; ai < 2; ++ai)
#pragma unroll
            for (int mp = 0; mp < 2; ++mp) {
                const int rowst = row0 + ai * HALF + (2 * mp + (fq & 1)) * 16;
#pragma unroll
                for (int bj = 0; bj < 2; ++bj) {
                    u32x2 pc[2];
#pragma unroll
                    for (int k = 0; k < 2; ++k) { const int m = 2 * mp + k; const float rw16 = rwv[ai][m] * 16.0f;
                        const f32x4 v0 = (acc[ai][bj][m][0] * 0.015625f + bv[bj][0]) * rw16, v1 = (acc[ai][bj][m][1] * 0.015625f + bv[bj][1]) * rw16;
                        pc[k] = (u32x2){pack_fp8x4(v0[0], v0[1], v0[2], v0[3]), pack_fp8x4(v1[0], v1[1], v1[2], v1[3])}; }
                    *(u32x4*)(ys + (size_t)rowst * DM + colp + bj * HALF) = pair16(pc[0], pc[1]);
                }
            }
    }
};
}

struct Args { const float* in[21]; float* out; unsigned char* ws; int ph_lo, ph_hi; };
enum { I_X = 0, I_LNIN_G, I_LNIN_B, I_WIN, I_GLN_G, I_GLN_B, I_WSP, I_BSP, I_WBA, I_WBB, I_WOUT, I_LNMIX_G, I_LNMIX_B, I_WR, I_BR, I_WUP, I_BUP, I_WDN, I_BDN, I_LNF_G, I_LNF_B };

struct Ctx { const Args* a; unsigned char* ws; LAS unsigned char* lds; unsigned char* ldsg; int tid, lane, wave, G, vcu; };

__device__ __forceinline__ void tr_item(const float* W, int N, int k0, int n0, bf16_t* dst, int drow0, int dld, int dcol0, LAS float* scr, int lane) {
#pragma unroll 8
    for (int i = 0; i < 32; ++i) { const int kk = 2 * i + (lane >> 5); scr[kk * 33 + (lane & 31)] = __builtin_nontemporal_load(W + (size_t)(k0 + kk) * N + n0 + (lane & 31)); }
    asm volatile("s_waitcnt lgkmcnt(0)" ::: "memory");
    const int c = lane & 7;
#pragma unroll
    for (int j = 0; j < 4; ++j) { const int n = (lane >> 3) + 8 * j; const LAS float* s = scr + (8 * c) * 33 + n;
        u32x4 o; o.x = pk2(s[0 * 33], s[1 * 33]); o.y = pk2(s[2 * 33], s[3 * 33]); o.z = pk2(s[4 * 33], s[5 * 33]); o.w = pk2(s[6 * 33], s[7 * 33]);
        *(u32x4*)(dst + (size_t)(drow0 + n) * dld + dcol0 + k0 + 8 * c) = o; }
    asm volatile("s_waitcnt lgkmcnt(0)" ::: "memory");
}
template <bool DEEP = false>
__device__ __forceinline__ void tr_item8(const float* W, int N, int k0, int n0, unsigned char* dst, int drow0, int dld, float sc, LAS float* scr, int lane) {
    if constexpr (DEEP) {
        float v[32];
#pragma unroll
        for (int i = 0; i < 32; ++i) v[i] = __builtin_nontemporal_load(W + (size_t)(k0 + 2 * i + (lane >> 5)) * N + n0 + (lane & 31));
#pragma unroll
        for (int i = 0; i < 32; ++i) scr[(2 * i + (lane >> 5)) * 33 + (lane & 31)] = v[i];
    } else {
#pragma unroll 8
        for (int i = 0; i < 32; ++i) { const int kk = 2 * i + (lane >> 5); scr[kk * 33 + (lane & 31)] = __builtin_nontemporal_load(W + (size_t)(k0 + kk) * N + n0 + (lane & 31)); }
    }
    asm volatile("s_waitcnt lgkmcnt(0)" ::: "memory");
    const int c = lane & 7;
#pragma unroll
    for (int j = 0; j < 4; ++j) { const int n = (lane >> 3) + 8 * j; const LAS float* s = scr + (8 * c) * 33 + n;
        unsigned w0 = 0u, w1 = 0u;
        w0 = __builtin_amdgcn_cvt_pk_fp8_f32(s[0 * 33] * sc, s[1 * 33] * sc, w0, false); w0 = __builtin_amdgcn_cvt_pk_fp8_f32(s[2 * 33] * sc, s[3 * 33] * sc, w0, true);
        w1 = __builtin_amdgcn_cvt_pk_fp8_f32(s[4 * 33] * sc, s[5 * 33] * sc, w1, false); w1 = __builtin_amdgcn_cvt_pk_fp8_f32(s[6 * 33] * sc, s[7 * 33] * sc, w1, true);
        *(u32x2*)(dst + (size_t)(drow0 + n) * dld + k0 + 8 * c) = (u32x2){w0, w1}; }
    asm volatile("s_waitcnt lgkmcnt(0)" ::: "memory");
}
__device__ __forceinline__ void ph_prologue(const Ctx& F) {
    const Args& A = *F.a;
    LAS float* scr = (LAS float*)(F.lds + F.wave * 16384);
    const int gw = F.vcu * 8 + F.wave, NGW = F.G * 8;
    bf16_t* WIN = (bf16_t*)(F.ws + WS_WIN); bf16_t* WAB = (bf16_t*)(F.ws + WS_WAB); bf16_t* WOUT = (bf16_t*)(F.ws + WS_WOUT);
    constexpr int I_IN = 16 * (INCOLS / 32), I_SQ = 16 * 32;
    constexpr int NITEMS = I_IN + 3 * I_SQ;
    for (int it = gw; it < NITEMS; it += NGW) {
        int r = it;
        if (r < I_IN) { const int nblk = INCOLS / 32, kb = r / nblk, nb = r % nblk;
            if (32 * nb >= PN8_LO * 256 && 32 * nb < PN8_HI * 256) tr_item8(A.in[I_WIN], INCOLS, 64 * kb, 32 * nb, F.ws + WS_WIN8, 32 * nb, DM, 32.0f, scr, F.lane);
            else tr_item(A.in[I_WIN], INCOLS, 64 * kb, 32 * nb, WIN, 32 * nb, DM, 0, scr, F.lane);
            continue; } r -= I_IN;
        if (r < I_SQ) { const int kb = r / 32, nb = r % 32; tr_item(A.in[I_WBA], DM, 64 * kb, 32 * nb, WAB, 32 * nb, 2048, 0, scr, F.lane); continue; } r -= I_SQ;
        if (r < I_SQ) { const int kb = r / 32, nb = r % 32; tr_item(A.in[I_WBB], DM, 64 * kb, 32 * nb, WAB, 32 * nb, 2048, 1024, scr, F.lane); continue; } r -= I_SQ;
        { const int kb = r / 32, nb = r % 32; tr_item(A.in[I_WOUT], DM, 64 * kb, 32 * nb, WOUT, 32 * nb, DM, 0, scr, F.lane); }
    }
    const float* lg = A.in[I_LNIN_G]; const float* lb = A.in[I_LNIN_B]; bf16_t* H0 = (bf16_t*)(F.ws + WS_H0);
    f32x4 gg[4], bb[4];
#pragma unroll
    for (int j = 0; j < 4; ++j) { gg[j] = *((const f32x4*)lg + F.lane + 64 * j); bb[j] = *((const f32x4*)lb + F.lane + 64 * j); }
    for (int m = gw; m < T; m += NGW) {
        const f32x4* xr = (const f32x4*)(A.in[I_X] + (size_t)m * DM) + F.lane;
        f32x4 v[4]; float s = 0.f;
#pragma unroll
        for (int j = 0; j < 4; ++j) { v[j] = __builtin_nontemporal_load(xr + 64 * j); s += (v[j].x + v[j].y) + (v[j].z + v[j].w); }
        const float mean = wave_sum(s) * (1.f / DM); float s2 = 0.f;
#pragma unroll
        for (int j = 0; j < 4; ++j) { v[j] = v[j] - mean; s2 += (v[j].x * v[j].x + v[j].y * v[j].y) + (v[j].z * v[j].z + v[j].w * v[j].w); }
        const float rstd = 1.f / sqrtf(wave_sum(s2) * (1.f / DM) + LN_EPS);
        u32x2* o8 = (u32x2*)(H0 + (size_t)m * DM) + F.lane; unsigned* o4 = (unsigned*)(F.ws + WS_H0F8 + (size_t)m * DM) + F.lane;
#pragma unroll
        for (int j = 0; j < 4; ++j) { const f32x4 y = v[j] * rstd * gg[j] + bb[j]; o8[64 * j] = (u32x2){pk2(y.x, y.y), pk2(y.z, y.w)}; o4[64 * j] = pack_fp8x4(y.x, y.y, y.z, y.w); }
    }
}

struct WItem { const float* src; unsigned char* dst; int N, dld; float sc; };
__device__ __forceinline__ void w_load(const WItem& w, float (&v)[64], int lane) {
    const float* src = w.src + (size_t)(lane >> 5) * w.N + (lane & 31);
#pragma unroll
    for (int i = 0; i < 64; ++i) v[i] = __builtin_nontemporal_load(src + (size_t)(2 * i) * w.N);
}
__device__ __forceinline__ void w_scatter(const float (&v)[64], LAS float* scr, int lane) {
    LAS float* d = scr + (lane & 31) * 130 + (lane >> 5);
#pragma unroll
    for (int i = 0; i < 64; ++i) d[2 * i] = v[i];
}
__device__ __forceinline__ void w_emit(const WItem& w, LAS const float* scr, int lane) {
    asm volatile("s_waitcnt lgkmcnt(0)" ::: "memory");
    const int c = lane & 7; const float sc = w.sc;
#pragma unroll
    for (int j = 0; j < 4; ++j) {
        const int nn = (lane >> 3) + 8 * j; const LAS float* sp = scr + nn * 130 + 16 * c;
        f32x2 a[8];
#pragma unroll
        for (int q = 0; q < 8; ++q) a[q] = *(LAS const f32x2*)(sp + 2 * q);
        u32x4 o;
        o.x = pack_fp8x4(a[0].x * sc, a[0].y * sc, a[1].x * sc, a[1].y * sc); o.y = pack_fp8x4(a[2].x * sc, a[2].y * sc, a[3].x * sc, a[3].y * sc);
        o.z = pack_fp8x4(a[4].x * sc, a[4].y * sc, a[5].x * sc, a[5].y * sc); o.w = pack_fp8x4(a[6].x * sc, a[6].y * sc, a[7].x * sc, a[7].y * sc);
        *(u32x4*)(w.dst + (size_t)nn * w.dld + 16 * c) = o;
    }
    asm volatile("s_waitcnt lgkmcnt(0)" ::: "memory");
}
__device__ __forceinline__ WItem w_decode(const Ctx& F, int r) {
    const Args& A = *F.a;
    constexpr int I_UP = NE * 8 * 64;
    WItem w;
    if (r < I_UP) { const int e = r / (8 * 64), rr = r % (8 * 64), kb = rr / 64, nb = rr % 64; const int n0 = 32 * nb, half = n0 >= FF, rem = n0 - half * FF, pn = rem >> 7, b = (rem & 127) >> 5;
        w.src = A.in[I_WUP] + (size_t)e * DM * 2 * FF + (size_t)(128 * kb) * (2 * FF) + n0; w.N = 2 * FF; w.dst = F.ws + WS_WUP + (size_t)(e * 2048 + 256 * pn + half * 128 + 32 * b) * DM + 128 * kb; w.dld = DM; w.sc = 32.0f; }
    else { r -= I_UP; const int e = r / (8 * 32), rr = r % (8 * 32), kb = rr / 32, nb = rr % 32;
        w.src = A.in[I_WDN] + (size_t)e * FF * DM + (size_t)(128 * kb) * DM + 32 * nb; w.N = DM; w.dst = F.ws + WS_WDN + (size_t)(e * 1024 + 32 * nb) * FF + 128 * kb; w.dld = FF; w.sc = 64.0f; }
    return w;
}
__device__ __forceinline__ void ph_wconv(const Ctx& F) {
    LAS float* scr = (LAS float*)(F.lds + F.wave * 16640);
    constexpr int NIT = NE * 8 * 64 + NE * 8 * 32;
    const int chunk = (NIT + F.G - 1) / F.G, lo = (int)blockIdx.x * chunk, hi = (lo + chunk < NIT) ? lo + chunk : NIT;
    __syncthreads();
    int it = lo + F.wave;
    if (it < hi) {
        float v[64];
        WItem cur = w_decode(F, it);
        w_load(cur, v, F.lane);
        for (;;) {
            w_scatter(v, scr, F.lane);
            const int itn = it + 8; const bool more = itn < hi;
            WItem nxt = cur;
            if (more) { nxt = w_decode(F, itn); w_load(nxt, v, F.lane); }
            w_emit(cur, scr, F.lane);
            if (!more) break;
            cur = nxt; it = itn;
        }
    }
    asm volatile("s_waitcnt vmcnt(0)" ::: "memory");
    __syncthreads();
}

typedef short v4i16_t __attribute__((ext_vector_type(4)));
__device__ __forceinline__ v4i16_t lds_tr16(LAS const unsigned char* p) { return __builtin_amdgcn_ds_read_tr16_b64_v4i16((LAS v4i16_t*)p); }
__device__ __forceinline__ void ph_mixer_a(const Ctx& F) {
    const Args& A = *F.a;
    const unsigned char* GV = F.ws + WS_GV; bf16_t* YAB = (bf16_t*)(F.ws + WS_YAB); const float* GVST = (const float*)(F.ws + WS_GVST);
    const float* lg = A.in[I_GLN_G]; const float* lb = A.in[I_GLN_B]; const float* wsp = A.in[I_WSP]; const float* bsp = A.in[I_BSP];
    constexpr int RSV = 544, RSW = 272, OFF_W = 128 * RSV, OFF_ST = OFF_W + 128 * RSW;
    LAS unsigned char* VT = F.lds; LAS unsigned char* WT = F.lds + OFF_W; LAS float* ST = (LAS float*)(F.lds + OFF_ST);
    const int lane = F.lane, wv = F.wave;
    int curg = -1;
    for (int it = F.vcu; it < NB * 32 * 4; it += F.G) {
        const int b = it / 128, c = (it >> 2) & 31, g = it & 3;
        const int tok0 = b * SEQ + c * 128;
        if (g != curg) {
            curg = g;
            for (int k = 0; k < 4; ++k) {
                const int idx = F.tid + 512 * k, t = idx >> 4, s8 = (idx & 15) * 8;
                const f32x4 w0 = *(const f32x4*)(wsp + ((size_t)g * 128 + t) * 128 + s8), w1 = *(const f32x4*)(wsp + ((size_t)g * 128 + t) * 128 + s8 + 4);
                float x[8] = {w0.x, w0.y, w0.z, w0.w, w1.x, w1.y, w1.z, w1.w};
#pragma unroll
                for (int j = 0; j < 8; ++j) x[j] = (s8 + j <= t) ? x[j] : 0.f;
                u32x4 o; o.x = pk2(x[0], x[1]); o.y = pk2(x[2], x[3]); o.z = pk2(x[4], x[5]); o.w = pk2(x[6], x[7]);
                *(LAS u32x4*)(WT + t * RSW + s8 * 2) = o;
            }
        }
        if (F.tid < 128) {
            const float* p = GVST + (size_t)(tok0 + F.tid) * 32; float s1 = 0.f, s2 = 0.f;
            for (int i = 0; i < 16; ++i) { s1 += p[2 * i]; s2 += p[2 * i + 1]; }
            const float mean = s1 * (1.f / DM), var = s2 * (1.f / DM) - mean * mean;
            ST[2 * F.tid] = mean; ST[2 * F.tid + 1] = 1.f / sqrtf(fmaxf(var, 0.f) + LN_EPS);
        }
        __syncthreads();
        {
            const int dc = F.tid & 31;
            const f32x4 g0 = *(const f32x4*)(lg + g * 256 + dc * 8), g1 = *(const f32x4*)(lg + g * 256 + dc * 8 + 4), b0 = *(const f32x4*)(lb + g * 256 + dc * 8), b1 = *(const f32x4*)(lb + g * 256 + dc * 8 + 4);
#pragma unroll
            for (int k = 0; k < 8; ++k) {
                const int s = (F.tid >> 5) + 16 * k;
                const u32x2 raw = *(const u32x2*)(GV + (size_t)(tok0 + s) * DM + g * 256 + dc * 8);
                const float mean = ST[2 * s], rstd = ST[2 * s + 1];
                const f32x2v f0 = __builtin_amdgcn_cvt_pk_f32_fp8((int)raw.x, false), f1 = __builtin_amdgcn_cvt_pk_f32_fp8((int)raw.x, true), f2 = __builtin_amdgcn_cvt_pk_f32_fp8((int)raw.y, false), f3 = __builtin_amdgcn_cvt_pk_f32_fp8((int)raw.y, true);
                f32x4 x0 = {f0.x, f0.y, f1.x, f1.y}, x1 = {f2.x, f2.y, f3.x, f3.y};
                x0 = (x0 - mean) * rstd * g0 + b0; x1 = (x1 - mean) * rstd * g1 + b1;
                u32x4 o; o.x = pk2(x0.x, x0.y); o.y = pk2(x0.z, x0.w); o.z = pk2(x1.x, x1.y); o.w = pk2(x1.z, x1.w);
                *(LAS u32x4*)(VT + s * RSV + dc * 16) = o;
            }
        }
        __syncthreads();
        {
            const int dbase = 32 * wv, kg = lane >> 4, q = (lane & 15) >> 2, p = lane & 3, fr = lane & 15;
            bf16x8 Af[2][4];
#pragma unroll
            for (int m = 0; m < 2; ++m)
#pragma unroll
                for (int kk = 0; kk < 4; ++kk) {
                    LAS const unsigned char* ap = VT + (32 * kk + 8 * kg + q) * RSV + (dbase + 16 * m + 4 * p) * 2;
                    const v4i16_t lo = lds_tr16(ap), hi = lds_tr16(ap + 4 * RSV);
                    Af[m][kk] = (bf16x8){lo[0], lo[1], lo[2], lo[3], hi[0], hi[1], hi[2], hi[3]};
                }
#pragma unroll
            for (int n = 0; n < 8; ++n) {
                f32x4 acc0 = {0.f, 0.f, 0.f, 0.f}, acc1 = {0.f, 0.f, 0.f, 0.f};
#pragma unroll
                for (int kk = 0; kk < 4; ++kk) if (kk <= (n >> 1)) {
                    const bf16x8 Bf = *(LAS const bf16x8*)(WT + (16 * n + fr) * RSW + (32 * kk + 8 * kg) * 2);
                    acc0 = __builtin_amdgcn_mfma_f32_16x16x32_bf16(Af[0][kk], Bf, acc0, 0, 0, 0);
                    acc1 = __builtin_amdgcn_mfma_f32_16x16x32_bf16(Af[1][kk], Bf, acc1, 0, 0, 0);
                }
                const int t = 16 * n + fr; const float bsv = bsp[g * 128 + t];
                bf16_t* yp = YAB + (size_t)(tok0 + t) * 2048 + g * 256 + dbase + 4 * kg;
                const u32x2 u0 = *(const u32x2*)yp, u1 = *(const u32x2*)(yp + 16);
                u32x2 o0, o1;
                o0.x = pk2(bflo(u0.x) * (acc0[0] + bsv), bfhi(u0.x) * (acc0[1] + bsv)); o0.y = pk2(bflo(u0.y) * (acc0[2] + bsv), bfhi(u0.y) * (acc0[3] + bsv));
                o1.x = pk2(bflo(u1.x) * (acc1[0] + bsv), bfhi(u1.x) * (acc1[1] + bsv)); o1.y = pk2(bflo(u1.y) * (acc1[2] + bsv), bfhi(u1.y) * (acc1[3] + bsv));
                *(u32x2*)yp = o0; *(u32x2*)(yp + 16) = o1;
            }
        }
        __syncthreads();
    }
}

__device__ __forceinline__ void ph_gate(const Ctx& F) {
    const unsigned char* Q = F.ws + WS_Q; const float* KM = (const float*)(F.ws + WS_KMEAN);
    unsigned* SEL = (unsigned*)(F.ws + WS_SEL); unsigned* LISTS = (unsigned*)(F.ws + WS_LISTS); unsigned* LCNT = (unsigned*)(F.ws + WS_CTL) + CW_LCNT;
    constexpr int KMR = 272;
    LAS unsigned char* kmh = F.lds; LAS unsigned char* kml = F.lds + 16 * KMR;
    unsigned* lc = (unsigned*)(F.ldsg + 2 * 16 * KMR);
    LAS float* scw = (LAS float*)(F.lds + 16384) + F.wave * 1024;
    const int fr = F.lane & 15, fq = F.lane >> 4;
    for (int it = F.vcu; it < NB * NH * 8; it += F.G) {
        const int b = it / 64, h = (it >> 3) & 7, tc = it & 7;
        {
            const int j = F.tid >> 5, d4 = (F.tid & 31) * 4;
            const float* kp = KM + (size_t)((b * NBLK + j) * 2) * DM + h * DH + d4;
            const f32x4 s0 = *(const f32x4*)kp, s1 = *(const f32x4*)(kp + DM);
            const f32x4 mv = (s0 + s1) * (1.0f / LBLK);
            unsigned hb[4]; float lo[4];
#pragma unroll
            for (int e = 0; e < 4; ++e) { hb[e] = f2bf(mv[e]); lo[e] = mv[e] - __uint_as_float(hb[e] << 16); }
            *(LAS u32x2*)(kmh + j * KMR + d4 * 2) = (u32x2){hb[0] | (hb[1] << 16), hb[2] | (hb[3] << 16)};
            *(LAS u32x2*)(kml + j * KMR + d4 * 2) = (u32x2){pk2(lo[0], lo[1]), pk2(lo[2], lo[3])};
        }
        if (F.tid < 32) lc[F.tid] = 0u;
        const int tw = tc * 512 + F.wave * 64;
        u32x4 qraw[4][2];
#pragma unroll
        for (int tg = 0; tg < 4; ++tg) { const unsigned char* qp = Q + (size_t)(b * SEQ + tw + 16 * tg + fr) * DM + h * DH + 32 * fq; qraw[tg][0] = *(const u32x4*)qp; qraw[tg][1] = *(const u32x4*)(qp + 16); }
        __syncthreads();
        bf16x8 Ah[4], Al[4];
#pragma unroll
        for (int ks = 0; ks < 4; ++ks) { Ah[ks] = *(LAS const bf16x8*)(kmh + fr * KMR + (32 * fq + 8 * ks) * 2); Al[ks] = *(LAS const bf16x8*)(kml + fr * KMR + (32 * fq + 8 * ks) * 2); }
#pragma unroll
        for (int tg = 0; tg < 4; ++tg) {
            f32x4 acc = {0.f, 0.f, 0.f, 0.f};
#pragma unroll
            for (int ks = 0; ks < 4; ++ks) {
                const u32x4 w = qraw[tg][ks >> 1]; const unsigned w0 = (ks & 1) ? w.z : w.x, w1 = (ks & 1) ? w.w : w.y;
                const bf16x8 Bq = __builtin_bit_cast(bf16x8, f8x8_to_bf16x8(w0, w1));
                acc = __builtin_amdgcn_mfma_f32_16x16x32_bf16(Ah[ks], Bq, acc, 0, 0, 0);
                acc = __builtin_amdgcn_mfma_f32_16x16x32_bf16(Al[ks], Bq, acc, 0, 0, 0);
            }
            *(LAS f32x4*)(scw + (16 * tg + fr) * 16 + 4 * fq) = acc;
        }
        asm volatile("s_waitcnt lgkmcnt(0)" ::: "memory");
        const int t = tc * 512 + F.tid, qi = t >> 8;
        float gsc[15];
        { const f32x4 c0 = *(LAS const f32x4*)(scw + F.lane * 16), c1 = *(LAS const f32x4*)(scw + F.lane * 16 + 4), c2 = *(LAS const f32x4*)(scw + F.lane * 16 + 8), c3 = *(LAS const f32x4*)(scw + F.lane * 16 + 12);
          gsc[0] = c0.x; gsc[1] = c0.y; gsc[2] = c0.z; gsc[3] = c0.w; gsc[4] = c1.x; gsc[5] = c1.y; gsc[6] = c1.z; gsc[7] = c1.w;
          gsc[8] = c2.x; gsc[9] = c2.y; gsc[10] = c2.z; gsc[11] = c2.w; gsc[12] = c3.x; gsc[13] = c3.y; gsc[14] = c3.z; }
        const int nsel = qi < 3 ? qi : 3;
        int sel[3] = {0, 0, 0}; unsigned lpos[3] = {0, 0, 0};
#pragma unroll
        for (int r = 0; r < 3; ++r) {
            float best = -INFINITY; int bi = -1;
#pragma unroll
            for (int j = 0; j < 15; ++j) { const bool c = (j < qi) && (gsc[j] > best); best = c ? gsc[j] : best; bi = c ? j : bi; }
#pragma unroll
            for (int j = 0; j < 15; ++j) if (j == bi) gsc[j] = -INFINITY;
            sel[r] = bi < 0 ? 0 : bi;
            if (r < nsel) lpos[r] = atomicAdd(&lc[sel[r]], 1u);
        }
        SEL[(size_t)(b * SEQ + t) * NH + h] = (unsigned)sel[0] | ((unsigned)sel[1] << 8) | ((unsigned)sel[2] << 16) | ((unsigned)nsel << 24);
        __syncthreads();
        if (F.tid < 16) lc[16 + F.tid] = lc[F.tid] ? atomicAdd(&LCNT[(b * NH + h) * NBLK + F.tid], lc[F.tid]) : 0u;
        __syncthreads();
#pragma unroll
        for (int r = 0; r < 3; ++r) if (r < nsel) LISTS[(size_t)((b * NH + h) * NBLK + sel[r]) * 4096 + lc[16 + sel[r]] + lpos[r]] = (unsigned)t | ((unsigned)r << 12);
        __syncthreads();
    }
}


typedef float f32x16 __attribute__((ext_vector_type(16)));
namespace att {
__device__ __forceinline__ int crow(int r, int hi) { return (r & 3) + 8 * (r >> 2) + 4 * hi; }
#define TRR(dst, vaddr, off) asm volatile("ds_read_b64_tr_b16 %0, %1 offset:%c2" : "=v"(dst) : "v"(vaddr), "i"(off) : "memory")
#define TRWAIT() do { asm volatile("s_waitcnt lgkmcnt(0)" ::: "memory"); __builtin_amdgcn_sched_barrier(0); } while (0)

}

namespace att2 {
constexpr int KCH2 = 1040, VDB2 = 4160, KSL = 8 * KCH2, VSL = 4 * VDB2;
constexpr int OFF_K = 0, OFF_V = 2 * KSL, OFF_STG = OFF_V + 2 * VSL  , OFF_WS = OFF_STG + 8 * 8192  , WSW = 1024, OFF_TAB = OFF_WS + 8 * WSW  ;
static_assert(OFF_TAB + 1028 * 4 <= LDS_BYTES - 64, "attention (partial) LDS map");
using att::crow;

__device__ __forceinline__ void tile_load(const Ctx& F, const unsigned char* K, const unsigned char* V, size_t tokbase, int h, int kt, u32x4& rk, u32x4& rv) {
    const size_t off = (tokbase + 64 * kt + (F.tid >> 3)) * DM + h * DH + (F.tid & 7) * 16;
    rk = *(const u32x4*)(K + off); rv = *(const u32x4*)(V + off);
}
__device__ __forceinline__ void tile_write(const Ctx& F, int slot, const u32x4& rk, const u32x4& rv) {
    const int key = F.tid >> 3, c = 2 * (F.tid & 7);
    *(LAS u32x4*)(F.lds + OFF_K + slot * KSL + (F.tid & 7) * KCH2 + key * 16) = rk;
    LAS unsigned char* vd = F.lds + OFF_V + slot * VSL + (c >> 2) * VDB2 + (key >> 3) * 512 + (key & 7) * 64 + (c & 3) * 16;
    *(LAS u32x4*)vd = f8x8_to_bf16x8(rv.x, rv.y); *(LAS u32x4*)(vd + 16) = f8x8_to_bf16x8(rv.z, rv.w);
}
template <bool CAUSAL = false>
__device__ __forceinline__ void tile_compute(const Ctx& F, int slot, const pg8::v8i_t (&qf)[2], f32x16 (&o)[4], float& m, float& l, bool first, bool diag = false) {
    const int r = F.lane & 31, hh = F.lane >> 5;
    LAS float* wsf = (LAS float*)(F.lds + OFF_WS + F.wave * WSW);
    LAS const unsigned char* kp = F.lds + OFF_K + slot * KSL + 2 * hh * KCH2 + r * 16;
    LAS const unsigned char* vp = F.lds + OFF_V + slot * VSL + (4 * hh + ((F.lane & 15) >> 2)) * 64 + ((F.lane >> 4) & 1) * 32 + (F.lane & 3) * 8;
    f32x16 p0, p1;
#pragma unroll
    for (int i = 0; i < 16; ++i) { p0[i] = 0.f; p1[i] = 0.f; }
    {
        pg8::v8i_t ka[2][2];
#pragma unroll
        for (int kb = 0; kb < 2; ++kb)
#pragma unroll
            for (int j2 = 0; j2 < 2; ++j2) ka[kb][j2] = __builtin_shufflevector(*(LAS const pg8::v4i_t*)(kp + 4 * j2 * KCH2 + kb * 512), *(LAS const pg8::v4i_t*)(kp + (4 * j2 + 1) * KCH2 + kb * 512), 0, 1, 2, 3, 4, 5, 6, 7);
        __builtin_amdgcn_sched_barrier(0);
#pragma unroll
        for (int j2 = 0; j2 < 2; ++j2) p0 = __builtin_amdgcn_mfma_scale_f32_32x32x64_f8f6f4(ka[0][j2], qf[j2], p0, 0, 0, 0, 0x7f7f7f7f, 0, 0x7f7f7f7f);
#pragma unroll
        for (int j2 = 0; j2 < 2; ++j2) p1 = __builtin_amdgcn_mfma_scale_f32_32x32x64_f8f6f4(ka[1][j2], qf[j2], p1, 0, 0, 0, 0x7f7f7f7f, 0, 0x7f7f7f7f);
        __builtin_amdgcn_sched_barrier(0);
    }
    v4i16_t vl[2][4], vh[2][4];
    const unsigned vaddr = (unsigned)(uintptr_t)vp;
#pragma unroll
    for (int ks = 0; ks < 2; ++ks)
#pragma unroll
        for (int db = 0; db < 4; ++db) { TRR(vl[ks][db], vaddr, db * VDB2 + ks * 1024); TRR(vh[ks][db], vaddr, db * VDB2 + ks * 1024 + 512); }
    __builtin_amdgcn_sched_barrier(0);
    if (CAUSAL && diag) {
        if (F.wave & 1) {
#pragma unroll
            for (int i = 0; i < 16; ++i) p1[i] = (crow(i, hh) > r) ? -INFINITY : p1[i];
        } else {
#pragma unroll
            for (int i = 0; i < 16; ++i) { p0[i] = (crow(i, hh) > r) ? -INFINITY : p0[i]; p1[i] = -INFINITY; }
        }
    }
    const float dm = first ? 0.f : m;
    { const f32x2 dm2 = {dm, dm};
#pragma unroll
      for (int j = 0; j < 8; ++j) { f32x2 a = {p0[2 * j], p0[2 * j + 1]}, b = {p1[2 * j], p1[2 * j + 1]}; a = a - dm2; b = b - dm2; p0[2 * j] = a.x; p0[2 * j + 1] = a.y; p1[2 * j] = b.x; p1[2 * j + 1] = b.y; } }
    float mx = fmaxf(p0[0], p1[0]);
#pragma unroll
    for (int i = 1; i < 16; ++i) mx = fmaxf(mx, fmaxf(p0[i], p1[i]));
    mx = fmaxf(mx, __shfl_xor(mx, 32));
    if (first || __any(mx > 8.0f)) {
        const float delta = first ? mx : fmaxf(mx, 0.f);
        const float alpha = first ? 0.f : __builtin_amdgcn_exp2f(-delta);
        l *= alpha; m = dm + delta;
        { const f32x2 d2 = {delta, delta};
#pragma unroll
          for (int j = 0; j < 8; ++j) { f32x2 a = {p0[2 * j], p0[2 * j + 1]}, b = {p1[2 * j], p1[2 * j + 1]}; a = a - d2; b = b - d2; p0[2 * j] = a.x; p0[2 * j + 1] = a.y; p1[2 * j] = b.x; p1[2 * j + 1] = b.y; } }
        if (!first) {
            if (hh == 0) wsf[r] = alpha;
            asm volatile("s_waitcnt lgkmcnt(0)" ::: "memory");
#pragma unroll
            for (int i = 0; i < 16; ++i) { const float a = wsf[crow(i, hh)];
#pragma unroll
                for (int db = 0; db < 4; ++db) o[db][i] *= a; }
        }
    }
    { f32x2 sa = {0.f, 0.f}, sb = {0.f, 0.f};
#pragma unroll
      for (int j = 0; j < 8; ++j) {
          p0[2 * j] = __builtin_amdgcn_exp2f(p0[2 * j]); p0[2 * j + 1] = __builtin_amdgcn_exp2f(p0[2 * j + 1]); p1[2 * j] = __builtin_amdgcn_exp2f(p1[2 * j]); p1[2 * j + 1] = __builtin_amdgcn_exp2f(p1[2 * j + 1]);
          sa = sa + (f32x2){p0[2 * j], p0[2 * j + 1]}; sb = sb + (f32x2){p1[2 * j], p1[2 * j + 1]}; }
      sa = sa + sb; l += sa.x + sa.y; }
    u32x4 pw[4];
#pragma unroll
    for (int s2 = 0; s2 < 2; ++s2) {
        pw[s2] = (u32x4){cvt_pk_bf16(p0[8 * s2], p0[8 * s2 + 1]), cvt_pk_bf16(p0[8 * s2 + 2], p0[8 * s2 + 3]), cvt_pk_bf16(p0[8 * s2 + 4], p0[8 * s2 + 5]), cvt_pk_bf16(p0[8 * s2 + 6], p0[8 * s2 + 7])};
        pw[2 + s2] = (u32x4){cvt_pk_bf16(p1[8 * s2], p1[8 * s2 + 1]), cvt_pk_bf16(p1[8 * s2 + 2], p1[8 * s2 + 3]), cvt_pk_bf16(p1[8 * s2 + 4], p1[8 * s2 + 5]), cvt_pk_bf16(p1[8 * s2 + 6], p1[8 * s2 + 7])};
    }
    TRWAIT();
#pragma unroll
    for (int ks = 0; ks < 2; ++ks) {
        const bf16x8 pa = __builtin_bit_cast(bf16x8, pw[ks]);
#pragma unroll
        for (int db = 0; db < 4; ++db) {
            const bf16x8 vf = (bf16x8){vl[ks][db][0], vl[ks][db][1], vl[ks][db][2], vl[ks][db][3], vh[ks][db][0], vh[ks][db][1], vh[ks][db][2], vh[ks][db][3]};
            o[db] = __builtin_amdgcn_mfma_f32_32x32x16_bf16(pa, vf, o[db], 0, 0, 0);
        }
    }
    __builtin_amdgcn_sched_barrier(0);
#pragma unroll
    for (int ks = 0; ks < 2; ++ks)
#pragma unroll
        for (int db = 0; db < 4; ++db) { TRR(vl[ks][db], vaddr, db * VDB2 + (2 + ks) * 1024); TRR(vh[ks][db], vaddr, db * VDB2 + (2 + ks) * 1024 + 512); }
    TRWAIT();
#pragma unroll
    for (int ks = 0; ks < 2; ++ks) {
        const bf16x8 pa = __builtin_bit_cast(bf16x8, pw[2 + ks]);
#pragma unroll
        for (int db = 0; db < 4; ++db) {
            const bf16x8 vf = (bf16x8){vl[ks][db][0], vl[ks][db][1], vl[ks][db][2], vl[ks][db][3], vh[ks][db][0], vh[ks][db][1], vh[ks][db][2], vh[ks][db][3]};
            o[db] = __builtin_amdgcn_mfma_f32_32x32x16_bf16(pa, vf, o[db], 0, 0, 0);
        }
    }
    __builtin_amdgcn_sched_barrier(0);
}
}

#define ATT2_DECODE(item, bhj_, chunk_) do { int lo_ = 0, hi_ = 1023; while (lo_ < hi_) { const int mid_ = (lo_ + hi_ + 1) >> 1; if (P[mid_] <= (item)) lo_ = mid_; else hi_ = mid_ - 1; } bhj_ = lo_; chunk_ = (item) - P[lo_]; } while (0)
__device__ __forceinline__ void ph_attn_partial(const Ctx& F) {
    using namespace att2;
    const unsigned char* Q = F.ws + WS_Q; const unsigned char* K = F.ws + WS_K; const unsigned char* V = F.ws + WS_V;
    const unsigned* LISTS = (const unsigned*)(F.ws + WS_LISTS); const unsigned* LCNT = (const unsigned*)(F.ws + WS_CTL) + CW_LCNT;
    unsigned char* OP = F.ws + WS_OP; float* LSE = (float*)(F.ws + WS_LSE);
    LAS int* P = (LAS int*)(F.lds + OFF_TAB);
    if (F.tid < 64) {
        int c[16]; int s = 0;
#pragma unroll
        for (int i = 0; i < 16; ++i) { c[i] = ((int)__hip_atomic_load(LCNT + F.tid * 16 + i, __ATOMIC_RELAXED, __HIP_MEMORY_SCOPE_AGENT) + 255) >> 8; s += c[i]; }
        int inc = s;
#pragma unroll
        for (int o = 1; o < 64; o <<= 1) { const int t = __shfl_up(inc, o); if (F.lane >= o) inc += t; }
        int run = inc - s;
#pragma unroll
        for (int i = 0; i < 16; ++i) { P[F.tid * 16 + i] = run; run += c[i]; }
        if (F.tid == 63) P[1024] = run;
    }
    __syncthreads();
    const int total = P[1024];
    LAS float* wsf = (LAS float*)(F.lds + OFF_WS + F.wave * WSW);
    LAS int* wsi = (LAS int*)wsf;
    const int r = F.lane & 31, hh = F.lane >> 5;
    int it = F.vcu;
    if (it < total) {
        int bhj, chunk; ATT2_DECODE(it, bhj, chunk);
        int itn = it + F.G, bhjn = 0, chunkn = 0; bool hasn = itn < total; if (hasn) ATT2_DECODE(itn, bhjn, chunkn);
        u32x4 rkA, rvA, rkB, rvB;
        { const int b = bhj >> 7, h = (bhj >> 4) & 7, j = bhj & 15; const size_t tb = (size_t)b * SEQ + j * LBLK;
          tile_load(F, K, V, tb, h, 0, rkA, rvA); tile_load(F, K, V, tb, h, 1, rkB, rvB); tile_write(F, 0, rkA, rvA); tile_write(F, 1, rkB, rvB);
          tile_load(F, K, V, tb, h, 2, rkA, rvA); }
        int cnt = (int)__hip_atomic_load(LCNT + bhj, __ATOMIC_RELAXED, __HIP_MEMORY_SCOPE_AGENT);
        int qi = chunk * 256 + F.wave * 32 + r;
        unsigned ent = LISTS[(size_t)bhj * 4096 + (qi < cnt ? qi : 0)];
        int tq = ent & 4095, slot = (qi < cnt) ? (int)(ent >> 12) : -1;
        u32x4 qraw[4];
        { const unsigned char* qrow = Q + ((size_t)(bhj >> 7) * SEQ + tq) * DM + ((bhj >> 4) & 7) * DH + hh * 32;
#pragma unroll
          for (int c = 0; c < 4; ++c) qraw[c] = *(const u32x4*)(qrow + (c >> 1) * 64 + (c & 1) * 16); }
        unsigned entn = 0u; int cntn = 0;
        __syncthreads();
        int s = 0;
        for (;;) {
            const int b = bhj >> 7, h = (bhj >> 4) & 7, j = bhj & 15;
            pg8::v8i_t qr[2];
#pragma unroll
            for (int j2 = 0; j2 < 2; ++j2) qr[j2] = __builtin_shufflevector(__builtin_bit_cast(pg8::v4i_t, qraw[2 * j2]), __builtin_bit_cast(pg8::v4i_t, qraw[2 * j2 + 1]), 0, 1, 2, 3, 4, 5, 6, 7);
            if (F.lane < 32) { wsi[64 + r] = tq; wsi[96 + r] = slot; }
            f32x16 o[4]; float m = -1e30f, l = 0.f;
#pragma unroll
            for (int db = 0; db < 4; ++db)
#pragma unroll
                for (int i = 0; i < 16; ++i) o[db][i] = 0.f;
#define ATT2_TB(bb) ((size_t)((bb) >> 7) * SEQ + ((bb) & 15) * LBLK)
#define ATT2_H(bb) (((bb) >> 4) & 7)
#pragma unroll 1
            for (int kp2 = 0; kp2 < 2; ++kp2) {
                const int kt = 2 * kp2;
                { const bool cur3 = kt + 3 < 4, have3 = cur3 || hasn, have2 = (kt + 2 < 4) || hasn;
                  if (have3) { const int bb = cur3 ? bhj : bhjn; tile_load(F, K, V, ATT2_TB(bb), ATT2_H(bb), (kt + 3) & 3, rkB, rvB); }
                  if (kt == 0 && hasn) { cntn = (int)__hip_atomic_load(LCNT + bhjn, __ATOMIC_RELAXED, __HIP_MEMORY_SCOPE_AGENT); }
                  if (kt == 2 && hasn) { const unsigned char* qrow = Q + ((size_t)(bhjn >> 7) * SEQ + (entn & 4095)) * DM + ((bhjn >> 4) & 7) * DH + hh * 32;
#pragma unroll
                      for (int c = 0; c < 4; ++c) qraw[c] = *(const u32x4*)(qrow + (c >> 1) * 64 + (c & 1) * 16); }
                  tile_compute(F, 0, qr, o, m, l, kp2 == 0);
                  asm volatile("s_waitcnt lgkmcnt(0)" ::: "memory"); __builtin_amdgcn_s_barrier(); asm volatile("" ::: "memory");
                  if (have2) tile_write(F, 0, rkA, rvA); }
                { const bool have4 = hasn, have3 = (kt + 3 < 4) || hasn;
                  if (have4) { tile_load(F, K, V, ATT2_TB(bhjn), ATT2_H(bhjn), kt, rkA, rvA); }
                  if (kt == 0 && hasn) { const int qn = chunkn * 256 + F.wave * 32 + r; entn = LISTS[(size_t)bhjn * 4096 + (qn < cntn ? qn : 0)]; }
                  tile_compute(F, 1, qr, o, m, l, false);
                  asm volatile("s_waitcnt lgkmcnt(0)" ::: "memory"); __builtin_amdgcn_s_barrier(); asm volatile("" ::: "memory");
                  if (have3) tile_write(F, 1, rkB, rvB); }
            }
            const float lt = l + __shfl_xor(l, 32);
            if (hh == 0) { wsf[r] = 1.0f / lt; wsf[32 + r] = m + __builtin_amdgcn_logf(lt); }
            asm volatile("s_waitcnt lgkmcnt(0)" ::: "memory");
            int re = r, he = hh; asm volatile("" : "+v"(re), "+v"(he));
#pragma unroll
            for (int i = 0; i < 16; ++i) {
                const int q = crow(i, he); const float a = wsf[q]; const int t = wsi[64 + q], sl = wsi[96 + q];
                const unsigned w = pack_fp8x4(o[0][i] * a, o[1][i] * a, o[2][i] * a, o[3][i] * a);
                if (sl >= 0) { const size_t row = (((size_t)sl * NB + b) * SEQ + t) * NH + h; *(unsigned*)(OP + row * DH + 4 * re) = w; }
            }
            if (he == 0 && slot >= 0) LSE[(((size_t)slot * NB + b) * SEQ + tq) * NH + h] = wsf[32 + re];
            asm volatile("s_waitcnt lgkmcnt(0)" ::: "memory");
            if (!hasn) break;
            it = itn; bhj = bhjn; chunk = chunkn; cnt = cntn;
            { const int qn = chunk * 256 + F.wave * 32 + r; tq = entn & 4095; slot = (qn < cnt) ? (int)(entn >> 12) : -1; }
            itn = it + F.G; hasn = itn < total; if (hasn) ATT2_DECODE(itn, bhjn, chunkn);
        }
    }
    __syncthreads();
}

__device__ __forceinline__ void ph_attn_own(const Ctx& F) {
    using namespace att2;
    const unsigned char* Q = F.ws + WS_Q; const unsigned char* K = F.ws + WS_K; const unsigned char* V = F.ws + WS_V;
    const unsigned char* OP = F.ws + WS_OP; const float* LSE = (const float*)(F.ws + WS_LSE); bf16_t* YAB = (bf16_t*)(F.ws + WS_YAB);
    LAS float* wsf = (LAS float*)(F.lds + OFF_WS + F.wave * WSW);
    const int r = F.lane & 31, hh = F.lane >> 5;
    constexpr int NIT = NB * NH * NBLK;
    int it = F.vcu;
    if (it < NIT) {
        int itn = it + F.G; bool hasn = itn < NIT;
        u32x4 rkA, rvA, rkB, rvB;
#define OWN_TB(i_) ((size_t)((i_) >> 7) * SEQ + ((i_) & 15) * LBLK)
#define OWN_H(i_) (((i_) >> 4) & 7)
        tile_load(F, K, V, OWN_TB(it), OWN_H(it), 0, rkA, rvA); tile_load(F, K, V, OWN_TB(it), OWN_H(it), 1, rkB, rvB); tile_write(F, 0, rkA, rvA); tile_write(F, 1, rkB, rvB);
        tile_load(F, K, V, OWN_TB(it), OWN_H(it), 2, rkA, rvA);
        u32x4 qraw[4];
        { const unsigned char* qrow = Q + (OWN_TB(it) + F.wave * 32 + r) * DM + OWN_H(it) * DH + hh * 32;
#pragma unroll
          for (int c = 0; c < 4; ++c) qraw[c] = *(const u32x4*)(qrow + (c >> 1) * 64 + (c & 1) * 16); }
        __syncthreads();
        const int wdiag = F.wave >> 1;
        for (;;) {
            const int b = it >> 7, h = (it >> 4) & 7, j = it & 15, t0 = j * LBLK + F.wave * 32;
            pg8::v8i_t qr[2];
#pragma unroll
            for (int j2 = 0; j2 < 2; ++j2) qr[j2] = __builtin_shufflevector(__builtin_bit_cast(pg8::v4i_t, qraw[2 * j2]), __builtin_bit_cast(pg8::v4i_t, qraw[2 * j2 + 1]), 0, 1, 2, 3, 4, 5, 6, 7);
            f32x16 o[4]; float m = -1e30f, l = 0.f;
#pragma unroll
            for (int db = 0; db < 4; ++db)
#pragma unroll
                for (int i = 0; i < 16; ++i) o[db][i] = 0.f;
#pragma unroll 1
            for (int kp2 = 0; kp2 < 2; ++kp2) {
                const int kt = 2 * kp2;
                { const bool cur3 = kt + 3 < 4, have3 = cur3 || hasn, have2 = (kt + 2 < 4) || hasn;
                  if (have3) { const int ii = cur3 ? it : itn; tile_load(F, K, V, OWN_TB(ii), OWN_H(ii), (kt + 3) & 3, rkB, rvB); }
                  if (kt == 2 && hasn) { const unsigned char* qrow = Q + (OWN_TB(itn) + F.wave * 32 + r) * DM + OWN_H(itn) * DH + hh * 32;
#pragma unroll
                      for (int c = 0; c < 4; ++c) qraw[c] = *(const u32x4*)(qrow + (c >> 1) * 64 + (c & 1) * 16); }
                  if (kt <= wdiag) tile_compute<true>(F, 0, qr, o, m, l, kp2 == 0, kt == wdiag);
                  asm volatile("s_waitcnt lgkmcnt(0)" ::: "memory"); __builtin_amdgcn_s_barrier(); asm volatile("" ::: "memory");
                  if (have2) tile_write(F, 0, rkA, rvA); }
                { const bool have4 = hasn, have3 = (kt + 3 < 4) || hasn;
                  if (have4) { tile_load(F, K, V, OWN_TB(itn), OWN_H(itn), kt, rkA, rvA); }
                  if (kt + 1 <= wdiag) tile_compute<true>(F, 1, qr, o, m, l, false, kt + 1 == wdiag);
                  asm volatile("s_waitcnt lgkmcnt(0)" ::: "memory"); __builtin_amdgcn_s_barrier(); asm volatile("" ::: "memory");
                  if (have3) tile_write(F, 1, rkB, rvB); }
            }
            const int nv = j < 3 ? j : 3;
            {
                const float lt = l + __shfl_xor(l, 32); const float lse_own = m + __builtin_amdgcn_logf(lt);
                float ls[3];
#pragma unroll
                for (int s2 = 0; s2 < 3; ++s2) ls[s2] = (s2 < nv) ? LSE[(((size_t)s2 * NB + b) * SEQ + t0 + r) * NH + h] : -1e30f;
                const float M = fmaxf(fmaxf(lse_own, ls[0]), fmaxf(ls[1], ls[2]));
                const float w0 = __builtin_amdgcn_exp2f(lse_own - M);
                float w[3], den = w0;
#pragma unroll
                for (int s2 = 0; s2 < 3; ++s2) { w[s2] = (s2 < nv) ? __builtin_amdgcn_exp2f(ls[s2] - M) : 0.f; den += w[s2]; }
                const float inv = 1.0f / den;
                if (hh == 0) { wsf[r] = w0 * inv / lt; wsf[32 + r] = w[0] * inv; wsf[64 + r] = w[1] * inv; wsf[96 + r] = w[2] * inv; }
                asm volatile("s_waitcnt lgkmcnt(0)" ::: "memory");
            }
            int re = r, he = hh; asm volatile("" : "+v"(re), "+v"(he));
            LAS float* stg = (LAS float*)(F.lds + OFF_STG + F.wave * 8192);
            {
                unsigned pv[16][3];
#pragma unroll
                for (int i = 0; i < 16; ++i) { const int q = crow(i, he);
#pragma unroll
                    for (int s2 = 0; s2 < 3; ++s2) { pv[i][s2] = 0u; if (s2 < nv) pv[i][s2] = *(const unsigned*)(OP + ((((size_t)s2 * NB + b) * SEQ + t0 + q) * NH + h) * DH + 4 * re); } }
#pragma unroll
                for (int i = 0; i < 16; ++i) { const int q = crow(i, he); const float a = wsf[q];
                    float x0 = o[0][i] * a, x1 = o[1][i] * a, x2 = o[2][i] * a, x3 = o[3][i] * a;
#pragma unroll
                    for (int s2 = 0; s2 < 3; ++s2) { const float ww = wsf[32 * (s2 + 1) + q]; const f32x2v f0 = __builtin_amdgcn_cvt_pk_f32_fp8((int)pv[i][s2], false), f1 = __builtin_amdgcn_cvt_pk_f32_fp8((int)pv[i][s2], true);
                        x0 += ww * f0.x; x1 += ww * f0.y; x2 += ww * f1.x; x3 += ww * f1.y; }
                    o[0][i] = x0; o[1][i] = x1; o[2][i] = x2; o[3][i] = x3; }
            }
#pragma unroll
            for (int half = 0; half < 2; ++half) {
#pragma unroll
                for (int i = 0; i < 16; ++i) { const int q = crow(i, he); stg[q * 64 + re] = o[2 * half][i]; stg[q * 64 + 32 + re] = o[2 * half + 1][i]; }
                asm volatile("s_waitcnt lgkmcnt(0)" ::: "memory");
#pragma unroll
                for (int ps = 0; ps < 4; ++ps) {
                    const int q = ps * 8 + ((re + 32 * he) >> 3), dc = re & 7;
                    const f32x4 x = *(LAS const f32x4*)(stg + q * 64 + dc * 8), y = *(LAS const f32x4*)(stg + q * 64 + dc * 8 + 4);
                    *(u32x4*)(YAB + ((size_t)b * SEQ + t0 + q) * 2048 + 1024 + h * DH + half * 64 + dc * 8) = (u32x4){cvt_pk_bf16(x.x, x.y), cvt_pk_bf16(x.z, x.w), cvt_pk_bf16(y.x, y.y), cvt_pk_bf16(y.z, y.w)};
                }
                asm volatile("s_waitcnt lgkmcnt(0)" ::: "memory");
            }
            if (!hasn) break;
            it = itn; itn = it + F.G; hasn = itn < NIT;
        }
#undef OWN_TB
#undef OWN_H
    }
    __syncthreads();
}

__device__ __forceinline__ void ph_router(const Ctx& F) {
    const Args& A = *F.a;
    const bf16_t* Z = (const bf16_t*)(F.ws + WS_Z); const float* ZST = (const float*)(F.ws + WS_ZST); bf16_t* H1 = (bf16_t*)(F.ws + WS_H1); unsigned char* H1F8 = F.ws + WS_H1F8;
    int* TKE = (int*)(F.ws + WS_TKE); int* TKP = (int*)(F.ws + WS_TKP); unsigned* ECNT = (unsigned*)(F.ws + WS_CTL) + CW_ECNT; int* RT = (int*)(F.ws + WS_RT); float* RW = (float*)(F.ws + WS_RW);
    const float* wr = A.in[I_WR]; const float* br = A.in[I_BR];
    constexpr int RS = 2064, OFF_LO = 32 * RS, OFF_G = 2 * 32 * RS  , OFF_B = OFF_G + 4096, OFF_LG = OFF_B + 4096  , OFF_CNT = OFF_LG + 8 * 2112  ;
    static_assert(OFF_CNT + 256 <= LDS_BYTES, "router LDS map");
    LAS unsigned char* WH = F.lds; LAS unsigned char* WL = F.lds + OFF_LO;
    LAS float* LG = (LAS float*)(F.lds + OFF_G); LAS float* LB = (LAS float*)(F.lds + OFF_B);
    LAS float* lgt = (LAS float*)(F.lds + OFF_LG + F.wave * 2112);
    LAS unsigned* lcnt = (LAS unsigned*)(F.lds + OFF_CNT);
    {
        f32x4 wa[8], wb[8];
#pragma unroll
        for (int u_ = 0; u_ < 8; ++u_) { const int i = F.tid + 512 * u_, nq = i & 7, k2 = i >> 3;
            wa[u_] = *(const f32x4*)(wr + (size_t)(2 * k2) * NE + 4 * nq); wb[u_] = *(const f32x4*)(wr + (size_t)(2 * k2 + 1) * NE + 4 * nq); }
#pragma unroll
        for (int u_ = 0; u_ < 8; ++u_) { const int i = F.tid + 512 * u_, nq = i & 7, k2 = i >> 3;
#pragma unroll
            for (int c = 0; c < 4; ++c) {
                const float w0 = wa[u_][c], w1 = wb[u_][c];
                const unsigned h0 = f2bf(w0), h1 = f2bf(w1);
                const float r0 = w0 - __uint_as_float(h0 << 16), r1 = w1 - __uint_as_float(h1 << 16);
                *(LAS unsigned*)(WH + (4 * nq + c) * RS + k2 * 4) = h0 | (h1 << 16);
                *(LAS unsigned*)(WL + (4 * nq + c) * RS + k2 * 4) = pk2(r0, r1);
            } }
    }
    for (int i = F.tid; i < DM; i += 512) { LG[i] = A.in[I_LNMIX_G][i]; LB[i] = A.in[I_LNMIX_B][i]; }
    if (F.tid < 64) lcnt[F.tid] = 0u;
    __syncthreads();
    const int fr = F.lane & 15, kg = F.lane >> 4;
    const int ntask = T / 16, NGW = F.G * 8;
    const int rounds = (ntask + NGW - 1) / NGW;
    for (int rd = 0; rd < rounds; ++rd) {
        const int task = rd * NGW + F.vcu * 8 + F.wave;
        const bool live = task < ntask;
        int te[4] = {0, 0, 0, 0}; float tw[4] = {0.f, 0.f, 0.f, 0.f}; unsigned lp[4] = {0, 0, 0, 0};
        if (live) {
            const int tok = task * 16 + fr;
            float mean, rstd;
            { const f32x4* sp = (const f32x4*)(ZST + (size_t)tok * 32); float s1 = 0.f, s2 = 0.f;
#pragma unroll
              for (int i = 0; i < 8; ++i) { const f32x4 v = sp[i]; s1 += v.x + v.z; s2 += v.y + v.w; }
              mean = s1 * (1.f / DM); const float var = s2 * (1.f / DM) - mean * mean; rstd = 1.f / sqrtf(fmaxf(var, 0.f) + LN_EPS); }
            f32x4 acc0 = {0.f, 0.f, 0.f, 0.f}, acc1 = {0.f, 0.f, 0.f, 0.f};
            const bf16_t* zp = Z + (size_t)tok * DM + 8 * kg; unsigned char* h8 = H1F8 + (size_t)tok * DM + 8 * kg;
#pragma unroll 8
            for (int kk = 0; kk < 32; ++kk) {
                const u32x4 zr = *(const u32x4*)(zp + 32 * kk); const f32x4 z0 = {bflo(zr.x), bfhi(zr.x), bflo(zr.y), bfhi(zr.y)}, z1 = {bflo(zr.z), bfhi(zr.z), bflo(zr.w), bfhi(zr.w)};
                const f32x4 g0 = *(LAS const f32x4*)(LG + 32 * kk + 8 * kg), g1 = *(LAS const f32x4*)(LG + 32 * kk + 8 * kg + 4);
                const f32x4 b0 = *(LAS const f32x4*)(LB + 32 * kk + 8 * kg), b1 = *(LAS const f32x4*)(LB + 32 * kk + 8 * kg + 4);
                const f32x4 x0 = (z0 - mean) * rstd * g0 + b0, x1 = (z1 - mean) * rstd * g1 + b1;
                u32x4 hi; hi.x = cvt_pk_bf16(x0.x, x0.y); hi.y = cvt_pk_bf16(x0.z, x0.w); hi.z = cvt_pk_bf16(x1.x, x1.y); hi.w = cvt_pk_bf16(x1.z, x1.w);
                { unsigned w0 = 0u, w1 = 0u;
                  w0 = __builtin_amdgcn_cvt_pk_fp8_f32(x0.x, x0.y, w0, false); w0 = __builtin_amdgcn_cvt_pk_fp8_f32(x0.z, x0.w, w0, true);
                  w1 = __builtin_amdgcn_cvt_pk_fp8_f32(x1.x, x1.y, w1, false); w1 = __builtin_amdgcn_cvt_pk_fp8_f32(x1.z, x1.w, w1, true);
                  *(u32x2*)(h8 + 32 * kk) = (u32x2){w0, w1}; }
                u32x4 lo; lo.x = cvt_pk_bf16(x0.x - bflo(hi.x), x0.y - bfhi(hi.x)); lo.y = cvt_pk_bf16(x0.z - bflo(hi.y), x0.w - bfhi(hi.y));
                lo.z = cvt_pk_bf16(x1.x - bflo(hi.z), x1.y - bfhi(hi.z)); lo.w = cvt_pk_bf16(x1.z - bflo(hi.w), x1.w - bfhi(hi.w));
                const bf16x8 ah = __builtin_bit_cast(bf16x8, hi), al = __builtin_bit_cast(bf16x8, lo);
                const int bo = fr * RS + (32 * kk + 8 * kg) * 2;
                const bf16x8 wh0 = *(LAS const bf16x8*)(WH + bo), wh1 = *(LAS const bf16x8*)(WH + bo + 16 * RS), wl0 = *(LAS const bf16x8*)(WL + bo), wl1 = *(LAS const bf16x8*)(WL + bo + 16 * RS);
                acc0 = __builtin_amdgcn_mfma_f32_16x16x32_bf16(ah, wh0, acc0, 0, 0, 0); acc1 = __builtin_amdgcn_mfma_f32_16x16x32_bf16(ah, wh1, acc1, 0, 0, 0);
                acc0 = __builtin_amdgcn_mfma_f32_16x16x32_bf16(ah, wl0, acc0, 0, 0, 0); acc1 = __builtin_amdgcn_mfma_f32_16x16x32_bf16(ah, wl1, acc1, 0, 0, 0);
                acc0 = __builtin_amdgcn_mfma_f32_16x16x32_bf16(al, wh0, acc0, 0, 0, 0); acc1 = __builtin_amdgcn_mfma_f32_16x16x32_bf16(al, wh1, acc1, 0, 0, 0);
            }
            const float br0 = br[fr], br1 = br[16 + fr];
#pragma unroll
            for (int i = 0; i < 4; ++i) { lgt[(4 * kg + i) * 33 + fr] = acc0[i] + br0; lgt[(4 * kg + i) * 33 + 16 + fr] = acc1[i] + br1; }
            asm volatile("s_waitcnt lgkmcnt(0)" ::: "memory");
            if (F.lane < 16) {
                float lg[NE];
#pragma unroll
                for (int e = 0; e < NE; ++e) lg[e] = lgt[F.lane * 33 + e];
                float tv[4];
#pragma unroll
                for (int r = 0; r < 4; ++r) {
                    float best = -INFINITY; int bi = 0;
#pragma unroll
                    for (int e = 0; e < NE; ++e) { const bool c = lg[e] > best; best = c ? lg[e] : best; bi = c ? e : bi; }
#pragma unroll
                    for (int e = 0; e < NE; ++e) lg[e] = (e == bi) ? -INFINITY : lg[e];
                    te[r] = bi; tv[r] = best;
                }
                const float e1 = __expf(tv[1] - tv[0]), e2 = __expf(tv[2] - tv[0]), e3 = __expf(tv[3] - tv[0]); const float inv = 1.f / (1.f + e1 + e2 + e3);
                tw[0] = inv; tw[1] = e1 * inv; tw[2] = e2 * inv; tw[3] = e3 * inv;
#pragma unroll
                for (int r = 0; r < 4; ++r) lp[r] = atomicAdd((unsigned*)(lcnt + te[r]), 1u);
            }
        }
        __syncthreads();
        if (F.tid < 32) { const unsigned c = lcnt[F.tid]; lcnt[32 + F.tid] = c ? atomicAdd(&ECNT[F.tid], c) : 0u; }
        __syncthreads();
        if (live && F.lane < 16) {
            const size_t tok = (size_t)task * 16 + F.lane;
            int4 pe = {te[0], te[1], te[2], te[3]};
            int4 pp = {(int)(lcnt[32 + te[0]] + lp[0]), (int)(lcnt[32 + te[1]] + lp[1]), (int)(lcnt[32 + te[2]] + lp[2]), (int)(lcnt[32 + te[3]] + lp[3])};
            *(int4*)(TKE + tok * 4) = pe; *(int4*)(TKP + tok * 4) = pp;
#pragma unroll
            for (int r = 0; r < 4; ++r) { const size_t o_ = (size_t)te[r] * T + (r == 0 ? pp.x : r == 1 ? pp.y : r == 2 ? pp.z : pp.w); RT[o_] = (int)tok; RW[o_] = tw[r]; }
        }
        __syncthreads();
        if (F.tid < 32) lcnt[F.tid] = 0u;
        __syncthreads();
    }
}

__device__ __forceinline__ void moe_table(const Ctx& F) {
    const unsigned* ECNT = (const unsigned*)(F.ws + WS_CTL) + CW_ECNT;
    LAS int* tab = (LAS int*)(F.lds + LDS_MOE);
    __syncthreads();
    if (F.tid == 0) {
        int acc = 0;
        for (int e = 0; e < NE; ++e) { const int c = (int)__hip_atomic_load(ECNT + e, __ATOMIC_RELAXED, __HIP_MEMORY_SCOPE_AGENT); tab[32 + e] = acc; acc += (c + 255) / 256 * 256; }
        tab[64] = acc; tab[0] = acc / 256;
    }
    __syncthreads();
    const int ntiles = tab[0];
    for (int i = F.tid; i < ntiles; i += 512) { int e = 0; for (int k = 1; k < NE; ++k) if (i * 256 >= tab[32 + k]) e = k; tab[128 + 2 * i] = e; tab[129 + 2 * i] = i - tab[32 + e] / 256; }
    __syncthreads();
}

__device__ __forceinline__ void ln_stats16(const float* st, int lane, float& mean, float& rstd) {
    float s1 = 0.f, s2 = 0.f;
    if (lane < 16) { const f32x2 p = *(const f32x2*)(st + 2 * lane); s1 = p.x; s2 = p.y; }
    s1 = wave_sum(s1); s2 = wave_sum(s2);
    mean = s1 * (1.f / DM); const float var = s2 * (1.f / DM) - mean * mean; rstd = 1.f / sqrtf(fmaxf(var, 0.f) + LN_EPS);
}
__device__ __forceinline__ void ph_final(const Ctx& F) {
    const Args& A = *F.a;
    const bf16_t* Z = (const bf16_t*)(F.ws + WS_Z); const float* ZST = (const float*)(F.ws + WS_ZST); const unsigned char* YS = F.ws + WS_YS; const int* TKE = (const int*)(F.ws + WS_TKE); const int* TKP = (const int*)(F.ws + WS_TKP);
    const LAS int* tab = (const LAS int*)(F.lds + LDS_MOE);
    const int gw = F.vcu * 8 + F.wave, NGW = F.G * 8;
    f32x4 g2[4], b2[4], g1[4], b1[4];
#pragma unroll
    for (int j = 0; j < 4; ++j) { g2[j] = *((const f32x4*)A.in[I_LNF_G] + F.lane + 64 * j); b2[j] = *((const f32x4*)A.in[I_LNF_B] + F.lane + 64 * j);
        g1[j] = *((const f32x4*)A.in[I_LNMIX_G] + F.lane + 64 * j) * ALPHA; b1[j] = *((const f32x4*)A.in[I_LNMIX_B] + F.lane + 64 * j) * ALPHA; }
    for (int m = gw; m < T; m += NGW) {
        float mean, rstd; ln_stats16(ZST + (size_t)m * 32, F.lane, mean, rstd);
        const u32x2* hr = (const u32x2*)(Z + (size_t)m * DM) + F.lane;
        f32x4 v[4];
#pragma unroll
        for (int j = 0; j < 4; ++j) { const u32x2 hb = hr[64 * j]; v[j] = ((f32x4){bflo(hb.x), bfhi(hb.x), bflo(hb.y), bfhi(hb.y)} - mean) * rstd * g1[j] + b1[j]; }
#pragma unroll
        for (int k = 0; k < 4; ++k) {
            const int row = tab[32 + TKE[(size_t)m * 4 + k]] + TKP[(size_t)m * 4 + k]; const unsigned* yr = (const unsigned*)(YS + (size_t)row * DM) + F.lane;
#pragma unroll
            for (int j = 0; j < 4; ++j) { const unsigned y = yr[64 * j]; const f32x2v f0 = __builtin_amdgcn_cvt_pk_f32_fp8((int)y, false), f1 = __builtin_amdgcn_cvt_pk_f32_fp8((int)y, true);
                v[j].x += 0.0625f * f0.x; v[j].y += 0.0625f * f0.y; v[j].z += 0.0625f * f1.x; v[j].w += 0.0625f * f1.y; }
        }
        float s = 0.f;
#pragma unroll
        for (int j = 0; j < 4; ++j) s += (v[j].x + v[j].y) + (v[j].z + v[j].w);
        const float mu = wave_sum(s) * (1.f / DM); float s2 = 0.f;
#pragma unroll
        for (int j = 0; j < 4; ++j) { v[j] = v[j] - mu; s2 += (v[j].x * v[j].x + v[j].y * v[j].y) + (v[j].z * v[j].z + v[j].w * v[j].w); }
        const float rs = 1.f / sqrtf(wave_sum(s2) * (1.f / DM) + LN_EPS);
        f32x4* orow = (f32x4*)(A.out + (size_t)m * DM) + F.lane;
#pragma unroll
        for (int j = 0; j < 4; ++j) orow[64 * j] = v[j] * rs * g2[j] + b2[j];
    }
}

#define XB_TMO      128
#define XB_XCNT(j)  (256  + 64 * (j))
#define XB_XSUB(j)  (1280 + 64 * (j))
#define XB_XGEN(j)  (2304 + 64 * (j))
#define XB_TOP      3328
#define XB_TOPGEN   3392
#define XCD_BAR_WORDS 3456
#define XB_SPIN_CAP (1u << 18)
__device__ __forceinline__ unsigned xb_ld(unsigned* p)              { return __hip_atomic_load(p, __ATOMIC_RELAXED, __HIP_MEMORY_SCOPE_AGENT); }
__device__ __forceinline__ unsigned xb_add(unsigned* p, unsigned v) { return __hip_atomic_fetch_add(p, v, __ATOMIC_RELAXED, __HIP_MEMORY_SCOPE_AGENT); }
__device__ __forceinline__ unsigned xb_xcc_id() { return (unsigned)__builtin_amdgcn_s_getreg((3 << 11) | 20) & 0xFu; }
#define XB_SPIN(cond, bar) do { unsigned _sp = 0; while (cond) { __builtin_amdgcn_s_sleep(1); \
    if ((++_sp & 255u) == 0u) { if (xb_ld(&(bar)[XB_TMO])) break; if (_sp > XB_SPIN_CAP) { atomicAdd(&(bar)[XB_TMO], 1u); break; } } } } while (0)
__device__ __forceinline__ void xcd_barrier_complete(unsigned* bar, unsigned x, unsigned& nloc, unsigned& nx) {
    const unsigned G = gridDim.x * gridDim.y * gridDim.z;
    unsigned sum, cnt, mine, sp = 0u;
    for (;;) {
        sum = 0u; cnt = 0u; mine = 0u;
#pragma unroll
        for (unsigned j = 0; j < 16; ++j) { const unsigned c = xb_ld(&bar[XB_XCNT(j)]); sum += c; cnt += (c > 0u) ? 1u : 0u; mine = (j == x) ? c : mine; }
        if (sum == G) break;
        __builtin_amdgcn_s_sleep(1);
        if ((++sp & 255u) == 0u) { if (xb_ld(&bar[XB_TMO])) break; if (sp > XB_SPIN_CAP) { atomicAdd(&bar[XB_TMO], 1u); break; } }
    }
    nloc = mine > 0u ? mine : 1u; nx = cnt > 0u ? cnt : 1u;
}
__device__ __forceinline__ void xcd_barrier(unsigned* bar, volatile LAS unsigned* st, unsigned x, bool leader_thread) {
    asm volatile("s_waitcnt vmcnt(0)" ::: "memory");
    __syncthreads();
    if (leader_thread) {
        __builtin_amdgcn_s_waitcnt(0);
        unsigned nloc = st[0], nx = st[1];
        if (nloc == 0u) { xcd_barrier_complete(bar, x, nloc, nx); st[0] = nloc; st[1] = nx; }
        const unsigned old = xb_add(&bar[XB_XSUB(x)], 1u);
        const unsigned gen = old / nloc;
        if (old + 1u == (gen + 1u) * nloc) {
            __builtin_amdgcn_fence(__ATOMIC_RELEASE, "agent");
            asm volatile("s_waitcnt vmcnt(0)" ::: "memory");
            const unsigned og = xb_add(&bar[XB_TOP], 1u);
            const unsigned tg = og / nx;
            if (og + 1u == (tg + 1u) * nx) xb_add(&bar[XB_TOPGEN], 1u);
            else XB_SPIN(xb_ld(&bar[XB_TOPGEN]) == tg, bar);
            __builtin_amdgcn_fence(__ATOMIC_ACQUIRE, "agent");
            xb_add(&bar[XB_XGEN(x)], 1u);
            asm volatile("s_waitcnt vmcnt(0)" ::: "memory");
        } else {
            XB_SPIN(xb_ld(&bar[XB_XGEN(x)]) == gen, bar);
            __builtin_amdgcn_fence(__ATOMIC_ACQUIRE, "agent");
            asm volatile("s_waitcnt vmcnt(0)" ::: "memory");
        }
    }
    __syncthreads();
}

template <bool COOP>
__global__ void __launch_bounds__(512, 2) mega(Args args) {
    extern __shared__ __attribute__((aligned(16))) unsigned char lds_raw[];
    Ctx F;
    const int wave0 = __builtin_amdgcn_readfirstlane(threadIdx.x >> 6);
#define MKCTX() do { F.a = &args; F.ws = args.ws; F.lds = (LAS unsigned char*)lds_raw; F.ldsg = lds_raw; F.lane = lane_id_asm(); F.wave = wave0; F.tid = wave0 * 64 + F.lane; \
    F.G = gridDim.x; { const int bx = blockIdx.x; F.vcu = (F.G % 8 == 0) ? (bx % 8) * (F.G / 8) + bx / 8 : bx; } } while (0)
    MKCTX();
    const int lo = args.ph_lo, hi = args.ph_hi;
    unsigned char* ws = args.ws;
#ifndef PHMASK
#define PHMASK 0xFFFF
#endif
#define IN(k) (((PHMASK >> (k)) & 1) && lo <= (k) && (k) < hi)
    unsigned* barw = (unsigned*)(ws + WS_CTL) + CW_BAR; volatile LAS unsigned* bst = (volatile LAS unsigned*)((LAS unsigned char*)lds_raw + LDS_BYTES - 64);
    const unsigned my_xcc = xb_xcc_id();
    if (COOP) { if (threadIdx.x == 0) { bst[0] = 0u; bst[1] = 0u; (void)xb_add(&barw[XB_XCNT(my_xcc)], 1u); } __syncthreads(); }
#define SEAM(k) do { if (COOP && IN(k) && IN((k) + 1)) { if (args.ph_hi > 1000) cg::this_grid().sync();   xcd_barrier(barw, bst, my_xcc, wave0 == 0 && lane_id_asm() == 0); } } while (0)
    if (IN(0)) { MKCTX(); ph_prologue(F); } SEAM(0);
    if (IN(1)) {
        const int wslot = (F.G % 8 == 0) ? ((int)blockIdx.x / 8) % 3 : (int)blockIdx.x % 3;
        if (wslot == 0) { MKCTX(); ph_wconv(F); }
        {
            pg8::Gemm g{(const bf16_t*)(ws + WS_H0), (const bf16_t*)(ws + WS_WIN), DM, DM, DM, nullptr}; pg8::StaticOrder S; S.init(T, (PN8_LO + 28 - PN8_HI) * 256, F.G, (int)blockIdx.x, 0, PN8_LO, PN8_HI - PN8_LO);
            const pg8::Epi1 E{(bf16_t*)(ws + WS_YAB), (bf16_t*)(ws + WS_GV), ws + WS_Q, ws + WS_K, ws + WS_V, (bf16_t*)(ws + WS_SA), (bf16_t*)(ws + WS_SB), (float*)(ws + WS_GVST), (float*)(ws + WS_KMEAN), 1.0f, 0.f};
            pg8::gemm_phase<pg8::Epi1, pg8::StaticOrder, true>(F.lds, g, S, E, wave0);
        }
        if (wslot == 1) { MKCTX(); ph_wconv(F); }
        {
            const pg8::Epi1 E{(bf16_t*)(ws + WS_YAB), (bf16_t*)(ws + WS_GV), ws + WS_Q, ws + WS_K, ws + WS_V, (bf16_t*)(ws + WS_SA), (bf16_t*)(ws + WS_SB), (float*)(ws + WS_GVST), (float*)(ws + WS_KMEAN), 0.03125f, 0.f};
            pg8::Gemm g{(const bf16_t*)(ws + WS_H0F8), (const bf16_t*)(ws + WS_WIN8), DM / 2, DM / 2, DM / 2, nullptr}; pg8::StaticOrder S; S.init(T, (PN8_HI - PN8_LO) * 256, F.G, (int)blockIdx.x, PN8_LO);
            pg8::gemm_phase<pg8::Epi1, pg8::StaticOrder, true, true>(F.lds, g, S, E, wave0);
        }
        if (wslot == 2) { MKCTX(); ph_wconv(F); }
    } SEAM(1);
    if (IN(2)) { MKCTX(); ph_mixer_a(F); __syncthreads(); ph_gate(F); } SEAM(2);
    if (IN(3)) { } if (COOP && IN(3) && IN(4)) { }
    if (IN(4)) { MKCTX(); ph_attn_partial(F); } SEAM(4);
    if (IN(5)) { MKCTX(); ph_attn_own(F); } SEAM(5);
    if (IN(6)) {
        pg8::Gemm g{(const bf16_t*)(ws + WS_YAB), (const bf16_t*)(ws + WS_WAB), 2048, 2048, 2048, nullptr}; pg8::StaticOrder S; S.init(T, DM, F.G, (int)blockIdx.x);
        pg8::Epi2 E{ws + WS_SA, ws + WS_SB, (bf16_t*)(ws + WS_MG)};
        pg8::gemm_phase<pg8::Epi2, pg8::StaticOrder, true>(F.lds, g, S, E, wave0);
    } SEAM(6);
    if (IN(7)) {
        pg8::Gemm g{(const bf16_t*)(ws + WS_MG), (const bf16_t*)(ws + WS_WOUT), DM, DM, DM, nullptr}; pg8::StaticOrder S; S.init(T, DM, F.G, (int)blockIdx.x);
        pg8::Epi3 E{(const bf16_t*)(ws + WS_H0), (bf16_t*)(ws + WS_Z), (float*)(ws + WS_ZST)};
        pg8::gemm_phase<pg8::Epi3, pg8::StaticOrder, true>(F.lds, g, S, E, wave0);
    } SEAM(7);
    if (IN(8)) { MKCTX(); ph_router(F); } SEAM(8);
    if (IN(9)) { } if (COOP && IN(9) && IN(10)) { }
    if (IN(10)) {
        MKCTX(); moe_table(F);
        pg8::Gemm g{(const bf16_t*)(ws + WS_H1F8), (const bf16_t*)(ws + WS_WUP), DM / 2, DM / 2, DM / 2, (const int*)(ws + WS_RT)}; pg8::MoeOrder S;   S.init((const LAS int*)(F.lds + LDS_MOE), 8, F.G, (int)blockIdx.x);
        pg8::Epi4 E{args.in[I_BUP], ws + WS_ACT};
        pg8::gemm_phase<pg8::Epi4, pg8::MoeOrder, true, true, true>(F.lds, g, S, E, wave0);
    } SEAM(10);
    if (IN(11)) {
        MKCTX(); moe_table(F);
        pg8::Gemm g{(const bf16_t*)(ws + WS_ACT), (const bf16_t*)(ws + WS_WDN), FF / 2, FF / 2, FF / 2, nullptr}; pg8::MoeOrder S; S.init((const LAS int*)(F.lds + LDS_MOE), 4, F.G, (int)blockIdx.x);
        pg8::Epi5 E{args.in[I_BDN], (const float*)(ws + WS_RW), ws + WS_YS};
        pg8::gemm_phase<pg8::Epi5, pg8::MoeOrder, true, true>(F.lds, g, S, E, wave0);
    } SEAM(11);
    if (IN(12)) { MKCTX(); moe_table(F); ph_final(F); }
#undef IN
#undef SEAM
}

extern "C" void kernel_launch(void* const* d_in, const int* in_sizes, int n_in, void* d_out, int out_size, void* d_ws, size_t ws_size, hipStream_t stream) {
    static int grid = 0;
    if (grid == 0) {
        if (n_in != 21 || in_sizes[0] != T * DM || out_size != T * DM || ws_size < WS_END) { fprintf(stderr, "kernel_launch: unexpected shapes (n_in %d, in0 %d, out %d, ws %zu)\n", n_in, n_in > 0 ? in_sizes[0] : -1, out_size, ws_size); grid = -1; return; }
        int dev = 0, cus = 0, per_cu = 0;
        hipGetDevice(&dev); hipDeviceGetAttribute(&cus, hipDeviceAttributeMultiprocessorCount, dev);
        const void* fn = MK_COOP ? (const void*)mega<true> : (const void*)mega<false>;
        hipFuncSetAttribute(fn, hipFuncAttributeMaxDynamicSharedMemorySize, LDS_BYTES);
        hipOccupancyMaxActiveBlocksPerMultiprocessor(&per_cu, fn, 512, LDS_BYTES);
        (void)hipGetLastError();
        if (per_cu < 1) { fprintf(stderr, "kernel_launch: occupancy query says %d blocks/CU\n", per_cu); per_cu = 1; }
        grid = cus * 1;
    }
    if (grid < 0) return;
    hipMemsetAsync((char*)d_ws + WS_CTL, 0, CTL_ZERO_BYTES, stream);
    Args a{};
    for (int i = 0; i < 21; ++i) a.in[i] = (const float*)d_in[i];
    a.out = (float*)d_out; a.ws = (unsigned char*)d_ws;
#if MK_COOP
    a.ph_lo = 0; a.ph_hi = NPHASE;
    void* kargs[] = {&a};
    hipError_t e = hipLaunchCooperativeKernel((const void*)mega<true>, dim3(grid), dim3(512), kargs, LDS_BYTES, stream);
    if (e != hipSuccess) fprintf(stderr, "cooperative launch failed: %s (grid %d)\n", hipGetErrorString(e), grid);
#else
    for (int p = 0; p < NPHASE; ++p) { a.ph_lo = p; a.ph_hi = p + 1; hipLaunchKernelGGL(mega<false>, dim3(grid), dim3(512), LDS_BYTES, stream, a); }
#endif
}
```

```cpp
#include <hip/hip_runtime.h>
#include <hip/hip_cooperative_groups.h>
#include <cstdio>
#include <cstdint>
namespace cg = cooperative_groups;

#ifndef MK_COOP
#define MK_COOP 1
#endif

#define LAS __attribute__((address_space(3)))
typedef unsigned short bf16_t;
typedef short bf16x8 __attribute__((ext_vector_type(8)));
typedef float f32x4 __attribute__((ext_vector_type(4)));
typedef float f32x2 __attribute__((ext_vector_type(2)));
typedef unsigned u32x4 __attribute__((ext_vector_type(4)));
typedef unsigned u32x2 __attribute__((ext_vector_type(2)));

constexpr int NB = 8, SEQ = 4096, DM = 1024, T = NB * SEQ;
constexpr int NH = 8, DH = 128, LBLK = 256, NBLK = SEQ / LBLK;
constexpr int NE = 32, TOPK = 4, FF = 1024;
constexpr int INCOLS = 7 * DM;
constexpr int RMAX = T * TOPK + NE * 256;
constexpr float LN_EPS = 1e-5f;
constexpr float ALPHA = 1.189207115002721f;
constexpr float QSCALE = 0.08838834764831845f * 1.4426950408889634f;

constexpr size_t MiB = 1u << 20, U64 = 64 * MiB;
constexpr size_t WS_CTL = 0, CTL_ZERO_BYTES = 1 * MiB;
constexpr int CW_ECNT = 64;
constexpr int CW_LCNT = 1024;
constexpr int CW_BAR = 4096;
constexpr size_t WS_KMEAN = 1 * MiB;
constexpr size_t WS_GVST = 2 * MiB;
constexpr size_t WS_ZST = 6 * MiB;
constexpr size_t WS_SEL = 10 * MiB;
constexpr size_t WS_TKE = 11 * MiB;
constexpr size_t WS_TKW = 11 * MiB + 512 * 1024;
constexpr size_t WS_TKP = 12 * MiB;
constexpr size_t WS_ROWOF = 12 * MiB + 512 * 1024;
constexpr size_t WS_ROWTOK = 13 * MiB;
constexpr size_t WS_ROWW = 14 * MiB;
constexpr size_t WS_TILE = 15 * MiB;
constexpr size_t WS_LISTS = 16 * MiB;
constexpr size_t WS_LSE = 32 * MiB;
constexpr size_t WS_RT = 16 * MiB;
constexpr size_t WS_RW = 20 * MiB;
constexpr int LDS_MOE = 131072 + 1024;
constexpr size_t WS_WIN = 40 * MiB;
constexpr size_t WS_WAB = 54 * MiB;
constexpr size_t WS_WOUT = 58 * MiB;
constexpr size_t WS_WDN = 60 * MiB;
constexpr size_t WS_WUP = 124 * MiB;
constexpr size_t WS_H0 = 4 * U64;
constexpr size_t WS_YAB = 5 * U64;
constexpr size_t WS_GV = 7 * U64;
constexpr size_t WS_Q = 8 * U64, WS_K = 9 * U64, WS_V = 10 * U64, WS_SA = 11 * U64, WS_SB = 12 * U64;
constexpr size_t WS_OP = 13 * U64;
constexpr size_t WS_MG = WS_GV;
constexpr size_t WS_Z = 14 * U64;
constexpr size_t WS_H1 = WS_H0;
constexpr size_t WS_XG = 5 * U64;
constexpr size_t WS_H1F8 = 12 * U64;
constexpr size_t WS_ACT = 9 * U64 + 16 * MiB;
constexpr size_t WS_YS = WS_XG;
constexpr size_t WS_H0F8 = 13 * U64;
constexpr size_t WS_WIN8 = 192 * MiB;
constexpr int PN8_LO = 8, PN8_HI = 28;
constexpr size_t WS_END = 16 * U64;
static_assert(WS_XG + (size_t)RMAX * 2048 <= WS_ACT && WS_ACT + (size_t)RMAX * 2048 <= WS_Z, "ws map");

constexpr int LDS_BYTES = 163840;
constexpr int LDS_MISC = 131072;
constexpr int NPHASE = 13;

__device__ __forceinline__ float bf2f(bf16_t v) { return __uint_as_float((unsigned)v << 16); }
__device__ __forceinline__ float bflo(unsigned u) { return __uint_as_float(u << 16); }
__device__ __forceinline__ float bfhi(unsigned u) { return __uint_as_float(u & 0xffff0000u); }
__device__ __forceinline__ unsigned f2bf(float f) { unsigned u = __builtin_bit_cast(unsigned, f); return (u + 0x7fffu + ((u >> 16) & 1u)) >> 16; }
__device__ __forceinline__ unsigned pk2(float lo, float hi) { return f2bf(lo) | (f2bf(hi) << 16); }
typedef __bf16 bf16x2_t __attribute__((ext_vector_type(2)));
__device__ __forceinline__ unsigned cvt_pk_bf16(float lo, float hi) { f32x2 v = {lo, hi}; bf16x2_t b = __builtin_convertvector(v, bf16x2_t); return __builtin_bit_cast(unsigned, b); }
__device__ __forceinline__ int lane_id_asm() { int l; asm volatile("v_mbcnt_lo_u32_b32 %0, -1, 0\n\tv_mbcnt_hi_u32_b32 %0, -1, %0" : "=v"(l)); return l; }
__device__ __forceinline__ float wave_sum(float v) {
#pragma unroll
    for (int o = 1; o < 64; o <<= 1) v += __shfl_xor(v, o);
    return v;
}
__device__ __forceinline__ float wave_max(float v) {
#pragma unroll
    for (int o = 1; o < 64; o <<= 1) v = fmaxf(v, __shfl_xor(v, o));
    return v;
}
__device__ __forceinline__ f32x2 gelu_pk(f32x2 v) {
    const f32x2 av = __builtin_elementwise_abs(v), d = av * 0.2316418882f + 1.0f;
    f32x2 t; t.x = __builtin_amdgcn_rcpf(d.x); t.y = __builtin_amdgcn_rcpf(d.y);
    f32x2 q = t * 0.5307027145f + (-0.7265760135f); q = q * t + 0.7107068705f; q = q * t + (-0.142248368f); q = q * t + 0.127414796f; q = q * t;
    const f32x2 s = (v * v) * (-0.72134752044f);
    f32x2 e; e.x = __builtin_amdgcn_exp2f(s.x); e.y = __builtin_amdgcn_exp2f(s.y);
    const f32x2 m = v * (q * e), r = v - m;
    f32x2 o; o.x = v.x < 0.f ? m.x : r.x; o.y = v.y < 0.f ? m.y : r.y; return o;
}
typedef float f32x2v __attribute__((ext_vector_type(2)));
template <bool HI> __device__ __forceinline__ unsigned f8x2_to_bf16x2(unsigned w) { const f32x2v f = __builtin_amdgcn_cvt_pk_f32_fp8((int)w, HI); return cvt_pk_bf16(f.x, f.y); }
__device__ __forceinline__ u32x4 f8x8_to_bf16x8(unsigned lo, unsigned hi) { return (u32x4){f8x2_to_bf16x2<false>(lo), f8x2_to_bf16x2<true>(lo), f8x2_to_bf16x2<false>(hi), f8x2_to_bf16x2<true>(hi)}; }
__device__ __forceinline__ unsigned pack_fp8x4(float a, float b, float c, float d) { unsigned w = 0u; w = __builtin_amdgcn_cvt_pk_fp8_f32(a, b, w, false); w = __builtin_amdgcn_cvt_pk_fp8_f32(c, d, w, true); return w; }
__device__ __forceinline__ float sigmoidf_(float x) { return __builtin_amdgcn_rcpf(1.0f + __builtin_amdgcn_exp2f(-1.4426950408889634f * x)); }

namespace pg8 {
constexpr int BM = 256, BK = 64, HALF = 128, HTB = HALF * BK * 2, STAGE_BYTES = 8 * HTB, NXCD = 8, WGM = 8;
__host__ __device__ __forceinline__ int lds_byte(int r, int c) { const int st = (r >> 4) * 2 + (c >> 5), rr = r & 15, cc = c & 31, ob = rr * 64 + cc * 2; return st * 1024 + (ob ^ (((ob >> 9) & 1) << 5)); }
__host__ __device__ __forceinline__ void stage_rc(int b, int& R, int& C) { const int st = b / 1024, sb = b % 1024, swz = sb ^ (((sb >> 9) & 1) << 5); R = (st >> 1) * 16 + swz / 64; C = (st & 1) * 32 + (swz % 64) / 2; }
__host__ __device__ __forceinline__ int perm32(int rho) { const int n = rho >> 4, i = rho & 15; return 8 * (i >> 2) + 4 * n + (i & 3); }

struct Unit { int pm, pn, bt, rbase; };
struct Gemm { const bf16_t* A; const bf16_t* Bt; int K, lda, ldb; const int* rowidx; };

struct StaticOrder {
    int nM, nN, nwg, G, c, pbase, psplit, pjump;
    __device__ void init(int M, int N, int G_, int c_, int pbase_ = 0, int psplit_ = 1 << 20, int pjump_ = 0) { nM = M / BM; nN = N / BM; nwg = nM * nN; G = G_; c = c_; pbase = pbase_; psplit = psplit_; pjump = pjump_; }
    __device__ bool next(int i, Unit& u) const {
        const long L = (long)i * G + c; if (L >= nwg) return false;
        int wgid = (int)L; { const int q = nwg / NXCD, r = nwg % NXCD, xcd = wgid % NXCD, off = wgid / NXCD; wgid = (xcd < r ? xcd * (q + 1) : r * (q + 1) + (xcd - r) * q) + off; }
        const int nig = WGM * nN, gid = wgid / nig, fm = gid * WGM, gsz = (nM - fm) < WGM ? (nM - fm) : WGM;
        u.pm = fm + ((wgid % nig) % gsz); const int p = (wgid % nig) / gsz; u.pn = pbase + (p < psplit ? p : p + pjump); u.bt = u.pn; u.rbase = u.pm * BM; return true;
    }
};
struct MoeOrder {
    int nM, nN, nwg, G, c; const LAS int* tab;
    __device__ void init(const LAS int* tiletab, int nN_, int G_, int c_) { nM = tiletab[0]; tab = tiletab; nN = nN_; nwg = nM * nN; G = G_; c = c_; }
    __device__ bool next(int i, Unit& u) const {
        const long L = (long)i * G + c; if (L >= nwg) return false;
        int wgid = (int)L; { const int q = nwg / NXCD, r = nwg % NXCD, xcd = wgid % NXCD, off = wgid / NXCD; wgid = (xcd < r ? xcd * (q + 1) : r * (q + 1) + (xcd - r) * q) + off; }
        const int nig = WGM * nN, gid = wgid / nig, fm = gid * WGM, gsz = (nM - fm) < WGM ? (nM - fm) : WGM;
        u.pm = fm + ((wgid % nig) % gsz); u.pn = (wgid % nig) / gsz; { const int e = tab[128 + 2 * u.pm], tl = tab[129 + 2 * u.pm]; u.bt = e * nN + u.pn; u.rbase = e * T + tl * BM; } return true;
    }
};

typedef int v4i_t __attribute__((ext_vector_type(4)));
typedef int v8i_t __attribute__((ext_vector_type(8)));
template <class Epi, class Sched, bool ALIGN_EPI, bool FP8 = false, bool GATHER = false>
__device__ __forceinline__ void gemm_phase(LAS unsigned char* lds, const Gemm g, const Sched& S, const Epi& E, const int wid) {
    const int lane = lane_id_asm(), tid = wid * 64 + lane;
    const int wr = wid >> 2, wc = wid & 3, fr = lane & 15, fq = lane >> 4;
    const int nt = g.K / BK;
    unsigned voffA[2], voffB[2]; int gR[2];
#pragma unroll
    for (int i = 0; i < 2; ++i) { int R, C; stage_rc(tid * 16 + i * 8192, R, C); const int Rb = Epi::PERM ? ((R & ~31) + perm32(R & 31)) : R;
        voffA[i] = GATHER ? (unsigned)C * 2u : (unsigned)(R * g.lda + C) * 2u; voffB[i] = (unsigned)(Rb * g.ldb + C) * 2u; gR[i] = R; }
    const size_t kstep = (size_t)(BK * 2);
    const size_t hstepA = GATHER ? 0 : (size_t)HALF * g.lda * 2, hstepB = (size_t)HALF * g.ldb * 2;
    const size_t tstepA = 2 * hstepA, tstepB = 2 * hstepB;
    const unsigned ldsw = (unsigned)wid * 1024u;
    const int aoff = lds_byte(wr * 64 + fr, fq * 8), boff = lds_byte(wc * 32 + fr, fq * 8);
#define PG8_SA(b, h) (((b) * 2 + (h)) * HTB)
#define PG8_SB(b, h) ((4 + (b) * 2 + (h)) * HTB)
#define PG8_STAGE(bufoff, gbase, voff) do { _Pragma("unroll") for (int _i = 0; _i < 2; ++_i) \
        __builtin_amdgcn_global_load_lds((const unsigned*)((const char*)(gbase) + (voff)[_i]), (LAS unsigned*)(lds + (bufoff) + ldsw + _i * 8192), 16, 0, 0); } while (0)
#define PG8_LD8(p) __builtin_shufflevector(*(const LAS v4i_t*)(p), *(const LAS v4i_t*)((p) + 1024), 0, 1, 2, 3, 4, 5, 6, 7)
#define PG8_LDA(dst, b, h) do { _Pragma("unroll") for (int m = 0; m < 4; ++m) { if constexpr (FP8) dst##8[m] = PG8_LD8(lds + PG8_SA(b, h) + aoff + m * 2048); \
        else { _Pragma("unroll") for (int k = 0; k < 2; ++k) dst[m][k] = *(const LAS bf16x8*)(lds + PG8_SA(b, h) + aoff + m * 2048 + k * 1024); } } } while (0)
#define PG8_LDB(dst, b, h) do { _Pragma("unroll") for (int n = 0; n < 2; ++n) { if constexpr (FP8) dst##8[n] = PG8_LD8(lds + PG8_SB(b, h) + boff + n * 2048); \
        else { _Pragma("unroll") for (int k = 0; k < 2; ++k) dst[n][k] = *(const LAS bf16x8*)(lds + PG8_SB(b, h) + boff + n * 2048 + k * 1024); } } } while (0)
#define PG8_MMA(ai, bj, At, Bt) do { __builtin_amdgcn_s_setprio(1); _Pragma("unroll") for (int m = 0; m < 4; ++m) _Pragma("unroll") for (int n = 0; n < 2; ++n) { \
        if constexpr (FP8) { asm volatile("s_nop 1\n\tv_mfma_scale_f32_16x16x128_f8f6f4 %0, %1, %2, %0, %3, %3 op_sel_hi:[0,0,0]" : "+v"(acc[ai][bj][m][n]) : "v"(Bt##8[n]), "v"(At##8[m]), "v"(scl8)); } \
        else { _Pragma("unroll") for (int k = 0; k < 2; ++k) acc[ai][bj][m][n] = __builtin_amdgcn_mfma_f32_16x16x32_bf16(Bt[n][k], At[m][k], acc[ai][bj][m][n], 0, 0, 0); } } \
        __builtin_amdgcn_s_setprio(0); } while (0)
#define PG8_WAIT_V(n) asm volatile("s_waitcnt vmcnt(" #n ")" ::: "memory")
#define PG8_WAIT_L(n) asm volatile("s_waitcnt lgkmcnt(" #n ")" ::: "memory")
#define PG8_BAR __builtin_amdgcn_s_barrier()
#define PG8_SCHED __builtin_amdgcn_sched_barrier(0)
    Unit cur, nxt; int ui = 0;
    if (!S.next(0, cur)) return;
    unsigned va0[2], va1[2], vn0[2], vn1[2];
#define PG8_GIDX(dst0, dst1, u) do { if constexpr (GATHER) { _Pragma("unroll") for (int _i = 0; _i < 2; ++_i) { \
        dst0[_i] = min((unsigned)g.rowidx[(u).rbase + gR[_i]], (unsigned)(T - 1)) * (unsigned)(g.lda * 2) + voffA[_i]; dst1[_i] = min((unsigned)g.rowidx[(u).rbase + HALF + gR[_i]], (unsigned)(T - 1)) * (unsigned)(g.lda * 2) + voffA[_i]; } } \
        else { _Pragma("unroll") for (int _i = 0; _i < 2; ++_i) { dst0[_i] = voffA[_i]; dst1[_i] = voffA[_i]; } } } while (0)
    PG8_GIDX(va0, va1, cur);
    f32x4 acc[2][2][4][2];
#pragma unroll
    for (int a = 0; a < 2; ++a)
#pragma unroll
        for (int b = 0; b < 2; ++b)
#pragma unroll
            for (int m = 0; m < 4; ++m)
#pragma unroll
                for (int n = 0; n < 2; ++n) acc[a][b][m][n] = (f32x4){0.f, 0.f, 0.f, 0.f};
    bf16x8 At[4][2], B0[2][2], B1[2][2]; v8i_t At8[4], B08[2], B18[2];
    int scl8 = 0x7f7f7f7f; asm volatile("" : "+v"(scl8));
    const char* cA = (const char*)g.A + (GATHER ? 0 : (size_t)cur.pm * tstepA); const char* cB = (const char*)g.Bt + (size_t)cur.bt * tstepB;
    PG8_STAGE(PG8_SB(0, 0), cB, voffB); PG8_STAGE(PG8_SB(0, 1), cB + hstepB, voffB); PG8_STAGE(PG8_SA(0, 0), cA, va0); PG8_STAGE(PG8_SA(0, 1), cA + hstepA, va1);
    if (wr == 1) PG8_BAR;
    PG8_WAIT_V(2); PG8_BAR;
    PG8_STAGE(PG8_SB(1, 0), cB + kstep, voffB); PG8_STAGE(PG8_SA(1, 0), cA + kstep, va0); PG8_STAGE(PG8_SB(1, 1), cB + hstepB + kstep, voffB);
    PG8_WAIT_V(6); PG8_BAR;
    for (;;) {
        const bool has_next = S.next(ui + 1, nxt);
        const char* nA = (has_next && !GATHER) ? (const char*)g.A + (size_t)nxt.pm * tstepA : cA; const char* nB = has_next ? (const char*)g.Bt + (size_t)nxt.bt * tstepB : cB;
        if (has_next) PG8_GIDX(vn0, vn1, nxt); else { _Pragma("unroll") for (int _i = 0; _i < 2; ++_i) { vn0[_i] = va0[_i]; vn1[_i] = va1[_i]; } }
#pragma unroll 1
        for (int t = 0; t < nt; t += 2) {
            const bool last = (t == nt - 2);
            const char* a1 = cA + (size_t)(t + 1) * kstep;
            const char* a2 = last ? nA : cA + (size_t)(t + 2) * kstep; const char* b2 = last ? nB : cB + (size_t)(t + 2) * kstep;
            const char* a3 = a2 + kstep; const char* b3 = b2 + kstep;
            if constexpr (Epi::MID_T > 0) { if (t == Epi::MID_T) E.mid(acc, cur, wr, wc, fr, fq); }
            unsigned vs0[2], vs1[2];
#pragma unroll
            for (int _i = 0; _i < 2; ++_i) { vs0[_i] = last ? vn0[_i] : va0[_i]; vs1[_i] = last ? vn1[_i] : va1[_i]; }
            PG8_LDB(B0, 0, 0); PG8_LDB(B1, 0, 1); PG8_SCHED; PG8_LDA(At, 0, 0); PG8_STAGE(PG8_SA(1, 1), a1 + hstepA, va1);
            PG8_WAIT_V(8); PG8_WAIT_L(0); PG8_BAR; PG8_MMA(0, 0, At, B0); PG8_MMA(0, 1, At, B1); PG8_BAR; PG8_SCHED;
            PG8_LDA(At, 0, 1); PG8_STAGE(PG8_SB(0, 0), b2, voffB); PG8_STAGE(PG8_SB(0, 1), b2 + hstepB, voffB); PG8_STAGE(PG8_SA(0, 0), a2, vs0);
            PG8_WAIT_V(8); PG8_WAIT_L(0); PG8_BAR; PG8_MMA(1, 0, At, B0); PG8_MMA(1, 1, At, B1); PG8_BAR; PG8_SCHED;
            PG8_LDB(B0, 1, 0); PG8_LDB(B1, 1, 1); PG8_SCHED; PG8_LDA(At, 1, 0); PG8_STAGE(PG8_SA(0, 1), a2 + hstepA, vs1);
            PG8_WAIT_V(8); PG8_WAIT_L(0); PG8_BAR; PG8_MMA(0, 0, At, B0); PG8_MMA(0, 1, At, B1); PG8_BAR; PG8_SCHED;
            PG8_LDA(At, 1, 1); PG8_STAGE(PG8_SB(1, 0), b3, voffB); PG8_STAGE(PG8_SB(1, 1), b3 + hstepB, voffB); PG8_STAGE(PG8_SA(1, 0), a3, vs0);
            PG8_WAIT_V(8); PG8_WAIT_L(0); PG8_BAR; PG8_MMA(1, 0, At, B0); PG8_MMA(1, 1, At, B1); PG8_BAR; PG8_SCHED;
        }
        if constexpr (ALIGN_EPI) { if (wr == 0) PG8_BAR; }
        if constexpr (FP8) {
#pragma unroll
            for (int a = 0; a < 2; ++a)
#pragma unroll
                for (int b = 0; b < 2; ++b)
                    asm volatile("s_nop 15\n\ts_nop 7" : "+v"(acc[a][b][0][0]), "+v"(acc[a][b][0][1]), "+v"(acc[a][b][1][0]), "+v"(acc[a][b][1][1]), "+v"(acc[a][b][2][0]), "+v"(acc[a][b][2][1]), "+v"(acc[a][b][3][0]), "+v"(acc[a][b][3][1]));
        }
        E(acc, cur, wr, wc, fr, fq);
        if (!has_next) break;
#pragma unroll
        for (int a = 0; a < 2; ++a)
#pragma unroll
            for (int b = 0; b < 2; ++b)
#pragma unroll
                for (int m = 0; m < 4; ++m)
#pragma unroll
                    for (int n = 0; n < 2; ++n) acc[a][b][m][n] = (f32x4){0.f, 0.f, 0.f, 0.f};
        cur = nxt; cA = nA; cB = nB; ++ui;
#pragma unroll
        for (int _i = 0; _i < 2; ++_i) { va0[_i] = vn0[_i]; va1[_i] = vn1[_i]; }
        if constexpr (ALIGN_EPI) { if (wr == 1) PG8_BAR; }
    }
    PG8_WAIT_V(0);
    if constexpr (!ALIGN_EPI) { if (wr == 0) PG8_BAR; }
    PG8_BAR;
#undef PG8_SA
#undef PG8_SB
#undef PG8_STAGE
#undef PG8_GIDX
#undef PG8_LDA
#undef PG8_LDB
#undef PG8_MMA
#undef PG8_LD8
#undef PG8_WAIT_V
#undef PG8_WAIT_L
#undef PG8_BAR
#undef PG8_SCHED
}

typedef f32x4 Acc[2][2][4][2];

__device__ __forceinline__ u32x4 pair16(u32x2 x, u32x2 y) {
    const auto r0 = __builtin_amdgcn_permlane16_swap(x.x, y.x, false, false);
    const auto r1 = __builtin_amdgcn_permlane16_swap(x.y, y.y, false, false);
    return (u32x4){r0[0], r1[0], r0[1], r1[1]};
}
struct Epi1 {
    static constexpr bool PERM = true; static constexpr int MID_T = 0;
    bf16_t *yab, *gv; unsigned char *q, *k, *v; bf16_t *sa, *sb; float* gvst; float* kmp; float sc, pad_;
    template <int MODE  >
    __device__ __forceinline__ void run(const Acc& acc, const Unit& u, int wr, int wc, int fr, int fq, bf16_t* base, int ld) const {
        const int row0 = u.pm * BM + wr * 64 + fr, col0 = (u.pn & 3) * 256 + wc * 32 + 8 * fq;
        const int colp = (u.pn & 3) * 256 + wc * 32 + 8 * (fq & ~1);
        f32x4 csA0 = {0.f, 0.f, 0.f, 0.f}, csB0 = csA0, csA1 = csA0, csB1 = csA0;
#pragma unroll
        for (int ai = 0; ai < 2; ++ai)
#pragma unroll
            for (int mp = 0; mp < 2; ++mp) {
                u32x2 pc[2][2];
#pragma unroll
                for (int k = 0; k < 2; ++k) {
                    const int m = 2 * mp + k;
                    const int row = row0 + ai * HALF + m * 16; bf16_t* rowp = base + (size_t)row * ld + col0;
                    float s1 = 0.f, s2 = 0.f;
#pragma unroll
                    for (int bj = 0; bj < 2; ++bj) {
                        f32x4 v0 = acc[ai][bj][m][0], v1 = acc[ai][bj][m][1];
                        if (MODE == 2 || MODE == 3 || MODE == 5) {
                            const float f = (MODE == 2) ? sc * QSCALE : sc; v0 = v0 * f; v1 = v1 * f;
                            if (MODE == 5) { if (bj == 0) { csA0 = csA0 + v0; csB0 = csB0 + v1; } else { csA1 = csA1 + v0; csB1 = csB1 + v1; } }
                            pc[bj][k] = (u32x2){pack_fp8x4(v0[0], v0[1], v0[2], v0[3]), pack_fp8x4(v1[0], v1[1], v1[2], v1[3])};
                            continue;
                        }
                        if (MODE == 0 || MODE == 1) {
                            f32x2 a = gelu_pk((f32x2){v0[0], v0[1]}), b = gelu_pk((f32x2){v0[2], v0[3]}), c = gelu_pk((f32x2){v1[0], v1[1]}), d = gelu_pk((f32x2){v1[2], v1[3]});
                            v0 = (f32x4){a.x, a.y, b.x, b.y}; v1 = (f32x4){c.x, c.y, d.x, d.y};
                        } else if (MODE == 4) {
                            { const float cs_ = -1.4426950408889634f * sc; const f32x4 t0 = v0 * cs_, t1 = v1 * cs_; f32x4 e0, e1;
#pragma unroll
                              for (int j = 0; j < 4; ++j) { e0[j] = __builtin_amdgcn_exp2f(t0[j]); e1[j] = __builtin_amdgcn_exp2f(t1[j]); }
                              e0 = e0 + 1.0f; e1 = e1 + 1.0f;
#pragma unroll
                              for (int j = 0; j < 4; ++j) { v0[j] = __builtin_amdgcn_rcpf(e0[j]); v1[j] = __builtin_amdgcn_rcpf(e1[j]); } }
                            pc[bj][k] = (u32x2){pack_fp8x4(v0[0], v0[1], v0[2], v0[3]), pack_fp8x4(v1[0], v1[1], v1[2], v1[3])};
                            continue;
                        }
                        if (MODE == 1) {
                            s1 += (v0[0] + v0[1]) + (v0[2] + v0[3]) + (v1[0] + v1[1]) + (v1[2] + v1[3]);
                            s2 += (v0[0] * v0[0] + v0[1] * v0[1]) + (v0[2] * v0[2] + v0[3] * v0[3]) + (v1[0] * v1[0] + v1[1] * v1[1]) + (v1[2] * v1[2] + v1[3] * v1[3]);
                            pc[bj][k] = (u32x2){pack_fp8x4(v0[0], v0[1], v0[2], v0[3]), pack_fp8x4(v1[0], v1[1], v1[2], v1[3])};
                            continue;
                        }
                        u32x4 w; w.x = cvt_pk_bf16(v0[0], v0[1]); w.y = cvt_pk_bf16(v0[2], v0[3]); w.z = cvt_pk_bf16(v1[0], v1[1]); w.w = cvt_pk_bf16(v1[2], v1[3]);
                        *(u32x4*)(rowp + bj * HALF) = w;
                    }
                    if (MODE == 1) {
                        s1 += __shfl_xor(s1, 16); s1 += __shfl_xor(s1, 32); s2 += __shfl_xor(s2, 16); s2 += __shfl_xor(s2, 32);
                        if (fq == 0) *(f32x2*)(gvst + ((size_t)row * 16 + (u.pn & 3) * 4 + wc) * 2) = (f32x2){s1, s2};
                    }
                }
                if (MODE != 0) {
                    const int rowst = row0 + ai * HALF + (2 * mp + (fq & 1)) * 16;
#pragma unroll
                    for (int bj = 0; bj < 2; ++bj) *(u32x4*)((unsigned char*)base + (size_t)rowst * 1024 + colp + bj * HALF) = pair16(pc[bj][0], pc[bj][1]);
                }
            }
        if (MODE == 5) {
#define KM_RED(v) do { _Pragma("unroll") for (int j_ = 0; j_ < 4; ++j_) { float x = v[j_]; x += __shfl_xor(x, 1); x += __shfl_xor(x, 2); x += __shfl_xor(x, 4); x += __shfl_xor(x, 8); v[j_] = x; } } while (0)
            KM_RED(csA0); KM_RED(csB0); KM_RED(csA1); KM_RED(csB1);
#undef KM_RED
            if (fr == 0) {
                float* kp = kmp + ((size_t)(u.pm * 2 + wr) * DM) + col0;
                *(f32x4*)kp = csA0; *(f32x4*)(kp + 4) = csB0; *(f32x4*)(kp + HALF) = csA1; *(f32x4*)(kp + HALF + 4) = csB1;
            }
        }
    }
    __device__ __forceinline__ void operator()(const Acc& acc, const Unit& u, int wr, int wc, int fr, int fq) const {
        const int region = u.pn >> 2;
        if (region == 0) run<0>(acc, u, wr, wc, fr, fq, yab, 2048);
        else if (region == 1) run<1>(acc, u, wr, wc, fr, fq, gv, 1024);
        else if (region == 2) run<2>(acc, u, wr, wc, fr, fq, (bf16_t*)q, 1024);
        else if (region == 3) run<5>(acc, u, wr, wc, fr, fq, (bf16_t*)k, 1024);
        else if (region == 4) run<3>(acc, u, wr, wc, fr, fq, (bf16_t*)v, 1024);
        else if (region == 5) run<4>(acc, u, wr, wc, fr, fq, sa, 1024);
        else run<4>(acc, u, wr, wc, fr, fq, sb, 1024);
    }
    __device__ __forceinline__ void mid(Acc&, const Unit&, int, int, int, int) const {}
};

struct Epi2 {
    static constexpr bool PERM = true; static constexpr int MID_T = 16;
    const unsigned char *sa, *sb; bf16_t* mg;
    __device__ __forceinline__ void mid(Acc& acc, const Unit& u, int wr, int wc, int fr, int fq) const {
        int row0 = u.pm * BM + wr * 64 + fr, col0 = u.pn * BM + wc * 32 + 8 * fq;
        asm volatile("" : "+v"(row0), "+v"(col0));
#pragma unroll
        for (int ai = 0; ai < 2; ++ai)
#pragma unroll
            for (int m = 0; m < 4; ++m) {
                const size_t off = (size_t)(row0 + ai * HALF + m * 16) * DM + col0;
#pragma unroll
                for (int bj = 0; bj < 2; ++bj) {
                    const u32x2 a = *(const u32x2*)(sa + off + bj * HALF), b = *(const u32x2*)(sb + off + bj * HALF);
                    const f32x2v a0 = __builtin_amdgcn_cvt_pk_f32_fp8((int)a.x, false), a1 = __builtin_amdgcn_cvt_pk_f32_fp8((int)a.x, true), a2 = __builtin_amdgcn_cvt_pk_f32_fp8((int)a.y, false), a3 = __builtin_amdgcn_cvt_pk_f32_fp8((int)a.y, true);
                    const f32x2v b0 = __builtin_amdgcn_cvt_pk_f32_fp8((int)b.x, false), b1 = __builtin_amdgcn_cvt_pk_f32_fp8((int)b.x, true), b2 = __builtin_amdgcn_cvt_pk_f32_fp8((int)b.y, false), b3 = __builtin_amdgcn_cvt_pk_f32_fp8((int)b.y, true);
                    f32x4 r0, r1;
#define RQ(x, y) ((x) * __builtin_amdgcn_rcpf(y))
                    r0[0] = RQ(a0.x, b0.x); r0[1] = RQ(a0.y, b0.y); r0[2] = RQ(a1.x, b1.x); r0[3] = RQ(a1.y, b1.y);
                    r1[0] = RQ(a2.x, b2.x); r1[1] = RQ(a2.y, b2.y); r1[2] = RQ(a3.x, b3.x); r1[3] = RQ(a3.y, b3.y);
#undef RQ
                    acc[ai][bj][m][0] = acc[ai][bj][m][0] * r0; acc[ai][bj][m][1] = acc[ai][bj][m][1] * r1;
                }
                asm volatile("" : "+v"(acc[ai][0][m][0]), "+v"(acc[ai][0][m][1]), "+v"(acc[ai][1][m][0]), "+v"(acc[ai][1][m][1]));
                asm volatile("" ::: "memory");
            }
    }
    __device__ __forceinline__ void operator()(const Acc& acc, const Unit& u, int wr, int wc, int fr, int fq) const {
        const int row0 = u.pm * BM + wr * 64 + fr, col0 = u.pn * BM + wc * 32 + 8 * fq;
#pragma unroll
        for (int ai = 0; ai < 2; ++ai)
#pragma unroll
            for (int m = 0; m < 4; ++m) {
                const size_t off = (size_t)(row0 + ai * HALF + m * 16) * DM + col0;
#pragma unroll
                for (int bj = 0; bj < 2; ++bj) {
                    const u32x2 b = *(const u32x2*)(sb + off + bj * HALF);
                    const f32x2v b0 = __builtin_amdgcn_cvt_pk_f32_fp8((int)b.x, false), b1 = __builtin_amdgcn_cvt_pk_f32_fp8((int)b.x, true), b2 = __builtin_amdgcn_cvt_pk_f32_fp8((int)b.y, false), b3 = __builtin_amdgcn_cvt_pk_f32_fp8((int)b.y, true);
                    const f32x4 v0 = acc[ai][bj][m][0], v1 = acc[ai][bj][m][1];
                    u32x4 w; w.x = cvt_pk_bf16(v0[0] * b0.x, v0[1] * b0.y); w.y = cvt_pk_bf16(v0[2] * b1.x, v0[3] * b1.y);
                    w.z = cvt_pk_bf16(v1[0] * b2.x, v1[1] * b2.y); w.w = cvt_pk_bf16(v1[2] * b3.x, v1[3] * b3.y);
                    *(u32x4*)(mg + off + bj * HALF) = w;
                }
            }
    }
};

struct Epi3 {
    static constexpr bool PERM = true; static constexpr int MID_T = 0;
    const bf16_t* h0; bf16_t* z; float* zst;
    __device__ __forceinline__ void mid(Acc&, const Unit&, int, int, int, int) const {}
    __device__ __forceinline__ void operator()(const Acc& acc, const Unit& u, int wr, int wc, int fr, int fq) const {
        const int row0 = u.pm * BM + wr * 64 + fr, col0 = u.pn * BM + wc * 32 + 8 * fq;
#pragma unroll
        for (int ai = 0; ai < 2; ++ai)
#pragma unroll
            for (int m = 0; m < 4; ++m) {
                const int row = row0 + ai * HALF + m * 16; const size_t off = (size_t)row * DM + col0;
                float s1 = 0.f, s2 = 0.f;
#pragma unroll
                for (int bj = 0; bj < 2; ++bj) {
                    const u32x4 hb = *(const u32x4*)(h0 + off + bj * HALF);
                    f32x4 v0 = acc[ai][bj][m][0], v1 = acc[ai][bj][m][1];
                    v0[0] += ALPHA * bflo(hb.x); v0[1] += ALPHA * bfhi(hb.x); v0[2] += ALPHA * bflo(hb.y); v0[3] += ALPHA * bfhi(hb.y);
                    v1[0] += ALPHA * bflo(hb.z); v1[1] += ALPHA * bfhi(hb.z); v1[2] += ALPHA * bflo(hb.w); v1[3] += ALPHA * bfhi(hb.w);
                    s1 += ((v0[0] + v0[1]) + (v0[2] + v0[3])) + ((v1[0] + v1[1]) + (v1[2] + v1[3]));
                    s2 += ((v0[0] * v0[0] + v0[1] * v0[1]) + (v0[2] * v0[2] + v0[3] * v0[3])) + ((v1[0] * v1[0] + v1[1] * v1[1]) + (v1[2] * v1[2] + v1[3] * v1[3]));
                    *(u32x4*)(z + off + bj * HALF) = (u32x4){cvt_pk_bf16(v0[0], v0[1]), cvt_pk_bf16(v0[2], v0[3]), cvt_pk_bf16(v1[0], v1[1]), cvt_pk_bf16(v1[2], v1[3])};
                }
                s1 += __shfl_xor(s1, 16); s1 += __shfl_xor(s1, 32); s2 += __shfl_xor(s2, 16); s2 += __shfl_xor(s2, 32);
                if (fq == 0) *(f32x2*)(zst + ((size_t)row * 16 + u.pn * 4 + wc) * 2) = (f32x2){s1, s2};
            }
    }
};

struct Epi4 {
    static constexpr bool PERM = true; static constexpr int MID_T = 0;
    const float* b_up; unsigned char* act;
    __device__ __forceinline__ void mid(Acc&, const Unit&, int, int, int, int) const {}
    __device__ __forceinline__ void operator()(const Acc& acc, const Unit& u, int wr, int wc, int fr, int fq) const {
        const int e = u.bt >> 3;
        const int row0 = u.pm * BM + wr * 64 + fr, c0 = u.pn * HALF + wc * 32 + 8 * fq;
        const float* bg = b_up + (size_t)e * 2 * FF + c0; const float* bu = bg + FF;
        const f32x4 bg0 = *(const f32x4*)bg, bg1 = *(const f32x4*)(bg + 4), bu0 = *(const f32x4*)bu, bu1 = *(const f32x4*)(bu + 4);
        const int cp = u.pn * HALF + wc * 32 + 8 * (fq & ~1);
#pragma unroll
        for (int ai = 0; ai < 2; ++ai)
#pragma unroll
            for (int mp = 0; mp < 2; ++mp) {
                u32x2 pc[2];
#pragma unroll
                for (int k = 0; k < 2; ++k) {
                    const int m = 2 * mp + k;
                    float o[8];
#pragma unroll
                    for (int n = 0; n < 2; ++n)
#pragma unroll
                        for (int jp = 0; jp < 2; ++jp) {
                            const int j = 2 * jp;
                            const f32x2 ag = {acc[ai][0][m][n][j], acc[ai][0][m][n][j + 1]}, au = {acc[ai][1][m][n][j], acc[ai][1][m][n][j + 1]};
                            const f32x2 vbg = n ? (f32x2){bg1[j], bg1[j + 1]} : (f32x2){bg0[j], bg0[j + 1]}, vbu = n ? (f32x2){bu1[j], bu1[j + 1]} : (f32x2){bu0[j], bu0[j + 1]};
                            f32x2 gg = ag * 0.03125f + vbg, uu = au * 0.03125f + vbu;
                            gg.x = fminf(gg.x, 7.0f); gg.y = fminf(gg.y, 7.0f);
                            uu.x = __builtin_amdgcn_fmed3f(uu.x, -7.0f, 7.0f); uu.y = __builtin_amdgcn_fmed3f(uu.y, -7.0f, 7.0f);
                            const f32x2 t = gg * (-1.702f * 1.4426950408889634f);
                            f32x2 ex; ex.x = __builtin_amdgcn_exp2f(t.x); ex.y = __builtin_amdgcn_exp2f(t.y);
                            const f32x2 d = ex + 1.0f;
                            f32x2 rc; rc.x = __builtin_amdgcn_rcpf(d.x); rc.y = __builtin_amdgcn_rcpf(d.y);
                            const f32x2 res = (uu + 1.0f) * (gg * rc);
                            o[n * 4 + j] = res.x; o[n * 4 + j + 1] = res.y;
                        }
                    unsigned w0 = 0u, w1 = 0u;
                    w0 = __builtin_amdgcn_cvt_pk_fp8_f32(o[0], o[1], w0, false); w0 = __builtin_amdgcn_cvt_pk_fp8_f32(o[2], o[3], w0, true);
                    w1 = __builtin_amdgcn_cvt_pk_fp8_f32(o[4], o[5], w1, false); w1 = __builtin_amdgcn_cvt_pk_fp8_f32(o[6], o[7], w1, true);
                    pc[k] = (u32x2){w0, w1};
                }
                const int rowst = row0 + ai * HALF + (2 * mp + (fq & 1)) * 16;
                *(u32x4*)(act + (size_t)rowst * FF + cp) = pair16(pc[0], pc[1]);
            }
    }
};

struct Epi5 {
    static constexpr bool PERM = true; static constexpr int MID_T = 0;
    const float* b_down; const float* roww; unsigned char* ys;
    __device__ __forceinline__ void mid(Acc&, const Unit&, int, int, int, int) const {}
    __device__ __forceinline__ void operator()(const Acc& acc, const Unit& u, int wr, int wc, int fr, int fq) const {
        const int e = u.bt >> 2;
        const int row0 = u.pm * BM + wr * 64 + fr, col0 = u.pn * BM + wc * 32 + 8 * fq;
        f32x4 bv[2][2];
#pragma unroll
        for (int bj = 0; bj < 2; ++bj)
#pragma unroll
            for (int n = 0; n < 2; ++n) bv[bj][n] = *(const f32x4*)(b_down + (size_t)e * DM + col0 + bj * HALF + 4 * n);
        float rwv[2][4];
#pragma unroll
        for (int ai = 0; ai < 2; ++ai)
#pragma unroll
            for (int m = 0; m < 4; ++m) rwv[ai][m] = roww[u.rbase + wr * 64 + fr + ai * HALF + m * 16];
        asm volatile("" ::: "memory");
        const int colp = u.pn * BM + wc * 32 + 8 * (fq & ~1);
#pragma unroll
        for (int ai = 0; ai < 2; ++ai)
#pragma unroll
            for (int mp = 0; mp < 2; ++mp) {
                const int rowst = row0 + ai * HALF + (2 * mp + (fq & 1)) * 16;
#pragma unroll
                for (int bj = 0; bj < 2; ++bj) {
                    u32x2 pc[2];
#pragma unroll
                    for (int k = 0; k < 2; ++k) { const int m = 2 * mp + k; const float rw16 = rwv[ai][m] * 16.0f;
                        const f32x4 v0 = (acc[ai][bj][m][0] * 0.015625f + bv[bj][0]) * rw16, v1 = (acc[ai][bj][m][1] * 0.015625f + bv[bj][1]) * rw16;
                        pc[k] = (u32x2){pack_fp8x4(v0[0], v0[1], v0[2], v0[3]), pack_fp8x4(v1[0], v1[1], v1[2], v1[3])}; }
                    *(u32x4*)(ys + (size_t)rowst * DM + colp + bj * HALF) = pair16(pc[0], pc[1]);
                }
            }
    }
};
}

struct Args { const float* in[21]; float* out; unsigned char* ws; int ph_lo, ph_hi; };
enum { I_X = 0, I_LNIN_G, I_LNIN_B, I_WIN, I_GLN_G, I_GLN_B, I_WSP, I_BSP, I_WBA, I_WBB, I_WOUT, I_LNMIX_G, I_LNMIX_B, I_WR, I_BR, I_WUP, I_BUP, I_WDN, I_BDN, I_LNF_G, I_LNF_B };

struct Ctx { const Args* a; unsigned char* ws; LAS unsigned char* lds; unsigned char* ldsg; int tid, lane, wave, G, vcu; };

__device__ __forceinline__ void tr_item(const float* W, int N, int k0, int n0, bf16_t* dst, int drow0, int dld, int dcol0, LAS float* scr, int lane) {
#pragma unroll 8
    for (int i = 0; i < 32; ++i) { const int kk = 2 * i + (lane >> 5); scr[kk * 33 + (lane & 31)] = __builtin_nontemporal_load(W + (size_t)(k0 + kk) * N + n0 + (lane & 31)); }
    asm volatile("s_waitcnt lgkmcnt(0)" ::: "memory");
    const int c = lane & 7;
#pragma unroll
    for (int j = 0; j < 4; ++j) { const int n = (lane >> 3) + 8 * j; const LAS float* s = scr + (8 * c) * 33 + n;
        u32x4 o; o.x = pk2(s[0 * 33], s[1 * 33]); o.y = pk2(s[2 * 33], s[3 * 33]); o.z = pk2(s[4 * 33], s[5 * 33]); o.w = pk2(s[6 * 33], s[7 * 33]);
        *(u32x4*)(dst + (size_t)(drow0 + n) * dld + dcol0 + k0 + 8 * c) = o; }
    asm volatile("s_waitcnt lgkmcnt(0)" ::: "memory");
}
template <bool DEEP = false>
__device__ __forceinline__ void tr_item8(const float* W, int N, int k0, int n0, unsigned char* dst, int drow0, int dld, float sc, LAS float* scr, int lane) {
    if constexpr (DEEP) {
        float v[32];
#pragma unroll
        for (int i = 0; i < 32; ++i) v[i] = __builtin_nontemporal_load(W + (size_t)(k0 + 2 * i + (lane >> 5)) * N + n0 + (lane & 31));
#pragma unroll
        for (int i = 0; i < 32; ++i) scr[(2 * i + (lane >> 5)) * 33 + (lane & 31)] = v[i];
    } else {
#pragma unroll 8
        for (int i = 0; i < 32; ++i) { const int kk = 2 * i + (lane >> 5); scr[kk * 33 + (lane & 31)] = __builtin_nontemporal_load(W + (size_t)(k0 + kk) * N + n0 + (lane & 31)); }
    }
    asm volatile("s_waitcnt lgkmcnt(0)" ::: "memory");
    const int c = lane & 7;
#pragma unroll
    for (int j = 0; j < 4; ++j) { const int n = (lane >> 3) + 8 * j; const LAS float* s = scr + (8 * c) * 33 + n;
        unsigned w0 = 0u, w1 = 0u;
        w0 = __builtin_amdgcn_cvt_pk_fp8_f32(s[0 * 33] * sc, s[1 * 33] * sc, w0, false); w0 = __builtin_amdgcn_cvt_pk_fp8_f32(s[2 * 33] * sc, s[3 * 33] * sc, w0, true);
        w1 = __builtin_amdgcn_cvt_pk_fp8_f32(s[4 * 33] * sc, s[5 * 33] * sc, w1, false); w1 = __builtin_amdgcn_cvt_pk_fp8_f32(s[6 * 33] * sc, s[7 * 33] * sc, w1, true);
        *(u32x2*)(dst + (size_t)(drow0 + n) * dld + k0 + 8 * c) = (u32x2){w0, w1}; }
    asm volatile("s_waitcnt lgkmcnt(0)" ::: "memory");
}
__device__ __forceinline__ void ph_prologue(const Ctx& F) {
    const Args& A = *F.a;
    LAS float* scr = (LAS float*)(F.lds + F.wave * 16384);
    const int gw = F.vcu * 8 + F.wave, NGW = F.G * 8;
    bf16_t* WIN = (bf16_t*)(F.ws + WS_WIN); bf16_t* WAB = (bf16_t*)(F.ws + WS_WAB); bf16_t* WOUT = (bf16_t*)(F.ws + WS_WOUT);
    constexpr int I_IN = 16 * (INCOLS / 32), I_SQ = 16 * 32;
    constexpr int NITEMS = I_IN + 3 * I_SQ;
    for (int it = gw; it < NITEMS; it += NGW) {
        int r = it;
        if (r < I_IN) { const int nblk = INCOLS / 32, kb = r / nblk, nb = r % nblk;
            if (32 * nb >= PN8_LO * 256 && 32 * nb < PN8_HI * 256) tr_item8(A.in[I_WIN], INCOLS, 64 * kb, 32 * nb, F.ws + WS_WIN8, 32 * nb, DM, 32.0f, scr, F.lane);
            else tr_item(A.in[I_WIN], INCOLS, 64 * kb, 32 * nb, WIN, 32 * nb, DM, 0, scr, F.lane);
            continue; } r -= I_IN;
        if (r < I_SQ) { const int kb = r / 32, nb = r % 32; tr_item(A.in[I_WBA], DM, 64 * kb, 32 * nb, WAB, 32 * nb, 2048, 0, scr, F.lane); continue; } r -= I_SQ;
        if (r < I_SQ) { const int kb = r / 32, nb = r % 32; tr_item(A.in[I_WBB], DM, 64 * kb, 32 * nb, WAB, 32 * nb, 2048, 1024, scr, F.lane); continue; } r -= I_SQ;
        { const int kb = r / 32, nb = r % 32; tr_item(A.in[I_WOUT], DM, 64 * kb, 32 * nb, WOUT, 32 * nb, DM, 0, scr, F.lane); }
    }
    const float* lg = A.in[I_LNIN_G]; const float* lb = A.in[I_LNIN_B]; bf16_t* H0 = (bf16_t*)(F.ws + WS_H0);
    f32x4 gg[4], bb[4];
#pragma unroll
    for (int j = 0; j < 4; ++j) { gg[j] = *((const f32x4*)lg + F.lane + 64 * j); bb[j] = *((const f32x4*)lb + F.lane + 64 * j); }
    for (int m = gw; m < T; m += NGW) {
        const f32x4* xr = (const f32x4*)(A.in[I_X] + (size_t)m * DM) + F.lane;
        f32x4 v[4]; float s = 0.f;
#pragma unroll
        for (int j = 0; j < 4; ++j) { v[j] = __builtin_nontemporal_load(xr + 64 * j); s += (v[j].x + v[j].y) + (v[j].z + v[j].w); }
        const float mean = wave_sum(s) * (1.f / DM); float s2 = 0.f;
#pragma unroll
        for (int j = 0; j < 4; ++j) { v[j] = v[j] - mean; s2 += (v[j].x * v[j].x + v[j].y * v[j].y) + (v[j].z * v[j].z + v[j].w * v[j].w); }
        const float rstd = 1.f / sqrtf(wave_sum(s2) * (1.f / DM) + LN_EPS);
        u32x2* o8 = (u32x2*)(H0 + (size_t)m * DM) + F.lane; unsigned* o4 = (unsigned*)(F.ws + WS_H0F8 + (size_t)m * DM) + F.lane;
#pragma unroll
        for (int j = 0; j < 4; ++j) { const f32x4 y = v[j] * rstd * gg[j] + bb[j]; o8[64 * j] = (u32x2){pk2(y.x, y.y), pk2(y.z, y.w)}; o4[64 * j] = pack_fp8x4(y.x, y.y, y.z, y.w); }
    }
}

struct WItem { const float* src; unsigned char* dst; int N, dld; float sc; };
__device__ __forceinline__ void w_load(const WItem& w, float (&v)[64], int lane) {
    const float* src = w.src + (size_t)(lane >> 5) * w.N + (lane & 31);
#pragma unroll
    for (int i = 0; i < 64; ++i) v[i] = __builtin_nontemporal_load(src + (size_t)(2 * i) * w.N);
}
__device__ __forceinline__ void w_scatter(const float (&v)[64], LAS float* scr, int lane) {
    LAS float* d = scr + (lane & 31) * 130 + (lane >> 5);
#pragma unroll
    for (int i = 0; i < 64; ++i) d[2 * i] = v[i];
}
__device__ __forceinline__ void w_emit(const WItem& w, LAS const float* scr, int lane) {
    asm volatile("s_waitcnt lgkmcnt(0)" ::: "memory");
    const int c = lane & 7; const float sc = w.sc;
#pragma unroll
    for (int j = 0; j < 4; ++j) {
        const int nn = (lane >> 3) + 8 * j; const LAS float* sp = scr + nn * 130 + 16 * c;
        f32x2 a[8];
#pragma unroll
        for (int q = 0; q < 8; ++q) a[q] = *(LAS const f32x2*)(sp + 2 * q);
        u32x4 o;
        o.x = pack_fp8x4(a[0].x * sc, a[0].y * sc, a[1].x * sc, a[1].y * sc); o.y = pack_fp8x4(a[2].x * sc, a[2].y * sc, a[3].x * sc, a[3].y * sc);
        o.z = pack_fp8x4(a[4].x * sc, a[4].y * sc, a[5].x * sc, a[5].y * sc); o.w = pack_fp8x4(a[6].x * sc, a[6].y * sc, a[7].x * sc, a[7].y * sc);
        *(u32x4*)(w.dst + (size_t)nn * w.dld + 16 * c) = o;
    }
    asm volatile("s_waitcnt lgkmcnt(0)" ::: "memory");
}
__device__ __forceinline__ WItem w_decode(const Ctx& F, int r) {
    const Args& A = *F.a;
    constexpr int I_UP = NE * 8 * 64;
    WItem w;
    if (r < I_UP) { const int e = r / (8 * 64), rr = r % (8 * 64), kb = rr / 64, nb = rr % 64; const int n0 = 32 * nb, half = n0 >= FF, rem = n0 - half * FF, pn = rem >> 7, b = (rem & 127) >> 5;
        w.src = A.in[I_WUP] + (size_t)e * DM * 2 * FF + (size_t)(128 * kb) * (2 * FF) + n0; w.N = 2 * FF; w.dst = F.ws + WS_WUP + (size_t)(e * 2048 + 256 * pn + half * 128 + 32 * b) * DM + 128 * kb; w.dld = DM; w.sc = 32.0f; }
    else { r -= I_UP; const int e = r / (8 * 32), rr = r % (8 * 32), kb = rr / 32, nb = rr % 32;
        w.src = A.in[I_WDN] + (size_t)e * FF * DM + (size_t)(128 * kb) * DM + 32 * nb; w.N = DM; w.dst = F.ws + WS_WDN + (size_t)(e * 1024 + 32 * nb) * FF + 128 * kb; w.dld = FF; w.sc = 64.0f; }
    return w;
}
__device__ __forceinline__ void ph_wconv(const Ctx& F) {
    LAS float* scr = (LAS float*)(F.lds + F.wave * 16640);
    constexpr int NIT = NE * 8 * 64 + NE * 8 * 32;
    const int chunk = (NIT + F.G - 1) / F.G, lo = (int)blockIdx.x * chunk, hi = (lo + chunk < NIT) ? lo + chunk : NIT;
    __syncthreads();
    int it = lo + F.wave;
    if (it < hi) {
        float v[64];
        WItem cur = w_decode(F, it);
        w_load(cur, v, F.lane);
        for (;;) {
            w_scatter(v, scr, F.lane);
            const int itn = it + 8; const bool more = itn < hi;
            WItem nxt = cur;
            if (more) { nxt = w_decode(F, itn); w_load(nxt, v, F.lane); }
            w_emit(cur, scr, F.lane);
            if (!more) break;
            cur = nxt; it = itn;
        }
    }
    asm volatile("s_waitcnt vmcnt(0)" ::: "memory");
    __syncthreads();
}

typedef short v4i16_t __attribute__((ext_vector_type(4)));
__device__ __forceinline__ v4i16_t lds_tr16(LAS const unsigned char* p) { return __builtin_amdgcn_ds_read_tr16_b64_v4i16((LAS v4i16_t*)p); }
__device__ __forceinline__ void ph_mixer_a(const Ctx& F) {
    const Args& A = *F.a;
    const unsigned char* GV = F.ws + WS_GV; bf16_t* YAB = (bf16_t*)(F.ws + WS_YAB); const float* GVST = (const float*)(F.ws + WS_GVST);
    const float* lg = A.in[I_GLN_G]; const float* lb = A.in[I_GLN_B]; const float* wsp = A.in[I_WSP]; const float* bsp = A.in[I_BSP];
    constexpr int RSV = 544, RSW = 272, OFF_W = 128 * RSV, OFF_ST = OFF_W + 128 * RSW;
    LAS unsigned char* VT = F.lds; LAS unsigned char* WT = F.lds + OFF_W; LAS float* ST = (LAS float*)(F.lds + OFF_ST);
    const int lane = F.lane, wv = F.wave;
    int curg = -1;
    for (int it = F.vcu; it < NB * 32 * 4; it += F.G) {
        const int b = it / 128, c = (it >> 2) & 31, g = it & 3;
        const int tok0 = b * SEQ + c * 128;
        if (g != curg) {
            curg = g;
            for (int k = 0; k < 4; ++k) {
                const int idx = F.tid + 512 * k, t = idx >> 4, s8 = (idx & 15) * 8;
                const f32x4 w0 = *(const f32x4*)(wsp + ((size_t)g * 128 + t) * 128 + s8), w1 = *(const f32x4*)(wsp + ((size_t)g * 128 + t) * 128 + s8 + 4);
                float x[8] = {w0.x, w0.y, w0.z, w0.w, w1.x, w1.y, w1.z, w1.w};
#pragma unroll
                for (int j = 0; j < 8; ++j) x[j] = (s8 + j <= t) ? x[j] : 0.f;
                u32x4 o; o.x = pk2(x[0], x[1]); o.y = pk2(x[2], x[3]); o.z = pk2(x[4], x[5]); o.w = pk2(x[6], x[7]);
                *(LAS u32x4*)(WT + t * RSW + s8 * 2) = o;
            }
        }
        if (F.tid < 128) {
            const float* p = GVST + (size_t)(tok0 + F.tid) * 32; float s1 = 0.f, s2 = 0.f;
            for (int i = 0; i < 16; ++i) { s1 += p[2 * i]; s2 += p[2 * i + 1]; }
            const float mean = s1 * (1.f / DM), var = s2 * (1.f / DM) - mean * mean;
            ST[2 * F.tid] = mean; ST[2 * F.tid + 1] = 1.f / sqrtf(fmaxf(var, 0.f) + LN_EPS);
        }
        __syncthreads();
        {
            const int dc = F.tid & 31;
            const f32x4 g0 = *(const f32x4*)(lg + g * 256 + dc * 8), g1 = *(const f32x4*)(lg + g * 256 + dc * 8 + 4), b0 = *(const f32x4*)(lb + g * 256 + dc * 8), b1 = *(const f32x4*)(lb + g * 256 + dc * 8 + 4);
#pragma unroll
            for (int k = 0; k < 8; ++k) {
                const int s = (F.tid >> 5) + 16 * k;
                const u32x2 raw = *(const u32x2*)(GV + (size_t)(tok0 + s) * DM + g * 256 + dc * 8);
                const float mean = ST[2 * s], rstd = ST[2 * s + 1];
                const f32x2v f0 = __builtin_amdgcn_cvt_pk_f32_fp8((int)raw.x, false), f1 = __builtin_amdgcn_cvt_pk_f32_fp8((int)raw.x, true), f2 = __builtin_amdgcn_cvt_pk_f32_fp8((int)raw.y, false), f3 = __builtin_amdgcn_cvt_pk_f32_fp8((int)raw.y, true);
                f32x4 x0 = {f0.x, f0.y, f1.x, f1.y}, x1 = {f2.x, f2.y, f3.x, f3.y};
                x0 = (x0 - mean) * rstd * g0 + b0; x1 = (x1 - mean) * rstd * g1 + b1;
                u32x4 o; o.x = pk2(x0.x, x0.y); o.y = pk2(x0.z, x0.w); o.z = pk2(x1.x, x1.y); o.w = pk2(x1.z, x1.w);
                *(LAS u32x4*)(VT + s * RSV + dc * 16) = o;
            }
        }
        __syncthreads();
        {
            const int dbase = 32 * wv, kg = lane >> 4, q = (lane & 15) >> 2, p = lane & 3, fr = lane & 15;
            bf16x8 Af[2][4];
#pragma unroll
            for (int m = 0; m < 2; ++m)
#pragma unroll
                for (int kk = 0; kk < 4; ++kk) {
                    LAS const unsigned char* ap = VT + (32 * kk + 8 * kg + q) * RSV + (dbase + 16 * m + 4 * p) * 2;
                    const v4i16_t lo = lds_tr16(ap), hi = lds_tr16(ap + 4 * RSV);
                    Af[m][kk] = (bf16x8){lo[0], lo[1], lo[2], lo[3], hi[0], hi[1], hi[2], hi[3]};
                }
#pragma unroll
            for (int n = 0; n < 8; ++n) {
                f32x4 acc0 = {0.f, 0.f, 0.f, 0.f}, acc1 = {0.f, 0.f, 0.f, 0.f};
#pragma unroll
                for (int kk = 0; kk < 4; ++kk) if (kk <= (n >> 1)) {
                    const bf16x8 Bf = *(LAS const bf16x8*)(WT + (16 * n + fr) * RSW + (32 * kk + 8 * kg) * 2);
                    acc0 = __builtin_amdgcn_mfma_f32_16x16x32_bf16(Af[0][kk], Bf, acc0, 0, 0, 0);
                    acc1 = __builtin_amdgcn_mfma_f32_16x16x32_bf16(Af[1][kk], Bf, acc1, 0, 0, 0);
                }
                const int t = 16 * n + fr; const float bsv = bsp[g * 128 + t];
                bf16_t* yp = YAB + (size_t)(tok0 + t) * 2048 + g * 256 + dbase + 4 * kg;
                const u32x2 u0 = *(const u32x2*)yp, u1 = *(const u32x2*)(yp + 16);
                u32x2 o0, o1;
                o0.x = pk2(bflo(u0.x) * (acc0[0] + bsv), bfhi(u0.x) * (acc0[1] + bsv)); o0.y = pk2(bflo(u0.y) * (acc0[2] + bsv), bfhi(u0.y) * (acc0[3] + bsv));
                o1.x = pk2(bflo(u1.x) * (acc1[0] + bsv), bfhi(u1.x) * (acc1[1] + bsv)); o1.y = pk2(bflo(u1.y) * (acc1[2] + bsv), bfhi(u1.y) * (acc1[3] + bsv));
                *(u32x2*)yp = o0; *(u32x2*)(yp + 16) = o1;
            }
        }
        __syncthreads();
    }
}

__device__ __forceinline__ void ph_gate(const Ctx& F) {
    const unsigned char* Q = F.ws + WS_Q; const float* KM = (const float*)(F.ws + WS_KMEAN);
    unsigned* SEL = (unsigned*)(F.ws + WS_SEL); unsigned* LISTS = (unsigned*)(F.ws + WS_LISTS); unsigned* LCNT = (unsigned*)(F.ws + WS_CTL) + CW_LCNT;
    constexpr int KMR = 272;
    LAS unsigned char* kmh = F.lds; LAS unsigned char* kml = F.lds + 16 * KMR;
    unsigned* lc = (unsigned*)(F.ldsg + 2 * 16 * KMR);
    LAS float* scw = (LAS float*)(F.lds + 16384) + F.wave * 1024;
    const int fr = F.lane & 15, fq = F.lane >> 4;
    for (int it = F.vcu; it < NB * NH * 8; it += F.G) {
        const int b = it / 64, h = (it >> 3) & 7, tc = it & 7;
        {
            const int j = F.tid >> 5, d4 = (F.tid & 31) * 4;
            const float* kp = KM + (size_t)((b * NBLK + j) * 2) * DM + h * DH + d4;
            const f32x4 s0 = *(const f32x4*)kp, s1 = *(const f32x4*)(kp + DM);
            const f32x4 mv = (s0 + s1) * (1.0f / LBLK);
            unsigned hb[4]; float lo[4];
#pragma unroll
            for (int e = 0; e < 4; ++e) { hb[e] = f2bf(mv[e]); lo[e] = mv[e] - __uint_as_float(hb[e] << 16); }
            *(LAS u32x2*)(kmh + j * KMR + d4 * 2) = (u32x2){hb[0] | (hb[1] << 16), hb[2] | (hb[3] << 16)};
            *(LAS u32x2*)(kml + j * KMR + d4 * 2) = (u32x2){pk2(lo[0], lo[1]), pk2(lo[2], lo[3])};
        }
        if (F.tid < 32) lc[F.tid] = 0u;
        const int tw = tc * 512 + F.wave * 64;
        u32x4 qraw[4][2];
#pragma unroll
        for (int tg = 0; tg < 4; ++tg) { const unsigned char* qp = Q + (size_t)(b * SEQ + tw + 16 * tg + fr) * DM + h * DH + 32 * fq; qraw[tg][0] = *(const u32x4*)qp; qraw[tg][1] = *(const u32x4*)(qp + 16); }
        __syncthreads();
        bf16x8 Ah[4], Al[4];
#pragma unroll
        for (int ks = 0; ks < 4; ++ks) { Ah[ks] = *(LAS const bf16x8*)(kmh + fr * KMR + (32 * fq + 8 * ks) * 2); Al[ks] = *(LAS const bf16x8*)(kml + fr * KMR + (32 * fq + 8 * ks) * 2); }
#pragma unroll
        for (int tg = 0; tg < 4; ++tg) {
            f32x4 acc = {0.f, 0.f, 0.f, 0.f};
#pragma unroll
            for (int ks = 0; ks < 4; ++ks) {
                const u32x4 w = qraw[tg][ks >> 1]; const unsigned w0 = (ks & 1) ? w.z : w.x, w1 = (ks & 1) ? w.w : w.y;
                const bf16x8 Bq = __builtin_bit_cast(bf16x8, f8x8_to_bf16x8(w0, w1));
                acc = __builtin_amdgcn_mfma_f32_16x16x32_bf16(Ah[ks], Bq, acc, 0, 0, 0);
                acc = __builtin_amdgcn_mfma_f32_16x16x32_bf16(Al[ks], Bq, acc, 0, 0, 0);
            }
            *(LAS f32x4*)(scw + (16 * tg + fr) * 16 + 4 * fq) = acc;
        }
        asm volatile("s_waitcnt lgkmcnt(0)" ::: "memory");
        const int t = tc * 512 + F.tid, qi = t >> 8;
        float gsc[15];
        { const f32x4 c0 = *(LAS const f32x4*)(scw + F.lane * 16), c1 = *(LAS const f32x4*)(scw + F.lane * 16 + 4), c2 = *(LAS const f32x4*)(scw + F.lane * 16 + 8), c3 = *(LAS const f32x4*)(scw + F.lane * 16 + 12);
          gsc[0] = c0.x; gsc[1] = c0.y; gsc[2] = c0.z; gsc[3] = c0.w; gsc[4] = c1.x; gsc[5] = c1.y; gsc[6] = c1.z; gsc[7] = c1.w;
          gsc[8] = c2.x; gsc[9] = c2.y; gsc[10] = c2.z; gsc[11] = c2.w; gsc[12] = c3.x; gsc[13] = c3.y; gsc[14] = c3.z; }
        const int nsel = qi < 3 ? qi : 3;
        int sel[3] = {0, 0, 0}; unsigned lpos[3] = {0, 0, 0};
#pragma unroll
        for (int r = 0; r < 3; ++r) {
            float best = -INFINITY; int bi = -1;
#pragma unroll
            for (int j = 0; j < 15; ++j) { const bool c = (j < qi) && (gsc[j] > best); best = c ? gsc[j] : best; bi = c ? j : bi; }
#pragma unroll
            for (int j = 0; j < 15; ++j) if (j == bi) gsc[j] = -INFINITY;
            sel[r] = bi < 0 ? 0 : bi;
            if (r < nsel) lpos[r] = atomicAdd(&lc[sel[r]], 1u);
        }
        SEL[(size_t)(b * SEQ + t) * NH + h] = (unsigned)sel[0] | ((unsigned)sel[1] << 8) | ((unsigned)sel[2] << 16) | ((unsigned)nsel << 24);
        __syncthreads();
        if (F.tid < 16) lc[16 + F.tid] = lc[F.tid] ? atomicAdd(&LCNT[(b * NH + h) * NBLK + F.tid], lc[F.tid]) : 0u;
        __syncthreads();
#pragma unroll
        for (int r = 0; r < 3; ++r) if (r < nsel) LISTS[(size_t)((b * NH + h) * NBLK + sel[r]) * 4096 + lc[16 + sel[r]] + lpos[r]] = (unsigned)t | ((unsigned)r << 12);
        __syncthreads();
    }
}


typedef float f32x16 __attribute__((ext_vector_type(16)));
namespace att {
__device__ __forceinline__ int crow(int r, int hi) { return (r & 3) + 8 * (r >> 2) + 4 * hi; }
#define TRR(dst, vaddr, off) asm volatile("ds_read_b64_tr_b16 %0, %1 offset:%c2" : "=v"(dst) : "v"(vaddr), "i"(off) : "memory")
#define TRWAIT() do { asm volatile("s_waitcnt lgkmcnt(0)" ::: "memory"); __builtin_amdgcn_sched_barrier(0); } while (0)

}

namespace att2 {
constexpr int KCH2 = 1040, VDB2 = 4160, KSL = 8 * KCH2, VSL = 4 * VDB2;
constexpr int OFF_K = 0, OFF_V = 2 * KSL, OFF_STG = OFF_V + 2 * VSL  , OFF_WS = OFF_STG + 8 * 8192  , WSW = 1024, OFF_TAB = OFF_WS + 8 * WSW  ;
static_assert(OFF_TAB + 1028 * 4 <= LDS_BYTES - 64, "attention (partial) LDS map");
using att::crow;

__device__ __forceinline__ void tile_load(const Ctx& F, const unsigned char* K, const unsigned char* V, size_t tokbase, int h, int kt, u32x4& rk, u32x4& rv) {
    const size_t off = (tokbase + 64 * kt + (F.tid >> 3)) * DM + h * DH + (F.tid & 7) * 16;
    rk = *(const u32x4*)(K + off); rv = *(const u32x4*)(V + off);
}
__device__ __forceinline__ void tile_write(const Ctx& F, int slot, const u32x4& rk, const u32x4& rv) {
    const int key = F.tid >> 3, c = 2 * (F.tid & 7);
    *(LAS u32x4*)(F.lds + OFF_K + slot * KSL + (F.tid & 7) * KCH2 + key * 16) = rk;
    LAS unsigned char* vd = F.lds + OFF_V + slot * VSL + (c >> 2) * VDB2 + (key >> 3) * 512 + (key & 7) * 64 + (c & 3) * 16;
    *(LAS u32x4*)vd = f8x8_to_bf16x8(rv.x, rv.y); *(LAS u32x4*)(vd + 16) = f8x8_to_bf16x8(rv.z, rv.w);
}
template <bool CAUSAL = false>
__device__ __forceinline__ void tile_compute(const Ctx& F, int slot, const pg8::v8i_t (&qf)[2], f32x16 (&o)[4], float& m, float& l, bool first, bool diag = false) {
    const int r = F.lane & 31, hh = F.lane >> 5;
    LAS float* wsf = (LAS float*)(F.lds + OFF_WS + F.wave * WSW);
    LAS const unsigned char* kp = F.lds + OFF_K + slot * KSL + 2 * hh * KCH2 + r * 16;
    LAS const unsigned char* vp = F.lds + OFF_V + slot * VSL + (4 * hh + ((F.lane & 15) >> 2)) * 64 + ((F.lane >> 4) & 1) * 32 + (F.lane & 3) * 8;
    f32x16 p0, p1;
#pragma unroll
    for (int i = 0; i < 16; ++i) { p0[i] = 0.f; p1[i] = 0.f; }
    {
        pg8::v8i_t ka[2][2];
#pragma unroll
        for (int kb = 0; kb < 2; ++kb)
#pragma unroll
            for (int j2 = 0; j2 < 2; ++j2) ka[kb][j2] = __builtin_shufflevector(*(LAS const pg8::v4i_t*)(kp + 4 * j2 * KCH2 + kb * 512), *(LAS const pg8::v4i_t*)(kp + (4 * j2 + 1) * KCH2 + kb * 512), 0, 1, 2, 3, 4, 5, 6, 7);
        __builtin_amdgcn_sched_barrier(0);
#pragma unroll
        for (int j2 = 0; j2 < 2; ++j2) p0 = __builtin_amdgcn_mfma_scale_f32_32x32x64_f8f6f4(ka[0][j2], qf[j2], p0, 0, 0, 0, 0x7f7f7f7f, 0, 0x7f7f7f7f);
#pragma unroll
        for (int j2 = 0; j2 < 2; ++j2) p1 = __builtin_amdgcn_mfma_scale_f32_32x32x64_f8f6f4(ka[1][j2], qf[j2], p1, 0, 0, 0, 0x7f7f7f7f, 0, 0x7f7f7f7f);
        __builtin_amdgcn_sched_barrier(0);
    }
    v4i16_t vl[2][4], vh[2][4];
    const unsigned vaddr = (unsigned)(uintptr_t)vp;
#pragma unroll
    for (int ks = 0; ks < 2; ++ks)
#pragma unroll
        for (int db = 0; db < 4; ++db) { TRR(vl[ks][db], vaddr, db * VDB2 + ks * 1024); TRR(vh[ks][db], vaddr, db * VDB2 + ks * 1024 + 512); }
    __builtin_amdgcn_sched_barrier(0);
    if (CAUSAL && diag) {
        if (F.wave & 1) {
#pragma unroll
            for (int i = 0; i < 16; ++i) p1[i] = (crow(i, hh) > r) ? -INFINITY : p1[i];
        } else {
#pragma unroll
            for (int i = 0; i < 16; ++i) { p0[i] = (crow(i, hh) > r) ? -INFINITY : p0[i]; p1[i] = -INFINITY; }
        }
    }
    const float dm = first ? 0.f : m;
    { const f32x2 dm2 = {dm, dm};
#pragma unroll
      for (int j = 0; j < 8; ++j) { f32x2 a = {p0[2 * j], p0[2 * j + 1]}, b = {p1[2 * j], p1[2 * j + 1]}; a = a - dm2; b = b - dm2; p0[2 * j] = a.x; p0[2 * j + 1] = a.y; p1[2 * j] = b.x; p1[2 * j + 1] = b.y; } }
    float mx = fmaxf(p0[0], p1[0]);
#pragma unroll
    for (int i = 1; i < 16; ++i) mx = fmaxf(mx, fmaxf(p0[i], p1[i]));
    mx = fmaxf(mx, __shfl_xor(mx, 32));
    if (first || __any(mx > 8.0f)) {
        const float delta = first ? mx : fmaxf(mx, 0.f);
        const float alpha = first ? 0.f : __builtin_amdgcn_exp2f(-delta);
        l *= alpha; m = dm + delta;
        { const f32x2 d2 = {delta, delta};
#pragma unroll
          for (int j = 0; j < 8; ++j) { f32x2 a = {p0[2 * j], p0[2 * j + 1]}, b = {p1[2 * j], p1[2 * j + 1]}; a = a - d2; b = b - d2; p0[2 * j] = a.x; p0[2 * j + 1] = a.y; p1[2 * j] = b.x; p1[2 * j + 1] = b.y; } }
        if (!first) {
            if (hh == 0) wsf[r] = alpha;
            asm volatile("s_waitcnt lgkmcnt(0)" ::: "memory");
#pragma unroll
            for (int i = 0; i < 16; ++i) { const float a = wsf[crow(i, hh)];
#pragma unroll
                for (int db = 0; db < 4; ++db) o[db][i] *= a; }
        }
    }
    { f32x2 sa = {0.f, 0.f}, sb = {0.f, 0.f};
#pragma unroll
      for (int j = 0; j < 8; ++j) {
          p0[2 * j] = __builtin_amdgcn_exp2f(p0[2 * j]); p0[2 * j + 1] = __builtin_amdgcn_exp2f(p0[2 * j + 1]); p1[2 * j] = __builtin_amdgcn_exp2f(p1[2 * j]); p1[2 * j + 1] = __builtin_amdgcn_exp2f(p1[2 * j + 1]);
          sa = sa + (f32x2){p0[2 * j], p0[2 * j + 1]}; sb = sb + (f32x2){p1[2 * j], p1[2 * j + 1]}; }
      sa = sa + sb; l += sa.x + sa.y; }
    u32x4 pw[4];
#pragma unroll
    for (int s2 = 0; s2 < 2; ++s2) {
        pw[s2] = (u32x4){cvt_pk_bf16(p0[8 * s2], p0[8 * s2 + 1]), cvt_pk_bf16(p0[8 * s2 + 2], p0[8 * s2 + 3]), cvt_pk_bf16(p0[8 * s2 + 4], p0[8 * s2 + 5]), cvt_pk_bf16(p0[8 * s2 + 6], p0[8 * s2 + 7])};
        pw[2 + s2] = (u32x4){cvt_pk_bf16(p1[8 * s2], p1[8 * s2 + 1]), cvt_pk_bf16(p1[8 * s2 + 2], p1[8 * s2 + 3]), cvt_pk_bf16(p1[8 * s2 + 4], p1[8 * s2 + 5]), cvt_pk_bf16(p1[8 * s2 + 6], p1[8 * s2 + 7])};
    }
    TRWAIT();
#pragma unroll
    for (int ks = 0; ks < 2; ++ks) {
        const bf16x8 pa = __builtin_bit_cast(bf16x8, pw[ks]);
#pragma unroll
        for (int db = 0; db < 4; ++db) {
            const bf16x8 vf = (bf16x8){vl[ks][db][0], vl[ks][db][1], vl[ks][db][2], vl[ks][db][3], vh[ks][db][0], vh[ks][db][1], vh[ks][db][2], vh[ks][db][3]};
            o[db] = __builtin_amdgcn_mfma_f32_32x32x16_bf16(pa, vf, o[db], 0, 0, 0);
        }
    }
    __builtin_amdgcn_sched_barrier(0);
#pragma unroll
    for (int ks = 0; ks < 2; ++ks)
#pragma unroll
        for (int db = 0; db < 4; ++db) { TRR(vl[ks][db], vaddr, db * VDB2 + (2 + ks) * 1024); TRR(vh[ks][db], vaddr, db * VDB2 + (2 + ks) * 1024 + 512); }
    TRWAIT();
#pragma unroll
    for (int ks = 0; ks < 2; ++ks) {
        const bf16x8 pa = __builtin_bit_cast(bf16x8, pw[2 + ks]);
#pragma unroll
        for (int db = 0; db < 4; ++db) {
            const bf16x8 vf = (bf16x8){vl[ks][db][0], vl[ks][db][1], vl[ks][db][2], vl[ks][db][3], vh[ks][db][0], vh[ks][db][1], vh[ks][db][2], vh[ks][db][3]};
            o[db] = __builtin_amdgcn_mfma_f32_32x32x16_bf16(pa, vf, o[db], 0, 0, 0);
        }
    }
    __builtin_amdgcn_sched_barrier(0);
}
}

#define ATT2_DECODE(item, bhj_, chunk_) do { int lo_ = 0, hi_ = 1023; while (lo_ < hi_) { const int mid_ = (lo_ + hi_ + 1) >> 1; if (P[mid_] <= (item)) lo_ = mid_; else hi_ = mid_ - 1; } bhj_ = lo_; chunk_ = (item) - P[lo_]; } while (0)
__device__ __forceinline__ void ph_attn_partial(const Ctx& F) {
    using namespace att2;
    const unsigned char* Q = F.ws + WS_Q; const unsigned char* K = F.ws + WS_K; const unsigned char* V = F.ws + WS_V;
    const unsigned* LISTS = (const unsigned*)(F.ws + WS_LISTS); const unsigned* LCNT = (const unsigned*)(F.ws + WS_CTL) + CW_LCNT;
    unsigned char* OP = F.ws + WS_OP; float* LSE = (float*)(F.ws + WS_LSE);
    LAS int* P = (LAS int*)(F.lds + OFF_TAB);
    if (F.tid < 64) {
        int c[16]; int s = 0;
#pragma unroll
        for (int i = 0; i < 16; ++i) { c[i] = ((int)__hip_atomic_load(LCNT + F.tid * 16 + i, __ATOMIC_RELAXED, __HIP_MEMORY_SCOPE_AGENT) + 255) >> 8; s += c[i]; }
        int inc = s;
#pragma unroll
        for (int o = 1; o < 64; o <<= 1) { const int t = __shfl_up(inc, o); if (F.lane >= o) inc += t; }
        int run = inc - s;
#pragma unroll
        for (int i = 0; i < 16; ++i) { P[F.tid * 16 + i] = run; run += c[i]; }
        if (F.tid == 63) P[1024] = run;
    }
    __syncthreads();
    const int total = P[1024];
    LAS float* wsf = (LAS float*)(F.lds + OFF_WS + F.wave * WSW);
    LAS int* wsi = (LAS int*)wsf;
    const int r = F.lane & 31, hh = F.lane >> 5;
    int it = F.vcu;
    if (it < total) {
        int bhj, chunk; ATT2_DECODE(it, bhj, chunk);
        int itn = it + F.G, bhjn = 0, chunkn = 0; bool hasn = itn < total; if (hasn) ATT2_DECODE(itn, bhjn, chunkn);
        u32x4 rkA, rvA, rkB, rvB;
        { const int b = bhj >> 7, h = (bhj >> 4) & 7, j = bhj & 15; const size_t tb = (size_t)b * SEQ + j * LBLK;
          tile_load(F, K, V, tb, h, 0, rkA, rvA); tile_load(F, K, V, tb, h, 1, rkB, rvB); tile_write(F, 0, rkA, rvA); tile_write(F, 1, rkB, rvB);
          tile_load(F, K, V, tb, h, 2, rkA, rvA); }
        int cnt = (int)__hip_atomic_load(LCNT + bhj, __ATOMIC_RELAXED, __HIP_MEMORY_SCOPE_AGENT);
        int qi = chunk * 256 + F.wave * 32 + r;
        unsigned ent = LISTS[(size_t)bhj * 4096 + (qi < cnt ? qi : 0)];
        int tq = ent & 4095, slot = (qi < cnt) ? (int)(ent >> 12) : -1;
        u32x4 qraw[4];
        { const unsigned char* qrow = Q + ((size_t)(bhj >> 7) * SEQ + tq) * DM + ((bhj >> 4) & 7) * DH + hh * 32;
#pragma unroll
          for (int c = 0; c < 4; ++c) qraw[c] = *(const u32x4*)(qrow + (c >> 1) * 64 + (c & 1) * 16); }
        unsigned entn = 0u; int cntn = 0;
        __syncthreads();
        int s = 0;
        for (;;) {
            const int b = bhj >> 7, h = (bhj >> 4) & 7, j = bhj & 15;
            pg8::v8i_t qr[2];
#pragma unroll
            for (int j2 = 0; j2 < 2; ++j2) qr[j2] = __builtin_shufflevector(__builtin_bit_cast(pg8::v4i_t, qraw[2 * j2]), __builtin_bit_cast(pg8::v4i_t, qraw[2 * j2 + 1]), 0, 1, 2, 3, 4, 5, 6, 7);
            if (F.lane < 32) { wsi[64 + r] = tq; wsi[96 + r] = slot; }
            f32x16 o[4]; float m = -1e30f, l = 0.f;
#pragma unroll
            for (int db = 0; db < 4; ++db)
#pragma unroll
                for (int i = 0; i < 16; ++i) o[db][i] = 0.f;
#define ATT2_TB(bb) ((size_t)((bb) >> 7) * SEQ + ((bb) & 15) * LBLK)
#define ATT2_H(bb) (((bb) >> 4) & 7)
#pragma unroll 1
            for (int kp2 = 0; kp2 < 2; ++kp2) {
                const int kt = 2 * kp2;
                { const bool cur3 = kt + 3 < 4, have3 = cur3 || hasn, have2 = (kt + 2 < 4) || hasn;
                  if (have3) { const int bb = cur3 ? bhj : bhjn; tile_load(F, K, V, ATT2_TB(bb), ATT2_H(bb), (kt + 3) & 3, rkB, rvB); }
                  if (kt == 0 && hasn) { cntn = (int)__hip_atomic_load(LCNT + bhjn, __ATOMIC_RELAXED, __HIP_MEMORY_SCOPE_AGENT); }
                  if (kt == 2 && hasn) { const unsigned char* qrow = Q + ((size_t)(bhjn >> 7) * SEQ + (entn & 4095)) * DM + ((bhjn >> 4) & 7) * DH + hh * 32;
#pragma unroll
                      for (int c = 0; c < 4; ++c) qraw[c] = *(const u32x4*)(qrow + (c >> 1) * 64 + (c & 1) * 16); }
                  tile_compute(F, 0, qr, o, m, l, kp2 == 0);
                  asm volatile("s_waitcnt lgkmcnt(0)" ::: "memory"); __builtin_amdgcn_s_barrier(); asm volatile("" ::: "memory");
                  if (have2) tile_write(F, 0, rkA, rvA); }
                { const bool have4 = hasn, have3 = (kt + 3 < 4) || hasn;
                  if (have4) { tile_load(F, K, V, ATT2_TB(bhjn), ATT2_H(bhjn), kt, rkA, rvA); }
                  if (kt == 0 && hasn) { const int qn = chunkn * 256 + F.wave * 32 + r; entn = LISTS[(size_t)bhjn * 4096 + (qn < cntn ? qn : 0)]; }
                  tile_compute(F, 1, qr, o, m, l, false);
                  asm volatile("s_waitcnt lgkmcnt(0)" ::: "memory"); __builtin_amdgcn_s_barrier(); asm volatile("" ::: "memory");
                  if (have3) tile_write(F, 1, rkB, rvB); }
            }
            const float lt = l + __shfl_xor(l, 32);
            if (hh == 0) { wsf[r] = 1.0f / lt; wsf[32 + r] = m + __builtin_amdgcn_logf(lt); }
            asm volatile("s_waitcnt lgkmcnt(0)" ::: "memory");
            int re = r, he = hh; asm volatile("" : "+v"(re), "+v"(he));
#pragma unroll
            for (int i = 0; i < 16; ++i) {
                const int q = crow(i, he); const float a = wsf[q]; const int t = wsi[64 + q], sl = wsi[96 + q];
                const unsigned w = pack_fp8x4(o[0][i] * a, o[1][i] * a, o[2][i] * a, o[3][i] * a);
                if (sl >= 0) { const size_t row = (((size_t)sl * NB + b) * SEQ + t) * NH + h; *(unsigned*)(OP + row * DH + 4 * re) = w; }
            }
            if (he == 0 && slot >= 0) LSE[(((size_t)slot * NB + b) * SEQ + tq) * NH + h] = wsf[32 + re];
            asm volatile("s_waitcnt lgkmcnt(0)" ::: "memory");
            if (!hasn) break;
            it = itn; bhj = bhjn; chunk = chunkn; cnt = cntn;
            { const int qn = chunk * 256 + F.wave * 32 + r; tq = entn & 4095; slot = (qn < cnt) ? (int)(entn >> 12) : -1; }
            itn = it + F.G; hasn = itn < total; if (hasn) ATT2_DECODE(itn, bhjn, chunkn);
        }
    }
    __syncthreads();
}

__device__ __forceinline__ void ph_attn_own(const Ctx& F) {
    using namespace att2;
    const unsigned char* Q = F.ws + WS_Q; const unsigned char* K = F.ws + WS_K; const unsigned char* V = F.ws + WS_V;
    const unsigned char* OP = F.ws + WS_OP; const float* LSE = (const float*)(F.ws + WS_LSE); bf16_t* YAB = (bf16_t*)(F.ws + WS_YAB);
    LAS float* wsf = (LAS float*)(F.lds + OFF_WS + F.wave * WSW);
    const int r = F.lane & 31, hh = F.lane >> 5;
    constexpr int NIT = NB * NH * NBLK;
    int it = F.vcu;
    if (it < NIT) {
        int itn = it + F.G; bool hasn = itn < NIT;
        u32x4 rkA, rvA, rkB, rvB;
#define OWN_TB(i_) ((size_t)((i_) >> 7) * SEQ + ((i_) & 15) * LBLK)
#define OWN_H(i_) (((i_) >> 4) & 7)
        tile_load(F, K, V, OWN_TB(it), OWN_H(it), 0, rkA, rvA); tile_load(F, K, V, OWN_TB(it), OWN_H(it), 1, rkB, rvB); tile_write(F, 0, rkA, rvA); tile_write(F, 1, rkB, rvB);
        tile_load(F, K, V, OWN_TB(it), OWN_H(it), 2, rkA, rvA);
        u32x4 qraw[4];
        { const unsigned char* qrow = Q + (OWN_TB(it) + F.wave * 32 + r) * DM + OWN_H(it) * DH + hh * 32;
#pragma unroll
          for (int c = 0; c < 4; ++c) qraw[c] = *(const u32x4*)(qrow + (c >> 1) * 64 + (c & 1) * 16); }
        __syncthreads();
        const int wdiag = F.wave >> 1;
        for (;;) {
            const int b = it >> 7, h = (it >> 4) & 7, j = it & 15, t0 = j * LBLK + F.wave * 32;
            pg8::v8i_t qr[2];
#pragma unroll
            for (int j2 = 0; j2 < 2; ++j2) qr[j2] = __builtin_shufflevector(__builtin_bit_cast(pg8::v4i_t, qraw[2 * j2]), __builtin_bit_cast(pg8::v4i_t, qraw[2 * j2 + 1]), 0, 1, 2, 3, 4, 5, 6, 7);
            f32x16 o[4]; float m = -1e30f, l = 0.f;
#pragma unroll
            for (int db = 0; db < 4; ++db)
#pragma unroll
                for (int i = 0; i < 16; ++i) o[db][i] = 0.f;
#pragma unroll 1
            for (int kp2 = 0; kp2 < 2; ++kp2) {
                const int kt = 2 * kp2;
                { const bool cur3 = kt + 3 < 4, have3 = cur3 || hasn, have2 = (kt + 2 < 4) || hasn;
                  if (have3) { const int ii = cur3 ? it : itn; tile_load(F, K, V, OWN_TB(ii), OWN_H(ii), (kt + 3) & 3, rkB, rvB); }
                  if (kt == 2 && hasn) { const unsigned char* qrow = Q + (OWN_TB(itn) + F.wave * 32 + r) * DM + OWN_H(itn) * DH + hh * 32;
#pragma unroll
                      for (int c = 0; c < 4; ++c) qraw[c] = *(const u32x4*)(qrow + (c >> 1) * 64 + (c & 1) * 16); }
                  if (kt <= wdiag) tile_compute<true>(F, 0, qr, o, m, l, kp2 == 0, kt == wdiag);
                  asm volatile("s_waitcnt lgkmcnt(0)" ::: "memory"); __builtin_amdgcn_s_barrier(); asm volatile("" ::: "memory");
                  if (have2) tile_write(F, 0, rkA, rvA); }
                { const bool have4 = hasn, have3 = (kt + 3 < 4) || hasn;
                  if (have4) { tile_load(F, K, V, OWN_TB(itn), OWN_H(itn), kt, rkA, rvA); }
                  if (kt + 1 <= wdiag) tile_compute<true>(F, 1, qr, o, m, l, false, kt + 1 == wdiag);
                  asm volatile("s_waitcnt lgkmcnt(0)" ::: "memory"); __builtin_amdgcn_s_barrier(); asm volatile("" ::: "memory");
                  if (have3) tile_write(F, 1, rkB, rvB); }
            }
            const int nv = j < 3 ? j : 3;
            {
                const float lt = l + __shfl_xor(l, 32); const float lse_own = m + __builtin_amdgcn_logf(lt);
                float ls[3];
#pragma unroll
                for (int s2 = 0; s2 < 3; ++s2) ls[s2] = (s2 < nv) ? LSE[(((size_t)s2 * NB + b) * SEQ + t0 + r) * NH + h] : -1e30f;
                const float M = fmaxf(fmaxf(lse_own, ls[0]), fmaxf(ls[1], ls[2]));
                const float w0 = __builtin_amdgcn_exp2f(lse_own - M);
                float w[3], den = w0;
#pragma unroll
                for (int s2 = 0; s2 < 3; ++s2) { w[s2] = (s2 < nv) ? __builtin_amdgcn_exp2f(ls[s2] - M) : 0.f; den += w[s2]; }
                const float inv = 1.0f / den;
                if (hh == 0) { wsf[r] = w0 * inv / lt; wsf[32 + r] = w[0] * inv; wsf[64 + r] = w[1] * inv; wsf[96 + r] = w[2] * inv; }
                asm volatile("s_waitcnt lgkmcnt(0)" ::: "memory");
            }
            int re = r, he = hh; asm volatile("" : "+v"(re), "+v"(he));
            LAS float* stg = (LAS float*)(F.lds + OFF_STG + F.wave * 8192);
            {
                unsigned pv[16][3];
#pragma unroll
                for (int i = 0; i < 16; ++i) { const int q = crow(i, he);
#pragma unroll
                    for (int s2 = 0; s2 < 3; ++s2) { pv[i][s2] = 0u; if (s2 < nv) pv[i][s2] = *(const unsigned*)(OP + ((((size_t)s2 * NB + b) * SEQ + t0 + q) * NH + h) * DH + 4 * re); } }
#pragma unroll
                for (int i = 0; i < 16; ++i) { const int q = crow(i, he); const float a = wsf[q];
                    float x0 = o[0][i] * a, x1 = o[1][i] * a, x2 = o[2][i] * a, x3 = o[3][i] * a;
#pragma unroll
                    for (int s2 = 0; s2 < 3; ++s2) { const float ww = wsf[32 * (s2 + 1) + q]; const f32x2v f0 = __builtin_amdgcn_cvt_pk_f32_fp8((int)pv[i][s2], false), f1 = __builtin_amdgcn_cvt_pk_f32_fp8((int)pv[i][s2], true);
                        x0 += ww * f0.x; x1 += ww * f0.y; x2 += ww * f1.x; x3 += ww * f1.y; }
                    o[0][i] = x0; o[1][i] = x1; o[2][i] = x2; o[3][i] = x3; }
            }
#pragma unroll
            for (int half = 0; half < 2; ++half) {
#pragma unroll
                for (int i = 0; i < 16; ++i) { const int q = crow(i, he); stg[q * 64 + re] = o[2 * half][i]; stg[q * 64 + 32 + re] = o[2 * half + 1][i]; }
                asm volatile("s_waitcnt lgkmcnt(0)" ::: "memory");
#pragma unroll
                for (int ps = 0; ps < 4; ++ps) {
                    const int q = ps * 8 + ((re + 32 * he) >> 3), dc = re & 7;
                    const f32x4 x = *(LAS const f32x4*)(stg + q * 64 + dc * 8), y = *(LAS const f32x4*)(stg + q * 64 + dc * 8 + 4);
                    *(u32x4*)(YAB + ((size_t)b * SEQ + t0 + q) * 2048 + 1024 + h * DH + half * 64 + dc * 8) = (u32x4){cvt_pk_bf16(x.x, x.y), cvt_pk_bf16(x.z, x.w), cvt_pk_bf16(y.x, y.y), cvt_pk_bf16(y.z, y.w)};
                }
                asm volatile("s_waitcnt lgkmcnt(0)" ::: "memory");
            }
            if (!hasn) break;
            it = itn; itn = it + F.G; hasn = itn < NIT;
        }
#undef OWN_TB
#undef OWN_H
    }
    __syncthreads();
}

__device__ __forceinline__ void ph_router(const Ctx& F) {
    const Args& A = *F.a;
    const bf16_t* Z = (const bf16_t*)(F.ws + WS_Z); const float* ZST = (const float*)(F.ws + WS_ZST); bf16_t* H1 = (bf16_t*)(F.ws + WS_H1); unsigned char* H1F8 = F.ws + WS_H1F8;
    int* TKE = (int*)(F.ws + WS_TKE); int* TKP = (int*)(F.ws + WS_TKP); unsigned* ECNT = (unsigned*)(F.ws + WS_CTL) + CW_ECNT; int* RT = (int*)(F.ws + WS_RT); float* RW = (float*)(F.ws + WS_RW);
    const float* wr = A.in[I_WR]; const float* br = A.in[I_BR];
    constexpr int RS = 2064, OFF_LO = 32 * RS, OFF_G = 2 * 32 * RS  , OFF_B = OFF_G + 4096, OFF_LG = OFF_B + 4096  , OFF_CNT = OFF_LG + 8 * 2112  ;
    static_assert(OFF_CNT + 256 <= LDS_BYTES, "router LDS map");
    LAS unsigned char* WH = F.lds; LAS unsigned char* WL = F.lds + OFF_LO;
    LAS float* LG = (LAS float*)(F.lds + OFF_G); LAS float* LB = (LAS float*)(F.lds + OFF_B);
    LAS float* lgt = (LAS float*)(F.lds + OFF_LG + F.wave * 2112);
    LAS unsigned* lcnt = (LAS unsigned*)(F.lds + OFF_CNT);
    {
        f32x4 wa[8], wb[8];
#pragma unroll
        for (int u_ = 0; u_ < 8; ++u_) { const int i = F.tid + 512 * u_, nq = i & 7, k2 = i >> 3;
            wa[u_] = *(const f32x4*)(wr + (size_t)(2 * k2) * NE + 4 * nq); wb[u_] = *(const f32x4*)(wr + (size_t)(2 * k2 + 1) * NE + 4 * nq); }
#pragma unroll
        for (int u_ = 0; u_ < 8; ++u_) { const int i = F.tid + 512 * u_, nq = i & 7, k2 = i >> 3;
#pragma unroll
            for (int c = 0; c < 4; ++c) {
                const float w0 = wa[u_][c], w1 = wb[u_][c];
                const unsigned h0 = f2bf(w0), h1 = f2bf(w1);
                const float r0 = w0 - __uint_as_float(h0 << 16), r1 = w1 - __uint_as_float(h1 << 16);
                *(LAS unsigned*)(WH + (4 * nq + c) * RS + k2 * 4) = h0 | (h1 << 16);
                *(LAS unsigned*)(WL + (4 * nq + c) * RS + k2 * 4) = pk2(r0, r1);
            } }
    }
    for (int i = F.tid; i < DM; i += 512) { LG[i] = A.in[I_LNMIX_G][i]; LB[i] = A.in[I_LNMIX_B][i]; }
    if (F.tid < 64) lcnt[F.tid] = 0u;
    __syncthreads();
    const int fr = F.lane & 15, kg = F.lane >> 4;
    const int ntask = T / 16, NGW = F.G * 8;
    const int rounds = (ntask + NGW - 1) / NGW;
    for (int rd = 0; rd < rounds; ++rd) {
        const int task = rd * NGW + F.vcu * 8 + F.wave;
        const bool live = task < ntask;
        int te[4] = {0, 0, 0, 0}; float tw[4] = {0.f, 0.f, 0.f, 0.f}; unsigned lp[4] = {0, 0, 0, 0};
        if (live) {
            const int tok = task * 16 + fr;
            float mean, rstd;
            { const f32x4* sp = (const f32x4*)(ZST + (size_t)tok * 32); float s1 = 0.f, s2 = 0.f;
#pragma unroll
              for (int i = 0; i < 8; ++i) { const f32x4 v = sp[i]; s1 += v.x + v.z; s2 += v.y + v.w; }
              mean = s1 * (1.f / DM); const float var = s2 * (1.f / DM) - mean * mean; rstd = 1.f / sqrtf(fmaxf(var, 0.f) + LN_EPS); }
            f32x4 acc0 = {0.f, 0.f, 0.f, 0.f}, acc1 = {0.f, 0.f, 0.f, 0.f};
            const bf16_t* zp = Z + (size_t)tok * DM + 8 * kg; unsigned char* h8 = H1F8 + (size_t)tok * DM + 8 * kg;
#pragma unroll 8
            for (int kk = 0; kk < 32; ++kk) {
                const u32x4 zr = *(const u32x4*)(zp + 32 * kk); const f32x4 z0 = {bflo(zr.x), bfhi(zr.x), bflo(zr.y), bfhi(zr.y)}, z1 = {bflo(zr.z), bfhi(zr.z), bflo(zr.w), bfhi(zr.w)};
                const f32x4 g0 = *(LAS const f32x4*)(LG + 32 * kk + 8 * kg), g1 = *(LAS const f32x4*)(LG + 32 * kk + 8 * kg + 4);
                const f32x4 b0 = *(LAS const f32x4*)(LB + 32 * kk + 8 * kg), b1 = *(LAS const f32x4*)(LB + 32 * kk + 8 * kg + 4);
                const f32x4 x0 = (z0 - mean) * rstd * g0 + b0, x1 = (z1 - mean) * rstd * g1 + b1;
                u32x4 hi; hi.x = cvt_pk_bf16(x0.x, x0.y); hi.y = cvt_pk_bf16(x0.z, x0.w); hi.z = cvt_pk_bf16(x1.x, x1.y); hi.w = cvt_pk_bf16(x1.z, x1.w);
                { unsigned w0 = 0u, w1 = 0u;
                  w0 = __builtin_amdgcn_cvt_pk_fp8_f32(x0.x, x0.y, w0, false); w0 = __builtin_amdgcn_cvt_pk_fp8_f32(x0.z, x0.w, w0, true);
                  w1 = __builtin_amdgcn_cvt_pk_fp8_f32(x1.x, x1.y, w1, false); w1 = __builtin_amdgcn_cvt_pk_fp8_f32(x1.z, x1.w, w1, true);
                  *(u32x2*)(h8 + 32 * kk) = (u32x2){w0, w1}; }
                u32x4 lo; lo.x = cvt_pk_bf16(x0.x - bflo(hi.x), x0.y - bfhi(hi.x)); lo.y = cvt_pk_bf16(x0.z - bflo(hi.y), x0.w - bfhi(hi.y));
                lo.z = cvt_pk_bf16(x1.x - bflo(hi.z), x1.y - bfhi(hi.z)); lo.w = cvt_pk_bf16(x1.z - bflo(hi.w), x1.w - bfhi(hi.w));
                const bf16x8 ah = __builtin_bit_cast(bf16x8, hi), al = __builtin_bit_cast(bf16x8, lo);
                const int bo = fr * RS + (32 * kk + 8 * kg) * 2;
                const bf16x8 wh0 = *(LAS const bf16x8*)(WH + bo), wh1 = *(LAS const bf16x8*)(WH + bo + 16 * RS), wl0 = *(LAS const bf16x8*)(WL + bo), wl1 = *(LAS const bf16x8*)(WL + bo + 16 * RS);
                acc0 = __builtin_amdgcn_mfma_f32_16x16x32_bf16(ah, wh0, acc0, 0, 0, 0); acc1 = __builtin_amdgcn_mfma_f32_16x16x32_bf16(ah, wh1, acc1, 0, 0, 0);
                acc0 = __builtin_amdgcn_mfma_f32_16x16x32_bf16(ah, wl0, acc0, 0, 0, 0); acc1 = __builtin_amdgcn_mfma_f32_16x16x32_bf16(ah, wl1, acc1, 0, 0, 0);
                acc0 = __builtin_amdgcn_mfma_f32_16x16x32_bf16(al, wh0, acc0, 0, 0, 0); acc1 = __builtin_amdgcn_mfma_f32_16x16x32_bf16(al, wh1, acc1, 0, 0, 0);
            }
            const float br0 = br[fr], br1 = br[16 + fr];
#pragma unroll
            for (int i = 0; i < 4; ++i) { lgt[(4 * kg + i) * 33 + fr] = acc0[i] + br0; lgt[(4 * kg + i) * 33 + 16 + fr] = acc1[i] + br1; }
            asm volatile("s_waitcnt lgkmcnt(0)" ::: "memory");
            if (F.lane < 16) {
                float lg[NE];
#pragma unroll
                for (int e = 0; e < NE; ++e) lg[e] = lgt[F.lane * 33 + e];
                float tv[4];
#pragma unroll
                for (int r = 0; r < 4; ++r) {
                    float best = -INFINITY; int bi = 0;
#pragma unroll
                    for (int e = 0; e < NE; ++e) { const bool c = lg[e] > best; best = c ? lg[e] : best; bi = c ? e : bi; }
#pragma unroll
                    for (int e = 0; e < NE; ++e) lg[e] = (e == bi) ? -INFINITY : lg[e];
                    te[r] = bi; tv[r] = best;
                }
                const float e1 = __expf(tv[1] - tv[0]), e2 = __expf(tv[2] - tv[0]), e3 = __expf(tv[3] - tv[0]); const float inv = 1.f / (1.f + e1 + e2 + e3);
                tw[0] = inv; tw[1] = e1 * inv; tw[2] = e2 * inv; tw[3] = e3 * inv;
#pragma unroll
                for (int r = 0; r < 4; ++r) lp[r] = atomicAdd((unsigned*)(lcnt + te[r]), 1u);
            }
        }
        __syncthreads();
        if (F.tid < 32) { const unsigned c = lcnt[F.tid]; lcnt[32 + F.tid] = c ? atomicAdd(&ECNT[F.tid], c) : 0u; }
        __syncthreads();
        if (live && F.lane < 16) {
            const size_t tok = (size_t)task * 16 + F.lane;
            int4 pe = {te[0], te[1], te[2], te[3]};
            int4 pp = {(int)(lcnt[32 + te[0]] + lp[0]), (int)(lcnt[32 + te[1]] + lp[1]), (int)(lcnt[32 + te[2]] + lp[2]), (int)(lcnt[32 + te[3]] + lp[3])};
            *(int4*)(TKE + tok * 4) = pe; *(int4*)(TKP + tok * 4) = pp;
#pragma unroll
            for (int r = 0; r < 4; ++r) { const size_t o_ = (size_t)te[r] * T + (r == 0 ? pp.x : r == 1 ? pp.y : r == 2 ? pp.z : pp.w); RT[o_] = (int)tok; RW[o_] = tw[r]; }
        }
        __syncthreads();
        if (F.tid < 32) lcnt[F.tid] = 0u;
        __syncthreads();
    }
}

__device__ __forceinline__ void moe_table(const Ctx& F) {
    const unsigned* ECNT = (const unsigned*)(F.ws + WS_CTL) + CW_ECNT;
    LAS int* tab = (LAS int*)(F.lds + LDS_MOE);
    __syncthreads();
    if (F.tid == 0) {
        int acc = 0;
        for (int e = 0; e < NE; ++e) { const int c = (int)__hip_atomic_load(ECNT + e, __ATOMIC_RELAXED, __HIP_MEMORY_SCOPE_AGENT); tab[32 + e] = acc; acc += (c + 255) / 256 * 256; }
        tab[64] = acc; tab[0] = acc / 256;
    }
    __syncthreads();
    const int ntiles = tab[0];
    for (int i = F.tid; i < ntiles; i += 512) { int e = 0; for (int k = 1; k < NE; ++k) if (i * 256 >= tab[32 + k]) e = k; tab[128 + 2 * i] = e; tab[129 + 2 * i] = i - tab[32 + e] / 256; }
    __syncthreads();
}

__device__ __forceinline__ void ln_stats16(const float* st, int lane, float& mean, float& rstd) {
    float s1 = 0.f, s2 = 0.f;
    if (lane < 16) { const f32x2 p = *(const f32x2*)(st + 2 * lane); s1 = p.x; s2 = p.y; }
    s1 = wave_sum(s1); s2 = wave_sum(s2);
    mean = s1 * (1.f / DM); const float var = s2 * (1.f / DM) - mean * mean; rstd = 1.f / sqrtf(fmaxf(var, 0.f) + LN_EPS);
}
__device__ __forceinline__ void ph_final(const Ctx& F) {
    const Args& A = *F.a;
    const bf16_t* Z = (const bf16_t*)(F.ws + WS_Z); const float* ZST = (const float*)(F.ws + WS_ZST); const unsigned char* YS = F.ws + WS_YS; const int* TKE = (const int*)(F.ws + WS_TKE); const int* TKP = (const int*)(F.ws + WS_TKP);
    const LAS int* tab = (const LAS int*)(F.lds + LDS_MOE);
    const int gw = F.vcu * 8 + F.wave, NGW = F.G * 8;
    f32x4 g2[4], b2[4], g1[4], b1[4];
#pragma unroll
    for (int j = 0; j < 4; ++j) { g2[j] = *((const f32x4*)A.in[I_LNF_G] + F.lane + 64 * j); b2[j] = *((const f32x4*)A.in[I_LNF_B] + F.lane + 64 * j);
        g1[j] = *((const f32x4*)A.in[I_LNMIX_G] + F.lane + 64 * j) * ALPHA; b1[j] = *((const f32x4*)A.in[I_LNMIX_B] + F.lane + 64 * j) * ALPHA; }
    for (int m = gw; m < T; m += NGW) {
        float mean, rstd; ln_stats16(ZST + (size_t)m * 32, F.lane, mean, rstd);
        const u32x2* hr = (const u32x2*)(Z + (size_t)m * DM) + F.lane;
        f32x4 v[4];
#pragma unroll
        for (int j = 0; j < 4; ++j) { const u32x2 hb = hr[64 * j]; v[j] = ((f32x4){bflo(hb.x), bfhi(hb.x), bflo(hb.y), bfhi(hb.y)} - mean) * rstd * g1[j] + b1[j]; }
#pragma unroll
        for (int k = 0; k < 4; ++k) {
            const int row = tab[32 + TKE[(size_t)m * 4 + k]] + TKP[(size_t)m * 4 + k]; const unsigned* yr = (const unsigned*)(YS + (size_t)row * DM) + F.lane;
#pragma unroll
            for (int j = 0; j < 4; ++j) { const unsigned y = yr[64 * j]; const f32x2v f0 = __builtin_amdgcn_cvt_pk_f32_fp8((int)y, false), f1 = __builtin_amdgcn_cvt_pk_f32_fp8((int)y, true);
                v[j].x += 0.0625f * f0.x; v[j].y += 0.0625f * f0.y; v[j].z += 0.0625f * f1.x; v[j].w += 0.0625f * f1.y; }
        }
        float s = 0.f;
#pragma unroll
        for (int j = 0; j < 4; ++j) s += (v[j].x + v[j].y) + (v[j].z + v[j].w);
        const float mu = wave_sum(s) * (1.f / DM); float s2 = 0.f;
#pragma unroll
        for (int j = 0; j < 4; ++j) { v[j] = v[j] - mu; s2 += (v[j].x * v[j].x + v[j].y * v[j].y) + (v[j].z * v[j].z + v[j].w * v[j].w); }
        const float rs = 1.f / sqrtf(wave_sum(s2) * (1.f / DM) + LN_EPS);
        f32x4* orow = (f32x4*)(A.out + (size_t)m * DM) + F.lane;
#pragma unroll
        for (int j = 0; j < 4; ++j) orow[64 * j] = v[j] * rs * g2[j] + b2[j];
    }
}

#define XB_TMO      128
#define XB_XCNT(j)  (256  + 64 * (j))
#define XB_XSUB(j)  (1280 + 64 * (j))
#define XB_XGEN(j)  (2304 + 64 * (j))
#define XB_TOP      3328
#define XB_TOPGEN   3392
#define XCD_BAR_WORDS 3456
#define XB_SPIN_CAP (1u << 18)
__device__ __forceinline__ unsigned xb_ld(unsigned* p)              { return __hip_atomic_load(p, __ATOMIC_RELAXED, __HIP_MEMORY_SCOPE_AGENT); }
__device__ __forceinline__ unsigned xb_add(unsigned* p, unsigned v) { return __hip_atomic_fetch_add(p, v, __ATOMIC_RELAXED, __HIP_MEMORY_SCOPE_AGENT); }
__device__ __forceinline__ unsigned xb_xcc_id() { return (unsigned)__builtin_amdgcn_s_getreg((3 << 11) | 20) & 0xFu; }
#define XB_SPIN(cond, bar) do { unsigned _sp = 0; while (cond) { __builtin_amdgcn_s_sleep(1); \
    if ((++_sp & 255u) == 0u) { if (xb_ld(&(bar)[XB_TMO])) break; if (_sp > XB_SPIN_CAP) { atomicAdd(&(bar)[XB_TMO], 1u); break; } } } } while (0)
__device__ __forceinline__ void xcd_barrier_complete(unsigned* bar, unsigned x, unsigned& nloc, unsigned& nx) {
    const unsigned G = gridDim.x * gridDim.y * gridDim.z;
    unsigned sum, cnt, mine, sp = 0u;
    for (;;) {
        sum = 0u; cnt = 0u; mine = 0u;
#pragma unroll
        for (unsigned j = 0; j < 16; ++j) { const unsigned c = xb_ld(&bar[XB_XCNT(j)]); sum += c; cnt += (c > 0u) ? 1u : 0u; mine = (j == x) ? c : mine; }
        if (sum == G) break;
        __builtin_amdgcn_s_sleep(1);
        if ((++sp & 255u) == 0u) { if (xb_ld(&bar[XB_TMO])) break; if (sp > XB_SPIN_CAP) { atomicAdd(&bar[XB_TMO], 1u); break; } }
    }
    nloc = mine > 0u ? mine : 1u; nx = cnt > 0u ? cnt : 1u;
}
__device__ __forceinline__ void xcd_barrier(unsigned* bar, volatile LAS unsigned* st, unsigned x, bool leader_thread) {
    asm volatile("s_waitcnt vmcnt(0)" ::: "memory");
    __syncthreads();
    if (leader_thread) {
        __builtin_amdgcn_s_waitcnt(0);
        unsigned nloc = st[0], nx = st[1];
        if (nloc == 0u) { xcd_barrier_complete(bar, x, nloc, nx); st[0] = nloc; st[1] = nx; }
        const unsigned old = xb_add(&bar[XB_XSUB(x)], 1u);
        const unsigned gen = old / nloc;
        if (old + 1u == (gen + 1u) * nloc) {
            __builtin_amdgcn_fence(__ATOMIC_RELEASE, "agent");
            asm volatile("s_waitcnt vmcnt(0)" ::: "memory");
            const unsigned og = xb_add(&bar[XB_TOP], 1u);
            const unsigned tg = og / nx;
            if (og + 1u == (tg + 1u) * nx) xb_add(&bar[XB_TOPGEN], 1u);
            else XB_SPIN(xb_ld(&bar[XB_TOPGEN]) == tg, bar);
            __builtin_amdgcn_fence(__ATOMIC_ACQUIRE, "agent");
            xb_add(&bar[XB_XGEN(x)], 1u);
            asm volatile("s_waitcnt vmcnt(0)" ::: "memory");
        } else {
            XB_SPIN(xb_ld(&bar[XB_XGEN(x)]) == gen, bar);
            __builtin_amdgcn_fence(__ATOMIC_ACQUIRE, "agent");
            asm volatile("s_waitcnt vmcnt(0)" ::: "memory");
        }
    }
    __syncthreads();
}

template <bool COOP>
__global__ void __launch_bounds__(512, 2) mega(Args args) {
    extern __shared__ __attribute__((aligned(16))) unsigned char lds_raw[];
    Ctx F;
    const int wave0 = __builtin_amdgcn_readfirstlane(threadIdx.x >> 6);
#define MKCTX() do { F.a = &args; F.ws = args.ws; F.lds = (LAS unsigned char*)lds_raw; F.ldsg = lds_raw; F.lane = lane_id_asm(); F.wave = wave0; F.tid = wave0 * 64 + F.lane; \
    F.G = gridDim.x; { const int bx = blockIdx.x; F.vcu = (F.G % 8 == 0) ? (bx % 8) * (F.G / 8) + bx / 8 : bx; } } while (0)
    MKCTX();
    const int lo = args.ph_lo, hi = args.ph_hi;
    unsigned char* ws = args.ws;
#ifndef PHMASK
#define PHMASK 0xFFFF
#endif
#define IN(k) (((PHMASK >> (k)) & 1) && lo <= (k) && (k) < hi)
    unsigned* barw = (unsigned*)(ws + WS_CTL) + CW_BAR; volatile LAS unsigned* bst = (volatile LAS unsigned*)((LAS unsigned char*)lds_raw + LDS_BYTES - 64);
    const unsigned my_xcc = xb_xcc_id();
    if (COOP) { if (threadIdx.x == 0) { bst[0] = 0u; bst[1] = 0u; (void)xb_add(&barw[XB_XCNT(my_xcc)], 1u); } __syncthreads(); }
#define SEAM(k) do { if (COOP && IN(k) && IN((k) + 1)) { if (args.ph_hi > 1000) cg::this_grid().sync();   xcd_barrier(barw, bst, my_xcc, wave0 == 0 && lane_id_asm() == 0); } } while (0)
    if (IN(0)) { MKCTX(); ph_prologue(F); } SEAM(0);
    if (IN(1)) {
        constexpr int NSLOT = 4;
        const int wslot = (F.G % 8 == 0) ? ((int)blockIdx.x / 8) % NSLOT : (int)blockIdx.x % NSLOT;
        if (wslot == 0) { MKCTX(); ph_wconv(F); }
        {
            pg8::Gemm g{(const bf16_t*)(ws + WS_H0), (const bf16_t*)(ws + WS_WIN), DM, DM, DM, nullptr}; pg8::StaticOrder S; S.init(T, (PN8_LO + 28 - PN8_HI) * 256, F.G, (int)blockIdx.x, 0, PN8_LO, PN8_HI - PN8_LO);
            const pg8::Epi1 E{(bf16_t*)(ws + WS_YAB), (bf16_t*)(ws + WS_GV), ws + WS_Q, ws + WS_K, ws + WS_V, (bf16_t*)(ws + WS_SA), (bf16_t*)(ws + WS_SB), (float*)(ws + WS_GVST), (float*)(ws + WS_KMEAN), 1.0f, 0.f};
            pg8::gemm_phase<pg8::Epi1, pg8::StaticOrder, true>(F.lds, g, S, E, wave0);
        }
#pragma unroll 1
        for (int hf = 0; hf < 2; ++hf) {
            if (wslot == 1 + hf) { MKCTX(); ph_wconv(F); }
            const pg8::Epi1 E{(bf16_t*)(ws + WS_YAB), (bf16_t*)(ws + WS_GV), ws + WS_Q, ws + WS_K, ws + WS_V, (bf16_t*)(ws + WS_SA), (bf16_t*)(ws + WS_SB), (float*)(ws + WS_GVST), (float*)(ws + WS_KMEAN), 0.03125f, 0.f};
            pg8::Gemm g{(const bf16_t*)(ws + WS_H0F8), (const bf16_t*)(ws + WS_WIN8), DM / 2, DM / 2, DM / 2, nullptr}; pg8::StaticOrder S; S.init(T, (PN8_HI - PN8_LO) / 2 * 256, F.G, (int)blockIdx.x, PN8_LO + hf * ((PN8_HI - PN8_LO) / 2));
            pg8::gemm_phase<pg8::Epi1, pg8::StaticOrder, true, true>(F.lds, g, S, E, wave0);
        }
        if (wslot == 3) { MKCTX(); ph_wconv(F); }
    } SEAM(1);
    if (IN(2)) { MKCTX(); ph_mixer_a(F); __syncthreads(); ph_gate(F); } SEAM(2);
    if (IN(3)) { } if (COOP && IN(3) && IN(4)) { }
    if (IN(4)) { MKCTX(); ph_attn_partial(F); } SEAM(4);
    if (IN(5)) { MKCTX(); ph_attn_own(F); } SEAM(5);
    if (IN(6)) {
        pg8::Gemm g{(const bf16_t*)(ws + WS_YAB), (const bf16_t*)(ws + WS_WAB), 2048, 2048, 2048, nullptr}; pg8::StaticOrder S; S.init(T, DM, F.G, (int)blockIdx.x);
        pg8::Epi2 E{ws + WS_SA, ws + WS_SB, (bf16_t*)(ws + WS_MG)};
        pg8::gemm_phase<pg8::Epi2, pg8::StaticOrder, true>(F.lds, g, S, E, wave0);
    } SEAM(6);
    if (IN(7)) {
        pg8::Gemm g{(const bf16_t*)(ws + WS_MG), (const bf16_t*)(ws + WS_WOUT), DM, DM, DM, nullptr}; pg8::StaticOrder S; S.init(T, DM, F.G, (int)blockIdx.x);
        pg8::Epi3 E{(const bf16_t*)(ws + WS_H0), (bf16_t*)(ws + WS_Z), (float*)(ws + WS_ZST)};
        pg8::gemm_phase<pg8::Epi3, pg8::StaticOrder, true>(F.lds, g, S, E, wave0);
    } SEAM(7);
    if (IN(8)) { MKCTX(); ph_router(F); } SEAM(8);
    if (IN(9)) { } if (COOP && IN(9) && IN(10)) { }
    if (IN(10)) {
        MKCTX(); moe_table(F);
        pg8::Gemm g{(const bf16_t*)(ws + WS_H1F8), (const bf16_t*)(ws + WS_WUP), DM / 2, DM / 2, DM / 2, (const int*)(ws + WS_RT)}; pg8::MoeOrder S;   S.init((const LAS int*)(F.lds + LDS_MOE), 8, F.G, (int)blockIdx.x);
        pg8::Epi4 E{args.in[I_BUP], ws + WS_ACT};
        pg8::gemm_phase<pg8::Epi4, pg8::MoeOrder, true, true, true>(F.lds, g, S, E, wave0);
    } SEAM(10);
    if (IN(11)) {
        MKCTX(); moe_table(F);
        pg8::Gemm g{(const bf16_t*)(ws + WS_ACT), (const bf16_t*)(ws + WS_WDN), FF / 2, FF / 2, FF / 2, nullptr}; pg8::MoeOrder S; S.init((const LAS int*)(F.lds + LDS_MOE), 4, F.G, (int)blockIdx.x);
        pg8::Epi5 E{args.in[I_BDN], (const float*)(ws + WS_RW), ws + WS_YS};
        pg8::gemm_phase<pg8::Epi5, pg8::MoeOrder, true, true>(F.lds, g, S, E, wave0);
    } SEAM(11);
    if (IN(12)) { MKCTX(); moe_table(F); ph_final(F); }
#undef IN
#undef SEAM
}

extern "C" void kernel_launch(void* const* d_in, const int* in_sizes, int n_in, void* d_out, int out_size, void* d_ws, size_t ws_size, hipStream_t stream) {
    static int grid = 0;
    if (grid == 0) {
        if (n_in != 21 || in_sizes[0] != T * DM || out_size != T * DM || ws_size < WS_END) { fprintf(stderr, "kernel_launch: unexpected shapes (n_in %d, in0 %d, out %d, ws %zu)\n", n_in, n_in > 0 ? in_sizes[0] : -1, out_size, ws_size); grid = -1; return; }
        int dev = 0, cus = 0, per_cu = 0;
        hipGetDevice(&dev); hipDeviceGetAttribute(&cus, hipDeviceAttributeMultiprocessorCount, dev);
        const void* fn = MK_COOP ? (const void*)mega<true> : (const void*)mega<false>;
        hipFuncSetAttribute(fn, hipFuncAttributeMaxDynamicSharedMemorySize, LDS_BYTES);
        hipOccupancyMaxActiveBlocksPerMultiprocessor(&per_cu, fn, 512, LDS_BYTES);
        (void)hipGetLastError();
        if (per_cu < 1) { fprintf(stderr, "kernel_launch: occupancy query says %d blocks/CU\n", per_cu); per_cu = 1; }
        grid = cus * 1;
    }
    if (grid < 0) return;
    hipMemsetAsync((char*)d_ws + WS_CTL, 0, CTL_ZERO_BYTES, stream);
    Args a{};
    for (int i = 0; i < 21; ++i) a.in[i] = (const float*)d_in[i];
    a.out = (float*)d_out; a.ws = (unsigned char*)d_ws;
#if MK_COOP
    a.ph_lo = 0; a.ph_hi = NPHASE;
    void* kargs[] = {&a};
    hipError_t e = hipLaunchCooperativeKernel((const void*)mega<true>, dim3(grid), dim3(512), kargs, LDS_BYTES, stream);
    if (e != hipSuccess) fprintf(stderr, "cooperative launch failed: %s (grid %d)\n", hipGetErrorString(e), grid);
#else
    for (int p = 0; p < NPHASE; ++p) { a.ph_lo = p; a.ph_hi = p + 1; hipLaunchKernelGGL(mega<false>, dim3(grid), dim3(512), LDS_BYTES, stream, a); }
#endif
}
```

```cpp
#include <hip/hip_runtime.h>
#include <hip/hip_cooperative_groups.h>
#include <cstdio>
#include <cstdint>
namespace cg = cooperative_groups;

#ifndef MK_COOP
#define MK_COOP 1
#endif

#define LAS __attribute__((address_space(3)))
typedef unsigned short bf16_t;
typedef short bf16x8 __attribute__((ext_vector_type(8)));
typedef float f32x4 __attribute__((ext_vector_type(4)));
typedef float f32x2 __attribute__((ext_vector_type(2)));
typedef unsigned u32x4 __attribute__((ext_vector_type(4)));
typedef unsigned u32x2 __attribute__((ext_vector_type(2)));

constexpr int NB = 8, SEQ = 4096, DM = 1024, T = NB * SEQ;
constexpr int NH = 8, DH = 128, LBLK = 256, NBLK = SEQ / LBLK;
constexpr int NE = 32, TOPK = 4, FF = 1024;
constexpr int INCOLS = 7 * DM;
constexpr int RMAX = T * TOPK + NE * 256;
constexpr float LN_EPS = 1e-5f;
constexpr float ALPHA = 1.189207115002721f;
constexpr float QSCALE = 0.08838834764831845f * 1.4426950408889634f;

constexpr size_t MiB = 1u << 20, U64 = 64 * MiB;
constexpr size_t WS_CTL = 0, CTL_ZERO_BYTES = 1 * MiB;
constexpr int CW_ECNT = 64;
constexpr int CW_LCNT = 1024;
constexpr int CW_BAR = 4096;
constexpr size_t WS_KMEAN = 1 * MiB;
constexpr size_t WS_GVST = 2 * MiB;
constexpr size_t WS_ZST = 6 * MiB;
constexpr size_t WS_SEL = 10 * MiB;
constexpr size_t WS_TKE = 11 * MiB;
constexpr size_t WS_TKW = 11 * MiB + 512 * 1024;
constexpr size_t WS_TKP = 12 * MiB;
constexpr size_t WS_ROWOF = 12 * MiB + 512 * 1024;
constexpr size_t WS_ROWTOK = 13 * MiB;
constexpr size_t WS_ROWW = 14 * MiB;
constexpr size_t WS_TILE = 15 * MiB;
constexpr size_t WS_LISTS = 16 * MiB;
constexpr size_t WS_LSE = 32 * MiB;
constexpr size_t WS_RT = 16 * MiB;
constexpr size_t WS_RW = 20 * MiB;
constexpr int LDS_MOE = 131072 + 1024;
constexpr size_t WS_WIN = 40 * MiB;
constexpr size_t WS_WAB = 54 * MiB;
constexpr size_t WS_WOUT = 58 * MiB;
constexpr size_t WS_WDN = 60 * MiB;
constexpr size_t WS_WUP = 124 * MiB;
constexpr size_t WS_H0 = 4 * U64;
constexpr size_t WS_YAB = 5 * U64;
constexpr size_t WS_GV = 7 * U64;
constexpr size_t WS_Q = 8 * U64, WS_K = 9 * U64, WS_V = 10 * U64, WS_SA = 11 * U64, WS_SB = 12 * U64;
constexpr size_t WS_OP = 13 * U64;
constexpr size_t WS_MG = WS_GV;
constexpr size_t WS_Z = 14 * U64;
constexpr size_t WS_H1 = WS_H0;
constexpr size_t WS_XG = 5 * U64;
constexpr size_t WS_H1F8 = 12 * U64;
constexpr size_t WS_ACT = 9 * U64 + 16 * MiB;
constexpr size_t WS_YS = WS_XG;
constexpr size_t WS_H0F8 = 13 * U64;
constexpr size_t WS_WIN8 = 192 * MiB;
constexpr int PN8_LO = 4, PN8_HI = 28;
constexpr size_t WS_YA8 = 15 * U64;
constexpr size_t WS_END = 16 * U64;
static_assert(WS_XG + (size_t)RMAX * 2048 <= WS_ACT && WS_ACT + (size_t)RMAX * 2048 <= WS_Z, "ws map");

constexpr int LDS_BYTES = 163840;
constexpr int LDS_MISC = 131072;
constexpr int NPHASE = 13;

__device__ __forceinline__ float bf2f(bf16_t v) { return __uint_as_float((unsigned)v << 16); }
__device__ __forceinline__ float bflo(unsigned u) { return __uint_as_float(u << 16); }
__device__ __forceinline__ float bfhi(unsigned u) { return __uint_as_float(u & 0xffff0000u); }
__device__ __forceinline__ unsigned f2bf(float f) { unsigned u = __builtin_bit_cast(unsigned, f); return (u + 0x7fffu + ((u >> 16) & 1u)) >> 16; }
__device__ __forceinline__ unsigned pk2(float lo, float hi) { return f2bf(lo) | (f2bf(hi) << 16); }
typedef __bf16 bf16x2_t __attribute__((ext_vector_type(2)));
__device__ __forceinline__ unsigned cvt_pk_bf16(float lo, float hi) { f32x2 v = {lo, hi}; bf16x2_t b = __builtin_convertvector(v, bf16x2_t); return __builtin_bit_cast(unsigned, b); }
__device__ __forceinline__ int lane_id_asm() { int l; asm volatile("v_mbcnt_lo_u32_b32 %0, -1, 0\n\tv_mbcnt_hi_u32_b32 %0, -1, %0" : "=v"(l)); return l; }
__device__ __forceinline__ float wave_sum(float v) {
#pragma unroll
    for (int o = 1; o < 64; o <<= 1) v += __shfl_xor(v, o);
    return v;
}
__device__ __forceinline__ float wave_max(float v) {
#pragma unroll
    for (int o = 1; o < 64; o <<= 1) v = fmaxf(v, __shfl_xor(v, o));
    return v;
}
__device__ __forceinline__ f32x2 gelu_pk(f32x2 v) {
    const f32x2 av = __builtin_elementwise_abs(v), d = av * 0.2316418882f + 1.0f;
    f32x2 t; t.x = __builtin_amdgcn_rcpf(d.x); t.y = __builtin_amdgcn_rcpf(d.y);
    f32x2 q = t * 0.5307027145f + (-0.7265760135f); q = q * t + 0.7107068705f; q = q * t + (-0.142248368f); q = q * t + 0.127414796f; q = q * t;
    const f32x2 s = (v * v) * (-0.72134752044f);
    f32x2 e; e.x = __builtin_amdgcn_exp2f(s.x); e.y = __builtin_amdgcn_exp2f(s.y);
    const f32x2 m = v * (q * e), r = v - m;
    f32x2 o; o.x = v.x < 0.f ? m.x : r.x; o.y = v.y < 0.f ? m.y : r.y; return o;
}
typedef float f32x2v __attribute__((ext_vector_type(2)));
template <bool HI> __device__ __forceinline__ unsigned f8x2_to_bf16x2(unsigned w) { const f32x2v f = __builtin_amdgcn_cvt_pk_f32_fp8((int)w, HI); return cvt_pk_bf16(f.x, f.y); }
__device__ __forceinline__ u32x4 f8x8_to_bf16x8(unsigned lo, unsigned hi) { return (u32x4){f8x2_to_bf16x2<false>(lo), f8x2_to_bf16x2<true>(lo), f8x2_to_bf16x2<false>(hi), f8x2_to_bf16x2<true>(hi)}; }
__device__ __forceinline__ unsigned pack_fp8x4(float a, float b, float c, float d) { unsigned w = 0u; w = __builtin_amdgcn_cvt_pk_fp8_f32(a, b, w, false); w = __builtin_amdgcn_cvt_pk_fp8_f32(c, d, w, true); return w; }
__device__ __forceinline__ float sigmoidf_(float x) { return __builtin_amdgcn_rcpf(1.0f + __builtin_amdgcn_exp2f(-1.4426950408889634f * x)); }

namespace pg8 {
constexpr int BM = 256, BK = 64, HALF = 128, HTB = HALF * BK * 2, STAGE_BYTES = 8 * HTB, NXCD = 8, WGM = 8;
__host__ __device__ __forceinline__ int lds_byte(int r, int c) { const int st = (r >> 4) * 2 + (c >> 5), rr = r & 15, cc = c & 31, ob = rr * 64 + cc * 2; return st * 1024 + (ob ^ (((ob >> 9) & 1) << 5)); }
__host__ __device__ __forceinline__ void stage_rc(int b, int& R, int& C) { const int st = b / 1024, sb = b % 1024, swz = sb ^ (((sb >> 9) & 1) << 5); R = (st >> 1) * 16 + swz / 64; C = (st & 1) * 32 + (swz % 64) / 2; }
__host__ __device__ __forceinline__ int perm32(int rho) { const int n = rho >> 4, i = rho & 15; return 8 * (i >> 2) + 4 * n + (i & 3); }

struct Unit { int pm, pn, bt, rbase; };
struct Gemm { const bf16_t* A; const bf16_t* Bt; int K, lda, ldb; const int* rowidx; };

struct StaticOrder {
    int nM, nN, nwg, G, c, pbase, psplit, pjump;
    __device__ void init(int M, int N, int G_, int c_, int pbase_ = 0, int psplit_ = 1 << 20, int pjump_ = 0) { nM = M / BM; nN = N / BM; nwg = nM * nN; G = G_; c = c_; pbase = pbase_; psplit = psplit_; pjump = pjump_; }
    __device__ bool next(int i, Unit& u) const {
        const long L = (long)i * G + c; if (L >= nwg) return false;
        int wgid = (int)L; { const int q = nwg / NXCD, r = nwg % NXCD, xcd = wgid % NXCD, off = wgid / NXCD; wgid = (xcd < r ? xcd * (q + 1) : r * (q + 1) + (xcd - r) * q) + off; }
        const int nig = WGM * nN, gid = wgid / nig, fm = gid * WGM, gsz = (nM - fm) < WGM ? (nM - fm) : WGM;
        u.pm = fm + ((wgid % nig) % gsz); const int p = (wgid % nig) / gsz; u.pn = pbase + (p < psplit ? p : p + pjump); u.bt = u.pn; u.rbase = u.pm * BM; return true;
    }
};
struct MoeOrder {
    int nM, nN, nwg, G, c; const LAS int* tab;
    __device__ void init(const LAS int* tiletab, int nN_, int G_, int c_) { nM = tiletab[0]; tab = tiletab; nN = nN_; nwg = nM * nN; G = G_; c = c_; }
    __device__ bool next(int i, Unit& u) const {
        const long L = (long)i * G + c; if (L >= nwg) return false;
        int wgid = (int)L; { const int q = nwg / NXCD, r = nwg % NXCD, xcd = wgid % NXCD, off = wgid / NXCD; wgid = (xcd < r ? xcd * (q + 1) : r * (q + 1) + (xcd - r) * q) + off; }
        const int nig = WGM * nN, gid = wgid / nig, fm = gid * WGM, gsz = (nM - fm) < WGM ? (nM - fm) : WGM;
        u.pm = fm + ((wgid % nig) % gsz); u.pn = (wgid % nig) / gsz; { const int e = tab[128 + 2 * u.pm], tl = tab[129 + 2 * u.pm]; u.bt = e * nN + u.pn; u.rbase = e * T + tl * BM; } return true;
    }
};

typedef int v4i_t __attribute__((ext_vector_type(4)));
typedef int v8i_t __attribute__((ext_vector_type(8)));
template <class Epi, class Sched, bool ALIGN_EPI, bool FP8 = false, bool GATHER = false>
__device__ __forceinline__ void gemm_phase(LAS unsigned char* lds, const Gemm g, const Sched& S, const Epi& E, const int wid) {
    const int lane = lane_id_asm(), tid = wid * 64 + lane;
    const int wr = wid >> 2, wc = wid & 3, fr = lane & 15, fq = lane >> 4;
    const int nt = g.K / BK;
    unsigned voffA[2], voffB[2]; int gR[2];
#pragma unroll
    for (int i = 0; i < 2; ++i) { int R, C; stage_rc(tid * 16 + i * 8192, R, C); const int Rb = Epi::PERM ? ((R & ~31) + perm32(R & 31)) : R;
        voffA[i] = GATHER ? (unsigned)C * 2u : (unsigned)(R * g.lda + C) * 2u; voffB[i] = (unsigned)(Rb * g.ldb + C) * 2u; gR[i] = R; }
    const size_t kstep = (size_t)(BK * 2);
    const size_t hstepA = GATHER ? 0 : (size_t)HALF * g.lda * 2, hstepB = (size_t)HALF * g.ldb * 2;
    const size_t tstepA = 2 * hstepA, tstepB = 2 * hstepB;
    const unsigned ldsw = (unsigned)wid * 1024u;
    const int aoff = lds_byte(wr * 64 + fr, fq * 8), boff = lds_byte(wc * 32 + fr, fq * 8);
#define PG8_SA(b, h) (((b) * 2 + (h)) * HTB)
#define PG8_SB(b, h) ((4 + (b) * 2 + (h)) * HTB)
#define PG8_STAGE(bufoff, gbase, voff) do { _Pragma("unroll") for (int _i = 0; _i < 2; ++_i) \
        __builtin_amdgcn_global_load_lds((const unsigned*)((const char*)(gbase) + (voff)[_i]), (LAS unsigned*)(lds + (bufoff) + ldsw + _i * 8192), 16, 0, 0); } while (0)
#define PG8_LD8(p) __builtin_shufflevector(*(const LAS v4i_t*)(p), *(const LAS v4i_t*)((p) + 1024), 0, 1, 2, 3, 4, 5, 6, 7)
#define PG8_LDA(dst, b, h) do { _Pragma("unroll") for (int m = 0; m < 4; ++m) { if constexpr (FP8) dst##8[m] = PG8_LD8(lds + PG8_SA(b, h) + aoff + m * 2048); \
        else { _Pragma("unroll") for (int k = 0; k < 2; ++k) dst[m][k] = *(const LAS bf16x8*)(lds + PG8_SA(b, h) + aoff + m * 2048 + k * 1024); } } } while (0)
#define PG8_LDB(dst, b, h) do { _Pragma("unroll") for (int n = 0; n < 2; ++n) { if constexpr (FP8) dst##8[n] = PG8_LD8(lds + PG8_SB(b, h) + boff + n * 2048); \
        else { _Pragma("unroll") for (int k = 0; k < 2; ++k) dst[n][k] = *(const LAS bf16x8*)(lds + PG8_SB(b, h) + boff + n * 2048 + k * 1024); } } } while (0)
#define PG8_MMA(ai, bj, At, Bt) do { __builtin_amdgcn_s_setprio(1); _Pragma("unroll") for (int m = 0; m < 4; ++m) _Pragma("unroll") for (int n = 0; n < 2; ++n) { \
        if constexpr (FP8) { asm volatile("s_nop 1\n\tv_mfma_scale_f32_16x16x128_f8f6f4 %0, %1, %2, %0, %3, %3 op_sel_hi:[0,0,0]" : "+v"(acc[ai][bj][m][n]) : "v"(Bt##8[n]), "v"(At##8[m]), "v"(scl8)); } \
        else { _Pragma("unroll") for (int k = 0; k < 2; ++k) acc[ai][bj][m][n] = __builtin_amdgcn_mfma_f32_16x16x32_bf16(Bt[n][k], At[m][k], acc[ai][bj][m][n], 0, 0, 0); } } \
        __builtin_amdgcn_s_setprio(0); } while (0)
#define PG8_WAIT_V(n) asm volatile("s_waitcnt vmcnt(" #n ")" ::: "memory")
#define PG8_WAIT_L(n) asm volatile("s_waitcnt lgkmcnt(" #n ")" ::: "memory")
#define PG8_BAR __builtin_amdgcn_s_barrier()
#define PG8_SCHED __builtin_amdgcn_sched_barrier(0)
    Unit cur, nxt; int ui = 0;
    if (!S.next(0, cur)) return;
    unsigned va0[2], va1[2], vn0[2], vn1[2];
#define PG8_GIDX(dst0, dst1, u) do { if constexpr (GATHER) { _Pragma("unroll") for (int _i = 0; _i < 2; ++_i) { \
        dst0[_i] = min((unsigned)g.rowidx[(u).rbase + gR[_i]], (unsigned)(T - 1)) * (unsigned)(g.lda * 2) + voffA[_i]; dst1[_i] = min((unsigned)g.rowidx[(u).rbase + HALF + gR[_i]], (unsigned)(T - 1)) * (unsigned)(g.lda * 2) + voffA[_i]; } } \
        else { _Pragma("unroll") for (int _i = 0; _i < 2; ++_i) { dst0[_i] = voffA[_i]; dst1[_i] = voffA[_i]; } } } while (0)
    PG8_GIDX(va0, va1, cur);
    f32x4 acc[2][2][4][2];
#pragma unroll
    for (int a = 0; a < 2; ++a)
#pragma unroll
        for (int b = 0; b < 2; ++b)
#pragma unroll
            for (int m = 0; m < 4; ++m)
#pragma unroll
                for (int n = 0; n < 2; ++n) acc[a][b][m][n] = (f32x4){0.f, 0.f, 0.f, 0.f};
    bf16x8 At[4][2], B0[2][2], B1[2][2]; v8i_t At8[4], B08[2], B18[2];
    int scl8 = 0x7f7f7f7f; asm volatile("" : "+v"(scl8));
    const char* cA = (const char*)g.A + (GATHER ? 0 : (size_t)cur.pm * tstepA); const char* cB = (const char*)g.Bt + (size_t)cur.bt * tstepB;
    PG8_STAGE(PG8_SB(0, 0), cB, voffB); PG8_STAGE(PG8_SB(0, 1), cB + hstepB, voffB); PG8_STAGE(PG8_SA(0, 0), cA, va0); PG8_STAGE(PG8_SA(0, 1), cA + hstepA, va1);
    if (wr == 1) PG8_BAR;
    PG8_WAIT_V(2); PG8_BAR;
    PG8_STAGE(PG8_SB(1, 0), cB + kstep, voffB); PG8_STAGE(PG8_SA(1, 0), cA + kstep, va0); PG8_STAGE(PG8_SB(1, 1), cB + hstepB + kstep, voffB);
    PG8_WAIT_V(6); PG8_BAR;
    for (;;) {
        const bool has_next = S.next(ui + 1, nxt);
        const char* nA = (has_next && !GATHER) ? (const char*)g.A + (size_t)nxt.pm * tstepA : cA; const char* nB = has_next ? (const char*)g.Bt + (size_t)nxt.bt * tstepB : cB;
        if (has_next) PG8_GIDX(vn0, vn1, nxt); else { _Pragma("unroll") for (int _i = 0; _i < 2; ++_i) { vn0[_i] = va0[_i]; vn1[_i] = va1[_i]; } }
#pragma unroll 1
        for (int t = 0; t < nt; t += 2) {
            const bool last = (t == nt - 2);
            const char* a1 = cA + (size_t)(t + 1) * kstep;
            const char* a2 = last ? nA : cA + (size_t)(t + 2) * kstep; const char* b2 = last ? nB : cB + (size_t)(t + 2) * kstep;
            const char* a3 = a2 + kstep; const char* b3 = b2 + kstep;
            if constexpr (Epi::MID_T > 0) { if (t == Epi::MID_T) {
                if constexpr (FP8) {
#pragma unroll
                    for (int a = 0; a < 2; ++a)
#pragma unroll
                        for (int b = 0; b < 2; ++b)
                            asm volatile("s_nop 15\n\ts_nop 7" : "+v"(acc[a][b][0][0]), "+v"(acc[a][b][0][1]), "+v"(acc[a][b][1][0]), "+v"(acc[a][b][1][1]), "+v"(acc[a][b][2][0]), "+v"(acc[a][b][2][1]), "+v"(acc[a][b][3][0]), "+v"(acc[a][b][3][1]));
                }
                E.mid(acc, cur, wr, wc, fr, fq); } }
            unsigned vs0[2], vs1[2];
#pragma unroll
            for (int _i = 0; _i < 2; ++_i) { vs0[_i] = last ? vn0[_i] : va0[_i]; vs1[_i] = last ? vn1[_i] : va1[_i]; }
            PG8_LDB(B0, 0, 0); PG8_LDB(B1, 0, 1); PG8_SCHED; PG8_LDA(At, 0, 0); PG8_STAGE(PG8_SA(1, 1), a1 + hstepA, va1);
            PG8_WAIT_V(8); PG8_WAIT_L(0); PG8_BAR; PG8_MMA(0, 0, At, B0); PG8_MMA(0, 1, At, B1); PG8_BAR; PG8_SCHED;
            PG8_LDA(At, 0, 1); PG8_STAGE(PG8_SB(0, 0), b2, voffB); PG8_STAGE(PG8_SB(0, 1), b2 + hstepB, voffB); PG8_STAGE(PG8_SA(0, 0), a2, vs0);
            PG8_WAIT_V(8); PG8_WAIT_L(0); PG8_BAR; PG8_MMA(1, 0, At, B0); PG8_MMA(1, 1, At, B1); PG8_BAR; PG8_SCHED;
            PG8_LDB(B0, 1, 0); PG8_LDB(B1, 1, 1); PG8_SCHED; PG8_LDA(At, 1, 0); PG8_STAGE(PG8_SA(0, 1), a2 + hstepA, vs1);
            PG8_WAIT_V(8); PG8_WAIT_L(0); PG8_BAR; PG8_MMA(0, 0, At, B0); PG8_MMA(0, 1, At, B1); PG8_BAR; PG8_SCHED;
            PG8_LDA(At, 1, 1); PG8_STAGE(PG8_SB(1, 0), b3, voffB); PG8_STAGE(PG8_SB(1, 1), b3 + hstepB, voffB); PG8_STAGE(PG8_SA(1, 0), a3, vs0);
            PG8_WAIT_V(8); PG8_WAIT_L(0); PG8_BAR; PG8_MMA(1, 0, At, B0); PG8_MMA(1, 1, At, B1); PG8_BAR; PG8_SCHED;
        }
        if constexpr (ALIGN_EPI) { if (wr == 0) PG8_BAR; }
        if constexpr (FP8) {
#pragma unroll
            for (int a = 0; a < 2; ++a)
#pragma unroll
                for (int b = 0; b < 2; ++b)
                    asm volatile("s_nop 15\n\ts_nop 7" : "+v"(acc[a][b][0][0]), "+v"(acc[a][b][0][1]), "+v"(acc[a][b][1][0]), "+v"(acc[a][b][1][1]), "+v"(acc[a][b][2][0]), "+v"(acc[a][b][2][1]), "+v"(acc[a][b][3][0]), "+v"(acc[a][b][3][1]));
        }
        E(acc, cur, wr, wc, fr, fq);
        if (!has_next) break;
#pragma unroll
        for (int a = 0; a < 2; ++a)
#pragma unroll
            for (int b = 0; b < 2; ++b)
#pragma unroll
                for (int m = 0; m < 4; ++m)
#pragma unroll
                    for (int n = 0; n < 2; ++n) acc[a][b][m][n] = (f32x4){0.f, 0.f, 0.f, 0.f};
        cur = nxt; cA = nA; cB = nB; ++ui;
#pragma unroll
        for (int _i = 0; _i < 2; ++_i) { va0[_i] = vn0[_i]; va1[_i] = vn1[_i]; }
        if constexpr (ALIGN_EPI) { if (wr == 1) PG8_BAR; }
    }
    PG8_WAIT_V(0);
    if constexpr (!ALIGN_EPI) { if (wr == 0) PG8_BAR; }
    PG8_BAR;
#undef PG8_SA
#undef PG8_SB
#undef PG8_STAGE
#undef PG8_GIDX
#undef PG8_LDA
#undef PG8_LDB
#undef PG8_MMA
#undef PG8_LD8
#undef PG8_WAIT_V
#undef PG8_WAIT_L
#undef PG8_BAR
#undef PG8_SCHED
}

typedef f32x4 Acc[2][2][4][2];

__device__ __forceinline__ u32x4 pair16(u32x2 x, u32x2 y) {
    const auto r0 = __builtin_amdgcn_permlane16_swap(x.x, y.x, false, false);
    const auto r1 = __builtin_amdgcn_permlane16_swap(x.y, y.y, false, false);
    return (u32x4){r0[0], r1[0], r0[1], r1[1]};
}
struct Epi1 {
    static constexpr bool PERM = true; static constexpr int MID_T = 0;
    bf16_t *yab, *gv; unsigned char *q, *k, *v; bf16_t *sa, *sb; float* gvst; float* kmp; float sc, pad_;
    template <int MODE  >
    __device__ __forceinline__ void run(const Acc& acc, const Unit& u, int wr, int wc, int fr, int fq, bf16_t* base, int ld) const {
        const int row0 = u.pm * BM + wr * 64 + fr, col0 = (u.pn & 3) * 256 + wc * 32 + 8 * fq;
        const int colp = (u.pn & 3) * 256 + wc * 32 + 8 * (fq & ~1);
        f32x4 csA0 = {0.f, 0.f, 0.f, 0.f}, csB0 = csA0, csA1 = csA0, csB1 = csA0;
#pragma unroll
        for (int ai = 0; ai < 2; ++ai)
#pragma unroll
            for (int mp = 0; mp < 2; ++mp) {
                u32x2 pc[2][2];
#pragma unroll
                for (int k = 0; k < 2; ++k) {
                    const int m = 2 * mp + k;
                    const int row = row0 + ai * HALF + m * 16; bf16_t* rowp = base + (size_t)row * ld + col0;
                    float s1 = 0.f, s2 = 0.f;
#pragma unroll
                    for (int bj = 0; bj < 2; ++bj) {
                        f32x4 v0 = acc[ai][bj][m][0], v1 = acc[ai][bj][m][1];
                        if (MODE == 2 || MODE == 3 || MODE == 5) {
                            const float f = (MODE == 2) ? sc * QSCALE : sc; v0 = v0 * f; v1 = v1 * f;
                            if (MODE == 5) { if (bj == 0) { csA0 = csA0 + v0; csB0 = csB0 + v1; } else { csA1 = csA1 + v0; csB1 = csB1 + v1; } }
                            pc[bj][k] = (u32x2){pack_fp8x4(v0[0], v0[1], v0[2], v0[3]), pack_fp8x4(v1[0], v1[1], v1[2], v1[3])};
                            continue;
                        }
                        if (MODE == 0 || MODE == 1) {
                            v0 = v0 * sc; v1 = v1 * sc;
                            f32x2 a = gelu_pk((f32x2){v0[0], v0[1]}), b = gelu_pk((f32x2){v0[2], v0[3]}), c = gelu_pk((f32x2){v1[0], v1[1]}), d = gelu_pk((f32x2){v1[2], v1[3]});
                            v0 = (f32x4){a.x, a.y, b.x, b.y}; v1 = (f32x4){c.x, c.y, d.x, d.y};
                        } else if (MODE == 4) {
                            { const float cs_ = -1.4426950408889634f * sc; const f32x4 t0 = v0 * cs_, t1 = v1 * cs_; f32x4 e0, e1;
#pragma unroll
                              for (int j = 0; j < 4; ++j) { e0[j] = __builtin_amdgcn_exp2f(t0[j]); e1[j] = __builtin_amdgcn_exp2f(t1[j]); }
                              e0 = e0 + 1.0f; e1 = e1 + 1.0f;
#pragma unroll
                              for (int j = 0; j < 4; ++j) { v0[j] = __builtin_amdgcn_rcpf(e0[j]); v1[j] = __builtin_amdgcn_rcpf(e1[j]); } }
                            pc[bj][k] = (u32x2){pack_fp8x4(v0[0], v0[1], v0[2], v0[3]), pack_fp8x4(v1[0], v1[1], v1[2], v1[3])};
                            continue;
                        }
                        if (MODE == 1) {
                            s1 += (v0[0] + v0[1]) + (v0[2] + v0[3]) + (v1[0] + v1[1]) + (v1[2] + v1[3]);
                            s2 += (v0[0] * v0[0] + v0[1] * v0[1]) + (v0[2] * v0[2] + v0[3] * v0[3]) + (v1[0] * v1[0] + v1[1] * v1[1]) + (v1[2] * v1[2] + v1[3] * v1[3]);
                            pc[bj][k] = (u32x2){pack_fp8x4(v0[0], v0[1], v0[2], v0[3]), pack_fp8x4(v1[0], v1[1], v1[2], v1[3])};
                            continue;
                        }
                        u32x4 w; w.x = cvt_pk_bf16(v0[0], v0[1]); w.y = cvt_pk_bf16(v0[2], v0[3]); w.z = cvt_pk_bf16(v1[0], v1[1]); w.w = cvt_pk_bf16(v1[2], v1[3]);
                        *(u32x4*)(rowp + bj * HALF) = w;
                    }
                    if (MODE == 1) {
                        s1 += __shfl_xor(s1, 16); s1 += __shfl_xor(s1, 32); s2 += __shfl_xor(s2, 16); s2 += __shfl_xor(s2, 32);
                        if (fq == 0) *(f32x2*)(gvst + ((size_t)row * 16 + (u.pn & 3) * 4 + wc) * 2) = (f32x2){s1, s2};
                    }
                }
                if (MODE != 0) {
                    const int rowst = row0 + ai * HALF + (2 * mp + (fq & 1)) * 16;
#pragma unroll
                    for (int bj = 0; bj < 2; ++bj) *(u32x4*)((unsigned char*)base + (size_t)rowst * 1024 + colp + bj * HALF) = pair16(pc[bj][0], pc[bj][1]);
                }
            }
        if (MODE == 5) {
#define KM_RED(v) do { _Pragma("unroll") for (int j_ = 0; j_ < 4; ++j_) { float x = v[j_]; x += __shfl_xor(x, 1); x += __shfl_xor(x, 2); x += __shfl_xor(x, 4); x += __shfl_xor(x, 8); v[j_] = x; } } while (0)
            KM_RED(csA0); KM_RED(csB0); KM_RED(csA1); KM_RED(csB1);
#undef KM_RED
            if (fr == 0) {
                float* kp = kmp + ((size_t)(u.pm * 2 + wr) * DM) + col0;
                *(f32x4*)kp = csA0; *(f32x4*)(kp + 4) = csB0; *(f32x4*)(kp + HALF) = csA1; *(f32x4*)(kp + HALF + 4) = csB1;
            }
        }
    }
    __device__ __forceinline__ void operator()(const Acc& acc, const Unit& u, int wr, int wc, int fr, int fq) const {
        const int region = u.pn >> 2;
        if (region == 0) run<0>(acc, u, wr, wc, fr, fq, yab, 2048);
        else if (region == 1) run<1>(acc, u, wr, wc, fr, fq, gv, 1024);
        else if (region == 2) run<2>(acc, u, wr, wc, fr, fq, (bf16_t*)q, 1024);
        else if (region == 3) run<5>(acc, u, wr, wc, fr, fq, (bf16_t*)k, 1024);
        else if (region == 4) run<3>(acc, u, wr, wc, fr, fq, (bf16_t*)v, 1024);
        else if (region == 5) run<4>(acc, u, wr, wc, fr, fq, sa, 1024);
        else run<4>(acc, u, wr, wc, fr, fq, sb, 1024);
    }
    __device__ __forceinline__ void mid(Acc&, const Unit&, int, int, int, int) const {}
};

struct Epi2 {
    static constexpr bool PERM = true; static constexpr int MID_T = 8;
    const unsigned char *sa, *sb; bf16_t* mg;
    __device__ __forceinline__ void mid(Acc& acc, const Unit& u, int wr, int wc, int fr, int fq) const {
        int row0 = u.pm * BM + wr * 64 + fr, col0 = u.pn * BM + wc * 32 + 8 * fq;
        asm volatile("" : "+v"(row0), "+v"(col0));
#pragma unroll
        for (int ai = 0; ai < 2; ++ai)
#pragma unroll
            for (int m = 0; m < 4; ++m) {
                const size_t off = (size_t)(row0 + ai * HALF + m * 16) * DM + col0;
#pragma unroll
                for (int bj = 0; bj < 2; ++bj) {
                    const u32x2 a = *(const u32x2*)(sa + off + bj * HALF), b = *(const u32x2*)(sb + off + bj * HALF);
                    const f32x2v a0 = __builtin_amdgcn_cvt_pk_f32_fp8((int)a.x, false), a1 = __builtin_amdgcn_cvt_pk_f32_fp8((int)a.x, true), a2 = __builtin_amdgcn_cvt_pk_f32_fp8((int)a.y, false), a3 = __builtin_amdgcn_cvt_pk_f32_fp8((int)a.y, true);
                    const f32x2v b0 = __builtin_amdgcn_cvt_pk_f32_fp8((int)b.x, false), b1 = __builtin_amdgcn_cvt_pk_f32_fp8((int)b.x, true), b2 = __builtin_amdgcn_cvt_pk_f32_fp8((int)b.y, false), b3 = __builtin_amdgcn_cvt_pk_f32_fp8((int)b.y, true);
                    f32x4 r0, r1;
#define RQ(x, y) ((x) * __builtin_amdgcn_rcpf(y))
                    r0[0] = RQ(a0.x, b0.x); r0[1] = RQ(a0.y, b0.y); r0[2] = RQ(a1.x, b1.x); r0[3] = RQ(a1.y, b1.y);
                    r1[0] = RQ(a2.x, b2.x); r1[1] = RQ(a2.y, b2.y); r1[2] = RQ(a3.x, b3.x); r1[3] = RQ(a3.y, b3.y);
#undef RQ
                    acc[ai][bj][m][0] = acc[ai][bj][m][0] * r0; acc[ai][bj][m][1] = acc[ai][bj][m][1] * r1;
                }
                asm volatile("" : "+v"(acc[ai][0][m][0]), "+v"(acc[ai][0][m][1]), "+v"(acc[ai][1][m][0]), "+v"(acc[ai][1][m][1]));
                asm volatile("" ::: "memory");
            }
    }
    __device__ __forceinline__ void operator()(const Acc& acc, const Unit& u, int wr, int wc, int fr, int fq) const {
        const int row0 = u.pm * BM + wr * 64 + fr, col0 = u.pn * BM + wc * 32 + 8 * fq;
#pragma unroll
        for (int ai = 0; ai < 2; ++ai)
#pragma unroll
            for (int m = 0; m < 4; ++m) {
                const size_t off = (size_t)(row0 + ai * HALF + m * 16) * DM + col0;
#pragma unroll
                for (int bj = 0; bj < 2; ++bj) {
                    const u32x2 b = *(const u32x2*)(sb + off + bj * HALF);
                    const f32x2v b0 = __builtin_amdgcn_cvt_pk_f32_fp8((int)b.x, false), b1 = __builtin_amdgcn_cvt_pk_f32_fp8((int)b.x, true), b2 = __builtin_amdgcn_cvt_pk_f32_fp8((int)b.y, false), b3 = __builtin_amdgcn_cvt_pk_f32_fp8((int)b.y, true);
                    const f32x4 v0 = acc[ai][bj][m][0] * 0.03125f, v1 = acc[ai][bj][m][1] * 0.03125f;
                    u32x4 w; w.x = cvt_pk_bf16(v0[0] * b0.x, v0[1] * b0.y); w.y = cvt_pk_bf16(v0[2] * b1.x, v0[3] * b1.y);
                    w.z = cvt_pk_bf16(v1[0] * b2.x, v1[1] * b2.y); w.w = cvt_pk_bf16(v1[2] * b3.x, v1[3] * b3.y);
                    *(u32x4*)(mg + off + bj * HALF) = w;
                }
            }
    }
};

struct Epi3 {
    static constexpr bool PERM = true; static constexpr int MID_T = 0;
    const bf16_t* h0; bf16_t* z; float* zst;
    __device__ __forceinline__ void mid(Acc&, const Unit&, int, int, int, int) const {}
    __device__ __forceinline__ void operator()(const Acc& acc, const Unit& u, int wr, int wc, int fr, int fq) const {
        const int row0 = u.pm * BM + wr * 64 + fr, col0 = u.pn * BM + wc * 32 + 8 * fq;
#pragma unroll
        for (int ai = 0; ai < 2; ++ai)
#pragma unroll
            for (int m = 0; m < 4; ++m) {
                const int row = row0 + ai * HALF + m * 16; const size_t off = (size_t)row * DM + col0;
                float s1 = 0.f, s2 = 0.f;
#pragma unroll
                for (int bj = 0; bj < 2; ++bj) {
                    const u32x4 hb = *(const u32x4*)(h0 + off + bj * HALF);
                    f32x4 v0 = acc[ai][bj][m][0], v1 = acc[ai][bj][m][1];
                    v0[0] += ALPHA * bflo(hb.x); v0[1] += ALPHA * bfhi(hb.x); v0[2] += ALPHA * bflo(hb.y); v0[3] += ALPHA * bfhi(hb.y);
                    v1[0] += ALPHA * bflo(hb.z); v1[1] += ALPHA * bfhi(hb.z); v1[2] += ALPHA * bflo(hb.w); v1[3] += ALPHA * bfhi(hb.w);
                    s1 += ((v0[0] + v0[1]) + (v0[2] + v0[3])) + ((v1[0] + v1[1]) + (v1[2] + v1[3]));
                    s2 += ((v0[0] * v0[0] + v0[1] * v0[1]) + (v0[2] * v0[2] + v0[3] * v0[3])) + ((v1[0] * v1[0] + v1[1] * v1[1]) + (v1[2] * v1[2] + v1[3] * v1[3]));
                    *(u32x4*)(z + off + bj * HALF) = (u32x4){cvt_pk_bf16(v0[0], v0[1]), cvt_pk_bf16(v0[2], v0[3]), cvt_pk_bf16(v1[0], v1[1]), cvt_pk_bf16(v1[2], v1[3])};
                }
                s1 += __shfl_xor(s1, 16); s1 += __shfl_xor(s1, 32); s2 += __shfl_xor(s2, 16); s2 += __shfl_xor(s2, 32);
                if (fq == 0) *(f32x2*)(zst + ((size_t)row * 16 + u.pn * 4 + wc) * 2) = (f32x2){s1, s2};
            }
    }
};

struct Epi4 {
    static constexpr bool PERM = true; static constexpr int MID_T = 0;
    const float* b_up; unsigned char* act;
    __device__ __forceinline__ void mid(Acc&, const Unit&, int, int, int, int) const {}
    __device__ __forceinline__ void operator()(const Acc& acc, const Unit& u, int wr, int wc, int fr, int fq) const {
        const int e = u.bt >> 3;
        const int row0 = u.pm * BM + wr * 64 + fr, c0 = u.pn * HALF + wc * 32 + 8 * fq;
        const float* bg = b_up + (size_t)e * 2 * FF + c0; const float* bu = bg + FF;
        const f32x4 bg0 = *(const f32x4*)bg, bg1 = *(const f32x4*)(bg + 4), bu0 = *(const f32x4*)bu, bu1 = *(const f32x4*)(bu + 4);
        const int cp = u.pn * HALF + wc * 32 + 8 * (fq & ~1);
#pragma unroll
        for (int ai = 0; ai < 2; ++ai)
#pragma unroll
            for (int mp = 0; mp < 2; ++mp) {
                u32x2 pc[2];
#pragma unroll
                for (int k = 0; k < 2; ++k) {
                    const int m = 2 * mp + k;
                    float o[8];
#pragma unroll
                    for (int n = 0; n < 2; ++n)
#pragma unroll
                        for (int jp = 0; jp < 2; ++jp) {
                            const int j = 2 * jp;
                            const f32x2 ag = {acc[ai][0][m][n][j], acc[ai][0][m][n][j + 1]}, au = {acc[ai][1][m][n][j], acc[ai][1][m][n][j + 1]};
                            const f32x2 vbg = n ? (f32x2){bg1[j], bg1[j + 1]} : (f32x2){bg0[j], bg0[j + 1]}, vbu = n ? (f32x2){bu1[j], bu1[j + 1]} : (f32x2){bu0[j], bu0[j + 1]};
                            f32x2 gg = ag * 0.03125f + vbg, uu = au * 0.03125f + vbu;
                            gg.x = fminf(gg.x, 7.0f); gg.y = fminf(gg.y, 7.0f);
                            uu.x = __builtin_amdgcn_fmed3f(uu.x, -7.0f, 7.0f); uu.y = __builtin_amdgcn_fmed3f(uu.y, -7.0f, 7.0f);
                            const f32x2 t = gg * (-1.702f * 1.4426950408889634f);
                            f32x2 ex; ex.x = __builtin_amdgcn_exp2f(t.x); ex.y = __builtin_amdgcn_exp2f(t.y);
                            const f32x2 d = ex + 1.0f;
                            f32x2 rc; rc.x = __builtin_amdgcn_rcpf(d.x); rc.y = __builtin_amdgcn_rcpf(d.y);
                            const f32x2 res = (uu + 1.0f) * (gg * rc);
                            o[n * 4 + j] = res.x; o[n * 4 + j + 1] = res.y;
                        }
                    unsigned w0 = 0u, w1 = 0u;
                    w0 = __builtin_amdgcn_cvt_pk_fp8_f32(o[0], o[1], w0, false); w0 = __builtin_amdgcn_cvt_pk_fp8_f32(o[2], o[3], w0, true);
                    w1 = __builtin_amdgcn_cvt_pk_fp8_f32(o[4], o[5], w1, false); w1 = __builtin_amdgcn_cvt_pk_fp8_f32(o[6], o[7], w1, true);
                    pc[k] = (u32x2){w0, w1};
                }
                const int rowst = row0 + ai * HALF + (2 * mp + (fq & 1)) * 16;
                *(u32x4*)(act + (size_t)rowst * FF + cp) = pair16(pc[0], pc[1]);
            }
    }
};

struct Epi5 {
    static constexpr bool PERM = true; static constexpr int MID_T = 0;
    const float* b_down; const float* roww; unsigned char* ys;
    __device__ __forceinline__ void mid(Acc&, const Unit&, int, int, int, int) const {}
    __device__ __forceinline__ void operator()(const Acc& acc, const Unit& u, int wr, int wc, int fr, int fq) const {
        const int e = u.bt >> 2;
        const int row0 = u.pm * BM + wr * 64 + fr, col0 = u.pn * BM + wc * 32 + 8 * fq;
        f32x4 bv[2][2];
#pragma unroll
        for (int bj = 0; bj < 2; ++bj)
#pragma unroll
            for (int n = 0; n < 2; ++n) bv[bj][n] = *(const f32x4*)(b_down + (size_t)e * DM + col0 + bj * HALF + 4 * n);
        float rwv[2][4];
#pragma unroll
        for (int ai = 0; ai < 2; ++ai)
#pragma unroll
            for (int m = 0; m < 4; ++m) rwv[ai][m] = roww[u.rbase + wr * 64 + fr + ai * HALF + m * 16];
        asm volatile("" ::: "memory");
        const int colp = u.pn * BM + wc * 32 + 8 * (fq & ~1);
#pragma unroll
        for (int ai = 0; ai < 2; ++ai)
#pragma unroll
            for (int mp = 0; mp < 2; ++mp) {
                const int rowst = row0 + ai * HALF + (2 * mp + (fq & 1)) * 16;
#pragma unroll
                for (int bj = 0; bj < 2; ++bj) {
                    u32x2 pc[2];
#pragma unroll
                    for (int k = 0; k < 2; ++k) { const int m = 2 * mp + k; const float rw16 = rwv[ai][m] * 16.0f;
                        const f32x4 v0 = (acc[ai][bj][m][0] * 0.015625f + bv[bj][0]) * rw16, v1 = (acc[ai][bj][m][1] * 0.015625f + bv[bj][1]) * rw16;
                        pc[k] = (u32x2){pack_fp8x4(v0[0], v0[1], v0[2], v0[3]), pack_fp8x4(v1[0], v1[1], v1[2], v1[3])}; }
                    *(u32x4*)(ys + (size_t)rowst * DM + colp + bj * HALF) = pair16(pc[0], pc[1]);
                }
            }
    }
};
}

struct Args { const float* in[21]; float* out; unsigned char* ws; int ph_lo, ph_hi; };
enum { I_X = 0, I_LNIN_G, I_LNIN_B, I_WIN, I_GLN_G, I_GLN_B, I_WSP, I_BSP, I_WBA, I_WBB, I_WOUT, I_LNMIX_G, I_LNMIX_B, I_WR, I_BR, I_WUP, I_BUP, I_WDN, I_BDN, I_LNF_G, I_LNF_B };

struct Ctx { const Args* a; unsigned char* ws; LAS unsigned char* lds; unsigned char* ldsg; int tid, lane, wave, G, vcu; };

__device__ __forceinline__ void tr_item(const float* W, int N, int k0, int n0, bf16_t* dst, int drow0, int dld, int dcol0, LAS float* scr, int lane) {
#pragma unroll 8
    for (int i = 0; i < 32; ++i) { const int kk = 2 * i + (lane >> 5); scr[kk * 33 + (lane & 31)] = __builtin_nontemporal_load(W + (size_t)(k0 + kk) * N + n0 + (lane & 31)); }
    asm volatile("s_waitcnt lgkmcnt(0)" ::: "memory");
    const int c = lane & 7;
#pragma unroll
    for (int j = 0; j < 4; ++j) { const int n = (lane >> 3) + 8 * j; const LAS float* s = scr + (8 * c) * 33 + n;
        u32x4 o; o.x = pk2(s[0 * 33], s[1 * 33]); o.y = pk2(s[2 * 33], s[3 * 33]); o.z = pk2(s[4 * 33], s[5 * 33]); o.w = pk2(s[6 * 33], s[7 * 33]);
        *(u32x4*)(dst + (size_t)(drow0 + n) * dld + dcol0 + k0 + 8 * c) = o; }
    asm volatile("s_waitcnt lgkmcnt(0)" ::: "memory");
}
template <bool DEEP = false>
__device__ __forceinline__ void tr_item8(const float* W, int N, int k0, int n0, unsigned char* dst, int drow0, int dld, float sc, LAS float* scr, int lane) {
    if constexpr (DEEP) {
        float v[32];
#pragma unroll
        for (int i = 0; i < 32; ++i) v[i] = __builtin_nontemporal_load(W + (size_t)(k0 + 2 * i + (lane >> 5)) * N + n0 + (lane & 31));
#pragma unroll
        for (int i = 0; i < 32; ++i) scr[(2 * i + (lane >> 5)) * 33 + (lane & 31)] = v[i];
    } else {
#pragma unroll 8
        for (int i = 0; i < 32; ++i) { const int kk = 2 * i + (lane >> 5); scr[kk * 33 + (lane & 31)] = __builtin_nontemporal_load(W + (size_t)(k0 + kk) * N + n0 + (lane & 31)); }
    }
    asm volatile("s_waitcnt lgkmcnt(0)" ::: "memory");
    const int c = lane & 7;
#pragma unroll
    for (int j = 0; j < 4; ++j) { const int n = (lane >> 3) + 8 * j; const LAS float* s = scr + (8 * c) * 33 + n;
        unsigned w0 = 0u, w1 = 0u;
        w0 = __builtin_amdgcn_cvt_pk_fp8_f32(s[0 * 33] * sc, s[1 * 33] * sc, w0, false); w0 = __builtin_amdgcn_cvt_pk_fp8_f32(s[2 * 33] * sc, s[3 * 33] * sc, w0, true);
        w1 = __builtin_amdgcn_cvt_pk_fp8_f32(s[4 * 33] * sc, s[5 * 33] * sc, w1, false); w1 = __builtin_amdgcn_cvt_pk_fp8_f32(s[6 * 33] * sc, s[7 * 33] * sc, w1, true);
        *(u32x2*)(dst + (size_t)(drow0 + n) * dld + k0 + 8 * c) = (u32x2){w0, w1}; }
    asm volatile("s_waitcnt lgkmcnt(0)" ::: "memory");
}
__device__ __forceinline__ void ph_prologue(const Ctx& F) {
    const Args& A = *F.a;
    LAS float* scr = (LAS float*)(F.lds + F.wave * 16384);
    const int gw = F.vcu * 8 + F.wave, NGW = F.G * 8;
    bf16_t* WIN = (bf16_t*)(F.ws + WS_WIN); bf16_t* WOUT = (bf16_t*)(F.ws + WS_WOUT);
    constexpr int I_IN = 16 * (INCOLS / 32), I_SQ = 16 * 32;
    constexpr int NITEMS = I_IN + 3 * I_SQ;
    for (int it = gw; it < NITEMS; it += NGW) {
        int r = it;
        if (r < I_IN) { const int nblk = INCOLS / 32, kb = r / nblk, nb = r % nblk;
            if (32 * nb >= PN8_LO * 256 && 32 * nb < PN8_HI * 256) tr_item8(A.in[I_WIN], INCOLS, 64 * kb, 32 * nb, F.ws + WS_WIN8, 32 * nb, DM, 32.0f, scr, F.lane);
            else tr_item(A.in[I_WIN], INCOLS, 64 * kb, 32 * nb, WIN, 32 * nb, DM, 0, scr, F.lane);
            continue; } r -= I_IN;
        if (r < I_SQ) { const int kb = r / 32, nb = r % 32; tr_item8(A.in[I_WBA], DM, 64 * kb, 32 * nb, F.ws + WS_WAB, 32 * nb, 2048, 32.0f, scr, F.lane); continue; } r -= I_SQ;
        if (r < I_SQ) { const int kb = r / 32, nb = r % 32; tr_item8(A.in[I_WBB], DM, 64 * kb, 32 * nb, F.ws + WS_WAB + 1024, 32 * nb, 2048, 32.0f, scr, F.lane); continue; } r -= I_SQ;
        { const int kb = r / 32, nb = r % 32; tr_item(A.in[I_WOUT], DM, 64 * kb, 32 * nb, WOUT, 32 * nb, DM, 0, scr, F.lane); }
    }
    const float* lg = A.in[I_LNIN_G]; const float* lb = A.in[I_LNIN_B]; bf16_t* H0 = (bf16_t*)(F.ws + WS_H0);
    f32x4 gg[4], bb[4];
#pragma unroll
    for (int j = 0; j < 4; ++j) { gg[j] = *((const f32x4*)lg + F.lane + 64 * j); bb[j] = *((const f32x4*)lb + F.lane + 64 * j); }
    for (int m = gw; m < T; m += NGW) {
        const f32x4* xr = (const f32x4*)(A.in[I_X] + (size_t)m * DM) + F.lane;
        f32x4 v[4]; float s = 0.f;
#pragma unroll
        for (int j = 0; j < 4; ++j) { v[j] = __builtin_nontemporal_load(xr + 64 * j); s += (v[j].x + v[j].y) + (v[j].z + v[j].w); }
        const float mean = wave_sum(s) * (1.f / DM); float s2 = 0.f;
#pragma unroll
        for (int j = 0; j < 4; ++j) { v[j] = v[j] - mean; s2 += (v[j].x * v[j].x + v[j].y * v[j].y) + (v[j].z * v[j].z + v[j].w * v[j].w); }
        const float rstd = 1.f / sqrtf(wave_sum(s2) * (1.f / DM) + LN_EPS);
        u32x2* o8 = (u32x2*)(H0 + (size_t)m * DM) + F.lane; unsigned* o4 = (unsigned*)(F.ws + WS_H0F8 + (size_t)m * DM) + F.lane;
#pragma unroll
        for (int j = 0; j < 4; ++j) { const f32x4 y = v[j] * rstd * gg[j] + bb[j]; o8[64 * j] = (u32x2){pk2(y.x, y.y), pk2(y.z, y.w)}; o4[64 * j] = pack_fp8x4(y.x, y.y, y.z, y.w); }
    }
}

struct WItem { const float* src; unsigned char* dst; int N, dld; float sc; };
__device__ __forceinline__ void w_load(const WItem& w, float (&v)[64], int lane) {
    const float* src = w.src + (size_t)(lane >> 5) * w.N + (lane & 31);
#pragma unroll
    for (int i = 0; i < 64; ++i) v[i] = __builtin_nontemporal_load(src + (size_t)(2 * i) * w.N);
}
__device__ __forceinline__ void w_scatter(const float (&v)[64], LAS float* scr, int lane) {
    LAS float* d = scr + (lane & 31) * 130 + (lane >> 5);
#pragma unroll
    for (int i = 0; i < 64; ++i) d[2 * i] = v[i];
}
__device__ __forceinline__ void w_emit(const WItem& w, LAS const float* scr, int lane) {
    asm volatile("s_waitcnt lgkmcnt(0)" ::: "memory");
    const int c = lane & 7; const float sc = w.sc;
#pragma unroll
    for (int j = 0; j < 4; ++j) {
        const int nn = (lane >> 3) + 8 * j; const LAS float* sp = scr + nn * 130 + 16 * c;
        f32x2 a[8];
#pragma unroll
        for (int q = 0; q < 8; ++q) a[q] = *(LAS const f32x2*)(sp + 2 * q);
        u32x4 o;
        o.x = pack_fp8x4(a[0].x * sc, a[0].y * sc, a[1].x * sc, a[1].y * sc); o.y = pack_fp8x4(a[2].x * sc, a[2].y * sc, a[3].x * sc, a[3].y * sc);
        o.z = pack_fp8x4(a[4].x * sc, a[4].y * sc, a[5].x * sc, a[5].y * sc); o.w = pack_fp8x4(a[6].x * sc, a[6].y * sc, a[7].x * sc, a[7].y * sc);
        *(u32x4*)(w.dst + (size_t)nn * w.dld + 16 * c) = o;
    }
    asm volatile("s_waitcnt lgkmcnt(0)" ::: "memory");
}
__device__ __forceinline__ WItem w_decode(const Ctx& F, int r) {
    const Args& A = *F.a;
    constexpr int I_UP = NE * 8 * 64;
    WItem w;
    if (r < I_UP) { const int e = r / (8 * 64), rr = r % (8 * 64), kb = rr / 64, nb = rr % 64; const int n0 = 32 * nb, half = n0 >= FF, rem = n0 - half * FF, pn = rem >> 7, b = (rem & 127) >> 5;
        w.src = A.in[I_WUP] + (size_t)e * DM * 2 * FF + (size_t)(128 * kb) * (2 * FF) + n0; w.N = 2 * FF; w.dst = F.ws + WS_WUP + (size_t)(e * 2048 + 256 * pn + half * 128 + 32 * b) * DM + 128 * kb; w.dld = DM; w.sc = 32.0f; }
    else { r -= I_UP; const int e = r / (8 * 32), rr = r % (8 * 32), kb = rr / 32, nb = rr % 32;
        w.src = A.in[I_WDN] + (size_t)e * FF * DM + (size_t)(128 * kb) * DM + 32 * nb; w.N = DM; w.dst = F.ws + WS_WDN + (size_t)(e * 1024 + 32 * nb) * FF + 128 * kb; w.dld = FF; w.sc = 64.0f; }
    return w;
}
__device__ __forceinline__ void ph_wconv(const Ctx& F) {
    LAS float* scr = (LAS float*)(F.lds + F.wave * 16640);
    constexpr int NIT = NE * 8 * 64 + NE * 8 * 32;
    const int chunk = (NIT + F.G - 1) / F.G, lo = (int)blockIdx.x * chunk, hi = (lo + chunk < NIT) ? lo + chunk : NIT;
    __syncthreads();
    int it = lo + F.wave;
    if (it < hi) {
        float v[64];
        WItem cur = w_decode(F, it);
        w_load(cur, v, F.lane);
        for (;;) {
            w_scatter(v, scr, F.lane);
            const int itn = it + 8; const bool more = itn < hi;
            WItem nxt = cur;
            if (more) { nxt = w_decode(F, itn); w_load(nxt, v, F.lane); }
            w_emit(cur, scr, F.lane);
            if (!more) break;
            cur = nxt; it = itn;
        }
    }
    asm volatile("s_waitcnt vmcnt(0)" ::: "memory");
    __syncthreads();
}

typedef short v4i16_t __attribute__((ext_vector_type(4)));
__device__ __forceinline__ v4i16_t lds_tr16(LAS const unsigned char* p) { return __builtin_amdgcn_ds_read_tr16_b64_v4i16((LAS v4i16_t*)p); }
__device__ __forceinline__ void ph_mixer_a(const Ctx& F) {
    const Args& A = *F.a;
    const unsigned char* GV = F.ws + WS_GV; bf16_t* YAB = (bf16_t*)(F.ws + WS_YAB); const float* GVST = (const float*)(F.ws + WS_GVST);
    const float* lg = A.in[I_GLN_G]; const float* lb = A.in[I_GLN_B]; const float* wsp = A.in[I_WSP]; const float* bsp = A.in[I_BSP];
    constexpr int RSV = 544, RSW = 272, OFF_W = 128 * RSV, OFF_ST = OFF_W + 128 * RSW;
    LAS unsigned char* VT = F.lds; LAS unsigned char* WT = F.lds + OFF_W; LAS float* ST = (LAS float*)(F.lds + OFF_ST);
    const int lane = F.lane, wv = F.wave;
    int curg = -1;
    for (int it = F.vcu; it < NB * 32 * 4; it += F.G) {
        const int b = it / 128, c = (it >> 2) & 31, g = it & 3;
        const int tok0 = b * SEQ + c * 128;
        if (g != curg) {
            curg = g;
            for (int k = 0; k < 4; ++k) {
                const int idx = F.tid + 512 * k, t = idx >> 4, s8 = (idx & 15) * 8;
                const f32x4 w0 = *(const f32x4*)(wsp + ((size_t)g * 128 + t) * 128 + s8), w1 = *(const f32x4*)(wsp + ((size_t)g * 128 + t) * 128 + s8 + 4);
                float x[8] = {w0.x, w0.y, w0.z, w0.w, w1.x, w1.y, w1.z, w1.w};
#pragma unroll
                for (int j = 0; j < 8; ++j) x[j] = (s8 + j <= t) ? x[j] : 0.f;
                u32x4 o; o.x = pk2(x[0], x[1]); o.y = pk2(x[2], x[3]); o.z = pk2(x[4], x[5]); o.w = pk2(x[6], x[7]);
                *(LAS u32x4*)(WT + t * RSW + s8 * 2) = o;
            }
        }
        if (F.tid < 128) {
            const float* p = GVST + (size_t)(tok0 + F.tid) * 32; float s1 = 0.f, s2 = 0.f;
            for (int i = 0; i < 16; ++i) { s1 += p[2 * i]; s2 += p[2 * i + 1]; }
            const float mean = s1 * (1.f / DM), var = s2 * (1.f / DM) - mean * mean;
            ST[2 * F.tid] = mean; ST[2 * F.tid + 1] = 1.f / sqrtf(fmaxf(var, 0.f) + LN_EPS);
        }
        __syncthreads();
        {
            const int dc = F.tid & 31;
            const f32x4 g0 = *(const f32x4*)(lg + g * 256 + dc * 8), g1 = *(const f32x4*)(lg + g * 256 + dc * 8 + 4), b0 = *(const f32x4*)(lb + g * 256 + dc * 8), b1 = *(const f32x4*)(lb + g * 256 + dc * 8 + 4);
#pragma unroll
            for (int k = 0; k < 8; ++k) {
                const int s = (F.tid >> 5) + 16 * k;
                const u32x2 raw = *(const u32x2*)(GV + (size_t)(tok0 + s) * DM + g * 256 + dc * 8);
                const float mean = ST[2 * s], rstd = ST[2 * s + 1];
                const f32x2v f0 = __builtin_amdgcn_cvt_pk_f32_fp8((int)raw.x, false), f1 = __builtin_amdgcn_cvt_pk_f32_fp8((int)raw.x, true), f2 = __builtin_amdgcn_cvt_pk_f32_fp8((int)raw.y, false), f3 = __builtin_amdgcn_cvt_pk_f32_fp8((int)raw.y, true);
                f32x4 x0 = {f0.x, f0.y, f1.x, f1.y}, x1 = {f2.x, f2.y, f3.x, f3.y};
                x0 = (x0 - mean) * rstd * g0 + b0; x1 = (x1 - mean) * rstd * g1 + b1;
                u32x4 o; o.x = pk2(x0.x, x0.y); o.y = pk2(x0.z, x0.w); o.z = pk2(x1.x, x1.y); o.w = pk2(x1.z, x1.w);
                *(LAS u32x4*)(VT + s * RSV + dc * 16) = o;
            }
        }
        __syncthreads();
        {
            const int dbase = 32 * wv, kg = lane >> 4, q = (lane & 15) >> 2, p = lane & 3, fr = lane & 15;
            bf16x8 Af[2][4];
#pragma unroll
            for (int m = 0; m < 2; ++m)
#pragma unroll
                for (int kk = 0; kk < 4; ++kk) {
                    LAS const unsigned char* ap = VT + (32 * kk + 8 * kg + q) * RSV + (dbase + 16 * m + 4 * p) * 2;
                    const v4i16_t lo = lds_tr16(ap), hi = lds_tr16(ap + 4 * RSV);
                    Af[m][kk] = (bf16x8){lo[0], lo[1], lo[2], lo[3], hi[0], hi[1], hi[2], hi[3]};
                }
#pragma unroll
            for (int n = 0; n < 8; ++n) {
                f32x4 acc0 = {0.f, 0.f, 0.f, 0.f}, acc1 = {0.f, 0.f, 0.f, 0.f};
#pragma unroll
                for (int kk = 0; kk < 4; ++kk) if (kk <= (n >> 1)) {
                    const bf16x8 Bf = *(LAS const bf16x8*)(WT + (16 * n + fr) * RSW + (32 * kk + 8 * kg) * 2);
                    acc0 = __builtin_amdgcn_mfma_f32_16x16x32_bf16(Af[0][kk], Bf, acc0, 0, 0, 0);
                    acc1 = __builtin_amdgcn_mfma_f32_16x16x32_bf16(Af[1][kk], Bf, acc1, 0, 0, 0);
                }
                const int t = 16 * n + fr; const float bsv = bsp[g * 128 + t];
                bf16_t* yp = YAB + (size_t)(tok0 + t) * 2048 + g * 256 + dbase + 4 * kg;
                const u32x2 u0 = *(const u32x2*)yp, u1 = *(const u32x2*)(yp + 16);
                unsigned char* y8 = F.ws + WS_YA8 + (size_t)(tok0 + t) * 2048 + g * 256 + dbase + 4 * kg;
                *(unsigned*)y8 = pack_fp8x4(bflo(u0.x) * (acc0[0] + bsv), bfhi(u0.x) * (acc0[1] + bsv), bflo(u0.y) * (acc0[2] + bsv), bfhi(u0.y) * (acc0[3] + bsv));
                *(unsigned*)(y8 + 16) = pack_fp8x4(bflo(u1.x) * (acc1[0] + bsv), bfhi(u1.x) * (acc1[1] + bsv), bflo(u1.y) * (acc1[2] + bsv), bfhi(u1.y) * (acc1[3] + bsv));
            }
        }
        __syncthreads();
    }
}

__device__ __forceinline__ void ph_gate(const Ctx& F) {
    const unsigned char* Q = F.ws + WS_Q; const float* KM = (const float*)(F.ws + WS_KMEAN);
    unsigned* SEL = (unsigned*)(F.ws + WS_SEL); unsigned* LISTS = (unsigned*)(F.ws + WS_LISTS); unsigned* LCNT = (unsigned*)(F.ws + WS_CTL) + CW_LCNT;
    constexpr int KMR = 272;
    LAS unsigned char* kmh = F.lds; LAS unsigned char* kml = F.lds + 16 * KMR;
    unsigned* lc = (unsigned*)(F.ldsg + 2 * 16 * KMR);
    LAS float* scw = (LAS float*)(F.lds + 16384) + F.wave * 1024;
    const int fr = F.lane & 15, fq = F.lane >> 4;
    for (int it = F.vcu; it < NB * NH * 8; it += F.G) {
        const int b = it / 64, h = (it >> 3) & 7, tc = it & 7;
        {
            const int j = F.tid >> 5, d4 = (F.tid & 31) * 4;
            const float* kp = KM + (size_t)((b * NBLK + j) * 2) * DM + h * DH + d4;
            const f32x4 s0 = *(const f32x4*)kp, s1 = *(const f32x4*)(kp + DM);
            const f32x4 mv = (s0 + s1) * (1.0f / LBLK);
            unsigned hb[4]; float lo[4];
#pragma unroll
            for (int e = 0; e < 4; ++e) { hb[e] = f2bf(mv[e]); lo[e] = mv[e] - __uint_as_float(hb[e] << 16); }
            *(LAS u32x2*)(kmh + j * KMR + d4 * 2) = (u32x2){hb[0] | (hb[1] << 16), hb[2] | (hb[3] << 16)};
            *(LAS u32x2*)(kml + j * KMR + d4 * 2) = (u32x2){pk2(lo[0], lo[1]), pk2(lo[2], lo[3])};
        }
        if (F.tid < 32) lc[F.tid] = 0u;
        const int tw = tc * 512 + F.wave * 64;
        u32x4 qraw[4][2];
#pragma unroll
        for (int tg = 0; tg < 4; ++tg) { const unsigned char* qp = Q + (size_t)(b * SEQ + tw + 16 * tg + fr) * DM + h * DH + 32 * fq; qraw[tg][0] = *(const u32x4*)qp; qraw[tg][1] = *(const u32x4*)(qp + 16); }
        __syncthreads();
        bf16x8 Ah[4], Al[4];
#pragma unroll
        for (int ks = 0; ks < 4; ++ks) { Ah[ks] = *(LAS const bf16x8*)(kmh + fr * KMR + (32 * fq + 8 * ks) * 2); Al[ks] = *(LAS const bf16x8*)(kml + fr * KMR + (32 * fq + 8 * ks) * 2); }
#pragma unroll
        for (int tg = 0; tg < 4; ++tg) {
            f32x4 acc = {0.f, 0.f, 0.f, 0.f};
#pragma unroll
            for (int ks = 0; ks < 4; ++ks) {
                const u32x4 w = qraw[tg][ks >> 1]; const unsigned w0 = (ks & 1) ? w.z : w.x, w1 = (ks & 1) ? w.w : w.y;
                const bf16x8 Bq = __builtin_bit_cast(bf16x8, f8x8_to_bf16x8(w0, w1));
                acc = __builtin_amdgcn_mfma_f32_16x16x32_bf16(Ah[ks], Bq, acc, 0, 0, 0);
                acc = __builtin_amdgcn_mfma_f32_16x16x32_bf16(Al[ks], Bq, acc, 0, 0, 0);
            }
            *(LAS f32x4*)(scw + (16 * tg + fr) * 16 + 4 * fq) = acc;
        }
        asm volatile("s_waitcnt lgkmcnt(0)" ::: "memory");
        const int t = tc * 512 + F.tid, qi = t >> 8;
        float gsc[15];
        { const f32x4 c0 = *(LAS const f32x4*)(scw + F.lane * 16), c1 = *(LAS const f32x4*)(scw + F.lane * 16 + 4), c2 = *(LAS const f32x4*)(scw + F.lane * 16 + 8), c3 = *(LAS const f32x4*)(scw + F.lane * 16 + 12);
          gsc[0] = c0.x; gsc[1] = c0.y; gsc[2] = c0.z; gsc[3] = c0.w; gsc[4] = c1.x; gsc[5] = c1.y; gsc[6] = c1.z; gsc[7] = c1.w;
          gsc[8] = c2.x; gsc[9] = c2.y; gsc[10] = c2.z; gsc[11] = c2.w; gsc[12] = c3.x; gsc[13] = c3.y; gsc[14] = c3.z; }
        const int nsel = qi < 3 ? qi : 3;
        int sel[3] = {0, 0, 0}; unsigned lpos[3] = {0, 0, 0};
#pragma unroll
        for (int r = 0; r < 3; ++r) {
            float best = -INFINITY; int bi = -1;
#pragma unroll
            for (int j = 0; j < 15; ++j) { const bool c = (j < qi) && (gsc[j] > best); best = c ? gsc[j] : best; bi = c ? j : bi; }
#pragma unroll
            for (int j = 0; j < 15; ++j) if (j == bi) gsc[j] = -INFINITY;
            sel[r] = bi < 0 ? 0 : bi;
            if (r < nsel) lpos[r] = atomicAdd(&lc[sel[r]], 1u);
        }
        SEL[(size_t)(b * SEQ + t) * NH + h] = (unsigned)sel[0] | ((unsigned)sel[1] << 8) | ((unsigned)sel[2] << 16) | ((unsigned)nsel << 24);
        __syncthreads();
        if (F.tid < 16) lc[16 + F.tid] = lc[F.tid] ? atomicAdd(&LCNT[(b * NH + h) * NBLK + F.tid], lc[F.tid]) : 0u;
        __syncthreads();
#pragma unroll
        for (int r = 0; r < 3; ++r) if (r < nsel) LISTS[(size_t)((b * NH + h) * NBLK + sel[r]) * 4096 + lc[16 + sel[r]] + lpos[r]] = (unsigned)t | ((unsigned)r << 12);
        __syncthreads();
    }
}


typedef float f32x16 __attribute__((ext_vector_type(16)));
namespace att {
__device__ __forceinline__ int crow(int r, int hi) { return (r & 3) + 8 * (r >> 2) + 4 * hi; }
#define TRR(dst, vaddr, off) asm volatile("ds_read_b64_tr_b16 %0, %1 offset:%c2" : "=v"(dst) : "v"(vaddr), "i"(off) : "memory")
#define TRWAIT() do { asm volatile("s_waitcnt lgkmcnt(0)" ::: "memory"); __builtin_amdgcn_sched_barrier(0); } while (0)

}

namespace att2 {
constexpr int KCH2 = 1040, VDB2 = 4160, KSL = 8 * KCH2, VSL = 4 * VDB2;
constexpr int OFF_K = 0, OFF_V = 2 * KSL, OFF_STG = OFF_V + 2 * VSL  , OFF_WS = OFF_STG + 8 * 8192  , WSW = 1024, OFF_TAB = OFF_WS + 8 * WSW  ;
static_assert(OFF_TAB + 1028 * 4 <= LDS_BYTES - 64, "attention (partial) LDS map");
using att::crow;

__device__ __forceinline__ void tile_load(const Ctx& F, const unsigned char* K, const unsigned char* V, size_t tokbase, int h, int kt, u32x4& rk, u32x4& rv) {
    const size_t off = (tokbase + 64 * kt + (F.tid >> 3)) * DM + h * DH + (F.tid & 7) * 16;
    rk = *(const u32x4*)(K + off); rv = *(const u32x4*)(V + off);
}
__device__ __forceinline__ void tile_write(const Ctx& F, int slot, const u32x4& rk, const u32x4& rv) {
    const int key = F.tid >> 3, c = 2 * (F.tid & 7);
    *(LAS u32x4*)(F.lds + OFF_K + slot * KSL + (F.tid & 7) * KCH2 + key * 16) = rk;
    LAS unsigned char* vd = F.lds + OFF_V + slot * VSL + (c >> 2) * VDB2 + (key >> 3) * 512 + (key & 7) * 64 + (c & 3) * 16;
    *(LAS u32x4*)vd = f8x8_to_bf16x8(rv.x, rv.y); *(LAS u32x4*)(vd + 16) = f8x8_to_bf16x8(rv.z, rv.w);
}
template <bool CAUSAL = false>
__device__ __forceinline__ void tile_compute(const Ctx& F, int slot, const pg8::v8i_t (&qf)[2], f32x16 (&o)[4], float& m, float& l, bool first, bool diag = false) {
    const int r = F.lane & 31, hh = F.lane >> 5;
    LAS float* wsf = (LAS float*)(F.lds + OFF_WS + F.wave * WSW);
    LAS const unsigned char* kp = F.lds + OFF_K + slot * KSL + 2 * hh * KCH2 + r * 16;
    LAS const unsigned char* vp = F.lds + OFF_V + slot * VSL + (4 * hh + ((F.lane & 15) >> 2)) * 64 + ((F.lane >> 4) & 1) * 32 + (F.lane & 3) * 8;
    f32x16 p0, p1;
#pragma unroll
    for (int i = 0; i < 16; ++i) { p0[i] = 0.f; p1[i] = 0.f; }
    {
        pg8::v8i_t ka[2][2];
#pragma unroll
        for (int kb = 0; kb < 2; ++kb)
#pragma unroll
            for (int j2 = 0; j2 < 2; ++j2) ka[kb][j2] = __builtin_shufflevector(*(LAS const pg8::v4i_t*)(kp + 4 * j2 * KCH2 + kb * 512), *(LAS const pg8::v4i_t*)(kp + (4 * j2 + 1) * KCH2 + kb * 512), 0, 1, 2, 3, 4, 5, 6, 7);
        __builtin_amdgcn_sched_barrier(0);
#pragma unroll
        for (int j2 = 0; j2 < 2; ++j2) p0 = __builtin_amdgcn_mfma_scale_f32_32x32x64_f8f6f4(ka[0][j2], qf[j2], p0, 0, 0, 0, 0x7f7f7f7f, 0, 0x7f7f7f7f);
#pragma unroll
        for (int j2 = 0; j2 < 2; ++j2) p1 = __builtin_amdgcn_mfma_scale_f32_32x32x64_f8f6f4(ka[1][j2], qf[j2], p1, 0, 0, 0, 0x7f7f7f7f, 0, 0x7f7f7f7f);
        __builtin_amdgcn_sched_barrier(0);
    }
    v4i16_t vl[2][4], vh[2][4];
    const unsigned vaddr = (unsigned)(uintptr_t)vp;
#pragma unroll
    for (int ks = 0; ks < 2; ++ks)
#pragma unroll
        for (int db = 0; db < 4; ++db) { TRR(vl[ks][db], vaddr, db * VDB2 + ks * 1024); TRR(vh[ks][db], vaddr, db * VDB2 + ks * 1024 + 512); }
    __builtin_amdgcn_sched_barrier(0);
    if (CAUSAL && diag) {
        if (F.wave & 1) {
#pragma unroll
            for (int i = 0; i < 16; ++i) p1[i] = (crow(i, hh) > r) ? -INFINITY : p1[i];
        } else {
#pragma unroll
            for (int i = 0; i < 16; ++i) { p0[i] = (crow(i, hh) > r) ? -INFINITY : p0[i]; p1[i] = -INFINITY; }
        }
    }
    const float dm = first ? 0.f : m;
    { const f32x2 dm2 = {dm, dm};
#pragma unroll
      for (int j = 0; j < 8; ++j) { f32x2 a = {p0[2 * j], p0[2 * j + 1]}, b = {p1[2 * j], p1[2 * j + 1]}; a = a - dm2; b = b - dm2; p0[2 * j] = a.x; p0[2 * j + 1] = a.y; p1[2 * j] = b.x; p1[2 * j + 1] = b.y; } }
    float mx = fmaxf(p0[0], p1[0]);
#pragma unroll
    for (int i = 1; i < 16; ++i) mx = fmaxf(mx, fmaxf(p0[i], p1[i]));
    mx = fmaxf(mx, __shfl_xor(mx, 32));
    if (first || __any(mx > 8.0f)) {
        const float delta = first ? mx : fmaxf(mx, 0.f);
        const float alpha = first ? 0.f : __builtin_amdgcn_exp2f(-delta);
        l *= alpha; m = dm + delta;
        { const f32x2 d2 = {delta, delta};
#pragma unroll
          for (int j = 0; j < 8; ++j) { f32x2 a = {p0[2 * j], p0[2 * j + 1]}, b = {p1[2 * j], p1[2 * j + 1]}; a = a - d2; b = b - d2; p0[2 * j] = a.x; p0[2 * j + 1] = a.y; p1[2 * j] = b.x; p1[2 * j + 1] = b.y; } }
        if (!first) {
            if (hh == 0) wsf[r] = alpha;
            asm volatile("s_waitcnt lgkmcnt(0)" ::: "memory");
#pragma unroll
            for (int i = 0; i < 16; ++i) { const float a = wsf[crow(i, hh)];
#pragma unroll
                for (int db = 0; db < 4; ++db) o[db][i] *= a; }
        }
    }
    { f32x2 sa = {0.f, 0.f}, sb = {0.f, 0.f};
#pragma unroll
      for (int j = 0; j < 8; ++j) {
          p0[2 * j] = __builtin_amdgcn_exp2f(p0[2 * j]); p0[2 * j + 1] = __builtin_amdgcn_exp2f(p0[2 * j + 1]); p1[2 * j] = __builtin_amdgcn_exp2f(p1[2 * j]); p1[2 * j + 1] = __builtin_amdgcn_exp2f(p1[2 * j + 1]);
          sa = sa + (f32x2){p0[2 * j], p0[2 * j + 1]}; sb = sb + (f32x2){p1[2 * j], p1[2 * j + 1]}; }
      sa = sa + sb; l += sa.x + sa.y; }
    u32x4 pw[4];
#pragma unroll
    for (int s2 = 0; s2 < 2; ++s2) {
        pw[s2] = (u32x4){cvt_pk_bf16(p0[8 * s2], p0[8 * s2 + 1]), cvt_pk_bf16(p0[8 * s2 + 2], p0[8 * s2 + 3]), cvt_pk_bf16(p0[8 * s2 + 4], p0[8 * s2 + 5]), cvt_pk_bf16(p0[8 * s2 + 6], p0[8 * s2 + 7])};
        pw[2 + s2] = (u32x4){cvt_pk_bf16(p1[8 * s2], p1[8 * s2 + 1]), cvt_pk_bf16(p1[8 * s2 + 2], p1[8 * s2 + 3]), cvt_pk_bf16(p1[8 * s2 + 4], p1[8 * s2 + 5]), cvt_pk_bf16(p1[8 * s2 + 6], p1[8 * s2 + 7])};
    }
    TRWAIT();
#pragma unroll
    for (int ks = 0; ks < 2; ++ks) {
        const bf16x8 pa = __builtin_bit_cast(bf16x8, pw[ks]);
#pragma unroll
        for (int db = 0; db < 4; ++db) {
            const bf16x8 vf = (bf16x8){vl[ks][db][0], vl[ks][db][1], vl[ks][db][2], vl[ks][db][3], vh[ks][db][0], vh[ks][db][1], vh[ks][db][2], vh[ks][db][3]};
            o[db] = __builtin_amdgcn_mfma_f32_32x32x16_bf16(pa, vf, o[db], 0, 0, 0);
        }
    }
    __builtin_amdgcn_sched_barrier(0);
#pragma unroll
    for (int ks = 0; ks < 2; ++ks)
#pragma unroll
        for (int db = 0; db < 4; ++db) { TRR(vl[ks][db], vaddr, db * VDB2 + (2 + ks) * 1024); TRR(vh[ks][db], vaddr, db * VDB2 + (2 + ks) * 1024 + 512); }
    TRWAIT();
#pragma unroll
    for (int ks = 0; ks < 2; ++ks) {
        const bf16x8 pa = __builtin_bit_cast(bf16x8, pw[2 + ks]);
#pragma unroll
        for (int db = 0; db < 4; ++db) {
            const bf16x8 vf = (bf16x8){vl[ks][db][0], vl[ks][db][1], vl[ks][db][2], vl[ks][db][3], vh[ks][db][0], vh[ks][db][1], vh[ks][db][2], vh[ks][db][3]};
            o[db] = __builtin_amdgcn_mfma_f32_32x32x16_bf16(pa, vf, o[db], 0, 0, 0);
        }
    }
    __builtin_amdgcn_sched_barrier(0);
}
}

#define ATT2_DECODE(item, bhj_, chunk_) do { int lo_ = 0, hi_ = 1023; while (lo_ < hi_) { const int mid_ = (lo_ + hi_ + 1) >> 1; if (P[mid_] <= (item)) lo_ = mid_; else hi_ = mid_ - 1; } bhj_ = lo_; chunk_ = (item) - P[lo_]; } while (0)
__device__ __forceinline__ void ph_attn_partial(const Ctx& F) {
    using namespace att2;
    const unsigned char* Q = F.ws + WS_Q; const unsigned char* K = F.ws + WS_K; const unsigned char* V = F.ws + WS_V;
    const unsigned* LISTS = (const unsigned*)(F.ws + WS_LISTS); const unsigned* LCNT = (const unsigned*)(F.ws + WS_CTL) + CW_LCNT;
    unsigned char* OP = F.ws + WS_OP; float* LSE = (float*)(F.ws + WS_LSE);
    LAS int* P = (LAS int*)(F.lds + OFF_TAB);
    if (F.tid < 64) {
        int c[16]; int s = 0;
#pragma unroll
        for (int i = 0; i < 16; ++i) { c[i] = ((int)__hip_atomic_load(LCNT + F.tid * 16 + i, __ATOMIC_RELAXED, __HIP_MEMORY_SCOPE_AGENT) + 255) >> 8; s += c[i]; }
        int inc = s;
#pragma unroll
        for (int o = 1; o < 64; o <<= 1) { const int t = __shfl_up(inc, o); if (F.lane >= o) inc += t; }
        int run = inc - s;
#pragma unroll
        for (int i = 0; i < 16; ++i) { P[F.tid * 16 + i] = run; run += c[i]; }
        if (F.tid == 63) P[1024] = run;
    }
    __syncthreads();
    const int total = P[1024];
    LAS float* wsf = (LAS float*)(F.lds + OFF_WS + F.wave * WSW);
    LAS int* wsi = (LAS int*)wsf;
    const int r = F.lane & 31, hh = F.lane >> 5;
    int it = F.vcu;
    if (it < total) {
        int bhj, chunk; ATT2_DECODE(it, bhj, chunk);
        int itn = it + F.G, bhjn = 0, chunkn = 0; bool hasn = itn < total; if (hasn) ATT2_DECODE(itn, bhjn, chunkn);
        u32x4 rkA, rvA, rkB, rvB;
        { const int b = bhj >> 7, h = (bhj >> 4) & 7, j = bhj & 15; const size_t tb = (size_t)b * SEQ + j * LBLK;
          tile_load(F, K, V, tb, h, 0, rkA, rvA); tile_load(F, K, V, tb, h, 1, rkB, rvB); tile_write(F, 0, rkA, rvA); tile_write(F, 1, rkB, rvB);
          tile_load(F, K, V, tb, h, 2, rkA, rvA); }
        int cnt = (int)__hip_atomic_load(LCNT + bhj, __ATOMIC_RELAXED, __HIP_MEMORY_SCOPE_AGENT);
        int qi = chunk * 256 + F.wave * 32 + r;
        unsigned ent = LISTS[(size_t)bhj * 4096 + (qi < cnt ? qi : 0)];
        int tq = ent & 4095, slot = (qi < cnt) ? (int)(ent >> 12) : -1;
        u32x4 qraw[4];
        { const unsigned char* qrow = Q + ((size_t)(bhj >> 7) * SEQ + tq) * DM + ((bhj >> 4) & 7) * DH + hh * 32;
#pragma unroll
          for (int c = 0; c < 4; ++c) qraw[c] = *(const u32x4*)(qrow + (c >> 1) * 64 + (c & 1) * 16); }
        unsigned entn = 0u; int cntn = 0;
        __syncthreads();
        int s = 0;
        for (;;) {
            const int b = bhj >> 7, h = (bhj >> 4) & 7, j = bhj & 15;
            pg8::v8i_t qr[2];
#pragma unroll
            for (int j2 = 0; j2 < 2; ++j2) qr[j2] = __builtin_shufflevector(__builtin_bit_cast(pg8::v4i_t, qraw[2 * j2]), __builtin_bit_cast(pg8::v4i_t, qraw[2 * j2 + 1]), 0, 1, 2, 3, 4, 5, 6, 7);
            if (F.lane < 32) { wsi[64 + r] = tq; wsi[96 + r] = slot; }
            f32x16 o[4]; float m = -1e30f, l = 0.f;
#pragma unroll
            for (int db = 0; db < 4; ++db)
#pragma unroll
                for (int i = 0; i < 16; ++i) o[db][i] = 0.f;
#define ATT2_TB(bb) ((size_t)((bb) >> 7) * SEQ + ((bb) & 15) * LBLK)
#define ATT2_H(bb) (((bb) >> 4) & 7)
#pragma unroll 1
            for (int kp2 = 0; kp2 < 2; ++kp2) {
                const int kt = 2 * kp2;
                { const bool cur3 = kt + 3 < 4, have3 = cur3 || hasn, have2 = (kt + 2 < 4) || hasn;
                  if (have3) { const int bb = cur3 ? bhj : bhjn; tile_load(F, K, V, ATT2_TB(bb), ATT2_H(bb), (kt + 3) & 3, rkB, rvB); }
                  if (kt == 0 && hasn) { cntn = (int)__hip_atomic_load(LCNT + bhjn, __ATOMIC_RELAXED, __HIP_MEMORY_SCOPE_AGENT); }
                  if (kt == 2 && hasn) { const unsigned char* qrow = Q + ((size_t)(bhjn >> 7) * SEQ + (entn & 4095)) * DM + ((bhjn >> 4) & 7) * DH + hh * 32;
#pragma unroll
                      for (int c = 0; c < 4; ++c) qraw[c] = *(const u32x4*)(qrow + (c >> 1) * 64 + (c & 1) * 16); }
                  tile_compute(F, 0, qr, o, m, l, kp2 == 0);
                  asm volatile("s_waitcnt lgkmcnt(0)" ::: "memory"); __builtin_amdgcn_s_barrier(); asm volatile("" ::: "memory");
                  if (have2) tile_write(F, 0, rkA, rvA); }
                { const bool have4 = hasn, have3 = (kt + 3 < 4) || hasn;
                  if (have4) { tile_load(F, K, V, ATT2_TB(bhjn), ATT2_H(bhjn), kt, rkA, rvA); }
                  if (kt == 0 && hasn) { const int qn = chunkn * 256 + F.wave * 32 + r; entn = LISTS[(size_t)bhjn * 4096 + (qn < cntn ? qn : 0)]; }
                  tile_compute(F, 1, qr, o, m, l, false);
                  asm volatile("s_waitcnt lgkmcnt(0)" ::: "memory"); __builtin_amdgcn_s_barrier(); asm volatile("" ::: "memory");
                  if (have3) tile_write(F, 1, rkB, rvB); }
            }
            const float lt = l + __shfl_xor(l, 32);
            if (hh == 0) { wsf[r] = 1.0f / lt; wsf[32 + r] = m + __builtin_amdgcn_logf(lt); }
            asm volatile("s_waitcnt lgkmcnt(0)" ::: "memory");
            int re = r, he = hh; asm volatile("" : "+v"(re), "+v"(he));
#pragma unroll
            for (int i = 0; i < 16; ++i) {
                const int q = crow(i, he); const float a = wsf[q]; const int t = wsi[64 + q], sl = wsi[96 + q];
                const unsigned w = pack_fp8x4(o[0][i] * a, o[1][i] * a, o[2][i] * a, o[3][i] * a);
                if (sl >= 0) { const size_t row = (((size_t)sl * NB + b) * SEQ + t) * NH + h; *(unsigned*)(OP + row * DH + 4 * re) = w; }
            }
            if (he == 0 && slot >= 0) LSE[(((size_t)slot * NB + b) * SEQ + tq) * NH + h] = wsf[32 + re];
            asm volatile("s_waitcnt lgkmcnt(0)" ::: "memory");
            if (!hasn) break;
            it = itn; bhj = bhjn; chunk = chunkn; cnt = cntn;
            { const int qn = chunk * 256 + F.wave * 32 + r; tq = entn & 4095; slot = (qn < cnt) ? (int)(entn >> 12) : -1; }
            itn = it + F.G; hasn = itn < total; if (hasn) ATT2_DECODE(itn, bhjn, chunkn);
        }
    }
    __syncthreads();
}

__device__ __forceinline__ void ph_attn_own(const Ctx& F) {
    using namespace att2;
    const unsigned char* Q = F.ws + WS_Q; const unsigned char* K = F.ws + WS_K; const unsigned char* V = F.ws + WS_V;
    const unsigned char* OP = F.ws + WS_OP; const float* LSE = (const float*)(F.ws + WS_LSE); unsigned char* YA8 = F.ws + WS_YA8;
    LAS float* wsf = (LAS float*)(F.lds + OFF_WS + F.wave * WSW);
    const int r = F.lane & 31, hh = F.lane >> 5;
    constexpr int NIT = NB * NH * NBLK;
    int it = F.vcu;
    if (it < NIT) {
        int itn = it + F.G; bool hasn = itn < NIT;
        u32x4 rkA, rvA, rkB, rvB;
#define OWN_TB(i_) ((size_t)((i_) >> 7) * SEQ + ((i_) & 15) * LBLK)
#define OWN_H(i_) (((i_) >> 4) & 7)
        tile_load(F, K, V, OWN_TB(it), OWN_H(it), 0, rkA, rvA); tile_load(F, K, V, OWN_TB(it), OWN_H(it), 1, rkB, rvB); tile_write(F, 0, rkA, rvA); tile_write(F, 1, rkB, rvB);
        tile_load(F, K, V, OWN_TB(it), OWN_H(it), 2, rkA, rvA);
        u32x4 qraw[4];
        { const unsigned char* qrow = Q + (OWN_TB(it) + F.wave * 32 + r) * DM + OWN_H(it) * DH + hh * 32;
#pragma unroll
          for (int c = 0; c < 4; ++c) qraw[c] = *(const u32x4*)(qrow + (c >> 1) * 64 + (c & 1) * 16); }
        __syncthreads();
        const int wdiag = F.wave >> 1;
        for (;;) {
            const int b = it >> 7, h = (it >> 4) & 7, j = it & 15, t0 = j * LBLK + F.wave * 32;
            pg8::v8i_t qr[2];
#pragma unroll
            for (int j2 = 0; j2 < 2; ++j2) qr[j2] = __builtin_shufflevector(__builtin_bit_cast(pg8::v4i_t, qraw[2 * j2]), __builtin_bit_cast(pg8::v4i_t, qraw[2 * j2 + 1]), 0, 1, 2, 3, 4, 5, 6, 7);
            f32x16 o[4]; float m = -1e30f, l = 0.f;
#pragma unroll
            for (int db = 0; db < 4; ++db)
#pragma unroll
                for (int i = 0; i < 16; ++i) o[db][i] = 0.f;
#pragma unroll 1
            for (int kp2 = 0; kp2 < 2; ++kp2) {
                const int kt = 2 * kp2;
                { const bool cur3 = kt + 3 < 4, have3 = cur3 || hasn, have2 = (kt + 2 < 4) || hasn;
                  if (have3) { const int ii = cur3 ? it : itn; tile_load(F, K, V, OWN_TB(ii), OWN_H(ii), (kt + 3) & 3, rkB, rvB); }
                  if (kt == 2 && hasn) { const unsigned char* qrow = Q + (OWN_TB(itn) + F.wave * 32 + r) * DM + OWN_H(itn) * DH + hh * 32;
#pragma unroll
                      for (int c = 0; c < 4; ++c) qraw[c] = *(const u32x4*)(qrow + (c >> 1) * 64 + (c & 1) * 16); }
                  if (kt <= wdiag) tile_compute<true>(F, 0, qr, o, m, l, kp2 == 0, kt == wdiag);
                  asm volatile("s_waitcnt lgkmcnt(0)" ::: "memory"); __builtin_amdgcn_s_barrier(); asm volatile("" ::: "memory");
                  if (have2) tile_write(F, 0, rkA, rvA); }
                { const bool have4 = hasn, have3 = (kt + 3 < 4) || hasn;
                  if (have4) { tile_load(F, K, V, OWN_TB(itn), OWN_H(itn), kt, rkA, rvA); }
                  if (kt + 1 <= wdiag) tile_compute<true>(F, 1, qr, o, m, l, false, kt + 1 == wdiag);
                  asm volatile("s_waitcnt lgkmcnt(0)" ::: "memory"); __builtin_amdgcn_s_barrier(); asm volatile("" ::: "memory");
                  if (have3) tile_write(F, 1, rkB, rvB); }
            }
            const int nv = j < 3 ? j : 3;
            {
                const float lt = l + __shfl_xor(l, 32); const float lse_own = m + __builtin_amdgcn_logf(lt);
                float ls[3];
#pragma unroll
                for (int s2 = 0; s2 < 3; ++s2) ls[s2] = (s2 < nv) ? LSE[(((size_t)s2 * NB + b) * SEQ + t0 + r) * NH + h] : -1e30f;
                const float M = fmaxf(fmaxf(lse_own, ls[0]), fmaxf(ls[1], ls[2]));
                const float w0 = __builtin_amdgcn_exp2f(lse_own - M);
                float w[3], den = w0;
#pragma unroll
                for (int s2 = 0; s2 < 3; ++s2) { w[s2] = (s2 < nv) ? __builtin_amdgcn_exp2f(ls[s2] - M) : 0.f; den += w[s2]; }
                const float inv = 1.0f / den;
                if (hh == 0) { wsf[r] = w0 * inv / lt; wsf[32 + r] = w[0] * inv; wsf[64 + r] = w[1] * inv; wsf[96 + r] = w[2] * inv; }
                asm volatile("s_waitcnt lgkmcnt(0)" ::: "memory");
            }
            int re = r, he = hh; asm volatile("" : "+v"(re), "+v"(he));
            LAS float* stg = (LAS float*)(F.lds + OFF_STG + F.wave * 8192);
            {
                unsigned pv[16][3];
#pragma unroll
                for (int i = 0; i < 16; ++i) { const int q = crow(i, he);
#pragma unroll
                    for (int s2 = 0; s2 < 3; ++s2) { pv[i][s2] = 0u; if (s2 < nv) pv[i][s2] = *(const unsigned*)(OP + ((((size_t)s2 * NB + b) * SEQ + t0 + q) * NH + h) * DH + 4 * re); } }
#pragma unroll
                for (int i = 0; i < 16; ++i) { const int q = crow(i, he); const float a = wsf[q];
                    float x0 = o[0][i] * a, x1 = o[1][i] * a, x2 = o[2][i] * a, x3 = o[3][i] * a;
#pragma unroll
                    for (int s2 = 0; s2 < 3; ++s2) { const float ww = wsf[32 * (s2 + 1) + q]; const f32x2v f0 = __builtin_amdgcn_cvt_pk_f32_fp8((int)pv[i][s2], false), f1 = __builtin_amdgcn_cvt_pk_f32_fp8((int)pv[i][s2], true);
                        x0 += ww * f0.x; x1 += ww * f0.y; x2 += ww * f1.x; x3 += ww * f1.y; }
                    o[0][i] = x0; o[1][i] = x1; o[2][i] = x2; o[3][i] = x3; }
            }
#pragma unroll
            for (int half = 0; half < 2; ++half) {
#pragma unroll
                for (int i = 0; i < 16; ++i) { const int q = crow(i, he); stg[q * 64 + re] = o[2 * half][i]; stg[q * 64 + 32 + re] = o[2 * half + 1][i]; }
                asm volatile("s_waitcnt lgkmcnt(0)" ::: "memory");
#pragma unroll
                for (int ps = 0; ps < 4; ++ps) {
                    const int q = ps * 8 + ((re + 32 * he) >> 3), dc = re & 7;
                    const f32x4 x = *(LAS const f32x4*)(stg + q * 64 + dc * 8), y = *(LAS const f32x4*)(stg + q * 64 + dc * 8 + 4);
                    *(u32x2*)(YA8 + ((size_t)b * SEQ + t0 + q) * 2048 + 1024 + h * DH + half * 64 + dc * 8) = (u32x2){pack_fp8x4(x.x, x.y, x.z, x.w), pack_fp8x4(y.x, y.y, y.z, y.w)};
                }
                asm volatile("s_waitcnt lgkmcnt(0)" ::: "memory");
            }
            if (!hasn) break;
            it = itn; itn = it + F.G; hasn = itn < NIT;
        }
#undef OWN_TB
#undef OWN_H
    }
    __syncthreads();
}

__device__ __forceinline__ void ph_router(const Ctx& F) {
    const Args& A = *F.a;
    const bf16_t* Z = (const bf16_t*)(F.ws + WS_Z); const float* ZST = (const float*)(F.ws + WS_ZST); bf16_t* H1 = (bf16_t*)(F.ws + WS_H1); unsigned char* H1F8 = F.ws + WS_H1F8;
    int* TKE = (int*)(F.ws + WS_TKE); int* TKP = (int*)(F.ws + WS_TKP); unsigned* ECNT = (unsigned*)(F.ws + WS_CTL) + CW_ECNT; int* RT = (int*)(F.ws + WS_RT); float* RW = (float*)(F.ws + WS_RW);
    const float* wr = A.in[I_WR]; const float* br = A.in[I_BR];
    constexpr int RS = 2064, OFF_LO = 32 * RS, OFF_G = 2 * 32 * RS  , OFF_B = OFF_G + 4096, OFF_LG = OFF_B + 4096  , OFF_CNT = OFF_LG + 8 * 2112  ;
    static_assert(OFF_CNT + 256 <= LDS_BYTES, "router LDS map");
    LAS unsigned char* WH = F.lds; LAS unsigned char* WL = F.lds + OFF_LO;
    LAS float* LG = (LAS float*)(F.lds + OFF_G); LAS float* LB = (LAS float*)(F.lds + OFF_B);
    LAS float* lgt = (LAS float*)(F.lds + OFF_LG + F.wave * 2112);
    LAS unsigned* lcnt = (LAS unsigned*)(F.lds + OFF_CNT);
    {
        f32x4 wa[8], wb[8];
#pragma unroll
        for (int u_ = 0; u_ < 8; ++u_) { const int i = F.tid + 512 * u_, nq = i & 7, k2 = i >> 3;
            wa[u_] = *(const f32x4*)(wr + (size_t)(2 * k2) * NE + 4 * nq); wb[u_] = *(const f32x4*)(wr + (size_t)(2 * k2 + 1) * NE + 4 * nq); }
#pragma unroll
        for (int u_ = 0; u_ < 8; ++u_) { const int i = F.tid + 512 * u_, nq = i & 7, k2 = i >> 3;
#pragma unroll
            for (int c = 0; c < 4; ++c) {
                const float w0 = wa[u_][c], w1 = wb[u_][c];
                const unsigned h0 = f2bf(w0), h1 = f2bf(w1);
                const float r0 = w0 - __uint_as_float(h0 << 16), r1 = w1 - __uint_as_float(h1 << 16);
                *(LAS unsigned*)(WH + (4 * nq + c) * RS + k2 * 4) = h0 | (h1 << 16);
                *(LAS unsigned*)(WL + (4 * nq + c) * RS + k2 * 4) = pk2(r0, r1);
            } }
    }
    for (int i = F.tid; i < DM; i += 512) { LG[i] = A.in[I_LNMIX_G][i]; LB[i] = A.in[I_LNMIX_B][i]; }
    if (F.tid < 64) lcnt[F.tid] = 0u;
    __syncthreads();
    const int fr = F.lane & 15, kg = F.lane >> 4;
    const int ntask = T / 16, NGW = F.G * 8;
    const int rounds = (ntask + NGW - 1) / NGW;
    for (int rd = 0; rd < rounds; ++rd) {
        const int task = rd * NGW + F.vcu * 8 + F.wave;
        const bool live = task < ntask;
        int te[4] = {0, 0, 0, 0}; float tw[4] = {0.f, 0.f, 0.f, 0.f}; unsigned lp[4] = {0, 0, 0, 0};
        if (live) {
            const int tok = task * 16 + fr;
            float mean, rstd;
            { const f32x4* sp = (const f32x4*)(ZST + (size_t)tok * 32); float s1 = 0.f, s2 = 0.f;
#pragma unroll
              for (int i = 0; i < 8; ++i) { const f32x4 v = sp[i]; s1 += v.x + v.z; s2 += v.y + v.w; }
              mean = s1 * (1.f / DM); const float var = s2 * (1.f / DM) - mean * mean; rstd = 1.f / sqrtf(fmaxf(var, 0.f) + LN_EPS); }
            f32x4 acc0 = {0.f, 0.f, 0.f, 0.f}, acc1 = {0.f, 0.f, 0.f, 0.f};
            const bf16_t* zp = Z + (size_t)tok * DM + 8 * kg; unsigned char* h8 = H1F8 + (size_t)tok * DM + 8 * kg;
#pragma unroll 8
            for (int kk = 0; kk < 32; ++kk) {
                const u32x4 zr = *(const u32x4*)(zp + 32 * kk); const f32x4 z0 = {bflo(zr.x), bfhi(zr.x), bflo(zr.y), bfhi(zr.y)}, z1 = {bflo(zr.z), bfhi(zr.z), bflo(zr.w), bfhi(zr.w)};
                const f32x4 g0 = *(LAS const f32x4*)(LG + 32 * kk + 8 * kg), g1 = *(LAS const f32x4*)(LG + 32 * kk + 8 * kg + 4);
                const f32x4 b0 = *(LAS const f32x4*)(LB + 32 * kk + 8 * kg), b1 = *(LAS const f32x4*)(LB + 32 * kk + 8 * kg + 4);
                const f32x4 x0 = (z0 - mean) * rstd * g0 + b0, x1 = (z1 - mean) * rstd * g1 + b1;
                u32x4 hi; hi.x = cvt_pk_bf16(x0.x, x0.y); hi.y = cvt_pk_bf16(x0.z, x0.w); hi.z = cvt_pk_bf16(x1.x, x1.y); hi.w = cvt_pk_bf16(x1.z, x1.w);
                { unsigned w0 = 0u, w1 = 0u;
                  w0 = __builtin_amdgcn_cvt_pk_fp8_f32(x0.x, x0.y, w0, false); w0 = __builtin_amdgcn_cvt_pk_fp8_f32(x0.z, x0.w, w0, true);
                  w1 = __builtin_amdgcn_cvt_pk_fp8_f32(x1.x, x1.y, w1, false); w1 = __builtin_amdgcn_cvt_pk_fp8_f32(x1.z, x1.w, w1, true);
                  *(u32x2*)(h8 + 32 * kk) = (u32x2){w0, w1}; }
                u32x4 lo; lo.x = cvt_pk_bf16(x0.x - bflo(hi.x), x0.y - bfhi(hi.x)); lo.y = cvt_pk_bf16(x0.z - bflo(hi.y), x0.w - bfhi(hi.y));
                lo.z = cvt_pk_bf16(x1.x - bflo(hi.z), x1.y - bfhi(hi.z)); lo.w = cvt_pk_bf16(x1.z - bflo(hi.w), x1.w - bfhi(hi.w));
                const bf16x8 ah = __builtin_bit_cast(bf16x8, hi), al = __builtin_bit_cast(bf16x8, lo);
                const int bo = fr * RS + (32 * kk + 8 * kg) * 2;
                const bf16x8 wh0 = *(LAS const bf16x8*)(WH + bo), wh1 = *(LAS const bf16x8*)(WH + bo + 16 * RS), wl0 = *(LAS const bf16x8*)(WL + bo), wl1 = *(LAS const bf16x8*)(WL + bo + 16 * RS);
                acc0 = __builtin_amdgcn_mfma_f32_16x16x32_bf16(ah, wh0, acc0, 0, 0, 0); acc1 = __builtin_amdgcn_mfma_f32_16x16x32_bf16(ah, wh1, acc1, 0, 0, 0);
                acc0 = __builtin_amdgcn_mfma_f32_16x16x32_bf16(ah, wl0, acc0, 0, 0, 0); acc1 = __builtin_amdgcn_mfma_f32_16x16x32_bf16(ah, wl1, acc1, 0, 0, 0);
                acc0 = __builtin_amdgcn_mfma_f32_16x16x32_bf16(al, wh0, acc0, 0, 0, 0); acc1 = __builtin_amdgcn_mfma_f32_16x16x32_bf16(al, wh1, acc1, 0, 0, 0);
            }
            const float br0 = br[fr], br1 = br[16 + fr];
#pragma unroll
            for (int i = 0; i < 4; ++i) { lgt[(4 * kg + i) * 33 + fr] = acc0[i] + br0; lgt[(4 * kg + i) * 33 + 16 + fr] = acc1[i] + br1; }
            asm volatile("s_waitcnt lgkmcnt(0)" ::: "memory");
            if (F.lane < 16) {
                float lg[NE];
#pragma unroll
                for (int e = 0; e < NE; ++e) lg[e] = lgt[F.lane * 33 + e];
                float tv[4];
#pragma unroll
                for (int r = 0; r < 4; ++r) {
                    float best = -INFINITY; int bi = 0;
#pragma unroll
                    for (int e = 0; e < NE; ++e) { const bool c = lg[e] > best; best = c ? lg[e] : best; bi = c ? e : bi; }
#pragma unroll
                    for (int e = 0; e < NE; ++e) lg[e] = (e == bi) ? -INFINITY : lg[e];
                    te[r] = bi; tv[r] = best;
                }
                const float e1 = __expf(tv[1] - tv[0]), e2 = __expf(tv[2] - tv[0]), e3 = __expf(tv[3] - tv[0]); const float inv = 1.f / (1.f + e1 + e2 + e3);
                tw[0] = inv; tw[1] = e1 * inv; tw[2] = e2 * inv; tw[3] = e3 * inv;
#pragma unroll
                for (int r = 0; r < 4; ++r) lp[r] = atomicAdd((unsigned*)(lcnt + te[r]), 1u);
            }
        }
        __syncthreads();
        if (F.tid < 32) { const unsigned c = lcnt[F.tid]; lcnt[32 + F.tid] = c ? atomicAdd(&ECNT[F.tid], c) : 0u; }
        __syncthreads();
        if (live && F.lane < 16) {
            const size_t tok = (size_t)task * 16 + F.lane;
            int4 pe = {te[0], te[1], te[2], te[3]};
            int4 pp = {(int)(lcnt[32 + te[0]] + lp[0]), (int)(lcnt[32 + te[1]] + lp[1]), (int)(lcnt[32 + te[2]] + lp[2]), (int)(lcnt[32 + te[3]] + lp[3])};
            *(int4*)(TKE + tok * 4) = pe; *(int4*)(TKP + tok * 4) = pp;
#pragma unroll
            for (int r = 0; r < 4; ++r) { const size_t o_ = (size_t)te[r] * T + (r == 0 ? pp.x : r == 1 ? pp.y : r == 2 ? pp.z : pp.w); RT[o_] = (int)tok; RW[o_] = tw[r]; }
        }
        __syncthreads();
        if (F.tid < 32) lcnt[F.tid] = 0u;
        __syncthreads();
    }
}

__device__ __forceinline__ void moe_table(const Ctx& F) {
    const unsigned* ECNT = (const unsigned*)(F.ws + WS_CTL) + CW_ECNT;
    LAS int* tab = (LAS int*)(F.lds + LDS_MOE);
    __syncthreads();
    if (F.tid == 0) {
        int acc = 0;
        for (int e = 0; e < NE; ++e) { const int c = (int)__hip_atomic_load(ECNT + e, __ATOMIC_RELAXED, __HIP_MEMORY_SCOPE_AGENT); tab[32 + e] = acc; acc += (c + 255) / 256 * 256; }
        tab[64] = acc; tab[0] = acc / 256;
    }
    __syncthreads();
    const int ntiles = tab[0];
    for (int i = F.tid; i < ntiles; i += 512) { int e = 0; for (int k = 1; k < NE; ++k) if (i * 256 >= tab[32 + k]) e = k; tab[128 + 2 * i] = e; tab[129 + 2 * i] = i - tab[32 + e] / 256; }
    __syncthreads();
}

__device__ __forceinline__ void ln_stats16(const float* st, int lane, float& mean, float& rstd) {
    float s1 = 0.f, s2 = 0.f;
    if (lane < 16) { const f32x2 p = *(const f32x2*)(st + 2 * lane); s1 = p.x; s2 = p.y; }
    s1 = wave_sum(s1); s2 = wave_sum(s2);
    mean = s1 * (1.f / DM); const float var = s2 * (1.f / DM) - mean * mean; rstd = 1.f / sqrtf(fmaxf(var, 0.f) + LN_EPS);
}
__device__ __forceinline__ void ph_final(const Ctx& F) {
    const Args& A = *F.a;
    const bf16_t* Z = (const bf16_t*)(F.ws + WS_Z); const float* ZST = (const float*)(F.ws + WS_ZST); const unsigned char* YS = F.ws + WS_YS; const int* TKE = (const int*)(F.ws + WS_TKE); const int* TKP = (const int*)(F.ws + WS_TKP);
    const LAS int* tab = (const LAS int*)(F.lds + LDS_MOE);
    const int gw = F.vcu * 8 + F.wave, NGW = F.G * 8;
    f32x4 g2[4], b2[4], g1[4], b1[4];
#pragma unroll
    for (int j = 0; j < 4; ++j) { g2[j] = *((const f32x4*)A.in[I_LNF_G] + F.lane + 64 * j); b2[j] = *((const f32x4*)A.in[I_LNF_B] + F.lane + 64 * j);
        g1[j] = *((const f32x4*)A.in[I_LNMIX_G] + F.lane + 64 * j) * ALPHA; b1[j] = *((const f32x4*)A.in[I_LNMIX_B] + F.lane + 64 * j) * ALPHA; }
    for (int m = gw; m < T; m += NGW) {
        float mean, rstd; ln_stats16(ZST + (size_t)m * 32, F.lane, mean, rstd);
        const u32x2* hr = (const u32x2*)(Z + (size_t)m * DM) + F.lane;
        f32x4 v[4];
#pragma unroll
        for (int j = 0; j < 4; ++j) { const u32x2 hb = hr[64 * j]; v[j] = ((f32x4){bflo(hb.x), bfhi(hb.x), bflo(hb.y), bfhi(hb.y)} - mean) * rstd * g1[j] + b1[j]; }
#pragma unroll
        for (int k = 0; k < 4; ++k) {
            const int row = tab[32 + TKE[(size_t)m * 4 + k]] + TKP[(size_t)m * 4 + k]; const unsigned* yr = (const unsigned*)(YS + (size_t)row * DM) + F.lane;
#pragma unroll
            for (int j = 0; j < 4; ++j) { const unsigned y = yr[64 * j]; const f32x2v f0 = __builtin_amdgcn_cvt_pk_f32_fp8((int)y, false), f1 = __builtin_amdgcn_cvt_pk_f32_fp8((int)y, true);
                v[j].x += 0.0625f * f0.x; v[j].y += 0.0625f * f0.y; v[j].z += 0.0625f * f1.x; v[j].w += 0.0625f * f1.y; }
        }
        float s = 0.f;
#pragma unroll
        for (int j = 0; j < 4; ++j) s += (v[j].x + v[j].y) + (v[j].z + v[j].w);
        const float mu = wave_sum(s) * (1.f / DM); float s2 = 0.f;
#pragma unroll
        for (int j = 0; j < 4; ++j) { v[j] = v[j] - mu; s2 += (v[j].x * v[j].x + v[j].y * v[j].y) + (v[j].z * v[j].z + v[j].w * v[j].w); }
        const float rs = 1.f / sqrtf(wave_sum(s2) * (1.f / DM) + LN_EPS);
        f32x4* orow = (f32x4*)(A.out + (size_t)m * DM) + F.lane;
#pragma unroll
        for (int j = 0; j < 4; ++j) orow[64 * j] = v[j] * rs * g2[j] + b2[j];
    }
}

#define XB_TMO      128
#define XB_XCNT(j)  (256  + 64 * (j))
#define XB_XSUB(j)  (1280 + 64 * (j))
#define XB_XGEN(j)  (2304 + 64 * (j))
#define XB_TOP      3328
#define XB_TOPGEN   3392
#define XCD_BAR_WORDS 3456
#define XB_SPIN_CAP (1u << 18)
__device__ __forceinline__ unsigned xb_ld(unsigned* p)              { return __hip_atomic_load(p, __ATOMIC_RELAXED, __HIP_MEMORY_SCOPE_AGENT); }
__device__ __forceinline__ unsigned xb_add(unsigned* p, unsigned v) { return __hip_atomic_fetch_add(p, v, __ATOMIC_RELAXED, __HIP_MEMORY_SCOPE_AGENT); }
__device__ __forceinline__ unsigned xb_xcc_id() { return (unsigned)__builtin_amdgcn_s_getreg((3 << 11) | 20) & 0xFu; }
#define XB_SPIN(cond, bar) do { unsigned _sp = 0; while (cond) { __builtin_amdgcn_s_sleep(1); \
    if ((++_sp & 255u) == 0u) { if (xb_ld(&(bar)[XB_TMO])) break; if (_sp > XB_SPIN_CAP) { atomicAdd(&(bar)[XB_TMO], 1u); break; } } } } while (0)
__device__ __forceinline__ void xcd_barrier_complete(unsigned* bar, unsigned x, unsigned& nloc, unsigned& nx) {
    const unsigned G = gridDim.x * gridDim.y * gridDim.z;
    unsigned sum, cnt, mine, sp = 0u;
    for (;;) {
        sum = 0u; cnt = 0u; mine = 0u;
#pragma unroll
        for (unsigned j = 0; j < 16; ++j) { const unsigned c = xb_ld(&bar[XB_XCNT(j)]); sum += c; cnt += (c > 0u) ? 1u : 0u; mine = (j == x) ? c : mine; }
        if (sum == G) break;
        __builtin_amdgcn_s_sleep(1);
        if ((++sp & 255u) == 0u) { if (xb_ld(&bar[XB_TMO])) break; if (sp > XB_SPIN_CAP) { atomicAdd(&bar[XB_TMO], 1u); break; } }
    }
    nloc = mine > 0u ? mine : 1u; nx = cnt > 0u ? cnt : 1u;
}
__device__ __forceinline__ void xcd_barrier(unsigned* bar, volatile LAS unsigned* st, unsigned x, bool leader_thread) {
    asm volatile("s_waitcnt vmcnt(0)" ::: "memory");
    __syncthreads();
    if (leader_thread) {
        __builtin_amdgcn_s_waitcnt(0);
        unsigned nloc = st[0], nx = st[1];
        if (nloc == 0u) { xcd_barrier_complete(bar, x, nloc, nx); st[0] = nloc; st[1] = nx; }
        const unsigned old = xb_add(&bar[XB_XSUB(x)], 1u);
        const unsigned gen = old / nloc;
        if (old + 1u == (gen + 1u) * nloc) {
            __builtin_amdgcn_fence(__ATOMIC_RELEASE, "agent");
            asm volatile("s_waitcnt vmcnt(0)" ::: "memory");
            const unsigned og = xb_add(&bar[XB_TOP], 1u);
            const unsigned tg = og / nx;
            if (og + 1u == (tg + 1u) * nx) xb_add(&bar[XB_TOPGEN], 1u);
            else XB_SPIN(xb_ld(&bar[XB_TOPGEN]) == tg, bar);
            __builtin_amdgcn_fence(__ATOMIC_ACQUIRE, "agent");
            xb_add(&bar[XB_XGEN(x)], 1u);
            asm volatile("s_waitcnt vmcnt(0)" ::: "memory");
        } else {
            XB_SPIN(xb_ld(&bar[XB_XGEN(x)]) == gen, bar);
            __builtin_amdgcn_fence(__ATOMIC_ACQUIRE, "agent");
            asm volatile("s_waitcnt vmcnt(0)" ::: "memory");
        }
    }
    __syncthreads();
}

template <bool COOP>
__global__ void __launch_bounds__(512, 2) mega(Args args) {
    extern __shared__ __attribute__((aligned(16))) unsigned char lds_raw[];
    Ctx F;
    const int wave0 = __builtin_amdgcn_readfirstlane(threadIdx.x >> 6);
#define MKCTX() do { F.a = &args; F.ws = args.ws; F.lds = (LAS unsigned char*)lds_raw; F.ldsg = lds_raw; F.lane = lane_id_asm(); F.wave = wave0; F.tid = wave0 * 64 + F.lane; \
    F.G = gridDim.x; { const int bx = blockIdx.x; F.vcu = (F.G % 8 == 0) ? (bx % 8) * (F.G / 8) + bx / 8 : bx; } } while (0)
    MKCTX();
    const int lo = args.ph_lo, hi = args.ph_hi;
    unsigned char* ws = args.ws;
#ifndef PHMASK
#define PHMASK 0xFFFF
#endif
#define IN(k) (((PHMASK >> (k)) & 1) && lo <= (k) && (k) < hi)
    unsigned* barw = (unsigned*)(ws + WS_CTL) + CW_BAR; volatile LAS unsigned* bst = (volatile LAS unsigned*)((LAS unsigned char*)lds_raw + LDS_BYTES - 64);
    const unsigned my_xcc = xb_xcc_id();
    if (COOP) { if (threadIdx.x == 0) { bst[0] = 0u; bst[1] = 0u; (void)xb_add(&barw[XB_XCNT(my_xcc)], 1u); } __syncthreads(); }
#define SEAM(k) do { if (COOP && IN(k) && IN((k) + 1)) { if (args.ph_hi > 1000) cg::this_grid().sync();   xcd_barrier(barw, bst, my_xcc, wave0 == 0 && lane_id_asm() == 0); } } while (0)
    if (IN(0)) { MKCTX(); ph_prologue(F); } SEAM(0);
    if (IN(1)) {
        constexpr int NSLOT = 4;
        const int wslot = (F.G % 8 == 0) ? ((int)blockIdx.x / 8) % NSLOT : (int)blockIdx.x % NSLOT;
        if (wslot == 0) { MKCTX(); ph_wconv(F); }
        {
            pg8::Gemm g{(const bf16_t*)(ws + WS_H0), (const bf16_t*)(ws + WS_WIN), DM, DM, DM, nullptr}; pg8::StaticOrder S; S.init(T, PN8_LO * 256, F.G, (int)blockIdx.x, 0);
            const pg8::Epi1 E{(bf16_t*)(ws + WS_YAB), (bf16_t*)(ws + WS_GV), ws + WS_Q, ws + WS_K, ws + WS_V, (bf16_t*)(ws + WS_SA), (bf16_t*)(ws + WS_SB), (float*)(ws + WS_GVST), (float*)(ws + WS_KMEAN), 1.0f, 0.f};
            pg8::gemm_phase<pg8::Epi1, pg8::StaticOrder, true>(F.lds, g, S, E, wave0);
        }
#pragma unroll 1
        for (int part = 0; part < 2; ++part) {
            if (wslot == 1 + part) { MKCTX(); ph_wconv(F); }
            const pg8::Epi1 E{(bf16_t*)(ws + WS_YAB), (bf16_t*)(ws + WS_GV), ws + WS_Q, ws + WS_K, ws + WS_V, (bf16_t*)(ws + WS_SA), (bf16_t*)(ws + WS_SB), (float*)(ws + WS_GVST), (float*)(ws + WS_KMEAN), 0.03125f, 0.f};
            pg8::Gemm g{(const bf16_t*)(ws + WS_H0F8), (const bf16_t*)(ws + WS_WIN8), DM / 2, DM / 2, DM / 2, nullptr}; pg8::StaticOrder S; S.init(T, (PN8_HI - PN8_LO) / 2 * 256, F.G, (int)blockIdx.x, PN8_LO + part * ((PN8_HI - PN8_LO) / 2));
            pg8::gemm_phase<pg8::Epi1, pg8::StaticOrder, true, true>(F.lds, g, S, E, wave0);
        }
        if (wslot == 3) { MKCTX(); ph_wconv(F); }
    } SEAM(1);
    if (IN(2)) { MKCTX(); ph_mixer_a(F); __syncthreads(); ph_gate(F); } SEAM(2);
    if (IN(3)) { } if (COOP && IN(3) && IN(4)) { }
    if (IN(4)) { MKCTX(); ph_attn_partial(F); } SEAM(4);
    if (IN(5)) { MKCTX(); ph_attn_own(F); } SEAM(5);
    if (IN(6)) {
        pg8::Gemm g{(const bf16_t*)(ws + WS_YA8), (const bf16_t*)(ws + WS_WAB), 2048 / 2, 2048 / 2, 2048 / 2, nullptr}; pg8::StaticOrder S; S.init(T, DM, F.G, (int)blockIdx.x);
        pg8::Epi2 E{ws + WS_SA, ws + WS_SB, (bf16_t*)(ws + WS_MG)};
        pg8::gemm_phase<pg8::Epi2, pg8::StaticOrder, true, true>(F.lds, g, S, E, wave0);
    } SEAM(6);
    if (IN(7)) {
        pg8::Gemm g{(const bf16_t*)(ws + WS_MG), (const bf16_t*)(ws + WS_WOUT), DM, DM, DM, nullptr}; pg8::StaticOrder S; S.init(T, DM, F.G, (int)blockIdx.x);
        pg8::Epi3 E{(const bf16_t*)(ws + WS_H0), (bf16_t*)(ws + WS_Z), (float*)(ws + WS_ZST)};
        pg8::gemm_phase<pg8::Epi3, pg8::StaticOrder, true>(F.lds, g, S, E, wave0);
    } SEAM(7);
    if (IN(8)) { MKCTX(); ph_router(F); } SEAM(8);
    if (IN(9)) { } if (COOP && IN(9) && IN(10)) { }
    if (IN(10)) {
        MKCTX(); moe_table(F);
        pg8::Gemm g{(const bf16_t*)(ws + WS_H1F8), (const bf16_t*)(ws + WS_WUP), DM / 2, DM / 2, DM / 2, (const int*)(ws + WS_RT)}; pg8::MoeOrder S;   S.init((const LAS int*)(F.lds + LDS_MOE), 8, F.G, (int)blockIdx.x);
        pg8::Epi4 E{args.in[I_BUP], ws + WS_ACT};
        pg8::gemm_phase<pg8::Epi4, pg8::MoeOrder, true, true, true>(F.lds, g, S, E, wave0);
    } SEAM(10);
    if (IN(11)) {
        MKCTX(); moe_table(F);
        pg8::Gemm g{(const bf16_t*)(ws + WS_ACT), (const bf16_t*)(ws + WS_WDN), FF / 2, FF / 2, FF / 2, nullptr}; pg8::MoeOrder S; S.init((const LAS int*)(F.lds + LDS_MOE), 4, F.G, (int)blockIdx.x);
        pg8::Epi5 E{args.in[I_BDN], (const float*)(ws + WS_RW), ws + WS_YS};
        pg8::gemm_phase<pg8::Epi5, pg8::MoeOrder, true, true>(F.lds, g, S, E, wave0);
    } SEAM(11);
    if (IN(12)) { MKCTX(); moe_table(F); ph_final(F); }
#undef IN
#undef SEAM
}

extern "C" void kernel_launch(void* const* d_in, const int* in_sizes, int n_in, void* d_out, int out_size, void* d_ws, size_t ws_size, hipStream_t stream) {
    static int grid = 0;
    if (grid == 0) {
        if (n_in != 21 || in_sizes[0] != T * DM || out_size != T * DM || ws_size < WS_END) { fprintf(stderr, "kernel_launch: unexpected shapes (n_in %d, in0 %d, out %d, ws %zu)\n", n_in, n_in > 0 ? in_sizes[0] : -1, out_size, ws_size); grid = -1; return; }
        int dev = 0, cus = 0, per_cu = 0;
        hipGetDevice(&dev); hipDeviceGetAttribute(&cus, hipDeviceAttributeMultiprocessorCount, dev);
        const void* fn = MK_COOP ? (const void*)mega<true> : (const void*)mega<false>;
        hipFuncSetAttribute(fn, hipFuncAttributeMaxDynamicSharedMemorySize, LDS_BYTES);
        hipOccupancyMaxActiveBlocksPerMultiprocessor(&per_cu, fn, 512, LDS_BYTES);
        (void)hipGetLastError();
        if (per_cu < 1) { fprintf(stderr, "kernel_launch: occupancy query says %d blocks/CU\n", per_cu); per_cu = 1; }
        grid = cus * 1;
    }
    if (grid < 0) return;
    hipMemsetAsync((char*)d_ws + WS_CTL, 0, CTL_ZERO_BYTES, stream);
    Args a{};
    for (int i = 0; i < 21; ++i) a.in[i] = (const float*)d_in[i];
    a.out = (float*)d_out; a.ws = (unsigned char*)d_ws;
#if MK_COOP
    a.ph_lo = 0; a.ph_hi = NPHASE;
    void* kargs[] = {&a};
    hipError_t e = hipLaunchCooperativeKernel((const void*)mega<true>, dim3(grid), dim3(512), kargs, LDS_BYTES, stream);
    if (e != hipSuccess) fprintf(stderr, "cooperative launch failed: %s (grid %d)\n", hipGetErrorString(e), grid);
#else
    for (int p = 0; p < NPHASE; ++p) { a.ph_lo = p; a.ph_hi = p + 1; hipLaunchKernelGGL(mega<false>, dim3(grid), dim3(512), LDS_BYTES, stream, a); }
#endif
}
```

```cpp
#include <hip/hip_runtime.h>
#include <hip/hip_cooperative_groups.h>
#include <cstdio>
#include <cstdint>
namespace cg = cooperative_groups;

#ifndef MK_COOP
#define MK_COOP 1
#endif

#define LAS __attribute__((address_space(3)))
typedef unsigned short bf16_t;
typedef short bf16x8 __attribute__((ext_vector_type(8)));
typedef float f32x4 __attribute__((ext_vector_type(4)));
typedef float f32x2 __attribute__((ext_vector_type(2)));
typedef unsigned u32x4 __attribute__((ext_vector_type(4)));
typedef unsigned u32x2 __attribute__((ext_vector_type(2)));

constexpr int NB = 8, SEQ = 4096, DM = 1024, T = NB * SEQ;
constexpr int NH = 8, DH = 128, LBLK = 256, NBLK = SEQ / LBLK;
constexpr int NE = 32, TOPK = 4, FF = 1024;
constexpr int INCOLS = 7 * DM;
constexpr int RMAX = T * TOPK + NE * 256;
constexpr float LN_EPS = 1e-5f;
constexpr float ALPHA = 1.189207115002721f;
constexpr float QSCALE = 0.08838834764831845f * 1.4426950408889634f;

constexpr size_t MiB = 1u << 20, U64 = 64 * MiB;
constexpr size_t WS_CTL = 0, CTL_ZERO_BYTES = 1 * MiB;
constexpr int CW_ECNT = 64;
constexpr int CW_LCNT = 1024;
constexpr int CW_BAR = 4096;
constexpr size_t WS_KMEAN = 1 * MiB;
constexpr size_t WS_GVST = 2 * MiB;
constexpr size_t WS_ZST = 6 * MiB;
constexpr size_t WS_SEL = 10 * MiB;
constexpr size_t WS_TKE = 11 * MiB;
constexpr size_t WS_TKW = 11 * MiB + 512 * 1024;
constexpr size_t WS_TKP = 12 * MiB;
constexpr size_t WS_ROWOF = 12 * MiB + 512 * 1024;
constexpr size_t WS_ROWTOK = 13 * MiB;
constexpr size_t WS_ROWW = 14 * MiB;
constexpr size_t WS_TILE = 15 * MiB;
constexpr size_t WS_LISTS = 16 * MiB;
constexpr size_t WS_LSE = 32 * MiB;
constexpr size_t WS_RT = 16 * MiB;
constexpr size_t WS_RW = 20 * MiB;
constexpr int LDS_MOE = 131072 + 1024;
constexpr size_t WS_WIN = 40 * MiB;
constexpr size_t WS_WAB = 54 * MiB;
constexpr size_t WS_WOUT = 58 * MiB;
constexpr size_t WS_WDN = 60 * MiB;
constexpr size_t WS_WUP = 124 * MiB;
constexpr size_t WS_H0 = 4 * U64;
constexpr size_t WS_YAB = 5 * U64;
constexpr size_t WS_GV = 7 * U64;
constexpr size_t WS_Q = 8 * U64, WS_K = 9 * U64, WS_V = 10 * U64, WS_SA = 11 * U64, WS_SB = 12 * U64;
constexpr size_t WS_OP = 13 * U64;
constexpr size_t WS_MG = WS_GV;
constexpr size_t WS_Z = 14 * U64;
constexpr size_t WS_H1 = WS_H0;
constexpr size_t WS_XG = 5 * U64;
constexpr size_t WS_H1F8 = 12 * U64;
constexpr size_t WS_ACT = 9 * U64 + 16 * MiB;
constexpr size_t WS_YS = WS_XG;
constexpr size_t WS_H0F8 = 13 * U64;
constexpr size_t WS_WIN8 = 192 * MiB;
constexpr int PN8_LO = 4, PN8_HI = 28;
constexpr size_t WS_YA8 = 15 * U64;
constexpr size_t WS_END = 16 * U64;
static_assert(WS_XG + (size_t)RMAX * 2048 <= WS_ACT && WS_ACT + (size_t)RMAX * 2048 <= WS_Z, "ws map");

constexpr int LDS_BYTES = 163840;
constexpr int LDS_MISC = 131072;
constexpr int NPHASE = 13;

__device__ __forceinline__ float bf2f(bf16_t v) { return __uint_as_float((unsigned)v << 16); }
__device__ __forceinline__ float bflo(unsigned u) { return __uint_as_float(u << 16); }
__device__ __forceinline__ float bfhi(unsigned u) { return __uint_as_float(u & 0xffff0000u); }
__device__ __forceinline__ unsigned f2bf(float f) { unsigned u = __builtin_bit_cast(unsigned, f); return (u + 0x7fffu + ((u >> 16) & 1u)) >> 16; }
__device__ __forceinline__ unsigned pk2(float lo, float hi) { return f2bf(lo) | (f2bf(hi) << 16); }
typedef __bf16 bf16x2_t __attribute__((ext_vector_type(2)));
__device__ __forceinline__ unsigned cvt_pk_bf16(float lo, float hi) { f32x2 v = {lo, hi}; bf16x2_t b = __builtin_convertvector(v, bf16x2_t); return __builtin_bit_cast(unsigned, b); }
__device__ __forceinline__ int lane_id_asm() { int l; asm volatile("v_mbcnt_lo_u32_b32 %0, -1, 0\n\tv_mbcnt_hi_u32_b32 %0, -1, %0" : "=v"(l)); return l; }
__device__ __forceinline__ float wave_sum(float v) {
#pragma unroll
    for (int o = 1; o < 64; o <<= 1) v += __shfl_xor(v, o);
    return v;
}
__device__ __forceinline__ float wave_max(float v) {
#pragma unroll
    for (int o = 1; o < 64; o <<= 1) v = fmaxf(v, __shfl_xor(v, o));
    return v;
}
__device__ __forceinline__ f32x2 gelu_pk(f32x2 v) {
    const f32x2 av = __builtin_elementwise_abs(v), d = av * 0.2316418882f + 1.0f;
    f32x2 t; t.x = __builtin_amdgcn_rcpf(d.x); t.y = __builtin_amdgcn_rcpf(d.y);
    f32x2 q = t * 0.5307027145f + (-0.7265760135f); q = q * t + 0.7107068705f; q = q * t + (-0.142248368f); q = q * t + 0.127414796f; q = q * t;
    const f32x2 s = (v * v) * (-0.72134752044f);
    f32x2 e; e.x = __builtin_amdgcn_exp2f(s.x); e.y = __builtin_amdgcn_exp2f(s.y);
    const f32x2 m = v * (q * e), r = v - m;
    f32x2 o; o.x = v.x < 0.f ? m.x : r.x; o.y = v.y < 0.f ? m.y : r.y; return o;
}
typedef float f32x2v __attribute__((ext_vector_type(2)));
template <bool HI> __device__ __forceinline__ unsigned f8x2_to_bf16x2(unsigned w) { const f32x2v f = __builtin_amdgcn_cvt_pk_f32_fp8((int)w, HI); return cvt_pk_bf16(f.x, f.y); }
__device__ __forceinline__ u32x4 f8x8_to_bf16x8(unsigned lo, unsigned hi) { return (u32x4){f8x2_to_bf16x2<false>(lo), f8x2_to_bf16x2<true>(lo), f8x2_to_bf16x2<false>(hi), f8x2_to_bf16x2<true>(hi)}; }
__device__ __forceinline__ unsigned pack_fp8x4(float a, float b, float c, float d) { unsigned w = 0u; w = __builtin_amdgcn_cvt_pk_fp8_f32(a, b, w, false); w = __builtin_amdgcn_cvt_pk_fp8_f32(c, d, w, true); return w; }
__device__ __forceinline__ float sigmoidf_(float x) { return __builtin_amdgcn_rcpf(1.0f + __builtin_amdgcn_exp2f(-1.4426950408889634f * x)); }

namespace pg8 {
constexpr int BM = 256, BK = 64, HALF = 128, HTB = HALF * BK * 2, STAGE_BYTES = 8 * HTB, NXCD = 8, WGM = 8;
__host__ __device__ __forceinline__ int lds_byte(int r, int c) { const int st = (r >> 4) * 2 + (c >> 5), rr = r & 15, cc = c & 31, ob = rr * 64 + cc * 2; return st * 1024 + (ob ^ (((ob >> 9) & 1) << 5)); }
__host__ __device__ __forceinline__ void stage_rc(int b, int& R, int& C) { const int st = b / 1024, sb = b % 1024, swz = sb ^ (((sb >> 9) & 1) << 5); R = (st >> 1) * 16 + swz / 64; C = (st & 1) * 32 + (swz % 64) / 2; }
__host__ __device__ __forceinline__ int perm32(int rho) { const int n = rho >> 4, i = rho & 15; return 8 * (i >> 2) + 4 * n + (i & 3); }

struct Unit { int pm, pn, bt, rbase; };
struct Gemm { const bf16_t* A; const bf16_t* Bt; int K, lda, ldb; const int* rowidx; };

struct StaticOrder {
    int nM, nN, nwg, G, c, pbase, psplit, pjump;
    __device__ void init(int M, int N, int G_, int c_, int pbase_ = 0, int psplit_ = 1 << 20, int pjump_ = 0) { nM = M / BM; nN = N / BM; nwg = nM * nN; G = G_; c = c_; pbase = pbase_; psplit = psplit_; pjump = pjump_; }
    __device__ bool next(int i, Unit& u) const {
        const long L = (long)i * G + c; if (L >= nwg) return false;
        int wgid = (int)L; { const int q = nwg / NXCD, r = nwg % NXCD, xcd = wgid % NXCD, off = wgid / NXCD; wgid = (xcd < r ? xcd * (q + 1) : r * (q + 1) + (xcd - r) * q) + off; }
        const int nig = WGM * nN, gid = wgid / nig, fm = gid * WGM, gsz = (nM - fm) < WGM ? (nM - fm) : WGM;
        u.pm = fm + ((wgid % nig) % gsz); const int p = (wgid % nig) / gsz; u.pn = pbase + (p < psplit ? p : p + pjump); u.bt = u.pn; u.rbase = u.pm * BM; return true;
    }
};
struct MoeOrder {
    int nM, nN, nwg, G, c; const LAS int* tab;
    __device__ void init(const LAS int* tiletab, int nN_, int G_, int c_) { nM = tiletab[0]; tab = tiletab; nN = nN_; nwg = nM * nN; G = G_; c = c_; }
    __device__ bool next(int i, Unit& u) const {
        const long L = (long)i * G + c; if (L >= nwg) return false;
        int wgid = (int)L; { const int q = nwg / NXCD, r = nwg % NXCD, xcd = wgid % NXCD, off = wgid / NXCD; wgid = (xcd < r ? xcd * (q + 1) : r * (q + 1) + (xcd - r) * q) + off; }
        const int nig = WGM * nN, gid = wgid / nig, fm = gid * WGM, gsz = (nM - fm) < WGM ? (nM - fm) : WGM;
        u.pm = fm + ((wgid % nig) % gsz); u.pn = (wgid % nig) / gsz; { const int e = tab[128 + 2 * u.pm], tl = tab[129 + 2 * u.pm]; u.bt = e * nN + u.pn; u.rbase = e * T + tl * BM; } return true;
    }
};

typedef int v4i_t __attribute__((ext_vector_type(4)));
typedef int v8i_t __attribute__((ext_vector_type(8)));
template <class Epi, class Sched, bool ALIGN_EPI, bool FP8 = false, bool GATHER = false>
__device__ __forceinline__ void gemm_phase(LAS unsigned char* lds, const Gemm g, const Sched& S, const Epi& E, const int wid) {
    const int lane = lane_id_asm(), tid = wid * 64 + lane;
    const int wr = wid >> 2, wc = wid & 3, fr = lane & 15, fq = lane >> 4;
    const int nt = g.K / BK;
    unsigned voffA[2], voffB[2]; int gR[2];
#pragma unroll
    for (int i = 0; i < 2; ++i) { int R, C; stage_rc(tid * 16 + i * 8192, R, C); const int Rb = Epi::PERM ? ((R & ~31) + perm32(R & 31)) : R;
        voffA[i] = GATHER ? (unsigned)C * 2u : (unsigned)(R * g.lda + C) * 2u; voffB[i] = (unsigned)(Rb * g.ldb + C) * 2u; gR[i] = R; }
    const size_t kstep = (size_t)(BK * 2);
    const size_t hstepA = GATHER ? 0 : (size_t)HALF * g.lda * 2, hstepB = (size_t)HALF * g.ldb * 2;
    const size_t tstepA = 2 * hstepA, tstepB = 2 * hstepB;
    const unsigned ldsw = (unsigned)wid * 1024u;
    const int aoff = lds_byte(wr * 64 + fr, fq * 8), boff = lds_byte(wc * 32 + fr, fq * 8);
#define PG8_SA(b, h) (((b) * 2 + (h)) * HTB)
#define PG8_SB(b, h) ((4 + (b) * 2 + (h)) * HTB)
#define PG8_STAGE(bufoff, gbase, voff) do { _Pragma("unroll") for (int _i = 0; _i < 2; ++_i) \
        __builtin_amdgcn_global_load_lds((const unsigned*)((const char*)(gbase) + (voff)[_i]), (LAS unsigned*)(lds + (bufoff) + ldsw + _i * 8192), 16, 0, 0); } while (0)
#define PG8_LD8(p) __builtin_shufflevector(*(const LAS v4i_t*)(p), *(const LAS v4i_t*)((p) + 1024), 0, 1, 2, 3, 4, 5, 6, 7)
#define PG8_LDA(dst, b, h) do { _Pragma("unroll") for (int m = 0; m < 4; ++m) { if constexpr (FP8) dst##8[m] = PG8_LD8(lds + PG8_SA(b, h) + aoff + m * 2048); \
        else { _Pragma("unroll") for (int k = 0; k < 2; ++k) dst[m][k] = *(const LAS bf16x8*)(lds + PG8_SA(b, h) + aoff + m * 2048 + k * 1024); } } } while (0)
#define PG8_LDB(dst, b, h) do { _Pragma("unroll") for (int n = 0; n < 2; ++n) { if constexpr (FP8) dst##8[n] = PG8_LD8(lds + PG8_SB(b, h) + boff + n * 2048); \
        else { _Pragma("unroll") for (int k = 0; k < 2; ++k) dst[n][k] = *(const LAS bf16x8*)(lds + PG8_SB(b, h) + boff + n * 2048 + k * 1024); } } } while (0)
#define PG8_MMA(ai, bj, At, Bt) do { __builtin_amdgcn_s_setprio(1); _Pragma("unroll") for (int m = 0; m < 4; ++m) _Pragma("unroll") for (int n = 0; n < 2; ++n) { \
        if constexpr (FP8) { asm volatile("s_nop 1\n\tv_mfma_scale_f32_16x16x128_f8f6f4 %0, %1, %2, %0, %3, %3 op_sel_hi:[0,0,0]" : "+v"(acc[ai][bj][m][n]) : "v"(Bt##8[n]), "v"(At##8[m]), "v"(scl8)); } \
        else { _Pragma("unroll") for (int k = 0; k < 2; ++k) acc[ai][bj][m][n] = __builtin_amdgcn_mfma_f32_16x16x32_bf16(Bt[n][k], At[m][k], acc[ai][bj][m][n], 0, 0, 0); } } \
        __builtin_amdgcn_s_setprio(0); } while (0)
#define PG8_WAIT_V(n) asm volatile("s_waitcnt vmcnt(" #n ")" ::: "memory")
#define PG8_WAIT_L(n) asm volatile("s_waitcnt lgkmcnt(" #n ")" ::: "memory")
#define PG8_BAR __builtin_amdgcn_s_barrier()
#define PG8_SCHED __builtin_amdgcn_sched_barrier(0)
    Unit cur, nxt; int ui = 0;
    if (!S.next(0, cur)) return;
    unsigned va0[2], va1[2], vn0[2], vn1[2];
#define PG8_GIDX(dst0, dst1, u) do { if constexpr (GATHER) { _Pragma("unroll") for (int _i = 0; _i < 2; ++_i) { \
        dst0[_i] = min((unsigned)g.rowidx[(u).rbase + gR[_i]], (unsigned)(T - 1)) * (unsigned)(g.lda * 2) + voffA[_i]; dst1[_i] = min((unsigned)g.rowidx[(u).rbase + HALF + gR[_i]], (unsigned)(T - 1)) * (unsigned)(g.lda * 2) + voffA[_i]; } } \
        else { _Pragma("unroll") for (int _i = 0; _i < 2; ++_i) { dst0[_i] = voffA[_i]; dst1[_i] = voffA[_i]; } } } while (0)
    PG8_GIDX(va0, va1, cur);
    f32x4 acc[2][2][4][2];
#pragma unroll
    for (int a = 0; a < 2; ++a)
#pragma unroll
        for (int b = 0; b < 2; ++b)
#pragma unroll
            for (int m = 0; m < 4; ++m)
#pragma unroll
                for (int n = 0; n < 2; ++n) acc[a][b][m][n] = (f32x4){0.f, 0.f, 0.f, 0.f};
    bf16x8 At[4][2], B0[2][2], B1[2][2]; v8i_t At8[4], B08[2], B18[2];
    int scl8 = 0x7f7f7f7f; asm volatile("" : "+v"(scl8));
    const char* cA = (const char*)g.A + (GATHER ? 0 : (size_t)cur.pm * tstepA); const char* cB = (const char*)g.Bt + (size_t)cur.bt * tstepB;
    PG8_STAGE(PG8_SB(0, 0), cB, voffB); PG8_STAGE(PG8_SB(0, 1), cB + hstepB, voffB); PG8_STAGE(PG8_SA(0, 0), cA, va0); PG8_STAGE(PG8_SA(0, 1), cA + hstepA, va1);
    if (wr == 1) PG8_BAR;
    PG8_WAIT_V(2); PG8_BAR;
    PG8_STAGE(PG8_SB(1, 0), cB + kstep, voffB); PG8_STAGE(PG8_SA(1, 0), cA + kstep, va0); PG8_STAGE(PG8_SB(1, 1), cB + hstepB + kstep, voffB);
    PG8_WAIT_V(6); PG8_BAR;
    for (;;) {
        const bool has_next = S.next(ui + 1, nxt);
        const char* nA = (has_next && !GATHER) ? (const char*)g.A + (size_t)nxt.pm * tstepA : cA; const char* nB = has_next ? (const char*)g.Bt + (size_t)nxt.bt * tstepB : cB;
        if (has_next) PG8_GIDX(vn0, vn1, nxt); else { _Pragma("unroll") for (int _i = 0; _i < 2; ++_i) { vn0[_i] = va0[_i]; vn1[_i] = va1[_i]; } }
#pragma unroll 1
        for (int t = 0; t < nt; t += 2) {
            const bool last = (t == nt - 2);
            const char* a1 = cA + (size_t)(t + 1) * kstep;
            const char* a2 = last ? nA : cA + (size_t)(t + 2) * kstep; const char* b2 = last ? nB : cB + (size_t)(t + 2) * kstep;
            const char* a3 = a2 + kstep; const char* b3 = b2 + kstep;
            if constexpr (Epi::MID_T > 0) { if (t == Epi::MID_T) {
                if constexpr (FP8) {
#pragma unroll
                    for (int a = 0; a < 2; ++a)
#pragma unroll
                        for (int b = 0; b < 2; ++b)
                            asm volatile("s_nop 15\n\ts_nop 7" : "+v"(acc[a][b][0][0]), "+v"(acc[a][b][0][1]), "+v"(acc[a][b][1][0]), "+v"(acc[a][b][1][1]), "+v"(acc[a][b][2][0]), "+v"(acc[a][b][2][1]), "+v"(acc[a][b][3][0]), "+v"(acc[a][b][3][1]));
                }
                E.mid(acc, cur, wr, wc, fr, fq); } }
            unsigned vs0[2], vs1[2];
#pragma unroll
            for (int _i = 0; _i < 2; ++_i) { vs0[_i] = last ? vn0[_i] : va0[_i]; vs1[_i] = last ? vn1[_i] : va1[_i]; }
            PG8_LDB(B0, 0, 0); PG8_LDB(B1, 0, 1); PG8_SCHED; PG8_LDA(At, 0, 0); PG8_STAGE(PG8_SA(1, 1), a1 + hstepA, va1);
            PG8_WAIT_V(8); PG8_WAIT_L(0); PG8_BAR; PG8_MMA(0, 0, At, B0); PG8_MMA(0, 1, At, B1); PG8_BAR; PG8_SCHED;
            PG8_LDA(At, 0, 1); PG8_STAGE(PG8_SB(0, 0), b2, voffB); PG8_STAGE(PG8_SB(0, 1), b2 + hstepB, voffB); PG8_STAGE(PG8_SA(0, 0), a2, vs0);
            PG8_WAIT_V(8); PG8_WAIT_L(0); PG8_BAR; PG8_MMA(1, 0, At, B0); PG8_MMA(1, 1, At, B1); PG8_BAR; PG8_SCHED;
            PG8_LDB(B0, 1, 0); PG8_LDB(B1, 1, 1); PG8_SCHED; PG8_LDA(At, 1, 0); PG8_STAGE(PG8_SA(0, 1), a2 + hstepA, vs1);
            PG8_WAIT_V(8); PG8_WAIT_L(0); PG8_BAR; PG8_MMA(0, 0, At, B0); PG8_MMA(0, 1, At, B1); PG8_BAR; PG8_SCHED;
            PG8_LDA(At, 1, 1); PG8_STAGE(PG8_SB(1, 0), b3, voffB); PG8_STAGE(PG8_SB(1, 1), b3 + hstepB, voffB); PG8_STAGE(PG8_SA(1, 0), a3, vs0);
            PG8_WAIT_V(8); PG8_WAIT_L(0); PG8_BAR; PG8_MMA(1, 0, At, B0); PG8_MMA(1, 1, At, B1); PG8_BAR; PG8_SCHED;
        }
        if constexpr (ALIGN_EPI) { if (wr == 0) PG8_BAR; }
        if constexpr (FP8) {
#pragma unroll
            for (int a = 0; a < 2; ++a)
#pragma unroll
                for (int b = 0; b < 2; ++b)
                    asm volatile("s_nop 15\n\ts_nop 7" : "+v"(acc[a][b][0][0]), "+v"(acc[a][b][0][1]), "+v"(acc[a][b][1][0]), "+v"(acc[a][b][1][1]), "+v"(acc[a][b][2][0]), "+v"(acc[a][b][2][1]), "+v"(acc[a][b][3][0]), "+v"(acc[a][b][3][1]));
        }
        E(acc, cur, wr, wc, fr, fq);
        if (!has_next) break;
#pragma unroll
        for (int a = 0; a < 2; ++a)
#pragma unroll
            for (int b = 0; b < 2; ++b)
#pragma unroll
                for (int m = 0; m < 4; ++m)
#pragma unroll
                    for (int n = 0; n < 2; ++n) acc[a][b][m][n] = (f32x4){0.f, 0.f, 0.f, 0.f};
        cur = nxt; cA = nA; cB = nB; ++ui;
#pragma unroll
        for (int _i = 0; _i < 2; ++_i) { va0[_i] = vn0[_i]; va1[_i] = vn1[_i]; }
        if constexpr (ALIGN_EPI) { if (wr == 1) PG8_BAR; }
    }
    PG8_WAIT_V(0);
    if constexpr (!ALIGN_EPI) { if (wr == 0) PG8_BAR; }
    PG8_BAR;
#undef PG8_SA
#undef PG8_SB
#undef PG8_STAGE
#undef PG8_GIDX
#undef PG8_LDA
#undef PG8_LDB
#undef PG8_MMA
#undef PG8_LD8
#undef PG8_WAIT_V
#undef PG8_WAIT_L
#undef PG8_BAR
#undef PG8_SCHED
}

typedef f32x4 Acc[2][2][4][2];

__device__ __forceinline__ u32x4 pair16(u32x2 x, u32x2 y) {
    const auto r0 = __builtin_amdgcn_permlane16_swap(x.x, y.x, false, false);
    const auto r1 = __builtin_amdgcn_permlane16_swap(x.y, y.y, false, false);
    return (u32x4){r0[0], r1[0], r0[1], r1[1]};
}
struct Epi1 {
    static constexpr bool PERM = true; static constexpr int MID_T = 0;
    bf16_t *yab, *gv; unsigned char *q, *k, *v; bf16_t *sa, *sb; float* gvst; float* kmp; float sc, pad_;
    template <int MODE  >
    __device__ __forceinline__ void run(const Acc& acc, const Unit& u, int wr, int wc, int fr, int fq, bf16_t* base, int ld) const {
        const int row0 = u.pm * BM + wr * 64 + fr, col0 = (u.pn & 3) * 256 + wc * 32 + 8 * fq;
        const int colp = (u.pn & 3) * 256 + wc * 32 + 8 * (fq & ~1);
        f32x4 csA0 = {0.f, 0.f, 0.f, 0.f}, csB0 = csA0, csA1 = csA0, csB1 = csA0;
#pragma unroll
        for (int ai = 0; ai < 2; ++ai)
#pragma unroll
            for (int mp = 0; mp < 2; ++mp) {
                u32x2 pc[2][2];
#pragma unroll
                for (int k = 0; k < 2; ++k) {
                    const int m = 2 * mp + k;
                    const int row = row0 + ai * HALF + m * 16; bf16_t* rowp = base + (size_t)row * ld + col0;
                    float s1 = 0.f, s2 = 0.f;
#pragma unroll
                    for (int bj = 0; bj < 2; ++bj) {
                        f32x4 v0 = acc[ai][bj][m][0], v1 = acc[ai][bj][m][1];
                        if (MODE == 2 || MODE == 3 || MODE == 5) {
                            const float f = (MODE == 2) ? sc * QSCALE : sc; v0 = v0 * f; v1 = v1 * f;
                            if (MODE == 5) { if (bj == 0) { csA0 = csA0 + v0; csB0 = csB0 + v1; } else { csA1 = csA1 + v0; csB1 = csB1 + v1; } }
                            pc[bj][k] = (u32x2){pack_fp8x4(v0[0], v0[1], v0[2], v0[3]), pack_fp8x4(v1[0], v1[1], v1[2], v1[3])};
                            continue;
                        }
                        if (MODE == 0 || MODE == 1) {
                            v0 = v0 * sc; v1 = v1 * sc;
                            f32x2 a = gelu_pk((f32x2){v0[0], v0[1]}), b = gelu_pk((f32x2){v0[2], v0[3]}), c = gelu_pk((f32x2){v1[0], v1[1]}), d = gelu_pk((f32x2){v1[2], v1[3]});
                            v0 = (f32x4){a.x, a.y, b.x, b.y}; v1 = (f32x4){c.x, c.y, d.x, d.y};
                        } else if (MODE == 4) {
                            { const float cs_ = -1.4426950408889634f * sc; const f32x4 t0 = v0 * cs_, t1 = v1 * cs_; f32x4 e0, e1;
#pragma unroll
                              for (int j = 0; j < 4; ++j) { e0[j] = __builtin_amdgcn_exp2f(t0[j]); e1[j] = __builtin_amdgcn_exp2f(t1[j]); }
                              e0 = e0 + 1.0f; e1 = e1 + 1.0f;
#pragma unroll
                              for (int j = 0; j < 4; ++j) { v0[j] = __builtin_amdgcn_rcpf(e0[j]); v1[j] = __builtin_amdgcn_rcpf(e1[j]); } }
                            pc[bj][k] = (u32x2){pack_fp8x4(v0[0], v0[1], v0[2], v0[3]), pack_fp8x4(v1[0], v1[1], v1[2], v1[3])};
                            continue;
                        }
                        if (MODE == 1) {
                            s1 += (v0[0] + v0[1]) + (v0[2] + v0[3]) + (v1[0] + v1[1]) + (v1[2] + v1[3]);
                            s2 += (v0[0] * v0[0] + v0[1] * v0[1]) + (v0[2] * v0[2] + v0[3] * v0[3]) + (v1[0] * v1[0] + v1[1] * v1[1]) + (v1[2] * v1[2] + v1[3] * v1[3]);
                            pc[bj][k] = (u32x2){pack_fp8x4(v0[0], v0[1], v0[2], v0[3]), pack_fp8x4(v1[0], v1[1], v1[2], v1[3])};
                            continue;
                        }
                        u32x4 w; w.x = cvt_pk_bf16(v0[0], v0[1]); w.y = cvt_pk_bf16(v0[2], v0[3]); w.z = cvt_pk_bf16(v1[0], v1[1]); w.w = cvt_pk_bf16(v1[2], v1[3]);
                        *(u32x4*)(rowp + bj * HALF) = w;
                    }
                    if (MODE == 1) {
                        s1 += __shfl_xor(s1, 16); s1 += __shfl_xor(s1, 32); s2 += __shfl_xor(s2, 16); s2 += __shfl_xor(s2, 32);
                        if (fq == 0) *(f32x2*)(gvst + ((size_t)row * 16 + (u.pn & 3) * 4 + wc) * 2) = (f32x2){s1, s2};
                    }
                }
                if (MODE != 0) {
                    const int rowst = row0 + ai * HALF + (2 * mp + (fq & 1)) * 16;
#pragma unroll
                    for (int bj = 0; bj < 2; ++bj) *(u32x4*)((unsigned char*)base + (size_t)rowst * 1024 + colp + bj * HALF) = pair16(pc[bj][0], pc[bj][1]);
                }
            }
        if (MODE == 5) {
#define KM_RED(v) do { _Pragma("unroll") for (int j_ = 0; j_ < 4; ++j_) { float x = v[j_]; x += __shfl_xor(x, 1); x += __shfl_xor(x, 2); x += __shfl_xor(x, 4); x += __shfl_xor(x, 8); v[j_] = x; } } while (0)
            KM_RED(csA0); KM_RED(csB0); KM_RED(csA1); KM_RED(csB1);
#undef KM_RED
            if (fr == 0) {
                float* kp = kmp + ((size_t)(u.pm * 2 + wr) * DM) + col0;
                *(f32x4*)kp = csA0; *(f32x4*)(kp + 4) = csB0; *(f32x4*)(kp + HALF) = csA1; *(f32x4*)(kp + HALF + 4) = csB1;
            }
        }
    }
    __device__ __forceinline__ void operator()(const Acc& acc, const Unit& u, int wr, int wc, int fr, int fq) const {
        const int region = u.pn >> 2;
        if (region == 0) run<0>(acc, u, wr, wc, fr, fq, yab, 2048);
        else if (region == 1) run<1>(acc, u, wr, wc, fr, fq, gv, 1024);
        else if (region == 2) run<2>(acc, u, wr, wc, fr, fq, (bf16_t*)q, 1024);
        else if (region == 3) run<5>(acc, u, wr, wc, fr, fq, (bf16_t*)k, 1024);
        else if (region == 4) run<3>(acc, u, wr, wc, fr, fq, (bf16_t*)v, 1024);
        else if (region == 5) run<4>(acc, u, wr, wc, fr, fq, sa, 1024);
        else run<4>(acc, u, wr, wc, fr, fq, sb, 1024);
    }
    __device__ __forceinline__ void mid(Acc&, const Unit&, int, int, int, int) const {}
};

struct Epi2 {
    static constexpr bool PERM = true; static constexpr int MID_T = 8;
    const unsigned char *sa, *sb; bf16_t* mg;
    __device__ __forceinline__ void mid(Acc& acc, const Unit& u, int wr, int wc, int fr, int fq) const {
        int row0 = u.pm * BM + wr * 64 + fr, col0 = u.pn * BM + wc * 32 + 8 * fq;
        asm volatile("" : "+v"(row0), "+v"(col0));
#pragma unroll
        for (int ai = 0; ai < 2; ++ai) {
            u32x2 av[4][2], bv[4][2];
#pragma unroll
            for (int m = 0; m < 4; ++m)
#pragma unroll
                for (int bj = 0; bj < 2; ++bj) { const size_t off = (size_t)(row0 + ai * HALF + m * 16) * DM + col0 + bj * HALF; av[m][bj] = *(const u32x2*)(sa + off); bv[m][bj] = *(const u32x2*)(sb + off); }
            asm volatile("" ::: "memory");
#pragma unroll
            for (int m = 0; m < 4; ++m) {
#pragma unroll
                for (int bj = 0; bj < 2; ++bj) {
                    const u32x2 a = av[m][bj], b = bv[m][bj];
                    const f32x2v a0 = __builtin_amdgcn_cvt_pk_f32_fp8((int)a.x, false), a1 = __builtin_amdgcn_cvt_pk_f32_fp8((int)a.x, true), a2 = __builtin_amdgcn_cvt_pk_f32_fp8((int)a.y, false), a3 = __builtin_amdgcn_cvt_pk_f32_fp8((int)a.y, true);
                    const f32x2v b0 = __builtin_amdgcn_cvt_pk_f32_fp8((int)b.x, false), b1 = __builtin_amdgcn_cvt_pk_f32_fp8((int)b.x, true), b2 = __builtin_amdgcn_cvt_pk_f32_fp8((int)b.y, false), b3 = __builtin_amdgcn_cvt_pk_f32_fp8((int)b.y, true);
                    f32x4 r0, r1;
#define RQ(x, y) ((x) * __builtin_amdgcn_rcpf(y))
                    r0[0] = RQ(a0.x, b0.x); r0[1] = RQ(a0.y, b0.y); r0[2] = RQ(a1.x, b1.x); r0[3] = RQ(a1.y, b1.y);
                    r1[0] = RQ(a2.x, b2.x); r1[1] = RQ(a2.y, b2.y); r1[2] = RQ(a3.x, b3.x); r1[3] = RQ(a3.y, b3.y);
#undef RQ
                    acc[ai][bj][m][0] = acc[ai][bj][m][0] * r0; acc[ai][bj][m][1] = acc[ai][bj][m][1] * r1;
                }
                asm volatile("" : "+v"(acc[ai][0][m][0]), "+v"(acc[ai][0][m][1]), "+v"(acc[ai][1][m][0]), "+v"(acc[ai][1][m][1]));
            }
            asm volatile("" ::: "memory");
        }
    }
    __device__ __forceinline__ void operator()(const Acc& acc, const Unit& u, int wr, int wc, int fr, int fq) const {
        const int row0 = u.pm * BM + wr * 64 + fr, col0 = u.pn * BM + wc * 32 + 8 * fq;
#pragma unroll
        for (int ai = 0; ai < 2; ++ai) {
            u32x2 bv[4][2];
#pragma unroll
            for (int m = 0; m < 4; ++m)
#pragma unroll
                for (int bj = 0; bj < 2; ++bj) bv[m][bj] = *(const u32x2*)(sb + (size_t)(row0 + ai * HALF + m * 16) * DM + col0 + bj * HALF);
            asm volatile("" ::: "memory");
#pragma unroll
            for (int m = 0; m < 4; ++m) {
                const size_t off = (size_t)(row0 + ai * HALF + m * 16) * DM + col0;
#pragma unroll
                for (int bj = 0; bj < 2; ++bj) {
                    const u32x2 b = bv[m][bj];
                    const f32x2v b0 = __builtin_amdgcn_cvt_pk_f32_fp8((int)b.x, false), b1 = __builtin_amdgcn_cvt_pk_f32_fp8((int)b.x, true), b2 = __builtin_amdgcn_cvt_pk_f32_fp8((int)b.y, false), b3 = __builtin_amdgcn_cvt_pk_f32_fp8((int)b.y, true);
                    const f32x4 v0 = acc[ai][bj][m][0] * 0.03125f, v1 = acc[ai][bj][m][1] * 0.03125f;
                    u32x4 w; w.x = cvt_pk_bf16(v0[0] * b0.x, v0[1] * b0.y); w.y = cvt_pk_bf16(v0[2] * b1.x, v0[3] * b1.y);
                    w.z = cvt_pk_bf16(v1[0] * b2.x, v1[1] * b2.y); w.w = cvt_pk_bf16(v1[2] * b3.x, v1[3] * b3.y);
                    *(u32x4*)(mg + off + bj * HALF) = w;
                }
            }
        }
    }
};

struct Epi3 {
    static constexpr bool PERM = true; static constexpr int MID_T = 0;
    const bf16_t* h0; bf16_t* z; float* zst;
    __device__ __forceinline__ void mid(Acc&, const Unit&, int, int, int, int) const {}
    __device__ __forceinline__ void operator()(const Acc& acc, const Unit& u, int wr, int wc, int fr, int fq) const {
        const int row0 = u.pm * BM + wr * 64 + fr, col0 = u.pn * BM + wc * 32 + 8 * fq;
#pragma unroll
        for (int ai = 0; ai < 2; ++ai) {
            u32x4 hbv[4][2];
#pragma unroll
            for (int m = 0; m < 4; ++m)
#pragma unroll
                for (int bj = 0; bj < 2; ++bj) hbv[m][bj] = *(const u32x4*)(h0 + (size_t)(row0 + ai * HALF + m * 16) * DM + col0 + bj * HALF);
            asm volatile("" ::: "memory");
#pragma unroll
            for (int m = 0; m < 4; ++m) {
                const int row = row0 + ai * HALF + m * 16; const size_t off = (size_t)row * DM + col0;
                float s1 = 0.f, s2 = 0.f;
#pragma unroll
                for (int bj = 0; bj < 2; ++bj) {
                    const u32x4 hb = hbv[m][bj];
                    f32x4 v0 = acc[ai][bj][m][0], v1 = acc[ai][bj][m][1];
                    v0[0] += ALPHA * bflo(hb.x); v0[1] += ALPHA * bfhi(hb.x); v0[2] += ALPHA * bflo(hb.y); v0[3] += ALPHA * bfhi(hb.y);
                    v1[0] += ALPHA * bflo(hb.z); v1[1] += ALPHA * bfhi(hb.z); v1[2] += ALPHA * bflo(hb.w); v1[3] += ALPHA * bfhi(hb.w);
                    s1 += ((v0[0] + v0[1]) + (v0[2] + v0[3])) + ((v1[0] + v1[1]) + (v1[2] + v1[3]));
                    s2 += ((v0[0] * v0[0] + v0[1] * v0[1]) + (v0[2] * v0[2] + v0[3] * v0[3])) + ((v1[0] * v1[0] + v1[1] * v1[1]) + (v1[2] * v1[2] + v1[3] * v1[3]));
                    *(u32x4*)(z + off + bj * HALF) = (u32x4){cvt_pk_bf16(v0[0], v0[1]), cvt_pk_bf16(v0[2], v0[3]), cvt_pk_bf16(v1[0], v1[1]), cvt_pk_bf16(v1[2], v1[3])};
                }
                s1 += __shfl_xor(s1, 16); s1 += __shfl_xor(s1, 32); s2 += __shfl_xor(s2, 16); s2 += __shfl_xor(s2, 32);
                if (fq == 0) *(f32x2*)(zst + ((size_t)row * 16 + u.pn * 4 + wc) * 2) = (f32x2){s1, s2};
            }
        }
    }
};

struct Epi4 {
    static constexpr bool PERM = true; static constexpr int MID_T = 0;
    const float* b_up; unsigned char* act;
    __device__ __forceinline__ void mid(Acc&, const Unit&, int, int, int, int) const {}
    __device__ __forceinline__ void operator()(const Acc& acc, const Unit& u, int wr, int wc, int fr, int fq) const {
        const int e = u.bt >> 3;
        const int row0 = u.pm * BM + wr * 64 + fr, c0 = u.pn * HALF + wc * 32 + 8 * fq;
        const float* bg = b_up + (size_t)e * 2 * FF + c0; const float* bu = bg + FF;
        const f32x4 bg0 = *(const f32x4*)bg, bg1 = *(const f32x4*)(bg + 4), bu0 = *(const f32x4*)bu, bu1 = *(const f32x4*)(bu + 4);
        const int cp = u.pn * HALF + wc * 32 + 8 * (fq & ~1);
#pragma unroll
        for (int ai = 0; ai < 2; ++ai)
#pragma unroll
            for (int mp = 0; mp < 2; ++mp) {
                u32x2 pc[2];
#pragma unroll
                for (int k = 0; k < 2; ++k) {
                    const int m = 2 * mp + k;
                    float o[8];
#pragma unroll
                    for (int n = 0; n < 2; ++n)
#pragma unroll
                        for (int jp = 0; jp < 2; ++jp) {
                            const int j = 2 * jp;
                            const f32x2 ag = {acc[ai][0][m][n][j], acc[ai][0][m][n][j + 1]}, au = {acc[ai][1][m][n][j], acc[ai][1][m][n][j + 1]};
                            const f32x2 vbg = n ? (f32x2){bg1[j], bg1[j + 1]} : (f32x2){bg0[j], bg0[j + 1]}, vbu = n ? (f32x2){bu1[j], bu1[j + 1]} : (f32x2){bu0[j], bu0[j + 1]};
                            f32x2 gg = ag * 0.03125f + vbg, uu = au * 0.03125f + vbu;
                            gg.x = fminf(gg.x, 7.0f); gg.y = fminf(gg.y, 7.0f);
                            uu.x = __builtin_amdgcn_fmed3f(uu.x, -7.0f, 7.0f); uu.y = __builtin_amdgcn_fmed3f(uu.y, -7.0f, 7.0f);
                            const f32x2 t = gg * (-1.702f * 1.4426950408889634f);
                            f32x2 ex; ex.x = __builtin_amdgcn_exp2f(t.x); ex.y = __builtin_amdgcn_exp2f(t.y);
                            const f32x2 d = ex + 1.0f;
                            f32x2 rc; rc.x = __builtin_amdgcn_rcpf(d.x); rc.y = __builtin_amdgcn_rcpf(d.y);
                            const f32x2 res = (uu + 1.0f) * (gg * rc);
                            o[n * 4 + j] = res.x; o[n * 4 + j + 1] = res.y;
                        }
                    unsigned w0 = 0u, w1 = 0u;
                    w0 = __builtin_amdgcn_cvt_pk_fp8_f32(o[0], o[1], w0, false); w0 = __builtin_amdgcn_cvt_pk_fp8_f32(o[2], o[3], w0, true);
                    w1 = __builtin_amdgcn_cvt_pk_fp8_f32(o[4], o[5], w1, false); w1 = __builtin_amdgcn_cvt_pk_fp8_f32(o[6], o[7], w1, true);
                    pc[k] = (u32x2){w0, w1};
                }
                const int rowst = row0 + ai * HALF + (2 * mp + (fq & 1)) * 16;
                *(u32x4*)(act + (size_t)rowst * FF + cp) = pair16(pc[0], pc[1]);
            }
    }
};

struct Epi5 {
    static constexpr bool PERM = true; static constexpr int MID_T = 0;
    const float* b_down; const float* roww; unsigned char* ys;
    __device__ __forceinline__ void mid(Acc&, const Unit&, int, int, int, int) const {}
    __device__ __forceinline__ void operator()(const Acc& acc, const Unit& u, int wr, int wc, int fr, int fq) const {
        const int e = u.bt >> 2;
        const int row0 = u.pm * BM + wr * 64 + fr, col0 = u.pn * BM + wc * 32 + 8 * fq;
        f32x4 bv[2][2];
#pragma unroll
        for (int bj = 0; bj < 2; ++bj)
#pragma unroll
            for (int n = 0; n < 2; ++n) bv[bj][n] = *(const f32x4*)(b_down + (size_t)e * DM + col0 + bj * HALF + 4 * n);
        float rwv[2][4];
#pragma unroll
        for (int ai = 0; ai < 2; ++ai)
#pragma unroll
            for (int m = 0; m < 4; ++m) rwv[ai][m] = roww[u.rbase + wr * 64 + fr + ai * HALF + m * 16];
        asm volatile("" ::: "memory");
        const int colp = u.pn * BM + wc * 32 + 8 * (fq & ~1);
#pragma unroll
        for (int ai = 0; ai < 2; ++ai)
#pragma unroll
            for (int mp = 0; mp < 2; ++mp) {
                const int rowst = row0 + ai * HALF + (2 * mp + (fq & 1)) * 16;
#pragma unroll
                for (int bj = 0; bj < 2; ++bj) {
                    u32x2 pc[2];
#pragma unroll
                    for (int k = 0; k < 2; ++k) { const int m = 2 * mp + k; const float rw16 = rwv[ai][m] * 16.0f;
                        const f32x4 v0 = (acc[ai][bj][m][0] * 0.015625f + bv[bj][0]) * rw16, v1 = (acc[ai][bj][m][1] * 0.015625f + bv[bj][1]) * rw16;
                        pc[k] = (u32x2){pack_fp8x4(v0[0], v0[1], v0[2], v0[3]), pack_fp8x4(v1[0], v1[1], v1[2], v1[3])}; }
                    *(u32x4*)(ys + (size_t)rowst * DM + colp + bj * HALF) = pair16(pc[0], pc[1]);
                }
            }
    }
};
}

struct Args { const float* in[21]; float* out; unsigned char* ws; int ph_lo, ph_hi; };
enum { I_X = 0, I_LNIN_G, I_LNIN_B, I_WIN, I_GLN_G, I_GLN_B, I_WSP, I_BSP, I_WBA, I_WBB, I_WOUT, I_LNMIX_G, I_LNMIX_B, I_WR, I_BR, I_WUP, I_BUP, I_WDN, I_BDN, I_LNF_G, I_LNF_B };

struct Ctx { const Args* a; unsigned char* ws; LAS unsigned char* lds; unsigned char* ldsg; int tid, lane, wave, G, vcu; };

__device__ __forceinline__ void tr_item(const float* W, int N, int k0, int n0, bf16_t* dst, int drow0, int dld, int dcol0, LAS float* scr, int lane) {
#pragma unroll 8
    for (int i = 0; i < 32; ++i) { const int kk = 2 * i + (lane >> 5); scr[kk * 33 + (lane & 31)] = __builtin_nontemporal_load(W + (size_t)(k0 + kk) * N + n0 + (lane & 31)); }
    asm volatile("s_waitcnt lgkmcnt(0)" ::: "memory");
    const int c = lane & 7;
#pragma unroll
    for (int j = 0; j < 4; ++j) { const int n = (lane >> 3) + 8 * j; const LAS float* s = scr + (8 * c) * 33 + n;
        u32x4 o; o.x = pk2(s[0 * 33], s[1 * 33]); o.y = pk2(s[2 * 33], s[3 * 33]); o.z = pk2(s[4 * 33], s[5 * 33]); o.w = pk2(s[6 * 33], s[7 * 33]);
        *(u32x4*)(dst + (size_t)(drow0 + n) * dld + dcol0 + k0 + 8 * c) = o; }
    asm volatile("s_waitcnt lgkmcnt(0)" ::: "memory");
}
template <bool DEEP = false>
__device__ __forceinline__ void tr_item8(const float* W, int N, int k0, int n0, unsigned char* dst, int drow0, int dld, float sc, LAS float* scr, int lane) {
    if constexpr (DEEP) {
        float v[32];
#pragma unroll
        for (int i = 0; i < 32; ++i) v[i] = __builtin_nontemporal_load(W + (size_t)(k0 + 2 * i + (lane >> 5)) * N + n0 + (lane & 31));
#pragma unroll
        for (int i = 0; i < 32; ++i) scr[(2 * i + (lane >> 5)) * 33 + (lane & 31)] = v[i];
    } else {
#pragma unroll 8
        for (int i = 0; i < 32; ++i) { const int kk = 2 * i + (lane >> 5); scr[kk * 33 + (lane & 31)] = __builtin_nontemporal_load(W + (size_t)(k0 + kk) * N + n0 + (lane & 31)); }
    }
    asm volatile("s_waitcnt lgkmcnt(0)" ::: "memory");
    const int c = lane & 7;
#pragma unroll
    for (int j = 0; j < 4; ++j) { const int n = (lane >> 3) + 8 * j; const LAS float* s = scr + (8 * c) * 33 + n;
        unsigned w0 = 0u, w1 = 0u;
        w0 = __builtin_amdgcn_cvt_pk_fp8_f32(s[0 * 33] * sc, s[1 * 33] * sc, w0, false); w0 = __builtin_amdgcn_cvt_pk_fp8_f32(s[2 * 33] * sc, s[3 * 33] * sc, w0, true);
        w1 = __builtin_amdgcn_cvt_pk_fp8_f32(s[4 * 33] * sc, s[5 * 33] * sc, w1, false); w1 = __builtin_amdgcn_cvt_pk_fp8_f32(s[6 * 33] * sc, s[7 * 33] * sc, w1, true);
        *(u32x2*)(dst + (size_t)(drow0 + n) * dld + k0 + 8 * c) = (u32x2){w0, w1}; }
    asm volatile("s_waitcnt lgkmcnt(0)" ::: "memory");
}
__device__ __forceinline__ void ph_prologue(const Ctx& F) {
    const Args& A = *F.a;
    LAS float* scr = (LAS float*)(F.lds + F.wave * 16384);
    const int gw = F.vcu * 8 + F.wave, NGW = F.G * 8;
    bf16_t* WIN = (bf16_t*)(F.ws + WS_WIN); bf16_t* WOUT = (bf16_t*)(F.ws + WS_WOUT);
    constexpr int I_IN = 16 * (INCOLS / 32), I_SQ = 16 * 32;
    constexpr int NITEMS = I_IN + 3 * I_SQ;
    for (int it = gw; it < NITEMS; it += NGW) {
        int r = it;
        if (r < I_IN) { const int nblk = INCOLS / 32, kb = r / nblk, nb = r % nblk;
            if (32 * nb >= PN8_LO * 256 && 32 * nb < PN8_HI * 256) tr_item8(A.in[I_WIN], INCOLS, 64 * kb, 32 * nb, F.ws + WS_WIN8, 32 * nb, DM, 32.0f, scr, F.lane);
            else tr_item(A.in[I_WIN], INCOLS, 64 * kb, 32 * nb, WIN, 32 * nb, DM, 0, scr, F.lane);
            continue; } r -= I_IN;
        if (r < I_SQ) { const int kb = r / 32, nb = r % 32; tr_item8(A.in[I_WBA], DM, 64 * kb, 32 * nb, F.ws + WS_WAB, 32 * nb, 2048, 32.0f, scr, F.lane); continue; } r -= I_SQ;
        if (r < I_SQ) { const int kb = r / 32, nb = r % 32; tr_item8(A.in[I_WBB], DM, 64 * kb, 32 * nb, F.ws + WS_WAB + 1024, 32 * nb, 2048, 32.0f, scr, F.lane); continue; } r -= I_SQ;
        { const int kb = r / 32, nb = r % 32; tr_item(A.in[I_WOUT], DM, 64 * kb, 32 * nb, WOUT, 32 * nb, DM, 0, scr, F.lane); }
    }
    const float* lg = A.in[I_LNIN_G]; const float* lb = A.in[I_LNIN_B]; bf16_t* H0 = (bf16_t*)(F.ws + WS_H0);
    f32x4 gg[4], bb[4];
#pragma unroll
    for (int j = 0; j < 4; ++j) { gg[j] = *((const f32x4*)lg + F.lane + 64 * j); bb[j] = *((const f32x4*)lb + F.lane + 64 * j); }
    for (int m = gw; m < T; m += NGW) {
        const f32x4* xr = (const f32x4*)(A.in[I_X] + (size_t)m * DM) + F.lane;
        f32x4 v[4]; float s = 0.f;
#pragma unroll
        for (int j = 0; j < 4; ++j) { v[j] = __builtin_nontemporal_load(xr + 64 * j); s += (v[j].x + v[j].y) + (v[j].z + v[j].w); }
        const float mean = wave_sum(s) * (1.f / DM); float s2 = 0.f;
#pragma unroll
        for (int j = 0; j < 4; ++j) { v[j] = v[j] - mean; s2 += (v[j].x * v[j].x + v[j].y * v[j].y) + (v[j].z * v[j].z + v[j].w * v[j].w); }
        const float rstd = 1.f / sqrtf(wave_sum(s2) * (1.f / DM) + LN_EPS);
        u32x2* o8 = (u32x2*)(H0 + (size_t)m * DM) + F.lane; unsigned* o4 = (unsigned*)(F.ws + WS_H0F8 + (size_t)m * DM) + F.lane;
#pragma unroll
        for (int j = 0; j < 4; ++j) { const f32x4 y = v[j] * rstd * gg[j] + bb[j]; o8[64 * j] = (u32x2){pk2(y.x, y.y), pk2(y.z, y.w)}; o4[64 * j] = pack_fp8x4(y.x, y.y, y.z, y.w); }
    }
}

struct WItem { const float* src; unsigned char* dst; int N, dld; float sc; };
__device__ __forceinline__ void w_load(const WItem& w, float (&v)[64], int lane) {
    const float* src = w.src + (size_t)(lane >> 5) * w.N + (lane & 31);
#pragma unroll
    for (int i = 0; i < 64; ++i) v[i] = __builtin_nontemporal_load(src + (size_t)(2 * i) * w.N);
}
__device__ __forceinline__ void w_scatter(const float (&v)[64], LAS float* scr, int lane) {
    LAS float* d = scr + (lane & 31) * 130 + (lane >> 5);
#pragma unroll
    for (int i = 0; i < 64; ++i) d[2 * i] = v[i];
}
__device__ __forceinline__ void w_emit(const WItem& w, LAS const float* scr, int lane) {
    asm volatile("s_waitcnt lgkmcnt(0)" ::: "memory");
    const int c = lane & 7; const float sc = w.sc;
#pragma unroll
    for (int j = 0; j < 4; ++j) {
        const int nn = (lane >> 3) + 8 * j; const LAS float* sp = scr + nn * 130 + 16 * c;
        f32x2 a[8];
#pragma unroll
        for (int q = 0; q < 8; ++q) a[q] = *(LAS const f32x2*)(sp + 2 * q);
        u32x4 o;
        o.x = pack_fp8x4(a[0].x * sc, a[0].y * sc, a[1].x * sc, a[1].y * sc); o.y = pack_fp8x4(a[2].x * sc, a[2].y * sc, a[3].x * sc, a[3].y * sc);
        o.z = pack_fp8x4(a[4].x * sc, a[4].y * sc, a[5].x * sc, a[5].y * sc); o.w = pack_fp8x4(a[6].x * sc, a[6].y * sc, a[7].x * sc, a[7].y * sc);
        *(u32x4*)(w.dst + (size_t)nn * w.dld + 16 * c) = o;
    }
    asm volatile("s_waitcnt lgkmcnt(0)" ::: "memory");
}
__device__ __forceinline__ WItem w_decode(const Ctx& F, int r) {
    const Args& A = *F.a;
    constexpr int I_UP = NE * 8 * 64;
    WItem w;
    if (r < I_UP) { const int e = r / (8 * 64), rr = r % (8 * 64), kb = rr / 64, nb = rr % 64; const int n0 = 32 * nb, half = n0 >= FF, rem = n0 - half * FF, pn = rem >> 7, b = (rem & 127) >> 5;
        w.src = A.in[I_WUP] + (size_t)e * DM * 2 * FF + (size_t)(128 * kb) * (2 * FF) + n0; w.N = 2 * FF; w.dst = F.ws + WS_WUP + (size_t)(e * 2048 + 256 * pn + half * 128 + 32 * b) * DM + 128 * kb; w.dld = DM; w.sc = 32.0f; }
    else { r -= I_UP; const int e = r / (8 * 32), rr = r % (8 * 32), kb = rr / 32, nb = rr % 32;
        w.src = A.in[I_WDN] + (size_t)e * FF * DM + (size_t)(128 * kb) * DM + 32 * nb; w.N = DM; w.dst = F.ws + WS_WDN + (size_t)(e * 1024 + 32 * nb) * FF + 128 * kb; w.dld = FF; w.sc = 64.0f; }
    return w;
}
__device__ __forceinline__ void ph_wconv(const Ctx& F) {
    LAS float* scr = (LAS float*)(F.lds + F.wave * 16640);
    constexpr int NIT = NE * 8 * 64 + NE * 8 * 32;
    const int chunk = (NIT + F.G - 1) / F.G, lo = (int)blockIdx.x * chunk, hi = (lo + chunk < NIT) ? lo + chunk : NIT;
    __syncthreads();
    int it = lo + F.wave;
    if (it < hi) {
        float v[64];
        WItem cur = w_decode(F, it);
        w_load(cur, v, F.lane);
        for (;;) {
            w_scatter(v, scr, F.lane);
            const int itn = it + 8; const bool more = itn < hi;
            WItem nxt = cur;
            if (more) { nxt = w_decode(F, itn); w_load(nxt, v, F.lane); }
            w_emit(cur, scr, F.lane);
            if (!more) break;
            cur = nxt; it = itn;
        }
    }
    asm volatile("s_waitcnt vmcnt(0)" ::: "memory");
    __syncthreads();
}

typedef short v4i16_t __attribute__((ext_vector_type(4)));
__device__ __forceinline__ v4i16_t lds_tr16(LAS const unsigned char* p) { return __builtin_amdgcn_ds_read_tr16_b64_v4i16((LAS v4i16_t*)p); }
__device__ __forceinline__ void ph_mixer_a(const Ctx& F) {
    const Args& A = *F.a;
    const unsigned char* GV = F.ws + WS_GV; bf16_t* YAB = (bf16_t*)(F.ws + WS_YAB); const float* GVST = (const float*)(F.ws + WS_GVST);
    const float* lg = A.in[I_GLN_G]; const float* lb = A.in[I_GLN_B]; const float* wsp = A.in[I_WSP]; const float* bsp = A.in[I_BSP];
    constexpr int RSV = 544, RSW = 272, OFF_W = 128 * RSV, OFF_ST = OFF_W + 128 * RSW;
    LAS unsigned char* VT = F.lds; LAS unsigned char* WT = F.lds + OFF_W; LAS float* ST = (LAS float*)(F.lds + OFF_ST);
    const int lane = F.lane, wv = F.wave;
    int curg = -1;
    for (int it = F.vcu; it < NB * 32 * 4; it += F.G) {
        const int b = it / 128, c = (it >> 2) & 31, g = it & 3;
        const int tok0 = b * SEQ + c * 128;
        if (g != curg) {
            curg = g;
            for (int k = 0; k < 4; ++k) {
                const int idx = F.tid + 512 * k, t = idx >> 4, s8 = (idx & 15) * 8;
                const f32x4 w0 = *(const f32x4*)(wsp + ((size_t)g * 128 + t) * 128 + s8), w1 = *(const f32x4*)(wsp + ((size_t)g * 128 + t) * 128 + s8 + 4);
                float x[8] = {w0.x, w0.y, w0.z, w0.w, w1.x, w1.y, w1.z, w1.w};
#pragma unroll
                for (int j = 0; j < 8; ++j) x[j] = (s8 + j <= t) ? x[j] : 0.f;
                u32x4 o; o.x = pk2(x[0], x[1]); o.y = pk2(x[2], x[3]); o.z = pk2(x[4], x[5]); o.w = pk2(x[6], x[7]);
                *(LAS u32x4*)(WT + t * RSW + s8 * 2) = o;
            }
        }
        if (F.tid < 128) {
            const float* p = GVST + (size_t)(tok0 + F.tid) * 32; float s1 = 0.f, s2 = 0.f;
            for (int i = 0; i < 16; ++i) { s1 += p[2 * i]; s2 += p[2 * i + 1]; }
            const float mean = s1 * (1.f / DM), var = s2 * (1.f / DM) - mean * mean;
            ST[2 * F.tid] = mean; ST[2 * F.tid + 1] = 1.f / sqrtf(fmaxf(var, 0.f) + LN_EPS);
        }
        __syncthreads();
        {
            const int dc = F.tid & 31;
            const f32x4 g0 = *(const f32x4*)(lg + g * 256 + dc * 8), g1 = *(const f32x4*)(lg + g * 256 + dc * 8 + 4), b0 = *(const f32x4*)(lb + g * 256 + dc * 8), b1 = *(const f32x4*)(lb + g * 256 + dc * 8 + 4);
            u32x2 rawv[8];
#pragma unroll
            for (int k = 0; k < 8; ++k) rawv[k] = *(const u32x2*)(GV + (size_t)(tok0 + (F.tid >> 5) + 16 * k) * DM + g * 256 + dc * 8);
#pragma unroll
            for (int k = 0; k < 8; ++k) {
                const int s = (F.tid >> 5) + 16 * k;
                const u32x2 raw = rawv[k];
                const float mean = ST[2 * s], rstd = ST[2 * s + 1];
                const f32x2v f0 = __builtin_amdgcn_cvt_pk_f32_fp8((int)raw.x, false), f1 = __builtin_amdgcn_cvt_pk_f32_fp8((int)raw.x, true), f2 = __builtin_amdgcn_cvt_pk_f32_fp8((int)raw.y, false), f3 = __builtin_amdgcn_cvt_pk_f32_fp8((int)raw.y, true);
                f32x4 x0 = {f0.x, f0.y, f1.x, f1.y}, x1 = {f2.x, f2.y, f3.x, f3.y};
                x0 = (x0 - mean) * rstd * g0 + b0; x1 = (x1 - mean) * rstd * g1 + b1;
                u32x4 o; o.x = pk2(x0.x, x0.y); o.y = pk2(x0.z, x0.w); o.z = pk2(x1.x, x1.y); o.w = pk2(x1.z, x1.w);
                *(LAS u32x4*)(VT + s * RSV + dc * 16) = o;
            }
        }
        __syncthreads();
        {
            const int dbase = 32 * wv, kg = lane >> 4, q = (lane & 15) >> 2, p = lane & 3, fr = lane & 15;
            u32x2 uu[8][2]; float bsn[8];
#pragma unroll
            for (int n = 0; n < 8; ++n) { const bf16_t* yp = YAB + (size_t)(tok0 + 16 * n + fr) * 2048 + g * 256 + dbase + 4 * kg; uu[n][0] = *(const u32x2*)yp; uu[n][1] = *(const u32x2*)(yp + 16); bsn[n] = bsp[g * 128 + 16 * n + fr]; }
            bf16x8 Af[2][4];
#pragma unroll
            for (int m = 0; m < 2; ++m)
#pragma unroll
                for (int kk = 0; kk < 4; ++kk) {
                    LAS const unsigned char* ap = VT + (32 * kk + 8 * kg + q) * RSV + (dbase + 16 * m + 4 * p) * 2;
                    const v4i16_t lo = lds_tr16(ap), hi = lds_tr16(ap + 4 * RSV);
                    Af[m][kk] = (bf16x8){lo[0], lo[1], lo[2], lo[3], hi[0], hi[1], hi[2], hi[3]};
                }
#pragma unroll
            for (int n = 0; n < 8; ++n) {
                f32x4 acc0 = {0.f, 0.f, 0.f, 0.f}, acc1 = {0.f, 0.f, 0.f, 0.f};
#pragma unroll
                for (int kk = 0; kk < 4; ++kk) if (kk <= (n >> 1)) {
                    const bf16x8 Bf = *(LAS const bf16x8*)(WT + (16 * n + fr) * RSW + (32 * kk + 8 * kg) * 2);
                    acc0 = __builtin_amdgcn_mfma_f32_16x16x32_bf16(Af[0][kk], Bf, acc0, 0, 0, 0);
                    acc1 = __builtin_amdgcn_mfma_f32_16x16x32_bf16(Af[1][kk], Bf, acc1, 0, 0, 0);
                }
                const int t = 16 * n + fr; const float bsv = bsn[n];
                const u32x2 u0 = uu[n][0], u1 = uu[n][1];
                unsigned char* y8 = F.ws + WS_YA8 + (size_t)(tok0 + t) * 2048 + g * 256 + dbase + 4 * kg;
                *(unsigned*)y8 = pack_fp8x4(bflo(u0.x) * (acc0[0] + bsv), bfhi(u0.x) * (acc0[1] + bsv), bflo(u0.y) * (acc0[2] + bsv), bfhi(u0.y) * (acc0[3] + bsv));
                *(unsigned*)(y8 + 16) = pack_fp8x4(bflo(u1.x) * (acc1[0] + bsv), bfhi(u1.x) * (acc1[1] + bsv), bflo(u1.y) * (acc1[2] + bsv), bfhi(u1.y) * (acc1[3] + bsv));
            }
        }
        __syncthreads();
    }
}

__device__ __forceinline__ void ph_gate(const Ctx& F) {
    const unsigned char* Q = F.ws + WS_Q; const float* KM = (const float*)(F.ws + WS_KMEAN);
    unsigned* SEL = (unsigned*)(F.ws + WS_SEL); unsigned* LISTS = (unsigned*)(F.ws + WS_LISTS); unsigned* LCNT = (unsigned*)(F.ws + WS_CTL) + CW_LCNT;
    constexpr int KMR = 272;
    LAS unsigned char* kmh = F.lds; LAS unsigned char* kml = F.lds + 16 * KMR;
    unsigned* lc = (unsigned*)(F.ldsg + 2 * 16 * KMR);
    LAS float* scw = (LAS float*)(F.lds + 16384) + F.wave * 1024;
    const int fr = F.lane & 15, fq = F.lane >> 4;
    for (int it = F.vcu; it < NB * NH * 8; it += F.G) {
        const int b = it / 64, h = (it >> 3) & 7, tc = it & 7;
        {
            const int j = F.tid >> 5, d4 = (F.tid & 31) * 4;
            const float* kp = KM + (size_t)((b * NBLK + j) * 2) * DM + h * DH + d4;
            const f32x4 s0 = *(const f32x4*)kp, s1 = *(const f32x4*)(kp + DM);
            const f32x4 mv = (s0 + s1) * (1.0f / LBLK);
            unsigned hb[4]; float lo[4];
#pragma unroll
            for (int e = 0; e < 4; ++e) { hb[e] = f2bf(mv[e]); lo[e] = mv[e] - __uint_as_float(hb[e] << 16); }
            *(LAS u32x2*)(kmh + j * KMR + d4 * 2) = (u32x2){hb[0] | (hb[1] << 16), hb[2] | (hb[3] << 16)};
            *(LAS u32x2*)(kml + j * KMR + d4 * 2) = (u32x2){pk2(lo[0], lo[1]), pk2(lo[2], lo[3])};
        }
        if (F.tid < 32) lc[F.tid] = 0u;
        const int tw = tc * 512 + F.wave * 64;
        u32x4 qraw[4][2];
#pragma unroll
        for (int tg = 0; tg < 4; ++tg) { const unsigned char* qp = Q + (size_t)(b * SEQ + tw + 16 * tg + fr) * DM + h * DH + 32 * fq; qraw[tg][0] = *(const u32x4*)qp; qraw[tg][1] = *(const u32x4*)(qp + 16); }
        __syncthreads();
        bf16x8 Ah[4], Al[4];
#pragma unroll
        for (int ks = 0; ks < 4; ++ks) { Ah[ks] = *(LAS const bf16x8*)(kmh + fr * KMR + (32 * fq + 8 * ks) * 2); Al[ks] = *(LAS const bf16x8*)(kml + fr * KMR + (32 * fq + 8 * ks) * 2); }
#pragma unroll
        for (int tg = 0; tg < 4; ++tg) {
            f32x4 acc = {0.f, 0.f, 0.f, 0.f};
#pragma unroll
            for (int ks = 0; ks < 4; ++ks) {
                const u32x4 w = qraw[tg][ks >> 1]; const unsigned w0 = (ks & 1) ? w.z : w.x, w1 = (ks & 1) ? w.w : w.y;
                const bf16x8 Bq = __builtin_bit_cast(bf16x8, f8x8_to_bf16x8(w0, w1));
                acc = __builtin_amdgcn_mfma_f32_16x16x32_bf16(Ah[ks], Bq, acc, 0, 0, 0);
                acc = __builtin_amdgcn_mfma_f32_16x16x32_bf16(Al[ks], Bq, acc, 0, 0, 0);
            }
            *(LAS f32x4*)(scw + (16 * tg + fr) * 16 + 4 * fq) = acc;
        }
        asm volatile("s_waitcnt lgkmcnt(0)" ::: "memory");
        const int t = tc * 512 + F.tid, qi = t >> 8;
        float gsc[15];
        { const f32x4 c0 = *(LAS const f32x4*)(scw + F.lane * 16), c1 = *(LAS const f32x4*)(scw + F.lane * 16 + 4), c2 = *(LAS const f32x4*)(scw + F.lane * 16 + 8), c3 = *(LAS const f32x4*)(scw + F.lane * 16 + 12);
          gsc[0] = c0.x; gsc[1] = c0.y; gsc[2] = c0.z; gsc[3] = c0.w; gsc[4] = c1.x; gsc[5] = c1.y; gsc[6] = c1.z; gsc[7] = c1.w;
          gsc[8] = c2.x; gsc[9] = c2.y; gsc[10] = c2.z; gsc[11] = c2.w; gsc[12] = c3.x; gsc[13] = c3.y; gsc[14] = c3.z; }
        const int nsel = qi < 3 ? qi : 3;
        int sel[3] = {0, 0, 0}; unsigned lpos[3] = {0, 0, 0};
#pragma unroll
        for (int r = 0; r < 3; ++r) {
            float best = -INFINITY; int bi = -1;
#pragma unroll
            for (int j = 0; j < 15; ++j) { const bool c = (j < qi) && (gsc[j] > best); best = c ? gsc[j] : best; bi = c ? j : bi; }
#pragma unroll
            for (int j = 0; j < 15; ++j) if (j == bi) gsc[j] = -INFINITY;
            sel[r] = bi < 0 ? 0 : bi;
            if (r < nsel) lpos[r] = atomicAdd(&lc[sel[r]], 1u);
        }
        SEL[(size_t)(b * SEQ + t) * NH + h] = (unsigned)sel[0] | ((unsigned)sel[1] << 8) | ((unsigned)sel[2] << 16) | ((unsigned)nsel << 24);
        __syncthreads();
        if (F.tid < 16) lc[16 + F.tid] = lc[F.tid] ? atomicAdd(&LCNT[(b * NH + h) * NBLK + F.tid], lc[F.tid]) : 0u;
        __syncthreads();
#pragma unroll
        for (int r = 0; r < 3; ++r) if (r < nsel) LISTS[(size_t)((b * NH + h) * NBLK + sel[r]) * 4096 + lc[16 + sel[r]] + lpos[r]] = (unsigned)t | ((unsigned)r << 12);
        __syncthreads();
    }
}


typedef float f32x16 __attribute__((ext_vector_type(16)));
namespace att {
__device__ __forceinline__ int crow(int r, int hi) { return (r & 3) + 8 * (r >> 2) + 4 * hi; }
#define TRR(dst, vaddr, off) asm volatile("ds_read_b64_tr_b16 %0, %1 offset:%c2" : "=v"(dst) : "v"(vaddr), "i"(off) : "memory")
#define TRWAIT() do { asm volatile("s_waitcnt lgkmcnt(0)" ::: "memory"); __builtin_amdgcn_sched_barrier(0); } while (0)

}

namespace att2 {
constexpr int KCH2 = 1040, VDB2 = 4160, KSL = 8 * KCH2, VSL = 4 * VDB2;
constexpr int OFF_K = 0, OFF_V = 2 * KSL, OFF_STG = OFF_V + 2 * VSL  , OFF_WS = OFF_STG + 8 * 8192  , WSW = 1024, OFF_TAB = OFF_WS + 8 * WSW  ;
static_assert(OFF_TAB + 1028 * 4 <= LDS_BYTES - 64, "attention (partial) LDS map");
using att::crow;

__device__ __forceinline__ void tile_load(const Ctx& F, const unsigned char* K, const unsigned char* V, size_t tokbase, int h, int kt, u32x4& rk, u32x4& rv) {
    const size_t off = (tokbase + 64 * kt + (F.tid >> 3)) * DM + h * DH + (F.tid & 7) * 16;
    rk = *(const u32x4*)(K + off); rv = *(const u32x4*)(V + off);
}
__device__ __forceinline__ void tile_write(const Ctx& F, int slot, const u32x4& rk, const u32x4& rv) {
    const int key = F.tid >> 3, c = 2 * (F.tid & 7);
    *(LAS u32x4*)(F.lds + OFF_K + slot * KSL + (F.tid & 7) * KCH2 + key * 16) = rk;
    LAS unsigned char* vd = F.lds + OFF_V + slot * VSL + (c >> 2) * VDB2 + (key >> 3) * 512 + (key & 7) * 64 + (c & 3) * 16;
    *(LAS u32x4*)vd = f8x8_to_bf16x8(rv.x, rv.y); *(LAS u32x4*)(vd + 16) = f8x8_to_bf16x8(rv.z, rv.w);
}
template <bool CAUSAL = false>
__device__ __forceinline__ void tile_compute(const Ctx& F, int slot, const pg8::v8i_t (&qf)[2], f32x16 (&o)[4], float& m, float& l, bool first, bool diag = false) {
    const int r = F.lane & 31, hh = F.lane >> 5;
    LAS float* wsf = (LAS float*)(F.lds + OFF_WS + F.wave * WSW);
    LAS const unsigned char* kp = F.lds + OFF_K + slot * KSL + 2 * hh * KCH2 + r * 16;
    LAS const unsigned char* vp = F.lds + OFF_V + slot * VSL + (4 * hh + ((F.lane & 15) >> 2)) * 64 + ((F.lane >> 4) & 1) * 32 + (F.lane & 3) * 8;
    f32x16 p0, p1;
#pragma unroll
    for (int i = 0; i < 16; ++i) { p0[i] = 0.f; p1[i] = 0.f; }
    {
        pg8::v8i_t ka[2][2];
#pragma unroll
        for (int kb = 0; kb < 2; ++kb)
#pragma unroll
            for (int j2 = 0; j2 < 2; ++j2) ka[kb][j2] = __builtin_shufflevector(*(LAS const pg8::v4i_t*)(kp + 4 * j2 * KCH2 + kb * 512), *(LAS const pg8::v4i_t*)(kp + (4 * j2 + 1) * KCH2 + kb * 512), 0, 1, 2, 3, 4, 5, 6, 7);
        __builtin_amdgcn_sched_barrier(0);
#pragma unroll
        for (int j2 = 0; j2 < 2; ++j2) p0 = __builtin_amdgcn_mfma_scale_f32_32x32x64_f8f6f4(ka[0][j2], qf[j2], p0, 0, 0, 0, 0x7f7f7f7f, 0, 0x7f7f7f7f);
#pragma unroll
        for (int j2 = 0; j2 < 2; ++j2) p1 = __builtin_amdgcn_mfma_scale_f32_32x32x64_f8f6f4(ka[1][j2], qf[j2], p1, 0, 0, 0, 0x7f7f7f7f, 0, 0x7f7f7f7f);
        __builtin_amdgcn_sched_barrier(0);
    }
    v4i16_t vl[2][4], vh[2][4];
    const unsigned vaddr = (unsigned)(uintptr_t)vp;
#pragma unroll
    for (int ks = 0; ks < 2; ++ks)
#pragma unroll
        for (int db = 0; db < 4; ++db) { TRR(vl[ks][db], vaddr, db * VDB2 + ks * 1024); TRR(vh[ks][db], vaddr, db * VDB2 + ks * 1024 + 512); }
    __builtin_amdgcn_sched_barrier(0);
    if (CAUSAL && diag) {
        if (F.wave & 1) {
#pragma unroll
            for (int i = 0; i < 16; ++i) p1[i] = (crow(i, hh) > r) ? -INFINITY : p1[i];
        } else {
#pragma unroll
            for (int i = 0; i < 16; ++i) { p0[i] = (crow(i, hh) > r) ? -INFINITY : p0[i]; p1[i] = -INFINITY; }
        }
    }
    const float dm = first ? 0.f : m;
    { const f32x2 dm2 = {dm, dm};
#pragma unroll
      for (int j = 0; j < 8; ++j) { f32x2 a = {p0[2 * j], p0[2 * j + 1]}, b = {p1[2 * j], p1[2 * j + 1]}; a = a - dm2; b = b - dm2; p0[2 * j] = a.x; p0[2 * j + 1] = a.y; p1[2 * j] = b.x; p1[2 * j + 1] = b.y; } }
    float mx = fmaxf(p0[0], p1[0]);
#pragma unroll
    for (int i = 1; i < 16; ++i) mx = fmaxf(mx, fmaxf(p0[i], p1[i]));
    mx = fmaxf(mx, __shfl_xor(mx, 32));
    if (first || __any(mx > 8.0f)) {
        const float delta = first ? mx : fmaxf(mx, 0.f);
        const float alpha = first ? 0.f : __builtin_amdgcn_exp2f(-delta);
        l *= alpha; m = dm + delta;
        { const f32x2 d2 = {delta, delta};
#pragma unroll
          for (int j = 0; j < 8; ++j) { f32x2 a = {p0[2 * j], p0[2 * j + 1]}, b = {p1[2 * j], p1[2 * j + 1]}; a = a - d2; b = b - d2; p0[2 * j] = a.x; p0[2 * j + 1] = a.y; p1[2 * j] = b.x; p1[2 * j + 1] = b.y; } }
        if (!first) {
            if (hh == 0) wsf[r] = alpha;
            asm volatile("s_waitcnt lgkmcnt(0)" ::: "memory");
#pragma unroll
            for (int i = 0; i < 16; ++i) { const float a = wsf[crow(i, hh)];
#pragma unroll
                for (int db = 0; db < 4; ++db) o[db][i] *= a; }
        }
    }
    { f32x2 sa = {0.f, 0.f}, sb = {0.f, 0.f};
#pragma unroll
      for (int j = 0; j < 8; ++j) {
          p0[2 * j] = __builtin_amdgcn_exp2f(p0[2 * j]); p0[2 * j + 1] = __builtin_amdgcn_exp2f(p0[2 * j + 1]); p1[2 * j] = __builtin_amdgcn_exp2f(p1[2 * j]); p1[2 * j + 1] = __builtin_amdgcn_exp2f(p1[2 * j + 1]);
          sa = sa + (f32x2){p0[2 * j], p0[2 * j + 1]}; sb = sb + (f32x2){p1[2 * j], p1[2 * j + 1]}; }
      sa = sa + sb; l += sa.x + sa.y; }
    u32x4 pw[4];
#pragma unroll
    for (int s2 = 0; s2 < 2; ++s2) {
        pw[s2] = (u32x4){cvt_pk_bf16(p0[8 * s2], p0[8 * s2 + 1]), cvt_pk_bf16(p0[8 * s2 + 2], p0[8 * s2 + 3]), cvt_pk_bf16(p0[8 * s2 + 4], p0[8 * s2 + 5]), cvt_pk_bf16(p0[8 * s2 + 6], p0[8 * s2 + 7])};
        pw[2 + s2] = (u32x4){cvt_pk_bf16(p1[8 * s2], p1[8 * s2 + 1]), cvt_pk_bf16(p1[8 * s2 + 2], p1[8 * s2 + 3]), cvt_pk_bf16(p1[8 * s2 + 4], p1[8 * s2 + 5]), cvt_pk_bf16(p1[8 * s2 + 6], p1[8 * s2 + 7])};
    }
    TRWAIT();
#pragma unroll
    for (int ks = 0; ks < 2; ++ks) {
        const bf16x8 pa = __builtin_bit_cast(bf16x8, pw[ks]);
#pragma unroll
        for (int db = 0; db < 4; ++db) {
            const bf16x8 vf = (bf16x8){vl[ks][db][0], vl[ks][db][1], vl[ks][db][2], vl[ks][db][3], vh[ks][db][0], vh[ks][db][1], vh[ks][db][2], vh[ks][db][3]};
            o[db] = __builtin_amdgcn_mfma_f32_32x32x16_bf16(pa, vf, o[db], 0, 0, 0);
        }
    }
    __builtin_amdgcn_sched_barrier(0);
#pragma unroll
    for (int ks = 0; ks < 2; ++ks)
#pragma unroll
        for (int db = 0; db < 4; ++db) { TRR(vl[ks][db], vaddr, db * VDB2 + (2 + ks) * 1024); TRR(vh[ks][db], vaddr, db * VDB2 + (2 + ks) * 1024 + 512); }
    TRWAIT();
#pragma unroll
    for (int ks = 0; ks < 2; ++ks) {
        const bf16x8 pa = __builtin_bit_cast(bf16x8, pw[2 + ks]);
#pragma unroll
        for (int db = 0; db < 4; ++db) {
            const bf16x8 vf = (bf16x8){vl[ks][db][0], vl[ks][db][1], vl[ks][db][2], vl[ks][db][3], vh[ks][db][0], vh[ks][db][1], vh[ks][db][2], vh[ks][db][3]};
            o[db] = __builtin_amdgcn_mfma_f32_32x32x16_bf16(pa, vf, o[db], 0, 0, 0);
        }
    }
    __builtin_amdgcn_sched_barrier(0);
}
}

#define ATT2_DECODE(item, bhj_, chunk_) do { int lo_ = 0, hi_ = 1023; while (lo_ < hi_) { const int mid_ = (lo_ + hi_ + 1) >> 1; if (P[mid_] <= (item)) lo_ = mid_; else hi_ = mid_ - 1; } bhj_ = lo_; chunk_ = (item) - P[lo_]; } while (0)
__device__ __forceinline__ void ph_attn_partial(const Ctx& F) {
    using namespace att2;
    const unsigned char* Q = F.ws + WS_Q; const unsigned char* K = F.ws + WS_K; const unsigned char* V = F.ws + WS_V;
    const unsigned* LISTS = (const unsigned*)(F.ws + WS_LISTS); const unsigned* LCNT = (const unsigned*)(F.ws + WS_CTL) + CW_LCNT;
    unsigned char* OP = F.ws + WS_OP; float* LSE = (float*)(F.ws + WS_LSE);
    LAS int* P = (LAS int*)(F.lds + OFF_TAB);
    if (F.tid < 64) {
        int c[16]; int s = 0;
#pragma unroll
        for (int i = 0; i < 16; ++i) { c[i] = ((int)__hip_atomic_load(LCNT + F.tid * 16 + i, __ATOMIC_RELAXED, __HIP_MEMORY_SCOPE_AGENT) + 255) >> 8; s += c[i]; }
        int inc = s;
#pragma unroll
        for (int o = 1; o < 64; o <<= 1) { const int t = __shfl_up(inc, o); if (F.lane >= o) inc += t; }
        int run = inc - s;
#pragma unroll
        for (int i = 0; i < 16; ++i) { P[F.tid * 16 + i] = run; run += c[i]; }
        if (F.tid == 63) P[1024] = run;
    }
    __syncthreads();
    const int total = P[1024];
    LAS float* wsf = (LAS float*)(F.lds + OFF_WS + F.wave * WSW);
    LAS int* wsi = (LAS int*)wsf;
    const int r = F.lane & 31, hh = F.lane >> 5;
    int it = F.vcu;
    if (it < total) {
        int bhj, chunk; ATT2_DECODE(it, bhj, chunk);
        int itn = it + F.G, bhjn = 0, chunkn = 0; bool hasn = itn < total; if (hasn) ATT2_DECODE(itn, bhjn, chunkn);
        u32x4 rkA, rvA, rkB, rvB;
        { const int b = bhj >> 7, h = (bhj >> 4) & 7, j = bhj & 15; const size_t tb = (size_t)b * SEQ + j * LBLK;
          tile_load(F, K, V, tb, h, 0, rkA, rvA); tile_load(F, K, V, tb, h, 1, rkB, rvB); tile_write(F, 0, rkA, rvA); tile_write(F, 1, rkB, rvB);
          tile_load(F, K, V, tb, h, 2, rkA, rvA); }
        int cnt = (int)__hip_atomic_load(LCNT + bhj, __ATOMIC_RELAXED, __HIP_MEMORY_SCOPE_AGENT);
        int qi = chunk * 256 + F.wave * 32 + r;
        unsigned ent = LISTS[(size_t)bhj * 4096 + (qi < cnt ? qi : 0)];
        int tq = ent & 4095, slot = (qi < cnt) ? (int)(ent >> 12) : -1;
        u32x4 qraw[4];
        { const unsigned char* qrow = Q + ((size_t)(bhj >> 7) * SEQ + tq) * DM + ((bhj >> 4) & 7) * DH + hh * 32;
#pragma unroll
          for (int c = 0; c < 4; ++c) qraw[c] = *(const u32x4*)(qrow + (c >> 1) * 64 + (c & 1) * 16); }
        unsigned entn = 0u; int cntn = 0;
        __syncthreads();
        int s = 0;
        for (;;) {
            const int b = bhj >> 7, h = (bhj >> 4) & 7, j = bhj & 15;
            pg8::v8i_t qr[2];
#pragma unroll
            for (int j2 = 0; j2 < 2; ++j2) qr[j2] = __builtin_shufflevector(__builtin_bit_cast(pg8::v4i_t, qraw[2 * j2]), __builtin_bit_cast(pg8::v4i_t, qraw[2 * j2 + 1]), 0, 1, 2, 3, 4, 5, 6, 7);
            if (F.lane < 32) { wsi[64 + r] = tq; wsi[96 + r] = slot; }
            f32x16 o[4]; float m = -1e30f, l = 0.f;
#pragma unroll
            for (int db = 0; db < 4; ++db)
#pragma unroll
                for (int i = 0; i < 16; ++i) o[db][i] = 0.f;
#define ATT2_TB(bb) ((size_t)((bb) >> 7) * SEQ + ((bb) & 15) * LBLK)
#define ATT2_H(bb) (((bb) >> 4) & 7)
#pragma unroll 1
            for (int kp2 = 0; kp2 < 2; ++kp2) {
                const int kt = 2 * kp2;
                { const bool cur3 = kt + 3 < 4, have3 = cur3 || hasn, have2 = (kt + 2 < 4) || hasn;
                  if (have3) { const int bb = cur3 ? bhj : bhjn; tile_load(F, K, V, ATT2_TB(bb), ATT2_H(bb), (kt + 3) & 3, rkB, rvB); }
                  if (kt == 0 && hasn) { cntn = (int)__hip_atomic_load(LCNT + bhjn, __ATOMIC_RELAXED, __HIP_MEMORY_SCOPE_AGENT); }
                  if (kt == 2 && hasn) { const unsigned char* qrow = Q + ((size_t)(bhjn >> 7) * SEQ + (entn & 4095)) * DM + ((bhjn >> 4) & 7) * DH + hh * 32;
#pragma unroll
                      for (int c = 0; c < 4; ++c) qraw[c] = *(const u32x4*)(qrow + (c >> 1) * 64 + (c & 1) * 16); }
                  tile_compute(F, 0, qr, o, m, l, kp2 == 0);
                  asm volatile("s_waitcnt lgkmcnt(0)" ::: "memory"); __builtin_amdgcn_s_barrier(); asm volatile("" ::: "memory");
                  if (have2) tile_write(F, 0, rkA, rvA); }
                { const bool have4 = hasn, have3 = (kt + 3 < 4) || hasn;
                  if (have4) { tile_load(F, K, V, ATT2_TB(bhjn), ATT2_H(bhjn), kt, rkA, rvA); }
                  if (kt == 0 && hasn) { const int qn = chunkn * 256 + F.wave * 32 + r; entn = LISTS[(size_t)bhjn * 4096 + (qn < cntn ? qn : 0)]; }
                  tile_compute(F, 1, qr, o, m, l, false);
                  asm volatile("s_waitcnt lgkmcnt(0)" ::: "memory"); __builtin_amdgcn_s_barrier(); asm volatile("" ::: "memory");
                  if (have3) tile_write(F, 1, rkB, rvB); }
            }
            const float lt = l + __shfl_xor(l, 32);
            if (hh == 0) { wsf[r] = 1.0f / lt; wsf[32 + r] = m + __builtin_amdgcn_logf(lt); }
            asm volatile("s_waitcnt lgkmcnt(0)" ::: "memory");
            int re = r, he = hh; asm volatile("" : "+v"(re), "+v"(he));
#pragma unroll
            for (int i = 0; i < 16; ++i) {
                const int q = crow(i, he); const float a = wsf[q]; const int t = wsi[64 + q], sl = wsi[96 + q];
                const unsigned w = pack_fp8x4(o[0][i] * a, o[1][i] * a, o[2][i] * a, o[3][i] * a);
                if (sl >= 0) { const size_t row = (((size_t)sl * NB + b) * SEQ + t) * NH + h; *(unsigned*)(OP + row * DH + 4 * re) = w; }
            }
            if (he == 0 && slot >= 0) LSE[(((size_t)slot * NB + b) * SEQ + tq) * NH + h] = wsf[32 + re];
            asm volatile("s_waitcnt lgkmcnt(0)" ::: "memory");
            if (!hasn) break;
            it = itn; bhj = bhjn; chunk = chunkn; cnt = cntn;
            { const int qn = chunk * 256 + F.wave * 32 + r; tq = entn & 4095; slot = (qn < cnt) ? (int)(entn >> 12) : -1; }
            itn = it + F.G; hasn = itn < total; if (hasn) ATT2_DECODE(itn, bhjn, chunkn);
        }
    }
    __syncthreads();
}

__device__ __forceinline__ void ph_attn_own(const Ctx& F) {
    using namespace att2;
    const unsigned char* Q = F.ws + WS_Q; const unsigned char* K = F.ws + WS_K; const unsigned char* V = F.ws + WS_V;
    const unsigned char* OP = F.ws + WS_OP; const float* LSE = (const float*)(F.ws + WS_LSE); unsigned char* YA8 = F.ws + WS_YA8;
    LAS float* wsf = (LAS float*)(F.lds + OFF_WS + F.wave * WSW);
    const int r = F.lane & 31, hh = F.lane >> 5;
    constexpr int NIT = NB * NH * NBLK;
    int it = F.vcu;
    if (it < NIT) {
        int itn = it + F.G; bool hasn = itn < NIT;
        u32x4 rkA, rvA, rkB, rvB;
#define OWN_TB(i_) ((size_t)((i_) >> 7) * SEQ + ((i_) & 15) * LBLK)
#define OWN_H(i_) (((i_) >> 4) & 7)
        tile_load(F, K, V, OWN_TB(it), OWN_H(it), 0, rkA, rvA); tile_load(F, K, V, OWN_TB(it), OWN_H(it), 1, rkB, rvB); tile_write(F, 0, rkA, rvA); tile_write(F, 1, rkB, rvB);
        tile_load(F, K, V, OWN_TB(it), OWN_H(it), 2, rkA, rvA);
        u32x4 qraw[4];
        { const unsigned char* qrow = Q + (OWN_TB(it) + F.wave * 32 + r) * DM + OWN_H(it) * DH + hh * 32;
#pragma unroll
          for (int c = 0; c < 4; ++c) qraw[c] = *(const u32x4*)(qrow + (c >> 1) * 64 + (c & 1) * 16); }
        __syncthreads();
        const int wdiag = F.wave >> 1;
        for (;;) {
            const int b = it >> 7, h = (it >> 4) & 7, j = it & 15, t0 = j * LBLK + F.wave * 32;
            pg8::v8i_t qr[2];
#pragma unroll
            for (int j2 = 0; j2 < 2; ++j2) qr[j2] = __builtin_shufflevector(__builtin_bit_cast(pg8::v4i_t, qraw[2 * j2]), __builtin_bit_cast(pg8::v4i_t, qraw[2 * j2 + 1]), 0, 1, 2, 3, 4, 5, 6, 7);
            f32x16 o[4]; float m = -1e30f, l = 0.f;
#pragma unroll
            for (int db = 0; db < 4; ++db)
#pragma unroll
                for (int i = 0; i < 16; ++i) o[db][i] = 0.f;
#pragma unroll 1
            for (int kp2 = 0; kp2 < 2; ++kp2) {
                const int kt = 2 * kp2;
                { const bool cur3 = kt + 3 < 4, have3 = cur3 || hasn, have2 = (kt + 2 < 4) || hasn;
                  if (have3) { const int ii = cur3 ? it : itn; tile_load(F, K, V, OWN_TB(ii), OWN_H(ii), (kt + 3) & 3, rkB, rvB); }
                  if (kt == 2 && hasn) { const unsigned char* qrow = Q + (OWN_TB(itn) + F.wave * 32 + r) * DM + OWN_H(itn) * DH + hh * 32;
#pragma unroll
                      for (int c = 0; c < 4; ++c) qraw[c] = *(const u32x4*)(qrow + (c >> 1) * 64 + (c & 1) * 16); }
                  if (kt <= wdiag) tile_compute<true>(F, 0, qr, o, m, l, kp2 == 0, kt == wdiag);
                  asm volatile("s_waitcnt lgkmcnt(0)" ::: "memory"); __builtin_amdgcn_s_barrier(); asm volatile("" ::: "memory");
                  if (have2) tile_write(F, 0, rkA, rvA); }
                { const bool have4 = hasn, have3 = (kt + 3 < 4) || hasn;
                  if (have4) { tile_load(F, K, V, OWN_TB(itn), OWN_H(itn), kt, rkA, rvA); }
                  if (kt + 1 <= wdiag) tile_compute<true>(F, 1, qr, o, m, l, false, kt + 1 == wdiag);
                  asm volatile("s_waitcnt lgkmcnt(0)" ::: "memory"); __builtin_amdgcn_s_barrier(); asm volatile("" ::: "memory");
                  if (have3) tile_write(F, 1, rkB, rvB); }
            }
            const int nv = j < 3 ? j : 3;
            int re = r, he = hh; asm volatile("" : "+v"(re), "+v"(he));
            LAS float* stg = (LAS float*)(F.lds + OFF_STG + F.wave * 8192);
            unsigned pv[16][3];
#pragma unroll
            for (int i = 0; i < 16; ++i) { const int q = crow(i, he);
#pragma unroll
                for (int s2 = 0; s2 < 3; ++s2) { pv[i][s2] = 0u; if (s2 < nv) pv[i][s2] = *(const unsigned*)(OP + ((((size_t)s2 * NB + b) * SEQ + t0 + q) * NH + h) * DH + 4 * re); } }
            {
                const float lt = l + __shfl_xor(l, 32); const float lse_own = m + __builtin_amdgcn_logf(lt);
                float ls[3];
#pragma unroll
                for (int s2 = 0; s2 < 3; ++s2) ls[s2] = (s2 < nv) ? LSE[(((size_t)s2 * NB + b) * SEQ + t0 + r) * NH + h] : -1e30f;
                const float M = fmaxf(fmaxf(lse_own, ls[0]), fmaxf(ls[1], ls[2]));
                const float w0 = __builtin_amdgcn_exp2f(lse_own - M);
                float w[3], den = w0;
#pragma unroll
                for (int s2 = 0; s2 < 3; ++s2) { w[s2] = (s2 < nv) ? __builtin_amdgcn_exp2f(ls[s2] - M) : 0.f; den += w[s2]; }
                const float inv = 1.0f / den;
                if (hh == 0) { wsf[r] = w0 * inv / lt; wsf[32 + r] = w[0] * inv; wsf[64 + r] = w[1] * inv; wsf[96 + r] = w[2] * inv; }
                asm volatile("s_waitcnt lgkmcnt(0)" ::: "memory");
            }
            {
#pragma unroll
                for (int i = 0; i < 16; ++i) { const int q = crow(i, he); const float a = wsf[q];
                    float x0 = o[0][i] * a, x1 = o[1][i] * a, x2 = o[2][i] * a, x3 = o[3][i] * a;
#pragma unroll
                    for (int s2 = 0; s2 < 3; ++s2) { const float ww = wsf[32 * (s2 + 1) + q]; const f32x2v f0 = __builtin_amdgcn_cvt_pk_f32_fp8((int)pv[i][s2], false), f1 = __builtin_amdgcn_cvt_pk_f32_fp8((int)pv[i][s2], true);
                        x0 += ww * f0.x; x1 += ww * f0.y; x2 += ww * f1.x; x3 += ww * f1.y; }
                    o[0][i] = x0; o[1][i] = x1; o[2][i] = x2; o[3][i] = x3; }
            }
#pragma unroll
            for (int half = 0; half < 2; ++half) {
#pragma unroll
                for (int i = 0; i < 16; ++i) { const int q = crow(i, he); stg[q * 64 + re] = o[2 * half][i]; stg[q * 64 + 32 + re] = o[2 * half + 1][i]; }
                asm volatile("s_waitcnt lgkmcnt(0)" ::: "memory");
#pragma unroll
                for (int ps = 0; ps < 4; ++ps) {
                    const int q = ps * 8 + ((re + 32 * he) >> 3), dc = re & 7;
                    const f32x4 x = *(LAS const f32x4*)(stg + q * 64 + dc * 8), y = *(LAS const f32x4*)(stg + q * 64 + dc * 8 + 4);
                    *(u32x2*)(YA8 + ((size_t)b * SEQ + t0 + q) * 2048 + 1024 + h * DH + half * 64 + dc * 8) = (u32x2){pack_fp8x4(x.x, x.y, x.z, x.w), pack_fp8x4(y.x, y.y, y.z, y.w)};
                }
                asm volatile("s_waitcnt lgkmcnt(0)" ::: "memory");
            }
            if (!hasn) break;
            it = itn; itn = it + F.G; hasn = itn < NIT;
        }
#undef OWN_TB
#undef OWN_H
    }
    __syncthreads();
}

__device__ __forceinline__ void ph_router(const Ctx& F) {
    const Args& A = *F.a;
    const bf16_t* Z = (const bf16_t*)(F.ws + WS_Z); const float* ZST = (const float*)(F.ws + WS_ZST); bf16_t* H1 = (bf16_t*)(F.ws + WS_H1); unsigned char* H1F8 = F.ws + WS_H1F8;
    int* TKE = (int*)(F.ws + WS_TKE); int* TKP = (int*)(F.ws + WS_TKP); unsigned* ECNT = (unsigned*)(F.ws + WS_CTL) + CW_ECNT; int* RT = (int*)(F.ws + WS_RT); float* RW = (float*)(F.ws + WS_RW);
    const float* wr = A.in[I_WR]; const float* br = A.in[I_BR];
    constexpr int RS = 2064, OFF_LO = 32 * RS, OFF_G = 2 * 32 * RS  , OFF_B = OFF_G + 4096, OFF_LG = OFF_B + 4096  , OFF_CNT = OFF_LG + 8 * 2112  ;
    static_assert(OFF_CNT + 256 <= LDS_BYTES, "router LDS map");
    LAS unsigned char* WH = F.lds; LAS unsigned char* WL = F.lds + OFF_LO;
    LAS float* LG = (LAS float*)(F.lds + OFF_G); LAS float* LB = (LAS float*)(F.lds + OFF_B);
    LAS float* lgt = (LAS float*)(F.lds + OFF_LG + F.wave * 2112);
    LAS unsigned* lcnt = (LAS unsigned*)(F.lds + OFF_CNT);
    {
        f32x4 wa[8], wb[8];
#pragma unroll
        for (int u_ = 0; u_ < 8; ++u_) { const int i = F.tid + 512 * u_, nq = i & 7, k2 = i >> 3;
            wa[u_] = *(const f32x4*)(wr + (size_t)(2 * k2) * NE + 4 * nq); wb[u_] = *(const f32x4*)(wr + (size_t)(2 * k2 + 1) * NE + 4 * nq); }
#pragma unroll
        for (int u_ = 0; u_ < 8; ++u_) { const int i = F.tid + 512 * u_, nq = i & 7, k2 = i >> 3;
#pragma unroll
            for (int c = 0; c < 4; ++c) {
                const float w0 = wa[u_][c], w1 = wb[u_][c];
                const unsigned h0 = f2bf(w0), h1 = f2bf(w1);
                const float r0 = w0 - __uint_as_float(h0 << 16), r1 = w1 - __uint_as_float(h1 << 16);
                *(LAS unsigned*)(WH + (4 * nq + c) * RS + k2 * 4) = h0 | (h1 << 16);
                *(LAS unsigned*)(WL + (4 * nq + c) * RS + k2 * 4) = pk2(r0, r1);
            } }
    }
    for (int i = F.tid; i < DM; i += 512) { LG[i] = A.in[I_LNMIX_G][i]; LB[i] = A.in[I_LNMIX_B][i]; }
    if (F.tid < 64) lcnt[F.tid] = 0u;
    __syncthreads();
    const int fr = F.lane & 15, kg = F.lane >> 4;
    const int ntask = T / 16, NGW = F.G * 8;
    const int rounds = (ntask + NGW - 1) / NGW;
    for (int rd = 0; rd < rounds; ++rd) {
        const int task = rd * NGW + F.vcu * 8 + F.wave;
        const bool live = task < ntask;
        int te[4] = {0, 0, 0, 0}; float tw[4] = {0.f, 0.f, 0.f, 0.f}; unsigned lp[4] = {0, 0, 0, 0};
        if (live) {
            const int tok = task * 16 + fr;
            float mean, rstd;
            { const f32x4* sp = (const f32x4*)(ZST + (size_t)tok * 32); float s1 = 0.f, s2 = 0.f;
#pragma unroll
              for (int i = 0; i < 8; ++i) { const f32x4 v = sp[i]; s1 += v.x + v.z; s2 += v.y + v.w; }
              mean = s1 * (1.f / DM); const float var = s2 * (1.f / DM) - mean * mean; rstd = 1.f / sqrtf(fmaxf(var, 0.f) + LN_EPS); }
            f32x4 acc0 = {0.f, 0.f, 0.f, 0.f}, acc1 = {0.f, 0.f, 0.f, 0.f};
            const bf16_t* zp = Z + (size_t)tok * DM + 8 * kg; unsigned char* h8 = H1F8 + (size_t)tok * DM + 8 * kg;
#pragma unroll 8
            for (int kk = 0; kk < 32; ++kk) {
                const u32x4 zr = *(const u32x4*)(zp + 32 * kk); const f32x4 z0 = {bflo(zr.x), bfhi(zr.x), bflo(zr.y), bfhi(zr.y)}, z1 = {bflo(zr.z), bfhi(zr.z), bflo(zr.w), bfhi(zr.w)};
                const f32x4 g0 = *(LAS const f32x4*)(LG + 32 * kk + 8 * kg), g1 = *(LAS const f32x4*)(LG + 32 * kk + 8 * kg + 4);
                const f32x4 b0 = *(LAS const f32x4*)(LB + 32 * kk + 8 * kg), b1 = *(LAS const f32x4*)(LB + 32 * kk + 8 * kg + 4);
                const f32x4 x0 = (z0 - mean) * rstd * g0 + b0, x1 = (z1 - mean) * rstd * g1 + b1;
                u32x4 hi; hi.x = cvt_pk_bf16(x0.x, x0.y); hi.y = cvt_pk_bf16(x0.z, x0.w); hi.z = cvt_pk_bf16(x1.x, x1.y); hi.w = cvt_pk_bf16(x1.z, x1.w);
                { unsigned w0 = 0u, w1 = 0u;
                  w0 = __builtin_amdgcn_cvt_pk_fp8_f32(x0.x, x0.y, w0, false); w0 = __builtin_amdgcn_cvt_pk_fp8_f32(x0.z, x0.w, w0, true);
                  w1 = __builtin_amdgcn_cvt_pk_fp8_f32(x1.x, x1.y, w1, false); w1 = __builtin_amdgcn_cvt_pk_fp8_f32(x1.z, x1.w, w1, true);
                  *(u32x2*)(h8 + 32 * kk) = (u32x2){w0, w1}; }
                u32x4 lo; lo.x = cvt_pk_bf16(x0.x - bflo(hi.x), x0.y - bfhi(hi.x)); lo.y = cvt_pk_bf16(x0.z - bflo(hi.y), x0.w - bfhi(hi.y));
                lo.z = cvt_pk_bf16(x1.x - bflo(hi.z), x1.y - bfhi(hi.z)); lo.w = cvt_pk_bf16(x1.z - bflo(hi.w), x1.w - bfhi(hi.w));
                const bf16x8 ah = __builtin_bit_cast(bf16x8, hi), al = __builtin_bit_cast(bf16x8, lo);
                const int bo = fr * RS + (32 * kk + 8 * kg) * 2;
                const bf16x8 wh0 = *(LAS const bf16x8*)(WH + bo), wh1 = *(LAS const bf16x8*)(WH + bo + 16 * RS), wl0 = *(LAS const bf16x8*)(WL + bo), wl1 = *(LAS const bf16x8*)(WL + bo + 16 * RS);
                acc0 = __builtin_amdgcn_mfma_f32_16x16x32_bf16(ah, wh0, acc0, 0, 0, 0); acc1 = __builtin_amdgcn_mfma_f32_16x16x32_bf16(ah, wh1, acc1, 0, 0, 0);
                acc0 = __builtin_amdgcn_mfma_f32_16x16x32_bf16(ah, wl0, acc0, 0, 0, 0); acc1 = __builtin_amdgcn_mfma_f32_16x16x32_bf16(ah, wl1, acc1, 0, 0, 0);
                acc0 = __builtin_amdgcn_mfma_f32_16x16x32_bf16(al, wh0, acc0, 0, 0, 0); acc1 = __builtin_amdgcn_mfma_f32_16x16x32_bf16(al, wh1, acc1, 0, 0, 0);
            }
            const float br0 = br[fr], br1 = br[16 + fr];
#pragma unroll
            for (int i = 0; i < 4; ++i) { lgt[(4 * kg + i) * 33 + fr] = acc0[i] + br0; lgt[(4 * kg + i) * 33 + 16 + fr] = acc1[i] + br1; }
            asm volatile("s_waitcnt lgkmcnt(0)" ::: "memory");
            if (F.lane < 16) {
                float lg[NE];
#pragma unroll
                for (int e = 0; e < NE; ++e) lg[e] = lgt[F.lane * 33 + e];
                float tv[4];
#pragma unroll
                for (int r = 0; r < 4; ++r) {
                    float best = -INFINITY; int bi = 0;
#pragma unroll
                    for (int e = 0; e < NE; ++e) { const bool c = lg[e] > best; best = c ? lg[e] : best; bi = c ? e : bi; }
#pragma unroll
                    for (int e = 0; e < NE; ++e) lg[e] = (e == bi) ? -INFINITY : lg[e];
                    te[r] = bi; tv[r] = best;
                }
                const float e1 = __expf(tv[1] - tv[0]), e2 = __expf(tv[2] - tv[0]), e3 = __expf(tv[3] - tv[0]); const float inv = 1.f / (1.f + e1 + e2 + e3);
                tw[0] = inv; tw[1] = e1 * inv; tw[2] = e2 * inv; tw[3] = e3 * inv;
#pragma unroll
                for (int r = 0; r < 4; ++r) lp[r] = atomicAdd((unsigned*)(lcnt + te[r]), 1u);
            }
        }
        __syncthreads();
        if (F.tid < 32) { const unsigned c = lcnt[F.tid]; lcnt[32 + F.tid] = c ? atomicAdd(&ECNT[F.tid], c) : 0u; }
        __syncthreads();
        if (live && F.lane < 16) {
            const size_t tok = (size_t)task * 16 + F.lane;
            int4 pe = {te[0], te[1], te[2], te[3]};
            int4 pp = {(int)(lcnt[32 + te[0]] + lp[0]), (int)(lcnt[32 + te[1]] + lp[1]), (int)(lcnt[32 + te[2]] + lp[2]), (int)(lcnt[32 + te[3]] + lp[3])};
            *(int4*)(TKE + tok * 4) = pe; *(int4*)(TKP + tok * 4) = pp;
#pragma unroll
            for (int r = 0; r < 4; ++r) { const size_t o_ = (size_t)te[r] * T + (r == 0 ? pp.x : r == 1 ? pp.y : r == 2 ? pp.z : pp.w); RT[o_] = (int)tok; RW[o_] = tw[r]; }
        }
        __syncthreads();
        if (F.tid < 32) lcnt[F.tid] = 0u;
        __syncthreads();
    }
}

__device__ __forceinline__ void moe_table(const Ctx& F) {
    const unsigned* ECNT = (const unsigned*)(F.ws + WS_CTL) + CW_ECNT;
    LAS int* tab = (LAS int*)(F.lds + LDS_MOE);
    __syncthreads();
    if (F.tid == 0) {
        int acc = 0;
        for (int e = 0; e < NE; ++e) { const int c = (int)__hip_atomic_load(ECNT + e, __ATOMIC_RELAXED, __HIP_MEMORY_SCOPE_AGENT); tab[32 + e] = acc; acc += (c + 255) / 256 * 256; }
        tab[64] = acc; tab[0] = acc / 256;
    }
    __syncthreads();
    const int ntiles = tab[0];
    for (int i = F.tid; i < ntiles; i += 512) { int e = 0; for (int k = 1; k < NE; ++k) if (i * 256 >= tab[32 + k]) e = k; tab[128 + 2 * i] = e; tab[129 + 2 * i] = i - tab[32 + e] / 256; }
    __syncthreads();
}

__device__ __forceinline__ void ln_stats16(const float* st, int lane, float& mean, float& rstd) {
    float s1 = 0.f, s2 = 0.f;
    if (lane < 16) { const f32x2 p = *(const f32x2*)(st + 2 * lane); s1 = p.x; s2 = p.y; }
    s1 = wave_sum(s1); s2 = wave_sum(s2);
    mean = s1 * (1.f / DM); const float var = s2 * (1.f / DM) - mean * mean; rstd = 1.f / sqrtf(fmaxf(var, 0.f) + LN_EPS);
}
__device__ __forceinline__ void ph_final(const Ctx& F) {
    const Args& A = *F.a;
    const bf16_t* Z = (const bf16_t*)(F.ws + WS_Z); const float* ZST = (const float*)(F.ws + WS_ZST); const unsigned char* YS = F.ws + WS_YS; const int* TKE = (const int*)(F.ws + WS_TKE); const int* TKP = (const int*)(F.ws + WS_TKP);
    const LAS int* tab = (const LAS int*)(F.lds + LDS_MOE);
    const int gw = F.vcu * 8 + F.wave, NGW = F.G * 8;
    f32x4 g2[4], b2[4], g1[4], b1[4];
#pragma unroll
    for (int j = 0; j < 4; ++j) { g2[j] = *((const f32x4*)A.in[I_LNF_G] + F.lane + 64 * j); b2[j] = *((const f32x4*)A.in[I_LNF_B] + F.lane + 64 * j);
        g1[j] = *((const f32x4*)A.in[I_LNMIX_G] + F.lane + 64 * j) * ALPHA; b1[j] = *((const f32x4*)A.in[I_LNMIX_B] + F.lane + 64 * j) * ALPHA; }
    for (int m = gw; m < T; m += NGW) {
        float mean, rstd; ln_stats16(ZST + (size_t)m * 32, F.lane, mean, rstd);
        const u32x2* hr = (const u32x2*)(Z + (size_t)m * DM) + F.lane;
        f32x4 v[4];
#pragma unroll
        for (int j = 0; j < 4; ++j) { const u32x2 hb = hr[64 * j]; v[j] = ((f32x4){bflo(hb.x), bfhi(hb.x), bflo(hb.y), bfhi(hb.y)} - mean) * rstd * g1[j] + b1[j]; }
#pragma unroll
        for (int k = 0; k < 4; ++k) {
            const int row = tab[32 + TKE[(size_t)m * 4 + k]] + TKP[(size_t)m * 4 + k]; const unsigned* yr = (const unsigned*)(YS + (size_t)row * DM) + F.lane;
#pragma unroll
            for (int j = 0; j < 4; ++j) { const unsigned y = yr[64 * j]; const f32x2v f0 = __builtin_amdgcn_cvt_pk_f32_fp8((int)y, false), f1 = __builtin_amdgcn_cvt_pk_f32_fp8((int)y, true);
                v[j].x += 0.0625f * f0.x; v[j].y += 0.0625f * f0.y; v[j].z += 0.0625f * f1.x; v[j].w += 0.0625f * f1.y; }
        }
        float s = 0.f;
#pragma unroll
        for (int j = 0; j < 4; ++j) s += (v[j].x + v[j].y) + (v[j].z + v[j].w);
        const float mu = wave_sum(s) * (1.f / DM); float s2 = 0.f;
#pragma unroll
        for (int j = 0; j < 4; ++j) { v[j] = v[j] - mu; s2 += (v[j].x * v[j].x + v[j].y * v[j].y) + (v[j].z * v[j].z + v[j].w * v[j].w); }
        const float rs = 1.f / sqrtf(wave_sum(s2) * (1.f / DM) + LN_EPS);
        f32x4* orow = (f32x4*)(A.out + (size_t)m * DM) + F.lane;
#pragma unroll
        for (int j = 0; j < 4; ++j) orow[64 * j] = v[j] * rs * g2[j] + b2[j];
    }
}

#define XB_TMO      128
#define XB_XCNT(j)  (256  + 64 * (j))
#define XB_XSUB(j)  (1280 + 64 * (j))
#define XB_XGEN(j)  (2304 + 64 * (j))
#define XB_TOP      3328
#define XB_TOPGEN   3392
#define XCD_BAR_WORDS 3456
#define XB_SPIN_CAP (1u << 18)
__device__ __forceinline__ unsigned xb_ld(unsigned* p)              { return __hip_atomic_load(p, __ATOMIC_RELAXED, __HIP_MEMORY_SCOPE_AGENT); }
__device__ __forceinline__ unsigned xb_add(unsigned* p, unsigned v) { return __hip_atomic_fetch_add(p, v, __ATOMIC_RELAXED, __HIP_MEMORY_SCOPE_AGENT); }
__device__ __forceinline__ unsigned xb_xcc_id() { return (unsigned)__builtin_amdgcn_s_getreg((3 << 11) | 20) & 0xFu; }
#define XB_SPIN(cond, bar) do { unsigned _sp = 0; while (cond) { __builtin_amdgcn_s_sleep(1); \
    if ((++_sp & 255u) == 0u) { if (xb_ld(&(bar)[XB_TMO])) break; if (_sp > XB_SPIN_CAP) { atomicAdd(&(bar)[XB_TMO], 1u); break; } } } } while (0)
__device__ __forceinline__ void xcd_barrier_complete(unsigned* bar, unsigned x, unsigned& nloc, unsigned& nx) {
    const unsigned G = gridDim.x * gridDim.y * gridDim.z;
    unsigned sum, cnt, mine, sp = 0u;
    for (;;) {
        sum = 0u; cnt = 0u; mine = 0u;
#pragma unroll
        for (unsigned j = 0; j < 16; ++j) { const unsigned c = xb_ld(&bar[XB_XCNT(j)]); sum += c; cnt += (c > 0u) ? 1u : 0u; mine = (j == x) ? c : mine; }
        if (sum == G) break;
        __builtin_amdgcn_s_sleep(1);
        if ((++sp & 255u) == 0u) { if (xb_ld(&bar[XB_TMO])) break; if (sp > XB_SPIN_CAP) { atomicAdd(&bar[XB_TMO], 1u); break; } }
    }
    nloc = mine > 0u ? mine : 1u; nx = cnt > 0u ? cnt : 1u;
}
__device__ __forceinline__ void xcd_barrier(unsigned* bar, volatile LAS unsigned* st, unsigned x, bool leader_thread) {
    asm volatile("s_waitcnt vmcnt(0)" ::: "memory");
    __syncthreads();
    if (leader_thread) {
        __builtin_amdgcn_s_waitcnt(0);
        unsigned nloc = st[0], nx = st[1];
        if (nloc == 0u) { xcd_barrier_complete(bar, x, nloc, nx); st[0] = nloc; st[1] = nx; }
        const unsigned old = xb_add(&bar[XB_XSUB(x)], 1u);
        const unsigned gen = old / nloc;
        if (old + 1u == (gen + 1u) * nloc) {
            __builtin_amdgcn_fence(__ATOMIC_RELEASE, "agent");
            asm volatile("s_waitcnt vmcnt(0)" ::: "memory");
            const unsigned og = xb_add(&bar[XB_TOP], 1u);
            const unsigned tg = og / nx;
            if (og + 1u == (tg + 1u) * nx) xb_add(&bar[XB_TOPGEN], 1u);
            else XB_SPIN(xb_ld(&bar[XB_TOPGEN]) == tg, bar);
            __builtin_amdgcn_fence(__ATOMIC_ACQUIRE, "agent");
            xb_add(&bar[XB_XGEN(x)], 1u);
            asm volatile("s_waitcnt vmcnt(0)" ::: "memory");
        } else {
            XB_SPIN(xb_ld(&bar[XB_XGEN(x)]) == gen, bar);
            __builtin_amdgcn_fence(__ATOMIC_ACQUIRE, "agent");
            asm volatile("s_waitcnt vmcnt(0)" ::: "memory");
        }
    }
    __syncthreads();
}

template <bool COOP>
__global__ void __launch_bounds__(512, 2) mega(Args args) {
    extern __shared__ __attribute__((aligned(16))) unsigned char lds_raw[];
    Ctx F;
    const int wave0 = __builtin_amdgcn_readfirstlane(threadIdx.x >> 6);
#define MKCTX() do { F.a = &args; F.ws = args.ws; F.lds = (LAS unsigned char*)lds_raw; F.ldsg = lds_raw; F.lane = lane_id_asm(); F.wave = wave0; F.tid = wave0 * 64 + F.lane; \
    F.G = gridDim.x; { const int bx = blockIdx.x; F.vcu = (F.G % 8 == 0) ? (bx % 8) * (F.G / 8) + bx / 8 : bx; } } while (0)
    MKCTX();
    const int lo = args.ph_lo, hi = args.ph_hi;
    unsigned char* ws = args.ws;
#ifndef PHMASK
#define PHMASK 0xFFFF
#endif
#define IN(k) (((PHMASK >> (k)) & 1) && lo <= (k) && (k) < hi)
    unsigned* barw = (unsigned*)(ws + WS_CTL) + CW_BAR; volatile LAS unsigned* bst = (volatile LAS unsigned*)((LAS unsigned char*)lds_raw + LDS_BYTES - 64);
    const unsigned my_xcc = xb_xcc_id();
    if (COOP) { if (threadIdx.x == 0) { bst[0] = 0u; bst[1] = 0u; (void)xb_add(&barw[XB_XCNT(my_xcc)], 1u); } __syncthreads(); }
#define SEAM(k) do { if (COOP && IN(k) && IN((k) + 1)) { if (args.ph_hi > 1000) cg::this_grid().sync();   xcd_barrier(barw, bst, my_xcc, wave0 == 0 && lane_id_asm() == 0); } } while (0)
    if (IN(0)) { MKCTX(); ph_prologue(F); } SEAM(0);
    if (IN(1)) {
        constexpr int NSLOT = 4;
        const int wslot = (F.G % 8 == 0) ? ((int)blockIdx.x / 8) % NSLOT : (int)blockIdx.x % NSLOT;
        if (wslot == 0) { MKCTX(); ph_wconv(F); }
        {
            pg8::Gemm g{(const bf16_t*)(ws + WS_H0), (const bf16_t*)(ws + WS_WIN), DM, DM, DM, nullptr}; pg8::StaticOrder S; S.init(T, PN8_LO * 256, F.G, (int)blockIdx.x, 0);
            const pg8::Epi1 E{(bf16_t*)(ws + WS_YAB), (bf16_t*)(ws + WS_GV), ws + WS_Q, ws + WS_K, ws + WS_V, (bf16_t*)(ws + WS_SA), (bf16_t*)(ws + WS_SB), (float*)(ws + WS_GVST), (float*)(ws + WS_KMEAN), 1.0f, 0.f};
            pg8::gemm_phase<pg8::Epi1, pg8::StaticOrder, true>(F.lds, g, S, E, wave0);
        }
#pragma unroll 1
        for (int part = 0; part < 2; ++part) {
            if (wslot == 1 + part) { MKCTX(); ph_wconv(F); }
            const pg8::Epi1 E{(bf16_t*)(ws + WS_YAB), (bf16_t*)(ws + WS_GV), ws + WS_Q, ws + WS_K, ws + WS_V, (bf16_t*)(ws + WS_SA), (bf16_t*)(ws + WS_SB), (float*)(ws + WS_GVST), (float*)(ws + WS_KMEAN), 0.03125f, 0.f};
            pg8::Gemm g{(const bf16_t*)(ws + WS_H0F8), (const bf16_t*)(ws + WS_WIN8), DM / 2, DM / 2, DM / 2, nullptr}; pg8::StaticOrder S; S.init(T, (PN8_HI - PN8_LO) / 2 * 256, F.G, (int)blockIdx.x, PN8_LO + part * ((PN8_HI - PN8_LO) / 2));
            pg8::gemm_phase<pg8::Epi1, pg8::StaticOrder, true, true>(F.lds, g, S, E, wave0);
        }
        if (wslot == 3) { MKCTX(); ph_wconv(F); }
    } SEAM(1);
    if (IN(2)) { MKCTX(); ph_mixer_a(F); __syncthreads(); ph_gate(F); } SEAM(2);
    if (IN(3)) { } if (COOP && IN(3) && IN(4)) { }
    if (IN(4)) { MKCTX(); ph_attn_partial(F); } SEAM(4);
    if (IN(5)) { MKCTX(); ph_attn_own(F); } SEAM(5);
    if (IN(6)) {
        pg8::Gemm g{(const bf16_t*)(ws + WS_YA8), (const bf16_t*)(ws + WS_WAB), 2048 / 2, 2048 / 2, 2048 / 2, nullptr}; pg8::StaticOrder S; S.init(T, DM, F.G, (int)blockIdx.x);
        pg8::Epi2 E{ws + WS_SA, ws + WS_SB, (bf16_t*)(ws + WS_MG)};
        pg8::gemm_phase<pg8::Epi2, pg8::StaticOrder, true, true>(F.lds, g, S, E, wave0);
    } SEAM(6);
    if (IN(7)) {
        pg8::Gemm g{(const bf16_t*)(ws + WS_MG), (const bf16_t*)(ws + WS_WOUT), DM, DM, DM, nullptr}; pg8::StaticOrder S; S.init(T, DM, F.G, (int)blockIdx.x);
        pg8::Epi3 E{(const bf16_t*)(ws + WS_H0), (bf16_t*)(ws + WS_Z), (float*)(ws + WS_ZST)};
        pg8::gemm_phase<pg8::Epi3, pg8::StaticOrder, true>(F.lds, g, S, E, wave0);
    } SEAM(7);
    if (IN(8)) { MKCTX(); ph_router(F); } SEAM(8);
    if (IN(9)) { } if (COOP && IN(9) && IN(10)) { }
    if (IN(10)) {
        MKCTX(); moe_table(F);
        pg8::Gemm g{(const bf16_t*)(ws + WS_H1F8), (const bf16_t*)(ws + WS_WUP), DM / 2, DM / 2, DM / 2, (const int*)(ws + WS_RT)}; pg8::MoeOrder S;   S.init((const LAS int*)(F.lds + LDS_MOE), 8, F.G, (int)blockIdx.x);
        pg8::Epi4 E{args.in[I_BUP], ws + WS_ACT};
        pg8::gemm_phase<pg8::Epi4, pg8::MoeOrder, true, true, true>(F.lds, g, S, E, wave0);
    } SEAM(10);
    if (IN(11)) {
        MKCTX(); moe_table(F);
        pg8::Gemm g{(const bf16_t*)(ws + WS_ACT), (const bf16_t*)(ws + WS_WDN), FF / 2, FF / 2, FF / 2, nullptr}; pg8::MoeOrder S; S.init((const LAS int*)(F.lds + LDS_MOE), 4, F.G, (int)blockIdx.x);
        pg8::Epi5 E{args.in[I_BDN], (const float*)(ws + WS_RW), ws + WS_YS};
        pg8::gemm_phase<pg8::Epi5, pg8::MoeOrder, true, true>(F.lds, g, S, E, wave0);
    } SEAM(11);
    if (IN(12)) { MKCTX(); moe_table(F); ph_final(F); }
#undef IN
#undef SEAM
}

extern "C" void kernel_launch(void* const* d_in, const int* in_sizes, int n_in, void* d_out, int out_size, void* d_ws, size_t ws_size, hipStream_t stream) {
    static int grid = 0;
    if (grid == 0) {
        if (n_in != 21 || in_sizes[0] != T * DM || out_size != T * DM || ws_size < WS_END) { fprintf(stderr, "kernel_launch: unexpected shapes (n_in %d, in0 %d, out %d, ws %zu)\n", n_in, n_in > 0 ? in_sizes[0] : -1, out_size, ws_size); grid = -1; return; }
        int dev = 0, cus = 0, per_cu = 0;
        hipGetDevice(&dev); hipDeviceGetAttribute(&cus, hipDeviceAttributeMultiprocessorCount, dev);
        const void* fn = MK_COOP ? (const void*)mega<true> : (const void*)mega<false>;
        hipFuncSetAttribute(fn, hipFuncAttributeMaxDynamicSharedMemorySize, LDS_BYTES);
        hipOccupancyMaxActiveBlocksPerMultiprocessor(&per_cu, fn, 512, LDS_BYTES);
        (void)hipGetLastError();
        if (per_cu < 1) { fprintf(stderr, "kernel_launch: occupancy query says %d blocks/CU\n", per_cu); per_cu = 1; }
        grid = cus * 1;
    }
    if (grid < 0) return;
    hipMemsetAsync((char*)d_ws + WS_CTL, 0, CTL_ZERO_BYTES, stream);
    Args a{};
    for (int i = 0; i < 21; ++i) a.in[i] = (const float*)d_in[i];
    a.out = (float*)d_out; a.ws = (unsigned char*)d_ws;
#if MK_COOP
    a.ph_lo = 0; a.ph_hi = NPHASE;
    void* kargs[] = {&a};
    hipError_t e = hipLaunchCooperativeKernel((const void*)mega<true>, dim3(grid), dim3(512), kargs, LDS_BYTES, stream);
    if (e != hipSuccess) fprintf(stderr, "cooperative launch failed: %s (grid %d)\n", hipGetErrorString(e), grid);
#else
    for (int p = 0; p < NPHASE; ++p) { a.ph_lo = p; a.ph_hi = p + 1; hipLaunchKernelGGL(mega<false>, dim3(grid), dim3(512), LDS_BYTES, stream, a); }
#endif
}
```

```cpp
#include <hip/hip_runtime.h>
#include <hip/hip_cooperative_groups.h>
#include <cstdio>
#include <cstdint>
namespace cg = cooperative_groups;

#ifndef MK_COOP
#define MK_COOP 1
#endif

#define LAS __attribute__((address_space(3)))
typedef unsigned short bf16_t;
typedef short bf16x8 __attribute__((ext_vector_type(8)));
typedef float f32x4 __attribute__((ext_vector_type(4)));
typedef float f32x2 __attribute__((ext_vector_type(2)));
typedef unsigned u32x4 __attribute__((ext_vector_type(4)));
typedef unsigned u32x2 __attribute__((ext_vector_type(2)));

constexpr int NB = 8, SEQ = 4096, DM = 1024, T = NB * SEQ;
constexpr int NH = 8, DH = 128, LBLK = 256, NBLK = SEQ / LBLK;
constexpr int NE = 32, TOPK = 4, FF = 1024;
constexpr int INCOLS = 7 * DM;
constexpr int RMAX = T * TOPK + NE * 256;
constexpr float LN_EPS = 1e-5f;
constexpr float ALPHA = 1.189207115002721f;
constexpr float QSCALE = 0.08838834764831845f * 1.4426950408889634f;

constexpr size_t MiB = 1u << 20, U64 = 64 * MiB;
constexpr size_t WS_CTL = 0, CTL_ZERO_BYTES = 1 * MiB;
constexpr int CW_ECNT = 64;
constexpr int CW_LCNT = 1024;
constexpr int CW_BAR = 4096;
constexpr size_t WS_KMEAN = 1 * MiB;
constexpr size_t WS_GVST = 2 * MiB;
constexpr size_t WS_ZST = 6 * MiB;
constexpr size_t WS_SEL = 10 * MiB;
constexpr size_t WS_TKE = 11 * MiB;
constexpr size_t WS_TKW = 11 * MiB + 512 * 1024;
constexpr size_t WS_TKP = 12 * MiB;
constexpr size_t WS_ROWOF = 12 * MiB + 512 * 1024;
constexpr size_t WS_ROWTOK = 13 * MiB;
constexpr size_t WS_ROWW = 14 * MiB;
constexpr size_t WS_TILE = 15 * MiB;
constexpr size_t WS_LISTS = 16 * MiB;
constexpr size_t WS_LSE = 32 * MiB;
constexpr size_t WS_RT = 16 * MiB;
constexpr size_t WS_RW = 20 * MiB;
constexpr int LDS_MOE = 131072 + 1024;
constexpr size_t WS_WIN = 40 * MiB;
constexpr size_t WS_WAB = 54 * MiB;
constexpr size_t WS_WOUT = 58 * MiB;
constexpr size_t WS_WDN = 60 * MiB;
constexpr size_t WS_WUP = 124 * MiB;
constexpr size_t WS_H0 = 4 * U64;
constexpr size_t WS_YAB = 5 * U64;
constexpr size_t WS_GV = 7 * U64;
constexpr size_t WS_Q = 8 * U64, WS_K = 9 * U64, WS_V = 10 * U64, WS_SA = 11 * U64, WS_SB = 12 * U64;
constexpr size_t WS_OP = 13 * U64;
constexpr size_t WS_MG = WS_GV;
constexpr size_t WS_Z = 14 * U64;
constexpr size_t WS_H1 = WS_H0;
constexpr size_t WS_XG = 5 * U64;
constexpr size_t WS_H1F8 = 12 * U64;
constexpr size_t WS_ACT = 9 * U64 + 16 * MiB;
constexpr size_t WS_YS = WS_XG;
constexpr size_t WS_H0F8 = 13 * U64;
constexpr size_t WS_WIN8 = 192 * MiB;
constexpr int PN8_LO = 4, PN8_HI = 28;
constexpr size_t WS_YA8 = 15 * U64;
constexpr size_t WS_END = 16 * U64;
static_assert(WS_XG + (size_t)RMAX * 2048 <= WS_ACT && WS_ACT + (size_t)RMAX * 2048 <= WS_Z, "ws map");

constexpr int LDS_BYTES = 163840;
constexpr int LDS_MISC = 131072;
constexpr int NPHASE = 13;

__device__ __forceinline__ float bf2f(bf16_t v) { return __uint_as_float((unsigned)v << 16); }
__device__ __forceinline__ float bflo(unsigned u) { return __uint_as_float(u << 16); }
__device__ __forceinline__ float bfhi(unsigned u) { return __uint_as_float(u & 0xffff0000u); }
__device__ __forceinline__ unsigned f2bf(float f) { unsigned u = __builtin_bit_cast(unsigned, f); return (u + 0x7fffu + ((u >> 16) & 1u)) >> 16; }
__device__ __forceinline__ unsigned pk2(float lo, float hi) { return f2bf(lo) | (f2bf(hi) << 16); }
typedef __bf16 bf16x2_t __attribute__((ext_vector_type(2)));
__device__ __forceinline__ unsigned cvt_pk_bf16(float lo, float hi) { f32x2 v = {lo, hi}; bf16x2_t b = __builtin_convertvector(v, bf16x2_t); return __builtin_bit_cast(unsigned, b); }
__device__ __forceinline__ int lane_id_asm() { int l; asm volatile("v_mbcnt_lo_u32_b32 %0, -1, 0\n\tv_mbcnt_hi_u32_b32 %0, -1, %0" : "=v"(l)); return l; }
__device__ __forceinline__ float wave_sum(float v) {
#pragma unroll
    for (int o = 1; o < 64; o <<= 1) v += __shfl_xor(v, o);
    return v;
}
__device__ __forceinline__ float wave_max(float v) {
#pragma unroll
    for (int o = 1; o < 64; o <<= 1) v = fmaxf(v, __shfl_xor(v, o));
    return v;
}
__device__ __forceinline__ f32x2 gelu_pk(f32x2 v) {
    const f32x2 av = __builtin_elementwise_abs(v), d = av * 0.2316418882f + 1.0f;
    f32x2 t; t.x = __builtin_amdgcn_rcpf(d.x); t.y = __builtin_amdgcn_rcpf(d.y);
    f32x2 q = t * 0.5307027145f + (-0.7265760135f); q = q * t + 0.7107068705f; q = q * t + (-0.142248368f); q = q * t + 0.127414796f; q = q * t;
    const f32x2 s = (v * v) * (-0.72134752044f);
    f32x2 e; e.x = __builtin_amdgcn_exp2f(s.x); e.y = __builtin_amdgcn_exp2f(s.y);
    const f32x2 m = v * (q * e), r = v - m;
    f32x2 o; o.x = v.x < 0.f ? m.x : r.x; o.y = v.y < 0.f ? m.y : r.y; return o;
}
typedef float f32x2v __attribute__((ext_vector_type(2)));
template <bool HI> __device__ __forceinline__ unsigned f8x2_to_bf16x2(unsigned w) { const f32x2v f = __builtin_amdgcn_cvt_pk_f32_fp8((int)w, HI); return cvt_pk_bf16(f.x, f.y); }
__device__ __forceinline__ u32x4 f8x8_to_bf16x8(unsigned lo, unsigned hi) { return (u32x4){f8x2_to_bf16x2<false>(lo), f8x2_to_bf16x2<true>(lo), f8x2_to_bf16x2<false>(hi), f8x2_to_bf16x2<true>(hi)}; }
__device__ __forceinline__ unsigned pack_fp8x4(float a, float b, float c, float d) { unsigned w = 0u; w = __builtin_amdgcn_cvt_pk_fp8_f32(a, b, w, false); w = __builtin_amdgcn_cvt_pk_fp8_f32(c, d, w, true); return w; }
__device__ __forceinline__ float sigmoidf_(float x) { return __builtin_amdgcn_rcpf(1.0f + __builtin_amdgcn_exp2f(-1.4426950408889634f * x)); }

namespace pg8 {
constexpr int BM = 256, BK = 64, HALF = 128, HTB = HALF * BK * 2, STAGE_BYTES = 8 * HTB, NXCD = 8, WGM = 4;
__host__ __device__ __forceinline__ int lds_byte(int r, int c) { const int st = (r >> 4) * 2 + (c >> 5), rr = r & 15, cc = c & 31, ob = rr * 64 + cc * 2; return st * 1024 + (ob ^ (((ob >> 9) & 1) << 5)); }
__host__ __device__ __forceinline__ void stage_rc(int b, int& R, int& C) { const int st = b / 1024, sb = b % 1024, swz = sb ^ (((sb >> 9) & 1) << 5); R = (st >> 1) * 16 + swz / 64; C = (st & 1) * 32 + (swz % 64) / 2; }
__host__ __device__ __forceinline__ int perm32(int rho) { const int n = rho >> 4, i = rho & 15; return 8 * (i >> 2) + 4 * n + (i & 3); }

struct Unit { int pm, pn, bt, rbase; };
struct Gemm { const bf16_t* A; const bf16_t* Bt; int K, lda, ldb; const int* rowidx; };

struct StaticOrder {
    int nM, nN, nwg, G, c, pbase, psplit, pjump;
    __device__ void init(int M, int N, int G_, int c_, int pbase_ = 0, int psplit_ = 1 << 20, int pjump_ = 0) { nM = M / BM; nN = N / BM; nwg = nM * nN; G = G_; c = c_; pbase = pbase_; psplit = psplit_; pjump = pjump_; }
    __device__ bool next(int i, Unit& u) const {
        const long L = (long)i * G + c; if (L >= nwg) return false;
        int wgid = (int)L; { const int q = nwg / NXCD, r = nwg % NXCD, xcd = wgid % NXCD, off = wgid / NXCD; wgid = (xcd < r ? xcd * (q + 1) : r * (q + 1) + (xcd - r) * q) + off; }
        const int nig = WGM * nN, gid = wgid / nig, fm = gid * WGM, gsz = (nM - fm) < WGM ? (nM - fm) : WGM;
        u.pm = fm + ((wgid % nig) % gsz); const int p = (wgid % nig) / gsz; u.pn = pbase + (p < psplit ? p : p + pjump); u.bt = u.pn; u.rbase = u.pm * BM; return true;
    }
};
struct MoeOrder {
    int nM, nN, nwg, G, c; const LAS int* tab;
    __device__ void init(const LAS int* tiletab, int nN_, int G_, int c_) { nM = tiletab[0]; tab = tiletab; nN = nN_; nwg = nM * nN; G = G_; c = c_; }
    __device__ bool next(int i, Unit& u) const {
        const long L = (long)i * G + c; if (L >= nwg) return false;
        int wgid = (int)L; { const int q = nwg / NXCD, r = nwg % NXCD, xcd = wgid % NXCD, off = wgid / NXCD; wgid = (xcd < r ? xcd * (q + 1) : r * (q + 1) + (xcd - r) * q) + off; }
        const int nig = WGM * nN, gid = wgid / nig, fm = gid * WGM, gsz = (nM - fm) < WGM ? (nM - fm) : WGM;
        u.pm = fm + ((wgid % nig) % gsz); u.pn = (wgid % nig) / gsz; { const int e = tab[128 + 2 * u.pm], tl = tab[129 + 2 * u.pm]; u.bt = e * nN + u.pn; u.rbase = e * T + tl * BM; } return true;
    }
};

typedef int v4i_t __attribute__((ext_vector_type(4)));
typedef int v8i_t __attribute__((ext_vector_type(8)));
template <class Epi, class Sched, bool ALIGN_EPI, bool FP8 = false, bool GATHER = false>
__device__ __forceinline__ void gemm_phase(LAS unsigned char* lds, const Gemm g, const Sched& S, const Epi& E, const int wid) {
    const int lane = lane_id_asm(), tid = wid * 64 + lane;
    const int wr = wid >> 2, wc = wid & 3, fr = lane & 15, fq = lane >> 4;
    const int nt = g.K / BK;
    unsigned voffA[2], voffB[2]; int gR[2];
#pragma unroll
    for (int i = 0; i < 2; ++i) { int R, C; stage_rc(tid * 16 + i * 8192, R, C); const int Rb = Epi::PERM ? ((R & ~31) + perm32(R & 31)) : R;
        voffA[i] = GATHER ? (unsigned)C * 2u : (unsigned)(R * g.lda + C) * 2u; voffB[i] = (unsigned)(Rb * g.ldb + C) * 2u; gR[i] = R; }
    const size_t kstep = (size_t)(BK * 2);
    const size_t hstepA = GATHER ? 0 : (size_t)HALF * g.lda * 2, hstepB = (size_t)HALF * g.ldb * 2;
    const size_t tstepA = 2 * hstepA, tstepB = 2 * hstepB;
    const unsigned ldsw = (unsigned)wid * 1024u;
    const int aoff = lds_byte(wr * 64 + fr, fq * 8), boff = lds_byte(wc * 32 + fr, fq * 8);
#define PG8_SA(b, h) (((b) * 2 + (h)) * HTB)
#define PG8_SB(b, h) ((4 + (b) * 2 + (h)) * HTB)
#define PG8_STAGE(bufoff, gbase, voff) do { _Pragma("unroll") for (int _i = 0; _i < 2; ++_i) \
        __builtin_amdgcn_global_load_lds((const unsigned*)((const char*)(gbase) + (voff)[_i]), (LAS unsigned*)(lds + (bufoff) + ldsw + _i * 8192), 16, 0, 0); } while (0)
#define PG8_LD8(p) __builtin_shufflevector(*(const LAS v4i_t*)(p), *(const LAS v4i_t*)((p) + 1024), 0, 1, 2, 3, 4, 5, 6, 7)
#define PG8_LDA(dst, b, h) do { _Pragma("unroll") for (int m = 0; m < 4; ++m) { if constexpr (FP8) dst##8[m] = PG8_LD8(lds + PG8_SA(b, h) + aoff + m * 2048); \
        else { _Pragma("unroll") for (int k = 0; k < 2; ++k) dst[m][k] = *(const LAS bf16x8*)(lds + PG8_SA(b, h) + aoff + m * 2048 + k * 1024); } } } while (0)
#define PG8_LDB(dst, b, h) do { _Pragma("unroll") for (int n = 0; n < 2; ++n) { if constexpr (FP8) dst##8[n] = PG8_LD8(lds + PG8_SB(b, h) + boff + n * 2048); \
        else { _Pragma("unroll") for (int k = 0; k < 2; ++k) dst[n][k] = *(const LAS bf16x8*)(lds + PG8_SB(b, h) + boff + n * 2048 + k * 1024); } } } while (0)
#define PG8_MMA(ai, bj, At, Bt) do { __builtin_amdgcn_s_setprio(1); _Pragma("unroll") for (int m = 0; m < 4; ++m) _Pragma("unroll") for (int n = 0; n < 2; ++n) { \
        if constexpr (FP8) { asm volatile("s_nop 1\n\tv_mfma_scale_f32_16x16x128_f8f6f4 %0, %1, %2, %0, %3, %3 op_sel_hi:[0,0,0]" : "+v"(acc[ai][bj][m][n]) : "v"(Bt##8[n]), "v"(At##8[m]), "v"(scl8)); } \
        else { _Pragma("unroll") for (int k = 0; k < 2; ++k) acc[ai][bj][m][n] = __builtin_amdgcn_mfma_f32_16x16x32_bf16(Bt[n][k], At[m][k], acc[ai][bj][m][n], 0, 0, 0); } } \
        __builtin_amdgcn_s_setprio(0); } while (0)
#define PG8_WAIT_V(n) asm volatile("s_waitcnt vmcnt(" #n ")" ::: "memory")
#define PG8_WAIT_L(n) asm volatile("s_waitcnt lgkmcnt(" #n ")" ::: "memory")
#define PG8_BAR __builtin_amdgcn_s_barrier()
#define PG8_SCHED __builtin_amdgcn_sched_barrier(0)
    Unit cur, nxt; int ui = 0;
    if (!S.next(0, cur)) return;
    unsigned va0[2], va1[2], vn0[2], vn1[2];
#define PG8_GIDX(dst0, dst1, u) do { if constexpr (GATHER) { _Pragma("unroll") for (int _i = 0; _i < 2; ++_i) { \
        dst0[_i] = min((unsigned)g.rowidx[(u).rbase + gR[_i]], (unsigned)(T - 1)) * (unsigned)(g.lda * 2) + voffA[_i]; dst1[_i] = min((unsigned)g.rowidx[(u).rbase + HALF + gR[_i]], (unsigned)(T - 1)) * (unsigned)(g.lda * 2) + voffA[_i]; } } \
        else { _Pragma("unroll") for (int _i = 0; _i < 2; ++_i) { dst0[_i] = voffA[_i]; dst1[_i] = voffA[_i]; } } } while (0)
    PG8_GIDX(va0, va1, cur);
    f32x4 acc[2][2][4][2];
#pragma unroll
    for (int a = 0; a < 2; ++a)
#pragma unroll
        for (int b = 0; b < 2; ++b)
#pragma unroll
            for (int m = 0; m < 4; ++m)
#pragma unroll
                for (int n = 0; n < 2; ++n) acc[a][b][m][n] = (f32x4){0.f, 0.f, 0.f, 0.f};
    bf16x8 At[4][2], B0[2][2], B1[2][2]; v8i_t At8[4], B08[2], B18[2];
    int scl8 = 0x7f7f7f7f; asm volatile("" : "+v"(scl8));
    const char* cA = (const char*)g.A + (GATHER ? 0 : (size_t)cur.pm * tstepA); const char* cB = (const char*)g.Bt + (size_t)cur.bt * tstepB;
    PG8_STAGE(PG8_SB(0, 0), cB, voffB); PG8_STAGE(PG8_SB(0, 1), cB + hstepB, voffB); PG8_STAGE(PG8_SA(0, 0), cA, va0); PG8_STAGE(PG8_SA(0, 1), cA + hstepA, va1);
    if (wr == 1) PG8_BAR;
    PG8_WAIT_V(2); PG8_BAR;
    PG8_STAGE(PG8_SB(1, 0), cB + kstep, voffB); PG8_STAGE(PG8_SA(1, 0), cA + kstep, va0); PG8_STAGE(PG8_SB(1, 1), cB + hstepB + kstep, voffB);
    PG8_WAIT_V(6); PG8_BAR;
    for (;;) {
        const bool has_next = S.next(ui + 1, nxt);
        const char* nA = (has_next && !GATHER) ? (const char*)g.A + (size_t)nxt.pm * tstepA : cA; const char* nB = has_next ? (const char*)g.Bt + (size_t)nxt.bt * tstepB : cB;
        if (has_next) PG8_GIDX(vn0, vn1, nxt); else { _Pragma("unroll") for (int _i = 0; _i < 2; ++_i) { vn0[_i] = va0[_i]; vn1[_i] = va1[_i]; } }
#pragma unroll 1
        for (int t = 0; t < nt; t += 2) {
            const bool last = (t == nt - 2);
            const char* a1 = cA + (size_t)(t + 1) * kstep;
            const char* a2 = last ? nA : cA + (size_t)(t + 2) * kstep; const char* b2 = last ? nB : cB + (size_t)(t + 2) * kstep;
            const char* a3 = a2 + kstep; const char* b3 = b2 + kstep;
            if constexpr (Epi::MID_T > 0) { if (t == Epi::MID_T) {
                if constexpr (FP8) {
#pragma unroll
                    for (int a = 0; a < 2; ++a)
#pragma unroll
                        for (int b = 0; b < 2; ++b)
                            asm volatile("s_nop 15\n\ts_nop 7" : "+v"(acc[a][b][0][0]), "+v"(acc[a][b][0][1]), "+v"(acc[a][b][1][0]), "+v"(acc[a][b][1][1]), "+v"(acc[a][b][2][0]), "+v"(acc[a][b][2][1]), "+v"(acc[a][b][3][0]), "+v"(acc[a][b][3][1]));
                }
                E.mid(acc, cur, wr, wc, fr, fq); } }
            unsigned vs0[2], vs1[2];
#pragma unroll
            for (int _i = 0; _i < 2; ++_i) { vs0[_i] = last ? vn0[_i] : va0[_i]; vs1[_i] = last ? vn1[_i] : va1[_i]; }
            PG8_LDB(B0, 0, 0); PG8_LDB(B1, 0, 1); PG8_SCHED; PG8_LDA(At, 0, 0); PG8_STAGE(PG8_SA(1, 1), a1 + hstepA, va1);
            PG8_WAIT_V(8); PG8_WAIT_L(0); PG8_BAR; PG8_MMA(0, 0, At, B0); PG8_MMA(0, 1, At, B1); PG8_BAR; PG8_SCHED;
            PG8_LDA(At, 0, 1); PG8_STAGE(PG8_SB(0, 0), b2, voffB); PG8_STAGE(PG8_SB(0, 1), b2 + hstepB, voffB); PG8_STAGE(PG8_SA(0, 0), a2, vs0);
            PG8_WAIT_V(8); PG8_WAIT_L(0); PG8_BAR; PG8_MMA(1, 0, At, B0); PG8_MMA(1, 1, At, B1); PG8_BAR; PG8_SCHED;
            PG8_LDB(B0, 1, 0); PG8_LDB(B1, 1, 1); PG8_SCHED; PG8_LDA(At, 1, 0); PG8_STAGE(PG8_SA(0, 1), a2 + hstepA, vs1);
            PG8_WAIT_V(8); PG8_WAIT_L(0); PG8_BAR; PG8_MMA(0, 0, At, B0); PG8_MMA(0, 1, At, B1); PG8_BAR; PG8_SCHED;
            PG8_LDA(At, 1, 1); PG8_STAGE(PG8_SB(1, 0), b3, voffB); PG8_STAGE(PG8_SB(1, 1), b3 + hstepB, voffB); PG8_STAGE(PG8_SA(1, 0), a3, vs0);
            PG8_WAIT_V(8); PG8_WAIT_L(0); PG8_BAR; PG8_MMA(1, 0, At, B0); PG8_MMA(1, 1, At, B1); PG8_BAR; PG8_SCHED;
        }
        if constexpr (ALIGN_EPI) { if (wr == 0) PG8_BAR; }
        if constexpr (FP8) {
#pragma unroll
            for (int a = 0; a < 2; ++a)
#pragma unroll
                for (int b = 0; b < 2; ++b)
                    asm volatile("s_nop 15\n\ts_nop 7" : "+v"(acc[a][b][0][0]), "+v"(acc[a][b][0][1]), "+v"(acc[a][b][1][0]), "+v"(acc[a][b][1][1]), "+v"(acc[a][b][2][0]), "+v"(acc[a][b][2][1]), "+v"(acc[a][b][3][0]), "+v"(acc[a][b][3][1]));
        }
        E(acc, cur, wr, wc, fr, fq);
        if (!has_next) break;
#pragma unroll
        for (int a = 0; a < 2; ++a)
#pragma unroll
            for (int b = 0; b < 2; ++b)
#pragma unroll
                for (int m = 0; m < 4; ++m)
#pragma unroll
                    for (int n = 0; n < 2; ++n) acc[a][b][m][n] = (f32x4){0.f, 0.f, 0.f, 0.f};
        cur = nxt; cA = nA; cB = nB; ++ui;
#pragma unroll
        for (int _i = 0; _i < 2; ++_i) { va0[_i] = vn0[_i]; va1[_i] = vn1[_i]; }
        if constexpr (ALIGN_EPI) { if (wr == 1) PG8_BAR; }
    }
    PG8_WAIT_V(0);
    if constexpr (!ALIGN_EPI) { if (wr == 0) PG8_BAR; }
    PG8_BAR;
#undef PG8_SA
#undef PG8_SB
#undef PG8_STAGE
#undef PG8_GIDX
#undef PG8_LDA
#undef PG8_LDB
#undef PG8_MMA
#undef PG8_LD8
#undef PG8_WAIT_V
#undef PG8_WAIT_L
#undef PG8_BAR
#undef PG8_SCHED
}

typedef f32x4 Acc[2][2][4][2];

__device__ __forceinline__ u32x4 pair16(u32x2 x, u32x2 y) {
    const auto r0 = __builtin_amdgcn_permlane16_swap(x.x, y.x, false, false);
    const auto r1 = __builtin_amdgcn_permlane16_swap(x.y, y.y, false, false);
    return (u32x4){r0[0], r1[0], r0[1], r1[1]};
}
struct Epi1 {
    static constexpr bool PERM = true; static constexpr int MID_T = 0;
    bf16_t *yab, *gv; unsigned char *q, *k, *v; bf16_t *sa, *sb; float* gvst; float* kmp; float sc, pad_;
    template <int MODE  >
    __device__ __forceinline__ void run(const Acc& acc, const Unit& u, int wr, int wc, int fr, int fq, bf16_t* base, int ld) const {
        const int row0 = u.pm * BM + wr * 64 + fr, col0 = (u.pn & 3) * 256 + wc * 32 + 8 * fq;
        const int colp = (u.pn & 3) * 256 + wc * 32 + 8 * (fq & ~1);
        f32x4 csA0 = {0.f, 0.f, 0.f, 0.f}, csB0 = csA0, csA1 = csA0, csB1 = csA0;
#pragma unroll
        for (int ai = 0; ai < 2; ++ai)
#pragma unroll
            for (int mp = 0; mp < 2; ++mp) {
                u32x2 pc[2][2];
#pragma unroll
                for (int k = 0; k < 2; ++k) {
                    const int m = 2 * mp + k;
                    const int row = row0 + ai * HALF + m * 16; bf16_t* rowp = base + (size_t)row * ld + col0;
                    float s1 = 0.f, s2 = 0.f;
#pragma unroll
                    for (int bj = 0; bj < 2; ++bj) {
                        f32x4 v0 = acc[ai][bj][m][0], v1 = acc[ai][bj][m][1];
                        if (MODE == 2 || MODE == 3 || MODE == 5) {
                            const float f = (MODE == 2) ? sc * QSCALE : sc; v0 = v0 * f; v1 = v1 * f;
                            if (MODE == 5) { if (bj == 0) { csA0 = csA0 + v0; csB0 = csB0 + v1; } else { csA1 = csA1 + v0; csB1 = csB1 + v1; } }
                            pc[bj][k] = (u32x2){pack_fp8x4(v0[0], v0[1], v0[2], v0[3]), pack_fp8x4(v1[0], v1[1], v1[2], v1[3])};
                            continue;
                        }
                        if (MODE == 0 || MODE == 1) {
                            v0 = v0 * sc; v1 = v1 * sc;
                            f32x2 a = gelu_pk((f32x2){v0[0], v0[1]}), b = gelu_pk((f32x2){v0[2], v0[3]}), c = gelu_pk((f32x2){v1[0], v1[1]}), d = gelu_pk((f32x2){v1[2], v1[3]});
                            v0 = (f32x4){a.x, a.y, b.x, b.y}; v1 = (f32x4){c.x, c.y, d.x, d.y};
                        } else if (MODE == 4) {
                            { const float cs_ = -1.4426950408889634f * sc; const f32x4 t0 = v0 * cs_, t1 = v1 * cs_; f32x4 e0, e1;
#pragma unroll
                              for (int j = 0; j < 4; ++j) { e0[j] = __builtin_amdgcn_exp2f(t0[j]); e1[j] = __builtin_amdgcn_exp2f(t1[j]); }
                              e0 = e0 + 1.0f; e1 = e1 + 1.0f;
#pragma unroll
                              for (int j = 0; j < 4; ++j) { v0[j] = __builtin_amdgcn_rcpf(e0[j]); v1[j] = __builtin_amdgcn_rcpf(e1[j]); } }
                            pc[bj][k] = (u32x2){pack_fp8x4(v0[0], v0[1], v0[2], v0[3]), pack_fp8x4(v1[0], v1[1], v1[2], v1[3])};
                            continue;
                        }
                        if (MODE == 1) {
                            s1 += (v0[0] + v0[1]) + (v0[2] + v0[3]) + (v1[0] + v1[1]) + (v1[2] + v1[3]);
                            s2 += (v0[0] * v0[0] + v0[1] * v0[1]) + (v0[2] * v0[2] + v0[3] * v0[3]) + (v1[0] * v1[0] + v1[1] * v1[1]) + (v1[2] * v1[2] + v1[3] * v1[3]);
                            pc[bj][k] = (u32x2){pack_fp8x4(v0[0], v0[1], v0[2], v0[3]), pack_fp8x4(v1[0], v1[1], v1[2], v1[3])};
                            continue;
                        }
                        u32x4 w; w.x = cvt_pk_bf16(v0[0], v0[1]); w.y = cvt_pk_bf16(v0[2], v0[3]); w.z = cvt_pk_bf16(v1[0], v1[1]); w.w = cvt_pk_bf16(v1[2], v1[3]);
                        *(u32x4*)(rowp + bj * HALF) = w;
                    }
                    if (MODE == 1) {
                        s1 += __shfl_xor(s1, 16); s1 += __shfl_xor(s1, 32); s2 += __shfl_xor(s2, 16); s2 += __shfl_xor(s2, 32);
                        if (fq == 0) *(f32x2*)(gvst + ((size_t)row * 16 + (u.pn & 3) * 4 + wc) * 2) = (f32x2){s1, s2};
                    }
                }
                if (MODE != 0) {
                    const int rowst = row0 + ai * HALF + (2 * mp + (fq & 1)) * 16;
#pragma unroll
                    for (int bj = 0; bj < 2; ++bj) *(u32x4*)((unsigned char*)base + (size_t)rowst * 1024 + colp + bj * HALF) = pair16(pc[bj][0], pc[bj][1]);
                }
            }
        if (MODE == 5) {
#define KM_RED(v) do { _Pragma("unroll") for (int j_ = 0; j_ < 4; ++j_) { float x = v[j_]; x += __shfl_xor(x, 1); x += __shfl_xor(x, 2); x += __shfl_xor(x, 4); x += __shfl_xor(x, 8); v[j_] = x; } } while (0)
            KM_RED(csA0); KM_RED(csB0); KM_RED(csA1); KM_RED(csB1);
#undef KM_RED
            if (fr == 0) {
                float* kp = kmp + ((size_t)(u.pm * 2 + wr) * DM) + col0;
                *(f32x4*)kp = csA0; *(f32x4*)(kp + 4) = csB0; *(f32x4*)(kp + HALF) = csA1; *(f32x4*)(kp + HALF + 4) = csB1;
            }
        }
    }
    __device__ __forceinline__ void operator()(const Acc& acc, const Unit& u, int wr, int wc, int fr, int fq) const {
        const int region = u.pn >> 2;
        if (region == 0) run<0>(acc, u, wr, wc, fr, fq, yab, 2048);
        else if (region == 1) run<1>(acc, u, wr, wc, fr, fq, gv, 1024);
        else if (region == 2) run<2>(acc, u, wr, wc, fr, fq, (bf16_t*)q, 1024);
        else if (region == 3) run<5>(acc, u, wr, wc, fr, fq, (bf16_t*)k, 1024);
        else if (region == 4) run<3>(acc, u, wr, wc, fr, fq, (bf16_t*)v, 1024);
        else if (region == 5) run<4>(acc, u, wr, wc, fr, fq, sa, 1024);
        else run<4>(acc, u, wr, wc, fr, fq, sb, 1024);
    }
    __device__ __forceinline__ void mid(Acc&, const Unit&, int, int, int, int) const {}
};

struct Epi2 {
    static constexpr bool PERM = true; static constexpr int MID_T = 8;
    const unsigned char *sa, *sb; bf16_t* mg;
    __device__ __forceinline__ void mid(Acc& acc, const Unit& u, int wr, int wc, int fr, int fq) const {
        int row0 = u.pm * BM + wr * 64 + fr, col0 = u.pn * BM + wc * 32 + 8 * fq;
        asm volatile("" : "+v"(row0), "+v"(col0));
#pragma unroll
        for (int ai = 0; ai < 2; ++ai) {
            u32x2 av[4][2], bv[4][2];
#pragma unroll
            for (int m = 0; m < 4; ++m)
#pragma unroll
                for (int bj = 0; bj < 2; ++bj) { const size_t off = (size_t)(row0 + ai * HALF + m * 16) * DM + col0 + bj * HALF; av[m][bj] = *(const u32x2*)(sa + off); bv[m][bj] = *(const u32x2*)(sb + off); }
            asm volatile("" ::: "memory");
#pragma unroll
            for (int m = 0; m < 4; ++m) {
#pragma unroll
                for (int bj = 0; bj < 2; ++bj) {
                    const u32x2 a = av[m][bj], b = bv[m][bj];
                    const f32x2v a0 = __builtin_amdgcn_cvt_pk_f32_fp8((int)a.x, false), a1 = __builtin_amdgcn_cvt_pk_f32_fp8((int)a.x, true), a2 = __builtin_amdgcn_cvt_pk_f32_fp8((int)a.y, false), a3 = __builtin_amdgcn_cvt_pk_f32_fp8((int)a.y, true);
                    const f32x2v b0 = __builtin_amdgcn_cvt_pk_f32_fp8((int)b.x, false), b1 = __builtin_amdgcn_cvt_pk_f32_fp8((int)b.x, true), b2 = __builtin_amdgcn_cvt_pk_f32_fp8((int)b.y, false), b3 = __builtin_amdgcn_cvt_pk_f32_fp8((int)b.y, true);
                    f32x4 r0, r1;
#define RQ(x, y) ((x) * __builtin_amdgcn_rcpf(y))
                    r0[0] = RQ(a0.x, b0.x); r0[1] = RQ(a0.y, b0.y); r0[2] = RQ(a1.x, b1.x); r0[3] = RQ(a1.y, b1.y);
                    r1[0] = RQ(a2.x, b2.x); r1[1] = RQ(a2.y, b2.y); r1[2] = RQ(a3.x, b3.x); r1[3] = RQ(a3.y, b3.y);
#undef RQ
                    acc[ai][bj][m][0] = acc[ai][bj][m][0] * r0; acc[ai][bj][m][1] = acc[ai][bj][m][1] * r1;
                }
                asm volatile("" : "+v"(acc[ai][0][m][0]), "+v"(acc[ai][0][m][1]), "+v"(acc[ai][1][m][0]), "+v"(acc[ai][1][m][1]));
            }
            asm volatile("" ::: "memory");
        }
    }
    __device__ __forceinline__ void operator()(const Acc& acc, const Unit& u, int wr, int wc, int fr, int fq) const {
        const int row0 = u.pm * BM + wr * 64 + fr, col0 = u.pn * BM + wc * 32 + 8 * fq;
#pragma unroll
        for (int ai = 0; ai < 2; ++ai) {
            u32x2 bv[4][2];
#pragma unroll
            for (int m = 0; m < 4; ++m)
#pragma unroll
                for (int bj = 0; bj < 2; ++bj) bv[m][bj] = *(const u32x2*)(sb + (size_t)(row0 + ai * HALF + m * 16) * DM + col0 + bj * HALF);
            asm volatile("" ::: "memory");
#pragma unroll
            for (int m = 0; m < 4; ++m) {
                const size_t off = (size_t)(row0 + ai * HALF + m * 16) * DM + col0;
#pragma unroll
                for (int bj = 0; bj < 2; ++bj) {
                    const u32x2 b = bv[m][bj];
                    const f32x2v b0 = __builtin_amdgcn_cvt_pk_f32_fp8((int)b.x, false), b1 = __builtin_amdgcn_cvt_pk_f32_fp8((int)b.x, true), b2 = __builtin_amdgcn_cvt_pk_f32_fp8((int)b.y, false), b3 = __builtin_amdgcn_cvt_pk_f32_fp8((int)b.y, true);
                    const f32x4 v0 = acc[ai][bj][m][0] * 0.03125f, v1 = acc[ai][bj][m][1] * 0.03125f;
                    u32x4 w; w.x = cvt_pk_bf16(v0[0] * b0.x, v0[1] * b0.y); w.y = cvt_pk_bf16(v0[2] * b1.x, v0[3] * b1.y);
                    w.z = cvt_pk_bf16(v1[0] * b2.x, v1[1] * b2.y); w.w = cvt_pk_bf16(v1[2] * b3.x, v1[3] * b3.y);
                    *(u32x4*)(mg + off + bj * HALF) = w;
                }
            }
        }
    }
};

struct Epi3 {
    static constexpr bool PERM = true; static constexpr int MID_T = 0;
    const bf16_t* h0; bf16_t* z; float* zst;
    __device__ __forceinline__ void mid(Acc&, const Unit&, int, int, int, int) const {}
    __device__ __forceinline__ void operator()(const Acc& acc, const Unit& u, int wr, int wc, int fr, int fq) const {
        const int row0 = u.pm * BM + wr * 64 + fr, col0 = u.pn * BM + wc * 32 + 8 * fq;
#pragma unroll
        for (int ai = 0; ai < 2; ++ai) {
            u32x4 hbv[4][2];
#pragma unroll
            for (int m = 0; m < 4; ++m)
#pragma unroll
                for (int bj = 0; bj < 2; ++bj) hbv[m][bj] = *(const u32x4*)(h0 + (size_t)(row0 + ai * HALF + m * 16) * DM + col0 + bj * HALF);
            asm volatile("" ::: "memory");
#pragma unroll
            for (int m = 0; m < 4; ++m) {
                const int row = row0 + ai * HALF + m * 16; const size_t off = (size_t)row * DM + col0;
                float s1 = 0.f, s2 = 0.f;
#pragma unroll
                for (int bj = 0; bj < 2; ++bj) {
                    const u32x4 hb = hbv[m][bj];
                    f32x4 v0 = acc[ai][bj][m][0], v1 = acc[ai][bj][m][1];
                    v0[0] += ALPHA * bflo(hb.x); v0[1] += ALPHA * bfhi(hb.x); v0[2] += ALPHA * bflo(hb.y); v0[3] += ALPHA * bfhi(hb.y);
                    v1[0] += ALPHA * bflo(hb.z); v1[1] += ALPHA * bfhi(hb.z); v1[2] += ALPHA * bflo(hb.w); v1[3] += ALPHA * bfhi(hb.w);
                    s1 += ((v0[0] + v0[1]) + (v0[2] + v0[3])) + ((v1[0] + v1[1]) + (v1[2] + v1[3]));
                    s2 += ((v0[0] * v0[0] + v0[1] * v0[1]) + (v0[2] * v0[2] + v0[3] * v0[3])) + ((v1[0] * v1[0] + v1[1] * v1[1]) + (v1[2] * v1[2] + v1[3] * v1[3]));
                    *(u32x4*)(z + off + bj * HALF) = (u32x4){cvt_pk_bf16(v0[0], v0[1]), cvt_pk_bf16(v0[2], v0[3]), cvt_pk_bf16(v1[0], v1[1]), cvt_pk_bf16(v1[2], v1[3])};
                }
                s1 += __shfl_xor(s1, 16); s1 += __shfl_xor(s1, 32); s2 += __shfl_xor(s2, 16); s2 += __shfl_xor(s2, 32);
                if (fq == 0) *(f32x2*)(zst + ((size_t)row * 16 + u.pn * 4 + wc) * 2) = (f32x2){s1, s2};
            }
        }
    }
};

struct Epi4 {
    static constexpr bool PERM = true; static constexpr int MID_T = 0;
    const float* b_up; unsigned char* act;
    __device__ __forceinline__ void mid(Acc&, const Unit&, int, int, int, int) const {}
    __device__ __forceinline__ void operator()(const Acc& acc, const Unit& u, int wr, int wc, int fr, int fq) const {
        const int e = u.bt >> 3;
        const int row0 = u.pm * BM + wr * 64 + fr, c0 = u.pn * HALF + wc * 32 + 8 * fq;
        const float* bg = b_up + (size_t)e * 2 * FF + c0; const float* bu = bg + FF;
        const f32x4 bg0 = *(const f32x4*)bg, bg1 = *(const f32x4*)(bg + 4), bu0 = *(const f32x4*)bu, bu1 = *(const f32x4*)(bu + 4);
        const int cp = u.pn * HALF + wc * 32 + 8 * (fq & ~1);
#pragma unroll
        for (int ai = 0; ai < 2; ++ai)
#pragma unroll
            for (int mp = 0; mp < 2; ++mp) {
                u32x2 pc[2];
#pragma unroll
                for (int k = 0; k < 2; ++k) {
                    const int m = 2 * mp + k;
                    float o[8];
#pragma unroll
                    for (int n = 0; n < 2; ++n)
#pragma unroll
                        for (int jp = 0; jp < 2; ++jp) {
                            const int j = 2 * jp;
                            const f32x2 ag = {acc[ai][0][m][n][j], acc[ai][0][m][n][j + 1]}, au = {acc[ai][1][m][n][j], acc[ai][1][m][n][j + 1]};
                            const f32x2 vbg = n ? (f32x2){bg1[j], bg1[j + 1]} : (f32x2){bg0[j], bg0[j + 1]}, vbu = n ? (f32x2){bu1[j], bu1[j + 1]} : (f32x2){bu0[j], bu0[j + 1]};
                            f32x2 gg = ag * 0.03125f + vbg, uu = au * 0.03125f + vbu;
                            gg.x = fminf(gg.x, 7.0f); gg.y = fminf(gg.y, 7.0f);
                            uu.x = __builtin_amdgcn_fmed3f(uu.x, -7.0f, 7.0f); uu.y = __builtin_amdgcn_fmed3f(uu.y, -7.0f, 7.0f);
                            const f32x2 t = gg * (-1.702f * 1.4426950408889634f);
                            f32x2 ex; ex.x = __builtin_amdgcn_exp2f(t.x); ex.y = __builtin_amdgcn_exp2f(t.y);
                            const f32x2 d = ex + 1.0f;
                            f32x2 rc; rc.x = __builtin_amdgcn_rcpf(d.x); rc.y = __builtin_amdgcn_rcpf(d.y);
                            const f32x2 res = (uu + 1.0f) * (gg * rc);
                            o[n * 4 + j] = res.x; o[n * 4 + j + 1] = res.y;
                        }
                    unsigned w0 = 0u, w1 = 0u;
                    w0 = __builtin_amdgcn_cvt_pk_fp8_f32(o[0], o[1], w0, false); w0 = __builtin_amdgcn_cvt_pk_fp8_f32(o[2], o[3], w0, true);
                    w1 = __builtin_amdgcn_cvt_pk_fp8_f32(o[4], o[5], w1, false); w1 = __builtin_amdgcn_cvt_pk_fp8_f32(o[6], o[7], w1, true);
                    pc[k] = (u32x2){w0, w1};
                }
                const int rowst = row0 + ai * HALF + (2 * mp + (fq & 1)) * 16;
                *(u32x4*)(act + (size_t)rowst * FF + cp) = pair16(pc[0], pc[1]);
            }
    }
};

struct Epi5 {
    static constexpr bool PERM = true; static constexpr int MID_T = 0;
    const float* b_down; const float* roww; unsigned char* ys;
    __device__ __forceinline__ void mid(Acc&, const Unit&, int, int, int, int) const {}
    __device__ __forceinline__ void operator()(const Acc& acc, const Unit& u, int wr, int wc, int fr, int fq) const {
        const int e = u.bt >> 2;
        const int row0 = u.pm * BM + wr * 64 + fr, col0 = u.pn * BM + wc * 32 + 8 * fq;
        f32x4 bv[2][2];
#pragma unroll
        for (int bj = 0; bj < 2; ++bj)
#pragma unroll
            for (int n = 0; n < 2; ++n) bv[bj][n] = *(const f32x4*)(b_down + (size_t)e * DM + col0 + bj * HALF + 4 * n);
        float rwv[2][4];
#pragma unroll
        for (int ai = 0; ai < 2; ++ai)
#pragma unroll
            for (int m = 0; m < 4; ++m) rwv[ai][m] = roww[u.rbase + wr * 64 + fr + ai * HALF + m * 16];
        asm volatile("" ::: "memory");
        const int colp = u.pn * BM + wc * 32 + 8 * (fq & ~1);
#pragma unroll
        for (int ai = 0; ai < 2; ++ai)
#pragma unroll
            for (int mp = 0; mp < 2; ++mp) {
                const int rowst = row0 + ai * HALF + (2 * mp + (fq & 1)) * 16;
#pragma unroll
                for (int bj = 0; bj < 2; ++bj) {
                    u32x2 pc[2];
#pragma unroll
                    for (int k = 0; k < 2; ++k) { const int m = 2 * mp + k; const float rw16 = rwv[ai][m] * 16.0f;
                        const f32x4 v0 = (acc[ai][bj][m][0] * 0.015625f + bv[bj][0]) * rw16, v1 = (acc[ai][bj][m][1] * 0.015625f + bv[bj][1]) * rw16;
                        pc[k] = (u32x2){pack_fp8x4(v0[0], v0[1], v0[2], v0[3]), pack_fp8x4(v1[0], v1[1], v1[2], v1[3])}; }
                    *(u32x4*)(ys + (size_t)rowst * DM + colp + bj * HALF) = pair16(pc[0], pc[1]);
                }
            }
    }
};
}

struct Args { const float* in[21]; float* out; unsigned char* ws; int ph_lo, ph_hi; };
enum { I_X = 0, I_LNIN_G, I_LNIN_B, I_WIN, I_GLN_G, I_GLN_B, I_WSP, I_BSP, I_WBA, I_WBB, I_WOUT, I_LNMIX_G, I_LNMIX_B, I_WR, I_BR, I_WUP, I_BUP, I_WDN, I_BDN, I_LNF_G, I_LNF_B };

struct Ctx { const Args* a; unsigned char* ws; LAS unsigned char* lds; unsigned char* ldsg; int tid, lane, wave, G, vcu; };

__device__ __forceinline__ void tr_item(const float* W, int N, int k0, int n0, bf16_t* dst, int drow0, int dld, int dcol0, LAS float* scr, int lane) {
#pragma unroll 8
    for (int i = 0; i < 32; ++i) { const int kk = 2 * i + (lane >> 5); scr[kk * 33 + (lane & 31)] = __builtin_nontemporal_load(W + (size_t)(k0 + kk) * N + n0 + (lane & 31)); }
    asm volatile("s_waitcnt lgkmcnt(0)" ::: "memory");
    const int c = lane & 7;
#pragma unroll
    for (int j = 0; j < 4; ++j) { const int n = (lane >> 3) + 8 * j; const LAS float* s = scr + (8 * c) * 33 + n;
        u32x4 o; o.x = pk2(s[0 * 33], s[1 * 33]); o.y = pk2(s[2 * 33], s[3 * 33]); o.z = pk2(s[4 * 33], s[5 * 33]); o.w = pk2(s[6 * 33], s[7 * 33]);
        *(u32x4*)(dst + (size_t)(drow0 + n) * dld + dcol0 + k0 + 8 * c) = o; }
    asm volatile("s_waitcnt lgkmcnt(0)" ::: "memory");
}
template <bool DEEP = false>
__device__ __forceinline__ void tr_item8(const float* W, int N, int k0, int n0, unsigned char* dst, int drow0, int dld, float sc, LAS float* scr, int lane) {
    if constexpr (DEEP) {
        float v[32];
#pragma unroll
        for (int i = 0; i < 32; ++i) v[i] = __builtin_nontemporal_load(W + (size_t)(k0 + 2 * i + (lane >> 5)) * N + n0 + (lane & 31));
#pragma unroll
        for (int i = 0; i < 32; ++i) scr[(2 * i + (lane >> 5)) * 33 + (lane & 31)] = v[i];
    } else {
#pragma unroll 8
        for (int i = 0; i < 32; ++i) { const int kk = 2 * i + (lane >> 5); scr[kk * 33 + (lane & 31)] = __builtin_nontemporal_load(W + (size_t)(k0 + kk) * N + n0 + (lane & 31)); }
    }
    asm volatile("s_waitcnt lgkmcnt(0)" ::: "memory");
    const int c = lane & 7;
#pragma unroll
    for (int j = 0; j < 4; ++j) { const int n = (lane >> 3) + 8 * j; const LAS float* s = scr + (8 * c) * 33 + n;
        unsigned w0 = 0u, w1 = 0u;
        w0 = __builtin_amdgcn_cvt_pk_fp8_f32(s[0 * 33] * sc, s[1 * 33] * sc, w0, false); w0 = __builtin_amdgcn_cvt_pk_fp8_f32(s[2 * 33] * sc, s[3 * 33] * sc, w0, true);
        w1 = __builtin_amdgcn_cvt_pk_fp8_f32(s[4 * 33] * sc, s[5 * 33] * sc, w1, false); w1 = __builtin_amdgcn_cvt_pk_fp8_f32(s[6 * 33] * sc, s[7 * 33] * sc, w1, true);
        *(u32x2*)(dst + (size_t)(drow0 + n) * dld + k0 + 8 * c) = (u32x2){w0, w1}; }
    asm volatile("s_waitcnt lgkmcnt(0)" ::: "memory");
}
__device__ __forceinline__ void ph_prologue(const Ctx& F) {
    const Args& A = *F.a;
    LAS float* scr = (LAS float*)(F.lds + F.wave * 16384);
    const int gw = F.vcu * 8 + F.wave, NGW = F.G * 8;
    bf16_t* WIN = (bf16_t*)(F.ws + WS_WIN); bf16_t* WOUT = (bf16_t*)(F.ws + WS_WOUT);
    constexpr int I_IN = 16 * (INCOLS / 32), I_SQ = 16 * 32;
    constexpr int NITEMS = I_IN + 3 * I_SQ;
    for (int it = gw; it < NITEMS; it += NGW) {
        int r = it;
        if (r < I_IN) { const int nblk = INCOLS / 32, kb = r / nblk, nb = r % nblk;
            if (32 * nb >= PN8_LO * 256 && 32 * nb < PN8_HI * 256) tr_item8(A.in[I_WIN], INCOLS, 64 * kb, 32 * nb, F.ws + WS_WIN8, 32 * nb, DM, 32.0f, scr, F.lane);
            else tr_item(A.in[I_WIN], INCOLS, 64 * kb, 32 * nb, WIN, 32 * nb, DM, 0, scr, F.lane);
            continue; } r -= I_IN;
        if (r < I_SQ) { const int kb = r / 32, nb = r % 32; tr_item8(A.in[I_WBA], DM, 64 * kb, 32 * nb, F.ws + WS_WAB, 32 * nb, 2048, 32.0f, scr, F.lane); continue; } r -= I_SQ;
        if (r < I_SQ) { const int kb = r / 32, nb = r % 32; tr_item8(A.in[I_WBB], DM, 64 * kb, 32 * nb, F.ws + WS_WAB + 1024, 32 * nb, 2048, 32.0f, scr, F.lane); continue; } r -= I_SQ;
        { const int kb = r / 32, nb = r % 32; tr_item(A.in[I_WOUT], DM, 64 * kb, 32 * nb, WOUT, 32 * nb, DM, 0, scr, F.lane); }
    }
    const float* lg = A.in[I_LNIN_G]; const float* lb = A.in[I_LNIN_B]; bf16_t* H0 = (bf16_t*)(F.ws + WS_H0);
    f32x4 gg[4], bb[4];
#pragma unroll
    for (int j = 0; j < 4; ++j) { gg[j] = *((const f32x4*)lg + F.lane + 64 * j); bb[j] = *((const f32x4*)lb + F.lane + 64 * j); }
    for (int m = gw; m < T; m += NGW) {
        const f32x4* xr = (const f32x4*)(A.in[I_X] + (size_t)m * DM) + F.lane;
        f32x4 v[4]; float s = 0.f;
#pragma unroll
        for (int j = 0; j < 4; ++j) { v[j] = __builtin_nontemporal_load(xr + 64 * j); s += (v[j].x + v[j].y) + (v[j].z + v[j].w); }
        const float mean = wave_sum(s) * (1.f / DM); float s2 = 0.f;
#pragma unroll
        for (int j = 0; j < 4; ++j) { v[j] = v[j] - mean; s2 += (v[j].x * v[j].x + v[j].y * v[j].y) + (v[j].z * v[j].z + v[j].w * v[j].w); }
        const float rstd = 1.f / sqrtf(wave_sum(s2) * (1.f / DM) + LN_EPS);
        u32x2* o8 = (u32x2*)(H0 + (size_t)m * DM) + F.lane; unsigned* o4 = (unsigned*)(F.ws + WS_H0F8 + (size_t)m * DM) + F.lane;
#pragma unroll
        for (int j = 0; j < 4; ++j) { const f32x4 y = v[j] * rstd * gg[j] + bb[j]; o8[64 * j] = (u32x2){pk2(y.x, y.y), pk2(y.z, y.w)}; o4[64 * j] = pack_fp8x4(y.x, y.y, y.z, y.w); }
    }
}

struct WItem { const float* src; unsigned char* dst; int N, dld; float sc; };
__device__ __forceinline__ void w_load(const WItem& w, float (&v)[64], int lane) {
    const float* src = w.src + (size_t)(lane >> 5) * w.N + (lane & 31);
#pragma unroll
    for (int i = 0; i < 64; ++i) v[i] = __builtin_nontemporal_load(src + (size_t)(2 * i) * w.N);
}
__device__ __forceinline__ void w_scatter(const float (&v)[64], LAS float* scr, int lane) {
    LAS float* d = scr + (lane & 31) * 130 + (lane >> 5);
#pragma unroll
    for (int i = 0; i < 64; ++i) d[2 * i] = v[i];
}
__device__ __forceinline__ void w_emit(const WItem& w, LAS const float* scr, int lane) {
    asm volatile("s_waitcnt lgkmcnt(0)" ::: "memory");
    const int c = lane & 7; const float sc = w.sc;
#pragma unroll
    for (int j = 0; j < 4; ++j) {
        const int nn = (lane >> 3) + 8 * j; const LAS float* sp = scr + nn * 130 + 16 * c;
        f32x2 a[8];
#pragma unroll
        for (int q = 0; q < 8; ++q) a[q] = *(LAS const f32x2*)(sp + 2 * q);
        u32x4 o;
        o.x = pack_fp8x4(a[0].x * sc, a[0].y * sc, a[1].x * sc, a[1].y * sc); o.y = pack_fp8x4(a[2].x * sc, a[2].y * sc, a[3].x * sc, a[3].y * sc);
        o.z = pack_fp8x4(a[4].x * sc, a[4].y * sc, a[5].x * sc, a[5].y * sc); o.w = pack_fp8x4(a[6].x * sc, a[6].y * sc, a[7].x * sc, a[7].y * sc);
        *(u32x4*)(w.dst + (size_t)nn * w.dld + 16 * c) = o;
    }
    asm volatile("s_waitcnt lgkmcnt(0)" ::: "memory");
}
__device__ __forceinline__ WItem w_decode(const Ctx& F, int r) {
    const Args& A = *F.a;
    constexpr int I_UP = NE * 8 * 64;
    WItem w;
    if (r < I_UP) { const int e = r / (8 * 64), rr = r % (8 * 64), kb = rr / 64, nb = rr % 64; const int n0 = 32 * nb, half = n0 >= FF, rem = n0 - half * FF, pn = rem >> 7, b = (rem & 127) >> 5;
        w.src = A.in[I_WUP] + (size_t)e * DM * 2 * FF + (size_t)(128 * kb) * (2 * FF) + n0; w.N = 2 * FF; w.dst = F.ws + WS_WUP + (size_t)(e * 2048 + 256 * pn + half * 128 + 32 * b) * DM + 128 * kb; w.dld = DM; w.sc = 32.0f; }
    else { r -= I_UP; const int e = r / (8 * 32), rr = r % (8 * 32), kb = rr / 32, nb = rr % 32;
        w.src = A.in[I_WDN] + (size_t)e * FF * DM + (size_t)(128 * kb) * DM + 32 * nb; w.N = DM; w.dst = F.ws + WS_WDN + (size_t)(e * 1024 + 32 * nb) * FF + 128 * kb; w.dld = FF; w.sc = 64.0f; }
    return w;
}
__device__ __forceinline__ void ph_wconv(const Ctx& F) {
    LAS float* scr = (LAS float*)(F.lds + F.wave * 16640);
    constexpr int NIT = NE * 8 * 64 + NE * 8 * 32;
    const int chunk = (NIT + F.G - 1) / F.G, lo = (int)blockIdx.x * chunk, hi = (lo + chunk < NIT) ? lo + chunk : NIT;
    __syncthreads();
    int it = lo + F.wave;
    if (it < hi) {
        float v[64];
        WItem cur = w_decode(F, it);
        w_load(cur, v, F.lane);
        for (;;) {
            w_scatter(v, scr, F.lane);
            const int itn = it + 8; const bool more = itn < hi;
            WItem nxt = cur;
            if (more) { nxt = w_decode(F, itn); w_load(nxt, v, F.lane); }
            w_emit(cur, scr, F.lane);
            if (!more) break;
            cur = nxt; it = itn;
        }
    }
    asm volatile("s_waitcnt vmcnt(0)" ::: "memory");
    __syncthreads();
}

typedef short v4i16_t __attribute__((ext_vector_type(4)));
__device__ __forceinline__ v4i16_t lds_tr16(LAS const unsigned char* p) { return __builtin_amdgcn_ds_read_tr16_b64_v4i16((LAS v4i16_t*)p); }
__device__ __forceinline__ void ph_mixer_a(const Ctx& F) {
    const Args& A = *F.a;
    const unsigned char* GV = F.ws + WS_GV; bf16_t* YAB = (bf16_t*)(F.ws + WS_YAB); const float* GVST = (const float*)(F.ws + WS_GVST);
    const float* lg = A.in[I_GLN_G]; const float* lb = A.in[I_GLN_B]; const float* wsp = A.in[I_WSP]; const float* bsp = A.in[I_BSP];
    constexpr int RSV = 544, RSW = 272, OFF_W = 128 * RSV, OFF_ST = OFF_W + 128 * RSW;
    LAS unsigned char* VT = F.lds; LAS unsigned char* WT = F.lds + OFF_W; LAS float* ST = (LAS float*)(F.lds + OFF_ST);
    const int lane = F.lane, wv = F.wave;
    int curg = -1;
    for (int it = F.vcu; it < NB * 32 * 4; it += F.G) {
        const int b = it / 128, c = (it >> 2) & 31, g = it & 3;
        const int tok0 = b * SEQ + c * 128;
        if (g != curg) {
            curg = g;
            for (int k = 0; k < 4; ++k) {
                const int idx = F.tid + 512 * k, t = idx >> 4, s8 = (idx & 15) * 8;
                const f32x4 w0 = *(const f32x4*)(wsp + ((size_t)g * 128 + t) * 128 + s8), w1 = *(const f32x4*)(wsp + ((size_t)g * 128 + t) * 128 + s8 + 4);
                float x[8] = {w0.x, w0.y, w0.z, w0.w, w1.x, w1.y, w1.z, w1.w};
#pragma unroll
                for (int j = 0; j < 8; ++j) x[j] = (s8 + j <= t) ? x[j] : 0.f;
                u32x4 o; o.x = pk2(x[0], x[1]); o.y = pk2(x[2], x[3]); o.z = pk2(x[4], x[5]); o.w = pk2(x[6], x[7]);
                *(LAS u32x4*)(WT + t * RSW + s8 * 2) = o;
            }
        }
        if (F.tid < 128) {
            const float* p = GVST + (size_t)(tok0 + F.tid) * 32; float s1 = 0.f, s2 = 0.f;
            for (int i = 0; i < 16; ++i) { s1 += p[2 * i]; s2 += p[2 * i + 1]; }
            const float mean = s1 * (1.f / DM), var = s2 * (1.f / DM) - mean * mean;
            ST[2 * F.tid] = mean; ST[2 * F.tid + 1] = 1.f / sqrtf(fmaxf(var, 0.f) + LN_EPS);
        }
        __syncthreads();
        {
            const int dc = F.tid & 31;
            const f32x4 g0 = *(const f32x4*)(lg + g * 256 + dc * 8), g1 = *(const f32x4*)(lg + g * 256 + dc * 8 + 4), b0 = *(const f32x4*)(lb + g * 256 + dc * 8), b1 = *(const f32x4*)(lb + g * 256 + dc * 8 + 4);
            u32x2 rawv[8];
#pragma unroll
            for (int k = 0; k < 8; ++k) rawv[k] = *(const u32x2*)(GV + (size_t)(tok0 + (F.tid >> 5) + 16 * k) * DM + g * 256 + dc * 8);
#pragma unroll
            for (int k = 0; k < 8; ++k) {
                const int s = (F.tid >> 5) + 16 * k;
                const u32x2 raw = rawv[k];
                const float mean = ST[2 * s], rstd = ST[2 * s + 1];
                const f32x2v f0 = __builtin_amdgcn_cvt_pk_f32_fp8((int)raw.x, false), f1 = __builtin_amdgcn_cvt_pk_f32_fp8((int)raw.x, true), f2 = __builtin_amdgcn_cvt_pk_f32_fp8((int)raw.y, false), f3 = __builtin_amdgcn_cvt_pk_f32_fp8((int)raw.y, true);
                f32x4 x0 = {f0.x, f0.y, f1.x, f1.y}, x1 = {f2.x, f2.y, f3.x, f3.y};
                x0 = (x0 - mean) * rstd * g0 + b0; x1 = (x1 - mean) * rstd * g1 + b1;
                u32x4 o; o.x = pk2(x0.x, x0.y); o.y = pk2(x0.z, x0.w); o.z = pk2(x1.x, x1.y); o.w = pk2(x1.z, x1.w);
                *(LAS u32x4*)(VT + s * RSV + dc * 16) = o;
            }
        }
        __syncthreads();
        {
            const int dbase = 32 * wv, kg = lane >> 4, q = (lane & 15) >> 2, p = lane & 3, fr = lane & 15;
            u32x2 uu[8][2]; float bsn[8];
#pragma unroll
            for (int n = 0; n < 8; ++n) { const bf16_t* yp = YAB + (size_t)(tok0 + 16 * n + fr) * 2048 + g * 256 + dbase + 4 * kg; uu[n][0] = *(const u32x2*)yp; uu[n][1] = *(const u32x2*)(yp + 16); bsn[n] = bsp[g * 128 + 16 * n + fr]; }
            bf16x8 Af[2][4];
#pragma unroll
            for (int m = 0; m < 2; ++m)
#pragma unroll
                for (int kk = 0; kk < 4; ++kk) {
                    LAS const unsigned char* ap = VT + (32 * kk + 8 * kg + q) * RSV + (dbase + 16 * m + 4 * p) * 2;
                    const v4i16_t lo = lds_tr16(ap), hi = lds_tr16(ap + 4 * RSV);
                    Af[m][kk] = (bf16x8){lo[0], lo[1], lo[2], lo[3], hi[0], hi[1], hi[2], hi[3]};
                }
#pragma unroll
            for (int n = 0; n < 8; ++n) {
                f32x4 acc0 = {0.f, 0.f, 0.f, 0.f}, acc1 = {0.f, 0.f, 0.f, 0.f};
#pragma unroll
                for (int kk = 0; kk < 4; ++kk) if (kk <= (n >> 1)) {
                    const bf16x8 Bf = *(LAS const bf16x8*)(WT + (16 * n + fr) * RSW + (32 * kk + 8 * kg) * 2);
                    acc0 = __builtin_amdgcn_mfma_f32_16x16x32_bf16(Af[0][kk], Bf, acc0, 0, 0, 0);
                    acc1 = __builtin_amdgcn_mfma_f32_16x16x32_bf16(Af[1][kk], Bf, acc1, 0, 0, 0);
                }
                const int t = 16 * n + fr; const float bsv = bsn[n];
                const u32x2 u0 = uu[n][0], u1 = uu[n][1];
                unsigned char* y8 = F.ws + WS_YA8 + (size_t)(tok0 + t) * 2048 + g * 256 + dbase + 4 * kg;
                *(unsigned*)y8 = pack_fp8x4(bflo(u0.x) * (acc0[0] + bsv), bfhi(u0.x) * (acc0[1] + bsv), bflo(u0.y) * (acc0[2] + bsv), bfhi(u0.y) * (acc0[3] + bsv));
                *(unsigned*)(y8 + 16) = pack_fp8x4(bflo(u1.x) * (acc1[0] + bsv), bfhi(u1.x) * (acc1[1] + bsv), bflo(u1.y) * (acc1[2] + bsv), bfhi(u1.y) * (acc1[3] + bsv));
            }
        }
        __syncthreads();
    }
}

__device__ __forceinline__ void ph_gate(const Ctx& F) {
    const unsigned char* Q = F.ws + WS_Q; const float* KM = (const float*)(F.ws + WS_KMEAN);
    unsigned* SEL = (unsigned*)(F.ws + WS_SEL); unsigned* LISTS = (unsigned*)(F.ws + WS_LISTS); unsigned* LCNT = (unsigned*)(F.ws + WS_CTL) + CW_LCNT;
    constexpr int KMR = 272;
    LAS unsigned char* kmh = F.lds; LAS unsigned char* kml = F.lds + 16 * KMR;
    unsigned* lc = (unsigned*)(F.ldsg + 2 * 16 * KMR);
    LAS float* scw = (LAS float*)(F.lds + 16384) + F.wave * 1024;
    const int fr = F.lane & 15, fq = F.lane >> 4;
    for (int it = F.vcu; it < NB * NH * 8; it += F.G) {
        const int b = it / 64, h = (it >> 3) & 7, tc = it & 7;
        {
            const int j = F.tid >> 5, d4 = (F.tid & 31) * 4;
            const float* kp = KM + (size_t)((b * NBLK + j) * 2) * DM + h * DH + d4;
            const f32x4 s0 = *(const f32x4*)kp, s1 = *(const f32x4*)(kp + DM);
            const f32x4 mv = (s0 + s1) * (1.0f / LBLK);
            unsigned hb[4]; float lo[4];
#pragma unroll
            for (int e = 0; e < 4; ++e) { hb[e] = f2bf(mv[e]); lo[e] = mv[e] - __uint_as_float(hb[e] << 16); }
            *(LAS u32x2*)(kmh + j * KMR + d4 * 2) = (u32x2){hb[0] | (hb[1] << 16), hb[2] | (hb[3] << 16)};
            *(LAS u32x2*)(kml + j * KMR + d4 * 2) = (u32x2){pk2(lo[0], lo[1]), pk2(lo[2], lo[3])};
        }
        if (F.tid < 32) lc[F.tid] = 0u;
        const int tw = tc * 512 + F.wave * 64;
        u32x4 qraw[4][2];
#pragma unroll
        for (int tg = 0; tg < 4; ++tg) { const unsigned char* qp = Q + (size_t)(b * SEQ + tw + 16 * tg + fr) * DM + h * DH + 32 * fq; qraw[tg][0] = *(const u32x4*)qp; qraw[tg][1] = *(const u32x4*)(qp + 16); }
        __syncthreads();
        bf16x8 Ah[4], Al[4];
#pragma unroll
        for (int ks = 0; ks < 4; ++ks) { Ah[ks] = *(LAS const bf16x8*)(kmh + fr * KMR + (32 * fq + 8 * ks) * 2); Al[ks] = *(LAS const bf16x8*)(kml + fr * KMR + (32 * fq + 8 * ks) * 2); }
#pragma unroll
        for (int tg = 0; tg < 4; ++tg) {
            f32x4 acc = {0.f, 0.f, 0.f, 0.f};
#pragma unroll
            for (int ks = 0; ks < 4; ++ks) {
                const u32x4 w = qraw[tg][ks >> 1]; const unsigned w0 = (ks & 1) ? w.z : w.x, w1 = (ks & 1) ? w.w : w.y;
                const bf16x8 Bq = __builtin_bit_cast(bf16x8, f8x8_to_bf16x8(w0, w1));
                acc = __builtin_amdgcn_mfma_f32_16x16x32_bf16(Ah[ks], Bq, acc, 0, 0, 0);
                acc = __builtin_amdgcn_mfma_f32_16x16x32_bf16(Al[ks], Bq, acc, 0, 0, 0);
            }
            *(LAS f32x4*)(scw + (16 * tg + fr) * 16 + 4 * fq) = acc;
        }
        asm volatile("s_waitcnt lgkmcnt(0)" ::: "memory");
        const int t = tc * 512 + F.tid, qi = t >> 8;
        float gsc[15];
        { const f32x4 c0 = *(LAS const f32x4*)(scw + F.lane * 16), c1 = *(LAS const f32x4*)(scw + F.lane * 16 + 4), c2 = *(LAS const f32x4*)(scw + F.lane * 16 + 8), c3 = *(LAS const f32x4*)(scw + F.lane * 16 + 12);
          gsc[0] = c0.x; gsc[1] = c0.y; gsc[2] = c0.z; gsc[3] = c0.w; gsc[4] = c1.x; gsc[5] = c1.y; gsc[6] = c1.z; gsc[7] = c1.w;
          gsc[8] = c2.x; gsc[9] = c2.y; gsc[10] = c2.z; gsc[11] = c2.w; gsc[12] = c3.x; gsc[13] = c3.y; gsc[14] = c3.z; }
        const int nsel = qi < 3 ? qi : 3;
        int sel[3] = {0, 0, 0}; unsigned lpos[3] = {0, 0, 0};
#pragma unroll
        for (int r = 0; r < 3; ++r) {
            float best = -INFINITY; int bi = -1;
#pragma unroll
            for (int j = 0; j < 15; ++j) { const bool c = (j < qi) && (gsc[j] > best); best = c ? gsc[j] : best; bi = c ? j : bi; }
#pragma unroll
            for (int j = 0; j < 15; ++j) if (j == bi) gsc[j] = -INFINITY;
            sel[r] = bi < 0 ? 0 : bi;
            if (r < nsel) lpos[r] = atomicAdd(&lc[sel[r]], 1u);
        }
        SEL[(size_t)(b * SEQ + t) * NH + h] = (unsigned)sel[0] | ((unsigned)sel[1] << 8) | ((unsigned)sel[2] << 16) | ((unsigned)nsel << 24);
        __syncthreads();
        if (F.tid < 16) lc[16 + F.tid] = lc[F.tid] ? atomicAdd(&LCNT[(b * NH + h) * NBLK + F.tid], lc[F.tid]) : 0u;
        __syncthreads();
#pragma unroll
        for (int r = 0; r < 3; ++r) if (r < nsel) LISTS[(size_t)((b * NH + h) * NBLK + sel[r]) * 4096 + lc[16 + sel[r]] + lpos[r]] = (unsigned)t | ((unsigned)r << 12);
        __syncthreads();
    }
}


typedef float f32x16 __attribute__((ext_vector_type(16)));
namespace att {
__device__ __forceinline__ int crow(int r, int hi) { return (r & 3) + 8 * (r >> 2) + 4 * hi; }
#define TRR(dst, vaddr, off) asm volatile("ds_read_b64_tr_b16 %0, %1 offset:%c2" : "=v"(dst) : "v"(vaddr), "i"(off) : "memory")
#define TRWAIT() do { asm volatile("s_waitcnt lgkmcnt(0)" ::: "memory"); __builtin_amdgcn_sched_barrier(0); } while (0)

}

namespace att2 {
constexpr int KCH2 = 1040, VRS = 160, KSL = 8 * KCH2, VSL = 64 * VRS;
constexpr int NSL = 4;
constexpr int OFF_K = 0, OFF_V = NSL * KSL, OFF_STG = OFF_V + NSL * VSL  , OFF_WS = OFF_STG + 8 * 8192  , WSW = 1024, OFF_TAB = OFF_WS + 8 * WSW  ;
static_assert(OFF_TAB + 1028 * 4 <= LDS_BYTES - 64, "attention (partial) LDS map");
using att::crow;

__device__ __forceinline__ void tile_load(const Ctx& F, const unsigned char* K, const unsigned char* V, size_t tokbase, int h, int kt, u32x4& rk, u32x4& rv) {
    const size_t off = (tokbase + 64 * kt + (F.tid >> 3)) * DM + h * DH + (F.tid & 7) * 16;
    rk = *(const u32x4*)(K + off); rv = *(const u32x4*)(V + off);
}
__device__ __forceinline__ void tile_write(const Ctx& F, int slot, const u32x4& rk, const u32x4& rv) {
    const int key = F.tid >> 3;
    *(LAS u32x4*)(F.lds + OFF_K + slot * KSL + (F.tid & 7) * KCH2 + key * 16) = rk;
    const int vrow = 32 * ((key >> 2) & 1) + (key & 3) + 4 * ((key >> 3) & 3) + 16 * (key >> 5);
    *(LAS u32x4*)(F.lds + OFF_V + slot * VSL + vrow * VRS + (F.tid & 7) * 16) = rv;
}
template <bool CAUSAL = false>
__device__ __forceinline__ void tile_compute(const Ctx& F, int slot, const pg8::v8i_t (&qf)[2], f32x16 (&o)[4], float& m, float& l, bool first, bool diag = false) {
    const int r = F.lane & 31, hh = F.lane >> 5;
    LAS float* wsf = (LAS float*)(F.lds + OFF_WS + F.wave * WSW);
    LAS const unsigned char* kp = F.lds + OFF_K + slot * KSL + 2 * hh * KCH2 + r * 16;
    LAS const unsigned char* vp = F.lds + OFF_V + slot * VSL + (32 * hh + ((F.lane & 15) >> 1)) * VRS + ((F.lane >> 4) & 1) * 16 + (F.lane & 1) * 8;
    f32x16 p0, p1;
#pragma unroll
    for (int i = 0; i < 16; ++i) { p0[i] = 0.f; p1[i] = 0.f; }
    {
        pg8::v8i_t ka[2][2];
#pragma unroll
        for (int kb = 0; kb < 2; ++kb)
#pragma unroll
            for (int j2 = 0; j2 < 2; ++j2) ka[kb][j2] = __builtin_shufflevector(*(LAS const pg8::v4i_t*)(kp + 4 * j2 * KCH2 + kb * 512), *(LAS const pg8::v4i_t*)(kp + (4 * j2 + 1) * KCH2 + kb * 512), 0, 1, 2, 3, 4, 5, 6, 7);
        __builtin_amdgcn_sched_barrier(0);
#pragma unroll
        for (int j2 = 0; j2 < 2; ++j2) p0 = __builtin_amdgcn_mfma_scale_f32_32x32x64_f8f6f4(ka[0][j2], qf[j2], p0, 0, 0, 0, 0x7f7f7f7f, 0, 0x7f7f7f7f);
#pragma unroll
        for (int j2 = 0; j2 < 2; ++j2) p1 = __builtin_amdgcn_mfma_scale_f32_32x32x64_f8f6f4(ka[1][j2], qf[j2], p1, 0, 0, 0, 0x7f7f7f7f, 0, 0x7f7f7f7f);
        __builtin_amdgcn_sched_barrier(0);
    }
    v4i16_t vr[4][4];
    const unsigned vaddr = (unsigned)(uintptr_t)vp;
#define TRR8(dst, vaddr, off) asm volatile("ds_read_b64_tr_b8 %0, %1 offset:%c2" : "=v"(dst) : "v"(vaddr), "i"(off) : "memory")
#pragma unroll
    for (int db = 0; db < 4; ++db)
#pragma unroll
        for (int q8 = 0; q8 < 4; ++q8) TRR8(vr[db][q8], vaddr, q8 * 8 * VRS + db * 32);
    __builtin_amdgcn_sched_barrier(0);
    if (CAUSAL && diag) {
        if (F.wave & 1) {
#pragma unroll
            for (int i = 0; i < 16; ++i) p1[i] = (crow(i, hh) > r) ? -INFINITY : p1[i];
        } else {
#pragma unroll
            for (int i = 0; i < 16; ++i) { p0[i] = (crow(i, hh) > r) ? -INFINITY : p0[i]; p1[i] = -INFINITY; }
        }
    }
    const float dm = first ? 0.f : m;
    { const f32x2 dm2 = {dm, dm};
#pragma unroll
      for (int j = 0; j < 8; ++j) { f32x2 a = {p0[2 * j], p0[2 * j + 1]}, b = {p1[2 * j], p1[2 * j + 1]}; a = a - dm2; b = b - dm2; p0[2 * j] = a.x; p0[2 * j + 1] = a.y; p1[2 * j] = b.x; p1[2 * j + 1] = b.y; } }
    float mx = fmaxf(p0[0], p1[0]);
#pragma unroll
    for (int i = 1; i < 16; ++i) mx = fmaxf(mx, fmaxf(p0[i], p1[i]));
    mx = fmaxf(mx, __shfl_xor(mx, 32));
    if (first || __any(mx > 8.0f)) {
        const float delta = first ? mx : fmaxf(mx, 0.f);
        const float alpha = first ? 0.f : __builtin_amdgcn_exp2f(-delta);
        l *= alpha; m = dm + delta;
        { const f32x2 d2 = {delta, delta};
#pragma unroll
          for (int j = 0; j < 8; ++j) { f32x2 a = {p0[2 * j], p0[2 * j + 1]}, b = {p1[2 * j], p1[2 * j + 1]}; a = a - d2; b = b - d2; p0[2 * j] = a.x; p0[2 * j + 1] = a.y; p1[2 * j] = b.x; p1[2 * j + 1] = b.y; } }
        if (!first) {
            if (hh == 0) wsf[r] = alpha;
            asm volatile("s_waitcnt lgkmcnt(0)" ::: "memory");
#pragma unroll
            for (int i = 0; i < 16; ++i) { const float a = wsf[crow(i, hh)];
#pragma unroll
                for (int db = 0; db < 4; ++db) o[db][i] *= a; }
        }
    }
    { f32x2 sa = {0.f, 0.f}, sb = {0.f, 0.f};
#pragma unroll
      for (int j = 0; j < 8; ++j) {
          p0[2 * j] = __builtin_amdgcn_exp2f(p0[2 * j]); p0[2 * j + 1] = __builtin_amdgcn_exp2f(p0[2 * j + 1]); p1[2 * j] = __builtin_amdgcn_exp2f(p1[2 * j]); p1[2 * j + 1] = __builtin_amdgcn_exp2f(p1[2 * j + 1]);
          sa = sa + (f32x2){p0[2 * j], p0[2 * j + 1]}; sb = sb + (f32x2){p1[2 * j], p1[2 * j + 1]}; }
      sa = sa + sb; l += sa.x + sa.y; }
    pg8::v8i_t pa;
#pragma unroll
    for (int i = 0; i < 4; ++i) { pa[i] = (int)pack_fp8x4(p0[4 * i], p0[4 * i + 1], p0[4 * i + 2], p0[4 * i + 3]); pa[4 + i] = (int)pack_fp8x4(p1[4 * i], p1[4 * i + 1], p1[4 * i + 2], p1[4 * i + 3]); }
    TRWAIT();
#pragma unroll
    for (int db = 0; db < 4; ++db) {
        pg8::v8i_t vf;
#pragma unroll
        for (int q8 = 0; q8 < 4; ++q8) { const u32x2 w = __builtin_bit_cast(u32x2, vr[db][q8]); vf[2 * q8] = (int)w.x; vf[2 * q8 + 1] = (int)w.y; }
        o[db] = __builtin_amdgcn_mfma_scale_f32_32x32x64_f8f6f4(pa, vf, o[db], 0, 0, 0, 0x7f7f7f7f, 0, 0x7f7f7f7f);
    }
    __builtin_amdgcn_sched_barrier(0);
#undef TRR8
}
}

#define ATT2_DECODE(item, bhj_, chunk_) do { int lo_ = 0, hi_ = 1023; while (lo_ < hi_) { const int mid_ = (lo_ + hi_ + 1) >> 1; if (P[mid_] <= (item)) lo_ = mid_; else hi_ = mid_ - 1; } bhj_ = lo_; chunk_ = (item) - P[lo_]; } while (0)
__device__ __forceinline__ void ph_attn_partial(const Ctx& F) {
    using namespace att2;
    const unsigned char* Q = F.ws + WS_Q; const unsigned char* K = F.ws + WS_K; const unsigned char* V = F.ws + WS_V;
    const unsigned* LISTS = (const unsigned*)(F.ws + WS_LISTS); const unsigned* LCNT = (const unsigned*)(F.ws + WS_CTL) + CW_LCNT;
    unsigned char* OP = F.ws + WS_OP; float* LSE = (float*)(F.ws + WS_LSE);
    LAS int* P = (LAS int*)(F.lds + OFF_TAB);
    if (F.tid < 64) {
        int c[16]; int s = 0;
#pragma unroll
        for (int i = 0; i < 16; ++i) { c[i] = ((int)__hip_atomic_load(LCNT + F.tid * 16 + i, __ATOMIC_RELAXED, __HIP_MEMORY_SCOPE_AGENT) + 255) >> 8; s += c[i]; }
        int inc = s;
#pragma unroll
        for (int o = 1; o < 64; o <<= 1) { const int t = __shfl_up(inc, o); if (F.lane >= o) inc += t; }
        int run = inc - s;
#pragma unroll
        for (int i = 0; i < 16; ++i) { P[F.tid * 16 + i] = run; run += c[i]; }
        if (F.tid == 63) P[1024] = run;
    }
    __syncthreads();
    const int total = P[1024];
    LAS float* wsf = (LAS float*)(F.lds + OFF_WS + F.wave * WSW);
    LAS int* wsi = (LAS int*)wsf;
    const int r = F.lane & 31, hh = F.lane >> 5;
    int it = F.vcu;
    if (it < total) {
        int bhj, chunk; ATT2_DECODE(it, bhj, chunk);
        int itn = it + F.G, bhjn = 0, chunkn = 0; bool hasn = itn < total; if (hasn) ATT2_DECODE(itn, bhjn, chunkn);
        u32x4 rkA, rvA, rkB, rvB;
        { const int b = bhj >> 7, h = (bhj >> 4) & 7, j = bhj & 15; const size_t tb = (size_t)b * SEQ + j * LBLK;
          tile_load(F, K, V, tb, h, 0, rkA, rvA); tile_load(F, K, V, tb, h, 1, rkB, rvB); tile_write(F, 0, rkA, rvA); tile_write(F, 1, rkB, rvB);
          tile_load(F, K, V, tb, h, 2, rkA, rvA); tile_load(F, K, V, tb, h, 3, rkB, rvB); tile_write(F, 2, rkA, rvA); tile_write(F, 3, rkB, rvB); }
        int cnt = (int)__hip_atomic_load(LCNT + bhj, __ATOMIC_RELAXED, __HIP_MEMORY_SCOPE_AGENT);
        int qi = chunk * 256 + F.wave * 32 + r;
        unsigned ent = LISTS[(size_t)bhj * 4096 + (qi < cnt ? qi : 0)];
        int tq = ent & 4095, slot = (qi < cnt) ? (int)(ent >> 12) : -1;
        u32x4 qraw[4];
        { const unsigned char* qrow = Q + ((size_t)(bhj >> 7) * SEQ + tq) * DM + ((bhj >> 4) & 7) * DH + hh * 32;
#pragma unroll
          for (int c = 0; c < 4; ++c) qraw[c] = *(const u32x4*)(qrow + (c >> 1) * 64 + (c & 1) * 16); }
        unsigned entn = 0u; int cntn = 0;
        __syncthreads();
        int s = 0;
        for (;;) {
            const int b = bhj >> 7, h = (bhj >> 4) & 7, j = bhj & 15;
            pg8::v8i_t qr[2];
#pragma unroll
            for (int j2 = 0; j2 < 2; ++j2) qr[j2] = __builtin_shufflevector(__builtin_bit_cast(pg8::v4i_t, qraw[2 * j2]), __builtin_bit_cast(pg8::v4i_t, qraw[2 * j2 + 1]), 0, 1, 2, 3, 4, 5, 6, 7);
            if (F.lane < 32) { wsi[64 + r] = tq; wsi[96 + r] = slot; }
            f32x16 o[4]; float m = -1e30f, l = 0.f;
#pragma unroll
            for (int db = 0; db < 4; ++db)
#pragma unroll
                for (int i = 0; i < 16; ++i) o[db][i] = 0.f;
#define ATT2_TB(bb) ((size_t)((bb) >> 7) * SEQ + ((bb) & 15) * LBLK)
#define ATT2_H(bb) (((bb) >> 4) & 7)
#pragma unroll 1
            for (int kp2 = 0; kp2 < 2; ++kp2) {
                const int kt = 2 * kp2;
                if (hasn) { tile_load(F, K, V, ATT2_TB(bhjn), ATT2_H(bhjn), kt, rkA, rvA); tile_load(F, K, V, ATT2_TB(bhjn), ATT2_H(bhjn), kt + 1, rkB, rvB); }
                if (kt == 0 && hasn) { cntn = (int)__hip_atomic_load(LCNT + bhjn, __ATOMIC_RELAXED, __HIP_MEMORY_SCOPE_AGENT); }
                if (kt == 2 && hasn) { const unsigned char* qrow = Q + ((size_t)(bhjn >> 7) * SEQ + (entn & 4095)) * DM + ((bhjn >> 4) & 7) * DH + hh * 32;
#pragma unroll
                    for (int c = 0; c < 4; ++c) qraw[c] = *(const u32x4*)(qrow + (c >> 1) * 64 + (c & 1) * 16); }
                tile_compute(F, kt, qr, o, m, l, kp2 == 0);
                if (kt == 0 && hasn) { const int qn = chunkn * 256 + F.wave * 32 + r; entn = LISTS[(size_t)bhjn * 4096 + (qn < cntn ? qn : 0)]; }
                tile_compute(F, kt + 1, qr, o, m, l, false);
                asm volatile("s_waitcnt lgkmcnt(0)" ::: "memory"); __builtin_amdgcn_s_barrier(); asm volatile("" ::: "memory");
                if (hasn) { tile_write(F, kt, rkA, rvA); tile_write(F, kt + 1, rkB, rvB); }
            }
            const float lt = l + __shfl_xor(l, 32);
            if (hh == 0) { wsf[r] = 1.0f / lt; wsf[32 + r] = m + __builtin_amdgcn_logf(lt); }
            asm volatile("s_waitcnt lgkmcnt(0)" ::: "memory");
            int re = r, he = hh; asm volatile("" : "+v"(re), "+v"(he));
#pragma unroll
            for (int i = 0; i < 16; ++i) {
                const int q = crow(i, he); const float a = wsf[q]; const int t = wsi[64 + q], sl = wsi[96 + q];
                const unsigned w = pack_fp8x4(o[0][i] * a, o[1][i] * a, o[2][i] * a, o[3][i] * a);
                if (sl >= 0) { const size_t row = (((size_t)sl * NB + b) * SEQ + t) * NH + h; *(unsigned*)(OP + row * DH + 4 * re) = w; }
            }
            if (he == 0 && slot >= 0) LSE[(((size_t)slot * NB + b) * SEQ + tq) * NH + h] = wsf[32 + re];
            asm volatile("s_waitcnt lgkmcnt(0)" ::: "memory");
            if (!hasn) break;
            it = itn; bhj = bhjn; chunk = chunkn; cnt = cntn;
            { const int qn = chunk * 256 + F.wave * 32 + r; tq = entn & 4095; slot = (qn < cnt) ? (int)(entn >> 12) : -1; }
            itn = it + F.G; hasn = itn < total; if (hasn) ATT2_DECODE(itn, bhjn, chunkn);
        }
    }
    __syncthreads();
}

__device__ __forceinline__ void ph_attn_own(const Ctx& F) {
    using namespace att2;
    const unsigned char* Q = F.ws + WS_Q; const unsigned char* K = F.ws + WS_K; const unsigned char* V = F.ws + WS_V;
    const unsigned char* OP = F.ws + WS_OP; const float* LSE = (const float*)(F.ws + WS_LSE); unsigned char* YA8 = F.ws + WS_YA8;
    LAS float* wsf = (LAS float*)(F.lds + OFF_WS + F.wave * WSW);
    const int r = F.lane & 31, hh = F.lane >> 5;
    constexpr int NIT = NB * NH * NBLK;
    int it = F.vcu;
    if (it < NIT) {
        int itn = it + F.G; bool hasn = itn < NIT;
        u32x4 rkA, rvA, rkB, rvB;
#define OWN_TB(i_) ((size_t)((i_) >> 7) * SEQ + ((i_) & 15) * LBLK)
#define OWN_H(i_) (((i_) >> 4) & 7)
        tile_load(F, K, V, OWN_TB(it), OWN_H(it), 0, rkA, rvA); tile_load(F, K, V, OWN_TB(it), OWN_H(it), 1, rkB, rvB); tile_write(F, 0, rkA, rvA); tile_write(F, 1, rkB, rvB);
        tile_load(F, K, V, OWN_TB(it), OWN_H(it), 2, rkA, rvA); tile_load(F, K, V, OWN_TB(it), OWN_H(it), 3, rkB, rvB); tile_write(F, 2, rkA, rvA); tile_write(F, 3, rkB, rvB);
        u32x4 qraw[4];
        { const unsigned char* qrow = Q + (OWN_TB(it) + F.wave * 32 + r) * DM + OWN_H(it) * DH + hh * 32;
#pragma unroll
          for (int c = 0; c < 4; ++c) qraw[c] = *(const u32x4*)(qrow + (c >> 1) * 64 + (c & 1) * 16); }
        __syncthreads();
        const int wdiag = F.wave >> 1;
        for (;;) {
            const int b = it >> 7, h = (it >> 4) & 7, j = it & 15, t0 = j * LBLK + F.wave * 32;
            pg8::v8i_t qr[2];
#pragma unroll
            for (int j2 = 0; j2 < 2; ++j2) qr[j2] = __builtin_shufflevector(__builtin_bit_cast(pg8::v4i_t, qraw[2 * j2]), __builtin_bit_cast(pg8::v4i_t, qraw[2 * j2 + 1]), 0, 1, 2, 3, 4, 5, 6, 7);
            f32x16 o[4]; float m = -1e30f, l = 0.f;
#pragma unroll
            for (int db = 0; db < 4; ++db)
#pragma unroll
                for (int i = 0; i < 16; ++i) o[db][i] = 0.f;
#pragma unroll 1
            for (int kp2 = 0; kp2 < 2; ++kp2) {
                const int kt = 2 * kp2;
                if (hasn) { tile_load(F, K, V, OWN_TB(itn), OWN_H(itn), kt, rkA, rvA); tile_load(F, K, V, OWN_TB(itn), OWN_H(itn), kt + 1, rkB, rvB); }
                if (kt == 2 && hasn) { const unsigned char* qrow = Q + (OWN_TB(itn) + F.wave * 32 + r) * DM + OWN_H(itn) * DH + hh * 32;
#pragma unroll
                    for (int c = 0; c < 4; ++c) qraw[c] = *(const u32x4*)(qrow + (c >> 1) * 64 + (c & 1) * 16); }
                if (kt <= wdiag) tile_compute<true>(F, kt, qr, o, m, l, kp2 == 0, kt == wdiag);
                if (kt + 1 <= wdiag) tile_compute<true>(F, kt + 1, qr, o, m, l, false, kt + 1 == wdiag);
                asm volatile("s_waitcnt lgkmcnt(0)" ::: "memory"); __builtin_amdgcn_s_barrier(); asm volatile("" ::: "memory");
                if (hasn) { tile_write(F, kt, rkA, rvA); tile_write(F, kt + 1, rkB, rvB); }
            }
            const int nv = j < 3 ? j : 3;
            int re = r, he = hh; asm volatile("" : "+v"(re), "+v"(he));
            LAS float* stg = (LAS float*)(F.lds + OFF_STG + F.wave * 8192);
            unsigned pv[16][3];
#pragma unroll
            for (int i = 0; i < 16; ++i) { const int q = crow(i, he);
#pragma unroll
                for (int s2 = 0; s2 < 3; ++s2) { pv[i][s2] = 0u; if (s2 < nv) pv[i][s2] = *(const unsigned*)(OP + ((((size_t)s2 * NB + b) * SEQ + t0 + q) * NH + h) * DH + 4 * re); } }
            {
                const float lt = l + __shfl_xor(l, 32); const float lse_own = m + __builtin_amdgcn_logf(lt);
                float ls[3];
#pragma unroll
                for (int s2 = 0; s2 < 3; ++s2) ls[s2] = (s2 < nv) ? LSE[(((size_t)s2 * NB + b) * SEQ + t0 + r) * NH + h] : -1e30f;
                const float M = fmaxf(fmaxf(lse_own, ls[0]), fmaxf(ls[1], ls[2]));
                const float w0 = __builtin_amdgcn_exp2f(lse_own - M);
                float w[3], den = w0;
#pragma unroll
                for (int s2 = 0; s2 < 3; ++s2) { w[s2] = (s2 < nv) ? __builtin_amdgcn_exp2f(ls[s2] - M) : 0.f; den += w[s2]; }
                const float inv = 1.0f / den;
                if (hh == 0) { wsf[r] = w0 * inv / lt; wsf[32 + r] = w[0] * inv; wsf[64 + r] = w[1] * inv; wsf[96 + r] = w[2] * inv; }
                asm volatile("s_waitcnt lgkmcnt(0)" ::: "memory");
            }
            {
#pragma unroll
                for (int i = 0; i < 16; ++i) { const int q = crow(i, he); const float a = wsf[q];
                    float x0 = o[0][i] * a, x1 = o[1][i] * a, x2 = o[2][i] * a, x3 = o[3][i] * a;
#pragma unroll
                    for (int s2 = 0; s2 < 3; ++s2) { const float ww = wsf[32 * (s2 + 1) + q]; const f32x2v f0 = __builtin_amdgcn_cvt_pk_f32_fp8((int)pv[i][s2], false), f1 = __builtin_amdgcn_cvt_pk_f32_fp8((int)pv[i][s2], true);
                        x0 += ww * f0.x; x1 += ww * f0.y; x2 += ww * f1.x; x3 += ww * f1.y; }
                    o[0][i] = x0; o[1][i] = x1; o[2][i] = x2; o[3][i] = x3; }
            }
#pragma unroll
            for (int half = 0; half < 2; ++half) {
#pragma unroll
                for (int i = 0; i < 16; ++i) { const int q = crow(i, he); stg[q * 64 + re] = o[2 * half][i]; stg[q * 64 + 32 + re] = o[2 * half + 1][i]; }
                asm volatile("s_waitcnt lgkmcnt(0)" ::: "memory");
#pragma unroll
                for (int ps = 0; ps < 4; ++ps) {
                    const int q = ps * 8 + ((re + 32 * he) >> 3), dc = re & 7;
                    const f32x4 x = *(LAS const f32x4*)(stg + q * 64 + dc * 8), y = *(LAS const f32x4*)(stg + q * 64 + dc * 8 + 4);
                    *(u32x2*)(YA8 + ((size_t)b * SEQ + t0 + q) * 2048 + 1024 + h * DH + half * 64 + dc * 8) = (u32x2){pack_fp8x4(x.x, x.y, x.z, x.w), pack_fp8x4(y.x, y.y, y.z, y.w)};
                }
                asm volatile("s_waitcnt lgkmcnt(0)" ::: "memory");
            }
            if (!hasn) break;
            it = itn; itn = it + F.G; hasn = itn < NIT;
        }
#undef OWN_TB
#undef OWN_H
    }
    __syncthreads();
}

__device__ __forceinline__ void ph_router(const Ctx& F) {
    const Args& A = *F.a;
    const bf16_t* Z = (const bf16_t*)(F.ws + WS_Z); const float* ZST = (const float*)(F.ws + WS_ZST); bf16_t* H1 = (bf16_t*)(F.ws + WS_H1); unsigned char* H1F8 = F.ws + WS_H1F8;
    int* TKE = (int*)(F.ws + WS_TKE); int* TKP = (int*)(F.ws + WS_TKP); unsigned* ECNT = (unsigned*)(F.ws + WS_CTL) + CW_ECNT; int* RT = (int*)(F.ws + WS_RT); float* RW = (float*)(F.ws + WS_RW);
    const float* wr = A.in[I_WR]; const float* br = A.in[I_BR];
    constexpr int RS = 2064, OFF_LO = 32 * RS, OFF_G = 2 * 32 * RS  , OFF_B = OFF_G + 4096, OFF_LG = OFF_B + 4096  , OFF_CNT = OFF_LG + 8 * 2112  ;
    static_assert(OFF_CNT + 256 <= LDS_BYTES, "router LDS map");
    LAS unsigned char* WH = F.lds; LAS unsigned char* WL = F.lds + OFF_LO;
    LAS float* LG = (LAS float*)(F.lds + OFF_G); LAS float* LB = (LAS float*)(F.lds + OFF_B);
    LAS float* lgt = (LAS float*)(F.lds + OFF_LG + F.wave * 2112);
    LAS unsigned* lcnt = (LAS unsigned*)(F.lds + OFF_CNT);
    {
        f32x4 wa[8], wb[8];
#pragma unroll
        for (int u_ = 0; u_ < 8; ++u_) { const int i = F.tid + 512 * u_, nq = i & 7, k2 = i >> 3;
            wa[u_] = *(const f32x4*)(wr + (size_t)(2 * k2) * NE + 4 * nq); wb[u_] = *(const f32x4*)(wr + (size_t)(2 * k2 + 1) * NE + 4 * nq); }
#pragma unroll
        for (int u_ = 0; u_ < 8; ++u_) { const int i = F.tid + 512 * u_, nq = i & 7, k2 = i >> 3;
#pragma unroll
            for (int c = 0; c < 4; ++c) {
                const float w0 = wa[u_][c], w1 = wb[u_][c];
                const unsigned h0 = f2bf(w0), h1 = f2bf(w1);
                const float r0 = w0 - __uint_as_float(h0 << 16), r1 = w1 - __uint_as_float(h1 << 16);
                *(LAS unsigned*)(WH + (4 * nq + c) * RS + k2 * 4) = h0 | (h1 << 16);
                *(LAS unsigned*)(WL + (4 * nq + c) * RS + k2 * 4) = pk2(r0, r1);
            } }
    }
    for (int i = F.tid; i < DM; i += 512) { LG[i] = A.in[I_LNMIX_G][i]; LB[i] = A.in[I_LNMIX_B][i]; }
    if (F.tid < 64) lcnt[F.tid] = 0u;
    __syncthreads();
    const int fr = F.lane & 15, kg = F.lane >> 4;
    const int ntask = T / 16, NGW = F.G * 8;
    const int rounds = (ntask + NGW - 1) / NGW;
    for (int rd = 0; rd < rounds; ++rd) {
        const int task = rd * NGW + F.vcu * 8 + F.wave;
        const bool live = task < ntask;
        int te[4] = {0, 0, 0, 0}; float tw[4] = {0.f, 0.f, 0.f, 0.f}; unsigned lp[4] = {0, 0, 0, 0};
        if (live) {
            const int tok = task * 16 + fr;
            float mean, rstd;
            { const f32x4* sp = (const f32x4*)(ZST + (size_t)tok * 32); float s1 = 0.f, s2 = 0.f;
#pragma unroll
              for (int i = 0; i < 8; ++i) { const f32x4 v = sp[i]; s1 += v.x + v.z; s2 += v.y + v.w; }
              mean = s1 * (1.f / DM); const float var = s2 * (1.f / DM) - mean * mean; rstd = 1.f / sqrtf(fmaxf(var, 0.f) + LN_EPS); }
            f32x4 acc0 = {0.f, 0.f, 0.f, 0.f}, acc1 = {0.f, 0.f, 0.f, 0.f};
            const bf16_t* zp = Z + (size_t)tok * DM + 8 * kg; unsigned char* h8 = H1F8 + (size_t)tok * DM + 8 * kg;
#pragma unroll 8
            for (int kk = 0; kk < 32; ++kk) {
                const u32x4 zr = *(const u32x4*)(zp + 32 * kk); const f32x4 z0 = {bflo(zr.x), bfhi(zr.x), bflo(zr.y), bfhi(zr.y)}, z1 = {bflo(zr.z), bfhi(zr.z), bflo(zr.w), bfhi(zr.w)};
                const f32x4 g0 = *(LAS const f32x4*)(LG + 32 * kk + 8 * kg), g1 = *(LAS const f32x4*)(LG + 32 * kk + 8 * kg + 4);
                const f32x4 b0 = *(LAS const f32x4*)(LB + 32 * kk + 8 * kg), b1 = *(LAS const f32x4*)(LB + 32 * kk + 8 * kg + 4);
                const f32x4 x0 = (z0 - mean) * rstd * g0 + b0, x1 = (z1 - mean) * rstd * g1 + b1;
                u32x4 hi; hi.x = cvt_pk_bf16(x0.x, x0.y); hi.y = cvt_pk_bf16(x0.z, x0.w); hi.z = cvt_pk_bf16(x1.x, x1.y); hi.w = cvt_pk_bf16(x1.z, x1.w);
                { unsigned w0 = 0u, w1 = 0u;
                  w0 = __builtin_amdgcn_cvt_pk_fp8_f32(x0.x, x0.y, w0, false); w0 = __builtin_amdgcn_cvt_pk_fp8_f32(x0.z, x0.w, w0, true);
                  w1 = __builtin_amdgcn_cvt_pk_fp8_f32(x1.x, x1.y, w1, false); w1 = __builtin_amdgcn_cvt_pk_fp8_f32(x1.z, x1.w, w1, true);
                  *(u32x2*)(h8 + 32 * kk) = (u32x2){w0, w1}; }
                u32x4 lo; lo.x = cvt_pk_bf16(x0.x - bflo(hi.x), x0.y - bfhi(hi.x)); lo.y = cvt_pk_bf16(x0.z - bflo(hi.y), x0.w - bfhi(hi.y));
                lo.z = cvt_pk_bf16(x1.x - bflo(hi.z), x1.y - bfhi(hi.z)); lo.w = cvt_pk_bf16(x1.z - bflo(hi.w), x1.w - bfhi(hi.w));
                const bf16x8 ah = __builtin_bit_cast(bf16x8, hi), al = __builtin_bit_cast(bf16x8, lo);
                const int bo = fr * RS + (32 * kk + 8 * kg) * 2;
                const bf16x8 wh0 = *(LAS const bf16x8*)(WH + bo), wh1 = *(LAS const bf16x8*)(WH + bo + 16 * RS), wl0 = *(LAS const bf16x8*)(WL + bo), wl1 = *(LAS const bf16x8*)(WL + bo + 16 * RS);
                acc0 = __builtin_amdgcn_mfma_f32_16x16x32_bf16(ah, wh0, acc0, 0, 0, 0); acc1 = __builtin_amdgcn_mfma_f32_16x16x32_bf16(ah, wh1, acc1, 0, 0, 0);
                acc0 = __builtin_amdgcn_mfma_f32_16x16x32_bf16(ah, wl0, acc0, 0, 0, 0); acc1 = __builtin_amdgcn_mfma_f32_16x16x32_bf16(ah, wl1, acc1, 0, 0, 0);
                acc0 = __builtin_amdgcn_mfma_f32_16x16x32_bf16(al, wh0, acc0, 0, 0, 0); acc1 = __builtin_amdgcn_mfma_f32_16x16x32_bf16(al, wh1, acc1, 0, 0, 0);
            }
            const float br0 = br[fr], br1 = br[16 + fr];
#pragma unroll
            for (int i = 0; i < 4; ++i) { lgt[(4 * kg + i) * 33 + fr] = acc0[i] + br0; lgt[(4 * kg + i) * 33 + 16 + fr] = acc1[i] + br1; }
            asm volatile("s_waitcnt lgkmcnt(0)" ::: "memory");
            if (F.lane < 16) {
                float lg[NE];
#pragma unroll
                for (int e = 0; e < NE; ++e) lg[e] = lgt[F.lane * 33 + e];
                float tv[4];
#pragma unroll
                for (int r = 0; r < 4; ++r) {
                    float best = -INFINITY; int bi = 0;
#pragma unroll
                    for (int e = 0; e < NE; ++e) { const bool c = lg[e] > best; best = c ? lg[e] : best; bi = c ? e : bi; }
#pragma unroll
                    for (int e = 0; e < NE; ++e) lg[e] = (e == bi) ? -INFINITY : lg[e];
                    te[r] = bi; tv[r] = best;
                }
                const float e1 = __expf(tv[1] - tv[0]), e2 = __expf(tv[2] - tv[0]), e3 = __expf(tv[3] - tv[0]); const float inv = 1.f / (1.f + e1 + e2 + e3);
                tw[0] = inv; tw[1] = e1 * inv; tw[2] = e2 * inv; tw[3] = e3 * inv;
#pragma unroll
                for (int r = 0; r < 4; ++r) lp[r] = atomicAdd((unsigned*)(lcnt + te[r]), 1u);
            }
        }
        __syncthreads();
        if (F.tid < 32) { const unsigned c = lcnt[F.tid]; lcnt[32 + F.tid] = c ? atomicAdd(&ECNT[F.tid], c) : 0u; }
        __syncthreads();
        if (live && F.lane < 16) {
            const size_t tok = (size_t)task * 16 + F.lane;
            int4 pe = {te[0], te[1], te[2], te[3]};
            int4 pp = {(int)(lcnt[32 + te[0]] + lp[0]), (int)(lcnt[32 + te[1]] + lp[1]), (int)(lcnt[32 + te[2]] + lp[2]), (int)(lcnt[32 + te[3]] + lp[3])};
            *(int4*)(TKE + tok * 4) = pe; *(int4*)(TKP + tok * 4) = pp;
#pragma unroll
            for (int r = 0; r < 4; ++r) { const size_t o_ = (size_t)te[r] * T + (r == 0 ? pp.x : r == 1 ? pp.y : r == 2 ? pp.z : pp.w); RT[o_] = (int)tok; RW[o_] = tw[r]; }
        }
        __syncthreads();
        if (F.tid < 32) lcnt[F.tid] = 0u;
        __syncthreads();
    }
}

__device__ __forceinline__ void moe_table(const Ctx& F) {
    const unsigned* ECNT = (const unsigned*)(F.ws + WS_CTL) + CW_ECNT;
    LAS int* tab = (LAS int*)(F.lds + LDS_MOE);
    __syncthreads();
    if (F.tid < 64) {
        const int c = (F.lane < NE) ? (int)__hip_atomic_load(ECNT + F.lane, __ATOMIC_RELAXED, __HIP_MEMORY_SCOPE_AGENT) : 0;
        const int padded = (c + 255) / 256 * 256;
        int inc = padded;
#pragma unroll
        for (int o = 1; o < 64; o <<= 1) { const int t = __shfl_up(inc, o); if (F.lane >= o) inc += t; }
        if (F.lane < NE) tab[32 + F.lane] = inc - padded;
        if (F.lane == NE - 1) { tab[64] = inc; tab[0] = inc / 256; }
    }
    __syncthreads();
    const int ntiles = tab[0];
    for (int i = F.tid; i < ntiles; i += 512) { int e = 0; for (int k = 1; k < NE; ++k) if (i * 256 >= tab[32 + k]) e = k; tab[128 + 2 * i] = e; tab[129 + 2 * i] = i - tab[32 + e] / 256; }
    __syncthreads();
}

__device__ __forceinline__ void ln_stats16(const float* st, int lane, float& mean, float& rstd) {
    float s1 = 0.f, s2 = 0.f;
    if (lane < 16) { const f32x2 p = *(const f32x2*)(st + 2 * lane); s1 = p.x; s2 = p.y; }
    s1 = wave_sum(s1); s2 = wave_sum(s2);
    mean = s1 * (1.f / DM); const float var = s2 * (1.f / DM) - mean * mean; rstd = 1.f / sqrtf(fmaxf(var, 0.f) + LN_EPS);
}
__device__ __forceinline__ void ph_final(const Ctx& F) {
    const Args& A = *F.a;
    const bf16_t* Z = (const bf16_t*)(F.ws + WS_Z); const float* ZST = (const float*)(F.ws + WS_ZST); const unsigned char* YS = F.ws + WS_YS; const int* TKE = (const int*)(F.ws + WS_TKE); const int* TKP = (const int*)(F.ws + WS_TKP);
    const LAS int* tab = (const LAS int*)(F.lds + LDS_MOE);
    const int gw = F.vcu * 8 + F.wave, NGW = F.G * 8;
    f32x4 g2[4], b2[4], g1[4], b1[4];
#pragma unroll
    for (int j = 0; j < 4; ++j) { g2[j] = *((const f32x4*)A.in[I_LNF_G] + F.lane + 64 * j); b2[j] = *((const f32x4*)A.in[I_LNF_B] + F.lane + 64 * j);
        g1[j] = *((const f32x4*)A.in[I_LNMIX_G] + F.lane + 64 * j) * ALPHA; b1[j] = *((const f32x4*)A.in[I_LNMIX_B] + F.lane + 64 * j) * ALPHA; }
    for (int m = gw; m < T; m += NGW) {
        float mean, rstd; ln_stats16(ZST + (size_t)m * 32, F.lane, mean, rstd);
        const u32x2* hr = (const u32x2*)(Z + (size_t)m * DM) + F.lane;
        f32x4 v[4];
#pragma unroll
        for (int j = 0; j < 4; ++j) { const u32x2 hb = hr[64 * j]; v[j] = ((f32x4){bflo(hb.x), bfhi(hb.x), bflo(hb.y), bfhi(hb.y)} - mean) * rstd * g1[j] + b1[j]; }
#pragma unroll
        for (int k = 0; k < 4; ++k) {
            const int row = tab[32 + TKE[(size_t)m * 4 + k]] + TKP[(size_t)m * 4 + k]; const unsigned* yr = (const unsigned*)(YS + (size_t)row * DM) + F.lane;
#pragma unroll
            for (int j = 0; j < 4; ++j) { const unsigned y = yr[64 * j]; const f32x2v f0 = __builtin_amdgcn_cvt_pk_f32_fp8((int)y, false), f1 = __builtin_amdgcn_cvt_pk_f32_fp8((int)y, true);
                v[j].x += 0.0625f * f0.x; v[j].y += 0.0625f * f0.y; v[j].z += 0.0625f * f1.x; v[j].w += 0.0625f * f1.y; }
        }
        float s = 0.f;
#pragma unroll
        for (int j = 0; j < 4; ++j) s += (v[j].x + v[j].y) + (v[j].z + v[j].w);
        const float mu = wave_sum(s) * (1.f / DM); float s2 = 0.f;
#pragma unroll
        for (int j = 0; j < 4; ++j) { v[j] = v[j] - mu; s2 += (v[j].x * v[j].x + v[j].y * v[j].y) + (v[j].z * v[j].z + v[j].w * v[j].w); }
        const float rs = 1.f / sqrtf(wave_sum(s2) * (1.f / DM) + LN_EPS);
        f32x4* orow = (f32x4*)(A.out + (size_t)m * DM) + F.lane;
#pragma unroll
        for (int j = 0; j < 4; ++j) orow[64 * j] = v[j] * rs * g2[j] + b2[j];
    }
}

#define XB_TMO      128
#define XB_XCNT(j)  (256  + 64 * (j))
#define XB_XSUB(j)  (1280 + 64 * (j))
#define XB_XGEN(j)  (2304 + 64 * (j))
#define XB_TOP      3328
#define XB_TOPGEN   3392
#define XCD_BAR_WORDS 3456
#define XB_SPIN_CAP (1u << 18)
__device__ __forceinline__ unsigned xb_ld(unsigned* p)              { return __hip_atomic_load(p, __ATOMIC_RELAXED, __HIP_MEMORY_SCOPE_AGENT); }
__device__ __forceinline__ unsigned xb_add(unsigned* p, unsigned v) { return __hip_atomic_fetch_add(p, v, __ATOMIC_RELAXED, __HIP_MEMORY_SCOPE_AGENT); }
__device__ __forceinline__ unsigned xb_xcc_id() { return (unsigned)__builtin_amdgcn_s_getreg((3 << 11) | 20) & 0xFu; }
#define XB_SPIN(cond, bar) do { unsigned _sp = 0; while (cond) { __builtin_amdgcn_s_sleep(1); \
    if ((++_sp & 255u) == 0u) { if (xb_ld(&(bar)[XB_TMO])) break; if (_sp > XB_SPIN_CAP) { atomicAdd(&(bar)[XB_TMO], 1u); break; } } } } while (0)
__device__ __forceinline__ void xcd_barrier_complete(unsigned* bar, unsigned x, unsigned& nloc, unsigned& nx) {
    const unsigned G = gridDim.x * gridDim.y * gridDim.z;
    unsigned sum, cnt, mine, sp = 0u;
    for (;;) {
        sum = 0u; cnt = 0u; mine = 0u;
#pragma unroll
        for (unsigned j = 0; j < 16; ++j) { const unsigned c = xb_ld(&bar[XB_XCNT(j)]); sum += c; cnt += (c > 0u) ? 1u : 0u; mine = (j == x) ? c : mine; }
        if (sum == G) break;
        __builtin_amdgcn_s_sleep(1);
        if ((++sp & 255u) == 0u) { if (xb_ld(&bar[XB_TMO])) break; if (sp > XB_SPIN_CAP) { atomicAdd(&bar[XB_TMO], 1u); break; } }
    }
    nloc = mine > 0u ? mine : 1u; nx = cnt > 0u ? cnt : 1u;
}
__device__ __forceinline__ void xcd_barrier(unsigned* bar, volatile LAS unsigned* st, unsigned x, bool leader_thread) {
    asm volatile("s_waitcnt vmcnt(0)" ::: "memory");
    __syncthreads();
    if (leader_thread) {
        __builtin_amdgcn_s_waitcnt(0);
        unsigned nloc = st[0], nx = st[1];
        if (nloc == 0u) { xcd_barrier_complete(bar, x, nloc, nx); st[0] = nloc; st[1] = nx; }
        const unsigned old = xb_add(&bar[XB_XSUB(x)], 1u);
        const unsigned gen = old / nloc;
        if (old + 1u == (gen + 1u) * nloc) {
            __builtin_amdgcn_fence(__ATOMIC_RELEASE, "agent");
            asm volatile("s_waitcnt vmcnt(0)" ::: "memory");
            const unsigned og = xb_add(&bar[XB_TOP], 1u);
            const unsigned tg = og / nx;
            if (og + 1u == (tg + 1u) * nx) xb_add(&bar[XB_TOPGEN], 1u);
            else XB_SPIN(xb_ld(&bar[XB_TOPGEN]) == tg, bar);
            __builtin_amdgcn_fence(__ATOMIC_ACQUIRE, "agent");
            xb_add(&bar[XB_XGEN(x)], 1u);
            asm volatile("s_waitcnt vmcnt(0)" ::: "memory");
        } else {
            XB_SPIN(xb_ld(&bar[XB_XGEN(x)]) == gen, bar);
            __builtin_amdgcn_fence(__ATOMIC_ACQUIRE, "agent");
            asm volatile("s_waitcnt vmcnt(0)" ::: "memory");
        }
    }
    __syncthreads();
}

template <bool COOP>
__global__ void __launch_bounds__(512, 2) mega(Args args) {
    extern __shared__ __attribute__((aligned(16))) unsigned char lds_raw[];
    Ctx F;
    const int wave0 = __builtin_amdgcn_readfirstlane(threadIdx.x >> 6);
#define MKCTX() do { F.a = &args; F.ws = args.ws; F.lds = (LAS unsigned char*)lds_raw; F.ldsg = lds_raw; F.lane = lane_id_asm(); F.wave = wave0; F.tid = wave0 * 64 + F.lane; \
    F.G = gridDim.x; { const int bx = blockIdx.x; F.vcu = (F.G % 8 == 0) ? (bx % 8) * (F.G / 8) + bx / 8 : bx; } } while (0)
    MKCTX();
    const int lo = args.ph_lo, hi = args.ph_hi;
    unsigned char* ws = args.ws;
#ifndef PHMASK
#define PHMASK 0xFFFF
#endif
#define IN(k) (((PHMASK >> (k)) & 1) && lo <= (k) && (k) < hi)
    unsigned* barw = (unsigned*)(ws + WS_CTL) + CW_BAR; volatile LAS unsigned* bst = (volatile LAS unsigned*)((LAS unsigned char*)lds_raw + LDS_BYTES - 64);
    const unsigned my_xcc = xb_xcc_id();
    if (COOP) { if (threadIdx.x == 0) { bst[0] = 0u; bst[1] = 0u; (void)xb_add(&barw[XB_XCNT(my_xcc)], 1u); } __syncthreads(); }
#define SEAM(k) do { if (COOP && IN(k) && IN((k) + 1)) { if (args.ph_hi > 1000) cg::this_grid().sync();   xcd_barrier(barw, bst, my_xcc, wave0 == 0 && lane_id_asm() == 0); } } while (0)
    if (IN(0)) { MKCTX(); ph_prologue(F); } SEAM(0);
    if (IN(1)) {
        constexpr int NSLOT = 4;
        const int wslot = (F.G % 8 == 0) ? ((int)blockIdx.x / 8) % NSLOT : (int)blockIdx.x % NSLOT;
        if (wslot == 0) { MKCTX(); ph_wconv(F); }
        {
            pg8::Gemm g{(const bf16_t*)(ws + WS_H0), (const bf16_t*)(ws + WS_WIN), DM, DM, DM, nullptr}; pg8::StaticOrder S; S.init(T, PN8_LO * 256, F.G, (int)blockIdx.x, 0);
            const pg8::Epi1 E{(bf16_t*)(ws + WS_YAB), (bf16_t*)(ws + WS_GV), ws + WS_Q, ws + WS_K, ws + WS_V, (bf16_t*)(ws + WS_SA), (bf16_t*)(ws + WS_SB), (float*)(ws + WS_GVST), (float*)(ws + WS_KMEAN), 1.0f, 0.f};
            pg8::gemm_phase<pg8::Epi1, pg8::StaticOrder, true>(F.lds, g, S, E, wave0);
        }
#pragma unroll 1
        for (int part = 0; part < 2; ++part) {
            if (wslot == 1 + part) { MKCTX(); ph_wconv(F); }
            const pg8::Epi1 E{(bf16_t*)(ws + WS_YAB), (bf16_t*)(ws + WS_GV), ws + WS_Q, ws + WS_K, ws + WS_V, (bf16_t*)(ws + WS_SA), (bf16_t*)(ws + WS_SB), (float*)(ws + WS_GVST), (float*)(ws + WS_KMEAN), 0.03125f, 0.f};
            pg8::Gemm g{(const bf16_t*)(ws + WS_H0F8), (const bf16_t*)(ws + WS_WIN8), DM / 2, DM / 2, DM / 2, nullptr}; pg8::StaticOrder S; if (part == 0) S.init(T, 12 * 256, F.G, (int)blockIdx.x, 4, 4, 12); else S.init(T, 12 * 256, F.G, (int)blockIdx.x, 8);
            pg8::gemm_phase<pg8::Epi1, pg8::StaticOrder, true, true>(F.lds, g, S, E, wave0);
        }
        if (wslot == 3) { MKCTX(); ph_wconv(F); }
    } SEAM(1);
    if (IN(2)) { MKCTX(); ph_mixer_a(F); __syncthreads(); ph_gate(F); } SEAM(2);
    if (IN(3)) { } if (COOP && IN(3) && IN(4)) { }
    if (IN(4)) { MKCTX(); ph_attn_partial(F); } SEAM(4);
    if (IN(5)) { MKCTX(); ph_attn_own(F); } SEAM(5);
    if (IN(6)) {
        pg8::Gemm g{(const bf16_t*)(ws + WS_YA8), (const bf16_t*)(ws + WS_WAB), 2048 / 2, 2048 / 2, 2048 / 2, nullptr}; pg8::StaticOrder S; S.init(T, DM, F.G, (int)blockIdx.x);
        pg8::Epi2 E{ws + WS_SA, ws + WS_SB, (bf16_t*)(ws + WS_MG)};
        pg8::gemm_phase<pg8::Epi2, pg8::StaticOrder, true, true>(F.lds, g, S, E, wave0);
    } SEAM(6);
    if (IN(7)) {
        pg8::Gemm g{(const bf16_t*)(ws + WS_MG), (const bf16_t*)(ws + WS_WOUT), DM, DM, DM, nullptr}; pg8::StaticOrder S; S.init(T, DM, F.G, (int)blockIdx.x);
        pg8::Epi3 E{(const bf16_t*)(ws + WS_H0), (bf16_t*)(ws + WS_Z), (float*)(ws + WS_ZST)};
        pg8::gemm_phase<pg8::Epi3, pg8::StaticOrder, true>(F.lds, g, S, E, wave0);
    } SEAM(7);
    if (IN(8)) { MKCTX(); ph_router(F); } SEAM(8);
    if (IN(9)) { } if (COOP && IN(9) && IN(10)) { }
    if (IN(10)) {
        MKCTX(); moe_table(F);
        pg8::Gemm g{(const bf16_t*)(ws + WS_H1F8), (const bf16_t*)(ws + WS_WUP), DM / 2, DM / 2, DM / 2, (const int*)(ws + WS_RT)}; pg8::MoeOrder S;   S.init((const LAS int*)(F.lds + LDS_MOE), 8, F.G, (int)blockIdx.x);
        pg8::Epi4 E{args.in[I_BUP], ws + WS_ACT};
        pg8::gemm_phase<pg8::Epi4, pg8::MoeOrder, true, true, true>(F.lds, g, S, E, wave0);
    } SEAM(10);
    if (IN(11)) {
        MKCTX(); moe_table(F);
        pg8::Gemm g{(const bf16_t*)(ws + WS_ACT), (const bf16_t*)(ws + WS_WDN), FF / 2, FF / 2, FF / 2, nullptr}; pg8::MoeOrder S; S.init((const LAS int*)(F.lds + LDS_MOE), 4, F.G, (int)blockIdx.x);
        pg8::Epi5 E{args.in[I_BDN], (const float*)(ws + WS_RW), ws + WS_YS};
        pg8::gemm_phase<pg8::Epi5, pg8::MoeOrder, true, true>(F.lds, g, S, E, wave0);
    } SEAM(11);
    if (IN(12)) { MKCTX(); moe_table(F); ph_final(F); }
#undef IN
#undef SEAM
}

extern "C" void kernel_launch(void* const* d_in, const int* in_sizes, int n_in, void* d_out, int out_size, void* d_ws, size_t ws_size, hipStream_t stream) {
    static int grid = 0;
    if (grid == 0) {
        if (n_in != 21 || in_sizes[0] != T * DM || out_size != T * DM || ws_size < WS_END) { fprintf(stderr, "kernel_launch: unexpected shapes (n_in %d, in0 %d, out %d, ws %zu)\n", n_in, n_in > 0 ? in_sizes[0] : -1, out_size, ws_size); grid = -1; return; }
        int dev = 0, cus = 0, per_cu = 0;
        hipGetDevice(&dev); hipDeviceGetAttribute(&cus, hipDeviceAttributeMultiprocessorCount, dev);
        const void* fn = MK_COOP ? (const void*)mega<true> : (const void*)mega<false>;
        hipFuncSetAttribute(fn, hipFuncAttributeMaxDynamicSharedMemorySize, LDS_BYTES);
        hipOccupancyMaxActiveBlocksPerMultiprocessor(&per_cu, fn, 512, LDS_BYTES);
        (void)hipGetLastError();
        if (per_cu < 1) { fprintf(stderr, "kernel_launch: occupancy query says %d blocks/CU\n", per_cu); per_cu = 1; }
        grid = cus * 1;
    }
    if (grid < 0) return;
    hipMemsetAsync((char*)d_ws + WS_CTL, 0, CTL_ZERO_BYTES, stream);
    Args a{};
    for (int i = 0; i < 21; ++i) a.in[i] = (const float*)d_in[i];
    a.out = (float*)d_out; a.ws = (unsigned char*)d_ws;
#if MK_COOP
    a.ph_lo = 0; a.ph_hi = NPHASE;
    void* kargs[] = {&a};
    hipError_t e = hipLaunchCooperativeKernel((const void*)mega<true>, dim3(grid), dim3(512), kargs, LDS_BYTES, stream);
    if (e != hipSuccess) fprintf(stderr, "cooperative launch failed: %s (grid %d)\n", hipGetErrorString(e), grid);
#else
    for (int p = 0; p < NPHASE; ++p) { a.ph_lo = p; a.ph_hi = p + 1; hipLaunchKernelGGL(mega<false>, dim3(grid), dim3(512), LDS_BYTES, stream, a); }
#endif
}
```

```cpp
#include <hip/hip_runtime.h>
#include <hip/hip_cooperative_groups.h>
#include <cstdio>
#include <cstdint>
namespace cg = cooperative_groups;

#ifndef MK_COOP
#define MK_COOP 1
#endif

#define LAS __attribute__((address_space(3)))
typedef unsigned short bf16_t;
typedef short bf16x8 __attribute__((ext_vector_type(8)));
typedef float f32x4 __attribute__((ext_vector_type(4)));
typedef float f32x2 __attribute__((ext_vector_type(2)));
typedef unsigned u32x4 __attribute__((ext_vector_type(4)));
typedef unsigned u32x2 __attribute__((ext_vector_type(2)));

constexpr int NB = 8, SEQ = 4096, DM = 1024, T = NB * SEQ;
constexpr int NH = 8, DH = 128, LBLK = 256, NBLK = SEQ / LBLK;
constexpr int NE = 32, TOPK = 4, FF = 1024;
constexpr int INCOLS = 7 * DM;
constexpr int RMAX = T * TOPK + NE * 256;
constexpr float LN_EPS = 1e-5f;
constexpr float ALPHA = 1.189207115002721f;
constexpr float QSCALE = 0.08838834764831845f * 1.4426950408889634f;

constexpr size_t MiB = 1u << 20, U64 = 64 * MiB;
constexpr size_t WS_CTL = 0, CTL_ZERO_BYTES = 1 * MiB;
constexpr int CW_ECNT = 64;
constexpr int CW_LCNT = 1024;
constexpr int CW_BAR = 4096;
constexpr size_t WS_KMEAN = 1 * MiB;
constexpr size_t WS_GVST = 2 * MiB;
constexpr size_t WS_ZST = 6 * MiB;
constexpr size_t WS_SEL = 10 * MiB;
constexpr size_t WS_TKE = 11 * MiB;
constexpr size_t WS_TKW = 11 * MiB + 512 * 1024;
constexpr size_t WS_TKP = 12 * MiB;
constexpr size_t WS_ROWOF = 12 * MiB + 512 * 1024;
constexpr size_t WS_ROWTOK = 13 * MiB;
constexpr size_t WS_ROWW = 14 * MiB;
constexpr size_t WS_TILE = 15 * MiB;
constexpr size_t WS_LISTS = 16 * MiB;
constexpr size_t WS_LSE = 32 * MiB;
constexpr size_t WS_RT = 16 * MiB;
constexpr size_t WS_RW = 20 * MiB;
constexpr int LDS_MOE = 131072 + 1024;
constexpr size_t WS_WIN = 40 * MiB;
constexpr size_t WS_WAB = 54 * MiB;
constexpr size_t WS_WOUT = 58 * MiB;
constexpr size_t WS_WDN = 60 * MiB;
constexpr size_t WS_WUP = 124 * MiB;
constexpr size_t WS_H0 = 4 * U64;
constexpr size_t WS_YAB = 5 * U64;
constexpr size_t WS_GV = 7 * U64;
constexpr size_t WS_Q = 8 * U64, WS_K = 9 * U64, WS_V = 10 * U64, WS_SA = 11 * U64, WS_SB = 12 * U64;
constexpr size_t WS_OP = 13 * U64;
constexpr size_t WS_MG = WS_GV;
constexpr size_t WS_Z = 14 * U64;
constexpr size_t WS_H1 = WS_H0;
constexpr size_t WS_XG = 5 * U64;
constexpr size_t WS_H1F8 = 12 * U64;
constexpr size_t WS_ACT = 9 * U64 + 16 * MiB;
constexpr size_t WS_YS = WS_XG;
constexpr size_t WS_H0F8 = 13 * U64;
constexpr size_t WS_WIN8 = 192 * MiB;
constexpr int PN8_LO = 4, PN8_HI = 28;
constexpr size_t WS_YA8 = 15 * U64;
constexpr size_t WS_END = 16 * U64;
static_assert(WS_XG + (size_t)RMAX * 2048 <= WS_ACT && WS_ACT + (size_t)RMAX * 2048 <= WS_Z, "ws map");

constexpr int LDS_BYTES = 163840;
constexpr int LDS_MISC = 131072;
constexpr int NPHASE = 13;

__device__ __forceinline__ float bf2f(bf16_t v) { return __uint_as_float((unsigned)v << 16); }
__device__ __forceinline__ float bflo(unsigned u) { return __uint_as_float(u << 16); }
__device__ __forceinline__ float bfhi(unsigned u) { return __uint_as_float(u & 0xffff0000u); }
__device__ __forceinline__ unsigned f2bf(float f) { unsigned u = __builtin_bit_cast(unsigned, f); return (u + 0x7fffu + ((u >> 16) & 1u)) >> 16; }
__device__ __forceinline__ unsigned pk2(float lo, float hi) { return f2bf(lo) | (f2bf(hi) << 16); }
typedef __bf16 bf16x2_t __attribute__((ext_vector_type(2)));
__device__ __forceinline__ unsigned cvt_pk_bf16(float lo, float hi) { f32x2 v = {lo, hi}; bf16x2_t b = __builtin_convertvector(v, bf16x2_t); return __builtin_bit_cast(unsigned, b); }
__device__ __forceinline__ int lane_id_asm() { int l; asm volatile("v_mbcnt_lo_u32_b32 %0, -1, 0\n\tv_mbcnt_hi_u32_b32 %0, -1, %0" : "=v"(l)); return l; }
__device__ __forceinline__ float wave_sum(float v) {
#pragma unroll
    for (int o = 1; o < 64; o <<= 1) v += __shfl_xor(v, o);
    return v;
}
__device__ __forceinline__ float wave_max(float v) {
#pragma unroll
    for (int o = 1; o < 64; o <<= 1) v = fmaxf(v, __shfl_xor(v, o));
    return v;
}
__device__ __forceinline__ f32x2 gelu_pk(f32x2 v) {
    const f32x2 av = __builtin_elementwise_abs(v), d = av * 0.2316418882f + 1.0f;
    f32x2 t; t.x = __builtin_amdgcn_rcpf(d.x); t.y = __builtin_amdgcn_rcpf(d.y);
    f32x2 q = t * 0.5307027145f + (-0.7265760135f); q = q * t + 0.7107068705f; q = q * t + (-0.142248368f); q = q * t + 0.127414796f; q = q * t;
    const f32x2 s = (v * v) * (-0.72134752044f);
    f32x2 e; e.x = __builtin_amdgcn_exp2f(s.x); e.y = __builtin_amdgcn_exp2f(s.y);
    const f32x2 m = v * (q * e), r = v - m;
    f32x2 o; o.x = v.x < 0.f ? m.x : r.x; o.y = v.y < 0.f ? m.y : r.y; return o;
}
typedef float f32x2v __attribute__((ext_vector_type(2)));
template <bool HI> __device__ __forceinline__ unsigned f8x2_to_bf16x2(unsigned w) { const f32x2v f = __builtin_amdgcn_cvt_pk_f32_fp8((int)w, HI); return cvt_pk_bf16(f.x, f.y); }
__device__ __forceinline__ u32x4 f8x8_to_bf16x8(unsigned lo, unsigned hi) { return (u32x4){f8x2_to_bf16x2<false>(lo), f8x2_to_bf16x2<true>(lo), f8x2_to_bf16x2<false>(hi), f8x2_to_bf16x2<true>(hi)}; }
__device__ __forceinline__ unsigned pack_fp8x4(float a, float b, float c, float d) { unsigned w = 0u; w = __builtin_amdgcn_cvt_pk_fp8_f32(a, b, w, false); w = __builtin_amdgcn_cvt_pk_fp8_f32(c, d, w, true); return w; }
__device__ __forceinline__ float sigmoidf_(float x) { return __builtin_amdgcn_rcpf(1.0f + __builtin_amdgcn_exp2f(-1.4426950408889634f * x)); }

namespace pg8 {
constexpr int BM = 256, BK = 64, HALF = 128, HTB = HALF * BK * 2, STAGE_BYTES = 8 * HTB, NXCD = 8, WGM = 4;
__host__ __device__ __forceinline__ int lds_byte(int r, int c) { const int st = (r >> 4) * 2 + (c >> 5), rr = r & 15, cc = c & 31, ob = rr * 64 + cc * 2; return st * 1024 + (ob ^ (((ob >> 9) & 1) << 5)); }
__host__ __device__ __forceinline__ void stage_rc(int b, int& R, int& C) { const int st = b / 1024, sb = b % 1024, swz = sb ^ (((sb >> 9) & 1) << 5); R = (st >> 1) * 16 + swz / 64; C = (st & 1) * 32 + (swz % 64) / 2; }
__host__ __device__ __forceinline__ int perm32(int rho) { const int n = rho >> 4, i = rho & 15; return 8 * (i >> 2) + 4 * n + (i & 3); }

struct Unit { int pm, pn, bt, rbase; };
struct Gemm { const bf16_t* A; const bf16_t* Bt; int K, lda, ldb; const int* rowidx; };

struct StaticOrder {
    int nM, nN, nwg, G, c, pbase, psplit, pjump;
    __device__ void init(int M, int N, int G_, int c_, int pbase_ = 0, int psplit_ = 1 << 20, int pjump_ = 0) { nM = M / BM; nN = N / BM; nwg = nM * nN; G = G_; c = c_; pbase = pbase_; psplit = psplit_; pjump = pjump_; }
    __device__ bool next(int i, Unit& u) const {
        const long L = (long)i * G + c; if (L >= nwg) return false;
        int wgid = (int)L; { const int q = nwg / NXCD, r = nwg % NXCD, xcd = wgid % NXCD, off = wgid / NXCD; wgid = (xcd < r ? xcd * (q + 1) : r * (q + 1) + (xcd - r) * q) + off; }
        const int nig = WGM * nN, gid = wgid / nig, fm = gid * WGM, gsz = (nM - fm) < WGM ? (nM - fm) : WGM;
        u.pm = fm + ((wgid % nig) % gsz); const int p = (wgid % nig) / gsz; u.pn = pbase + (p < psplit ? p : p + pjump); u.bt = u.pn; u.rbase = u.pm * BM; return true;
    }
};
struct MoeOrder {
    int nM, nN, nwg, G, c; const LAS int* tab;
    __device__ void init(const LAS int* tiletab, int nN_, int G_, int c_) { nM = tiletab[0]; tab = tiletab; nN = nN_; nwg = nM * nN; G = G_; c = c_; }
    __device__ bool next(int i, Unit& u) const {
        const long L = (long)i * G + c; if (L >= nwg) return false;
        int wgid = (int)L; { const int q = nwg / NXCD, r = nwg % NXCD, xcd = wgid % NXCD, off = wgid / NXCD; wgid = (xcd < r ? xcd * (q + 1) : r * (q + 1) + (xcd - r) * q) + off; }
        const int nig = WGM * nN, gid = wgid / nig, fm = gid * WGM, gsz = (nM - fm) < WGM ? (nM - fm) : WGM;
        u.pm = fm + ((wgid % nig) % gsz); u.pn = (wgid % nig) / gsz; { const int e = tab[128 + 2 * u.pm], tl = tab[129 + 2 * u.pm]; u.bt = e * nN + u.pn; u.rbase = e * T + tl * BM; } return true;
    }
};

typedef int v4i_t __attribute__((ext_vector_type(4)));
typedef int v8i_t __attribute__((ext_vector_type(8)));
template <class Epi, class Sched, bool ALIGN_EPI, bool FP8 = false, bool GATHER = false>
__device__ __forceinline__ void gemm_phase(LAS unsigned char* lds, const Gemm g, const Sched& S, const Epi& E, const int wid) {
    const int lane = lane_id_asm(), tid = wid * 64 + lane;
    const int wr = wid >> 2, wc = wid & 3, fr = lane & 15, fq = lane >> 4;
    const int nt = g.K / BK;
    unsigned voffA[2], voffB[2]; int gR[2];
#pragma unroll
    for (int i = 0; i < 2; ++i) { int R, C; stage_rc(tid * 16 + i * 8192, R, C); const int Rb = Epi::PERM ? ((R & ~31) + perm32(R & 31)) : R;
        voffA[i] = GATHER ? (unsigned)C * 2u : (unsigned)(R * g.lda + C) * 2u; voffB[i] = (unsigned)(Rb * g.ldb + C) * 2u; gR[i] = R; }
    const size_t kstep = (size_t)(BK * 2);
    const size_t hstepA = GATHER ? 0 : (size_t)HALF * g.lda * 2, hstepB = (size_t)HALF * g.ldb * 2;
    const size_t tstepA = 2 * hstepA, tstepB = 2 * hstepB;
    const unsigned ldsw = (unsigned)wid * 1024u;
    const int aoff = lds_byte(wr * 64 + fr, fq * 8), boff = lds_byte(wc * 32 + fr, fq * 8);
#define PG8_SA(b, h) (((b) * 2 + (h)) * HTB)
#define PG8_SB(b, h) ((4 + (b) * 2 + (h)) * HTB)
#define PG8_STAGE(bufoff, gbase, voff) do { _Pragma("unroll") for (int _i = 0; _i < 2; ++_i) \
        __builtin_amdgcn_global_load_lds((const unsigned*)((const char*)(gbase) + (voff)[_i]), (LAS unsigned*)(lds + (bufoff) + ldsw + _i * 8192), 16, 0, 0); } while (0)
#define PG8_LD8(p) __builtin_shufflevector(*(const LAS v4i_t*)(p), *(const LAS v4i_t*)((p) + 1024), 0, 1, 2, 3, 4, 5, 6, 7)
#define PG8_LDA(dst, b, h) do { _Pragma("unroll") for (int m = 0; m < 4; ++m) { if constexpr (FP8) dst##8[m] = PG8_LD8(lds + PG8_SA(b, h) + aoff + m * 2048); \
        else { _Pragma("unroll") for (int k = 0; k < 2; ++k) dst[m][k] = *(const LAS bf16x8*)(lds + PG8_SA(b, h) + aoff + m * 2048 + k * 1024); } } } while (0)
#define PG8_LDB(dst, b, h) do { _Pragma("unroll") for (int n = 0; n < 2; ++n) { if constexpr (FP8) dst##8[n] = PG8_LD8(lds + PG8_SB(b, h) + boff + n * 2048); \
        else { _Pragma("unroll") for (int k = 0; k < 2; ++k) dst[n][k] = *(const LAS bf16x8*)(lds + PG8_SB(b, h) + boff + n * 2048 + k * 1024); } } } while (0)
#define PG8_MMA(ai, bj, At, Bt) do { __builtin_amdgcn_s_setprio(1); _Pragma("unroll") for (int m = 0; m < 4; ++m) _Pragma("unroll") for (int n = 0; n < 2; ++n) { \
        if constexpr (FP8) { asm volatile("s_nop 1\n\tv_mfma_scale_f32_16x16x128_f8f6f4 %0, %1, %2, %0, %3, %3 op_sel_hi:[0,0,0]" : "+v"(acc[ai][bj][m][n]) : "v"(Bt##8[n]), "v"(At##8[m]), "v"(scl8)); } \
        else { _Pragma("unroll") for (int k = 0; k < 2; ++k) acc[ai][bj][m][n] = __builtin_amdgcn_mfma_f32_16x16x32_bf16(Bt[n][k], At[m][k], acc[ai][bj][m][n], 0, 0, 0); } } \
        __builtin_amdgcn_s_setprio(0); } while (0)
#define PG8_WAIT_V(n) asm volatile("s_waitcnt vmcnt(" #n ")" ::: "memory")
#define PG8_WAIT_L(n) asm volatile("s_waitcnt lgkmcnt(" #n ")" ::: "memory")
#define PG8_BAR __builtin_amdgcn_s_barrier()
#define PG8_SCHED __builtin_amdgcn_sched_barrier(0)
    Unit cur, nxt; int ui = 0;
    if (!S.next(0, cur)) return;
    unsigned va0[2], va1[2], vn0[2], vn1[2];
#define PG8_GIDX(dst0, dst1, u) do { if constexpr (GATHER) { _Pragma("unroll") for (int _i = 0; _i < 2; ++_i) { \
        dst0[_i] = min((unsigned)g.rowidx[(u).rbase + gR[_i]], (unsigned)(T - 1)) * (unsigned)(g.lda * 2) + voffA[_i]; dst1[_i] = min((unsigned)g.rowidx[(u).rbase + HALF + gR[_i]], (unsigned)(T - 1)) * (unsigned)(g.lda * 2) + voffA[_i]; } } \
        else { _Pragma("unroll") for (int _i = 0; _i < 2; ++_i) { dst0[_i] = voffA[_i]; dst1[_i] = voffA[_i]; } } } while (0)
    PG8_GIDX(va0, va1, cur);
    f32x4 acc[2][2][4][2];
#pragma unroll
    for (int a = 0; a < 2; ++a)
#pragma unroll
        for (int b = 0; b < 2; ++b)
#pragma unroll
            for (int m = 0; m < 4; ++m)
#pragma unroll
                for (int n = 0; n < 2; ++n) acc[a][b][m][n] = (f32x4){0.f, 0.f, 0.f, 0.f};
    bf16x8 At[4][2], B0[2][2], B1[2][2]; v8i_t At8[4], B08[2], B18[2];
    int scl8 = 0x7f7f7f7f; asm volatile("" : "+v"(scl8));
    const char* cA = (const char*)g.A + (GATHER ? 0 : (size_t)cur.pm * tstepA); const char* cB = (const char*)g.Bt + (size_t)cur.bt * tstepB;
    PG8_STAGE(PG8_SB(0, 0), cB, voffB); PG8_STAGE(PG8_SB(0, 1), cB + hstepB, voffB); PG8_STAGE(PG8_SA(0, 0), cA, va0); PG8_STAGE(PG8_SA(0, 1), cA + hstepA, va1);
    if (wr == 1) PG8_BAR;
    PG8_WAIT_V(2); PG8_BAR;
    PG8_STAGE(PG8_SB(1, 0), cB + kstep, voffB); PG8_STAGE(PG8_SA(1, 0), cA + kstep, va0); PG8_STAGE(PG8_SB(1, 1), cB + hstepB + kstep, voffB);
    PG8_WAIT_V(6); PG8_BAR;
    for (;;) {
        const bool has_next = S.next(ui + 1, nxt);
        const char* nA = (has_next && !GATHER) ? (const char*)g.A + (size_t)nxt.pm * tstepA : cA; const char* nB = has_next ? (const char*)g.Bt + (size_t)nxt.bt * tstepB : cB;
        if (has_next) PG8_GIDX(vn0, vn1, nxt); else { _Pragma("unroll") for (int _i = 0; _i < 2; ++_i) { vn0[_i] = va0[_i]; vn1[_i] = va1[_i]; } }
#pragma unroll 1
        for (int t = 0; t < nt; t += 2) {
            const bool last = (t == nt - 2);
            const char* a1 = cA + (size_t)(t + 1) * kstep;
            const char* a2 = last ? nA : cA + (size_t)(t + 2) * kstep; const char* b2 = last ? nB : cB + (size_t)(t + 2) * kstep;
            const char* a3 = a2 + kstep; const char* b3 = b2 + kstep;
            if constexpr (Epi::MID_T > 0) { if (t == Epi::MID_T) {
                if constexpr (FP8) {
#pragma unroll
                    for (int a = 0; a < 2; ++a)
#pragma unroll
                        for (int b = 0; b < 2; ++b)
                            asm volatile("s_nop 15\n\ts_nop 7" : "+v"(acc[a][b][0][0]), "+v"(acc[a][b][0][1]), "+v"(acc[a][b][1][0]), "+v"(acc[a][b][1][1]), "+v"(acc[a][b][2][0]), "+v"(acc[a][b][2][1]), "+v"(acc[a][b][3][0]), "+v"(acc[a][b][3][1]));
                }
                E.mid(acc, cur, wr, wc, fr, fq); } }
            unsigned vs0[2], vs1[2];
#pragma unroll
            for (int _i = 0; _i < 2; ++_i) { vs0[_i] = last ? vn0[_i] : va0[_i]; vs1[_i] = last ? vn1[_i] : va1[_i]; }
            PG8_LDB(B0, 0, 0); PG8_LDB(B1, 0, 1); PG8_SCHED; PG8_LDA(At, 0, 0); PG8_STAGE(PG8_SA(1, 1), a1 + hstepA, va1);
            PG8_WAIT_V(8); PG8_WAIT_L(0); PG8_BAR; PG8_MMA(0, 0, At, B0); PG8_MMA(0, 1, At, B1); PG8_BAR; PG8_SCHED;
            PG8_LDA(At, 0, 1); PG8_STAGE(PG8_SB(0, 0), b2, voffB); PG8_STAGE(PG8_SB(0, 1), b2 + hstepB, voffB); PG8_STAGE(PG8_SA(0, 0), a2, vs0);
            PG8_WAIT_V(8); PG8_WAIT_L(0); PG8_BAR; PG8_MMA(1, 0, At, B0); PG8_MMA(1, 1, At, B1); PG8_BAR; PG8_SCHED;
            PG8_LDB(B0, 1, 0); PG8_LDB(B1, 1, 1); PG8_SCHED; PG8_LDA(At, 1, 0); PG8_STAGE(PG8_SA(0, 1), a2 + hstepA, vs1);
            PG8_WAIT_V(8); PG8_WAIT_L(0); PG8_BAR; PG8_MMA(0, 0, At, B0); PG8_MMA(0, 1, At, B1); PG8_BAR; PG8_SCHED;
            PG8_LDA(At, 1, 1); PG8_STAGE(PG8_SB(1, 0), b3, voffB); PG8_STAGE(PG8_SB(1, 1), b3 + hstepB, voffB); PG8_STAGE(PG8_SA(1, 0), a3, vs0);
            PG8_WAIT_V(8); PG8_WAIT_L(0); PG8_BAR; PG8_MMA(1, 0, At, B0); PG8_MMA(1, 1, At, B1); PG8_BAR; PG8_SCHED;
        }
        if constexpr (ALIGN_EPI) { if (wr == 0) PG8_BAR; }
        if constexpr (FP8) {
#pragma unroll
            for (int a = 0; a < 2; ++a)
#pragma unroll
                for (int b = 0; b < 2; ++b)
                    asm volatile("s_nop 15\n\ts_nop 7" : "+v"(acc[a][b][0][0]), "+v"(acc[a][b][0][1]), "+v"(acc[a][b][1][0]), "+v"(acc[a][b][1][1]), "+v"(acc[a][b][2][0]), "+v"(acc[a][b][2][1]), "+v"(acc[a][b][3][0]), "+v"(acc[a][b][3][1]));
        }
        E(acc, cur, wr, wc, fr, fq);
        if (!has_next) break;
#pragma unroll
        for (int a = 0; a < 2; ++a)
#pragma unroll
            for (int b = 0; b < 2; ++b)
#pragma unroll
                for (int m = 0; m < 4; ++m)
#pragma unroll
                    for (int n = 0; n < 2; ++n) acc[a][b][m][n] = (f32x4){0.f, 0.f, 0.f, 0.f};
        cur = nxt; cA = nA; cB = nB; ++ui;
#pragma unroll
        for (int _i = 0; _i < 2; ++_i) { va0[_i] = vn0[_i]; va1[_i] = vn1[_i]; }
        if constexpr (ALIGN_EPI) { if (wr == 1) PG8_BAR; }
    }
    PG8_WAIT_V(0);
    if constexpr (!ALIGN_EPI) { if (wr == 0) PG8_BAR; }
    PG8_BAR;
#undef PG8_SA
#undef PG8_SB
#undef PG8_STAGE
#undef PG8_GIDX
#undef PG8_LDA
#undef PG8_LDB
#undef PG8_MMA
#undef PG8_LD8
#undef PG8_WAIT_V
#undef PG8_WAIT_L
#undef PG8_BAR
#undef PG8_SCHED
}

typedef f32x4 Acc[2][2][4][2];

__device__ __forceinline__ u32x4 pair16(u32x2 x, u32x2 y) {
    const auto r0 = __builtin_amdgcn_permlane16_swap(x.x, y.x, false, false);
    const auto r1 = __builtin_amdgcn_permlane16_swap(x.y, y.y, false, false);
    return (u32x4){r0[0], r1[0], r0[1], r1[1]};
}
struct Epi1 {
    static constexpr bool PERM = true; static constexpr int MID_T = 0;
    bf16_t *yab, *gv; unsigned char *q, *k, *v; bf16_t *sa, *sb; float* gvst; float* kmp; float sc, pad_;
    template <int MODE  >
    __device__ __forceinline__ void run(const Acc& acc, const Unit& u, int wr, int wc, int fr, int fq, bf16_t* base, int ld) const {
        const int row0 = u.pm * BM + wr * 64 + fr, col0 = (u.pn & 3) * 256 + wc * 32 + 8 * fq;
        const int colp = (u.pn & 3) * 256 + wc * 32 + 8 * (fq & ~1);
        f32x4 csA0 = {0.f, 0.f, 0.f, 0.f}, csB0 = csA0, csA1 = csA0, csB1 = csA0;
#pragma unroll
        for (int ai = 0; ai < 2; ++ai)
#pragma unroll
            for (int mp = 0; mp < 2; ++mp) {
                u32x2 pc[2][2];
#pragma unroll
                for (int k = 0; k < 2; ++k) {
                    const int m = 2 * mp + k;
                    const int row = row0 + ai * HALF + m * 16; bf16_t* rowp = base + (size_t)row * ld + col0;
                    float s1 = 0.f, s2 = 0.f;
#pragma unroll
                    for (int bj = 0; bj < 2; ++bj) {
                        f32x4 v0 = acc[ai][bj][m][0], v1 = acc[ai][bj][m][1];
                        if (MODE == 2 || MODE == 3 || MODE == 5) {
                            const float f = (MODE == 2) ? sc * QSCALE : sc; v0 = v0 * f; v1 = v1 * f;
                            if (MODE == 5) { if (bj == 0) { csA0 = csA0 + v0; csB0 = csB0 + v1; } else { csA1 = csA1 + v0; csB1 = csB1 + v1; } }
                            pc[bj][k] = (u32x2){pack_fp8x4(v0[0], v0[1], v0[2], v0[3]), pack_fp8x4(v1[0], v1[1], v1[2], v1[3])};
                            continue;
                        }
                        if (MODE == 0 || MODE == 1) {
                            v0 = v0 * sc; v1 = v1 * sc;
                            f32x2 a = gelu_pk((f32x2){v0[0], v0[1]}), b = gelu_pk((f32x2){v0[2], v0[3]}), c = gelu_pk((f32x2){v1[0], v1[1]}), d = gelu_pk((f32x2){v1[2], v1[3]});
                            v0 = (f32x4){a.x, a.y, b.x, b.y}; v1 = (f32x4){c.x, c.y, d.x, d.y};
                        } else if (MODE == 4) {
                            { const float cs_ = -1.4426950408889634f * sc; const f32x4 t0 = v0 * cs_, t1 = v1 * cs_; f32x4 e0, e1;
#pragma unroll
                              for (int j = 0; j < 4; ++j) { e0[j] = __builtin_amdgcn_exp2f(t0[j]); e1[j] = __builtin_amdgcn_exp2f(t1[j]); }
                              e0 = e0 + 1.0f; e1 = e1 + 1.0f;
#pragma unroll
                              for (int j = 0; j < 4; ++j) { v0[j] = __builtin_amdgcn_rcpf(e0[j]); v1[j] = __builtin_amdgcn_rcpf(e1[j]); } }
                            pc[bj][k] = (u32x2){pack_fp8x4(v0[0], v0[1], v0[2], v0[3]), pack_fp8x4(v1[0], v1[1], v1[2], v1[3])};
                            continue;
                        }
                        if (MODE == 1) {
                            s1 += (v0[0] + v0[1]) + (v0[2] + v0[3]) + (v1[0] + v1[1]) + (v1[2] + v1[3]);
                            s2 += (v0[0] * v0[0] + v0[1] * v0[1]) + (v0[2] * v0[2] + v0[3] * v0[3]) + (v1[0] * v1[0] + v1[1] * v1[1]) + (v1[2] * v1[2] + v1[3] * v1[3]);
                            pc[bj][k] = (u32x2){pack_fp8x4(v0[0], v0[1], v0[2], v0[3]), pack_fp8x4(v1[0], v1[1], v1[2], v1[3])};
                            continue;
                        }
                        u32x4 w; w.x = cvt_pk_bf16(v0[0], v0[1]); w.y = cvt_pk_bf16(v0[2], v0[3]); w.z = cvt_pk_bf16(v1[0], v1[1]); w.w = cvt_pk_bf16(v1[2], v1[3]);
                        *(u32x4*)(rowp + bj * HALF) = w;
                    }
                    if (MODE == 1) {
                        s1 += __shfl_xor(s1, 16); s1 += __shfl_xor(s1, 32); s2 += __shfl_xor(s2, 16); s2 += __shfl_xor(s2, 32);
                        if (fq == 0) *(f32x2*)(gvst + ((size_t)row * 16 + (u.pn & 3) * 4 + wc) * 2) = (f32x2){s1, s2};
                    }
                }
                if (MODE != 0) {
                    const int rowst = row0 + ai * HALF + (2 * mp + (fq & 1)) * 16;
#pragma unroll
                    for (int bj = 0; bj < 2; ++bj) *(u32x4*)((unsigned char*)base + (size_t)rowst * 1024 + colp + bj * HALF) = pair16(pc[bj][0], pc[bj][1]);
                }
            }
        if (MODE == 5) {
#define KM_RED(v) do { _Pragma("unroll") for (int j_ = 0; j_ < 4; ++j_) { float x = v[j_]; x += __shfl_xor(x, 1); x += __shfl_xor(x, 2); x += __shfl_xor(x, 4); x += __shfl_xor(x, 8); v[j_] = x; } } while (0)
            KM_RED(csA0); KM_RED(csB0); KM_RED(csA1); KM_RED(csB1);
#undef KM_RED
            if (fr == 0) {
                float* kp = kmp + ((size_t)(u.pm * 2 + wr) * DM) + col0;
                *(f32x4*)kp = csA0; *(f32x4*)(kp + 4) = csB0; *(f32x4*)(kp + HALF) = csA1; *(f32x4*)(kp + HALF + 4) = csB1;
            }
        }
    }
    __device__ __forceinline__ void operator()(const Acc& acc, const Unit& u, int wr, int wc, int fr, int fq) const {
        const int region = u.pn >> 2;
        if (region == 0) run<0>(acc, u, wr, wc, fr, fq, yab, 2048);
        else if (region == 1) run<1>(acc, u, wr, wc, fr, fq, gv, 1024);
        else if (region == 2) run<2>(acc, u, wr, wc, fr, fq, (bf16_t*)q, 1024);
        else if (region == 3) run<5>(acc, u, wr, wc, fr, fq, (bf16_t*)k, 1024);
        else if (region == 4) run<3>(acc, u, wr, wc, fr, fq, (bf16_t*)v, 1024);
        else if (region == 5) run<4>(acc, u, wr, wc, fr, fq, sa, 1024);
        else run<4>(acc, u, wr, wc, fr, fq, sb, 1024);
    }
    __device__ __forceinline__ void mid(Acc&, const Unit&, int, int, int, int) const {}
};

struct Epi2 {
    static constexpr bool PERM = true; static constexpr int MID_T = 8;
    const unsigned char *sa, *sb; bf16_t* mg;
    __device__ __forceinline__ void mid(Acc& acc, const Unit& u, int wr, int wc, int fr, int fq) const {
        int row0 = u.pm * BM + wr * 64 + fr, col0 = u.pn * BM + wc * 32 + 8 * fq;
        asm volatile("" : "+v"(row0), "+v"(col0));
#pragma unroll
        for (int ai = 0; ai < 2; ++ai) {
            u32x2 av[4][2], bv[4][2];
#pragma unroll
            for (int m = 0; m < 4; ++m)
#pragma unroll
                for (int bj = 0; bj < 2; ++bj) { const size_t off = (size_t)(row0 + ai * HALF + m * 16) * DM + col0 + bj * HALF; av[m][bj] = *(const u32x2*)(sa + off); bv[m][bj] = *(const u32x2*)(sb + off); }
            asm volatile("" ::: "memory");
#pragma unroll
            for (int m = 0; m < 4; ++m) {
#pragma unroll
                for (int bj = 0; bj < 2; ++bj) {
                    const u32x2 a = av[m][bj], b = bv[m][bj];
                    const f32x2v a0 = __builtin_amdgcn_cvt_pk_f32_fp8((int)a.x, false), a1 = __builtin_amdgcn_cvt_pk_f32_fp8((int)a.x, true), a2 = __builtin_amdgcn_cvt_pk_f32_fp8((int)a.y, false), a3 = __builtin_amdgcn_cvt_pk_f32_fp8((int)a.y, true);
                    const f32x2v b0 = __builtin_amdgcn_cvt_pk_f32_fp8((int)b.x, false), b1 = __builtin_amdgcn_cvt_pk_f32_fp8((int)b.x, true), b2 = __builtin_amdgcn_cvt_pk_f32_fp8((int)b.y, false), b3 = __builtin_amdgcn_cvt_pk_f32_fp8((int)b.y, true);
                    f32x4 r0, r1;
#define RQ(x, y) ((x) * __builtin_amdgcn_rcpf(y))
                    r0[0] = RQ(a0.x, b0.x); r0[1] = RQ(a0.y, b0.y); r0[2] = RQ(a1.x, b1.x); r0[3] = RQ(a1.y, b1.y);
                    r1[0] = RQ(a2.x, b2.x); r1[1] = RQ(a2.y, b2.y); r1[2] = RQ(a3.x, b3.x); r1[3] = RQ(a3.y, b3.y);
#undef RQ
                    acc[ai][bj][m][0] = acc[ai][bj][m][0] * r0; acc[ai][bj][m][1] = acc[ai][bj][m][1] * r1;
                }
                asm volatile("" : "+v"(acc[ai][0][m][0]), "+v"(acc[ai][0][m][1]), "+v"(acc[ai][1][m][0]), "+v"(acc[ai][1][m][1]));
            }
            asm volatile("" ::: "memory");
        }
    }
    __device__ __forceinline__ void operator()(const Acc& acc, const Unit& u, int wr, int wc, int fr, int fq) const {
        const int row0 = u.pm * BM + wr * 64 + fr, col0 = u.pn * BM + wc * 32 + 8 * fq;
#pragma unroll
        for (int ai = 0; ai < 2; ++ai) {
            u32x2 bv[4][2];
#pragma unroll
            for (int m = 0; m < 4; ++m)
#pragma unroll
                for (int bj = 0; bj < 2; ++bj) bv[m][bj] = *(const u32x2*)(sb + (size_t)(row0 + ai * HALF + m * 16) * DM + col0 + bj * HALF);
            asm volatile("" ::: "memory");
#pragma unroll
            for (int m = 0; m < 4; ++m) {
                const size_t off = (size_t)(row0 + ai * HALF + m * 16) * DM + col0;
#pragma unroll
                for (int bj = 0; bj < 2; ++bj) {
                    const u32x2 b = bv[m][bj];
                    const f32x2v b0 = __builtin_amdgcn_cvt_pk_f32_fp8((int)b.x, false), b1 = __builtin_amdgcn_cvt_pk_f32_fp8((int)b.x, true), b2 = __builtin_amdgcn_cvt_pk_f32_fp8((int)b.y, false), b3 = __builtin_amdgcn_cvt_pk_f32_fp8((int)b.y, true);
                    const f32x4 v0 = acc[ai][bj][m][0] * 0.03125f, v1 = acc[ai][bj][m][1] * 0.03125f;
                    u32x4 w; w.x = cvt_pk_bf16(v0[0] * b0.x, v0[1] * b0.y); w.y = cvt_pk_bf16(v0[2] * b1.x, v0[3] * b1.y);
                    w.z = cvt_pk_bf16(v1[0] * b2.x, v1[1] * b2.y); w.w = cvt_pk_bf16(v1[2] * b3.x, v1[3] * b3.y);
                    *(u32x4*)(mg + off + bj * HALF) = w;
                }
            }
        }
    }
};

struct Epi3 {
    static constexpr bool PERM = true; static constexpr int MID_T = 0;
    const bf16_t* h0; bf16_t* z; float* zst;
    __device__ __forceinline__ void mid(Acc&, const Unit&, int, int, int, int) const {}
    __device__ __forceinline__ void operator()(const Acc& acc, const Unit& u, int wr, int wc, int fr, int fq) const {
        const int row0 = u.pm * BM + wr * 64 + fr, col0 = u.pn * BM + wc * 32 + 8 * fq;
#pragma unroll
        for (int ai = 0; ai < 2; ++ai) {
            u32x4 hbv[4][2];
#pragma unroll
            for (int m = 0; m < 4; ++m)
#pragma unroll
                for (int bj = 0; bj < 2; ++bj) hbv[m][bj] = *(const u32x4*)(h0 + (size_t)(row0 + ai * HALF + m * 16) * DM + col0 + bj * HALF);
            asm volatile("" ::: "memory");
#pragma unroll
            for (int m = 0; m < 4; ++m) {
                const int row = row0 + ai * HALF + m * 16; const size_t off = (size_t)row * DM + col0;
                float s1 = 0.f, s2 = 0.f;
#pragma unroll
                for (int bj = 0; bj < 2; ++bj) {
                    const u32x4 hb = hbv[m][bj];
                    f32x4 v0 = acc[ai][bj][m][0], v1 = acc[ai][bj][m][1];
                    v0[0] += ALPHA * bflo(hb.x); v0[1] += ALPHA * bfhi(hb.x); v0[2] += ALPHA * bflo(hb.y); v0[3] += ALPHA * bfhi(hb.y);
                    v1[0] += ALPHA * bflo(hb.z); v1[1] += ALPHA * bfhi(hb.z); v1[2] += ALPHA * bflo(hb.w); v1[3] += ALPHA * bfhi(hb.w);
                    s1 += ((v0[0] + v0[1]) + (v0[2] + v0[3])) + ((v1[0] + v1[1]) + (v1[2] + v1[3]));
                    s2 += ((v0[0] * v0[0] + v0[1] * v0[1]) + (v0[2] * v0[2] + v0[3] * v0[3])) + ((v1[0] * v1[0] + v1[1] * v1[1]) + (v1[2] * v1[2] + v1[3] * v1[3]));
                    *(u32x4*)(z + off + bj * HALF) = (u32x4){cvt_pk_bf16(v0[0], v0[1]), cvt_pk_bf16(v0[2], v0[3]), cvt_pk_bf16(v1[0], v1[1]), cvt_pk_bf16(v1[2], v1[3])};
                }
                s1 += __shfl_xor(s1, 16); s1 += __shfl_xor(s1, 32); s2 += __shfl_xor(s2, 16); s2 += __shfl_xor(s2, 32);
                if (fq == 0) *(f32x2*)(zst + ((size_t)row * 16 + u.pn * 4 + wc) * 2) = (f32x2){s1, s2};
            }
        }
    }
};

struct Epi4 {
    static constexpr bool PERM = true; static constexpr int MID_T = 0;
    const float* b_up; unsigned char* act;
    __device__ __forceinline__ void mid(Acc&, const Unit&, int, int, int, int) const {}
    __device__ __forceinline__ void operator()(const Acc& acc, const Unit& u, int wr, int wc, int fr, int fq) const {
        const int e = u.bt >> 3;
        const int row0 = u.pm * BM + wr * 64 + fr, c0 = u.pn * HALF + wc * 32 + 8 * fq;
        const float* bg = b_up + (size_t)e * 2 * FF + c0; const float* bu = bg + FF;
        const f32x4 bg0 = *(const f32x4*)bg, bg1 = *(const f32x4*)(bg + 4), bu0 = *(const f32x4*)bu, bu1 = *(const f32x4*)(bu + 4);
        const int cp = u.pn * HALF + wc * 32 + 8 * (fq & ~1);
#pragma unroll
        for (int ai = 0; ai < 2; ++ai)
#pragma unroll
            for (int mp = 0; mp < 2; ++mp) {
                u32x2 pc[2];
#pragma unroll
                for (int k = 0; k < 2; ++k) {
                    const int m = 2 * mp + k;
                    float o[8];
#pragma unroll
                    for (int n = 0; n < 2; ++n)
#pragma unroll
                        for (int jp = 0; jp < 2; ++jp) {
                            const int j = 2 * jp;
                            const f32x2 ag = {acc[ai][0][m][n][j], acc[ai][0][m][n][j + 1]}, au = {acc[ai][1][m][n][j], acc[ai][1][m][n][j + 1]};
                            const f32x2 vbg = n ? (f32x2){bg1[j], bg1[j + 1]} : (f32x2){bg0[j], bg0[j + 1]}, vbu = n ? (f32x2){bu1[j], bu1[j + 1]} : (f32x2){bu0[j], bu0[j + 1]};
                            f32x2 gg = ag * 0.03125f + vbg, uu = au * 0.03125f + vbu;
                            gg.x = fminf(gg.x, 7.0f); gg.y = fminf(gg.y, 7.0f);
                            uu.x = __builtin_amdgcn_fmed3f(uu.x, -7.0f, 7.0f); uu.y = __builtin_amdgcn_fmed3f(uu.y, -7.0f, 7.0f);
                            const f32x2 t = gg * (-1.702f * 1.4426950408889634f);
                            f32x2 ex; ex.x = __builtin_amdgcn_exp2f(t.x); ex.y = __builtin_amdgcn_exp2f(t.y);
                            const f32x2 d = ex + 1.0f;
                            f32x2 rc; rc.x = __builtin_amdgcn_rcpf(d.x); rc.y = __builtin_amdgcn_rcpf(d.y);
                            const f32x2 res = (uu + 1.0f) * (gg * rc);
                            o[n * 4 + j] = res.x; o[n * 4 + j + 1] = res.y;
                        }
                    unsigned w0 = 0u, w1 = 0u;
                    w0 = __builtin_amdgcn_cvt_pk_fp8_f32(o[0], o[1], w0, false); w0 = __builtin_amdgcn_cvt_pk_fp8_f32(o[2], o[3], w0, true);
                    w1 = __builtin_amdgcn_cvt_pk_fp8_f32(o[4], o[5], w1, false); w1 = __builtin_amdgcn_cvt_pk_fp8_f32(o[6], o[7], w1, true);
                    pc[k] = (u32x2){w0, w1};
                }
                const int rowst = row0 + ai * HALF + (2 * mp + (fq & 1)) * 16;
                *(u32x4*)(act + (size_t)rowst * FF + cp) = pair16(pc[0], pc[1]);
            }
    }
};

struct Epi5 {
    static constexpr bool PERM = true; static constexpr int MID_T = 0;
    const float* b_down; const float* roww; unsigned char* ys;
    __device__ __forceinline__ void mid(Acc&, const Unit&, int, int, int, int) const {}
    __device__ __forceinline__ void operator()(const Acc& acc, const Unit& u, int wr, int wc, int fr, int fq) const {
        const int e = u.bt >> 2;
        const int row0 = u.pm * BM + wr * 64 + fr, col0 = u.pn * BM + wc * 32 + 8 * fq;
        f32x4 bv[2][2];
#pragma unroll
        for (int bj = 0; bj < 2; ++bj)
#pragma unroll
            for (int n = 0; n < 2; ++n) bv[bj][n] = *(const f32x4*)(b_down + (size_t)e * DM + col0 + bj * HALF + 4 * n);
        float rwv[2][4];
#pragma unroll
        for (int ai = 0; ai < 2; ++ai)
#pragma unroll
            for (int m = 0; m < 4; ++m) rwv[ai][m] = roww[u.rbase + wr * 64 + fr + ai * HALF + m * 16];
        asm volatile("" ::: "memory");
        const int colp = u.pn * BM + wc * 32 + 8 * (fq & ~1);
#pragma unroll
        for (int ai = 0; ai < 2; ++ai)
#pragma unroll
            for (int mp = 0; mp < 2; ++mp) {
                const int rowst = row0 + ai * HALF + (2 * mp + (fq & 1)) * 16;
#pragma unroll
                for (int bj = 0; bj < 2; ++bj) {
                    u32x2 pc[2];
#pragma unroll
                    for (int k = 0; k < 2; ++k) { const int m = 2 * mp + k; const float rw16 = rwv[ai][m] * 16.0f;
                        const f32x4 v0 = (acc[ai][bj][m][0] * 0.015625f + bv[bj][0]) * rw16, v1 = (acc[ai][bj][m][1] * 0.015625f + bv[bj][1]) * rw16;
                        pc[k] = (u32x2){pack_fp8x4(v0[0], v0[1], v0[2], v0[3]), pack_fp8x4(v1[0], v1[1], v1[2], v1[3])}; }
                    *(u32x4*)(ys + (size_t)rowst * DM + colp + bj * HALF) = pair16(pc[0], pc[1]);
                }
            }
    }
};
}

struct Args { const float* in[21]; float* out; unsigned char* ws; int ph_lo, ph_hi; };
enum { I_X = 0, I_LNIN_G, I_LNIN_B, I_WIN, I_GLN_G, I_GLN_B, I_WSP, I_BSP, I_WBA, I_WBB, I_WOUT, I_LNMIX_G, I_LNMIX_B, I_WR, I_BR, I_WUP, I_BUP, I_WDN, I_BDN, I_LNF_G, I_LNF_B };

struct Ctx { const Args* a; unsigned char* ws; LAS unsigned char* lds; unsigned char* ldsg; int tid, lane, wave, G, vcu; };

__device__ __forceinline__ void tr_item(const float* W, int N, int k0, int n0, bf16_t* dst, int drow0, int dld, int dcol0, LAS float* scr, int lane) {
#pragma unroll 8
    for (int i = 0; i < 32; ++i) { const int kk = 2 * i + (lane >> 5); scr[kk * 33 + (lane & 31)] = __builtin_nontemporal_load(W + (size_t)(k0 + kk) * N + n0 + (lane & 31)); }
    asm volatile("s_waitcnt lgkmcnt(0)" ::: "memory");
    const int c = lane & 7;
#pragma unroll
    for (int j = 0; j < 4; ++j) { const int n = (lane >> 3) + 8 * j; const LAS float* s = scr + (8 * c) * 33 + n;
        u32x4 o; o.x = pk2(s[0 * 33], s[1 * 33]); o.y = pk2(s[2 * 33], s[3 * 33]); o.z = pk2(s[4 * 33], s[5 * 33]); o.w = pk2(s[6 * 33], s[7 * 33]);
        *(u32x4*)(dst + (size_t)(drow0 + n) * dld + dcol0 + k0 + 8 * c) = o; }
    asm volatile("s_waitcnt lgkmcnt(0)" ::: "memory");
}
template <bool DEEP = false>
__device__ __forceinline__ void tr_item8(const float* W, int N, int k0, int n0, unsigned char* dst, int drow0, int dld, float sc, LAS float* scr, int lane) {
    if constexpr (DEEP) {
        float v[32];
#pragma unroll
        for (int i = 0; i < 32; ++i) v[i] = __builtin_nontemporal_load(W + (size_t)(k0 + 2 * i + (lane >> 5)) * N + n0 + (lane & 31));
#pragma unroll
        for (int i = 0; i < 32; ++i) scr[(2 * i + (lane >> 5)) * 33 + (lane & 31)] = v[i];
    } else {
#pragma unroll 8
        for (int i = 0; i < 32; ++i) { const int kk = 2 * i + (lane >> 5); scr[kk * 33 + (lane & 31)] = __builtin_nontemporal_load(W + (size_t)(k0 + kk) * N + n0 + (lane & 31)); }
    }
    asm volatile("s_waitcnt lgkmcnt(0)" ::: "memory");
    const int c = lane & 7;
#pragma unroll
    for (int j = 0; j < 4; ++j) { const int n = (lane >> 3) + 8 * j; const LAS float* s = scr + (8 * c) * 33 + n;
        unsigned w0 = 0u, w1 = 0u;
        w0 = __builtin_amdgcn_cvt_pk_fp8_f32(s[0 * 33] * sc, s[1 * 33] * sc, w0, false); w0 = __builtin_amdgcn_cvt_pk_fp8_f32(s[2 * 33] * sc, s[3 * 33] * sc, w0, true);
        w1 = __builtin_amdgcn_cvt_pk_fp8_f32(s[4 * 33] * sc, s[5 * 33] * sc, w1, false); w1 = __builtin_amdgcn_cvt_pk_fp8_f32(s[6 * 33] * sc, s[7 * 33] * sc, w1, true);
        *(u32x2*)(dst + (size_t)(drow0 + n) * dld + k0 + 8 * c) = (u32x2){w0, w1}; }
    asm volatile("s_waitcnt lgkmcnt(0)" ::: "memory");
}
__device__ __forceinline__ void ph_prologue(const Ctx& F) {
    const Args& A = *F.a;
    LAS float* scr = (LAS float*)(F.lds + F.wave * 16384);
    const int gw = F.vcu * 8 + F.wave, NGW = F.G * 8;
    bf16_t* WIN = (bf16_t*)(F.ws + WS_WIN); bf16_t* WOUT = (bf16_t*)(F.ws + WS_WOUT);
    constexpr int I_IN = 16 * (INCOLS / 32), I_SQ = 16 * 32;
    constexpr int NITEMS = I_IN + 3 * I_SQ;
    for (int it = gw; it < NITEMS; it += NGW) {
        int r = it;
        if (r < I_IN) { const int nblk = INCOLS / 32, kb = r / nblk, nb = r % nblk;
            if (32 * nb >= PN8_LO * 256 && 32 * nb < PN8_HI * 256) tr_item8(A.in[I_WIN], INCOLS, 64 * kb, 32 * nb, F.ws + WS_WIN8, 32 * nb, DM, 32.0f, scr, F.lane);
            else tr_item(A.in[I_WIN], INCOLS, 64 * kb, 32 * nb, WIN, 32 * nb, DM, 0, scr, F.lane);
            continue; } r -= I_IN;
        if (r < I_SQ) { const int kb = r / 32, nb = r % 32; tr_item8(A.in[I_WBA], DM, 64 * kb, 32 * nb, F.ws + WS_WAB, 32 * nb, 2048, 32.0f, scr, F.lane); continue; } r -= I_SQ;
        if (r < I_SQ) { const int kb = r / 32, nb = r % 32; tr_item8(A.in[I_WBB], DM, 64 * kb, 32 * nb, F.ws + WS_WAB + 1024, 32 * nb, 2048, 32.0f, scr, F.lane); continue; } r -= I_SQ;
        { const int kb = r / 32, nb = r % 32; tr_item(A.in[I_WOUT], DM, 64 * kb, 32 * nb, WOUT, 32 * nb, DM, 0, scr, F.lane); }
    }
    const float* lg = A.in[I_LNIN_G]; const float* lb = A.in[I_LNIN_B]; bf16_t* H0 = (bf16_t*)(F.ws + WS_H0);
    f32x4 gg[4], bb[4];
#pragma unroll
    for (int j = 0; j < 4; ++j) { gg[j] = *((const f32x4*)lg + F.lane + 64 * j); bb[j] = *((const f32x4*)lb + F.lane + 64 * j); }
    for (int m = gw; m < T; m += NGW) {
        const f32x4* xr = (const f32x4*)(A.in[I_X] + (size_t)m * DM) + F.lane;
        f32x4 v[4]; float s = 0.f;
#pragma unroll
        for (int j = 0; j < 4; ++j) { v[j] = __builtin_nontemporal_load(xr + 64 * j); s += (v[j].x + v[j].y) + (v[j].z + v[j].w); }
        const float mean = wave_sum(s) * (1.f / DM); float s2 = 0.f;
#pragma unroll
        for (int j = 0; j < 4; ++j) { v[j] = v[j] - mean; s2 += (v[j].x * v[j].x + v[j].y * v[j].y) + (v[j].z * v[j].z + v[j].w * v[j].w); }
        const float rstd = 1.f / sqrtf(wave_sum(s2) * (1.f / DM) + LN_EPS);
        u32x2* o8 = (u32x2*)(H0 + (size_t)m * DM) + F.lane; unsigned* o4 = (unsigned*)(F.ws + WS_H0F8 + (size_t)m * DM) + F.lane;
#pragma unroll
        for (int j = 0; j < 4; ++j) { const f32x4 y = v[j] * rstd * gg[j] + bb[j]; o8[64 * j] = (u32x2){pk2(y.x, y.y), pk2(y.z, y.w)}; o4[64 * j] = pack_fp8x4(y.x, y.y, y.z, y.w); }
    }
}

struct WItem { const float* src; unsigned char* dst; int N, dld; float sc; };
__device__ __forceinline__ void w_load(const WItem& w, float (&v)[64], int lane) {
    const float* src = w.src + (size_t)(lane >> 5) * w.N + (lane & 31);
#pragma unroll
    for (int i = 0; i < 64; ++i) v[i] = __builtin_nontemporal_load(src + (size_t)(2 * i) * w.N);
}
__device__ __forceinline__ void w_scatter(const float (&v)[64], LAS float* scr, int lane) {
    LAS float* d = scr + (lane & 31) * 130 + (lane >> 5);
#pragma unroll
    for (int i = 0; i < 64; ++i) d[2 * i] = v[i];
}
__device__ __forceinline__ void w_emit(const WItem& w, LAS const float* scr, int lane) {
    asm volatile("s_waitcnt lgkmcnt(0)" ::: "memory");
    const int c = lane & 7; const float sc = w.sc;
#pragma unroll
    for (int j = 0; j < 4; ++j) {
        const int nn = (lane >> 3) + 8 * j; const LAS float* sp = scr + nn * 130 + 16 * c;
        f32x2 a[8];
#pragma unroll
        for (int q = 0; q < 8; ++q) a[q] = *(LAS const f32x2*)(sp + 2 * q);
        u32x4 o;
        o.x = pack_fp8x4(a[0].x * sc, a[0].y * sc, a[1].x * sc, a[1].y * sc); o.y = pack_fp8x4(a[2].x * sc, a[2].y * sc, a[3].x * sc, a[3].y * sc);
        o.z = pack_fp8x4(a[4].x * sc, a[4].y * sc, a[5].x * sc, a[5].y * sc); o.w = pack_fp8x4(a[6].x * sc, a[6].y * sc, a[7].x * sc, a[7].y * sc);
        *(u32x4*)(w.dst + (size_t)nn * w.dld + 16 * c) = o;
    }
    asm volatile("s_waitcnt lgkmcnt(0)" ::: "memory");
}
__device__ __forceinline__ WItem w_decode(const Ctx& F, int r) {
    const Args& A = *F.a;
    constexpr int I_UP = NE * 8 * 64;
    WItem w;
    if (r < I_UP) { const int e = r / (8 * 64), rr = r % (8 * 64), kb = rr / 64, nb = rr % 64; const int n0 = 32 * nb, half = n0 >= FF, rem = n0 - half * FF, pn = rem >> 7, b = (rem & 127) >> 5;
        w.src = A.in[I_WUP] + (size_t)e * DM * 2 * FF + (size_t)(128 * kb) * (2 * FF) + n0; w.N = 2 * FF; w.dst = F.ws + WS_WUP + (size_t)(e * 2048 + 256 * pn + half * 128 + 32 * b) * DM + 128 * kb; w.dld = DM; w.sc = 32.0f; }
    else { r -= I_UP; const int e = r / (8 * 32), rr = r % (8 * 32), kb = rr / 32, nb = rr % 32;
        w.src = A.in[I_WDN] + (size_t)e * FF * DM + (size_t)(128 * kb) * DM + 32 * nb; w.N = DM; w.dst = F.ws + WS_WDN + (size_t)(e * 1024 + 32 * nb) * FF + 128 * kb; w.dld = FF; w.sc = 64.0f; }
    return w;
}
__device__ __forceinline__ void ph_wconv(const Ctx& F) {
    LAS float* scr = (LAS float*)(F.lds + F.wave * 16640);
    constexpr int NIT = NE * 8 * 64 + NE * 8 * 32;
    const int chunk = (NIT + F.G - 1) / F.G, lo = (int)blockIdx.x * chunk, hi = (lo + chunk < NIT) ? lo + chunk : NIT;
    __syncthreads();
    int it = lo + F.wave;
    if (it < hi) {
        float v[64];
        WItem cur = w_decode(F, it);
        w_load(cur, v, F.lane);
        for (;;) {
            w_scatter(v, scr, F.lane);
            const int itn = it + 8; const bool more = itn < hi;
            WItem nxt = cur;
            if (more) { nxt = w_decode(F, itn); w_load(nxt, v, F.lane); }
            w_emit(cur, scr, F.lane);
            if (!more) break;
            cur = nxt; it = itn;
        }
    }
    asm volatile("s_waitcnt vmcnt(0)" ::: "memory");
    __syncthreads();
}

typedef short v4i16_t __attribute__((ext_vector_type(4)));
__device__ __forceinline__ v4i16_t lds_tr16(LAS const unsigned char* p) { return __builtin_amdgcn_ds_read_tr16_b64_v4i16((LAS v4i16_t*)p); }
__device__ __forceinline__ void ph_mixer_a(const Ctx& F) {
    const Args& A = *F.a;
    const unsigned char* GV = F.ws + WS_GV; bf16_t* YAB = (bf16_t*)(F.ws + WS_YAB); const float* GVST = (const float*)(F.ws + WS_GVST);
    const float* lg = A.in[I_GLN_G]; const float* lb = A.in[I_GLN_B]; const float* wsp = A.in[I_WSP]; const float* bsp = A.in[I_BSP];
    constexpr int RSV = 544, RSW = 272, OFF_W = 128 * RSV, OFF_ST = OFF_W + 128 * RSW;
    LAS unsigned char* VT = F.lds; LAS unsigned char* WT = F.lds + OFF_W; LAS float* ST = (LAS float*)(F.lds + OFF_ST);
    const int lane = F.lane, wv = F.wave;
    int curg = -1;
    for (int it = F.vcu; it < NB * 32 * 4; it += F.G) {
        const int b = it / 128, c = (it >> 2) & 31, g = it & 3;
        const int tok0 = b * SEQ + c * 128;
        if (g != curg) {
            curg = g;
            for (int k = 0; k < 4; ++k) {
                const int idx = F.tid + 512 * k, t = idx >> 4, s8 = (idx & 15) * 8;
                const f32x4 w0 = *(const f32x4*)(wsp + ((size_t)g * 128 + t) * 128 + s8), w1 = *(const f32x4*)(wsp + ((size_t)g * 128 + t) * 128 + s8 + 4);
                float x[8] = {w0.x, w0.y, w0.z, w0.w, w1.x, w1.y, w1.z, w1.w};
#pragma unroll
                for (int j = 0; j < 8; ++j) x[j] = (s8 + j <= t) ? x[j] : 0.f;
                u32x4 o; o.x = pk2(x[0], x[1]); o.y = pk2(x[2], x[3]); o.z = pk2(x[4], x[5]); o.w = pk2(x[6], x[7]);
                *(LAS u32x4*)(WT + t * RSW + s8 * 2) = o;
            }
        }
        if (F.tid < 128) {
            const float* p = GVST + (size_t)(tok0 + F.tid) * 32; float s1 = 0.f, s2 = 0.f;
            for (int i = 0; i < 16; ++i) { s1 += p[2 * i]; s2 += p[2 * i + 1]; }
            const float mean = s1 * (1.f / DM), var = s2 * (1.f / DM) - mean * mean;
            ST[2 * F.tid] = mean; ST[2 * F.tid + 1] = 1.f / sqrtf(fmaxf(var, 0.f) + LN_EPS);
        }
        __syncthreads();
        {
            const int dc = F.tid & 31;
            const f32x4 g0 = *(const f32x4*)(lg + g * 256 + dc * 8), g1 = *(const f32x4*)(lg + g * 256 + dc * 8 + 4), b0 = *(const f32x4*)(lb + g * 256 + dc * 8), b1 = *(const f32x4*)(lb + g * 256 + dc * 8 + 4);
            u32x2 rawv[8];
#pragma unroll
            for (int k = 0; k < 8; ++k) rawv[k] = *(const u32x2*)(GV + (size_t)(tok0 + (F.tid >> 5) + 16 * k) * DM + g * 256 + dc * 8);
#pragma unroll
            for (int k = 0; k < 8; ++k) {
                const int s = (F.tid >> 5) + 16 * k;
                const u32x2 raw = rawv[k];
                const float mean = ST[2 * s], rstd = ST[2 * s + 1];
                const f32x2v f0 = __builtin_amdgcn_cvt_pk_f32_fp8((int)raw.x, false), f1 = __builtin_amdgcn_cvt_pk_f32_fp8((int)raw.x, true), f2 = __builtin_amdgcn_cvt_pk_f32_fp8((int)raw.y, false), f3 = __builtin_amdgcn_cvt_pk_f32_fp8((int)raw.y, true);
                f32x4 x0 = {f0.x, f0.y, f1.x, f1.y}, x1 = {f2.x, f2.y, f3.x, f3.y};
                x0 = (x0 - mean) * rstd * g0 + b0; x1 = (x1 - mean) * rstd * g1 + b1;
                u32x4 o; o.x = pk2(x0.x, x0.y); o.y = pk2(x0.z, x0.w); o.z = pk2(x1.x, x1.y); o.w = pk2(x1.z, x1.w);
                *(LAS u32x4*)(VT + s * RSV + dc * 16) = o;
            }
        }
        __syncthreads();
        {
            const int dbase = 32 * wv, kg = lane >> 4, q = (lane & 15) >> 2, p = lane & 3, fr = lane & 15;
            u32x2 uu[8][2]; float bsn[8];
#pragma unroll
            for (int n = 0; n < 8; ++n) { const bf16_t* yp = YAB + (size_t)(tok0 + 16 * n + fr) * 2048 + g * 256 + dbase + 4 * kg; uu[n][0] = *(const u32x2*)yp; uu[n][1] = *(const u32x2*)(yp + 16); bsn[n] = bsp[g * 128 + 16 * n + fr]; }
            bf16x8 Af[2][4];
#pragma unroll
            for (int m = 0; m < 2; ++m)
#pragma unroll
                for (int kk = 0; kk < 4; ++kk) {
                    LAS const unsigned char* ap = VT + (32 * kk + 8 * kg + q) * RSV + (dbase + 16 * m + 4 * p) * 2;
                    const v4i16_t lo = lds_tr16(ap), hi = lds_tr16(ap + 4 * RSV);
                    Af[m][kk] = (bf16x8){lo[0], lo[1], lo[2], lo[3], hi[0], hi[1], hi[2], hi[3]};
                }
#pragma unroll
            for (int n = 0; n < 8; ++n) {
                f32x4 acc0 = {0.f, 0.f, 0.f, 0.f}, acc1 = {0.f, 0.f, 0.f, 0.f};
#pragma unroll
                for (int kk = 0; kk < 4; ++kk) if (kk <= (n >> 1)) {
                    const bf16x8 Bf = *(LAS const bf16x8*)(WT + (16 * n + fr) * RSW + (32 * kk + 8 * kg) * 2);
                    acc0 = __builtin_amdgcn_mfma_f32_16x16x32_bf16(Af[0][kk], Bf, acc0, 0, 0, 0);
                    acc1 = __builtin_amdgcn_mfma_f32_16x16x32_bf16(Af[1][kk], Bf, acc1, 0, 0, 0);
                }
                const int t = 16 * n + fr; const float bsv = bsn[n];
                const u32x2 u0 = uu[n][0], u1 = uu[n][1];
                unsigned char* y8 = F.ws + WS_YA8 + (size_t)(tok0 + t) * 2048 + g * 256 + dbase + 4 * kg;
                *(unsigned*)y8 = pack_fp8x4(bflo(u0.x) * (acc0[0] + bsv), bfhi(u0.x) * (acc0[1] + bsv), bflo(u0.y) * (acc0[2] + bsv), bfhi(u0.y) * (acc0[3] + bsv));
                *(unsigned*)(y8 + 16) = pack_fp8x4(bflo(u1.x) * (acc1[0] + bsv), bfhi(u1.x) * (acc1[1] + bsv), bflo(u1.y) * (acc1[2] + bsv), bfhi(u1.y) * (acc1[3] + bsv));
            }
        }
        __syncthreads();
    }
}

__device__ __forceinline__ void ph_gate(const Ctx& F) {
    const unsigned char* Q = F.ws + WS_Q; const float* KM = (const float*)(F.ws + WS_KMEAN);
    unsigned* SEL = (unsigned*)(F.ws + WS_SEL); unsigned* LISTS = (unsigned*)(F.ws + WS_LISTS); unsigned* LCNT = (unsigned*)(F.ws + WS_CTL) + CW_LCNT;
    constexpr int KMR = 272;
    LAS unsigned char* kmh = F.lds; LAS unsigned char* kml = F.lds + 16 * KMR;
    unsigned* lc = (unsigned*)(F.ldsg + 2 * 16 * KMR);
    LAS float* scw = (LAS float*)(F.lds + 16384) + F.wave * 1024;
    const int fr = F.lane & 15, fq = F.lane >> 4;
    for (int it = F.vcu; it < NB * NH * 8; it += F.G) {
        const int b = it / 64, h = (it >> 3) & 7, tc = it & 7;
        {
            const int j = F.tid >> 5, d4 = (F.tid & 31) * 4;
            const float* kp = KM + (size_t)((b * NBLK + j) * 2) * DM + h * DH + d4;
            const f32x4 s0 = *(const f32x4*)kp, s1 = *(const f32x4*)(kp + DM);
            const f32x4 mv = (s0 + s1) * (1.0f / LBLK);
            unsigned hb[4]; float lo[4];
#pragma unroll
            for (int e = 0; e < 4; ++e) { hb[e] = f2bf(mv[e]); lo[e] = mv[e] - __uint_as_float(hb[e] << 16); }
            *(LAS u32x2*)(kmh + j * KMR + d4 * 2) = (u32x2){hb[0] | (hb[1] << 16), hb[2] | (hb[3] << 16)};
            *(LAS u32x2*)(kml + j * KMR + d4 * 2) = (u32x2){pk2(lo[0], lo[1]), pk2(lo[2], lo[3])};
        }
        if (F.tid < 32) lc[F.tid] = 0u;
        const int tw = tc * 512 + F.wave * 64;
        u32x4 qraw[4][2];
#pragma unroll
        for (int tg = 0; tg < 4; ++tg) { const unsigned char* qp = Q + (size_t)(b * SEQ + tw + 16 * tg + fr) * DM + h * DH + 32 * fq; qraw[tg][0] = *(const u32x4*)qp; qraw[tg][1] = *(const u32x4*)(qp + 16); }
        __syncthreads();
        bf16x8 Ah[4], Al[4];
#pragma unroll
        for (int ks = 0; ks < 4; ++ks) { Ah[ks] = *(LAS const bf16x8*)(kmh + fr * KMR + (32 * fq + 8 * ks) * 2); Al[ks] = *(LAS const bf16x8*)(kml + fr * KMR + (32 * fq + 8 * ks) * 2); }
#pragma unroll
        for (int tg = 0; tg < 4; ++tg) {
            f32x4 acc = {0.f, 0.f, 0.f, 0.f};
#pragma unroll
            for (int ks = 0; ks < 4; ++ks) {
                const u32x4 w = qraw[tg][ks >> 1]; const unsigned w0 = (ks & 1) ? w.z : w.x, w1 = (ks & 1) ? w.w : w.y;
                const bf16x8 Bq = __builtin_bit_cast(bf16x8, f8x8_to_bf16x8(w0, w1));
                acc = __builtin_amdgcn_mfma_f32_16x16x32_bf16(Ah[ks], Bq, acc, 0, 0, 0);
                acc = __builtin_amdgcn_mfma_f32_16x16x32_bf16(Al[ks], Bq, acc, 0, 0, 0);
            }
            *(LAS f32x4*)(scw + (16 * tg + fr) * 16 + 4 * fq) = acc;
        }
        asm volatile("s_waitcnt lgkmcnt(0)" ::: "memory");
        const int t = tc * 512 + F.tid, qi = t >> 8;
        float gsc[15];
        { const f32x4 c0 = *(LAS const f32x4*)(scw + F.lane * 16), c1 = *(LAS const f32x4*)(scw + F.lane * 16 + 4), c2 = *(LAS const f32x4*)(scw + F.lane * 16 + 8), c3 = *(LAS const f32x4*)(scw + F.lane * 16 + 12);
          gsc[0] = c0.x; gsc[1] = c0.y; gsc[2] = c0.z; gsc[3] = c0.w; gsc[4] = c1.x; gsc[5] = c1.y; gsc[6] = c1.z; gsc[7] = c1.w;
          gsc[8] = c2.x; gsc[9] = c2.y; gsc[10] = c2.z; gsc[11] = c2.w; gsc[12] = c3.x; gsc[13] = c3.y; gsc[14] = c3.z; }
        const int nsel = qi < 3 ? qi : 3;
        int sel[3] = {0, 0, 0}; unsigned lpos[3] = {0, 0, 0};
#pragma unroll
        for (int r = 0; r < 3; ++r) {
            float best = -INFINITY; int bi = -1;
#pragma unroll
            for (int j = 0; j < 15; ++j) { const bool c = (j < qi) && (gsc[j] > best); best = c ? gsc[j] : best; bi = c ? j : bi; }
#pragma unroll
            for (int j = 0; j < 15; ++j) if (j == bi) gsc[j] = -INFINITY;
            sel[r] = bi < 0 ? 0 : bi;
            if (r < nsel) lpos[r] = atomicAdd(&lc[sel[r]], 1u);
        }
        SEL[(size_t)(b * SEQ + t) * NH + h] = (unsigned)sel[0] | ((unsigned)sel[1] << 8) | ((unsigned)sel[2] << 16) | ((unsigned)nsel << 24);
        __syncthreads();
        if (F.tid < 16) lc[16 + F.tid] = lc[F.tid] ? atomicAdd(&LCNT[(b * NH + h) * NBLK + F.tid], lc[F.tid]) : 0u;
        __syncthreads();
#pragma unroll
        for (int r = 0; r < 3; ++r) if (r < nsel) LISTS[(size_t)((b * NH + h) * NBLK + sel[r]) * 4096 + lc[16 + sel[r]] + lpos[r]] = (unsigned)t | ((unsigned)r << 12);
        __syncthreads();
    }
}


typedef float f32x16 __attribute__((ext_vector_type(16)));
namespace att {
__device__ __forceinline__ int crow(int r, int hi) { return (r & 3) + 8 * (r >> 2) + 4 * hi; }
#define TRR(dst, vaddr, off) asm volatile("ds_read_b64_tr_b16 %0, %1 offset:%c2" : "=v"(dst) : "v"(vaddr), "i"(off) : "memory")
#define TRWAIT() do { asm volatile("s_waitcnt lgkmcnt(0)" ::: "memory"); __builtin_amdgcn_sched_barrier(0); } while (0)

}

namespace att2 {
constexpr int KCH2 = 1040, VRS = 160, KSL = 8 * KCH2, VSL = 64 * VRS;
constexpr int OFF_K = 0, OFF_V = 2 * KSL, OFF_STG = OFF_V + 2 * VSL  , OFF_WS = OFF_STG + 8 * 8192  , WSW = 1024, OFF_TAB = OFF_WS + 8 * WSW  ;
static_assert(OFF_TAB + 1028 * 4 <= LDS_BYTES - 64, "attention (partial) LDS map");
using att::crow;

__device__ __forceinline__ void tile_load(const Ctx& F, const unsigned char* K, const unsigned char* V, size_t tokbase, int h, int kt, u32x4& rk, u32x4& rv) {
    const size_t off = (tokbase + 64 * kt + (F.tid >> 3)) * DM + h * DH + (F.tid & 7) * 16;
    rk = *(const u32x4*)(K + off); rv = *(const u32x4*)(V + off);
}
__device__ __forceinline__ void tile_write(const Ctx& F, int slot, const u32x4& rk, const u32x4& rv) {
    const int key = F.tid >> 3;
    *(LAS u32x4*)(F.lds + OFF_K + slot * KSL + (F.tid & 7) * KCH2 + key * 16) = rk;
    const int vrow = 32 * ((key >> 2) & 1) + (key & 3) + 4 * ((key >> 3) & 3) + 16 * (key >> 5);
    *(LAS u32x4*)(F.lds + OFF_V + slot * VSL + vrow * VRS + (F.tid & 7) * 16) = rv;
}
template <bool CAUSAL = false>
__device__ __forceinline__ void tile_compute(const Ctx& F, int slot, const pg8::v8i_t (&qf)[2], f32x16 (&o)[4], float& m, float& l, bool first, bool diag = false) {
    const int r = F.lane & 31, hh = F.lane >> 5;
    LAS float* wsf = (LAS float*)(F.lds + OFF_WS + F.wave * WSW);
    LAS const unsigned char* kp = F.lds + OFF_K + slot * KSL + 2 * hh * KCH2 + r * 16;
    LAS const unsigned char* vp = F.lds + OFF_V + slot * VSL + (32 * hh + ((F.lane & 15) >> 1)) * VRS + ((F.lane >> 4) & 1) * 16 + (F.lane & 1) * 8;
    f32x16 p0, p1;
#pragma unroll
    for (int i = 0; i < 16; ++i) { p0[i] = 0.f; p1[i] = 0.f; }
    {
        pg8::v8i_t ka[2][2];
#pragma unroll
        for (int kb = 0; kb < 2; ++kb)
#pragma unroll
            for (int j2 = 0; j2 < 2; ++j2) ka[kb][j2] = __builtin_shufflevector(*(LAS const pg8::v4i_t*)(kp + 4 * j2 * KCH2 + kb * 512), *(LAS const pg8::v4i_t*)(kp + (4 * j2 + 1) * KCH2 + kb * 512), 0, 1, 2, 3, 4, 5, 6, 7);
        __builtin_amdgcn_sched_barrier(0);
#pragma unroll
        for (int j2 = 0; j2 < 2; ++j2) p0 = __builtin_amdgcn_mfma_scale_f32_32x32x64_f8f6f4(ka[0][j2], qf[j2], p0, 0, 0, 0, 0x7f7f7f7f, 0, 0x7f7f7f7f);
#pragma unroll
        for (int j2 = 0; j2 < 2; ++j2) p1 = __builtin_amdgcn_mfma_scale_f32_32x32x64_f8f6f4(ka[1][j2], qf[j2], p1, 0, 0, 0, 0x7f7f7f7f, 0, 0x7f7f7f7f);
        __builtin_amdgcn_sched_barrier(0);
    }
    v4i16_t vr[4][4];
    const unsigned vaddr = (unsigned)(uintptr_t)vp;
#define TRR8(dst, vaddr, off) asm volatile("ds_read_b64_tr_b8 %0, %1 offset:%c2" : "=v"(dst) : "v"(vaddr), "i"(off) : "memory")
#pragma unroll
    for (int db = 0; db < 4; ++db)
#pragma unroll
        for (int q8 = 0; q8 < 4; ++q8) TRR8(vr[db][q8], vaddr, q8 * 8 * VRS + db * 32);
    __builtin_amdgcn_sched_barrier(0);
    if (CAUSAL && diag) {
        if (F.wave & 1) {
#pragma unroll
            for (int i = 0; i < 16; ++i) p1[i] = (crow(i, hh) > r) ? -INFINITY : p1[i];
        } else {
#pragma unroll
            for (int i = 0; i < 16; ++i) { p0[i] = (crow(i, hh) > r) ? -INFINITY : p0[i]; p1[i] = -INFINITY; }
        }
    }
    const float dm = first ? 0.f : m;
    { const f32x2 dm2 = {dm, dm};
#pragma unroll
      for (int j = 0; j < 8; ++j) { f32x2 a = {p0[2 * j], p0[2 * j + 1]}, b = {p1[2 * j], p1[2 * j + 1]}; a = a - dm2; b = b - dm2; p0[2 * j] = a.x; p0[2 * j + 1] = a.y; p1[2 * j] = b.x; p1[2 * j + 1] = b.y; } }
    float mx = fmaxf(p0[0], p1[0]);
#pragma unroll
    for (int i = 1; i < 16; ++i) mx = fmaxf(mx, fmaxf(p0[i], p1[i]));
    mx = fmaxf(mx, __shfl_xor(mx, 32));
    if (first || __any(mx > 8.0f)) {
        const float delta = first ? mx : fmaxf(mx, 0.f);
        const float alpha = first ? 0.f : __builtin_amdgcn_exp2f(-delta);
        l *= alpha; m = dm + delta;
        { const f32x2 d2 = {delta, delta};
#pragma unroll
          for (int j = 0; j < 8; ++j) { f32x2 a = {p0[2 * j], p0[2 * j + 1]}, b = {p1[2 * j], p1[2 * j + 1]}; a = a - d2; b = b - d2; p0[2 * j] = a.x; p0[2 * j + 1] = a.y; p1[2 * j] = b.x; p1[2 * j + 1] = b.y; } }
        if (!first) {
            if (hh == 0) wsf[r] = alpha;
            asm volatile("s_waitcnt lgkmcnt(0)" ::: "memory");
#pragma unroll
            for (int i = 0; i < 16; ++i) { const float a = wsf[crow(i, hh)];
#pragma unroll
                for (int db = 0; db < 4; ++db) o[db][i] *= a; }
        }
    }
    { f32x2 sa = {0.f, 0.f}, sb = {0.f, 0.f};
#pragma unroll
      for (int j = 0; j < 8; ++j) {
          p0[2 * j] = __builtin_amdgcn_exp2f(p0[2 * j]); p0[2 * j + 1] = __builtin_amdgcn_exp2f(p0[2 * j + 1]); p1[2 * j] = __builtin_amdgcn_exp2f(p1[2 * j]); p1[2 * j + 1] = __builtin_amdgcn_exp2f(p1[2 * j + 1]);
          sa = sa + (f32x2){p0[2 * j], p0[2 * j + 1]}; sb = sb + (f32x2){p1[2 * j], p1[2 * j + 1]}; }
      sa = sa + sb; l += sa.x + sa.y; }
    pg8::v8i_t pa;
#pragma unroll
    for (int i = 0; i < 4; ++i) { pa[i] = (int)pack_fp8x4(p0[4 * i], p0[4 * i + 1], p0[4 * i + 2], p0[4 * i + 3]); pa[4 + i] = (int)pack_fp8x4(p1[4 * i], p1[4 * i + 1], p1[4 * i + 2], p1[4 * i + 3]); }
    TRWAIT();
#pragma unroll
    for (int db = 0; db < 4; ++db) {
        pg8::v8i_t vf;
#pragma unroll
        for (int q8 = 0; q8 < 4; ++q8) { const u32x2 w = __builtin_bit_cast(u32x2, vr[db][q8]); vf[2 * q8] = (int)w.x; vf[2 * q8 + 1] = (int)w.y; }
        o[db] = __builtin_amdgcn_mfma_scale_f32_32x32x64_f8f6f4(pa, vf, o[db], 0, 0, 0, 0x7f7f7f7f, 0, 0x7f7f7f7f);
    }
    __builtin_amdgcn_sched_barrier(0);
#undef TRR8
}
}

#define ATT2_DECODE(item, bhj_, chunk_) do { int lo_ = 0, hi_ = 1023; while (lo_ < hi_) { const int mid_ = (lo_ + hi_ + 1) >> 1; if (P[mid_] <= (item)) lo_ = mid_; else hi_ = mid_ - 1; } bhj_ = lo_; chunk_ = (item) - P[lo_]; } while (0)
__device__ __forceinline__ void ph_attn_partial(const Ctx& F) {
    using namespace att2;
    const unsigned char* Q = F.ws + WS_Q; const unsigned char* K = F.ws + WS_K; const unsigned char* V = F.ws + WS_V;
    const unsigned* LISTS = (const unsigned*)(F.ws + WS_LISTS); const unsigned* LCNT = (const unsigned*)(F.ws + WS_CTL) + CW_LCNT;
    unsigned char* OP = F.ws + WS_OP; float* LSE = (float*)(F.ws + WS_LSE);
    LAS int* P = (LAS int*)(F.lds + OFF_TAB);
    if (F.tid < 64) {
        int c[16]; int s = 0;
#pragma unroll
        for (int i = 0; i < 16; ++i) { c[i] = ((int)__hip_atomic_load(LCNT + F.tid * 16 + i, __ATOMIC_RELAXED, __HIP_MEMORY_SCOPE_AGENT) + 255) >> 8; s += c[i]; }
        int inc = s;
#pragma unroll
        for (int o = 1; o < 64; o <<= 1) { const int t = __shfl_up(inc, o); if (F.lane >= o) inc += t; }
        int run = inc - s;
#pragma unroll
        for (int i = 0; i < 16; ++i) { P[F.tid * 16 + i] = run; run += c[i]; }
        if (F.tid == 63) P[1024] = run;
    }
    __syncthreads();
    const int total = P[1024];
    LAS float* wsf = (LAS float*)(F.lds + OFF_WS + F.wave * WSW);
    LAS int* wsi = (LAS int*)wsf;
    const int r = F.lane & 31, hh = F.lane >> 5;
    int it = F.vcu;
    if (it < total) {
        int bhj, chunk; ATT2_DECODE(it, bhj, chunk);
        int itn = it + F.G, bhjn = 0, chunkn = 0; bool hasn = itn < total; if (hasn) ATT2_DECODE(itn, bhjn, chunkn);
        u32x4 rkA, rvA, rkB, rvB;
        { const int b = bhj >> 7, h = (bhj >> 4) & 7, j = bhj & 15; const size_t tb = (size_t)b * SEQ + j * LBLK;
          tile_load(F, K, V, tb, h, 0, rkA, rvA); tile_load(F, K, V, tb, h, 1, rkB, rvB); tile_write(F, 0, rkA, rvA); tile_write(F, 1, rkB, rvB);
          tile_load(F, K, V, tb, h, 2, rkA, rvA); }
        int cnt = (int)__hip_atomic_load(LCNT + bhj, __ATOMIC_RELAXED, __HIP_MEMORY_SCOPE_AGENT);
        int qi = chunk * 256 + F.wave * 32 + r;
        unsigned ent = LISTS[(size_t)bhj * 4096 + (qi < cnt ? qi : 0)];
        int tq = ent & 4095, slot = (qi < cnt) ? (int)(ent >> 12) : -1;
        u32x4 qraw[4];
        { const unsigned char* qrow = Q + ((size_t)(bhj >> 7) * SEQ + tq) * DM + ((bhj >> 4) & 7) * DH + hh * 32;
#pragma unroll
          for (int c = 0; c < 4; ++c) qraw[c] = *(const u32x4*)(qrow + (c >> 1) * 64 + (c & 1) * 16); }
        unsigned entn = 0u; int cntn = 0;
        __syncthreads();
        int s = 0;
        for (;;) {
            const int b = bhj >> 7, h = (bhj >> 4) & 7, j = bhj & 15;
            pg8::v8i_t qr[2];
#pragma unroll
            for (int j2 = 0; j2 < 2; ++j2) qr[j2] = __builtin_shufflevector(__builtin_bit_cast(pg8::v4i_t, qraw[2 * j2]), __builtin_bit_cast(pg8::v4i_t, qraw[2 * j2 + 1]), 0, 1, 2, 3, 4, 5, 6, 7);
            if (F.lane < 32) wsi[64 + r] = (slot >= 0) ? (int)(((((unsigned)slot * NB + b) * SEQ + tq) * NH + h) * DH) : -1;
            f32x16 o[4]; float m = -1e30f, l = 0.f;
#pragma unroll
            for (int db = 0; db < 4; ++db)
#pragma unroll
                for (int i = 0; i < 16; ++i) o[db][i] = 0.f;
#define ATT2_TB(bb) ((size_t)((bb) >> 7) * SEQ + ((bb) & 15) * LBLK)
#define ATT2_H(bb) (((bb) >> 4) & 7)
#pragma unroll 1
            for (int kp2 = 0; kp2 < 2; ++kp2) {
                const int kt = 2 * kp2;
                { const bool cur3 = kt + 3 < 4, have3 = cur3 || hasn, have2 = (kt + 2 < 4) || hasn;
                  if (have3) { const int bb = cur3 ? bhj : bhjn; tile_load(F, K, V, ATT2_TB(bb), ATT2_H(bb), (kt + 3) & 3, rkB, rvB); }
                  if (kt == 0 && hasn) { cntn = (int)__hip_atomic_load(LCNT + bhjn, __ATOMIC_RELAXED, __HIP_MEMORY_SCOPE_AGENT); }
                  if (kt == 2 && hasn) { const unsigned char* qrow = Q + ((size_t)(bhjn >> 7) * SEQ + (entn & 4095)) * DM + ((bhjn >> 4) & 7) * DH + hh * 32;
#pragma unroll
                      for (int c = 0; c < 4; ++c) qraw[c] = *(const u32x4*)(qrow + (c >> 1) * 64 + (c & 1) * 16); }
                  tile_compute(F, 0, qr, o, m, l, kp2 == 0);
                  asm volatile("s_waitcnt lgkmcnt(0)" ::: "memory"); __builtin_amdgcn_s_barrier(); asm volatile("" ::: "memory");
                  if (have2) tile_write(F, 0, rkA, rvA); }
                { const bool have4 = hasn, have3 = (kt + 3 < 4) || hasn;
                  if (have4) { tile_load(F, K, V, ATT2_TB(bhjn), ATT2_H(bhjn), kt, rkA, rvA); }
                  if (kt == 0 && hasn) { const int qn = chunkn * 256 + F.wave * 32 + r; entn = LISTS[(size_t)bhjn * 4096 + (qn < cntn ? qn : 0)]; }
                  tile_compute(F, 1, qr, o, m, l, false);
                  asm volatile("s_waitcnt lgkmcnt(0)" ::: "memory"); __builtin_amdgcn_s_barrier(); asm volatile("" ::: "memory");
                  if (have3) tile_write(F, 1, rkB, rvB); }
            }
            const float lt = l + __shfl_xor(l, 32);
            if (hh == 0) { wsf[r] = 1.0f / lt; wsf[32 + r] = m + __builtin_amdgcn_logf(lt); }
            asm volatile("s_waitcnt lgkmcnt(0)" ::: "memory");
            int re = r, he = hh; asm volatile("" : "+v"(re), "+v"(he));
#pragma unroll
            for (int i = 0; i < 16; ++i) {
                const int q = crow(i, he); const float a = wsf[q]; const int ro = wsi[64 + q];
                const unsigned w = pack_fp8x4(o[0][i] * a, o[1][i] * a, o[2][i] * a, o[3][i] * a);
                if (ro >= 0) *(unsigned*)(OP + (size_t)(unsigned)ro + 4 * re) = w;
            }
            if (he == 0 && slot >= 0) LSE[(((size_t)slot * NB + b) * SEQ + tq) * NH + h] = wsf[32 + re];
            asm volatile("s_waitcnt lgkmcnt(0)" ::: "memory");
            if (!hasn) break;
            it = itn; bhj = bhjn; chunk = chunkn; cnt = cntn;
            { const int qn = chunk * 256 + F.wave * 32 + r; tq = entn & 4095; slot = (qn < cnt) ? (int)(entn >> 12) : -1; }
            itn = it + F.G; hasn = itn < total; if (hasn) ATT2_DECODE(itn, bhjn, chunkn);
        }
    }
    __syncthreads();
}

__device__ __forceinline__ void ph_attn_own(const Ctx& F) {
    using namespace att2;
    const unsigned char* Q = F.ws + WS_Q; const unsigned char* K = F.ws + WS_K; const unsigned char* V = F.ws + WS_V;
    const unsigned char* OP = F.ws + WS_OP; const float* LSE = (const float*)(F.ws + WS_LSE); unsigned char* YA8 = F.ws + WS_YA8;
    LAS float* wsf = (LAS float*)(F.lds + OFF_WS + F.wave * WSW);
    const int r = F.lane & 31, hh = F.lane >> 5;
    constexpr int NIT = NB * NH * NBLK;
    int it = F.vcu;
    if (it < NIT) {
        int itn = it + F.G; bool hasn = itn < NIT;
        u32x4 rkA, rvA, rkB, rvB;
#define OWN_TB(i_) ((size_t)((i_) >> 7) * SEQ + ((i_) & 15) * LBLK)
#define OWN_H(i_) (((i_) >> 4) & 7)
        tile_load(F, K, V, OWN_TB(it), OWN_H(it), 0, rkA, rvA); tile_load(F, K, V, OWN_TB(it), OWN_H(it), 1, rkB, rvB); tile_write(F, 0, rkA, rvA); tile_write(F, 1, rkB, rvB);
        tile_load(F, K, V, OWN_TB(it), OWN_H(it), 2, rkA, rvA);
        u32x4 qraw[4];
        { const unsigned char* qrow = Q + (OWN_TB(it) + F.wave * 32 + r) * DM + OWN_H(it) * DH + hh * 32;
#pragma unroll
          for (int c = 0; c < 4; ++c) qraw[c] = *(const u32x4*)(qrow + (c >> 1) * 64 + (c & 1) * 16); }
        __syncthreads();
        const int wdiag = F.wave >> 1;
        for (;;) {
            const int b = it >> 7, h = (it >> 4) & 7, j = it & 15, t0 = j * LBLK + F.wave * 32;
            pg8::v8i_t qr[2];
#pragma unroll
            for (int j2 = 0; j2 < 2; ++j2) qr[j2] = __builtin_shufflevector(__builtin_bit_cast(pg8::v4i_t, qraw[2 * j2]), __builtin_bit_cast(pg8::v4i_t, qraw[2 * j2 + 1]), 0, 1, 2, 3, 4, 5, 6, 7);
            f32x16 o[4]; float m = -1e30f, l = 0.f;
#pragma unroll
            for (int db = 0; db < 4; ++db)
#pragma unroll
                for (int i = 0; i < 16; ++i) o[db][i] = 0.f;
#pragma unroll 1
            for (int kp2 = 0; kp2 < 2; ++kp2) {
                const int kt = 2 * kp2;
                { const bool cur3 = kt + 3 < 4, have3 = cur3 || hasn, have2 = (kt + 2 < 4) || hasn;
                  if (have3) { const int ii = cur3 ? it : itn; tile_load(F, K, V, OWN_TB(ii), OWN_H(ii), (kt + 3) & 3, rkB, rvB); }
                  if (kt == 2 && hasn) { const unsigned char* qrow = Q + (OWN_TB(itn) + F.wave * 32 + r) * DM + OWN_H(itn) * DH + hh * 32;
#pragma unroll
                      for (int c = 0; c < 4; ++c) qraw[c] = *(const u32x4*)(qrow + (c >> 1) * 64 + (c & 1) * 16); }
                  if (kt <= wdiag) tile_compute<true>(F, 0, qr, o, m, l, kp2 == 0, kt == wdiag);
                  asm volatile("s_waitcnt lgkmcnt(0)" ::: "memory"); __builtin_amdgcn_s_barrier(); asm volatile("" ::: "memory");
                  if (have2) tile_write(F, 0, rkA, rvA); }
                { const bool have4 = hasn, have3 = (kt + 3 < 4) || hasn;
                  if (have4) { tile_load(F, K, V, OWN_TB(itn), OWN_H(itn), kt, rkA, rvA); }
                  if (kt + 1 <= wdiag) tile_compute<true>(F, 1, qr, o, m, l, false, kt + 1 == wdiag);
                  asm volatile("s_waitcnt lgkmcnt(0)" ::: "memory"); __builtin_amdgcn_s_barrier(); asm volatile("" ::: "memory");
                  if (have3) tile_write(F, 1, rkB, rvB); }
            }
            const int nv = j < 3 ? j : 3;
            int re = r, he = hh; asm volatile("" : "+v"(re), "+v"(he));
            LAS float* stg = (LAS float*)(F.lds + OFF_STG + F.wave * 8192);
            unsigned pv[16][3];
#pragma unroll
            for (int i = 0; i < 16; ++i) { const int q = crow(i, he);
#pragma unroll
                for (int s2 = 0; s2 < 3; ++s2) { pv[i][s2] = 0u; if (s2 < nv) pv[i][s2] = *(const unsigned*)(OP + ((((size_t)s2 * NB + b) * SEQ + t0 + q) * NH + h) * DH + 4 * re); } }
            {
                const float lt = l + __shfl_xor(l, 32); const float lse_own = m + __builtin_amdgcn_logf(lt);
                float ls[3];
#pragma unroll
                for (int s2 = 0; s2 < 3; ++s2) ls[s2] = (s2 < nv) ? LSE[(((size_t)s2 * NB + b) * SEQ + t0 + r) * NH + h] : -1e30f;
                const float M = fmaxf(fmaxf(lse_own, ls[0]), fmaxf(ls[1], ls[2]));
                const float w0 = __builtin_amdgcn_exp2f(lse_own - M);
                float w[3], den = w0;
#pragma unroll
                for (int s2 = 0; s2 < 3; ++s2) { w[s2] = (s2 < nv) ? __builtin_amdgcn_exp2f(ls[s2] - M) : 0.f; den += w[s2]; }
                const float inv = 1.0f / den;
                if (hh == 0) { wsf[r] = w0 * inv / lt; wsf[32 + r] = w[0] * inv; wsf[64 + r] = w[1] * inv; wsf[96 + r] = w[2] * inv; }
                asm volatile("s_waitcnt lgkmcnt(0)" ::: "memory");
            }
            {
#pragma unroll
                for (int i = 0; i < 16; ++i) { const int q = crow(i, he); const float a = wsf[q];
                    float x0 = o[0][i] * a, x1 = o[1][i] * a, x2 = o[2][i] * a, x3 = o[3][i] * a;
#pragma unroll
                    for (int s2 = 0; s2 < 3; ++s2) { const float ww = wsf[32 * (s2 + 1) + q]; const f32x2v f0 = __builtin_amdgcn_cvt_pk_f32_fp8((int)pv[i][s2], false), f1 = __builtin_amdgcn_cvt_pk_f32_fp8((int)pv[i][s2], true);
                        x0 += ww * f0.x; x1 += ww * f0.y; x2 += ww * f1.x; x3 += ww * f1.y; }
                    o[0][i] = x0; o[1][i] = x1; o[2][i] = x2; o[3][i] = x3; }
            }
#pragma unroll
            for (int half = 0; half < 2; ++half) {
#pragma unroll
                for (int i = 0; i < 16; ++i) { const int q = crow(i, he); stg[q * 64 + re] = o[2 * half][i]; stg[q * 64 + 32 + re] = o[2 * half + 1][i]; }
                asm volatile("s_waitcnt lgkmcnt(0)" ::: "memory");
#pragma unroll
                for (int ps = 0; ps < 4; ++ps) {
                    const int q = ps * 8 + ((re + 32 * he) >> 3), dc = re & 7;
                    const f32x4 x = *(LAS const f32x4*)(stg + q * 64 + dc * 8), y = *(LAS const f32x4*)(stg + q * 64 + dc * 8 + 4);
                    *(u32x2*)(YA8 + ((size_t)b * SEQ + t0 + q) * 2048 + 1024 + h * DH + half * 64 + dc * 8) = (u32x2){pack_fp8x4(x.x, x.y, x.z, x.w), pack_fp8x4(y.x, y.y, y.z, y.w)};
                }
                asm volatile("s_waitcnt lgkmcnt(0)" ::: "memory");
            }
            if (!hasn) break;
            it = itn; itn = it + F.G; hasn = itn < NIT;
        }
#undef OWN_TB
#undef OWN_H
    }
    __syncthreads();
}

__device__ __forceinline__ void ph_router(const Ctx& F) {
    const Args& A = *F.a;
    const bf16_t* Z = (const bf16_t*)(F.ws + WS_Z); const float* ZST = (const float*)(F.ws + WS_ZST); bf16_t* H1 = (bf16_t*)(F.ws + WS_H1); unsigned char* H1F8 = F.ws + WS_H1F8;
    int* TKE = (int*)(F.ws + WS_TKE); int* TKP = (int*)(F.ws + WS_TKP); unsigned* ECNT = (unsigned*)(F.ws + WS_CTL) + CW_ECNT; int* RT = (int*)(F.ws + WS_RT); float* RW = (float*)(F.ws + WS_RW);
    const float* wr = A.in[I_WR]; const float* br = A.in[I_BR];
    constexpr int RS = 2064, OFF_LO = 32 * RS, OFF_G = 2 * 32 * RS  , OFF_B = OFF_G + 4096, OFF_LG = OFF_B + 4096  , OFF_CNT = OFF_LG + 8 * 2112  ;
    static_assert(OFF_CNT + 256 <= LDS_BYTES, "router LDS map");
    LAS unsigned char* WH = F.lds; LAS unsigned char* WL = F.lds + OFF_LO;
    LAS float* LG = (LAS float*)(F.lds + OFF_G); LAS float* LB = (LAS float*)(F.lds + OFF_B);
    LAS float* lgt = (LAS float*)(F.lds + OFF_LG + F.wave * 2112);
    LAS unsigned* lcnt = (LAS unsigned*)(F.lds + OFF_CNT);
    {
        f32x4 wa[8], wb[8];
#pragma unroll
        for (int u_ = 0; u_ < 8; ++u_) { const int i = F.tid + 512 * u_, nq = i & 7, k2 = i >> 3;
            wa[u_] = *(const f32x4*)(wr + (size_t)(2 * k2) * NE + 4 * nq); wb[u_] = *(const f32x4*)(wr + (size_t)(2 * k2 + 1) * NE + 4 * nq); }
#pragma unroll
        for (int u_ = 0; u_ < 8; ++u_) { const int i = F.tid + 512 * u_, nq = i & 7, k2 = i >> 3;
#pragma unroll
            for (int c = 0; c < 4; ++c) {
                const float w0 = wa[u_][c], w1 = wb[u_][c];
                const unsigned h0 = f2bf(w0), h1 = f2bf(w1);
                const float r0 = w0 - __uint_as_float(h0 << 16), r1 = w1 - __uint_as_float(h1 << 16);
                *(LAS unsigned*)(WH + (4 * nq + c) * RS + k2 * 4) = h0 | (h1 << 16);
                *(LAS unsigned*)(WL + (4 * nq + c) * RS + k2 * 4) = pk2(r0, r1);
            } }
    }
    for (int i = F.tid; i < DM; i += 512) { LG[i] = A.in[I_LNMIX_G][i]; LB[i] = A.in[I_LNMIX_B][i]; }
    if (F.tid < 64) lcnt[F.tid] = 0u;
    __syncthreads();
    const int fr = F.lane & 15, kg = F.lane >> 4;
    const int ntask = T / 16, NGW = F.G * 8;
    const int rounds = (ntask + NGW - 1) / NGW;
    for (int rd = 0; rd < rounds; ++rd) {
        const int task = rd * NGW + F.vcu * 8 + F.wave;
        const bool live = task < ntask;
        int te[4] = {0, 0, 0, 0}; float tw[4] = {0.f, 0.f, 0.f, 0.f}; unsigned lp[4] = {0, 0, 0, 0};
        if (live) {
            const int tok = task * 16 + fr;
            float mean, rstd;
            { const f32x4* sp = (const f32x4*)(ZST + (size_t)tok * 32); float s1 = 0.f, s2 = 0.f;
#pragma unroll
              for (int i = 0; i < 8; ++i) { const f32x4 v = sp[i]; s1 += v.x + v.z; s2 += v.y + v.w; }
              mean = s1 * (1.f / DM); const float var = s2 * (1.f / DM) - mean * mean; rstd = 1.f / sqrtf(fmaxf(var, 0.f) + LN_EPS); }
            f32x4 acc0 = {0.f, 0.f, 0.f, 0.f}, acc1 = {0.f, 0.f, 0.f, 0.f};
            const bf16_t* zp = Z + (size_t)tok * DM + 8 * kg; unsigned char* h8 = H1F8 + (size_t)tok * DM + 8 * kg;
#pragma unroll 8
            for (int kk = 0; kk < 32; ++kk) {
                const u32x4 zr = *(const u32x4*)(zp + 32 * kk); const f32x4 z0 = {bflo(zr.x), bfhi(zr.x), bflo(zr.y), bfhi(zr.y)}, z1 = {bflo(zr.z), bfhi(zr.z), bflo(zr.w), bfhi(zr.w)};
                const f32x4 g0 = *(LAS const f32x4*)(LG + 32 * kk + 8 * kg), g1 = *(LAS const f32x4*)(LG + 32 * kk + 8 * kg + 4);
                const f32x4 b0 = *(LAS const f32x4*)(LB + 32 * kk + 8 * kg), b1 = *(LAS const f32x4*)(LB + 32 * kk + 8 * kg + 4);
                const f32x4 x0 = (z0 - mean) * rstd * g0 + b0, x1 = (z1 - mean) * rstd * g1 + b1;
                u32x4 hi; hi.x = cvt_pk_bf16(x0.x, x0.y); hi.y = cvt_pk_bf16(x0.z, x0.w); hi.z = cvt_pk_bf16(x1.x, x1.y); hi.w = cvt_pk_bf16(x1.z, x1.w);
                { unsigned w0 = 0u, w1 = 0u;
                  w0 = __builtin_amdgcn_cvt_pk_fp8_f32(x0.x, x0.y, w0, false); w0 = __builtin_amdgcn_cvt_pk_fp8_f32(x0.z, x0.w, w0, true);
                  w1 = __builtin_amdgcn_cvt_pk_fp8_f32(x1.x, x1.y, w1, false); w1 = __builtin_amdgcn_cvt_pk_fp8_f32(x1.z, x1.w, w1, true);
                  *(u32x2*)(h8 + 32 * kk) = (u32x2){w0, w1}; }
                u32x4 lo; lo.x = cvt_pk_bf16(x0.x - bflo(hi.x), x0.y - bfhi(hi.x)); lo.y = cvt_pk_bf16(x0.z - bflo(hi.y), x0.w - bfhi(hi.y));
                lo.z = cvt_pk_bf16(x1.x - bflo(hi.z), x1.y - bfhi(hi.z)); lo.w = cvt_pk_bf16(x1.z - bflo(hi.w), x1.w - bfhi(hi.w));
                const bf16x8 ah = __builtin_bit_cast(bf16x8, hi), al = __builtin_bit_cast(bf16x8, lo);
                const int bo = fr * RS + (32 * kk + 8 * kg) * 2;
                const bf16x8 wh0 = *(LAS const bf16x8*)(WH + bo), wh1 = *(LAS const bf16x8*)(WH + bo + 16 * RS), wl0 = *(LAS const bf16x8*)(WL + bo), wl1 = *(LAS const bf16x8*)(WL + bo + 16 * RS);
                acc0 = __builtin_amdgcn_mfma_f32_16x16x32_bf16(ah, wh0, acc0, 0, 0, 0); acc1 = __builtin_amdgcn_mfma_f32_16x16x32_bf16(ah, wh1, acc1, 0, 0, 0);
                acc0 = __builtin_amdgcn_mfma_f32_16x16x32_bf16(ah, wl0, acc0, 0, 0, 0); acc1 = __builtin_amdgcn_mfma_f32_16x16x32_bf16(ah, wl1, acc1, 0, 0, 0);
                acc0 = __builtin_amdgcn_mfma_f32_16x16x32_bf16(al, wh0, acc0, 0, 0, 0); acc1 = __builtin_amdgcn_mfma_f32_16x16x32_bf16(al, wh1, acc1, 0, 0, 0);
            }
            const float br0 = br[fr], br1 = br[16 + fr];
#pragma unroll
            for (int i = 0; i < 4; ++i) { lgt[(4 * kg + i) * 33 + fr] = acc0[i] + br0; lgt[(4 * kg + i) * 33 + 16 + fr] = acc1[i] + br1; }
            asm volatile("s_waitcnt lgkmcnt(0)" ::: "memory");
            if (F.lane < 16) {
                float lg[NE];
#pragma unroll
                for (int e = 0; e < NE; ++e) lg[e] = lgt[F.lane * 33 + e];
                float tv[4];
#pragma unroll
                for (int r = 0; r < 4; ++r) {
                    float best = -INFINITY; int bi = 0;
#pragma unroll
                    for (int e = 0; e < NE; ++e) { const bool c = lg[e] > best; best = c ? lg[e] : best; bi = c ? e : bi; }
#pragma unroll
                    for (int e = 0; e < NE; ++e) lg[e] = (e == bi) ? -INFINITY : lg[e];
                    te[r] = bi; tv[r] = best;
                }
                const float e1 = __expf(tv[1] - tv[0]), e2 = __expf(tv[2] - tv[0]), e3 = __expf(tv[3] - tv[0]); const float inv = 1.f / (1.f + e1 + e2 + e3);
                tw[0] = inv; tw[1] = e1 * inv; tw[2] = e2 * inv; tw[3] = e3 * inv;
#pragma unroll
                for (int r = 0; r < 4; ++r) lp[r] = atomicAdd((unsigned*)(lcnt + te[r]), 1u);
            }
        }
        __syncthreads();
        if (F.tid < 32) { const unsigned c = lcnt[F.tid]; lcnt[32 + F.tid] = c ? atomicAdd(&ECNT[F.tid], c) : 0u; }
        __syncthreads();
        if (live && F.lane < 16) {
            const size_t tok = (size_t)task * 16 + F.lane;
            int4 pe = {te[0], te[1], te[2], te[3]};
            int4 pp = {(int)(lcnt[32 + te[0]] + lp[0]), (int)(lcnt[32 + te[1]] + lp[1]), (int)(lcnt[32 + te[2]] + lp[2]), (int)(lcnt[32 + te[3]] + lp[3])};
            *(int4*)(TKE + tok * 4) = pe; *(int4*)(TKP + tok * 4) = pp;
#pragma unroll
            for (int r = 0; r < 4; ++r) { const size_t o_ = (size_t)te[r] * T + (r == 0 ? pp.x : r == 1 ? pp.y : r == 2 ? pp.z : pp.w); RT[o_] = (int)tok; RW[o_] = tw[r]; }
        }
        __syncthreads();
        if (F.tid < 32) lcnt[F.tid] = 0u;
        __syncthreads();
    }
}

__device__ __forceinline__ void moe_table(const Ctx& F) {
    const unsigned* ECNT = (const unsigned*)(F.ws + WS_CTL) + CW_ECNT;
    LAS int* tab = (LAS int*)(F.lds + LDS_MOE);
    __syncthreads();
    if (F.tid < 64) {
        const int c = (F.lane < NE) ? (int)__hip_atomic_load(ECNT + F.lane, __ATOMIC_RELAXED, __HIP_MEMORY_SCOPE_AGENT) : 0;
        const int padded = (c + 255) / 256 * 256;
        int inc = padded;
#pragma unroll
        for (int o = 1; o < 64; o <<= 1) { const int t = __shfl_up(inc, o); if (F.lane >= o) inc += t; }
        if (F.lane < NE) tab[32 + F.lane] = inc - padded;
        if (F.lane == NE - 1) { tab[64] = inc; tab[0] = inc / 256; }
    }
    __syncthreads();
    const int ntiles = tab[0];
    for (int i = F.tid; i < ntiles; i += 512) { int e = 0; for (int k = 1; k < NE; ++k) if (i * 256 >= tab[32 + k]) e = k; tab[128 + 2 * i] = e; tab[129 + 2 * i] = i - tab[32 + e] / 256; }
    __syncthreads();
}

__device__ __forceinline__ void ln_stats16(const float* st, int lane, float& mean, float& rstd) {
    float s1 = 0.f, s2 = 0.f;
    if (lane < 16) { const f32x2 p = *(const f32x2*)(st + 2 * lane); s1 = p.x; s2 = p.y; }
    s1 = wave_sum(s1); s2 = wave_sum(s2);
    mean = s1 * (1.f / DM); const float var = s2 * (1.f / DM) - mean * mean; rstd = 1.f / sqrtf(fmaxf(var, 0.f) + LN_EPS);
}
__device__ __forceinline__ void ph_final(const Ctx& F) {
    const Args& A = *F.a;
    const bf16_t* Z = (const bf16_t*)(F.ws + WS_Z); const float* ZST = (const float*)(F.ws + WS_ZST); const unsigned char* YS = F.ws + WS_YS; const int* TKE = (const int*)(F.ws + WS_TKE); const int* TKP = (const int*)(F.ws + WS_TKP);
    const LAS int* tab = (const LAS int*)(F.lds + LDS_MOE);
    const int gw = F.vcu * 8 + F.wave, NGW = F.G * 8;
    f32x4 g2[4], b2[4], g1[4], b1[4];
#pragma unroll
    for (int j = 0; j < 4; ++j) { g2[j] = *((const f32x4*)A.in[I_LNF_G] + F.lane + 64 * j); b2[j] = *((const f32x4*)A.in[I_LNF_B] + F.lane + 64 * j);
        g1[j] = *((const f32x4*)A.in[I_LNMIX_G] + F.lane + 64 * j) * ALPHA; b1[j] = *((const f32x4*)A.in[I_LNMIX_B] + F.lane + 64 * j) * ALPHA; }
    for (int m = gw; m < T; m += NGW) {
        float mean, rstd; ln_stats16(ZST + (size_t)m * 32, F.lane, mean, rstd);
        const u32x2* hr = (const u32x2*)(Z + (size_t)m * DM) + F.lane;
        f32x4 v[4];
#pragma unroll
        for (int j = 0; j < 4; ++j) { const u32x2 hb = hr[64 * j]; v[j] = ((f32x4){bflo(hb.x), bfhi(hb.x), bflo(hb.y), bfhi(hb.y)} - mean) * rstd * g1[j] + b1[j]; }
#pragma unroll
        for (int k = 0; k < 4; ++k) {
            const int row = tab[32 + TKE[(size_t)m * 4 + k]] + TKP[(size_t)m * 4 + k]; const unsigned* yr = (const unsigned*)(YS + (size_t)row * DM) + F.lane;
#pragma unroll
            for (int j = 0; j < 4; ++j) { const unsigned y = yr[64 * j]; const f32x2v f0 = __builtin_amdgcn_cvt_pk_f32_fp8((int)y, false), f1 = __builtin_amdgcn_cvt_pk_f32_fp8((int)y, true);
                v[j].x += 0.0625f * f0.x; v[j].y += 0.0625f * f0.y; v[j].z += 0.0625f * f1.x; v[j].w += 0.0625f * f1.y; }
        }
        float s = 0.f;
#pragma unroll
        for (int j = 0; j < 4; ++j) s += (v[j].x + v[j].y) + (v[j].z + v[j].w);
        const float mu = wave_sum(s) * (1.f / DM); float s2 = 0.f;
#pragma unroll
        for (int j = 0; j < 4; ++j) { v[j] = v[j] - mu; s2 += (v[j].x * v[j].x + v[j].y * v[j].y) + (v[j].z * v[j].z + v[j].w * v[j].w); }
        const float rs = 1.f / sqrtf(wave_sum(s2) * (1.f / DM) + LN_EPS);
        f32x4* orow = (f32x4*)(A.out + (size_t)m * DM) + F.lane;
#pragma unroll
        for (int j = 0; j < 4; ++j) orow[64 * j] = v[j] * rs * g2[j] + b2[j];
    }
}

#define XB_TMO      128
#define XB_XCNT(j)  (256  + 64 * (j))
#define XB_XSUB(j)  (1280 + 64 * (j))
#define XB_XGEN(j)  (2304 + 64 * (j))
#define XB_TOP      3328
#define XB_TOPGEN   3392
#define XCD_BAR_WORDS 3456
#define XB_SPIN_CAP (1u << 18)
__device__ __forceinline__ unsigned xb_ld(unsigned* p)              { return __hip_atomic_load(p, __ATOMIC_RELAXED, __HIP_MEMORY_SCOPE_AGENT); }
__device__ __forceinline__ unsigned xb_add(unsigned* p, unsigned v) { return __hip_atomic_fetch_add(p, v, __ATOMIC_RELAXED, __HIP_MEMORY_SCOPE_AGENT); }
__device__ __forceinline__ unsigned xb_xcc_id() { return (unsigned)__builtin_amdgcn_s_getreg((3 << 11) | 20) & 0xFu; }
#define XB_SPIN(cond, bar) do { unsigned _sp = 0; while (cond) { __builtin_amdgcn_s_sleep(1); \
    if ((++_sp & 255u) == 0u) { if (xb_ld(&(bar)[XB_TMO])) break; if (_sp > XB_SPIN_CAP) { atomicAdd(&(bar)[XB_TMO], 1u); break; } } } } while (0)
__device__ __forceinline__ void xcd_barrier_complete(unsigned* bar, unsigned x, unsigned& nloc, unsigned& nx) {
    const unsigned G = gridDim.x * gridDim.y * gridDim.z;
    unsigned sum, cnt, mine, sp = 0u;
    for (;;) {
        sum = 0u; cnt = 0u; mine = 0u;
#pragma unroll
        for (unsigned j = 0; j < 16; ++j) { const unsigned c = xb_ld(&bar[XB_XCNT(j)]); sum += c; cnt += (c > 0u) ? 1u : 0u; mine = (j == x) ? c : mine; }
        if (sum == G) break;
        __builtin_amdgcn_s_sleep(1);
        if ((++sp & 255u) == 0u) { if (xb_ld(&bar[XB_TMO])) break; if (sp > XB_SPIN_CAP) { atomicAdd(&bar[XB_TMO], 1u); break; } }
    }
    nloc = mine > 0u ? mine : 1u; nx = cnt > 0u ? cnt : 1u;
}
__device__ __forceinline__ void xcd_barrier(unsigned* bar, volatile LAS unsigned* st, unsigned x, bool leader_thread) {
    asm volatile("s_waitcnt vmcnt(0)" ::: "memory");
    __syncthreads();
    if (leader_thread) {
        __builtin_amdgcn_s_waitcnt(0);
        unsigned nloc = st[0], nx = st[1];
        if (nloc == 0u) { xcd_barrier_complete(bar, x, nloc, nx); st[0] = nloc; st[1] = nx; }
        const unsigned old = xb_add(&bar[XB_XSUB(x)], 1u);
        const unsigned gen = old / nloc;
        if (old + 1u == (gen + 1u) * nloc) {
            __builtin_amdgcn_fence(__ATOMIC_RELEASE, "agent");
            asm volatile("s_waitcnt vmcnt(0)" ::: "memory");
            const unsigned og = xb_add(&bar[XB_TOP], 1u);
            const unsigned tg = og / nx;
            if (og + 1u == (tg + 1u) * nx) xb_add(&bar[XB_TOPGEN], 1u);
            else XB_SPIN(xb_ld(&bar[XB_TOPGEN]) == tg, bar);
            __builtin_amdgcn_fence(__ATOMIC_ACQUIRE, "agent");
            xb_add(&bar[XB_XGEN(x)], 1u);
            asm volatile("s_waitcnt vmcnt(0)" ::: "memory");
        } else {
            XB_SPIN(xb_ld(&bar[XB_XGEN(x)]) == gen, bar);
            __builtin_amdgcn_fence(__ATOMIC_ACQUIRE, "agent");
            asm volatile("s_waitcnt vmcnt(0)" ::: "memory");
        }
    }
    __syncthreads();
}

template <bool COOP>
__global__ void __launch_bounds__(512, 2) mega(Args args) {
    extern __shared__ __attribute__((aligned(16))) unsigned char lds_raw[];
    Ctx F;
    const int wave0 = __builtin_amdgcn_readfirstlane(threadIdx.x >> 6);
#define MKCTX() do { F.a = &args; F.ws = args.ws; F.lds = (LAS unsigned char*)lds_raw; F.ldsg = lds_raw; F.lane = lane_id_asm(); F.wave = wave0; F.tid = wave0 * 64 + F.lane; \
    F.G = gridDim.x; { const int bx = blockIdx.x; F.vcu = (F.G % 8 == 0) ? (bx % 8) * (F.G / 8) + bx / 8 : bx; } } while (0)
    MKCTX();
    const int lo = args.ph_lo, hi = args.ph_hi;
    unsigned char* ws = args.ws;
#ifndef PHMASK
#define PHMASK 0xFFFF
#endif
#define IN(k) (((PHMASK >> (k)) & 1) && lo <= (k) && (k) < hi)
    unsigned* barw = (unsigned*)(ws + WS_CTL) + CW_BAR; volatile LAS unsigned* bst = (volatile LAS unsigned*)((LAS unsigned char*)lds_raw + LDS_BYTES - 64);
    const unsigned my_xcc = xb_xcc_id();
    if (COOP) { if (threadIdx.x == 0) { bst[0] = 0u; bst[1] = 0u; (void)xb_add(&barw[XB_XCNT(my_xcc)], 1u); } __syncthreads(); }
#define SEAM(k) do { if (COOP && IN(k) && IN((k) + 1)) { if (args.ph_hi > 1000) cg::this_grid().sync();   xcd_barrier(barw, bst, my_xcc, wave0 == 0 && lane_id_asm() == 0); } } while (0)
    if (IN(0)) { MKCTX(); ph_prologue(F); } SEAM(0);
    if (IN(1)) {
        constexpr int NSLOT = 4;
        const int wslot = (F.G % 8 == 0) ? ((int)blockIdx.x / 8) % NSLOT : (int)blockIdx.x % NSLOT;
        if (wslot == 0) { MKCTX(); ph_wconv(F); }
        {
            pg8::Gemm g{(const bf16_t*)(ws + WS_H0), (const bf16_t*)(ws + WS_WIN), DM, DM, DM, nullptr}; pg8::StaticOrder S; S.init(T, PN8_LO * 256, F.G, (int)blockIdx.x, 0);
            const pg8::Epi1 E{(bf16_t*)(ws + WS_YAB), (bf16_t*)(ws + WS_GV), ws + WS_Q, ws + WS_K, ws + WS_V, (bf16_t*)(ws + WS_SA), (bf16_t*)(ws + WS_SB), (float*)(ws + WS_GVST), (float*)(ws + WS_KMEAN), 1.0f, 0.f};
            pg8::gemm_phase<pg8::Epi1, pg8::StaticOrder, true>(F.lds, g, S, E, wave0);
        }
#pragma unroll 1
        for (int part = 0; part < 2; ++part) {
            if (wslot == 1 + part) { MKCTX(); ph_wconv(F); }
            const pg8::Epi1 E{(bf16_t*)(ws + WS_YAB), (bf16_t*)(ws + WS_GV), ws + WS_Q, ws + WS_K, ws + WS_V, (bf16_t*)(ws + WS_SA), (bf16_t*)(ws + WS_SB), (float*)(ws + WS_GVST), (float*)(ws + WS_KMEAN), 0.03125f, 0.f};
            pg8::Gemm g{(const bf16_t*)(ws + WS_H0F8), (const bf16_t*)(ws + WS_WIN8), DM / 2, DM / 2, DM / 2, nullptr}; pg8::StaticOrder S; if (part == 0) S.init(T, 12 * 256, F.G, (int)blockIdx.x, 4, 4, 12); else S.init(T, 12 * 256, F.G, (int)blockIdx.x, 8);
            pg8::gemm_phase<pg8::Epi1, pg8::StaticOrder, true, true>(F.lds, g, S, E, wave0);
        }
        if (wslot == 3) { MKCTX(); ph_wconv(F); }
    } SEAM(1);
    if (IN(2)) { MKCTX(); ph_mixer_a(F); __syncthreads(); ph_gate(F); } SEAM(2);
    if (IN(3)) { } if (COOP && IN(3) && IN(4)) { }
    if (IN(4)) { MKCTX(); ph_attn_partial(F); } SEAM(4);
    if (IN(5)) { MKCTX(); ph_attn_own(F); } SEAM(5);
    if (IN(6)) {
        pg8::Gemm g{(const bf16_t*)(ws + WS_YA8), (const bf16_t*)(ws + WS_WAB), 2048 / 2, 2048 / 2, 2048 / 2, nullptr}; pg8::StaticOrder S; S.init(T, DM, F.G, (int)blockIdx.x);
        pg8::Epi2 E{ws + WS_SA, ws + WS_SB, (bf16_t*)(ws + WS_MG)};
        pg8::gemm_phase<pg8::Epi2, pg8::StaticOrder, true, true>(F.lds, g, S, E, wave0);
    } SEAM(6);
    if (IN(7)) {
        pg8::Gemm g{(const bf16_t*)(ws + WS_MG), (const bf16_t*)(ws + WS_WOUT), DM, DM, DM, nullptr}; pg8::StaticOrder S; S.init(T, DM, F.G, (int)blockIdx.x);
        pg8::Epi3 E{(const bf16_t*)(ws + WS_H0), (bf16_t*)(ws + WS_Z), (float*)(ws + WS_ZST)};
        pg8::gemm_phase<pg8::Epi3, pg8::StaticOrder, true>(F.lds, g, S, E, wave0);
    } SEAM(7);
    if (IN(8)) { MKCTX(); ph_router(F); } SEAM(8);
    if (IN(9)) { } if (COOP && IN(9) && IN(10)) { }
    if (IN(10)) {
        MKCTX(); moe_table(F);
        pg8::Gemm g{(const bf16_t*)(ws + WS_H1F8), (const bf16_t*)(ws + WS_WUP), DM / 2, DM / 2, DM / 2, (const int*)(ws + WS_RT)}; pg8::MoeOrder S;   S.init((const LAS int*)(F.lds + LDS_MOE), 8, F.G, (int)blockIdx.x);
        pg8::Epi4 E{args.in[I_BUP], ws + WS_ACT};
        pg8::gemm_phase<pg8::Epi4, pg8::MoeOrder, true, true, true>(F.lds, g, S, E, wave0);
    } SEAM(10);
    if (IN(11)) {
        MKCTX(); moe_table(F);
        pg8::Gemm g{(const bf16_t*)(ws + WS_ACT), (const bf16_t*)(ws + WS_WDN), FF / 2, FF / 2, FF / 2, nullptr}; pg8::MoeOrder S; S.init((const LAS int*)(F.lds + LDS_MOE), 4, F.G, (int)blockIdx.x);
        pg8::Epi5 E{args.in[I_BDN], (const float*)(ws + WS_RW), ws + WS_YS};
        pg8::gemm_phase<pg8::Epi5, pg8::MoeOrder, true, true>(F.lds, g, S, E, wave0);
    } SEAM(11);
    if (IN(12)) { MKCTX(); moe_table(F); ph_final(F); }
#undef IN
#undef SEAM
}

extern "C" void kernel_launch(void* const* d_in, const int* in_sizes, int n_in, void* d_out, int out_size, void* d_ws, size_t ws_size, hipStream_t stream) {
    static int grid = 0;
    if (grid == 0) {
        if (n_in != 21 || in_sizes[0] != T * DM || out_size != T * DM || ws_size < WS_END) { fprintf(stderr, "kernel_launch: unexpected shapes (n_in %d, in0 %d, out %d, ws %zu)\n", n_in, n_in > 0 ? in_sizes[0] : -1, out_size, ws_size); grid = -1; return; }
        int dev = 0, cus = 0, per_cu = 0;
        hipGetDevice(&dev); hipDeviceGetAttribute(&cus, hipDeviceAttributeMultiprocessorCount, dev);
        const void* fn = MK_COOP ? (const void*)mega<true> : (const void*)mega<false>;
        hipFuncSetAttribute(fn, hipFuncAttributeMaxDynamicSharedMemorySize, LDS_BYTES);
        hipOccupancyMaxActiveBlocksPerMultiprocessor(&per_cu, fn, 512, LDS_BYTES);
        (void)hipGetLastError();
        if (per_cu < 1) { fprintf(stderr, "kernel_launch: occupancy query says %d blocks/CU\n", per_cu); per_cu = 1; }
        grid = cus * 1;
    }
    if (grid < 0) return;
    hipMemsetAsync((char*)d_ws + WS_CTL, 0, CTL_ZERO_BYTES, stream);
    Args a{};
    for (int i = 0; i < 21; ++i) a.in[i] = (const float*)d_in[i];
    a.out = (float*)d_out; a.ws = (unsigned char*)d_ws;
#if MK_COOP
    a.ph_lo = 0; a.ph_hi = NPHASE;
    void* kargs[] = {&a};
    hipError_t e = hipLaunchCooperativeKernel((const void*)mega<true>, dim3(grid), dim3(512), kargs, LDS_BYTES, stream);
    if (e != hipSuccess) fprintf(stderr, "cooperative launch failed: %s (grid %d)\n", hipGetErrorString(e), grid);
#else
    for (int p = 0; p < NPHASE; ++p) { a.ph_lo = p; a.ph_hi = p + 1; hipLaunchKernelGGL(mega<false>, dim3(grid), dim3(512), LDS_BYTES, stream, a); }
#endif
}
```

```cpp
#include <hip/hip_runtime.h>
#include <hip/hip_cooperative_groups.h>
#include <cstdio>
#include <cstdint>
namespace cg = cooperative_groups;

#ifndef MK_COOP
#define MK_COOP 1
#endif

#define LAS __attribute__((address_space(3)))
typedef unsigned short bf16_t;
typedef short bf16x8 __attribute__((ext_vector_type(8)));
typedef float f32x4 __attribute__((ext_vector_type(4)));
typedef float f32x2 __attribute__((ext_vector_type(2)));
typedef unsigned u32x4 __attribute__((ext_vector_type(4)));
typedef unsigned u32x2 __attribute__((ext_vector_type(2)));

constexpr int NB = 8, SEQ = 4096, DM = 1024, T = NB * SEQ;
constexpr int NH = 8, DH = 128, LBLK = 256, NBLK = SEQ / LBLK;
constexpr int NE = 32, TOPK = 4, FF = 1024;
constexpr int INCOLS = 7 * DM;
constexpr int RMAX = T * TOPK + NE * 256;
constexpr float LN_EPS = 1e-5f;
constexpr float ALPHA = 1.189207115002721f;
constexpr float QSCALE = 0.08838834764831845f * 1.4426950408889634f;

constexpr size_t MiB = 1u << 20, U64 = 64 * MiB;
constexpr size_t WS_CTL = 0, CTL_ZERO_BYTES = 1 * MiB;
constexpr int CW_ECNT = 64;
constexpr int CW_LCNT = 1024;
constexpr int CW_BAR = 4096;
constexpr size_t WS_KMEAN = 1 * MiB;
constexpr size_t WS_GVST = 2 * MiB;
constexpr size_t WS_ZST = 6 * MiB;
constexpr size_t WS_SEL = 10 * MiB;
constexpr size_t WS_TKE = 11 * MiB;
constexpr size_t WS_TKW = 11 * MiB + 512 * 1024;
constexpr size_t WS_TKP = 12 * MiB;
constexpr size_t WS_ROWOF = 12 * MiB + 512 * 1024;
constexpr size_t WS_ROWTOK = 13 * MiB;
constexpr size_t WS_ROWW = 14 * MiB;
constexpr size_t WS_TILE = 15 * MiB;
constexpr size_t WS_LISTS = 16 * MiB;
constexpr size_t WS_LSE = 32 * MiB;
constexpr size_t WS_RT = 16 * MiB;
constexpr size_t WS_RW = 20 * MiB;
constexpr int LDS_MOE = 131072 + 1024;
constexpr size_t WS_WIN = 40 * MiB;
constexpr size_t WS_WAB = 54 * MiB;
constexpr size_t WS_WOUT = 58 * MiB;
constexpr size_t WS_WDN = 60 * MiB;
constexpr size_t WS_WUP = 124 * MiB;
constexpr size_t WS_H0 = 4 * U64;
constexpr size_t WS_YAB = 5 * U64;
constexpr size_t WS_GV = 7 * U64;
constexpr size_t WS_Q = 8 * U64, WS_K = 9 * U64, WS_V = 10 * U64, WS_SA = 11 * U64, WS_SB = 12 * U64;
constexpr size_t WS_OP = 13 * U64;
constexpr size_t WS_MG = WS_GV;
constexpr size_t WS_Z = 14 * U64;
constexpr size_t WS_H1 = WS_H0;
constexpr size_t WS_XG = 5 * U64;
constexpr size_t WS_H1F8 = 12 * U64;
constexpr size_t WS_ACT = 9 * U64 + 16 * MiB;
constexpr size_t WS_YS = WS_XG;
constexpr size_t WS_H0F8 = 13 * U64;
constexpr size_t WS_WIN8 = 192 * MiB;
constexpr int PN8_LO = 4, PN8_HI = 28;
constexpr size_t WS_YA8 = 15 * U64;
constexpr size_t WS_END = 16 * U64;
static_assert(WS_XG + (size_t)RMAX * 2048 <= WS_ACT && WS_ACT + (size_t)RMAX * 2048 <= WS_Z, "ws map");

constexpr int LDS_BYTES = 163840;
constexpr int LDS_MISC = 131072;
constexpr int NPHASE = 13;

__device__ __forceinline__ float bf2f(bf16_t v) { return __uint_as_float((unsigned)v << 16); }
__device__ __forceinline__ float bflo(unsigned u) { return __uint_as_float(u << 16); }
__device__ __forceinline__ float bfhi(unsigned u) { return __uint_as_float(u & 0xffff0000u); }
__device__ __forceinline__ unsigned f2bf(float f) { unsigned u = __builtin_bit_cast(unsigned, f); return (u + 0x7fffu + ((u >> 16) & 1u)) >> 16; }
__device__ __forceinline__ unsigned pk2(float lo, float hi) { return f2bf(lo) | (f2bf(hi) << 16); }
typedef __bf16 bf16x2_t __attribute__((ext_vector_type(2)));
__device__ __forceinline__ unsigned cvt_pk_bf16(float lo, float hi) { f32x2 v = {lo, hi}; bf16x2_t b = __builtin_convertvector(v, bf16x2_t); return __builtin_bit_cast(unsigned, b); }
__device__ __forceinline__ int lane_id_asm() { int l; asm volatile("v_mbcnt_lo_u32_b32 %0, -1, 0\n\tv_mbcnt_hi_u32_b32 %0, -1, %0" : "=v"(l)); return l; }
__device__ __forceinline__ float wave_sum(float v) {
#pragma unroll
    for (int o = 1; o < 64; o <<= 1) v += __shfl_xor(v, o);
    return v;
}
__device__ __forceinline__ float wave_max(float v) {
#pragma unroll
    for (int o = 1; o < 64; o <<= 1) v = fmaxf(v, __shfl_xor(v, o));
    return v;
}
__device__ __forceinline__ f32x2 gelu_pk(f32x2 v) {
    const f32x2 av = __builtin_elementwise_abs(v), d = av * 0.2316418882f + 1.0f;
    f32x2 t; t.x = __builtin_amdgcn_rcpf(d.x); t.y = __builtin_amdgcn_rcpf(d.y);
    f32x2 q = t * 0.5307027145f + (-0.7265760135f); q = q * t + 0.7107068705f; q = q * t + (-0.142248368f); q = q * t + 0.127414796f; q = q * t;
    const f32x2 s = (v * v) * (-0.72134752044f);
    f32x2 e; e.x = __builtin_amdgcn_exp2f(s.x); e.y = __builtin_amdgcn_exp2f(s.y);
    const f32x2 m = v * (q * e), r = v - m;
    f32x2 o; o.x = v.x < 0.f ? m.x : r.x; o.y = v.y < 0.f ? m.y : r.y; return o;
}
typedef float f32x2v __attribute__((ext_vector_type(2)));
template <bool HI> __device__ __forceinline__ unsigned f8x2_to_bf16x2(unsigned w) { const f32x2v f = __builtin_amdgcn_cvt_pk_f32_fp8((int)w, HI); return cvt_pk_bf16(f.x, f.y); }
__device__ __forceinline__ u32x4 f8x8_to_bf16x8(unsigned lo, unsigned hi) { return (u32x4){f8x2_to_bf16x2<false>(lo), f8x2_to_bf16x2<true>(lo), f8x2_to_bf16x2<false>(hi), f8x2_to_bf16x2<true>(hi)}; }
__device__ __forceinline__ unsigned pack_fp8x4(float a, float b, float c, float d) { unsigned w = 0u; w = __builtin_amdgcn_cvt_pk_fp8_f32(a, b, w, false); w = __builtin_amdgcn_cvt_pk_fp8_f32(c, d, w, true); return w; }
__device__ __forceinline__ float sigmoidf_(float x) { return __builtin_amdgcn_rcpf(1.0f + __builtin_amdgcn_exp2f(-1.4426950408889634f * x)); }

namespace pg8 {
constexpr int BM = 256, BK = 64, HALF = 128, HTB = HALF * BK * 2, STAGE_BYTES = 8 * HTB, NXCD = 8, WGM = 4;
__host__ __device__ __forceinline__ int lds_byte(int r, int c) { const int st = (r >> 4) * 2 + (c >> 5), rr = r & 15, cc = c & 31, ob = rr * 64 + cc * 2; return st * 1024 + (ob ^ (((ob >> 9) & 1) << 5)); }
__host__ __device__ __forceinline__ void stage_rc(int b, int& R, int& C) { const int st = b / 1024, sb = b % 1024, swz = sb ^ (((sb >> 9) & 1) << 5); R = (st >> 1) * 16 + swz / 64; C = (st & 1) * 32 + (swz % 64) / 2; }
__host__ __device__ __forceinline__ int perm32(int rho) { const int n = rho >> 4, i = rho & 15; return 8 * (i >> 2) + 4 * n + (i & 3); }

struct Unit { int pm, pn, bt, rbase; };
struct Gemm { const bf16_t* A; const bf16_t* Bt; int K, lda, ldb; const int* rowidx; };

struct StaticOrder {
    int nM, nN, nwg, G, c, pbase, psplit, pjump;
    __device__ void init(int M, int N, int G_, int c_, int pbase_ = 0, int psplit_ = 1 << 20, int pjump_ = 0) { nM = M / BM; nN = N / BM; nwg = nM * nN; G = G_; c = c_; pbase = pbase_; psplit = psplit_; pjump = pjump_; }
    __device__ bool next(int i, Unit& u) const {
        const long L = (long)i * G + c; if (L >= nwg) return false;
        int wgid = (int)L; { const int q = nwg / NXCD, r = nwg % NXCD, xcd = wgid % NXCD, off = wgid / NXCD; wgid = (xcd < r ? xcd * (q + 1) : r * (q + 1) + (xcd - r) * q) + off; }
        const int nig = WGM * nN, gid = wgid / nig, fm = gid * WGM, gsz = (nM - fm) < WGM ? (nM - fm) : WGM;
        u.pm = fm + ((wgid % nig) % gsz); const int p = (wgid % nig) / gsz; u.pn = pbase + (p < psplit ? p : p + pjump); u.bt = u.pn; u.rbase = u.pm * BM; return true;
    }
};
struct MoeOrder {
    int nM, nN, nwg, G, c; const LAS int* tab;
    __device__ void init(const LAS int* tiletab, int nN_, int G_, int c_) { nM = tiletab[0]; tab = tiletab; nN = nN_; nwg = nM * nN; G = G_; c = c_; }
    __device__ bool next(int i, Unit& u) const {
        const long L = (long)i * G + c; if (L >= nwg) return false;
        int wgid = (int)L; { const int q = nwg / NXCD, r = nwg % NXCD, xcd = wgid % NXCD, off = wgid / NXCD; wgid = (xcd < r ? xcd * (q + 1) : r * (q + 1) + (xcd - r) * q) + off; }
        const int nig = WGM * nN, gid = wgid / nig, fm = gid * WGM, gsz = (nM - fm) < WGM ? (nM - fm) : WGM;
        u.pm = fm + ((wgid % nig) % gsz); u.pn = (wgid % nig) / gsz; { const int e = tab[128 + 2 * u.pm], tl = tab[129 + 2 * u.pm]; u.bt = e * nN + u.pn; u.rbase = e * T + tl * BM; } return true;
    }
};

typedef int v4i_t __attribute__((ext_vector_type(4)));
typedef int v8i_t __attribute__((ext_vector_type(8)));
template <class Epi, class Sched, bool ALIGN_EPI, bool FP8 = false, bool GATHER = false>
__device__ __forceinline__ void gemm_phase(LAS unsigned char* lds, const Gemm g, const Sched& S, const Epi& E, const int wid) {
    const int lane = lane_id_asm(), tid = wid * 64 + lane;
    const int wr = wid >> 2, wc = wid & 3, fr = lane & 15, fq = lane >> 4;
    const int nt = g.K / BK;
    unsigned voffA[2], voffB[2]; int gR[2];
#pragma unroll
    for (int i = 0; i < 2; ++i) { int R, C; stage_rc(tid * 16 + i * 8192, R, C); const int Rb = Epi::PERM ? ((R & ~31) + perm32(R & 31)) : R;
        voffA[i] = GATHER ? (unsigned)C * 2u : (unsigned)(R * g.lda + C) * 2u; voffB[i] = (unsigned)(Rb * g.ldb + C) * 2u; gR[i] = R; }
    const size_t kstep = (size_t)(BK * 2);
    const size_t hstepA = GATHER ? 0 : (size_t)HALF * g.lda * 2, hstepB = (size_t)HALF * g.ldb * 2;
    const size_t tstepA = 2 * hstepA, tstepB = 2 * hstepB;
    const unsigned ldsw = (unsigned)wid * 1024u;
    const int aoff = lds_byte(wr * 64 + fr, fq * 8), boff = lds_byte(wc * 32 + fr, fq * 8);
#define PG8_SA(b, h) (((b) * 2 + (h)) * HTB)
#define PG8_SB(b, h) ((4 + (b) * 2 + (h)) * HTB)
#define PG8_STAGE(bufoff, gbase, voff) do { _Pragma("unroll") for (int _i = 0; _i < 2; ++_i) \
        __builtin_amdgcn_global_load_lds((const unsigned*)((const char*)(gbase) + (voff)[_i]), (LAS unsigned*)(lds + (bufoff) + ldsw + _i * 8192), 16, 0, 0); } while (0)
#define PG8_LD8(p) __builtin_shufflevector(*(const LAS v4i_t*)(p), *(const LAS v4i_t*)((p) + 1024), 0, 1, 2, 3, 4, 5, 6, 7)
#define PG8_LDA(dst, b, h) do { _Pragma("unroll") for (int m = 0; m < 4; ++m) { if constexpr (FP8) dst##8[m] = PG8_LD8(lds + PG8_SA(b, h) + aoff + m * 2048); \
        else { _Pragma("unroll") for (int k = 0; k < 2; ++k) dst[m][k] = *(const LAS bf16x8*)(lds + PG8_SA(b, h) + aoff + m * 2048 + k * 1024); } } } while (0)
#define PG8_LDB(dst, b, h) do { _Pragma("unroll") for (int n = 0; n < 2; ++n) { if constexpr (FP8) dst##8[n] = PG8_LD8(lds + PG8_SB(b, h) + boff + n * 2048); \
        else { _Pragma("unroll") for (int k = 0; k < 2; ++k) dst[n][k] = *(const LAS bf16x8*)(lds + PG8_SB(b, h) + boff + n * 2048 + k * 1024); } } } while (0)
#define PG8_MMA(ai, bj, At, Bt) do { __builtin_amdgcn_s_setprio(1); _Pragma("unroll") for (int m = 0; m < 4; ++m) _Pragma("unroll") for (int n = 0; n < 2; ++n) { \
        if constexpr (FP8) { asm volatile("s_nop 1\n\tv_mfma_scale_f32_16x16x128_f8f6f4 %0, %1, %2, %0, %3, %3 op_sel_hi:[0,0,0]" : "+v"(acc[ai][bj][m][n]) : "v"(Bt##8[n]), "v"(At##8[m]), "v"(scl8)); } \
        else { _Pragma("unroll") for (int k = 0; k < 2; ++k) acc[ai][bj][m][n] = __builtin_amdgcn_mfma_f32_16x16x32_bf16(Bt[n][k], At[m][k], acc[ai][bj][m][n], 0, 0, 0); } } \
        __builtin_amdgcn_s_setprio(0); } while (0)
#define PG8_WAIT_V(n) asm volatile("s_waitcnt vmcnt(" #n ")" ::: "memory")
#define PG8_WAIT_L(n) asm volatile("s_waitcnt lgkmcnt(" #n ")" ::: "memory")
#define PG8_BAR __builtin_amdgcn_s_barrier()
#define PG8_SCHED __builtin_amdgcn_sched_barrier(0)
    Unit cur, nxt; int ui = 0;
    if (!S.next(0, cur)) return;
    unsigned va0[2], va1[2], vn0[2], vn1[2];
#define PG8_GIDX(dst0, dst1, u) do { if constexpr (GATHER) { _Pragma("unroll") for (int _i = 0; _i < 2; ++_i) { \
        dst0[_i] = min((unsigned)g.rowidx[(u).rbase + gR[_i]], (unsigned)(T - 1)) * (unsigned)(g.lda * 2) + voffA[_i]; dst1[_i] = min((unsigned)g.rowidx[(u).rbase + HALF + gR[_i]], (unsigned)(T - 1)) * (unsigned)(g.lda * 2) + voffA[_i]; } } \
        else { _Pragma("unroll") for (int _i = 0; _i < 2; ++_i) { dst0[_i] = voffA[_i]; dst1[_i] = voffA[_i]; } } } while (0)
    PG8_GIDX(va0, va1, cur);
    f32x4 acc[2][2][4][2];
#pragma unroll
    for (int a = 0; a < 2; ++a)
#pragma unroll
        for (int b = 0; b < 2; ++b)
#pragma unroll
            for (int m = 0; m < 4; ++m)
#pragma unroll
                for (int n = 0; n < 2; ++n) acc[a][b][m][n] = (f32x4){0.f, 0.f, 0.f, 0.f};
    bf16x8 At[4][2], B0[2][2], B1[2][2]; v8i_t At8[4], B08[2], B18[2];
    int scl8 = 0x7f7f7f7f; asm volatile("" : "+v"(scl8));
    const char* cA = (const char*)g.A + (GATHER ? 0 : (size_t)cur.pm * tstepA); const char* cB = (const char*)g.Bt + (size_t)cur.bt * tstepB;
    PG8_STAGE(PG8_SB(0, 0), cB, voffB); PG8_STAGE(PG8_SB(0, 1), cB + hstepB, voffB); PG8_STAGE(PG8_SA(0, 0), cA, va0); PG8_STAGE(PG8_SA(0, 1), cA + hstepA, va1);
    if (wr == 1) PG8_BAR;
    PG8_WAIT_V(2); PG8_BAR;
    PG8_STAGE(PG8_SB(1, 0), cB + kstep, voffB); PG8_STAGE(PG8_SA(1, 0), cA + kstep, va0); PG8_STAGE(PG8_SB(1, 1), cB + hstepB + kstep, voffB);
    PG8_WAIT_V(6); PG8_BAR;
    for (;;) {
        const bool has_next = S.next(ui + 1, nxt);
        const char* nA = (has_next && !GATHER) ? (const char*)g.A + (size_t)nxt.pm * tstepA : cA; const char* nB = has_next ? (const char*)g.Bt + (size_t)nxt.bt * tstepB : cB;
        if (has_next) PG8_GIDX(vn0, vn1, nxt); else { _Pragma("unroll") for (int _i = 0; _i < 2; ++_i) { vn0[_i] = va0[_i]; vn1[_i] = va1[_i]; } }
#pragma unroll 1
        for (int t = 0; t < nt; t += 2) {
            const bool last = (t == nt - 2);
            const char* a1 = cA + (size_t)(t + 1) * kstep;
            const char* a2 = last ? nA : cA + (size_t)(t + 2) * kstep; const char* b2 = last ? nB : cB + (size_t)(t + 2) * kstep;
            const char* a3 = a2 + kstep; const char* b3 = b2 + kstep;
            if constexpr (Epi::MID_T > 0) { if (t == Epi::MID_T) {
                if constexpr (FP8) {
#pragma unroll
                    for (int a = 0; a < 2; ++a)
#pragma unroll
                        for (int b = 0; b < 2; ++b)
                            asm volatile("s_nop 15\n\ts_nop 7" : "+v"(acc[a][b][0][0]), "+v"(acc[a][b][0][1]), "+v"(acc[a][b][1][0]), "+v"(acc[a][b][1][1]), "+v"(acc[a][b][2][0]), "+v"(acc[a][b][2][1]), "+v"(acc[a][b][3][0]), "+v"(acc[a][b][3][1]));
                }
                E.mid(acc, cur, wr, wc, fr, fq); } }
            unsigned vs0[2], vs1[2];
#pragma unroll
            for (int _i = 0; _i < 2; ++_i) { vs0[_i] = last ? vn0[_i] : va0[_i]; vs1[_i] = last ? vn1[_i] : va1[_i]; }
            PG8_LDB(B0, 0, 0); PG8_LDB(B1, 0, 1); PG8_SCHED; PG8_LDA(At, 0, 0); PG8_STAGE(PG8_SA(1, 1), a1 + hstepA, va1);
            PG8_WAIT_V(8); PG8_WAIT_L(0); PG8_BAR; PG8_MMA(0, 0, At, B0); PG8_MMA(0, 1, At, B1); PG8_BAR; PG8_SCHED;
            PG8_LDA(At, 0, 1); PG8_STAGE(PG8_SB(0, 0), b2, voffB); PG8_STAGE(PG8_SB(0, 1), b2 + hstepB, voffB); PG8_STAGE(PG8_SA(0, 0), a2, vs0);
            PG8_WAIT_V(8); PG8_WAIT_L(0); PG8_BAR; PG8_MMA(1, 0, At, B0); PG8_MMA(1, 1, At, B1); PG8_BAR; PG8_SCHED;
            PG8_LDB(B0, 1, 0); PG8_LDB(B1, 1, 1); PG8_SCHED; PG8_LDA(At, 1, 0); PG8_STAGE(PG8_SA(0, 1), a2 + hstepA, vs1);
            PG8_WAIT_V(8); PG8_WAIT_L(0); PG8_BAR; PG8_MMA(0, 0, At, B0); PG8_MMA(0, 1, At, B1); PG8_BAR; PG8_SCHED;
            PG8_LDA(At, 1, 1); PG8_STAGE(PG8_SB(1, 0), b3, voffB); PG8_STAGE(PG8_SB(1, 1), b3 + hstepB, voffB); PG8_STAGE(PG8_SA(1, 0), a3, vs0);
            PG8_WAIT_V(8); PG8_WAIT_L(0); PG8_BAR; PG8_MMA(1, 0, At, B0); PG8_MMA(1, 1, At, B1); PG8_BAR; PG8_SCHED;
        }
        if constexpr (ALIGN_EPI) { if (wr == 0) PG8_BAR; }
        if constexpr (FP8) {
#pragma unroll
            for (int a = 0; a < 2; ++a)
#pragma unroll
                for (int b = 0; b < 2; ++b)
                    asm volatile("s_nop 15\n\ts_nop 7" : "+v"(acc[a][b][0][0]), "+v"(acc[a][b][0][1]), "+v"(acc[a][b][1][0]), "+v"(acc[a][b][1][1]), "+v"(acc[a][b][2][0]), "+v"(acc[a][b][2][1]), "+v"(acc[a][b][3][0]), "+v"(acc[a][b][3][1]));
        }
        E(acc, cur, wr, wc, fr, fq);
        if (!has_next) break;
#pragma unroll
        for (int a = 0; a < 2; ++a)
#pragma unroll
            for (int b = 0; b < 2; ++b)
#pragma unroll
                for (int m = 0; m < 4; ++m)
#pragma unroll
                    for (int n = 0; n < 2; ++n) acc[a][b][m][n] = (f32x4){0.f, 0.f, 0.f, 0.f};
        cur = nxt; cA = nA; cB = nB; ++ui;
#pragma unroll
        for (int _i = 0; _i < 2; ++_i) { va0[_i] = vn0[_i]; va1[_i] = vn1[_i]; }
        if constexpr (ALIGN_EPI) { if (wr == 1) PG8_BAR; }
    }
    PG8_WAIT_V(0);
    if constexpr (!ALIGN_EPI) { if (wr == 0) PG8_BAR; }
    PG8_BAR;
#undef PG8_SA
#undef PG8_SB
#undef PG8_STAGE
#undef PG8_GIDX
#undef PG8_LDA
#undef PG8_LDB
#undef PG8_MMA
#undef PG8_LD8
#undef PG8_WAIT_V
#undef PG8_WAIT_L
#undef PG8_BAR
#undef PG8_SCHED
}

typedef f32x4 Acc[2][2][4][2];

__device__ __forceinline__ u32x4 pair16(u32x2 x, u32x2 y) {
    const auto r0 = __builtin_amdgcn_permlane16_swap(x.x, y.x, false, false);
    const auto r1 = __builtin_amdgcn_permlane16_swap(x.y, y.y, false, false);
    return (u32x4){r0[0], r1[0], r0[1], r1[1]};
}
struct Epi1 {
    static constexpr bool PERM = true; static constexpr int MID_T = 0;
    bf16_t *yab, *gv; unsigned char *q, *k, *v; bf16_t *sa, *sb; float* gvst; float* kmp; float sc, pad_;
    template <int MODE  >
    __device__ __forceinline__ void run(const Acc& acc, const Unit& u, int wr, int wc, int fr, int fq, bf16_t* base, int ld) const {
        const int row0 = u.pm * BM + wr * 64 + fr, col0 = (u.pn & 3) * 256 + wc * 32 + 8 * fq;
        const int colp = (u.pn & 3) * 256 + wc * 32 + 8 * (fq & ~1);
        f32x4 csA0 = {0.f, 0.f, 0.f, 0.f}, csB0 = csA0, csA1 = csA0, csB1 = csA0;
#pragma unroll
        for (int ai = 0; ai < 2; ++ai)
#pragma unroll
            for (int mp = 0; mp < 2; ++mp) {
                u32x2 pc[2][2];
#pragma unroll
                for (int k = 0; k < 2; ++k) {
                    const int m = 2 * mp + k;
                    const int row = row0 + ai * HALF + m * 16; bf16_t* rowp = base + (size_t)row * ld + col0;
                    float s1 = 0.f, s2 = 0.f;
#pragma unroll
                    for (int bj = 0; bj < 2; ++bj) {
                        f32x4 v0 = acc[ai][bj][m][0], v1 = acc[ai][bj][m][1];
                        if (MODE == 2 || MODE == 3 || MODE == 5) {
                            const float f = (MODE == 2) ? sc * QSCALE : sc; v0 = v0 * f; v1 = v1 * f;
                            if (MODE == 5) { if (bj == 0) { csA0 = csA0 + v0; csB0 = csB0 + v1; } else { csA1 = csA1 + v0; csB1 = csB1 + v1; } }
                            pc[bj][k] = (u32x2){pack_fp8x4(v0[0], v0[1], v0[2], v0[3]), pack_fp8x4(v1[0], v1[1], v1[2], v1[3])};
                            continue;
                        }
                        if (MODE == 0 || MODE == 1) {
                            v0 = v0 * sc; v1 = v1 * sc;
                            f32x2 a = gelu_pk((f32x2){v0[0], v0[1]}), b = gelu_pk((f32x2){v0[2], v0[3]}), c = gelu_pk((f32x2){v1[0], v1[1]}), d = gelu_pk((f32x2){v1[2], v1[3]});
                            v0 = (f32x4){a.x, a.y, b.x, b.y}; v1 = (f32x4){c.x, c.y, d.x, d.y};
                        } else if (MODE == 4) {
                            { const float cs_ = -1.4426950408889634f * sc; const f32x4 t0 = v0 * cs_, t1 = v1 * cs_; f32x4 e0, e1;
#pragma unroll
                              for (int j = 0; j < 4; ++j) { e0[j] = __builtin_amdgcn_exp2f(t0[j]); e1[j] = __builtin_amdgcn_exp2f(t1[j]); }
                              e0 = e0 + 1.0f; e1 = e1 + 1.0f;
#pragma unroll
                              for (int j = 0; j < 4; ++j) { v0[j] = __builtin_amdgcn_rcpf(e0[j]); v1[j] = __builtin_amdgcn_rcpf(e1[j]); } }
                            pc[bj][k] = (u32x2){pack_fp8x4(v0[0], v0[1], v0[2], v0[3]), pack_fp8x4(v1[0], v1[1], v1[2], v1[3])};
                            continue;
                        }
                        if (MODE == 1) {
                            s1 += (v0[0] + v0[1]) + (v0[2] + v0[3]) + (v1[0] + v1[1]) + (v1[2] + v1[3]);
                            s2 += (v0[0] * v0[0] + v0[1] * v0[1]) + (v0[2] * v0[2] + v0[3] * v0[3]) + (v1[0] * v1[0] + v1[1] * v1[1]) + (v1[2] * v1[2] + v1[3] * v1[3]);
                            pc[bj][k] = (u32x2){pack_fp8x4(v0[0], v0[1], v0[2], v0[3]), pack_fp8x4(v1[0], v1[1], v1[2], v1[3])};
                            continue;
                        }
                        u32x4 w; w.x = cvt_pk_bf16(v0[0], v0[1]); w.y = cvt_pk_bf16(v0[2], v0[3]); w.z = cvt_pk_bf16(v1[0], v1[1]); w.w = cvt_pk_bf16(v1[2], v1[3]);
                        *(u32x4*)(rowp + bj * HALF) = w;
                    }
                    if (MODE == 1) {
                        s1 += __shfl_xor(s1, 16); s1 += __shfl_xor(s1, 32); s2 += __shfl_xor(s2, 16); s2 += __shfl_xor(s2, 32);
                        if (fq == 0) *(f32x2*)(gvst + ((size_t)row * 16 + (u.pn & 3) * 4 + wc) * 2) = (f32x2){s1, s2};
                    }
                }
                if (MODE != 0) {
                    const int rowst = row0 + ai * HALF + (2 * mp + (fq & 1)) * 16;
#pragma unroll
                    for (int bj = 0; bj < 2; ++bj) *(u32x4*)((unsigned char*)base + (size_t)rowst * 1024 + colp + bj * HALF) = pair16(pc[bj][0], pc[bj][1]);
                }
            }
        if (MODE == 5) {
#define KM_RED(v) do { _Pragma("unroll") for (int j_ = 0; j_ < 4; ++j_) { float x = v[j_]; x += __shfl_xor(x, 1); x += __shfl_xor(x, 2); x += __shfl_xor(x, 4); x += __shfl_xor(x, 8); v[j_] = x; } } while (0)
            KM_RED(csA0); KM_RED(csB0); KM_RED(csA1); KM_RED(csB1);
#undef KM_RED
            if (fr == 0) {
                float* kp = kmp + ((size_t)(u.pm * 2 + wr) * DM) + col0;
                *(f32x4*)kp = csA0; *(f32x4*)(kp + 4) = csB0; *(f32x4*)(kp + HALF) = csA1; *(f32x4*)(kp + HALF + 4) = csB1;
            }
        }
    }
    __device__ __forceinline__ void operator()(const Acc& acc, const Unit& u, int wr, int wc, int fr, int fq) const {
        const int region = u.pn >> 2;
        if (region == 0) run<0>(acc, u, wr, wc, fr, fq, yab, 2048);
        else if (region == 1) run<1>(acc, u, wr, wc, fr, fq, gv, 1024);
        else if (region == 2) run<2>(acc, u, wr, wc, fr, fq, (bf16_t*)q, 1024);
        else if (region == 3) run<5>(acc, u, wr, wc, fr, fq, (bf16_t*)k, 1024);
        else if (region == 4) run<3>(acc, u, wr, wc, fr, fq, (bf16_t*)v, 1024);
        else if (region == 5) run<4>(acc, u, wr, wc, fr, fq, sa, 1024);
        else run<4>(acc, u, wr, wc, fr, fq, sb, 1024);
    }
    __device__ __forceinline__ void mid(Acc&, const Unit&, int, int, int, int) const {}
};

struct Epi2 {
    static constexpr bool PERM = true; static constexpr int MID_T = 8;
    const unsigned char *sa, *sb; bf16_t* mg;
    __device__ __forceinline__ void mid(Acc& acc, const Unit& u, int wr, int wc, int fr, int fq) const {
        int row0 = u.pm * BM + wr * 64 + fr, col0 = u.pn * BM + wc * 32 + 8 * fq;
        asm volatile("" : "+v"(row0), "+v"(col0));
#pragma unroll
        for (int ai = 0; ai < 2; ++ai) {
            u32x2 av[4][2], bv[4][2];
#pragma unroll
            for (int m = 0; m < 4; ++m)
#pragma unroll
                for (int bj = 0; bj < 2; ++bj) { const size_t off = (size_t)(row0 + ai * HALF + m * 16) * DM + col0 + bj * HALF; av[m][bj] = *(const u32x2*)(sa + off); bv[m][bj] = *(const u32x2*)(sb + off); }
            asm volatile("" ::: "memory");
#pragma unroll
            for (int m = 0; m < 4; ++m) {
#pragma unroll
                for (int bj = 0; bj < 2; ++bj) {
                    const u32x2 a = av[m][bj], b = bv[m][bj];
                    const f32x2v a0 = __builtin_amdgcn_cvt_pk_f32_fp8((int)a.x, false), a1 = __builtin_amdgcn_cvt_pk_f32_fp8((int)a.x, true), a2 = __builtin_amdgcn_cvt_pk_f32_fp8((int)a.y, false), a3 = __builtin_amdgcn_cvt_pk_f32_fp8((int)a.y, true);
                    const f32x2v b0 = __builtin_amdgcn_cvt_pk_f32_fp8((int)b.x, false), b1 = __builtin_amdgcn_cvt_pk_f32_fp8((int)b.x, true), b2 = __builtin_amdgcn_cvt_pk_f32_fp8((int)b.y, false), b3 = __builtin_amdgcn_cvt_pk_f32_fp8((int)b.y, true);
                    f32x4 r0, r1;
#define RQ(x, y) ((x) * __builtin_amdgcn_rcpf(y))
                    r0[0] = RQ(a0.x, b0.x); r0[1] = RQ(a0.y, b0.y); r0[2] = RQ(a1.x, b1.x); r0[3] = RQ(a1.y, b1.y);
                    r1[0] = RQ(a2.x, b2.x); r1[1] = RQ(a2.y, b2.y); r1[2] = RQ(a3.x, b3.x); r1[3] = RQ(a3.y, b3.y);
#undef RQ
                    acc[ai][bj][m][0] = acc[ai][bj][m][0] * r0; acc[ai][bj][m][1] = acc[ai][bj][m][1] * r1;
                }
                asm volatile("" : "+v"(acc[ai][0][m][0]), "+v"(acc[ai][0][m][1]), "+v"(acc[ai][1][m][0]), "+v"(acc[ai][1][m][1]));
            }
            asm volatile("" ::: "memory");
        }
    }
    __device__ __forceinline__ void operator()(const Acc& acc, const Unit& u, int wr, int wc, int fr, int fq) const {
        const int row0 = u.pm * BM + wr * 64 + fr, col0 = u.pn * BM + wc * 32 + 8 * fq;
#pragma unroll
        for (int ai = 0; ai < 2; ++ai) {
            u32x2 bv[4][2];
#pragma unroll
            for (int m = 0; m < 4; ++m)
#pragma unroll
                for (int bj = 0; bj < 2; ++bj) bv[m][bj] = *(const u32x2*)(sb + (size_t)(row0 + ai * HALF + m * 16) * DM + col0 + bj * HALF);
            asm volatile("" ::: "memory");
#pragma unroll
            for (int m = 0; m < 4; ++m) {
                const size_t off = (size_t)(row0 + ai * HALF + m * 16) * DM + col0;
#pragma unroll
                for (int bj = 0; bj < 2; ++bj) {
                    const u32x2 b = bv[m][bj];
                    const f32x2v b0 = __builtin_amdgcn_cvt_pk_f32_fp8((int)b.x, false), b1 = __builtin_amdgcn_cvt_pk_f32_fp8((int)b.x, true), b2 = __builtin_amdgcn_cvt_pk_f32_fp8((int)b.y, false), b3 = __builtin_amdgcn_cvt_pk_f32_fp8((int)b.y, true);
                    const f32x4 v0 = acc[ai][bj][m][0] * 0.03125f, v1 = acc[ai][bj][m][1] * 0.03125f;
                    u32x4 w; w.x = cvt_pk_bf16(v0[0] * b0.x, v0[1] * b0.y); w.y = cvt_pk_bf16(v0[2] * b1.x, v0[3] * b1.y);
                    w.z = cvt_pk_bf16(v1[0] * b2.x, v1[1] * b2.y); w.w = cvt_pk_bf16(v1[2] * b3.x, v1[3] * b3.y);
                    *(u32x4*)(mg + off + bj * HALF) = w;
                }
            }
        }
    }
};

struct Epi3 {
    static constexpr bool PERM = true; static constexpr int MID_T = 0;
    const bf16_t* h0; bf16_t* z; float* zst;
    __device__ __forceinline__ void mid(Acc&, const Unit&, int, int, int, int) const {}
    __device__ __forceinline__ void operator()(const Acc& acc, const Unit& u, int wr, int wc, int fr, int fq) const {
        const int row0 = u.pm * BM + wr * 64 + fr, col0 = u.pn * BM + wc * 32 + 8 * fq;
#pragma unroll
        for (int ai = 0; ai < 2; ++ai) {
            u32x4 hbv[4][2];
#pragma unroll
            for (int m = 0; m < 4; ++m)
#pragma unroll
                for (int bj = 0; bj < 2; ++bj) hbv[m][bj] = *(const u32x4*)(h0 + (size_t)(row0 + ai * HALF + m * 16) * DM + col0 + bj * HALF);
            asm volatile("" ::: "memory");
#pragma unroll
            for (int m = 0; m < 4; ++m) {
                const int row = row0 + ai * HALF + m * 16; const size_t off = (size_t)row * DM + col0;
                float s1 = 0.f, s2 = 0.f;
#pragma unroll
                for (int bj = 0; bj < 2; ++bj) {
                    const u32x4 hb = hbv[m][bj];
                    f32x4 v0 = acc[ai][bj][m][0], v1 = acc[ai][bj][m][1];
                    v0[0] += ALPHA * bflo(hb.x); v0[1] += ALPHA * bfhi(hb.x); v0[2] += ALPHA * bflo(hb.y); v0[3] += ALPHA * bfhi(hb.y);
                    v1[0] += ALPHA * bflo(hb.z); v1[1] += ALPHA * bfhi(hb.z); v1[2] += ALPHA * bflo(hb.w); v1[3] += ALPHA * bfhi(hb.w);
                    s1 += ((v0[0] + v0[1]) + (v0[2] + v0[3])) + ((v1[0] + v1[1]) + (v1[2] + v1[3]));
                    s2 += ((v0[0] * v0[0] + v0[1] * v0[1]) + (v0[2] * v0[2] + v0[3] * v0[3])) + ((v1[0] * v1[0] + v1[1] * v1[1]) + (v1[2] * v1[2] + v1[3] * v1[3]));
                    *(u32x4*)(z + off + bj * HALF) = (u32x4){cvt_pk_bf16(v0[0], v0[1]), cvt_pk_bf16(v0[2], v0[3]), cvt_pk_bf16(v1[0], v1[1]), cvt_pk_bf16(v1[2], v1[3])};
                }
                s1 += __shfl_xor(s1, 16); s1 += __shfl_xor(s1, 32); s2 += __shfl_xor(s2, 16); s2 += __shfl_xor(s2, 32);
                if (fq == 0) *(f32x2*)(zst + ((size_t)row * 16 + u.pn * 4 + wc) * 2) = (f32x2){s1, s2};
            }
        }
    }
};

struct Epi4 {
    static constexpr bool PERM = true; static constexpr int MID_T = 0;
    const float* b_up; unsigned char* act;
    __device__ __forceinline__ void mid(Acc&, const Unit&, int, int, int, int) const {}
    __device__ __forceinline__ void operator()(const Acc& acc, const Unit& u, int wr, int wc, int fr, int fq) const {
        const int e = u.bt >> 3;
        const int row0 = u.pm * BM + wr * 64 + fr, c0 = u.pn * HALF + wc * 32 + 8 * fq;
        const float* bg = b_up + (size_t)e * 2 * FF + c0; const float* bu = bg + FF;
        const f32x4 bg0 = *(const f32x4*)bg, bg1 = *(const f32x4*)(bg + 4), bu0 = *(const f32x4*)bu, bu1 = *(const f32x4*)(bu + 4);
        const int cp = u.pn * HALF + wc * 32 + 8 * (fq & ~1);
#pragma unroll
        for (int ai = 0; ai < 2; ++ai)
#pragma unroll
            for (int mp = 0; mp < 2; ++mp) {
                u32x2 pc[2];
#pragma unroll
                for (int k = 0; k < 2; ++k) {
                    const int m = 2 * mp + k;
                    float o[8];
#pragma unroll
                    for (int n = 0; n < 2; ++n)
#pragma unroll
                        for (int jp = 0; jp < 2; ++jp) {
                            const int j = 2 * jp;
                            const f32x2 ag = {acc[ai][0][m][n][j], acc[ai][0][m][n][j + 1]}, au = {acc[ai][1][m][n][j], acc[ai][1][m][n][j + 1]};
                            const f32x2 vbg = n ? (f32x2){bg1[j], bg1[j + 1]} : (f32x2){bg0[j], bg0[j + 1]}, vbu = n ? (f32x2){bu1[j], bu1[j + 1]} : (f32x2){bu0[j], bu0[j + 1]};
                            f32x2 gg = ag * 0.03125f + vbg, uu = au * 0.03125f + vbu;
                            gg.x = fminf(gg.x, 7.0f); gg.y = fminf(gg.y, 7.0f);
                            uu.x = __builtin_amdgcn_fmed3f(uu.x, -7.0f, 7.0f); uu.y = __builtin_amdgcn_fmed3f(uu.y, -7.0f, 7.0f);
                            const f32x2 t = gg * (-1.702f * 1.4426950408889634f);
                            f32x2 ex; ex.x = __builtin_amdgcn_exp2f(t.x); ex.y = __builtin_amdgcn_exp2f(t.y);
                            const f32x2 d = ex + 1.0f;
                            f32x2 rc; rc.x = __builtin_amdgcn_rcpf(d.x); rc.y = __builtin_amdgcn_rcpf(d.y);
                            const f32x2 res = (uu + 1.0f) * (gg * rc);
                            o[n * 4 + j] = res.x; o[n * 4 + j + 1] = res.y;
                        }
                    unsigned w0 = 0u, w1 = 0u;
                    w0 = __builtin_amdgcn_cvt_pk_fp8_f32(o[0], o[1], w0, false); w0 = __builtin_amdgcn_cvt_pk_fp8_f32(o[2], o[3], w0, true);
                    w1 = __builtin_amdgcn_cvt_pk_fp8_f32(o[4], o[5], w1, false); w1 = __builtin_amdgcn_cvt_pk_fp8_f32(o[6], o[7], w1, true);
                    pc[k] = (u32x2){w0, w1};
                }
                const int rowst = row0 + ai * HALF + (2 * mp + (fq & 1)) * 16;
                *(u32x4*)(act + (size_t)rowst * FF + cp) = pair16(pc[0], pc[1]);
            }
    }
};

struct Epi5 {
    static constexpr bool PERM = true; static constexpr int MID_T = 0;
    const float* b_down; const float* roww; unsigned char* ys;
    __device__ __forceinline__ void mid(Acc&, const Unit&, int, int, int, int) const {}
    __device__ __forceinline__ void operator()(const Acc& acc, const Unit& u, int wr, int wc, int fr, int fq) const {
        const int e = u.bt >> 2;
        const int row0 = u.pm * BM + wr * 64 + fr, col0 = u.pn * BM + wc * 32 + 8 * fq;
        f32x4 bv[2][2];
#pragma unroll
        for (int bj = 0; bj < 2; ++bj)
#pragma unroll
            for (int n = 0; n < 2; ++n) bv[bj][n] = *(const f32x4*)(b_down + (size_t)e * DM + col0 + bj * HALF + 4 * n);
        float rwv[2][4];
#pragma unroll
        for (int ai = 0; ai < 2; ++ai)
#pragma unroll
            for (int m = 0; m < 4; ++m) rwv[ai][m] = roww[u.rbase + wr * 64 + fr + ai * HALF + m * 16];
        asm volatile("" ::: "memory");
        const int colp = u.pn * BM + wc * 32 + 8 * (fq & ~1);
#pragma unroll
        for (int ai = 0; ai < 2; ++ai)
#pragma unroll
            for (int mp = 0; mp < 2; ++mp) {
                const int rowst = row0 + ai * HALF + (2 * mp + (fq & 1)) * 16;
#pragma unroll
                for (int bj = 0; bj < 2; ++bj) {
                    u32x2 pc[2];
#pragma unroll
                    for (int k = 0; k < 2; ++k) { const int m = 2 * mp + k; const float rw16 = rwv[ai][m] * 16.0f;
                        const f32x4 v0 = (acc[ai][bj][m][0] * 0.015625f + bv[bj][0]) * rw16, v1 = (acc[ai][bj][m][1] * 0.015625f + bv[bj][1]) * rw16;
                        pc[k] = (u32x2){pack_fp8x4(v0[0], v0[1], v0[2], v0[3]), pack_fp8x4(v1[0], v1[1], v1[2], v1[3])}; }
                    *(u32x4*)(ys + (size_t)rowst * DM + colp + bj * HALF) = pair16(pc[0], pc[1]);
                }
            }
    }
};
}

struct Args { const float* in[21]; float* out; unsigned char* ws; int ph_lo, ph_hi; };
enum { I_X = 0, I_LNIN_G, I_LNIN_B, I_WIN, I_GLN_G, I_GLN_B, I_WSP, I_BSP, I_WBA, I_WBB, I_WOUT, I_LNMIX_G, I_LNMIX_B, I_WR, I_BR, I_WUP, I_BUP, I_WDN, I_BDN, I_LNF_G, I_LNF_B };

struct Ctx { const Args* a; unsigned char* ws; LAS unsigned char* lds; unsigned char* ldsg; int tid, lane, wave, G, vcu; };

__device__ __forceinline__ void tr_item(const float* W, int N, int k0, int n0, bf16_t* dst, int drow0, int dld, int dcol0, LAS float* scr, int lane) {
#pragma unroll 8
    for (int i = 0; i < 32; ++i) { const int kk = 2 * i + (lane >> 5); scr[kk * 33 + (lane & 31)] = __builtin_nontemporal_load(W + (size_t)(k0 + kk) * N + n0 + (lane & 31)); }
    asm volatile("s_waitcnt lgkmcnt(0)" ::: "memory");
    const int c = lane & 7;
#pragma unroll
    for (int j = 0; j < 4; ++j) { const int n = (lane >> 3) + 8 * j; const LAS float* s = scr + (8 * c) * 33 + n;
        u32x4 o; o.x = pk2(s[0 * 33], s[1 * 33]); o.y = pk2(s[2 * 33], s[3 * 33]); o.z = pk2(s[4 * 33], s[5 * 33]); o.w = pk2(s[6 * 33], s[7 * 33]);
        *(u32x4*)(dst + (size_t)(drow0 + n) * dld + dcol0 + k0 + 8 * c) = o; }
    asm volatile("s_waitcnt lgkmcnt(0)" ::: "memory");
}
template <bool DEEP = false>
__device__ __forceinline__ void tr_item8(const float* W, int N, int k0, int n0, unsigned char* dst, int drow0, int dld, float sc, LAS float* scr, int lane) {
    if constexpr (DEEP) {
        float v[32];
#pragma unroll
        for (int i = 0; i < 32; ++i) v[i] = __builtin_nontemporal_load(W + (size_t)(k0 + 2 * i + (lane >> 5)) * N + n0 + (lane & 31));
#pragma unroll
        for (int i = 0; i < 32; ++i) scr[(2 * i + (lane >> 5)) * 33 + (lane & 31)] = v[i];
    } else {
#pragma unroll 8
        for (int i = 0; i < 32; ++i) { const int kk = 2 * i + (lane >> 5); scr[kk * 33 + (lane & 31)] = __builtin_nontemporal_load(W + (size_t)(k0 + kk) * N + n0 + (lane & 31)); }
    }
    asm volatile("s_waitcnt lgkmcnt(0)" ::: "memory");
    const int c = lane & 7;
#pragma unroll
    for (int j = 0; j < 4; ++j) { const int n = (lane >> 3) + 8 * j; const LAS float* s = scr + (8 * c) * 33 + n;
        unsigned w0 = 0u, w1 = 0u;
        w0 = __builtin_amdgcn_cvt_pk_fp8_f32(s[0 * 33] * sc, s[1 * 33] * sc, w0, false); w0 = __builtin_amdgcn_cvt_pk_fp8_f32(s[2 * 33] * sc, s[3 * 33] * sc, w0, true);
        w1 = __builtin_amdgcn_cvt_pk_fp8_f32(s[4 * 33] * sc, s[5 * 33] * sc, w1, false); w1 = __builtin_amdgcn_cvt_pk_fp8_f32(s[6 * 33] * sc, s[7 * 33] * sc, w1, true);
        *(u32x2*)(dst + (size_t)(drow0 + n) * dld + k0 + 8 * c) = (u32x2){w0, w1}; }
    asm volatile("s_waitcnt lgkmcnt(0)" ::: "memory");
}
__device__ __forceinline__ void ph_prologue(const Ctx& F) {
    const Args& A = *F.a;
    LAS float* scr = (LAS float*)(F.lds + F.wave * 16384);
    const int gw = F.vcu * 8 + F.wave, NGW = F.G * 8;
    bf16_t* WIN = (bf16_t*)(F.ws + WS_WIN); bf16_t* WOUT = (bf16_t*)(F.ws + WS_WOUT);
    constexpr int I_IN = 16 * (INCOLS / 32), I_SQ = 16 * 32;
    constexpr int NITEMS = I_IN + 3 * I_SQ;
    for (int it = gw; it < NITEMS; it += NGW) {
        int r = it;
        if (r < I_IN) { const int nblk = INCOLS / 32, kb = r / nblk, nb = r % nblk;
            if (32 * nb >= PN8_LO * 256 && 32 * nb < PN8_HI * 256) tr_item8(A.in[I_WIN], INCOLS, 64 * kb, 32 * nb, F.ws + WS_WIN8, 32 * nb, DM, 32.0f, scr, F.lane);
            else tr_item(A.in[I_WIN], INCOLS, 64 * kb, 32 * nb, WIN, 32 * nb, DM, 0, scr, F.lane);
            continue; } r -= I_IN;
        if (r < I_SQ) { const int kb = r / 32, nb = r % 32; tr_item8(A.in[I_WBA], DM, 64 * kb, 32 * nb, F.ws + WS_WAB, 32 * nb, 2048, 32.0f, scr, F.lane); continue; } r -= I_SQ;
        if (r < I_SQ) { const int kb = r / 32, nb = r % 32; tr_item8(A.in[I_WBB], DM, 64 * kb, 32 * nb, F.ws + WS_WAB + 1024, 32 * nb, 2048, 32.0f, scr, F.lane); continue; } r -= I_SQ;
        { const int kb = r / 32, nb = r % 32; tr_item(A.in[I_WOUT], DM, 64 * kb, 32 * nb, WOUT, 32 * nb, DM, 0, scr, F.lane); }
    }
    const float* lg = A.in[I_LNIN_G]; const float* lb = A.in[I_LNIN_B]; bf16_t* H0 = (bf16_t*)(F.ws + WS_H0);
    f32x4 gg[4], bb[4];
#pragma unroll
    for (int j = 0; j < 4; ++j) { gg[j] = *((const f32x4*)lg + F.lane + 64 * j); bb[j] = *((const f32x4*)lb + F.lane + 64 * j); }
    for (int m = gw; m < T; m += NGW) {
        const f32x4* xr = (const f32x4*)(A.in[I_X] + (size_t)m * DM) + F.lane;
        f32x4 v[4]; float s = 0.f;
#pragma unroll
        for (int j = 0; j < 4; ++j) { v[j] = __builtin_nontemporal_load(xr + 64 * j); s += (v[j].x + v[j].y) + (v[j].z + v[j].w); }
        const float mean = wave_sum(s) * (1.f / DM); float s2 = 0.f;
#pragma unroll
        for (int j = 0; j < 4; ++j) { v[j] = v[j] - mean; s2 += (v[j].x * v[j].x + v[j].y * v[j].y) + (v[j].z * v[j].z + v[j].w * v[j].w); }
        const float rstd = 1.f / sqrtf(wave_sum(s2) * (1.f / DM) + LN_EPS);
        u32x2* o8 = (u32x2*)(H0 + (size_t)m * DM) + F.lane; unsigned* o4 = (unsigned*)(F.ws + WS_H0F8 + (size_t)m * DM) + F.lane;
#pragma unroll
        for (int j = 0; j < 4; ++j) { const f32x4 y = v[j] * rstd * gg[j] + bb[j]; o8[64 * j] = (u32x2){pk2(y.x, y.y), pk2(y.z, y.w)}; o4[64 * j] = pack_fp8x4(y.x, y.y, y.z, y.w); }
    }
}

struct WItem { const float* src; unsigned char* dst; int N, dld; float sc; };
__device__ __forceinline__ void w_load(const WItem& w, float (&v)[64], int lane) {
    const float* src = w.src + (size_t)(lane >> 5) * w.N + (lane & 31);
#pragma unroll
    for (int i = 0; i < 64; ++i) v[i] = __builtin_nontemporal_load(src + (size_t)(2 * i) * w.N);
}
__device__ __forceinline__ void w_scatter(const float (&v)[64], LAS float* scr, int lane) {
    LAS float* d = scr + (lane & 31) * 130 + (lane >> 5);
#pragma unroll
    for (int i = 0; i < 64; ++i) d[2 * i] = v[i];
}
__device__ __forceinline__ void w_emit(const WItem& w, LAS const float* scr, int lane) {
    asm volatile("s_waitcnt lgkmcnt(0)" ::: "memory");
    const int c = lane & 7; const float sc = w.sc;
#pragma unroll
    for (int j = 0; j < 4; ++j) {
        const int nn = (lane >> 3) + 8 * j; const LAS float* sp = scr + nn * 130 + 16 * c;
        f32x2 a[8];
#pragma unroll
        for (int q = 0; q < 8; ++q) a[q] = *(LAS const f32x2*)(sp + 2 * q);
        u32x4 o;
        o.x = pack_fp8x4(a[0].x * sc, a[0].y * sc, a[1].x * sc, a[1].y * sc); o.y = pack_fp8x4(a[2].x * sc, a[2].y * sc, a[3].x * sc, a[3].y * sc);
        o.z = pack_fp8x4(a[4].x * sc, a[4].y * sc, a[5].x * sc, a[5].y * sc); o.w = pack_fp8x4(a[6].x * sc, a[6].y * sc, a[7].x * sc, a[7].y * sc);
        *(u32x4*)(w.dst + (size_t)nn * w.dld + 16 * c) = o;
    }
    asm volatile("s_waitcnt lgkmcnt(0)" ::: "memory");
}
__device__ __forceinline__ WItem w_decode(const Ctx& F, int r) {
    const Args& A = *F.a;
    constexpr int I_UP = NE * 8 * 64;
    WItem w;
    if (r < I_UP) { const int e = r / (8 * 64), rr = r % (8 * 64), kb = rr / 64, nb = rr % 64; const int n0 = 32 * nb, half = n0 >= FF, rem = n0 - half * FF, pn = rem >> 7, b = (rem & 127) >> 5;
        w.src = A.in[I_WUP] + (size_t)e * DM * 2 * FF + (size_t)(128 * kb) * (2 * FF) + n0; w.N = 2 * FF; w.dst = F.ws + WS_WUP + (size_t)(e * 2048 + 256 * pn + half * 128 + 32 * b) * DM + 128 * kb; w.dld = DM; w.sc = 32.0f; }
    else { r -= I_UP; const int e = r / (8 * 32), rr = r % (8 * 32), kb = rr / 32, nb = rr % 32;
        w.src = A.in[I_WDN] + (size_t)e * FF * DM + (size_t)(128 * kb) * DM + 32 * nb; w.N = DM; w.dst = F.ws + WS_WDN + (size_t)(e * 1024 + 32 * nb) * FF + 128 * kb; w.dld = FF; w.sc = 64.0f; }
    return w;
}
__device__ __forceinline__ void ph_wconv(const Ctx& F) {
    LAS float* scr = (LAS float*)(F.lds + F.wave * 16640);
    constexpr int NIT = NE * 8 * 64 + NE * 8 * 32;
    const int chunk = (NIT + F.G - 1) / F.G, lo = (int)blockIdx.x * chunk, hi = (lo + chunk < NIT) ? lo + chunk : NIT;
    __syncthreads();
    int it = lo + F.wave;
    if (it < hi) {
        float v[64];
        WItem cur = w_decode(F, it);
        w_load(cur, v, F.lane);
        for (;;) {
            w_scatter(v, scr, F.lane);
            const int itn = it + 8; const bool more = itn < hi;
            WItem nxt = cur;
            if (more) { nxt = w_decode(F, itn); w_load(nxt, v, F.lane); }
            w_emit(cur, scr, F.lane);
            if (!more) break;
            cur = nxt; it = itn;
        }
    }
    asm volatile("s_waitcnt vmcnt(0)" ::: "memory");
    __syncthreads();
}

typedef short v4i16_t __attribute__((ext_vector_type(4)));
__device__ __forceinline__ v4i16_t lds_tr16(LAS const unsigned char* p) { return __builtin_amdgcn_ds_read_tr16_b64_v4i16((LAS v4i16_t*)p); }
__device__ __forceinline__ void ph_mixer_a(const Ctx& F) {
    const Args& A = *F.a;
    const unsigned char* GV = F.ws + WS_GV; bf16_t* YAB = (bf16_t*)(F.ws + WS_YAB); const float* GVST = (const float*)(F.ws + WS_GVST);
    const float* lg = A.in[I_GLN_G]; const float* lb = A.in[I_GLN_B]; const float* wsp = A.in[I_WSP]; const float* bsp = A.in[I_BSP];
    constexpr int RSV = 544, RSW = 272, OFF_W = 128 * RSV, OFF_ST = OFF_W + 128 * RSW;
    LAS unsigned char* VT = F.lds; LAS unsigned char* WT = F.lds + OFF_W; LAS float* ST = (LAS float*)(F.lds + OFF_ST);
    const int lane = F.lane, wv = F.wave;
    int curg = -1;
    for (int it = F.vcu; it < NB * 32 * 4; it += F.G) {
        const int b = it / 128, c = (it >> 2) & 31, g = it & 3;
        const int tok0 = b * SEQ + c * 128;
        if (g != curg) {
            curg = g;
            for (int k = 0; k < 4; ++k) {
                const int idx = F.tid + 512 * k, t = idx >> 4, s8 = (idx & 15) * 8;
                const f32x4 w0 = *(const f32x4*)(wsp + ((size_t)g * 128 + t) * 128 + s8), w1 = *(const f32x4*)(wsp + ((size_t)g * 128 + t) * 128 + s8 + 4);
                float x[8] = {w0.x, w0.y, w0.z, w0.w, w1.x, w1.y, w1.z, w1.w};
#pragma unroll
                for (int j = 0; j < 8; ++j) x[j] = (s8 + j <= t) ? x[j] : 0.f;
                u32x4 o; o.x = pk2(x[0], x[1]); o.y = pk2(x[2], x[3]); o.z = pk2(x[4], x[5]); o.w = pk2(x[6], x[7]);
                *(LAS u32x4*)(WT + t * RSW + s8 * 2) = o;
            }
        }
        if (F.tid < 128) {
            const float* p = GVST + (size_t)(tok0 + F.tid) * 32; float s1 = 0.f, s2 = 0.f;
            for (int i = 0; i < 16; ++i) { s1 += p[2 * i]; s2 += p[2 * i + 1]; }
            const float mean = s1 * (1.f / DM), var = s2 * (1.f / DM) - mean * mean;
            ST[2 * F.tid] = mean; ST[2 * F.tid + 1] = 1.f / sqrtf(fmaxf(var, 0.f) + LN_EPS);
        }
        __syncthreads();
        {
            const int dc = F.tid & 31;
            const f32x4 g0 = *(const f32x4*)(lg + g * 256 + dc * 8), g1 = *(const f32x4*)(lg + g * 256 + dc * 8 + 4), b0 = *(const f32x4*)(lb + g * 256 + dc * 8), b1 = *(const f32x4*)(lb + g * 256 + dc * 8 + 4);
            u32x2 rawv[8];
#pragma unroll
            for (int k = 0; k < 8; ++k) rawv[k] = *(const u32x2*)(GV + (size_t)(tok0 + (F.tid >> 5) + 16 * k) * DM + g * 256 + dc * 8);
#pragma unroll
            for (int k = 0; k < 8; ++k) {
                const int s = (F.tid >> 5) + 16 * k;
                const u32x2 raw = rawv[k];
                const float mean = ST[2 * s], rstd = ST[2 * s + 1];
                const f32x2v f0 = __builtin_amdgcn_cvt_pk_f32_fp8((int)raw.x, false), f1 = __builtin_amdgcn_cvt_pk_f32_fp8((int)raw.x, true), f2 = __builtin_amdgcn_cvt_pk_f32_fp8((int)raw.y, false), f3 = __builtin_amdgcn_cvt_pk_f32_fp8((int)raw.y, true);
                f32x4 x0 = {f0.x, f0.y, f1.x, f1.y}, x1 = {f2.x, f2.y, f3.x, f3.y};
                x0 = (x0 - mean) * rstd * g0 + b0; x1 = (x1 - mean) * rstd * g1 + b1;
                u32x4 o; o.x = pk2(x0.x, x0.y); o.y = pk2(x0.z, x0.w); o.z = pk2(x1.x, x1.y); o.w = pk2(x1.z, x1.w);
                *(LAS u32x4*)(VT + s * RSV + dc * 16) = o;
            }
        }
        __syncthreads();
        {
            const int dbase = 32 * wv, kg = lane >> 4, q = (lane & 15) >> 2, p = lane & 3, fr = lane & 15;
            u32x2 uu[8][2]; float bsn[8];
#pragma unroll
            for (int n = 0; n < 8; ++n) { const bf16_t* yp = YAB + (size_t)(tok0 + 16 * n + fr) * 2048 + g * 256 + dbase + 4 * kg; uu[n][0] = *(const u32x2*)yp; uu[n][1] = *(const u32x2*)(yp + 16); bsn[n] = bsp[g * 128 + 16 * n + fr]; }
            bf16x8 Af[2][4];
#pragma unroll
            for (int m = 0; m < 2; ++m)
#pragma unroll
                for (int kk = 0; kk < 4; ++kk) {
                    LAS const unsigned char* ap = VT + (32 * kk + 8 * kg + q) * RSV + (dbase + 16 * m + 4 * p) * 2;
                    const v4i16_t lo = lds_tr16(ap), hi = lds_tr16(ap + 4 * RSV);
                    Af[m][kk] = (bf16x8){lo[0], lo[1], lo[2], lo[3], hi[0], hi[1], hi[2], hi[3]};
                }
#pragma unroll
            for (int n = 0; n < 8; ++n) {
                f32x4 acc0 = {0.f, 0.f, 0.f, 0.f}, acc1 = {0.f, 0.f, 0.f, 0.f};
#pragma unroll
                for (int kk = 0; kk < 4; ++kk) if (kk <= (n >> 1)) {
                    const bf16x8 Bf = *(LAS const bf16x8*)(WT + (16 * n + fr) * RSW + (32 * kk + 8 * kg) * 2);
                    acc0 = __builtin_amdgcn_mfma_f32_16x16x32_bf16(Af[0][kk], Bf, acc0, 0, 0, 0);
                    acc1 = __builtin_amdgcn_mfma_f32_16x16x32_bf16(Af[1][kk], Bf, acc1, 0, 0, 0);
                }
                const int t = 16 * n + fr; const float bsv = bsn[n];
                const u32x2 u0 = uu[n][0], u1 = uu[n][1];
                unsigned char* y8 = F.ws + WS_YA8 + (size_t)(tok0 + t) * 2048 + g * 256 + dbase + 4 * kg;
                *(unsigned*)y8 = pack_fp8x4(bflo(u0.x) * (acc0[0] + bsv), bfhi(u0.x) * (acc0[1] + bsv), bflo(u0.y) * (acc0[2] + bsv), bfhi(u0.y) * (acc0[3] + bsv));
                *(unsigned*)(y8 + 16) = pack_fp8x4(bflo(u1.x) * (acc1[0] + bsv), bfhi(u1.x) * (acc1[1] + bsv), bflo(u1.y) * (acc1[2] + bsv), bfhi(u1.y) * (acc1[3] + bsv));
            }
        }
        __syncthreads();
    }
}

__device__ __forceinline__ void ph_gate(const Ctx& F) {
    const unsigned char* Q = F.ws + WS_Q; const float* KM = (const float*)(F.ws + WS_KMEAN);
    unsigned* SEL = (unsigned*)(F.ws + WS_SEL); unsigned* LISTS = (unsigned*)(F.ws + WS_LISTS); unsigned* LCNT = (unsigned*)(F.ws + WS_CTL) + CW_LCNT;
    constexpr int KMR = 272;
    LAS unsigned char* kmh = F.lds; LAS unsigned char* kml = F.lds + 16 * KMR;
    unsigned* lc = (unsigned*)(F.ldsg + 2 * 16 * KMR);
    LAS float* scw = (LAS float*)(F.lds + 16384) + F.wave * 1024;
    const int fr = F.lane & 15, fq = F.lane >> 4;
    for (int it = F.vcu; it < NB * NH * 8; it += F.G) {
        const int b = it / 64, h = (it >> 3) & 7, tc = it & 7;
        {
            const int j = F.tid >> 5, d4 = (F.tid & 31) * 4;
            const float* kp = KM + (size_t)((b * NBLK + j) * 2) * DM + h * DH + d4;
            const f32x4 s0 = *(const f32x4*)kp, s1 = *(const f32x4*)(kp + DM);
            const f32x4 mv = (s0 + s1) * (1.0f / LBLK);
            unsigned hb[4]; float lo[4];
#pragma unroll
            for (int e = 0; e < 4; ++e) { hb[e] = f2bf(mv[e]); lo[e] = mv[e] - __uint_as_float(hb[e] << 16); }
            *(LAS u32x2*)(kmh + j * KMR + d4 * 2) = (u32x2){hb[0] | (hb[1] << 16), hb[2] | (hb[3] << 16)};
            *(LAS u32x2*)(kml + j * KMR + d4 * 2) = (u32x2){pk2(lo[0], lo[1]), pk2(lo[2], lo[3])};
        }
        if (F.tid < 32) lc[F.tid] = 0u;
        const int tw = tc * 512 + F.wave * 64;
        u32x4 qraw[4][2];
#pragma unroll
        for (int tg = 0; tg < 4; ++tg) { const unsigned char* qp = Q + (size_t)(b * SEQ + tw + 16 * tg + fr) * DM + h * DH + 32 * fq; qraw[tg][0] = *(const u32x4*)qp; qraw[tg][1] = *(const u32x4*)(qp + 16); }
        __syncthreads();
        bf16x8 Ah[4], Al[4];
#pragma unroll
        for (int ks = 0; ks < 4; ++ks) { Ah[ks] = *(LAS const bf16x8*)(kmh + fr * KMR + (32 * fq + 8 * ks) * 2); Al[ks] = *(LAS const bf16x8*)(kml + fr * KMR + (32 * fq + 8 * ks) * 2); }
#pragma unroll
        for (int tg = 0; tg < 4; ++tg) {
            f32x4 acc = {0.f, 0.f, 0.f, 0.f};
#pragma unroll
            for (int ks = 0; ks < 4; ++ks) {
                const u32x4 w = qraw[tg][ks >> 1]; const unsigned w0 = (ks & 1) ? w.z : w.x, w1 = (ks & 1) ? w.w : w.y;
                const bf16x8 Bq = __builtin_bit_cast(bf16x8, f8x8_to_bf16x8(w0, w1));
                acc = __builtin_amdgcn_mfma_f32_16x16x32_bf16(Ah[ks], Bq, acc, 0, 0, 0);
                acc = __builtin_amdgcn_mfma_f32_16x16x32_bf16(Al[ks], Bq, acc, 0, 0, 0);
            }
            *(LAS f32x4*)(scw + (16 * tg + fr) * 16 + 4 * fq) = acc;
        }
        asm volatile("s_waitcnt lgkmcnt(0)" ::: "memory");
        const int t = tc * 512 + F.tid, qi = t >> 8;
        float gsc[15];
        { const f32x4 c0 = *(LAS const f32x4*)(scw + F.lane * 16), c1 = *(LAS const f32x4*)(scw + F.lane * 16 + 4), c2 = *(LAS const f32x4*)(scw + F.lane * 16 + 8), c3 = *(LAS const f32x4*)(scw + F.lane * 16 + 12);
          gsc[0] = c0.x; gsc[1] = c0.y; gsc[2] = c0.z; gsc[3] = c0.w; gsc[4] = c1.x; gsc[5] = c1.y; gsc[6] = c1.z; gsc[7] = c1.w;
          gsc[8] = c2.x; gsc[9] = c2.y; gsc[10] = c2.z; gsc[11] = c2.w; gsc[12] = c3.x; gsc[13] = c3.y; gsc[14] = c3.z; }
        const int nsel = qi < 3 ? qi : 3;
        int sel[3] = {0, 0, 0}; unsigned lpos[3] = {0, 0, 0};
#pragma unroll
        for (int r = 0; r < 3; ++r) {
            float best = -INFINITY; int bi = -1;
#pragma unroll
            for (int j = 0; j < 15; ++j) { const bool c = (j < qi) && (gsc[j] > best); best = c ? gsc[j] : best; bi = c ? j : bi; }
#pragma unroll
            for (int j = 0; j < 15; ++j) if (j == bi) gsc[j] = -INFINITY;
            sel[r] = bi < 0 ? 0 : bi;
            if (r < nsel) lpos[r] = atomicAdd(&lc[sel[r]], 1u);
        }
        SEL[(size_t)(b * SEQ + t) * NH + h] = (unsigned)sel[0] | ((unsigned)sel[1] << 8) | ((unsigned)sel[2] << 16) | ((unsigned)nsel << 24);
        __syncthreads();
        if (F.tid < 16) lc[16 + F.tid] = lc[F.tid] ? atomicAdd(&LCNT[(b * NH + h) * NBLK + F.tid], lc[F.tid]) : 0u;
        __syncthreads();
#pragma unroll
        for (int r = 0; r < 3; ++r) if (r < nsel) LISTS[(size_t)((b * NH + h) * NBLK + sel[r]) * 4096 + lc[16 + sel[r]] + lpos[r]] = (unsigned)t | ((unsigned)r << 12);
        __syncthreads();
    }
}


typedef float f32x16 __attribute__((ext_vector_type(16)));
namespace att {
__device__ __forceinline__ int crow(int r, int hi) { return (r & 3) + 8 * (r >> 2) + 4 * hi; }
#define TRR(dst, vaddr, off) asm volatile("ds_read_b64_tr_b16 %0, %1 offset:%c2" : "=v"(dst) : "v"(vaddr), "i"(off) : "memory")
#define TRWAIT() do { asm volatile("s_waitcnt lgkmcnt(0)" ::: "memory"); __builtin_amdgcn_sched_barrier(0); } while (0)

}

namespace att2 {
constexpr int KCH2 = 1040, VRS = 160, KSL = 8 * KCH2, VSL = 64 * VRS;
constexpr int OFF_K = 0, OFF_V = 2 * KSL, OFF_STG = OFF_V + 2 * VSL  , OFF_WS = OFF_STG + 8 * 8192  , WSW = 1024, OFF_TAB = OFF_WS + 8 * WSW  ;
static_assert(OFF_TAB + (1032 + 64) * 4 <= LDS_BYTES - 64, "attention (partial) LDS map");
using att::crow;

__device__ __forceinline__ void tile_load(const Ctx& F, const unsigned char* K, const unsigned char* V, size_t tokbase, int h, int kt, u32x4& rk, u32x4& rv) {
    const size_t off = (tokbase + 64 * kt + (F.tid >> 3)) * DM + h * DH + (F.tid & 7) * 16;
    rk = *(const u32x4*)(K + off); rv = *(const u32x4*)(V + off);
}
__device__ __forceinline__ void tile_write(const Ctx& F, int slot, const u32x4& rk, const u32x4& rv) {
    const int key = F.tid >> 3;
    *(LAS u32x4*)(F.lds + OFF_K + slot * KSL + (F.tid & 7) * KCH2 + key * 16) = rk;
    const int vrow = 32 * ((key >> 2) & 1) + (key & 3) + 4 * ((key >> 3) & 3) + 16 * (key >> 5);
    *(LAS u32x4*)(F.lds + OFF_V + slot * VSL + vrow * VRS + (F.tid & 7) * 16) = rv;
}
template <bool CAUSAL = false>
__device__ __forceinline__ void tile_compute(const Ctx& F, int slot, const pg8::v8i_t (&qf)[2], f32x16 (&o)[4], float& m, float& l, bool first, bool diag = false) {
    const int r = F.lane & 31, hh = F.lane >> 5;
    LAS float* wsf = (LAS float*)(F.lds + OFF_WS + F.wave * WSW);
    LAS const unsigned char* kp = F.lds + OFF_K + slot * KSL + 2 * hh * KCH2 + r * 16;
    LAS const unsigned char* vp = F.lds + OFF_V + slot * VSL + (32 * hh + ((F.lane & 15) >> 1)) * VRS + ((F.lane >> 4) & 1) * 16 + (F.lane & 1) * 8;
    f32x16 p0, p1;
#pragma unroll
    for (int i = 0; i < 16; ++i) { p0[i] = 0.f; p1[i] = 0.f; }
    {
        pg8::v8i_t ka[2][2];
#pragma unroll
        for (int kb = 0; kb < 2; ++kb)
#pragma unroll
            for (int j2 = 0; j2 < 2; ++j2) ka[kb][j2] = __builtin_shufflevector(*(LAS const pg8::v4i_t*)(kp + 4 * j2 * KCH2 + kb * 512), *(LAS const pg8::v4i_t*)(kp + (4 * j2 + 1) * KCH2 + kb * 512), 0, 1, 2, 3, 4, 5, 6, 7);
        __builtin_amdgcn_sched_barrier(0);
#pragma unroll
        for (int j2 = 0; j2 < 2; ++j2) p0 = __builtin_amdgcn_mfma_scale_f32_32x32x64_f8f6f4(ka[0][j2], qf[j2], p0, 0, 0, 0, 0x7f7f7f7f, 0, 0x7f7f7f7f);
#pragma unroll
        for (int j2 = 0; j2 < 2; ++j2) p1 = __builtin_amdgcn_mfma_scale_f32_32x32x64_f8f6f4(ka[1][j2], qf[j2], p1, 0, 0, 0, 0x7f7f7f7f, 0, 0x7f7f7f7f);
        __builtin_amdgcn_sched_barrier(0);
    }
    v4i16_t vr[4][4];
    const unsigned vaddr = (unsigned)(uintptr_t)vp;
#define TRR8(dst, vaddr, off) asm volatile("ds_read_b64_tr_b8 %0, %1 offset:%c2" : "=v"(dst) : "v"(vaddr), "i"(off) : "memory")
#pragma unroll
    for (int db = 0; db < 4; ++db)
#pragma unroll
        for (int q8 = 0; q8 < 4; ++q8) TRR8(vr[db][q8], vaddr, q8 * 8 * VRS + db * 32);
    __builtin_amdgcn_sched_barrier(0);
    if (CAUSAL && diag) {
        if (F.wave & 1) {
#pragma unroll
            for (int i = 0; i < 16; ++i) p1[i] = (crow(i, hh) > r) ? -INFINITY : p1[i];
        } else {
#pragma unroll
            for (int i = 0; i < 16; ++i) { p0[i] = (crow(i, hh) > r) ? -INFINITY : p0[i]; p1[i] = -INFINITY; }
        }
    }
    const float dm = first ? 0.f : m;
    { const f32x2 dm2 = {dm, dm};
#pragma unroll
      for (int j = 0; j < 8; ++j) { f32x2 a = {p0[2 * j], p0[2 * j + 1]}, b = {p1[2 * j], p1[2 * j + 1]}; a = a - dm2; b = b - dm2; p0[2 * j] = a.x; p0[2 * j + 1] = a.y; p1[2 * j] = b.x; p1[2 * j + 1] = b.y; } }
    float mx = fmaxf(p0[0], p1[0]);
#pragma unroll
    for (int i = 1; i < 16; ++i) mx = fmaxf(mx, fmaxf(p0[i], p1[i]));
    mx = fmaxf(mx, __shfl_xor(mx, 32));
    if (first || __any(mx > 8.0f)) {
        const float delta = first ? mx : fmaxf(mx, 0.f);
        const float alpha = first ? 0.f : __builtin_amdgcn_exp2f(-delta);
        l *= alpha; m = dm + delta;
        { const f32x2 d2 = {delta, delta};
#pragma unroll
          for (int j = 0; j < 8; ++j) { f32x2 a = {p0[2 * j], p0[2 * j + 1]}, b = {p1[2 * j], p1[2 * j + 1]}; a = a - d2; b = b - d2; p0[2 * j] = a.x; p0[2 * j + 1] = a.y; p1[2 * j] = b.x; p1[2 * j + 1] = b.y; } }
        if (!first) {
            if (hh == 0) wsf[r] = alpha;
            asm volatile("s_waitcnt lgkmcnt(0)" ::: "memory");
#pragma unroll
            for (int i = 0; i < 16; ++i) { const float a = wsf[crow(i, hh)];
#pragma unroll
                for (int db = 0; db < 4; ++db) o[db][i] *= a; }
        }
    }
    { f32x2 sa = {0.f, 0.f}, sb = {0.f, 0.f};
#pragma unroll
      for (int j = 0; j < 8; ++j) {
          p0[2 * j] = __builtin_amdgcn_exp2f(p0[2 * j]); p0[2 * j + 1] = __builtin_amdgcn_exp2f(p0[2 * j + 1]); p1[2 * j] = __builtin_amdgcn_exp2f(p1[2 * j]); p1[2 * j + 1] = __builtin_amdgcn_exp2f(p1[2 * j + 1]);
          sa = sa + (f32x2){p0[2 * j], p0[2 * j + 1]}; sb = sb + (f32x2){p1[2 * j], p1[2 * j + 1]}; }
      sa = sa + sb; l += sa.x + sa.y; }
    pg8::v8i_t pa;
#pragma unroll
    for (int i = 0; i < 4; ++i) { pa[i] = (int)pack_fp8x4(p0[4 * i], p0[4 * i + 1], p0[4 * i + 2], p0[4 * i + 3]); pa[4 + i] = (int)pack_fp8x4(p1[4 * i], p1[4 * i + 1], p1[4 * i + 2], p1[4 * i + 3]); }
    TRWAIT();
#pragma unroll
    for (int db = 0; db < 4; ++db) {
        pg8::v8i_t vf;
#pragma unroll
        for (int q8 = 0; q8 < 4; ++q8) { const u32x2 w = __builtin_bit_cast(u32x2, vr[db][q8]); vf[2 * q8] = (int)w.x; vf[2 * q8 + 1] = (int)w.y; }
        o[db] = __builtin_amdgcn_mfma_scale_f32_32x32x64_f8f6f4(pa, vf, o[db], 0, 0, 0, 0x7f7f7f7f, 0, 0x7f7f7f7f);
    }
    __builtin_amdgcn_sched_barrier(0);
#undef TRR8
}
}

#define ATT2_DECODE(item, bhj_, chunk_) do { int lo_ = 0, hi_ = 1023; while (lo_ < hi_) { const int mid_ = (lo_ + hi_ + 1) >> 1; if (P[mid_] <= (item)) lo_ = mid_; else hi_ = mid_ - 1; } bhj_ = lo_; chunk_ = (item) - P[lo_]; } while (0)
__device__ __forceinline__ void ph_attn_partial(const Ctx& F) {
    using namespace att2;
    const unsigned char* Q = F.ws + WS_Q; const unsigned char* K = F.ws + WS_K; const unsigned char* V = F.ws + WS_V;
    const unsigned* LISTS = (const unsigned*)(F.ws + WS_LISTS); const unsigned* LCNT = (const unsigned*)(F.ws + WS_CTL) + CW_LCNT;
    unsigned char* OP = F.ws + WS_OP; float* LSE = (float*)(F.ws + WS_LSE);
    LAS int* P = (LAS int*)(F.lds + OFF_TAB);
    if (F.tid < 64) {
        int c[16]; int s = 0;
#pragma unroll
        for (int i = 0; i < 16; ++i) { c[i] = ((int)__hip_atomic_load(LCNT + F.tid * 16 + i, __ATOMIC_RELAXED, __HIP_MEMORY_SCOPE_AGENT) + 255) >> 8; s += c[i]; }
        int inc = s;
#pragma unroll
        for (int o = 1; o < 64; o <<= 1) { const int t = __shfl_up(inc, o); if (F.lane >= o) inc += t; }
        int run = inc - s;
#pragma unroll
        for (int i = 0; i < 16; ++i) { P[F.tid * 16 + i] = run; run += c[i]; }
        if (F.tid == 63) P[1024] = run;
    }
    __syncthreads();
    const int total = P[1024];
    LAS int* ITB = P + 1032;
    if (F.tid < 32) { const int idx = F.vcu + F.tid * F.G; int bb = 0, cc = 0; if (idx < total) ATT2_DECODE(idx, bb, cc); ITB[2 * F.tid] = bb; ITB[2 * F.tid + 1] = cc; }
    __syncthreads();
#define ATT2_ITEM(k_, item_, bhj_, chunk_) do { if ((k_) < 32) { bhj_ = ITB[2 * (k_)]; chunk_ = ITB[2 * (k_) + 1]; } else ATT2_DECODE(item_, bhj_, chunk_); } while (0)
    LAS float* wsf = (LAS float*)(F.lds + OFF_WS + F.wave * WSW);
    LAS int* wsi = (LAS int*)wsf;
    const int r = F.lane & 31, hh = F.lane >> 5;
    int it = F.vcu, kit = 0;
    if (it < total) {
        int bhj, chunk; ATT2_ITEM(0, it, bhj, chunk);
        int itn = it + F.G, bhjn = 0, chunkn = 0; bool hasn = itn < total; if (hasn) ATT2_ITEM(1, itn, bhjn, chunkn);
        u32x4 rkA, rvA, rkB, rvB;
        { const int b = bhj >> 7, h = (bhj >> 4) & 7, j = bhj & 15; const size_t tb = (size_t)b * SEQ + j * LBLK;
          tile_load(F, K, V, tb, h, 0, rkA, rvA); tile_load(F, K, V, tb, h, 1, rkB, rvB); tile_write(F, 0, rkA, rvA); tile_write(F, 1, rkB, rvB);
          tile_load(F, K, V, tb, h, 2, rkA, rvA); }
        int cnt = (int)__hip_atomic_load(LCNT + bhj, __ATOMIC_RELAXED, __HIP_MEMORY_SCOPE_AGENT);
        int qi = chunk * 256 + F.wave * 32 + r;
        unsigned ent = LISTS[(size_t)bhj * 4096 + (qi < cnt ? qi : 0)];
        int tq = ent & 4095, slot = (qi < cnt) ? (int)(ent >> 12) : -1;
        u32x4 qraw[4];
        { const unsigned char* qrow = Q + ((size_t)(bhj >> 7) * SEQ + tq) * DM + ((bhj >> 4) & 7) * DH + hh * 32;
#pragma unroll
          for (int c = 0; c < 4; ++c) qraw[c] = *(const u32x4*)(qrow + (c >> 1) * 64 + (c & 1) * 16); }
        unsigned entn = 0u; int cntn = 0;
        __syncthreads();
        int s = 0;
        for (;;) {
            const int b = bhj >> 7, h = (bhj >> 4) & 7, j = bhj & 15;
            pg8::v8i_t qr[2];
#pragma unroll
            for (int j2 = 0; j2 < 2; ++j2) qr[j2] = __builtin_shufflevector(__builtin_bit_cast(pg8::v4i_t, qraw[2 * j2]), __builtin_bit_cast(pg8::v4i_t, qraw[2 * j2 + 1]), 0, 1, 2, 3, 4, 5, 6, 7);
            if (F.lane < 32) { wsi[64 + r] = tq; wsi[96 + r] = slot; }
            f32x16 o[4]; float m = -1e30f, l = 0.f;
#pragma unroll
            for (int db = 0; db < 4; ++db)
#pragma unroll
                for (int i = 0; i < 16; ++i) o[db][i] = 0.f;
#define ATT2_TB(bb) ((size_t)((bb) >> 7) * SEQ + ((bb) & 15) * LBLK)
#define ATT2_H(bb) (((bb) >> 4) & 7)
#pragma unroll 1
            for (int kp2 = 0; kp2 < 2; ++kp2) {
                const int kt = 2 * kp2;
                { const bool cur3 = kt + 3 < 4, have3 = cur3 || hasn, have2 = (kt + 2 < 4) || hasn;
                  if (have3) { const int bb = cur3 ? bhj : bhjn; tile_load(F, K, V, ATT2_TB(bb), ATT2_H(bb), (kt + 3) & 3, rkB, rvB); }
                  if (kt == 0 && hasn) { cntn = (int)__hip_atomic_load(LCNT + bhjn, __ATOMIC_RELAXED, __HIP_MEMORY_SCOPE_AGENT); }
                  if (kt == 2 && hasn) { const unsigned char* qrow = Q + ((size_t)(bhjn >> 7) * SEQ + (entn & 4095)) * DM + ((bhjn >> 4) & 7) * DH + hh * 32;
#pragma unroll
                      for (int c = 0; c < 4; ++c) qraw[c] = *(const u32x4*)(qrow + (c >> 1) * 64 + (c & 1) * 16); }
                  tile_compute(F, 0, qr, o, m, l, kp2 == 0);
                  asm volatile("s_waitcnt lgkmcnt(0)" ::: "memory"); __builtin_amdgcn_s_barrier(); asm volatile("" ::: "memory");
                  if (have2) tile_write(F, 0, rkA, rvA); }
                { const bool have4 = hasn, have3 = (kt + 3 < 4) || hasn;
                  if (have4) { tile_load(F, K, V, ATT2_TB(bhjn), ATT2_H(bhjn), kt, rkA, rvA); }
                  if (kt == 0 && hasn) { const int qn = chunkn * 256 + F.wave * 32 + r; entn = LISTS[(size_t)bhjn * 4096 + (qn < cntn ? qn : 0)]; }
                  tile_compute(F, 1, qr, o, m, l, false);
                  asm volatile("s_waitcnt lgkmcnt(0)" ::: "memory"); __builtin_amdgcn_s_barrier(); asm volatile("" ::: "memory");
                  if (have3) tile_write(F, 1, rkB, rvB); }
            }
            const float lt = l + __shfl_xor(l, 32);
            if (hh == 0) { wsf[r] = 1.0f / lt; wsf[32 + r] = m + __builtin_amdgcn_logf(lt); }
            asm volatile("s_waitcnt lgkmcnt(0)" ::: "memory");
            int re = r, he = hh; asm volatile("" : "+v"(re), "+v"(he));
#pragma unroll
            for (int i = 0; i < 16; ++i) {
                const int q = crow(i, he); const float a = wsf[q]; const int t = wsi[64 + q], sl = wsi[96 + q];
                const unsigned w = pack_fp8x4(o[0][i] * a, o[1][i] * a, o[2][i] * a, o[3][i] * a);
                if (sl >= 0) { const size_t row = (((size_t)sl * NB + b) * SEQ + t) * NH + h; *(unsigned*)(OP + row * DH + 4 * re) = w; }
            }
            if (he == 0 && slot >= 0) LSE[(((size_t)slot * NB + b) * SEQ + tq) * NH + h] = wsf[32 + re];
            asm volatile("s_waitcnt lgkmcnt(0)" ::: "memory");
            if (!hasn) break;
            it = itn; bhj = bhjn; chunk = chunkn; cnt = cntn;
            { const int qn = chunk * 256 + F.wave * 32 + r; tq = entn & 4095; slot = (qn < cnt) ? (int)(entn >> 12) : -1; }
            ++kit; itn = it + F.G; hasn = itn < total; if (hasn) ATT2_ITEM(kit + 1, itn, bhjn, chunkn);
        }
    }
    __syncthreads();
}

__device__ __forceinline__ void ph_attn_own(const Ctx& F) {
    using namespace att2;
    const unsigned char* Q = F.ws + WS_Q; const unsigned char* K = F.ws + WS_K; const unsigned char* V = F.ws + WS_V;
    const unsigned char* OP = F.ws + WS_OP; const float* LSE = (const float*)(F.ws + WS_LSE); unsigned char* YA8 = F.ws + WS_YA8;
    LAS float* wsf = (LAS float*)(F.lds + OFF_WS + F.wave * WSW);
    const int r = F.lane & 31, hh = F.lane >> 5;
    constexpr int NIT = NB * NH * NBLK;
    int it = F.vcu;
    if (it < NIT) {
        int itn = it + F.G; bool hasn = itn < NIT;
        u32x4 rkA, rvA, rkB, rvB;
#define OWN_TB(i_) ((size_t)((i_) >> 7) * SEQ + ((i_) & 15) * LBLK)
#define OWN_H(i_) (((i_) >> 4) & 7)
        tile_load(F, K, V, OWN_TB(it), OWN_H(it), 0, rkA, rvA); tile_load(F, K, V, OWN_TB(it), OWN_H(it), 1, rkB, rvB); tile_write(F, 0, rkA, rvA); tile_write(F, 1, rkB, rvB);
        tile_load(F, K, V, OWN_TB(it), OWN_H(it), 2, rkA, rvA);
        u32x4 qraw[4];
        { const unsigned char* qrow = Q + (OWN_TB(it) + F.wave * 32 + r) * DM + OWN_H(it) * DH + hh * 32;
#pragma unroll
          for (int c = 0; c < 4; ++c) qraw[c] = *(const u32x4*)(qrow + (c >> 1) * 64 + (c & 1) * 16); }
        __syncthreads();
        const int wdiag = F.wave >> 1;
        for (;;) {
            const int b = it >> 7, h = (it >> 4) & 7, j = it & 15, t0 = j * LBLK + F.wave * 32;
            pg8::v8i_t qr[2];
#pragma unroll
            for (int j2 = 0; j2 < 2; ++j2) qr[j2] = __builtin_shufflevector(__builtin_bit_cast(pg8::v4i_t, qraw[2 * j2]), __builtin_bit_cast(pg8::v4i_t, qraw[2 * j2 + 1]), 0, 1, 2, 3, 4, 5, 6, 7);
            f32x16 o[4]; float m = -1e30f, l = 0.f;
#pragma unroll
            for (int db = 0; db < 4; ++db)
#pragma unroll
                for (int i = 0; i < 16; ++i) o[db][i] = 0.f;
#pragma unroll 1
            for (int kp2 = 0; kp2 < 2; ++kp2) {
                const int kt = 2 * kp2;
                { const bool cur3 = kt + 3 < 4, have3 = cur3 || hasn, have2 = (kt + 2 < 4) || hasn;
                  if (have3) { const int ii = cur3 ? it : itn; tile_load(F, K, V, OWN_TB(ii), OWN_H(ii), (kt + 3) & 3, rkB, rvB); }
                  if (kt == 2 && hasn) { const unsigned char* qrow = Q + (OWN_TB(itn) + F.wave * 32 + r) * DM + OWN_H(itn) * DH + hh * 32;
#pragma unroll
                      for (int c = 0; c < 4; ++c) qraw[c] = *(const u32x4*)(qrow + (c >> 1) * 64 + (c & 1) * 16); }
                  if (kt <= wdiag) tile_compute<true>(F, 0, qr, o, m, l, kp2 == 0, kt == wdiag);
                  asm volatile("s_waitcnt lgkmcnt(0)" ::: "memory"); __builtin_amdgcn_s_barrier(); asm volatile("" ::: "memory");
                  if (have2) tile_write(F, 0, rkA, rvA); }
                { const bool have4 = hasn, have3 = (kt + 3 < 4) || hasn;
                  if (have4) { tile_load(F, K, V, OWN_TB(itn), OWN_H(itn), kt, rkA, rvA); }
                  if (kt + 1 <= wdiag) tile_compute<true>(F, 1, qr, o, m, l, false, kt + 1 == wdiag);
                  asm volatile("s_waitcnt lgkmcnt(0)" ::: "memory"); __builtin_amdgcn_s_barrier(); asm volatile("" ::: "memory");
                  if (have3) tile_write(F, 1, rkB, rvB); }
            }
            const int nv = j < 3 ? j : 3;
            int re = r, he = hh; asm volatile("" : "+v"(re), "+v"(he));
            LAS float* stg = (LAS float*)(F.lds + OFF_STG + F.wave * 8192);
            unsigned pv[16][3];
#pragma unroll
            for (int i = 0; i < 16; ++i) { const int q = crow(i, he);
#pragma unroll
                for (int s2 = 0; s2 < 3; ++s2) { pv[i][s2] = 0u; if (s2 < nv) pv[i][s2] = *(const unsigned*)(OP + ((((size_t)s2 * NB + b) * SEQ + t0 + q) * NH + h) * DH + 4 * re); } }
            {
                const float lt = l + __shfl_xor(l, 32); const float lse_own = m + __builtin_amdgcn_logf(lt);
                float ls[3];
#pragma unroll
                for (int s2 = 0; s2 < 3; ++s2) ls[s2] = (s2 < nv) ? LSE[(((size_t)s2 * NB + b) * SEQ + t0 + r) * NH + h] : -1e30f;
                const float M = fmaxf(fmaxf(lse_own, ls[0]), fmaxf(ls[1], ls[2]));
                const float w0 = __builtin_amdgcn_exp2f(lse_own - M);
                float w[3], den = w0;
#pragma unroll
                for (int s2 = 0; s2 < 3; ++s2) { w[s2] = (s2 < nv) ? __builtin_amdgcn_exp2f(ls[s2] - M) : 0.f; den += w[s2]; }
                const float inv = 1.0f / den;
                if (hh == 0) { wsf[r] = w0 * inv / lt; wsf[32 + r] = w[0] * inv; wsf[64 + r] = w[1] * inv; wsf[96 + r] = w[2] * inv; }
                asm volatile("s_waitcnt lgkmcnt(0)" ::: "memory");
            }
            {
#pragma unroll
                for (int i = 0; i < 16; ++i) { const int q = crow(i, he); const float a = wsf[q];
                    float x0 = o[0][i] * a, x1 = o[1][i] * a, x2 = o[2][i] * a, x3 = o[3][i] * a;
#pragma unroll
                    for (int s2 = 0; s2 < 3; ++s2) { const float ww = wsf[32 * (s2 + 1) + q]; const f32x2v f0 = __builtin_amdgcn_cvt_pk_f32_fp8((int)pv[i][s2], false), f1 = __builtin_amdgcn_cvt_pk_f32_fp8((int)pv[i][s2], true);
                        x0 += ww * f0.x; x1 += ww * f0.y; x2 += ww * f1.x; x3 += ww * f1.y; }
                    o[0][i] = x0; o[1][i] = x1; o[2][i] = x2; o[3][i] = x3; }
            }
#pragma unroll
            for (int half = 0; half < 2; ++half) {
#pragma unroll
                for (int i = 0; i < 16; ++i) { const int q = crow(i, he); stg[q * 64 + re] = o[2 * half][i]; stg[q * 64 + 32 + re] = o[2 * half + 1][i]; }
                asm volatile("s_waitcnt lgkmcnt(0)" ::: "memory");
#pragma unroll
                for (int ps = 0; ps < 4; ++ps) {
                    const int q = ps * 8 + ((re + 32 * he) >> 3), dc = re & 7;
                    const f32x4 x = *(LAS const f32x4*)(stg + q * 64 + dc * 8), y = *(LAS const f32x4*)(stg + q * 64 + dc * 8 + 4);
                    *(u32x2*)(YA8 + ((size_t)b * SEQ + t0 + q) * 2048 + 1024 + h * DH + half * 64 + dc * 8) = (u32x2){pack_fp8x4(x.x, x.y, x.z, x.w), pack_fp8x4(y.x, y.y, y.z, y.w)};
                }
                asm volatile("s_waitcnt lgkmcnt(0)" ::: "memory");
            }
            if (!hasn) break;
            it = itn; itn = it + F.G; hasn = itn < NIT;
        }
#undef OWN_TB
#undef OWN_H
    }
    __syncthreads();
}

__device__ __forceinline__ void ph_router(const Ctx& F) {
    const Args& A = *F.a;
    const bf16_t* Z = (const bf16_t*)(F.ws + WS_Z); const float* ZST = (const float*)(F.ws + WS_ZST); bf16_t* H1 = (bf16_t*)(F.ws + WS_H1); unsigned char* H1F8 = F.ws + WS_H1F8;
    int* TKE = (int*)(F.ws + WS_TKE); int* TKP = (int*)(F.ws + WS_TKP); unsigned* ECNT = (unsigned*)(F.ws + WS_CTL) + CW_ECNT; int* RT = (int*)(F.ws + WS_RT); float* RW = (float*)(F.ws + WS_RW);
    const float* wr = A.in[I_WR]; const float* br = A.in[I_BR];
    constexpr int RS = 2064, OFF_LO = 32 * RS, OFF_G = 2 * 32 * RS  , OFF_B = OFF_G + 4096, OFF_LG = OFF_B + 4096  , OFF_CNT = OFF_LG + 8 * 2112  ;
    static_assert(OFF_CNT + 256 <= LDS_BYTES, "router LDS map");
    LAS unsigned char* WH = F.lds; LAS unsigned char* WL = F.lds + OFF_LO;
    LAS float* LG = (LAS float*)(F.lds + OFF_G); LAS float* LB = (LAS float*)(F.lds + OFF_B);
    LAS float* lgt = (LAS float*)(F.lds + OFF_LG + F.wave * 2112);
    LAS unsigned* lcnt = (LAS unsigned*)(F.lds + OFF_CNT);
    {
        f32x4 wa[8], wb[8];
#pragma unroll
        for (int u_ = 0; u_ < 8; ++u_) { const int i = F.tid + 512 * u_, nq = i & 7, k2 = i >> 3;
            wa[u_] = *(const f32x4*)(wr + (size_t)(2 * k2) * NE + 4 * nq); wb[u_] = *(const f32x4*)(wr + (size_t)(2 * k2 + 1) * NE + 4 * nq); }
#pragma unroll
        for (int u_ = 0; u_ < 8; ++u_) { const int i = F.tid + 512 * u_, nq = i & 7, k2 = i >> 3;
#pragma unroll
            for (int c = 0; c < 4; ++c) {
                const float w0 = wa[u_][c], w1 = wb[u_][c];
                const unsigned h0 = f2bf(w0), h1 = f2bf(w1);
                const float r0 = w0 - __uint_as_float(h0 << 16), r1 = w1 - __uint_as_float(h1 << 16);
                *(LAS unsigned*)(WH + (4 * nq + c) * RS + k2 * 4) = h0 | (h1 << 16);
                *(LAS unsigned*)(WL + (4 * nq + c) * RS + k2 * 4) = pk2(r0, r1);
            } }
    }
    for (int i = F.tid; i < DM; i += 512) { LG[i] = A.in[I_LNMIX_G][i]; LB[i] = A.in[I_LNMIX_B][i]; }
    if (F.tid < 64) lcnt[F.tid] = 0u;
    __syncthreads();
    const int fr = F.lane & 15, kg = F.lane >> 4;
    const int ntask = T / 16, NGW = F.G * 8;
    const int rounds = (ntask + NGW - 1) / NGW;
    for (int rd = 0; rd < rounds; ++rd) {
        const int task = rd * NGW + F.vcu * 8 + F.wave;
        const bool live = task < ntask;
        int te[4] = {0, 0, 0, 0}; float tw[4] = {0.f, 0.f, 0.f, 0.f}; unsigned lp[4] = {0, 0, 0, 0};
        if (live) {
            const int tok = task * 16 + fr;
            float mean, rstd;
            { const f32x4* sp = (const f32x4*)(ZST + (size_t)tok * 32); float s1 = 0.f, s2 = 0.f;
#pragma unroll
              for (int i = 0; i < 8; ++i) { const f32x4 v = sp[i]; s1 += v.x + v.z; s2 += v.y + v.w; }
              mean = s1 * (1.f / DM); const float var = s2 * (1.f / DM) - mean * mean; rstd = 1.f / sqrtf(fmaxf(var, 0.f) + LN_EPS); }
            f32x4 acc0 = {0.f, 0.f, 0.f, 0.f}, acc1 = {0.f, 0.f, 0.f, 0.f};
            const bf16_t* zp = Z + (size_t)tok * DM + 8 * kg; unsigned char* h8 = H1F8 + (size_t)tok * DM + 8 * kg;
#pragma unroll 8
            for (int kk = 0; kk < 32; ++kk) {
                const u32x4 zr = *(const u32x4*)(zp + 32 * kk); const f32x4 z0 = {bflo(zr.x), bfhi(zr.x), bflo(zr.y), bfhi(zr.y)}, z1 = {bflo(zr.z), bfhi(zr.z), bflo(zr.w), bfhi(zr.w)};
                const f32x4 g0 = *(LAS const f32x4*)(LG + 32 * kk + 8 * kg), g1 = *(LAS const f32x4*)(LG + 32 * kk + 8 * kg + 4);
                const f32x4 b0 = *(LAS const f32x4*)(LB + 32 * kk + 8 * kg), b1 = *(LAS const f32x4*)(LB + 32 * kk + 8 * kg + 4);
                const f32x4 x0 = (z0 - mean) * rstd * g0 + b0, x1 = (z1 - mean) * rstd * g1 + b1;
                u32x4 hi; hi.x = cvt_pk_bf16(x0.x, x0.y); hi.y = cvt_pk_bf16(x0.z, x0.w); hi.z = cvt_pk_bf16(x1.x, x1.y); hi.w = cvt_pk_bf16(x1.z, x1.w);
                { unsigned w0 = 0u, w1 = 0u;
                  w0 = __builtin_amdgcn_cvt_pk_fp8_f32(x0.x, x0.y, w0, false); w0 = __builtin_amdgcn_cvt_pk_fp8_f32(x0.z, x0.w, w0, true);
                  w1 = __builtin_amdgcn_cvt_pk_fp8_f32(x1.x, x1.y, w1, false); w1 = __builtin_amdgcn_cvt_pk_fp8_f32(x1.z, x1.w, w1, true);
                  *(u32x2*)(h8 + 32 * kk) = (u32x2){w0, w1}; }
                u32x4 lo; lo.x = cvt_pk_bf16(x0.x - bflo(hi.x), x0.y - bfhi(hi.x)); lo.y = cvt_pk_bf16(x0.z - bflo(hi.y), x0.w - bfhi(hi.y));
                lo.z = cvt_pk_bf16(x1.x - bflo(hi.z), x1.y - bfhi(hi.z)); lo.w = cvt_pk_bf16(x1.z - bflo(hi.w), x1.w - bfhi(hi.w));
                const bf16x8 ah = __builtin_bit_cast(bf16x8, hi), al = __builtin_bit_cast(bf16x8, lo);
                const int bo = fr * RS + (32 * kk + 8 * kg) * 2;
                const bf16x8 wh0 = *(LAS const bf16x8*)(WH + bo), wh1 = *(LAS const bf16x8*)(WH + bo + 16 * RS), wl0 = *(LAS const bf16x8*)(WL + bo), wl1 = *(LAS const bf16x8*)(WL + bo + 16 * RS);
                acc0 = __builtin_amdgcn_mfma_f32_16x16x32_bf16(ah, wh0, acc0, 0, 0, 0); acc1 = __builtin_amdgcn_mfma_f32_16x16x32_bf16(ah, wh1, acc1, 0, 0, 0);
                acc0 = __builtin_amdgcn_mfma_f32_16x16x32_bf16(ah, wl0, acc0, 0, 0, 0); acc1 = __builtin_amdgcn_mfma_f32_16x16x32_bf16(ah, wl1, acc1, 0, 0, 0);
                acc0 = __builtin_amdgcn_mfma_f32_16x16x32_bf16(al, wh0, acc0, 0, 0, 0); acc1 = __builtin_amdgcn_mfma_f32_16x16x32_bf16(al, wh1, acc1, 0, 0, 0);
            }
            const float br0 = br[fr], br1 = br[16 + fr];
#pragma unroll
            for (int i = 0; i < 4; ++i) { lgt[(4 * kg + i) * 33 + fr] = acc0[i] + br0; lgt[(4 * kg + i) * 33 + 16 + fr] = acc1[i] + br1; }
            asm volatile("s_waitcnt lgkmcnt(0)" ::: "memory");
            if (F.lane < 16) {
                float lg[NE];
#pragma unroll
                for (int e = 0; e < NE; ++e) lg[e] = lgt[F.lane * 33 + e];
                float tv[4];
#pragma unroll
                for (int r = 0; r < 4; ++r) {
                    float best = -INFINITY; int bi = 0;
#pragma unroll
                    for (int e = 0; e < NE; ++e) { const bool c = lg[e] > best; best = c ? lg[e] : best; bi = c ? e : bi; }
#pragma unroll
                    for (int e = 0; e < NE; ++e) lg[e] = (e == bi) ? -INFINITY : lg[e];
                    te[r] = bi; tv[r] = best;
                }
                const float e1 = __expf(tv[1] - tv[0]), e2 = __expf(tv[2] - tv[0]), e3 = __expf(tv[3] - tv[0]); const float inv = 1.f / (1.f + e1 + e2 + e3);
                tw[0] = inv; tw[1] = e1 * inv; tw[2] = e2 * inv; tw[3] = e3 * inv;
#pragma unroll
                for (int r = 0; r < 4; ++r) lp[r] = atomicAdd((unsigned*)(lcnt + te[r]), 1u);
            }
        }
        __syncthreads();
        if (F.tid < 32) { const unsigned c = lcnt[F.tid]; lcnt[32 + F.tid] = c ? atomicAdd(&ECNT[F.tid], c) : 0u; }
        __syncthreads();
        if (live && F.lane < 16) {
            const size_t tok = (size_t)task * 16 + F.lane;
            int4 pe = {te[0], te[1], te[2], te[3]};
            int4 pp = {(int)(lcnt[32 + te[0]] + lp[0]), (int)(lcnt[32 + te[1]] + lp[1]), (int)(lcnt[32 + te[2]] + lp[2]), (int)(lcnt[32 + te[3]] + lp[3])};
            *(int4*)(TKE + tok * 4) = pe; *(int4*)(TKP + tok * 4) = pp;
#pragma unroll
            for (int r = 0; r < 4; ++r) { const size_t o_ = (size_t)te[r] * T + (r == 0 ? pp.x : r == 1 ? pp.y : r == 2 ? pp.z : pp.w); RT[o_] = (int)tok; RW[o_] = tw[r]; }
        }
        __syncthreads();
        if (F.tid < 32) lcnt[F.tid] = 0u;
        __syncthreads();
    }
}

__device__ __forceinline__ void moe_table(const Ctx& F) {
    const unsigned* ECNT = (const unsigned*)(F.ws + WS_CTL) + CW_ECNT;
    LAS int* tab = (LAS int*)(F.lds + LDS_MOE);
    __syncthreads();
    if (F.tid < 64) {
        const int c = (F.lane < NE) ? (int)__hip_atomic_load(ECNT + F.lane, __ATOMIC_RELAXED, __HIP_MEMORY_SCOPE_AGENT) : 0;
        const int padded = (c + 255) / 256 * 256;
        int inc = padded;
#pragma unroll
        for (int o = 1; o < 64; o <<= 1) { const int t = __shfl_up(inc, o); if (F.lane >= o) inc += t; }
        if (F.lane < NE) tab[32 + F.lane] = inc - padded;
        if (F.lane == NE - 1) { tab[64] = inc; tab[0] = inc / 256; }
    }
    __syncthreads();
    const int ntiles = tab[0];
    for (int i = F.tid; i < ntiles; i += 512) { int e = 0; for (int k = 1; k < NE; ++k) if (i * 256 >= tab[32 + k]) e = k; tab[128 + 2 * i] = e; tab[129 + 2 * i] = i - tab[32 + e] / 256; }
    __syncthreads();
}

__device__ __forceinline__ void ln_stats16(const float* st, int lane, float& mean, float& rstd) {
    float s1 = 0.f, s2 = 0.f;
    if (lane < 16) { const f32x2 p = *(const f32x2*)(st + 2 * lane); s1 = p.x; s2 = p.y; }
    s1 = wave_sum(s1); s2 = wave_sum(s2);
    mean = s1 * (1.f / DM); const float var = s2 * (1.f / DM) - mean * mean; rstd = 1.f / sqrtf(fmaxf(var, 0.f) + LN_EPS);
}
__device__ __forceinline__ void ph_final(const Ctx& F) {
    const Args& A = *F.a;
    const bf16_t* Z = (const bf16_t*)(F.ws + WS_Z); const float* ZST = (const float*)(F.ws + WS_ZST); const unsigned char* YS = F.ws + WS_YS; const int* TKE = (const int*)(F.ws + WS_TKE); const int* TKP = (const int*)(F.ws + WS_TKP);
    const LAS int* tab = (const LAS int*)(F.lds + LDS_MOE);
    const int gw = F.vcu * 8 + F.wave, NGW = F.G * 8;
    f32x4 g2[4], b2[4], g1[4], b1[4];
#pragma unroll
    for (int j = 0; j < 4; ++j) { g2[j] = *((const f32x4*)A.in[I_LNF_G] + F.lane + 64 * j); b2[j] = *((const f32x4*)A.in[I_LNF_B] + F.lane + 64 * j);
        g1[j] = *((const f32x4*)A.in[I_LNMIX_G] + F.lane + 64 * j) * ALPHA; b1[j] = *((const f32x4*)A.in[I_LNMIX_B] + F.lane + 64 * j) * ALPHA; }
    for (int m = gw; m < T; m += NGW) {
        float mean, rstd; ln_stats16(ZST + (size_t)m * 32, F.lane, mean, rstd);
        const u32x2* hr = (const u32x2*)(Z + (size_t)m * DM) + F.lane;
        f32x4 v[4];
#pragma unroll
        for (int j = 0; j < 4; ++j) { const u32x2 hb = hr[64 * j]; v[j] = ((f32x4){bflo(hb.x), bfhi(hb.x), bflo(hb.y), bfhi(hb.y)} - mean) * rstd * g1[j] + b1[j]; }
#pragma unroll
        for (int k = 0; k < 4; ++k) {
            const int row = tab[32 + TKE[(size_t)m * 4 + k]] + TKP[(size_t)m * 4 + k]; const unsigned* yr = (const unsigned*)(YS + (size_t)row * DM) + F.lane;
#pragma unroll
            for (int j = 0; j < 4; ++j) { const unsigned y = yr[64 * j]; const f32x2v f0 = __builtin_amdgcn_cvt_pk_f32_fp8((int)y, false), f1 = __builtin_amdgcn_cvt_pk_f32_fp8((int)y, true);
                v[j].x += 0.0625f * f0.x; v[j].y += 0.0625f * f0.y; v[j].z += 0.0625f * f1.x; v[j].w += 0.0625f * f1.y; }
        }
        float s = 0.f;
#pragma unroll
        for (int j = 0; j < 4; ++j) s += (v[j].x + v[j].y) + (v[j].z + v[j].w);
        const float mu = wave_sum(s) * (1.f / DM); float s2 = 0.f;
#pragma unroll
        for (int j = 0; j < 4; ++j) { v[j] = v[j] - mu; s2 += (v[j].x * v[j].x + v[j].y * v[j].y) + (v[j].z * v[j].z + v[j].w * v[j].w); }
        const float rs = 1.f / sqrtf(wave_sum(s2) * (1.f / DM) + LN_EPS);
        f32x4* orow = (f32x4*)(A.out + (size_t)m * DM) + F.lane;
#pragma unroll
        for (int j = 0; j < 4; ++j) orow[64 * j] = v[j] * rs * g2[j] + b2[j];
    }
}

#define XB_TMO      128
#define XB_XCNT(j)  (256  + 64 * (j))
#define XB_XSUB(j)  (1280 + 64 * (j))
#define XB_XGEN(j)  (2304 + 64 * (j))
#define XB_TOP      3328
#define XB_TOPGEN   3392
#define XCD_BAR_WORDS 3456
#define XB_SPIN_CAP (1u << 18)
__device__ __forceinline__ unsigned xb_ld(unsigned* p)              { return __hip_atomic_load(p, __ATOMIC_RELAXED, __HIP_MEMORY_SCOPE_AGENT); }
__device__ __forceinline__ unsigned xb_add(unsigned* p, unsigned v) { return __hip_atomic_fetch_add(p, v, __ATOMIC_RELAXED, __HIP_MEMORY_SCOPE_AGENT); }
__device__ __forceinline__ unsigned xb_xcc_id() { return (unsigned)__builtin_amdgcn_s_getreg((3 << 11) | 20) & 0xFu; }
#define XB_SPIN(cond, bar) do { unsigned _sp = 0; while (cond) { __builtin_amdgcn_s_sleep(1); \
    if ((++_sp & 255u) == 0u) { if (xb_ld(&(bar)[XB_TMO])) break; if (_sp > XB_SPIN_CAP) { atomicAdd(&(bar)[XB_TMO], 1u); break; } } } } while (0)
__device__ __forceinline__ void xcd_barrier_complete(unsigned* bar, unsigned x, unsigned& nloc, unsigned& nx) {
    const unsigned G = gridDim.x * gridDim.y * gridDim.z;
    unsigned sum, cnt, mine, sp = 0u;
    for (;;) {
        sum = 0u; cnt = 0u; mine = 0u;
#pragma unroll
        for (unsigned j = 0; j < 16; ++j) { const unsigned c = xb_ld(&bar[XB_XCNT(j)]); sum += c; cnt += (c > 0u) ? 1u : 0u; mine = (j == x) ? c : mine; }
        if (sum == G) break;
        __builtin_amdgcn_s_sleep(1);
        if ((++sp & 255u) == 0u) { if (xb_ld(&bar[XB_TMO])) break; if (sp > XB_SPIN_CAP) { atomicAdd(&bar[XB_TMO], 1u); break; } }
    }
    nloc = mine > 0u ? mine : 1u; nx = cnt > 0u ? cnt : 1u;
}
__device__ __forceinline__ void xcd_barrier(unsigned* bar, volatile LAS unsigned* st, unsigned x, bool leader_thread) {
    asm volatile("s_waitcnt vmcnt(0)" ::: "memory");
    __syncthreads();
    if (leader_thread) {
        __builtin_amdgcn_s_waitcnt(0);
        unsigned nloc = st[0], nx = st[1];
        if (nloc == 0u) { xcd_barrier_complete(bar, x, nloc, nx); st[0] = nloc; st[1] = nx; }
        const unsigned old = xb_add(&bar[XB_XSUB(x)], 1u);
        const unsigned gen = old / nloc;
        if (old + 1u == (gen + 1u) * nloc) {
            __builtin_amdgcn_fence(__ATOMIC_RELEASE, "agent");
            asm volatile("s_waitcnt vmcnt(0)" ::: "memory");
            const unsigned og = xb_add(&bar[XB_TOP], 1u);
            const unsigned tg = og / nx;
            if (og + 1u == (tg + 1u) * nx) xb_add(&bar[XB_TOPGEN], 1u);
            else XB_SPIN(xb_ld(&bar[XB_TOPGEN]) == tg, bar);
            __builtin_amdgcn_fence(__ATOMIC_ACQUIRE, "agent");
            xb_add(&bar[XB_XGEN(x)], 1u);
            asm volatile("s_waitcnt vmcnt(0)" ::: "memory");
        } else {
            XB_SPIN(xb_ld(&bar[XB_XGEN(x)]) == gen, bar);
            __builtin_amdgcn_fence(__ATOMIC_ACQUIRE, "agent");
            asm volatile("s_waitcnt vmcnt(0)" ::: "memory");
        }
    }
    __syncthreads();
}

template <bool COOP>
__global__ void __launch_bounds__(512, 2) mega(Args args) {
    extern __shared__ __attribute__((aligned(16))) unsigned char lds_raw[];
    Ctx F;
    const int wave0 = __builtin_amdgcn_readfirstlane(threadIdx.x >> 6);
#define MKCTX() do { F.a = &args; F.ws = args.ws; F.lds = (LAS unsigned char*)lds_raw; F.ldsg = lds_raw; F.lane = lane_id_asm(); F.wave = wave0; F.tid = wave0 * 64 + F.lane; \
    F.G = gridDim.x; { const int bx = blockIdx.x; F.vcu = (F.G % 8 == 0) ? (bx % 8) * (F.G / 8) + bx / 8 : bx; } } while (0)
    MKCTX();
    const int lo = args.ph_lo, hi = args.ph_hi;
    unsigned char* ws = args.ws;
#ifndef PHMASK
#define PHMASK 0xFFFF
#endif
#define IN(k) (((PHMASK >> (k)) & 1) && lo <= (k) && (k) < hi)
    unsigned* barw = (unsigned*)(ws + WS_CTL) + CW_BAR; volatile LAS unsigned* bst = (volatile LAS unsigned*)((LAS unsigned char*)lds_raw + LDS_BYTES - 64);
    const unsigned my_xcc = xb_xcc_id();
    if (COOP) { if (threadIdx.x == 0) { bst[0] = 0u; bst[1] = 0u; (void)xb_add(&barw[XB_XCNT(my_xcc)], 1u); } __syncthreads(); }
#define SEAM(k) do { if (COOP && IN(k) && IN((k) + 1)) { if (args.ph_hi > 1000) cg::this_grid().sync();   xcd_barrier(barw, bst, my_xcc, wave0 == 0 && lane_id_asm() == 0); } } while (0)
    if (IN(0)) { MKCTX(); ph_prologue(F); } SEAM(0);
    if (IN(1)) {
        constexpr int NSLOT = 4;
        const int wslot = (F.G % 8 == 0) ? ((int)blockIdx.x / 8) % NSLOT : (int)blockIdx.x % NSLOT;
        if (wslot == 0) { MKCTX(); ph_wconv(F); }
        {
            pg8::Gemm g{(const bf16_t*)(ws + WS_H0), (const bf16_t*)(ws + WS_WIN), DM, DM, DM, nullptr}; pg8::StaticOrder S; S.init(T, PN8_LO * 256, F.G, (int)blockIdx.x, 0);
            const pg8::Epi1 E{(bf16_t*)(ws + WS_YAB), (bf16_t*)(ws + WS_GV), ws + WS_Q, ws + WS_K, ws + WS_V, (bf16_t*)(ws + WS_SA), (bf16_t*)(ws + WS_SB), (float*)(ws + WS_GVST), (float*)(ws + WS_KMEAN), 1.0f, 0.f};
            pg8::gemm_phase<pg8::Epi1, pg8::StaticOrder, true>(F.lds, g, S, E, wave0);
        }
#pragma unroll 1
        for (int part = 0; part < 2; ++part) {
            if (wslot == 1 + part) { MKCTX(); ph_wconv(F); }
            const pg8::Epi1 E{(bf16_t*)(ws + WS_YAB), (bf16_t*)(ws + WS_GV), ws + WS_Q, ws + WS_K, ws + WS_V, (bf16_t*)(ws + WS_SA), (bf16_t*)(ws + WS_SB), (float*)(ws + WS_GVST), (float*)(ws + WS_KMEAN), 0.03125f, 0.f};
            pg8::Gemm g{(const bf16_t*)(ws + WS_H0F8), (const bf16_t*)(ws + WS_WIN8), DM / 2, DM / 2, DM / 2, nullptr}; pg8::StaticOrder S; if (part == 0) S.init(T, 12 * 256, F.G, (int)blockIdx.x, 4, 4, 12); else S.init(T, 12 * 256, F.G, (int)blockIdx.x, 8);
            pg8::gemm_phase<pg8::Epi1, pg8::StaticOrder, true, true>(F.lds, g, S, E, wave0);
        }
        if (wslot == 3) { MKCTX(); ph_wconv(F); }
    } SEAM(1);
    if (IN(2)) { MKCTX(); ph_mixer_a(F); __syncthreads(); ph_gate(F); } SEAM(2);
    if (IN(3)) { } if (COOP && IN(3) && IN(4)) { }
    if (IN(4)) { MKCTX(); ph_attn_partial(F); } SEAM(4);
    if (IN(5)) { MKCTX(); ph_attn_own(F); } SEAM(5);
    if (IN(6)) {
        pg8::Gemm g{(const bf16_t*)(ws + WS_YA8), (const bf16_t*)(ws + WS_WAB), 2048 / 2, 2048 / 2, 2048 / 2, nullptr}; pg8::StaticOrder S; S.init(T, DM, F.G, (int)blockIdx.x);
        pg8::Epi2 E{ws + WS_SA, ws + WS_SB, (bf16_t*)(ws + WS_MG)};
        pg8::gemm_phase<pg8::Epi2, pg8::StaticOrder, true, true>(F.lds, g, S, E, wave0);
    } SEAM(6);
    if (IN(7)) {
        pg8::Gemm g{(const bf16_t*)(ws + WS_MG), (const bf16_t*)(ws + WS_WOUT), DM, DM, DM, nullptr}; pg8::StaticOrder S; S.init(T, DM, F.G, (int)blockIdx.x);
        pg8::Epi3 E{(const bf16_t*)(ws + WS_H0), (bf16_t*)(ws + WS_Z), (float*)(ws + WS_ZST)};
        pg8::gemm_phase<pg8::Epi3, pg8::StaticOrder, true>(F.lds, g, S, E, wave0);
    } SEAM(7);
    if (IN(8)) { MKCTX(); ph_router(F); } SEAM(8);
    if (IN(9)) { } if (COOP && IN(9) && IN(10)) { }
    if (IN(10)) {
        MKCTX(); moe_table(F);
        pg8::Gemm g{(const bf16_t*)(ws + WS_H1F8), (const bf16_t*)(ws + WS_WUP), DM / 2, DM / 2, DM / 2, (const int*)(ws + WS_RT)}; pg8::MoeOrder S;   S.init((const LAS int*)(F.lds + LDS_MOE), 8, F.G, (int)blockIdx.x);
        pg8::Epi4 E{args.in[I_BUP], ws + WS_ACT};
        pg8::gemm_phase<pg8::Epi4, pg8::MoeOrder, true, true, true>(F.lds, g, S, E, wave0);
    } SEAM(10);
    if (IN(11)) {
        MKCTX(); moe_table(F);
        pg8::Gemm g{(const bf16_t*)(ws + WS_ACT), (const bf16_t*)(ws + WS_WDN), FF / 2, FF / 2, FF / 2, nullptr}; pg8::MoeOrder S; S.init((const LAS int*)(F.lds + LDS_MOE), 4, F.G, (int)blockIdx.x);
        pg8::Epi5 E{args.in[I_BDN], (const float*)(ws + WS_RW), ws + WS_YS};
        pg8::gemm_phase<pg8::Epi5, pg8::MoeOrder, true, true>(F.lds, g, S, E, wave0);
    } SEAM(11);
    if (IN(12)) { MKCTX(); moe_table(F); ph_final(F); }
#undef IN
#undef SEAM
}

extern "C" void kernel_launch(void* const* d_in, const int* in_sizes, int n_in, void* d_out, int out_size, void* d_ws, size_t ws_size, hipStream_t stream) {
    static int grid = 0;
    if (grid == 0) {
        if (n_in != 21 || in_sizes[0] != T * DM || out_size != T * DM || ws_size < WS_END) { fprintf(stderr, "kernel_launch: unexpected shapes (n_in %d, in0 %d, out %d, ws %zu)\n", n_in, n_in > 0 ? in_sizes[0] : -1, out_size, ws_size); grid = -1; return; }
        int dev = 0, cus = 0, per_cu = 0;
        hipGetDevice(&dev); hipDeviceGetAttribute(&cus, hipDeviceAttributeMultiprocessorCount, dev);
        const void* fn = MK_COOP ? (const void*)mega<true> : (const void*)mega<false>;
        hipFuncSetAttribute(fn, hipFuncAttributeMaxDynamicSharedMemorySize, LDS_BYTES);
        hipOccupancyMaxActiveBlocksPerMultiprocessor(&per_cu, fn, 512, LDS_BYTES);
        (void)hipGetLastError();
        if (per_cu < 1) { fprintf(stderr, "kernel_launch: occupancy query says %d blocks/CU\n", per_cu); per_cu = 1; }
        grid = cus * 1;
    }
    if (grid < 0) return;
    hipMemsetAsync((char*)d_ws + WS_CTL, 0, CTL_ZERO_BYTES, stream);
    Args a{};
    for (int i = 0; i < 21; ++i) a.in[i] = (const float*)d_in[i];
    a.out = (float*)d_out; a.ws = (unsigned char*)d_ws;
#if MK_COOP
    a.ph_lo = 0; a.ph_hi = NPHASE;
    void* kargs[] = {&a};
    hipError_t e = hipLaunchCooperativeKernel((const void*)mega<true>, dim3(grid), dim3(512), kargs, LDS_BYTES, stream);
    if (e != hipSuccess) fprintf(stderr, "cooperative launch failed: %s (grid %d)\n", hipGetErrorString(e), grid);
#else
    for (int p = 0; p < NPHASE; ++p) { a.ph_lo = p; a.ph_hi = p + 1; hipLaunchKernelGGL(mega<false>, dim3(grid), dim3(512), LDS_BYTES, stream, a); }
#endif
}
```
